# Optimizing an MI355X kernel written in HIP

```python
import math
import jax, jax.numpy as jnp
from jax import lax
import numpy as np

D_MODEL = 1024
BATCH = 4
SEQ = 4096
DEPTH = 2
DEC_BATCH = 8
DEC_SEQ = 64
PAST_LEN = 1024

CHUNK = 64
DA_HEADS = 4
DA_HEAD_DIM = 64
DA_VDIM = 2 * DA_HEAD_DIM
DA_WIDTH = DA_HEADS * DA_VDIM
ML_HEADS = 4
ML_HEAD_DIM = 64
ML_WIDTH = ML_HEADS * ML_HEAD_DIM
ML_CONV = 4
CM_GROUPS = 4
CM_WIDTH = 256
CM_GROUP_DIM = CM_WIDTH // CM_GROUPS
CM_CHUNK = 128
MIX_WIDTH = DA_WIDTH + ML_WIDTH + CM_WIDTH
SPLIT_SIZES = (DA_WIDTH, DA_WIDTH, DA_WIDTH, ML_WIDTH, ML_WIDTH, ML_WIDTH, ML_HEADS, ML_HEADS, CM_WIDTH, CM_WIDTH)
IN_WIDTH = sum(SPLIT_SIZES)
PEER_HEADS = 8
PEER_KEYS = 128
PEER_EXPERTS = PEER_KEYS * PEER_KEYS
PEER_QDIM = 256
PEER_HALF = PEER_QDIM // 2
PEER_TOPK = 16
PEER_BLOCK = 128
REL_BUCKETS = 32
REL_MAX_DIST = 128
QBLOCK = 128
EPS = 1e-6
NEG_INF = -1e30

kernel_name = "hybrid_stream_encoder_step"


def rmsnorm(x, g):
    xf = x.astype(jnp.float32)
    y = xf * lax.rsqrt(jnp.mean(xf * xf, axis=-1, keepdims=True) + EPS)
    return (y * g.astype(jnp.float32)).astype(x.dtype)


def split_proj(p):
    offs = [int(o) for o in np.cumsum(SPLIT_SIZES)[:-1]]
    return jnp.split(p, offs, axis=-1)


def rel_bucket(rel):
    half = REL_BUCKETS // 2
    max_exact = half // 2
    ret = jnp.where(rel > 0, half, 0)
    n = jnp.abs(rel)
    nf = jnp.maximum(n, 1).astype(jnp.float32)
    large = max_exact + (jnp.log(nf / max_exact) / math.log(REL_MAX_DIST / max_exact)
                         * (half - max_exact)).astype(jnp.int32)
    large = jnp.minimum(large, half - 1)
    return ret + jnp.where(n < max_exact, n, large)


def rel_bias(q_pos, k_pos, table):
    b = rel_bucket(k_pos[None, :] - q_pos[:, None])
    return jnp.transpose(table[b], (2, 0, 1)).astype(jnp.float32)


def diff_weights(q, k, bias, mask, lam):
    s = jnp.einsum('bqhcd,bkhcd->bhcqk', q, k).astype(jnp.float32) * (DA_HEAD_DIM ** -0.5)
    s = s + bias[None, :, None]
    if mask is not None:
        s = jnp.where(mask, s, NEG_INF)
    p = jax.nn.softmax(s, axis=-1)
    return p[:, :, 0] - lam * p[:, :, 1]


def diff_attention_prompt(q, k, v, rel_table, lam):
    B, S = q.shape[0], q.shape[1]
    nb = S // QBLOCK
    kk = k.reshape(B, S, DA_HEADS, 2, DA_HEAD_DIM)
    k_pos = jnp.arange(S)
    qb = jnp.moveaxis(q.reshape(B, nb, QBLOCK, DA_HEADS, 2, DA_HEAD_DIM), 1, 0)

    def block(args):
        qi, bi = args
        q_pos = bi * QBLOCK + jnp.arange(QBLOCK)
        mask = (k_pos[None, :] // CHUNK) <= (q_pos[:, None] // CHUNK)
        a = diff_weights(qi, kk, rel_bias(q_pos, k_pos, rel_table), mask, lam)
        return jnp.einsum('bhqk,bkhv->bqhv', a.astype(v.dtype), v)

    o = lax.map(block, (qb, jnp.arange(nb)))
    return jnp.moveaxis(o, 0, 1).reshape(B, S, DA_HEADS, DA_VDIM)


def diff_attention_step(q, k_all, v_all, rel_table, lam, past_len):
    B, L = q.shape[0], q.shape[1]
    K = k_all.shape[1]
    kk = k_all.reshape(B, K, DA_HEADS, 2, DA_HEAD_DIM)
    q_pos = past_len + jnp.arange(L)
    k_pos = jnp.arange(K)
    a = diff_weights(q, kk, rel_bias(q_pos, k_pos, rel_table), None, lam)
    return jnp.einsum('bhqk,bkhv->bqhv', a.astype(v_all.dtype), v_all)


def causal_conv(x, prev, w, b):
    L = x.shape[1]
    xp = jnp.concatenate([prev, x], axis=1)
    y = b
    for i in range(ML_CONV):
        y = y + xp[:, i:i + L] * w[i]
    return y, xp[:, xp.shape[1] - (ML_CONV - 1):]


def mlstm_chunk(state, inp):
    C, n, m = state
    q, k, v, ig, lf = inp
    L = q.shape[2]
    F = jnp.cumsum(lf, axis=-1)
    causal = jnp.tril(jnp.ones((L, L), dtype=bool))
    D = jnp.where(causal, F[..., :, None] - F[..., None, :] + ig[..., None, :], NEG_INF)
    inter = F + m[..., None]
    m_t = jnp.maximum(inter, jnp.max(D, axis=-1))
    Sw = jnp.einsum('bhtd,bhsd->bhts', q, k) * jnp.exp(D - m_t[..., None])
    iw = jnp.exp(inter - m_t)
    num = jnp.einsum('bhts,bhsv->bhtv', Sw, v) + iw[..., None] * jnp.einsum('bhtd,bhdv->bhtv', q, C)
    den = jnp.sum(Sw, axis=-1) + iw * jnp.einsum('bhtd,bhd->bht', q, n)
    h = num / jnp.maximum(jnp.abs(den), jnp.exp(-m_t))[..., None]
    FL = F[..., -1]
    tail = FL[..., None] - F + ig
    m_new = jnp.maximum(FL + m, jnp.max(tail, axis=-1))
    wc = jnp.exp(FL + m - m_new)
    ws = jnp.exp(tail - m_new[..., None])
    C_new = wc[..., None, None] * C + jnp.einsum('bhs,bhsd,bhsv->bhdv', ws, k, v)
    n_new = wc[..., None] * n + jnp.einsum('bhs,bhsd->bhd', ws, k)
    return (C_new, n_new, m_new), h


def peer(x2d, w_q, sub_keys, u_tab, v_tab):
    T = x2d.shape[0]
    Tp = ((T + PEER_BLOCK - 1) // PEER_BLOCK) * PEER_BLOCK
    xb = jnp.pad(x2d, ((0, Tp - T), (0, 0))).reshape(Tp // PEER_BLOCK, PEER_BLOCK, D_MODEL)
    keys = sub_keys.astype(jnp.float32)

    def block(xi):
        q = (xi @ w_q).astype(jnp.float32).reshape(PEER_BLOCK, PEER_HEADS, PEER_QDIM)
        q = q * lax.rsqrt(jnp.mean(q * q, axis=-1, keepdims=True) + EPS)
        q = q.reshape(PEER_BLOCK, PEER_HEADS, 2, PEER_HALF)
        s = jnp.einsum('thcd,hckd->thck', q, keys)
        v1, i1 = lax.top_k(s[:, :, 0], PEER_TOPK)
        v2, i2 = lax.top_k(s[:, :, 1], PEER_TOPK)
        cand = (v1[..., :, None] + v2[..., None, :]).reshape(PEER_BLOCK, PEER_HEADS, PEER_TOPK * PEER_TOPK)
        vs, ci = lax.top_k(cand, PEER_TOPK)
        e = (jnp.take_along_axis(i1, ci // PEER_TOPK, axis=-1) * PEER_KEYS
             + jnp.take_along_axis(i2, ci % PEER_TOPK, axis=-1))
        g = jax.nn.softmax(vs, axis=-1)
        act = jax.nn.gelu(jnp.einsum('thkd,td->thk', u_tab[e], xi).astype(jnp.float32), approximate=False)
        return jnp.einsum('thk,thkd->td', (g * act).astype(v_tab.dtype), v_tab[e])

    y = lax.map(block, xb).reshape(Tp, D_MODEL)
    return y[:T]


def layer(x, past, l, rel_table, norm1_g, w_in, da_lambda, da_subln_g, ml_conv_w, ml_conv_b,
          ml_wq, ml_wk, ml_gate_b, ml_norm_g, ml_skip, cm_norm_g, cm_ws, cm_b, w_out,
          norm2_g, peer_wq, peer_keys, peer_u, peer_v):
    B, L = x.shape[0], x.shape[1]
    f32 = jnp.float32
    lam_init = 0.8 - 0.6 * math.exp(-0.3 * l)
    xn = rmsnorm(x, norm1_g)
    qa, ka, va, mc, mv, mo, mi, mf, cu, cv = split_proj(xn @ w_in)

    q = qa.reshape(B, L, DA_HEADS, 2, DA_HEAD_DIM)
    k_rows = ka.reshape(B, L, DA_HEADS, 2 * DA_HEAD_DIM)
    v_rows = va.reshape(B, L, DA_HEADS, DA_VDIM)
    lp = da_lambda.astype(f32)
    lam = jnp.exp(jnp.sum(lp[0] * lp[1])) - jnp.exp(jnp.sum(lp[2] * lp[3])) + lam_init
    if past is None:
        o_da = diff_attention_prompt(q, k_rows, v_rows, rel_table, lam)
    else:
        past_k, past_v = past[0], past[1]
        k_all = jnp.concatenate([past_k, k_rows], axis=1)
        v_all = jnp.concatenate([past_v, v_rows], axis=1)
        o_da = diff_attention_step(q, k_all, v_all, rel_table, lam, past_k.shape[1])
    o_da = (rmsnorm(o_da, da_subln_g) * (1.0 - lam_init)).reshape(B, L, DA_WIDTH)

    prev = jnp.zeros((B, ML_CONV - 1, ML_WIDTH), x.dtype) if past is None else past[5]
    cc, conv_new = causal_conv(mc, prev, ml_conv_w, ml_conv_b)
    cc = jax.nn.silu(cc)
    cch = cc.reshape(B, L, ML_HEADS, ML_HEAD_DIM)
    qm = jnp.einsum('blhd,hde->bhle', cch, ml_wq).astype(f32)
    km = jnp.einsum('blhd,hde->bhle', cch, ml_wk).astype(f32) * (ML_HEAD_DIM ** -0.5)
    vm = jnp.transpose(mv.reshape(B, L, ML_HEADS, ML_HEAD_DIM), (0, 2, 1, 3)).astype(f32)
    ig = jnp.transpose((mi + ml_gate_b[0]).astype(f32), (0, 2, 1))
    lf = jax.nn.log_sigmoid(jnp.transpose((mf + ml_gate_b[1]).astype(f32), (0, 2, 1)))
    if past is None:
        nc = L // CHUNK
        state0 = (jnp.zeros((B, ML_HEADS, ML_HEAD_DIM, ML_HEAD_DIM), f32),
                  jnp.zeros((B, ML_HEADS, ML_HEAD_DIM), f32),
                  jnp.zeros((B, ML_HEADS), f32))

        def to_chunks(t):
            return jnp.moveaxis(t.reshape(t.shape[:2] + (nc, CHUNK) + t.shape[3:]), 2, 0)

        (C_new, n_new, m_new), hs = lax.scan(
            mlstm_chunk, state0,
            (to_chunks(qm), to_chunks(km), to_chunks(vm), to_chunks(ig), to_chunks(lf)))
        h = jnp.moveaxis(hs, 0, 2).reshape(B, ML_HEADS, L, ML_HEAD_DIM)
    else:
        (C_new, n_new, m_new), h = mlstm_chunk(
            (past[2].astype(f32), past[3].astype(f32), past[4].astype(f32)), (qm, km, vm, ig, lf))
    h = jnp.transpose(h, (0, 2, 1, 3))
    hn = rmsnorm(h, ml_norm_g.reshape(ML_HEADS, ML_HEAD_DIM)).reshape(B, L, ML_WIDTH).astype(x.dtype)
    o_ml = (hn + ml_skip * cc) * jax.nn.sigmoid(mo)

    u = jax.nn.gelu(cu, approximate=False)
    vcm = rmsnorm(jax.nn.gelu(cv, approximate=False), cm_norm_g)
    ws = cm_ws * jnp.tril(jnp.ones((CM_CHUNK, CM_CHUNK), cm_ws.dtype))
    vg = vcm.reshape(B, L, CM_GROUPS, CM_GROUP_DIM)
    if past is None:
        nchunk = L // CM_CHUNK
        vgc = vg.reshape(B, nchunk, CM_CHUNK, CM_GROUPS, CM_GROUP_DIM)
        mixed = jnp.einsum('gts,bnsgd->bntgd', ws, vgc) + cm_b.T[None, None, :, :, None]
        mixed = mixed.reshape(B, L, CM_WIDTH)
    else:
        mixed = jnp.einsum('gts,bsgd->btgd', ws[:, :L, :L], vg) + cm_b[:, :L].T[None, :, :, None]
        mixed = mixed.reshape(B, L, CM_WIDTH)
    o_cm = u * mixed

    x = x + jnp.concatenate([o_da, o_ml, o_cm], axis=-1) @ w_out
    xn2 = rmsnorm(x, norm2_g).reshape(B * L, D_MODEL)
    x = x + peer(xn2, peer_wq, peer_keys, peer_u, peer_v).reshape(B, L, D_MODEL)
    if past is None:
        return x, (k_rows, v_rows, C_new, n_new, m_new, conv_new)
    return x, (k_rows, v_rows, C_new, n_new, m_new, conv_new, vcm)


def setup_inputs(seed: int = 0) -> dict:
    key = jax.random.key(seed)
    ks = jax.random.split(key, 32)
    nrm = jax.random.normal
    f32 = jnp.float32
    fb = jnp.linspace(3.0, 6.0, ML_HEADS, dtype=f32)
    gate_b = jnp.stack([0.1 * nrm(ks[12], (DEPTH, ML_HEADS), f32),
                        fb[None, :] + 0.1 * nrm(ks[13], (DEPTH, ML_HEADS), f32)], axis=1)
    return {
        "x_prompt": nrm(ks[0], (BATCH, SEQ, D_MODEL), f32),
        "x_sample": nrm(ks[1], (DEC_BATCH, DEC_SEQ, D_MODEL), f32),
        "cache_k": nrm(ks[2], (DEPTH, DEC_BATCH, PAST_LEN, DA_HEADS, 2 * DA_HEAD_DIM), f32),
        "cache_v": nrm(ks[3], (DEPTH, DEC_BATCH, PAST_LEN, DA_HEADS, DA_VDIM), f32),
        "state_mlstm_c": 0.3 * nrm(ks[4], (DEPTH, DEC_BATCH, ML_HEADS, ML_HEAD_DIM, ML_HEAD_DIM), f32),
        "state_mlstm_n": 0.3 * nrm(ks[5], (DEPTH, DEC_BATCH, ML_HEADS, ML_HEAD_DIM), f32),
        "state_mlstm_m": 0.5 * nrm(ks[6], (DEPTH, DEC_BATCH, ML_HEADS), f32),
        "state_mlstm_conv": nrm(ks[7], (DEPTH, DEC_BATCH, ML_CONV - 1, ML_WIDTH), f32),
        "norm1_g": 1.0 + 0.1 * nrm(ks[8], (DEPTH, D_MODEL), f32),
        "w_in": nrm(ks[9], (DEPTH, D_MODEL, IN_WIDTH), f32) * D_MODEL ** -0.5,
        "da_lambda": 0.1 * nrm(ks[10], (DEPTH, 4, DA_HEAD_DIM), f32),
        "da_subln_g": 1.0 + 0.1 * nrm(ks[11], (DEPTH, DA_VDIM), f32),
        "rel_bias_table": 0.5 * nrm(ks[14], (REL_BUCKETS, DA_HEADS), f32),
        "ml_conv_w": nrm(ks[15], (DEPTH, ML_CONV, ML_WIDTH), f32) * ML_CONV ** -0.5,
        "ml_conv_b": 0.05 * nrm(ks[16], (DEPTH, ML_WIDTH), f32),
        "ml_wq": nrm(ks[17], (DEPTH, ML_HEADS, ML_HEAD_DIM, ML_HEAD_DIM), f32) * ML_HEAD_DIM ** -0.5,
        "ml_wk": nrm(ks[18], (DEPTH, ML_HEADS, ML_HEAD_DIM, ML_HEAD_DIM), f32) * ML_HEAD_DIM ** -0.5,
        "ml_gate_b": gate_b,
        "ml_norm_g": 1.0 + 0.1 * nrm(ks[19], (DEPTH, ML_WIDTH), f32),
        "ml_skip": 1.0 + 0.1 * nrm(ks[20], (DEPTH, ML_WIDTH), f32),
        "cm_norm_g": 1.0 + 0.1 * nrm(ks[21], (DEPTH, CM_WIDTH), f32),
        "cm_ws": nrm(ks[22], (DEPTH, CM_GROUPS, CM_CHUNK, CM_CHUNK), f32) * CM_CHUNK ** -0.5,
        "cm_b": 1.0 + 0.1 * nrm(ks[23], (DEPTH, CM_GROUPS, CM_CHUNK), f32),
        "w_out": nrm(ks[24], (DEPTH, MIX_WIDTH, D_MODEL), f32) * MIX_WIDTH ** -0.5,
        "norm2_g": 1.0 + 0.1 * nrm(ks[25], (DEPTH, D_MODEL), f32),
        "peer_wq": nrm(ks[26], (DEPTH, D_MODEL, PEER_HEADS * PEER_QDIM), f32) * D_MODEL ** -0.5,
        "peer_keys": nrm(ks[27], (DEPTH, PEER_HEADS, 2, PEER_KEYS, PEER_HALF), f32) * PEER_HALF ** -0.5,
        "peer_u": nrm(ks[28], (DEPTH, PEER_EXPERTS, D_MODEL), f32) * D_MODEL ** -0.5,
        "peer_v": 0.1 * nrm(ks[29], (DEPTH, PEER_EXPERTS, D_MODEL), f32),
        "final_g": 1.0 + 0.1 * nrm(ks[30], (D_MODEL,), f32),
    }


def reference(x_prompt, x_sample, cache_k, cache_v, state_mlstm_c, state_mlstm_n, state_mlstm_m,
              state_mlstm_conv, norm1_g, w_in, da_lambda, da_subln_g, rel_bias_table, ml_conv_w,
              ml_conv_b, ml_wq, ml_wk, ml_gate_b, ml_norm_g, ml_skip, cm_norm_g, cm_ws, cm_b,
              w_out, norm2_g, peer_wq, peer_keys, peer_u, peer_v, final_g):
    hp, hs = x_prompt, x_sample
    st_p, st_s = [], []
    for l in range(DEPTH):
        lw = (norm1_g[l], w_in[l], da_lambda[l], da_subln_g[l], ml_conv_w[l], ml_conv_b[l],
              ml_wq[l], ml_wk[l], ml_gate_b[l], ml_norm_g[l], ml_skip[l], cm_norm_g[l], cm_ws[l],
              cm_b[l], w_out[l], norm2_g[l], peer_wq[l], peer_keys[l], peer_u[l], peer_v[l])
        hp, sp = layer(hp, None, l, rel_bias_table, *lw)
        past = (cache_k[l], cache_v[l], state_mlstm_c[l], state_mlstm_n[l], state_mlstm_m[l],
                state_mlstm_conv[l])
        hs, ss = layer(hs, past, l, rel_bias_table, *lw)
        st_p.append(sp)
        st_s.append(ss)
    y_prompt = rmsnorm(hp, final_g)
    y_sample = rmsnorm(hs, final_g)
    new_k_prompt = jnp.stack([s[0] for s in st_p])
    new_v_prompt = jnp.stack([s[1] for s in st_p])
    new_c_prompt = jnp.stack([s[2] for s in st_p])
    new_n_prompt = jnp.stack([s[3] for s in st_p])
    new_m_prompt = jnp.stack([s[4] for s in st_p])
    new_conv_prompt = jnp.stack([s[5] for s in st_p])
    new_k_sample = jnp.stack([s[0] for s in st_s])
    new_v_sample = jnp.stack([s[1] for s in st_s])
    new_c_sample = jnp.stack([s[2] for s in st_s])
    new_n_sample = jnp.stack([s[3] for s in st_s])
    new_m_sample = jnp.stack([s[4] for s in st_s])
    new_conv_sample = jnp.stack([s[5] for s in st_s])
    new_cmv_sample = jnp.stack([s[6] for s in st_s])
    return (y_prompt, y_sample, new_k_prompt, new_v_prompt, new_c_prompt, new_n_prompt, new_m_prompt,
            new_conv_prompt, new_k_sample, new_v_sample, new_c_sample, new_n_sample, new_m_sample,
            new_conv_sample, new_cmv_sample)
```

```cpp
#include <hip/hip_runtime.h>
#include <hip/hip_cooperative_groups.h>
#include <cstdio>
#include <cstdint>

namespace cg = cooperative_groups;

typedef unsigned short bf16_t;
typedef __attribute__((ext_vector_type(8))) __bf16 bf16x8;
typedef __attribute__((ext_vector_type(2))) __bf16 bf16x2;
typedef __attribute__((ext_vector_type(16))) float f32x16;
typedef __attribute__((ext_vector_type(2))) float f32x2;

#define D_MODEL 1024
#define NTOK 16896
#define NPROMPT 16384
#define SEQ 4096
#define NIN 2816
#define EPS 1e-6f
#define LOG2E 1.4426950408889634f
#define SKEYS 1088
#define NCU_UNITS 1056

constexpr size_t O_Y_P = 0;
constexpr size_t O_Y_S = O_Y_P + 16777216;
constexpr size_t O_K_P = O_Y_S + 524288;
constexpr size_t O_V_P = O_K_P + 16777216;
constexpr size_t O_C_P = O_V_P + 16777216;
constexpr size_t O_N_P = O_C_P + 131072;
constexpr size_t O_M_P = O_N_P + 2048;
constexpr size_t O_CONV_P = O_M_P + 32;
constexpr size_t O_K_S = O_CONV_P + 6144;
constexpr size_t O_V_S = O_K_S + 524288;
constexpr size_t O_C_S = O_V_S + 524288;
constexpr size_t O_N_S = O_C_S + 262144;
constexpr size_t O_M_S = O_N_S + 4096;
constexpr size_t O_CONV_S = O_M_S + 64;
constexpr size_t O_CMV_S = O_CONV_S + 12288;

struct Params {
  const float *x_prompt, *x_sample, *cache_k, *cache_v, *st_c, *st_n, *st_m, *st_conv;
  const float *norm1_g, *w_in, *da_lambda, *da_subln_g, *rel_table, *ml_conv_w, *ml_conv_b;
  const float *ml_wq, *ml_wk, *ml_gate_b, *ml_norm_g, *ml_skip, *cm_norm_g, *cm_ws, *cm_b;
  const float *w_out, *norm2_g, *peer_wq, *peer_keys, *peer_u, *peer_v, *final_g;
  float* out;
  float* lam;
  float* lut;
  bf16_t* wt_in;
  float* wg;
  bf16_t* wt_out;
  bf16_t* wt_pq;
  bf16_t* keysb;
  bf16_t* ub;
  bf16_t* vb;
  bf16_t* Kbs;
  bf16_t* Vts;
  float* x;
  bf16_t* xn;
  bf16_t* Qb;
  bf16_t* Kb;
  bf16_t* Vt;
  float* P5;
  float* ig;
  float* lf;
  float* Fc;
  float* cc;
  float* qm;
  float* km;
  float* mst;
  float* mnx;
  float* wcs;
  float* FLs;
  float* U;
  float* un;
  float* Cst;
  float* nst;
  bf16_t* qp;
  float* sc;
  int* eidx;
  float* egate;
};

__device__ __forceinline__ unsigned pack2(float a, float b) {
  f32x2 v = {a, b};
  bf16x2 r = __builtin_convertvector(v, bf16x2);
  return *reinterpret_cast<unsigned*>(&r);
}
__device__ __forceinline__ bf16_t f2bf(float a) { return (bf16_t)(pack2(a, 0.f) & 0xFFFFu); }
__device__ __forceinline__ float bf_lo(unsigned u) { return __uint_as_float(u << 16); }
__device__ __forceinline__ float bf_hi(unsigned u) { return __uint_as_float(u & 0xFFFF0000u); }
__device__ __forceinline__ float gelu_exact(float x) { return 0.5f * x * (1.f + erff(x * 0.70710678118654752f)); }
__device__ __forceinline__ float sigmoidf_(float x) { return 1.f / (1.f + __expf(-x)); }
__device__ __forceinline__ float wave_sum(float v) {
#pragma unroll
  for (int m = 32; m >= 1; m >>= 1) v += __shfl_xor(v, m);
  return v;
}
__device__ __forceinline__ float wave_max(float v) {
#pragma unroll
  for (int m = 32; m >= 1; m >>= 1) v = fmaxf(v, __shfl_xor(v, m));
  return v;
}
__device__ __forceinline__ const float* xrow_in(const Params& p, int l, int t) {
  if (l == 0) return (t < NPROMPT) ? p.x_prompt + (size_t)t * D_MODEL : p.x_sample + (size_t)(t - NPROMPT) * D_MODEL;
  return p.x + (size_t)t * D_MODEL;
}
__device__ __forceinline__ bf16x8 as_bf16x8(uint4 v) { return *reinterpret_cast<bf16x8*>(&v); }

#define SMEM_BYTES 73728

__device__ void transpose_tile(const float* __restrict__ src, int lds, bf16_t* __restrict__ dst, int K, int n0, int k0,
                               int gate_skip, float* tile  ) {
  const int tid = threadIdx.x;
  const int c = tid & 63, r0 = tid >> 6;
  int n = n0 + c;
  int col = n + ((gate_skip && n >= 2304) ? 8 : 0);
#pragma unroll 4
  for (int j = 0; j < 16; ++j) {
    int r = r0 + 4 * j;
    tile[r * 65 + c] = src[(size_t)(k0 + r) * lds + col];
  }
  __syncthreads();
  const int nn = tid >> 2, kg = (tid & 3) * 16;
  unsigned w[8];
#pragma unroll
  for (int j = 0; j < 8; ++j) w[j] = pack2(tile[(kg + 2 * j) * 65 + nn], tile[(kg + 2 * j + 1) * 65 + nn]);
  uint4* d = reinterpret_cast<uint4*>(dst + (size_t)(n0 + nn) * K + k0 + kg);
  d[0] = make_uint4(w[0], w[1], w[2], w[3]);
  d[1] = make_uint4(w[4], w[5], w[6], w[7]);
  __syncthreads();
}

__device__ __forceinline__ int rel_bucket_dev(int rel) {
  int ret = rel > 0 ? 16 : 0;
  int n = rel < 0 ? -rel : rel;
  int b;
  if (n < 8) b = n;
  else if (n < 12) b = 8;
  else if (n < 16) b = 9;
  else if (n < 23) b = 10;
  else if (n < 32) b = 11;
  else if (n < 46) b = 12;
  else if (n < 64) b = 13;
  else if (n < 91) b = 14;
  else b = 15;
  return ret + b;
}

__device__ void ph_prep(const Params& p, char* smem, int bid, int nblk) {
  const int tid = threadIdx.x;
  float* tile = reinterpret_cast<float*>(smem);
  for (int u = bid; u < 2 * 1472; u += nblk) {
    int l = u / 1472, r = u % 1472;
    if (r < 704) {
      int nt = r / 16, kt = r % 16;
      transpose_tile(p.w_in + (size_t)l * 1024 * 2824, 2824, p.wt_in + (size_t)l * NIN * 1024, 1024, nt * 64, kt * 64, 1, tile);
    } else if (r < 960) {
      r -= 704; int nt = r / 16, kt = r % 16;
      transpose_tile(p.w_out + (size_t)l * 1024 * 1024, 1024, p.wt_out + (size_t)l * 1024 * 1024, 1024, nt * 64, kt * 64, 0, tile);
    } else {
      r -= 960; int nt = r / 16, kt = r % 16;
      transpose_tile(p.peer_wq + (size_t)l * 1024 * 2048, 2048, p.wt_pq + (size_t)l * 2048 * 1024, 1024, nt * 64, kt * 64, 0, tile);
    }
  }
  for (int u = bid; u < 1024; u += nblk) {
    int kt = u & 15, h = (u >> 4) & 3, b = (u >> 6) & 7, l = u >> 9;
    const float* src = p.cache_v + (((size_t)(l * 8 + b) * 1024 + kt * 64) * 4 + h) * 128;
    {
      int c = tid & 127, r0 = tid >> 7;
      for (int j = 0; j < 32; ++j) { int r = r0 + 2 * j; tile[r * 129 + c] = src[(size_t)r * 512 + c]; }
    }
    __syncthreads();
    {
      int dv = tid >> 1, half = tid & 1;
      bf16_t* dst = p.Vts + ((size_t)((l * 8 + b) * 4 + h) * 128 + dv) * SKEYS + kt * 64 + half * 32;
      unsigned w[16];
#pragma unroll
      for (int j = 0; j < 16; ++j) {
        int pos0 = half * 32 + 2 * j;
        int blk = (pos0 >> 2) & 3;
        int oblk = (blk == 1) ? 2 : (blk == 2 ? 1 : blk);
        int key0 = (pos0 & ~15) + oblk * 4 + (pos0 & 3);
        w[j] = pack2(tile[key0 * 129 + dv], tile[(key0 + 1) * 129 + dv]);
      }
      uint4* d4 = reinterpret_cast<uint4*>(dst);
      d4[0] = make_uint4(w[0], w[1], w[2], w[3]);
      d4[1] = make_uint4(w[4], w[5], w[6], w[7]);
      d4[2] = make_uint4(w[8], w[9], w[10], w[11]);
      d4[3] = make_uint4(w[12], w[13], w[14], w[15]);
    }
    __syncthreads();
  }
  const size_t gtid = (size_t)bid * 256 + tid, gsz = (size_t)nblk * 256;
  {
    const size_t n8 = (size_t)2 * 16384 * 1024 / 8;
    for (size_t i = gtid; i < n8; i += gsz) {
      float4 a = reinterpret_cast<const float4*>(p.peer_u)[2 * i], b = reinterpret_cast<const float4*>(p.peer_u)[2 * i + 1];
      reinterpret_cast<uint4*>(p.ub)[i] = make_uint4(pack2(a.x, a.y), pack2(a.z, a.w), pack2(b.x, b.y), pack2(b.z, b.w));
      float4 c = reinterpret_cast<const float4*>(p.peer_v)[2 * i], d = reinterpret_cast<const float4*>(p.peer_v)[2 * i + 1];
      reinterpret_cast<uint4*>(p.vb)[i] = make_uint4(pack2(c.x, c.y), pack2(c.z, c.w), pack2(d.x, d.y), pack2(d.z, d.w));
    }
  }
  {
    const size_t n8 = (size_t)2 * 16 * 128 * 128 / 8;
    for (size_t i = gtid; i < n8; i += gsz) {
      float4 a = reinterpret_cast<const float4*>(p.peer_keys)[2 * i], b = reinterpret_cast<const float4*>(p.peer_keys)[2 * i + 1];
      reinterpret_cast<uint4*>(p.keysb)[i] = make_uint4(pack2(a.x, a.y), pack2(a.z, a.w), pack2(b.x, b.y), pack2(b.z, b.w));
    }
  }
  {
    const size_t n8 = (size_t)2 * 8 * 1024 * 512 / 8;
    for (size_t i = gtid; i < n8; i += gsz) {
      size_t e = i * 8;
      size_t lb = e / (1024 * 512), rem = e % (1024 * 512);
      float4 a = reinterpret_cast<const float4*>(p.cache_k)[2 * i], b = reinterpret_cast<const float4*>(p.cache_k)[2 * i + 1];
      *reinterpret_cast<uint4*>(p.Kbs + lb * (SKEYS * 512) + rem) = make_uint4(pack2(a.x, a.y), pack2(a.z, a.w), pack2(b.x, b.y), pack2(b.z, b.w));
    }
  }
  for (size_t i = gtid; i < 2 * 8 * 1024; i += gsz) {
    int l = (int)(i / 8192), r = (int)(i % 8192), g = r / 1024, k = r % 1024;
    p.wg[i] = p.w_in[((size_t)l * 1024 + k) * 2824 + 2304 + g];
  }
  if (bid == 0) {
    for (int i = tid; i < 4 * 256; i += 256) {
      int h = i >> 8, j = i & 255;
      int rel = j - 191; if (rel > 63) rel = 63;
      p.lut[i] = p.rel_table[rel_bucket_dev(rel) * 4 + h] * LOG2E;
    }
    if (tid < 2) {
      const float* lp = p.da_lambda + tid * 256;
      float s01 = 0.f, s23 = 0.f;
      for (int d = 0; d < 64; ++d) { s01 += lp[d] * lp[64 + d]; s23 += lp[128 + d] * lp[192 + d]; }
      float lam_init = 0.8f - 0.6f * expf(-0.3f * (float)tid);
      p.lam[tid] = expf(s01) - expf(s23) + lam_init;
    }
  }
}

template <int MODE>
__device__ void ph_rmsnorm(const Params& p, int l, int bid, int nblk) {
  const int lane = threadIdx.x & 63, w = threadIdx.x >> 6;
  const float* g = (MODE == 0) ? p.norm1_g + l * 1024 : (MODE == 1 ? p.norm2_g + l * 1024 : p.final_g);
  float4 gv[4];
#pragma unroll
  for (int j = 0; j < 4; ++j) gv[j] = reinterpret_cast<const float4*>(g)[lane + 64 * j];
  for (int t = bid * 4 + w; t < NTOK; t += nblk * 4) {
    const float* xr = (MODE == 0) ? xrow_in(p, l, t) : p.x + (size_t)t * 1024;
    float4 xv[4];
    float ss = 0.f;
#pragma unroll
    for (int j = 0; j < 4; ++j) {
      xv[j] = reinterpret_cast<const float4*>(xr)[lane + 64 * j];
      ss += xv[j].x * xv[j].x + xv[j].y * xv[j].y + xv[j].z * xv[j].z + xv[j].w * xv[j].w;
    }
    ss = wave_sum(ss);
    float r = rsqrtf(ss * (1.f / 1024.f) + EPS);
#pragma unroll
    for (int j = 0; j < 4; ++j) {
      xv[j].x *= r * gv[j].x; xv[j].y *= r * gv[j].y; xv[j].z *= r * gv[j].z; xv[j].w *= r * gv[j].w;
    }
    if (MODE == 2) {
      float* o = (t < NPROMPT) ? p.out + O_Y_P + (size_t)t * 1024 : p.out + O_Y_S + (size_t)(t - NPROMPT) * 1024;
#pragma unroll
      for (int j = 0; j < 4; ++j) reinterpret_cast<float4*>(o)[lane + 64 * j] = xv[j];
    } else {
      uint2* o = reinterpret_cast<uint2*>(p.xn + (size_t)t * 1024);
#pragma unroll
      for (int j = 0; j < 4; ++j) o[lane + 64 * j] = make_uint2(pack2(xv[j].x, xv[j].y), pack2(xv[j].z, xv[j].w));
    }
    if (MODE == 0) {
      float pre[8];
#pragma unroll
      for (int i = 0; i < 8; ++i) {
        const float4* wr = reinterpret_cast<const float4*>(p.wg + ((size_t)l * 8 + i) * 1024);
        float s = 0.f;
#pragma unroll
        for (int j = 0; j < 4; ++j) {
          float4 wv = wr[lane + 64 * j];
          s += xv[j].x * wv.x + xv[j].y * wv.y + xv[j].z * wv.z + xv[j].w * wv.w;
        }
        pre[i] = wave_sum(s);
      }
      if (lane < 4) {
        float a = pre[0]; a = lane == 1 ? pre[1] : a; a = lane == 2 ? pre[2] : a; a = lane == 3 ? pre[3] : a;
        float f = pre[4]; f = lane == 1 ? pre[5] : f; f = lane == 2 ? pre[6] : f; f = lane == 3 ? pre[7] : f;
        p.ig[(size_t)t * 4 + lane] = a + p.ml_gate_b[l * 8 + lane];
        float z = f + p.ml_gate_b[l * 8 + 4 + lane];
        p.lf[(size_t)t * 4 + lane] = fminf(z, 0.f) - log1pf(expf(-fabsf(z)));
      }
    }
  }
}

enum { EPI_WIN = 0, EPI_WOUT = 1, EPI_PQ = 2, EPI_SC = 3 };

template <int EPI>
__device__ __forceinline__ void gemm_store(const Params& p, int l, int t, int n, float v) {
  if (EPI == EPI_WOUT) {
    const float* xi = xrow_in(p, l, t);
    p.x[(size_t)t * 1024 + n] = xi[n] + v;
  } else if (EPI == EPI_PQ) {
    p.qp[(size_t)t * 2048 + n] = f2bf(v);
  } else if (EPI == EPI_SC) {
    p.sc[(size_t)t * 2048 + n] = v;
  }
}

template <int EPI>
__device__ void ph_gemm(const Params& p, int l, char* smem, int bid, int nblk) {
  constexpr int NT = (EPI == EPI_WIN) ? 22 : (EPI == EPI_WOUT ? 8 : 16);
  constexpr int MT = NTOK / 128;
  constexpr int K = (EPI == EPI_SC) ? 128 : 1024;
  constexpr int NK = K / 64;
  const bf16_t* A; int lda; const bf16_t* Bt; int ldb;
  if (EPI == EPI_WIN) { A = p.xn; lda = 1024; Bt = p.wt_in + (size_t)l * NIN * 1024; ldb = 1024; }
  else if (EPI == EPI_WOUT) { A = p.xn; lda = 1024; Bt = p.wt_out + (size_t)l * 1024 * 1024; ldb = 1024; }
  else if (EPI == EPI_PQ) { A = p.xn; lda = 1024; Bt = p.wt_pq + (size_t)l * 2048 * 1024; ldb = 1024; }
  else { A = p.qp; lda = 2048; Bt = p.keysb + (size_t)l * 16 * 128 * 128; ldb = 128; }

  const int tid = threadIdx.x, lane = tid & 63, w = tid >> 6;
  const int wm = w >> 1, wn = w & 1, lr = lane & 31, lh = lane >> 5;
  char* sA = smem;
  char* sB = smem + 32768;
  const int ld_c = tid & 7, ld_r = tid >> 3;

  for (int tile = bid; tile < MT * NT; tile += nblk) {
    const int mt = tile / NT, nt = tile % NT;
    const bf16_t* Ag = A + (size_t)(mt * 128) * lda + ((EPI == EPI_SC) ? nt * 128 : 0);
    const bf16_t* Bg = Bt + (size_t)(nt * 128) * ldb;
    uint4 ra[4], rb[4];
    f32x16 acc[2][2];
#pragma unroll
    for (int i = 0; i < 2; ++i)
#pragma unroll
      for (int j = 0; j < 2; ++j)
#pragma unroll
        for (int r = 0; r < 16; ++r) acc[i][j][r] = 0.f;

#pragma unroll
    for (int j = 0; j < 4; ++j) {
      ra[j] = *reinterpret_cast<const uint4*>(Ag + (size_t)(ld_r + 32 * j) * lda + ld_c * 8);
      rb[j] = *reinterpret_cast<const uint4*>(Bg + (size_t)(ld_r + 32 * j) * ldb + ld_c * 8);
    }
#pragma unroll
    for (int j = 0; j < 4; ++j) {
      int row = ld_r + 32 * j; int pc = ld_c ^ ((row >> 1) & 7);
      *reinterpret_cast<uint4*>(sA + row * 128 + pc * 16) = ra[j];
      *reinterpret_cast<uint4*>(sB + row * 128 + pc * 16) = rb[j];
    }
    __syncthreads();
    for (int kt = 0; kt < NK; ++kt) {
      const int buf = kt & 1;
      if (kt + 1 < NK) {
#pragma unroll
        for (int j = 0; j < 4; ++j) {
          ra[j] = *reinterpret_cast<const uint4*>(Ag + (size_t)(ld_r + 32 * j) * lda + (kt + 1) * 64 + ld_c * 8);
          rb[j] = *reinterpret_cast<const uint4*>(Bg + (size_t)(ld_r + 32 * j) * ldb + (kt + 1) * 64 + ld_c * 8);
        }
      }
      const char* cA = sA + buf * 16384;
      const char* cB = sB + buf * 16384;
#pragma unroll
      for (int ks = 0; ks < 4; ++ks) {
        bf16x8 af[2], bfr[2];
#pragma unroll
        for (int i = 0; i < 2; ++i) {
          int row = wm * 64 + i * 32 + lr; int pc = (ks * 2 + lh) ^ ((row >> 1) & 7);
          af[i] = as_bf16x8(*reinterpret_cast<const uint4*>(cA + row * 128 + pc * 16));
        }
#pragma unroll
        for (int j = 0; j < 2; ++j) {
          int row = wn * 64 + j * 32 + lr; int pc = (ks * 2 + lh) ^ ((row >> 1) & 7);
          bfr[j] = as_bf16x8(*reinterpret_cast<const uint4*>(cB + row * 128 + pc * 16));
        }
#pragma unroll
        for (int i = 0; i < 2; ++i)
#pragma unroll
          for (int j = 0; j < 2; ++j)
            acc[i][j] = __builtin_amdgcn_mfma_f32_32x32x16_bf16(af[i], bfr[j], acc[i][j], 0, 0, 0);
      }
      if (kt + 1 < NK) {
        char* nA = sA + (buf ^ 1) * 16384;
        char* nB = sB + (buf ^ 1) * 16384;
#pragma unroll
        for (int j = 0; j < 4; ++j) {
          int row = ld_r + 32 * j; int pc = ld_c ^ ((row >> 1) & 7);
          *reinterpret_cast<uint4*>(nA + row * 128 + pc * 16) = ra[j];
          *reinterpret_cast<uint4*>(nB + row * 128 + pc * 16) = rb[j];
        }
      }
      __syncthreads();
    }
    if (EPI != EPI_WIN) {
#pragma unroll
      for (int i = 0; i < 2; ++i)
#pragma unroll
        for (int j = 0; j < 2; ++j)
#pragma unroll
          for (int r = 0; r < 16; ++r) {
            int t = mt * 128 + wm * 64 + i * 32 + (r & 3) + 8 * (r >> 2) + 4 * lh;
            int n = nt * 128 + wn * 64 + j * 32 + lr;
            gemm_store<EPI>(p, l, t, n, acc[i][j][r]);
          }
    } else {
      const int seg = nt >> 2;
#pragma unroll
      for (int i = 0; i < 2; ++i)
#pragma unroll
        for (int j = 0; j < 2; ++j) {
          const int n = nt * 128 + wn * 64 + j * 32 + lr;
          if (nt < 4) {
#pragma unroll
            for (int r = 0; r < 16; ++r) {
              int t = mt * 128 + wm * 64 + i * 32 + (r & 3) + 8 * (r >> 2) + 4 * lh;
              p.Qb[(size_t)t * 512 + n] = f2bf(acc[i][j][r] * (0.125f * LOG2E));
            }
          } else if (nt < 8) {
            const int n2 = n - 512;
#pragma unroll
            for (int r = 0; r < 16; ++r) {
              int t = mt * 128 + wm * 64 + i * 32 + (r & 3) + 8 * (r >> 2) + 4 * lh;
              float v = acc[i][j][r];
              if (t < NPROMPT) {
                p.out[O_K_P + (size_t)l * (4 * 4096 * 512) + (size_t)t * 512 + n2] = v;
                p.Kb[(size_t)t * 512 + n2] = f2bf(v);
              } else {
                int ts = t - NPROMPT, b = ts >> 6, ii = ts & 63;
                p.out[O_K_S + (size_t)l * (8 * 64 * 512) + (size_t)ts * 512 + n2] = v;
                p.Kbs[((size_t)(l * 8 + b) * SKEYS + 1024 + ii) * 512 + n2] = f2bf(v);
              }
            }
          } else if (nt < 12) {
            const int n2 = n - 1024, h = n2 >> 7, dv = n2 & 127;
#pragma unroll
            for (int rg = 0; rg < 4; ++rg) {
              int tb = mt * 128 + wm * 64 + i * 32 + 8 * rg + 4 * lh;
              float v0 = acc[i][j][rg * 4 + 0], v1 = acc[i][j][rg * 4 + 1], v2 = acc[i][j][rg * 4 + 2], v3 = acc[i][j][rg * 4 + 3];
              uint2 pk = make_uint2(pack2(v0, v1), pack2(v2, v3));
              int posblk = 2 * lh + (rg & 1);
              if (tb < NPROMPT) {
                float* o = p.out + O_V_P + (size_t)l * (4 * 4096 * 512) + (size_t)tb * 512 + n2;
                o[0] = v0; o[512] = v1; o[1024] = v2; o[1536] = v3;
                int b = tb >> 12, s = tb & 4095;
                int pos = (s & ~15) + posblk * 4;
                *reinterpret_cast<uint2*>(p.Vt + ((size_t)(b * 4 + h) * 128 + dv) * SEQ + pos) = pk;
              } else {
                int ts = tb - NPROMPT, b = ts >> 6, ii = ts & 63;
                float* o = p.out + O_V_S + (size_t)l * (8 * 64 * 512) + (size_t)ts * 512 + n2;
                o[0] = v0; o[512] = v1; o[1024] = v2; o[1536] = v3;
                int pos = 1024 + (ii & ~15) + posblk * 4;
                *reinterpret_cast<uint2*>(p.Vts + ((size_t)((l * 8 + b) * 4 + h) * 128 + dv) * SKEYS + pos) = pk;
              }
            }
          } else {
            const int n2 = n - 1536;
            const bool act = (n >= 2304);
#pragma unroll
            for (int r = 0; r < 16; ++r) {
              int t = mt * 128 + wm * 64 + i * 32 + (r & 3) + 8 * (r >> 2) + 4 * lh;
              float v = acc[i][j][r];
              if (act) v = gelu_exact(v);
              p.P5[(size_t)t * 1280 + n2] = v;
            }
          }
        }
      (void)seg;
    }
  }
}

__device__ void ph_attn(const Params& p, int l, char* smem, int bid, int nblk) {
  const int tid = threadIdx.x, lane = tid & 63, w = tid >> 6;
  const int c = w >> 1, qhalf = w & 1, lr = lane & 31, lh = lane >> 5;
  char* sK = smem;
  char* sV = smem + 16384;
  float* sLut = reinterpret_cast<float*>(smem + 32768);
  float* sO2 = reinterpret_cast<float*>(smem);
  const float lam = p.lam[l];
  const float lam_init = 0.8f - 0.6f * expf(-0.3f * (float)l);

  for (int uu = bid; uu < 1056; uu += nblk) {
    int b, h, qc, S, qrow0; const bf16_t *Kbase, *Vbase;
    bool samp = false; int u2 = uu;
    if (uu >= 752 && uu < 784) samp = true; else if (uu >= 784) u2 = uu - 32;
    if (!samp) {
      qc = 63 - (u2 >> 4); int bh = u2 & 15; b = bh >> 2; h = bh & 3; S = SEQ;
      Kbase = p.Kb + (size_t)b * SEQ * 512 + h * 128;
      Vbase = p.Vt + (size_t)(b * 4 + h) * 128 * SEQ;
      qrow0 = b * SEQ + qc * 64;
    } else {
      int us = uu - 752; b = us >> 2; h = us & 3; qc = 16; S = SKEYS;
      Kbase = p.Kbs + (size_t)(l * 8 + b) * SKEYS * 512 + h * 128;
      Vbase = p.Vts + (size_t)((l * 8 + b) * 4 + h) * 128 * SKEYS;
      qrow0 = NPROMPT + b * 64;
    }
    const int ntiles = qc + 1;
    __syncthreads();
    sLut[tid] = p.lut[h * 256 + tid];
    bf16x8 qf[4];
    {
      const bf16_t* qrow = p.Qb + (size_t)(qrow0 + qhalf * 32 + lr) * 512 + h * 128 + c * 64 + lh * 8;
#pragma unroll
      for (int ks = 0; ks < 4; ++ks) qf[ks] = as_bf16x8(*reinterpret_cast<const uint4*>(qrow + ks * 16));
    }
    f32x16 o[4];
#pragma unroll
    for (int d = 0; d < 4; ++d)
#pragma unroll
      for (int r = 0; r < 16; ++r) o[d][r] = 0.f;
    float m_run = -1e30f, l_run = 0.f;
    const float c15 = p.lut[h * 256];

    uint4 rk0, rk1, rk2, rk3, rv0, rv1, rv2, rv3;
    const int kc = tid & 15, kr = tid >> 4;
    const int vc = tid & 7, vr = tid >> 3;
#define ATTN_GL1(KT, J, RK, RV)                                                                              \
  RK = *reinterpret_cast<const uint4*>(Kbase + (size_t)((KT) * 64 + kr + 16 * (J)) * 512 + kc * 8);          \
  RV = *reinterpret_cast<const uint4*>(Vbase + (size_t)(vr + 32 * (J)) * S + (KT) * 64 + vc * 8);
#define ATTN_GLOAD(KT) ATTN_GL1(KT, 0, rk0, rv0) ATTN_GL1(KT, 1, rk1, rv1) ATTN_GL1(KT, 2, rk2, rv2) ATTN_GL1(KT, 3, rk3, rv3)
#define ATTN_SW1(J, RK, RV)                                                                                  \
  {                                                                                                          \
    int row = kr + 16 * (J); int pc = (kc & 7) ^ ((row >> 1) & 7);                                           \
    *reinterpret_cast<uint4*>(sK + (kc >> 3) * 8192 + row * 128 + pc * 16) = RK;                             \
    int row2 = vr + 32 * (J); int pc2 = vc ^ ((row2 >> 1) & 7);                                              \
    *reinterpret_cast<uint4*>(sV + row2 * 128 + pc2 * 16) = RV;                                              \
  }
    ATTN_GLOAD(0)
    for (int kt = 0; kt < ntiles; ++kt) {
      __syncthreads();
      ATTN_SW1(0, rk0, rv0) ATTN_SW1(1, rk1, rv1) ATTN_SW1(2, rk2, rv2) ATTN_SW1(3, rk3, rv3)
      __syncthreads();
      if (kt + 1 < ntiles) { ATTN_GLOAD(kt + 1) }
      f32x16 s[2];
#pragma unroll
      for (int kb = 0; kb < 2; ++kb) {
#pragma unroll
        for (int r = 0; r < 16; ++r) s[kb][r] = 0.f;
#pragma unroll
        for (int ks = 0; ks < 4; ++ks) {
          int row = kb * 32 + lr; int pc = (ks * 2 + lh) ^ ((row >> 1) & 7);
          bf16x8 kf = as_bf16x8(*reinterpret_cast<const uint4*>(sK + c * 8192 + row * 128 + pc * 16));
          s[kb] = __builtin_amdgcn_mfma_f32_32x32x16_bf16(kf, qf[ks], s[kb], 0, 0, 0);
        }
      }
      if (kt >= qc - 2) {
        const int base = (kt - qc) * 64 - (qhalf * 32 + lr) + 191 + 4 * lh;
#pragma unroll
        for (int kb = 0; kb < 2; ++kb)
#pragma unroll
          for (int r = 0; r < 16; ++r) s[kb][r] += sLut[base + kb * 32 + (r & 3) + 8 * (r >> 2)];
      } else {
#pragma unroll
        for (int kb = 0; kb < 2; ++kb)
#pragma unroll
          for (int r = 0; r < 16; ++r) s[kb][r] += c15;
      }
      float mx = s[0][0];
#pragma unroll
      for (int kb = 0; kb < 2; ++kb)
#pragma unroll
        for (int r = 0; r < 16; ++r) mx = fmaxf(mx, s[kb][r]);
      mx = fmaxf(mx, __shfl_xor(mx, 32));
      const float m_new = fmaxf(m_run, mx);
      const float alpha = exp2f(m_run - m_new);
      m_run = m_new;
      float ps = 0.f;
#pragma unroll
      for (int kb = 0; kb < 2; ++kb)
#pragma unroll
        for (int r = 0; r < 16; ++r) { float pv = exp2f(s[kb][r] - m_new); s[kb][r] = pv; ps += pv; }
      l_run = l_run * alpha + ps;
#pragma unroll
      for (int d = 0; d < 4; ++d)
#pragma unroll
        for (int r = 0; r < 16; ++r) o[d][r] *= alpha;
#pragma unroll
      for (int ks2 = 0; ks2 < 4; ++ks2) {
        const int kb = ks2 >> 1, sh = (ks2 & 1) * 8;
        uint4 pw = make_uint4(pack2(s[kb][sh + 0], s[kb][sh + 1]), pack2(s[kb][sh + 2], s[kb][sh + 3]),
                              pack2(s[kb][sh + 4], s[kb][sh + 5]), pack2(s[kb][sh + 6], s[kb][sh + 7]));
        bf16x8 pf = as_bf16x8(pw);
#pragma unroll
        for (int d = 0; d < 4; ++d) {
          int row = d * 32 + lr; int pc = (ks2 * 2 + lh) ^ ((row >> 1) & 7);
          bf16x8 vf = as_bf16x8(*reinterpret_cast<const uint4*>(sV + row * 128 + pc * 16));
          o[d] = __builtin_amdgcn_mfma_f32_32x32x16_bf16(vf, pf, o[d], 0, 0, 0);
        }
      }
    }
    float lt = l_run + __shfl_xor(l_run, 32);
    float inv = 1.f / lt;
    __syncthreads();
    if (c == 1) {
#pragma unroll
      for (int d = 0; d < 4; ++d)
#pragma unroll
        for (int r = 0; r < 16; ++r) sO2[(qhalf * 64 + d * 16 + r) * 64 + lane] = o[d][r] * inv;
    }
    __syncthreads();
    if (c == 0) {
      float ss = 0.f;
#pragma unroll
      for (int d = 0; d < 4; ++d)
#pragma unroll
        for (int r = 0; r < 16; ++r) {
          float v = o[d][r] * inv - lam * sO2[(qhalf * 64 + d * 16 + r) * 64 + lane];
          o[d][r] = v; ss += v * v;
        }
      ss += __shfl_xor(ss, 32);
      const float rn = rsqrtf(ss * (1.f / 128.f) + EPS) * (1.f - lam_init);
      const float* gs = p.da_subln_g + l * 128;
      bf16_t* orow = p.xn + (size_t)(qrow0 + qhalf * 32 + lr) * 1024 + h * 128;
#pragma unroll
      for (int d = 0; d < 4; ++d)
#pragma unroll
        for (int rg = 0; rg < 4; ++rg) {
          int dv = d * 32 + 8 * rg + 4 * lh;
          float4 g4 = *reinterpret_cast<const float4*>(gs + dv);
          uint2 pk = make_uint2(pack2(o[d][rg * 4 + 0] * rn * g4.x, o[d][rg * 4 + 1] * rn * g4.y),
                                pack2(o[d][rg * 4 + 2] * rn * g4.z, o[d][rg * 4 + 3] * rn * g4.w));
          *reinterpret_cast<uint2*>(orow + dv) = pk;
        }
    }
  }
}

__device__ void ph_mlconv(const Params& p, int l, char* smem, int bid, int nblk) {
  const int tid = threadIdx.x;
  float* s_mc = reinterpret_cast<float*>(smem);
  float* s_cc = s_mc + 67 * 64;
  float* s_wq = s_cc + 64 * 65;
  float* s_wk = s_wq + 4096;
  for (int u = bid; u < 264 * 4; u += nblk) {
    const int ci = u >> 2, h = u & 3;
    int token0, bq; bool samp = ci >= 256;
    if (!samp) token0 = ci * 64; else token0 = NPROMPT + (ci - 256) * 64;
    bq = samp ? (ci - 256) : (ci >> 6);
    const int cidx = samp ? 0 : (ci & 63);
    __syncthreads();
    for (int i = tid; i < 67 * 64; i += 256) {
      int r = i >> 6, d = i & 63;
      float v;
      if (r >= 3) v = p.P5[(size_t)(token0 + r - 3) * 1280 + h * 64 + d];
      else if (samp) v = p.st_conv[((size_t)(l * 8 + bq) * 3 + r) * 256 + h * 64 + d];
      else if (cidx == 0) v = 0.f;
      else v = p.P5[(size_t)(token0 + r - 3) * 1280 + h * 64 + d];
      s_mc[i] = v;
    }
    for (int i = tid; i < 4096; i += 256) {
      s_wq[i] = p.ml_wq[(size_t)(l * 4 + h) * 4096 + i];
      s_wk[i] = p.ml_wk[(size_t)(l * 4 + h) * 4096 + i];
    }
    __syncthreads();
    {
      const int d = tid & 63, t0 = tid >> 6;
      const int ch = h * 64 + d;
      const float w0 = p.ml_conv_w[(l * 4 + 0) * 256 + ch], w1 = p.ml_conv_w[(l * 4 + 1) * 256 + ch];
      const float w2 = p.ml_conv_w[(l * 4 + 2) * 256 + ch], w3 = p.ml_conv_w[(l * 4 + 3) * 256 + ch];
      const float bb = p.ml_conv_b[l * 256 + ch];
      for (int t = t0; t < 64; t += 4) {
        float y = bb + w0 * s_mc[t * 64 + d] + w1 * s_mc[(t + 1) * 64 + d] + w2 * s_mc[(t + 2) * 64 + d] + w3 * s_mc[(t + 3) * 64 + d];
        y = y * sigmoidf_(y);
        s_cc[t * 65 + d] = y;
        p.cc[(size_t)(token0 + t) * 256 + ch] = y;
      }
      if (samp || cidx == 63) {
        if (tid < 192) {
          int r = tid >> 6;
          float v = s_mc[(64 + r) * 64 + d];
          if (samp) p.out[O_CONV_S + ((size_t)(l * 8 + bq) * 3 + r) * 256 + ch] = v;
          else p.out[O_CONV_P + ((size_t)(l * 4 + bq) * 3 + r) * 256 + ch] = v;
        }
      }
    }
    __syncthreads();
    {
      const int ty = tid >> 4, tx = tid & 15;
      float aq[4][4], ak[4][4];
#pragma unroll
      for (int i = 0; i < 4; ++i)
#pragma unroll
        for (int j = 0; j < 4; ++j) { aq[i][j] = 0.f; ak[i][j] = 0.f; }
      for (int d = 0; d < 64; ++d) {
        float4 wq4 = *reinterpret_cast<const float4*>(s_wq + d * 64 + tx * 4);
        float4 wk4 = *reinterpret_cast<const float4*>(s_wk + d * 64 + tx * 4);
#pragma unroll
        for (int i = 0; i < 4; ++i) {
          float a = s_cc[(ty * 4 + i) * 65 + d];
          aq[i][0] += a * wq4.x; aq[i][1] += a * wq4.y; aq[i][2] += a * wq4.z; aq[i][3] += a * wq4.w;
          ak[i][0] += a * wk4.x; ak[i][1] += a * wk4.y; ak[i][2] += a * wk4.z; ak[i][3] += a * wk4.w;
        }
      }
#pragma unroll
      for (int i = 0; i < 4; ++i) {
        size_t o = (size_t)(token0 + ty * 4 + i) * 256 + h * 64 + tx * 4;
        *reinterpret_cast<float4*>(p.qm + o) = make_float4(aq[i][0], aq[i][1], aq[i][2], aq[i][3]);
        *reinterpret_cast<float4*>(p.km + o) = make_float4(ak[i][0] * 0.125f, ak[i][1] * 0.125f, ak[i][2] * 0.125f, ak[i][3] * 0.125f);
      }
    }
  }
}

__device__ void ph_mchain(const Params& p, int l, int bid, int nblk) {
  const int lane = threadIdx.x & 63, w = threadIdx.x >> 6;
  for (int u = bid * 4 + w; u < 48; u += nblk * 4) {
    const bool samp = u >= 16;
    int b, h, nch, token0, cu0; float m;
    if (!samp) { b = u >> 2; h = u & 3; nch = 64; token0 = b * SEQ; cu0 = (b * 4 + h) * 64; m = 0.f; }
    else { int us = u - 16; b = us >> 2; h = us & 3; nch = 1; token0 = NPROMPT + b * 64; cu0 = 1024 + us; m = p.st_m[(l * 8 + b) * 4 + h]; }
    for (int c = 0; c < nch; ++c) {
      const int t = token0 + c * 64 + lane;
      float lfv = p.lf[(size_t)t * 4 + h], igv = p.ig[(size_t)t * 4 + h];
      float F = lfv;
#pragma unroll
      for (int d = 1; d < 64; d <<= 1) { float n = __shfl_up(F, d); if (lane >= d) F += n; }
      const float FL = __shfl(F, 63);
      const float tail = FL - F + igv;
      const float mx = wave_max(tail);
      const float mn = fmaxf(FL + m, mx);
      p.Fc[(size_t)t * 4 + h] = F;
      if (lane == 0) {
        p.mst[cu0 + c] = m; p.mnx[cu0 + c] = mn; p.wcs[cu0 + c] = expf(FL + m - mn); p.FLs[cu0 + c] = FL;
      }
      m = mn;
    }
    if (lane == 0) {
      if (!samp) p.out[O_M_P + (l * 4 + b) * 4 + h] = m;
      else p.out[O_M_S + (l * 8 + b) * 4 + h] = m;
    }
  }
}

__device__ __forceinline__ void cu_decode(int cu, int& token0, int& h) {
  if (cu < 1024) { int bh = cu >> 6, c = cu & 63; token0 = (bh >> 2) * SEQ + c * 64; h = bh & 3; }
  else { int us = cu - 1024; token0 = NPROMPT + (us >> 2) * 64; h = us & 3; }
}

__device__ void ph_mlU(const Params& p, int l, char* smem, int bid, int nblk) {
  const int tid = threadIdx.x;
  float* s_k = reinterpret_cast<float*>(smem);
  float* s_v = s_k + 4096;
  for (int cu = bid; cu < NCU_UNITS; cu += nblk) {
    int token0, h; cu_decode(cu, token0, h);
    const float FL = p.FLs[cu], mn = p.mnx[cu];
    __syncthreads();
    for (int i = tid; i < 1024; i += 256) {
      int s = i >> 4, d4 = (i & 15) * 4;
      const int t = token0 + s;
      float wsv = expf(FL - p.Fc[(size_t)t * 4 + h] + p.ig[(size_t)t * 4 + h] - mn);
      float4 k4 = *reinterpret_cast<const float4*>(p.km + (size_t)t * 256 + h * 64 + d4);
      float4 v4 = *reinterpret_cast<const float4*>(p.P5 + (size_t)t * 1280 + 256 + h * 64 + d4);
      *reinterpret_cast<float4*>(s_k + s * 64 + d4) = make_float4(k4.x * wsv, k4.y * wsv, k4.z * wsv, k4.w * wsv);
      *reinterpret_cast<float4*>(s_v + s * 64 + d4) = v4;
    }
    __syncthreads();
    const int ty = tid >> 4, tx = tid & 15;
    float a[4][4];
#pragma unroll
    for (int i = 0; i < 4; ++i)
#pragma unroll
      for (int j = 0; j < 4; ++j) a[i][j] = 0.f;
    for (int s = 0; s < 64; ++s) {
      float4 k4 = *reinterpret_cast<const float4*>(s_k + s * 64 + ty * 4);
      float4 v4 = *reinterpret_cast<const float4*>(s_v + s * 64 + tx * 4);
      float kk[4] = {k4.x, k4.y, k4.z, k4.w};
#pragma unroll
      for (int i = 0; i < 4; ++i) { a[i][0] += kk[i] * v4.x; a[i][1] += kk[i] * v4.y; a[i][2] += kk[i] * v4.z; a[i][3] += kk[i] * v4.w; }
    }
#pragma unroll
    for (int i = 0; i < 4; ++i)
      *reinterpret_cast<float4*>(p.U + (size_t)cu * 4096 + (ty * 4 + i) * 64 + tx * 4) = make_float4(a[i][0], a[i][1], a[i][2], a[i][3]);
    if (tid < 64) {
      float s0 = 0.f;
      for (int s = 0; s < 64; ++s) s0 += s_k[s * 64 + tid];
      p.un[(size_t)cu * 64 + tid] = s0;
    }
  }
}

__device__ void ph_mlscan(const Params& p, int l, int bid, int nblk) {
  const size_t gtid = (size_t)bid * 256 + threadIdx.x, gsz = (size_t)nblk * 256;
  const size_t NPC = 16 * 4096, NSC = 32 * 4096, NPN = 16 * 64, NSN = 32 * 64;
  for (size_t i = gtid; i < NPC + NSC + NPN + NSN; i += gsz) {
    if (i < NPC) {
      int bh = (int)(i >> 12), e = (int)(i & 4095);
      float C = 0.f;
      for (int c = 0; c < 64; ++c) {
        int cu = bh * 64 + c;
        p.Cst[(size_t)cu * 4096 + e] = C;
        C = p.wcs[cu] * C + p.U[(size_t)cu * 4096 + e];
      }
      p.out[O_C_P + (size_t)l * (16 * 4096) + i] = C;
    } else if (i < NPC + NSC) {
      size_t j = i - NPC; int us = (int)(j >> 12), e = (int)(j & 4095); int cu = 1024 + us;
      float C = p.st_c[(size_t)l * (32 * 4096) + j];
      p.Cst[(size_t)cu * 4096 + e] = C;
      p.out[O_C_S + (size_t)l * (32 * 4096) + j] = p.wcs[cu] * C + p.U[(size_t)cu * 4096 + e];
    } else if (i < NPC + NSC + NPN) {
      size_t j = i - NPC - NSC; int bh = (int)(j >> 6), d = (int)(j & 63);
      float n = 0.f;
      for (int c = 0; c < 64; ++c) {
        int cu = bh * 64 + c;
        p.nst[(size_t)cu * 64 + d] = n;
        n = p.wcs[cu] * n + p.un[(size_t)cu * 64 + d];
      }
      p.out[O_N_P + (size_t)l * (16 * 64) + j] = n;
    } else {
      size_t j = i - NPC - NSC - NPN; int us = (int)(j >> 6), d = (int)(j & 63); int cu = 1024 + us;
      float n = p.st_n[(size_t)l * (32 * 64) + j];
      p.nst[(size_t)cu * 64 + d] = n;
      p.out[O_N_S + (size_t)l * (32 * 64) + j] = p.wcs[cu] * n + p.un[(size_t)cu * 64 + d];
    }
  }
}

__device__ void ph_mlout(const Params& p, int l, char* smem, int bid, int nblk) {
  const int tid = threadIdx.x;
  float* s_q = reinterpret_cast<float*>(smem);
  float* s_k = s_q + 64 * 65;
  float* s_v = s_k + 64 * 65;
  float* s_C = s_v + 4096;
  float* s_F = s_C + 4096;
  float* s_a = s_F + 64;
  float* s_mt = s_a + 64;
  float* s_iw = s_mt + 64;
  float* s_n = s_iw + 64;
  float* s_den = s_n + 64;
  for (int cu = bid; cu < NCU_UNITS; cu += nblk) {
    int token0, h; cu_decode(cu, token0, h);
    const float m0 = p.mst[cu];
    __syncthreads();
    for (int i = tid; i < 1024; i += 256) {
      int s = i >> 4, d4 = (i & 15) * 4;
      const int t = token0 + s;
      float4 q4 = *reinterpret_cast<const float4*>(p.qm + (size_t)t * 256 + h * 64 + d4);
      float4 k4 = *reinterpret_cast<const float4*>(p.km + (size_t)t * 256 + h * 64 + d4);
      float4 v4 = *reinterpret_cast<const float4*>(p.P5 + (size_t)t * 1280 + 256 + h * 64 + d4);
      float4 c4 = *reinterpret_cast<const float4*>(p.Cst + (size_t)cu * 4096 + s * 64 + d4);
      s_q[s * 65 + d4] = q4.x; s_q[s * 65 + d4 + 1] = q4.y; s_q[s * 65 + d4 + 2] = q4.z; s_q[s * 65 + d4 + 3] = q4.w;
      s_k[s * 65 + d4] = k4.x; s_k[s * 65 + d4 + 1] = k4.y; s_k[s * 65 + d4 + 2] = k4.z; s_k[s * 65 + d4 + 3] = k4.w;
      *reinterpret_cast<float4*>(s_v + s * 64 + d4) = v4;
      *reinterpret_cast<float4*>(s_C + s * 64 + d4) = c4;
    }
    if (tid < 64) {
      const int t = token0 + tid;
      float F = p.Fc[(size_t)t * 4 + h], g = p.ig[(size_t)t * 4 + h];
      s_F[tid] = F; s_a[tid] = g - F;
      s_n[tid] = p.nst[(size_t)cu * 64 + tid];
    }
    __syncthreads();
    if (tid < 64) {
      float pm = -1e30f;
      for (int s = 0; s <= tid; ++s) pm = fmaxf(pm, s_a[s]);
      float F = s_F[tid];
      float mt = F + fmaxf(m0, pm);
      s_mt[tid] = mt;
      s_iw[tid] = expf(F + m0 - mt);
    }
    __syncthreads();
    const int ty = tid >> 4, tx = tid & 15;
    float acc[4][4];
#pragma unroll
    for (int i = 0; i < 4; ++i)
#pragma unroll
      for (int j = 0; j < 4; ++j) acc[i][j] = 0.f;
    for (int d = 0; d < 64; ++d) {
      float qv[4], kv[4];
#pragma unroll
      for (int i = 0; i < 4; ++i) { qv[i] = s_q[(ty * 4 + i) * 65 + d]; kv[i] = s_k[(tx * 4 + i) * 65 + d]; }
#pragma unroll
      for (int i = 0; i < 4; ++i)
#pragma unroll
        for (int j = 0; j < 4; ++j) acc[i][j] += qv[i] * kv[j];
    }
    __syncthreads();
#pragma unroll
    for (int i = 0; i < 4; ++i) {
      const int t = ty * 4 + i;
      const float Ft = s_F[t], mt = s_mt[t];
#pragma unroll
      for (int j = 0; j < 4; ++j) {
        const int s = tx * 4 + j;
        float v = (s <= t) ? acc[i][j] * expf(Ft + s_a[s] - mt) : 0.f;
        s_k[t * 65 + s] = v;
      }
    }
    __syncthreads();
    if (tid < 64) {
      float den = 0.f, qn = 0.f;
      for (int s = 0; s < 64; ++s) { den += s_k[tid * 65 + s]; qn += s_q[tid * 65 + s] * s_n[s]; }
      s_den[tid] = den + s_iw[tid] * qn;
    }
    float num[4][4], qc[4][4];
#pragma unroll
    for (int i = 0; i < 4; ++i)
#pragma unroll
      for (int j = 0; j < 4; ++j) { num[i][j] = 0.f; qc[i][j] = 0.f; }
    for (int s = 0; s < 64; ++s) {
      float4 v4 = *reinterpret_cast<const float4*>(s_v + s * 64 + tx * 4);
      float4 c4 = *reinterpret_cast<const float4*>(s_C + s * 64 + tx * 4);
#pragma unroll
      for (int i = 0; i < 4; ++i) {
        float sw = s_k[(ty * 4 + i) * 65 + s], qq = s_q[(ty * 4 + i) * 65 + s];
        num[i][0] += sw * v4.x; num[i][1] += sw * v4.y; num[i][2] += sw * v4.z; num[i][3] += sw * v4.w;
        qc[i][0] += qq * c4.x; qc[i][1] += qq * c4.y; qc[i][2] += qq * c4.z; qc[i][3] += qq * c4.w;
      }
    }
    __syncthreads();
#pragma unroll
    for (int i = 0; i < 4; ++i) {
      const int t = ty * 4 + i;
      const float iw = s_iw[t];
      const float dn = fmaxf(fabsf(s_den[t]), expf(-s_mt[t]));
      float hv[4]; float ss = 0.f;
#pragma unroll
      for (int j = 0; j < 4; ++j) { hv[j] = (num[i][j] + iw * qc[i][j]) / dn; ss += hv[j] * hv[j]; }
      ss += __shfl_xor(ss, 1); ss += __shfl_xor(ss, 2); ss += __shfl_xor(ss, 4); ss += __shfl_xor(ss, 8);
      const float rn = rsqrtf(ss * (1.f / 64.f) + EPS);
      const int ch = h * 64 + tx * 4;
      const size_t tg = (size_t)(token0 + t);
      float4 g4 = *reinterpret_cast<const float4*>(p.ml_norm_g + l * 256 + ch);
      float4 k4 = *reinterpret_cast<const float4*>(p.ml_skip + l * 256 + ch);
      float4 c4 = *reinterpret_cast<const float4*>(p.cc + tg * 256 + ch);
      float4 o4 = *reinterpret_cast<const float4*>(p.P5 + tg * 1280 + 512 + ch);
      float r0 = (hv[0] * rn * g4.x + k4.x * c4.x) * sigmoidf_(o4.x);
      float r1 = (hv[1] * rn * g4.y + k4.y * c4.y) * sigmoidf_(o4.y);
      float r2 = (hv[2] * rn * g4.z + k4.z * c4.z) * sigmoidf_(o4.z);
      float r3 = (hv[3] * rn * g4.w + k4.w * c4.w) * sigmoidf_(o4.w);
      *reinterpret_cast<uint2*>(p.xn + tg * 1024 + 512 + ch) = make_uint2(pack2(r0, r1), pack2(r2, r3));
    }
  }
}

__device__ void ph_cmlp(const Params& p, int l, char* smem, int bid, int nblk) {
  const int tid = threadIdx.x, lane = tid & 63, w = tid >> 6;
  float* s_vg = reinterpret_cast<float*>(smem);
  float* s_ws = s_vg + 128 * 64;
  float* s_r = s_ws + 128 * 33;
  for (int u = bid; u < 544; u += nblk) {
    const int g = u & 3, ci = u >> 2;
    const bool samp = ci >= 128;
    const int L = samp ? 64 : 128;
    const int token0 = samp ? NPROMPT + (ci - 128) * 64 : ci * 128;
    __syncthreads();
    for (int r = w; r < L; r += 4) {
      float4 v = *reinterpret_cast<const float4*>(p.P5 + (size_t)(token0 + r) * 1280 + 1024 + lane * 4);
      float ss = v.x * v.x + v.y * v.y + v.z * v.z + v.w * v.w;
      ss = wave_sum(ss);
      if (lane == 0) s_r[r] = rsqrtf(ss * (1.f / 256.f) + EPS);
    }
    __syncthreads();
    for (int i = tid; i < L * 16; i += 256) {
      int s = i >> 4, d4 = (i & 15) * 4;
      float4 v = *reinterpret_cast<const float4*>(p.P5 + (size_t)(token0 + s) * 1280 + 1024 + g * 64 + d4);
      float4 gn = *reinterpret_cast<const float4*>(p.cm_norm_g + l * 256 + g * 64 + d4);
      float r = s_r[s];
      float4 o = make_float4(v.x * r * gn.x, v.y * r * gn.y, v.z * r * gn.z, v.w * r * gn.w);
      *reinterpret_cast<float4*>(s_vg + s * 64 + d4) = o;
      if (samp) {
        int ts = token0 - NPROMPT + s;
        *reinterpret_cast<float4*>(p.out + O_CMV_S + (size_t)l * (512 * 256) + (size_t)ts * 256 + g * 64 + d4) = o;
      }
    }
    const int ty = tid >> 4, tx = tid & 15;
    float acc[8][4];
#pragma unroll
    for (int i = 0; i < 8; ++i)
#pragma unroll
      for (int j = 0; j < 4; ++j) acc[i][j] = 0.f;
    const float* wsg = p.cm_ws + (size_t)(l * 4 + g) * 128 * 128;
    for (int s0 = 0; s0 < L; s0 += 32) {
      __syncthreads();
      for (int i = tid; i < L * 32; i += 256) {
        int t = i >> 5, ss = i & 31;
        s_ws[t * 33 + ss] = (s0 + ss <= t) ? wsg[t * 128 + s0 + ss] : 0.f;
      }
      __syncthreads();
      if (ty * 8 < L) {
        for (int ss = 0; ss < 32; ++ss) {
          float4 v4 = *reinterpret_cast<const float4*>(s_vg + (s0 + ss) * 64 + tx * 4);
#pragma unroll
          for (int i = 0; i < 8; ++i) {
            float wv = s_ws[(ty * 8 + i) * 33 + ss];
            acc[i][0] += wv * v4.x; acc[i][1] += wv * v4.y; acc[i][2] += wv * v4.z; acc[i][3] += wv * v4.w;
          }
        }
      }
    }
    if (ty * 8 < L) {
#pragma unroll
      for (int i = 0; i < 8; ++i) {
        const int t = ty * 8 + i;
        const float bb = p.cm_b[(l * 4 + g) * 128 + t];
        const size_t tg = (size_t)(token0 + t);
        float4 u4 = *reinterpret_cast<const float4*>(p.P5 + tg * 1280 + 768 + g * 64 + tx * 4);
        *reinterpret_cast<uint2*>(p.xn + tg * 1024 + 768 + g * 64 + tx * 4) =
            make_uint2(pack2(u4.x * (acc[i][0] + bb), u4.y * (acc[i][1] + bb)), pack2(u4.z * (acc[i][2] + bb), u4.w * (acc[i][3] + bb)));
      }
    }
  }
}

__device__ __forceinline__ int mono_key(float v) { int b = __float_as_int(v); return b ^ ((b >> 31) & 0x7FFFFFFF); }
__device__ __forceinline__ float mono_val(int k) { int b = k ^ ((k >> 31) & 0x7FFFFFFF); return __int_as_float(b); }

#define INS16(L, kv)                                   \
  {                                                    \
    int _v = (kv);                                     \
    _Pragma("unroll") for (int _j = 0; _j < 16; ++_j) { \
      int _t = max(L[_j], _v);                         \
      _v = min(L[_j], _v);                             \
      L[_j] = _t;                                      \
    }                                                  \
  }

__device__ void ph_topk(const Params& p, int l, char* smem, int bid, int nblk) {
  const int tid = threadIdx.x, lane = tid & 63, w = tid >> 6;
  float* s_tile = reinterpret_cast<float*>(smem) + w * (64 * 33);
  int* s_list = reinterpret_cast<int*>(smem + 4 * 64 * 33 * 4) + w * (2 * 16 * 64);
  float* s_ss = reinterpret_cast<float*>(smem + 4 * 64 * 33 * 4 + 4 * 2 * 16 * 64 * 4) + w * 64;
  for (int u = bid * 4 + w; u < 264 * 8; u += nblk * 4) {
    const int tg = u >> 3, h = u & 7;
    const int t0 = tg * 64;
    for (int i = 0; i < 32; ++i) {
      const int tt = 2 * i + (lane >> 5);
      uint4 qv = *reinterpret_cast<const uint4*>(p.qp + (size_t)(t0 + tt) * 2048 + h * 256 + (lane & 31) * 8);
      float a0 = bf_lo(qv.x), a1 = bf_hi(qv.x), a2 = bf_lo(qv.y), a3 = bf_hi(qv.y);
      float a4 = bf_lo(qv.z), a5 = bf_hi(qv.z), a6 = bf_lo(qv.w), a7 = bf_hi(qv.w);
      float ss = a0 * a0 + a1 * a1 + a2 * a2 + a3 * a3 + a4 * a4 + a5 * a5 + a6 * a6 + a7 * a7;
      ss += __shfl_xor(ss, 1); ss += __shfl_xor(ss, 2); ss += __shfl_xor(ss, 4); ss += __shfl_xor(ss, 8); ss += __shfl_xor(ss, 16);
      if ((lane & 31) == 0) s_ss[tt] = ss;
    }
    int L1[16], L2[16];
#pragma unroll
    for (int j = 0; j < 16; ++j) { L1[j] = (int)0x80000000; L2[j] = (int)0x80000000; }
#pragma unroll
    for (int c = 0; c < 2; ++c) {
      for (int ps = 0; ps < 4; ++ps) {
        const float* src = p.sc + (size_t)t0 * 2048 + h * 256 + c * 128 + ps * 32;
#pragma unroll
        for (int j = 0; j < 8; ++j) {
          int tt = (lane >> 3) + 8 * j, f4 = lane & 7;
          float4 v = *reinterpret_cast<const float4*>(src + (size_t)tt * 2048 + f4 * 4);
          float* d = s_tile + tt * 33 + f4 * 4;
          d[0] = v.x; d[1] = v.y; d[2] = v.z; d[3] = v.w;
        }
        for (int s = 0; s < 32; ++s) {
          float v = s_tile[lane * 33 + s];
          int key = (mono_key(v) & ~127) | (127 - (ps * 32 + s));
          if (c == 0) INS16(L1, key) else INS16(L2, key)
        }
      }
    }
#pragma unroll
    for (int j = 0; j < 16; ++j) { s_list[(0 * 16 + j) * 64 + lane] = 127 - (L1[j] & 127); s_list[(1 * 16 + j) * 64 + lane] = 127 - (L2[j] & 127); }
    float v1[16], v2[16];
#pragma unroll
    for (int j = 0; j < 16; ++j) { v1[j] = mono_val(L1[j] & ~127); v2[j] = mono_val(L2[j] & ~127); }
    int LC[16];
#pragma unroll
    for (int j = 0; j < 16; ++j) LC[j] = (int)0x80000000;
#pragma unroll
    for (int i = 0; i < 16; ++i)
#pragma unroll
      for (int j = 0; j < 16; ++j)
        if ((i + 1) * (j + 1) <= 16) {
          int key = (mono_key(v1[i] + v2[j]) & ~255) | (255 - (i * 16 + j));
          INS16(LC, key)
        }
    const float scale = rsqrtf(s_ss[lane] * (1.f / 256.f) + EPS);
    float vs[16]; float den = 0.f;
    const float top = mono_val(LC[0] & ~255);
#pragma unroll
    for (int k = 0; k < 16; ++k) { vs[k] = __expf((mono_val(LC[k] & ~255) - top) * scale); den += vs[k]; }
    const float inv = 1.f / den;
    const size_t ob = (size_t)(t0 + lane) * 128 + h * 16;
#pragma unroll
    for (int k4 = 0; k4 < 4; ++k4) {
      int ee[4]; float gg[4];
#pragma unroll
      for (int q = 0; q < 4; ++q) {
        int k = k4 * 4 + q;
        int ci = 255 - (LC[k] & 255);
        int i1 = s_list[(0 * 16 + (ci >> 4)) * 64 + lane];
        int i2 = s_list[(1 * 16 + (ci & 15)) * 64 + lane];
        ee[q] = i1 * 128 + i2; gg[q] = vs[k] * inv;
      }
      *reinterpret_cast<int4*>(p.eidx + ob + k4 * 4) = make_int4(ee[0], ee[1], ee[2], ee[3]);
      *reinterpret_cast<float4*>(p.egate + ob + k4 * 4) = make_float4(gg[0], gg[1], gg[2], gg[3]);
    }
  }
}

__device__ __forceinline__ float dot8(uint4 a, uint4 b, float acc) {
  acc = __builtin_amdgcn_fdot2_f32_bf16(*reinterpret_cast<bf16x2*>(&a.x), *reinterpret_cast<bf16x2*>(&b.x), acc, false);
  acc = __builtin_amdgcn_fdot2_f32_bf16(*reinterpret_cast<bf16x2*>(&a.y), *reinterpret_cast<bf16x2*>(&b.y), acc, false);
  acc = __builtin_amdgcn_fdot2_f32_bf16(*reinterpret_cast<bf16x2*>(&a.z), *reinterpret_cast<bf16x2*>(&b.z), acc, false);
  acc = __builtin_amdgcn_fdot2_f32_bf16(*reinterpret_cast<bf16x2*>(&a.w), *reinterpret_cast<bf16x2*>(&b.w), acc, false);
  return acc;
}
__device__ __forceinline__ void axpy8(float* y, float wgt, uint4 v) {
  y[0] += wgt * bf_lo(v.x); y[1] += wgt * bf_hi(v.x); y[2] += wgt * bf_lo(v.y); y[3] += wgt * bf_hi(v.y);
  y[4] += wgt * bf_lo(v.z); y[5] += wgt * bf_hi(v.z); y[6] += wgt * bf_lo(v.w); y[7] += wgt * bf_hi(v.w);
}

__device__ void ph_gather(const Params& p, int l, int bid, int nblk) {
  const int lane = threadIdx.x & 63, w = threadIdx.x >> 6;
  const bf16_t* ubl = p.ub + (size_t)l * 16384 * 1024;
  const bf16_t* vbl = p.vb + (size_t)l * 16384 * 1024;
  for (int t = bid * 4 + w; t < NTOK; t += nblk * 4) {
    const uint4 xa = *reinterpret_cast<const uint4*>(p.xn + (size_t)t * 1024 + lane * 8);
    const uint4 xb = *reinterpret_cast<const uint4*>(p.xn + (size_t)t * 1024 + 512 + lane * 8);
    const int e_lo = p.eidx[(size_t)t * 128 + lane], e_hi = p.eidx[(size_t)t * 128 + 64 + lane];
    const float g_lo = p.egate[(size_t)t * 128 + lane], g_hi = p.egate[(size_t)t * 128 + 64 + lane];
    float y[16];
#pragma unroll
    for (int i = 0; i < 16; ++i) y[i] = 0.f;
    for (int k0 = 0; k0 < 128; k0 += 4) {
      uint4 ua[4], ubv[4], va[4], vbv[4]; float gt[4];
#pragma unroll
      for (int q = 0; q < 4; ++q) {
        const int k = k0 + q;
        const int e = (k < 64) ? __shfl(e_lo, k) : __shfl(e_hi, k - 64);
        gt[q] = (k < 64) ? __shfl(g_lo, k) : __shfl(g_hi, k - 64);
        const bf16_t* ur = ubl + (size_t)e * 1024 + lane * 8;
        const bf16_t* vr = vbl + (size_t)e * 1024 + lane * 8;
        ua[q] = *reinterpret_cast<const uint4*>(ur);
        ubv[q] = *reinterpret_cast<const uint4*>(ur + 512);
        va[q] = *reinterpret_cast<const uint4*>(vr);
        vbv[q] = *reinterpret_cast<const uint4*>(vr + 512);
      }
#pragma unroll
      for (int q = 0; q < 4; ++q) {
        float d = dot8(xa, ua[q], 0.f);
        d = dot8(xb, ubv[q], d);
        d = wave_sum(d);
        const float wgt = gt[q] * gelu_exact(d);
        axpy8(y, wgt, va[q]);
        axpy8(y + 8, wgt, vbv[q]);
      }
    }
    float* xr = p.x + (size_t)t * 1024;
    float4 a0 = *reinterpret_cast<float4*>(xr + lane * 8), a1 = *reinterpret_cast<float4*>(xr + lane * 8 + 4);
    float4 b0 = *reinterpret_cast<float4*>(xr + 512 + lane * 8), b1 = *reinterpret_cast<float4*>(xr + 512 + lane * 8 + 4);
    a0.x += y[0]; a0.y += y[1]; a0.z += y[2]; a0.w += y[3]; a1.x += y[4]; a1.y += y[5]; a1.z += y[6]; a1.w += y[7];
    b0.x += y[8]; b0.y += y[9]; b0.z += y[10]; b0.w += y[11]; b1.x += y[12]; b1.y += y[13]; b1.z += y[14]; b1.w += y[15];
    *reinterpret_cast<float4*>(xr + lane * 8) = a0; *reinterpret_cast<float4*>(xr + lane * 8 + 4) = a1;
    *reinterpret_cast<float4*>(xr + 512 + lane * 8) = b0; *reinterpret_cast<float4*>(xr + 512 + lane * 8 + 4) = b1;
  }
}

enum { PH_PREP = 0, PH_NORM1, PH_GEMM_IN, PH_ATTN, PH_MLCONV, PH_MCHAIN, PH_MLU, PH_MLSCAN, PH_MLOUT, PH_CMLP,
       PH_GEMM_OUT, PH_NORM2, PH_GEMM_PQ, PH_GEMM_SC, PH_TOPK, PH_GATHER, PH_FINAL };

template <int PH>
__global__ void __launch_bounds__(256, 2) phase_kernel(Params p, int l) {
  __shared__ __attribute__((aligned(16))) char smem[SMEM_BYTES];
  const int bid = blockIdx.x, nblk = gridDim.x;
  if (PH == PH_PREP) ph_prep(p, smem, bid, nblk);
  else if (PH == PH_NORM1) ph_rmsnorm<0>(p, l, bid, nblk);
  else if (PH == PH_GEMM_IN) ph_gemm<EPI_WIN>(p, l, smem, bid, nblk);
  else if (PH == PH_ATTN) ph_attn(p, l, smem, bid, nblk);
  else if (PH == PH_MLCONV) ph_mlconv(p, l, smem, bid, nblk);
  else if (PH == PH_MCHAIN) ph_mchain(p, l, bid, nblk);
  else if (PH == PH_MLU) ph_mlU(p, l, smem, bid, nblk);
  else if (PH == PH_MLSCAN) ph_mlscan(p, l, bid, nblk);
  else if (PH == PH_MLOUT) ph_mlout(p, l, smem, bid, nblk);
  else if (PH == PH_CMLP) ph_cmlp(p, l, smem, bid, nblk);
  else if (PH == PH_GEMM_OUT) ph_gemm<EPI_WOUT>(p, l, smem, bid, nblk);
  else if (PH == PH_NORM2) ph_rmsnorm<1>(p, l, bid, nblk);
  else if (PH == PH_GEMM_PQ) ph_gemm<EPI_PQ>(p, l, smem, bid, nblk);
  else if (PH == PH_GEMM_SC) ph_gemm<EPI_SC>(p, l, smem, bid, nblk);
  else if (PH == PH_TOPK) ph_topk(p, l, smem, bid, nblk);
  else if (PH == PH_GATHER) ph_gather(p, l, bid, nblk);
  else if (PH == PH_FINAL) ph_rmsnorm<2>(p, l, bid, nblk);
}

static inline size_t align_up(size_t v, size_t a) { return (v + a - 1) / a * a; }

extern "C" void kernel_launch(void* const* d_in, const int* in_sizes, int n_in, void* d_out, int out_size, void* d_ws,
                              size_t ws_size, hipStream_t stream) {
  Params p{};
  const float** ins = reinterpret_cast<const float**>(&p);
  for (int i = 0; i < 30; ++i) ins[i] = reinterpret_cast<const float*>(d_in[i]);
  p.out = reinterpret_cast<float*>(d_out);
  char* base = reinterpret_cast<char*>(d_ws);
  size_t off = 0;
  auto take = [&](size_t bytes) { char* r = base + off; off = align_up(off + bytes, 256); return r; };
  take(16384);
  p.lam = (float*)take(256);
  p.lut = (float*)take(4 * 256 * 4);
  p.wt_in = (bf16_t*)take((size_t)2 * NIN * 1024 * 2);
  p.wg = (float*)take((size_t)2 * 8 * 1024 * 4);
  p.wt_out = (bf16_t*)take((size_t)2 * 1024 * 1024 * 2);
  p.wt_pq = (bf16_t*)take((size_t)2 * 2048 * 1024 * 2);
  p.keysb = (bf16_t*)take((size_t)2 * 16 * 128 * 128 * 2);
  p.ub = (bf16_t*)take((size_t)2 * 16384 * 1024 * 2);
  p.vb = (bf16_t*)take((size_t)2 * 16384 * 1024 * 2);
  p.Kbs = (bf16_t*)take((size_t)2 * 8 * SKEYS * 512 * 2);
  p.Vts = (bf16_t*)take((size_t)2 * 8 * 4 * 128 * SKEYS * 2);
  p.x = (float*)take((size_t)NTOK * 1024 * 4);
  p.xn = (bf16_t*)take((size_t)NTOK * 1024 * 2);
  const size_t r0 = off;
  p.Qb = (bf16_t*)take((size_t)NTOK * 512 * 2);
  p.Kb = (bf16_t*)take((size_t)NPROMPT * 512 * 2);
  p.Vt = (bf16_t*)take((size_t)16 * 128 * SEQ * 2);
  p.P5 = (float*)take((size_t)NTOK * 1280 * 4);
  p.ig = (float*)take((size_t)NTOK * 4 * 4);
  p.lf = (float*)take((size_t)NTOK * 4 * 4);
  p.Fc = (float*)take((size_t)NTOK * 4 * 4);
  p.cc = (float*)take((size_t)NTOK * 256 * 4);
  p.qm = (float*)take((size_t)NTOK * 256 * 4);
  p.km = (float*)take((size_t)NTOK * 256 * 4);
  p.mst = (float*)take(NCU_UNITS * 4);
  p.mnx = (float*)take(NCU_UNITS * 4);
  p.wcs = (float*)take(NCU_UNITS * 4);
  p.FLs = (float*)take(NCU_UNITS * 4);
  p.U = (float*)take((size_t)NCU_UNITS * 4096 * 4);
  p.un = (float*)take((size_t)NCU_UNITS * 64 * 4);
  p.Cst = (float*)take((size_t)NCU_UNITS * 4096 * 4);
  p.nst = (float*)take((size_t)NCU_UNITS * 64 * 4);
  const size_t end_mixer = off;
  off = r0;
  p.qp = (bf16_t*)take((size_t)NTOK * 2048 * 2);
  p.sc = (float*)take((size_t)NTOK * 2048 * 4);
  p.eidx = (int*)take((size_t)NTOK * 128 * 4);
  p.egate = (float*)take((size_t)NTOK * 128 * 4);
  const size_t end_peer = off;
  const size_t need = end_mixer > end_peer ? end_mixer : end_peer;
  if (need > ws_size) { fprintf(stderr, "workspace too small: need %zu have %zu\n", need, ws_size); return; }

  const int G = 512;
  dim3 blk(256);
#define LAUNCH(PH, grid, l) hipLaunchKernelGGL(phase_kernel<PH>, dim3(grid), blk, 0, stream, p, l)
  LAUNCH(PH_PREP, 1024, 0);
  for (int l = 0; l < 2; ++l) {
    LAUNCH(PH_NORM1, G, l);
    LAUNCH(PH_GEMM_IN, G, l);
    LAUNCH(PH_ATTN, G, l);
    LAUNCH(PH_MLCONV, G, l);
    LAUNCH(PH_MCHAIN, 12, l);
    LAUNCH(PH_MLU, G, l);
    LAUNCH(PH_MLSCAN, G, l);
    LAUNCH(PH_MLOUT, G, l);
    LAUNCH(PH_CMLP, G, l);
    LAUNCH(PH_GEMM_OUT, G, l);
    LAUNCH(PH_NORM2, G, l);
    LAUNCH(PH_GEMM_PQ, G, l);
    LAUNCH(PH_GEMM_SC, G, l);
    LAUNCH(PH_TOPK, G, l);
    LAUNCH(PH_GATHER, G, l);
  }
  LAUNCH(PH_FINAL, G, 0);
#undef LAUNCH
}
```

```cpp
#include <hip/hip_runtime.h>
#include <hip/hip_cooperative_groups.h>
#include <cstdio>
#include <cstdint>

namespace cg = cooperative_groups;

typedef unsigned short bf16_t;
typedef __attribute__((ext_vector_type(8))) __bf16 bf16x8;
typedef __attribute__((ext_vector_type(2))) __bf16 bf16x2;
typedef __attribute__((ext_vector_type(16))) float f32x16;
typedef __attribute__((ext_vector_type(2))) float f32x2;

#define D_MODEL 1024
#define NTOK 16896
#define NPROMPT 16384
#define SEQ 4096
#define NIN 2816
#define EPS 1e-6f
#define LOG2E 1.4426950408889634f
#define SKEYS 1088
#define NCU_UNITS 1056

constexpr size_t O_Y_P = 0;
constexpr size_t O_Y_S = O_Y_P + 16777216;
constexpr size_t O_K_P = O_Y_S + 524288;
constexpr size_t O_V_P = O_K_P + 16777216;
constexpr size_t O_C_P = O_V_P + 16777216;
constexpr size_t O_N_P = O_C_P + 131072;
constexpr size_t O_M_P = O_N_P + 2048;
constexpr size_t O_CONV_P = O_M_P + 32;
constexpr size_t O_K_S = O_CONV_P + 6144;
constexpr size_t O_V_S = O_K_S + 524288;
constexpr size_t O_C_S = O_V_S + 524288;
constexpr size_t O_N_S = O_C_S + 262144;
constexpr size_t O_M_S = O_N_S + 4096;
constexpr size_t O_CONV_S = O_M_S + 64;
constexpr size_t O_CMV_S = O_CONV_S + 12288;

constexpr size_t al256(size_t v) { return (v + 255) / 256 * 256; }
constexpr int SP_st_c = 0;
constexpr int SP_st_n = 262144;
constexpr int SP_st_m = 266240;
constexpr int SP_st_conv = 266304;
constexpr int SP_norm1_g = 278592;
constexpr int SP_da_subln_g = 280640;
constexpr int SP_ml_conv_w = 280896;
constexpr int SP_ml_conv_b = 282944;
constexpr int SP_ml_wq = 283456;
constexpr int SP_ml_wk = 316224;
constexpr int SP_ml_gate_b = 348992;
constexpr int SP_ml_norm_g = 349056;
constexpr int SP_ml_skip = 349568;
constexpr int SP_cm_norm_g = 350080;
constexpr int SP_cm_ws = 350592;
constexpr int SP_cm_b = 481664;
constexpr int SP_norm2_g = 482688;
constexpr int SP_final_g = 484736;
constexpr int SP_TOTAL = 485760;
constexpr size_t WS_bar = 0;
constexpr size_t WS_lam = al256(WS_bar + 16384);
constexpr size_t WS_lut = al256(WS_lam + (256));
constexpr size_t WS_sp = al256(WS_lut + (4*256*4));
constexpr size_t WS_wt_in = al256(WS_sp + (SP_TOTAL*4));
constexpr size_t WS_wg = al256(WS_wt_in + ((size_t)2*NIN*1024*2));
constexpr size_t WS_wt_out = al256(WS_wg + ((size_t)2*8*1024*4));
constexpr size_t WS_wt_pq = al256(WS_wt_out + ((size_t)2*1024*1024*2));
constexpr size_t WS_keysb = al256(WS_wt_pq + ((size_t)2*2048*1024*2));
constexpr size_t WS_ub = al256(WS_keysb + ((size_t)2*16*128*128*2));
constexpr size_t WS_vb = al256(WS_ub + ((size_t)2*16384*1024*2));
constexpr size_t WS_Kbs = al256(WS_vb + ((size_t)2*16384*1024*2));
constexpr size_t WS_Vts = al256(WS_Kbs + ((size_t)2*8*SKEYS*512*2));
constexpr size_t WS_x = al256(WS_Vts + ((size_t)2*8*4*128*SKEYS*2));
constexpr size_t WS_xn = al256(WS_x + ((size_t)NTOK*1024*4));
constexpr size_t WS_R0 = al256(WS_xn + ((size_t)NTOK*1024*2));
constexpr size_t WS_R0x = WS_R0;
constexpr size_t WS_Qb = al256(WS_R0x + (0));
constexpr size_t WS_Kb = al256(WS_Qb + ((size_t)NTOK*512*2));
constexpr size_t WS_Vt = al256(WS_Kb + ((size_t)NPROMPT*512*2));
constexpr size_t WS_P5 = al256(WS_Vt + ((size_t)16*128*SEQ*2));
constexpr size_t WS_ig = al256(WS_P5 + ((size_t)NTOK*1280*4));
constexpr size_t WS_lf = al256(WS_ig + ((size_t)NTOK*4*4));
constexpr size_t WS_Fc = al256(WS_lf + ((size_t)NTOK*4*4));
constexpr size_t WS_cc = al256(WS_Fc + ((size_t)NTOK*4*4));
constexpr size_t WS_qm = al256(WS_cc + ((size_t)NTOK*256*4));
constexpr size_t WS_km = al256(WS_qm + ((size_t)NTOK*256*4));
constexpr size_t WS_mst = al256(WS_km + ((size_t)NTOK*256*4));
constexpr size_t WS_mnx = al256(WS_mst + (NCU_UNITS*4));
constexpr size_t WS_wcs = al256(WS_mnx + (NCU_UNITS*4));
constexpr size_t WS_FLs = al256(WS_wcs + (NCU_UNITS*4));
constexpr size_t WS_U = al256(WS_FLs + (NCU_UNITS*4));
constexpr size_t WS_un = al256(WS_U + ((size_t)NCU_UNITS*4096*4));
constexpr size_t WS_Cst = al256(WS_un + ((size_t)NCU_UNITS*64*4));
constexpr size_t WS_nst = al256(WS_Cst + ((size_t)NCU_UNITS*4096*4));
constexpr size_t WS_END_MIXER = al256(WS_nst + ((size_t)NCU_UNITS*64*4));
constexpr size_t WS_qp = al256(WS_R0x + (0));
constexpr size_t WS_sc = al256(WS_qp + ((size_t)NTOK*2048*2));
constexpr size_t WS_eidx = al256(WS_sc + ((size_t)NTOK*2048*4));
constexpr size_t WS_egate = al256(WS_eidx + ((size_t)NTOK*128*4));
constexpr size_t WS_END_PEER = al256(WS_egate + ((size_t)NTOK*128*4));
constexpr size_t WS_NEED = WS_END_MIXER > WS_END_PEER ? WS_END_MIXER : WS_END_PEER;

struct Params {
  const float* in[30];
  float* out;
  char* ws;
  __device__ __forceinline__ const float* x_prompt() const { return in[0]; }
  __device__ __forceinline__ const float* x_sample() const { return in[1]; }
  __device__ __forceinline__ const float* cache_k() const { return in[2]; }
  __device__ __forceinline__ const float* cache_v() const { return in[3]; }
  __device__ __forceinline__ const float* w_in() const { return in[9]; }
  __device__ __forceinline__ const float* da_lambda() const { return in[10]; }
  __device__ __forceinline__ const float* rel_table() const { return in[12]; }
  __device__ __forceinline__ const float* w_out() const { return in[23]; }
  __device__ __forceinline__ const float* peer_wq() const { return in[25]; }
  __device__ __forceinline__ const float* peer_keys() const { return in[26]; }
  __device__ __forceinline__ const float* peer_u() const { return in[27]; }
  __device__ __forceinline__ const float* peer_v() const { return in[28]; }
  __device__ __forceinline__ const float* st_c() const { return reinterpret_cast<const float*>(ws + WS_sp) + SP_st_c; }
  __device__ __forceinline__ const float* st_n() const { return reinterpret_cast<const float*>(ws + WS_sp) + SP_st_n; }
  __device__ __forceinline__ const float* st_m() const { return reinterpret_cast<const float*>(ws + WS_sp) + SP_st_m; }
  __device__ __forceinline__ const float* st_conv() const { return reinterpret_cast<const float*>(ws + WS_sp) + SP_st_conv; }
  __device__ __forceinline__ const float* norm1_g() const { return reinterpret_cast<const float*>(ws + WS_sp) + SP_norm1_g; }
  __device__ __forceinline__ const float* da_subln_g() const { return reinterpret_cast<const float*>(ws + WS_sp) + SP_da_subln_g; }
  __device__ __forceinline__ const float* ml_conv_w() const { return reinterpret_cast<const float*>(ws + WS_sp) + SP_ml_conv_w; }
  __device__ __forceinline__ const float* ml_conv_b() const { return reinterpret_cast<const float*>(ws + WS_sp) + SP_ml_conv_b; }
  __device__ __forceinline__ const float* ml_wq() const { return reinterpret_cast<const float*>(ws + WS_sp) + SP_ml_wq; }
  __device__ __forceinline__ const float* ml_wk() const { return reinterpret_cast<const float*>(ws + WS_sp) + SP_ml_wk; }
  __device__ __forceinline__ const float* ml_gate_b() const { return reinterpret_cast<const float*>(ws + WS_sp) + SP_ml_gate_b; }
  __device__ __forceinline__ const float* ml_norm_g() const { return reinterpret_cast<const float*>(ws + WS_sp) + SP_ml_norm_g; }
  __device__ __forceinline__ const float* ml_skip() const { return reinterpret_cast<const float*>(ws + WS_sp) + SP_ml_skip; }
  __device__ __forceinline__ const float* cm_norm_g() const { return reinterpret_cast<const float*>(ws + WS_sp) + SP_cm_norm_g; }
  __device__ __forceinline__ const float* cm_ws() const { return reinterpret_cast<const float*>(ws + WS_sp) + SP_cm_ws; }
  __device__ __forceinline__ const float* cm_b() const { return reinterpret_cast<const float*>(ws + WS_sp) + SP_cm_b; }
  __device__ __forceinline__ const float* norm2_g() const { return reinterpret_cast<const float*>(ws + WS_sp) + SP_norm2_g; }
  __device__ __forceinline__ const float* final_g() const { return reinterpret_cast<const float*>(ws + WS_sp) + SP_final_g; }
  __device__ __forceinline__ float* lam() const { return reinterpret_cast<float*>(ws + WS_lam); }
  __device__ __forceinline__ float* lut() const { return reinterpret_cast<float*>(ws + WS_lut); }
  __device__ __forceinline__ float* sp() const { return reinterpret_cast<float*>(ws + WS_sp); }
  __device__ __forceinline__ bf16_t* wt_in() const { return reinterpret_cast<bf16_t*>(ws + WS_wt_in); }
  __device__ __forceinline__ float* wg() const { return reinterpret_cast<float*>(ws + WS_wg); }
  __device__ __forceinline__ bf16_t* wt_out() const { return reinterpret_cast<bf16_t*>(ws + WS_wt_out); }
  __device__ __forceinline__ bf16_t* wt_pq() const { return reinterpret_cast<bf16_t*>(ws + WS_wt_pq); }
  __device__ __forceinline__ bf16_t* keysb() const { return reinterpret_cast<bf16_t*>(ws + WS_keysb); }
  __device__ __forceinline__ bf16_t* ub() const { return reinterpret_cast<bf16_t*>(ws + WS_ub); }
  __device__ __forceinline__ bf16_t* vb() const { return reinterpret_cast<bf16_t*>(ws + WS_vb); }
  __device__ __forceinline__ bf16_t* Kbs() const { return reinterpret_cast<bf16_t*>(ws + WS_Kbs); }
  __device__ __forceinline__ bf16_t* Vts() const { return reinterpret_cast<bf16_t*>(ws + WS_Vts); }
  __device__ __forceinline__ float* x() const { return reinterpret_cast<float*>(ws + WS_x); }
  __device__ __forceinline__ bf16_t* xn() const { return reinterpret_cast<bf16_t*>(ws + WS_xn); }
  __device__ __forceinline__ bf16_t* Qb() const { return reinterpret_cast<bf16_t*>(ws + WS_Qb); }
  __device__ __forceinline__ bf16_t* Kb() const { return reinterpret_cast<bf16_t*>(ws + WS_Kb); }
  __device__ __forceinline__ bf16_t* Vt() const { return reinterpret_cast<bf16_t*>(ws + WS_Vt); }
  __device__ __forceinline__ float* P5() const { return reinterpret_cast<float*>(ws + WS_P5); }
  __device__ __forceinline__ float* ig() const { return reinterpret_cast<float*>(ws + WS_ig); }
  __device__ __forceinline__ float* lf() const { return reinterpret_cast<float*>(ws + WS_lf); }
  __device__ __forceinline__ float* Fc() const { return reinterpret_cast<float*>(ws + WS_Fc); }
  __device__ __forceinline__ float* cc() const { return reinterpret_cast<float*>(ws + WS_cc); }
  __device__ __forceinline__ float* qm() const { return reinterpret_cast<float*>(ws + WS_qm); }
  __device__ __forceinline__ float* km() const { return reinterpret_cast<float*>(ws + WS_km); }
  __device__ __forceinline__ float* mst() const { return reinterpret_cast<float*>(ws + WS_mst); }
  __device__ __forceinline__ float* mnx() const { return reinterpret_cast<float*>(ws + WS_mnx); }
  __device__ __forceinline__ float* wcs() const { return reinterpret_cast<float*>(ws + WS_wcs); }
  __device__ __forceinline__ float* FLs() const { return reinterpret_cast<float*>(ws + WS_FLs); }
  __device__ __forceinline__ float* U() const { return reinterpret_cast<float*>(ws + WS_U); }
  __device__ __forceinline__ float* un() const { return reinterpret_cast<float*>(ws + WS_un); }
  __device__ __forceinline__ float* Cst() const { return reinterpret_cast<float*>(ws + WS_Cst); }
  __device__ __forceinline__ float* nst() const { return reinterpret_cast<float*>(ws + WS_nst); }
  __device__ __forceinline__ bf16_t* qp() const { return reinterpret_cast<bf16_t*>(ws + WS_qp); }
  __device__ __forceinline__ float* sc() const { return reinterpret_cast<float*>(ws + WS_sc); }
  __device__ __forceinline__ int* eidx() const { return reinterpret_cast<int*>(ws + WS_eidx); }
  __device__ __forceinline__ float* egate() const { return reinterpret_cast<float*>(ws + WS_egate); }
};

__device__ __forceinline__ unsigned pack2(float a, float b) {
  f32x2 v = {a, b};
  bf16x2 r = __builtin_convertvector(v, bf16x2);
  return *reinterpret_cast<unsigned*>(&r);
}
__device__ __forceinline__ bf16_t f2bf(float a) { return (bf16_t)(pack2(a, 0.f) & 0xFFFFu); }
__device__ __forceinline__ float bf_lo(unsigned u) { return __uint_as_float(u << 16); }
__device__ __forceinline__ float bf_hi(unsigned u) { return __uint_as_float(u & 0xFFFF0000u); }
__device__ __forceinline__ float gelu_exact(float x) { return 0.5f * x * (1.f + erff(x * 0.70710678118654752f)); }
__device__ __forceinline__ float sigmoidf_(float x) { return 1.f / (1.f + __expf(-x)); }
template <int CTRL>
__device__ __forceinline__ float dpp_f(float v) {
  return __builtin_bit_cast(float, __builtin_amdgcn_update_dpp(0, __builtin_bit_cast(int, v), CTRL, 0xf, 0xf, true));
}
__device__ __forceinline__ float swap16_sum(float x) {
  auto s = __builtin_amdgcn_permlane16_swap(__float_as_uint(x), __float_as_uint(x), false, false);
  return __uint_as_float(s[0]) + __uint_as_float(s[1]);
}
__device__ __forceinline__ float swap32_sum(float x) {
  auto s = __builtin_amdgcn_permlane32_swap(__float_as_uint(x), __float_as_uint(x), false, false);
  return __uint_as_float(s[0]) + __uint_as_float(s[1]);
}
__device__ __forceinline__ float swap16_max(float x) {
  auto s = __builtin_amdgcn_permlane16_swap(__float_as_uint(x), __float_as_uint(x), false, false);
  return fmaxf(__uint_as_float(s[0]), __uint_as_float(s[1]));
}
__device__ __forceinline__ float swap32_max(float x) {
  auto s = __builtin_amdgcn_permlane32_swap(__float_as_uint(x), __float_as_uint(x), false, false);
  return fmaxf(__uint_as_float(s[0]), __uint_as_float(s[1]));
}
__device__ __forceinline__ float row16_sum(float v) {
  v += dpp_f<0xB1>(v); v += dpp_f<0x4E>(v); v += dpp_f<0x141>(v); v += dpp_f<0x140>(v);
  return v;
}
__device__ __forceinline__ float row16_max(float v) {
  v = fmaxf(v, dpp_f<0xB1>(v)); v = fmaxf(v, dpp_f<0x4E>(v)); v = fmaxf(v, dpp_f<0x141>(v)); v = fmaxf(v, dpp_f<0x140>(v));
  return v;
}
__device__ __forceinline__ float wave_sum(float v) { return swap32_sum(swap16_sum(row16_sum(v))); }
__device__ __forceinline__ float wave_max(float v) { return swap32_max(swap16_max(row16_max(v))); }
__device__ __forceinline__ const float* xrow_in(const Params& p, int l, int t) {
  if (l == 0) return (t < NPROMPT) ? p.x_prompt() + (size_t)t * D_MODEL : p.x_sample() + (size_t)(t - NPROMPT) * D_MODEL;
  return p.x() + (size_t)t * D_MODEL;
}
__device__ __forceinline__ bf16x8 as_bf16x8(uint4 v) { return *reinterpret_cast<bf16x8*>(&v); }

__device__ __forceinline__ int tid_opaque() { int t = threadIdx.x; asm volatile("" : "+v"(t)); return t; }
__device__ __forceinline__ int sgpr_opaque(int v) { asm volatile("" : "+s"(v)); return v; }
__device__ __forceinline__ int bid_opaque(int v) { asm volatile("" : "+s"(v)); __builtin_assume(v >= 0); __builtin_assume(v < 1024); return v; }
__device__ __forceinline__ int nblk_opaque(int v) { asm volatile("" : "+s"(v)); __builtin_assume(v >= 1); __builtin_assume(v <= 1024); return v; }
#define SMEM_BYTES 73728

__device__ __forceinline__ void transpose_tile(const float* __restrict__ src, int lds, bf16_t* __restrict__ dst, int K, int n0, int k0,
                               int gate_skip, float* tile  ) {
  const int tid = tid_opaque();
  const int c = tid & 63, r0 = tid >> 6;
  int n = n0 + c;
  int col = n + ((gate_skip && n >= 2304) ? 8 : 0);
#pragma unroll 4
  for (int j = 0; j < 16; ++j) {
    int r = r0 + 4 * j;
    tile[r * 65 + c] = src[(size_t)(k0 + r) * lds + col];
  }
  __syncthreads();
  const int nn = tid >> 2, kg = (tid & 3) * 16;
  unsigned w[8];
#pragma unroll
  for (int j = 0; j < 8; ++j) w[j] = pack2(tile[(kg + 2 * j) * 65 + nn], tile[(kg + 2 * j + 1) * 65 + nn]);
  uint4* d = reinterpret_cast<uint4*>(dst + (size_t)(n0 + nn) * K + k0 + kg);
  d[0] = make_uint4(w[0], w[1], w[2], w[3]);
  d[1] = make_uint4(w[4], w[5], w[6], w[7]);
  __syncthreads();
}

__device__ __forceinline__ int rel_bucket_dev(int rel) {
  int ret = rel > 0 ? 16 : 0;
  int n = rel < 0 ? -rel : rel;
  int b;
  if (n < 8) b = n;
  else if (n < 12) b = 8;
  else if (n < 16) b = 9;
  else if (n < 23) b = 10;
  else if (n < 32) b = 11;
  else if (n < 46) b = 12;
  else if (n < 64) b = 13;
  else if (n < 91) b = 14;
  else b = 15;
  return ret + b;
}

__device__ __forceinline__ void ph_prep(const Params& p, char* smem, int bid, int nblk) {
  const int tid = tid_opaque();
  float* tile = reinterpret_cast<float*>(smem);
  for (int u = bid; u < 2 * 1472; u += nblk) {
    int l = u / 1472, r = u % 1472;
    if (r < 704) {
      int nt = r / 16, kt = r % 16;
      transpose_tile(p.w_in() + (size_t)l * 1024 * 2824, 2824, p.wt_in() + (size_t)l * NIN * 1024, 1024, nt * 64, kt * 64, 1, tile);
    } else if (r < 960) {
      r -= 704; int nt = r / 16, kt = r % 16;
      transpose_tile(p.w_out() + (size_t)l * 1024 * 1024, 1024, p.wt_out() + (size_t)l * 1024 * 1024, 1024, nt * 64, kt * 64, 0, tile);
    } else {
      r -= 960; int nt = r / 16, kt = r % 16;
      transpose_tile(p.peer_wq() + (size_t)l * 1024 * 2048, 2048, p.wt_pq() + (size_t)l * 2048 * 1024, 1024, nt * 64, kt * 64, 0, tile);
    }
  }
  for (int u = bid; u < 1024; u += nblk) {
    int kt = u & 15, h = (u >> 4) & 3, b = (u >> 6) & 7, l = u >> 9;
    const float* src = p.cache_v() + (((size_t)(l * 8 + b) * 1024 + kt * 64) * 4 + h) * 128;
    {
      int c = tid & 127, r0 = tid >> 7;
      for (int j = 0; j < 32; ++j) { int r = r0 + 2 * j; tile[r * 129 + c] = src[(size_t)r * 512 + c]; }
    }
    __syncthreads();
    {
      int dv = tid >> 1, half = tid & 1;
      bf16_t* dst = p.Vts() + ((size_t)((l * 8 + b) * 4 + h) * 128 + dv) * SKEYS + kt * 64 + half * 32;
      unsigned w[16];
#pragma unroll
      for (int j = 0; j < 16; ++j) {
        int pos0 = half * 32 + 2 * j;
        int blk = (pos0 >> 2) & 3;
        int oblk = (blk == 1) ? 2 : (blk == 2 ? 1 : blk);
        int key0 = (pos0 & ~15) + oblk * 4 + (pos0 & 3);
        w[j] = pack2(tile[key0 * 129 + dv], tile[(key0 + 1) * 129 + dv]);
      }
      uint4* d4 = reinterpret_cast<uint4*>(dst);
      d4[0] = make_uint4(w[0], w[1], w[2], w[3]);
      d4[1] = make_uint4(w[4], w[5], w[6], w[7]);
      d4[2] = make_uint4(w[8], w[9], w[10], w[11]);
      d4[3] = make_uint4(w[12], w[13], w[14], w[15]);
    }
    __syncthreads();
  }
  const size_t gtid = (size_t)bid * 256 + tid, gsz = (size_t)nblk * 256;
  {
    const size_t n8 = (size_t)2 * 16384 * 1024 / 8;
    for (size_t i = gtid; i < n8; i += gsz) {
      float4 a = reinterpret_cast<const float4*>(p.peer_u())[2 * i], b = reinterpret_cast<const float4*>(p.peer_u())[2 * i + 1];
      reinterpret_cast<uint4*>(p.ub())[i] = make_uint4(pack2(a.x, a.y), pack2(a.z, a.w), pack2(b.x, b.y), pack2(b.z, b.w));
      float4 c = reinterpret_cast<const float4*>(p.peer_v())[2 * i], d = reinterpret_cast<const float4*>(p.peer_v())[2 * i + 1];
      reinterpret_cast<uint4*>(p.vb())[i] = make_uint4(pack2(c.x, c.y), pack2(c.z, c.w), pack2(d.x, d.y), pack2(d.z, d.w));
    }
  }
  {
    const size_t n8 = (size_t)2 * 16 * 128 * 128 / 8;
    for (size_t i = gtid; i < n8; i += gsz) {
      float4 a = reinterpret_cast<const float4*>(p.peer_keys())[2 * i], b = reinterpret_cast<const float4*>(p.peer_keys())[2 * i + 1];
      reinterpret_cast<uint4*>(p.keysb())[i] = make_uint4(pack2(a.x, a.y), pack2(a.z, a.w), pack2(b.x, b.y), pack2(b.z, b.w));
    }
  }
  {
    const size_t n8 = (size_t)2 * 8 * 1024 * 512 / 8;
    for (size_t i = gtid; i < n8; i += gsz) {
      size_t e = i * 8;
      size_t lb = e / (1024 * 512), rem = e % (1024 * 512);
      float4 a = reinterpret_cast<const float4*>(p.cache_k())[2 * i], b = reinterpret_cast<const float4*>(p.cache_k())[2 * i + 1];
      *reinterpret_cast<uint4*>(p.Kbs() + lb * (SKEYS * 512) + rem) = make_uint4(pack2(a.x, a.y), pack2(a.z, a.w), pack2(b.x, b.y), pack2(b.z, b.w));
    }
  }
  for (size_t i = gtid; i < 2 * 8 * 1024; i += gsz) {
    int l = (int)(i / 8192), r = (int)(i % 8192), g = r / 1024, k = r % 1024;
    p.wg()[i] = p.w_in()[((size_t)l * 1024 + k) * 2824 + 2304 + g];
  }
  {
    float* sp = reinterpret_cast<float*>(p.ws + WS_sp);
    for (size_t i = gtid; i < 262144; i += gsz) sp[SP_st_c + i] = p.in[4][i];
    for (size_t i = gtid; i < 4096; i += gsz) sp[SP_st_n + i] = p.in[5][i];
    for (size_t i = gtid; i < 64; i += gsz) sp[SP_st_m + i] = p.in[6][i];
    for (size_t i = gtid; i < 12288; i += gsz) sp[SP_st_conv + i] = p.in[7][i];
    for (size_t i = gtid; i < 2048; i += gsz) sp[SP_norm1_g + i] = p.in[8][i];
    for (size_t i = gtid; i < 256; i += gsz) sp[SP_da_subln_g + i] = p.in[11][i];
    for (size_t i = gtid; i < 2048; i += gsz) sp[SP_ml_conv_w + i] = p.in[13][i];
    for (size_t i = gtid; i < 512; i += gsz) sp[SP_ml_conv_b + i] = p.in[14][i];
    for (size_t i = gtid; i < 32768; i += gsz) sp[SP_ml_wq + i] = p.in[15][i];
    for (size_t i = gtid; i < 32768; i += gsz) sp[SP_ml_wk + i] = p.in[16][i];
    for (size_t i = gtid; i < 16; i += gsz) sp[SP_ml_gate_b + i] = p.in[17][i];
    for (size_t i = gtid; i < 512; i += gsz) sp[SP_ml_norm_g + i] = p.in[18][i];
    for (size_t i = gtid; i < 512; i += gsz) sp[SP_ml_skip + i] = p.in[19][i];
    for (size_t i = gtid; i < 512; i += gsz) sp[SP_cm_norm_g + i] = p.in[20][i];
    for (size_t i = gtid; i < 131072; i += gsz) sp[SP_cm_ws + i] = p.in[21][i];
    for (size_t i = gtid; i < 1024; i += gsz) sp[SP_cm_b + i] = p.in[22][i];
    for (size_t i = gtid; i < 2048; i += gsz) sp[SP_norm2_g + i] = p.in[24][i];
    for (size_t i = gtid; i < 1024; i += gsz) sp[SP_final_g + i] = p.in[29][i];
  }
  if (bid == 0) {
    for (int i = tid; i < 4 * 256; i += 256) {
      int h = i >> 8, j = i & 255;
      int rel = j - 191; if (rel > 63) rel = 63;
      p.lut()[i] = p.rel_table()[rel_bucket_dev(rel) * 4 + h] * LOG2E;
    }
    if (tid < 2) {
      const float* lp = p.da_lambda() + tid * 256;
      float s01 = 0.f, s23 = 0.f;
      for (int d = 0; d < 64; ++d) { s01 += lp[d] * lp[64 + d]; s23 += lp[128 + d] * lp[192 + d]; }
      float lam_init = 0.8f - 0.6f * expf(-0.3f * (float)tid);
      p.lam()[tid] = expf(s01) - expf(s23) + lam_init;
    }
  }
}

template <int MODE>
__device__ __forceinline__ void ph_rmsnorm(const Params& p, int l, int bid, int nblk) {
  const int lane = tid_opaque() & 63, w = tid_opaque() >> 6;
  const float* g = (MODE == 0) ? p.norm1_g() + l * 1024 : (MODE == 1 ? p.norm2_g() + l * 1024 : p.final_g());
  float4 gv[4];
#pragma unroll
  for (int j = 0; j < 4; ++j) gv[j] = reinterpret_cast<const float4*>(g)[lane + 64 * j];
  for (int t = bid * 4 + w; t < NTOK; t += nblk * 4) {
    const float* xr = (MODE == 0) ? xrow_in(p, l, t) : p.x() + (size_t)t * 1024;
    float4 xv[4];
    float ss = 0.f;
#pragma unroll
    for (int j = 0; j < 4; ++j) {
      xv[j] = reinterpret_cast<const float4*>(xr)[lane + 64 * j];
      ss += xv[j].x * xv[j].x + xv[j].y * xv[j].y + xv[j].z * xv[j].z + xv[j].w * xv[j].w;
    }
    ss = wave_sum(ss);
    float r = rsqrtf(ss * (1.f / 1024.f) + EPS);
#pragma unroll
    for (int j = 0; j < 4; ++j) {
      xv[j].x *= r * gv[j].x; xv[j].y *= r * gv[j].y; xv[j].z *= r * gv[j].z; xv[j].w *= r * gv[j].w;
    }
    if (MODE == 2) {
      float* o = (t < NPROMPT) ? p.out + O_Y_P + (size_t)t * 1024 : p.out + O_Y_S + (size_t)(t - NPROMPT) * 1024;
#pragma unroll
      for (int j = 0; j < 4; ++j) reinterpret_cast<float4*>(o)[lane + 64 * j] = xv[j];
    } else {
      uint2* o = reinterpret_cast<uint2*>(p.xn() + (size_t)t * 1024);
#pragma unroll
      for (int j = 0; j < 4; ++j) o[lane + 64 * j] = make_uint2(pack2(xv[j].x, xv[j].y), pack2(xv[j].z, xv[j].w));
    }
    if (MODE == 0) {
      float pre[8];
#pragma unroll
      for (int i = 0; i < 8; ++i) {
        const float4* wr = reinterpret_cast<const float4*>(p.wg() + ((size_t)l * 8 + i) * 1024);
        float s = 0.f;
#pragma unroll
        for (int j = 0; j < 4; ++j) {
          float4 wv = wr[lane + 64 * j];
          s += xv[j].x * wv.x + xv[j].y * wv.y + xv[j].z * wv.z + xv[j].w * wv.w;
        }
        pre[i] = wave_sum(s);
      }
      if (lane < 4) {
        float a = pre[0]; a = lane == 1 ? pre[1] : a; a = lane == 2 ? pre[2] : a; a = lane == 3 ? pre[3] : a;
        float f = pre[4]; f = lane == 1 ? pre[5] : f; f = lane == 2 ? pre[6] : f; f = lane == 3 ? pre[7] : f;
        p.ig()[(size_t)t * 4 + lane] = a + p.ml_gate_b()[l * 8 + lane];
        float z = f + p.ml_gate_b()[l * 8 + 4 + lane];
        p.lf()[(size_t)t * 4 + lane] = fminf(z, 0.f) - log1pf(expf(-fabsf(z)));
      }
    }
  }
}

enum { EPI_WIN = 0, EPI_WOUT = 1, EPI_PQ = 2, EPI_SC = 3 };

template <int EPI>
__device__ __forceinline__ void gemm_store(const Params& p, int l, int t, int n, float v) {
  if (EPI == EPI_WOUT) {
    const float* xi = xrow_in(p, l, t);
    p.x()[(size_t)t * 1024 + n] = xi[n] + v;
  } else if (EPI == EPI_PQ) {
    p.qp()[(size_t)t * 2048 + n] = f2bf(v);
  } else if (EPI == EPI_SC) {
    p.sc()[(size_t)t * 2048 + n] = v;
  }
}

template <int EPI>
__device__ __forceinline__ void ph_gemm(const Params& p, int l, char* smem, int bid, int nblk) {
  constexpr int NT = (EPI == EPI_WIN) ? 22 : (EPI == EPI_WOUT ? 8 : 16);
  constexpr int MT = NTOK / 128;
  constexpr int K = (EPI == EPI_SC) ? 128 : 1024;
  constexpr int NK = K / 64;
  const bf16_t* A; int lda; const bf16_t* Bt; int ldb;
  if (EPI == EPI_WIN) { A = p.xn(); lda = 1024; Bt = p.wt_in() + (size_t)l * NIN * 1024; ldb = 1024; }
  else if (EPI == EPI_WOUT) { A = p.xn(); lda = 1024; Bt = p.wt_out() + (size_t)l * 1024 * 1024; ldb = 1024; }
  else if (EPI == EPI_PQ) { A = p.xn(); lda = 1024; Bt = p.wt_pq() + (size_t)l * 2048 * 1024; ldb = 1024; }
  else { A = p.qp(); lda = 2048; Bt = p.keysb() + (size_t)l * 16 * 128 * 128; ldb = 128; }

  const int tid = tid_opaque(), lane = tid & 63, w = tid >> 6;
  const int wm = w >> 1, wn = w & 1, lr = lane & 31, lh = lane >> 5;
  char* sA = smem;
  char* sB = smem + 32768;
  const int ld_c = tid & 7, ld_r = tid >> 3;

  for (int tile = bid; tile < MT * NT; tile += nblk) {
    const int mt = tile / NT, nt = tile % NT;
    const bf16_t* Ag = A + (size_t)(mt * 128) * lda + ((EPI == EPI_SC) ? nt * 128 : 0);
    const bf16_t* Bg = Bt + (size_t)(nt * 128) * ldb;
    uint4 ra[4], rb[4];
    f32x16 acc[2][2];
#pragma unroll
    for (int i = 0; i < 2; ++i)
#pragma unroll
      for (int j = 0; j < 2; ++j)
#pragma unroll
        for (int r = 0; r < 16; ++r) acc[i][j][r] = 0.f;

#pragma unroll
    for (int j = 0; j < 4; ++j) {
      ra[j] = *reinterpret_cast<const uint4*>(Ag + (size_t)(ld_r + 32 * j) * lda + ld_c * 8);
      rb[j] = *reinterpret_cast<const uint4*>(Bg + (size_t)(ld_r + 32 * j) * ldb + ld_c * 8);
    }
#pragma unroll
    for (int j = 0; j < 4; ++j) {
      int row = ld_r + 32 * j; int pc = ld_c ^ ((row >> 1) & 7);
      *reinterpret_cast<uint4*>(sA + row * 128 + pc * 16) = ra[j];
      *reinterpret_cast<uint4*>(sB + row * 128 + pc * 16) = rb[j];
    }
    __syncthreads();
    for (int kt = 0; kt < NK; ++kt) {
      const int buf = kt & 1;
      if (kt + 1 < NK) {
#pragma unroll
        for (int j = 0; j < 4; ++j) {
          ra[j] = *reinterpret_cast<const uint4*>(Ag + (size_t)(ld_r + 32 * j) * lda + (kt + 1) * 64 + ld_c * 8);
          rb[j] = *reinterpret_cast<const uint4*>(Bg + (size_t)(ld_r + 32 * j) * ldb + (kt + 1) * 64 + ld_c * 8);
        }
      }
      const char* cA = sA + buf * 16384;
      const char* cB = sB + buf * 16384;
#pragma unroll
      for (int ks = 0; ks < 4; ++ks) {
        bf16x8 af[2], bfr[2];
#pragma unroll
        for (int i = 0; i < 2; ++i) {
          int row = wm * 64 + i * 32 + lr; int pc = (ks * 2 + lh) ^ ((row >> 1) & 7);
          af[i] = as_bf16x8(*reinterpret_cast<const uint4*>(cA + row * 128 + pc * 16));
        }
#pragma unroll
        for (int j = 0; j < 2; ++j) {
          int row = wn * 64 + j * 32 + lr; int pc = (ks * 2 + lh) ^ ((row >> 1) & 7);
          bfr[j] = as_bf16x8(*reinterpret_cast<const uint4*>(cB + row * 128 + pc * 16));
        }
#pragma unroll
        for (int i = 0; i < 2; ++i)
#pragma unroll
          for (int j = 0; j < 2; ++j)
            acc[i][j] = __builtin_amdgcn_mfma_f32_32x32x16_bf16(af[i], bfr[j], acc[i][j], 0, 0, 0);
      }
      if (kt + 1 < NK) {
        char* nA = sA + (buf ^ 1) * 16384;
        char* nB = sB + (buf ^ 1) * 16384;
#pragma unroll
        for (int j = 0; j < 4; ++j) {
          int row = ld_r + 32 * j; int pc = ld_c ^ ((row >> 1) & 7);
          *reinterpret_cast<uint4*>(nA + row * 128 + pc * 16) = ra[j];
          *reinterpret_cast<uint4*>(nB + row * 128 + pc * 16) = rb[j];
        }
      }
      __syncthreads();
    }
    if (EPI != EPI_WIN) {
#pragma unroll
      for (int i = 0; i < 2; ++i)
#pragma unroll
        for (int j = 0; j < 2; ++j)
#pragma unroll
          for (int r = 0; r < 16; ++r) {
            int t = mt * 128 + wm * 64 + i * 32 + (r & 3) + 8 * (r >> 2) + 4 * lh;
            int n = nt * 128 + wn * 64 + j * 32 + lr;
            gemm_store<EPI>(p, l, t, n, acc[i][j][r]);
          }
    } else {
      const int seg = nt >> 2;
#pragma unroll
      for (int i = 0; i < 2; ++i)
#pragma unroll
        for (int j = 0; j < 2; ++j) {
          const int n = nt * 128 + wn * 64 + j * 32 + lr;
          if (nt < 4) {
#pragma unroll
            for (int r = 0; r < 16; ++r) {
              int t = mt * 128 + wm * 64 + i * 32 + (r & 3) + 8 * (r >> 2) + 4 * lh;
              p.Qb()[(size_t)t * 512 + n] = f2bf(acc[i][j][r] * (0.125f * LOG2E));
            }
          } else if (nt < 8) {
            const int n2 = n - 512;
#pragma unroll
            for (int r = 0; r < 16; ++r) {
              int t = mt * 128 + wm * 64 + i * 32 + (r & 3) + 8 * (r >> 2) + 4 * lh;
              float v = acc[i][j][r];
              if (t < NPROMPT) {
                p.out[O_K_P + (size_t)l * (4 * 4096 * 512) + (size_t)t * 512 + n2] = v;
                p.Kb()[(size_t)t * 512 + n2] = f2bf(v);
              } else {
                int ts = t - NPROMPT, b = ts >> 6, ii = ts & 63;
                p.out[O_K_S + (size_t)l * (8 * 64 * 512) + (size_t)ts * 512 + n2] = v;
                p.Kbs()[((size_t)(l * 8 + b) * SKEYS + 1024 + ii) * 512 + n2] = f2bf(v);
              }
            }
          } else if (nt < 12) {
            const int n2 = n - 1024, h = n2 >> 7, dv = n2 & 127;
#pragma unroll
            for (int rg = 0; rg < 4; ++rg) {
              int tb = mt * 128 + wm * 64 + i * 32 + 8 * rg + 4 * lh;
              float v0 = acc[i][j][rg * 4 + 0], v1 = acc[i][j][rg * 4 + 1], v2 = acc[i][j][rg * 4 + 2], v3 = acc[i][j][rg * 4 + 3];
              uint2 pk = make_uint2(pack2(v0, v1), pack2(v2, v3));
              int posblk = 2 * lh + (rg & 1);
              if (tb < NPROMPT) {
                float* o = p.out + O_V_P + (size_t)l * (4 * 4096 * 512) + (size_t)tb * 512 + n2;
                o[0] = v0; o[512] = v1; o[1024] = v2; o[1536] = v3;
                int b = tb >> 12, s = tb & 4095;
                int pos = (s & ~15) + posblk * 4;
                *reinterpret_cast<uint2*>(p.Vt() + ((size_t)(b * 4 + h) * 128 + dv) * SEQ + pos) = pk;
              } else {
                int ts = tb - NPROMPT, b = ts >> 6, ii = ts & 63;
                float* o = p.out + O_V_S + (size_t)l * (8 * 64 * 512) + (size_t)ts * 512 + n2;
                o[0] = v0; o[512] = v1; o[1024] = v2; o[1536] = v3;
                int pos = 1024 + (ii & ~15) + posblk * 4;
                *reinterpret_cast<uint2*>(p.Vts() + ((size_t)((l * 8 + b) * 4 + h) * 128 + dv) * SKEYS + pos) = pk;
              }
            }
          } else {
            const int n2 = n - 1536;
            const bool act = (n >= 2304);
#pragma unroll
            for (int r = 0; r < 16; ++r) {
              int t = mt * 128 + wm * 64 + i * 32 + (r & 3) + 8 * (r >> 2) + 4 * lh;
              float v = acc[i][j][r];
              if (act) v = gelu_exact(v);
              p.P5()[(size_t)t * 1280 + n2] = v;
            }
          }
        }
      (void)seg;
    }
  }
}

__device__ __forceinline__ void ph_attn(const Params& p, int l, char* smem, int bid, int nblk) {
  const int tid = tid_opaque(), lane = tid & 63, w = tid >> 6;
  const int c = w >> 1, qhalf = w & 1, lr = lane & 31, lh = lane >> 5;
  char* sK = smem;
  char* sV = smem + 16384;
  float* sLut = reinterpret_cast<float*>(smem + 32768);
  char* sQ = smem + 33792 + w * 4096;
  float* sO2 = reinterpret_cast<float*>(smem);
  const float lam = p.lam()[l];
  const float lam_init = 0.8f - 0.6f * expf(-0.3f * (float)l);

  for (int uu = bid; uu < 1056; uu += nblk) {
    int b, h, qc, S, qrow0; const bf16_t *Kbase, *Vbase;
    bool samp = false; int u2 = uu;
    if (uu >= 752 && uu < 784) samp = true; else if (uu >= 784) u2 = uu - 32;
    if (!samp) {
      qc = 63 - (u2 >> 4); int bh = u2 & 15; b = bh >> 2; h = bh & 3; S = SEQ;
      Kbase = p.Kb() + (size_t)b * SEQ * 512 + h * 128;
      Vbase = p.Vt() + (size_t)(b * 4 + h) * 128 * SEQ;
      qrow0 = b * SEQ + qc * 64;
    } else {
      int us = uu - 752; b = us >> 2; h = us & 3; qc = 16; S = SKEYS;
      Kbase = p.Kbs() + (size_t)(l * 8 + b) * SKEYS * 512 + h * 128;
      Vbase = p.Vts() + (size_t)((l * 8 + b) * 4 + h) * 128 * SKEYS;
      qrow0 = NPROMPT + b * 64;
    }
    const int ntiles = qc + 1;
    __syncthreads();
    sLut[tid] = p.lut()[h * 256 + tid];
    {
      const int qc8 = lane & 7, qr = lane >> 3;
#pragma unroll
      for (int j = 0; j < 4; ++j) {
        int row = qr + 8 * j;
        uint4 v = *reinterpret_cast<const uint4*>(p.Qb() + (size_t)(qrow0 + qhalf * 32 + row) * 512 + h * 128 + c * 64 + qc8 * 8);
        *reinterpret_cast<uint4*>(sQ + row * 128 + ((qc8 ^ ((row >> 1) & 7)) * 16)) = v;
      }
    }
    f32x16 o[4];
#pragma unroll
    for (int d = 0; d < 4; ++d)
#pragma unroll
      for (int r = 0; r < 16; ++r) o[d][r] = 0.f;
    float m_run = -1e30f, l_run = 0.f;
    const float c15 = p.lut()[h * 256];

    uint4 rk0, rk1, rk2, rk3, rv0, rv1, rv2, rv3;
    const int kc = tid & 15, kr = tid >> 4;
    const int vc = tid & 7, vr = tid >> 3;
    const char* Kt = reinterpret_cast<const char*>(Kbase);
    const char* Vb = reinterpret_cast<const char*>(Vbase);
    const unsigned koff = (unsigned)kr * 1024u + (unsigned)kc * 16u;
    const unsigned voff = (unsigned)vr * (unsigned)(S * 2) + (unsigned)vc * 16u;
    const size_t vjs = (size_t)S * 64;
#define ATTN_GL1(KT, J, RK, RV)                                                                              \
  RK = *reinterpret_cast<const uint4*>(Kt + ((size_t)((KT) * 64 + 16 * (J)) * 1024) + koff);                 \
  RV = *reinterpret_cast<const uint4*>(Vb + ((size_t)(J) * vjs + (size_t)(KT) * 128) + voff);
#define ATTN_GLOAD(KT) ATTN_GL1(KT, 0, rk0, rv0) ATTN_GL1(KT, 1, rk1, rv1) ATTN_GL1(KT, 2, rk2, rv2) ATTN_GL1(KT, 3, rk3, rv3)
#define ATTN_SW1(J, RK, RV)                                                                                  \
  {                                                                                                          \
    int row = kr + 16 * (J); int pc = (kc & 7) ^ ((row >> 1) & 7);                                           \
    *reinterpret_cast<uint4*>(sK + (kc >> 3) * 8192 + row * 128 + pc * 16) = RK;                             \
    int row2 = vr + 32 * (J); int pc2 = vc ^ ((row2 >> 1) & 7);                                              \
    *reinterpret_cast<uint4*>(sV + row2 * 128 + pc2 * 16) = RV;                                              \
  }
    ATTN_GLOAD(0)
    for (int kt = 0; kt < ntiles; ++kt) {
      __syncthreads();
      ATTN_SW1(0, rk0, rv0) ATTN_SW1(1, rk1, rv1) ATTN_SW1(2, rk2, rv2) ATTN_SW1(3, rk3, rv3)
      __syncthreads();
      if (kt + 1 < ntiles) { ATTN_GLOAD(kt + 1) }
      f32x16 s[2];
#pragma unroll
      for (int kb = 0; kb < 2; ++kb) {
#pragma unroll
        for (int r = 0; r < 16; ++r) s[kb][r] = 0.f;
#pragma unroll
        for (int ks = 0; ks < 4; ++ks) {
          int row = kb * 32 + lr; int pc = (ks * 2 + lh) ^ ((row >> 1) & 7);
          bf16x8 kf = as_bf16x8(*reinterpret_cast<const uint4*>(sK + c * 8192 + row * 128 + pc * 16));
          bf16x8 qf = as_bf16x8(*reinterpret_cast<const uint4*>(sQ + lr * 128 + (((ks * 2 + lh) ^ ((lr >> 1) & 7)) * 16)));
          s[kb] = __builtin_amdgcn_mfma_f32_32x32x16_bf16(kf, qf, s[kb], 0, 0, 0);
        }
      }
      if (kt >= qc - 2) {
        const int base = (kt - qc) * 64 - (qhalf * 32 + lr) + 191 + 4 * lh;
#pragma unroll
        for (int kb = 0; kb < 2; ++kb)
#pragma unroll
          for (int r = 0; r < 16; ++r) s[kb][r] += sLut[base + kb * 32 + (r & 3) + 8 * (r >> 2)];
      } else {
#pragma unroll
        for (int kb = 0; kb < 2; ++kb)
#pragma unroll
          for (int r = 0; r < 16; ++r) s[kb][r] += c15;
      }
      float mx = s[0][0];
#pragma unroll
      for (int kb = 0; kb < 2; ++kb)
#pragma unroll
        for (int r = 0; r < 16; ++r) mx = fmaxf(mx, s[kb][r]);
      mx = swap32_max(mx);
      const float m_new = fmaxf(m_run, mx);
      const float alpha = __builtin_amdgcn_exp2f(m_run - m_new);
      m_run = m_new;
      float ps = 0.f;
#pragma unroll
      for (int kb = 0; kb < 2; ++kb)
#pragma unroll
        for (int r = 0; r < 16; ++r) { float pv = __builtin_amdgcn_exp2f(s[kb][r] - m_new); s[kb][r] = pv; ps += pv; }
      l_run = l_run * alpha + ps;
#pragma unroll
      for (int d = 0; d < 4; ++d)
#pragma unroll
        for (int r = 0; r < 16; ++r) o[d][r] *= alpha;
#pragma unroll
      for (int ks2 = 0; ks2 < 4; ++ks2) {
        const int kb = ks2 >> 1, sh = (ks2 & 1) * 8;
        uint4 pw = make_uint4(pack2(s[kb][sh + 0], s[kb][sh + 1]), pack2(s[kb][sh + 2], s[kb][sh + 3]),
                              pack2(s[kb][sh + 4], s[kb][sh + 5]), pack2(s[kb][sh + 6], s[kb][sh + 7]));
        bf16x8 pf = as_bf16x8(pw);
#pragma unroll
        for (int d = 0; d < 4; ++d) {
          int row = d * 32 + lr; int pc = (ks2 * 2 + lh) ^ ((row >> 1) & 7);
          bf16x8 vf = as_bf16x8(*reinterpret_cast<const uint4*>(sV + row * 128 + pc * 16));
          o[d] = __builtin_amdgcn_mfma_f32_32x32x16_bf16(vf, pf, o[d], 0, 0, 0);
        }
        __builtin_amdgcn_sched_barrier(0);
      }
    }
    float lt = swap32_sum(l_run);
    float inv = 1.f / lt;
    __syncthreads();
    if (c == 1) {
#pragma unroll
      for (int d = 0; d < 4; ++d)
#pragma unroll
        for (int r = 0; r < 16; ++r) sO2[(qhalf * 64 + d * 16 + r) * 64 + lane] = o[d][r] * inv;
    }
    __syncthreads();
    if (c == 0) {
      float ss = 0.f;
#pragma unroll
      for (int d = 0; d < 4; ++d)
#pragma unroll
        for (int r = 0; r < 16; ++r) {
          float v = o[d][r] * inv - lam * sO2[(qhalf * 64 + d * 16 + r) * 64 + lane];
          o[d][r] = v; ss += v * v;
        }
      ss = swap32_sum(ss);
      const float rn = rsqrtf(ss * (1.f / 128.f) + EPS) * (1.f - lam_init);
      const float* gs = p.da_subln_g() + l * 128;
      bf16_t* orow = p.xn() + (size_t)(qrow0 + qhalf * 32 + lr) * 1024 + h * 128;
#pragma unroll
      for (int d = 0; d < 4; ++d)
#pragma unroll
        for (int rg = 0; rg < 4; ++rg) {
          int dv = d * 32 + 8 * rg + 4 * lh;
          float4 g4 = *reinterpret_cast<const float4*>(gs + dv);
          uint2 pk = make_uint2(pack2(o[d][rg * 4 + 0] * rn * g4.x, o[d][rg * 4 + 1] * rn * g4.y),
                                pack2(o[d][rg * 4 + 2] * rn * g4.z, o[d][rg * 4 + 3] * rn * g4.w));
          *reinterpret_cast<uint2*>(orow + dv) = pk;
        }
    }
  }
}

__device__ __forceinline__ void ph_mlconv(const Params& p, int l, char* smem, int bid, int nblk) {
  const int tid = tid_opaque();
  float* s_mc = reinterpret_cast<float*>(smem);
  float* s_cc = s_mc + 67 * 64;
  float* s_wq = s_cc + 64 * 65;
  float* s_wk = s_wq + 4096;
  for (int u = bid; u < 264 * 4; u += nblk) {
    const int ci = u >> 2, h = u & 3;
    int token0, bq; bool samp = ci >= 256;
    if (!samp) token0 = ci * 64; else token0 = NPROMPT + (ci - 256) * 64;
    bq = samp ? (ci - 256) : (ci >> 6);
    const int cidx = samp ? 0 : (ci & 63);
    __syncthreads();
    for (int i = tid; i < 67 * 64; i += 256) {
      int r = i >> 6, d = i & 63;
      float v;
      if (r >= 3) v = p.P5()[(size_t)(token0 + r - 3) * 1280 + h * 64 + d];
      else if (samp) v = p.st_conv()[((size_t)(l * 8 + bq) * 3 + r) * 256 + h * 64 + d];
      else if (cidx == 0) v = 0.f;
      else v = p.P5()[(size_t)(token0 + r - 3) * 1280 + h * 64 + d];
      s_mc[i] = v;
    }
    for (int i = tid; i < 4096; i += 256) {
      s_wq[i] = p.ml_wq()[(size_t)(l * 4 + h) * 4096 + i];
      s_wk[i] = p.ml_wk()[(size_t)(l * 4 + h) * 4096 + i];
    }
    __syncthreads();
    {
      const int d = tid & 63, t0 = tid >> 6;
      const int ch = h * 64 + d;
      const float w0 = p.ml_conv_w()[(l * 4 + 0) * 256 + ch], w1 = p.ml_conv_w()[(l * 4 + 1) * 256 + ch];
      const float w2 = p.ml_conv_w()[(l * 4 + 2) * 256 + ch], w3 = p.ml_conv_w()[(l * 4 + 3) * 256 + ch];
      const float bb = p.ml_conv_b()[l * 256 + ch];
      for (int t = t0; t < 64; t += 4) {
        float y = bb + w0 * s_mc[t * 64 + d] + w1 * s_mc[(t + 1) * 64 + d] + w2 * s_mc[(t + 2) * 64 + d] + w3 * s_mc[(t + 3) * 64 + d];
        y = y * sigmoidf_(y);
        s_cc[t * 65 + d] = y;
        p.cc()[(size_t)(token0 + t) * 256 + ch] = y;
      }
      if (samp || cidx == 63) {
        if (tid < 192) {
          int r = tid >> 6;
          float v = s_mc[(64 + r) * 64 + d];
          if (samp) p.out[O_CONV_S + ((size_t)(l * 8 + bq) * 3 + r) * 256 + ch] = v;
          else p.out[O_CONV_P + ((size_t)(l * 4 + bq) * 3 + r) * 256 + ch] = v;
        }
      }
    }
    __syncthreads();
    {
      const int ty = tid >> 4, tx = tid & 15;
      float aq[4][4], ak[4][4];
#pragma unroll
      for (int i = 0; i < 4; ++i)
#pragma unroll
        for (int j = 0; j < 4; ++j) { aq[i][j] = 0.f; ak[i][j] = 0.f; }
      for (int d = 0; d < 64; ++d) {
        float4 wq4 = *reinterpret_cast<const float4*>(s_wq + d * 64 + tx * 4);
        float4 wk4 = *reinterpret_cast<const float4*>(s_wk + d * 64 + tx * 4);
#pragma unroll
        for (int i = 0; i < 4; ++i) {
          float a = s_cc[(ty * 4 + i) * 65 + d];
          aq[i][0] += a * wq4.x; aq[i][1] += a * wq4.y; aq[i][2] += a * wq4.z; aq[i][3] += a * wq4.w;
          ak[i][0] += a * wk4.x; ak[i][1] += a * wk4.y; ak[i][2] += a * wk4.z; ak[i][3] += a * wk4.w;
        }
      }
#pragma unroll
      for (int i = 0; i < 4; ++i) {
        size_t o = (size_t)(token0 + ty * 4 + i) * 256 + h * 64 + tx * 4;
        *reinterpret_cast<float4*>(p.qm() + o) = make_float4(aq[i][0], aq[i][1], aq[i][2], aq[i][3]);
        *reinterpret_cast<float4*>(p.km() + o) = make_float4(ak[i][0] * 0.125f, ak[i][1] * 0.125f, ak[i][2] * 0.125f, ak[i][3] * 0.125f);
      }
    }
  }
}

__device__ __forceinline__ void ph_mchain(const Params& p, int l, int bid, int nblk) {
  const int lane = tid_opaque() & 63, w = tid_opaque() >> 6;
  for (int u = bid * 4 + w; u < 48; u += nblk * 4) {
    const bool samp = u >= 16;
    int b, h, nch, token0, cu0; float m;
    if (!samp) { b = u >> 2; h = u & 3; nch = 64; token0 = b * SEQ; cu0 = (b * 4 + h) * 64; m = 0.f; }
    else { int us = u - 16; b = us >> 2; h = us & 3; nch = 1; token0 = NPROMPT + b * 64; cu0 = 1024 + us; m = p.st_m()[(l * 8 + b) * 4 + h]; }
    for (int c = 0; c < nch; ++c) {
      const int t = token0 + c * 64 + lane;
      float lfv = p.lf()[(size_t)t * 4 + h], igv = p.ig()[(size_t)t * 4 + h];
      float F = lfv;
#pragma unroll
      for (int d = 1; d < 64; d <<= 1) { float n = __shfl_up(F, d); if (lane >= d) F += n; }
      const float FL = __shfl(F, 63);
      const float tail = FL - F + igv;
      const float mx = wave_max(tail);
      const float mn = fmaxf(FL + m, mx);
      p.Fc()[(size_t)t * 4 + h] = F;
      if (lane == 0) {
        p.mst()[cu0 + c] = m; p.mnx()[cu0 + c] = mn; p.wcs()[cu0 + c] = expf(FL + m - mn); p.FLs()[cu0 + c] = FL;
      }
      m = mn;
    }
    if (lane == 0) {
      if (!samp) p.out[O_M_P + (l * 4 + b) * 4 + h] = m;
      else p.out[O_M_S + (l * 8 + b) * 4 + h] = m;
    }
  }
}

__device__ __forceinline__ void cu_decode(int cu, int& token0, int& h) {
  if (cu < 1024) { int bh = cu >> 6, c = cu & 63; token0 = (bh >> 2) * SEQ + c * 64; h = bh & 3; }
  else { int us = cu - 1024; token0 = NPROMPT + (us >> 2) * 64; h = us & 3; }
}

__device__ __forceinline__ void ph_mlU(const Params& p, int l, char* smem, int bid, int nblk) {
  const int tid = tid_opaque();
  float* s_k = reinterpret_cast<float*>(smem);
  float* s_v = s_k + 4096;
  for (int cu = bid; cu < NCU_UNITS; cu += nblk) {
    int token0, h; cu_decode(cu, token0, h);
    const float FL = p.FLs()[cu], mn = p.mnx()[cu];
    __syncthreads();
    for (int i = tid; i < 1024; i += 256) {
      int s = i >> 4, d4 = (i & 15) * 4;
      const int t = token0 + s;
      float wsv = expf(FL - p.Fc()[(size_t)t * 4 + h] + p.ig()[(size_t)t * 4 + h] - mn);
      float4 k4 = *reinterpret_cast<const float4*>(p.km() + (size_t)t * 256 + h * 64 + d4);
      float4 v4 = *reinterpret_cast<const float4*>(p.P5() + (size_t)t * 1280 + 256 + h * 64 + d4);
      *reinterpret_cast<float4*>(s_k + s * 64 + d4) = make_float4(k4.x * wsv, k4.y * wsv, k4.z * wsv, k4.w * wsv);
      *reinterpret_cast<float4*>(s_v + s * 64 + d4) = v4;
    }
    __syncthreads();
    const int ty = tid >> 4, tx = tid & 15;
    float a[4][4];
#pragma unroll
    for (int i = 0; i < 4; ++i)
#pragma unroll
      for (int j = 0; j < 4; ++j) a[i][j] = 0.f;
    for (int s = 0; s < 64; ++s) {
      float4 k4 = *reinterpret_cast<const float4*>(s_k + s * 64 + ty * 4);
      float4 v4 = *reinterpret_cast<const float4*>(s_v + s * 64 + tx * 4);
      float kk[4] = {k4.x, k4.y, k4.z, k4.w};
#pragma unroll
      for (int i = 0; i < 4; ++i) { a[i][0] += kk[i] * v4.x; a[i][1] += kk[i] * v4.y; a[i][2] += kk[i] * v4.z; a[i][3] += kk[i] * v4.w; }
    }
#pragma unroll
    for (int i = 0; i < 4; ++i)
      *reinterpret_cast<float4*>(p.U() + (size_t)cu * 4096 + (ty * 4 + i) * 64 + tx * 4) = make_float4(a[i][0], a[i][1], a[i][2], a[i][3]);
    if (tid < 64) {
      float s0 = 0.f;
      for (int s = 0; s < 64; ++s) s0 += s_k[s * 64 + tid];
      p.un()[(size_t)cu * 64 + tid] = s0;
    }
  }
}

__device__ __forceinline__ void ph_mlscan(const Params& p, int l, int bid, int nblk) {
  const size_t gtid = (size_t)bid * 256 + tid_opaque(), gsz = (size_t)nblk * 256;
  const size_t NPC = 16 * 4096, NSC = 32 * 4096, NPN = 16 * 64, NSN = 32 * 64;
  for (size_t i = gtid; i < NPC + NSC + NPN + NSN; i += gsz) {
    if (i < NPC) {
      int bh = (int)(i >> 12), e = (int)(i & 4095);
      float C = 0.f;
      for (int c = 0; c < 64; ++c) {
        int cu = bh * 64 + c;
        p.Cst()[(size_t)cu * 4096 + e] = C;
        C = p.wcs()[cu] * C + p.U()[(size_t)cu * 4096 + e];
      }
      p.out[O_C_P + (size_t)l * (16 * 4096) + i] = C;
    } else if (i < NPC + NSC) {
      size_t j = i - NPC; int us = (int)(j >> 12), e = (int)(j & 4095); int cu = 1024 + us;
      float C = p.st_c()[(size_t)l * (32 * 4096) + j];
      p.Cst()[(size_t)cu * 4096 + e] = C;
      p.out[O_C_S + (size_t)l * (32 * 4096) + j] = p.wcs()[cu] * C + p.U()[(size_t)cu * 4096 + e];
    } else if (i < NPC + NSC + NPN) {
      size_t j = i - NPC - NSC; int bh = (int)(j >> 6), d = (int)(j & 63);
      float n = 0.f;
      for (int c = 0; c < 64; ++c) {
        int cu = bh * 64 + c;
        p.nst()[(size_t)cu * 64 + d] = n;
        n = p.wcs()[cu] * n + p.un()[(size_t)cu * 64 + d];
      }
      p.out[O_N_P + (size_t)l * (16 * 64) + j] = n;
    } else {
      size_t j = i - NPC - NSC - NPN; int us = (int)(j >> 6), d = (int)(j & 63); int cu = 1024 + us;
      float n = p.st_n()[(size_t)l * (32 * 64) + j];
      p.nst()[(size_t)cu * 64 + d] = n;
      p.out[O_N_S + (size_t)l * (32 * 64) + j] = p.wcs()[cu] * n + p.un()[(size_t)cu * 64 + d];
    }
  }
}

__device__ __forceinline__ void ph_mlout(const Params& p, int l, char* smem, int bid, int nblk) {
  const int tid = tid_opaque();
  float* s_q = reinterpret_cast<float*>(smem);
  float* s_k = s_q + 64 * 65;
  float* s_v = s_k + 64 * 65;
  float* s_C = s_v + 4096;
  float* s_F = s_C + 4096;
  float* s_a = s_F + 64;
  float* s_mt = s_a + 64;
  float* s_iw = s_mt + 64;
  float* s_n = s_iw + 64;
  float* s_den = s_n + 64;
  for (int cu = bid; cu < NCU_UNITS; cu += nblk) {
    int token0, h; cu_decode(cu, token0, h);
    const float m0 = p.mst()[cu];
    __syncthreads();
    for (int i = tid; i < 1024; i += 256) {
      int s = i >> 4, d4 = (i & 15) * 4;
      const int t = token0 + s;
      float4 q4 = *reinterpret_cast<const float4*>(p.qm() + (size_t)t * 256 + h * 64 + d4);
      float4 k4 = *reinterpret_cast<const float4*>(p.km() + (size_t)t * 256 + h * 64 + d4);
      float4 v4 = *reinterpret_cast<const float4*>(p.P5() + (size_t)t * 1280 + 256 + h * 64 + d4);
      float4 c4 = *reinterpret_cast<const float4*>(p.Cst() + (size_t)cu * 4096 + s * 64 + d4);
      s_q[s * 65 + d4] = q4.x; s_q[s * 65 + d4 + 1] = q4.y; s_q[s * 65 + d4 + 2] = q4.z; s_q[s * 65 + d4 + 3] = q4.w;
      s_k[s * 65 + d4] = k4.x; s_k[s * 65 + d4 + 1] = k4.y; s_k[s * 65 + d4 + 2] = k4.z; s_k[s * 65 + d4 + 3] = k4.w;
      *reinterpret_cast<float4*>(s_v + s * 64 + d4) = v4;
      *reinterpret_cast<float4*>(s_C + s * 64 + d4) = c4;
    }
    if (tid < 64) {
      const int t = token0 + tid;
      float F = p.Fc()[(size_t)t * 4 + h], g = p.ig()[(size_t)t * 4 + h];
      s_F[tid] = F; s_a[tid] = g - F;
      s_n[tid] = p.nst()[(size_t)cu * 64 + tid];
    }
    __syncthreads();
    if (tid < 64) {
      float pm = -1e30f;
      for (int s = 0; s <= tid; ++s) pm = fmaxf(pm, s_a[s]);
      float F = s_F[tid];
      float mt = F + fmaxf(m0, pm);
      s_mt[tid] = mt;
      s_iw[tid] = expf(F + m0 - mt);
    }
    __syncthreads();
    const int ty = tid >> 4, tx = tid & 15;
    float acc[4][4];
#pragma unroll
    for (int i = 0; i < 4; ++i)
#pragma unroll
      for (int j = 0; j < 4; ++j) acc[i][j] = 0.f;
    for (int d = 0; d < 64; ++d) {
      float qv[4], kv[4];
#pragma unroll
      for (int i = 0; i < 4; ++i) { qv[i] = s_q[(ty * 4 + i) * 65 + d]; kv[i] = s_k[(tx * 4 + i) * 65 + d]; }
#pragma unroll
      for (int i = 0; i < 4; ++i)
#pragma unroll
        for (int j = 0; j < 4; ++j) acc[i][j] += qv[i] * kv[j];
    }
    __syncthreads();
#pragma unroll
    for (int i = 0; i < 4; ++i) {
      const int t = ty * 4 + i;
      const float Ft = s_F[t], mt = s_mt[t];
#pragma unroll
      for (int j = 0; j < 4; ++j) {
        const int s = tx * 4 + j;
        float v = (s <= t) ? acc[i][j] * expf(Ft + s_a[s] - mt) : 0.f;
        s_k[t * 65 + s] = v;
      }
    }
    __syncthreads();
    if (tid < 64) {
      float den = 0.f, qn = 0.f;
      for (int s = 0; s < 64; ++s) { den += s_k[tid * 65 + s]; qn += s_q[tid * 65 + s] * s_n[s]; }
      s_den[tid] = den + s_iw[tid] * qn;
    }
    float num[4][4], qc[4][4];
#pragma unroll
    for (int i = 0; i < 4; ++i)
#pragma unroll
      for (int j = 0; j < 4; ++j) { num[i][j] = 0.f; qc[i][j] = 0.f; }
    for (int s = 0; s < 64; ++s) {
      float4 v4 = *reinterpret_cast<const float4*>(s_v + s * 64 + tx * 4);
      float4 c4 = *reinterpret_cast<const float4*>(s_C + s * 64 + tx * 4);
#pragma unroll
      for (int i = 0; i < 4; ++i) {
        float sw = s_k[(ty * 4 + i) * 65 + s], qq = s_q[(ty * 4 + i) * 65 + s];
        num[i][0] += sw * v4.x; num[i][1] += sw * v4.y; num[i][2] += sw * v4.z; num[i][3] += sw * v4.w;
        qc[i][0] += qq * c4.x; qc[i][1] += qq * c4.y; qc[i][2] += qq * c4.z; qc[i][3] += qq * c4.w;
      }
    }
    __syncthreads();
#pragma unroll
    for (int i = 0; i < 4; ++i) {
      const int t = ty * 4 + i;
      const float iw = s_iw[t];
      const float dn = fmaxf(fabsf(s_den[t]), expf(-s_mt[t]));
      float hv[4]; float ss = 0.f;
#pragma unroll
      for (int j = 0; j < 4; ++j) { hv[j] = (num[i][j] + iw * qc[i][j]) / dn; ss += hv[j] * hv[j]; }
      ss = row16_sum(ss);
      const float rn = rsqrtf(ss * (1.f / 64.f) + EPS);
      const int ch = h * 64 + tx * 4;
      const size_t tg = (size_t)(token0 + t);
      float4 g4 = *reinterpret_cast<const float4*>(p.ml_norm_g() + l * 256 + ch);
      float4 k4 = *reinterpret_cast<const float4*>(p.ml_skip() + l * 256 + ch);
      float4 c4 = *reinterpret_cast<const float4*>(p.cc() + tg * 256 + ch);
      float4 o4 = *reinterpret_cast<const float4*>(p.P5() + tg * 1280 + 512 + ch);
      float r0 = (hv[0] * rn * g4.x + k4.x * c4.x) * sigmoidf_(o4.x);
      float r1 = (hv[1] * rn * g4.y + k4.y * c4.y) * sigmoidf_(o4.y);
      float r2 = (hv[2] * rn * g4.z + k4.z * c4.z) * sigmoidf_(o4.z);
      float r3 = (hv[3] * rn * g4.w + k4.w * c4.w) * sigmoidf_(o4.w);
      *reinterpret_cast<uint2*>(p.xn() + tg * 1024 + 512 + ch) = make_uint2(pack2(r0, r1), pack2(r2, r3));
    }
  }
}

__device__ __forceinline__ void ph_cmlp(const Params& p, int l, char* smem, int bid, int nblk) {
  const int tid = tid_opaque(), lane = tid & 63, w = tid >> 6;
  float* s_vg = reinterpret_cast<float*>(smem);
  float* s_ws = s_vg + 128 * 64;
  float* s_r = s_ws + 128 * 33;
  for (int u = bid; u < 544; u += nblk) {
    const int g = u & 3, ci = u >> 2;
    const bool samp = ci >= 128;
    const int L = samp ? 64 : 128;
    const int token0 = samp ? NPROMPT + (ci - 128) * 64 : ci * 128;
    __syncthreads();
    for (int r = w; r < L; r += 4) {
      float4 v = *reinterpret_cast<const float4*>(p.P5() + (size_t)(token0 + r) * 1280 + 1024 + lane * 4);
      float ss = v.x * v.x + v.y * v.y + v.z * v.z + v.w * v.w;
      ss = wave_sum(ss);
      if (lane == 0) s_r[r] = rsqrtf(ss * (1.f / 256.f) + EPS);
    }
    __syncthreads();
    for (int i = tid; i < L * 16; i += 256) {
      int s = i >> 4, d4 = (i & 15) * 4;
      float4 v = *reinterpret_cast<const float4*>(p.P5() + (size_t)(token0 + s) * 1280 + 1024 + g * 64 + d4);
      float4 gn = *reinterpret_cast<const float4*>(p.cm_norm_g() + l * 256 + g * 64 + d4);
      float r = s_r[s];
      float4 o = make_float4(v.x * r * gn.x, v.y * r * gn.y, v.z * r * gn.z, v.w * r * gn.w);
      *reinterpret_cast<float4*>(s_vg + s * 64 + d4) = o;
      if (samp) {
        int ts = token0 - NPROMPT + s;
        *reinterpret_cast<float4*>(p.out + O_CMV_S + (size_t)l * (512 * 256) + (size_t)ts * 256 + g * 64 + d4) = o;
      }
    }
    const int ty = tid >> 4, tx = tid & 15;
    float acc[8][4];
#pragma unroll
    for (int i = 0; i < 8; ++i)
#pragma unroll
      for (int j = 0; j < 4; ++j) acc[i][j] = 0.f;
    const float* wsg = p.cm_ws() + (size_t)(l * 4 + g) * 128 * 128;
    for (int s0 = 0; s0 < L; s0 += 32) {
      __syncthreads();
      for (int i = tid; i < L * 32; i += 256) {
        int t = i >> 5, ss = i & 31;
        s_ws[t * 33 + ss] = (s0 + ss <= t) ? wsg[t * 128 + s0 + ss] : 0.f;
      }
      __syncthreads();
      if (ty * 8 < L) {
        for (int ss = 0; ss < 32; ++ss) {
          float4 v4 = *reinterpret_cast<const float4*>(s_vg + (s0 + ss) * 64 + tx * 4);
#pragma unroll
          for (int i = 0; i < 8; ++i) {
            float wv = s_ws[(ty * 8 + i) * 33 + ss];
            acc[i][0] += wv * v4.x; acc[i][1] += wv * v4.y; acc[i][2] += wv * v4.z; acc[i][3] += wv * v4.w;
          }
        }
      }
    }
    if (ty * 8 < L) {
#pragma unroll
      for (int i = 0; i < 8; ++i) {
        const int t = ty * 8 + i;
        const float bb = p.cm_b()[(l * 4 + g) * 128 + t];
        const size_t tg = (size_t)(token0 + t);
        float4 u4 = *reinterpret_cast<const float4*>(p.P5() + tg * 1280 + 768 + g * 64 + tx * 4);
        *reinterpret_cast<uint2*>(p.xn() + tg * 1024 + 768 + g * 64 + tx * 4) =
            make_uint2(pack2(u4.x * (acc[i][0] + bb), u4.y * (acc[i][1] + bb)), pack2(u4.z * (acc[i][2] + bb), u4.w * (acc[i][3] + bb)));
      }
    }
  }
}

__device__ __forceinline__ int mono_key(float v) { int b = __float_as_int(v); return b ^ ((b >> 31) & 0x7FFFFFFF); }
__device__ __forceinline__ float mono_val(int k) { int b = k ^ ((k >> 31) & 0x7FFFFFFF); return __int_as_float(b); }

#define INS16(L, kv)                                   \
  {                                                    \
    int _v = (kv);                                     \
    _Pragma("unroll") for (int _j = 0; _j < 16; ++_j) { \
      int _t = max(L[_j], _v);                         \
      _v = min(L[_j], _v);                             \
      L[_j] = _t;                                      \
    }                                                  \
  }

__device__ __forceinline__ void ph_topk(const Params& p, int l, char* smem, int bid, int nblk) {
  const int tid = tid_opaque(), lane = tid & 63, w = tid >> 6;
  float* s_tile = reinterpret_cast<float*>(smem) + w * (64 * 33);
  int* s_list = reinterpret_cast<int*>(smem + 4 * 64 * 33 * 4) + w * (2 * 16 * 64);
  float* s_ss = reinterpret_cast<float*>(smem + 4 * 64 * 33 * 4 + 4 * 2 * 16 * 64 * 4) + w * 64;
  for (int u = bid * 4 + w; u < 264 * 8; u += nblk * 4) {
    const int tg = u >> 3, h = u & 7;
    const int t0 = tg * 64;
#pragma unroll 2
    for (int i = 0; i < 32; ++i) {
      const int tt = 2 * i + (lane >> 5);
      uint4 qv = *reinterpret_cast<const uint4*>(p.qp() + (size_t)(t0 + tt) * 2048 + h * 256 + (lane & 31) * 8);
      float a0 = bf_lo(qv.x), a1 = bf_hi(qv.x), a2 = bf_lo(qv.y), a3 = bf_hi(qv.y);
      float a4 = bf_lo(qv.z), a5 = bf_hi(qv.z), a6 = bf_lo(qv.w), a7 = bf_hi(qv.w);
      float ss = a0 * a0 + a1 * a1 + a2 * a2 + a3 * a3 + a4 * a4 + a5 * a5 + a6 * a6 + a7 * a7;
      ss = swap16_sum(row16_sum(ss));
      if ((lane & 31) == 0) s_ss[tt] = ss;
    }
    int L1[16], L2[16];
#pragma unroll
    for (int j = 0; j < 16; ++j) { L1[j] = (int)0x80000000; L2[j] = (int)0x80000000; }
#pragma unroll
    for (int c = 0; c < 2; ++c) {
#pragma unroll 1
      for (int ps = 0; ps < 4; ++ps) {
        const float* src = p.sc() + (size_t)t0 * 2048 + h * 256 + c * 128 + ps * 32;
#pragma unroll
        for (int j = 0; j < 8; ++j) {
          int tt = (lane >> 3) + 8 * j, f4 = lane & 7;
          float4 v = *reinterpret_cast<const float4*>(src + (size_t)tt * 2048 + f4 * 4);
          float* d = s_tile + tt * 33 + f4 * 4;
          d[0] = v.x; d[1] = v.y; d[2] = v.z; d[3] = v.w;
        }
#pragma unroll 4
        for (int s = 0; s < 32; ++s) {
          float v = s_tile[lane * 33 + s];
          int key = (mono_key(v) & ~127) | (127 - (ps * 32 + s));
          if (c == 0) INS16(L1, key) else INS16(L2, key)
        }
      }
    }
#pragma unroll
    for (int j = 0; j < 16; ++j) { s_list[(0 * 16 + j) * 64 + lane] = 127 - (L1[j] & 127); s_list[(1 * 16 + j) * 64 + lane] = 127 - (L2[j] & 127); }
    float v1[16], v2[16];
#pragma unroll
    for (int j = 0; j < 16; ++j) { v1[j] = mono_val(L1[j] & ~127); v2[j] = mono_val(L2[j] & ~127); }
    int LC[16];
#pragma unroll
    for (int j = 0; j < 16; ++j) LC[j] = (int)0x80000000;
#pragma unroll
    for (int i = 0; i < 16; ++i)
#pragma unroll
      for (int j = 0; j < 16; ++j)
        if ((i + 1) * (j + 1) <= 16) {
          int key = (mono_key(v1[i] + v2[j]) & ~255) | (255 - (i * 16 + j));
          INS16(LC, key)
        }
    const float scale = rsqrtf(s_ss[lane] * (1.f / 256.f) + EPS);
    float vs[16]; float den = 0.f;
    const float top = mono_val(LC[0] & ~255);
#pragma unroll
    for (int k = 0; k < 16; ++k) { vs[k] = __expf((mono_val(LC[k] & ~255) - top) * scale); den += vs[k]; }
    const float inv = 1.f / den;
    const size_t ob = (size_t)(t0 + lane) * 128 + h * 16;
#pragma unroll
    for (int k4 = 0; k4 < 4; ++k4) {
      int ee[4]; float gg[4];
#pragma unroll
      for (int q = 0; q < 4; ++q) {
        int k = k4 * 4 + q;
        int ci = 255 - (LC[k] & 255);
        int i1 = s_list[(0 * 16 + (ci >> 4)) * 64 + lane];
        int i2 = s_list[(1 * 16 + (ci & 15)) * 64 + lane];
        ee[q] = i1 * 128 + i2; gg[q] = vs[k] * inv;
      }
      *reinterpret_cast<int4*>(p.eidx() + ob + k4 * 4) = make_int4(ee[0], ee[1], ee[2], ee[3]);
      *reinterpret_cast<float4*>(p.egate() + ob + k4 * 4) = make_float4(gg[0], gg[1], gg[2], gg[3]);
    }
  }
}

__device__ __forceinline__ float dot8(uint4 a, uint4 b, float acc) {
  acc = __builtin_amdgcn_fdot2_f32_bf16(*reinterpret_cast<bf16x2*>(&a.x), *reinterpret_cast<bf16x2*>(&b.x), acc, false);
  acc = __builtin_amdgcn_fdot2_f32_bf16(*reinterpret_cast<bf16x2*>(&a.y), *reinterpret_cast<bf16x2*>(&b.y), acc, false);
  acc = __builtin_amdgcn_fdot2_f32_bf16(*reinterpret_cast<bf16x2*>(&a.z), *reinterpret_cast<bf16x2*>(&b.z), acc, false);
  acc = __builtin_amdgcn_fdot2_f32_bf16(*reinterpret_cast<bf16x2*>(&a.w), *reinterpret_cast<bf16x2*>(&b.w), acc, false);
  return acc;
}
__device__ __forceinline__ void axpy8(float* y, float wgt, uint4 v) {
  y[0] += wgt * bf_lo(v.x); y[1] += wgt * bf_hi(v.x); y[2] += wgt * bf_lo(v.y); y[3] += wgt * bf_hi(v.y);
  y[4] += wgt * bf_lo(v.z); y[5] += wgt * bf_hi(v.z); y[6] += wgt * bf_lo(v.w); y[7] += wgt * bf_hi(v.w);
}

__device__ __forceinline__ void ph_gather(const Params& p, int l, int bid, int nblk) {
  const int lane = tid_opaque() & 63, w = tid_opaque() >> 6;
  const bf16_t* ubl = p.ub() + (size_t)l * 16384 * 1024;
  const bf16_t* vbl = p.vb() + (size_t)l * 16384 * 1024;
  for (int t = bid * 4 + w; t < NTOK; t += nblk * 4) {
    const uint4 xa = *reinterpret_cast<const uint4*>(p.xn() + (size_t)t * 1024 + lane * 8);
    const uint4 xb = *reinterpret_cast<const uint4*>(p.xn() + (size_t)t * 1024 + 512 + lane * 8);
    const int e_lo = p.eidx()[(size_t)t * 128 + lane], e_hi = p.eidx()[(size_t)t * 128 + 64 + lane];
    const float g_lo = p.egate()[(size_t)t * 128 + lane], g_hi = p.egate()[(size_t)t * 128 + 64 + lane];
    float y[16];
#pragma unroll
    for (int i = 0; i < 16; ++i) y[i] = 0.f;
    for (int k0 = 0; k0 < 128; k0 += 4) {
      uint4 ua[4], ubv[4], va[4], vbv[4]; float gt[4];
#pragma unroll
      for (int q = 0; q < 4; ++q) {
        const int k = k0 + q;
        const int e = (k < 64) ? __shfl(e_lo, k) : __shfl(e_hi, k - 64);
        gt[q] = (k < 64) ? __shfl(g_lo, k) : __shfl(g_hi, k - 64);
        const bf16_t* ur = ubl + (size_t)e * 1024 + lane * 8;
        const bf16_t* vr = vbl + (size_t)e * 1024 + lane * 8;
        ua[q] = *reinterpret_cast<const uint4*>(ur);
        ubv[q] = *reinterpret_cast<const uint4*>(ur + 512);
        va[q] = *reinterpret_cast<const uint4*>(vr);
        vbv[q] = *reinterpret_cast<const uint4*>(vr + 512);
      }
#pragma unroll
      for (int q = 0; q < 4; ++q) {
        float d = dot8(xa, ua[q], 0.f);
        d = dot8(xb, ubv[q], d);
        d = wave_sum(d);
        const float wgt = gt[q] * gelu_exact(d);
        axpy8(y, wgt, va[q]);
        axpy8(y + 8, wgt, vbv[q]);
      }
    }
    float* xr = p.x() + (size_t)t * 1024;
    float4 a0 = *reinterpret_cast<float4*>(xr + lane * 8), a1 = *reinterpret_cast<float4*>(xr + lane * 8 + 4);
    float4 b0 = *reinterpret_cast<float4*>(xr + 512 + lane * 8), b1 = *reinterpret_cast<float4*>(xr + 512 + lane * 8 + 4);
    a0.x += y[0]; a0.y += y[1]; a0.z += y[2]; a0.w += y[3]; a1.x += y[4]; a1.y += y[5]; a1.z += y[6]; a1.w += y[7];
    b0.x += y[8]; b0.y += y[9]; b0.z += y[10]; b0.w += y[11]; b1.x += y[12]; b1.y += y[13]; b1.z += y[14]; b1.w += y[15];
    *reinterpret_cast<float4*>(xr + lane * 8) = a0; *reinterpret_cast<float4*>(xr + lane * 8 + 4) = a1;
    *reinterpret_cast<float4*>(xr + 512 + lane * 8) = b0; *reinterpret_cast<float4*>(xr + 512 + lane * 8 + 4) = b1;
  }
}

enum { PH_PREP = 0, PH_NORM1, PH_GEMM_IN, PH_ATTN, PH_MLCONV, PH_MCHAIN, PH_MLU, PH_MLSCAN, PH_MLOUT, PH_CMLP,
       PH_GEMM_OUT, PH_NORM2, PH_GEMM_PQ, PH_GEMM_SC, PH_TOPK, PH_GATHER, PH_FINAL };

__device__ __forceinline__ Params phase_params(const Params& kp, bool with_inputs) {
  Params q;
  size_t z = 0;
  asm volatile("" : "+s"(z));
  q.out = kp.out + z;
  q.ws = kp.ws + z;
  q.in[0] = kp.in[0] + z;
  q.in[1] = kp.in[1] + z;
  if (with_inputs) {
#pragma unroll
    for (int i = 2; i < 30; ++i) q.in[i] = kp.in[i] + z;
  }
  return q;
}

#define GSYNC() grid.sync()
#define PP(wi) phase_params(p, wi)
#define BN bid_opaque(bid), nblk_opaque(nblk)

template <int L>
__device__ __forceinline__ void layer_phases(const Params& p, char* smem, cg::grid_group& grid, int bid, int nblk) {
  ph_rmsnorm<0>(PP(false), L, BN);
  GSYNC();
  ph_gemm<EPI_WIN>(PP(false), L, smem, BN);
  GSYNC();
  ph_attn(PP(false), L, smem, BN);
  ph_mlconv(PP(false), L, smem, BN);
  ph_mchain(PP(false), L, BN);
  ph_cmlp(PP(false), L, smem, BN);
  GSYNC();
  ph_mlU(PP(false), L, smem, BN);
  GSYNC();
  ph_mlscan(PP(false), L, BN);
  GSYNC();
  ph_mlout(PP(false), L, smem, BN);
  GSYNC();
  ph_gemm<EPI_WOUT>(PP(false), L, smem, BN);
  GSYNC();
  ph_rmsnorm<1>(PP(false), L, BN);
  GSYNC();
  ph_gemm<EPI_PQ>(PP(false), L, smem, BN);
  GSYNC();
  ph_gemm<EPI_SC>(PP(false), L, smem, BN);
  GSYNC();
  ph_topk(PP(false), L, smem, BN);
  GSYNC();
  ph_gather(PP(false), L, BN);
  GSYNC();
}

__global__ void __launch_bounds__(256, 2) mega_kernel(Params p) {
  __shared__ __attribute__((aligned(16))) char smem[SMEM_BYTES];
  cg::grid_group grid = cg::this_grid();
  const int bid = blockIdx.x, nblk = gridDim.x;
  ph_prep(PP(true), smem, BN);
  GSYNC();
  layer_phases<0>(p, smem, grid, bid, nblk);
  layer_phases<1>(p, smem, grid, bid, nblk);
  ph_rmsnorm<2>(PP(false), 0, BN);
}

static inline size_t align_up(size_t v, size_t a) { return (v + a - 1) / a * a; }

extern "C" void kernel_launch(void* const* d_in, const int* in_sizes, int n_in, void* d_out, int out_size, void* d_ws,
                              size_t ws_size, hipStream_t stream) {
  Params p{};
  for (int i = 0; i < 30; ++i) p.in[i] = reinterpret_cast<const float*>(d_in[i]);
  p.out = reinterpret_cast<float*>(d_out);
  p.ws = reinterpret_cast<char*>(d_ws);
  if (WS_NEED > ws_size) { fprintf(stderr, "workspace too small: need %zu have %zu\n", (size_t)WS_NEED, ws_size); return; }
  static int grid_blocks = 0;
  if (!grid_blocks) {
    int dev = 0, cus = 0, per_cu = 0;
    hipGetDevice(&dev);
    hipDeviceGetAttribute(&cus, hipDeviceAttributeMultiprocessorCount, dev);
    hipOccupancyMaxActiveBlocksPerMultiprocessor(&per_cu, mega_kernel, 256, 0);
    if (per_cu > 2) per_cu = 2;
    if (per_cu < 1) per_cu = 1;
    grid_blocks = cus * per_cu;
  }
  void* args[] = {&p};
  hipError_t e = hipLaunchCooperativeKernel((void*)mega_kernel, dim3(grid_blocks), dim3(256), args, 0, stream);
  if (e != hipSuccess) fprintf(stderr, "cooperative launch failed: %s (grid %d)\n", hipGetErrorString(e), grid_blocks);
}
```

```cpp
#include <hip/hip_runtime.h>
#include <hip/hip_cooperative_groups.h>
#include <cstdio>
#include <cstdint>

namespace cg = cooperative_groups;

typedef unsigned short bf16_t;
typedef __attribute__((ext_vector_type(8))) __bf16 bf16x8;
typedef __attribute__((ext_vector_type(2))) __bf16 bf16x2;
typedef __attribute__((ext_vector_type(16))) float f32x16;
typedef __attribute__((ext_vector_type(2))) float f32x2;

#define D_MODEL 1024
#define NTOK 16896
#define NPROMPT 16384
#define SEQ 4096
#define NIN 2816
#define EPS 1e-6f
#define LOG2E 1.4426950408889634f
#define SKEYS 1088
#define NCU_UNITS 1056

constexpr size_t O_Y_P = 0;
constexpr size_t O_Y_S = O_Y_P + 16777216;
constexpr size_t O_K_P = O_Y_S + 524288;
constexpr size_t O_V_P = O_K_P + 16777216;
constexpr size_t O_C_P = O_V_P + 16777216;
constexpr size_t O_N_P = O_C_P + 131072;
constexpr size_t O_M_P = O_N_P + 2048;
constexpr size_t O_CONV_P = O_M_P + 32;
constexpr size_t O_K_S = O_CONV_P + 6144;
constexpr size_t O_V_S = O_K_S + 524288;
constexpr size_t O_C_S = O_V_S + 524288;
constexpr size_t O_N_S = O_C_S + 262144;
constexpr size_t O_M_S = O_N_S + 4096;
constexpr size_t O_CONV_S = O_M_S + 64;
constexpr size_t O_CMV_S = O_CONV_S + 12288;

constexpr size_t al256(size_t v) { return (v + 255) / 256 * 256; }
constexpr int SP_st_c = 0;
constexpr int SP_st_n = 262144;
constexpr int SP_st_m = 266240;
constexpr int SP_st_conv = 266304;
constexpr int SP_norm1_g = 278592;
constexpr int SP_da_subln_g = 280640;
constexpr int SP_ml_conv_w = 280896;
constexpr int SP_ml_conv_b = 282944;
constexpr int SP_ml_wq = 283456;
constexpr int SP_ml_wk = 316224;
constexpr int SP_ml_gate_b = 348992;
constexpr int SP_ml_norm_g = 349056;
constexpr int SP_ml_skip = 349568;
constexpr int SP_cm_norm_g = 350080;
constexpr int SP_cm_ws = 350592;
constexpr int SP_cm_b = 481664;
constexpr int SP_norm2_g = 482688;
constexpr int SP_final_g = 484736;
constexpr int SP_TOTAL = 485760;
constexpr size_t WS_bar = 0;
constexpr size_t WS_lam = al256(WS_bar + 16384);
constexpr size_t WS_lut = al256(WS_lam + (256));
constexpr size_t WS_sp = al256(WS_lut + (4*256*4));
constexpr size_t WS_wt_in = al256(WS_sp + (SP_TOTAL*4));
constexpr size_t WS_wg = al256(WS_wt_in + ((size_t)2*NIN*1024*2));
constexpr size_t WS_wt_out = al256(WS_wg + ((size_t)2*8*1024*4));
constexpr size_t WS_wt_pq = al256(WS_wt_out + ((size_t)2*1024*1024*2));
constexpr size_t WS_keysb = al256(WS_wt_pq + ((size_t)2*2048*1024*2));
constexpr size_t WS_ub = al256(WS_keysb + ((size_t)2*16*128*128*2));
constexpr size_t WS_vb = al256(WS_ub + ((size_t)2*16384*1024*2));
constexpr size_t WS_Kbs = al256(WS_vb + ((size_t)2*16384*1024*2));
constexpr size_t WS_Vts = al256(WS_Kbs + ((size_t)2*8*SKEYS*512*2));
constexpr size_t WS_x = al256(WS_Vts + ((size_t)2*8*4*128*SKEYS*2));
constexpr size_t WS_xn = al256(WS_x + ((size_t)NTOK*1024*4));
constexpr size_t WS_R0 = al256(WS_xn + ((size_t)NTOK*1024*2));
constexpr size_t WS_R0x = WS_R0;
constexpr size_t WS_Qb = al256(WS_R0x + (0));
constexpr size_t WS_Kb = al256(WS_Qb + ((size_t)NTOK*512*2));
constexpr size_t WS_Vt = al256(WS_Kb + ((size_t)NPROMPT*512*2));
constexpr size_t WS_P5 = al256(WS_Vt + ((size_t)16*128*SEQ*2));
constexpr size_t WS_ig = al256(WS_P5 + ((size_t)NTOK*1280*4));
constexpr size_t WS_lf = al256(WS_ig + ((size_t)NTOK*4*4));
constexpr size_t WS_Fc = al256(WS_lf + ((size_t)NTOK*4*4));
constexpr size_t WS_cc = al256(WS_Fc + ((size_t)NTOK*4*4));
constexpr size_t WS_qm = al256(WS_cc + ((size_t)NTOK*256*4));
constexpr size_t WS_km = al256(WS_qm + ((size_t)NTOK*256*4));
constexpr size_t WS_mst = al256(WS_km + ((size_t)NTOK*256*4));
constexpr size_t WS_mnx = al256(WS_mst + (NCU_UNITS*4));
constexpr size_t WS_wcs = al256(WS_mnx + (NCU_UNITS*4));
constexpr size_t WS_FLs = al256(WS_wcs + (NCU_UNITS*4));
constexpr size_t WS_U = al256(WS_FLs + (NCU_UNITS*4));
constexpr size_t WS_un = al256(WS_U + ((size_t)NCU_UNITS*4096*4));
constexpr size_t WS_Cst = al256(WS_un + ((size_t)NCU_UNITS*64*4));
constexpr size_t WS_nst = al256(WS_Cst + ((size_t)NCU_UNITS*4096*4));
constexpr size_t WS_END_MIXER = al256(WS_nst + ((size_t)NCU_UNITS*64*4));
constexpr size_t WS_qp = al256(WS_R0x + (0));
constexpr size_t WS_sc = al256(WS_qp + ((size_t)NTOK*2048*2));
constexpr size_t WS_eidx = al256(WS_sc + ((size_t)NTOK*2048*4));
constexpr size_t WS_egate = al256(WS_eidx + ((size_t)NTOK*128*4));
constexpr size_t WS_END_PEER = al256(WS_egate + ((size_t)NTOK*128*4));
constexpr size_t WS_NEED = WS_END_MIXER > WS_END_PEER ? WS_END_MIXER : WS_END_PEER;

struct Params {
  const float* in[30];
  float* out;
  char* ws;
  __device__ __forceinline__ const float* x_prompt() const { return in[0]; }
  __device__ __forceinline__ const float* x_sample() const { return in[1]; }
  __device__ __forceinline__ const float* cache_k() const { return in[2]; }
  __device__ __forceinline__ const float* cache_v() const { return in[3]; }
  __device__ __forceinline__ const float* w_in() const { return in[9]; }
  __device__ __forceinline__ const float* da_lambda() const { return in[10]; }
  __device__ __forceinline__ const float* rel_table() const { return in[12]; }
  __device__ __forceinline__ const float* w_out() const { return in[23]; }
  __device__ __forceinline__ const float* peer_wq() const { return in[25]; }
  __device__ __forceinline__ const float* peer_keys() const { return in[26]; }
  __device__ __forceinline__ const float* peer_u() const { return in[27]; }
  __device__ __forceinline__ const float* peer_v() const { return in[28]; }
  __device__ __forceinline__ const float* st_c() const { return reinterpret_cast<const float*>(ws + WS_sp) + SP_st_c; }
  __device__ __forceinline__ const float* st_n() const { return reinterpret_cast<const float*>(ws + WS_sp) + SP_st_n; }
  __device__ __forceinline__ const float* st_m() const { return reinterpret_cast<const float*>(ws + WS_sp) + SP_st_m; }
  __device__ __forceinline__ const float* st_conv() const { return reinterpret_cast<const float*>(ws + WS_sp) + SP_st_conv; }
  __device__ __forceinline__ const float* norm1_g() const { return reinterpret_cast<const float*>(ws + WS_sp) + SP_norm1_g; }
  __device__ __forceinline__ const float* da_subln_g() const { return reinterpret_cast<const float*>(ws + WS_sp) + SP_da_subln_g; }
  __device__ __forceinline__ const float* ml_conv_w() const { return reinterpret_cast<const float*>(ws + WS_sp) + SP_ml_conv_w; }
  __device__ __forceinline__ const float* ml_conv_b() const { return reinterpret_cast<const float*>(ws + WS_sp) + SP_ml_conv_b; }
  __device__ __forceinline__ const float* ml_wq() const { return reinterpret_cast<const float*>(ws + WS_sp) + SP_ml_wq; }
  __device__ __forceinline__ const float* ml_wk() const { return reinterpret_cast<const float*>(ws + WS_sp) + SP_ml_wk; }
  __device__ __forceinline__ const float* ml_gate_b() const { return reinterpret_cast<const float*>(ws + WS_sp) + SP_ml_gate_b; }
  __device__ __forceinline__ const float* ml_norm_g() const { return reinterpret_cast<const float*>(ws + WS_sp) + SP_ml_norm_g; }
  __device__ __forceinline__ const float* ml_skip() const { return reinterpret_cast<const float*>(ws + WS_sp) + SP_ml_skip; }
  __device__ __forceinline__ const float* cm_norm_g() const { return reinterpret_cast<const float*>(ws + WS_sp) + SP_cm_norm_g; }
  __device__ __forceinline__ const float* cm_ws() const { return reinterpret_cast<const float*>(ws + WS_sp) + SP_cm_ws; }
  __device__ __forceinline__ const float* cm_b() const { return reinterpret_cast<const float*>(ws + WS_sp) + SP_cm_b; }
  __device__ __forceinline__ const float* norm2_g() const { return reinterpret_cast<const float*>(ws + WS_sp) + SP_norm2_g; }
  __device__ __forceinline__ const float* final_g() const { return reinterpret_cast<const float*>(ws + WS_sp) + SP_final_g; }
  __device__ __forceinline__ float* lam() const { return reinterpret_cast<float*>(ws + WS_lam); }
  __device__ __forceinline__ float* lut() const { return reinterpret_cast<float*>(ws + WS_lut); }
  __device__ __forceinline__ float* sp() const { return reinterpret_cast<float*>(ws + WS_sp); }
  __device__ __forceinline__ bf16_t* wt_in() const { return reinterpret_cast<bf16_t*>(ws + WS_wt_in); }
  __device__ __forceinline__ float* wg() const { return reinterpret_cast<float*>(ws + WS_wg); }
  __device__ __forceinline__ bf16_t* wt_out() const { return reinterpret_cast<bf16_t*>(ws + WS_wt_out); }
  __device__ __forceinline__ bf16_t* wt_pq() const { return reinterpret_cast<bf16_t*>(ws + WS_wt_pq); }
  __device__ __forceinline__ bf16_t* keysb() const { return reinterpret_cast<bf16_t*>(ws + WS_keysb); }
  __device__ __forceinline__ bf16_t* ub() const { return reinterpret_cast<bf16_t*>(ws + WS_ub); }
  __device__ __forceinline__ bf16_t* vb() const { return reinterpret_cast<bf16_t*>(ws + WS_vb); }
  __device__ __forceinline__ bf16_t* Kbs() const { return reinterpret_cast<bf16_t*>(ws + WS_Kbs); }
  __device__ __forceinline__ bf16_t* Vts() const { return reinterpret_cast<bf16_t*>(ws + WS_Vts); }
  __device__ __forceinline__ float* x() const { return reinterpret_cast<float*>(ws + WS_x); }
  __device__ __forceinline__ bf16_t* xn() const { return reinterpret_cast<bf16_t*>(ws + WS_xn); }
  __device__ __forceinline__ bf16_t* Qb() const { return reinterpret_cast<bf16_t*>(ws + WS_Qb); }
  __device__ __forceinline__ bf16_t* Kb() const { return reinterpret_cast<bf16_t*>(ws + WS_Kb); }
  __device__ __forceinline__ bf16_t* Vt() const { return reinterpret_cast<bf16_t*>(ws + WS_Vt); }
  __device__ __forceinline__ float* P5() const { return reinterpret_cast<float*>(ws + WS_P5); }
  __device__ __forceinline__ float* ig() const { return reinterpret_cast<float*>(ws + WS_ig); }
  __device__ __forceinline__ float* lf() const { return reinterpret_cast<float*>(ws + WS_lf); }
  __device__ __forceinline__ float* Fc() const { return reinterpret_cast<float*>(ws + WS_Fc); }
  __device__ __forceinline__ float* cc() const { return reinterpret_cast<float*>(ws + WS_cc); }
  __device__ __forceinline__ float* qm() const { return reinterpret_cast<float*>(ws + WS_qm); }
  __device__ __forceinline__ float* km() const { return reinterpret_cast<float*>(ws + WS_km); }
  __device__ __forceinline__ float* mst() const { return reinterpret_cast<float*>(ws + WS_mst); }
  __device__ __forceinline__ float* mnx() const { return reinterpret_cast<float*>(ws + WS_mnx); }
  __device__ __forceinline__ float* wcs() const { return reinterpret_cast<float*>(ws + WS_wcs); }
  __device__ __forceinline__ float* FLs() const { return reinterpret_cast<float*>(ws + WS_FLs); }
  __device__ __forceinline__ float* U() const { return reinterpret_cast<float*>(ws + WS_U); }
  __device__ __forceinline__ float* un() const { return reinterpret_cast<float*>(ws + WS_un); }
  __device__ __forceinline__ float* Cst() const { return reinterpret_cast<float*>(ws + WS_Cst); }
  __device__ __forceinline__ float* nst() const { return reinterpret_cast<float*>(ws + WS_nst); }
  __device__ __forceinline__ bf16_t* qp() const { return reinterpret_cast<bf16_t*>(ws + WS_qp); }
  __device__ __forceinline__ float* sc() const { return reinterpret_cast<float*>(ws + WS_sc); }
  __device__ __forceinline__ int* eidx() const { return reinterpret_cast<int*>(ws + WS_eidx); }
  __device__ __forceinline__ float* egate() const { return reinterpret_cast<float*>(ws + WS_egate); }
};

__device__ __forceinline__ unsigned pack2(float a, float b) {
  f32x2 v = {a, b};
  bf16x2 r = __builtin_convertvector(v, bf16x2);
  return *reinterpret_cast<unsigned*>(&r);
}
__device__ __forceinline__ bf16_t f2bf(float a) { return (bf16_t)(pack2(a, 0.f) & 0xFFFFu); }
__device__ __forceinline__ float bf_lo(unsigned u) { return __uint_as_float(u << 16); }
__device__ __forceinline__ float bf_hi(unsigned u) { return __uint_as_float(u & 0xFFFF0000u); }
__device__ __forceinline__ float gelu_exact(float x) { return 0.5f * x * (1.f + erff(x * 0.70710678118654752f)); }
__device__ __forceinline__ float sigmoidf_(float x) { return 1.f / (1.f + __expf(-x)); }
template <int CTRL>
__device__ __forceinline__ float dpp_f(float v) {
  return __builtin_bit_cast(float, __builtin_amdgcn_update_dpp(0, __builtin_bit_cast(int, v), CTRL, 0xf, 0xf, true));
}
__device__ __forceinline__ float swap16_sum(float x) {
  auto s = __builtin_amdgcn_permlane16_swap(__float_as_uint(x), __float_as_uint(x), false, false);
  return __uint_as_float(s[0]) + __uint_as_float(s[1]);
}
__device__ __forceinline__ float swap32_sum(float x) {
  auto s = __builtin_amdgcn_permlane32_swap(__float_as_uint(x), __float_as_uint(x), false, false);
  return __uint_as_float(s[0]) + __uint_as_float(s[1]);
}
__device__ __forceinline__ float swap16_max(float x) {
  auto s = __builtin_amdgcn_permlane16_swap(__float_as_uint(x), __float_as_uint(x), false, false);
  return fmaxf(__uint_as_float(s[0]), __uint_as_float(s[1]));
}
__device__ __forceinline__ float swap32_max(float x) {
  auto s = __builtin_amdgcn_permlane32_swap(__float_as_uint(x), __float_as_uint(x), false, false);
  return fmaxf(__uint_as_float(s[0]), __uint_as_float(s[1]));
}
__device__ __forceinline__ float row16_sum(float v) {
  v += dpp_f<0xB1>(v); v += dpp_f<0x4E>(v); v += dpp_f<0x141>(v); v += dpp_f<0x140>(v);
  return v;
}
__device__ __forceinline__ float row16_max(float v) {
  v = fmaxf(v, dpp_f<0xB1>(v)); v = fmaxf(v, dpp_f<0x4E>(v)); v = fmaxf(v, dpp_f<0x141>(v)); v = fmaxf(v, dpp_f<0x140>(v));
  return v;
}
__device__ __forceinline__ float wave_sum(float v) { return swap32_sum(swap16_sum(row16_sum(v))); }
__device__ __forceinline__ float wave_max(float v) { return swap32_max(swap16_max(row16_max(v))); }
__device__ __forceinline__ const float* xrow_in(const Params& p, int l, int t) {
  if (l == 0) return (t < NPROMPT) ? p.x_prompt() + (size_t)t * D_MODEL : p.x_sample() + (size_t)(t - NPROMPT) * D_MODEL;
  return p.x() + (size_t)t * D_MODEL;
}
__device__ __forceinline__ bf16x8 as_bf16x8(uint4 v) { return *reinterpret_cast<bf16x8*>(&v); }

__device__ __forceinline__ int tid_opaque() { int t = threadIdx.x; asm volatile("" : "+v"(t)); return t; }
__device__ __forceinline__ int sgpr_opaque(int v) { asm volatile("" : "+s"(v)); return v; }
__device__ __forceinline__ int bid_opaque(int v) { asm volatile("" : "+s"(v)); __builtin_assume(v >= 0); __builtin_assume(v < 1024); return v; }
__device__ __forceinline__ int nblk_opaque(int v) { asm volatile("" : "+s"(v)); __builtin_assume(v >= 1); __builtin_assume(v <= 1024); return v; }
#define SMEM_BYTES 73728

__device__ __forceinline__ void transpose_tile(const float* __restrict__ src, int lds, bf16_t* __restrict__ dst, int K, int n0, int k0,
                               int gate_skip, float* tile  ) {
  const int tid = tid_opaque();
  const int c = tid & 63, r0 = tid >> 6;
  int n = n0 + c;
  int col = n + ((gate_skip && n >= 2304) ? 8 : 0);
#pragma unroll 4
  for (int j = 0; j < 16; ++j) {
    int r = r0 + 4 * j;
    tile[r * 65 + c] = src[(size_t)(k0 + r) * lds + col];
  }
  __syncthreads();
  const int nn = tid >> 2, kg = (tid & 3) * 16;
  unsigned w[8];
#pragma unroll
  for (int j = 0; j < 8; ++j) w[j] = pack2(tile[(kg + 2 * j) * 65 + nn], tile[(kg + 2 * j + 1) * 65 + nn]);
  uint4* d = reinterpret_cast<uint4*>(dst + (size_t)(n0 + nn) * K + k0 + kg);
  d[0] = make_uint4(w[0], w[1], w[2], w[3]);
  d[1] = make_uint4(w[4], w[5], w[6], w[7]);
  __syncthreads();
}

__device__ __forceinline__ int rel_bucket_dev(int rel) {
  int ret = rel > 0 ? 16 : 0;
  int n = rel < 0 ? -rel : rel;
  int b;
  if (n < 8) b = n;
  else if (n < 12) b = 8;
  else if (n < 16) b = 9;
  else if (n < 23) b = 10;
  else if (n < 32) b = 11;
  else if (n < 46) b = 12;
  else if (n < 64) b = 13;
  else if (n < 91) b = 14;
  else b = 15;
  return ret + b;
}

__device__ __forceinline__ void ph_prep(const Params& p, char* smem, int bid, int nblk) {
  const int tid = tid_opaque();
  float* tile = reinterpret_cast<float*>(smem);
  for (int u = bid; u < 2 * 1472; u += nblk) {
    int l = u / 1472, r = u % 1472;
    if (r < 704) {
      int nt = r / 16, kt = r % 16;
      transpose_tile(p.w_in() + (size_t)l * 1024 * 2824, 2824, p.wt_in() + (size_t)l * NIN * 1024, 1024, nt * 64, kt * 64, 1, tile);
    } else if (r < 960) {
      r -= 704; int nt = r / 16, kt = r % 16;
      transpose_tile(p.w_out() + (size_t)l * 1024 * 1024, 1024, p.wt_out() + (size_t)l * 1024 * 1024, 1024, nt * 64, kt * 64, 0, tile);
    } else {
      r -= 960; int nt = r / 16, kt = r % 16;
      transpose_tile(p.peer_wq() + (size_t)l * 1024 * 2048, 2048, p.wt_pq() + (size_t)l * 2048 * 1024, 1024, nt * 64, kt * 64, 0, tile);
    }
  }
  for (int u = bid; u < 1024; u += nblk) {
    int kt = u & 15, h = (u >> 4) & 3, b = (u >> 6) & 7, l = u >> 9;
    const float* src = p.cache_v() + (((size_t)(l * 8 + b) * 1024 + kt * 64) * 4 + h) * 128;
    {
      int c = tid & 127, r0 = tid >> 7;
      for (int j = 0; j < 32; ++j) { int r = r0 + 2 * j; tile[r * 129 + c] = src[(size_t)r * 512 + c]; }
    }
    __syncthreads();
    {
      int dv = tid >> 1, half = tid & 1;
      bf16_t* dst = p.Vts() + ((size_t)((l * 8 + b) * 4 + h) * 128 + dv) * SKEYS + kt * 64 + half * 32;
      unsigned w[16];
#pragma unroll
      for (int j = 0; j < 16; ++j) {
        int pos0 = half * 32 + 2 * j;
        int blk = (pos0 >> 2) & 3;
        int oblk = (blk == 1) ? 2 : (blk == 2 ? 1 : blk);
        int key0 = (pos0 & ~15) + oblk * 4 + (pos0 & 3);
        w[j] = pack2(tile[key0 * 129 + dv], tile[(key0 + 1) * 129 + dv]);
      }
      uint4* d4 = reinterpret_cast<uint4*>(dst);
      d4[0] = make_uint4(w[0], w[1], w[2], w[3]);
      d4[1] = make_uint4(w[4], w[5], w[6], w[7]);
      d4[2] = make_uint4(w[8], w[9], w[10], w[11]);
      d4[3] = make_uint4(w[12], w[13], w[14], w[15]);
    }
    __syncthreads();
  }
  const size_t gtid = (size_t)bid * 256 + tid, gsz = (size_t)nblk * 256;
  {
    const size_t n8 = (size_t)2 * 16384 * 1024 / 8;
    for (size_t i = gtid; i < n8; i += gsz) {
      float4 a = reinterpret_cast<const float4*>(p.peer_u())[2 * i], b = reinterpret_cast<const float4*>(p.peer_u())[2 * i + 1];
      reinterpret_cast<uint4*>(p.ub())[i] = make_uint4(pack2(a.x, a.y), pack2(a.z, a.w), pack2(b.x, b.y), pack2(b.z, b.w));
      float4 c = reinterpret_cast<const float4*>(p.peer_v())[2 * i], d = reinterpret_cast<const float4*>(p.peer_v())[2 * i + 1];
      reinterpret_cast<uint4*>(p.vb())[i] = make_uint4(pack2(c.x, c.y), pack2(c.z, c.w), pack2(d.x, d.y), pack2(d.z, d.w));
    }
  }
  {
    const size_t n8 = (size_t)2 * 16 * 128 * 128 / 8;
    for (size_t i = gtid; i < n8; i += gsz) {
      float4 a = reinterpret_cast<const float4*>(p.peer_keys())[2 * i], b = reinterpret_cast<const float4*>(p.peer_keys())[2 * i + 1];
      reinterpret_cast<uint4*>(p.keysb())[i] = make_uint4(pack2(a.x, a.y), pack2(a.z, a.w), pack2(b.x, b.y), pack2(b.z, b.w));
    }
  }
  {
    const size_t n8 = (size_t)2 * 8 * 1024 * 512 / 8;
    for (size_t i = gtid; i < n8; i += gsz) {
      size_t e = i * 8;
      size_t lb = e / (1024 * 512), rem = e % (1024 * 512);
      float4 a = reinterpret_cast<const float4*>(p.cache_k())[2 * i], b = reinterpret_cast<const float4*>(p.cache_k())[2 * i + 1];
      *reinterpret_cast<uint4*>(p.Kbs() + lb * (SKEYS * 512) + rem) = make_uint4(pack2(a.x, a.y), pack2(a.z, a.w), pack2(b.x, b.y), pack2(b.z, b.w));
    }
  }
  for (size_t i = gtid; i < 2 * 8 * 1024; i += gsz) {
    int l = (int)(i / 8192), r = (int)(i % 8192), g = r / 1024, k = r % 1024;
    p.wg()[i] = p.w_in()[((size_t)l * 1024 + k) * 2824 + 2304 + g];
  }
  {
    float* sp = reinterpret_cast<float*>(p.ws + WS_sp);
    for (size_t i = gtid; i < 262144; i += gsz) sp[SP_st_c + i] = p.in[4][i];
    for (size_t i = gtid; i < 4096; i += gsz) sp[SP_st_n + i] = p.in[5][i];
    for (size_t i = gtid; i < 64; i += gsz) sp[SP_st_m + i] = p.in[6][i];
    for (size_t i = gtid; i < 12288; i += gsz) sp[SP_st_conv + i] = p.in[7][i];
    for (size_t i = gtid; i < 2048; i += gsz) sp[SP_norm1_g + i] = p.in[8][i];
    for (size_t i = gtid; i < 256; i += gsz) sp[SP_da_subln_g + i] = p.in[11][i];
    for (size_t i = gtid; i < 2048; i += gsz) sp[SP_ml_conv_w + i] = p.in[13][i];
    for (size_t i = gtid; i < 512; i += gsz) sp[SP_ml_conv_b + i] = p.in[14][i];
    for (size_t i = gtid; i < 32768; i += gsz) sp[SP_ml_wq + i] = p.in[15][i];
    for (size_t i = gtid; i < 32768; i += gsz) sp[SP_ml_wk + i] = p.in[16][i];
    for (size_t i = gtid; i < 16; i += gsz) sp[SP_ml_gate_b + i] = p.in[17][i];
    for (size_t i = gtid; i < 512; i += gsz) sp[SP_ml_norm_g + i] = p.in[18][i];
    for (size_t i = gtid; i < 512; i += gsz) sp[SP_ml_skip + i] = p.in[19][i];
    for (size_t i = gtid; i < 512; i += gsz) sp[SP_cm_norm_g + i] = p.in[20][i];
    for (size_t i = gtid; i < 131072; i += gsz) sp[SP_cm_ws + i] = p.in[21][i];
    for (size_t i = gtid; i < 1024; i += gsz) sp[SP_cm_b + i] = p.in[22][i];
    for (size_t i = gtid; i < 2048; i += gsz) sp[SP_norm2_g + i] = p.in[24][i];
    for (size_t i = gtid; i < 1024; i += gsz) sp[SP_final_g + i] = p.in[29][i];
  }
  if (bid == 0) {
    for (int i = tid; i < 4 * 256; i += 256) {
      int h = i >> 8, j = i & 255;
      int rel = j - 191; if (rel > 63) rel = 63;
      p.lut()[i] = p.rel_table()[rel_bucket_dev(rel) * 4 + h] * LOG2E;
    }
    if (tid < 2) {
      const float* lp = p.da_lambda() + tid * 256;
      float s01 = 0.f, s23 = 0.f;
      for (int d = 0; d < 64; ++d) { s01 += lp[d] * lp[64 + d]; s23 += lp[128 + d] * lp[192 + d]; }
      float lam_init = 0.8f - 0.6f * expf(-0.3f * (float)tid);
      p.lam()[tid] = expf(s01) - expf(s23) + lam_init;
    }
  }
}

template <int MODE>
__device__ __forceinline__ void ph_rmsnorm(const Params& p, int l, int bid, int nblk) {
  const int lane = tid_opaque() & 63, w = tid_opaque() >> 6;
  const float* g = (MODE == 0) ? p.norm1_g() + l * 1024 : (MODE == 1 ? p.norm2_g() + l * 1024 : p.final_g());
  float4 gv[4];
#pragma unroll
  for (int j = 0; j < 4; ++j) gv[j] = reinterpret_cast<const float4*>(g)[lane + 64 * j];
  for (int t = bid * 4 + w; t < NTOK; t += nblk * 4) {
    const float* xr = (MODE == 0) ? xrow_in(p, l, t) : p.x() + (size_t)t * 1024;
    float4 xv[4];
    float ss = 0.f;
#pragma unroll
    for (int j = 0; j < 4; ++j) {
      xv[j] = reinterpret_cast<const float4*>(xr)[lane + 64 * j];
      ss += xv[j].x * xv[j].x + xv[j].y * xv[j].y + xv[j].z * xv[j].z + xv[j].w * xv[j].w;
    }
    ss = wave_sum(ss);
    float r = rsqrtf(ss * (1.f / 1024.f) + EPS);
#pragma unroll
    for (int j = 0; j < 4; ++j) {
      xv[j].x *= r * gv[j].x; xv[j].y *= r * gv[j].y; xv[j].z *= r * gv[j].z; xv[j].w *= r * gv[j].w;
    }
    if (MODE == 2) {
      float* o = (t < NPROMPT) ? p.out + O_Y_P + (size_t)t * 1024 : p.out + O_Y_S + (size_t)(t - NPROMPT) * 1024;
#pragma unroll
      for (int j = 0; j < 4; ++j) reinterpret_cast<float4*>(o)[lane + 64 * j] = xv[j];
    } else {
      uint2* o = reinterpret_cast<uint2*>(p.xn() + (size_t)t * 1024);
#pragma unroll
      for (int j = 0; j < 4; ++j) o[lane + 64 * j] = make_uint2(pack2(xv[j].x, xv[j].y), pack2(xv[j].z, xv[j].w));
    }
    if (MODE == 0) {
      float pre[8];
#pragma unroll
      for (int i = 0; i < 8; ++i) {
        const float4* wr = reinterpret_cast<const float4*>(p.wg() + ((size_t)l * 8 + i) * 1024);
        float s = 0.f;
#pragma unroll
        for (int j = 0; j < 4; ++j) {
          float4 wv = wr[lane + 64 * j];
          s += xv[j].x * wv.x + xv[j].y * wv.y + xv[j].z * wv.z + xv[j].w * wv.w;
        }
        pre[i] = wave_sum(s);
      }
      if (lane < 4) {
        float a = pre[0]; a = lane == 1 ? pre[1] : a; a = lane == 2 ? pre[2] : a; a = lane == 3 ? pre[3] : a;
        float f = pre[4]; f = lane == 1 ? pre[5] : f; f = lane == 2 ? pre[6] : f; f = lane == 3 ? pre[7] : f;
        p.ig()[(size_t)t * 4 + lane] = a + p.ml_gate_b()[l * 8 + lane];
        float z = f + p.ml_gate_b()[l * 8 + 4 + lane];
        p.lf()[(size_t)t * 4 + lane] = fminf(z, 0.f) - log1pf(expf(-fabsf(z)));
      }
    }
  }
}

enum { EPI_WIN = 0, EPI_WOUT = 1, EPI_PQ = 2, EPI_SC = 3 };

template <int EPI>
__device__ __forceinline__ void gemm_store(const Params& p, int l, int t, int n, float v) {
  if (EPI == EPI_WOUT) {
    const float* xi = xrow_in(p, l, t);
    p.x()[(size_t)t * 1024 + n] = xi[n] + v;
  } else if (EPI == EPI_PQ) {
    p.qp()[(size_t)t * 2048 + n] = f2bf(v);
  } else if (EPI == EPI_SC) {
    p.sc()[(size_t)t * 2048 + n] = v;
  }
}

template <int EPI>
__device__ __forceinline__ void ph_gemm(const Params& p, int l, char* smem, int bid, int nblk) {
  constexpr int NT = (EPI == EPI_WIN) ? 22 : (EPI == EPI_WOUT ? 8 : 16);
  constexpr int MT = NTOK / 128;
  constexpr int K = (EPI == EPI_SC) ? 128 : 1024;
  constexpr int NK = K / 64;
  const bf16_t* A; int lda; const bf16_t* Bt; int ldb;
  if (EPI == EPI_WIN) { A = p.xn(); lda = 1024; Bt = p.wt_in() + (size_t)l * NIN * 1024; ldb = 1024; }
  else if (EPI == EPI_WOUT) { A = p.xn(); lda = 1024; Bt = p.wt_out() + (size_t)l * 1024 * 1024; ldb = 1024; }
  else if (EPI == EPI_PQ) { A = p.xn(); lda = 1024; Bt = p.wt_pq() + (size_t)l * 2048 * 1024; ldb = 1024; }
  else { A = p.qp(); lda = 2048; Bt = p.keysb() + (size_t)l * 16 * 128 * 128; ldb = 128; }

  const int tid = tid_opaque(), lane = tid & 63, w = tid >> 6;
  const int wm = w >> 1, wn = w & 1, lr = lane & 31, lh = lane >> 5;
  char* sA = smem;
  char* sB = smem + 32768;
  const int ld_c = tid & 7, ld_r = tid >> 3;

  for (int tile = bid; tile < MT * NT; tile += nblk) {
    const int mt = tile / NT, nt = tile % NT;
    const bf16_t* Ag = A + (size_t)(mt * 128) * lda + ((EPI == EPI_SC) ? nt * 128 : 0);
    const bf16_t* Bg = Bt + (size_t)(nt * 128) * ldb;
    uint4 ra[4], rb[4];
    f32x16 acc[2][2];
#pragma unroll
    for (int i = 0; i < 2; ++i)
#pragma unroll
      for (int j = 0; j < 2; ++j)
#pragma unroll
        for (int r = 0; r < 16; ++r) acc[i][j][r] = 0.f;

#pragma unroll
    for (int j = 0; j < 4; ++j) {
      ra[j] = *reinterpret_cast<const uint4*>(Ag + (size_t)(ld_r + 32 * j) * lda + ld_c * 8);
      rb[j] = *reinterpret_cast<const uint4*>(Bg + (size_t)(ld_r + 32 * j) * ldb + ld_c * 8);
    }
#pragma unroll
    for (int j = 0; j < 4; ++j) {
      int row = ld_r + 32 * j; int pc = ld_c ^ ((row >> 1) & 7);
      *reinterpret_cast<uint4*>(sA + row * 128 + pc * 16) = ra[j];
      *reinterpret_cast<uint4*>(sB + row * 128 + pc * 16) = rb[j];
    }
    __syncthreads();
    for (int kt = 0; kt < NK; ++kt) {
      const int buf = kt & 1;
      if (kt + 1 < NK) {
#pragma unroll
        for (int j = 0; j < 4; ++j) {
          ra[j] = *reinterpret_cast<const uint4*>(Ag + (size_t)(ld_r + 32 * j) * lda + (kt + 1) * 64 + ld_c * 8);
          rb[j] = *reinterpret_cast<const uint4*>(Bg + (size_t)(ld_r + 32 * j) * ldb + (kt + 1) * 64 + ld_c * 8);
        }
      }
      const char* cA = sA + buf * 16384;
      const char* cB = sB + buf * 16384;
#pragma unroll
      for (int ks = 0; ks < 4; ++ks) {
        bf16x8 af[2], bfr[2];
#pragma unroll
        for (int i = 0; i < 2; ++i) {
          int row = wm * 64 + i * 32 + lr; int pc = (ks * 2 + lh) ^ ((row >> 1) & 7);
          af[i] = as_bf16x8(*reinterpret_cast<const uint4*>(cA + row * 128 + pc * 16));
        }
#pragma unroll
        for (int j = 0; j < 2; ++j) {
          int row = wn * 64 + j * 32 + lr; int pc = (ks * 2 + lh) ^ ((row >> 1) & 7);
          bfr[j] = as_bf16x8(*reinterpret_cast<const uint4*>(cB + row * 128 + pc * 16));
        }
#pragma unroll
        for (int i = 0; i < 2; ++i)
#pragma unroll
          for (int j = 0; j < 2; ++j)
            acc[i][j] = __builtin_amdgcn_mfma_f32_32x32x16_bf16(af[i], bfr[j], acc[i][j], 0, 0, 0);
      }
      if (kt + 1 < NK) {
        char* nA = sA + (buf ^ 1) * 16384;
        char* nB = sB + (buf ^ 1) * 16384;
#pragma unroll
        for (int j = 0; j < 4; ++j) {
          int row = ld_r + 32 * j; int pc = ld_c ^ ((row >> 1) & 7);
          *reinterpret_cast<uint4*>(nA + row * 128 + pc * 16) = ra[j];
          *reinterpret_cast<uint4*>(nB + row * 128 + pc * 16) = rb[j];
        }
      }
      __syncthreads();
    }
    if (EPI != EPI_WIN) {
#pragma unroll
      for (int i = 0; i < 2; ++i)
#pragma unroll
        for (int j = 0; j < 2; ++j)
#pragma unroll
          for (int r = 0; r < 16; ++r) {
            int t = mt * 128 + wm * 64 + i * 32 + (r & 3) + 8 * (r >> 2) + 4 * lh;
            int n = nt * 128 + wn * 64 + j * 32 + lr;
            gemm_store<EPI>(p, l, t, n, acc[i][j][r]);
          }
    } else {
      const int seg = nt >> 2;
#pragma unroll
      for (int i = 0; i < 2; ++i)
#pragma unroll
        for (int j = 0; j < 2; ++j) {
          const int n = nt * 128 + wn * 64 + j * 32 + lr;
          if (nt < 4) {
#pragma unroll
            for (int r = 0; r < 16; ++r) {
              int t = mt * 128 + wm * 64 + i * 32 + (r & 3) + 8 * (r >> 2) + 4 * lh;
              p.Qb()[(size_t)t * 512 + n] = f2bf(acc[i][j][r] * (0.125f * LOG2E));
            }
          } else if (nt < 8) {
            const int n2 = n - 512;
#pragma unroll
            for (int r = 0; r < 16; ++r) {
              int t = mt * 128 + wm * 64 + i * 32 + (r & 3) + 8 * (r >> 2) + 4 * lh;
              float v = acc[i][j][r];
              if (t < NPROMPT) {
                p.out[O_K_P + (size_t)l * (4 * 4096 * 512) + (size_t)t * 512 + n2] = v;
                p.Kb()[(size_t)t * 512 + n2] = f2bf(v);
              } else {
                int ts = t - NPROMPT, b = ts >> 6, ii = ts & 63;
                p.out[O_K_S + (size_t)l * (8 * 64 * 512) + (size_t)ts * 512 + n2] = v;
                p.Kbs()[((size_t)(l * 8 + b) * SKEYS + 1024 + ii) * 512 + n2] = f2bf(v);
              }
            }
          } else if (nt < 12) {
            const int n2 = n - 1024, h = n2 >> 7, dv = n2 & 127;
#pragma unroll
            for (int rg = 0; rg < 4; ++rg) {
              int tb = mt * 128 + wm * 64 + i * 32 + 8 * rg + 4 * lh;
              float v0 = acc[i][j][rg * 4 + 0], v1 = acc[i][j][rg * 4 + 1], v2 = acc[i][j][rg * 4 + 2], v3 = acc[i][j][rg * 4 + 3];
              uint2 pk = make_uint2(pack2(v0, v1), pack2(v2, v3));
              int posblk = 2 * lh + (rg & 1);
              if (tb < NPROMPT) {
                float* o = p.out + O_V_P + (size_t)l * (4 * 4096 * 512) + (size_t)tb * 512 + n2;
                o[0] = v0; o[512] = v1; o[1024] = v2; o[1536] = v3;
                int b = tb >> 12, s = tb & 4095;
                int pos = (s & ~15) + posblk * 4;
                *reinterpret_cast<uint2*>(p.Vt() + ((size_t)(b * 4 + h) * 128 + dv) * SEQ + pos) = pk;
              } else {
                int ts = tb - NPROMPT, b = ts >> 6, ii = ts & 63;
                float* o = p.out + O_V_S + (size_t)l * (8 * 64 * 512) + (size_t)ts * 512 + n2;
                o[0] = v0; o[512] = v1; o[1024] = v2; o[1536] = v3;
                int pos = 1024 + (ii & ~15) + posblk * 4;
                *reinterpret_cast<uint2*>(p.Vts() + ((size_t)((l * 8 + b) * 4 + h) * 128 + dv) * SKEYS + pos) = pk;
              }
            }
          } else {
            const int n2 = n - 1536;
            const bool act = (n >= 2304);
#pragma unroll
            for (int r = 0; r < 16; ++r) {
              int t = mt * 128 + wm * 64 + i * 32 + (r & 3) + 8 * (r >> 2) + 4 * lh;
              float v = acc[i][j][r];
              if (act) v = gelu_exact(v);
              p.P5()[(size_t)t * 1280 + n2] = v;
            }
          }
        }
      (void)seg;
    }
  }
}

__device__ __forceinline__ void ph_attn(const Params& p, int l, char* smem, int bid, int nblk) {
  const int tid = tid_opaque(), lane = tid & 63, w = tid >> 6;
  const int c = w >> 1, qhalf = w & 1, lr = lane & 31, lh = lane >> 5;
  char* sK = smem;
  char* sV = smem + 16384;
  float* sLut = reinterpret_cast<float*>(smem + 32768);
  char* sQ = smem + 33792 + w * 4096;
  float* sO2 = reinterpret_cast<float*>(smem);
  const float lam = p.lam()[l];
  const float lam_init = 0.8f - 0.6f * expf(-0.3f * (float)l);

  for (int uu = bid; uu < 1056; uu += nblk) {
    int b, h, qc, S, qrow0; const bf16_t *Kbase, *Vbase;
    bool samp = false; int u2 = uu;
    if (uu >= 752 && uu < 784) samp = true; else if (uu >= 784) u2 = uu - 32;
    if (!samp) {
      qc = 63 - (u2 >> 4); int bh = u2 & 15; b = bh >> 2; h = bh & 3; S = SEQ;
      Kbase = p.Kb() + (size_t)b * SEQ * 512 + h * 128;
      Vbase = p.Vt() + (size_t)(b * 4 + h) * 128 * SEQ;
      qrow0 = b * SEQ + qc * 64;
    } else {
      int us = uu - 752; b = us >> 2; h = us & 3; qc = 16; S = SKEYS;
      Kbase = p.Kbs() + (size_t)(l * 8 + b) * SKEYS * 512 + h * 128;
      Vbase = p.Vts() + (size_t)((l * 8 + b) * 4 + h) * 128 * SKEYS;
      qrow0 = NPROMPT + b * 64;
    }
    const int ntiles = qc + 1;
    __syncthreads();
    sLut[tid] = p.lut()[h * 256 + tid];
    {
      const int qc8 = lane & 7, qr = lane >> 3;
#pragma unroll
      for (int j = 0; j < 4; ++j) {
        int row = qr + 8 * j;
        uint4 v = *reinterpret_cast<const uint4*>(p.Qb() + (size_t)(qrow0 + qhalf * 32 + row) * 512 + h * 128 + c * 64 + qc8 * 8);
        *reinterpret_cast<uint4*>(sQ + row * 128 + ((qc8 ^ ((row >> 1) & 7)) * 16)) = v;
      }
    }
    f32x16 o[4];
#pragma unroll
    for (int d = 0; d < 4; ++d)
#pragma unroll
      for (int r = 0; r < 16; ++r) o[d][r] = 0.f;
    float m_run = -1e30f, l_run = 0.f;
    const float c15 = p.lut()[h * 256];

    uint4 rk0, rk1, rk2, rk3, rv0, rv1, rv2, rv3;
    const int kc = tid & 15, kr = tid >> 4;
    const int vc = tid & 7, vr = tid >> 3;
    const char* Kt = reinterpret_cast<const char*>(Kbase);
    const char* Vb = reinterpret_cast<const char*>(Vbase);
    const unsigned koff = (unsigned)kr * 1024u + (unsigned)kc * 16u;
    const unsigned voff = (unsigned)vr * (unsigned)(S * 2) + (unsigned)vc * 16u;
    const size_t vjs = (size_t)S * 64;
#define ATTN_GL1(KT, J, RK, RV)                                                                              \
  RK = *reinterpret_cast<const uint4*>(Kt + ((size_t)((KT) * 64 + 16 * (J)) * 1024) + koff);                 \
  RV = *reinterpret_cast<const uint4*>(Vb + ((size_t)(J) * vjs + (size_t)(KT) * 128) + voff);
#define ATTN_GLOAD(KT) ATTN_GL1(KT, 0, rk0, rv0) ATTN_GL1(KT, 1, rk1, rv1) ATTN_GL1(KT, 2, rk2, rv2) ATTN_GL1(KT, 3, rk3, rv3)
#define ATTN_SW1(J, RK, RV)                                                                                  \
  {                                                                                                          \
    int row = kr + 16 * (J); int pc = (kc & 7) ^ ((row >> 1) & 7);                                           \
    *reinterpret_cast<uint4*>(sK + (kc >> 3) * 8192 + row * 128 + pc * 16) = RK;                             \
    int row2 = vr + 32 * (J); int pc2 = vc ^ ((row2 >> 1) & 7);                                              \
    *reinterpret_cast<uint4*>(sV + row2 * 128 + pc2 * 16) = RV;                                              \
  }
    ATTN_GLOAD(0)
    for (int kt = 0; kt < ntiles; ++kt) {
      __syncthreads();
      ATTN_SW1(0, rk0, rv0) ATTN_SW1(1, rk1, rv1) ATTN_SW1(2, rk2, rv2) ATTN_SW1(3, rk3, rv3)
      __syncthreads();
      if (kt + 1 < ntiles) { ATTN_GLOAD(kt + 1) }
      f32x16 s[2];
#pragma unroll
      for (int kb = 0; kb < 2; ++kb) {
#pragma unroll
        for (int r = 0; r < 16; ++r) s[kb][r] = 0.f;
#pragma unroll
        for (int ks = 0; ks < 4; ++ks) {
          int row = kb * 32 + lr; int pc = (ks * 2 + lh) ^ ((row >> 1) & 7);
          bf16x8 kf = as_bf16x8(*reinterpret_cast<const uint4*>(sK + c * 8192 + row * 128 + pc * 16));
          bf16x8 qf = as_bf16x8(*reinterpret_cast<const uint4*>(sQ + lr * 128 + (((ks * 2 + lh) ^ ((lr >> 1) & 7)) * 16)));
          s[kb] = __builtin_amdgcn_mfma_f32_32x32x16_bf16(kf, qf, s[kb], 0, 0, 0);
        }
      }
      if (kt >= qc - 2) {
        const int base = (kt - qc) * 64 - (qhalf * 32 + lr) + 191 + 4 * lh;
#pragma unroll
        for (int kb = 0; kb < 2; ++kb)
#pragma unroll
          for (int r = 0; r < 16; ++r) s[kb][r] += sLut[base + kb * 32 + (r & 3) + 8 * (r >> 2)];
      } else {
#pragma unroll
        for (int kb = 0; kb < 2; ++kb)
#pragma unroll
          for (int r = 0; r < 16; ++r) s[kb][r] += c15;
      }
      float mx = s[0][0];
#pragma unroll
      for (int kb = 0; kb < 2; ++kb)
#pragma unroll
        for (int r = 0; r < 16; ++r) mx = fmaxf(mx, s[kb][r]);
      mx = swap32_max(mx);
      const float m_new = fmaxf(m_run, mx);
      const float alpha = __builtin_amdgcn_exp2f(m_run - m_new);
      m_run = m_new;
      float ps = 0.f;
#pragma unroll
      for (int kb = 0; kb < 2; ++kb)
#pragma unroll
        for (int r = 0; r < 16; ++r) { float pv = __builtin_amdgcn_exp2f(s[kb][r] - m_new); s[kb][r] = pv; ps += pv; }
      l_run = l_run * alpha + ps;
#pragma unroll
      for (int d = 0; d < 4; ++d)
#pragma unroll
        for (int r = 0; r < 16; ++r) o[d][r] *= alpha;
#pragma unroll
      for (int ks2 = 0; ks2 < 4; ++ks2) {
        const int kb = ks2 >> 1, sh = (ks2 & 1) * 8;
        uint4 pw = make_uint4(pack2(s[kb][sh + 0], s[kb][sh + 1]), pack2(s[kb][sh + 2], s[kb][sh + 3]),
                              pack2(s[kb][sh + 4], s[kb][sh + 5]), pack2(s[kb][sh + 6], s[kb][sh + 7]));
        bf16x8 pf = as_bf16x8(pw);
#pragma unroll
        for (int d = 0; d < 4; ++d) {
          int row = d * 32 + lr; int pc = (ks2 * 2 + lh) ^ ((row >> 1) & 7);
          bf16x8 vf = as_bf16x8(*reinterpret_cast<const uint4*>(sV + row * 128 + pc * 16));
          o[d] = __builtin_amdgcn_mfma_f32_32x32x16_bf16(vf, pf, o[d], 0, 0, 0);
        }
        __builtin_amdgcn_sched_barrier(0);
      }
    }
    float lt = swap32_sum(l_run);
    float inv = 1.f / lt;
    __syncthreads();
    if (c == 1) {
#pragma unroll
      for (int d = 0; d < 4; ++d)
#pragma unroll
        for (int r = 0; r < 16; ++r) sO2[(qhalf * 64 + d * 16 + r) * 64 + lane] = o[d][r] * inv;
    }
    __syncthreads();
    if (c == 0) {
      float ss = 0.f;
#pragma unroll
      for (int d = 0; d < 4; ++d)
#pragma unroll
        for (int r = 0; r < 16; ++r) {
          float v = o[d][r] * inv - lam * sO2[(qhalf * 64 + d * 16 + r) * 64 + lane];
          o[d][r] = v; ss += v * v;
        }
      ss = swap32_sum(ss);
      const float rn = rsqrtf(ss * (1.f / 128.f) + EPS) * (1.f - lam_init);
      const float* gs = p.da_subln_g() + l * 128;
      bf16_t* orow = p.xn() + (size_t)(qrow0 + qhalf * 32 + lr) * 1024 + h * 128;
#pragma unroll
      for (int d = 0; d < 4; ++d)
#pragma unroll
        for (int rg = 0; rg < 4; ++rg) {
          int dv = d * 32 + 8 * rg + 4 * lh;
          float4 g4 = *reinterpret_cast<const float4*>(gs + dv);
          uint2 pk = make_uint2(pack2(o[d][rg * 4 + 0] * rn * g4.x, o[d][rg * 4 + 1] * rn * g4.y),
                                pack2(o[d][rg * 4 + 2] * rn * g4.z, o[d][rg * 4 + 3] * rn * g4.w));
          *reinterpret_cast<uint2*>(orow + dv) = pk;
        }
    }
  }
}

__device__ __forceinline__ void ph_mlconv(const Params& p, int l, char* smem, int bid, int nblk) {
  const int tid = tid_opaque();
  float* s_mc = reinterpret_cast<float*>(smem);
  float* s_cc = s_mc + 67 * 64;
  float* s_wq = s_cc + 64 * 65;
  float* s_wk = s_wq + 4096;
  for (int u = bid; u < 264 * 4; u += nblk) {
    const int ci = u >> 2, h = u & 3;
    int token0, bq; bool samp = ci >= 256;
    if (!samp) token0 = ci * 64; else token0 = NPROMPT + (ci - 256) * 64;
    bq = samp ? (ci - 256) : (ci >> 6);
    const int cidx = samp ? 0 : (ci & 63);
    __syncthreads();
    for (int i = tid; i < 67 * 64; i += 256) {
      int r = i >> 6, d = i & 63;
      float v;
      if (r >= 3) v = p.P5()[(size_t)(token0 + r - 3) * 1280 + h * 64 + d];
      else if (samp) v = p.st_conv()[((size_t)(l * 8 + bq) * 3 + r) * 256 + h * 64 + d];
      else if (cidx == 0) v = 0.f;
      else v = p.P5()[(size_t)(token0 + r - 3) * 1280 + h * 64 + d];
      s_mc[i] = v;
    }
    for (int i = tid; i < 4096; i += 256) {
      s_wq[i] = p.ml_wq()[(size_t)(l * 4 + h) * 4096 + i];
      s_wk[i] = p.ml_wk()[(size_t)(l * 4 + h) * 4096 + i];
    }
    __syncthreads();
    {
      const int d = tid & 63, t0 = tid >> 6;
      const int ch = h * 64 + d;
      const float w0 = p.ml_conv_w()[(l * 4 + 0) * 256 + ch], w1 = p.ml_conv_w()[(l * 4 + 1) * 256 + ch];
      const float w2 = p.ml_conv_w()[(l * 4 + 2) * 256 + ch], w3 = p.ml_conv_w()[(l * 4 + 3) * 256 + ch];
      const float bb = p.ml_conv_b()[l * 256 + ch];
      for (int t = t0; t < 64; t += 4) {
        float y = bb + w0 * s_mc[t * 64 + d] + w1 * s_mc[(t + 1) * 64 + d] + w2 * s_mc[(t + 2) * 64 + d] + w3 * s_mc[(t + 3) * 64 + d];
        y = y * sigmoidf_(y);
        s_cc[t * 65 + d] = y;
        p.cc()[(size_t)(token0 + t) * 256 + ch] = y;
      }
      if (samp || cidx == 63) {
        if (tid < 192) {
          int r = tid >> 6;
          float v = s_mc[(64 + r) * 64 + d];
          if (samp) p.out[O_CONV_S + ((size_t)(l * 8 + bq) * 3 + r) * 256 + ch] = v;
          else p.out[O_CONV_P + ((size_t)(l * 4 + bq) * 3 + r) * 256 + ch] = v;
        }
      }
    }
    __syncthreads();
    {
      const int ty = tid >> 4, tx = tid & 15;
      float aq[4][4], ak[4][4];
#pragma unroll
      for (int i = 0; i < 4; ++i)
#pragma unroll
        for (int j = 0; j < 4; ++j) { aq[i][j] = 0.f; ak[i][j] = 0.f; }
      for (int d = 0; d < 64; ++d) {
        float4 wq4 = *reinterpret_cast<const float4*>(s_wq + d * 64 + tx * 4);
        float4 wk4 = *reinterpret_cast<const float4*>(s_wk + d * 64 + tx * 4);
#pragma unroll
        for (int i = 0; i < 4; ++i) {
          float a = s_cc[(ty * 4 + i) * 65 + d];
          aq[i][0] += a * wq4.x; aq[i][1] += a * wq4.y; aq[i][2] += a * wq4.z; aq[i][3] += a * wq4.w;
          ak[i][0] += a * wk4.x; ak[i][1] += a * wk4.y; ak[i][2] += a * wk4.z; ak[i][3] += a * wk4.w;
        }
      }
#pragma unroll
      for (int i = 0; i < 4; ++i) {
        size_t o = (size_t)(token0 + ty * 4 + i) * 256 + h * 64 + tx * 4;
        *reinterpret_cast<float4*>(p.qm() + o) = make_float4(aq[i][0], aq[i][1], aq[i][2], aq[i][3]);
        *reinterpret_cast<float4*>(p.km() + o) = make_float4(ak[i][0] * 0.125f, ak[i][1] * 0.125f, ak[i][2] * 0.125f, ak[i][3] * 0.125f);
      }
    }
  }
}

__device__ __forceinline__ void ph_mchain(const Params& p, int l, int bid, int nblk) {
  const int lane = tid_opaque() & 63, w = tid_opaque() >> 6;
  for (int u = bid * 4 + w; u < 48; u += nblk * 4) {
    const bool samp = u >= 16;
    int b, h, nch, token0, cu0; float m;
    if (!samp) { b = u >> 2; h = u & 3; nch = 64; token0 = b * SEQ; cu0 = (b * 4 + h) * 64; m = 0.f; }
    else { int us = u - 16; b = us >> 2; h = us & 3; nch = 1; token0 = NPROMPT + b * 64; cu0 = 1024 + us; m = p.st_m()[(l * 8 + b) * 4 + h]; }
    for (int c = 0; c < nch; ++c) {
      const int t = token0 + c * 64 + lane;
      float lfv = p.lf()[(size_t)t * 4 + h], igv = p.ig()[(size_t)t * 4 + h];
      float F = lfv;
#pragma unroll
      for (int d = 1; d < 64; d <<= 1) { float n = __shfl_up(F, d); if (lane >= d) F += n; }
      const float FL = __shfl(F, 63);
      const float tail = FL - F + igv;
      const float mx = wave_max(tail);
      const float mn = fmaxf(FL + m, mx);
      p.Fc()[(size_t)t * 4 + h] = F;
      if (lane == 0) {
        p.mst()[cu0 + c] = m; p.mnx()[cu0 + c] = mn; p.wcs()[cu0 + c] = expf(FL + m - mn); p.FLs()[cu0 + c] = FL;
      }
      m = mn;
    }
    if (lane == 0) {
      if (!samp) p.out[O_M_P + (l * 4 + b) * 4 + h] = m;
      else p.out[O_M_S + (l * 8 + b) * 4 + h] = m;
    }
  }
}

__device__ __forceinline__ void cu_decode(int cu, int& token0, int& h) {
  if (cu < 1024) { int bh = cu >> 6, c = cu & 63; token0 = (bh >> 2) * SEQ + c * 64; h = bh & 3; }
  else { int us = cu - 1024; token0 = NPROMPT + (us >> 2) * 64; h = us & 3; }
}

__device__ __forceinline__ void ph_mlU(const Params& p, int l, char* smem, int bid, int nblk) {
  const int tid = tid_opaque();
  float* s_k = reinterpret_cast<float*>(smem);
  float* s_v = s_k + 4096;
  for (int cu = bid; cu < NCU_UNITS; cu += nblk) {
    int token0, h; cu_decode(cu, token0, h);
    const float FL = p.FLs()[cu], mn = p.mnx()[cu];
    __syncthreads();
    for (int i = tid; i < 1024; i += 256) {
      int s = i >> 4, d4 = (i & 15) * 4;
      const int t = token0 + s;
      float wsv = expf(FL - p.Fc()[(size_t)t * 4 + h] + p.ig()[(size_t)t * 4 + h] - mn);
      float4 k4 = *reinterpret_cast<const float4*>(p.km() + (size_t)t * 256 + h * 64 + d4);
      float4 v4 = *reinterpret_cast<const float4*>(p.P5() + (size_t)t * 1280 + 256 + h * 64 + d4);
      *reinterpret_cast<float4*>(s_k + s * 64 + d4) = make_float4(k4.x * wsv, k4.y * wsv, k4.z * wsv, k4.w * wsv);
      *reinterpret_cast<float4*>(s_v + s * 64 + d4) = v4;
    }
    __syncthreads();
    const int ty = tid >> 4, tx = tid & 15;
    float a[4][4];
#pragma unroll
    for (int i = 0; i < 4; ++i)
#pragma unroll
      for (int j = 0; j < 4; ++j) a[i][j] = 0.f;
    for (int s = 0; s < 64; ++s) {
      float4 k4 = *reinterpret_cast<const float4*>(s_k + s * 64 + ty * 4);
      float4 v4 = *reinterpret_cast<const float4*>(s_v + s * 64 + tx * 4);
      float kk[4] = {k4.x, k4.y, k4.z, k4.w};
#pragma unroll
      for (int i = 0; i < 4; ++i) { a[i][0] += kk[i] * v4.x; a[i][1] += kk[i] * v4.y; a[i][2] += kk[i] * v4.z; a[i][3] += kk[i] * v4.w; }
    }
#pragma unroll
    for (int i = 0; i < 4; ++i)
      *reinterpret_cast<float4*>(p.U() + (size_t)cu * 4096 + (ty * 4 + i) * 64 + tx * 4) = make_float4(a[i][0], a[i][1], a[i][2], a[i][3]);
    if (tid < 64) {
      float s0 = 0.f;
      for (int s = 0; s < 64; ++s) s0 += s_k[s * 64 + tid];
      p.un()[(size_t)cu * 64 + tid] = s0;
    }
  }
}

__device__ __forceinline__ void ph_mlscan(const Params& p, int l, int bid, int nblk) {
  const size_t gtid = (size_t)bid * 256 + tid_opaque(), gsz = (size_t)nblk * 256;
  const size_t NPC = 16 * 4096, NSC = 32 * 4096, NPN = 16 * 64, NSN = 32 * 64;
  for (size_t i = gtid; i < NPC + NSC + NPN + NSN; i += gsz) {
    if (i < NPC) {
      int bh = (int)(i >> 12), e = (int)(i & 4095);
      float C = 0.f;
      for (int c = 0; c < 64; ++c) {
        int cu = bh * 64 + c;
        p.Cst()[(size_t)cu * 4096 + e] = C;
        C = p.wcs()[cu] * C + p.U()[(size_t)cu * 4096 + e];
      }
      p.out[O_C_P + (size_t)l * (16 * 4096) + i] = C;
    } else if (i < NPC + NSC) {
      size_t j = i - NPC; int us = (int)(j >> 12), e = (int)(j & 4095); int cu = 1024 + us;
      float C = p.st_c()[(size_t)l * (32 * 4096) + j];
      p.Cst()[(size_t)cu * 4096 + e] = C;
      p.out[O_C_S + (size_t)l * (32 * 4096) + j] = p.wcs()[cu] * C + p.U()[(size_t)cu * 4096 + e];
    } else if (i < NPC + NSC + NPN) {
      size_t j = i - NPC - NSC; int bh = (int)(j >> 6), d = (int)(j & 63);
      float n = 0.f;
      for (int c = 0; c < 64; ++c) {
        int cu = bh * 64 + c;
        p.nst()[(size_t)cu * 64 + d] = n;
        n = p.wcs()[cu] * n + p.un()[(size_t)cu * 64 + d];
      }
      p.out[O_N_P + (size_t)l * (16 * 64) + j] = n;
    } else {
      size_t j = i - NPC - NSC - NPN; int us = (int)(j >> 6), d = (int)(j & 63); int cu = 1024 + us;
      float n = p.st_n()[(size_t)l * (32 * 64) + j];
      p.nst()[(size_t)cu * 64 + d] = n;
      p.out[O_N_S + (size_t)l * (32 * 64) + j] = p.wcs()[cu] * n + p.un()[(size_t)cu * 64 + d];
    }
  }
}

__device__ __forceinline__ void ph_mlout(const Params& p, int l, char* smem, int bid, int nblk) {
  const int tid = tid_opaque();
  float* s_q = reinterpret_cast<float*>(smem);
  float* s_k = s_q + 64 * 65;
  float* s_v = s_k + 64 * 65;
  float* s_C = s_v + 4096;
  float* s_F = s_C + 4096;
  float* s_a = s_F + 64;
  float* s_mt = s_a + 64;
  float* s_iw = s_mt + 64;
  float* s_n = s_iw + 64;
  float* s_den = s_n + 64;
  for (int cu = bid; cu < NCU_UNITS; cu += nblk) {
    int token0, h; cu_decode(cu, token0, h);
    const float m0 = p.mst()[cu];
    __syncthreads();
    for (int i = tid; i < 1024; i += 256) {
      int s = i >> 4, d4 = (i & 15) * 4;
      const int t = token0 + s;
      float4 q4 = *reinterpret_cast<const float4*>(p.qm() + (size_t)t * 256 + h * 64 + d4);
      float4 k4 = *reinterpret_cast<const float4*>(p.km() + (size_t)t * 256 + h * 64 + d4);
      float4 v4 = *reinterpret_cast<const float4*>(p.P5() + (size_t)t * 1280 + 256 + h * 64 + d4);
      float4 c4 = *reinterpret_cast<const float4*>(p.Cst() + (size_t)cu * 4096 + s * 64 + d4);
      s_q[s * 65 + d4] = q4.x; s_q[s * 65 + d4 + 1] = q4.y; s_q[s * 65 + d4 + 2] = q4.z; s_q[s * 65 + d4 + 3] = q4.w;
      s_k[s * 65 + d4] = k4.x; s_k[s * 65 + d4 + 1] = k4.y; s_k[s * 65 + d4 + 2] = k4.z; s_k[s * 65 + d4 + 3] = k4.w;
      *reinterpret_cast<float4*>(s_v + s * 64 + d4) = v4;
      *reinterpret_cast<float4*>(s_C + s * 64 + d4) = c4;
    }
    if (tid < 64) {
      const int t = token0 + tid;
      float F = p.Fc()[(size_t)t * 4 + h], g = p.ig()[(size_t)t * 4 + h];
      s_F[tid] = F; s_a[tid] = g - F;
      s_n[tid] = p.nst()[(size_t)cu * 64 + tid];
    }
    __syncthreads();
    if (tid < 64) {
      float pm = -1e30f;
      for (int s = 0; s <= tid; ++s) pm = fmaxf(pm, s_a[s]);
      float F = s_F[tid];
      float mt = F + fmaxf(m0, pm);
      s_mt[tid] = mt;
      s_iw[tid] = expf(F + m0 - mt);
    }
    __syncthreads();
    const int ty = tid >> 4, tx = tid & 15;
    float acc[4][4];
#pragma unroll
    for (int i = 0; i < 4; ++i)
#pragma unroll
      for (int j = 0; j < 4; ++j) acc[i][j] = 0.f;
    for (int d = 0; d < 64; ++d) {
      float qv[4], kv[4];
#pragma unroll
      for (int i = 0; i < 4; ++i) { qv[i] = s_q[(ty * 4 + i) * 65 + d]; kv[i] = s_k[(tx * 4 + i) * 65 + d]; }
#pragma unroll
      for (int i = 0; i < 4; ++i)
#pragma unroll
        for (int j = 0; j < 4; ++j) acc[i][j] += qv[i] * kv[j];
    }
    __syncthreads();
#pragma unroll
    for (int i = 0; i < 4; ++i) {
      const int t = ty * 4 + i;
      const float Ft = s_F[t], mt = s_mt[t];
#pragma unroll
      for (int j = 0; j < 4; ++j) {
        const int s = tx * 4 + j;
        float v = (s <= t) ? acc[i][j] * expf(Ft + s_a[s] - mt) : 0.f;
        s_k[t * 65 + s] = v;
      }
    }
    __syncthreads();
    if (tid < 64) {
      float den = 0.f, qn = 0.f;
      for (int s = 0; s < 64; ++s) { den += s_k[tid * 65 + s]; qn += s_q[tid * 65 + s] * s_n[s]; }
      s_den[tid] = den + s_iw[tid] * qn;
    }
    float num[4][4], qc[4][4];
#pragma unroll
    for (int i = 0; i < 4; ++i)
#pragma unroll
      for (int j = 0; j < 4; ++j) { num[i][j] = 0.f; qc[i][j] = 0.f; }
    for (int s = 0; s < 64; ++s) {
      float4 v4 = *reinterpret_cast<const float4*>(s_v + s * 64 + tx * 4);
      float4 c4 = *reinterpret_cast<const float4*>(s_C + s * 64 + tx * 4);
#pragma unroll
      for (int i = 0; i < 4; ++i) {
        float sw = s_k[(ty * 4 + i) * 65 + s], qq = s_q[(ty * 4 + i) * 65 + s];
        num[i][0] += sw * v4.x; num[i][1] += sw * v4.y; num[i][2] += sw * v4.z; num[i][3] += sw * v4.w;
        qc[i][0] += qq * c4.x; qc[i][1] += qq * c4.y; qc[i][2] += qq * c4.z; qc[i][3] += qq * c4.w;
      }
    }
    __syncthreads();
#pragma unroll
    for (int i = 0; i < 4; ++i) {
      const int t = ty * 4 + i;
      const float iw = s_iw[t];
      const float dn = fmaxf(fabsf(s_den[t]), expf(-s_mt[t]));
      float hv[4]; float ss = 0.f;
#pragma unroll
      for (int j = 0; j < 4; ++j) { hv[j] = (num[i][j] + iw * qc[i][j]) / dn; ss += hv[j] * hv[j]; }
      ss = row16_sum(ss);
      const float rn = rsqrtf(ss * (1.f / 64.f) + EPS);
      const int ch = h * 64 + tx * 4;
      const size_t tg = (size_t)(token0 + t);
      float4 g4 = *reinterpret_cast<const float4*>(p.ml_norm_g() + l * 256 + ch);
      float4 k4 = *reinterpret_cast<const float4*>(p.ml_skip() + l * 256 + ch);
      float4 c4 = *reinterpret_cast<const float4*>(p.cc() + tg * 256 + ch);
      float4 o4 = *reinterpret_cast<const float4*>(p.P5() + tg * 1280 + 512 + ch);
      float r0 = (hv[0] * rn * g4.x + k4.x * c4.x) * sigmoidf_(o4.x);
      float r1 = (hv[1] * rn * g4.y + k4.y * c4.y) * sigmoidf_(o4.y);
      float r2 = (hv[2] * rn * g4.z + k4.z * c4.z) * sigmoidf_(o4.z);
      float r3 = (hv[3] * rn * g4.w + k4.w * c4.w) * sigmoidf_(o4.w);
      *reinterpret_cast<uint2*>(p.xn() + tg * 1024 + 512 + ch) = make_uint2(pack2(r0, r1), pack2(r2, r3));
    }
  }
}

__device__ __forceinline__ void ph_cmlp(const Params& p, int l, char* smem, int bid, int nblk) {
  const int tid = tid_opaque(), lane = tid & 63, w = tid >> 6;
  float* s_vg = reinterpret_cast<float*>(smem);
  float* s_ws = s_vg + 128 * 64;
  float* s_r = s_ws + 128 * 33;
  for (int u = bid; u < 544; u += nblk) {
    const int g = u & 3, ci = u >> 2;
    const bool samp = ci >= 128;
    const int L = samp ? 64 : 128;
    const int token0 = samp ? NPROMPT + (ci - 128) * 64 : ci * 128;
    __syncthreads();
    for (int r = w; r < L; r += 4) {
      float4 v = *reinterpret_cast<const float4*>(p.P5() + (size_t)(token0 + r) * 1280 + 1024 + lane * 4);
      float ss = v.x * v.x + v.y * v.y + v.z * v.z + v.w * v.w;
      ss = wave_sum(ss);
      if (lane == 0) s_r[r] = rsqrtf(ss * (1.f / 256.f) + EPS);
    }
    __syncthreads();
    for (int i = tid; i < L * 16; i += 256) {
      int s = i >> 4, d4 = (i & 15) * 4;
      float4 v = *reinterpret_cast<const float4*>(p.P5() + (size_t)(token0 + s) * 1280 + 1024 + g * 64 + d4);
      float4 gn = *reinterpret_cast<const float4*>(p.cm_norm_g() + l * 256 + g * 64 + d4);
      float r = s_r[s];
      float4 o = make_float4(v.x * r * gn.x, v.y * r * gn.y, v.z * r * gn.z, v.w * r * gn.w);
      *reinterpret_cast<float4*>(s_vg + s * 64 + d4) = o;
      if (samp) {
        int ts = token0 - NPROMPT + s;
        *reinterpret_cast<float4*>(p.out + O_CMV_S + (size_t)l * (512 * 256) + (size_t)ts * 256 + g * 64 + d4) = o;
      }
    }
    const int ty = tid >> 4, tx = tid & 15;
    float acc[8][4];
#pragma unroll
    for (int i = 0; i < 8; ++i)
#pragma unroll
      for (int j = 0; j < 4; ++j) acc[i][j] = 0.f;
    const float* wsg = p.cm_ws() + (size_t)(l * 4 + g) * 128 * 128;
    for (int s0 = 0; s0 < L; s0 += 32) {
      __syncthreads();
      for (int i = tid; i < L * 32; i += 256) {
        int t = i >> 5, ss = i & 31;
        s_ws[t * 33 + ss] = (s0 + ss <= t) ? wsg[t * 128 + s0 + ss] : 0.f;
      }
      __syncthreads();
      if (ty * 8 < L) {
        for (int ss = 0; ss < 32; ++ss) {
          float4 v4 = *reinterpret_cast<const float4*>(s_vg + (s0 + ss) * 64 + tx * 4);
#pragma unroll
          for (int i = 0; i < 8; ++i) {
            float wv = s_ws[(ty * 8 + i) * 33 + ss];
            acc[i][0] += wv * v4.x; acc[i][1] += wv * v4.y; acc[i][2] += wv * v4.z; acc[i][3] += wv * v4.w;
          }
        }
      }
    }
    if (ty * 8 < L) {
#pragma unroll
      for (int i = 0; i < 8; ++i) {
        const int t = ty * 8 + i;
        const float bb = p.cm_b()[(l * 4 + g) * 128 + t];
        const size_t tg = (size_t)(token0 + t);
        float4 u4 = *reinterpret_cast<const float4*>(p.P5() + tg * 1280 + 768 + g * 64 + tx * 4);
        *reinterpret_cast<uint2*>(p.xn() + tg * 1024 + 768 + g * 64 + tx * 4) =
            make_uint2(pack2(u4.x * (acc[i][0] + bb), u4.y * (acc[i][1] + bb)), pack2(u4.z * (acc[i][2] + bb), u4.w * (acc[i][3] + bb)));
      }
    }
  }
}

__device__ __forceinline__ int mono_key(float v) { int b = __float_as_int(v); return b ^ ((b >> 31) & 0x7FFFFFFF); }
__device__ __forceinline__ float mono_val(int k) { int b = k ^ ((k >> 31) & 0x7FFFFFFF); return __int_as_float(b); }

#define INS16(L, kv)                                   \
  {                                                    \
    int _v = (kv);                                     \
    _Pragma("unroll") for (int _j = 0; _j < 16; ++_j) { \
      int _t = max(L[_j], _v);                         \
      _v = min(L[_j], _v);                             \
      L[_j] = _t;                                      \
    }                                                  \
  }

__device__ __forceinline__ void ph_topk(const Params& p, int l, char* smem, int bid, int nblk) {
  const int tid = tid_opaque(), lane = tid & 63, w = tid >> 6;
  float* s_tile = reinterpret_cast<float*>(smem) + w * (64 * 33);
  int* s_list = reinterpret_cast<int*>(smem + 4 * 64 * 33 * 4) + w * (2 * 16 * 64);
  float* s_ss = reinterpret_cast<float*>(smem + 4 * 64 * 33 * 4 + 4 * 2 * 16 * 64 * 4) + w * 64;
  for (int u = bid * 4 + w; u < 264 * 8; u += nblk * 4) {
    const int tg = u >> 3, h = u & 7;
    const int t0 = tg * 64;
#pragma unroll 2
    for (int i = 0; i < 32; ++i) {
      const int tt = 2 * i + (lane >> 5);
      uint4 qv = *reinterpret_cast<const uint4*>(p.qp() + (size_t)(t0 + tt) * 2048 + h * 256 + (lane & 31) * 8);
      float a0 = bf_lo(qv.x), a1 = bf_hi(qv.x), a2 = bf_lo(qv.y), a3 = bf_hi(qv.y);
      float a4 = bf_lo(qv.z), a5 = bf_hi(qv.z), a6 = bf_lo(qv.w), a7 = bf_hi(qv.w);
      float ss = a0 * a0 + a1 * a1 + a2 * a2 + a3 * a3 + a4 * a4 + a5 * a5 + a6 * a6 + a7 * a7;
      ss = swap16_sum(row16_sum(ss));
      if ((lane & 31) == 0) s_ss[tt] = ss;
    }
    int L1[16], L2[16];
#pragma unroll
    for (int j = 0; j < 16; ++j) { L1[j] = (int)0x80000000; L2[j] = (int)0x80000000; }
#pragma unroll
    for (int c = 0; c < 2; ++c) {
#pragma unroll 1
      for (int ps = 0; ps < 4; ++ps) {
        const float* src = p.sc() + (size_t)t0 * 2048 + h * 256 + c * 128 + ps * 32;
#pragma unroll
        for (int j = 0; j < 8; ++j) {
          int tt = (lane >> 3) + 8 * j, f4 = lane & 7;
          float4 v = *reinterpret_cast<const float4*>(src + (size_t)tt * 2048 + f4 * 4);
          float* d = s_tile + tt * 33 + f4 * 4;
          d[0] = v.x; d[1] = v.y; d[2] = v.z; d[3] = v.w;
        }
#pragma unroll 4
        for (int s = 0; s < 32; ++s) {
          float v = s_tile[lane * 33 + s];
          int key = (mono_key(v) & ~127) | (127 - (ps * 32 + s));
          if (c == 0) INS16(L1, key) else INS16(L2, key)
        }
      }
    }
#pragma unroll
    for (int j = 0; j < 16; ++j) { s_list[(0 * 16 + j) * 64 + lane] = 127 - (L1[j] & 127); s_list[(1 * 16 + j) * 64 + lane] = 127 - (L2[j] & 127); }
    float v1[16], v2[16];
#pragma unroll
    for (int j = 0; j < 16; ++j) { v1[j] = mono_val(L1[j] & ~127); v2[j] = mono_val(L2[j] & ~127); }
    int LC[16];
#pragma unroll
    for (int j = 0; j < 16; ++j) LC[j] = (int)0x80000000;
#pragma unroll
    for (int i = 0; i < 16; ++i)
#pragma unroll
      for (int j = 0; j < 16; ++j)
        if ((i + 1) * (j + 1) <= 16) {
          int key = (mono_key(v1[i] + v2[j]) & ~255) | (255 - (i * 16 + j));
          INS16(LC, key)
        }
    const float scale = rsqrtf(s_ss[lane] * (1.f / 256.f) + EPS);
    float vs[16]; float den = 0.f;
    const float top = mono_val(LC[0] & ~255);
#pragma unroll
    for (int k = 0; k < 16; ++k) { vs[k] = __expf((mono_val(LC[k] & ~255) - top) * scale); den += vs[k]; }
    const float inv = 1.f / den;
    const size_t ob = (size_t)(t0 + lane) * 128 + h * 16;
#pragma unroll
    for (int k4 = 0; k4 < 4; ++k4) {
      int ee[4]; float gg[4];
#pragma unroll
      for (int q = 0; q < 4; ++q) {
        int k = k4 * 4 + q;
        int ci = 255 - (LC[k] & 255);
        int i1 = s_list[(0 * 16 + (ci >> 4)) * 64 + lane];
        int i2 = s_list[(1 * 16 + (ci & 15)) * 64 + lane];
        ee[q] = i1 * 128 + i2; gg[q] = vs[k] * inv;
      }
      *reinterpret_cast<int4*>(p.eidx() + ob + k4 * 4) = make_int4(ee[0], ee[1], ee[2], ee[3]);
      *reinterpret_cast<float4*>(p.egate() + ob + k4 * 4) = make_float4(gg[0], gg[1], gg[2], gg[3]);
    }
  }
}

__device__ __forceinline__ float dot8(uint4 a, uint4 b, float acc) {
  acc = __builtin_amdgcn_fdot2_f32_bf16(*reinterpret_cast<bf16x2*>(&a.x), *reinterpret_cast<bf16x2*>(&b.x), acc, false);
  acc = __builtin_amdgcn_fdot2_f32_bf16(*reinterpret_cast<bf16x2*>(&a.y), *reinterpret_cast<bf16x2*>(&b.y), acc, false);
  acc = __builtin_amdgcn_fdot2_f32_bf16(*reinterpret_cast<bf16x2*>(&a.z), *reinterpret_cast<bf16x2*>(&b.z), acc, false);
  acc = __builtin_amdgcn_fdot2_f32_bf16(*reinterpret_cast<bf16x2*>(&a.w), *reinterpret_cast<bf16x2*>(&b.w), acc, false);
  return acc;
}
__device__ __forceinline__ void axpy8(float* y, float wgt, uint4 v) {
  y[0] += wgt * bf_lo(v.x); y[1] += wgt * bf_hi(v.x); y[2] += wgt * bf_lo(v.y); y[3] += wgt * bf_hi(v.y);
  y[4] += wgt * bf_lo(v.z); y[5] += wgt * bf_hi(v.z); y[6] += wgt * bf_lo(v.w); y[7] += wgt * bf_hi(v.w);
}

__device__ __forceinline__ void ph_gather(const Params& p, int l, int bid, int nblk) {
  const int lane = tid_opaque() & 63, w = tid_opaque() >> 6;
  const bf16_t* ubl = p.ub() + (size_t)l * 16384 * 1024;
  const bf16_t* vbl = p.vb() + (size_t)l * 16384 * 1024;
  for (int t = bid * 4 + w; t < NTOK; t += nblk * 4) {
    const uint4 xa = *reinterpret_cast<const uint4*>(p.xn() + (size_t)t * 1024 + lane * 8);
    const uint4 xb = *reinterpret_cast<const uint4*>(p.xn() + (size_t)t * 1024 + 512 + lane * 8);
    const int e_lo = p.eidx()[(size_t)t * 128 + lane], e_hi = p.eidx()[(size_t)t * 128 + 64 + lane];
    const float g_lo = p.egate()[(size_t)t * 128 + lane], g_hi = p.egate()[(size_t)t * 128 + 64 + lane];
    float y[16];
#pragma unroll
    for (int i = 0; i < 16; ++i) y[i] = 0.f;
    for (int k0 = 0; k0 < 128; k0 += 4) {
      uint4 ua[4], ubv[4], va[4], vbv[4]; float gt[4];
#pragma unroll
      for (int q = 0; q < 4; ++q) {
        const int k = k0 + q;
        const int e = (k < 64) ? __shfl(e_lo, k) : __shfl(e_hi, k - 64);
        gt[q] = (k < 64) ? __shfl(g_lo, k) : __shfl(g_hi, k - 64);
        const bf16_t* ur = ubl + (size_t)e * 1024 + lane * 8;
        const bf16_t* vr = vbl + (size_t)e * 1024 + lane * 8;
        ua[q] = *reinterpret_cast<const uint4*>(ur);
        ubv[q] = *reinterpret_cast<const uint4*>(ur + 512);
        va[q] = *reinterpret_cast<const uint4*>(vr);
        vbv[q] = *reinterpret_cast<const uint4*>(vr + 512);
      }
#pragma unroll
      for (int q = 0; q < 4; ++q) {
        float d = dot8(xa, ua[q], 0.f);
        d = dot8(xb, ubv[q], d);
        d = wave_sum(d);
        const float wgt = gt[q] * gelu_exact(d);
        axpy8(y, wgt, va[q]);
        axpy8(y + 8, wgt, vbv[q]);
      }
    }
    float* xr = p.x() + (size_t)t * 1024;
    float4 a0 = *reinterpret_cast<float4*>(xr + lane * 8), a1 = *reinterpret_cast<float4*>(xr + lane * 8 + 4);
    float4 b0 = *reinterpret_cast<float4*>(xr + 512 + lane * 8), b1 = *reinterpret_cast<float4*>(xr + 512 + lane * 8 + 4);
    a0.x += y[0]; a0.y += y[1]; a0.z += y[2]; a0.w += y[3]; a1.x += y[4]; a1.y += y[5]; a1.z += y[6]; a1.w += y[7];
    b0.x += y[8]; b0.y += y[9]; b0.z += y[10]; b0.w += y[11]; b1.x += y[12]; b1.y += y[13]; b1.z += y[14]; b1.w += y[15];
    *reinterpret_cast<float4*>(xr + lane * 8) = a0; *reinterpret_cast<float4*>(xr + lane * 8 + 4) = a1;
    *reinterpret_cast<float4*>(xr + 512 + lane * 8) = b0; *reinterpret_cast<float4*>(xr + 512 + lane * 8 + 4) = b1;
  }
}

enum { PH_PREP = 0, PH_NORM1, PH_GEMM_IN, PH_ATTN, PH_MLCONV, PH_MCHAIN, PH_MLU, PH_MLSCAN, PH_MLOUT, PH_CMLP,
       PH_GEMM_OUT, PH_NORM2, PH_GEMM_PQ, PH_GEMM_SC, PH_TOPK, PH_GATHER, PH_FINAL };

__device__ __forceinline__ Params phase_params(const Params& kp, bool with_inputs) {
  Params q;
  size_t z = 0;
  asm volatile("" : "+s"(z));
  q.out = kp.out + z;
  q.ws = kp.ws + z;
  q.in[0] = kp.in[0] + z;
  q.in[1] = kp.in[1] + z;
  if (with_inputs) {
#pragma unroll
    for (int i = 2; i < 30; ++i) q.in[i] = kp.in[i] + z;
  }
  return q;
}


#define XB_TMO      128
#define XB_XCNT(j)  (256  + 64 * (j))
#define XB_XSUB(j)  (1280 + 64 * (j))
#define XB_XGEN(j)  (2304 + 64 * (j))
#define XB_TOP      3328
#define XB_TOPGEN   3392
#define XCD_BAR_WORDS 3456
#define XB_SPIN_CAP (1u << 22)
#define LAS __attribute__((address_space(3)))
__device__ __forceinline__ unsigned xb_ld(unsigned* p)              { return __hip_atomic_load(p, __ATOMIC_RELAXED, __HIP_MEMORY_SCOPE_AGENT); }
__device__ __forceinline__ unsigned xb_add(unsigned* p, unsigned v) { return __hip_atomic_fetch_add(p, v, __ATOMIC_RELAXED, __HIP_MEMORY_SCOPE_AGENT); }
__device__ __forceinline__ unsigned xb_xcc_id() { return (unsigned)__builtin_amdgcn_s_getreg((3 << 11) | 20) & 0xFu; }
#define XB_SPIN(cond, bar) do { unsigned _sp = 0; while (cond) { __builtin_amdgcn_s_sleep(1); \
    if ((++_sp & 255u) == 0u) { if (xb_ld(&(bar)[XB_TMO])) break; if (_sp > XB_SPIN_CAP) { atomicAdd(&(bar)[XB_TMO], 1u); break; } } } } while (0)

struct XcdBarrier { unsigned* bar; unsigned x; volatile LAS unsigned* st; };

__device__ __forceinline__ XcdBarrier xcd_barrier_post(unsigned* bar, volatile LAS unsigned* st) {
  XcdBarrier b; b.bar = bar; b.x = xb_xcc_id(); b.st = st;
  if (threadIdx.x == 0) (void)xb_add(&bar[XB_XCNT(b.x)], 1u);
  return b;
}
__device__ __forceinline__ void xcd_barrier_complete(unsigned* bar, unsigned x, unsigned& nloc, unsigned& nx) {
  const unsigned G = gridDim.x * gridDim.y * gridDim.z;
  unsigned sum, cnt, mine, sp = 0u;
  for (;;) {
    sum = 0u; cnt = 0u; mine = 0u;
#pragma unroll
    for (unsigned j = 0; j < 16; ++j) { const unsigned c = xb_ld(&bar[XB_XCNT(j)]); sum += c; cnt += (c > 0u) ? 1u : 0u; mine = (j == x) ? c : mine; }
    if (sum == G) break;
    __builtin_amdgcn_s_sleep(1);
    if ((++sp & 255u) == 0u) { if (xb_ld(&bar[XB_TMO])) break; if (sp > XB_SPIN_CAP) { atomicAdd(&bar[XB_TMO], 1u); break; } }
  }
  nloc = mine > 0u ? mine : 1u; nx = cnt > 0u ? cnt : 1u;
}
__device__ __forceinline__ void xcd_barrier(const XcdBarrier& b) {
  asm volatile("s_waitcnt vmcnt(0)" ::: "memory");
  __syncthreads();
  if (threadIdx.x == 0) {
    unsigned* bar = b.bar;
    __builtin_amdgcn_s_waitcnt(0);
    unsigned nloc = b.st[0], nx = b.st[1];
    if (nloc == 0u) { xcd_barrier_complete(bar, b.x, nloc, nx); b.st[0] = nloc; b.st[1] = nx; }
    const unsigned old = xb_add(&bar[XB_XSUB(b.x)], 1u);
    const unsigned gen = old / nloc;
    if (old + 1u == (gen + 1u) * nloc) {
      __builtin_amdgcn_fence(__ATOMIC_RELEASE, "agent");
      asm volatile("s_waitcnt vmcnt(0)" ::: "memory");
      const unsigned og = xb_add(&bar[XB_TOP], 1u);
      const unsigned tg = og / nx;
      if (og + 1u == (tg + 1u) * nx) xb_add(&bar[XB_TOPGEN], 1u);
      else XB_SPIN(xb_ld(&bar[XB_TOPGEN]) == tg, bar);
      __builtin_amdgcn_fence(__ATOMIC_ACQUIRE, "agent");
      xb_add(&bar[XB_XGEN(b.x)], 1u);
      asm volatile("s_waitcnt vmcnt(0)" ::: "memory");
    } else {
      XB_SPIN(xb_ld(&bar[XB_XGEN(b.x)]) == gen, bar);
      __builtin_amdgcn_fence(__ATOMIC_ACQUIRE, "agent");
      asm volatile("s_waitcnt vmcnt(0)" ::: "memory");
    }
  }
  __syncthreads();
}

#define GSYNC() xcd_barrier(xb)
#define PP(wi) phase_params(p, wi)
#define BN bid_opaque(bid), nblk_opaque(nblk)

template <int L>
__device__ __forceinline__ void layer_phases(const Params& p, char* smem, const XcdBarrier& xb, int bid, int nblk) {
  ph_rmsnorm<0>(PP(false), L, BN);
  GSYNC();
  ph_gemm<EPI_WIN>(PP(false), L, smem, BN);
  GSYNC();
  ph_attn(PP(false), L, smem, BN);
  ph_mlconv(PP(false), L, smem, BN);
  ph_mchain(PP(false), L, BN);
  ph_cmlp(PP(false), L, smem, BN);
  GSYNC();
  ph_mlU(PP(false), L, smem, BN);
  GSYNC();
  ph_mlscan(PP(false), L, BN);
  GSYNC();
  ph_mlout(PP(false), L, smem, BN);
  GSYNC();
  ph_gemm<EPI_WOUT>(PP(false), L, smem, BN);
  GSYNC();
  ph_rmsnorm<1>(PP(false), L, BN);
  GSYNC();
  ph_gemm<EPI_PQ>(PP(false), L, smem, BN);
  GSYNC();
  ph_gemm<EPI_SC>(PP(false), L, smem, BN);
  GSYNC();
  ph_topk(PP(false), L, smem, BN);
  GSYNC();
  ph_gather(PP(false), L, BN);
  GSYNC();
}

__global__ void __launch_bounds__(256, 2) mega_kernel(Params p) {
  __shared__ __attribute__((aligned(16))) char smem[SMEM_BYTES];
  __shared__ uint4 xb_words;
  cg::grid_group grid = cg::this_grid();
  const int bid = blockIdx.x, nblk = gridDim.x;
  if (threadIdx.x == 0) xb_words = make_uint4(0u, 0u, 0u, 0u);
  __syncthreads();
  XcdBarrier xb = xcd_barrier_post(reinterpret_cast<unsigned*>(p.ws), (volatile LAS unsigned*)&xb_words);
  grid.sync();
  ph_prep(PP(true), smem, BN);
  GSYNC();
  layer_phases<0>(p, smem, xb, bid, nblk);
  layer_phases<1>(p, smem, xb, bid, nblk);
  ph_rmsnorm<2>(PP(false), 0, BN);
}

static inline size_t align_up(size_t v, size_t a) { return (v + a - 1) / a * a; }

extern "C" void kernel_launch(void* const* d_in, const int* in_sizes, int n_in, void* d_out, int out_size, void* d_ws,
                              size_t ws_size, hipStream_t stream) {
  Params p{};
  for (int i = 0; i < 30; ++i) p.in[i] = reinterpret_cast<const float*>(d_in[i]);
  p.out = reinterpret_cast<float*>(d_out);
  p.ws = reinterpret_cast<char*>(d_ws);
  if (WS_NEED > ws_size) { fprintf(stderr, "workspace too small: need %zu have %zu\n", (size_t)WS_NEED, ws_size); return; }
  static int grid_blocks = 0;
  if (!grid_blocks) {
    int dev = 0, cus = 0, per_cu = 0;
    hipGetDevice(&dev);
    hipDeviceGetAttribute(&cus, hipDeviceAttributeMultiprocessorCount, dev);
    hipOccupancyMaxActiveBlocksPerMultiprocessor(&per_cu, mega_kernel, 256, 0);
    if (per_cu > 2) per_cu = 2;
    if (per_cu < 1) per_cu = 1;
    grid_blocks = cus * per_cu;
  }
  hipMemsetAsync(d_ws, 0, 16384, stream);
  void* args[] = {&p};
  hipError_t e = hipLaunchCooperativeKernel((void*)mega_kernel, dim3(grid_blocks), dim3(256), args, 0, stream);
  if (e != hipSuccess) fprintf(stderr, "cooperative launch failed: %s (grid %d)\n", hipGetErrorString(e), grid_blocks);
}
```

```cpp
#include <hip/hip_runtime.h>
#include <hip/hip_cooperative_groups.h>
#include <cstdio>
#include <cstdint>

namespace cg = cooperative_groups;

typedef unsigned short bf16_t;
typedef __attribute__((ext_vector_type(8))) __bf16 bf16x8;
typedef __attribute__((ext_vector_type(2))) __bf16 bf16x2;
typedef __attribute__((ext_vector_type(16))) float f32x16;
typedef __attribute__((ext_vector_type(2))) float f32x2;

#define D_MODEL 1024
#define NTOK 16896
#define NPROMPT 16384
#define SEQ 4096
#define NIN 2816
#define EPS 1e-6f
#define LOG2E 1.4426950408889634f
#define SKEYS 1088
#define NCU_UNITS 1056

constexpr size_t O_Y_P = 0;
constexpr size_t O_Y_S = O_Y_P + 16777216;
constexpr size_t O_K_P = O_Y_S + 524288;
constexpr size_t O_V_P = O_K_P + 16777216;
constexpr size_t O_C_P = O_V_P + 16777216;
constexpr size_t O_N_P = O_C_P + 131072;
constexpr size_t O_M_P = O_N_P + 2048;
constexpr size_t O_CONV_P = O_M_P + 32;
constexpr size_t O_K_S = O_CONV_P + 6144;
constexpr size_t O_V_S = O_K_S + 524288;
constexpr size_t O_C_S = O_V_S + 524288;
constexpr size_t O_N_S = O_C_S + 262144;
constexpr size_t O_M_S = O_N_S + 4096;
constexpr size_t O_CONV_S = O_M_S + 64;
constexpr size_t O_CMV_S = O_CONV_S + 12288;

constexpr size_t al256(size_t v) { return (v + 255) / 256 * 256; }
constexpr int SP_st_c = 0;
constexpr int SP_st_n = 262144;
constexpr int SP_st_m = 266240;
constexpr int SP_st_conv = 266304;
constexpr int SP_norm1_g = 278592;
constexpr int SP_da_subln_g = 280640;
constexpr int SP_ml_conv_w = 280896;
constexpr int SP_ml_conv_b = 282944;
constexpr int SP_ml_wq = 283456;
constexpr int SP_ml_wk = 316224;
constexpr int SP_ml_gate_b = 348992;
constexpr int SP_ml_norm_g = 349056;
constexpr int SP_ml_skip = 349568;
constexpr int SP_cm_norm_g = 350080;
constexpr int SP_cm_ws = 350592;
constexpr int SP_cm_b = 481664;
constexpr int SP_norm2_g = 482688;
constexpr int SP_final_g = 484736;
constexpr int SP_TOTAL = 485760;
constexpr size_t WS_bar = 0;
constexpr size_t WS_lam = al256(WS_bar + 16384);
constexpr size_t WS_lut = al256(WS_lam + (256));
constexpr size_t WS_sp = al256(WS_lut + (4*256*4));
constexpr size_t WS_wt_in = al256(WS_sp + (SP_TOTAL*4));
constexpr size_t WS_wg = al256(WS_wt_in + ((size_t)2*NIN*1024*2));
constexpr size_t WS_wt_out = al256(WS_wg + ((size_t)2*8*1024*4));
constexpr size_t WS_wt_pq = al256(WS_wt_out + ((size_t)2*1024*1024*2));
constexpr size_t WS_keysb = al256(WS_wt_pq + ((size_t)2*2048*1024*2));
constexpr size_t WS_ub8 = al256(WS_keysb + ((size_t)2*16*128*128*2));
constexpr size_t WS_vb8 = al256(WS_ub8 + ((size_t)2*16384*1024));
constexpr size_t WS_us = al256(WS_vb8 + ((size_t)2*16384*1024));
constexpr size_t WS_vs = al256(WS_us + ((size_t)2*16384*4));
constexpr size_t WS_Kbs = al256(WS_vs + ((size_t)2*16384*4));
constexpr size_t WS_Vts = al256(WS_Kbs + ((size_t)2*8*SKEYS*512*2));
constexpr size_t WS_x = al256(WS_Vts + ((size_t)2*8*4*128*SKEYS*2));
constexpr size_t WS_xn = al256(WS_x + ((size_t)NTOK*1024*4));
constexpr size_t WS_R0 = al256(WS_xn + ((size_t)NTOK*1024*2));
constexpr size_t WS_R0x = WS_R0;
constexpr size_t WS_Qb = al256(WS_R0x + (0));
constexpr size_t WS_Kb = al256(WS_Qb + ((size_t)NTOK*512*2));
constexpr size_t WS_Vt = al256(WS_Kb + ((size_t)NPROMPT*512*2));
constexpr size_t WS_P5 = al256(WS_Vt + ((size_t)16*128*SEQ*2));
constexpr size_t WS_ig = al256(WS_P5 + ((size_t)NTOK*1280*4));
constexpr size_t WS_lf = al256(WS_ig + ((size_t)NTOK*4*4));
constexpr size_t WS_Fc = al256(WS_lf + ((size_t)NTOK*4*4));
constexpr size_t WS_cc = al256(WS_Fc + ((size_t)NTOK*4*4));
constexpr size_t WS_qm = al256(WS_cc + ((size_t)NTOK*256*4));
constexpr size_t WS_km = al256(WS_qm + ((size_t)NTOK*256*4));
constexpr size_t WS_mst = al256(WS_km + ((size_t)NTOK*256*4));
constexpr size_t WS_mnx = al256(WS_mst + (NCU_UNITS*4));
constexpr size_t WS_wcs = al256(WS_mnx + (NCU_UNITS*4));
constexpr size_t WS_FLs = al256(WS_wcs + (NCU_UNITS*4));
constexpr size_t WS_U = al256(WS_FLs + (NCU_UNITS*4));
constexpr size_t WS_un = al256(WS_U + ((size_t)NCU_UNITS*4096*4));
constexpr size_t WS_Cst = al256(WS_un + ((size_t)NCU_UNITS*64*4));
constexpr size_t WS_nst = al256(WS_Cst + ((size_t)NCU_UNITS*4096*4));
constexpr size_t WS_END_MIXER = al256(WS_nst + ((size_t)NCU_UNITS*64*4));
constexpr size_t WS_qp = al256(WS_R0x + (0));
constexpr size_t WS_sc = al256(WS_qp + ((size_t)NTOK*2048*2));
constexpr size_t WS_eidx = al256(WS_sc + ((size_t)NTOK*2048*4));
constexpr size_t WS_egate = al256(WS_eidx + ((size_t)NTOK*128*4));
constexpr size_t WS_esu = al256(WS_egate + ((size_t)NTOK*128*4));
constexpr size_t WS_END_PEER = al256(WS_esu + ((size_t)NTOK*128*4));
constexpr size_t WS_NEED = WS_END_MIXER > WS_END_PEER ? WS_END_MIXER : WS_END_PEER;

struct Params {
  const float* in[30];
  float* out;
  char* ws;
  __device__ __forceinline__ const float* x_prompt() const { return in[0]; }
  __device__ __forceinline__ const float* x_sample() const { return in[1]; }
  __device__ __forceinline__ const float* cache_k() const { return in[2]; }
  __device__ __forceinline__ const float* cache_v() const { return in[3]; }
  __device__ __forceinline__ const float* w_in() const { return in[9]; }
  __device__ __forceinline__ const float* da_lambda() const { return in[10]; }
  __device__ __forceinline__ const float* rel_table() const { return in[12]; }
  __device__ __forceinline__ const float* w_out() const { return in[23]; }
  __device__ __forceinline__ const float* peer_wq() const { return in[25]; }
  __device__ __forceinline__ const float* peer_keys() const { return in[26]; }
  __device__ __forceinline__ const float* peer_u() const { return in[27]; }
  __device__ __forceinline__ const float* peer_v() const { return in[28]; }
  __device__ __forceinline__ const float* st_c() const { return reinterpret_cast<const float*>(ws + WS_sp) + SP_st_c; }
  __device__ __forceinline__ const float* st_n() const { return reinterpret_cast<const float*>(ws + WS_sp) + SP_st_n; }
  __device__ __forceinline__ const float* st_m() const { return reinterpret_cast<const float*>(ws + WS_sp) + SP_st_m; }
  __device__ __forceinline__ const float* st_conv() const { return reinterpret_cast<const float*>(ws + WS_sp) + SP_st_conv; }
  __device__ __forceinline__ const float* norm1_g() const { return reinterpret_cast<const float*>(ws + WS_sp) + SP_norm1_g; }
  __device__ __forceinline__ const float* da_subln_g() const { return reinterpret_cast<const float*>(ws + WS_sp) + SP_da_subln_g; }
  __device__ __forceinline__ const float* ml_conv_w() const { return reinterpret_cast<const float*>(ws + WS_sp) + SP_ml_conv_w; }
  __device__ __forceinline__ const float* ml_conv_b() const { return reinterpret_cast<const float*>(ws + WS_sp) + SP_ml_conv_b; }
  __device__ __forceinline__ const float* ml_wq() const { return reinterpret_cast<const float*>(ws + WS_sp) + SP_ml_wq; }
  __device__ __forceinline__ const float* ml_wk() const { return reinterpret_cast<const float*>(ws + WS_sp) + SP_ml_wk; }
  __device__ __forceinline__ const float* ml_gate_b() const { return reinterpret_cast<const float*>(ws + WS_sp) + SP_ml_gate_b; }
  __device__ __forceinline__ const float* ml_norm_g() const { return reinterpret_cast<const float*>(ws + WS_sp) + SP_ml_norm_g; }
  __device__ __forceinline__ const float* ml_skip() const { return reinterpret_cast<const float*>(ws + WS_sp) + SP_ml_skip; }
  __device__ __forceinline__ const float* cm_norm_g() const { return reinterpret_cast<const float*>(ws + WS_sp) + SP_cm_norm_g; }
  __device__ __forceinline__ const float* cm_ws() const { return reinterpret_cast<const float*>(ws + WS_sp) + SP_cm_ws; }
  __device__ __forceinline__ const float* cm_b() const { return reinterpret_cast<const float*>(ws + WS_sp) + SP_cm_b; }
  __device__ __forceinline__ const float* norm2_g() const { return reinterpret_cast<const float*>(ws + WS_sp) + SP_norm2_g; }
  __device__ __forceinline__ const float* final_g() const { return reinterpret_cast<const float*>(ws + WS_sp) + SP_final_g; }
  __device__ __forceinline__ float* lam() const { return reinterpret_cast<float*>(ws + WS_lam); }
  __device__ __forceinline__ float* lut() const { return reinterpret_cast<float*>(ws + WS_lut); }
  __device__ __forceinline__ float* sp() const { return reinterpret_cast<float*>(ws + WS_sp); }
  __device__ __forceinline__ bf16_t* wt_in() const { return reinterpret_cast<bf16_t*>(ws + WS_wt_in); }
  __device__ __forceinline__ float* wg() const { return reinterpret_cast<float*>(ws + WS_wg); }
  __device__ __forceinline__ bf16_t* wt_out() const { return reinterpret_cast<bf16_t*>(ws + WS_wt_out); }
  __device__ __forceinline__ bf16_t* wt_pq() const { return reinterpret_cast<bf16_t*>(ws + WS_wt_pq); }
  __device__ __forceinline__ bf16_t* keysb() const { return reinterpret_cast<bf16_t*>(ws + WS_keysb); }
  __device__ __forceinline__ unsigned char* ub8() const { return reinterpret_cast<unsigned char*>(ws + WS_ub8); }
  __device__ __forceinline__ unsigned char* vb8() const { return reinterpret_cast<unsigned char*>(ws + WS_vb8); }
  __device__ __forceinline__ float* us() const { return reinterpret_cast<float*>(ws + WS_us); }
  __device__ __forceinline__ float* vs() const { return reinterpret_cast<float*>(ws + WS_vs); }
  __device__ __forceinline__ bf16_t* Kbs() const { return reinterpret_cast<bf16_t*>(ws + WS_Kbs); }
  __device__ __forceinline__ bf16_t* Vts() const { return reinterpret_cast<bf16_t*>(ws + WS_Vts); }
  __device__ __forceinline__ float* x() const { return reinterpret_cast<float*>(ws + WS_x); }
  __device__ __forceinline__ bf16_t* xn() const { return reinterpret_cast<bf16_t*>(ws + WS_xn); }
  __device__ __forceinline__ bf16_t* Qb() const { return reinterpret_cast<bf16_t*>(ws + WS_Qb); }
  __device__ __forceinline__ bf16_t* Kb() const { return reinterpret_cast<bf16_t*>(ws + WS_Kb); }
  __device__ __forceinline__ bf16_t* Vt() const { return reinterpret_cast<bf16_t*>(ws + WS_Vt); }
  __device__ __forceinline__ float* P5() const { return reinterpret_cast<float*>(ws + WS_P5); }
  __device__ __forceinline__ float* ig() const { return reinterpret_cast<float*>(ws + WS_ig); }
  __device__ __forceinline__ float* lf() const { return reinterpret_cast<float*>(ws + WS_lf); }
  __device__ __forceinline__ float* Fc() const { return reinterpret_cast<float*>(ws + WS_Fc); }
  __device__ __forceinline__ float* cc() const { return reinterpret_cast<float*>(ws + WS_cc); }
  __device__ __forceinline__ float* qm() const { return reinterpret_cast<float*>(ws + WS_qm); }
  __device__ __forceinline__ float* km() const { return reinterpret_cast<float*>(ws + WS_km); }
  __device__ __forceinline__ float* mst() const { return reinterpret_cast<float*>(ws + WS_mst); }
  __device__ __forceinline__ float* mnx() const { return reinterpret_cast<float*>(ws + WS_mnx); }
  __device__ __forceinline__ float* wcs() const { return reinterpret_cast<float*>(ws + WS_wcs); }
  __device__ __forceinline__ float* FLs() const { return reinterpret_cast<float*>(ws + WS_FLs); }
  __device__ __forceinline__ float* U() const { return reinterpret_cast<float*>(ws + WS_U); }
  __device__ __forceinline__ float* un() const { return reinterpret_cast<float*>(ws + WS_un); }
  __device__ __forceinline__ float* Cst() const { return reinterpret_cast<float*>(ws + WS_Cst); }
  __device__ __forceinline__ float* nst() const { return reinterpret_cast<float*>(ws + WS_nst); }
  __device__ __forceinline__ bf16_t* qp() const { return reinterpret_cast<bf16_t*>(ws + WS_qp); }
  __device__ __forceinline__ float* sc() const { return reinterpret_cast<float*>(ws + WS_sc); }
  __device__ __forceinline__ int* eidx() const { return reinterpret_cast<int*>(ws + WS_eidx); }
  __device__ __forceinline__ float* egate() const { return reinterpret_cast<float*>(ws + WS_egate); }
  __device__ __forceinline__ float* esu() const { return reinterpret_cast<float*>(ws + WS_esu); }
};

__device__ __forceinline__ unsigned pack2(float a, float b) {
  f32x2 v = {a, b};
  bf16x2 r = __builtin_convertvector(v, bf16x2);
  return *reinterpret_cast<unsigned*>(&r);
}
__device__ __forceinline__ bf16_t f2bf(float a) { return (bf16_t)(pack2(a, 0.f) & 0xFFFFu); }
__device__ __forceinline__ float bf_lo(unsigned u) { return __uint_as_float(u << 16); }
__device__ __forceinline__ float bf_hi(unsigned u) { return __uint_as_float(u & 0xFFFF0000u); }
__device__ __forceinline__ float gelu_exact(float x) { return 0.5f * x * (1.f + erff(x * 0.70710678118654752f)); }
__device__ __forceinline__ float sigmoidf_(float x) { return 1.f / (1.f + __expf(-x)); }
template <int CTRL>
__device__ __forceinline__ float dpp_f(float v) {
  return __builtin_bit_cast(float, __builtin_amdgcn_update_dpp(0, __builtin_bit_cast(int, v), CTRL, 0xf, 0xf, true));
}
__device__ __forceinline__ float swap16_sum(float x) {
  auto s = __builtin_amdgcn_permlane16_swap(__float_as_uint(x), __float_as_uint(x), false, false);
  return __uint_as_float(s[0]) + __uint_as_float(s[1]);
}
__device__ __forceinline__ float swap32_sum(float x) {
  auto s = __builtin_amdgcn_permlane32_swap(__float_as_uint(x), __float_as_uint(x), false, false);
  return __uint_as_float(s[0]) + __uint_as_float(s[1]);
}
__device__ __forceinline__ float swap16_max(float x) {
  auto s = __builtin_amdgcn_permlane16_swap(__float_as_uint(x), __float_as_uint(x), false, false);
  return fmaxf(__uint_as_float(s[0]), __uint_as_float(s[1]));
}
__device__ __forceinline__ float swap32_max(float x) {
  auto s = __builtin_amdgcn_permlane32_swap(__float_as_uint(x), __float_as_uint(x), false, false);
  return fmaxf(__uint_as_float(s[0]), __uint_as_float(s[1]));
}
__device__ __forceinline__ float row16_sum(float v) {
  v += dpp_f<0xB1>(v); v += dpp_f<0x4E>(v); v += dpp_f<0x141>(v); v += dpp_f<0x140>(v);
  return v;
}
__device__ __forceinline__ float row16_max(float v) {
  v = fmaxf(v, dpp_f<0xB1>(v)); v = fmaxf(v, dpp_f<0x4E>(v)); v = fmaxf(v, dpp_f<0x141>(v)); v = fmaxf(v, dpp_f<0x140>(v));
  return v;
}
__device__ __forceinline__ float wave_sum(float v) { return swap32_sum(swap16_sum(row16_sum(v))); }
__device__ __forceinline__ float wave_max(float v) { return swap32_max(swap16_max(row16_max(v))); }
__device__ __forceinline__ const float* xrow_in(const Params& p, int l, int t) {
  if (l == 0) return (t < NPROMPT) ? p.x_prompt() + (size_t)t * D_MODEL : p.x_sample() + (size_t)(t - NPROMPT) * D_MODEL;
  return p.x() + (size_t)t * D_MODEL;
}
__device__ __forceinline__ bf16x8 as_bf16x8(uint4 v) { return *reinterpret_cast<bf16x8*>(&v); }

__device__ __forceinline__ int tid_opaque() { int t = threadIdx.x; asm volatile("" : "+v"(t)); return t; }
__device__ __forceinline__ int sgpr_opaque(int v) { asm volatile("" : "+s"(v)); return v; }
__device__ __forceinline__ int bid_opaque(int v) { asm volatile("" : "+s"(v)); __builtin_assume(v >= 0); __builtin_assume(v < 1024); return v; }
__device__ __forceinline__ int nblk_opaque(int v) { asm volatile("" : "+s"(v)); __builtin_assume(v >= 1); __builtin_assume(v <= 1024); return v; }
#define SMEM_BYTES 73728

__device__ __forceinline__ void transpose_tile(const float* __restrict__ src, int lds, bf16_t* __restrict__ dst, int K, int n0, int k0,
                               int gate_skip, float* tile  ) {
  const int tid = tid_opaque();
  const int c = tid & 63, r0 = tid >> 6;
  int n = n0 + c;
  int col = n + ((gate_skip && n >= 2304) ? 8 : 0);
#pragma unroll 4
  for (int j = 0; j < 16; ++j) {
    int r = r0 + 4 * j;
    tile[r * 65 + c] = src[(size_t)(k0 + r) * lds + col];
  }
  __syncthreads();
  const int nn = tid >> 2, kg = (tid & 3) * 16;
  unsigned w[8];
#pragma unroll
  for (int j = 0; j < 8; ++j) w[j] = pack2(tile[(kg + 2 * j) * 65 + nn], tile[(kg + 2 * j + 1) * 65 + nn]);
  uint4* d = reinterpret_cast<uint4*>(dst + (size_t)(n0 + nn) * K + k0 + kg);
  d[0] = make_uint4(w[0], w[1], w[2], w[3]);
  d[1] = make_uint4(w[4], w[5], w[6], w[7]);
  __syncthreads();
}

__device__ __forceinline__ int rel_bucket_dev(int rel) {
  int ret = rel > 0 ? 16 : 0;
  int n = rel < 0 ? -rel : rel;
  int b;
  if (n < 8) b = n;
  else if (n < 12) b = 8;
  else if (n < 16) b = 9;
  else if (n < 23) b = 10;
  else if (n < 32) b = 11;
  else if (n < 46) b = 12;
  else if (n < 64) b = 13;
  else if (n < 91) b = 14;
  else b = 15;
  return ret + b;
}

__device__ __forceinline__ void ph_prep(const Params& p, char* smem, int bid, int nblk) {
  const int tid = tid_opaque();
  float* tile = reinterpret_cast<float*>(smem);
  for (int u = bid; u < 2 * 1472; u += nblk) {
    int l = u / 1472, r = u % 1472;
    if (r < 704) {
      int nt = r / 16, kt = r % 16;
      transpose_tile(p.w_in() + (size_t)l * 1024 * 2824, 2824, p.wt_in() + (size_t)l * NIN * 1024, 1024, nt * 64, kt * 64, 1, tile);
    } else if (r < 960) {
      r -= 704; int nt = r / 16, kt = r % 16;
      transpose_tile(p.w_out() + (size_t)l * 1024 * 1024, 1024, p.wt_out() + (size_t)l * 1024 * 1024, 1024, nt * 64, kt * 64, 0, tile);
    } else {
      r -= 960; int nt = r / 16, kt = r % 16;
      transpose_tile(p.peer_wq() + (size_t)l * 1024 * 2048, 2048, p.wt_pq() + (size_t)l * 2048 * 1024, 1024, nt * 64, kt * 64, 0, tile);
    }
  }
  for (int u = bid; u < 1024; u += nblk) {
    int kt = u & 15, h = (u >> 4) & 3, b = (u >> 6) & 7, l = u >> 9;
    const float* src = p.cache_v() + (((size_t)(l * 8 + b) * 1024 + kt * 64) * 4 + h) * 128;
    {
      int c = tid & 127, r0 = tid >> 7;
      for (int j = 0; j < 32; ++j) { int r = r0 + 2 * j; tile[r * 129 + c] = src[(size_t)r * 512 + c]; }
    }
    __syncthreads();
    {
      int dv = tid >> 1, half = tid & 1;
      bf16_t* dst = p.Vts() + ((size_t)((l * 8 + b) * 4 + h) * 128 + dv) * SKEYS + kt * 64 + half * 32;
      unsigned w[16];
#pragma unroll
      for (int j = 0; j < 16; ++j) {
        int pos0 = half * 32 + 2 * j;
        int blk = (pos0 >> 2) & 3;
        int oblk = (blk == 1) ? 2 : (blk == 2 ? 1 : blk);
        int key0 = (pos0 & ~15) + oblk * 4 + (pos0 & 3);
        w[j] = pack2(tile[key0 * 129 + dv], tile[(key0 + 1) * 129 + dv]);
      }
      uint4* d4 = reinterpret_cast<uint4*>(dst);
      d4[0] = make_uint4(w[0], w[1], w[2], w[3]);
      d4[1] = make_uint4(w[4], w[5], w[6], w[7]);
      d4[2] = make_uint4(w[8], w[9], w[10], w[11]);
      d4[3] = make_uint4(w[12], w[13], w[14], w[15]);
    }
    __syncthreads();
  }
  const size_t gtid = (size_t)bid * 256 + tid, gsz = (size_t)nblk * 256;
  {
    const int lane = tid & 63, wv = tid >> 6;
    for (int r = bid * 4 + wv; r < 2 * 32768; r += nblk * 4) {
      const int tab = r >> 15, row = r & 32767;
      const float* src = (tab == 0 ? p.peer_u() : p.peer_v()) + (size_t)row * 1024 + lane * 16;
      float4 f0 = reinterpret_cast<const float4*>(src)[0], f1 = reinterpret_cast<const float4*>(src)[1];
      float4 f2 = reinterpret_cast<const float4*>(src)[2], f3 = reinterpret_cast<const float4*>(src)[3];
      float am = fmaxf(fmaxf(fmaxf(fabsf(f0.x), fabsf(f0.y)), fmaxf(fabsf(f0.z), fabsf(f0.w))),
                       fmaxf(fmaxf(fabsf(f1.x), fabsf(f1.y)), fmaxf(fabsf(f1.z), fabsf(f1.w))));
      am = fmaxf(am, fmaxf(fmaxf(fmaxf(fabsf(f2.x), fabsf(f2.y)), fmaxf(fabsf(f2.z), fabsf(f2.w))),
                           fmaxf(fmaxf(fabsf(f3.x), fabsf(f3.y)), fmaxf(fabsf(f3.z), fabsf(f3.w)))));
      am = wave_max(am);
      const float sc = am > 0.f ? 224.f / am : 1.f;
      int w0 = 0, w1 = 0, w2 = 0, w3 = 0;
      w0 = __builtin_amdgcn_cvt_pk_fp8_f32(f0.x * sc, f0.y * sc, w0, false); w0 = __builtin_amdgcn_cvt_pk_fp8_f32(f0.z * sc, f0.w * sc, w0, true);
      w1 = __builtin_amdgcn_cvt_pk_fp8_f32(f1.x * sc, f1.y * sc, w1, false); w1 = __builtin_amdgcn_cvt_pk_fp8_f32(f1.z * sc, f1.w * sc, w1, true);
      w2 = __builtin_amdgcn_cvt_pk_fp8_f32(f2.x * sc, f2.y * sc, w2, false); w2 = __builtin_amdgcn_cvt_pk_fp8_f32(f2.z * sc, f2.w * sc, w2, true);
      w3 = __builtin_amdgcn_cvt_pk_fp8_f32(f3.x * sc, f3.y * sc, w3, false); w3 = __builtin_amdgcn_cvt_pk_fp8_f32(f3.z * sc, f3.w * sc, w3, true);
      unsigned char* dst = (tab == 0 ? p.ub8() : p.vb8()) + (size_t)row * 1024 + lane * 16;
      *reinterpret_cast<uint4*>(dst) = make_uint4((unsigned)w0, (unsigned)w1, (unsigned)w2, (unsigned)w3);
      if (lane == 0) (tab == 0 ? p.us() : p.vs())[row] = am > 0.f ? am * (1.f / 224.f) : 1.f;
    }
  }
  {
    const size_t n8 = (size_t)2 * 16 * 128 * 128 / 8;
    for (size_t i = gtid; i < n8; i += gsz) {
      float4 a = reinterpret_cast<const float4*>(p.peer_keys())[2 * i], b = reinterpret_cast<const float4*>(p.peer_keys())[2 * i + 1];
      reinterpret_cast<uint4*>(p.keysb())[i] = make_uint4(pack2(a.x, a.y), pack2(a.z, a.w), pack2(b.x, b.y), pack2(b.z, b.w));
    }
  }
  {
    const size_t n8 = (size_t)2 * 8 * 1024 * 512 / 8;
    for (size_t i = gtid; i < n8; i += gsz) {
      size_t e = i * 8;
      size_t lb = e / (1024 * 512), rem = e % (1024 * 512);
      float4 a = reinterpret_cast<const float4*>(p.cache_k())[2 * i], b = reinterpret_cast<const float4*>(p.cache_k())[2 * i + 1];
      *reinterpret_cast<uint4*>(p.Kbs() + lb * (SKEYS * 512) + rem) = make_uint4(pack2(a.x, a.y), pack2(a.z, a.w), pack2(b.x, b.y), pack2(b.z, b.w));
    }
  }
  for (size_t i = gtid; i < 2 * 8 * 1024; i += gsz) {
    int l = (int)(i / 8192), r = (int)(i % 8192), g = r / 1024, k = r % 1024;
    p.wg()[i] = p.w_in()[((size_t)l * 1024 + k) * 2824 + 2304 + g];
  }
  {
    float* sp = reinterpret_cast<float*>(p.ws + WS_sp);
    for (size_t i = gtid; i < 262144; i += gsz) sp[SP_st_c + i] = p.in[4][i];
    for (size_t i = gtid; i < 4096; i += gsz) sp[SP_st_n + i] = p.in[5][i];
    for (size_t i = gtid; i < 64; i += gsz) sp[SP_st_m + i] = p.in[6][i];
    for (size_t i = gtid; i < 12288; i += gsz) sp[SP_st_conv + i] = p.in[7][i];
    for (size_t i = gtid; i < 2048; i += gsz) sp[SP_norm1_g + i] = p.in[8][i];
    for (size_t i = gtid; i < 256; i += gsz) sp[SP_da_subln_g + i] = p.in[11][i];
    for (size_t i = gtid; i < 2048; i += gsz) sp[SP_ml_conv_w + i] = p.in[13][i];
    for (size_t i = gtid; i < 512; i += gsz) sp[SP_ml_conv_b + i] = p.in[14][i];
    for (size_t i = gtid; i < 32768; i += gsz) sp[SP_ml_wq + i] = p.in[15][i];
    for (size_t i = gtid; i < 32768; i += gsz) sp[SP_ml_wk + i] = p.in[16][i];
    for (size_t i = gtid; i < 16; i += gsz) sp[SP_ml_gate_b + i] = p.in[17][i];
    for (size_t i = gtid; i < 512; i += gsz) sp[SP_ml_norm_g + i] = p.in[18][i];
    for (size_t i = gtid; i < 512; i += gsz) sp[SP_ml_skip + i] = p.in[19][i];
    for (size_t i = gtid; i < 512; i += gsz) sp[SP_cm_norm_g + i] = p.in[20][i];
    for (size_t i = gtid; i < 131072; i += gsz) sp[SP_cm_ws + i] = p.in[21][i];
    for (size_t i = gtid; i < 1024; i += gsz) sp[SP_cm_b + i] = p.in[22][i];
    for (size_t i = gtid; i < 2048; i += gsz) sp[SP_norm2_g + i] = p.in[24][i];
    for (size_t i = gtid; i < 1024; i += gsz) sp[SP_final_g + i] = p.in[29][i];
  }
  if (bid == 0) {
    for (int i = tid; i < 4 * 256; i += 256) {
      int h = i >> 8, j = i & 255;
      int rel = j - 191; if (rel > 63) rel = 63;
      p.lut()[i] = p.rel_table()[rel_bucket_dev(rel) * 4 + h] * LOG2E;
    }
    if (tid < 2) {
      const float* lp = p.da_lambda() + tid * 256;
      float s01 = 0.f, s23 = 0.f;
      for (int d = 0; d < 64; ++d) { s01 += lp[d] * lp[64 + d]; s23 += lp[128 + d] * lp[192 + d]; }
      float lam_init = 0.8f - 0.6f * expf(-0.3f * (float)tid);
      p.lam()[tid] = expf(s01) - expf(s23) + lam_init;
    }
  }
}

template <int MODE>
__device__ __forceinline__ void ph_rmsnorm(const Params& p, int l, int bid, int nblk) {
  const int lane = tid_opaque() & 63, w = tid_opaque() >> 6;
  const float* g = (MODE == 0) ? p.norm1_g() + l * 1024 : (MODE == 1 ? p.norm2_g() + l * 1024 : p.final_g());
  float4 gv[4];
#pragma unroll
  for (int j = 0; j < 4; ++j) gv[j] = reinterpret_cast<const float4*>(g)[lane + 64 * j];
  for (int t = bid * 4 + w; t < NTOK; t += nblk * 4) {
    const float* xr = (MODE == 0) ? xrow_in(p, l, t) : p.x() + (size_t)t * 1024;
    float4 xv[4];
    float ss = 0.f;
#pragma unroll
    for (int j = 0; j < 4; ++j) {
      xv[j] = reinterpret_cast<const float4*>(xr)[lane + 64 * j];
      ss += xv[j].x * xv[j].x + xv[j].y * xv[j].y + xv[j].z * xv[j].z + xv[j].w * xv[j].w;
    }
    ss = wave_sum(ss);
    float r = rsqrtf(ss * (1.f / 1024.f) + EPS);
#pragma unroll
    for (int j = 0; j < 4; ++j) {
      xv[j].x *= r * gv[j].x; xv[j].y *= r * gv[j].y; xv[j].z *= r * gv[j].z; xv[j].w *= r * gv[j].w;
    }
    if (MODE == 2) {
      float* o = (t < NPROMPT) ? p.out + O_Y_P + (size_t)t * 1024 : p.out + O_Y_S + (size_t)(t - NPROMPT) * 1024;
#pragma unroll
      for (int j = 0; j < 4; ++j) reinterpret_cast<float4*>(o)[lane + 64 * j] = xv[j];
    } else {
      uint2* o = reinterpret_cast<uint2*>(p.xn() + (size_t)t * 1024);
#pragma unroll
      for (int j = 0; j < 4; ++j) o[lane + 64 * j] = make_uint2(pack2(xv[j].x, xv[j].y), pack2(xv[j].z, xv[j].w));
    }
    if (MODE == 0) {
      float pre[8];
#pragma unroll
      for (int i = 0; i < 8; ++i) {
        const float4* wr = reinterpret_cast<const float4*>(p.wg() + ((size_t)l * 8 + i) * 1024);
        float s = 0.f;
#pragma unroll
        for (int j = 0; j < 4; ++j) {
          float4 wv = wr[lane + 64 * j];
          s += xv[j].x * wv.x + xv[j].y * wv.y + xv[j].z * wv.z + xv[j].w * wv.w;
        }
        pre[i] = wave_sum(s);
      }
      if (lane < 4) {
        float a = pre[0]; a = lane == 1 ? pre[1] : a; a = lane == 2 ? pre[2] : a; a = lane == 3 ? pre[3] : a;
        float f = pre[4]; f = lane == 1 ? pre[5] : f; f = lane == 2 ? pre[6] : f; f = lane == 3 ? pre[7] : f;
        p.ig()[(size_t)t * 4 + lane] = a + p.ml_gate_b()[l * 8 + lane];
        float z = f + p.ml_gate_b()[l * 8 + 4 + lane];
        p.lf()[(size_t)t * 4 + lane] = fminf(z, 0.f) - log1pf(expf(-fabsf(z)));
      }
    }
  }
}

enum { EPI_WIN = 0, EPI_WOUT = 1, EPI_PQ = 2, EPI_SC = 3 };

template <int EPI>
__device__ __forceinline__ void gemm_store(const Params& p, int l, int t, int n, float v) {
  if (EPI == EPI_WOUT) {
    const float* xi = xrow_in(p, l, t);
    p.x()[(size_t)t * 1024 + n] = xi[n] + v;
  } else if (EPI == EPI_PQ) {
    p.qp()[(size_t)t * 2048 + n] = f2bf(v);
  } else if (EPI == EPI_SC) {
    p.sc()[(size_t)t * 2048 + n] = v;
  }
}

template <int EPI>
__device__ __forceinline__ void ph_gemm(const Params& p, int l, char* smem, int bid, int nblk) {
  constexpr int NT = (EPI == EPI_WIN) ? 22 : (EPI == EPI_WOUT ? 8 : 16);
  constexpr int MT = NTOK / 128;
  constexpr int K = (EPI == EPI_SC) ? 128 : 1024;
  constexpr int NK = K / 64;
  const bf16_t* A; int lda; const bf16_t* Bt; int ldb;
  if (EPI == EPI_WIN) { A = p.xn(); lda = 1024; Bt = p.wt_in() + (size_t)l * NIN * 1024; ldb = 1024; }
  else if (EPI == EPI_WOUT) { A = p.xn(); lda = 1024; Bt = p.wt_out() + (size_t)l * 1024 * 1024; ldb = 1024; }
  else if (EPI == EPI_PQ) { A = p.xn(); lda = 1024; Bt = p.wt_pq() + (size_t)l * 2048 * 1024; ldb = 1024; }
  else { A = p.qp(); lda = 2048; Bt = p.keysb() + (size_t)l * 16 * 128 * 128; ldb = 128; }

  const int tid = tid_opaque(), lane = tid & 63, w = tid >> 6;
  const int wm = w >> 1, wn = w & 1, lr = lane & 31, lh = lane >> 5;
  char* sA = smem;
  char* sB = smem + 32768;
  const int ld_c = tid & 7, ld_r = tid >> 3;

  for (int tile = bid; tile < MT * NT; tile += nblk) {
    const int mt = tile / NT, nt = tile % NT;
    const bf16_t* Ag = A + (size_t)(mt * 128) * lda + ((EPI == EPI_SC) ? nt * 128 : 0);
    const bf16_t* Bg = Bt + (size_t)(nt * 128) * ldb;
    uint4 ra[4], rb[4];
    f32x16 acc[2][2];
#pragma unroll
    for (int i = 0; i < 2; ++i)
#pragma unroll
      for (int j = 0; j < 2; ++j)
#pragma unroll
        for (int r = 0; r < 16; ++r) acc[i][j][r] = 0.f;

#pragma unroll
    for (int j = 0; j < 4; ++j) {
      ra[j] = *reinterpret_cast<const uint4*>(Ag + (size_t)(ld_r + 32 * j) * lda + ld_c * 8);
      rb[j] = *reinterpret_cast<const uint4*>(Bg + (size_t)(ld_r + 32 * j) * ldb + ld_c * 8);
    }
#pragma unroll
    for (int j = 0; j < 4; ++j) {
      int row = ld_r + 32 * j; int pc = ld_c ^ ((row >> 1) & 7);
      *reinterpret_cast<uint4*>(sA + row * 128 + pc * 16) = ra[j];
      *reinterpret_cast<uint4*>(sB + row * 128 + pc * 16) = rb[j];
    }
    __syncthreads();
    for (int kt = 0; kt < NK; ++kt) {
      const int buf = kt & 1;
      if (kt + 1 < NK) {
#pragma unroll
        for (int j = 0; j < 4; ++j) {
          ra[j] = *reinterpret_cast<const uint4*>(Ag + (size_t)(ld_r + 32 * j) * lda + (kt + 1) * 64 + ld_c * 8);
          rb[j] = *reinterpret_cast<const uint4*>(Bg + (size_t)(ld_r + 32 * j) * ldb + (kt + 1) * 64 + ld_c * 8);
        }
      }
      const char* cA = sA + buf * 16384;
      const char* cB = sB + buf * 16384;
#pragma unroll
      for (int ks = 0; ks < 4; ++ks) {
        bf16x8 af[2], bfr[2];
#pragma unroll
        for (int i = 0; i < 2; ++i) {
          int row = wm * 64 + i * 32 + lr; int pc = (ks * 2 + lh) ^ ((row >> 1) & 7);
          af[i] = as_bf16x8(*reinterpret_cast<const uint4*>(cA + row * 128 + pc * 16));
        }
#pragma unroll
        for (int j = 0; j < 2; ++j) {
          int row = wn * 64 + j * 32 + lr; int pc = (ks * 2 + lh) ^ ((row >> 1) & 7);
          bfr[j] = as_bf16x8(*reinterpret_cast<const uint4*>(cB + row * 128 + pc * 16));
        }
#pragma unroll
        for (int i = 0; i < 2; ++i)
#pragma unroll
          for (int j = 0; j < 2; ++j)
            acc[i][j] = __builtin_amdgcn_mfma_f32_32x32x16_bf16(af[i], bfr[j], acc[i][j], 0, 0, 0);
      }
      if (kt + 1 < NK) {
        char* nA = sA + (buf ^ 1) * 16384;
        char* nB = sB + (buf ^ 1) * 16384;
#pragma unroll
        for (int j = 0; j < 4; ++j) {
          int row = ld_r + 32 * j; int pc = ld_c ^ ((row >> 1) & 7);
          *reinterpret_cast<uint4*>(nA + row * 128 + pc * 16) = ra[j];
          *reinterpret_cast<uint4*>(nB + row * 128 + pc * 16) = rb[j];
        }
      }
      __syncthreads();
    }
    if (EPI != EPI_WIN) {
#pragma unroll
      for (int i = 0; i < 2; ++i)
#pragma unroll
        for (int j = 0; j < 2; ++j)
#pragma unroll
          for (int r = 0; r < 16; ++r) {
            int t = mt * 128 + wm * 64 + i * 32 + (r & 3) + 8 * (r >> 2) + 4 * lh;
            int n = nt * 128 + wn * 64 + j * 32 + lr;
            gemm_store<EPI>(p, l, t, n, acc[i][j][r]);
          }
    } else {
      const int seg = nt >> 2;
#pragma unroll
      for (int i = 0; i < 2; ++i)
#pragma unroll
        for (int j = 0; j < 2; ++j) {
          const int n = nt * 128 + wn * 64 + j * 32 + lr;
          if (nt < 4) {
#pragma unroll
            for (int r = 0; r < 16; ++r) {
              int t = mt * 128 + wm * 64 + i * 32 + (r & 3) + 8 * (r >> 2) + 4 * lh;
              p.Qb()[(size_t)t * 512 + n] = f2bf(acc[i][j][r] * (0.125f * LOG2E));
            }
          } else if (nt < 8) {
            const int n2 = n - 512;
#pragma unroll
            for (int r = 0; r < 16; ++r) {
              int t = mt * 128 + wm * 64 + i * 32 + (r & 3) + 8 * (r >> 2) + 4 * lh;
              float v = acc[i][j][r];
              if (t < NPROMPT) {
                p.out[O_K_P + (size_t)l * (4 * 4096 * 512) + (size_t)t * 512 + n2] = v;
                p.Kb()[(size_t)t * 512 + n2] = f2bf(v);
              } else {
                int ts = t - NPROMPT, b = ts >> 6, ii = ts & 63;
                p.out[O_K_S + (size_t)l * (8 * 64 * 512) + (size_t)ts * 512 + n2] = v;
                p.Kbs()[((size_t)(l * 8 + b) * SKEYS + 1024 + ii) * 512 + n2] = f2bf(v);
              }
            }
          } else if (nt < 12) {
            const int n2 = n - 1024, h = n2 >> 7, dv = n2 & 127;
#pragma unroll
            for (int rg = 0; rg < 4; ++rg) {
              int tb = mt * 128 + wm * 64 + i * 32 + 8 * rg + 4 * lh;
              float v0 = acc[i][j][rg * 4 + 0], v1 = acc[i][j][rg * 4 + 1], v2 = acc[i][j][rg * 4 + 2], v3 = acc[i][j][rg * 4 + 3];
              uint2 pk = make_uint2(pack2(v0, v1), pack2(v2, v3));
              int posblk = 2 * lh + (rg & 1);
              if (tb < NPROMPT) {
                float* o = p.out + O_V_P + (size_t)l * (4 * 4096 * 512) + (size_t)tb * 512 + n2;
                o[0] = v0; o[512] = v1; o[1024] = v2; o[1536] = v3;
                int b = tb >> 12, s = tb & 4095;
                int pos = (s & ~15) + posblk * 4;
                *reinterpret_cast<uint2*>(p.Vt() + ((size_t)(b * 4 + h) * 128 + dv) * SEQ + pos) = pk;
              } else {
                int ts = tb - NPROMPT, b = ts >> 6, ii = ts & 63;
                float* o = p.out + O_V_S + (size_t)l * (8 * 64 * 512) + (size_t)ts * 512 + n2;
                o[0] = v0; o[512] = v1; o[1024] = v2; o[1536] = v3;
                int pos = 1024 + (ii & ~15) + posblk * 4;
                *reinterpret_cast<uint2*>(p.Vts() + ((size_t)((l * 8 + b) * 4 + h) * 128 + dv) * SKEYS + pos) = pk;
              }
            }
          } else {
            const int n2 = n - 1536;
            const bool act = (n >= 2304);
#pragma unroll
            for (int r = 0; r < 16; ++r) {
              int t = mt * 128 + wm * 64 + i * 32 + (r & 3) + 8 * (r >> 2) + 4 * lh;
              float v = acc[i][j][r];
              if (act) v = gelu_exact(v);
              p.P5()[(size_t)t * 1280 + n2] = v;
            }
          }
        }
      (void)seg;
    }
  }
}

__device__ __forceinline__ void ph_attn(const Params& p, int l, char* smem, int bid, int nblk) {
  const int tid = tid_opaque(), lane = tid & 63, w = tid >> 6;
  const int c = w >> 1, qhalf = w & 1, lr = lane & 31, lh = lane >> 5;
  char* sK = smem;
  char* sV = smem + 16384;
  float* sLut = reinterpret_cast<float*>(smem + 32768);
  char* sQ = smem + 33792 + w * 4096;
  float* sO2 = reinterpret_cast<float*>(smem);
  const float lam = p.lam()[l];
  const float lam_init = 0.8f - 0.6f * expf(-0.3f * (float)l);

  for (int uu = bid; uu < 1056; uu += nblk) {
    int b, h, qc, S, qrow0; const bf16_t *Kbase, *Vbase;
    bool samp = false; int u2 = uu;
    if (uu >= 752 && uu < 784) samp = true; else if (uu >= 784) u2 = uu - 32;
    if (!samp) {
      qc = 63 - (u2 >> 4); int bh = u2 & 15; b = bh >> 2; h = bh & 3; S = SEQ;
      Kbase = p.Kb() + (size_t)b * SEQ * 512 + h * 128;
      Vbase = p.Vt() + (size_t)(b * 4 + h) * 128 * SEQ;
      qrow0 = b * SEQ + qc * 64;
    } else {
      int us = uu - 752; b = us >> 2; h = us & 3; qc = 16; S = SKEYS;
      Kbase = p.Kbs() + (size_t)(l * 8 + b) * SKEYS * 512 + h * 128;
      Vbase = p.Vts() + (size_t)((l * 8 + b) * 4 + h) * 128 * SKEYS;
      qrow0 = NPROMPT + b * 64;
    }
    const int ntiles = qc + 1;
    __syncthreads();
    sLut[tid] = p.lut()[h * 256 + tid];
    {
      const int qc8 = lane & 7, qr = lane >> 3;
#pragma unroll
      for (int j = 0; j < 4; ++j) {
        int row = qr + 8 * j;
        uint4 v = *reinterpret_cast<const uint4*>(p.Qb() + (size_t)(qrow0 + qhalf * 32 + row) * 512 + h * 128 + c * 64 + qc8 * 8);
        *reinterpret_cast<uint4*>(sQ + row * 128 + ((qc8 ^ ((row >> 1) & 7)) * 16)) = v;
      }
    }
    f32x16 o[4];
#pragma unroll
    for (int d = 0; d < 4; ++d)
#pragma unroll
      for (int r = 0; r < 16; ++r) o[d][r] = 0.f;
    float m_run = -1e30f, l_run = 0.f;
    const float c15 = p.lut()[h * 256];

    uint4 rk0, rk1, rk2, rk3, rv0, rv1, rv2, rv3;
    const int kc = tid & 15, kr = tid >> 4;
    const int vc = tid & 7, vr = tid >> 3;
    const char* Kt = reinterpret_cast<const char*>(Kbase);
    const char* Vb = reinterpret_cast<const char*>(Vbase);
    const unsigned koff = (unsigned)kr * 1024u + (unsigned)kc * 16u;
    const unsigned voff = (unsigned)vr * (unsigned)(S * 2) + (unsigned)vc * 16u;
    const size_t vjs = (size_t)S * 64;
#define ATTN_GL1(KT, J, RK, RV)                                                                              \
  RK = *reinterpret_cast<const uint4*>(Kt + ((size_t)((KT) * 64 + 16 * (J)) * 1024) + koff);                 \
  RV = *reinterpret_cast<const uint4*>(Vb + ((size_t)(J) * vjs + (size_t)(KT) * 128) + voff);
#define ATTN_GLOAD(KT) ATTN_GL1(KT, 0, rk0, rv0) ATTN_GL1(KT, 1, rk1, rv1) ATTN_GL1(KT, 2, rk2, rv2) ATTN_GL1(KT, 3, rk3, rv3)
#define ATTN_SW1(J, RK, RV)                                                                                  \
  {                                                                                                          \
    int row = kr + 16 * (J); int pc = (kc & 7) ^ ((row >> 1) & 7);                                           \
    *reinterpret_cast<uint4*>(sK + (kc >> 3) * 8192 + row * 128 + pc * 16) = RK;                             \
    int row2 = vr + 32 * (J); int pc2 = vc ^ ((row2 >> 1) & 7);                                              \
    *reinterpret_cast<uint4*>(sV + row2 * 128 + pc2 * 16) = RV;                                              \
  }
    ATTN_GLOAD(0)
    for (int kt = 0; kt < ntiles; ++kt) {
      __syncthreads();
      ATTN_SW1(0, rk0, rv0) ATTN_SW1(1, rk1, rv1) ATTN_SW1(2, rk2, rv2) ATTN_SW1(3, rk3, rv3)
      __syncthreads();
      if (kt + 1 < ntiles) { ATTN_GLOAD(kt + 1) }
      f32x16 s[2];
#pragma unroll
      for (int kb = 0; kb < 2; ++kb) {
#pragma unroll
        for (int r = 0; r < 16; ++r) s[kb][r] = 0.f;
#pragma unroll
        for (int ks = 0; ks < 4; ++ks) {
          int row = kb * 32 + lr; int pc = (ks * 2 + lh) ^ ((row >> 1) & 7);
          bf16x8 kf = as_bf16x8(*reinterpret_cast<const uint4*>(sK + c * 8192 + row * 128 + pc * 16));
          bf16x8 qf = as_bf16x8(*reinterpret_cast<const uint4*>(sQ + lr * 128 + (((ks * 2 + lh) ^ ((lr >> 1) & 7)) * 16)));
          s[kb] = __builtin_amdgcn_mfma_f32_32x32x16_bf16(kf, qf, s[kb], 0, 0, 0);
        }
      }
      if (kt >= qc - 2) {
        const int base = (kt - qc) * 64 - (qhalf * 32 + lr) + 191 + 4 * lh;
#pragma unroll
        for (int kb = 0; kb < 2; ++kb)
#pragma unroll
          for (int r = 0; r < 16; ++r) s[kb][r] += sLut[base + kb * 32 + (r & 3) + 8 * (r >> 2)];
      } else {
#pragma unroll
        for (int kb = 0; kb < 2; ++kb)
#pragma unroll
          for (int r = 0; r < 16; ++r) s[kb][r] += c15;
      }
      float mx = s[0][0];
#pragma unroll
      for (int kb = 0; kb < 2; ++kb)
#pragma unroll
        for (int r = 0; r < 16; ++r) mx = fmaxf(mx, s[kb][r]);
      mx = swap32_max(mx);
      const float m_new = fmaxf(m_run, mx);
      const float alpha = __builtin_amdgcn_exp2f(m_run - m_new);
      m_run = m_new;
      float ps = 0.f;
#pragma unroll
      for (int kb = 0; kb < 2; ++kb)
#pragma unroll
        for (int r = 0; r < 16; ++r) { float pv = __builtin_amdgcn_exp2f(s[kb][r] - m_new); s[kb][r] = pv; ps += pv; }
      l_run = l_run * alpha + ps;
#pragma unroll
      for (int d = 0; d < 4; ++d)
#pragma unroll
        for (int r = 0; r < 16; ++r) o[d][r] *= alpha;
#pragma unroll
      for (int ks2 = 0; ks2 < 4; ++ks2) {
        const int kb = ks2 >> 1, sh = (ks2 & 1) * 8;
        uint4 pw = make_uint4(pack2(s[kb][sh + 0], s[kb][sh + 1]), pack2(s[kb][sh + 2], s[kb][sh + 3]),
                              pack2(s[kb][sh + 4], s[kb][sh + 5]), pack2(s[kb][sh + 6], s[kb][sh + 7]));
        bf16x8 pf = as_bf16x8(pw);
#pragma unroll
        for (int d = 0; d < 4; ++d) {
          int row = d * 32 + lr; int pc = (ks2 * 2 + lh) ^ ((row >> 1) & 7);
          bf16x8 vf = as_bf16x8(*reinterpret_cast<const uint4*>(sV + row * 128 + pc * 16));
          o[d] = __builtin_amdgcn_mfma_f32_32x32x16_bf16(vf, pf, o[d], 0, 0, 0);
        }
        __builtin_amdgcn_sched_barrier(0);
      }
    }
    float lt = swap32_sum(l_run);
    float inv = 1.f / lt;
    __syncthreads();
    if (c == 1) {
#pragma unroll
      for (int d = 0; d < 4; ++d)
#pragma unroll
        for (int r = 0; r < 16; ++r) sO2[(qhalf * 64 + d * 16 + r) * 64 + lane] = o[d][r] * inv;
    }
    __syncthreads();
    if (c == 0) {
      float ss = 0.f;
#pragma unroll
      for (int d = 0; d < 4; ++d)
#pragma unroll
        for (int r = 0; r < 16; ++r) {
          float v = o[d][r] * inv - lam * sO2[(qhalf * 64 + d * 16 + r) * 64 + lane];
          o[d][r] = v; ss += v * v;
        }
      ss = swap32_sum(ss);
      const float rn = rsqrtf(ss * (1.f / 128.f) + EPS) * (1.f - lam_init);
      const float* gs = p.da_subln_g() + l * 128;
      bf16_t* orow = p.xn() + (size_t)(qrow0 + qhalf * 32 + lr) * 1024 + h * 128;
#pragma unroll
      for (int d = 0; d < 4; ++d)
#pragma unroll
        for (int rg = 0; rg < 4; ++rg) {
          int dv = d * 32 + 8 * rg + 4 * lh;
          float4 g4 = *reinterpret_cast<const float4*>(gs + dv);
          uint2 pk = make_uint2(pack2(o[d][rg * 4 + 0] * rn * g4.x, o[d][rg * 4 + 1] * rn * g4.y),
                                pack2(o[d][rg * 4 + 2] * rn * g4.z, o[d][rg * 4 + 3] * rn * g4.w));
          *reinterpret_cast<uint2*>(orow + dv) = pk;
        }
    }
  }
}

__device__ __forceinline__ void ph_mlconv(const Params& p, int l, char* smem, int bid, int nblk) {
  const int tid = tid_opaque();
  float* s_mc = reinterpret_cast<float*>(smem);
  float* s_cc = s_mc + 67 * 64;
  float* s_wq = s_cc + 64 * 65;
  float* s_wk = s_wq + 4096;
  for (int u = bid; u < 264 * 4; u += nblk) {
    const int ci = u >> 2, h = u & 3;
    int token0, bq; bool samp = ci >= 256;
    if (!samp) token0 = ci * 64; else token0 = NPROMPT + (ci - 256) * 64;
    bq = samp ? (ci - 256) : (ci >> 6);
    const int cidx = samp ? 0 : (ci & 63);
    __syncthreads();
    for (int i = tid; i < 67 * 64; i += 256) {
      int r = i >> 6, d = i & 63;
      float v;
      if (r >= 3) v = p.P5()[(size_t)(token0 + r - 3) * 1280 + h * 64 + d];
      else if (samp) v = p.st_conv()[((size_t)(l * 8 + bq) * 3 + r) * 256 + h * 64 + d];
      else if (cidx == 0) v = 0.f;
      else v = p.P5()[(size_t)(token0 + r - 3) * 1280 + h * 64 + d];
      s_mc[i] = v;
    }
    for (int i = tid; i < 4096; i += 256) {
      s_wq[i] = p.ml_wq()[(size_t)(l * 4 + h) * 4096 + i];
      s_wk[i] = p.ml_wk()[(size_t)(l * 4 + h) * 4096 + i];
    }
    __syncthreads();
    {
      const int d = tid & 63, t0 = tid >> 6;
      const int ch = h * 64 + d;
      const float w0 = p.ml_conv_w()[(l * 4 + 0) * 256 + ch], w1 = p.ml_conv_w()[(l * 4 + 1) * 256 + ch];
      const float w2 = p.ml_conv_w()[(l * 4 + 2) * 256 + ch], w3 = p.ml_conv_w()[(l * 4 + 3) * 256 + ch];
      const float bb = p.ml_conv_b()[l * 256 + ch];
      for (int t = t0; t < 64; t += 4) {
        float y = bb + w0 * s_mc[t * 64 + d] + w1 * s_mc[(t + 1) * 64 + d] + w2 * s_mc[(t + 2) * 64 + d] + w3 * s_mc[(t + 3) * 64 + d];
        y = y * sigmoidf_(y);
        s_cc[t * 65 + d] = y;
        p.cc()[(size_t)(token0 + t) * 256 + ch] = y;
      }
      if (samp || cidx == 63) {
        if (tid < 192) {
          int r = tid >> 6;
          float v = s_mc[(64 + r) * 64 + d];
          if (samp) p.out[O_CONV_S + ((size_t)(l * 8 + bq) * 3 + r) * 256 + ch] = v;
          else p.out[O_CONV_P + ((size_t)(l * 4 + bq) * 3 + r) * 256 + ch] = v;
        }
      }
    }
    __syncthreads();
    {
      const int ty = tid >> 4, tx = tid & 15;
      float aq[4][4], ak[4][4];
#pragma unroll
      for (int i = 0; i < 4; ++i)
#pragma unroll
        for (int j = 0; j < 4; ++j) { aq[i][j] = 0.f; ak[i][j] = 0.f; }
      for (int d = 0; d < 64; ++d) {
        float4 wq4 = *reinterpret_cast<const float4*>(s_wq + d * 64 + tx * 4);
        float4 wk4 = *reinterpret_cast<const float4*>(s_wk + d * 64 + tx * 4);
#pragma unroll
        for (int i = 0; i < 4; ++i) {
          float a = s_cc[(ty * 4 + i) * 65 + d];
          aq[i][0] += a * wq4.x; aq[i][1] += a * wq4.y; aq[i][2] += a * wq4.z; aq[i][3] += a * wq4.w;
          ak[i][0] += a * wk4.x; ak[i][1] += a * wk4.y; ak[i][2] += a * wk4.z; ak[i][3] += a * wk4.w;
        }
      }
#pragma unroll
      for (int i = 0; i < 4; ++i) {
        size_t o = (size_t)(token0 + ty * 4 + i) * 256 + h * 64 + tx * 4;
        *reinterpret_cast<float4*>(p.qm() + o) = make_float4(aq[i][0], aq[i][1], aq[i][2], aq[i][3]);
        *reinterpret_cast<float4*>(p.km() + o) = make_float4(ak[i][0] * 0.125f, ak[i][1] * 0.125f, ak[i][2] * 0.125f, ak[i][3] * 0.125f);
      }
    }
  }
}

__device__ __forceinline__ void ph_mchain(const Params& p, int l, int bid, int nblk) {
  const int lane = tid_opaque() & 63, w = tid_opaque() >> 6;
  for (int u = bid * 4 + w; u < 48; u += nblk * 4) {
    const bool samp = u >= 16;
    int b, h, nch, token0, cu0; float m;
    if (!samp) { b = u >> 2; h = u & 3; nch = 64; token0 = b * SEQ; cu0 = (b * 4 + h) * 64; m = 0.f; }
    else { int us = u - 16; b = us >> 2; h = us & 3; nch = 1; token0 = NPROMPT + b * 64; cu0 = 1024 + us; m = p.st_m()[(l * 8 + b) * 4 + h]; }
    for (int c = 0; c < nch; ++c) {
      const int t = token0 + c * 64 + lane;
      float lfv = p.lf()[(size_t)t * 4 + h], igv = p.ig()[(size_t)t * 4 + h];
      float F = lfv;
#pragma unroll
      for (int d = 1; d < 64; d <<= 1) { float n = __shfl_up(F, d); if (lane >= d) F += n; }
      const float FL = __shfl(F, 63);
      const float tail = FL - F + igv;
      const float mx = wave_max(tail);
      const float mn = fmaxf(FL + m, mx);
      p.Fc()[(size_t)t * 4 + h] = F;
      if (lane == 0) {
        p.mst()[cu0 + c] = m; p.mnx()[cu0 + c] = mn; p.wcs()[cu0 + c] = expf(FL + m - mn); p.FLs()[cu0 + c] = FL;
      }
      m = mn;
    }
    if (lane == 0) {
      if (!samp) p.out[O_M_P + (l * 4 + b) * 4 + h] = m;
      else p.out[O_M_S + (l * 8 + b) * 4 + h] = m;
    }
  }
}

__device__ __forceinline__ void cu_decode(int cu, int& token0, int& h) {
  if (cu < 1024) { int bh = cu >> 6, c = cu & 63; token0 = (bh >> 2) * SEQ + c * 64; h = bh & 3; }
  else { int us = cu - 1024; token0 = NPROMPT + (us >> 2) * 64; h = us & 3; }
}

__device__ __forceinline__ void ph_mlU(const Params& p, int l, char* smem, int bid, int nblk) {
  const int tid = tid_opaque();
  float* s_k = reinterpret_cast<float*>(smem);
  float* s_v = s_k + 4096;
  for (int cu = bid; cu < NCU_UNITS; cu += nblk) {
    int token0, h; cu_decode(cu, token0, h);
    const float FL = p.FLs()[cu], mn = p.mnx()[cu];
    __syncthreads();
    for (int i = tid; i < 1024; i += 256) {
      int s = i >> 4, d4 = (i & 15) * 4;
      const int t = token0 + s;
      float wsv = expf(FL - p.Fc()[(size_t)t * 4 + h] + p.ig()[(size_t)t * 4 + h] - mn);
      float4 k4 = *reinterpret_cast<const float4*>(p.km() + (size_t)t * 256 + h * 64 + d4);
      float4 v4 = *reinterpret_cast<const float4*>(p.P5() + (size_t)t * 1280 + 256 + h * 64 + d4);
      *reinterpret_cast<float4*>(s_k + s * 64 + d4) = make_float4(k4.x * wsv, k4.y * wsv, k4.z * wsv, k4.w * wsv);
      *reinterpret_cast<float4*>(s_v + s * 64 + d4) = v4;
    }
    __syncthreads();
    const int ty = tid >> 4, tx = tid & 15;
    float a[4][4];
#pragma unroll
    for (int i = 0; i < 4; ++i)
#pragma unroll
      for (int j = 0; j < 4; ++j) a[i][j] = 0.f;
    for (int s = 0; s < 64; ++s) {
      float4 k4 = *reinterpret_cast<const float4*>(s_k + s * 64 + ty * 4);
      float4 v4 = *reinterpret_cast<const float4*>(s_v + s * 64 + tx * 4);
      float kk[4] = {k4.x, k4.y, k4.z, k4.w};
#pragma unroll
      for (int i = 0; i < 4; ++i) { a[i][0] += kk[i] * v4.x; a[i][1] += kk[i] * v4.y; a[i][2] += kk[i] * v4.z; a[i][3] += kk[i] * v4.w; }
    }
#pragma unroll
    for (int i = 0; i < 4; ++i)
      *reinterpret_cast<float4*>(p.U() + (size_t)cu * 4096 + (ty * 4 + i) * 64 + tx * 4) = make_float4(a[i][0], a[i][1], a[i][2], a[i][3]);
    if (tid < 64) {
      float s0 = 0.f;
      for (int s = 0; s < 64; ++s) s0 += s_k[s * 64 + tid];
      p.un()[(size_t)cu * 64 + tid] = s0;
    }
  }
}

__device__ __forceinline__ void ph_mlscan(const Params& p, int l, int bid, int nblk) {
  const size_t gtid = (size_t)bid * 256 + tid_opaque(), gsz = (size_t)nblk * 256;
  const size_t NPC = 16 * 4096, NSC = 32 * 4096, NPN = 16 * 64, NSN = 32 * 64;
  for (size_t i = gtid; i < NPC + NSC + NPN + NSN; i += gsz) {
    if (i < NPC) {
      int bh = (int)(i >> 12), e = (int)(i & 4095);
      float C = 0.f;
      for (int c = 0; c < 64; ++c) {
        int cu = bh * 64 + c;
        p.Cst()[(size_t)cu * 4096 + e] = C;
        C = p.wcs()[cu] * C + p.U()[(size_t)cu * 4096 + e];
      }
      p.out[O_C_P + (size_t)l * (16 * 4096) + i] = C;
    } else if (i < NPC + NSC) {
      size_t j = i - NPC; int us = (int)(j >> 12), e = (int)(j & 4095); int cu = 1024 + us;
      float C = p.st_c()[(size_t)l * (32 * 4096) + j];
      p.Cst()[(size_t)cu * 4096 + e] = C;
      p.out[O_C_S + (size_t)l * (32 * 4096) + j] = p.wcs()[cu] * C + p.U()[(size_t)cu * 4096 + e];
    } else if (i < NPC + NSC + NPN) {
      size_t j = i - NPC - NSC; int bh = (int)(j >> 6), d = (int)(j & 63);
      float n = 0.f;
      for (int c = 0; c < 64; ++c) {
        int cu = bh * 64 + c;
        p.nst()[(size_t)cu * 64 + d] = n;
        n = p.wcs()[cu] * n + p.un()[(size_t)cu * 64 + d];
      }
      p.out[O_N_P + (size_t)l * (16 * 64) + j] = n;
    } else {
      size_t j = i - NPC - NSC - NPN; int us = (int)(j >> 6), d = (int)(j & 63); int cu = 1024 + us;
      float n = p.st_n()[(size_t)l * (32 * 64) + j];
      p.nst()[(size_t)cu * 64 + d] = n;
      p.out[O_N_S + (size_t)l * (32 * 64) + j] = p.wcs()[cu] * n + p.un()[(size_t)cu * 64 + d];
    }
  }
}

__device__ __forceinline__ void ph_mlout(const Params& p, int l, char* smem, int bid, int nblk) {
  const int tid = tid_opaque();
  float* s_q = reinterpret_cast<float*>(smem);
  float* s_k = s_q + 64 * 65;
  float* s_v = s_k + 64 * 65;
  float* s_C = s_v + 4096;
  float* s_F = s_C + 4096;
  float* s_a = s_F + 64;
  float* s_mt = s_a + 64;
  float* s_iw = s_mt + 64;
  float* s_n = s_iw + 64;
  float* s_den = s_n + 64;
  for (int cu = bid; cu < NCU_UNITS; cu += nblk) {
    int token0, h; cu_decode(cu, token0, h);
    const float m0 = p.mst()[cu];
    __syncthreads();
    for (int i = tid; i < 1024; i += 256) {
      int s = i >> 4, d4 = (i & 15) * 4;
      const int t = token0 + s;
      float4 q4 = *reinterpret_cast<const float4*>(p.qm() + (size_t)t * 256 + h * 64 + d4);
      float4 k4 = *reinterpret_cast<const float4*>(p.km() + (size_t)t * 256 + h * 64 + d4);
      float4 v4 = *reinterpret_cast<const float4*>(p.P5() + (size_t)t * 1280 + 256 + h * 64 + d4);
      float4 c4 = *reinterpret_cast<const float4*>(p.Cst() + (size_t)cu * 4096 + s * 64 + d4);
      s_q[s * 65 + d4] = q4.x; s_q[s * 65 + d4 + 1] = q4.y; s_q[s * 65 + d4 + 2] = q4.z; s_q[s * 65 + d4 + 3] = q4.w;
      s_k[s * 65 + d4] = k4.x; s_k[s * 65 + d4 + 1] = k4.y; s_k[s * 65 + d4 + 2] = k4.z; s_k[s * 65 + d4 + 3] = k4.w;
      *reinterpret_cast<float4*>(s_v + s * 64 + d4) = v4;
      *reinterpret_cast<float4*>(s_C + s * 64 + d4) = c4;
    }
    if (tid < 64) {
      const int t = token0 + tid;
      float F = p.Fc()[(size_t)t * 4 + h], g = p.ig()[(size_t)t * 4 + h];
      s_F[tid] = F; s_a[tid] = g - F;
      s_n[tid] = p.nst()[(size_t)cu * 64 + tid];
    }
    __syncthreads();
    if (tid < 64) {
      float pm = -1e30f;
      for (int s = 0; s <= tid; ++s) pm = fmaxf(pm, s_a[s]);
      float F = s_F[tid];
      float mt = F + fmaxf(m0, pm);
      s_mt[tid] = mt;
      s_iw[tid] = expf(F + m0 - mt);
    }
    __syncthreads();
    const int ty = tid >> 4, tx = tid & 15;
    float acc[4][4];
#pragma unroll
    for (int i = 0; i < 4; ++i)
#pragma unroll
      for (int j = 0; j < 4; ++j) acc[i][j] = 0.f;
    for (int d = 0; d < 64; ++d) {
      float qv[4], kv[4];
#pragma unroll
      for (int i = 0; i < 4; ++i) { qv[i] = s_q[(ty * 4 + i) * 65 + d]; kv[i] = s_k[(tx * 4 + i) * 65 + d]; }
#pragma unroll
      for (int i = 0; i < 4; ++i)
#pragma unroll
        for (int j = 0; j < 4; ++j) acc[i][j] += qv[i] * kv[j];
    }
    __syncthreads();
#pragma unroll
    for (int i = 0; i < 4; ++i) {
      const int t = ty * 4 + i;
      const float Ft = s_F[t], mt = s_mt[t];
#pragma unroll
      for (int j = 0; j < 4; ++j) {
        const int s = tx * 4 + j;
        float v = (s <= t) ? acc[i][j] * expf(Ft + s_a[s] - mt) : 0.f;
        s_k[t * 65 + s] = v;
      }
    }
    __syncthreads();
    if (tid < 64) {
      float den = 0.f, qn = 0.f;
      for (int s = 0; s < 64; ++s) { den += s_k[tid * 65 + s]; qn += s_q[tid * 65 + s] * s_n[s]; }
      s_den[tid] = den + s_iw[tid] * qn;
    }
    float num[4][4], qc[4][4];
#pragma unroll
    for (int i = 0; i < 4; ++i)
#pragma unroll
      for (int j = 0; j < 4; ++j) { num[i][j] = 0.f; qc[i][j] = 0.f; }
    for (int s = 0; s < 64; ++s) {
      float4 v4 = *reinterpret_cast<const float4*>(s_v + s * 64 + tx * 4);
      float4 c4 = *reinterpret_cast<const float4*>(s_C + s * 64 + tx * 4);
#pragma unroll
      for (int i = 0; i < 4; ++i) {
        float sw = s_k[(ty * 4 + i) * 65 + s], qq = s_q[(ty * 4 + i) * 65 + s];
        num[i][0] += sw * v4.x; num[i][1] += sw * v4.y; num[i][2] += sw * v4.z; num[i][3] += sw * v4.w;
        qc[i][0] += qq * c4.x; qc[i][1] += qq * c4.y; qc[i][2] += qq * c4.z; qc[i][3] += qq * c4.w;
      }
    }
    __syncthreads();
#pragma unroll
    for (int i = 0; i < 4; ++i) {
      const int t = ty * 4 + i;
      const float iw = s_iw[t];
      const float dn = fmaxf(fabsf(s_den[t]), expf(-s_mt[t]));
      float hv[4]; float ss = 0.f;
#pragma unroll
      for (int j = 0; j < 4; ++j) { hv[j] = (num[i][j] + iw * qc[i][j]) / dn; ss += hv[j] * hv[j]; }
      ss = row16_sum(ss);
      const float rn = rsqrtf(ss * (1.f / 64.f) + EPS);
      const int ch = h * 64 + tx * 4;
      const size_t tg = (size_t)(token0 + t);
      float4 g4 = *reinterpret_cast<const float4*>(p.ml_norm_g() + l * 256 + ch);
      float4 k4 = *reinterpret_cast<const float4*>(p.ml_skip() + l * 256 + ch);
      float4 c4 = *reinterpret_cast<const float4*>(p.cc() + tg * 256 + ch);
      float4 o4 = *reinterpret_cast<const float4*>(p.P5() + tg * 1280 + 512 + ch);
      float r0 = (hv[0] * rn * g4.x + k4.x * c4.x) * sigmoidf_(o4.x);
      float r1 = (hv[1] * rn * g4.y + k4.y * c4.y) * sigmoidf_(o4.y);
      float r2 = (hv[2] * rn * g4.z + k4.z * c4.z) * sigmoidf_(o4.z);
      float r3 = (hv[3] * rn * g4.w + k4.w * c4.w) * sigmoidf_(o4.w);
      *reinterpret_cast<uint2*>(p.xn() + tg * 1024 + 512 + ch) = make_uint2(pack2(r0, r1), pack2(r2, r3));
    }
  }
}

__device__ __forceinline__ void ph_cmlp(const Params& p, int l, char* smem, int bid, int nblk) {
  const int tid = tid_opaque(), lane = tid & 63, w = tid >> 6;
  float* s_vg = reinterpret_cast<float*>(smem);
  float* s_ws = s_vg + 128 * 64;
  float* s_r = s_ws + 128 * 33;
  for (int u = bid; u < 544; u += nblk) {
    const int g = u & 3, ci = u >> 2;
    const bool samp = ci >= 128;
    const int L = samp ? 64 : 128;
    const int token0 = samp ? NPROMPT + (ci - 128) * 64 : ci * 128;
    __syncthreads();
    for (int r = w; r < L; r += 4) {
      float4 v = *reinterpret_cast<const float4*>(p.P5() + (size_t)(token0 + r) * 1280 + 1024 + lane * 4);
      float ss = v.x * v.x + v.y * v.y + v.z * v.z + v.w * v.w;
      ss = wave_sum(ss);
      if (lane == 0) s_r[r] = rsqrtf(ss * (1.f / 256.f) + EPS);
    }
    __syncthreads();
    for (int i = tid; i < L * 16; i += 256) {
      int s = i >> 4, d4 = (i & 15) * 4;
      float4 v = *reinterpret_cast<const float4*>(p.P5() + (size_t)(token0 + s) * 1280 + 1024 + g * 64 + d4);
      float4 gn = *reinterpret_cast<const float4*>(p.cm_norm_g() + l * 256 + g * 64 + d4);
      float r = s_r[s];
      float4 o = make_float4(v.x * r * gn.x, v.y * r * gn.y, v.z * r * gn.z, v.w * r * gn.w);
      *reinterpret_cast<float4*>(s_vg + s * 64 + d4) = o;
      if (samp) {
        int ts = token0 - NPROMPT + s;
        *reinterpret_cast<float4*>(p.out + O_CMV_S + (size_t)l * (512 * 256) + (size_t)ts * 256 + g * 64 + d4) = o;
      }
    }
    const int ty = tid >> 4, tx = tid & 15;
    float acc[8][4];
#pragma unroll
    for (int i = 0; i < 8; ++i)
#pragma unroll
      for (int j = 0; j < 4; ++j) acc[i][j] = 0.f;
    const float* wsg = p.cm_ws() + (size_t)(l * 4 + g) * 128 * 128;
    for (int s0 = 0; s0 < L; s0 += 32) {
      __syncthreads();
      for (int i = tid; i < L * 32; i += 256) {
        int t = i >> 5, ss = i & 31;
        s_ws[t * 33 + ss] = (s0 + ss <= t) ? wsg[t * 128 + s0 + ss] : 0.f;
      }
      __syncthreads();
      if (ty * 8 < L) {
        for (int ss = 0; ss < 32; ++ss) {
          float4 v4 = *reinterpret_cast<const float4*>(s_vg + (s0 + ss) * 64 + tx * 4);
#pragma unroll
          for (int i = 0; i < 8; ++i) {
            float wv = s_ws[(ty * 8 + i) * 33 + ss];
            acc[i][0] += wv * v4.x; acc[i][1] += wv * v4.y; acc[i][2] += wv * v4.z; acc[i][3] += wv * v4.w;
          }
        }
      }
    }
    if (ty * 8 < L) {
#pragma unroll
      for (int i = 0; i < 8; ++i) {
        const int t = ty * 8 + i;
        const float bb = p.cm_b()[(l * 4 + g) * 128 + t];
        const size_t tg = (size_t)(token0 + t);
        float4 u4 = *reinterpret_cast<const float4*>(p.P5() + tg * 1280 + 768 + g * 64 + tx * 4);
        *reinterpret_cast<uint2*>(p.xn() + tg * 1024 + 768 + g * 64 + tx * 4) =
            make_uint2(pack2(u4.x * (acc[i][0] + bb), u4.y * (acc[i][1] + bb)), pack2(u4.z * (acc[i][2] + bb), u4.w * (acc[i][3] + bb)));
      }
    }
  }
}

__device__ __forceinline__ int mono_key(float v) { int b = __float_as_int(v); return b ^ ((b >> 31) & 0x7FFFFFFF); }
__device__ __forceinline__ float mono_val(int k) { int b = k ^ ((k >> 31) & 0x7FFFFFFF); return __int_as_float(b); }

#define INS16(L, kv)                                   \
  {                                                    \
    int _v = (kv);                                     \
    _Pragma("unroll") for (int _j = 0; _j < 16; ++_j) { \
      int _t = max(L[_j], _v);                         \
      _v = min(L[_j], _v);                             \
      L[_j] = _t;                                      \
    }                                                  \
  }

__device__ __forceinline__ void ph_topk(const Params& p, int l, char* smem, int bid, int nblk) {
  const int tid = tid_opaque(), lane = tid & 63, w = tid >> 6;
  float* s_tile = reinterpret_cast<float*>(smem) + w * (64 * 33);
  int* s_list = reinterpret_cast<int*>(smem + 4 * 64 * 33 * 4) + w * (2 * 16 * 64);
  float* s_ss = reinterpret_cast<float*>(smem + 4 * 64 * 33 * 4 + 4 * 2 * 16 * 64 * 4) + w * 64;
  for (int u = bid * 4 + w; u < 264 * 8; u += nblk * 4) {
    const int tg = u >> 3, h = u & 7;
    const int t0 = tg * 64;
#pragma unroll 2
    for (int i = 0; i < 32; ++i) {
      const int tt = 2 * i + (lane >> 5);
      uint4 qv = *reinterpret_cast<const uint4*>(p.qp() + (size_t)(t0 + tt) * 2048 + h * 256 + (lane & 31) * 8);
      float a0 = bf_lo(qv.x), a1 = bf_hi(qv.x), a2 = bf_lo(qv.y), a3 = bf_hi(qv.y);
      float a4 = bf_lo(qv.z), a5 = bf_hi(qv.z), a6 = bf_lo(qv.w), a7 = bf_hi(qv.w);
      float ss = a0 * a0 + a1 * a1 + a2 * a2 + a3 * a3 + a4 * a4 + a5 * a5 + a6 * a6 + a7 * a7;
      ss = swap16_sum(row16_sum(ss));
      if ((lane & 31) == 0) s_ss[tt] = ss;
    }
    int L1[16], L2[16];
#pragma unroll
    for (int j = 0; j < 16; ++j) { L1[j] = (int)0x80000000; L2[j] = (int)0x80000000; }
#pragma unroll
    for (int c = 0; c < 2; ++c) {
#pragma unroll 1
      for (int ps = 0; ps < 4; ++ps) {
        const float* src = p.sc() + (size_t)t0 * 2048 + h * 256 + c * 128 + ps * 32;
#pragma unroll
        for (int j = 0; j < 8; ++j) {
          int tt = (lane >> 3) + 8 * j, f4 = lane & 7;
          float4 v = *reinterpret_cast<const float4*>(src + (size_t)tt * 2048 + f4 * 4);
          float* d = s_tile + tt * 33 + f4 * 4;
          d[0] = v.x; d[1] = v.y; d[2] = v.z; d[3] = v.w;
        }
#pragma unroll 4
        for (int s = 0; s < 32; ++s) {
          float v = s_tile[lane * 33 + s];
          int key = (mono_key(v) & ~127) | (127 - (ps * 32 + s));
          if (c == 0) INS16(L1, key) else INS16(L2, key)
        }
      }
    }
#pragma unroll
    for (int j = 0; j < 16; ++j) { s_list[(0 * 16 + j) * 64 + lane] = 127 - (L1[j] & 127); s_list[(1 * 16 + j) * 64 + lane] = 127 - (L2[j] & 127); }
    float v1[16], v2[16];
#pragma unroll
    for (int j = 0; j < 16; ++j) { v1[j] = mono_val(L1[j] & ~127); v2[j] = mono_val(L2[j] & ~127); }
    int LC[16];
#pragma unroll
    for (int j = 0; j < 16; ++j) LC[j] = (int)0x80000000;
#pragma unroll
    for (int i = 0; i < 16; ++i)
#pragma unroll
      for (int j = 0; j < 16; ++j)
        if ((i + 1) * (j + 1) <= 16) {
          int key = (mono_key(v1[i] + v2[j]) & ~255) | (255 - (i * 16 + j));
          INS16(LC, key)
        }
    const float scale = rsqrtf(s_ss[lane] * (1.f / 256.f) + EPS);
    float vs[16]; float den = 0.f;
    const float top = mono_val(LC[0] & ~255);
#pragma unroll
    for (int k = 0; k < 16; ++k) { vs[k] = __expf((mono_val(LC[k] & ~255) - top) * scale); den += vs[k]; }
    const float inv = 1.f / den;
    const size_t ob = (size_t)(t0 + lane) * 128 + h * 16;
#pragma unroll
    for (int k4 = 0; k4 < 4; ++k4) {
      int ee[4]; float gg[4], su[4];
#pragma unroll
      for (int q = 0; q < 4; ++q) {
        int k = k4 * 4 + q;
        int ci = 255 - (LC[k] & 255);
        int i1 = s_list[(0 * 16 + (ci >> 4)) * 64 + lane];
        int i2 = s_list[(1 * 16 + (ci & 15)) * 64 + lane];
        ee[q] = i1 * 128 + i2;
        gg[q] = vs[k] * inv * p.vs()[l * 16384 + ee[q]];
        su[q] = p.us()[l * 16384 + ee[q]];
      }
      *reinterpret_cast<int4*>(p.eidx() + ob + k4 * 4) = make_int4(ee[0], ee[1], ee[2], ee[3]);
      *reinterpret_cast<float4*>(p.egate() + ob + k4 * 4) = make_float4(gg[0], gg[1], gg[2], gg[3]);
      *reinterpret_cast<float4*>(p.esu() + ob + k4 * 4) = make_float4(su[0], su[1], su[2], su[3]);
    }
  }
}

__device__ __forceinline__ float dot16_fp8(const float* xf, uint4 u) {
  f32x2 a0 = __builtin_amdgcn_cvt_pk_f32_fp8(u.x, false), a1 = __builtin_amdgcn_cvt_pk_f32_fp8(u.x, true);
  f32x2 a2 = __builtin_amdgcn_cvt_pk_f32_fp8(u.y, false), a3 = __builtin_amdgcn_cvt_pk_f32_fp8(u.y, true);
  f32x2 a4 = __builtin_amdgcn_cvt_pk_f32_fp8(u.z, false), a5 = __builtin_amdgcn_cvt_pk_f32_fp8(u.z, true);
  f32x2 a6 = __builtin_amdgcn_cvt_pk_f32_fp8(u.w, false), a7 = __builtin_amdgcn_cvt_pk_f32_fp8(u.w, true);
  float s0 = xf[0] * a0.x, s1 = xf[1] * a0.y;
  s0 = fmaf(xf[2], a1.x, s0); s1 = fmaf(xf[3], a1.y, s1);
  s0 = fmaf(xf[4], a2.x, s0); s1 = fmaf(xf[5], a2.y, s1);
  s0 = fmaf(xf[6], a3.x, s0); s1 = fmaf(xf[7], a3.y, s1);
  s0 = fmaf(xf[8], a4.x, s0); s1 = fmaf(xf[9], a4.y, s1);
  s0 = fmaf(xf[10], a5.x, s0); s1 = fmaf(xf[11], a5.y, s1);
  s0 = fmaf(xf[12], a6.x, s0); s1 = fmaf(xf[13], a6.y, s1);
  s0 = fmaf(xf[14], a7.x, s0); s1 = fmaf(xf[15], a7.y, s1);
  return s0 + s1;
}
__device__ __forceinline__ void axpy16_fp8(float* y, float wgt, uint4 v) {
  f32x2 a0 = __builtin_amdgcn_cvt_pk_f32_fp8(v.x, false), a1 = __builtin_amdgcn_cvt_pk_f32_fp8(v.x, true);
  f32x2 a2 = __builtin_amdgcn_cvt_pk_f32_fp8(v.y, false), a3 = __builtin_amdgcn_cvt_pk_f32_fp8(v.y, true);
  f32x2 a4 = __builtin_amdgcn_cvt_pk_f32_fp8(v.z, false), a5 = __builtin_amdgcn_cvt_pk_f32_fp8(v.z, true);
  f32x2 a6 = __builtin_amdgcn_cvt_pk_f32_fp8(v.w, false), a7 = __builtin_amdgcn_cvt_pk_f32_fp8(v.w, true);
  y[0] = fmaf(wgt, a0.x, y[0]); y[1] = fmaf(wgt, a0.y, y[1]); y[2] = fmaf(wgt, a1.x, y[2]); y[3] = fmaf(wgt, a1.y, y[3]);
  y[4] = fmaf(wgt, a2.x, y[4]); y[5] = fmaf(wgt, a2.y, y[5]); y[6] = fmaf(wgt, a3.x, y[6]); y[7] = fmaf(wgt, a3.y, y[7]);
  y[8] = fmaf(wgt, a4.x, y[8]); y[9] = fmaf(wgt, a4.y, y[9]); y[10] = fmaf(wgt, a5.x, y[10]); y[11] = fmaf(wgt, a5.y, y[11]);
  y[12] = fmaf(wgt, a6.x, y[12]); y[13] = fmaf(wgt, a6.y, y[13]); y[14] = fmaf(wgt, a7.x, y[14]); y[15] = fmaf(wgt, a7.y, y[15]);
}

template <bool DRY>
__device__ __forceinline__ void ph_gather(const Params& p, int l, int bid, int nblk) {
  const int lane = tid_opaque() & 63, w = tid_opaque() >> 6;
  const unsigned char* u8 = p.ub8() + (size_t)l * 16384 * 1024;
  const unsigned char* v8 = p.vb8() + (size_t)l * 16384 * 1024;
  const unsigned loff = (unsigned)lane * 16u;
  for (int t = bid * 4 + w; t < NTOK; t += nblk * 4) {
    float xf[16];
    {
      const uint4 xa = *reinterpret_cast<const uint4*>(p.xn() + (size_t)t * 1024 + lane * 16);
      const uint4 xb = *reinterpret_cast<const uint4*>(p.xn() + (size_t)t * 1024 + lane * 16 + 8);
      xf[0] = bf_lo(xa.x); xf[1] = bf_hi(xa.x); xf[2] = bf_lo(xa.y); xf[3] = bf_hi(xa.y);
      xf[4] = bf_lo(xa.z); xf[5] = bf_hi(xa.z); xf[6] = bf_lo(xa.w); xf[7] = bf_hi(xa.w);
      xf[8] = bf_lo(xb.x); xf[9] = bf_hi(xb.x); xf[10] = bf_lo(xb.y); xf[11] = bf_hi(xb.y);
      xf[12] = bf_lo(xb.z); xf[13] = bf_hi(xb.z); xf[14] = bf_lo(xb.w); xf[15] = bf_hi(xb.w);
    }
    const int e_lo = p.eidx()[(size_t)t * 128 + lane], e_hi = p.eidx()[(size_t)t * 128 + 64 + lane];
    const float g_lo = p.egate()[(size_t)t * 128 + lane], g_hi = p.egate()[(size_t)t * 128 + 64 + lane];
    const float s_lo = p.esu()[(size_t)t * 128 + lane], s_hi = p.esu()[(size_t)t * 128 + 64 + lane];
    float y[16];
#pragma unroll
    for (int i = 0; i < 16; ++i) y[i] = 0.f;
#pragma unroll 1
    for (int k0 = 0; k0 < 128; k0 += 8) {
      uint4 ur[8], vr[8];
#pragma unroll
      for (int q = 0; q < 8; ++q) {
        const int kk = (k0 & 63) + q;
        const int e = (k0 < 64) ? __builtin_amdgcn_readlane(e_lo, kk) : __builtin_amdgcn_readlane(e_hi, kk);
        ur[q] = *reinterpret_cast<const uint4*>(u8 + (size_t)e * 1024 + loff);
        vr[q] = *reinterpret_cast<const uint4*>(v8 + (size_t)e * 1024 + loff);
      }
#pragma unroll
      for (int q = 0; q < 8; ++q) {
        const int kk = (k0 & 63) + q;
        const float gt = __int_as_float((k0 < 64) ? __builtin_amdgcn_readlane(__float_as_int(g_lo), kk) : __builtin_amdgcn_readlane(__float_as_int(g_hi), kk));
        const float su = __int_as_float((k0 < 64) ? __builtin_amdgcn_readlane(__float_as_int(s_lo), kk) : __builtin_amdgcn_readlane(__float_as_int(s_hi), kk));
        float d = wave_sum(dot16_fp8(xf, ur[q])) * su;
        const float wgt = gt * gelu_exact(d);
        axpy16_fp8(y, wgt, vr[q]);
      }
    }
    if (DRY) {
#pragma unroll
      for (int i = 0; i < 16; ++i) asm volatile("" ::"v"(y[i]));
      continue;
    }
    float* xr = p.x() + (size_t)t * 1024 + lane * 16;
#pragma unroll
    for (int j = 0; j < 4; ++j) {
      float4 a = reinterpret_cast<float4*>(xr)[j];
      a.x += y[4 * j]; a.y += y[4 * j + 1]; a.z += y[4 * j + 2]; a.w += y[4 * j + 3];
      reinterpret_cast<float4*>(xr)[j] = a;
    }
  }
}

enum { PH_PREP = 0, PH_NORM1, PH_GEMM_IN, PH_ATTN, PH_MLCONV, PH_MCHAIN, PH_MLU, PH_MLSCAN, PH_MLOUT, PH_CMLP,
       PH_GEMM_OUT, PH_NORM2, PH_GEMM_PQ, PH_GEMM_SC, PH_TOPK, PH_GATHER, PH_FINAL };

__device__ __forceinline__ Params phase_params(const Params& kp, bool with_inputs) {
  Params q;
  size_t z = 0;
  asm volatile("" : "+s"(z));
  q.out = kp.out + z;
  q.ws = kp.ws + z;
  q.in[0] = kp.in[0] + z;
  q.in[1] = kp.in[1] + z;
  if (with_inputs) {
#pragma unroll
    for (int i = 2; i < 30; ++i) q.in[i] = kp.in[i] + z;
  }
  return q;
}


#define XB_TMO      128
#define XB_XCNT(j)  (256  + 64 * (j))
#define XB_XSUB(j)  (1280 + 64 * (j))
#define XB_XGEN(j)  (2304 + 64 * (j))
#define XB_TOP      3328
#define XB_TOPGEN   3392
#define XCD_BAR_WORDS 3456
#define XB_SPIN_CAP (1u << 22)
#define LAS __attribute__((address_space(3)))
__device__ __forceinline__ unsigned xb_ld(unsigned* p)              { return __hip_atomic_load(p, __ATOMIC_RELAXED, __HIP_MEMORY_SCOPE_AGENT); }
__device__ __forceinline__ unsigned xb_add(unsigned* p, unsigned v) { return __hip_atomic_fetch_add(p, v, __ATOMIC_RELAXED, __HIP_MEMORY_SCOPE_AGENT); }
__device__ __forceinline__ unsigned xb_xcc_id() { return (unsigned)__builtin_amdgcn_s_getreg((3 << 11) | 20) & 0xFu; }
#define XB_SPIN(cond, bar) do { unsigned _sp = 0; while (cond) { __builtin_amdgcn_s_sleep(1); \
    if ((++_sp & 255u) == 0u) { if (xb_ld(&(bar)[XB_TMO])) break; if (_sp > XB_SPIN_CAP) { atomicAdd(&(bar)[XB_TMO], 1u); break; } } } } while (0)

struct XcdBarrier { unsigned* bar; unsigned x; volatile LAS unsigned* st; };

__device__ __forceinline__ XcdBarrier xcd_barrier_post(unsigned* bar, volatile LAS unsigned* st) {
  XcdBarrier b; b.bar = bar; b.x = xb_xcc_id(); b.st = st;
  if (threadIdx.x == 0) (void)xb_add(&bar[XB_XCNT(b.x)], 1u);
  return b;
}
__device__ __forceinline__ void xcd_barrier_complete(unsigned* bar, unsigned x, unsigned& nloc, unsigned& nx) {
  const unsigned G = gridDim.x * gridDim.y * gridDim.z;
  unsigned sum, cnt, mine, sp = 0u;
  for (;;) {
    sum = 0u; cnt = 0u; mine = 0u;
#pragma unroll
    for (unsigned j = 0; j < 16; ++j) { const unsigned c = xb_ld(&bar[XB_XCNT(j)]); sum += c; cnt += (c > 0u) ? 1u : 0u; mine = (j == x) ? c : mine; }
    if (sum == G) break;
    __builtin_amdgcn_s_sleep(1);
    if ((++sp & 255u) == 0u) { if (xb_ld(&bar[XB_TMO])) break; if (sp > XB_SPIN_CAP) { atomicAdd(&bar[XB_TMO], 1u); break; } }
  }
  nloc = mine > 0u ? mine : 1u; nx = cnt > 0u ? cnt : 1u;
}
__device__ __forceinline__ void xcd_barrier(const XcdBarrier& b) {
  asm volatile("s_waitcnt vmcnt(0)" ::: "memory");
  __syncthreads();
  if (threadIdx.x == 0) {
    unsigned* bar = b.bar;
    __builtin_amdgcn_s_waitcnt(0);
    unsigned nloc = b.st[0], nx = b.st[1];
    if (nloc == 0u) { xcd_barrier_complete(bar, b.x, nloc, nx); b.st[0] = nloc; b.st[1] = nx; }
    const unsigned old = xb_add(&bar[XB_XSUB(b.x)], 1u);
    const unsigned gen = old / nloc;
    if (old + 1u == (gen + 1u) * nloc) {
      __builtin_amdgcn_fence(__ATOMIC_RELEASE, "agent");
      asm volatile("s_waitcnt vmcnt(0)" ::: "memory");
      const unsigned og = xb_add(&bar[XB_TOP], 1u);
      const unsigned tg = og / nx;
      if (og + 1u == (tg + 1u) * nx) xb_add(&bar[XB_TOPGEN], 1u);
      else XB_SPIN(xb_ld(&bar[XB_TOPGEN]) == tg, bar);
      __builtin_amdgcn_fence(__ATOMIC_ACQUIRE, "agent");
      xb_add(&bar[XB_XGEN(b.x)], 1u);
      asm volatile("s_waitcnt vmcnt(0)" ::: "memory");
    } else {
      XB_SPIN(xb_ld(&bar[XB_XGEN(b.x)]) == gen, bar);
      __builtin_amdgcn_fence(__ATOMIC_ACQUIRE, "agent");
      asm volatile("s_waitcnt vmcnt(0)" ::: "memory");
    }
  }
  __syncthreads();
}

#define GSYNC() xcd_barrier(xb)
#define PP(wi) phase_params(p, wi)
#define BN bid_opaque(bid), nblk_opaque(nblk)

template <int L>
__device__ __forceinline__ void layer_phases(const Params& p, char* smem, const XcdBarrier& xb, int bid, int nblk) {
  ph_rmsnorm<0>(PP(false), L, BN);
  GSYNC();
  ph_gemm<EPI_WIN>(PP(false), L, smem, BN);
  GSYNC();
  ph_attn(PP(false), L, smem, BN);
  ph_mlconv(PP(false), L, smem, BN);
  ph_mchain(PP(false), L, BN);
  ph_cmlp(PP(false), L, smem, BN);
  GSYNC();
  ph_mlU(PP(false), L, smem, BN);
  GSYNC();
  ph_mlscan(PP(false), L, BN);
  GSYNC();
  ph_mlout(PP(false), L, smem, BN);
  GSYNC();
  ph_gemm<EPI_WOUT>(PP(false), L, smem, BN);
  GSYNC();
  ph_rmsnorm<1>(PP(false), L, BN);
  GSYNC();
  ph_gemm<EPI_PQ>(PP(false), L, smem, BN);
  GSYNC();
  ph_gemm<EPI_SC>(PP(false), L, smem, BN);
  GSYNC();
  ph_topk(PP(false), L, smem, BN);
  GSYNC();
  ph_gather<false>(PP(false), L, BN);
  GSYNC();
}

__global__ void __launch_bounds__(256, 2) mega_kernel(Params p) {
  __shared__ __attribute__((aligned(16))) char smem[SMEM_BYTES];
  __shared__ uint4 xb_words;
  cg::grid_group grid = cg::this_grid();
  const int bid = blockIdx.x, nblk = gridDim.x;
  if (threadIdx.x == 0) xb_words = make_uint4(0u, 0u, 0u, 0u);
  __syncthreads();
  XcdBarrier xb = xcd_barrier_post(reinterpret_cast<unsigned*>(p.ws), (volatile LAS unsigned*)&xb_words);
  grid.sync();
  ph_prep(PP(true), smem, BN);
  GSYNC();
  layer_phases<0>(p, smem, xb, bid, nblk);
  layer_phases<1>(p, smem, xb, bid, nblk);
  ph_rmsnorm<2>(PP(false), 0, BN);
}

static inline size_t align_up(size_t v, size_t a) { return (v + a - 1) / a * a; }

extern "C" void kernel_launch(void* const* d_in, const int* in_sizes, int n_in, void* d_out, int out_size, void* d_ws,
                              size_t ws_size, hipStream_t stream) {
  Params p{};
  for (int i = 0; i < 30; ++i) p.in[i] = reinterpret_cast<const float*>(d_in[i]);
  p.out = reinterpret_cast<float*>(d_out);
  p.ws = reinterpret_cast<char*>(d_ws);
  if (WS_NEED > ws_size) { fprintf(stderr, "workspace too small: need %zu have %zu\n", (size_t)WS_NEED, ws_size); return; }
  static int grid_blocks = 0;
  if (!grid_blocks) {
    int dev = 0, cus = 0, per_cu = 0;
    hipGetDevice(&dev);
    hipDeviceGetAttribute(&cus, hipDeviceAttributeMultiprocessorCount, dev);
    hipOccupancyMaxActiveBlocksPerMultiprocessor(&per_cu, mega_kernel, 256, 0);
    if (per_cu > 2) per_cu = 2;
    if (per_cu < 1) per_cu = 1;
    grid_blocks = cus * per_cu;
  }
  hipMemsetAsync(d_ws, 0, 16384, stream);
  void* args[] = {&p};
  hipError_t e = hipLaunchCooperativeKernel((void*)mega_kernel, dim3(grid_blocks), dim3(256), args, 0, stream);
  if (e != hipSuccess) fprintf(stderr, "cooperative launch failed: %s (grid %d)\n", hipGetErrorString(e), grid_blocks);
}
```

```cpp
#include <hip/hip_runtime.h>
#include <hip/hip_cooperative_groups.h>
#include <cstdio>
#include <cstdint>

namespace cg = cooperative_groups;

typedef unsigned short bf16_t;
typedef __attribute__((ext_vector_type(8))) __bf16 bf16x8;
typedef __attribute__((ext_vector_type(2))) __bf16 bf16x2;
typedef __attribute__((ext_vector_type(16))) float f32x16;
typedef __attribute__((ext_vector_type(2))) float f32x2;

#define D_MODEL 1024
#define NTOK 16896
#define NPROMPT 16384
#define SEQ 4096
#define NIN 2816
#define EPS 1e-6f
#define LOG2E 1.4426950408889634f
#define SKEYS 1088
#define NCU_UNITS 1056

constexpr size_t O_Y_P = 0;
constexpr size_t O_Y_S = O_Y_P + 16777216;
constexpr size_t O_K_P = O_Y_S + 524288;
constexpr size_t O_V_P = O_K_P + 16777216;
constexpr size_t O_C_P = O_V_P + 16777216;
constexpr size_t O_N_P = O_C_P + 131072;
constexpr size_t O_M_P = O_N_P + 2048;
constexpr size_t O_CONV_P = O_M_P + 32;
constexpr size_t O_K_S = O_CONV_P + 6144;
constexpr size_t O_V_S = O_K_S + 524288;
constexpr size_t O_C_S = O_V_S + 524288;
constexpr size_t O_N_S = O_C_S + 262144;
constexpr size_t O_M_S = O_N_S + 4096;
constexpr size_t O_CONV_S = O_M_S + 64;
constexpr size_t O_CMV_S = O_CONV_S + 12288;

constexpr size_t al256(size_t v) { return (v + 255) / 256 * 256; }
constexpr int SP_st_c = 0;
constexpr int SP_st_n = 262144;
constexpr int SP_st_m = 266240;
constexpr int SP_st_conv = 266304;
constexpr int SP_norm1_g = 278592;
constexpr int SP_da_subln_g = 280640;
constexpr int SP_ml_conv_w = 280896;
constexpr int SP_ml_conv_b = 282944;
constexpr int SP_ml_wq = 283456;
constexpr int SP_ml_wk = 316224;
constexpr int SP_ml_gate_b = 348992;
constexpr int SP_ml_norm_g = 349056;
constexpr int SP_ml_skip = 349568;
constexpr int SP_cm_norm_g = 350080;
constexpr int SP_cm_ws = 350592;
constexpr int SP_cm_b = 481664;
constexpr int SP_norm2_g = 482688;
constexpr int SP_final_g = 484736;
constexpr int SP_TOTAL = 485760;
constexpr size_t WS_bar = 0;
constexpr size_t WS_lam = al256(WS_bar + 16384);
constexpr size_t WS_lut = al256(WS_lam + (256));
constexpr size_t WS_sp = al256(WS_lut + (4*256*4));
constexpr size_t WS_wt_in = al256(WS_sp + (SP_TOTAL*4));
constexpr size_t WS_wg = al256(WS_wt_in + ((size_t)2*NIN*1024*2));
constexpr size_t WS_wt_out = al256(WS_wg + ((size_t)2*8*1024*4));
constexpr size_t WS_wt_pq = al256(WS_wt_out + ((size_t)2*1024*1024*2));
constexpr size_t WS_keysb = al256(WS_wt_pq + ((size_t)2*2048*1024*2));
constexpr size_t WS_ub8 = al256(WS_keysb + ((size_t)2*16*128*128*2));
constexpr size_t WS_vb8 = al256(WS_ub8 + ((size_t)2*16384*1024));
constexpr size_t WS_us = al256(WS_vb8 + ((size_t)2*16384*1024));
constexpr size_t WS_vs = al256(WS_us + ((size_t)2*16384*4));
constexpr size_t WS_Kbs = al256(WS_vs + ((size_t)2*16384*4));
constexpr size_t WS_Vts = al256(WS_Kbs + ((size_t)2*8*SKEYS*512*2));
constexpr size_t WS_x = al256(WS_Vts + ((size_t)2*8*4*128*SKEYS*2));
constexpr size_t WS_xn = al256(WS_x + ((size_t)NTOK*1024*4));
constexpr size_t WS_R0 = al256(WS_xn + ((size_t)NTOK*1024*2));
constexpr size_t WS_R0x = WS_R0;
constexpr size_t WS_Qb = al256(WS_R0x + (0));
constexpr size_t WS_Kb = al256(WS_Qb + ((size_t)NTOK*512*2));
constexpr size_t WS_Vt = al256(WS_Kb + ((size_t)NPROMPT*512*2));
constexpr size_t WS_P5 = al256(WS_Vt + ((size_t)16*128*SEQ*2));
constexpr size_t WS_ig = al256(WS_P5 + ((size_t)NTOK*1280*4));
constexpr size_t WS_lf = al256(WS_ig + ((size_t)NTOK*4*4));
constexpr size_t WS_Fc = al256(WS_lf + ((size_t)NTOK*4*4));
constexpr size_t WS_cc = al256(WS_Fc + ((size_t)NTOK*4*4));
constexpr size_t WS_qm = al256(WS_cc + ((size_t)NTOK*256*4));
constexpr size_t WS_km = al256(WS_qm + ((size_t)NTOK*256*4));
constexpr size_t WS_mst = al256(WS_km + ((size_t)NTOK*256*4));
constexpr size_t WS_mnx = al256(WS_mst + (NCU_UNITS*4));
constexpr size_t WS_wcs = al256(WS_mnx + (NCU_UNITS*4));
constexpr size_t WS_FLs = al256(WS_wcs + (NCU_UNITS*4));
constexpr size_t WS_mxt = al256(WS_FLs + (NCU_UNITS*4));
constexpr size_t WS_U = al256(WS_mxt + (NCU_UNITS*4));
constexpr size_t WS_un = al256(WS_U + ((size_t)NCU_UNITS*4096*4));
constexpr size_t WS_Cst = al256(WS_un + ((size_t)NCU_UNITS*64*4));
constexpr size_t WS_nst = al256(WS_Cst + ((size_t)NCU_UNITS*4096*4));
constexpr size_t WS_END_MIXER = al256(WS_nst + ((size_t)NCU_UNITS*64*4));
constexpr size_t WS_qp = al256(WS_R0x + (0));
constexpr size_t WS_sc = al256(WS_qp + ((size_t)NTOK*2048*2));
constexpr size_t WS_eidx = al256(WS_sc + ((size_t)NTOK*2048*4));
constexpr size_t WS_egate = al256(WS_eidx + ((size_t)NTOK*128*4));
constexpr size_t WS_esu = al256(WS_egate + ((size_t)NTOK*128*4));
constexpr size_t WS_END_PEER = al256(WS_esu + ((size_t)NTOK*128*4));
constexpr size_t WS_NEED = WS_END_MIXER > WS_END_PEER ? WS_END_MIXER : WS_END_PEER;

struct Params {
  const float* in[30];
  float* out;
  char* ws;
  __device__ __forceinline__ const float* x_prompt() const { return in[0]; }
  __device__ __forceinline__ const float* x_sample() const { return in[1]; }
  __device__ __forceinline__ const float* cache_k() const { return in[2]; }
  __device__ __forceinline__ const float* cache_v() const { return in[3]; }
  __device__ __forceinline__ const float* w_in() const { return in[9]; }
  __device__ __forceinline__ const float* da_lambda() const { return in[10]; }
  __device__ __forceinline__ const float* rel_table() const { return in[12]; }
  __device__ __forceinline__ const float* w_out() const { return in[23]; }
  __device__ __forceinline__ const float* peer_wq() const { return in[25]; }
  __device__ __forceinline__ const float* peer_keys() const { return in[26]; }
  __device__ __forceinline__ const float* peer_u() const { return in[27]; }
  __device__ __forceinline__ const float* peer_v() const { return in[28]; }
  __device__ __forceinline__ const float* st_c() const { return reinterpret_cast<const float*>(ws + WS_sp) + SP_st_c; }
  __device__ __forceinline__ const float* st_n() const { return reinterpret_cast<const float*>(ws + WS_sp) + SP_st_n; }
  __device__ __forceinline__ const float* st_m() const { return reinterpret_cast<const float*>(ws + WS_sp) + SP_st_m; }
  __device__ __forceinline__ const float* st_conv() const { return reinterpret_cast<const float*>(ws + WS_sp) + SP_st_conv; }
  __device__ __forceinline__ const float* norm1_g() const { return reinterpret_cast<const float*>(ws + WS_sp) + SP_norm1_g; }
  __device__ __forceinline__ const float* da_subln_g() const { return reinterpret_cast<const float*>(ws + WS_sp) + SP_da_subln_g; }
  __device__ __forceinline__ const float* ml_conv_w() const { return reinterpret_cast<const float*>(ws + WS_sp) + SP_ml_conv_w; }
  __device__ __forceinline__ const float* ml_conv_b() const { return reinterpret_cast<const float*>(ws + WS_sp) + SP_ml_conv_b; }
  __device__ __forceinline__ const float* ml_wq() const { return reinterpret_cast<const float*>(ws + WS_sp) + SP_ml_wq; }
  __device__ __forceinline__ const float* ml_wk() const { return reinterpret_cast<const float*>(ws + WS_sp) + SP_ml_wk; }
  __device__ __forceinline__ const float* ml_gate_b() const { return reinterpret_cast<const float*>(ws + WS_sp) + SP_ml_gate_b; }
  __device__ __forceinline__ const float* ml_norm_g() const { return reinterpret_cast<const float*>(ws + WS_sp) + SP_ml_norm_g; }
  __device__ __forceinline__ const float* ml_skip() const { return reinterpret_cast<const float*>(ws + WS_sp) + SP_ml_skip; }
  __device__ __forceinline__ const float* cm_norm_g() const { return reinterpret_cast<const float*>(ws + WS_sp) + SP_cm_norm_g; }
  __device__ __forceinline__ const float* cm_ws() const { return reinterpret_cast<const float*>(ws + WS_sp) + SP_cm_ws; }
  __device__ __forceinline__ const float* cm_b() const { return reinterpret_cast<const float*>(ws + WS_sp) + SP_cm_b; }
  __device__ __forceinline__ const float* norm2_g() const { return reinterpret_cast<const float*>(ws + WS_sp) + SP_norm2_g; }
  __device__ __forceinline__ const float* final_g() const { return reinterpret_cast<const float*>(ws + WS_sp) + SP_final_g; }
  __device__ __forceinline__ float* lam() const { return reinterpret_cast<float*>(ws + WS_lam); }
  __device__ __forceinline__ float* lut() const { return reinterpret_cast<float*>(ws + WS_lut); }
  __device__ __forceinline__ float* sp() const { return reinterpret_cast<float*>(ws + WS_sp); }
  __device__ __forceinline__ bf16_t* wt_in() const { return reinterpret_cast<bf16_t*>(ws + WS_wt_in); }
  __device__ __forceinline__ float* wg() const { return reinterpret_cast<float*>(ws + WS_wg); }
  __device__ __forceinline__ bf16_t* wt_out() const { return reinterpret_cast<bf16_t*>(ws + WS_wt_out); }
  __device__ __forceinline__ bf16_t* wt_pq() const { return reinterpret_cast<bf16_t*>(ws + WS_wt_pq); }
  __device__ __forceinline__ bf16_t* keysb() const { return reinterpret_cast<bf16_t*>(ws + WS_keysb); }
  __device__ __forceinline__ unsigned char* ub8() const { return reinterpret_cast<unsigned char*>(ws + WS_ub8); }
  __device__ __forceinline__ unsigned char* vb8() const { return reinterpret_cast<unsigned char*>(ws + WS_vb8); }
  __device__ __forceinline__ float* us() const { return reinterpret_cast<float*>(ws + WS_us); }
  __device__ __forceinline__ float* vs() const { return reinterpret_cast<float*>(ws + WS_vs); }
  __device__ __forceinline__ bf16_t* Kbs() const { return reinterpret_cast<bf16_t*>(ws + WS_Kbs); }
  __device__ __forceinline__ bf16_t* Vts() const { return reinterpret_cast<bf16_t*>(ws + WS_Vts); }
  __device__ __forceinline__ float* x() const { return reinterpret_cast<float*>(ws + WS_x); }
  __device__ __forceinline__ bf16_t* xn() const { return reinterpret_cast<bf16_t*>(ws + WS_xn); }
  __device__ __forceinline__ bf16_t* Qb() const { return reinterpret_cast<bf16_t*>(ws + WS_Qb); }
  __device__ __forceinline__ bf16_t* Kb() const { return reinterpret_cast<bf16_t*>(ws + WS_Kb); }
  __device__ __forceinline__ bf16_t* Vt() const { return reinterpret_cast<bf16_t*>(ws + WS_Vt); }
  __device__ __forceinline__ float* P5() const { return reinterpret_cast<float*>(ws + WS_P5); }
  __device__ __forceinline__ float* ig() const { return reinterpret_cast<float*>(ws + WS_ig); }
  __device__ __forceinline__ float* lf() const { return reinterpret_cast<float*>(ws + WS_lf); }
  __device__ __forceinline__ float* Fc() const { return reinterpret_cast<float*>(ws + WS_Fc); }
  __device__ __forceinline__ float* cc() const { return reinterpret_cast<float*>(ws + WS_cc); }
  __device__ __forceinline__ float* qm() const { return reinterpret_cast<float*>(ws + WS_qm); }
  __device__ __forceinline__ float* km() const { return reinterpret_cast<float*>(ws + WS_km); }
  __device__ __forceinline__ float* mst() const { return reinterpret_cast<float*>(ws + WS_mst); }
  __device__ __forceinline__ float* mnx() const { return reinterpret_cast<float*>(ws + WS_mnx); }
  __device__ __forceinline__ float* wcs() const { return reinterpret_cast<float*>(ws + WS_wcs); }
  __device__ __forceinline__ float* FLs() const { return reinterpret_cast<float*>(ws + WS_FLs); }
  __device__ __forceinline__ float* mxt() const { return reinterpret_cast<float*>(ws + WS_mxt); }
  __device__ __forceinline__ float* U() const { return reinterpret_cast<float*>(ws + WS_U); }
  __device__ __forceinline__ float* un() const { return reinterpret_cast<float*>(ws + WS_un); }
  __device__ __forceinline__ float* Cst() const { return reinterpret_cast<float*>(ws + WS_Cst); }
  __device__ __forceinline__ float* nst() const { return reinterpret_cast<float*>(ws + WS_nst); }
  __device__ __forceinline__ bf16_t* qp() const { return reinterpret_cast<bf16_t*>(ws + WS_qp); }
  __device__ __forceinline__ float* sc() const { return reinterpret_cast<float*>(ws + WS_sc); }
  __device__ __forceinline__ int* eidx() const { return reinterpret_cast<int*>(ws + WS_eidx); }
  __device__ __forceinline__ float* egate() const { return reinterpret_cast<float*>(ws + WS_egate); }
  __device__ __forceinline__ float* esu() const { return reinterpret_cast<float*>(ws + WS_esu); }
};

__device__ __forceinline__ unsigned pack2(float a, float b) {
  f32x2 v = {a, b};
  bf16x2 r = __builtin_convertvector(v, bf16x2);
  return *reinterpret_cast<unsigned*>(&r);
}
__device__ __forceinline__ bf16_t f2bf(float a) { return (bf16_t)(pack2(a, 0.f) & 0xFFFFu); }
__device__ __forceinline__ float bf_lo(unsigned u) { return __uint_as_float(u << 16); }
__device__ __forceinline__ float bf_hi(unsigned u) { return __uint_as_float(u & 0xFFFF0000u); }
__device__ __forceinline__ float gelu_exact(float x) { return 0.5f * x * (1.f + erff(x * 0.70710678118654752f)); }
__device__ __forceinline__ float sigmoidf_(float x) { return 1.f / (1.f + __expf(-x)); }
template <int CTRL>
__device__ __forceinline__ float dpp_f(float v) {
  return __builtin_bit_cast(float, __builtin_amdgcn_update_dpp(0, __builtin_bit_cast(int, v), CTRL, 0xf, 0xf, true));
}
__device__ __forceinline__ float swap16_sum(float x) {
  auto s = __builtin_amdgcn_permlane16_swap(__float_as_uint(x), __float_as_uint(x), false, false);
  return __uint_as_float(s[0]) + __uint_as_float(s[1]);
}
__device__ __forceinline__ float swap32_sum(float x) {
  auto s = __builtin_amdgcn_permlane32_swap(__float_as_uint(x), __float_as_uint(x), false, false);
  return __uint_as_float(s[0]) + __uint_as_float(s[1]);
}
__device__ __forceinline__ float swap16_max(float x) {
  auto s = __builtin_amdgcn_permlane16_swap(__float_as_uint(x), __float_as_uint(x), false, false);
  return fmaxf(__uint_as_float(s[0]), __uint_as_float(s[1]));
}
__device__ __forceinline__ float swap32_max(float x) {
  auto s = __builtin_amdgcn_permlane32_swap(__float_as_uint(x), __float_as_uint(x), false, false);
  return fmaxf(__uint_as_float(s[0]), __uint_as_float(s[1]));
}
__device__ __forceinline__ float row16_sum(float v) {
  v += dpp_f<0xB1>(v); v += dpp_f<0x4E>(v); v += dpp_f<0x141>(v); v += dpp_f<0x140>(v);
  return v;
}
__device__ __forceinline__ float row16_max(float v) {
  v = fmaxf(v, dpp_f<0xB1>(v)); v = fmaxf(v, dpp_f<0x4E>(v)); v = fmaxf(v, dpp_f<0x141>(v)); v = fmaxf(v, dpp_f<0x140>(v));
  return v;
}
__device__ __forceinline__ float wave_sum(float v) { return swap32_sum(swap16_sum(row16_sum(v))); }
__device__ __forceinline__ float wave_max(float v) { return swap32_max(swap16_max(row16_max(v))); }
__device__ __forceinline__ const float* xrow_in(const Params& p, int l, int t) {
  if (l == 0) return (t < NPROMPT) ? p.x_prompt() + (size_t)t * D_MODEL : p.x_sample() + (size_t)(t - NPROMPT) * D_MODEL;
  return p.x() + (size_t)t * D_MODEL;
}
__device__ __forceinline__ bf16x8 as_bf16x8(uint4 v) { return *reinterpret_cast<bf16x8*>(&v); }

__device__ __forceinline__ int tid_opaque() { int t = threadIdx.x; asm volatile("" : "+v"(t)); return t; }
__device__ __forceinline__ int sgpr_opaque(int v) { asm volatile("" : "+s"(v)); return v; }
__device__ __forceinline__ int bid_opaque(int v) { asm volatile("" : "+s"(v)); __builtin_assume(v >= 0); __builtin_assume(v < 1024); return v; }
__device__ __forceinline__ int nblk_opaque(int v) { asm volatile("" : "+s"(v)); __builtin_assume(v >= 1); __builtin_assume(v <= 1024); return v; }
#define LAS __attribute__((address_space(3)))
#ifndef PROBE
#define PROBE 0
#endif
#define SMEM_BYTES 73728

__device__ __forceinline__ void transpose_tile(const float* __restrict__ src, int lds, bf16_t* __restrict__ dst, int K, int n0, int k0,
                               int gate_skip, float* tile  ) {
  const int tid = tid_opaque();
  const int c = tid & 63, r0 = tid >> 6;
  int n = n0 + c;
  int col = n + ((gate_skip && n >= 2304) ? 8 : 0);
#pragma unroll 4
  for (int j = 0; j < 16; ++j) {
    int r = r0 + 4 * j;
    tile[r * 65 + c] = src[(size_t)(k0 + r) * lds + col];
  }
  __syncthreads();
  const int nn = tid >> 2, kg = (tid & 3) * 16;
  unsigned w[8];
#pragma unroll
  for (int j = 0; j < 8; ++j) w[j] = pack2(tile[(kg + 2 * j) * 65 + nn], tile[(kg + 2 * j + 1) * 65 + nn]);
  uint4* d = reinterpret_cast<uint4*>(dst + (size_t)(n0 + nn) * K + k0 + kg);
  d[0] = make_uint4(w[0], w[1], w[2], w[3]);
  d[1] = make_uint4(w[4], w[5], w[6], w[7]);
  __syncthreads();
}

__device__ __forceinline__ int rel_bucket_dev(int rel) {
  int ret = rel > 0 ? 16 : 0;
  int n = rel < 0 ? -rel : rel;
  int b;
  if (n < 8) b = n;
  else if (n < 12) b = 8;
  else if (n < 16) b = 9;
  else if (n < 23) b = 10;
  else if (n < 32) b = 11;
  else if (n < 46) b = 12;
  else if (n < 64) b = 13;
  else if (n < 91) b = 14;
  else b = 15;
  return ret + b;
}

__device__ __forceinline__ void ph_prep(const Params& p, char* smem, int bid, int nblk) {
  const int tid = tid_opaque();
  float* tile = reinterpret_cast<float*>(smem);
  for (int u = bid; u < 2 * 1472; u += nblk) {
    int l = u / 1472, r = u % 1472;
    if (r < 704) {
      int nt = r / 16, kt = r % 16;
      transpose_tile(p.w_in() + (size_t)l * 1024 * 2824, 2824, p.wt_in() + (size_t)l * NIN * 1024, 1024, nt * 64, kt * 64, 1, tile);
    } else if (r < 960) {
      r -= 704; int nt = r / 16, kt = r % 16;
      transpose_tile(p.w_out() + (size_t)l * 1024 * 1024, 1024, p.wt_out() + (size_t)l * 1024 * 1024, 1024, nt * 64, kt * 64, 0, tile);
    } else {
      r -= 960; int nt = r / 16, kt = r % 16;
      transpose_tile(p.peer_wq() + (size_t)l * 1024 * 2048, 2048, p.wt_pq() + (size_t)l * 2048 * 1024, 1024, nt * 64, kt * 64, 0, tile);
    }
  }
  for (int u = bid; u < 1024; u += nblk) {
    int kt = u & 15, h = (u >> 4) & 3, b = (u >> 6) & 7, l = u >> 9;
    const float* src = p.cache_v() + (((size_t)(l * 8 + b) * 1024 + kt * 64) * 4 + h) * 128;
    {
      int c = tid & 127, r0 = tid >> 7;
      for (int j = 0; j < 32; ++j) { int r = r0 + 2 * j; tile[r * 129 + c] = src[(size_t)r * 512 + c]; }
    }
    __syncthreads();
    {
      int dv = tid >> 1, half = tid & 1;
      bf16_t* dst = p.Vts() + ((size_t)((l * 8 + b) * 4 + h) * 128 + dv) * SKEYS + kt * 64 + half * 32;
      unsigned w[16];
#pragma unroll
      for (int j = 0; j < 16; ++j) {
        int pos0 = half * 32 + 2 * j;
        int blk = (pos0 >> 2) & 3;
        int oblk = (blk == 1) ? 2 : (blk == 2 ? 1 : blk);
        int key0 = (pos0 & ~15) + oblk * 4 + (pos0 & 3);
        w[j] = pack2(tile[key0 * 129 + dv], tile[(key0 + 1) * 129 + dv]);
      }
      uint4* d4 = reinterpret_cast<uint4*>(dst);
      d4[0] = make_uint4(w[0], w[1], w[2], w[3]);
      d4[1] = make_uint4(w[4], w[5], w[6], w[7]);
      d4[2] = make_uint4(w[8], w[9], w[10], w[11]);
      d4[3] = make_uint4(w[12], w[13], w[14], w[15]);
    }
    __syncthreads();
  }
  const size_t gtid = (size_t)bid * 256 + tid, gsz = (size_t)nblk * 256;
  {
    const int lane = tid & 63, wv = tid >> 6;
    for (int r = bid * 4 + wv; r < 2 * 32768; r += nblk * 4) {
      const int tab = r >> 15, row = r & 32767;
      const float* src = (tab == 0 ? p.peer_u() : p.peer_v()) + (size_t)row * 1024 + lane * 16;
      float4 f0 = reinterpret_cast<const float4*>(src)[0], f1 = reinterpret_cast<const float4*>(src)[1];
      float4 f2 = reinterpret_cast<const float4*>(src)[2], f3 = reinterpret_cast<const float4*>(src)[3];
      float am = fmaxf(fmaxf(fmaxf(fabsf(f0.x), fabsf(f0.y)), fmaxf(fabsf(f0.z), fabsf(f0.w))),
                       fmaxf(fmaxf(fabsf(f1.x), fabsf(f1.y)), fmaxf(fabsf(f1.z), fabsf(f1.w))));
      am = fmaxf(am, fmaxf(fmaxf(fmaxf(fabsf(f2.x), fabsf(f2.y)), fmaxf(fabsf(f2.z), fabsf(f2.w))),
                           fmaxf(fmaxf(fabsf(f3.x), fabsf(f3.y)), fmaxf(fabsf(f3.z), fabsf(f3.w)))));
      am = wave_max(am);
      const float sc = am > 0.f ? 224.f / am : 1.f;
      int w0 = 0, w1 = 0, w2 = 0, w3 = 0;
      w0 = __builtin_amdgcn_cvt_pk_fp8_f32(f0.x * sc, f0.y * sc, w0, false); w0 = __builtin_amdgcn_cvt_pk_fp8_f32(f0.z * sc, f0.w * sc, w0, true);
      w1 = __builtin_amdgcn_cvt_pk_fp8_f32(f1.x * sc, f1.y * sc, w1, false); w1 = __builtin_amdgcn_cvt_pk_fp8_f32(f1.z * sc, f1.w * sc, w1, true);
      w2 = __builtin_amdgcn_cvt_pk_fp8_f32(f2.x * sc, f2.y * sc, w2, false); w2 = __builtin_amdgcn_cvt_pk_fp8_f32(f2.z * sc, f2.w * sc, w2, true);
      w3 = __builtin_amdgcn_cvt_pk_fp8_f32(f3.x * sc, f3.y * sc, w3, false); w3 = __builtin_amdgcn_cvt_pk_fp8_f32(f3.z * sc, f3.w * sc, w3, true);
      unsigned char* dst = (tab == 0 ? p.ub8() : p.vb8()) + (size_t)row * 1024 + lane * 16;
      *reinterpret_cast<uint4*>(dst) = make_uint4((unsigned)w0, (unsigned)w1, (unsigned)w2, (unsigned)w3);
      if (lane == 0) (tab == 0 ? p.us() : p.vs())[row] = am > 0.f ? am * (1.f / 224.f) : 1.f;
    }
  }
  {
    const size_t n8 = (size_t)2 * 16 * 128 * 128 / 8;
    for (size_t i = gtid; i < n8; i += gsz) {
      float4 a = reinterpret_cast<const float4*>(p.peer_keys())[2 * i], b = reinterpret_cast<const float4*>(p.peer_keys())[2 * i + 1];
      reinterpret_cast<uint4*>(p.keysb())[i] = make_uint4(pack2(a.x, a.y), pack2(a.z, a.w), pack2(b.x, b.y), pack2(b.z, b.w));
    }
  }
  {
    const size_t n8 = (size_t)2 * 8 * 1024 * 512 / 8;
    for (size_t i = gtid; i < n8; i += gsz) {
      size_t e = i * 8;
      size_t lb = e / (1024 * 512), rem = e % (1024 * 512);
      float4 a = reinterpret_cast<const float4*>(p.cache_k())[2 * i], b = reinterpret_cast<const float4*>(p.cache_k())[2 * i + 1];
      *reinterpret_cast<uint4*>(p.Kbs() + lb * (SKEYS * 512) + rem) = make_uint4(pack2(a.x, a.y), pack2(a.z, a.w), pack2(b.x, b.y), pack2(b.z, b.w));
    }
  }
  for (size_t i = gtid; i < 2 * 8 * 1024; i += gsz) {
    int l = (int)(i / 8192), r = (int)(i % 8192), g = r / 1024, k = r % 1024;
    p.wg()[i] = p.w_in()[((size_t)l * 1024 + k) * 2824 + 2304 + g];
  }
  {
    float* sp = reinterpret_cast<float*>(p.ws + WS_sp);
    for (size_t i = gtid; i < 262144; i += gsz) sp[SP_st_c + i] = p.in[4][i];
    for (size_t i = gtid; i < 4096; i += gsz) sp[SP_st_n + i] = p.in[5][i];
    for (size_t i = gtid; i < 64; i += gsz) sp[SP_st_m + i] = p.in[6][i];
    for (size_t i = gtid; i < 12288; i += gsz) sp[SP_st_conv + i] = p.in[7][i];
    for (size_t i = gtid; i < 2048; i += gsz) sp[SP_norm1_g + i] = p.in[8][i];
    for (size_t i = gtid; i < 256; i += gsz) sp[SP_da_subln_g + i] = p.in[11][i];
    for (size_t i = gtid; i < 2048; i += gsz) sp[SP_ml_conv_w + i] = p.in[13][i];
    for (size_t i = gtid; i < 512; i += gsz) sp[SP_ml_conv_b + i] = p.in[14][i];
    for (size_t i = gtid; i < 32768; i += gsz) sp[SP_ml_wq + i] = p.in[15][i];
    for (size_t i = gtid; i < 32768; i += gsz) sp[SP_ml_wk + i] = p.in[16][i];
    for (size_t i = gtid; i < 16; i += gsz) sp[SP_ml_gate_b + i] = p.in[17][i];
    for (size_t i = gtid; i < 512; i += gsz) sp[SP_ml_norm_g + i] = p.in[18][i];
    for (size_t i = gtid; i < 512; i += gsz) sp[SP_ml_skip + i] = p.in[19][i];
    for (size_t i = gtid; i < 512; i += gsz) sp[SP_cm_norm_g + i] = p.in[20][i];
    for (size_t i = gtid; i < 131072; i += gsz) sp[SP_cm_ws + i] = p.in[21][i];
    for (size_t i = gtid; i < 1024; i += gsz) sp[SP_cm_b + i] = p.in[22][i];
    for (size_t i = gtid; i < 2048; i += gsz) sp[SP_norm2_g + i] = p.in[24][i];
    for (size_t i = gtid; i < 1024; i += gsz) sp[SP_final_g + i] = p.in[29][i];
  }
  if (bid == 0) {
    for (int i = tid; i < 4 * 256; i += 256) {
      int h = i >> 8, j = i & 255;
      int rel = j - 191; if (rel > 63) rel = 63;
      p.lut()[i] = p.rel_table()[rel_bucket_dev(rel) * 4 + h] * LOG2E;
    }
    if (tid < 2) {
      const float* lp = p.da_lambda() + tid * 256;
      float s01 = 0.f, s23 = 0.f;
      for (int d = 0; d < 64; ++d) { s01 += lp[d] * lp[64 + d]; s23 += lp[128 + d] * lp[192 + d]; }
      float lam_init = 0.8f - 0.6f * expf(-0.3f * (float)tid);
      p.lam()[tid] = expf(s01) - expf(s23) + lam_init;
    }
  }
}

template <int MODE>
__device__ __forceinline__ void ph_rmsnorm(const Params& p, int l, int bid, int nblk) {
  const int lane = tid_opaque() & 63, w = tid_opaque() >> 6;
  const float* g = (MODE == 0) ? p.norm1_g() + l * 1024 : (MODE == 1 ? p.norm2_g() + l * 1024 : p.final_g());
  float4 gv[4];
#pragma unroll
  for (int j = 0; j < 4; ++j) gv[j] = reinterpret_cast<const float4*>(g)[lane + 64 * j];
  for (int t = bid * 4 + w; t < NTOK; t += nblk * 4) {
    const float* xr = (MODE == 0) ? xrow_in(p, l, t) : p.x() + (size_t)t * 1024;
    float4 xv[4];
    float ss = 0.f;
#pragma unroll
    for (int j = 0; j < 4; ++j) {
      xv[j] = reinterpret_cast<const float4*>(xr)[lane + 64 * j];
      ss += xv[j].x * xv[j].x + xv[j].y * xv[j].y + xv[j].z * xv[j].z + xv[j].w * xv[j].w;
    }
    ss = wave_sum(ss);
    float r = rsqrtf(ss * (1.f / 1024.f) + EPS);
#pragma unroll
    for (int j = 0; j < 4; ++j) {
      xv[j].x *= r * gv[j].x; xv[j].y *= r * gv[j].y; xv[j].z *= r * gv[j].z; xv[j].w *= r * gv[j].w;
    }
    if (MODE == 2) {
      float* o = (t < NPROMPT) ? p.out + O_Y_P + (size_t)t * 1024 : p.out + O_Y_S + (size_t)(t - NPROMPT) * 1024;
#pragma unroll
      for (int j = 0; j < 4; ++j) reinterpret_cast<float4*>(o)[lane + 64 * j] = xv[j];
    } else {
      uint2* o = reinterpret_cast<uint2*>(p.xn() + (size_t)t * 1024);
#pragma unroll
      for (int j = 0; j < 4; ++j) o[lane + 64 * j] = make_uint2(pack2(xv[j].x, xv[j].y), pack2(xv[j].z, xv[j].w));
    }
    if (MODE == 0) {
      float pre[8];
#pragma unroll
      for (int i = 0; i < 8; ++i) {
        const float4* wr = reinterpret_cast<const float4*>(p.wg() + ((size_t)l * 8 + i) * 1024);
        float s = 0.f;
#pragma unroll
        for (int j = 0; j < 4; ++j) {
          float4 wv = wr[lane + 64 * j];
          s += xv[j].x * wv.x + xv[j].y * wv.y + xv[j].z * wv.z + xv[j].w * wv.w;
        }
        pre[i] = wave_sum(s);
      }
      if (lane < 4) {
        float a = pre[0]; a = lane == 1 ? pre[1] : a; a = lane == 2 ? pre[2] : a; a = lane == 3 ? pre[3] : a;
        float f = pre[4]; f = lane == 1 ? pre[5] : f; f = lane == 2 ? pre[6] : f; f = lane == 3 ? pre[7] : f;
        p.ig()[(size_t)t * 4 + lane] = a + p.ml_gate_b()[l * 8 + lane];
        float z = f + p.ml_gate_b()[l * 8 + 4 + lane];
        p.lf()[(size_t)t * 4 + lane] = fminf(z, 0.f) - log1pf(expf(-fabsf(z)));
      }
    }
  }
}

enum { EPI_WIN = 0, EPI_WOUT = 1, EPI_PQ = 2, EPI_SC = 3 };

template <int EPI>
__device__ __forceinline__ void gemm_store(const Params& p, int l, int t, int n, float v) {
  if (EPI == EPI_WOUT) {
    const float* xi = xrow_in(p, l, t);
    p.x()[(size_t)t * 1024 + n] = xi[n] + v;
  } else if (EPI == EPI_PQ) {
    p.qp()[(size_t)t * 2048 + n] = f2bf(v);
  } else if (EPI == EPI_SC) {
    p.sc()[(size_t)t * 2048 + n] = v;
  }
}

template <int EPI>
__device__ __forceinline__ void ph_gemm(const Params& p, int l, char* smem, int bid, int nblk) {
  constexpr int NT = (EPI == EPI_WIN) ? 22 : (EPI == EPI_WOUT ? 8 : 16);
  constexpr int MT = NTOK / 128;
  constexpr int K = (EPI == EPI_SC) ? 128 : 1024;
  constexpr int NK = K / 64;
  const bf16_t* A; int lda; const bf16_t* Bt; int ldb;
  if (EPI == EPI_WIN) { A = p.xn(); lda = 1024; Bt = p.wt_in() + (size_t)l * NIN * 1024; ldb = 1024; }
  else if (EPI == EPI_WOUT) { A = p.xn(); lda = 1024; Bt = p.wt_out() + (size_t)l * 1024 * 1024; ldb = 1024; }
  else if (EPI == EPI_PQ) { A = p.xn(); lda = 1024; Bt = p.wt_pq() + (size_t)l * 2048 * 1024; ldb = 1024; }
  else { A = p.qp(); lda = 2048; Bt = p.keysb() + (size_t)l * 16 * 128 * 128; ldb = 128; }

  const int tid = tid_opaque(), lane = tid & 63, w = tid >> 6;
  const int wm = w >> 1, wn = w & 1, lr = lane & 31, lh = lane >> 5;
  char* sA = smem;
  char* sB = smem + 32768;
  const int ld_c = tid & 7, ld_r = tid >> 3;

  const int nx = nblk >> 3;
  constexpr int FG = MT / 8, LR = MT % 8;
  for (int rnd = 0;; ++rnd) {
    const int q = (nblk & 7) ? rnd * nblk + bid : rnd * nblk + (bid & 7) * nx + (bid >> 3);
    if (q >= MT * NT) break;
    int mt, nt;
    if (q < FG * 8 * NT) { const int mg = q / (8 * NT), rem = q % (8 * NT); nt = rem >> 3; mt = mg * 8 + (rem & 7); }
    else { const int q2 = q - FG * 8 * NT; nt = q2 / (LR > 0 ? LR : 1); mt = FG * 8 + q2 % (LR > 0 ? LR : 1); }
    const bf16_t* Ag = A + (size_t)(mt * 128) * lda + ((EPI == EPI_SC) ? nt * 128 : 0);
    const bf16_t* Bg = Bt + (size_t)(nt * 128) * ldb;
    f32x16 acc[2][2];
#pragma unroll
    for (int i = 0; i < 2; ++i)
#pragma unroll
      for (int j = 0; j < 2; ++j)
#pragma unroll
        for (int r = 0; r < 16; ++r) acc[i][j][r] = 0.f;

    const int g_row = w * 32 + (lane >> 3);
    const int g_pc = lane & 7;
    const bf16_t* Ath = Ag + (size_t)g_row * lda;
    const bf16_t* Bth = Bg + (size_t)g_row * ldb;
#define GEMM_STAGE(KT, BUF)                                                                                          \
  _Pragma("unroll") for (int j = 0; j < 4; ++j) {                                                                    \
    const int row = g_row + 8 * j;                                                                                   \
    const int cch = g_pc ^ ((row >> 1) & 7);                                                                         \
    __builtin_amdgcn_global_load_lds((const unsigned*)(Ath + (size_t)(8 * j) * lda + (KT) * 64 + cch * 8),           \
                                     (LAS unsigned*)(sA + (BUF) * 16384 + (w * 4 + j) * 1024 + lane * 16), 16, 0, 0); \
    __builtin_amdgcn_global_load_lds((const unsigned*)(Bth + (size_t)(8 * j) * ldb + (KT) * 64 + cch * 8),           \
                                     (LAS unsigned*)(sB + (BUF) * 16384 + (w * 4 + j) * 1024 + lane * 16), 16, 0, 0); \
  }
    GEMM_STAGE(0, 0)
    __syncthreads();
    for (int kt = 0; kt < NK; ++kt) {
      const int buf = kt & 1;
      if (kt + 1 < NK) { GEMM_STAGE(kt + 1, buf ^ 1) }
      const char* cA = sA + buf * 16384;
      const char* cB = sB + buf * 16384;
#pragma unroll
      for (int ks = 0; ks < 4; ++ks) {
        bf16x8 af[2], bfr[2];
#pragma unroll
        for (int i = 0; i < 2; ++i) {
          int row = wm * 64 + i * 32 + lr; int pc = (ks * 2 + lh) ^ ((row >> 1) & 7);
          af[i] = as_bf16x8(*reinterpret_cast<const uint4*>(cA + row * 128 + pc * 16));
        }
#pragma unroll
        for (int j = 0; j < 2; ++j) {
          int row = wn * 64 + j * 32 + lr; int pc = (ks * 2 + lh) ^ ((row >> 1) & 7);
          bfr[j] = as_bf16x8(*reinterpret_cast<const uint4*>(cB + row * 128 + pc * 16));
        }
#pragma unroll
        for (int i = 0; i < 2; ++i)
#pragma unroll
          for (int j = 0; j < 2; ++j)
            acc[i][j] = __builtin_amdgcn_mfma_f32_32x32x16_bf16(af[i], bfr[j], acc[i][j], 0, 0, 0);
      }
      __syncthreads();
    }
    if (EPI != EPI_WIN) {
#pragma unroll
      for (int i = 0; i < 2; ++i)
#pragma unroll
        for (int j = 0; j < 2; ++j)
#pragma unroll
          for (int r = 0; r < 16; ++r) {
            int t = mt * 128 + wm * 64 + i * 32 + (r & 3) + 8 * (r >> 2) + 4 * lh;
            int n = nt * 128 + wn * 64 + j * 32 + lr;
            gemm_store<EPI>(p, l, t, n, acc[i][j][r]);
          }
    } else {
      const int seg = nt >> 2;
#pragma unroll
      for (int i = 0; i < 2; ++i)
#pragma unroll
        for (int j = 0; j < 2; ++j) {
          const int n = nt * 128 + wn * 64 + j * 32 + lr;
          if (nt < 4) {
#pragma unroll
            for (int r = 0; r < 16; ++r) {
              int t = mt * 128 + wm * 64 + i * 32 + (r & 3) + 8 * (r >> 2) + 4 * lh;
              p.Qb()[(size_t)t * 512 + n] = f2bf(acc[i][j][r] * (0.125f * LOG2E));
            }
          } else if (nt < 8) {
            const int n2 = n - 512;
#pragma unroll
            for (int r = 0; r < 16; ++r) {
              int t = mt * 128 + wm * 64 + i * 32 + (r & 3) + 8 * (r >> 2) + 4 * lh;
              float v = acc[i][j][r];
              if (t < NPROMPT) {
                p.out[O_K_P + (size_t)l * (4 * 4096 * 512) + (size_t)t * 512 + n2] = v;
                p.Kb()[(size_t)t * 512 + n2] = f2bf(v);
              } else {
                int ts = t - NPROMPT, b = ts >> 6, ii = ts & 63;
                p.out[O_K_S + (size_t)l * (8 * 64 * 512) + (size_t)ts * 512 + n2] = v;
                p.Kbs()[((size_t)(l * 8 + b) * SKEYS + 1024 + ii) * 512 + n2] = f2bf(v);
              }
            }
          } else if (nt < 12) {
            const int n2 = n - 1024, h = n2 >> 7, dv = n2 & 127;
#pragma unroll
            for (int rg = 0; rg < 4; ++rg) {
              int tb = mt * 128 + wm * 64 + i * 32 + 8 * rg + 4 * lh;
              float v0 = acc[i][j][rg * 4 + 0], v1 = acc[i][j][rg * 4 + 1], v2 = acc[i][j][rg * 4 + 2], v3 = acc[i][j][rg * 4 + 3];
              uint2 pk = make_uint2(pack2(v0, v1), pack2(v2, v3));
              int posblk = 2 * lh + (rg & 1);
              if (tb < NPROMPT) {
                float* o = p.out + O_V_P + (size_t)l * (4 * 4096 * 512) + (size_t)tb * 512 + n2;
                o[0] = v0; o[512] = v1; o[1024] = v2; o[1536] = v3;
                int b = tb >> 12, s = tb & 4095;
                int pos = (s & ~15) + posblk * 4;
                *reinterpret_cast<uint2*>(p.Vt() + ((size_t)(b * 4 + h) * 128 + dv) * SEQ + pos) = pk;
              } else {
                int ts = tb - NPROMPT, b = ts >> 6, ii = ts & 63;
                float* o = p.out + O_V_S + (size_t)l * (8 * 64 * 512) + (size_t)ts * 512 + n2;
                o[0] = v0; o[512] = v1; o[1024] = v2; o[1536] = v3;
                int pos = 1024 + (ii & ~15) + posblk * 4;
                *reinterpret_cast<uint2*>(p.Vts() + ((size_t)((l * 8 + b) * 4 + h) * 128 + dv) * SKEYS + pos) = pk;
              }
            }
          } else {
            const int n2 = n - 1536;
            const bool act = (n >= 2304);
#pragma unroll
            for (int r = 0; r < 16; ++r) {
              int t = mt * 128 + wm * 64 + i * 32 + (r & 3) + 8 * (r >> 2) + 4 * lh;
              float v = acc[i][j][r];
              if (act) v = gelu_exact(v);
              p.P5()[(size_t)t * 1280 + n2] = v;
            }
          }
        }
      (void)seg;
    }
  }
}

__device__ __forceinline__ void ph_attn(const Params& p, int l, char* smem, int bid, int nblk) {
  const int tid = tid_opaque(), lane = tid & 63, w = tid >> 6;
  const int c = w >> 1, qhalf = w & 1, lr = lane & 31, lh = lane >> 5;
  char* sK = smem;
  char* sV = smem + 16384;
  float* sLut = reinterpret_cast<float*>(smem + 32768);
  char* sQ = smem + 33792 + w * 4096;
  float* sO2 = reinterpret_cast<float*>(smem);
  const float lam = p.lam()[l];
  const float lam_init = 0.8f - 0.6f * expf(-0.3f * (float)l);

  for (int uu = bid; uu < 1056; uu += nblk) {
    int b, h, qc, S, qrow0; const bf16_t *Kbase, *Vbase;
    bool samp = false; int u2 = uu;
    if (uu >= 752 && uu < 784) samp = true; else if (uu >= 784) u2 = uu - 32;
    if (!samp) {
      qc = 63 - (u2 >> 4); int bh = u2 & 15; b = bh >> 2; h = bh & 3; S = SEQ;
      Kbase = p.Kb() + (size_t)b * SEQ * 512 + h * 128;
      Vbase = p.Vt() + (size_t)(b * 4 + h) * 128 * SEQ;
      qrow0 = b * SEQ + qc * 64;
    } else {
      int us = uu - 752; b = us >> 2; h = us & 3; qc = 16; S = SKEYS;
      Kbase = p.Kbs() + (size_t)(l * 8 + b) * SKEYS * 512 + h * 128;
      Vbase = p.Vts() + (size_t)((l * 8 + b) * 4 + h) * 128 * SKEYS;
      qrow0 = NPROMPT + b * 64;
    }
    const int ntiles = qc + 1;
    __syncthreads();
    sLut[tid] = p.lut()[h * 256 + tid];
    {
      const int qc8 = lane & 7, qr = lane >> 3;
#pragma unroll
      for (int j = 0; j < 4; ++j) {
        int row = qr + 8 * j;
        uint4 v = *reinterpret_cast<const uint4*>(p.Qb() + (size_t)(qrow0 + qhalf * 32 + row) * 512 + h * 128 + c * 64 + qc8 * 8);
        *reinterpret_cast<uint4*>(sQ + row * 128 + ((qc8 ^ ((row >> 1) & 7)) * 16)) = v;
      }
    }
    f32x16 o[4];
#pragma unroll
    for (int d = 0; d < 4; ++d)
#pragma unroll
      for (int r = 0; r < 16; ++r) o[d][r] = 0.f;
    float m_run = -1e30f, l_run = 0.f;
    const float c15 = p.lut()[h * 256];

    uint4 rk0, rk1, rk2, rk3, rv0, rv1, rv2, rv3;
    const int kc = tid & 15, kr = tid >> 4;
    const int vc = tid & 7, vr = tid >> 3;
    const char* Kt = reinterpret_cast<const char*>(Kbase);
    const char* Vb = reinterpret_cast<const char*>(Vbase);
    const unsigned koff = (unsigned)kr * 1024u + (unsigned)kc * 16u;
    const unsigned voff = (unsigned)vr * (unsigned)(S * 2) + (unsigned)vc * 16u;
    const size_t vjs = (size_t)S * 64;
#define ATTN_GL1(KT, J, RK, RV)                                                                              \
  RK = *reinterpret_cast<const uint4*>(Kt + ((size_t)((KT) * 64 + 16 * (J)) * 1024) + koff);                 \
  RV = *reinterpret_cast<const uint4*>(Vb + ((size_t)(J) * vjs + (size_t)(KT) * 128) + voff);
#define ATTN_GLOAD(KT) ATTN_GL1(KT, 0, rk0, rv0) ATTN_GL1(KT, 1, rk1, rv1) ATTN_GL1(KT, 2, rk2, rv2) ATTN_GL1(KT, 3, rk3, rv3)
#define ATTN_SW1(J, RK, RV)                                                                                  \
  {                                                                                                          \
    int row = kr + 16 * (J); int pc = (kc & 7) ^ ((row >> 1) & 7);                                           \
    *reinterpret_cast<uint4*>(sK + (kc >> 3) * 8192 + row * 128 + pc * 16) = RK;                             \
    int row2 = vr + 32 * (J); int pc2 = vc ^ ((row2 >> 1) & 7);                                              \
    *reinterpret_cast<uint4*>(sV + row2 * 128 + pc2 * 16) = RV;                                              \
  }
    ATTN_GLOAD(0)
    for (int kt = 0; kt < ntiles; ++kt) {
      __syncthreads();
      ATTN_SW1(0, rk0, rv0) ATTN_SW1(1, rk1, rv1) ATTN_SW1(2, rk2, rv2) ATTN_SW1(3, rk3, rv3)
      __syncthreads();
      if (kt + 1 < ntiles) { ATTN_GLOAD(kt + 1) }
      f32x16 s[2];
#pragma unroll
      for (int kb = 0; kb < 2; ++kb) {
#pragma unroll
        for (int r = 0; r < 16; ++r) s[kb][r] = 0.f;
#pragma unroll
        for (int ks = 0; ks < 4; ++ks) {
          int row = kb * 32 + lr; int pc = (ks * 2 + lh) ^ ((row >> 1) & 7);
          bf16x8 kf = as_bf16x8(*reinterpret_cast<const uint4*>(sK + c * 8192 + row * 128 + pc * 16));
          bf16x8 qf = as_bf16x8(*reinterpret_cast<const uint4*>(sQ + lr * 128 + (((ks * 2 + lh) ^ ((lr >> 1) & 7)) * 16)));
          s[kb] = __builtin_amdgcn_mfma_f32_32x32x16_bf16(kf, qf, s[kb], 0, 0, 0);
        }
      }
      if (kt >= qc - 2) {
        const int base = (kt - qc) * 64 - (qhalf * 32 + lr) + 191 + 4 * lh;
#pragma unroll
        for (int kb = 0; kb < 2; ++kb)
#pragma unroll
          for (int r = 0; r < 16; ++r) s[kb][r] += sLut[base + kb * 32 + (r & 3) + 8 * (r >> 2)];
      } else {
#pragma unroll
        for (int kb = 0; kb < 2; ++kb)
#pragma unroll
          for (int r = 0; r < 16; ++r) s[kb][r] += c15;
      }
      float mx = s[0][0];
#pragma unroll
      for (int kb = 0; kb < 2; ++kb)
#pragma unroll
        for (int r = 0; r < 16; ++r) mx = fmaxf(mx, s[kb][r]);
      mx = swap32_max(mx);
      const float m_new = fmaxf(m_run, mx);
      const float alpha = __builtin_amdgcn_exp2f(m_run - m_new);
      m_run = m_new;
      float ps = 0.f;
#pragma unroll
      for (int kb = 0; kb < 2; ++kb)
#pragma unroll
        for (int r = 0; r < 16; ++r) { float pv = __builtin_amdgcn_exp2f(s[kb][r] - m_new); s[kb][r] = pv; ps += pv; }
      l_run = l_run * alpha + ps;
#pragma unroll
      for (int d = 0; d < 4; ++d)
#pragma unroll
        for (int r = 0; r < 16; ++r) o[d][r] *= alpha;
#pragma unroll
      for (int ks2 = 0; ks2 < 4; ++ks2) {
        const int kb = ks2 >> 1, sh = (ks2 & 1) * 8;
        uint4 pw = make_uint4(pack2(s[kb][sh + 0], s[kb][sh + 1]), pack2(s[kb][sh + 2], s[kb][sh + 3]),
                              pack2(s[kb][sh + 4], s[kb][sh + 5]), pack2(s[kb][sh + 6], s[kb][sh + 7]));
        bf16x8 pf = as_bf16x8(pw);
#pragma unroll
        for (int d = 0; d < 4; ++d) {
          int row = d * 32 + lr; int pc = (ks2 * 2 + lh) ^ ((row >> 1) & 7);
          bf16x8 vf = as_bf16x8(*reinterpret_cast<const uint4*>(sV + row * 128 + pc * 16));
          o[d] = __builtin_amdgcn_mfma_f32_32x32x16_bf16(vf, pf, o[d], 0, 0, 0);
        }
        __builtin_amdgcn_sched_barrier(0);
      }
    }
    float lt = swap32_sum(l_run);
    float inv = 1.f / lt;
    __syncthreads();
    if (c == 1) {
#pragma unroll
      for (int d = 0; d < 4; ++d)
#pragma unroll
        for (int r = 0; r < 16; ++r) sO2[(qhalf * 64 + d * 16 + r) * 64 + lane] = o[d][r] * inv;
    }
    __syncthreads();
    if (c == 0) {
      float ss = 0.f;
#pragma unroll
      for (int d = 0; d < 4; ++d)
#pragma unroll
        for (int r = 0; r < 16; ++r) {
          float v = o[d][r] * inv - lam * sO2[(qhalf * 64 + d * 16 + r) * 64 + lane];
          o[d][r] = v; ss += v * v;
        }
      ss = swap32_sum(ss);
      const float rn = rsqrtf(ss * (1.f / 128.f) + EPS) * (1.f - lam_init);
      const float* gs = p.da_subln_g() + l * 128;
      bf16_t* orow = p.xn() + (size_t)(qrow0 + qhalf * 32 + lr) * 1024 + h * 128;
#pragma unroll
      for (int d = 0; d < 4; ++d)
#pragma unroll
        for (int rg = 0; rg < 4; ++rg) {
          int dv = d * 32 + 8 * rg + 4 * lh;
          float4 g4 = *reinterpret_cast<const float4*>(gs + dv);
          uint2 pk = make_uint2(pack2(o[d][rg * 4 + 0] * rn * g4.x, o[d][rg * 4 + 1] * rn * g4.y),
                                pack2(o[d][rg * 4 + 2] * rn * g4.z, o[d][rg * 4 + 3] * rn * g4.w));
          *reinterpret_cast<uint2*>(orow + dv) = pk;
        }
    }
  }
}


template <int K>
__device__ __forceinline__ void mfma32_f32(f32x16& acc, const float* a, int a_rs, int a_ks, const float* b, int b_ks, int b_js, int lane) {
  const float* ap = a + (lane & 31) * a_rs + (lane >> 5) * a_ks;
  const float* bp = b + (lane >> 5) * b_ks + (lane & 31) * b_js;
#pragma unroll 8
  for (int k = 0; k < K; k += 2) acc = __builtin_amdgcn_mfma_f32_32x32x2f32(ap[k * a_ks], bp[k * b_ks], acc, 0, 0, 0);
}
__device__ __forceinline__ void zero16(f32x16& a) {
#pragma unroll
  for (int r = 0; r < 16; ++r) a[r] = 0.f;
}

__device__ __forceinline__ void ph_mlconv(const Params& p, int l, char* smem, int bid, int nblk) {
  const int tid = tid_opaque();
  float* s_mc = reinterpret_cast<float*>(smem);
  float* s_cc = s_mc + 67 * 64;
  float* s_wq = s_cc + 64 * 65;
  float* s_wk = s_wq + 4096;
  for (int u = bid; u < 264 * 4; u += nblk) {
    const int ci = u >> 2, h = u & 3;
    int token0, bq; bool samp = ci >= 256;
    if (!samp) token0 = ci * 64; else token0 = NPROMPT + (ci - 256) * 64;
    bq = samp ? (ci - 256) : (ci >> 6);
    const int cidx = samp ? 0 : (ci & 63);
    __syncthreads();
    for (int i = tid; i < 67 * 64; i += 256) {
      int r = i >> 6, d = i & 63;
      float v;
      if (r >= 3) v = p.P5()[(size_t)(token0 + r - 3) * 1280 + h * 64 + d];
      else if (samp) v = p.st_conv()[((size_t)(l * 8 + bq) * 3 + r) * 256 + h * 64 + d];
      else if (cidx == 0) v = 0.f;
      else v = p.P5()[(size_t)(token0 + r - 3) * 1280 + h * 64 + d];
      s_mc[i] = v;
    }
    for (int i = tid; i < 4096; i += 256) {
      s_wq[i] = p.ml_wq()[(size_t)(l * 4 + h) * 4096 + i];
      s_wk[i] = p.ml_wk()[(size_t)(l * 4 + h) * 4096 + i];
    }
    __syncthreads();
    {
      const int d = tid & 63, t0 = tid >> 6;
      const int ch = h * 64 + d;
      const float w0 = p.ml_conv_w()[(l * 4 + 0) * 256 + ch], w1 = p.ml_conv_w()[(l * 4 + 1) * 256 + ch];
      const float w2 = p.ml_conv_w()[(l * 4 + 2) * 256 + ch], w3 = p.ml_conv_w()[(l * 4 + 3) * 256 + ch];
      const float bb = p.ml_conv_b()[l * 256 + ch];
      for (int t = t0; t < 64; t += 4) {
        float y = bb + w0 * s_mc[t * 64 + d] + w1 * s_mc[(t + 1) * 64 + d] + w2 * s_mc[(t + 2) * 64 + d] + w3 * s_mc[(t + 3) * 64 + d];
        y = y * sigmoidf_(y);
        s_cc[t * 65 + d] = y;
        p.cc()[(size_t)(token0 + t) * 256 + ch] = y;
      }
      if (samp || cidx == 63) {
        if (tid < 192) {
          int r = tid >> 6;
          float v = s_mc[(64 + r) * 64 + d];
          if (samp) p.out[O_CONV_S + ((size_t)(l * 8 + bq) * 3 + r) * 256 + ch] = v;
          else p.out[O_CONV_P + ((size_t)(l * 4 + bq) * 3 + r) * 256 + ch] = v;
        }
      }
    }
    __syncthreads();
    {
      const int lane = tid & 63, w = tid >> 6, ti = w >> 1, tj = w & 1;
      f32x16 aq, ak; zero16(aq); zero16(ak);
      mfma32_f32<64>(aq, s_cc + ti * 32 * 65, 65, 1, s_wq + tj * 32, 64, 1, lane);
      mfma32_f32<64>(ak, s_cc + ti * 32 * 65, 65, 1, s_wk + tj * 32, 64, 1, lane);
#pragma unroll
      for (int r = 0; r < 16; ++r) {
        const int t = ti * 32 + (r & 3) + 8 * (r >> 2) + 4 * (lane >> 5);
        const size_t o = (size_t)(token0 + t) * 256 + h * 64 + tj * 32 + (lane & 31);
        p.qm()[o] = aq[r];
        p.km()[o] = ak[r] * 0.125f;
      }
      if (w == 0) {
        const int t = token0 + lane;
        const float lfv = p.lf()[(size_t)t * 4 + h], igv = p.ig()[(size_t)t * 4 + h];
        float F = lfv;
#pragma unroll
        for (int d = 1; d < 64; d <<= 1) { float n = __shfl_up(F, d); if (lane >= d) F += n; }
        const float FL = __shfl(F, 63);
        const float mx = wave_max(FL - F + igv);
        p.Fc()[(size_t)t * 4 + h] = F;
        if (lane == 0) {
          const int cu = samp ? 1024 + bq * 4 + h : (bq * 4 + h) * 64 + cidx;
          p.FLs()[cu] = FL; p.mxt()[cu] = mx;
        }
      }
    }
  }
}

__device__ __forceinline__ void cu_decode(int cu, int& token0, int& h) {
  if (cu < 1024) { int bh = cu >> 6, c = cu & 63; token0 = (bh >> 2) * SEQ + c * 64; h = bh & 3; }
  else { int us = cu - 1024; token0 = NPROMPT + (us >> 2) * 64; h = us & 3; }
}

__device__ __forceinline__ void ph_mlU(const Params& p, int l, char* smem, int bid, int nblk) {
  const int tid = tid_opaque();
  const int lane = tid & 63, w = tid >> 6, ti = w >> 1, tj = w & 1;
  float* s_k = reinterpret_cast<float*>(smem);
  float* s_v = s_k + 4096;
  for (int cu = bid; cu < NCU_UNITS; cu += nblk) {
    int token0, h; cu_decode(cu, token0, h);
    float m0, mn, FL;
    {
      const bool samp = cu >= 1024;
      const int cu0 = samp ? cu : (cu & ~63), c = samp ? 0 : (cu & 63);
      float flv = 0.f, mxv = 0.f;
      if (lane <= c) { flv = p.FLs()[cu0 + lane]; mxv = p.mxt()[cu0 + lane]; }
      float m = samp ? p.st_m()[l * 32 + (cu - 1024)] : 0.f;
      for (int j = 0; j < c; ++j) {
        const float fj = __int_as_float(__builtin_amdgcn_readlane(__float_as_int(flv), j));
        const float xj = __int_as_float(__builtin_amdgcn_readlane(__float_as_int(mxv), j));
        m = fmaxf(fj + m, xj);
      }
      FL = __int_as_float(__builtin_amdgcn_readlane(__float_as_int(flv), c));
      const float xc = __int_as_float(__builtin_amdgcn_readlane(__float_as_int(mxv), c));
      m0 = m; mn = fmaxf(FL + m, xc);
      if (tid == 0) {
        p.mst()[cu] = m0; p.mnx()[cu] = mn; p.wcs()[cu] = expf(FL + m0 - mn);
        if (samp) p.out[O_M_S + l * 32 + (cu - 1024)] = mn;
        else if (c == 63) p.out[O_M_P + l * 16 + (cu >> 6)] = mn;
      }
    }
    __syncthreads();
    for (int i = tid; i < 1024; i += 256) {
      int s = i >> 4, d4 = (i & 15) * 4;
      const int t = token0 + s;
      float wsv = expf(FL - p.Fc()[(size_t)t * 4 + h] + p.ig()[(size_t)t * 4 + h] - mn);
      float4 k4 = *reinterpret_cast<const float4*>(p.km() + (size_t)t * 256 + h * 64 + d4);
      float4 v4 = *reinterpret_cast<const float4*>(p.P5() + (size_t)t * 1280 + 256 + h * 64 + d4);
      *reinterpret_cast<float4*>(s_k + s * 64 + d4) = make_float4(k4.x * wsv, k4.y * wsv, k4.z * wsv, k4.w * wsv);
      *reinterpret_cast<float4*>(s_v + s * 64 + d4) = v4;
    }
    __syncthreads();
    f32x16 acc; zero16(acc);
    mfma32_f32<64>(acc, s_k + ti * 32, 1, 64, s_v + tj * 32, 64, 1, lane);
#pragma unroll
    for (int r = 0; r < 16; ++r) {
      const int d = ti * 32 + (r & 3) + 8 * (r >> 2) + 4 * (lane >> 5);
      p.U()[(size_t)cu * 4096 + d * 64 + tj * 32 + (lane & 31)] = acc[r];
    }
    if (tid < 64) {
      float s0 = 0.f;
      for (int s = 0; s < 64; ++s) s0 += s_k[s * 64 + tid];
      p.un()[(size_t)cu * 64 + tid] = s0;
    }
  }
}

__device__ __forceinline__ void ph_mlscan(const Params& p, int l, int bid, int nblk) {
  const size_t gtid = (size_t)bid * 256 + tid_opaque(), gsz = (size_t)nblk * 256;
  const size_t NPC = 16 * 4096, NSC = 32 * 4096, NPN = 16 * 64, NSN = 32 * 64;
  for (size_t i = gtid; i < NPC + NSC + NPN + NSN; i += gsz) {
    if (i < NPC) {
      int bh = (int)(i >> 12), e = (int)(i & 4095);
      float C = 0.f;
      for (int c = 0; c < 64; ++c) {
        int cu = bh * 64 + c;
        p.Cst()[(size_t)cu * 4096 + e] = C;
        C = p.wcs()[cu] * C + p.U()[(size_t)cu * 4096 + e];
      }
      p.out[O_C_P + (size_t)l * (16 * 4096) + i] = C;
    } else if (i < NPC + NSC) {
      size_t j = i - NPC; int us = (int)(j >> 12), e = (int)(j & 4095); int cu = 1024 + us;
      float C = p.st_c()[(size_t)l * (32 * 4096) + j];
      p.Cst()[(size_t)cu * 4096 + e] = C;
      p.out[O_C_S + (size_t)l * (32 * 4096) + j] = p.wcs()[cu] * C + p.U()[(size_t)cu * 4096 + e];
    } else if (i < NPC + NSC + NPN) {
      size_t j = i - NPC - NSC; int bh = (int)(j >> 6), d = (int)(j & 63);
      float n = 0.f;
      for (int c = 0; c < 64; ++c) {
        int cu = bh * 64 + c;
        p.nst()[(size_t)cu * 64 + d] = n;
        n = p.wcs()[cu] * n + p.un()[(size_t)cu * 64 + d];
      }
      p.out[O_N_P + (size_t)l * (16 * 64) + j] = n;
    } else {
      size_t j = i - NPC - NSC - NPN; int us = (int)(j >> 6), d = (int)(j & 63); int cu = 1024 + us;
      float n = p.st_n()[(size_t)l * (32 * 64) + j];
      p.nst()[(size_t)cu * 64 + d] = n;
      p.out[O_N_S + (size_t)l * (32 * 64) + j] = p.wcs()[cu] * n + p.un()[(size_t)cu * 64 + d];
    }
  }
}

__device__ __forceinline__ void ph_mlout(const Params& p, int l, char* smem, int bid, int nblk) {
  const int tid = tid_opaque();
  float* s_q = reinterpret_cast<float*>(smem);
  float* s_k = s_q + 64 * 65;
  float* s_v = s_k + 64 * 65;
  float* s_C = s_v + 4096;
  float* s_F = s_C + 4096;
  float* s_a = s_F + 64;
  float* s_mt = s_a + 64;
  float* s_iw = s_mt + 64;
  float* s_n = s_iw + 64;
  float* s_den = s_n + 64;
  for (int cu = bid; cu < NCU_UNITS; cu += nblk) {
    int token0, h; cu_decode(cu, token0, h);
    const float m0 = p.mst()[cu];
    __syncthreads();
    for (int i = tid; i < 1024; i += 256) {
      int s = i >> 4, d4 = (i & 15) * 4;
      const int t = token0 + s;
      float4 q4 = *reinterpret_cast<const float4*>(p.qm() + (size_t)t * 256 + h * 64 + d4);
      float4 k4 = *reinterpret_cast<const float4*>(p.km() + (size_t)t * 256 + h * 64 + d4);
      float4 v4 = *reinterpret_cast<const float4*>(p.P5() + (size_t)t * 1280 + 256 + h * 64 + d4);
      float4 c4 = *reinterpret_cast<const float4*>(p.Cst() + (size_t)cu * 4096 + s * 64 + d4);
      s_q[s * 65 + d4] = q4.x; s_q[s * 65 + d4 + 1] = q4.y; s_q[s * 65 + d4 + 2] = q4.z; s_q[s * 65 + d4 + 3] = q4.w;
      s_k[s * 65 + d4] = k4.x; s_k[s * 65 + d4 + 1] = k4.y; s_k[s * 65 + d4 + 2] = k4.z; s_k[s * 65 + d4 + 3] = k4.w;
      *reinterpret_cast<float4*>(s_v + s * 64 + d4) = v4;
      *reinterpret_cast<float4*>(s_C + s * 64 + d4) = c4;
    }
    if (tid < 64) {
      const int t = token0 + tid;
      float F = p.Fc()[(size_t)t * 4 + h], g = p.ig()[(size_t)t * 4 + h];
      s_F[tid] = F; s_a[tid] = g - F;
      s_n[tid] = p.nst()[(size_t)cu * 64 + tid];
    }
    __syncthreads();
    if (tid < 64) {
      float pm = -1e30f;
      for (int s = 0; s <= tid; ++s) pm = fmaxf(pm, s_a[s]);
      float F = s_F[tid];
      float mt = F + fmaxf(m0, pm);
      s_mt[tid] = mt;
      s_iw[tid] = expf(F + m0 - mt);
    }
    __syncthreads();
    const int lane = tid & 63, w = tid >> 6, ti = w >> 1, tj = w & 1;
    const int ty = tid >> 4, tx = tid & 15;
    {
      f32x16 accS; zero16(accS);
      mfma32_f32<64>(accS, s_q + ti * 32 * 65, 65, 1, s_k + tj * 32 * 65, 1, 65, lane);
      __syncthreads();
      const int s = tj * 32 + (lane & 31);
      const float as = s_a[s];
#pragma unroll
      for (int r = 0; r < 16; ++r) {
        const int t = ti * 32 + (r & 3) + 8 * (r >> 2) + 4 * (lane >> 5);
        s_k[t * 65 + s] = (s <= t) ? accS[r] * expf(s_F[t] + as - s_mt[t]) : 0.f;
      }
    }
    __syncthreads();
    if (tid < 64) {
      float den = 0.f, qn = 0.f;
      for (int s = 0; s < 64; ++s) { den += s_k[tid * 65 + s]; qn += s_q[tid * 65 + s] * s_n[s]; }
      s_den[tid] = den + s_iw[tid] * qn;
    }
    {
      f32x16 accN, accC; zero16(accN); zero16(accC);
      mfma32_f32<64>(accN, s_k + ti * 32 * 65, 65, 1, s_v + tj * 32, 64, 1, lane);
      mfma32_f32<64>(accC, s_q + ti * 32 * 65, 65, 1, s_C + tj * 32, 64, 1, lane);
      __syncthreads();
#pragma unroll
      for (int r = 0; r < 16; ++r) {
        const int t = ti * 32 + (r & 3) + 8 * (r >> 2) + 4 * (lane >> 5);
        s_q[t * 65 + tj * 32 + (lane & 31)] = accN[r] + s_iw[t] * accC[r];
      }
    }
    __syncthreads();
#pragma unroll
    for (int i = 0; i < 4; ++i) {
      const int t = ty * 4 + i;
      const float dn = fmaxf(fabsf(s_den[t]), expf(-s_mt[t]));
      float hv[4]; float ss = 0.f;
#pragma unroll
      for (int j = 0; j < 4; ++j) { hv[j] = s_q[t * 65 + tx * 4 + j] / dn; ss += hv[j] * hv[j]; }
      ss = row16_sum(ss);
      const float rn = rsqrtf(ss * (1.f / 64.f) + EPS);
      const int ch = h * 64 + tx * 4;
      const size_t tg = (size_t)(token0 + t);
      float4 g4 = *reinterpret_cast<const float4*>(p.ml_norm_g() + l * 256 + ch);
      float4 k4 = *reinterpret_cast<const float4*>(p.ml_skip() + l * 256 + ch);
      float4 c4 = *reinterpret_cast<const float4*>(p.cc() + tg * 256 + ch);
      float4 o4 = *reinterpret_cast<const float4*>(p.P5() + tg * 1280 + 512 + ch);
      float r0 = (hv[0] * rn * g4.x + k4.x * c4.x) * sigmoidf_(o4.x);
      float r1 = (hv[1] * rn * g4.y + k4.y * c4.y) * sigmoidf_(o4.y);
      float r2 = (hv[2] * rn * g4.z + k4.z * c4.z) * sigmoidf_(o4.z);
      float r3 = (hv[3] * rn * g4.w + k4.w * c4.w) * sigmoidf_(o4.w);
      *reinterpret_cast<uint2*>(p.xn() + tg * 1024 + 512 + ch) = make_uint2(pack2(r0, r1), pack2(r2, r3));
    }
  }
}

__device__ __forceinline__ void ph_cmlp(const Params& p, int l, char* smem, int bid, int nblk) {
  const int tid = tid_opaque(), lane = tid & 63, w = tid >> 6;
  float* s_vg = reinterpret_cast<float*>(smem);
  float* s_ws = s_vg + 128 * 64;
  float* s_r = s_ws + 128 * 33;
  for (int u = bid; u < 544; u += nblk) {
    const int g = u & 3, ci = u >> 2;
    const bool samp = ci >= 128;
    const int L = samp ? 64 : 128;
    const int token0 = samp ? NPROMPT + (ci - 128) * 64 : ci * 128;
    __syncthreads();
    for (int r = w; r < L; r += 4) {
      float4 v = *reinterpret_cast<const float4*>(p.P5() + (size_t)(token0 + r) * 1280 + 1024 + lane * 4);
      float ss = v.x * v.x + v.y * v.y + v.z * v.z + v.w * v.w;
      ss = wave_sum(ss);
      if (lane == 0) s_r[r] = rsqrtf(ss * (1.f / 256.f) + EPS);
    }
    __syncthreads();
    for (int i = tid; i < L * 16; i += 256) {
      int s = i >> 4, d4 = (i & 15) * 4;
      float4 v = *reinterpret_cast<const float4*>(p.P5() + (size_t)(token0 + s) * 1280 + 1024 + g * 64 + d4);
      float4 gn = *reinterpret_cast<const float4*>(p.cm_norm_g() + l * 256 + g * 64 + d4);
      float r = s_r[s];
      float4 o = make_float4(v.x * r * gn.x, v.y * r * gn.y, v.z * r * gn.z, v.w * r * gn.w);
      *reinterpret_cast<float4*>(s_vg + s * 64 + d4) = o;
      if (samp) {
        int ts = token0 - NPROMPT + s;
        *reinterpret_cast<float4*>(p.out + O_CMV_S + (size_t)l * (512 * 256) + (size_t)ts * 256 + g * 64 + d4) = o;
      }
    }
    const int rtA = (w < 2) ? 3 : 2, rtB = (w < 2) ? 0 : 1, ct = w & 1;
    const int nrt = L >> 5;
    f32x16 accA, accB; zero16(accA); zero16(accB);
    const float* wsg = p.cm_ws() + (size_t)(l * 4 + g) * 128 * 128;
    for (int s0 = 0; s0 < L; s0 += 32) {
      __syncthreads();
      for (int i = tid; i < L * 32; i += 256) {
        int t = i >> 5, ss = i & 31;
        s_ws[t * 33 + ss] = (s0 + ss <= t) ? wsg[t * 128 + s0 + ss] : 0.f;
      }
      __syncthreads();
      const int c = s0 >> 5;
      if (rtA < nrt && c <= rtA) mfma32_f32<32>(accA, s_ws + rtA * 32 * 33, 33, 1, s_vg + s0 * 64 + ct * 32, 64, 1, lane);
      if (rtB < nrt && c <= rtB) mfma32_f32<32>(accB, s_ws + rtB * 32 * 33, 33, 1, s_vg + s0 * 64 + ct * 32, 64, 1, lane);
    }
    __syncthreads();
#pragma unroll
    for (int r = 0; r < 16; ++r) {
      const int tr = (r & 3) + 8 * (r >> 2) + 4 * (lane >> 5);
      if (rtA < nrt) s_vg[(rtA * 32 + tr) * 64 + ct * 32 + (lane & 31)] = accA[r];
      if (rtB < nrt) s_vg[(rtB * 32 + tr) * 64 + ct * 32 + (lane & 31)] = accB[r];
    }
    __syncthreads();
    {
      const int ty = tid >> 4, tx = tid & 15;
      if (ty * 8 < L) {
#pragma unroll
        for (int i = 0; i < 8; ++i) {
          const int t = ty * 8 + i;
          const float bb = p.cm_b()[(l * 4 + g) * 128 + t];
          const size_t tg = (size_t)(token0 + t);
          float4 a4 = *reinterpret_cast<const float4*>(s_vg + t * 64 + tx * 4);
          float4 u4 = *reinterpret_cast<const float4*>(p.P5() + tg * 1280 + 768 + g * 64 + tx * 4);
          *reinterpret_cast<uint2*>(p.xn() + tg * 1024 + 768 + g * 64 + tx * 4) =
              make_uint2(pack2(u4.x * (a4.x + bb), u4.y * (a4.y + bb)), pack2(u4.z * (a4.z + bb), u4.w * (a4.w + bb)));
        }
      }
    }
  }
}

__device__ __forceinline__ int mono_key(float v) { int b = __float_as_int(v); return b ^ ((b >> 31) & 0x7FFFFFFF); }
__device__ __forceinline__ float mono_val(int k) { int b = k ^ ((k >> 31) & 0x7FFFFFFF); return __int_as_float(b); }

#define INS16(L, kv)                                   \
  {                                                    \
    int _v = (kv);                                     \
    _Pragma("unroll") for (int _j = 0; _j < 16; ++_j) { \
      int _t = max(L[_j], _v);                         \
      _v = min(L[_j], _v);                             \
      L[_j] = _t;                                      \
    }                                                  \
  }

__device__ __forceinline__ void ph_topk(const Params& p, int l, char* smem, int bid, int nblk) {
  const int tid = tid_opaque(), lane = tid & 63, w = tid >> 6;
  float* s_tile = reinterpret_cast<float*>(smem) + w * (64 * 33);
  int* s_list = reinterpret_cast<int*>(smem + 4 * 64 * 33 * 4) + w * (2 * 16 * 64);
  float* s_ss = reinterpret_cast<float*>(smem + 4 * 64 * 33 * 4 + 4 * 2 * 16 * 64 * 4) + w * 64;
  for (int u = bid * 4 + w; u < 264 * 8; u += nblk * 4) {
    const int tg = u >> 3, h = u & 7;
    const int t0 = tg * 64;
#pragma unroll 2
    for (int i = 0; i < 32; ++i) {
      const int tt = 2 * i + (lane >> 5);
      uint4 qv = *reinterpret_cast<const uint4*>(p.qp() + (size_t)(t0 + tt) * 2048 + h * 256 + (lane & 31) * 8);
      float a0 = bf_lo(qv.x), a1 = bf_hi(qv.x), a2 = bf_lo(qv.y), a3 = bf_hi(qv.y);
      float a4 = bf_lo(qv.z), a5 = bf_hi(qv.z), a6 = bf_lo(qv.w), a7 = bf_hi(qv.w);
      float ss = a0 * a0 + a1 * a1 + a2 * a2 + a3 * a3 + a4 * a4 + a5 * a5 + a6 * a6 + a7 * a7;
      ss = swap16_sum(row16_sum(ss));
      if ((lane & 31) == 0) s_ss[tt] = ss;
    }
    int L1[16], L2[16];
#pragma unroll
    for (int j = 0; j < 16; ++j) { L1[j] = (int)0x80000000; L2[j] = (int)0x80000000; }
#pragma unroll
    for (int c = 0; c < 2; ++c) {
#pragma unroll 1
      for (int ps = 0; ps < 4; ++ps) {
        const float* src = p.sc() + (size_t)t0 * 2048 + h * 256 + c * 128 + ps * 32;
#pragma unroll
        for (int j = 0; j < 8; ++j) {
          int tt = (lane >> 3) + 8 * j, f4 = lane & 7;
          float4 v = *reinterpret_cast<const float4*>(src + (size_t)tt * 2048 + f4 * 4);
          float* d = s_tile + tt * 33 + f4 * 4;
          d[0] = v.x; d[1] = v.y; d[2] = v.z; d[3] = v.w;
        }
#pragma unroll 4
        for (int s = 0; s < 32; ++s) {
          float v = s_tile[lane * 33 + s];
          int key = (mono_key(v) & ~127) | (127 - (ps * 32 + s));
          if (c == 0) INS16(L1, key) else INS16(L2, key)
        }
      }
    }
#pragma unroll
    for (int j = 0; j < 16; ++j) { s_list[(0 * 16 + j) * 64 + lane] = 127 - (L1[j] & 127); s_list[(1 * 16 + j) * 64 + lane] = 127 - (L2[j] & 127); }
    float v1[16], v2[16];
#pragma unroll
    for (int j = 0; j < 16; ++j) { v1[j] = mono_val(L1[j] & ~127); v2[j] = mono_val(L2[j] & ~127); }
    int LC[16];
#pragma unroll
    for (int j = 0; j < 16; ++j) LC[j] = (int)0x80000000;
#pragma unroll
    for (int i = 0; i < 16; ++i)
#pragma unroll
      for (int j = 0; j < 16; ++j)
        if ((i + 1) * (j + 1) <= 16) {
          int key = (mono_key(v1[i] + v2[j]) & ~255) | (255 - (i * 16 + j));
          INS16(LC, key)
        }
    const float scale = rsqrtf(s_ss[lane] * (1.f / 256.f) + EPS);
    float vs[16]; float den = 0.f;
    const float top = mono_val(LC[0] & ~255);
#pragma unroll
    for (int k = 0; k < 16; ++k) { vs[k] = __expf((mono_val(LC[k] & ~255) - top) * scale); den += vs[k]; }
    const float inv = 1.f / den;
    const size_t ob = (size_t)(t0 + lane) * 128 + h * 16;
#pragma unroll
    for (int k4 = 0; k4 < 4; ++k4) {
      int ee[4]; float gg[4], su[4];
#pragma unroll
      for (int q = 0; q < 4; ++q) {
        int k = k4 * 4 + q;
        int ci = 255 - (LC[k] & 255);
        int i1 = s_list[(0 * 16 + (ci >> 4)) * 64 + lane];
        int i2 = s_list[(1 * 16 + (ci & 15)) * 64 + lane];
        ee[q] = i1 * 128 + i2;
        gg[q] = vs[k] * inv * p.vs()[l * 16384 + ee[q]];
        su[q] = p.us()[l * 16384 + ee[q]];
      }
      *reinterpret_cast<int4*>(p.eidx() + ob + k4 * 4) = make_int4(ee[0], ee[1], ee[2], ee[3]);
      *reinterpret_cast<float4*>(p.egate() + ob + k4 * 4) = make_float4(gg[0], gg[1], gg[2], gg[3]);
      *reinterpret_cast<float4*>(p.esu() + ob + k4 * 4) = make_float4(su[0], su[1], su[2], su[3]);
    }
  }
}

__device__ __forceinline__ float dot16_fp8(const float* xf, uint4 u) {
  f32x2 a0 = __builtin_amdgcn_cvt_pk_f32_fp8(u.x, false), a1 = __builtin_amdgcn_cvt_pk_f32_fp8(u.x, true);
  f32x2 a2 = __builtin_amdgcn_cvt_pk_f32_fp8(u.y, false), a3 = __builtin_amdgcn_cvt_pk_f32_fp8(u.y, true);
  f32x2 a4 = __builtin_amdgcn_cvt_pk_f32_fp8(u.z, false), a5 = __builtin_amdgcn_cvt_pk_f32_fp8(u.z, true);
  f32x2 a6 = __builtin_amdgcn_cvt_pk_f32_fp8(u.w, false), a7 = __builtin_amdgcn_cvt_pk_f32_fp8(u.w, true);
  float s0 = xf[0] * a0.x, s1 = xf[1] * a0.y;
  s0 = fmaf(xf[2], a1.x, s0); s1 = fmaf(xf[3], a1.y, s1);
  s0 = fmaf(xf[4], a2.x, s0); s1 = fmaf(xf[5], a2.y, s1);
  s0 = fmaf(xf[6], a3.x, s0); s1 = fmaf(xf[7], a3.y, s1);
  s0 = fmaf(xf[8], a4.x, s0); s1 = fmaf(xf[9], a4.y, s1);
  s0 = fmaf(xf[10], a5.x, s0); s1 = fmaf(xf[11], a5.y, s1);
  s0 = fmaf(xf[12], a6.x, s0); s1 = fmaf(xf[13], a6.y, s1);
  s0 = fmaf(xf[14], a7.x, s0); s1 = fmaf(xf[15], a7.y, s1);
  return s0 + s1;
}
__device__ __forceinline__ void axpy16_fp8(float* y, float wgt, uint4 v) {
  f32x2 a0 = __builtin_amdgcn_cvt_pk_f32_fp8(v.x, false), a1 = __builtin_amdgcn_cvt_pk_f32_fp8(v.x, true);
  f32x2 a2 = __builtin_amdgcn_cvt_pk_f32_fp8(v.y, false), a3 = __builtin_amdgcn_cvt_pk_f32_fp8(v.y, true);
  f32x2 a4 = __builtin_amdgcn_cvt_pk_f32_fp8(v.z, false), a5 = __builtin_amdgcn_cvt_pk_f32_fp8(v.z, true);
  f32x2 a6 = __builtin_amdgcn_cvt_pk_f32_fp8(v.w, false), a7 = __builtin_amdgcn_cvt_pk_f32_fp8(v.w, true);
  y[0] = fmaf(wgt, a0.x, y[0]); y[1] = fmaf(wgt, a0.y, y[1]); y[2] = fmaf(wgt, a1.x, y[2]); y[3] = fmaf(wgt, a1.y, y[3]);
  y[4] = fmaf(wgt, a2.x, y[4]); y[5] = fmaf(wgt, a2.y, y[5]); y[6] = fmaf(wgt, a3.x, y[6]); y[7] = fmaf(wgt, a3.y, y[7]);
  y[8] = fmaf(wgt, a4.x, y[8]); y[9] = fmaf(wgt, a4.y, y[9]); y[10] = fmaf(wgt, a5.x, y[10]); y[11] = fmaf(wgt, a5.y, y[11]);
  y[12] = fmaf(wgt, a6.x, y[12]); y[13] = fmaf(wgt, a6.y, y[13]); y[14] = fmaf(wgt, a7.x, y[14]); y[15] = fmaf(wgt, a7.y, y[15]);
}

template <bool DRY>
__device__ __forceinline__ void ph_gather(const Params& p, int l, int bid, int nblk) {
  const int lane = tid_opaque() & 63, w = tid_opaque() >> 6;
  const unsigned char* u8 = p.ub8() + (size_t)l * 16384 * 1024;
  const unsigned char* v8 = p.vb8() + (size_t)l * 16384 * 1024;
  const unsigned loff = (unsigned)lane * 16u;
  for (int t = bid * 4 + w; t < NTOK; t += nblk * 4) {
    float xf[16];
    {
      const uint4 xa = *reinterpret_cast<const uint4*>(p.xn() + (size_t)t * 1024 + lane * 16);
      const uint4 xb = *reinterpret_cast<const uint4*>(p.xn() + (size_t)t * 1024 + lane * 16 + 8);
      xf[0] = bf_lo(xa.x); xf[1] = bf_hi(xa.x); xf[2] = bf_lo(xa.y); xf[3] = bf_hi(xa.y);
      xf[4] = bf_lo(xa.z); xf[5] = bf_hi(xa.z); xf[6] = bf_lo(xa.w); xf[7] = bf_hi(xa.w);
      xf[8] = bf_lo(xb.x); xf[9] = bf_hi(xb.x); xf[10] = bf_lo(xb.y); xf[11] = bf_hi(xb.y);
      xf[12] = bf_lo(xb.z); xf[13] = bf_hi(xb.z); xf[14] = bf_lo(xb.w); xf[15] = bf_hi(xb.w);
    }
    const int e_lo = p.eidx()[(size_t)t * 128 + lane], e_hi = p.eidx()[(size_t)t * 128 + 64 + lane];
    const float g_lo = p.egate()[(size_t)t * 128 + lane], g_hi = p.egate()[(size_t)t * 128 + 64 + lane];
    const float s_lo = p.esu()[(size_t)t * 128 + lane], s_hi = p.esu()[(size_t)t * 128 + 64 + lane];
    float y[16];
#pragma unroll
    for (int i = 0; i < 16; ++i) y[i] = 0.f;
#pragma unroll 1
    for (int k0 = 0; k0 < 128; k0 += 8) {
      uint4 ur[8], vr[8];
#pragma unroll
      for (int q = 0; q < 8; ++q) {
        const int kk = (k0 & 63) + q;
        const int e = (k0 < 64) ? __builtin_amdgcn_readlane(e_lo, kk) : __builtin_amdgcn_readlane(e_hi, kk);
        ur[q] = *reinterpret_cast<const uint4*>(u8 + (size_t)e * 1024 + loff);
        vr[q] = *reinterpret_cast<const uint4*>(v8 + (size_t)e * 1024 + loff);
      }
#pragma unroll
      for (int q = 0; q < 8; ++q) {
        const int kk = (k0 & 63) + q;
        const float gt = __int_as_float((k0 < 64) ? __builtin_amdgcn_readlane(__float_as_int(g_lo), kk) : __builtin_amdgcn_readlane(__float_as_int(g_hi), kk));
        const float su = __int_as_float((k0 < 64) ? __builtin_amdgcn_readlane(__float_as_int(s_lo), kk) : __builtin_amdgcn_readlane(__float_as_int(s_hi), kk));
        float d = wave_sum(dot16_fp8(xf, ur[q])) * su;
        const float wgt = gt * gelu_exact(d);
        axpy16_fp8(y, wgt, vr[q]);
      }
    }
    if (DRY) {
#pragma unroll
      for (int i = 0; i < 16; ++i) asm volatile("" ::"v"(y[i]));
      continue;
    }
    float* xr = p.x() + (size_t)t * 1024 + lane * 16;
#pragma unroll
    for (int j = 0; j < 4; ++j) {
      float4 a = reinterpret_cast<float4*>(xr)[j];
      a.x += y[4 * j]; a.y += y[4 * j + 1]; a.z += y[4 * j + 2]; a.w += y[4 * j + 3];
      reinterpret_cast<float4*>(xr)[j] = a;
    }
  }
}

enum { PH_PREP = 0, PH_NORM1, PH_GEMM_IN, PH_ATTN, PH_MLCONV, PH_MCHAIN, PH_MLU, PH_MLSCAN, PH_MLOUT, PH_CMLP,
       PH_GEMM_OUT, PH_NORM2, PH_GEMM_PQ, PH_GEMM_SC, PH_TOPK, PH_GATHER, PH_FINAL };

__device__ __forceinline__ Params phase_params(const Params& kp, bool with_inputs) {
  Params q;
  size_t z = 0;
  asm volatile("" : "+s"(z));
  q.out = kp.out + z;
  q.ws = kp.ws + z;
  q.in[0] = kp.in[0] + z;
  q.in[1] = kp.in[1] + z;
  if (with_inputs) {
#pragma unroll
    for (int i = 2; i < 30; ++i) q.in[i] = kp.in[i] + z;
  }
  return q;
}


#define XB_TMO      128
#define XB_XCNT(j)  (256  + 64 * (j))
#define XB_XSUB(j)  (1280 + 64 * (j))
#define XB_XGEN(j)  (2304 + 64 * (j))
#define XB_TOP      3328
#define XB_TOPGEN   3392
#define XCD_BAR_WORDS 3456
#define XB_SPIN_CAP (1u << 22)
__device__ __forceinline__ unsigned xb_ld(unsigned* p)              { return __hip_atomic_load(p, __ATOMIC_RELAXED, __HIP_MEMORY_SCOPE_AGENT); }
__device__ __forceinline__ unsigned xb_add(unsigned* p, unsigned v) { return __hip_atomic_fetch_add(p, v, __ATOMIC_RELAXED, __HIP_MEMORY_SCOPE_AGENT); }
__device__ __forceinline__ unsigned xb_xcc_id() { return (unsigned)__builtin_amdgcn_s_getreg((3 << 11) | 20) & 0xFu; }
#define XB_SPIN(cond, bar) do { unsigned _sp = 0; while (cond) { __builtin_amdgcn_s_sleep(1); \
    if ((++_sp & 255u) == 0u) { if (xb_ld(&(bar)[XB_TMO])) break; if (_sp > XB_SPIN_CAP) { atomicAdd(&(bar)[XB_TMO], 1u); break; } } } } while (0)

struct XcdBarrier { unsigned* bar; unsigned x; volatile LAS unsigned* st; };

__device__ __forceinline__ XcdBarrier xcd_barrier_post(unsigned* bar, volatile LAS unsigned* st) {
  XcdBarrier b; b.bar = bar; b.x = xb_xcc_id(); b.st = st;
  if (threadIdx.x == 0) (void)xb_add(&bar[XB_XCNT(b.x)], 1u);
  return b;
}
__device__ __forceinline__ void xcd_barrier_complete(unsigned* bar, unsigned x, unsigned& nloc, unsigned& nx) {
  const unsigned G = gridDim.x * gridDim.y * gridDim.z;
  unsigned sum, cnt, mine, sp = 0u;
  for (;;) {
    sum = 0u; cnt = 0u; mine = 0u;
#pragma unroll
    for (unsigned j = 0; j < 16; ++j) { const unsigned c = xb_ld(&bar[XB_XCNT(j)]); sum += c; cnt += (c > 0u) ? 1u : 0u; mine = (j == x) ? c : mine; }
    if (sum == G) break;
    __builtin_amdgcn_s_sleep(1);
    if ((++sp & 255u) == 0u) { if (xb_ld(&bar[XB_TMO])) break; if (sp > XB_SPIN_CAP) { atomicAdd(&bar[XB_TMO], 1u); break; } }
  }
  nloc = mine > 0u ? mine : 1u; nx = cnt > 0u ? cnt : 1u;
}
__device__ __forceinline__ void xcd_barrier(const XcdBarrier& b) {
  asm volatile("s_waitcnt vmcnt(0)" ::: "memory");
  __syncthreads();
  if (threadIdx.x == 0) {
    unsigned* bar = b.bar;
    __builtin_amdgcn_s_waitcnt(0);
    unsigned nloc = b.st[0], nx = b.st[1];
    if (nloc == 0u) { xcd_barrier_complete(bar, b.x, nloc, nx); b.st[0] = nloc; b.st[1] = nx; }
    const unsigned old = xb_add(&bar[XB_XSUB(b.x)], 1u);
    const unsigned gen = old / nloc;
    if (old + 1u == (gen + 1u) * nloc) {
      __builtin_amdgcn_fence(__ATOMIC_RELEASE, "agent");
      asm volatile("s_waitcnt vmcnt(0)" ::: "memory");
      const unsigned og = xb_add(&bar[XB_TOP], 1u);
      const unsigned tg = og / nx;
      if (og + 1u == (tg + 1u) * nx) xb_add(&bar[XB_TOPGEN], 1u);
      else XB_SPIN(xb_ld(&bar[XB_TOPGEN]) == tg, bar);
      __builtin_amdgcn_fence(__ATOMIC_ACQUIRE, "agent");
      xb_add(&bar[XB_XGEN(b.x)], 1u);
      asm volatile("s_waitcnt vmcnt(0)" ::: "memory");
    } else {
      XB_SPIN(xb_ld(&bar[XB_XGEN(b.x)]) == gen, bar);
      __builtin_amdgcn_fence(__ATOMIC_ACQUIRE, "agent");
      asm volatile("s_waitcnt vmcnt(0)" ::: "memory");
    }
  }
  __syncthreads();
}

#define GSYNC() xcd_barrier(xb)
#define PP(wi) phase_params(p, wi)
#define BN bid_opaque(bid), nblk_opaque(nblk)

template <int L>
__device__ __forceinline__ void layer_phases(const Params& p, char* smem, const XcdBarrier& xb, int bid, int nblk) {
  ph_rmsnorm<0>(PP(false), L, BN);
#if PROBE == 11
  GSYNC();
  ph_rmsnorm<0>(PP(false), L, BN);
#endif
  GSYNC();
  ph_gemm<EPI_WIN>(PP(false), L, smem, BN);
#if PROBE == 1
  GSYNC();
  ph_gemm<EPI_WIN>(PP(false), L, smem, BN);
#endif
  GSYNC();
  ph_attn(PP(false), L, smem, BN);
#if PROBE == 4
  GSYNC();
  ph_attn(PP(false), L, smem, BN);
#endif
  ph_mlconv(PP(false), L, smem, BN);
#if PROBE == 8 || PROBE == 20
  GSYNC();
  ph_mlconv(PP(false), L, smem, BN);
#endif
  ph_cmlp(PP(false), L, smem, BN);
#if PROBE == 7 || PROBE == 20
  GSYNC();
  ph_cmlp(PP(false), L, smem, BN);
#endif
  GSYNC();
  ph_mlU(PP(false), L, smem, BN);
#if PROBE == 9 || PROBE == 20
  GSYNC();
  ph_mlU(PP(false), L, smem, BN);
#endif
  GSYNC();
  ph_mlscan(PP(false), L, BN);
#if PROBE == 10 || PROBE == 20
  GSYNC();
  ph_mlscan(PP(false), L, BN);
#endif
  GSYNC();
  ph_mlout(PP(false), L, smem, BN);
#if PROBE == 6 || PROBE == 20
  GSYNC();
  ph_mlout(PP(false), L, smem, BN);
#endif
  GSYNC();
  ph_gemm<EPI_WOUT>(PP(false), L, smem, BN);
  GSYNC();
  ph_rmsnorm<1>(PP(false), L, BN);
  GSYNC();
  ph_gemm<EPI_PQ>(PP(false), L, smem, BN);
#if PROBE == 2
  GSYNC();
  ph_gemm<EPI_PQ>(PP(false), L, smem, BN);
#endif
  GSYNC();
  ph_gemm<EPI_SC>(PP(false), L, smem, BN);
#if PROBE == 3
  GSYNC();
  ph_gemm<EPI_SC>(PP(false), L, smem, BN);
#endif
  GSYNC();
  ph_topk(PP(false), L, smem, BN);
#if PROBE == 5
  GSYNC();
  ph_topk(PP(false), L, smem, BN);
#endif
  GSYNC();
  ph_gather<false>(PP(false), L, BN);
  GSYNC();
}

__global__ void __launch_bounds__(256, 2) mega_kernel(Params p) {
  __shared__ __attribute__((aligned(16))) char smem[SMEM_BYTES];
  __shared__ uint4 xb_words;
  cg::grid_group grid = cg::this_grid();
  const int bid = blockIdx.x, nblk = gridDim.x;
  if (threadIdx.x == 0) xb_words = make_uint4(0u, 0u, 0u, 0u);
  __syncthreads();
  XcdBarrier xb = xcd_barrier_post(reinterpret_cast<unsigned*>(p.ws), (volatile LAS unsigned*)&xb_words);
  grid.sync();
  ph_prep(PP(true), smem, BN);
#if PROBE == 12
  GSYNC();
  ph_prep(PP(true), smem, BN);
#endif
  GSYNC();
  layer_phases<0>(p, smem, xb, bid, nblk);
  layer_phases<1>(p, smem, xb, bid, nblk);
  ph_rmsnorm<2>(PP(false), 0, BN);
}

static inline size_t align_up(size_t v, size_t a) { return (v + a - 1) / a * a; }

extern "C" void kernel_launch(void* const* d_in, const int* in_sizes, int n_in, void* d_out, int out_size, void* d_ws,
                              size_t ws_size, hipStream_t stream) {
  Params p{};
  for (int i = 0; i < 30; ++i) p.in[i] = reinterpret_cast<const float*>(d_in[i]);
  p.out = reinterpret_cast<float*>(d_out);
  p.ws = reinterpret_cast<char*>(d_ws);
  if (WS_NEED > ws_size) { fprintf(stderr, "workspace too small: need %zu have %zu\n", (size_t)WS_NEED, ws_size); return; }
  static int grid_blocks = 0;
  if (!grid_blocks) {
    int dev = 0, cus = 0, per_cu = 0;
    hipGetDevice(&dev);
    hipDeviceGetAttribute(&cus, hipDeviceAttributeMultiprocessorCount, dev);
    hipOccupancyMaxActiveBlocksPerMultiprocessor(&per_cu, mega_kernel, 256, 0);
    if (per_cu > 2) per_cu = 2;
    if (per_cu < 1) per_cu = 1;
    grid_blocks = cus * per_cu;
  }
  hipMemsetAsync(d_ws, 0, 16384, stream);
  void* args[] = {&p};
  hipError_t e = hipLaunchCooperativeKernel((void*)mega_kernel, dim3(grid_blocks), dim3(256), args, 0, stream);
  if (e != hipSuccess) fprintf(stderr, "cooperative launch failed: %s (grid %d)\n", hipGetErrorString(e), grid_blocks);
}
```

```cpp
#include <hip/hip_runtime.h>
#include <hip/hip_cooperative_groups.h>
#include <cstdio>
#include <cstdint>

namespace cg = cooperative_groups;

typedef unsigned short bf16_t;
typedef __attribute__((ext_vector_type(8))) __bf16 bf16x8;
typedef __attribute__((ext_vector_type(2))) __bf16 bf16x2;
typedef __attribute__((ext_vector_type(16))) float f32x16;
typedef __attribute__((ext_vector_type(2))) float f32x2;

#define D_MODEL 1024
#define NTOK 16896
#define NPROMPT 16384
#define SEQ 4096
#define NIN 2816
#define EPS 1e-6f
#define LOG2E 1.4426950408889634f
#define SKEYS 1088
#define NCU_UNITS 1056

constexpr size_t O_Y_P = 0;
constexpr size_t O_Y_S = O_Y_P + 16777216;
constexpr size_t O_K_P = O_Y_S + 524288;
constexpr size_t O_V_P = O_K_P + 16777216;
constexpr size_t O_C_P = O_V_P + 16777216;
constexpr size_t O_N_P = O_C_P + 131072;
constexpr size_t O_M_P = O_N_P + 2048;
constexpr size_t O_CONV_P = O_M_P + 32;
constexpr size_t O_K_S = O_CONV_P + 6144;
constexpr size_t O_V_S = O_K_S + 524288;
constexpr size_t O_C_S = O_V_S + 524288;
constexpr size_t O_N_S = O_C_S + 262144;
constexpr size_t O_M_S = O_N_S + 4096;
constexpr size_t O_CONV_S = O_M_S + 64;
constexpr size_t O_CMV_S = O_CONV_S + 12288;

constexpr size_t al256(size_t v) { return (v + 255) / 256 * 256; }
constexpr int SP_st_c = 0;
constexpr int SP_st_n = 262144;
constexpr int SP_st_m = 266240;
constexpr int SP_st_conv = 266304;
constexpr int SP_norm1_g = 278592;
constexpr int SP_da_subln_g = 280640;
constexpr int SP_ml_conv_w = 280896;
constexpr int SP_ml_conv_b = 282944;
constexpr int SP_ml_wq = 283456;
constexpr int SP_ml_wk = 316224;
constexpr int SP_ml_gate_b = 348992;
constexpr int SP_ml_norm_g = 349056;
constexpr int SP_ml_skip = 349568;
constexpr int SP_cm_norm_g = 350080;
constexpr int SP_cm_ws = 350592;
constexpr int SP_cm_b = 481664;
constexpr int SP_norm2_g = 482688;
constexpr int SP_final_g = 484736;
constexpr int SP_TOTAL = 485760;
constexpr size_t WS_bar = 0;
constexpr size_t WS_lam = al256(WS_bar + 16384);
constexpr size_t WS_lut = al256(WS_lam + (256));
constexpr size_t WS_sp = al256(WS_lut + (4*256*4));
constexpr size_t WS_wt_in = al256(WS_sp + (SP_TOTAL*4));
constexpr size_t WS_wg = al256(WS_wt_in + ((size_t)2*NIN*1024*2));
constexpr size_t WS_wt_out = al256(WS_wg + ((size_t)2*8*1024*4));
constexpr size_t WS_wt_pq = al256(WS_wt_out + ((size_t)2*1024*1024*2));
constexpr size_t WS_keysb = al256(WS_wt_pq + ((size_t)2*2048*1024*2));
constexpr size_t WS_ub8 = al256(WS_keysb + ((size_t)2*16*128*128*2));
constexpr size_t WS_vb8 = al256(WS_ub8 + ((size_t)2*16384*1024));
constexpr size_t WS_us = al256(WS_vb8 + ((size_t)2*16384*1024));
constexpr size_t WS_vs = al256(WS_us + ((size_t)2*16384*4));
constexpr size_t WS_Kbs = al256(WS_vs + ((size_t)2*16384*4));
constexpr size_t WS_Vts = al256(WS_Kbs + ((size_t)2*8*SKEYS*512*2));
constexpr size_t WS_x = al256(WS_Vts + ((size_t)2*8*4*128*SKEYS*2));
constexpr size_t WS_xn = al256(WS_x + ((size_t)NTOK*1024*4));
constexpr size_t WS_R0 = al256(WS_xn + ((size_t)NTOK*1024*2));
constexpr size_t WS_R0x = WS_R0;
constexpr size_t WS_Qb = al256(WS_R0x + (0));
constexpr size_t WS_Kb = al256(WS_Qb + ((size_t)NTOK*512*2));
constexpr size_t WS_Vt = al256(WS_Kb + ((size_t)NPROMPT*512*2));
constexpr size_t WS_P5 = al256(WS_Vt + ((size_t)16*128*SEQ*2));
constexpr size_t WS_ig = al256(WS_P5 + ((size_t)NTOK*1280*4));
constexpr size_t WS_lf = al256(WS_ig + ((size_t)NTOK*4*4));
constexpr size_t WS_Fc = al256(WS_lf + ((size_t)NTOK*4*4));
constexpr size_t WS_cc = al256(WS_Fc + ((size_t)NTOK*4*4));
constexpr size_t WS_qm = al256(WS_cc + ((size_t)NTOK*256*4));
constexpr size_t WS_km = al256(WS_qm + ((size_t)NTOK*256*4));
constexpr size_t WS_mst = al256(WS_km + ((size_t)NTOK*256*4));
constexpr size_t WS_mnx = al256(WS_mst + (NCU_UNITS*4));
constexpr size_t WS_wcs = al256(WS_mnx + (NCU_UNITS*4));
constexpr size_t WS_FLs = al256(WS_wcs + (NCU_UNITS*4));
constexpr size_t WS_mxt = al256(WS_FLs + (NCU_UNITS*4));
constexpr size_t WS_U = al256(WS_mxt + (NCU_UNITS*4));
constexpr size_t WS_un = al256(WS_U + ((size_t)NCU_UNITS*4096*4));
constexpr size_t WS_Cst = al256(WS_un + ((size_t)NCU_UNITS*64*4));
constexpr size_t WS_nst = al256(WS_Cst + ((size_t)NCU_UNITS*4096*4));
constexpr size_t WS_END_MIXER = al256(WS_nst + ((size_t)NCU_UNITS*64*4));
constexpr size_t WS_qp = al256(WS_R0x + (0));
constexpr size_t WS_sc = al256(WS_qp + ((size_t)NTOK*2048*2));
constexpr size_t WS_eidx = al256(WS_sc + ((size_t)NTOK*2048*4));
constexpr size_t WS_egate = al256(WS_eidx + ((size_t)NTOK*128*4));
constexpr size_t WS_esu = al256(WS_egate + ((size_t)NTOK*128*4));
constexpr size_t WS_END_PEER = al256(WS_esu + ((size_t)NTOK*128*4));
constexpr size_t WS_NEED = WS_END_MIXER > WS_END_PEER ? WS_END_MIXER : WS_END_PEER;

struct Params {
  const float* in[30];
  float* out;
  char* ws;
  __device__ __forceinline__ const float* x_prompt() const { return in[0]; }
  __device__ __forceinline__ const float* x_sample() const { return in[1]; }
  __device__ __forceinline__ const float* cache_k() const { return in[2]; }
  __device__ __forceinline__ const float* cache_v() const { return in[3]; }
  __device__ __forceinline__ const float* w_in() const { return in[9]; }
  __device__ __forceinline__ const float* da_lambda() const { return in[10]; }
  __device__ __forceinline__ const float* rel_table() const { return in[12]; }
  __device__ __forceinline__ const float* w_out() const { return in[23]; }
  __device__ __forceinline__ const float* peer_wq() const { return in[25]; }
  __device__ __forceinline__ const float* peer_keys() const { return in[26]; }
  __device__ __forceinline__ const float* peer_u() const { return in[27]; }
  __device__ __forceinline__ const float* peer_v() const { return in[28]; }
  __device__ __forceinline__ const float* st_c() const { return reinterpret_cast<const float*>(ws + WS_sp) + SP_st_c; }
  __device__ __forceinline__ const float* st_n() const { return reinterpret_cast<const float*>(ws + WS_sp) + SP_st_n; }
  __device__ __forceinline__ const float* st_m() const { return reinterpret_cast<const float*>(ws + WS_sp) + SP_st_m; }
  __device__ __forceinline__ const float* st_conv() const { return reinterpret_cast<const float*>(ws + WS_sp) + SP_st_conv; }
  __device__ __forceinline__ const float* norm1_g() const { return reinterpret_cast<const float*>(ws + WS_sp) + SP_norm1_g; }
  __device__ __forceinline__ const float* da_subln_g() const { return reinterpret_cast<const float*>(ws + WS_sp) + SP_da_subln_g; }
  __device__ __forceinline__ const float* ml_conv_w() const { return reinterpret_cast<const float*>(ws + WS_sp) + SP_ml_conv_w; }
  __device__ __forceinline__ const float* ml_conv_b() const { return reinterpret_cast<const float*>(ws + WS_sp) + SP_ml_conv_b; }
  __device__ __forceinline__ const float* ml_wq() const { return reinterpret_cast<const float*>(ws + WS_sp) + SP_ml_wq; }
  __device__ __forceinline__ const float* ml_wk() const { return reinterpret_cast<const float*>(ws + WS_sp) + SP_ml_wk; }
  __device__ __forceinline__ const float* ml_gate_b() const { return reinterpret_cast<const float*>(ws + WS_sp) + SP_ml_gate_b; }
  __device__ __forceinline__ const float* ml_norm_g() const { return reinterpret_cast<const float*>(ws + WS_sp) + SP_ml_norm_g; }
  __device__ __forceinline__ const float* ml_skip() const { return reinterpret_cast<const float*>(ws + WS_sp) + SP_ml_skip; }
  __device__ __forceinline__ const float* cm_norm_g() const { return reinterpret_cast<const float*>(ws + WS_sp) + SP_cm_norm_g; }
  __device__ __forceinline__ const float* cm_ws() const { return reinterpret_cast<const float*>(ws + WS_sp) + SP_cm_ws; }
  __device__ __forceinline__ const float* cm_b() const { return reinterpret_cast<const float*>(ws + WS_sp) + SP_cm_b; }
  __device__ __forceinline__ const float* norm2_g() const { return reinterpret_cast<const float*>(ws + WS_sp) + SP_norm2_g; }
  __device__ __forceinline__ const float* final_g() const { return reinterpret_cast<const float*>(ws + WS_sp) + SP_final_g; }
  __device__ __forceinline__ float* lam() const { return reinterpret_cast<float*>(ws + WS_lam); }
  __device__ __forceinline__ float* lut() const { return reinterpret_cast<float*>(ws + WS_lut); }
  __device__ __forceinline__ float* sp() const { return reinterpret_cast<float*>(ws + WS_sp); }
  __device__ __forceinline__ bf16_t* wt_in() const { return reinterpret_cast<bf16_t*>(ws + WS_wt_in); }
  __device__ __forceinline__ float* wg() const { return reinterpret_cast<float*>(ws + WS_wg); }
  __device__ __forceinline__ bf16_t* wt_out() const { return reinterpret_cast<bf16_t*>(ws + WS_wt_out); }
  __device__ __forceinline__ bf16_t* wt_pq() const { return reinterpret_cast<bf16_t*>(ws + WS_wt_pq); }
  __device__ __forceinline__ bf16_t* keysb() const { return reinterpret_cast<bf16_t*>(ws + WS_keysb); }
  __device__ __forceinline__ unsigned char* ub8() const { return reinterpret_cast<unsigned char*>(ws + WS_ub8); }
  __device__ __forceinline__ unsigned char* vb8() const { return reinterpret_cast<unsigned char*>(ws + WS_vb8); }
  __device__ __forceinline__ float* us() const { return reinterpret_cast<float*>(ws + WS_us); }
  __device__ __forceinline__ float* vs() const { return reinterpret_cast<float*>(ws + WS_vs); }
  __device__ __forceinline__ bf16_t* Kbs() const { return reinterpret_cast<bf16_t*>(ws + WS_Kbs); }
  __device__ __forceinline__ bf16_t* Vts() const { return reinterpret_cast<bf16_t*>(ws + WS_Vts); }
  __device__ __forceinline__ float* x() const { return reinterpret_cast<float*>(ws + WS_x); }
  __device__ __forceinline__ bf16_t* xn() const { return reinterpret_cast<bf16_t*>(ws + WS_xn); }
  __device__ __forceinline__ bf16_t* Qb() const { return reinterpret_cast<bf16_t*>(ws + WS_Qb); }
  __device__ __forceinline__ bf16_t* Kb() const { return reinterpret_cast<bf16_t*>(ws + WS_Kb); }
  __device__ __forceinline__ bf16_t* Vt() const { return reinterpret_cast<bf16_t*>(ws + WS_Vt); }
  __device__ __forceinline__ float* P5() const { return reinterpret_cast<float*>(ws + WS_P5); }
  __device__ __forceinline__ float* ig() const { return reinterpret_cast<float*>(ws + WS_ig); }
  __device__ __forceinline__ float* lf() const { return reinterpret_cast<float*>(ws + WS_lf); }
  __device__ __forceinline__ float* Fc() const { return reinterpret_cast<float*>(ws + WS_Fc); }
  __device__ __forceinline__ float* cc() const { return reinterpret_cast<float*>(ws + WS_cc); }
  __device__ __forceinline__ float* qm() const { return reinterpret_cast<float*>(ws + WS_qm); }
  __device__ __forceinline__ float* km() const { return reinterpret_cast<float*>(ws + WS_km); }
  __device__ __forceinline__ float* mst() const { return reinterpret_cast<float*>(ws + WS_mst); }
  __device__ __forceinline__ float* mnx() const { return reinterpret_cast<float*>(ws + WS_mnx); }
  __device__ __forceinline__ float* wcs() const { return reinterpret_cast<float*>(ws + WS_wcs); }
  __device__ __forceinline__ float* FLs() const { return reinterpret_cast<float*>(ws + WS_FLs); }
  __device__ __forceinline__ float* mxt() const { return reinterpret_cast<float*>(ws + WS_mxt); }
  __device__ __forceinline__ float* U() const { return reinterpret_cast<float*>(ws + WS_U); }
  __device__ __forceinline__ float* un() const { return reinterpret_cast<float*>(ws + WS_un); }
  __device__ __forceinline__ float* Cst() const { return reinterpret_cast<float*>(ws + WS_Cst); }
  __device__ __forceinline__ float* nst() const { return reinterpret_cast<float*>(ws + WS_nst); }
  __device__ __forceinline__ bf16_t* qp() const { return reinterpret_cast<bf16_t*>(ws + WS_qp); }
  __device__ __forceinline__ float* sc() const { return reinterpret_cast<float*>(ws + WS_sc); }
  __device__ __forceinline__ int* eidx() const { return reinterpret_cast<int*>(ws + WS_eidx); }
  __device__ __forceinline__ float* egate() const { return reinterpret_cast<float*>(ws + WS_egate); }
  __device__ __forceinline__ float* esu() const { return reinterpret_cast<float*>(ws + WS_esu); }
};

__device__ __forceinline__ unsigned pack2(float a, float b) {
  f32x2 v = {a, b};
  bf16x2 r = __builtin_convertvector(v, bf16x2);
  return *reinterpret_cast<unsigned*>(&r);
}
__device__ __forceinline__ bf16_t f2bf(float a) { return (bf16_t)(pack2(a, 0.f) & 0xFFFFu); }
__device__ __forceinline__ float bf_lo(unsigned u) { return __uint_as_float(u << 16); }
__device__ __forceinline__ float bf_hi(unsigned u) { return __uint_as_float(u & 0xFFFF0000u); }
__device__ __forceinline__ float gelu_exact(float x) { return 0.5f * x * (1.f + erff(x * 0.70710678118654752f)); }
__device__ __forceinline__ float sigmoidf_(float x) { return 1.f / (1.f + __expf(-x)); }
template <int CTRL>
__device__ __forceinline__ float dpp_f(float v) {
  return __builtin_bit_cast(float, __builtin_amdgcn_update_dpp(0, __builtin_bit_cast(int, v), CTRL, 0xf, 0xf, true));
}
__device__ __forceinline__ float swap16_sum(float x) {
  auto s = __builtin_amdgcn_permlane16_swap(__float_as_uint(x), __float_as_uint(x), false, false);
  return __uint_as_float(s[0]) + __uint_as_float(s[1]);
}
__device__ __forceinline__ float swap32_sum(float x) {
  auto s = __builtin_amdgcn_permlane32_swap(__float_as_uint(x), __float_as_uint(x), false, false);
  return __uint_as_float(s[0]) + __uint_as_float(s[1]);
}
__device__ __forceinline__ float swap16_max(float x) {
  auto s = __builtin_amdgcn_permlane16_swap(__float_as_uint(x), __float_as_uint(x), false, false);
  return fmaxf(__uint_as_float(s[0]), __uint_as_float(s[1]));
}
__device__ __forceinline__ float swap32_max(float x) {
  auto s = __builtin_amdgcn_permlane32_swap(__float_as_uint(x), __float_as_uint(x), false, false);
  return fmaxf(__uint_as_float(s[0]), __uint_as_float(s[1]));
}
__device__ __forceinline__ float row16_sum(float v) {
  v += dpp_f<0xB1>(v); v += dpp_f<0x4E>(v); v += dpp_f<0x141>(v); v += dpp_f<0x140>(v);
  return v;
}
__device__ __forceinline__ float row16_max(float v) {
  v = fmaxf(v, dpp_f<0xB1>(v)); v = fmaxf(v, dpp_f<0x4E>(v)); v = fmaxf(v, dpp_f<0x141>(v)); v = fmaxf(v, dpp_f<0x140>(v));
  return v;
}
__device__ __forceinline__ float wave_sum(float v) { return swap32_sum(swap16_sum(row16_sum(v))); }
__device__ __forceinline__ float wave_max(float v) { return swap32_max(swap16_max(row16_max(v))); }
__device__ __forceinline__ const float* xrow_in(const Params& p, int l, int t) {
  if (l == 0) return (t < NPROMPT) ? p.x_prompt() + (size_t)t * D_MODEL : p.x_sample() + (size_t)(t - NPROMPT) * D_MODEL;
  return p.x() + (size_t)t * D_MODEL;
}
__device__ __forceinline__ bf16x8 as_bf16x8(uint4 v) { return *reinterpret_cast<bf16x8*>(&v); }

__device__ __forceinline__ int tid_opaque() { int t = threadIdx.x; asm volatile("" : "+v"(t)); return t; }
__device__ __forceinline__ int sgpr_opaque(int v) { asm volatile("" : "+s"(v)); return v; }
__device__ __forceinline__ int bid_opaque(int v) { asm volatile("" : "+s"(v)); __builtin_assume(v >= 0); __builtin_assume(v < 1024); return v; }
__device__ __forceinline__ int nblk_opaque(int v) { asm volatile("" : "+s"(v)); __builtin_assume(v >= 1); __builtin_assume(v <= 1024); return v; }
#define LAS __attribute__((address_space(3)))
#ifndef PROBE
#define PROBE 0
#endif
#define SMEM_BYTES 73728

__device__ __forceinline__ void transpose_tile(const float* __restrict__ src, int lds, bf16_t* __restrict__ dst, int K, int n0, int k0,
                               int gate_skip, float* tile  ) {
  const int tid = tid_opaque();
  const int c = tid & 63, r0 = tid >> 6;
  int n = n0 + c;
  int col = n + ((gate_skip && n >= 2304) ? 8 : 0);
#pragma unroll 4
  for (int j = 0; j < 16; ++j) {
    int r = r0 + 4 * j;
    tile[r * 65 + c] = src[(size_t)(k0 + r) * lds + col];
  }
  __syncthreads();
  const int nn = tid >> 2, kg = (tid & 3) * 16;
  unsigned w[8];
#pragma unroll
  for (int j = 0; j < 8; ++j) w[j] = pack2(tile[(kg + 2 * j) * 65 + nn], tile[(kg + 2 * j + 1) * 65 + nn]);
  uint4* d = reinterpret_cast<uint4*>(dst + (size_t)(n0 + nn) * K + k0 + kg);
  d[0] = make_uint4(w[0], w[1], w[2], w[3]);
  d[1] = make_uint4(w[4], w[5], w[6], w[7]);
  __syncthreads();
}

__device__ __forceinline__ int rel_bucket_dev(int rel) {
  int ret = rel > 0 ? 16 : 0;
  int n = rel < 0 ? -rel : rel;
  int b;
  if (n < 8) b = n;
  else if (n < 12) b = 8;
  else if (n < 16) b = 9;
  else if (n < 23) b = 10;
  else if (n < 32) b = 11;
  else if (n < 46) b = 12;
  else if (n < 64) b = 13;
  else if (n < 91) b = 14;
  else b = 15;
  return ret + b;
}

__device__ __forceinline__ void ph_prep(const Params& p, char* smem, int bid, int nblk) {
  const int tid = tid_opaque();
  float* tile = reinterpret_cast<float*>(smem);
  for (int u = bid; u < 2 * 1472; u += nblk) {
    int l = u / 1472, r = u % 1472;
    if (r < 704) {
      int nt = r / 16, kt = r % 16;
      transpose_tile(p.w_in() + (size_t)l * 1024 * 2824, 2824, p.wt_in() + (size_t)l * NIN * 1024, 1024, nt * 64, kt * 64, 1, tile);
    } else if (r < 960) {
      r -= 704; int nt = r / 16, kt = r % 16;
      transpose_tile(p.w_out() + (size_t)l * 1024 * 1024, 1024, p.wt_out() + (size_t)l * 1024 * 1024, 1024, nt * 64, kt * 64, 0, tile);
    } else {
      r -= 960; int nt = r / 16, kt = r % 16;
      transpose_tile(p.peer_wq() + (size_t)l * 1024 * 2048, 2048, p.wt_pq() + (size_t)l * 2048 * 1024, 1024, nt * 64, kt * 64, 0, tile);
    }
  }
  for (int u = bid; u < 1024; u += nblk) {
    int kt = u & 15, h = (u >> 4) & 3, b = (u >> 6) & 7, l = u >> 9;
    const float* src = p.cache_v() + (((size_t)(l * 8 + b) * 1024 + kt * 64) * 4 + h) * 128;
    {
      int c = tid & 127, r0 = tid >> 7;
      for (int j = 0; j < 32; ++j) { int r = r0 + 2 * j; tile[r * 129 + c] = src[(size_t)r * 512 + c]; }
    }
    __syncthreads();
    {
      int dv = tid >> 1, half = tid & 1;
      bf16_t* dst = p.Vts() + ((size_t)((l * 8 + b) * 4 + h) * 128 + dv) * SKEYS + kt * 64 + half * 32;
      unsigned w[16];
#pragma unroll
      for (int j = 0; j < 16; ++j) {
        int pos0 = half * 32 + 2 * j;
        int blk = (pos0 >> 2) & 3;
        int oblk = (blk == 1) ? 2 : (blk == 2 ? 1 : blk);
        int key0 = (pos0 & ~15) + oblk * 4 + (pos0 & 3);
        w[j] = pack2(tile[key0 * 129 + dv], tile[(key0 + 1) * 129 + dv]);
      }
      uint4* d4 = reinterpret_cast<uint4*>(dst);
      d4[0] = make_uint4(w[0], w[1], w[2], w[3]);
      d4[1] = make_uint4(w[4], w[5], w[6], w[7]);
      d4[2] = make_uint4(w[8], w[9], w[10], w[11]);
      d4[3] = make_uint4(w[12], w[13], w[14], w[15]);
    }
    __syncthreads();
  }
  const size_t gtid = (size_t)bid * 256 + tid, gsz = (size_t)nblk * 256;
  {
    const int lane = tid & 63, wv = tid >> 6;
    for (int r = bid * 4 + wv; r < 2 * 32768; r += nblk * 4) {
      const int tab = r >> 15, row = r & 32767;
      const float* src = (tab == 0 ? p.peer_u() : p.peer_v()) + (size_t)row * 1024 + lane * 16;
      float4 f0 = reinterpret_cast<const float4*>(src)[0], f1 = reinterpret_cast<const float4*>(src)[1];
      float4 f2 = reinterpret_cast<const float4*>(src)[2], f3 = reinterpret_cast<const float4*>(src)[3];
      float am = fmaxf(fmaxf(fmaxf(fabsf(f0.x), fabsf(f0.y)), fmaxf(fabsf(f0.z), fabsf(f0.w))),
                       fmaxf(fmaxf(fabsf(f1.x), fabsf(f1.y)), fmaxf(fabsf(f1.z), fabsf(f1.w))));
      am = fmaxf(am, fmaxf(fmaxf(fmaxf(fabsf(f2.x), fabsf(f2.y)), fmaxf(fabsf(f2.z), fabsf(f2.w))),
                           fmaxf(fmaxf(fabsf(f3.x), fabsf(f3.y)), fmaxf(fabsf(f3.z), fabsf(f3.w)))));
      am = wave_max(am);
      const float sc = am > 0.f ? 224.f / am : 1.f;
      int w0 = 0, w1 = 0, w2 = 0, w3 = 0;
      w0 = __builtin_amdgcn_cvt_pk_fp8_f32(f0.x * sc, f0.y * sc, w0, false); w0 = __builtin_amdgcn_cvt_pk_fp8_f32(f0.z * sc, f0.w * sc, w0, true);
      w1 = __builtin_amdgcn_cvt_pk_fp8_f32(f1.x * sc, f1.y * sc, w1, false); w1 = __builtin_amdgcn_cvt_pk_fp8_f32(f1.z * sc, f1.w * sc, w1, true);
      w2 = __builtin_amdgcn_cvt_pk_fp8_f32(f2.x * sc, f2.y * sc, w2, false); w2 = __builtin_amdgcn_cvt_pk_fp8_f32(f2.z * sc, f2.w * sc, w2, true);
      w3 = __builtin_amdgcn_cvt_pk_fp8_f32(f3.x * sc, f3.y * sc, w3, false); w3 = __builtin_amdgcn_cvt_pk_fp8_f32(f3.z * sc, f3.w * sc, w3, true);
      unsigned char* dst = (tab == 0 ? p.ub8() : p.vb8()) + (size_t)row * 1024 + lane * 16;
      *reinterpret_cast<uint4*>(dst) = make_uint4((unsigned)w0, (unsigned)w1, (unsigned)w2, (unsigned)w3);
      if (lane == 0) (tab == 0 ? p.us() : p.vs())[row] = am > 0.f ? am * (1.f / 224.f) : 1.f;
    }
  }
  {
    const size_t n8 = (size_t)2 * 16 * 128 * 128 / 8;
    for (size_t i = gtid; i < n8; i += gsz) {
      float4 a = reinterpret_cast<const float4*>(p.peer_keys())[2 * i], b = reinterpret_cast<const float4*>(p.peer_keys())[2 * i + 1];
      reinterpret_cast<uint4*>(p.keysb())[i] = make_uint4(pack2(a.x, a.y), pack2(a.z, a.w), pack2(b.x, b.y), pack2(b.z, b.w));
    }
  }
  {
    const size_t n8 = (size_t)2 * 8 * 1024 * 512 / 8;
    for (size_t i = gtid; i < n8; i += gsz) {
      size_t e = i * 8;
      size_t lb = e / (1024 * 512), rem = e % (1024 * 512);
      float4 a = reinterpret_cast<const float4*>(p.cache_k())[2 * i], b = reinterpret_cast<const float4*>(p.cache_k())[2 * i + 1];
      *reinterpret_cast<uint4*>(p.Kbs() + lb * (SKEYS * 512) + rem) = make_uint4(pack2(a.x, a.y), pack2(a.z, a.w), pack2(b.x, b.y), pack2(b.z, b.w));
    }
  }
  for (size_t i = gtid; i < 2 * 8 * 1024; i += gsz) {
    int l = (int)(i / 8192), r = (int)(i % 8192), g = r / 1024, k = r % 1024;
    p.wg()[i] = p.w_in()[((size_t)l * 1024 + k) * 2824 + 2304 + g];
  }
  {
    float* sp = reinterpret_cast<float*>(p.ws + WS_sp);
    for (size_t i = gtid; i < 262144; i += gsz) sp[SP_st_c + i] = p.in[4][i];
    for (size_t i = gtid; i < 4096; i += gsz) sp[SP_st_n + i] = p.in[5][i];
    for (size_t i = gtid; i < 64; i += gsz) sp[SP_st_m + i] = p.in[6][i];
    for (size_t i = gtid; i < 12288; i += gsz) sp[SP_st_conv + i] = p.in[7][i];
    for (size_t i = gtid; i < 2048; i += gsz) sp[SP_norm1_g + i] = p.in[8][i];
    for (size_t i = gtid; i < 256; i += gsz) sp[SP_da_subln_g + i] = p.in[11][i];
    for (size_t i = gtid; i < 2048; i += gsz) sp[SP_ml_conv_w + i] = p.in[13][i];
    for (size_t i = gtid; i < 512; i += gsz) sp[SP_ml_conv_b + i] = p.in[14][i];
    for (size_t i = gtid; i < 32768; i += gsz) sp[SP_ml_wq + i] = p.in[15][i];
    for (size_t i = gtid; i < 32768; i += gsz) sp[SP_ml_wk + i] = p.in[16][i];
    for (size_t i = gtid; i < 16; i += gsz) sp[SP_ml_gate_b + i] = p.in[17][i];
    for (size_t i = gtid; i < 512; i += gsz) sp[SP_ml_norm_g + i] = p.in[18][i];
    for (size_t i = gtid; i < 512; i += gsz) sp[SP_ml_skip + i] = p.in[19][i];
    for (size_t i = gtid; i < 512; i += gsz) sp[SP_cm_norm_g + i] = p.in[20][i];
    for (size_t i = gtid; i < 131072; i += gsz) sp[SP_cm_ws + i] = p.in[21][i];
    for (size_t i = gtid; i < 1024; i += gsz) sp[SP_cm_b + i] = p.in[22][i];
    for (size_t i = gtid; i < 2048; i += gsz) sp[SP_norm2_g + i] = p.in[24][i];
    for (size_t i = gtid; i < 1024; i += gsz) sp[SP_final_g + i] = p.in[29][i];
  }
  if (bid == 0) {
    for (int i = tid; i < 4 * 256; i += 256) {
      int h = i >> 8, j = i & 255;
      int rel = j - 191; if (rel > 63) rel = 63;
      p.lut()[i] = p.rel_table()[rel_bucket_dev(rel) * 4 + h] * LOG2E;
    }
    if (tid < 2) {
      const float* lp = p.da_lambda() + tid * 256;
      float s01 = 0.f, s23 = 0.f;
      for (int d = 0; d < 64; ++d) { s01 += lp[d] * lp[64 + d]; s23 += lp[128 + d] * lp[192 + d]; }
      float lam_init = 0.8f - 0.6f * expf(-0.3f * (float)tid);
      p.lam()[tid] = expf(s01) - expf(s23) + lam_init;
    }
  }
}

template <int MODE>
__device__ __forceinline__ void ph_rmsnorm(const Params& p, int l, int bid, int nblk) {
  const int lane = tid_opaque() & 63, w = tid_opaque() >> 6;
  const float* g = (MODE == 0) ? p.norm1_g() + l * 1024 : (MODE == 1 ? p.norm2_g() + l * 1024 : p.final_g());
  float4 gv[4];
#pragma unroll
  for (int j = 0; j < 4; ++j) gv[j] = reinterpret_cast<const float4*>(g)[lane + 64 * j];
  for (int t = bid * 4 + w; t < NTOK; t += nblk * 4) {
    const float* xr = (MODE == 0) ? xrow_in(p, l, t) : p.x() + (size_t)t * 1024;
    float4 xv[4];
    float ss = 0.f;
#pragma unroll
    for (int j = 0; j < 4; ++j) {
      xv[j] = reinterpret_cast<const float4*>(xr)[lane + 64 * j];
      ss += xv[j].x * xv[j].x + xv[j].y * xv[j].y + xv[j].z * xv[j].z + xv[j].w * xv[j].w;
    }
    ss = wave_sum(ss);
    float r = rsqrtf(ss * (1.f / 1024.f) + EPS);
#pragma unroll
    for (int j = 0; j < 4; ++j) {
      xv[j].x *= r * gv[j].x; xv[j].y *= r * gv[j].y; xv[j].z *= r * gv[j].z; xv[j].w *= r * gv[j].w;
    }
    if (MODE == 2) {
      float* o = (t < NPROMPT) ? p.out + O_Y_P + (size_t)t * 1024 : p.out + O_Y_S + (size_t)(t - NPROMPT) * 1024;
#pragma unroll
      for (int j = 0; j < 4; ++j) reinterpret_cast<float4*>(o)[lane + 64 * j] = xv[j];
    } else {
      uint2* o = reinterpret_cast<uint2*>(p.xn() + (size_t)t * 1024);
#pragma unroll
      for (int j = 0; j < 4; ++j) o[lane + 64 * j] = make_uint2(pack2(xv[j].x, xv[j].y), pack2(xv[j].z, xv[j].w));
    }
    if (MODE == 0) {
      float pre[8];
#pragma unroll
      for (int i = 0; i < 8; ++i) {
        const float4* wr = reinterpret_cast<const float4*>(p.wg() + ((size_t)l * 8 + i) * 1024);
        float s = 0.f;
#pragma unroll
        for (int j = 0; j < 4; ++j) {
          float4 wv = wr[lane + 64 * j];
          s += xv[j].x * wv.x + xv[j].y * wv.y + xv[j].z * wv.z + xv[j].w * wv.w;
        }
        pre[i] = wave_sum(s);
      }
      if (lane < 4) {
        float a = pre[0]; a = lane == 1 ? pre[1] : a; a = lane == 2 ? pre[2] : a; a = lane == 3 ? pre[3] : a;
        float f = pre[4]; f = lane == 1 ? pre[5] : f; f = lane == 2 ? pre[6] : f; f = lane == 3 ? pre[7] : f;
        p.ig()[(size_t)t * 4 + lane] = a + p.ml_gate_b()[l * 8 + lane];
        float z = f + p.ml_gate_b()[l * 8 + 4 + lane];
        p.lf()[(size_t)t * 4 + lane] = fminf(z, 0.f) - log1pf(expf(-fabsf(z)));
      }
    }
  }
}

enum { EPI_WIN = 0, EPI_WOUT = 1, EPI_PQ = 2, EPI_SC = 3 };

template <int EPI>
__device__ __forceinline__ void gemm_store(const Params& p, int l, int t, int n, float v) {
  if (EPI == EPI_WOUT) {
    const float* xi = xrow_in(p, l, t);
    p.x()[(size_t)t * 1024 + n] = xi[n] + v;
  } else if (EPI == EPI_PQ) {
    p.qp()[(size_t)t * 2048 + n] = f2bf(v);
  } else if (EPI == EPI_SC) {
    p.sc()[(size_t)t * 2048 + n] = v;
  }
}

template <int EPI>
__device__ __forceinline__ void ph_gemm(const Params& p, int l, char* smem, int bid, int nblk) {
  constexpr int NT = (EPI == EPI_WIN) ? 22 : (EPI == EPI_WOUT ? 8 : 16);
  constexpr int MT = NTOK / 128;
  constexpr int K = (EPI == EPI_SC) ? 128 : 1024;
  constexpr int NK = K / 64;
  const bf16_t* A; int lda; const bf16_t* Bt; int ldb;
  if (EPI == EPI_WIN) { A = p.xn(); lda = 1024; Bt = p.wt_in() + (size_t)l * NIN * 1024; ldb = 1024; }
  else if (EPI == EPI_WOUT) { A = p.xn(); lda = 1024; Bt = p.wt_out() + (size_t)l * 1024 * 1024; ldb = 1024; }
  else if (EPI == EPI_PQ) { A = p.xn(); lda = 1024; Bt = p.wt_pq() + (size_t)l * 2048 * 1024; ldb = 1024; }
  else { A = p.qp(); lda = 2048; Bt = p.keysb() + (size_t)l * 16 * 128 * 128; ldb = 128; }

  const int tid = tid_opaque(), lane = tid & 63, w = tid >> 6;
  const int wm = w >> 1, wn = w & 1, lr = lane & 31, lh = lane >> 5;
  char* sA = smem;
  char* sB = smem + 32768;
  const int ld_c = tid & 7, ld_r = tid >> 3;

  const int nx = nblk >> 3;
  constexpr int FG = MT / 8, LR = MT % 8;
  for (int rnd = 0;; ++rnd) {
    const int q = (nblk & 7) ? rnd * nblk + bid : rnd * nblk + (bid & 7) * nx + (bid >> 3);
    if (q >= MT * NT) break;
    int mt, nt;
    if (q < FG * 8 * NT) { const int mg = q / (8 * NT), rem = q % (8 * NT); nt = rem >> 3; mt = mg * 8 + (rem & 7); }
    else { const int q2 = q - FG * 8 * NT; nt = q2 / (LR > 0 ? LR : 1); mt = FG * 8 + q2 % (LR > 0 ? LR : 1); }
    const bf16_t* Ag = A + (size_t)(mt * 128) * lda + ((EPI == EPI_SC) ? nt * 128 : 0);
    const bf16_t* Bg = Bt + (size_t)(nt * 128) * ldb;
    f32x16 acc[2][2];
#pragma unroll
    for (int i = 0; i < 2; ++i)
#pragma unroll
      for (int j = 0; j < 2; ++j)
#pragma unroll
        for (int r = 0; r < 16; ++r) acc[i][j][r] = 0.f;

    const int g_row = w * 32 + (lane >> 3);
    const int g_pc = lane & 7;
    const bf16_t* Ath = Ag + (size_t)g_row * lda;
    const bf16_t* Bth = Bg + (size_t)g_row * ldb;
#define GEMM_STAGE(KT, BUF)                                                                                          \
  _Pragma("unroll") for (int j = 0; j < 4; ++j) {                                                                    \
    const int row = g_row + 8 * j;                                                                                   \
    const int cch = g_pc ^ ((row >> 1) & 7);                                                                         \
    __builtin_amdgcn_global_load_lds((const unsigned*)(Ath + (size_t)(8 * j) * lda + (KT) * 64 + cch * 8),           \
                                     (LAS unsigned*)(sA + (BUF) * 16384 + (w * 4 + j) * 1024 + lane * 16), 16, 0, 0); \
    __builtin_amdgcn_global_load_lds((const unsigned*)(Bth + (size_t)(8 * j) * ldb + (KT) * 64 + cch * 8),           \
                                     (LAS unsigned*)(sB + (BUF) * 16384 + (w * 4 + j) * 1024 + lane * 16), 16, 0, 0); \
  }
    GEMM_STAGE(0, 0)
    __syncthreads();
    for (int kt = 0; kt < NK; ++kt) {
      const int buf = kt & 1;
      if (kt + 1 < NK) { GEMM_STAGE(kt + 1, buf ^ 1) }
      const char* cA = sA + buf * 16384;
      const char* cB = sB + buf * 16384;
#pragma unroll
      for (int ks = 0; ks < 4; ++ks) {
        bf16x8 af[2], bfr[2];
#pragma unroll
        for (int i = 0; i < 2; ++i) {
          int row = wm * 64 + i * 32 + lr; int pc = (ks * 2 + lh) ^ ((row >> 1) & 7);
          af[i] = as_bf16x8(*reinterpret_cast<const uint4*>(cA + row * 128 + pc * 16));
        }
#pragma unroll
        for (int j = 0; j < 2; ++j) {
          int row = wn * 64 + j * 32 + lr; int pc = (ks * 2 + lh) ^ ((row >> 1) & 7);
          bfr[j] = as_bf16x8(*reinterpret_cast<const uint4*>(cB + row * 128 + pc * 16));
        }
#pragma unroll
        for (int i = 0; i < 2; ++i)
#pragma unroll
          for (int j = 0; j < 2; ++j)
            acc[i][j] = __builtin_amdgcn_mfma_f32_32x32x16_bf16(af[i], bfr[j], acc[i][j], 0, 0, 0);
      }
      __syncthreads();
    }
    if (EPI != EPI_WIN) {
#pragma unroll
      for (int i = 0; i < 2; ++i)
#pragma unroll
        for (int j = 0; j < 2; ++j)
#pragma unroll
          for (int r = 0; r < 16; ++r) {
            int t = mt * 128 + wm * 64 + i * 32 + (r & 3) + 8 * (r >> 2) + 4 * lh;
            int n = nt * 128 + wn * 64 + j * 32 + lr;
            gemm_store<EPI>(p, l, t, n, acc[i][j][r]);
          }
    } else {
      const int seg = nt >> 2;
#pragma unroll
      for (int i = 0; i < 2; ++i)
#pragma unroll
        for (int j = 0; j < 2; ++j) {
          const int n = nt * 128 + wn * 64 + j * 32 + lr;
          if (nt < 4) {
#pragma unroll
            for (int r = 0; r < 16; ++r) {
              int t = mt * 128 + wm * 64 + i * 32 + (r & 3) + 8 * (r >> 2) + 4 * lh;
              p.Qb()[(size_t)t * 512 + n] = f2bf(acc[i][j][r] * (0.125f * LOG2E));
            }
          } else if (nt < 8) {
            const int n2 = n - 512;
#pragma unroll
            for (int r = 0; r < 16; ++r) {
              int t = mt * 128 + wm * 64 + i * 32 + (r & 3) + 8 * (r >> 2) + 4 * lh;
              float v = acc[i][j][r];
              if (t < NPROMPT) {
                p.out[O_K_P + (size_t)l * (4 * 4096 * 512) + (size_t)t * 512 + n2] = v;
                p.Kb()[(size_t)t * 512 + n2] = f2bf(v);
              } else {
                int ts = t - NPROMPT, b = ts >> 6, ii = ts & 63;
                p.out[O_K_S + (size_t)l * (8 * 64 * 512) + (size_t)ts * 512 + n2] = v;
                p.Kbs()[((size_t)(l * 8 + b) * SKEYS + 1024 + ii) * 512 + n2] = f2bf(v);
              }
            }
          } else if (nt < 12) {
            const int n2 = n - 1024, h = n2 >> 7, dv = n2 & 127;
#pragma unroll
            for (int rg = 0; rg < 4; ++rg) {
              int tb = mt * 128 + wm * 64 + i * 32 + 8 * rg + 4 * lh;
              float v0 = acc[i][j][rg * 4 + 0], v1 = acc[i][j][rg * 4 + 1], v2 = acc[i][j][rg * 4 + 2], v3 = acc[i][j][rg * 4 + 3];
              uint2 pk = make_uint2(pack2(v0, v1), pack2(v2, v3));
              int posblk = 2 * lh + (rg & 1);
              if (tb < NPROMPT) {
                float* o = p.out + O_V_P + (size_t)l * (4 * 4096 * 512) + (size_t)tb * 512 + n2;
                o[0] = v0; o[512] = v1; o[1024] = v2; o[1536] = v3;
                int b = tb >> 12, s = tb & 4095;
                int pos = (s & ~15) + posblk * 4;
                *reinterpret_cast<uint2*>(p.Vt() + ((size_t)(b * 4 + h) * 128 + dv) * SEQ + pos) = pk;
              } else {
                int ts = tb - NPROMPT, b = ts >> 6, ii = ts & 63;
                float* o = p.out + O_V_S + (size_t)l * (8 * 64 * 512) + (size_t)ts * 512 + n2;
                o[0] = v0; o[512] = v1; o[1024] = v2; o[1536] = v3;
                int pos = 1024 + (ii & ~15) + posblk * 4;
                *reinterpret_cast<uint2*>(p.Vts() + ((size_t)((l * 8 + b) * 4 + h) * 128 + dv) * SKEYS + pos) = pk;
              }
            }
          } else {
            const int n2 = n - 1536;
            const bool act = (n >= 2304);
#pragma unroll
            for (int r = 0; r < 16; ++r) {
              int t = mt * 128 + wm * 64 + i * 32 + (r & 3) + 8 * (r >> 2) + 4 * lh;
              float v = acc[i][j][r];
              if (act) v = gelu_exact(v);
              p.P5()[(size_t)t * 1280 + n2] = v;
            }
          }
        }
      (void)seg;
    }
  }
}

__device__ __forceinline__ void ph_attn(const Params& p, int l, char* smem, int bid, int nblk) {
  const int tid = tid_opaque(), lane = tid & 63, w = tid >> 6;
  const int c = w >> 1, qhalf = w & 1, lr = lane & 31, lh = lane >> 5;
  float* sLut = reinterpret_cast<float*>(smem + 65536);
  float* sO2 = reinterpret_cast<float*>(smem);
  const float lam = p.lam()[l];
  const float lam_init = 0.8f - 0.6f * expf(-0.3f * (float)l);

  for (int uu = bid; uu < 1056; uu += nblk) {
    int b, h, qc, S, qrow0; const bf16_t *Kbase, *Vbase;
    bool samp = false; int u2 = uu;
    if (uu >= 752 && uu < 784) samp = true; else if (uu >= 784) u2 = uu - 32;
    if (!samp) {
      qc = 63 - (u2 >> 4); int bh = u2 & 15; b = bh >> 2; h = bh & 3; S = SEQ;
      Kbase = p.Kb() + (size_t)b * SEQ * 512 + h * 128;
      Vbase = p.Vt() + (size_t)(b * 4 + h) * 128 * SEQ;
      qrow0 = b * SEQ + qc * 64;
    } else {
      int us = uu - 752; b = us >> 2; h = us & 3; qc = 16; S = SKEYS;
      Kbase = p.Kbs() + (size_t)(l * 8 + b) * SKEYS * 512 + h * 128;
      Vbase = p.Vts() + (size_t)((l * 8 + b) * 4 + h) * 128 * SKEYS;
      qrow0 = NPROMPT + b * 64;
    }
    const int ntiles = qc + 1;
    __syncthreads();
    sLut[tid] = p.lut()[h * 256 + tid];
    if (tid < 128) sLut[256 + tid] = p.da_subln_g()[l * 128 + tid];
    bf16x8 qf[4];
    {
      const bf16_t* qrow = p.Qb() + (size_t)(qrow0 + qhalf * 32 + lr) * 512 + h * 128 + c * 64 + lh * 8;
#pragma unroll
      for (int ks = 0; ks < 4; ++ks) qf[ks] = as_bf16x8(*reinterpret_cast<const uint4*>(qrow + ks * 16));
    }
    f32x16 o[4];
#pragma unroll
    for (int d = 0; d < 4; ++d)
#pragma unroll
      for (int r = 0; r < 16; ++r) o[d][r] = 0.f;
    float m_run = -1e30f, l_run = 0.f;
    const float c15 = p.lut()[h * 256];

    const char* Kt = reinterpret_cast<const char*>(Kbase);
    const char* Vb = reinterpret_cast<const char*>(Vbase);
    const int g_r8 = lane >> 3, g_pc = lane & 7;
#define ATTN_STAGE(KT, BUF)                                                                                         \
  _Pragma("unroll") for (int j = 0; j < 4; ++j) {                                                                   \
    const int I = w * 4 + j;                                                                                        \
    const int rk = (I & 7) * 8 + g_r8;                                                                              \
    const unsigned kof = (unsigned)rk * 1024u + (unsigned)(I >> 3) * 128u + (unsigned)((g_pc ^ ((rk >> 1) & 7)) * 16); \
    __builtin_amdgcn_global_load_lds((const unsigned*)(Kt + (size_t)(KT) * 65536 + kof),                            \
                                     (LAS unsigned*)(smem + (BUF) * 32768 + I * 1024 + lane * 16), 16, 0, 0);       \
    const int rv = I * 8 + g_r8;                                                                                    \
    const unsigned vof = (unsigned)rv * (unsigned)(S * 2) + (unsigned)((g_pc ^ ((rv >> 1) & 7)) * 16);              \
    __builtin_amdgcn_global_load_lds((const unsigned*)(Vb + (size_t)(KT) * 128 + vof),                              \
                                     (LAS unsigned*)(smem + (BUF) * 32768 + 16384 + I * 1024 + lane * 16), 16, 0, 0); \
  }
    ATTN_STAGE(0, 0)
    __syncthreads();
    for (int kt = 0; kt < ntiles; ++kt) {
      const int buf = kt & 1;
      if (kt + 1 < ntiles) { ATTN_STAGE(kt + 1, buf ^ 1) }
      const char* sK = smem + buf * 32768;
      const char* sV = sK + 16384;
      f32x16 s[2];
      {
        bf16x8 kf[2][4];
#pragma unroll
        for (int kb = 0; kb < 2; ++kb)
#pragma unroll
          for (int ks = 0; ks < 4; ++ks) {
            int row = kb * 32 + lr; int pc = (ks * 2 + lh) ^ ((row >> 1) & 7);
            kf[kb][ks] = as_bf16x8(*reinterpret_cast<const uint4*>(sK + c * 8192 + row * 128 + pc * 16));
          }
        __builtin_amdgcn_sched_barrier(0);
#pragma unroll
        for (int kb = 0; kb < 2; ++kb) {
#pragma unroll
          for (int r = 0; r < 16; ++r) s[kb][r] = 0.f;
#pragma unroll
          for (int ks = 0; ks < 4; ++ks) s[kb] = __builtin_amdgcn_mfma_f32_32x32x16_bf16(kf[kb][ks], qf[ks], s[kb], 0, 0, 0);
        }
      }
      bf16x8 vfa[2][4];
#pragma unroll
      for (int k2 = 0; k2 < 2; ++k2)
#pragma unroll
        for (int d = 0; d < 4; ++d) {
          int row = d * 32 + lr; int pc = (k2 * 2 + lh) ^ ((row >> 1) & 7);
          vfa[k2][d] = as_bf16x8(*reinterpret_cast<const uint4*>(sV + row * 128 + pc * 16));
        }
      __builtin_amdgcn_sched_barrier(0);
      float boff = c15;
      if (kt >= qc - 2) {
        const int base = (kt - qc) * 64 - (qhalf * 32 + lr) + 191 + 4 * lh;
#pragma unroll
        for (int kb = 0; kb < 2; ++kb)
#pragma unroll
          for (int r = 0; r < 16; ++r) s[kb][r] += sLut[base + kb * 32 + (r & 3) + 8 * (r >> 2)];
        boff = 0.f;
      }
      float mx = s[0][0];
#pragma unroll
      for (int kb = 0; kb < 2; ++kb)
#pragma unroll
        for (int r = 0; r < 16; ++r) mx = fmaxf(mx, s[kb][r]);
      mx = swap32_max(mx) + boff;
      if (__any(mx > m_run)) {
        const float m_new = fmaxf(m_run, mx);
        const float alpha = __builtin_amdgcn_exp2f(m_run - m_new);
        m_run = m_new;
        l_run *= alpha;
#pragma unroll
        for (int d = 0; d < 4; ++d)
#pragma unroll
          for (int r = 0; r < 16; ++r) o[d][r] *= alpha;
      }
      const float eoff = boff - m_run;
      float ps = 0.f;
#pragma unroll
      for (int kb = 0; kb < 2; ++kb)
#pragma unroll
        for (int r = 0; r < 16; ++r) { float pv = __builtin_amdgcn_exp2f(s[kb][r] + eoff); s[kb][r] = pv; ps += pv; }
      l_run += ps;
      bf16x8 pf[4];
#pragma unroll
      for (int ks2 = 0; ks2 < 4; ++ks2) {
        const int kb = ks2 >> 1, sh = (ks2 & 1) * 8;
        uint4 pw = make_uint4(pack2(s[kb][sh + 0], s[kb][sh + 1]), pack2(s[kb][sh + 2], s[kb][sh + 3]),
                              pack2(s[kb][sh + 4], s[kb][sh + 5]), pack2(s[kb][sh + 6], s[kb][sh + 7]));
        pf[ks2] = as_bf16x8(pw);
      }
      __builtin_amdgcn_sched_barrier(0);
#define ATTN_VREAD(DST, K2)                                                                        \
  _Pragma("unroll") for (int d = 0; d < 4; ++d) {                                                  \
    int row = d * 32 + lr; int pc = ((K2) * 2 + lh) ^ ((row >> 1) & 7);                            \
    DST[d] = as_bf16x8(*reinterpret_cast<const uint4*>(sV + row * 128 + pc * 16));                 \
  }
#define ATTN_PV(SRC, K2) \
  _Pragma("unroll") for (int d = 0; d < 4; ++d) o[d] = __builtin_amdgcn_mfma_f32_32x32x16_bf16(SRC[d], pf[K2], o[d], 0, 0, 0);
      bf16x8 vfc[4];
      ATTN_VREAD(vfc, 2)
      ATTN_PV(vfa[0], 0)
      __builtin_amdgcn_sched_barrier(0);
      ATTN_VREAD(vfa[0], 3)
      ATTN_PV(vfa[1], 1)
      __builtin_amdgcn_sched_barrier(0);
      ATTN_PV(vfc, 2)
      ATTN_PV(vfa[0], 3)
      __syncthreads();
    }
    int lane_e = lane; asm volatile("" : "+v"(lane_e));
    const int lr_e = lane_e & 31, lh_e = lane_e >> 5;
    float lt = swap32_sum(l_run);
    float inv = 1.f / lt;
    __syncthreads();
    if (c == 1) {
#pragma unroll
      for (int d = 0; d < 4; ++d)
#pragma unroll
        for (int r = 0; r < 16; ++r) sO2[(qhalf * 64 + d * 16 + r) * 64 + lane_e] = o[d][r] * inv;
    }
    __syncthreads();
    if (c == 0) {
      float ss = 0.f;
#pragma unroll
      for (int d = 0; d < 4; ++d)
#pragma unroll
        for (int r = 0; r < 16; ++r) {
          float v = o[d][r] * inv - lam * sO2[(qhalf * 64 + d * 16 + r) * 64 + lane_e];
          o[d][r] = v; ss += v * v;
        }
      ss = swap32_sum(ss);
      const float rn = rsqrtf(ss * (1.f / 128.f) + EPS) * (1.f - lam_init);
      const float* gs = sLut + 256;
      bf16_t* orow = p.xn() + (size_t)(qrow0 + qhalf * 32 + lr_e) * 1024 + h * 128;
#pragma unroll
      for (int d = 0; d < 4; ++d)
#pragma unroll
        for (int rg = 0; rg < 4; ++rg) {
          int dv = d * 32 + 8 * rg + 4 * lh_e;
          float4 g4 = *reinterpret_cast<const float4*>(gs + dv);
          uint2 pk = make_uint2(pack2(o[d][rg * 4 + 0] * rn * g4.x, o[d][rg * 4 + 1] * rn * g4.y),
                                pack2(o[d][rg * 4 + 2] * rn * g4.z, o[d][rg * 4 + 3] * rn * g4.w));
          *reinterpret_cast<uint2*>(orow + dv) = pk;
        }
    }
  }
}


template <int K>
__device__ __forceinline__ void mfma32_f32(f32x16& acc, const float* a, int a_rs, int a_ks, const float* b, int b_ks, int b_js, int lane) {
  const float* ap = a + (lane & 31) * a_rs + (lane >> 5) * a_ks;
  const float* bp = b + (lane >> 5) * b_ks + (lane & 31) * b_js;
#pragma unroll 8
  for (int k = 0; k < K; k += 2) acc = __builtin_amdgcn_mfma_f32_32x32x2f32(ap[k * a_ks], bp[k * b_ks], acc, 0, 0, 0);
}
__device__ __forceinline__ void zero16(f32x16& a) {
#pragma unroll
  for (int r = 0; r < 16; ++r) a[r] = 0.f;
}

__device__ __forceinline__ void ph_mlconv(const Params& p, int l, char* smem, int bid, int nblk) {
  const int tid = tid_opaque();
  float* s_mc = reinterpret_cast<float*>(smem);
  float* s_cc = s_mc + 67 * 64;
  float* s_wq = s_cc + 64 * 65;
  float* s_wk = s_wq + 4096;
  for (int u = bid; u < 264 * 4; u += nblk) {
    const int ci = u >> 2, h = u & 3;
    int token0, bq; bool samp = ci >= 256;
    if (!samp) token0 = ci * 64; else token0 = NPROMPT + (ci - 256) * 64;
    bq = samp ? (ci - 256) : (ci >> 6);
    const int cidx = samp ? 0 : (ci & 63);
    __syncthreads();
    for (int i = tid; i < 67 * 64; i += 256) {
      int r = i >> 6, d = i & 63;
      float v;
      if (r >= 3) v = p.P5()[(size_t)(token0 + r - 3) * 1280 + h * 64 + d];
      else if (samp) v = p.st_conv()[((size_t)(l * 8 + bq) * 3 + r) * 256 + h * 64 + d];
      else if (cidx == 0) v = 0.f;
      else v = p.P5()[(size_t)(token0 + r - 3) * 1280 + h * 64 + d];
      s_mc[i] = v;
    }
    for (int i = tid; i < 4096; i += 256) {
      s_wq[i] = p.ml_wq()[(size_t)(l * 4 + h) * 4096 + i];
      s_wk[i] = p.ml_wk()[(size_t)(l * 4 + h) * 4096 + i];
    }
    __syncthreads();
    {
      const int d = tid & 63, t0 = tid >> 6;
      const int ch = h * 64 + d;
      const float w0 = p.ml_conv_w()[(l * 4 + 0) * 256 + ch], w1 = p.ml_conv_w()[(l * 4 + 1) * 256 + ch];
      const float w2 = p.ml_conv_w()[(l * 4 + 2) * 256 + ch], w3 = p.ml_conv_w()[(l * 4 + 3) * 256 + ch];
      const float bb = p.ml_conv_b()[l * 256 + ch];
      for (int t = t0; t < 64; t += 4) {
        float y = bb + w0 * s_mc[t * 64 + d] + w1 * s_mc[(t + 1) * 64 + d] + w2 * s_mc[(t + 2) * 64 + d] + w3 * s_mc[(t + 3) * 64 + d];
        y = y * sigmoidf_(y);
        s_cc[t * 65 + d] = y;
        p.cc()[(size_t)(token0 + t) * 256 + ch] = y;
      }
      if (samp || cidx == 63) {
        if (tid < 192) {
          int r = tid >> 6;
          float v = s_mc[(64 + r) * 64 + d];
          if (samp) p.out[O_CONV_S + ((size_t)(l * 8 + bq) * 3 + r) * 256 + ch] = v;
          else p.out[O_CONV_P + ((size_t)(l * 4 + bq) * 3 + r) * 256 + ch] = v;
        }
      }
    }
    __syncthreads();
    {
      const int lane = tid & 63, w = tid >> 6, ti = w >> 1, tj = w & 1;
      f32x16 aq, ak; zero16(aq); zero16(ak);
      mfma32_f32<64>(aq, s_cc + ti * 32 * 65, 65, 1, s_wq + tj * 32, 64, 1, lane);
      mfma32_f32<64>(ak, s_cc + ti * 32 * 65, 65, 1, s_wk + tj * 32, 64, 1, lane);
#pragma unroll
      for (int r = 0; r < 16; ++r) {
        const int t = ti * 32 + (r & 3) + 8 * (r >> 2) + 4 * (lane >> 5);
        const size_t o = (size_t)(token0 + t) * 256 + h * 64 + tj * 32 + (lane & 31);
        p.qm()[o] = aq[r];
        p.km()[o] = ak[r] * 0.125f;
      }
      if (w == 0) {
        const int t = token0 + lane;
        const float lfv = p.lf()[(size_t)t * 4 + h], igv = p.ig()[(size_t)t * 4 + h];
        float F = lfv;
#pragma unroll
        for (int d = 1; d < 64; d <<= 1) { float n = __shfl_up(F, d); if (lane >= d) F += n; }
        const float FL = __shfl(F, 63);
        const float mx = wave_max(FL - F + igv);
        p.Fc()[(size_t)t * 4 + h] = F;
        if (lane == 0) {
          const int cu = samp ? 1024 + bq * 4 + h : (bq * 4 + h) * 64 + cidx;
          p.FLs()[cu] = FL; p.mxt()[cu] = mx;
        }
      }
    }
  }
}

__device__ __forceinline__ void cu_decode(int cu, int& token0, int& h) {
  if (cu < 1024) { int bh = cu >> 6, c = cu & 63; token0 = (bh >> 2) * SEQ + c * 64; h = bh & 3; }
  else { int us = cu - 1024; token0 = NPROMPT + (us >> 2) * 64; h = us & 3; }
}

__device__ __forceinline__ void ph_mlU(const Params& p, int l, char* smem, int bid, int nblk) {
  const int tid = tid_opaque();
  const int lane = tid & 63, w = tid >> 6, ti = w >> 1, tj = w & 1;
  float* s_k = reinterpret_cast<float*>(smem);
  float* s_v = s_k + 4096;
  for (int cu = bid; cu < NCU_UNITS; cu += nblk) {
    int token0, h; cu_decode(cu, token0, h);
    float m0, mn, FL;
    {
      const bool samp = cu >= 1024;
      const int cu0 = samp ? cu : (cu & ~63), c = samp ? 0 : (cu & 63);
      float flv = 0.f, mxv = 0.f;
      if (lane <= c) { flv = p.FLs()[cu0 + lane]; mxv = p.mxt()[cu0 + lane]; }
      float m = samp ? p.st_m()[l * 32 + (cu - 1024)] : 0.f;
      for (int j = 0; j < c; ++j) {
        const float fj = __int_as_float(__builtin_amdgcn_readlane(__float_as_int(flv), j));
        const float xj = __int_as_float(__builtin_amdgcn_readlane(__float_as_int(mxv), j));
        m = fmaxf(fj + m, xj);
      }
      FL = __int_as_float(__builtin_amdgcn_readlane(__float_as_int(flv), c));
      const float xc = __int_as_float(__builtin_amdgcn_readlane(__float_as_int(mxv), c));
      m0 = m; mn = fmaxf(FL + m, xc);
      if (tid == 0) {
        p.mst()[cu] = m0; p.mnx()[cu] = mn; p.wcs()[cu] = expf(FL + m0 - mn);
        if (samp) p.out[O_M_S + l * 32 + (cu - 1024)] = mn;
        else if (c == 63) p.out[O_M_P + l * 16 + (cu >> 6)] = mn;
      }
    }
    __syncthreads();
    for (int i = tid; i < 1024; i += 256) {
      int s = i >> 4, d4 = (i & 15) * 4;
      const int t = token0 + s;
      float wsv = expf(FL - p.Fc()[(size_t)t * 4 + h] + p.ig()[(size_t)t * 4 + h] - mn);
      float4 k4 = *reinterpret_cast<const float4*>(p.km() + (size_t)t * 256 + h * 64 + d4);
      float4 v4 = *reinterpret_cast<const float4*>(p.P5() + (size_t)t * 1280 + 256 + h * 64 + d4);
      *reinterpret_cast<float4*>(s_k + s * 64 + d4) = make_float4(k4.x * wsv, k4.y * wsv, k4.z * wsv, k4.w * wsv);
      *reinterpret_cast<float4*>(s_v + s * 64 + d4) = v4;
    }
    __syncthreads();
    f32x16 acc; zero16(acc);
    mfma32_f32<64>(acc, s_k + ti * 32, 1, 64, s_v + tj * 32, 64, 1, lane);
#pragma unroll
    for (int r = 0; r < 16; ++r) {
      const int d = ti * 32 + (r & 3) + 8 * (r >> 2) + 4 * (lane >> 5);
      p.U()[(size_t)cu * 4096 + d * 64 + tj * 32 + (lane & 31)] = acc[r];
    }
    if (tid < 64) {
      float s0 = 0.f;
      for (int s = 0; s < 64; ++s) s0 += s_k[s * 64 + tid];
      p.un()[(size_t)cu * 64 + tid] = s0;
    }
  }
}

__device__ __forceinline__ void ph_mlscan(const Params& p, int l, int bid, int nblk) {
  const size_t gtid = (size_t)bid * 256 + tid_opaque(), gsz = (size_t)nblk * 256;
  const size_t NPC = 16 * 4096, NSC = 32 * 4096, NPN = 16 * 64, NSN = 32 * 64;
  for (size_t i = gtid; i < NPC + NSC + NPN + NSN; i += gsz) {
    if (i < NPC) {
      int bh = (int)(i >> 12), e = (int)(i & 4095);
      float C = 0.f;
      for (int c = 0; c < 64; ++c) {
        int cu = bh * 64 + c;
        p.Cst()[(size_t)cu * 4096 + e] = C;
        C = p.wcs()[cu] * C + p.U()[(size_t)cu * 4096 + e];
      }
      p.out[O_C_P + (size_t)l * (16 * 4096) + i] = C;
    } else if (i < NPC + NSC) {
      size_t j = i - NPC; int us = (int)(j >> 12), e = (int)(j & 4095); int cu = 1024 + us;
      float C = p.st_c()[(size_t)l * (32 * 4096) + j];
      p.Cst()[(size_t)cu * 4096 + e] = C;
      p.out[O_C_S + (size_t)l * (32 * 4096) + j] = p.wcs()[cu] * C + p.U()[(size_t)cu * 4096 + e];
    } else if (i < NPC + NSC + NPN) {
      size_t j = i - NPC - NSC; int bh = (int)(j >> 6), d = (int)(j & 63);
      float n = 0.f;
      for (int c = 0; c < 64; ++c) {
        int cu = bh * 64 + c;
        p.nst()[(size_t)cu * 64 + d] = n;
        n = p.wcs()[cu] * n + p.un()[(size_t)cu * 64 + d];
      }
      p.out[O_N_P + (size_t)l * (16 * 64) + j] = n;
    } else {
      size_t j = i - NPC - NSC - NPN; int us = (int)(j >> 6), d = (int)(j & 63); int cu = 1024 + us;
      float n = p.st_n()[(size_t)l * (32 * 64) + j];
      p.nst()[(size_t)cu * 64 + d] = n;
      p.out[O_N_S + (size_t)l * (32 * 64) + j] = p.wcs()[cu] * n + p.un()[(size_t)cu * 64 + d];
    }
  }
}

__device__ __forceinline__ void ph_mlout(const Params& p, int l, char* smem, int bid, int nblk) {
  const int tid = tid_opaque();
  float* s_q = reinterpret_cast<float*>(smem);
  float* s_k = s_q + 64 * 65;
  float* s_v = s_k + 64 * 65;
  float* s_C = s_v + 4096;
  float* s_F = s_C + 4096;
  float* s_a = s_F + 64;
  float* s_mt = s_a + 64;
  float* s_iw = s_mt + 64;
  float* s_n = s_iw + 64;
  float* s_den = s_n + 64;
  for (int cu = bid; cu < NCU_UNITS; cu += nblk) {
    int token0, h; cu_decode(cu, token0, h);
    const float m0 = p.mst()[cu];
    __syncthreads();
    for (int i = tid; i < 1024; i += 256) {
      int s = i >> 4, d4 = (i & 15) * 4;
      const int t = token0 + s;
      float4 q4 = *reinterpret_cast<const float4*>(p.qm() + (size_t)t * 256 + h * 64 + d4);
      float4 k4 = *reinterpret_cast<const float4*>(p.km() + (size_t)t * 256 + h * 64 + d4);
      float4 v4 = *reinterpret_cast<const float4*>(p.P5() + (size_t)t * 1280 + 256 + h * 64 + d4);
      float4 c4 = *reinterpret_cast<const float4*>(p.Cst() + (size_t)cu * 4096 + s * 64 + d4);
      s_q[s * 65 + d4] = q4.x; s_q[s * 65 + d4 + 1] = q4.y; s_q[s * 65 + d4 + 2] = q4.z; s_q[s * 65 + d4 + 3] = q4.w;
      s_k[s * 65 + d4] = k4.x; s_k[s * 65 + d4 + 1] = k4.y; s_k[s * 65 + d4 + 2] = k4.z; s_k[s * 65 + d4 + 3] = k4.w;
      *reinterpret_cast<float4*>(s_v + s * 64 + d4) = v4;
      *reinterpret_cast<float4*>(s_C + s * 64 + d4) = c4;
    }
    if (tid < 64) {
      const int t = token0 + tid;
      float F = p.Fc()[(size_t)t * 4 + h], g = p.ig()[(size_t)t * 4 + h];
      s_F[tid] = F; s_a[tid] = g - F;
      s_n[tid] = p.nst()[(size_t)cu * 64 + tid];
    }
    __syncthreads();
    if (tid < 64) {
      float pm = -1e30f;
      for (int s = 0; s <= tid; ++s) pm = fmaxf(pm, s_a[s]);
      float F = s_F[tid];
      float mt = F + fmaxf(m0, pm);
      s_mt[tid] = mt;
      s_iw[tid] = expf(F + m0 - mt);
    }
    __syncthreads();
    const int lane = tid & 63, w = tid >> 6, ti = w >> 1, tj = w & 1;
    const int ty = tid >> 4, tx = tid & 15;
    {
      f32x16 accS; zero16(accS);
      mfma32_f32<64>(accS, s_q + ti * 32 * 65, 65, 1, s_k + tj * 32 * 65, 1, 65, lane);
      __syncthreads();
      const int s = tj * 32 + (lane & 31);
      const float as = s_a[s];
#pragma unroll
      for (int r = 0; r < 16; ++r) {
        const int t = ti * 32 + (r & 3) + 8 * (r >> 2) + 4 * (lane >> 5);
        s_k[t * 65 + s] = (s <= t) ? accS[r] * expf(s_F[t] + as - s_mt[t]) : 0.f;
      }
    }
    __syncthreads();
    if (tid < 64) {
      float den = 0.f, qn = 0.f;
      for (int s = 0; s < 64; ++s) { den += s_k[tid * 65 + s]; qn += s_q[tid * 65 + s] * s_n[s]; }
      s_den[tid] = den + s_iw[tid] * qn;
    }
    {
      f32x16 accN, accC; zero16(accN); zero16(accC);
      mfma32_f32<64>(accN, s_k + ti * 32 * 65, 65, 1, s_v + tj * 32, 64, 1, lane);
      mfma32_f32<64>(accC, s_q + ti * 32 * 65, 65, 1, s_C + tj * 32, 64, 1, lane);
      __syncthreads();
#pragma unroll
      for (int r = 0; r < 16; ++r) {
        const int t = ti * 32 + (r & 3) + 8 * (r >> 2) + 4 * (lane >> 5);
        s_q[t * 65 + tj * 32 + (lane & 31)] = accN[r] + s_iw[t] * accC[r];
      }
    }
    __syncthreads();
#pragma unroll
    for (int i = 0; i < 4; ++i) {
      const int t = ty * 4 + i;
      const float dn = fmaxf(fabsf(s_den[t]), expf(-s_mt[t]));
      float hv[4]; float ss = 0.f;
#pragma unroll
      for (int j = 0; j < 4; ++j) { hv[j] = s_q[t * 65 + tx * 4 + j] / dn; ss += hv[j] * hv[j]; }
      ss = row16_sum(ss);
      const float rn = rsqrtf(ss * (1.f / 64.f) + EPS);
      const int ch = h * 64 + tx * 4;
      const size_t tg = (size_t)(token0 + t);
      float4 g4 = *reinterpret_cast<const float4*>(p.ml_norm_g() + l * 256 + ch);
      float4 k4 = *reinterpret_cast<const float4*>(p.ml_skip() + l * 256 + ch);
      float4 c4 = *reinterpret_cast<const float4*>(p.cc() + tg * 256 + ch);
      float4 o4 = *reinterpret_cast<const float4*>(p.P5() + tg * 1280 + 512 + ch);
      float r0 = (hv[0] * rn * g4.x + k4.x * c4.x) * sigmoidf_(o4.x);
      float r1 = (hv[1] * rn * g4.y + k4.y * c4.y) * sigmoidf_(o4.y);
      float r2 = (hv[2] * rn * g4.z + k4.z * c4.z) * sigmoidf_(o4.z);
      float r3 = (hv[3] * rn * g4.w + k4.w * c4.w) * sigmoidf_(o4.w);
      *reinterpret_cast<uint2*>(p.xn() + tg * 1024 + 512 + ch) = make_uint2(pack2(r0, r1), pack2(r2, r3));
    }
  }
}

__device__ __forceinline__ void ph_cmlp(const Params& p, int l, char* smem, int bid, int nblk) {
  const int tid = tid_opaque(), lane = tid & 63, w = tid >> 6;
  float* s_vg = reinterpret_cast<float*>(smem);
  float* s_ws = s_vg + 128 * 64;
  float* s_r = s_ws + 128 * 33;
  for (int u = bid; u < 544; u += nblk) {
    const int g = u & 3, ci = u >> 2;
    const bool samp = ci >= 128;
    const int L = samp ? 64 : 128;
    const int token0 = samp ? NPROMPT + (ci - 128) * 64 : ci * 128;
    __syncthreads();
    for (int r = w; r < L; r += 4) {
      float4 v = *reinterpret_cast<const float4*>(p.P5() + (size_t)(token0 + r) * 1280 + 1024 + lane * 4);
      float ss = v.x * v.x + v.y * v.y + v.z * v.z + v.w * v.w;
      ss = wave_sum(ss);
      if (lane == 0) s_r[r] = rsqrtf(ss * (1.f / 256.f) + EPS);
    }
    __syncthreads();
    for (int i = tid; i < L * 16; i += 256) {
      int s = i >> 4, d4 = (i & 15) * 4;
      float4 v = *reinterpret_cast<const float4*>(p.P5() + (size_t)(token0 + s) * 1280 + 1024 + g * 64 + d4);
      float4 gn = *reinterpret_cast<const float4*>(p.cm_norm_g() + l * 256 + g * 64 + d4);
      float r = s_r[s];
      float4 o = make_float4(v.x * r * gn.x, v.y * r * gn.y, v.z * r * gn.z, v.w * r * gn.w);
      *reinterpret_cast<float4*>(s_vg + s * 64 + d4) = o;
      if (samp) {
        int ts = token0 - NPROMPT + s;
        *reinterpret_cast<float4*>(p.out + O_CMV_S + (size_t)l * (512 * 256) + (size_t)ts * 256 + g * 64 + d4) = o;
      }
    }
    const int rtA = (w < 2) ? 3 : 2, rtB = (w < 2) ? 0 : 1, ct = w & 1;
    const int nrt = L >> 5;
    f32x16 accA, accB; zero16(accA); zero16(accB);
    const float* wsg = p.cm_ws() + (size_t)(l * 4 + g) * 128 * 128;
    for (int s0 = 0; s0 < L; s0 += 32) {
      __syncthreads();
      for (int i = tid; i < L * 32; i += 256) {
        int t = i >> 5, ss = i & 31;
        s_ws[t * 33 + ss] = (s0 + ss <= t) ? wsg[t * 128 + s0 + ss] : 0.f;
      }
      __syncthreads();
      const int c = s0 >> 5;
      if (rtA < nrt && c <= rtA) mfma32_f32<32>(accA, s_ws + rtA * 32 * 33, 33, 1, s_vg + s0 * 64 + ct * 32, 64, 1, lane);
      if (rtB < nrt && c <= rtB) mfma32_f32<32>(accB, s_ws + rtB * 32 * 33, 33, 1, s_vg + s0 * 64 + ct * 32, 64, 1, lane);
    }
    __syncthreads();
#pragma unroll
    for (int r = 0; r < 16; ++r) {
      const int tr = (r & 3) + 8 * (r >> 2) + 4 * (lane >> 5);
      if (rtA < nrt) s_vg[(rtA * 32 + tr) * 64 + ct * 32 + (lane & 31)] = accA[r];
      if (rtB < nrt) s_vg[(rtB * 32 + tr) * 64 + ct * 32 + (lane & 31)] = accB[r];
    }
    __syncthreads();
    {
      const int ty = tid >> 4, tx = tid & 15;
      if (ty * 8 < L) {
#pragma unroll
        for (int i = 0; i < 8; ++i) {
          const int t = ty * 8 + i;
          const float bb = p.cm_b()[(l * 4 + g) * 128 + t];
          const size_t tg = (size_t)(token0 + t);
          float4 a4 = *reinterpret_cast<const float4*>(s_vg + t * 64 + tx * 4);
          float4 u4 = *reinterpret_cast<const float4*>(p.P5() + tg * 1280 + 768 + g * 64 + tx * 4);
          *reinterpret_cast<uint2*>(p.xn() + tg * 1024 + 768 + g * 64 + tx * 4) =
              make_uint2(pack2(u4.x * (a4.x + bb), u4.y * (a4.y + bb)), pack2(u4.z * (a4.z + bb), u4.w * (a4.w + bb)));
        }
      }
    }
  }
}

__device__ __forceinline__ int mono_key(float v) { int b = __float_as_int(v); return b ^ ((b >> 31) & 0x7FFFFFFF); }
__device__ __forceinline__ float mono_val(int k) { int b = k ^ ((k >> 31) & 0x7FFFFFFF); return __int_as_float(b); }

#define INS16(L, kv)                                   \
  {                                                    \
    int _v = (kv);                                     \
    _Pragma("unroll") for (int _j = 0; _j < 16; ++_j) { \
      int _t = max(L[_j], _v);                         \
      _v = min(L[_j], _v);                             \
      L[_j] = _t;                                      \
    }                                                  \
  }

__device__ __forceinline__ void ph_topk(const Params& p, int l, char* smem, int bid, int nblk) {
  const int tid = tid_opaque(), lane = tid & 63, w = tid >> 6;
  float* s_tile = reinterpret_cast<float*>(smem) + w * (64 * 33);
  int* s_list = reinterpret_cast<int*>(smem + 4 * 64 * 33 * 4) + w * (2 * 16 * 64);
  float* s_ss = reinterpret_cast<float*>(smem + 4 * 64 * 33 * 4 + 4 * 2 * 16 * 64 * 4) + w * 64;
  for (int u = bid * 4 + w; u < 264 * 8; u += nblk * 4) {
    const int tg = u >> 3, h = u & 7;
    const int t0 = tg * 64;
#pragma unroll 2
    for (int i = 0; i < 32; ++i) {
      const int tt = 2 * i + (lane >> 5);
      uint4 qv = *reinterpret_cast<const uint4*>(p.qp() + (size_t)(t0 + tt) * 2048 + h * 256 + (lane & 31) * 8);
      float a0 = bf_lo(qv.x), a1 = bf_hi(qv.x), a2 = bf_lo(qv.y), a3 = bf_hi(qv.y);
      float a4 = bf_lo(qv.z), a5 = bf_hi(qv.z), a6 = bf_lo(qv.w), a7 = bf_hi(qv.w);
      float ss = a0 * a0 + a1 * a1 + a2 * a2 + a3 * a3 + a4 * a4 + a5 * a5 + a6 * a6 + a7 * a7;
      ss = swap16_sum(row16_sum(ss));
      if ((lane & 31) == 0) s_ss[tt] = ss;
    }
    int L1[16], L2[16];
#pragma unroll
    for (int j = 0; j < 16; ++j) { L1[j] = (int)0x80000000; L2[j] = (int)0x80000000; }
#pragma unroll
    for (int c = 0; c < 2; ++c) {
#pragma unroll 1
      for (int ps = 0; ps < 4; ++ps) {
        const float* src = p.sc() + (size_t)t0 * 2048 + h * 256 + c * 128 + ps * 32;
#pragma unroll
        for (int j = 0; j < 8; ++j) {
          int tt = (lane >> 3) + 8 * j, f4 = lane & 7;
          float4 v = *reinterpret_cast<const float4*>(src + (size_t)tt * 2048 + f4 * 4);
          float* d = s_tile + tt * 33 + f4 * 4;
          d[0] = v.x; d[1] = v.y; d[2] = v.z; d[3] = v.w;
        }
#pragma unroll 4
        for (int s = 0; s < 32; ++s) {
          float v = s_tile[lane * 33 + s];
          int key = (mono_key(v) & ~127) | (127 - (ps * 32 + s));
          if (c == 0) INS16(L1, key) else INS16(L2, key)
        }
      }
    }
#pragma unroll
    for (int j = 0; j < 16; ++j) { s_list[(0 * 16 + j) * 64 + lane] = 127 - (L1[j] & 127); s_list[(1 * 16 + j) * 64 + lane] = 127 - (L2[j] & 127); }
    float v1[16], v2[16];
#pragma unroll
    for (int j = 0; j < 16; ++j) { v1[j] = mono_val(L1[j] & ~127); v2[j] = mono_val(L2[j] & ~127); }
    int LC[16];
#pragma unroll
    for (int j = 0; j < 16; ++j) LC[j] = (int)0x80000000;
#pragma unroll
    for (int i = 0; i < 16; ++i)
#pragma unroll
      for (int j = 0; j < 16; ++j)
        if ((i + 1) * (j + 1) <= 16) {
          int key = (mono_key(v1[i] + v2[j]) & ~255) | (255 - (i * 16 + j));
          INS16(LC, key)
        }
    const float scale = rsqrtf(s_ss[lane] * (1.f / 256.f) + EPS);
    float vs[16]; float den = 0.f;
    const float top = mono_val(LC[0] & ~255);
#pragma unroll
    for (int k = 0; k < 16; ++k) { vs[k] = __expf((mono_val(LC[k] & ~255) - top) * scale); den += vs[k]; }
    const float inv = 1.f / den;
    const size_t ob = (size_t)(t0 + lane) * 128 + h * 16;
#pragma unroll
    for (int k4 = 0; k4 < 4; ++k4) {
      int ee[4]; float gg[4], su[4];
#pragma unroll
      for (int q = 0; q < 4; ++q) {
        int k = k4 * 4 + q;
        int ci = 255 - (LC[k] & 255);
        int i1 = s_list[(0 * 16 + (ci >> 4)) * 64 + lane];
        int i2 = s_list[(1 * 16 + (ci & 15)) * 64 + lane];
        ee[q] = i1 * 128 + i2;
        gg[q] = vs[k] * inv * p.vs()[l * 16384 + ee[q]];
        su[q] = p.us()[l * 16384 + ee[q]];
      }
      *reinterpret_cast<int4*>(p.eidx() + ob + k4 * 4) = make_int4(ee[0], ee[1], ee[2], ee[3]);
      *reinterpret_cast<float4*>(p.egate() + ob + k4 * 4) = make_float4(gg[0], gg[1], gg[2], gg[3]);
      *reinterpret_cast<float4*>(p.esu() + ob + k4 * 4) = make_float4(su[0], su[1], su[2], su[3]);
    }
  }
}

__device__ __forceinline__ float dot16_fp8(const float* xf, uint4 u) {
  f32x2 a0 = __builtin_amdgcn_cvt_pk_f32_fp8(u.x, false), a1 = __builtin_amdgcn_cvt_pk_f32_fp8(u.x, true);
  f32x2 a2 = __builtin_amdgcn_cvt_pk_f32_fp8(u.y, false), a3 = __builtin_amdgcn_cvt_pk_f32_fp8(u.y, true);
  f32x2 a4 = __builtin_amdgcn_cvt_pk_f32_fp8(u.z, false), a5 = __builtin_amdgcn_cvt_pk_f32_fp8(u.z, true);
  f32x2 a6 = __builtin_amdgcn_cvt_pk_f32_fp8(u.w, false), a7 = __builtin_amdgcn_cvt_pk_f32_fp8(u.w, true);
  float s0 = xf[0] * a0.x, s1 = xf[1] * a0.y;
  s0 = fmaf(xf[2], a1.x, s0); s1 = fmaf(xf[3], a1.y, s1);
  s0 = fmaf(xf[4], a2.x, s0); s1 = fmaf(xf[5], a2.y, s1);
  s0 = fmaf(xf[6], a3.x, s0); s1 = fmaf(xf[7], a3.y, s1);
  s0 = fmaf(xf[8], a4.x, s0); s1 = fmaf(xf[9], a4.y, s1);
  s0 = fmaf(xf[10], a5.x, s0); s1 = fmaf(xf[11], a5.y, s1);
  s0 = fmaf(xf[12], a6.x, s0); s1 = fmaf(xf[13], a6.y, s1);
  s0 = fmaf(xf[14], a7.x, s0); s1 = fmaf(xf[15], a7.y, s1);
  return s0 + s1;
}
__device__ __forceinline__ void axpy16_fp8(float* y, float wgt, uint4 v) {
  f32x2 a0 = __builtin_amdgcn_cvt_pk_f32_fp8(v.x, false), a1 = __builtin_amdgcn_cvt_pk_f32_fp8(v.x, true);
  f32x2 a2 = __builtin_amdgcn_cvt_pk_f32_fp8(v.y, false), a3 = __builtin_amdgcn_cvt_pk_f32_fp8(v.y, true);
  f32x2 a4 = __builtin_amdgcn_cvt_pk_f32_fp8(v.z, false), a5 = __builtin_amdgcn_cvt_pk_f32_fp8(v.z, true);
  f32x2 a6 = __builtin_amdgcn_cvt_pk_f32_fp8(v.w, false), a7 = __builtin_amdgcn_cvt_pk_f32_fp8(v.w, true);
  y[0] = fmaf(wgt, a0.x, y[0]); y[1] = fmaf(wgt, a0.y, y[1]); y[2] = fmaf(wgt, a1.x, y[2]); y[3] = fmaf(wgt, a1.y, y[3]);
  y[4] = fmaf(wgt, a2.x, y[4]); y[5] = fmaf(wgt, a2.y, y[5]); y[6] = fmaf(wgt, a3.x, y[6]); y[7] = fmaf(wgt, a3.y, y[7]);
  y[8] = fmaf(wgt, a4.x, y[8]); y[9] = fmaf(wgt, a4.y, y[9]); y[10] = fmaf(wgt, a5.x, y[10]); y[11] = fmaf(wgt, a5.y, y[11]);
  y[12] = fmaf(wgt, a6.x, y[12]); y[13] = fmaf(wgt, a6.y, y[13]); y[14] = fmaf(wgt, a7.x, y[14]); y[15] = fmaf(wgt, a7.y, y[15]);
}

template <bool DRY>
__device__ __forceinline__ void ph_gather(const Params& p, int l, int bid, int nblk) {
  const int lane = tid_opaque() & 63, w = tid_opaque() >> 6;
  const unsigned char* u8 = p.ub8() + (size_t)l * 16384 * 1024;
  const unsigned char* v8 = p.vb8() + (size_t)l * 16384 * 1024;
  const unsigned loff = (unsigned)lane * 16u;
  for (int t = bid * 4 + w; t < NTOK; t += nblk * 4) {
    float xf[16];
    {
      const uint4 xa = *reinterpret_cast<const uint4*>(p.xn() + (size_t)t * 1024 + lane * 16);
      const uint4 xb = *reinterpret_cast<const uint4*>(p.xn() + (size_t)t * 1024 + lane * 16 + 8);
      xf[0] = bf_lo(xa.x); xf[1] = bf_hi(xa.x); xf[2] = bf_lo(xa.y); xf[3] = bf_hi(xa.y);
      xf[4] = bf_lo(xa.z); xf[5] = bf_hi(xa.z); xf[6] = bf_lo(xa.w); xf[7] = bf_hi(xa.w);
      xf[8] = bf_lo(xb.x); xf[9] = bf_hi(xb.x); xf[10] = bf_lo(xb.y); xf[11] = bf_hi(xb.y);
      xf[12] = bf_lo(xb.z); xf[13] = bf_hi(xb.z); xf[14] = bf_lo(xb.w); xf[15] = bf_hi(xb.w);
    }
    const int e_lo = p.eidx()[(size_t)t * 128 + lane], e_hi = p.eidx()[(size_t)t * 128 + 64 + lane];
    const float g_lo = p.egate()[(size_t)t * 128 + lane], g_hi = p.egate()[(size_t)t * 128 + 64 + lane];
    const float s_lo = p.esu()[(size_t)t * 128 + lane], s_hi = p.esu()[(size_t)t * 128 + 64 + lane];
    float y[16];
#pragma unroll
    for (int i = 0; i < 16; ++i) y[i] = 0.f;
#pragma unroll 1
    for (int k0 = 0; k0 < 128; k0 += 8) {
      uint4 ur[8], vr[8];
#pragma unroll
      for (int q = 0; q < 8; ++q) {
        const int kk = (k0 & 63) + q;
        const int e = (k0 < 64) ? __builtin_amdgcn_readlane(e_lo, kk) : __builtin_amdgcn_readlane(e_hi, kk);
        ur[q] = *reinterpret_cast<const uint4*>(u8 + (size_t)e * 1024 + loff);
        vr[q] = *reinterpret_cast<const uint4*>(v8 + (size_t)e * 1024 + loff);
      }
#pragma unroll
      for (int q = 0; q < 8; ++q) {
        const int kk = (k0 & 63) + q;
        const float gt = __int_as_float((k0 < 64) ? __builtin_amdgcn_readlane(__float_as_int(g_lo), kk) : __builtin_amdgcn_readlane(__float_as_int(g_hi), kk));
        const float su = __int_as_float((k0 < 64) ? __builtin_amdgcn_readlane(__float_as_int(s_lo), kk) : __builtin_amdgcn_readlane(__float_as_int(s_hi), kk));
        float d = wave_sum(dot16_fp8(xf, ur[q])) * su;
        const float wgt = gt * gelu_exact(d);
        axpy16_fp8(y, wgt, vr[q]);
      }
    }
    if (DRY) {
#pragma unroll
      for (int i = 0; i < 16; ++i) asm volatile("" ::"v"(y[i]));
      continue;
    }
    float* xr = p.x() + (size_t)t * 1024 + lane * 16;
#pragma unroll
    for (int j = 0; j < 4; ++j) {
      float4 a = reinterpret_cast<float4*>(xr)[j];
      a.x += y[4 * j]; a.y += y[4 * j + 1]; a.z += y[4 * j + 2]; a.w += y[4 * j + 3];
      reinterpret_cast<float4*>(xr)[j] = a;
    }
  }
}

enum { PH_PREP = 0, PH_NORM1, PH_GEMM_IN, PH_ATTN, PH_MLCONV, PH_MCHAIN, PH_MLU, PH_MLSCAN, PH_MLOUT, PH_CMLP,
       PH_GEMM_OUT, PH_NORM2, PH_GEMM_PQ, PH_GEMM_SC, PH_TOPK, PH_GATHER, PH_FINAL };

__device__ __forceinline__ Params phase_params(const Params& kp, bool with_inputs) {
  Params q;
  size_t z = 0;
  asm volatile("" : "+s"(z));
  q.out = kp.out + z;
  q.ws = kp.ws + z;
  q.in[0] = kp.in[0] + z;
  q.in[1] = kp.in[1] + z;
  if (with_inputs) {
#pragma unroll
    for (int i = 2; i < 30; ++i) q.in[i] = kp.in[i] + z;
  }
  return q;
}


#define GT 4
typedef __attribute__((ext_vector_type(4))) float f32x4;

__device__ __forceinline__ float dot16_fp8v(const f32x2* x2, uint4 u) {
  f32x2 acc = x2[0] * __builtin_amdgcn_cvt_pk_f32_fp8(u.x, false);
  acc += x2[1] * __builtin_amdgcn_cvt_pk_f32_fp8(u.x, true);
  acc += x2[2] * __builtin_amdgcn_cvt_pk_f32_fp8(u.y, false);
  acc += x2[3] * __builtin_amdgcn_cvt_pk_f32_fp8(u.y, true);
  acc += x2[4] * __builtin_amdgcn_cvt_pk_f32_fp8(u.z, false);
  acc += x2[5] * __builtin_amdgcn_cvt_pk_f32_fp8(u.z, true);
  acc += x2[6] * __builtin_amdgcn_cvt_pk_f32_fp8(u.w, false);
  acc += x2[7] * __builtin_amdgcn_cvt_pk_f32_fp8(u.w, true);
  return acc.x + acc.y;
}
__device__ __forceinline__ void axpy16_fp8v(f32x2* y2, float wgt, uint4 v) {
  const f32x2 w2 = {wgt, wgt};
  y2[0] += w2 * __builtin_amdgcn_cvt_pk_f32_fp8(v.x, false);
  y2[1] += w2 * __builtin_amdgcn_cvt_pk_f32_fp8(v.x, true);
  y2[2] += w2 * __builtin_amdgcn_cvt_pk_f32_fp8(v.y, false);
  y2[3] += w2 * __builtin_amdgcn_cvt_pk_f32_fp8(v.y, true);
  y2[4] += w2 * __builtin_amdgcn_cvt_pk_f32_fp8(v.z, false);
  y2[5] += w2 * __builtin_amdgcn_cvt_pk_f32_fp8(v.z, true);
  y2[6] += w2 * __builtin_amdgcn_cvt_pk_f32_fp8(v.w, false);
  y2[7] += w2 * __builtin_amdgcn_cvt_pk_f32_fp8(v.w, true);
}

struct GU { uint4 ur[4]; f32x4 su; };
struct GV { uint4 vr[4]; f32x4 gt; };
#define GREC 384
__device__ __forceinline__ void gload_u(GU& U, const float* rec, int i4, const unsigned char* u8, unsigned loff) {
  const f32x4 ev = *reinterpret_cast<const f32x4*>(rec + i4);
  U.su = *reinterpret_cast<const f32x4*>(rec + 256 + i4);
  const int e0 = __builtin_amdgcn_readfirstlane(__float_as_int(ev.x)), e1 = __builtin_amdgcn_readfirstlane(__float_as_int(ev.y));
  const int e2 = __builtin_amdgcn_readfirstlane(__float_as_int(ev.z)), e3 = __builtin_amdgcn_readfirstlane(__float_as_int(ev.w));
  U.ur[0] = *reinterpret_cast<const uint4*>(u8 + (size_t)e0 * 1024 + loff);
  U.ur[1] = *reinterpret_cast<const uint4*>(u8 + (size_t)e1 * 1024 + loff);
  U.ur[2] = *reinterpret_cast<const uint4*>(u8 + (size_t)e2 * 1024 + loff);
  U.ur[3] = *reinterpret_cast<const uint4*>(u8 + (size_t)e3 * 1024 + loff);
}
__device__ __forceinline__ void gload_v(GV& V, const float* rec, int i4, const unsigned char* v8, unsigned loff) {
  const f32x4 ev = *reinterpret_cast<const f32x4*>(rec + i4);
  V.gt = *reinterpret_cast<const f32x4*>(rec + 128 + i4);
  const int e0 = __builtin_amdgcn_readfirstlane(__float_as_int(ev.x)), e1 = __builtin_amdgcn_readfirstlane(__float_as_int(ev.y));
  const int e2 = __builtin_amdgcn_readfirstlane(__float_as_int(ev.z)), e3 = __builtin_amdgcn_readfirstlane(__float_as_int(ev.w));
  V.vr[0] = *reinterpret_cast<const uint4*>(v8 + (size_t)e0 * 1024 + loff);
  V.vr[1] = *reinterpret_cast<const uint4*>(v8 + (size_t)e1 * 1024 + loff);
  V.vr[2] = *reinterpret_cast<const uint4*>(v8 + (size_t)e2 * 1024 + loff);
  V.vr[3] = *reinterpret_cast<const uint4*>(v8 + (size_t)e3 * 1024 + loff);
}
__device__ __forceinline__ void gstep(GU& U, GV& V, const uint4* xl, f32x2* y2, const float* nrec, int ni4,
                                      const unsigned char* u8, const unsigned char* v8, unsigned loff, int lane) {
  f32x2 x2[8];
  {
    const uint4 xa = xl[0], xb = xl[1];
    x2[0] = f32x2{bf_lo(xa.x), bf_hi(xa.x)}; x2[1] = f32x2{bf_lo(xa.y), bf_hi(xa.y)};
    x2[2] = f32x2{bf_lo(xa.z), bf_hi(xa.z)}; x2[3] = f32x2{bf_lo(xa.w), bf_hi(xa.w)};
    x2[4] = f32x2{bf_lo(xb.x), bf_hi(xb.x)}; x2[5] = f32x2{bf_lo(xb.y), bf_hi(xb.y)};
    x2[6] = f32x2{bf_lo(xb.z), bf_hi(xb.z)}; x2[7] = f32x2{bf_lo(xb.w), bf_hi(xb.w)};
  }
  float d[4], su[4];
#pragma unroll
  for (int q = 0; q < 4; ++q) { d[q] = dot16_fp8v(x2, U.ur[q]); su[q] = U.su[q]; }
  gload_u(U, nrec, ni4, u8, loff);
#pragma unroll
  for (int q = 0; q < 4; ++q) d[q] = wave_sum(d[q]) * su[q];
  float dv = d[0]; dv = (lane == 1) ? d[1] : dv; dv = (lane == 2) ? d[2] : dv; dv = (lane == 3) ? d[3] : dv;
  const float av = gelu_exact(dv);
#pragma unroll
  for (int q = 0; q < 4; ++q) {
    const float act = __int_as_float(__builtin_amdgcn_readlane(__float_as_int(av), q));
    axpy16_fp8v(y2, V.gt[q] * act, V.vr[q]);
  }
  gload_v(V, nrec, ni4, v8, loff);
}
__device__ __forceinline__ void gsort_token(const Params& p, int t, float* rec, int lane) {
  const int e0 = p.eidx()[(size_t)t * 128 + lane], e1 = p.eidx()[(size_t)t * 128 + 64 + lane];
  const float g0 = p.egate()[(size_t)t * 128 + lane], g1 = p.egate()[(size_t)t * 128 + 64 + lane];
  const float q0 = p.esu()[(size_t)t * 128 + lane], q1 = p.esu()[(size_t)t * 128 + 64 + lane];
  int base = 0;
#pragma unroll 4
  for (int s = 0; s < 16; ++s) {
    const unsigned long long m0 = __ballot((e0 >> 10) == s), m1 = __ballot((e1 >> 10) == s);
    const int c0 = __popcll(m0), c1 = __popcll(m1);
    const int p0 = base + (int)__builtin_amdgcn_mbcnt_hi((unsigned)(m0 >> 32), __builtin_amdgcn_mbcnt_lo((unsigned)m0, 0));
    const int p1 = base + c0 + (int)__builtin_amdgcn_mbcnt_hi((unsigned)(m1 >> 32), __builtin_amdgcn_mbcnt_lo((unsigned)m1, 0));
    if ((e0 >> 10) == s) { rec[p0] = __int_as_float(e0); rec[128 + p0] = g0; rec[256 + p0] = q0; }
    if ((e1 >> 10) == s) { rec[p1] = __int_as_float(e1); rec[128 + p1] = g1; rec[256 + p1] = q1; }
    base += c0 + c1;
  }
}
__device__ __forceinline__ void gload_x(const Params& p, int t, uint4* xl, int lane) {
  xl[0] = *reinterpret_cast<const uint4*>(p.xn() + (size_t)t * 1024 + lane * 16);
  xl[1] = *reinterpret_cast<const uint4*>(p.xn() + (size_t)t * 1024 + lane * 16 + 8);
}
template <bool LAST>
__device__ __forceinline__ void gstore_x(const Params& p, int l, int t, const f32x2* y2, int lane) {
  float* xr = p.x() + (size_t)t * 1024 + lane * 16;
  float4 a[4];
  float ss = 0.f;
#pragma unroll
  for (int j = 0; j < 4; ++j) {
    a[j] = reinterpret_cast<float4*>(xr)[j];
    a[j].x += y2[2 * j].x; a[j].y += y2[2 * j].y; a[j].z += y2[2 * j + 1].x; a[j].w += y2[2 * j + 1].y;
    ss += a[j].x * a[j].x + a[j].y * a[j].y + a[j].z * a[j].z + a[j].w * a[j].w;
  }
  ss = wave_sum(ss);
  const float r = rsqrtf(ss * (1.f / 1024.f) + EPS);
  if (LAST) {
    const float* g = p.final_g() + lane * 16;
    float* o = ((t < NPROMPT) ? p.out + O_Y_P + (size_t)t * 1024 : p.out + O_Y_S + (size_t)(t - NPROMPT) * 1024) + lane * 16;
#pragma unroll
    for (int j = 0; j < 4; ++j) {
      const float4 gv = reinterpret_cast<const float4*>(g)[j];
      reinterpret_cast<float4*>(o)[j] = make_float4(a[j].x * r * gv.x, a[j].y * r * gv.y, a[j].z * r * gv.z, a[j].w * r * gv.w);
    }
  } else {
    const float* g = p.norm1_g() + (l + 1) * 1024 + lane * 16;
#pragma unroll
    for (int j = 0; j < 4; ++j) {
      reinterpret_cast<float4*>(xr)[j] = a[j];
      const float4 gv = reinterpret_cast<const float4*>(g)[j];
      a[j].x *= r * gv.x; a[j].y *= r * gv.y; a[j].z *= r * gv.z; a[j].w *= r * gv.w;
    }
    uint4* o = reinterpret_cast<uint4*>(p.xn() + (size_t)t * 1024 + lane * 16);
    o[0] = make_uint4(pack2(a[0].x, a[0].y), pack2(a[0].z, a[0].w), pack2(a[1].x, a[1].y), pack2(a[1].z, a[1].w));
    o[1] = make_uint4(pack2(a[2].x, a[2].y), pack2(a[2].z, a[2].w), pack2(a[3].x, a[3].y), pack2(a[3].z, a[3].w));
    float pre[8];
#pragma unroll
    for (int i = 0; i < 8; ++i) {
      const float4* wr = reinterpret_cast<const float4*>(p.wg() + ((size_t)(l + 1) * 8 + i) * 1024 + lane * 16);
      float s = 0.f;
#pragma unroll
      for (int j = 0; j < 4; ++j) {
        const float4 wv = wr[j];
        s += a[j].x * wv.x + a[j].y * wv.y + a[j].z * wv.z + a[j].w * wv.w;
      }
      pre[i] = wave_sum(s);
    }
    if (lane < 4) {
      float ai = pre[0]; ai = lane == 1 ? pre[1] : ai; ai = lane == 2 ? pre[2] : ai; ai = lane == 3 ? pre[3] : ai;
      float f = pre[4]; f = lane == 1 ? pre[5] : f; f = lane == 2 ? pre[6] : f; f = lane == 3 ? pre[7] : f;
      p.ig()[(size_t)t * 4 + lane] = ai + p.ml_gate_b()[(l + 1) * 8 + lane];
      const float z = f + p.ml_gate_b()[(l + 1) * 8 + 4 + lane];
      p.lf()[(size_t)t * 4 + lane] = fminf(z, 0.f) - log1pf(expf(-fabsf(z)));
    }
  }
}

template <bool LAST>
__device__ __forceinline__ void ph_gather2(const Params& p, int l, char* smem, int bid, int nblk) {
  const int tid = tid_opaque(), lane = tid & 63, w = tid >> 6;
  const unsigned char* u8 = p.ub8() + (size_t)l * 16384 * 1024;
  const unsigned char* v8 = p.vb8() + (size_t)l * 16384 * 1024;
  const unsigned loff = (unsigned)lane * 16u;
  float* rec = reinterpret_cast<float*>(smem) + w * (GT * GREC);
  uint4* xl = reinterpret_cast<uint4*>(smem + 4 * GT * GREC * 4) + (w * GT * 64 + lane) * 2;
  const int rot = (bid & 7) * 4;
  const int nwaves = nblk * 4, wg = bid * 4 + w;
  const int nfull = (NTOK / (nwaves * GT)) * nwaves;
  for (int grp = wg; grp < nfull; grp += nwaves) {
    const int t0 = grp * GT;
    int lane_s = lane; asm volatile("" : "+v"(lane_s));
#pragma unroll 1
    for (int ti = 0; ti < GT; ++ti) {
      gload_x(p, t0 + ti, xl + ti * 128, lane_s);
      gsort_token(p, t0 + ti, rec + ti * GREC, lane_s);
    }
    f32x2 y2[GT][8];
#pragma unroll
    for (int ti = 0; ti < GT; ++ti)
#pragma unroll
      for (int i = 0; i < 8; ++i) y2[ti][i] = f32x2{0.f, 0.f};
    GU U; GV V;
    gload_u(U, rec, (rot & 31) * 4, u8, loff);
    gload_v(V, rec, (rot & 31) * 4, v8, loff);
#pragma unroll 1
    for (int b = 0; b < 32; ++b) {
      const int bo = ((b + rot) & 31) * 4, bn = ((b + 1 + rot) & 31) * 4;
      gstep(U, V, xl + 0 * 128, y2[0], rec + 1 * GREC, bo, u8, v8, loff, lane);
      __builtin_amdgcn_sched_barrier(0);
      gstep(U, V, xl + 1 * 128, y2[1], rec + 2 * GREC, bo, u8, v8, loff, lane);
      __builtin_amdgcn_sched_barrier(0);
      gstep(U, V, xl + 2 * 128, y2[2], rec + 3 * GREC, bo, u8, v8, loff, lane);
      __builtin_amdgcn_sched_barrier(0);
      gstep(U, V, xl + 3 * 128, y2[3], rec, bn, u8, v8, loff, lane);
    }
    int lane_e = lane; asm volatile("" : "+v"(lane_e));
#pragma unroll
    for (int ti = 0; ti < GT; ++ti) gstore_x<LAST>(p, l, t0 + ti, y2[ti], lane_e);
  }
  float* ysum = reinterpret_cast<float*>(smem + 4 * GT * GREC * 4 + 4 * GT * 2048);
  for (int t = nfull * GT + bid; t < NTOK; t += nblk) {
    f32x2 y2[8];
    gload_x(p, t, xl, lane);
#pragma unroll
    for (int i = 0; i < 8; ++i) y2[i] = f32x2{0.f, 0.f};
    gsort_token(p, t, rec, lane);
    GU U; GV V;
    gload_u(U, rec, (w * 8) * 4, u8, loff);
    gload_v(V, rec, (w * 8) * 4, v8, loff);
#pragma unroll 1
    for (int b = 0; b < 8; ++b) gstep(U, V, xl, y2, rec, (w * 8 + ((b + 1) & 7)) * 4, u8, v8, loff, lane);
    __syncthreads();
#pragma unroll
    for (int i = 0; i < 8; ++i) { ysum[w * 1024 + lane * 16 + 2 * i] = y2[i].x; ysum[w * 1024 + lane * 16 + 2 * i + 1] = y2[i].y; }
    __syncthreads();
    if (w == 0) {
#pragma unroll
      for (int i = 0; i < 8; ++i) {
        y2[i].x += ysum[1024 + lane * 16 + 2 * i] + ysum[2048 + lane * 16 + 2 * i] + ysum[3072 + lane * 16 + 2 * i];
        y2[i].y += ysum[1024 + lane * 16 + 2 * i + 1] + ysum[2048 + lane * 16 + 2 * i + 1] + ysum[3072 + lane * 16 + 2 * i + 1];
      }
      gstore_x<LAST>(p, l, t, y2, lane);
    }
  }
}

#define XB_TMO      128
#define XB_XCNT(j)  (256  + 64 * (j))
#define XB_XSUB(j)  (1280 + 64 * (j))
#define XB_XGEN(j)  (2304 + 64 * (j))
#define XB_TOP      3328
#define XB_TOPGEN   3392
#define XCD_BAR_WORDS 3456
#define XB_SPIN_CAP (1u << 22)
__device__ __forceinline__ unsigned xb_ld(unsigned* p)              { return __hip_atomic_load(p, __ATOMIC_RELAXED, __HIP_MEMORY_SCOPE_AGENT); }
__device__ __forceinline__ unsigned xb_add(unsigned* p, unsigned v) { return __hip_atomic_fetch_add(p, v, __ATOMIC_RELAXED, __HIP_MEMORY_SCOPE_AGENT); }
__device__ __forceinline__ unsigned xb_xcc_id() { return (unsigned)__builtin_amdgcn_s_getreg((3 << 11) | 20) & 0xFu; }
#define XB_SPIN(cond, bar) do { unsigned _sp = 0; while (cond) { __builtin_amdgcn_s_sleep(1); \
    if ((++_sp & 255u) == 0u) { if (xb_ld(&(bar)[XB_TMO])) break; if (_sp > XB_SPIN_CAP) { atomicAdd(&(bar)[XB_TMO], 1u); break; } } } } while (0)

struct XcdBarrier { unsigned* bar; unsigned x; volatile LAS unsigned* st; };

__device__ __forceinline__ XcdBarrier xcd_barrier_post(unsigned* bar, volatile LAS unsigned* st) {
  XcdBarrier b; b.bar = bar; b.x = xb_xcc_id(); b.st = st;
  if (threadIdx.x == 0) (void)xb_add(&bar[XB_XCNT(b.x)], 1u);
  return b;
}
__device__ __forceinline__ void xcd_barrier_complete(unsigned* bar, unsigned x, unsigned& nloc, unsigned& nx) {
  const unsigned G = gridDim.x * gridDim.y * gridDim.z;
  unsigned sum, cnt, mine, sp = 0u;
  for (;;) {
    sum = 0u; cnt = 0u; mine = 0u;
#pragma unroll
    for (unsigned j = 0; j < 16; ++j) { const unsigned c = xb_ld(&bar[XB_XCNT(j)]); sum += c; cnt += (c > 0u) ? 1u : 0u; mine = (j == x) ? c : mine; }
    if (sum == G) break;
    __builtin_amdgcn_s_sleep(1);
    if ((++sp & 255u) == 0u) { if (xb_ld(&bar[XB_TMO])) break; if (sp > XB_SPIN_CAP) { atomicAdd(&bar[XB_TMO], 1u); break; } }
  }
  nloc = mine > 0u ? mine : 1u; nx = cnt > 0u ? cnt : 1u;
}
__device__ __forceinline__ void xcd_barrier(const XcdBarrier& b) {
  asm volatile("s_waitcnt vmcnt(0)" ::: "memory");
  __syncthreads();
  if (threadIdx.x == 0) {
    unsigned* bar = b.bar;
    __builtin_amdgcn_s_waitcnt(0);
    unsigned nloc = b.st[0], nx = b.st[1];
    if (nloc == 0u) { xcd_barrier_complete(bar, b.x, nloc, nx); b.st[0] = nloc; b.st[1] = nx; }
    const unsigned old = xb_add(&bar[XB_XSUB(b.x)], 1u);
    const unsigned gen = old / nloc;
    if (old + 1u == (gen + 1u) * nloc) {
      __builtin_amdgcn_fence(__ATOMIC_RELEASE, "agent");
      asm volatile("s_waitcnt vmcnt(0)" ::: "memory");
      const unsigned og = xb_add(&bar[XB_TOP], 1u);
      const unsigned tg = og / nx;
      if (og + 1u == (tg + 1u) * nx) xb_add(&bar[XB_TOPGEN], 1u);
      else XB_SPIN(xb_ld(&bar[XB_TOPGEN]) == tg, bar);
      __builtin_amdgcn_fence(__ATOMIC_ACQUIRE, "agent");
      xb_add(&bar[XB_XGEN(b.x)], 1u);
      asm volatile("s_waitcnt vmcnt(0)" ::: "memory");
    } else {
      XB_SPIN(xb_ld(&bar[XB_XGEN(b.x)]) == gen, bar);
      __builtin_amdgcn_fence(__ATOMIC_ACQUIRE, "agent");
      asm volatile("s_waitcnt vmcnt(0)" ::: "memory");
    }
  }
  __syncthreads();
}

#define GSYNC() xcd_barrier(xb)
#define PP(wi) phase_params(p, wi)
#define BN bid_opaque(bid), nblk_opaque(nblk)

template <int L>
__device__ __forceinline__ void layer_phases(const Params& p, char* smem, const XcdBarrier& xb, int bid, int nblk) {
  if (L == 0) {
  ph_rmsnorm<0>(PP(false), L, BN);
#if PROBE == 11
  GSYNC();
  ph_rmsnorm<0>(PP(false), L, BN);
#endif
  GSYNC();
  }
  ph_gemm<EPI_WIN>(PP(false), L, smem, BN);
#if PROBE == 1
  GSYNC();
  ph_gemm<EPI_WIN>(PP(false), L, smem, BN);
#endif
  GSYNC();
  ph_attn(PP(false), L, smem, BN);
#if PROBE == 4
  GSYNC();
  ph_attn(PP(false), L, smem, BN);
#endif
  ph_mlconv(PP(false), L, smem, BN);
#if PROBE == 8 || PROBE == 20
  GSYNC();
  ph_mlconv(PP(false), L, smem, BN);
#endif
  ph_cmlp(PP(false), L, smem, BN);
#if PROBE == 7 || PROBE == 20
  GSYNC();
  ph_cmlp(PP(false), L, smem, BN);
#endif
  GSYNC();
  ph_mlU(PP(false), L, smem, BN);
#if PROBE == 9 || PROBE == 20
  GSYNC();
  ph_mlU(PP(false), L, smem, BN);
#endif
  GSYNC();
  ph_mlscan(PP(false), L, BN);
#if PROBE == 10 || PROBE == 20
  GSYNC();
  ph_mlscan(PP(false), L, BN);
#endif
  GSYNC();
  ph_mlout(PP(false), L, smem, BN);
#if PROBE == 6 || PROBE == 20
  GSYNC();
  ph_mlout(PP(false), L, smem, BN);
#endif
  GSYNC();
  ph_gemm<EPI_WOUT>(PP(false), L, smem, BN);
  GSYNC();
  ph_rmsnorm<1>(PP(false), L, BN);
  GSYNC();
  ph_gemm<EPI_PQ>(PP(false), L, smem, BN);
#if PROBE == 2
  GSYNC();
  ph_gemm<EPI_PQ>(PP(false), L, smem, BN);
#endif
  GSYNC();
  ph_gemm<EPI_SC>(PP(false), L, smem, BN);
#if PROBE == 3
  GSYNC();
  ph_gemm<EPI_SC>(PP(false), L, smem, BN);
#endif
  GSYNC();
  ph_topk(PP(false), L, smem, BN);
#if PROBE == 5
  GSYNC();
  ph_topk(PP(false), L, smem, BN);
#endif
  GSYNC();
  ph_gather2<(L == 1)>(PP(false), L, smem, BN);
  GSYNC();
}

__global__ void __launch_bounds__(256, 2) mega_kernel(Params p) {
  __shared__ __attribute__((aligned(16))) char smem[SMEM_BYTES];
  __shared__ uint4 xb_words;
  cg::grid_group grid = cg::this_grid();
  const int bid = blockIdx.x, nblk = gridDim.x;
  if (threadIdx.x == 0) xb_words = make_uint4(0u, 0u, 0u, 0u);
  __syncthreads();
  XcdBarrier xb = xcd_barrier_post(reinterpret_cast<unsigned*>(p.ws), (volatile LAS unsigned*)&xb_words);
  grid.sync();
  ph_prep(PP(true), smem, BN);
#if PROBE == 12
  GSYNC();
  ph_prep(PP(true), smem, BN);
#endif
  GSYNC();
  layer_phases<0>(p, smem, xb, bid, nblk);
  layer_phases<1>(p, smem, xb, bid, nblk);
}

static inline size_t align_up(size_t v, size_t a) { return (v + a - 1) / a * a; }

extern "C" void kernel_launch(void* const* d_in, const int* in_sizes, int n_in, void* d_out, int out_size, void* d_ws,
                              size_t ws_size, hipStream_t stream) {
  Params p{};
  for (int i = 0; i < 30; ++i) p.in[i] = reinterpret_cast<const float*>(d_in[i]);
  p.out = reinterpret_cast<float*>(d_out);
  p.ws = reinterpret_cast<char*>(d_ws);
  if (WS_NEED > ws_size) { fprintf(stderr, "workspace too small: need %zu have %zu\n", (size_t)WS_NEED, ws_size); return; }
  static int grid_blocks = 0;
  if (!grid_blocks) {
    int dev = 0, cus = 0, per_cu = 0;
    hipGetDevice(&dev);
    hipDeviceGetAttribute(&cus, hipDeviceAttributeMultiprocessorCount, dev);
    hipOccupancyMaxActiveBlocksPerMultiprocessor(&per_cu, mega_kernel, 256, 0);
    if (per_cu > 2) per_cu = 2;
    if (per_cu < 1) per_cu = 1;
    grid_blocks = cus * per_cu;
  }
  hipMemsetAsync(d_ws, 0, 16384, stream);
  void* args[] = {&p};
  hipError_t e = hipLaunchCooperativeKernel((void*)mega_kernel, dim3(grid_blocks), dim3(256), args, 0, stream);
  if (e != hipSuccess) fprintf(stderr, "cooperative launch failed: %s (grid %d)\n", hipGetErrorString(e), grid_blocks);
}
```

```cpp
#include <hip/hip_runtime.h>
#include <hip/hip_cooperative_groups.h>
#include <cstdio>
#include <cstdint>

namespace cg = cooperative_groups;

typedef unsigned short bf16_t;
typedef __attribute__((ext_vector_type(8))) __bf16 bf16x8;
typedef __attribute__((ext_vector_type(2))) __bf16 bf16x2;
typedef __attribute__((ext_vector_type(16))) float f32x16;
typedef __attribute__((ext_vector_type(2))) float f32x2;

#define D_MODEL 1024
#define NTOK 16896
#define NPROMPT 16384
#define SEQ 4096
#define NIN 2816
#define EPS 1e-6f
#define LOG2E 1.4426950408889634f
#define SKEYS 1088
#define NCU_UNITS 1056

constexpr size_t O_Y_P = 0;
constexpr size_t O_Y_S = O_Y_P + 16777216;
constexpr size_t O_K_P = O_Y_S + 524288;
constexpr size_t O_V_P = O_K_P + 16777216;
constexpr size_t O_C_P = O_V_P + 16777216;
constexpr size_t O_N_P = O_C_P + 131072;
constexpr size_t O_M_P = O_N_P + 2048;
constexpr size_t O_CONV_P = O_M_P + 32;
constexpr size_t O_K_S = O_CONV_P + 6144;
constexpr size_t O_V_S = O_K_S + 524288;
constexpr size_t O_C_S = O_V_S + 524288;
constexpr size_t O_N_S = O_C_S + 262144;
constexpr size_t O_M_S = O_N_S + 4096;
constexpr size_t O_CONV_S = O_M_S + 64;
constexpr size_t O_CMV_S = O_CONV_S + 12288;

constexpr size_t al256(size_t v) { return (v + 255) / 256 * 256; }
constexpr int SP_st_c = 0;
constexpr int SP_st_n = 262144;
constexpr int SP_st_m = 266240;
constexpr int SP_st_conv = 266304;
constexpr int SP_norm1_g = 278592;
constexpr int SP_da_subln_g = 280640;
constexpr int SP_ml_conv_w = 280896;
constexpr int SP_ml_conv_b = 282944;
constexpr int SP_ml_wq = 283456;
constexpr int SP_ml_wk = 316224;
constexpr int SP_ml_gate_b = 348992;
constexpr int SP_ml_norm_g = 349056;
constexpr int SP_ml_skip = 349568;
constexpr int SP_cm_norm_g = 350080;
constexpr int SP_cm_ws = 350592;
constexpr int SP_cm_b = 481664;
constexpr int SP_norm2_g = 482688;
constexpr int SP_final_g = 484736;
constexpr int SP_TOTAL = 485760;
constexpr size_t WS_bar = 0;
constexpr size_t WS_lam = al256(WS_bar + 16384);
constexpr size_t WS_lut = al256(WS_lam + (256));
constexpr size_t WS_sp = al256(WS_lut + (4*256*4));
constexpr size_t WS_wt_in = al256(WS_sp + (SP_TOTAL*4));
constexpr size_t WS_wg = al256(WS_wt_in + ((size_t)2*NIN*1024*2));
constexpr size_t WS_wt_out = al256(WS_wg + ((size_t)2*8*1024*4));
constexpr size_t WS_wt_pq = al256(WS_wt_out + ((size_t)2*1024*1024*2));
constexpr size_t WS_keysb = al256(WS_wt_pq + ((size_t)2*2048*1024*2));
constexpr size_t WS_ub8 = al256(WS_keysb + ((size_t)2*16*128*128*2));
constexpr size_t WS_vb8 = al256(WS_ub8 + ((size_t)2*16384*1024));
constexpr size_t WS_us = al256(WS_vb8 + ((size_t)2*16384*1024));
constexpr size_t WS_vs = al256(WS_us + ((size_t)2*16384*4));
constexpr size_t WS_Kbs = al256(WS_vs + ((size_t)2*16384*4));
constexpr size_t WS_Vts = al256(WS_Kbs + ((size_t)2*8*SKEYS*512*2));
constexpr size_t WS_x = al256(WS_Vts + ((size_t)2*8*4*128*SKEYS*2));
constexpr size_t WS_xn = al256(WS_x + ((size_t)NTOK*1024*4));
constexpr size_t WS_R0 = al256(WS_xn + ((size_t)NTOK*1024*2));
constexpr size_t WS_R0x = WS_R0;
constexpr size_t WS_Qb = al256(WS_R0x + (0));
constexpr size_t WS_Kb = al256(WS_Qb + ((size_t)NTOK*512*2));
constexpr size_t WS_Vt = al256(WS_Kb + ((size_t)NPROMPT*512*2));
constexpr size_t WS_P5 = al256(WS_Vt + ((size_t)16*128*SEQ*2));
constexpr size_t WS_ig = al256(WS_P5 + ((size_t)NTOK*1280*4));
constexpr size_t WS_lf = al256(WS_ig + ((size_t)NTOK*4*4));
constexpr size_t WS_Fc = al256(WS_lf + ((size_t)NTOK*4*4));
constexpr size_t WS_cc = al256(WS_Fc + ((size_t)NTOK*4*4));
constexpr size_t WS_qm = al256(WS_cc + ((size_t)NTOK*256*4));
constexpr size_t WS_km = al256(WS_qm + ((size_t)NTOK*256*4));
constexpr size_t WS_mst = al256(WS_km + ((size_t)NTOK*256*4));
constexpr size_t WS_mnx = al256(WS_mst + (NCU_UNITS*4));
constexpr size_t WS_wcs = al256(WS_mnx + (NCU_UNITS*4));
constexpr size_t WS_FLs = al256(WS_wcs + (NCU_UNITS*4));
constexpr size_t WS_mxt = al256(WS_FLs + (NCU_UNITS*4));
constexpr size_t WS_U = al256(WS_mxt + (NCU_UNITS*4));
constexpr size_t WS_un = al256(WS_U + ((size_t)NCU_UNITS*4096*4));
constexpr size_t WS_Cst = al256(WS_un + ((size_t)NCU_UNITS*64*4));
constexpr size_t WS_nst = al256(WS_Cst + ((size_t)NCU_UNITS*4096*4));
constexpr size_t WS_END_MIXER = al256(WS_nst + ((size_t)NCU_UNITS*64*4));
constexpr size_t WS_qp = al256(WS_R0x + (0));
constexpr size_t WS_sc = al256(WS_qp + ((size_t)NTOK*2048*2));
constexpr size_t WS_eidx = al256(WS_sc + ((size_t)NTOK*2048*4));
constexpr size_t WS_egate = al256(WS_eidx + ((size_t)NTOK*128*4));
constexpr size_t WS_esu = al256(WS_egate + ((size_t)NTOK*128*4));
constexpr size_t WS_ssp = al256(WS_esu + ((size_t)NTOK*128*4));
constexpr size_t WS_END_PEER = al256(WS_ssp + ((size_t)NTOK*32*4));
constexpr size_t WS_NEED = WS_END_MIXER > WS_END_PEER ? WS_END_MIXER : WS_END_PEER;

struct Params {
  const float* in[30];
  float* out;
  char* ws;
  __device__ __forceinline__ const float* x_prompt() const { return in[0]; }
  __device__ __forceinline__ const float* x_sample() const { return in[1]; }
  __device__ __forceinline__ const float* cache_k() const { return in[2]; }
  __device__ __forceinline__ const float* cache_v() const { return in[3]; }
  __device__ __forceinline__ const float* w_in() const { return in[9]; }
  __device__ __forceinline__ const float* da_lambda() const { return in[10]; }
  __device__ __forceinline__ const float* rel_table() const { return in[12]; }
  __device__ __forceinline__ const float* w_out() const { return in[23]; }
  __device__ __forceinline__ const float* peer_wq() const { return in[25]; }
  __device__ __forceinline__ const float* peer_keys() const { return in[26]; }
  __device__ __forceinline__ const float* peer_u() const { return in[27]; }
  __device__ __forceinline__ const float* peer_v() const { return in[28]; }
  __device__ __forceinline__ const float* st_c() const { return reinterpret_cast<const float*>(ws + WS_sp) + SP_st_c; }
  __device__ __forceinline__ const float* st_n() const { return reinterpret_cast<const float*>(ws + WS_sp) + SP_st_n; }
  __device__ __forceinline__ const float* st_m() const { return reinterpret_cast<const float*>(ws + WS_sp) + SP_st_m; }
  __device__ __forceinline__ const float* st_conv() const { return reinterpret_cast<const float*>(ws + WS_sp) + SP_st_conv; }
  __device__ __forceinline__ const float* norm1_g() const { return reinterpret_cast<const float*>(ws + WS_sp) + SP_norm1_g; }
  __device__ __forceinline__ const float* da_subln_g() const { return reinterpret_cast<const float*>(ws + WS_sp) + SP_da_subln_g; }
  __device__ __forceinline__ const float* ml_conv_w() const { return reinterpret_cast<const float*>(ws + WS_sp) + SP_ml_conv_w; }
  __device__ __forceinline__ const float* ml_conv_b() const { return reinterpret_cast<const float*>(ws + WS_sp) + SP_ml_conv_b; }
  __device__ __forceinline__ const float* ml_wq() const { return reinterpret_cast<const float*>(ws + WS_sp) + SP_ml_wq; }
  __device__ __forceinline__ const float* ml_wk() const { return reinterpret_cast<const float*>(ws + WS_sp) + SP_ml_wk; }
  __device__ __forceinline__ const float* ml_gate_b() const { return reinterpret_cast<const float*>(ws + WS_sp) + SP_ml_gate_b; }
  __device__ __forceinline__ const float* ml_norm_g() const { return reinterpret_cast<const float*>(ws + WS_sp) + SP_ml_norm_g; }
  __device__ __forceinline__ const float* ml_skip() const { return reinterpret_cast<const float*>(ws + WS_sp) + SP_ml_skip; }
  __device__ __forceinline__ const float* cm_norm_g() const { return reinterpret_cast<const float*>(ws + WS_sp) + SP_cm_norm_g; }
  __device__ __forceinline__ const float* cm_ws() const { return reinterpret_cast<const float*>(ws + WS_sp) + SP_cm_ws; }
  __device__ __forceinline__ const float* cm_b() const { return reinterpret_cast<const float*>(ws + WS_sp) + SP_cm_b; }
  __device__ __forceinline__ const float* norm2_g() const { return reinterpret_cast<const float*>(ws + WS_sp) + SP_norm2_g; }
  __device__ __forceinline__ const float* final_g() const { return reinterpret_cast<const float*>(ws + WS_sp) + SP_final_g; }
  __device__ __forceinline__ float* lam() const { return reinterpret_cast<float*>(ws + WS_lam); }
  __device__ __forceinline__ float* lut() const { return reinterpret_cast<float*>(ws + WS_lut); }
  __device__ __forceinline__ float* sp() const { return reinterpret_cast<float*>(ws + WS_sp); }
  __device__ __forceinline__ bf16_t* wt_in() const { return reinterpret_cast<bf16_t*>(ws + WS_wt_in); }
  __device__ __forceinline__ float* wg() const { return reinterpret_cast<float*>(ws + WS_wg); }
  __device__ __forceinline__ bf16_t* wt_out() const { return reinterpret_cast<bf16_t*>(ws + WS_wt_out); }
  __device__ __forceinline__ bf16_t* wt_pq() const { return reinterpret_cast<bf16_t*>(ws + WS_wt_pq); }
  __device__ __forceinline__ bf16_t* keysb() const { return reinterpret_cast<bf16_t*>(ws + WS_keysb); }
  __device__ __forceinline__ unsigned char* ub8() const { return reinterpret_cast<unsigned char*>(ws + WS_ub8); }
  __device__ __forceinline__ unsigned char* vb8() const { return reinterpret_cast<unsigned char*>(ws + WS_vb8); }
  __device__ __forceinline__ float* us() const { return reinterpret_cast<float*>(ws + WS_us); }
  __device__ __forceinline__ float* vs() const { return reinterpret_cast<float*>(ws + WS_vs); }
  __device__ __forceinline__ bf16_t* Kbs() const { return reinterpret_cast<bf16_t*>(ws + WS_Kbs); }
  __device__ __forceinline__ bf16_t* Vts() const { return reinterpret_cast<bf16_t*>(ws + WS_Vts); }
  __device__ __forceinline__ float* x() const { return reinterpret_cast<float*>(ws + WS_x); }
  __device__ __forceinline__ bf16_t* xn() const { return reinterpret_cast<bf16_t*>(ws + WS_xn); }
  __device__ __forceinline__ bf16_t* Qb() const { return reinterpret_cast<bf16_t*>(ws + WS_Qb); }
  __device__ __forceinline__ bf16_t* Kb() const { return reinterpret_cast<bf16_t*>(ws + WS_Kb); }
  __device__ __forceinline__ bf16_t* Vt() const { return reinterpret_cast<bf16_t*>(ws + WS_Vt); }
  __device__ __forceinline__ float* P5() const { return reinterpret_cast<float*>(ws + WS_P5); }
  __device__ __forceinline__ float* ig() const { return reinterpret_cast<float*>(ws + WS_ig); }
  __device__ __forceinline__ float* lf() const { return reinterpret_cast<float*>(ws + WS_lf); }
  __device__ __forceinline__ float* Fc() const { return reinterpret_cast<float*>(ws + WS_Fc); }
  __device__ __forceinline__ float* cc() const { return reinterpret_cast<float*>(ws + WS_cc); }
  __device__ __forceinline__ float* qm() const { return reinterpret_cast<float*>(ws + WS_qm); }
  __device__ __forceinline__ float* km() const { return reinterpret_cast<float*>(ws + WS_km); }
  __device__ __forceinline__ float* mst() const { return reinterpret_cast<float*>(ws + WS_mst); }
  __device__ __forceinline__ float* mnx() const { return reinterpret_cast<float*>(ws + WS_mnx); }
  __device__ __forceinline__ float* wcs() const { return reinterpret_cast<float*>(ws + WS_wcs); }
  __device__ __forceinline__ float* FLs() const { return reinterpret_cast<float*>(ws + WS_FLs); }
  __device__ __forceinline__ float* mxt() const { return reinterpret_cast<float*>(ws + WS_mxt); }
  __device__ __forceinline__ float* U() const { return reinterpret_cast<float*>(ws + WS_U); }
  __device__ __forceinline__ float* un() const { return reinterpret_cast<float*>(ws + WS_un); }
  __device__ __forceinline__ float* Cst() const { return reinterpret_cast<float*>(ws + WS_Cst); }
  __device__ __forceinline__ float* nst() const { return reinterpret_cast<float*>(ws + WS_nst); }
  __device__ __forceinline__ bf16_t* qp() const { return reinterpret_cast<bf16_t*>(ws + WS_qp); }
  __device__ __forceinline__ float* sc() const { return reinterpret_cast<float*>(ws + WS_sc); }
  __device__ __forceinline__ int* eidx() const { return reinterpret_cast<int*>(ws + WS_eidx); }
  __device__ __forceinline__ float* egate() const { return reinterpret_cast<float*>(ws + WS_egate); }
  __device__ __forceinline__ float* esu() const { return reinterpret_cast<float*>(ws + WS_esu); }
  __device__ __forceinline__ float* ssp() const { return reinterpret_cast<float*>(ws + WS_ssp); }
};

__device__ __forceinline__ unsigned pack2(float a, float b) {
  f32x2 v = {a, b};
  bf16x2 r = __builtin_convertvector(v, bf16x2);
  return *reinterpret_cast<unsigned*>(&r);
}
__device__ __forceinline__ bf16_t f2bf(float a) { return (bf16_t)(pack2(a, 0.f) & 0xFFFFu); }
__device__ __forceinline__ float bf_lo(unsigned u) { return __uint_as_float(u << 16); }
__device__ __forceinline__ float bf_hi(unsigned u) { return __uint_as_float(u & 0xFFFF0000u); }
__device__ __forceinline__ float gelu_exact(float x) { return 0.5f * x * (1.f + erff(x * 0.70710678118654752f)); }
__device__ __forceinline__ float sigmoidf_(float x) { return 1.f / (1.f + __expf(-x)); }
template <int CTRL>
__device__ __forceinline__ float dpp_f(float v) {
  return __builtin_bit_cast(float, __builtin_amdgcn_update_dpp(0, __builtin_bit_cast(int, v), CTRL, 0xf, 0xf, true));
}
__device__ __forceinline__ float swap16_sum(float x) {
  auto s = __builtin_amdgcn_permlane16_swap(__float_as_uint(x), __float_as_uint(x), false, false);
  return __uint_as_float(s[0]) + __uint_as_float(s[1]);
}
__device__ __forceinline__ float swap32_sum(float x) {
  auto s = __builtin_amdgcn_permlane32_swap(__float_as_uint(x), __float_as_uint(x), false, false);
  return __uint_as_float(s[0]) + __uint_as_float(s[1]);
}
__device__ __forceinline__ float swap16_max(float x) {
  auto s = __builtin_amdgcn_permlane16_swap(__float_as_uint(x), __float_as_uint(x), false, false);
  return fmaxf(__uint_as_float(s[0]), __uint_as_float(s[1]));
}
__device__ __forceinline__ float swap32_max(float x) {
  auto s = __builtin_amdgcn_permlane32_swap(__float_as_uint(x), __float_as_uint(x), false, false);
  return fmaxf(__uint_as_float(s[0]), __uint_as_float(s[1]));
}
__device__ __forceinline__ float row16_sum(float v) {
  v += dpp_f<0xB1>(v); v += dpp_f<0x4E>(v); v += dpp_f<0x141>(v); v += dpp_f<0x140>(v);
  return v;
}
__device__ __forceinline__ float row16_max(float v) {
  v = fmaxf(v, dpp_f<0xB1>(v)); v = fmaxf(v, dpp_f<0x4E>(v)); v = fmaxf(v, dpp_f<0x141>(v)); v = fmaxf(v, dpp_f<0x140>(v));
  return v;
}
__device__ __forceinline__ float wave_sum(float v) { return swap32_sum(swap16_sum(row16_sum(v))); }
__device__ __forceinline__ float wave_max(float v) { return swap32_max(swap16_max(row16_max(v))); }
__device__ __forceinline__ const float* xrow_in(const Params& p, int l, int t) {
  if (l == 0) return (t < NPROMPT) ? p.x_prompt() + (size_t)t * D_MODEL : p.x_sample() + (size_t)(t - NPROMPT) * D_MODEL;
  return p.x() + (size_t)t * D_MODEL;
}
__device__ __forceinline__ bf16x8 as_bf16x8(uint4 v) { return *reinterpret_cast<bf16x8*>(&v); }

__device__ __forceinline__ int tid_opaque() { int t = threadIdx.x; asm volatile("" : "+v"(t)); return t; }
__device__ __forceinline__ int sgpr_opaque(int v) { asm volatile("" : "+s"(v)); return v; }
__device__ __forceinline__ int bid_opaque(int v) { asm volatile("" : "+s"(v)); __builtin_assume(v >= 0); __builtin_assume(v < 1024); return v; }
__device__ __forceinline__ int nblk_opaque(int v) { asm volatile("" : "+s"(v)); __builtin_assume(v >= 1); __builtin_assume(v <= 1024); return v; }
#define LAS __attribute__((address_space(3)))
#ifndef PROBE
#define PROBE 0
#endif
#define SMEM_BYTES 73728

__device__ __forceinline__ void transpose_tile(const float* __restrict__ src, int lds, bf16_t* __restrict__ dst, int K, int n0, int k0,
                               int gate_skip, float* tile  ) {
  const int tid = tid_opaque();
  const int c = tid & 63, r0 = tid >> 6;
  int n = n0 + c;
  int col = n + ((gate_skip && n >= 2304) ? 8 : 0);
#pragma unroll 4
  for (int j = 0; j < 16; ++j) {
    int r = r0 + 4 * j;
    tile[r * 65 + c] = src[(size_t)(k0 + r) * lds + col];
  }
  __syncthreads();
  const int nn = tid >> 2, kg = (tid & 3) * 16;
  unsigned w[8];
#pragma unroll
  for (int j = 0; j < 8; ++j) w[j] = pack2(tile[(kg + 2 * j) * 65 + nn], tile[(kg + 2 * j + 1) * 65 + nn]);
  uint4* d = reinterpret_cast<uint4*>(dst + (size_t)(n0 + nn) * K + k0 + kg);
  d[0] = make_uint4(w[0], w[1], w[2], w[3]);
  d[1] = make_uint4(w[4], w[5], w[6], w[7]);
  __syncthreads();
}

__device__ __forceinline__ int rel_bucket_dev(int rel) {
  int ret = rel > 0 ? 16 : 0;
  int n = rel < 0 ? -rel : rel;
  int b;
  if (n < 8) b = n;
  else if (n < 12) b = 8;
  else if (n < 16) b = 9;
  else if (n < 23) b = 10;
  else if (n < 32) b = 11;
  else if (n < 46) b = 12;
  else if (n < 64) b = 13;
  else if (n < 91) b = 14;
  else b = 15;
  return ret + b;
}

__device__ __forceinline__ void ph_prep(const Params& p, char* smem, int bid, int nblk) {
  const int tid = tid_opaque();
  float* tile = reinterpret_cast<float*>(smem);
  for (int u = bid; u < 2 * 1472; u += nblk) {
    int l = u / 1472, r = u % 1472;
    if (r < 704) {
      int nt = r / 16, kt = r % 16;
      transpose_tile(p.w_in() + (size_t)l * 1024 * 2824, 2824, p.wt_in() + (size_t)l * NIN * 1024, 1024, nt * 64, kt * 64, 1, tile);
    } else if (r < 960) {
      r -= 704; int nt = r / 16, kt = r % 16;
      transpose_tile(p.w_out() + (size_t)l * 1024 * 1024, 1024, p.wt_out() + (size_t)l * 1024 * 1024, 1024, nt * 64, kt * 64, 0, tile);
    } else {
      r -= 960; int nt = r / 16, kt = r % 16;
      transpose_tile(p.peer_wq() + (size_t)l * 1024 * 2048, 2048, p.wt_pq() + (size_t)l * 2048 * 1024, 1024, nt * 64, kt * 64, 0, tile);
    }
  }
  for (int u = bid; u < 1024; u += nblk) {
    int kt = u & 15, h = (u >> 4) & 3, b = (u >> 6) & 7, l = u >> 9;
    const float* src = p.cache_v() + (((size_t)(l * 8 + b) * 1024 + kt * 64) * 4 + h) * 128;
    {
      int c = tid & 127, r0 = tid >> 7;
      for (int j = 0; j < 32; ++j) { int r = r0 + 2 * j; tile[r * 129 + c] = src[(size_t)r * 512 + c]; }
    }
    __syncthreads();
    {
      int dv = tid >> 1, half = tid & 1;
      bf16_t* dst = p.Vts() + ((size_t)((l * 8 + b) * 4 + h) * 128 + dv) * SKEYS + kt * 64 + half * 32;
      unsigned w[16];
#pragma unroll
      for (int j = 0; j < 16; ++j) {
        int pos0 = half * 32 + 2 * j;
        int blk = (pos0 >> 2) & 3;
        int oblk = (blk == 1) ? 2 : (blk == 2 ? 1 : blk);
        int key0 = (pos0 & ~15) + oblk * 4 + (pos0 & 3);
        w[j] = pack2(tile[key0 * 129 + dv], tile[(key0 + 1) * 129 + dv]);
      }
      uint4* d4 = reinterpret_cast<uint4*>(dst);
      d4[0] = make_uint4(w[0], w[1], w[2], w[3]);
      d4[1] = make_uint4(w[4], w[5], w[6], w[7]);
      d4[2] = make_uint4(w[8], w[9], w[10], w[11]);
      d4[3] = make_uint4(w[12], w[13], w[14], w[15]);
    }
    __syncthreads();
  }
  const size_t gtid = (size_t)bid * 256 + tid, gsz = (size_t)nblk * 256;
  {
    const int lane = tid & 63, wv = tid >> 6;
    for (int r = bid * 4 + wv; r < 2 * 32768; r += nblk * 4) {
      const int tab = r >> 15, row = r & 32767;
      const float* src = (tab == 0 ? p.peer_u() : p.peer_v()) + (size_t)row * 1024 + lane * 16;
      float4 f0 = reinterpret_cast<const float4*>(src)[0], f1 = reinterpret_cast<const float4*>(src)[1];
      float4 f2 = reinterpret_cast<const float4*>(src)[2], f3 = reinterpret_cast<const float4*>(src)[3];
      float am = fmaxf(fmaxf(fmaxf(fabsf(f0.x), fabsf(f0.y)), fmaxf(fabsf(f0.z), fabsf(f0.w))),
                       fmaxf(fmaxf(fabsf(f1.x), fabsf(f1.y)), fmaxf(fabsf(f1.z), fabsf(f1.w))));
      am = fmaxf(am, fmaxf(fmaxf(fmaxf(fabsf(f2.x), fabsf(f2.y)), fmaxf(fabsf(f2.z), fabsf(f2.w))),
                           fmaxf(fmaxf(fabsf(f3.x), fabsf(f3.y)), fmaxf(fabsf(f3.z), fabsf(f3.w)))));
      am = wave_max(am);
      const float sc = am > 0.f ? 224.f / am : 1.f;
      int w0 = 0, w1 = 0, w2 = 0, w3 = 0;
      w0 = __builtin_amdgcn_cvt_pk_fp8_f32(f0.x * sc, f0.y * sc, w0, false); w0 = __builtin_amdgcn_cvt_pk_fp8_f32(f0.z * sc, f0.w * sc, w0, true);
      w1 = __builtin_amdgcn_cvt_pk_fp8_f32(f1.x * sc, f1.y * sc, w1, false); w1 = __builtin_amdgcn_cvt_pk_fp8_f32(f1.z * sc, f1.w * sc, w1, true);
      w2 = __builtin_amdgcn_cvt_pk_fp8_f32(f2.x * sc, f2.y * sc, w2, false); w2 = __builtin_amdgcn_cvt_pk_fp8_f32(f2.z * sc, f2.w * sc, w2, true);
      w3 = __builtin_amdgcn_cvt_pk_fp8_f32(f3.x * sc, f3.y * sc, w3, false); w3 = __builtin_amdgcn_cvt_pk_fp8_f32(f3.z * sc, f3.w * sc, w3, true);
      unsigned char* dst = (tab == 0 ? p.ub8() : p.vb8()) + (size_t)row * 1024 + lane * 16;
      *reinterpret_cast<uint4*>(dst) = make_uint4((unsigned)w0, (unsigned)w1, (unsigned)w2, (unsigned)w3);
      if (lane == 0) (tab == 0 ? p.us() : p.vs())[row] = am > 0.f ? am * (1.f / 224.f) : 1.f;
    }
  }
  {
    const size_t n8 = (size_t)2 * 16 * 128 * 128 / 8;
    for (size_t i = gtid; i < n8; i += gsz) {
      float4 a = reinterpret_cast<const float4*>(p.peer_keys())[2 * i], b = reinterpret_cast<const float4*>(p.peer_keys())[2 * i + 1];
      reinterpret_cast<uint4*>(p.keysb())[i] = make_uint4(pack2(a.x, a.y), pack2(a.z, a.w), pack2(b.x, b.y), pack2(b.z, b.w));
    }
  }
  {
    const size_t n8 = (size_t)2 * 8 * 1024 * 512 / 8;
    for (size_t i = gtid; i < n8; i += gsz) {
      size_t e = i * 8;
      size_t lb = e / (1024 * 512), rem = e % (1024 * 512);
      float4 a = reinterpret_cast<const float4*>(p.cache_k())[2 * i], b = reinterpret_cast<const float4*>(p.cache_k())[2 * i + 1];
      *reinterpret_cast<uint4*>(p.Kbs() + lb * (SKEYS * 512) + rem) = make_uint4(pack2(a.x, a.y), pack2(a.z, a.w), pack2(b.x, b.y), pack2(b.z, b.w));
    }
  }
  for (size_t i = gtid; i < 2 * 8 * 1024; i += gsz) {
    int l = (int)(i / 8192), r = (int)(i % 8192), g = r / 1024, k = r % 1024;
    p.wg()[i] = p.w_in()[((size_t)l * 1024 + k) * 2824 + 2304 + g];
  }
  {
    float* sp = reinterpret_cast<float*>(p.ws + WS_sp);
    for (size_t i = gtid; i < 262144; i += gsz) sp[SP_st_c + i] = p.in[4][i];
    for (size_t i = gtid; i < 4096; i += gsz) sp[SP_st_n + i] = p.in[5][i];
    for (size_t i = gtid; i < 64; i += gsz) sp[SP_st_m + i] = p.in[6][i];
    for (size_t i = gtid; i < 12288; i += gsz) sp[SP_st_conv + i] = p.in[7][i];
    for (size_t i = gtid; i < 2048; i += gsz) sp[SP_norm1_g + i] = p.in[8][i];
    for (size_t i = gtid; i < 256; i += gsz) sp[SP_da_subln_g + i] = p.in[11][i];
    for (size_t i = gtid; i < 2048; i += gsz) sp[SP_ml_conv_w + i] = p.in[13][i];
    for (size_t i = gtid; i < 512; i += gsz) sp[SP_ml_conv_b + i] = p.in[14][i];
    for (size_t i = gtid; i < 32768; i += gsz) sp[SP_ml_wq + i] = p.in[15][i];
    for (size_t i = gtid; i < 32768; i += gsz) sp[SP_ml_wk + i] = p.in[16][i];
    for (size_t i = gtid; i < 16; i += gsz) sp[SP_ml_gate_b + i] = p.in[17][i];
    for (size_t i = gtid; i < 512; i += gsz) sp[SP_ml_norm_g + i] = p.in[18][i];
    for (size_t i = gtid; i < 512; i += gsz) sp[SP_ml_skip + i] = p.in[19][i];
    for (size_t i = gtid; i < 512; i += gsz) sp[SP_cm_norm_g + i] = p.in[20][i];
    for (size_t i = gtid; i < 131072; i += gsz) sp[SP_cm_ws + i] = p.in[21][i];
    for (size_t i = gtid; i < 1024; i += gsz) sp[SP_cm_b + i] = p.in[22][i];
    for (size_t i = gtid; i < 2048; i += gsz) sp[SP_norm2_g + i] = p.in[24][i];
    for (size_t i = gtid; i < 1024; i += gsz) sp[SP_final_g + i] = p.in[29][i];
  }
  if (bid == 0) {
    for (int i = tid; i < 4 * 256; i += 256) {
      int h = i >> 8, j = i & 255;
      int rel = j - 191; if (rel > 63) rel = 63;
      p.lut()[i] = p.rel_table()[rel_bucket_dev(rel) * 4 + h] * LOG2E;
    }
    if (tid < 2) {
      const float* lp = p.da_lambda() + tid * 256;
      float s01 = 0.f, s23 = 0.f;
      for (int d = 0; d < 64; ++d) { s01 += lp[d] * lp[64 + d]; s23 += lp[128 + d] * lp[192 + d]; }
      float lam_init = 0.8f - 0.6f * expf(-0.3f * (float)tid);
      p.lam()[tid] = expf(s01) - expf(s23) + lam_init;
    }
  }
}

template <int MODE>
__device__ __forceinline__ void ph_rmsnorm(const Params& p, int l, int bid, int nblk) {
  const int lane = tid_opaque() & 63, w = tid_opaque() >> 6;
  const float* g = (MODE == 0) ? p.norm1_g() + l * 1024 : (MODE == 1 ? p.norm2_g() + l * 1024 : p.final_g());
  float4 gv[4];
#pragma unroll
  for (int j = 0; j < 4; ++j) gv[j] = reinterpret_cast<const float4*>(g)[lane + 64 * j];
  for (int t = bid * 4 + w; t < NTOK; t += nblk * 4) {
    const float* xr = (MODE == 0) ? xrow_in(p, l, t) : p.x() + (size_t)t * 1024;
    float4 xv[4];
    float ss = 0.f;
#pragma unroll
    for (int j = 0; j < 4; ++j) {
      xv[j] = reinterpret_cast<const float4*>(xr)[lane + 64 * j];
      ss += xv[j].x * xv[j].x + xv[j].y * xv[j].y + xv[j].z * xv[j].z + xv[j].w * xv[j].w;
    }
    ss = wave_sum(ss);
    float r = rsqrtf(ss * (1.f / 1024.f) + EPS);
#pragma unroll
    for (int j = 0; j < 4; ++j) {
      xv[j].x *= r * gv[j].x; xv[j].y *= r * gv[j].y; xv[j].z *= r * gv[j].z; xv[j].w *= r * gv[j].w;
    }
    if (MODE == 2) {
      float* o = (t < NPROMPT) ? p.out + O_Y_P + (size_t)t * 1024 : p.out + O_Y_S + (size_t)(t - NPROMPT) * 1024;
#pragma unroll
      for (int j = 0; j < 4; ++j) reinterpret_cast<float4*>(o)[lane + 64 * j] = xv[j];
    } else {
      uint2* o = reinterpret_cast<uint2*>(p.xn() + (size_t)t * 1024);
#pragma unroll
      for (int j = 0; j < 4; ++j) o[lane + 64 * j] = make_uint2(pack2(xv[j].x, xv[j].y), pack2(xv[j].z, xv[j].w));
    }
    if (MODE == 0) {
      float pre[8];
#pragma unroll
      for (int i = 0; i < 8; ++i) {
        const float4* wr = reinterpret_cast<const float4*>(p.wg() + ((size_t)l * 8 + i) * 1024);
        float s = 0.f;
#pragma unroll
        for (int j = 0; j < 4; ++j) {
          float4 wv = wr[lane + 64 * j];
          s += xv[j].x * wv.x + xv[j].y * wv.y + xv[j].z * wv.z + xv[j].w * wv.w;
        }
        pre[i] = wave_sum(s);
      }
      if (lane < 4) {
        float a = pre[0]; a = lane == 1 ? pre[1] : a; a = lane == 2 ? pre[2] : a; a = lane == 3 ? pre[3] : a;
        float f = pre[4]; f = lane == 1 ? pre[5] : f; f = lane == 2 ? pre[6] : f; f = lane == 3 ? pre[7] : f;
        p.ig()[(size_t)t * 4 + lane] = a + p.ml_gate_b()[l * 8 + lane];
        float z = f + p.ml_gate_b()[l * 8 + 4 + lane];
        p.lf()[(size_t)t * 4 + lane] = fminf(z, 0.f) - log1pf(expf(-fabsf(z)));
      }
    }
  }
}

enum { EPI_WIN = 0, EPI_WOUT = 1, EPI_PQ = 2, EPI_SC = 3 };

template <int EPI>
__device__ __forceinline__ void gemm_store(const Params& p, int l, int t, int n, float v) {
  if (EPI == EPI_WOUT) {
    const float* xi = xrow_in(p, l, t);
    p.x()[(size_t)t * 1024 + n] = xi[n] + v;
  } else if (EPI == EPI_PQ) {
    p.qp()[(size_t)t * 2048 + n] = f2bf(v);
  } else if (EPI == EPI_SC) {
    p.sc()[(size_t)t * 2048 + n] = v;
  }
}

template <int EPI>
__device__ __forceinline__ void ph_gemm(const Params& p, int l, char* smem, int bid, int nblk) {
  constexpr int NT = (EPI == EPI_WIN) ? 22 : (EPI == EPI_WOUT ? 8 : 16);
  constexpr int MT = NTOK / 128;
  constexpr int K = (EPI == EPI_SC) ? 128 : 1024;
  constexpr int NK = K / 64;
  const bf16_t* A; int lda; const bf16_t* Bt; int ldb;
  if (EPI == EPI_WIN) { A = p.xn(); lda = 1024; Bt = p.wt_in() + (size_t)l * NIN * 1024; ldb = 1024; }
  else if (EPI == EPI_WOUT) { A = p.xn(); lda = 1024; Bt = p.wt_out() + (size_t)l * 1024 * 1024; ldb = 1024; }
  else if (EPI == EPI_PQ) { A = p.xn(); lda = 1024; Bt = p.wt_pq() + (size_t)l * 2048 * 1024; ldb = 1024; }
  else { A = p.qp(); lda = 2048; Bt = p.keysb() + (size_t)l * 16 * 128 * 128; ldb = 128; }

  const int tid = tid_opaque(), lane = tid & 63, w = tid >> 6;
  const int wm = w >> 1, wn = w & 1, lr = lane & 31, lh = lane >> 5;
  char* sA = smem;
  char* sB = smem + 32768;
  const int ld_c = tid & 7, ld_r = tid >> 3;

  const int nx = nblk >> 3;
  constexpr int FG = MT / 8, LR = MT % 8;
  for (int rnd = 0;; ++rnd) {
    const int q = (nblk & 7) ? rnd * nblk + bid : rnd * nblk + (bid & 7) * nx + (bid >> 3);
    if (q >= MT * NT) break;
    int mt, nt;
    if (q < FG * 8 * NT) { const int mg = q / (8 * NT), rem = q % (8 * NT); nt = rem >> 3; mt = mg * 8 + (rem & 7); }
    else { const int q2 = q - FG * 8 * NT; nt = q2 / (LR > 0 ? LR : 1); mt = FG * 8 + q2 % (LR > 0 ? LR : 1); }
    const bf16_t* Ag = A + (size_t)(mt * 128) * lda + ((EPI == EPI_SC) ? nt * 128 : 0);
    const bf16_t* Bg = Bt + (size_t)(nt * 128) * ldb;
    f32x16 acc[2][2];
#pragma unroll
    for (int i = 0; i < 2; ++i)
#pragma unroll
      for (int j = 0; j < 2; ++j)
#pragma unroll
        for (int r = 0; r < 16; ++r) acc[i][j][r] = 0.f;

    const int g_row = w * 32 + (lane >> 3);
    const int g_pc = lane & 7;
    const bf16_t* Ath = Ag + (size_t)g_row * lda;
    const bf16_t* Bth = Bg + (size_t)g_row * ldb;
#define GEMM_STAGE(KT, BUF)                                                                                          \
  _Pragma("unroll") for (int j = 0; j < 4; ++j) {                                                                    \
    const int row = g_row + 8 * j;                                                                                   \
    const int cch = g_pc ^ ((row >> 1) & 7);                                                                         \
    __builtin_amdgcn_global_load_lds((const unsigned*)(Ath + (size_t)(8 * j) * lda + (KT) * 64 + cch * 8),           \
                                     (LAS unsigned*)(sA + (BUF) * 16384 + (w * 4 + j) * 1024 + lane * 16), 16, 0, 0); \
    __builtin_amdgcn_global_load_lds((const unsigned*)(Bth + (size_t)(8 * j) * ldb + (KT) * 64 + cch * 8),           \
                                     (LAS unsigned*)(sB + (BUF) * 16384 + (w * 4 + j) * 1024 + lane * 16), 16, 0, 0); \
  }
    GEMM_STAGE(0, 0)
    __syncthreads();
    for (int kt = 0; kt < NK; ++kt) {
      const int buf = kt & 1;
      if (kt + 1 < NK) { GEMM_STAGE(kt + 1, buf ^ 1) }
      const char* cA = sA + buf * 16384;
      const char* cB = sB + buf * 16384;
#pragma unroll
      for (int ks = 0; ks < 4; ++ks) {
        bf16x8 af[2], bfr[2];
#pragma unroll
        for (int i = 0; i < 2; ++i) {
          int row = wm * 64 + i * 32 + lr; int pc = (ks * 2 + lh) ^ ((row >> 1) & 7);
          af[i] = as_bf16x8(*reinterpret_cast<const uint4*>(cA + row * 128 + pc * 16));
        }
#pragma unroll
        for (int j = 0; j < 2; ++j) {
          int row = wn * 64 + j * 32 + lr; int pc = (ks * 2 + lh) ^ ((row >> 1) & 7);
          bfr[j] = as_bf16x8(*reinterpret_cast<const uint4*>(cB + row * 128 + pc * 16));
        }
#pragma unroll
        for (int i = 0; i < 2; ++i)
#pragma unroll
          for (int j = 0; j < 2; ++j)
            acc[i][j] = __builtin_amdgcn_mfma_f32_32x32x16_bf16(af[i], bfr[j], acc[i][j], 0, 0, 0);
      }
      __syncthreads();
    }
    if (EPI == EPI_PQ) {
      int lane_q = lane; asm volatile("" : "+v"(lane_q));
      const int lr = lane_q & 31, lh = lane_q >> 5;
      char* sA2 = smem;
      char* sB2 = smem + 32768;
      const bf16_t* kg = p.keysb() + ((size_t)l * 16 + nt) * 128 * 128;
#pragma unroll
      for (int jj = 0; jj < 8; ++jj) {
        const int I = w * 8 + jj;
        const int row = I * 4 + (lane_q >> 4);
        const int cch = (lane_q & 15) ^ (row & 15);
        __builtin_amdgcn_global_load_lds((const unsigned*)(kg + (size_t)row * 128 + cch * 8),
                                         (LAS unsigned*)(sB2 + I * 1024 + lane_q * 16), 16, 0, 0);
      }
#pragma unroll
      for (int i = 0; i < 2; ++i) {
        float rs[16];
#pragma unroll
        for (int r = 0; r < 16; ++r) rs[r] = 0.f;
#pragma unroll
        for (int j = 0; j < 2; ++j) {
          const int n = wn * 64 + j * 32 + lr;
#pragma unroll
          for (int r = 0; r < 16; ++r) {
            const int row = wm * 64 + i * 32 + (r & 3) + 8 * (r >> 2) + 4 * lh;
            const float v = acc[i][j][r];
            rs[r] += v * v;
            *reinterpret_cast<bf16_t*>(sA2 + row * 256 + (((n >> 3) ^ (row & 15)) * 16) + (n & 7) * 2) = f2bf(v);
          }
        }
#pragma unroll
        for (int r = 0; r < 16; ++r) {
          const float s = swap16_sum(row16_sum(rs[r]));
          if (lr == 0) {
            const int t = mt * 128 + wm * 64 + i * 32 + (r & 3) + 8 * (r >> 2) + 4 * lh;
            p.ssp()[(size_t)t * 32 + nt * 2 + wn] = s;
          }
        }
      }
      __syncthreads();
      f32x16 sc2[2][2];
#pragma unroll
      for (int i = 0; i < 2; ++i)
#pragma unroll
        for (int j = 0; j < 2; ++j)
#pragma unroll
          for (int r = 0; r < 16; ++r) sc2[i][j][r] = 0.f;
#pragma unroll
      for (int ks = 0; ks < 8; ++ks) {
        bf16x8 af[2], bfr[2];
#pragma unroll
        for (int i = 0; i < 2; ++i) {
          const int row = wm * 64 + i * 32 + lr;
          af[i] = as_bf16x8(*reinterpret_cast<const uint4*>(sA2 + row * 256 + (((ks * 2 + lh) ^ (row & 15)) * 16)));
        }
#pragma unroll
        for (int j = 0; j < 2; ++j) {
          const int row = wn * 64 + j * 32 + lr;
          bfr[j] = as_bf16x8(*reinterpret_cast<const uint4*>(sB2 + row * 256 + (((ks * 2 + lh) ^ (row & 15)) * 16)));
        }
#pragma unroll
        for (int i = 0; i < 2; ++i)
#pragma unroll
          for (int j = 0; j < 2; ++j)
            sc2[i][j] = __builtin_amdgcn_mfma_f32_32x32x16_bf16(af[i], bfr[j], sc2[i][j], 0, 0, 0);
      }
#pragma unroll
      for (int i = 0; i < 2; ++i)
#pragma unroll
        for (int j = 0; j < 2; ++j)
#pragma unroll
          for (int r = 0; r < 16; ++r) {
            const int t = mt * 128 + wm * 64 + i * 32 + (r & 3) + 8 * (r >> 2) + 4 * lh;
            p.sc()[(size_t)t * 2048 + nt * 128 + wn * 64 + j * 32 + lr] = sc2[i][j][r];
          }
      __syncthreads();
    } else if (EPI != EPI_WIN) {
#pragma unroll
      for (int i = 0; i < 2; ++i)
#pragma unroll
        for (int j = 0; j < 2; ++j)
#pragma unroll
          for (int r = 0; r < 16; ++r) {
            int t = mt * 128 + wm * 64 + i * 32 + (r & 3) + 8 * (r >> 2) + 4 * lh;
            int n = nt * 128 + wn * 64 + j * 32 + lr;
            gemm_store<EPI>(p, l, t, n, acc[i][j][r]);
          }
    } else {
      const int seg = nt >> 2;
#pragma unroll
      for (int i = 0; i < 2; ++i)
#pragma unroll
        for (int j = 0; j < 2; ++j) {
          const int n = nt * 128 + wn * 64 + j * 32 + lr;
          if (nt < 4) {
#pragma unroll
            for (int r = 0; r < 16; ++r) {
              int t = mt * 128 + wm * 64 + i * 32 + (r & 3) + 8 * (r >> 2) + 4 * lh;
              p.Qb()[(size_t)t * 512 + n] = f2bf(acc[i][j][r] * (0.125f * LOG2E));
            }
          } else if (nt < 8) {
            const int n2 = n - 512;
#pragma unroll
            for (int r = 0; r < 16; ++r) {
              int t = mt * 128 + wm * 64 + i * 32 + (r & 3) + 8 * (r >> 2) + 4 * lh;
              float v = acc[i][j][r];
              if (t < NPROMPT) {
                p.out[O_K_P + (size_t)l * (4 * 4096 * 512) + (size_t)t * 512 + n2] = v;
                p.Kb()[(size_t)t * 512 + n2] = f2bf(v);
              } else {
                int ts = t - NPROMPT, b = ts >> 6, ii = ts & 63;
                p.out[O_K_S + (size_t)l * (8 * 64 * 512) + (size_t)ts * 512 + n2] = v;
                p.Kbs()[((size_t)(l * 8 + b) * SKEYS + 1024 + ii) * 512 + n2] = f2bf(v);
              }
            }
          } else if (nt < 12) {
            const int n2 = n - 1024, h = n2 >> 7, dv = n2 & 127;
#pragma unroll
            for (int rg = 0; rg < 4; ++rg) {
              int tb = mt * 128 + wm * 64 + i * 32 + 8 * rg + 4 * lh;
              float v0 = acc[i][j][rg * 4 + 0], v1 = acc[i][j][rg * 4 + 1], v2 = acc[i][j][rg * 4 + 2], v3 = acc[i][j][rg * 4 + 3];
              uint2 pk = make_uint2(pack2(v0, v1), pack2(v2, v3));
              int posblk = 2 * lh + (rg & 1);
              if (tb < NPROMPT) {
                float* o = p.out + O_V_P + (size_t)l * (4 * 4096 * 512) + (size_t)tb * 512 + n2;
                o[0] = v0; o[512] = v1; o[1024] = v2; o[1536] = v3;
                int b = tb >> 12, s = tb & 4095;
                int pos = (s & ~15) + posblk * 4;
                *reinterpret_cast<uint2*>(p.Vt() + ((size_t)(b * 4 + h) * 128 + dv) * SEQ + pos) = pk;
              } else {
                int ts = tb - NPROMPT, b = ts >> 6, ii = ts & 63;
                float* o = p.out + O_V_S + (size_t)l * (8 * 64 * 512) + (size_t)ts * 512 + n2;
                o[0] = v0; o[512] = v1; o[1024] = v2; o[1536] = v3;
                int pos = 1024 + (ii & ~15) + posblk * 4;
                *reinterpret_cast<uint2*>(p.Vts() + ((size_t)((l * 8 + b) * 4 + h) * 128 + dv) * SKEYS + pos) = pk;
              }
            }
          } else {
            const int n2 = n - 1536;
            const bool act = (n >= 2304);
#pragma unroll
            for (int r = 0; r < 16; ++r) {
              int t = mt * 128 + wm * 64 + i * 32 + (r & 3) + 8 * (r >> 2) + 4 * lh;
              float v = acc[i][j][r];
              if (act) v = gelu_exact(v);
              p.P5()[(size_t)t * 1280 + n2] = v;
            }
          }
        }
      (void)seg;
    }
  }
}

__device__ __forceinline__ void ph_attn(const Params& p, int l, char* smem, int bid, int nblk) {
  const int tid = tid_opaque(), lane = tid & 63, w = tid >> 6;
  const int c = w >> 1, qhalf = w & 1, lr = lane & 31, lh = lane >> 5;
  float* sLut = reinterpret_cast<float*>(smem + 65536);
  float* sO2 = reinterpret_cast<float*>(smem);
  const float lam = p.lam()[l];
  const float lam_init = 0.8f - 0.6f * expf(-0.3f * (float)l);

  for (int uu = bid; uu < 1056; uu += nblk) {
    int b, h, qc, S, qrow0; const bf16_t *Kbase, *Vbase;
    bool samp = false; int u2 = uu;
    if (uu >= 752 && uu < 784) samp = true; else if (uu >= 784) u2 = uu - 32;
    if (!samp) {
      qc = 63 - (u2 >> 4); int bh = u2 & 15; b = bh >> 2; h = bh & 3; S = SEQ;
      Kbase = p.Kb() + (size_t)b * SEQ * 512 + h * 128;
      Vbase = p.Vt() + (size_t)(b * 4 + h) * 128 * SEQ;
      qrow0 = b * SEQ + qc * 64;
    } else {
      int us = uu - 752; b = us >> 2; h = us & 3; qc = 16; S = SKEYS;
      Kbase = p.Kbs() + (size_t)(l * 8 + b) * SKEYS * 512 + h * 128;
      Vbase = p.Vts() + (size_t)((l * 8 + b) * 4 + h) * 128 * SKEYS;
      qrow0 = NPROMPT + b * 64;
    }
    const int ntiles = qc + 1;
    __syncthreads();
    sLut[tid] = p.lut()[h * 256 + tid];
    if (tid < 128) sLut[256 + tid] = p.da_subln_g()[l * 128 + tid];
    bf16x8 qf[4];
    {
      const bf16_t* qrow = p.Qb() + (size_t)(qrow0 + qhalf * 32 + lr) * 512 + h * 128 + c * 64 + lh * 8;
#pragma unroll
      for (int ks = 0; ks < 4; ++ks) qf[ks] = as_bf16x8(*reinterpret_cast<const uint4*>(qrow + ks * 16));
    }
    f32x16 o[4];
#pragma unroll
    for (int d = 0; d < 4; ++d)
#pragma unroll
      for (int r = 0; r < 16; ++r) o[d][r] = 0.f;
    float m_run = -1e30f, l_run = 0.f;
    const float c15 = p.lut()[h * 256];

    const char* Kt = reinterpret_cast<const char*>(Kbase);
    const char* Vb = reinterpret_cast<const char*>(Vbase);
    const int g_r8 = lane >> 3, g_pc = lane & 7;
#define ATTN_STAGE(KT, BUF)                                                                                         \
  _Pragma("unroll") for (int j = 0; j < 4; ++j) {                                                                   \
    const int I = w * 4 + j;                                                                                        \
    const int rk = (I & 7) * 8 + g_r8;                                                                              \
    const unsigned kof = (unsigned)rk * 1024u + (unsigned)(I >> 3) * 128u + (unsigned)((g_pc ^ ((rk >> 1) & 7)) * 16); \
    __builtin_amdgcn_global_load_lds((const unsigned*)(Kt + (size_t)(KT) * 65536 + kof),                            \
                                     (LAS unsigned*)(smem + (BUF) * 32768 + I * 1024 + lane * 16), 16, 0, 0);       \
    const int rv = I * 8 + g_r8;                                                                                    \
    const unsigned vof = (unsigned)rv * (unsigned)(S * 2) + (unsigned)((g_pc ^ ((rv >> 1) & 7)) * 16);              \
    __builtin_amdgcn_global_load_lds((const unsigned*)(Vb + (size_t)(KT) * 128 + vof),                              \
                                     (LAS unsigned*)(smem + (BUF) * 32768 + 16384 + I * 1024 + lane * 16), 16, 0, 0); \
  }
    ATTN_STAGE(0, 0)
    __syncthreads();
    for (int kt = 0; kt < ntiles; ++kt) {
      const int buf = kt & 1;
      if (kt + 1 < ntiles) { ATTN_STAGE(kt + 1, buf ^ 1) }
      const char* sK = smem + buf * 32768;
      const char* sV = sK + 16384;
      f32x16 s[2];
      {
        bf16x8 kf[2][4];
#pragma unroll
        for (int kb = 0; kb < 2; ++kb)
#pragma unroll
          for (int ks = 0; ks < 4; ++ks) {
            int row = kb * 32 + lr; int pc = (ks * 2 + lh) ^ ((row >> 1) & 7);
            kf[kb][ks] = as_bf16x8(*reinterpret_cast<const uint4*>(sK + c * 8192 + row * 128 + pc * 16));
          }
        __builtin_amdgcn_sched_barrier(0);
#pragma unroll
        for (int kb = 0; kb < 2; ++kb) {
#pragma unroll
          for (int r = 0; r < 16; ++r) s[kb][r] = 0.f;
#pragma unroll
          for (int ks = 0; ks < 4; ++ks) s[kb] = __builtin_amdgcn_mfma_f32_32x32x16_bf16(kf[kb][ks], qf[ks], s[kb], 0, 0, 0);
        }
      }
      bf16x8 vfa[2][4];
#pragma unroll
      for (int k2 = 0; k2 < 2; ++k2)
#pragma unroll
        for (int d = 0; d < 4; ++d) {
          int row = d * 32 + lr; int pc = (k2 * 2 + lh) ^ ((row >> 1) & 7);
          vfa[k2][d] = as_bf16x8(*reinterpret_cast<const uint4*>(sV + row * 128 + pc * 16));
        }
      __builtin_amdgcn_sched_barrier(0);
      float boff = c15;
      if (kt >= qc - 2) {
        const int base = (kt - qc) * 64 - (qhalf * 32 + lr) + 191 + 4 * lh;
#pragma unroll
        for (int kb = 0; kb < 2; ++kb)
#pragma unroll
          for (int r = 0; r < 16; ++r) s[kb][r] += sLut[base + kb * 32 + (r & 3) + 8 * (r >> 2)];
        boff = 0.f;
      }
      float mx = s[0][0];
#pragma unroll
      for (int kb = 0; kb < 2; ++kb)
#pragma unroll
        for (int r = 0; r < 16; ++r) mx = fmaxf(mx, s[kb][r]);
      mx = swap32_max(mx) + boff;
      if (__any(mx > m_run)) {
        const float m_new = fmaxf(m_run, mx);
        const float alpha = __builtin_amdgcn_exp2f(m_run - m_new);
        m_run = m_new;
        l_run *= alpha;
#pragma unroll
        for (int d = 0; d < 4; ++d)
#pragma unroll
          for (int r = 0; r < 16; ++r) o[d][r] *= alpha;
      }
      const float eoff = boff - m_run;
      float ps = 0.f;
#pragma unroll
      for (int kb = 0; kb < 2; ++kb)
#pragma unroll
        for (int r = 0; r < 16; ++r) { float pv = __builtin_amdgcn_exp2f(s[kb][r] + eoff); s[kb][r] = pv; ps += pv; }
      l_run += ps;
      bf16x8 pf[4];
#pragma unroll
      for (int ks2 = 0; ks2 < 4; ++ks2) {
        const int kb = ks2 >> 1, sh = (ks2 & 1) * 8;
        uint4 pw = make_uint4(pack2(s[kb][sh + 0], s[kb][sh + 1]), pack2(s[kb][sh + 2], s[kb][sh + 3]),
                              pack2(s[kb][sh + 4], s[kb][sh + 5]), pack2(s[kb][sh + 6], s[kb][sh + 7]));
        pf[ks2] = as_bf16x8(pw);
      }
      __builtin_amdgcn_sched_barrier(0);
#define ATTN_VREAD(DST, K2)                                                                        \
  _Pragma("unroll") for (int d = 0; d < 4; ++d) {                                                  \
    int row = d * 32 + lr; int pc = ((K2) * 2 + lh) ^ ((row >> 1) & 7);                            \
    DST[d] = as_bf16x8(*reinterpret_cast<const uint4*>(sV + row * 128 + pc * 16));                 \
  }
#define ATTN_PV(SRC, K2) \
  _Pragma("unroll") for (int d = 0; d < 4; ++d) o[d] = __builtin_amdgcn_mfma_f32_32x32x16_bf16(SRC[d], pf[K2], o[d], 0, 0, 0);
      bf16x8 vfc[4];
      ATTN_VREAD(vfc, 2)
      ATTN_PV(vfa[0], 0)
      __builtin_amdgcn_sched_barrier(0);
      ATTN_VREAD(vfa[0], 3)
      ATTN_PV(vfa[1], 1)
      __builtin_amdgcn_sched_barrier(0);
      ATTN_PV(vfc, 2)
      ATTN_PV(vfa[0], 3)
      __syncthreads();
    }
    int lane_e = lane; asm volatile("" : "+v"(lane_e));
    const int lr_e = lane_e & 31, lh_e = lane_e >> 5;
    float lt = swap32_sum(l_run);
    float inv = 1.f / lt;
    __syncthreads();
    if (c == 1) {
#pragma unroll
      for (int d = 0; d < 4; ++d)
#pragma unroll
        for (int r = 0; r < 16; ++r) sO2[(qhalf * 64 + d * 16 + r) * 64 + lane_e] = o[d][r] * inv;
    }
    __syncthreads();
    if (c == 0) {
      float ss = 0.f;
#pragma unroll
      for (int d = 0; d < 4; ++d)
#pragma unroll
        for (int r = 0; r < 16; ++r) {
          float v = o[d][r] * inv - lam * sO2[(qhalf * 64 + d * 16 + r) * 64 + lane_e];
          o[d][r] = v; ss += v * v;
        }
      ss = swap32_sum(ss);
      const float rn = rsqrtf(ss * (1.f / 128.f) + EPS) * (1.f - lam_init);
      const float* gs = sLut + 256;
      bf16_t* orow = p.xn() + (size_t)(qrow0 + qhalf * 32 + lr_e) * 1024 + h * 128;
#pragma unroll
      for (int d = 0; d < 4; ++d)
#pragma unroll
        for (int rg = 0; rg < 4; ++rg) {
          int dv = d * 32 + 8 * rg + 4 * lh_e;
          float4 g4 = *reinterpret_cast<const float4*>(gs + dv);
          uint2 pk = make_uint2(pack2(o[d][rg * 4 + 0] * rn * g4.x, o[d][rg * 4 + 1] * rn * g4.y),
                                pack2(o[d][rg * 4 + 2] * rn * g4.z, o[d][rg * 4 + 3] * rn * g4.w));
          *reinterpret_cast<uint2*>(orow + dv) = pk;
        }
    }
  }
}


template <int K>
__device__ __forceinline__ void mfma32_f32(f32x16& acc, const float* a, int a_rs, int a_ks, const float* b, int b_ks, int b_js, int lane) {
  const float* ap = a + (lane & 31) * a_rs + (lane >> 5) * a_ks;
  const float* bp = b + (lane >> 5) * b_ks + (lane & 31) * b_js;
#pragma unroll 8
  for (int k = 0; k < K; k += 2) acc = __builtin_amdgcn_mfma_f32_32x32x2f32(ap[k * a_ks], bp[k * b_ks], acc, 0, 0, 0);
}
__device__ __forceinline__ void zero16(f32x16& a) {
#pragma unroll
  for (int r = 0; r < 16; ++r) a[r] = 0.f;
}

__device__ __forceinline__ void ph_mlconv(const Params& p, int l, char* smem, int bid, int nblk) {
  const int tid = tid_opaque();
  float* s_mc = reinterpret_cast<float*>(smem);
  float* s_cc = s_mc + 67 * 64;
  float* s_wq = s_cc + 64 * 65;
  float* s_wk = s_wq + 4096;
  for (int u = bid; u < 264 * 4; u += nblk) {
    const int ci = u >> 2, h = u & 3;
    int token0, bq; bool samp = ci >= 256;
    if (!samp) token0 = ci * 64; else token0 = NPROMPT + (ci - 256) * 64;
    bq = samp ? (ci - 256) : (ci >> 6);
    const int cidx = samp ? 0 : (ci & 63);
    __syncthreads();
    for (int i = tid; i < 67 * 64; i += 256) {
      int r = i >> 6, d = i & 63;
      float v;
      if (r >= 3) v = p.P5()[(size_t)(token0 + r - 3) * 1280 + h * 64 + d];
      else if (samp) v = p.st_conv()[((size_t)(l * 8 + bq) * 3 + r) * 256 + h * 64 + d];
      else if (cidx == 0) v = 0.f;
      else v = p.P5()[(size_t)(token0 + r - 3) * 1280 + h * 64 + d];
      s_mc[i] = v;
    }
    for (int i = tid; i < 4096; i += 256) {
      s_wq[i] = p.ml_wq()[(size_t)(l * 4 + h) * 4096 + i];
      s_wk[i] = p.ml_wk()[(size_t)(l * 4 + h) * 4096 + i];
    }
    __syncthreads();
    {
      const int d = tid & 63, t0 = tid >> 6;
      const int ch = h * 64 + d;
      const float w0 = p.ml_conv_w()[(l * 4 + 0) * 256 + ch], w1 = p.ml_conv_w()[(l * 4 + 1) * 256 + ch];
      const float w2 = p.ml_conv_w()[(l * 4 + 2) * 256 + ch], w3 = p.ml_conv_w()[(l * 4 + 3) * 256 + ch];
      const float bb = p.ml_conv_b()[l * 256 + ch];
      for (int t = t0; t < 64; t += 4) {
        float y = bb + w0 * s_mc[t * 64 + d] + w1 * s_mc[(t + 1) * 64 + d] + w2 * s_mc[(t + 2) * 64 + d] + w3 * s_mc[(t + 3) * 64 + d];
        y = y * sigmoidf_(y);
        s_cc[t * 65 + d] = y;
        p.cc()[(size_t)(token0 + t) * 256 + ch] = y;
      }
      if (samp || cidx == 63) {
        if (tid < 192) {
          int r = tid >> 6;
          float v = s_mc[(64 + r) * 64 + d];
          if (samp) p.out[O_CONV_S + ((size_t)(l * 8 + bq) * 3 + r) * 256 + ch] = v;
          else p.out[O_CONV_P + ((size_t)(l * 4 + bq) * 3 + r) * 256 + ch] = v;
        }
      }
    }
    __syncthreads();
    {
      const int lane = tid & 63, w = tid >> 6, ti = w >> 1, tj = w & 1;
      f32x16 aq, ak; zero16(aq); zero16(ak);
      mfma32_f32<64>(aq, s_cc + ti * 32 * 65, 65, 1, s_wq + tj * 32, 64, 1, lane);
      mfma32_f32<64>(ak, s_cc + ti * 32 * 65, 65, 1, s_wk + tj * 32, 64, 1, lane);
#pragma unroll
      for (int r = 0; r < 16; ++r) {
        const int t = ti * 32 + (r & 3) + 8 * (r >> 2) + 4 * (lane >> 5);
        const size_t o = (size_t)(token0 + t) * 256 + h * 64 + tj * 32 + (lane & 31);
        p.qm()[o] = aq[r];
        p.km()[o] = ak[r] * 0.125f;
      }
      if (w == 0) {
        const int t = token0 + lane;
        const float lfv = p.lf()[(size_t)t * 4 + h], igv = p.ig()[(size_t)t * 4 + h];
        float F = lfv;
#pragma unroll
        for (int d = 1; d < 64; d <<= 1) { float n = __shfl_up(F, d); if (lane >= d) F += n; }
        const float FL = __shfl(F, 63);
        const float mx = wave_max(FL - F + igv);
        p.Fc()[(size_t)t * 4 + h] = F;
        if (lane == 0) {
          const int cu = samp ? 1024 + bq * 4 + h : (bq * 4 + h) * 64 + cidx;
          p.FLs()[cu] = FL; p.mxt()[cu] = mx;
        }
      }
    }
  }
}

__device__ __forceinline__ void cu_decode(int cu, int& token0, int& h) {
  if (cu < 1024) { int bh = cu >> 6, c = cu & 63; token0 = (bh >> 2) * SEQ + c * 64; h = bh & 3; }
  else { int us = cu - 1024; token0 = NPROMPT + (us >> 2) * 64; h = us & 3; }
}

__device__ __forceinline__ void ph_mlU(const Params& p, int l, char* smem, int bid, int nblk) {
  const int tid = tid_opaque();
  const int lane = tid & 63, w = tid >> 6, ti = w >> 1, tj = w & 1;
  float* s_k = reinterpret_cast<float*>(smem);
  float* s_v = s_k + 4096;
  for (int cu = bid; cu < NCU_UNITS; cu += nblk) {
    int token0, h; cu_decode(cu, token0, h);
    float m0, mn, FL;
    {
      const bool samp = cu >= 1024;
      const int cu0 = samp ? cu : (cu & ~63), c = samp ? 0 : (cu & 63);
      float flv = 0.f, mxv = 0.f;
      if (lane <= c) { flv = p.FLs()[cu0 + lane]; mxv = p.mxt()[cu0 + lane]; }
      float m = samp ? p.st_m()[l * 32 + (cu - 1024)] : 0.f;
      for (int j = 0; j < c; ++j) {
        const float fj = __int_as_float(__builtin_amdgcn_readlane(__float_as_int(flv), j));
        const float xj = __int_as_float(__builtin_amdgcn_readlane(__float_as_int(mxv), j));
        m = fmaxf(fj + m, xj);
      }
      FL = __int_as_float(__builtin_amdgcn_readlane(__float_as_int(flv), c));
      const float xc = __int_as_float(__builtin_amdgcn_readlane(__float_as_int(mxv), c));
      m0 = m; mn = fmaxf(FL + m, xc);
      if (tid == 0) {
        p.mst()[cu] = m0; p.mnx()[cu] = mn; p.wcs()[cu] = expf(FL + m0 - mn);
        if (samp) p.out[O_M_S + l * 32 + (cu - 1024)] = mn;
        else if (c == 63) p.out[O_M_P + l * 16 + (cu >> 6)] = mn;
      }
    }
    __syncthreads();
    for (int i = tid; i < 1024; i += 256) {
      int s = i >> 4, d4 = (i & 15) * 4;
      const int t = token0 + s;
      float wsv = expf(FL - p.Fc()[(size_t)t * 4 + h] + p.ig()[(size_t)t * 4 + h] - mn);
      float4 k4 = *reinterpret_cast<const float4*>(p.km() + (size_t)t * 256 + h * 64 + d4);
      float4 v4 = *reinterpret_cast<const float4*>(p.P5() + (size_t)t * 1280 + 256 + h * 64 + d4);
      *reinterpret_cast<float4*>(s_k + s * 64 + d4) = make_float4(k4.x * wsv, k4.y * wsv, k4.z * wsv, k4.w * wsv);
      *reinterpret_cast<float4*>(s_v + s * 64 + d4) = v4;
    }
    __syncthreads();
    f32x16 acc; zero16(acc);
    mfma32_f32<64>(acc, s_k + ti * 32, 1, 64, s_v + tj * 32, 64, 1, lane);
#pragma unroll
    for (int r = 0; r < 16; ++r) {
      const int d = ti * 32 + (r & 3) + 8 * (r >> 2) + 4 * (lane >> 5);
      p.U()[(size_t)cu * 4096 + d * 64 + tj * 32 + (lane & 31)] = acc[r];
    }
    if (tid < 64) {
      float s0 = 0.f;
      for (int s = 0; s < 64; ++s) s0 += s_k[s * 64 + tid];
      p.un()[(size_t)cu * 64 + tid] = s0;
    }
  }
}

__device__ __forceinline__ void ph_mlscan(const Params& p, int l, int bid, int nblk) {
  const size_t gtid = (size_t)bid * 256 + tid_opaque(), gsz = (size_t)nblk * 256;
  const size_t NPC = 16 * 4096, NSC = 32 * 4096, NPN = 16 * 64, NSN = 32 * 64;
  for (size_t i = gtid; i < NPC + NSC + NPN + NSN; i += gsz) {
    if (i < NPC) {
      int bh = (int)(i >> 12), e = (int)(i & 4095);
      float C = 0.f;
      for (int c = 0; c < 64; ++c) {
        int cu = bh * 64 + c;
        p.Cst()[(size_t)cu * 4096 + e] = C;
        C = p.wcs()[cu] * C + p.U()[(size_t)cu * 4096 + e];
      }
      p.out[O_C_P + (size_t)l * (16 * 4096) + i] = C;
    } else if (i < NPC + NSC) {
      size_t j = i - NPC; int us = (int)(j >> 12), e = (int)(j & 4095); int cu = 1024 + us;
      float C = p.st_c()[(size_t)l * (32 * 4096) + j];
      p.Cst()[(size_t)cu * 4096 + e] = C;
      p.out[O_C_S + (size_t)l * (32 * 4096) + j] = p.wcs()[cu] * C + p.U()[(size_t)cu * 4096 + e];
    } else if (i < NPC + NSC + NPN) {
      size_t j = i - NPC - NSC; int bh = (int)(j >> 6), d = (int)(j & 63);
      float n = 0.f;
      for (int c = 0; c < 64; ++c) {
        int cu = bh * 64 + c;
        p.nst()[(size_t)cu * 64 + d] = n;
        n = p.wcs()[cu] * n + p.un()[(size_t)cu * 64 + d];
      }
      p.out[O_N_P + (size_t)l * (16 * 64) + j] = n;
    } else {
      size_t j = i - NPC - NSC - NPN; int us = (int)(j >> 6), d = (int)(j & 63); int cu = 1024 + us;
      float n = p.st_n()[(size_t)l * (32 * 64) + j];
      p.nst()[(size_t)cu * 64 + d] = n;
      p.out[O_N_S + (size_t)l * (32 * 64) + j] = p.wcs()[cu] * n + p.un()[(size_t)cu * 64 + d];
    }
  }
}

__device__ __forceinline__ void ph_mlout(const Params& p, int l, char* smem, int bid, int nblk) {
  const int tid = tid_opaque();
  float* s_q = reinterpret_cast<float*>(smem);
  float* s_k = s_q + 64 * 65;
  float* s_v = s_k + 64 * 65;
  float* s_C = s_v + 4096;
  float* s_F = s_C + 4096;
  float* s_a = s_F + 64;
  float* s_mt = s_a + 64;
  float* s_iw = s_mt + 64;
  float* s_n = s_iw + 64;
  float* s_den = s_n + 64;
  for (int cu = bid; cu < NCU_UNITS; cu += nblk) {
    int token0, h; cu_decode(cu, token0, h);
    const float m0 = p.mst()[cu];
    __syncthreads();
    for (int i = tid; i < 1024; i += 256) {
      int s = i >> 4, d4 = (i & 15) * 4;
      const int t = token0 + s;
      float4 q4 = *reinterpret_cast<const float4*>(p.qm() + (size_t)t * 256 + h * 64 + d4);
      float4 k4 = *reinterpret_cast<const float4*>(p.km() + (size_t)t * 256 + h * 64 + d4);
      float4 v4 = *reinterpret_cast<const float4*>(p.P5() + (size_t)t * 1280 + 256 + h * 64 + d4);
      float4 c4 = *reinterpret_cast<const float4*>(p.Cst() + (size_t)cu * 4096 + s * 64 + d4);
      s_q[s * 65 + d4] = q4.x; s_q[s * 65 + d4 + 1] = q4.y; s_q[s * 65 + d4 + 2] = q4.z; s_q[s * 65 + d4 + 3] = q4.w;
      s_k[s * 65 + d4] = k4.x; s_k[s * 65 + d4 + 1] = k4.y; s_k[s * 65 + d4 + 2] = k4.z; s_k[s * 65 + d4 + 3] = k4.w;
      *reinterpret_cast<float4*>(s_v + s * 64 + d4) = v4;
      *reinterpret_cast<float4*>(s_C + s * 64 + d4) = c4;
    }
    if (tid < 64) {
      const int t = token0 + tid;
      float F = p.Fc()[(size_t)t * 4 + h], g = p.ig()[(size_t)t * 4 + h];
      s_F[tid] = F; s_a[tid] = g - F;
      s_n[tid] = p.nst()[(size_t)cu * 64 + tid];
    }
    __syncthreads();
    if (tid < 64) {
      float pm = -1e30f;
      for (int s = 0; s <= tid; ++s) pm = fmaxf(pm, s_a[s]);
      float F = s_F[tid];
      float mt = F + fmaxf(m0, pm);
      s_mt[tid] = mt;
      s_iw[tid] = expf(F + m0 - mt);
    }
    __syncthreads();
    const int lane = tid & 63, w = tid >> 6, ti = w >> 1, tj = w & 1;
    const int ty = tid >> 4, tx = tid & 15;
    {
      f32x16 accS; zero16(accS);
      mfma32_f32<64>(accS, s_q + ti * 32 * 65, 65, 1, s_k + tj * 32 * 65, 1, 65, lane);
      __syncthreads();
      const int s = tj * 32 + (lane & 31);
      const float as = s_a[s];
#pragma unroll
      for (int r = 0; r < 16; ++r) {
        const int t = ti * 32 + (r & 3) + 8 * (r >> 2) + 4 * (lane >> 5);
        s_k[t * 65 + s] = (s <= t) ? accS[r] * expf(s_F[t] + as - s_mt[t]) : 0.f;
      }
    }
    __syncthreads();
    if (tid < 64) {
      float den = 0.f, qn = 0.f;
      for (int s = 0; s < 64; ++s) { den += s_k[tid * 65 + s]; qn += s_q[tid * 65 + s] * s_n[s]; }
      s_den[tid] = den + s_iw[tid] * qn;
    }
    {
      f32x16 accN, accC; zero16(accN); zero16(accC);
      mfma32_f32<64>(accN, s_k + ti * 32 * 65, 65, 1, s_v + tj * 32, 64, 1, lane);
      mfma32_f32<64>(accC, s_q + ti * 32 * 65, 65, 1, s_C + tj * 32, 64, 1, lane);
      __syncthreads();
#pragma unroll
      for (int r = 0; r < 16; ++r) {
        const int t = ti * 32 + (r & 3) + 8 * (r >> 2) + 4 * (lane >> 5);
        s_q[t * 65 + tj * 32 + (lane & 31)] = accN[r] + s_iw[t] * accC[r];
      }
    }
    __syncthreads();
#pragma unroll
    for (int i = 0; i < 4; ++i) {
      const int t = ty * 4 + i;
      const float dn = fmaxf(fabsf(s_den[t]), expf(-s_mt[t]));
      float hv[4]; float ss = 0.f;
#pragma unroll
      for (int j = 0; j < 4; ++j) { hv[j] = s_q[t * 65 + tx * 4 + j] / dn; ss += hv[j] * hv[j]; }
      ss = row16_sum(ss);
      const float rn = rsqrtf(ss * (1.f / 64.f) + EPS);
      const int ch = h * 64 + tx * 4;
      const size_t tg = (size_t)(token0 + t);
      float4 g4 = *reinterpret_cast<const float4*>(p.ml_norm_g() + l * 256 + ch);
      float4 k4 = *reinterpret_cast<const float4*>(p.ml_skip() + l * 256 + ch);
      float4 c4 = *reinterpret_cast<const float4*>(p.cc() + tg * 256 + ch);
      float4 o4 = *reinterpret_cast<const float4*>(p.P5() + tg * 1280 + 512 + ch);
      float r0 = (hv[0] * rn * g4.x + k4.x * c4.x) * sigmoidf_(o4.x);
      float r1 = (hv[1] * rn * g4.y + k4.y * c4.y) * sigmoidf_(o4.y);
      float r2 = (hv[2] * rn * g4.z + k4.z * c4.z) * sigmoidf_(o4.z);
      float r3 = (hv[3] * rn * g4.w + k4.w * c4.w) * sigmoidf_(o4.w);
      *reinterpret_cast<uint2*>(p.xn() + tg * 1024 + 512 + ch) = make_uint2(pack2(r0, r1), pack2(r2, r3));
    }
  }
}

__device__ __forceinline__ void ph_cmlp(const Params& p, int l, char* smem, int bid, int nblk) {
  const int tid = tid_opaque(), lane = tid & 63, w = tid >> 6;
  float* s_vg = reinterpret_cast<float*>(smem);
  float* s_ws = s_vg + 128 * 64;
  float* s_r = s_ws + 128 * 33;
  for (int u = bid; u < 544; u += nblk) {
    const int g = u & 3, ci = u >> 2;
    const bool samp = ci >= 128;
    const int L = samp ? 64 : 128;
    const int token0 = samp ? NPROMPT + (ci - 128) * 64 : ci * 128;
    __syncthreads();
    for (int r = w; r < L; r += 4) {
      float4 v = *reinterpret_cast<const float4*>(p.P5() + (size_t)(token0 + r) * 1280 + 1024 + lane * 4);
      float ss = v.x * v.x + v.y * v.y + v.z * v.z + v.w * v.w;
      ss = wave_sum(ss);
      if (lane == 0) s_r[r] = rsqrtf(ss * (1.f / 256.f) + EPS);
    }
    __syncthreads();
    for (int i = tid; i < L * 16; i += 256) {
      int s = i >> 4, d4 = (i & 15) * 4;
      float4 v = *reinterpret_cast<const float4*>(p.P5() + (size_t)(token0 + s) * 1280 + 1024 + g * 64 + d4);
      float4 gn = *reinterpret_cast<const float4*>(p.cm_norm_g() + l * 256 + g * 64 + d4);
      float r = s_r[s];
      float4 o = make_float4(v.x * r * gn.x, v.y * r * gn.y, v.z * r * gn.z, v.w * r * gn.w);
      *reinterpret_cast<float4*>(s_vg + s * 64 + d4) = o;
      if (samp) {
        int ts = token0 - NPROMPT + s;
        *reinterpret_cast<float4*>(p.out + O_CMV_S + (size_t)l * (512 * 256) + (size_t)ts * 256 + g * 64 + d4) = o;
      }
    }
    const int rtA = (w < 2) ? 3 : 2, rtB = (w < 2) ? 0 : 1, ct = w & 1;
    const int nrt = L >> 5;
    f32x16 accA, accB; zero16(accA); zero16(accB);
    const float* wsg = p.cm_ws() + (size_t)(l * 4 + g) * 128 * 128;
    for (int s0 = 0; s0 < L; s0 += 32) {
      __syncthreads();
      for (int i = tid; i < L * 32; i += 256) {
        int t = i >> 5, ss = i & 31;
        s_ws[t * 33 + ss] = (s0 + ss <= t) ? wsg[t * 128 + s0 + ss] : 0.f;
      }
      __syncthreads();
      const int c = s0 >> 5;
      if (rtA < nrt && c <= rtA) mfma32_f32<32>(accA, s_ws + rtA * 32 * 33, 33, 1, s_vg + s0 * 64 + ct * 32, 64, 1, lane);
      if (rtB < nrt && c <= rtB) mfma32_f32<32>(accB, s_ws + rtB * 32 * 33, 33, 1, s_vg + s0 * 64 + ct * 32, 64, 1, lane);
    }
    __syncthreads();
#pragma unroll
    for (int r = 0; r < 16; ++r) {
      const int tr = (r & 3) + 8 * (r >> 2) + 4 * (lane >> 5);
      if (rtA < nrt) s_vg[(rtA * 32 + tr) * 64 + ct * 32 + (lane & 31)] = accA[r];
      if (rtB < nrt) s_vg[(rtB * 32 + tr) * 64 + ct * 32 + (lane & 31)] = accB[r];
    }
    __syncthreads();
    {
      const int ty = tid >> 4, tx = tid & 15;
      if (ty * 8 < L) {
#pragma unroll
        for (int i = 0; i < 8; ++i) {
          const int t = ty * 8 + i;
          const float bb = p.cm_b()[(l * 4 + g) * 128 + t];
          const size_t tg = (size_t)(token0 + t);
          float4 a4 = *reinterpret_cast<const float4*>(s_vg + t * 64 + tx * 4);
          float4 u4 = *reinterpret_cast<const float4*>(p.P5() + tg * 1280 + 768 + g * 64 + tx * 4);
          *reinterpret_cast<uint2*>(p.xn() + tg * 1024 + 768 + g * 64 + tx * 4) =
              make_uint2(pack2(u4.x * (a4.x + bb), u4.y * (a4.y + bb)), pack2(u4.z * (a4.z + bb), u4.w * (a4.w + bb)));
        }
      }
    }
  }
}

__device__ __forceinline__ int mono_key(float v) { int b = __float_as_int(v); return b ^ ((b >> 31) & 0x7FFFFFFF); }
__device__ __forceinline__ float mono_val(int k) { int b = k ^ ((k >> 31) & 0x7FFFFFFF); return __int_as_float(b); }

__device__ __forceinline__ int med3i(int a, int b, int c) { return max(min(a, b), min(max(a, b), c)); }
#define INS16(L, kv)                                                          \
  {                                                                           \
    const int _v = (kv);                                                      \
    _Pragma("unroll") for (int _j = 15; _j >= 1; --_j) L[_j] = med3i(L[_j - 1], L[_j], _v); \
    L[0] = max(L[0], _v);                                                     \
  }

__device__ __forceinline__ void ph_topk(const Params& p, int l, char* smem, int bid, int nblk) {
  const int tid = tid_opaque(), lane = tid & 63, w = tid >> 6;
  float* s_tile = reinterpret_cast<float*>(smem) + w * (64 * 33);
  int* s_list = reinterpret_cast<int*>(smem + 4 * 64 * 33 * 4) + w * (2 * 16 * 64);
  float* s_ss = reinterpret_cast<float*>(smem + 4 * 64 * 33 * 4 + 4 * 2 * 16 * 64 * 4) + w * 64;
  for (int u = bid * 4 + w; u < 264 * 8; u += nblk * 4) {
    const int tg = u >> 3, h = u & 7;
    const int t0 = tg * 64;
    {
      const float4 pp = *reinterpret_cast<const float4*>(p.ssp() + (size_t)(t0 + lane) * 32 + h * 4);
      s_ss[lane] = pp.x + pp.y + pp.z + pp.w;
    }
    int L1[16], L2[16];
#pragma unroll
    for (int j = 0; j < 16; ++j) { L1[j] = (int)0x80000000; L2[j] = (int)0x80000000; }
#pragma unroll
    for (int c = 0; c < 2; ++c) {
#pragma unroll 1
      for (int ps = 0; ps < 4; ++ps) {
        const float* src = p.sc() + (size_t)t0 * 2048 + h * 256 + c * 128 + ps * 32;
#pragma unroll
        for (int j = 0; j < 8; ++j) {
          int tt = (lane >> 3) + 8 * j, f4 = lane & 7;
          float4 v = *reinterpret_cast<const float4*>(src + (size_t)tt * 2048 + f4 * 4);
          float* d = s_tile + tt * 33 + f4 * 4;
          d[0] = v.x; d[1] = v.y; d[2] = v.z; d[3] = v.w;
        }
#pragma unroll 4
        for (int s = 0; s < 32; ++s) {
          float v = s_tile[lane * 33 + s];
          int key = (mono_key(v) & ~127) | (127 - (ps * 32 + s));
          if (c == 0) INS16(L1, key) else INS16(L2, key)
        }
      }
    }
#pragma unroll
    for (int j = 0; j < 16; ++j) { s_list[(0 * 16 + j) * 64 + lane] = 127 - (L1[j] & 127); s_list[(1 * 16 + j) * 64 + lane] = 127 - (L2[j] & 127); }
    float v1[16], v2[16];
#pragma unroll
    for (int j = 0; j < 16; ++j) { v1[j] = mono_val(L1[j] & ~127); v2[j] = mono_val(L2[j] & ~127); }
    int LC[16];
#pragma unroll
    for (int j = 0; j < 16; ++j) LC[j] = (int)0x80000000;
#pragma unroll
    for (int i = 0; i < 16; ++i)
#pragma unroll
      for (int j = 0; j < 16; ++j)
        if ((i + 1) * (j + 1) <= 16) {
          int key = (mono_key(v1[i] + v2[j]) & ~255) | (255 - (i * 16 + j));
          INS16(LC, key)
        }
    const float scale = rsqrtf(s_ss[lane] * (1.f / 256.f) + EPS);
    float vs[16]; float den = 0.f;
    const float top = mono_val(LC[0] & ~255);
#pragma unroll
    for (int k = 0; k < 16; ++k) { vs[k] = __expf((mono_val(LC[k] & ~255) - top) * scale); den += vs[k]; }
    const float inv = 1.f / den;
    const size_t ob = (size_t)(t0 + lane) * 128 + h * 16;
#pragma unroll
    for (int k4 = 0; k4 < 4; ++k4) {
      int ee[4]; float gg[4], su[4];
#pragma unroll
      for (int q = 0; q < 4; ++q) {
        int k = k4 * 4 + q;
        int ci = 255 - (LC[k] & 255);
        int i1 = s_list[(0 * 16 + (ci >> 4)) * 64 + lane];
        int i2 = s_list[(1 * 16 + (ci & 15)) * 64 + lane];
        ee[q] = i1 * 128 + i2;
        gg[q] = vs[k] * inv * p.vs()[l * 16384 + ee[q]];
        su[q] = p.us()[l * 16384 + ee[q]];
      }
      *reinterpret_cast<int4*>(p.eidx() + ob + k4 * 4) = make_int4(ee[0], ee[1], ee[2], ee[3]);
      *reinterpret_cast<float4*>(p.egate() + ob + k4 * 4) = make_float4(gg[0], gg[1], gg[2], gg[3]);
      *reinterpret_cast<float4*>(p.esu() + ob + k4 * 4) = make_float4(su[0], su[1], su[2], su[3]);
    }
  }
}

__device__ __forceinline__ float dot16_fp8(const float* xf, uint4 u) {
  f32x2 a0 = __builtin_amdgcn_cvt_pk_f32_fp8(u.x, false), a1 = __builtin_amdgcn_cvt_pk_f32_fp8(u.x, true);
  f32x2 a2 = __builtin_amdgcn_cvt_pk_f32_fp8(u.y, false), a3 = __builtin_amdgcn_cvt_pk_f32_fp8(u.y, true);
  f32x2 a4 = __builtin_amdgcn_cvt_pk_f32_fp8(u.z, false), a5 = __builtin_amdgcn_cvt_pk_f32_fp8(u.z, true);
  f32x2 a6 = __builtin_amdgcn_cvt_pk_f32_fp8(u.w, false), a7 = __builtin_amdgcn_cvt_pk_f32_fp8(u.w, true);
  float s0 = xf[0] * a0.x, s1 = xf[1] * a0.y;
  s0 = fmaf(xf[2], a1.x, s0); s1 = fmaf(xf[3], a1.y, s1);
  s0 = fmaf(xf[4], a2.x, s0); s1 = fmaf(xf[5], a2.y, s1);
  s0 = fmaf(xf[6], a3.x, s0); s1 = fmaf(xf[7], a3.y, s1);
  s0 = fmaf(xf[8], a4.x, s0); s1 = fmaf(xf[9], a4.y, s1);
  s0 = fmaf(xf[10], a5.x, s0); s1 = fmaf(xf[11], a5.y, s1);
  s0 = fmaf(xf[12], a6.x, s0); s1 = fmaf(xf[13], a6.y, s1);
  s0 = fmaf(xf[14], a7.x, s0); s1 = fmaf(xf[15], a7.y, s1);
  return s0 + s1;
}
__device__ __forceinline__ void axpy16_fp8(float* y, float wgt, uint4 v) {
  f32x2 a0 = __builtin_amdgcn_cvt_pk_f32_fp8(v.x, false), a1 = __builtin_amdgcn_cvt_pk_f32_fp8(v.x, true);
  f32x2 a2 = __builtin_amdgcn_cvt_pk_f32_fp8(v.y, false), a3 = __builtin_amdgcn_cvt_pk_f32_fp8(v.y, true);
  f32x2 a4 = __builtin_amdgcn_cvt_pk_f32_fp8(v.z, false), a5 = __builtin_amdgcn_cvt_pk_f32_fp8(v.z, true);
  f32x2 a6 = __builtin_amdgcn_cvt_pk_f32_fp8(v.w, false), a7 = __builtin_amdgcn_cvt_pk_f32_fp8(v.w, true);
  y[0] = fmaf(wgt, a0.x, y[0]); y[1] = fmaf(wgt, a0.y, y[1]); y[2] = fmaf(wgt, a1.x, y[2]); y[3] = fmaf(wgt, a1.y, y[3]);
  y[4] = fmaf(wgt, a2.x, y[4]); y[5] = fmaf(wgt, a2.y, y[5]); y[6] = fmaf(wgt, a3.x, y[6]); y[7] = fmaf(wgt, a3.y, y[7]);
  y[8] = fmaf(wgt, a4.x, y[8]); y[9] = fmaf(wgt, a4.y, y[9]); y[10] = fmaf(wgt, a5.x, y[10]); y[11] = fmaf(wgt, a5.y, y[11]);
  y[12] = fmaf(wgt, a6.x, y[12]); y[13] = fmaf(wgt, a6.y, y[13]); y[14] = fmaf(wgt, a7.x, y[14]); y[15] = fmaf(wgt, a7.y, y[15]);
}

template <bool DRY>
__device__ __forceinline__ void ph_gather(const Params& p, int l, int bid, int nblk) {
  const int lane = tid_opaque() & 63, w = tid_opaque() >> 6;
  const unsigned char* u8 = p.ub8() + (size_t)l * 16384 * 1024;
  const unsigned char* v8 = p.vb8() + (size_t)l * 16384 * 1024;
  const unsigned loff = (unsigned)lane * 16u;
  for (int t = bid * 4 + w; t < NTOK; t += nblk * 4) {
    float xf[16];
    {
      const uint4 xa = *reinterpret_cast<const uint4*>(p.xn() + (size_t)t * 1024 + lane * 16);
      const uint4 xb = *reinterpret_cast<const uint4*>(p.xn() + (size_t)t * 1024 + lane * 16 + 8);
      xf[0] = bf_lo(xa.x); xf[1] = bf_hi(xa.x); xf[2] = bf_lo(xa.y); xf[3] = bf_hi(xa.y);
      xf[4] = bf_lo(xa.z); xf[5] = bf_hi(xa.z); xf[6] = bf_lo(xa.w); xf[7] = bf_hi(xa.w);
      xf[8] = bf_lo(xb.x); xf[9] = bf_hi(xb.x); xf[10] = bf_lo(xb.y); xf[11] = bf_hi(xb.y);
      xf[12] = bf_lo(xb.z); xf[13] = bf_hi(xb.z); xf[14] = bf_lo(xb.w); xf[15] = bf_hi(xb.w);
    }
    const int e_lo = p.eidx()[(size_t)t * 128 + lane], e_hi = p.eidx()[(size_t)t * 128 + 64 + lane];
    const float g_lo = p.egate()[(size_t)t * 128 + lane], g_hi = p.egate()[(size_t)t * 128 + 64 + lane];
    const float s_lo = p.esu()[(size_t)t * 128 + lane], s_hi = p.esu()[(size_t)t * 128 + 64 + lane];
    float y[16];
#pragma unroll
    for (int i = 0; i < 16; ++i) y[i] = 0.f;
#pragma unroll 1
    for (int k0 = 0; k0 < 128; k0 += 8) {
      uint4 ur[8], vr[8];
#pragma unroll
      for (int q = 0; q < 8; ++q) {
        const int kk = (k0 & 63) + q;
        const int e = (k0 < 64) ? __builtin_amdgcn_readlane(e_lo, kk) : __builtin_amdgcn_readlane(e_hi, kk);
        ur[q] = *reinterpret_cast<const uint4*>(u8 + (size_t)e * 1024 + loff);
        vr[q] = *reinterpret_cast<const uint4*>(v8 + (size_t)e * 1024 + loff);
      }
#pragma unroll
      for (int q = 0; q < 8; ++q) {
        const int kk = (k0 & 63) + q;
        const float gt = __int_as_float((k0 < 64) ? __builtin_amdgcn_readlane(__float_as_int(g_lo), kk) : __builtin_amdgcn_readlane(__float_as_int(g_hi), kk));
        const float su = __int_as_float((k0 < 64) ? __builtin_amdgcn_readlane(__float_as_int(s_lo), kk) : __builtin_amdgcn_readlane(__float_as_int(s_hi), kk));
        float d = wave_sum(dot16_fp8(xf, ur[q])) * su;
        const float wgt = gt * gelu_exact(d);
        axpy16_fp8(y, wgt, vr[q]);
      }
    }
    if (DRY) {
#pragma unroll
      for (int i = 0; i < 16; ++i) asm volatile("" ::"v"(y[i]));
      continue;
    }
    float* xr = p.x() + (size_t)t * 1024 + lane * 16;
#pragma unroll
    for (int j = 0; j < 4; ++j) {
      float4 a = reinterpret_cast<float4*>(xr)[j];
      a.x += y[4 * j]; a.y += y[4 * j + 1]; a.z += y[4 * j + 2]; a.w += y[4 * j + 3];
      reinterpret_cast<float4*>(xr)[j] = a;
    }
  }
}

enum { PH_PREP = 0, PH_NORM1, PH_GEMM_IN, PH_ATTN, PH_MLCONV, PH_MCHAIN, PH_MLU, PH_MLSCAN, PH_MLOUT, PH_CMLP,
       PH_GEMM_OUT, PH_NORM2, PH_GEMM_PQ, PH_GEMM_SC, PH_TOPK, PH_GATHER, PH_FINAL };

__device__ __forceinline__ Params phase_params(const Params& kp, bool with_inputs) {
  Params q;
  size_t z = 0;
  asm volatile("" : "+s"(z));
  q.out = kp.out + z;
  q.ws = kp.ws + z;
  q.in[0] = kp.in[0] + z;
  q.in[1] = kp.in[1] + z;
  if (with_inputs) {
#pragma unroll
    for (int i = 2; i < 30; ++i) q.in[i] = kp.in[i] + z;
  }
  return q;
}


#define GT 4
typedef __attribute__((ext_vector_type(4))) float f32x4;

__device__ __forceinline__ float dot16_fp8v(const f32x2* x2, uint4 u) {
  f32x2 acc = x2[0] * __builtin_amdgcn_cvt_pk_f32_fp8(u.x, false);
  acc += x2[1] * __builtin_amdgcn_cvt_pk_f32_fp8(u.x, true);
  acc += x2[2] * __builtin_amdgcn_cvt_pk_f32_fp8(u.y, false);
  acc += x2[3] * __builtin_amdgcn_cvt_pk_f32_fp8(u.y, true);
  acc += x2[4] * __builtin_amdgcn_cvt_pk_f32_fp8(u.z, false);
  acc += x2[5] * __builtin_amdgcn_cvt_pk_f32_fp8(u.z, true);
  acc += x2[6] * __builtin_amdgcn_cvt_pk_f32_fp8(u.w, false);
  acc += x2[7] * __builtin_amdgcn_cvt_pk_f32_fp8(u.w, true);
  return acc.x + acc.y;
}
__device__ __forceinline__ void axpy16_fp8v(f32x2* y2, float wgt, uint4 v) {
  const f32x2 w2 = {wgt, wgt};
  y2[0] += w2 * __builtin_amdgcn_cvt_pk_f32_fp8(v.x, false);
  y2[1] += w2 * __builtin_amdgcn_cvt_pk_f32_fp8(v.x, true);
  y2[2] += w2 * __builtin_amdgcn_cvt_pk_f32_fp8(v.y, false);
  y2[3] += w2 * __builtin_amdgcn_cvt_pk_f32_fp8(v.y, true);
  y2[4] += w2 * __builtin_amdgcn_cvt_pk_f32_fp8(v.z, false);
  y2[5] += w2 * __builtin_amdgcn_cvt_pk_f32_fp8(v.z, true);
  y2[6] += w2 * __builtin_amdgcn_cvt_pk_f32_fp8(v.w, false);
  y2[7] += w2 * __builtin_amdgcn_cvt_pk_f32_fp8(v.w, true);
}

struct GU { uint4 ur[4]; f32x4 su; };
struct GV { uint4 vr[4]; f32x4 gt; };
#define GREC 384
__device__ __forceinline__ void gload_u(GU& U, const float* rec, int i4, const unsigned char* u8, unsigned loff) {
  const f32x4 ev = *reinterpret_cast<const f32x4*>(rec + i4);
  U.su = *reinterpret_cast<const f32x4*>(rec + 256 + i4);
  const int e0 = __builtin_amdgcn_readfirstlane(__float_as_int(ev.x)), e1 = __builtin_amdgcn_readfirstlane(__float_as_int(ev.y));
  const int e2 = __builtin_amdgcn_readfirstlane(__float_as_int(ev.z)), e3 = __builtin_amdgcn_readfirstlane(__float_as_int(ev.w));
  U.ur[0] = *reinterpret_cast<const uint4*>(u8 + (size_t)e0 * 1024 + loff);
  U.ur[1] = *reinterpret_cast<const uint4*>(u8 + (size_t)e1 * 1024 + loff);
  U.ur[2] = *reinterpret_cast<const uint4*>(u8 + (size_t)e2 * 1024 + loff);
  U.ur[3] = *reinterpret_cast<const uint4*>(u8 + (size_t)e3 * 1024 + loff);
}
__device__ __forceinline__ void gload_v(GV& V, const float* rec, int i4, const unsigned char* v8, unsigned loff) {
  const f32x4 ev = *reinterpret_cast<const f32x4*>(rec + i4);
  V.gt = *reinterpret_cast<const f32x4*>(rec + 128 + i4);
  const int e0 = __builtin_amdgcn_readfirstlane(__float_as_int(ev.x)), e1 = __builtin_amdgcn_readfirstlane(__float_as_int(ev.y));
  const int e2 = __builtin_amdgcn_readfirstlane(__float_as_int(ev.z)), e3 = __builtin_amdgcn_readfirstlane(__float_as_int(ev.w));
  V.vr[0] = *reinterpret_cast<const uint4*>(v8 + (size_t)e0 * 1024 + loff);
  V.vr[1] = *reinterpret_cast<const uint4*>(v8 + (size_t)e1 * 1024 + loff);
  V.vr[2] = *reinterpret_cast<const uint4*>(v8 + (size_t)e2 * 1024 + loff);
  V.vr[3] = *reinterpret_cast<const uint4*>(v8 + (size_t)e3 * 1024 + loff);
}
__device__ __forceinline__ float gelu_as(float z) {
  const float x = fabsf(z) * 0.70710678118654752f;
  const float t = __builtin_amdgcn_rcpf(fmaf(0.3275911f, x, 1.f));
  float pl = fmaf(1.061405429f, t, -1.453152027f);
  pl = fmaf(pl, t, 1.421413741f); pl = fmaf(pl, t, -0.284496736f); pl = fmaf(pl, t, 0.254829592f);
  const float e = __builtin_amdgcn_exp2f(-x * x * LOG2E);
  const float erfa = 1.f - pl * t * e;
  return 0.5f * z + 0.5f * fabsf(z) * erfa;
}
template <int PAT>
__device__ __forceinline__ float swz_f(float v) { return __int_as_float(__builtin_amdgcn_ds_swizzle(__float_as_int(v), PAT)); }

__device__ __forceinline__ void gstep2(GU& UA, GV& VA, GU& UB, GV& VB, const uint4* xlA, const uint4* xlB, f32x2* yA, f32x2* yB,
                                       const float* recA, const float* recB, int ci4, const float* nxtA, const float* nxtB, int ni4,
                                       const unsigned char* u8, const unsigned char* v8, unsigned loff, int lane) {
  float d[8];
  {
    f32x2 x2[8];
    const uint4 xa = xlA[0], xb = xlA[1];
    x2[0] = f32x2{bf_lo(xa.x), bf_hi(xa.x)}; x2[1] = f32x2{bf_lo(xa.y), bf_hi(xa.y)};
    x2[2] = f32x2{bf_lo(xa.z), bf_hi(xa.z)}; x2[3] = f32x2{bf_lo(xa.w), bf_hi(xa.w)};
    x2[4] = f32x2{bf_lo(xb.x), bf_hi(xb.x)}; x2[5] = f32x2{bf_lo(xb.y), bf_hi(xb.y)};
    x2[6] = f32x2{bf_lo(xb.z), bf_hi(xb.z)}; x2[7] = f32x2{bf_lo(xb.w), bf_hi(xb.w)};
#pragma unroll
    for (int q = 0; q < 4; ++q) d[q] = dot16_fp8v(x2, UA.ur[q]);
  }
  gload_u(UA, nxtA, ni4, u8, loff);
  {
    f32x2 x2[8];
    const uint4 xa = xlB[0], xb = xlB[1];
    x2[0] = f32x2{bf_lo(xa.x), bf_hi(xa.x)}; x2[1] = f32x2{bf_lo(xa.y), bf_hi(xa.y)};
    x2[2] = f32x2{bf_lo(xa.z), bf_hi(xa.z)}; x2[3] = f32x2{bf_lo(xa.w), bf_hi(xa.w)};
    x2[4] = f32x2{bf_lo(xb.x), bf_hi(xb.x)}; x2[5] = f32x2{bf_lo(xb.y), bf_hi(xb.y)};
    x2[6] = f32x2{bf_lo(xb.z), bf_hi(xb.z)}; x2[7] = f32x2{bf_lo(xb.w), bf_hi(xb.w)};
#pragma unroll
    for (int q = 0; q < 4; ++q) d[4 + q] = dot16_fp8v(x2, UB.ur[q]);
  }
  gload_u(UB, nxtB, ni4, u8, loff);
  const bool b0 = lane & 1, b1 = lane & 2, b2 = lane & 4;
  float a[4];
#pragma unroll
  for (int j = 0; j < 4; ++j) {
    const float keep = b0 ? d[4 + j] : d[j], send = b0 ? d[j] : d[4 + j];
    a[j] = keep + dpp_f<0xB1>(send);
  }
  float c2[2];
#pragma unroll
  for (int j = 0; j < 2; ++j) {
    const float keep = b1 ? a[2 + j] : a[j], send = b1 ? a[j] : a[2 + j];
    c2[j] = keep + dpp_f<0x4E>(send);
  }
  float tot;
  {
    const float keep = b2 ? c2[1] : c2[0], send = b2 ? c2[0] : c2[1];
    tot = keep + swz_f<0x101F>(send);
  }
  tot += swz_f<0x201F>(tot);
  tot = swap32_sum(swap16_sum(tot));
  const int pq = ((lane >> 1) & 1) * 2 + ((lane >> 2) & 1);
  const float* rl = (b0 ? recB : recA) + ci4 + pq;
  const float z = tot * rl[256];
  const float wv = rl[128] * gelu_as(z);
#pragma unroll
  for (int q = 0; q < 4; ++q) {
    const int ln = ((q >> 1) & 1) * 2 + (q & 1) * 4;
    const float wa = __int_as_float(__builtin_amdgcn_readlane(__float_as_int(wv), ln));
    const float wb = __int_as_float(__builtin_amdgcn_readlane(__float_as_int(wv), ln + 1));
    axpy16_fp8v(yA, wa, VA.vr[q]);
    axpy16_fp8v(yB, wb, VB.vr[q]);
  }
  gload_v(VA, nxtA, ni4, v8, loff);
  gload_v(VB, nxtB, ni4, v8, loff);
}

__device__ __forceinline__ void gstep(GU& U, GV& V, const uint4* xl, f32x2* y2, const float* nrec, int ni4,
                                      const unsigned char* u8, const unsigned char* v8, unsigned loff, int lane) {
  f32x2 x2[8];
  {
    const uint4 xa = xl[0], xb = xl[1];
    x2[0] = f32x2{bf_lo(xa.x), bf_hi(xa.x)}; x2[1] = f32x2{bf_lo(xa.y), bf_hi(xa.y)};
    x2[2] = f32x2{bf_lo(xa.z), bf_hi(xa.z)}; x2[3] = f32x2{bf_lo(xa.w), bf_hi(xa.w)};
    x2[4] = f32x2{bf_lo(xb.x), bf_hi(xb.x)}; x2[5] = f32x2{bf_lo(xb.y), bf_hi(xb.y)};
    x2[6] = f32x2{bf_lo(xb.z), bf_hi(xb.z)}; x2[7] = f32x2{bf_lo(xb.w), bf_hi(xb.w)};
  }
  float d[4], su[4];
#pragma unroll
  for (int q = 0; q < 4; ++q) { d[q] = dot16_fp8v(x2, U.ur[q]); su[q] = U.su[q]; }
  gload_u(U, nrec, ni4, u8, loff);
#pragma unroll
  for (int q = 0; q < 4; ++q) d[q] = wave_sum(d[q]) * su[q];
  float dv = d[0]; dv = (lane == 1) ? d[1] : dv; dv = (lane == 2) ? d[2] : dv; dv = (lane == 3) ? d[3] : dv;
  const float av = gelu_as(dv);
#pragma unroll
  for (int q = 0; q < 4; ++q) {
    const float act = __int_as_float(__builtin_amdgcn_readlane(__float_as_int(av), q));
    axpy16_fp8v(y2, V.gt[q] * act, V.vr[q]);
  }
  gload_v(V, nrec, ni4, v8, loff);
}

__device__ __forceinline__ void gsort_token(const Params& p, int t, float* rec, int lane) {
  const int e0 = p.eidx()[(size_t)t * 128 + lane], e1 = p.eidx()[(size_t)t * 128 + 64 + lane];
  const float g0 = p.egate()[(size_t)t * 128 + lane], g1 = p.egate()[(size_t)t * 128 + 64 + lane];
  const float q0 = p.esu()[(size_t)t * 128 + lane], q1 = p.esu()[(size_t)t * 128 + 64 + lane];
  int base = 0;
#pragma unroll 4
  for (int s = 0; s < 16; ++s) {
    const unsigned long long m0 = __ballot((e0 >> 10) == s), m1 = __ballot((e1 >> 10) == s);
    const int c0 = __popcll(m0), c1 = __popcll(m1);
    const int p0 = base + (int)__builtin_amdgcn_mbcnt_hi((unsigned)(m0 >> 32), __builtin_amdgcn_mbcnt_lo((unsigned)m0, 0));
    const int p1 = base + c0 + (int)__builtin_amdgcn_mbcnt_hi((unsigned)(m1 >> 32), __builtin_amdgcn_mbcnt_lo((unsigned)m1, 0));
    if ((e0 >> 10) == s) { rec[p0] = __int_as_float(e0); rec[128 + p0] = g0; rec[256 + p0] = q0; }
    if ((e1 >> 10) == s) { rec[p1] = __int_as_float(e1); rec[128 + p1] = g1; rec[256 + p1] = q1; }
    base += c0 + c1;
  }
}
__device__ __forceinline__ void gload_x(const Params& p, int t, uint4* xl, int lane) {
  xl[0] = *reinterpret_cast<const uint4*>(p.xn() + (size_t)t * 1024 + lane * 16);
  xl[1] = *reinterpret_cast<const uint4*>(p.xn() + (size_t)t * 1024 + lane * 16 + 8);
}
template <bool LAST>
__device__ __forceinline__ void gstore_x(const Params& p, int l, int t, const f32x2* y2, int lane) {
  float* xr = p.x() + (size_t)t * 1024 + lane * 16;
  float4 a[4];
  float ss = 0.f;
#pragma unroll
  for (int j = 0; j < 4; ++j) {
    a[j] = reinterpret_cast<float4*>(xr)[j];
    a[j].x += y2[2 * j].x; a[j].y += y2[2 * j].y; a[j].z += y2[2 * j + 1].x; a[j].w += y2[2 * j + 1].y;
    ss += a[j].x * a[j].x + a[j].y * a[j].y + a[j].z * a[j].z + a[j].w * a[j].w;
  }
  ss = wave_sum(ss);
  const float r = rsqrtf(ss * (1.f / 1024.f) + EPS);
  if (LAST) {
    const float* g = p.final_g() + lane * 16;
    float* o = ((t < NPROMPT) ? p.out + O_Y_P + (size_t)t * 1024 : p.out + O_Y_S + (size_t)(t - NPROMPT) * 1024) + lane * 16;
#pragma unroll
    for (int j = 0; j < 4; ++j) {
      const float4 gv = reinterpret_cast<const float4*>(g)[j];
      reinterpret_cast<float4*>(o)[j] = make_float4(a[j].x * r * gv.x, a[j].y * r * gv.y, a[j].z * r * gv.z, a[j].w * r * gv.w);
    }
  } else {
    const float* g = p.norm1_g() + (l + 1) * 1024 + lane * 16;
#pragma unroll
    for (int j = 0; j < 4; ++j) {
      reinterpret_cast<float4*>(xr)[j] = a[j];
      const float4 gv = reinterpret_cast<const float4*>(g)[j];
      a[j].x *= r * gv.x; a[j].y *= r * gv.y; a[j].z *= r * gv.z; a[j].w *= r * gv.w;
    }
    uint4* o = reinterpret_cast<uint4*>(p.xn() + (size_t)t * 1024 + lane * 16);
    o[0] = make_uint4(pack2(a[0].x, a[0].y), pack2(a[0].z, a[0].w), pack2(a[1].x, a[1].y), pack2(a[1].z, a[1].w));
    o[1] = make_uint4(pack2(a[2].x, a[2].y), pack2(a[2].z, a[2].w), pack2(a[3].x, a[3].y), pack2(a[3].z, a[3].w));
    float pre[8];
#pragma unroll
    for (int i = 0; i < 8; ++i) {
      const float4* wr = reinterpret_cast<const float4*>(p.wg() + ((size_t)(l + 1) * 8 + i) * 1024 + lane * 16);
      float s = 0.f;
#pragma unroll
      for (int j = 0; j < 4; ++j) {
        const float4 wv = wr[j];
        s += a[j].x * wv.x + a[j].y * wv.y + a[j].z * wv.z + a[j].w * wv.w;
      }
      pre[i] = wave_sum(s);
    }
    if (lane < 4) {
      float ai = pre[0]; ai = lane == 1 ? pre[1] : ai; ai = lane == 2 ? pre[2] : ai; ai = lane == 3 ? pre[3] : ai;
      float f = pre[4]; f = lane == 1 ? pre[5] : f; f = lane == 2 ? pre[6] : f; f = lane == 3 ? pre[7] : f;
      p.ig()[(size_t)t * 4 + lane] = ai + p.ml_gate_b()[(l + 1) * 8 + lane];
      const float z = f + p.ml_gate_b()[(l + 1) * 8 + 4 + lane];
      p.lf()[(size_t)t * 4 + lane] = fminf(z, 0.f) - log1pf(expf(-fabsf(z)));
    }
  }
}

template <bool LAST>
__device__ __forceinline__ void ph_gather2(const Params& p, int l, char* smem, int bid, int nblk) {
  const int tid = tid_opaque(), lane = tid & 63, w = tid >> 6;
  const unsigned char* u8 = p.ub8() + (size_t)l * 16384 * 1024;
  const unsigned char* v8 = p.vb8() + (size_t)l * 16384 * 1024;
  const unsigned loff = (unsigned)lane * 16u;
  float* rec = reinterpret_cast<float*>(smem) + w * (GT * GREC);
  uint4* xl = reinterpret_cast<uint4*>(smem + 4 * GT * GREC * 4) + (w * GT * 64 + lane) * 2;
  const int rot = (bid & 7) * 4;
  const int nwaves = nblk * 4, wg = bid * 4 + w;
  const int nfull = (NTOK / (nwaves * GT)) * nwaves;
  for (int grp = wg; grp < nfull; grp += nwaves) {
    const int t0 = grp * GT;
    int lane_s = lane; asm volatile("" : "+v"(lane_s));
#pragma unroll 1
    for (int ti = 0; ti < GT; ++ti) {
      gload_x(p, t0 + ti, xl + ti * 128, lane_s);
      gsort_token(p, t0 + ti, rec + ti * GREC, lane_s);
    }
    f32x2 y2[GT][8];
#pragma unroll
    for (int ti = 0; ti < GT; ++ti)
#pragma unroll
      for (int i = 0; i < 8; ++i) y2[ti][i] = f32x2{0.f, 0.f};
    GU U0, U1; GV V0, V1;
    gload_u(U0, rec, (rot & 31) * 4, u8, loff); gload_v(V0, rec, (rot & 31) * 4, v8, loff);
    gload_u(U1, rec + GREC, (rot & 31) * 4, u8, loff); gload_v(V1, rec + GREC, (rot & 31) * 4, v8, loff);
#pragma unroll 1
    for (int b = 0; b < 32; ++b) {
      const int bo = ((b + rot) & 31) * 4, bn = ((b + 1 + rot) & 31) * 4;
      gstep2(U0, V0, U1, V1, xl, xl + 128, y2[0], y2[1], rec, rec + GREC, bo, rec + 2 * GREC, rec + 3 * GREC, bo, u8, v8, loff, lane);
      __builtin_amdgcn_sched_barrier(0);
      gstep2(U0, V0, U1, V1, xl + 256, xl + 384, y2[2], y2[3], rec + 2 * GREC, rec + 3 * GREC, bo, rec, rec + GREC, bn, u8, v8, loff, lane);
      __builtin_amdgcn_sched_barrier(0);
    }
    int lane_e = lane; asm volatile("" : "+v"(lane_e));
#pragma unroll
    for (int ti = 0; ti < GT; ++ti) gstore_x<LAST>(p, l, t0 + ti, y2[ti], lane_e);
  }
  float* ysum = reinterpret_cast<float*>(smem + 4 * GT * GREC * 4 + 4 * GT * 2048);
  for (int t = nfull * GT + bid; t < NTOK; t += nblk) {
    f32x2 y2[8];
    gload_x(p, t, xl, lane);
#pragma unroll
    for (int i = 0; i < 8; ++i) y2[i] = f32x2{0.f, 0.f};
    gsort_token(p, t, rec, lane);
    GU U; GV V;
    gload_u(U, rec, (w * 8) * 4, u8, loff);
    gload_v(V, rec, (w * 8) * 4, v8, loff);
#pragma unroll 1
    for (int b = 0; b < 8; ++b) gstep(U, V, xl, y2, rec, (w * 8 + ((b + 1) & 7)) * 4, u8, v8, loff, lane);
    __syncthreads();
#pragma unroll
    for (int i = 0; i < 8; ++i) { ysum[w * 1024 + lane * 16 + 2 * i] = y2[i].x; ysum[w * 1024 + lane * 16 + 2 * i + 1] = y2[i].y; }
    __syncthreads();
    if (w == 0) {
#pragma unroll
      for (int i = 0; i < 8; ++i) {
        y2[i].x += ysum[1024 + lane * 16 + 2 * i] + ysum[2048 + lane * 16 + 2 * i] + ysum[3072 + lane * 16 + 2 * i];
        y2[i].y += ysum[1024 + lane * 16 + 2 * i + 1] + ysum[2048 + lane * 16 + 2 * i + 1] + ysum[3072 + lane * 16 + 2 * i + 1];
      }
      gstore_x<LAST>(p, l, t, y2, lane);
    }
  }
}

#define XB_TMO      128
#define XB_XCNT(j)  (256  + 64 * (j))
#define XB_XSUB(j)  (1280 + 64 * (j))
#define XB_XGEN(j)  (2304 + 64 * (j))
#define XB_TOP      3328
#define XB_TOPGEN   3392
#define XCD_BAR_WORDS 3456
#define XB_SPIN_CAP (1u << 22)
__device__ __forceinline__ unsigned xb_ld(unsigned* p)              { return __hip_atomic_load(p, __ATOMIC_RELAXED, __HIP_MEMORY_SCOPE_AGENT); }
__device__ __forceinline__ unsigned xb_add(unsigned* p, unsigned v) { return __hip_atomic_fetch_add(p, v, __ATOMIC_RELAXED, __HIP_MEMORY_SCOPE_AGENT); }
__device__ __forceinline__ unsigned xb_xcc_id() { return (unsigned)__builtin_amdgcn_s_getreg((3 << 11) | 20) & 0xFu; }
#define XB_SPIN(cond, bar) do { unsigned _sp = 0; while (cond) { __builtin_amdgcn_s_sleep(1); \
    if ((++_sp & 255u) == 0u) { if (xb_ld(&(bar)[XB_TMO])) break; if (_sp > XB_SPIN_CAP) { atomicAdd(&(bar)[XB_TMO], 1u); break; } } } } while (0)

struct XcdBarrier { unsigned* bar; unsigned x; volatile LAS unsigned* st; };

__device__ __forceinline__ XcdBarrier xcd_barrier_post(unsigned* bar, volatile LAS unsigned* st) {
  XcdBarrier b; b.bar = bar; b.x = xb_xcc_id(); b.st = st;
  if (threadIdx.x == 0) (void)xb_add(&bar[XB_XCNT(b.x)], 1u);
  return b;
}
__device__ __forceinline__ void xcd_barrier_complete(unsigned* bar, unsigned x, unsigned& nloc, unsigned& nx) {
  const unsigned G = gridDim.x * gridDim.y * gridDim.z;
  unsigned sum, cnt, mine, sp = 0u;
  for (;;) {
    sum = 0u; cnt = 0u; mine = 0u;
#pragma unroll
    for (unsigned j = 0; j < 16; ++j) { const unsigned c = xb_ld(&bar[XB_XCNT(j)]); sum += c; cnt += (c > 0u) ? 1u : 0u; mine = (j == x) ? c : mine; }
    if (sum == G) break;
    __builtin_amdgcn_s_sleep(1);
    if ((++sp & 255u) == 0u) { if (xb_ld(&bar[XB_TMO])) break; if (sp > XB_SPIN_CAP) { atomicAdd(&bar[XB_TMO], 1u); break; } }
  }
  nloc = mine > 0u ? mine : 1u; nx = cnt > 0u ? cnt : 1u;
}
__device__ __forceinline__ void xcd_barrier(const XcdBarrier& b) {
  asm volatile("s_waitcnt vmcnt(0)" ::: "memory");
  __syncthreads();
  if (threadIdx.x == 0) {
    unsigned* bar = b.bar;
    __builtin_amdgcn_s_waitcnt(0);
    unsigned nloc = b.st[0], nx = b.st[1];
    if (nloc == 0u) { xcd_barrier_complete(bar, b.x, nloc, nx); b.st[0] = nloc; b.st[1] = nx; }
    const unsigned old = xb_add(&bar[XB_XSUB(b.x)], 1u);
    const unsigned gen = old / nloc;
    if (old + 1u == (gen + 1u) * nloc) {
      __builtin_amdgcn_fence(__ATOMIC_RELEASE, "agent");
      asm volatile("s_waitcnt vmcnt(0)" ::: "memory");
      const unsigned og = xb_add(&bar[XB_TOP], 1u);
      const unsigned tg = og / nx;
      if (og + 1u == (tg + 1u) * nx) xb_add(&bar[XB_TOPGEN], 1u);
      else XB_SPIN(xb_ld(&bar[XB_TOPGEN]) == tg, bar);
      __builtin_amdgcn_fence(__ATOMIC_ACQUIRE, "agent");
      xb_add(&bar[XB_XGEN(b.x)], 1u);
      asm volatile("s_waitcnt vmcnt(0)" ::: "memory");
    } else {
      XB_SPIN(xb_ld(&bar[XB_XGEN(b.x)]) == gen, bar);
      __builtin_amdgcn_fence(__ATOMIC_ACQUIRE, "agent");
      asm volatile("s_waitcnt vmcnt(0)" ::: "memory");
    }
  }
  __syncthreads();
}

#define GSYNC() xcd_barrier(xb)
#define PP(wi) phase_params(p, wi)
#define BN bid_opaque(bid), nblk_opaque(nblk)

template <int L>
__device__ __forceinline__ void layer_phases(const Params& p, char* smem, const XcdBarrier& xb, int bid, int nblk) {
  if (L == 0) {
  ph_rmsnorm<0>(PP(false), L, BN);
#if PROBE == 11
  GSYNC();
  ph_rmsnorm<0>(PP(false), L, BN);
#endif
  GSYNC();
  }
  ph_gemm<EPI_WIN>(PP(false), L, smem, BN);
#if PROBE == 1
  GSYNC();
  ph_gemm<EPI_WIN>(PP(false), L, smem, BN);
#endif
  GSYNC();
  ph_attn(PP(false), L, smem, BN);
#if PROBE == 4
  GSYNC();
  ph_attn(PP(false), L, smem, BN);
#endif
  ph_mlconv(PP(false), L, smem, BN);
#if PROBE == 8 || PROBE == 20
  GSYNC();
  ph_mlconv(PP(false), L, smem, BN);
#endif
  ph_cmlp(PP(false), L, smem, BN);
#if PROBE == 7 || PROBE == 20
  GSYNC();
  ph_cmlp(PP(false), L, smem, BN);
#endif
  GSYNC();
  ph_mlU(PP(false), L, smem, BN);
#if PROBE == 9 || PROBE == 20
  GSYNC();
  ph_mlU(PP(false), L, smem, BN);
#endif
  GSYNC();
  ph_mlscan(PP(false), L, BN);
#if PROBE == 10 || PROBE == 20
  GSYNC();
  ph_mlscan(PP(false), L, BN);
#endif
  GSYNC();
  ph_mlout(PP(false), L, smem, BN);
#if PROBE == 6 || PROBE == 20
  GSYNC();
  ph_mlout(PP(false), L, smem, BN);
#endif
  GSYNC();
  ph_gemm<EPI_WOUT>(PP(false), L, smem, BN);
  GSYNC();
  ph_rmsnorm<1>(PP(false), L, BN);
  GSYNC();
  ph_gemm<EPI_PQ>(PP(false), L, smem, BN);
#if PROBE == 2
  GSYNC();
  ph_gemm<EPI_PQ>(PP(false), L, smem, BN);
#endif
  GSYNC();
  ph_topk(PP(false), L, smem, BN);
#if PROBE == 5
  GSYNC();
  ph_topk(PP(false), L, smem, BN);
#endif
  GSYNC();
  ph_gather2<(L == 1)>(PP(false), L, smem, BN);
  GSYNC();
}

__global__ void __launch_bounds__(256, 2) mega_kernel(Params p) {
  __shared__ __attribute__((aligned(16))) char smem[SMEM_BYTES];
  __shared__ uint4 xb_words;
  cg::grid_group grid = cg::this_grid();
  const int bid = blockIdx.x, nblk = gridDim.x;
  if (threadIdx.x == 0) xb_words = make_uint4(0u, 0u, 0u, 0u);
  __syncthreads();
  XcdBarrier xb = xcd_barrier_post(reinterpret_cast<unsigned*>(p.ws), (volatile LAS unsigned*)&xb_words);
  grid.sync();
  ph_prep(PP(true), smem, BN);
#if PROBE == 12
  GSYNC();
  ph_prep(PP(true), smem, BN);
#endif
  GSYNC();
  layer_phases<0>(p, smem, xb, bid, nblk);
  layer_phases<1>(p, smem, xb, bid, nblk);
}

static inline size_t align_up(size_t v, size_t a) { return (v + a - 1) / a * a; }

extern "C" void kernel_launch(void* const* d_in, const int* in_sizes, int n_in, void* d_out, int out_size, void* d_ws,
                              size_t ws_size, hipStream_t stream) {
  Params p{};
  for (int i = 0; i < 30; ++i) p.in[i] = reinterpret_cast<const float*>(d_in[i]);
  p.out = reinterpret_cast<float*>(d_out);
  p.ws = reinterpret_cast<char*>(d_ws);
  if (WS_NEED > ws_size) { fprintf(stderr, "workspace too small: need %zu have %zu\n", (size_t)WS_NEED, ws_size); return; }
  static int grid_blocks = 0;
  if (!grid_blocks) {
    int dev = 0, cus = 0, per_cu = 0;
    hipGetDevice(&dev);
    hipDeviceGetAttribute(&cus, hipDeviceAttributeMultiprocessorCount, dev);
    hipOccupancyMaxActiveBlocksPerMultiprocessor(&per_cu, mega_kernel, 256, 0);
    if (per_cu > 2) per_cu = 2;
    if (per_cu < 1) per_cu = 1;
    grid_blocks = cus * per_cu;
  }
  hipMemsetAsync(d_ws, 0, 16384, stream);
  void* args[] = {&p};
  hipError_t e = hipLaunchCooperativeKernel((void*)mega_kernel, dim3(grid_blocks), dim3(256), args, 0, stream);
  if (e != hipSuccess) fprintf(stderr, "cooperative launch failed: %s (grid %d)\n", hipGetErrorString(e), grid_blocks);
}
```

```cpp
#include <hip/hip_runtime.h>
#include <hip/hip_cooperative_groups.h>
#include <cstdio>
#include <cstdint>

namespace cg = cooperative_groups;

typedef unsigned short bf16_t;
typedef __attribute__((ext_vector_type(8))) __bf16 bf16x8;
typedef __attribute__((ext_vector_type(2))) __bf16 bf16x2;
typedef __attribute__((ext_vector_type(16))) float f32x16;
typedef __attribute__((ext_vector_type(2))) float f32x2;

#define D_MODEL 1024
#define NTOK 16896
#define NPROMPT 16384
#define SEQ 4096
#define NIN 2816
#define EPS 1e-6f
#define LOG2E 1.4426950408889634f
#define SKEYS 1088
#define NCU_UNITS 1056

constexpr size_t O_Y_P = 0;
constexpr size_t O_Y_S = O_Y_P + 16777216;
constexpr size_t O_K_P = O_Y_S + 524288;
constexpr size_t O_V_P = O_K_P + 16777216;
constexpr size_t O_C_P = O_V_P + 16777216;
constexpr size_t O_N_P = O_C_P + 131072;
constexpr size_t O_M_P = O_N_P + 2048;
constexpr size_t O_CONV_P = O_M_P + 32;
constexpr size_t O_K_S = O_CONV_P + 6144;
constexpr size_t O_V_S = O_K_S + 524288;
constexpr size_t O_C_S = O_V_S + 524288;
constexpr size_t O_N_S = O_C_S + 262144;
constexpr size_t O_M_S = O_N_S + 4096;
constexpr size_t O_CONV_S = O_M_S + 64;
constexpr size_t O_CMV_S = O_CONV_S + 12288;

constexpr size_t al256(size_t v) { return (v + 255) / 256 * 256; }
constexpr int SP_st_c = 0;
constexpr int SP_st_n = 262144;
constexpr int SP_st_m = 266240;
constexpr int SP_st_conv = 266304;
constexpr int SP_norm1_g = 278592;
constexpr int SP_da_subln_g = 280640;
constexpr int SP_ml_conv_w = 280896;
constexpr int SP_ml_conv_b = 282944;
constexpr int SP_ml_wq = 283456;
constexpr int SP_ml_wk = 316224;
constexpr int SP_ml_gate_b = 348992;
constexpr int SP_ml_norm_g = 349056;
constexpr int SP_ml_skip = 349568;
constexpr int SP_cm_norm_g = 350080;
constexpr int SP_cm_ws = 350592;
constexpr int SP_cm_b = 481664;
constexpr int SP_norm2_g = 482688;
constexpr int SP_final_g = 484736;
constexpr int SP_TOTAL = 485760;
constexpr size_t WS_bar = 0;
constexpr size_t WS_lam = al256(WS_bar + 16384);
constexpr size_t WS_lut = al256(WS_lam + (256));
constexpr size_t WS_sp = al256(WS_lut + (4*256*4));
constexpr size_t WS_wt_in = al256(WS_sp + (SP_TOTAL*4));
constexpr size_t WS_wg = al256(WS_wt_in + ((size_t)2*NIN*1024*2));
constexpr size_t WS_wt_out = al256(WS_wg + ((size_t)2*8*1024*4));
constexpr size_t WS_wt_pq = al256(WS_wt_out + ((size_t)2*1024*1024*2));
constexpr size_t WS_keysb = al256(WS_wt_pq + ((size_t)2*2048*1024*2));
constexpr size_t WS_ub8 = al256(WS_keysb + ((size_t)2*16*128*128*2));
constexpr size_t WS_vb8 = al256(WS_ub8 + ((size_t)2*16384*1024));
constexpr size_t WS_us = al256(WS_vb8 + ((size_t)2*16384*1024));
constexpr size_t WS_vs = al256(WS_us + ((size_t)2*16384*4));
constexpr size_t WS_Kbs = al256(WS_vs + ((size_t)2*16384*4));
constexpr size_t WS_Vts = al256(WS_Kbs + ((size_t)2*8*SKEYS*512*2));
constexpr size_t WS_x = al256(WS_Vts + ((size_t)2*8*4*128*SKEYS*2));
constexpr size_t WS_xn = al256(WS_x + ((size_t)NTOK*1024*4));
constexpr size_t WS_R0 = al256(WS_xn + ((size_t)NTOK*1024*2));
constexpr size_t WS_R0x = WS_R0;
constexpr size_t WS_Qb = al256(WS_R0x + (0));
constexpr size_t WS_Kb = al256(WS_Qb + ((size_t)NTOK*512*2));
constexpr size_t WS_Vt = al256(WS_Kb + ((size_t)NPROMPT*512*2));
constexpr size_t WS_P5 = al256(WS_Vt + ((size_t)16*128*SEQ*2));
constexpr size_t WS_ig = al256(WS_P5 + ((size_t)NTOK*1280*4));
constexpr size_t WS_lf = al256(WS_ig + ((size_t)NTOK*4*4));
constexpr size_t WS_Fc = al256(WS_lf + ((size_t)NTOK*4*4));
constexpr size_t WS_cc = al256(WS_Fc + ((size_t)NTOK*4*4));
constexpr size_t WS_qm = al256(WS_cc + ((size_t)NTOK*256*4));
constexpr size_t WS_km = al256(WS_qm + ((size_t)NTOK*256*4));
constexpr size_t WS_mst = al256(WS_km + ((size_t)NTOK*256*4));
constexpr size_t WS_mnx = al256(WS_mst + (NCU_UNITS*4));
constexpr size_t WS_wcs = al256(WS_mnx + (NCU_UNITS*4));
constexpr size_t WS_FLs = al256(WS_wcs + (NCU_UNITS*4));
constexpr size_t WS_mxt = al256(WS_FLs + (NCU_UNITS*4));
constexpr size_t WS_U = al256(WS_mxt + (NCU_UNITS*4));
constexpr size_t WS_un = al256(WS_U + ((size_t)NCU_UNITS*4096*4));
constexpr size_t WS_Cst = al256(WS_un + ((size_t)NCU_UNITS*64*4));
constexpr size_t WS_nst = al256(WS_Cst + ((size_t)NCU_UNITS*4096*4));
constexpr size_t WS_END_MIXER = al256(WS_nst + ((size_t)NCU_UNITS*64*4));
constexpr size_t WS_qp = al256(WS_R0x + (0));
constexpr size_t WS_sc = al256(WS_qp + ((size_t)NTOK*2048*2));
constexpr size_t WS_eidx = al256(WS_sc + ((size_t)NTOK*2048*4));
constexpr size_t WS_egate = al256(WS_eidx + ((size_t)NTOK*128*4));
constexpr size_t WS_esu = al256(WS_egate + ((size_t)NTOK*128*4));
constexpr size_t WS_ssp = al256(WS_esu + ((size_t)NTOK*128*4));
constexpr size_t WS_END_PEER = al256(WS_ssp + ((size_t)NTOK*32*4));
constexpr size_t WS_NEED = WS_END_MIXER > WS_END_PEER ? WS_END_MIXER : WS_END_PEER;

struct Params {
  const float* in[30];
  float* out;
  char* ws;
  __device__ __forceinline__ const float* x_prompt() const { return in[0]; }
  __device__ __forceinline__ const float* x_sample() const { return in[1]; }
  __device__ __forceinline__ const float* cache_k() const { return in[2]; }
  __device__ __forceinline__ const float* cache_v() const { return in[3]; }
  __device__ __forceinline__ const float* w_in() const { return in[9]; }
  __device__ __forceinline__ const float* da_lambda() const { return in[10]; }
  __device__ __forceinline__ const float* rel_table() const { return in[12]; }
  __device__ __forceinline__ const float* w_out() const { return in[23]; }
  __device__ __forceinline__ const float* peer_wq() const { return in[25]; }
  __device__ __forceinline__ const float* peer_keys() const { return in[26]; }
  __device__ __forceinline__ const float* peer_u() const { return in[27]; }
  __device__ __forceinline__ const float* peer_v() const { return in[28]; }
  __device__ __forceinline__ const float* st_c() const { return reinterpret_cast<const float*>(ws + WS_sp) + SP_st_c; }
  __device__ __forceinline__ const float* st_n() const { return reinterpret_cast<const float*>(ws + WS_sp) + SP_st_n; }
  __device__ __forceinline__ const float* st_m() const { return reinterpret_cast<const float*>(ws + WS_sp) + SP_st_m; }
  __device__ __forceinline__ const float* st_conv() const { return reinterpret_cast<const float*>(ws + WS_sp) + SP_st_conv; }
  __device__ __forceinline__ const float* norm1_g() const { return reinterpret_cast<const float*>(ws + WS_sp) + SP_norm1_g; }
  __device__ __forceinline__ const float* da_subln_g() const { return reinterpret_cast<const float*>(ws + WS_sp) + SP_da_subln_g; }
  __device__ __forceinline__ const float* ml_conv_w() const { return reinterpret_cast<const float*>(ws + WS_sp) + SP_ml_conv_w; }
  __device__ __forceinline__ const float* ml_conv_b() const { return reinterpret_cast<const float*>(ws + WS_sp) + SP_ml_conv_b; }
  __device__ __forceinline__ const float* ml_wq() const { return reinterpret_cast<const float*>(ws + WS_sp) + SP_ml_wq; }
  __device__ __forceinline__ const float* ml_wk() const { return reinterpret_cast<const float*>(ws + WS_sp) + SP_ml_wk; }
  __device__ __forceinline__ const float* ml_gate_b() const { return reinterpret_cast<const float*>(ws + WS_sp) + SP_ml_gate_b; }
  __device__ __forceinline__ const float* ml_norm_g() const { return reinterpret_cast<const float*>(ws + WS_sp) + SP_ml_norm_g; }
  __device__ __forceinline__ const float* ml_skip() const { return reinterpret_cast<const float*>(ws + WS_sp) + SP_ml_skip; }
  __device__ __forceinline__ const float* cm_norm_g() const { return reinterpret_cast<const float*>(ws + WS_sp) + SP_cm_norm_g; }
  __device__ __forceinline__ const float* cm_ws() const { return reinterpret_cast<const float*>(ws + WS_sp) + SP_cm_ws; }
  __device__ __forceinline__ const float* cm_b() const { return reinterpret_cast<const float*>(ws + WS_sp) + SP_cm_b; }
  __device__ __forceinline__ const float* norm2_g() const { return reinterpret_cast<const float*>(ws + WS_sp) + SP_norm2_g; }
  __device__ __forceinline__ const float* final_g() const { return reinterpret_cast<const float*>(ws + WS_sp) + SP_final_g; }
  __device__ __forceinline__ float* lam() const { return reinterpret_cast<float*>(ws + WS_lam); }
  __device__ __forceinline__ float* lut() const { return reinterpret_cast<float*>(ws + WS_lut); }
  __device__ __forceinline__ float* sp() const { return reinterpret_cast<float*>(ws + WS_sp); }
  __device__ __forceinline__ bf16_t* wt_in() const { return reinterpret_cast<bf16_t*>(ws + WS_wt_in); }
  __device__ __forceinline__ float* wg() const { return reinterpret_cast<float*>(ws + WS_wg); }
  __device__ __forceinline__ bf16_t* wt_out() const { return reinterpret_cast<bf16_t*>(ws + WS_wt_out); }
  __device__ __forceinline__ bf16_t* wt_pq() const { return reinterpret_cast<bf16_t*>(ws + WS_wt_pq); }
  __device__ __forceinline__ bf16_t* keysb() const { return reinterpret_cast<bf16_t*>(ws + WS_keysb); }
  __device__ __forceinline__ unsigned char* ub8() const { return reinterpret_cast<unsigned char*>(ws + WS_ub8); }
  __device__ __forceinline__ unsigned char* vb8() const { return reinterpret_cast<unsigned char*>(ws + WS_vb8); }
  __device__ __forceinline__ float* us() const { return reinterpret_cast<float*>(ws + WS_us); }
  __device__ __forceinline__ float* vs() const { return reinterpret_cast<float*>(ws + WS_vs); }
  __device__ __forceinline__ bf16_t* Kbs() const { return reinterpret_cast<bf16_t*>(ws + WS_Kbs); }
  __device__ __forceinline__ bf16_t* Vts() const { return reinterpret_cast<bf16_t*>(ws + WS_Vts); }
  __device__ __forceinline__ float* x() const { return reinterpret_cast<float*>(ws + WS_x); }
  __device__ __forceinline__ bf16_t* xn() const { return reinterpret_cast<bf16_t*>(ws + WS_xn); }
  __device__ __forceinline__ bf16_t* Qb() const { return reinterpret_cast<bf16_t*>(ws + WS_Qb); }
  __device__ __forceinline__ bf16_t* Kb() const { return reinterpret_cast<bf16_t*>(ws + WS_Kb); }
  __device__ __forceinline__ bf16_t* Vt() const { return reinterpret_cast<bf16_t*>(ws + WS_Vt); }
  __device__ __forceinline__ float* P5() const { return reinterpret_cast<float*>(ws + WS_P5); }
  __device__ __forceinline__ float* ig() const { return reinterpret_cast<float*>(ws + WS_ig); }
  __device__ __forceinline__ float* lf() const { return reinterpret_cast<float*>(ws + WS_lf); }
  __device__ __forceinline__ float* Fc() const { return reinterpret_cast<float*>(ws + WS_Fc); }
  __device__ __forceinline__ float* cc() const { return reinterpret_cast<float*>(ws + WS_cc); }
  __device__ __forceinline__ float* qm() const { return reinterpret_cast<float*>(ws + WS_qm); }
  __device__ __forceinline__ float* km() const { return reinterpret_cast<float*>(ws + WS_km); }
  __device__ __forceinline__ float* mst() const { return reinterpret_cast<float*>(ws + WS_mst); }
  __device__ __forceinline__ float* mnx() const { return reinterpret_cast<float*>(ws + WS_mnx); }
  __device__ __forceinline__ float* wcs() const { return reinterpret_cast<float*>(ws + WS_wcs); }
  __device__ __forceinline__ float* FLs() const { return reinterpret_cast<float*>(ws + WS_FLs); }
  __device__ __forceinline__ float* mxt() const { return reinterpret_cast<float*>(ws + WS_mxt); }
  __device__ __forceinline__ float* U() const { return reinterpret_cast<float*>(ws + WS_U); }
  __device__ __forceinline__ float* un() const { return reinterpret_cast<float*>(ws + WS_un); }
  __device__ __forceinline__ float* Cst() const { return reinterpret_cast<float*>(ws + WS_Cst); }
  __device__ __forceinline__ float* nst() const { return reinterpret_cast<float*>(ws + WS_nst); }
  __device__ __forceinline__ bf16_t* qp() const { return reinterpret_cast<bf16_t*>(ws + WS_qp); }
  __device__ __forceinline__ float* sc() const { return reinterpret_cast<float*>(ws + WS_sc); }
  __device__ __forceinline__ int* eidx() const { return reinterpret_cast<int*>(ws + WS_eidx); }
  __device__ __forceinline__ float* egate() const { return reinterpret_cast<float*>(ws + WS_egate); }
  __device__ __forceinline__ float* esu() const { return reinterpret_cast<float*>(ws + WS_esu); }
  __device__ __forceinline__ float* ssp() const { return reinterpret_cast<float*>(ws + WS_ssp); }
  __device__ __forceinline__ int* tl() const { return reinterpret_cast<int*>(ws + WS_sc); }
};

__device__ __forceinline__ unsigned pack2(float a, float b) {
  f32x2 v = {a, b};
  bf16x2 r = __builtin_convertvector(v, bf16x2);
  return *reinterpret_cast<unsigned*>(&r);
}
__device__ __forceinline__ bf16_t f2bf(float a) { return (bf16_t)(pack2(a, 0.f) & 0xFFFFu); }
__device__ __forceinline__ float bf_lo(unsigned u) { return __uint_as_float(u << 16); }
__device__ __forceinline__ float bf_hi(unsigned u) { return __uint_as_float(u & 0xFFFF0000u); }
__device__ __forceinline__ float gelu_exact(float x) { return 0.5f * x * (1.f + erff(x * 0.70710678118654752f)); }
__device__ __forceinline__ float sigmoidf_(float x) { return 1.f / (1.f + __expf(-x)); }
template <int CTRL>
__device__ __forceinline__ float dpp_f(float v) {
  return __builtin_bit_cast(float, __builtin_amdgcn_update_dpp(0, __builtin_bit_cast(int, v), CTRL, 0xf, 0xf, true));
}
__device__ __forceinline__ float swap16_sum(float x) {
  auto s = __builtin_amdgcn_permlane16_swap(__float_as_uint(x), __float_as_uint(x), false, false);
  return __uint_as_float(s[0]) + __uint_as_float(s[1]);
}
__device__ __forceinline__ float swap32_sum(float x) {
  auto s = __builtin_amdgcn_permlane32_swap(__float_as_uint(x), __float_as_uint(x), false, false);
  return __uint_as_float(s[0]) + __uint_as_float(s[1]);
}
__device__ __forceinline__ float swap16_max(float x) {
  auto s = __builtin_amdgcn_permlane16_swap(__float_as_uint(x), __float_as_uint(x), false, false);
  return fmaxf(__uint_as_float(s[0]), __uint_as_float(s[1]));
}
__device__ __forceinline__ float swap32_max(float x) {
  auto s = __builtin_amdgcn_permlane32_swap(__float_as_uint(x), __float_as_uint(x), false, false);
  return fmaxf(__uint_as_float(s[0]), __uint_as_float(s[1]));
}
__device__ __forceinline__ float row16_sum(float v) {
  v += dpp_f<0xB1>(v); v += dpp_f<0x4E>(v); v += dpp_f<0x141>(v); v += dpp_f<0x140>(v);
  return v;
}
__device__ __forceinline__ float row16_max(float v) {
  v = fmaxf(v, dpp_f<0xB1>(v)); v = fmaxf(v, dpp_f<0x4E>(v)); v = fmaxf(v, dpp_f<0x141>(v)); v = fmaxf(v, dpp_f<0x140>(v));
  return v;
}
__device__ __forceinline__ float wave_sum(float v) { return swap32_sum(swap16_sum(row16_sum(v))); }
__device__ __forceinline__ float wave_max(float v) { return swap32_max(swap16_max(row16_max(v))); }
__device__ __forceinline__ const float* xrow_in(const Params& p, int l, int t) {
  if (l == 0) return (t < NPROMPT) ? p.x_prompt() + (size_t)t * D_MODEL : p.x_sample() + (size_t)(t - NPROMPT) * D_MODEL;
  return p.x() + (size_t)t * D_MODEL;
}
__device__ __forceinline__ bf16x8 as_bf16x8(uint4 v) { return *reinterpret_cast<bf16x8*>(&v); }

__device__ __forceinline__ int tid_opaque() { int t = threadIdx.x; asm volatile("" : "+v"(t)); return t; }
__device__ __forceinline__ int sgpr_opaque(int v) { asm volatile("" : "+s"(v)); return v; }
__device__ __forceinline__ int bid_opaque(int v) { asm volatile("" : "+s"(v)); __builtin_assume(v >= 0); __builtin_assume(v < 1024); return v; }
__device__ __forceinline__ int nblk_opaque(int v) { asm volatile("" : "+s"(v)); __builtin_assume(v >= 1); __builtin_assume(v <= 1024); return v; }
#define LAS __attribute__((address_space(3)))
#ifndef PROBE
#define PROBE 0
#endif
#define SMEM_BYTES 73728

__device__ __forceinline__ void transpose_tile(const float* __restrict__ src, int lds, bf16_t* __restrict__ dst, int K, int n0, int k0,
                               int gate_skip, float* tile  ) {
  const int tid = tid_opaque();
  const int c = tid & 63, r0 = tid >> 6;
  int n = n0 + c;
  int col = n + ((gate_skip && n >= 2304) ? 8 : 0);
#pragma unroll 4
  for (int j = 0; j < 16; ++j) {
    int r = r0 + 4 * j;
    tile[r * 65 + c] = src[(size_t)(k0 + r) * lds + col];
  }
  __syncthreads();
  const int nn = tid >> 2, kg = (tid & 3) * 16;
  unsigned w[8];
#pragma unroll
  for (int j = 0; j < 8; ++j) w[j] = pack2(tile[(kg + 2 * j) * 65 + nn], tile[(kg + 2 * j + 1) * 65 + nn]);
  uint4* d = reinterpret_cast<uint4*>(dst + (size_t)(n0 + nn) * K + k0 + kg);
  d[0] = make_uint4(w[0], w[1], w[2], w[3]);
  d[1] = make_uint4(w[4], w[5], w[6], w[7]);
  __syncthreads();
}

__device__ __forceinline__ int rel_bucket_dev(int rel) {
  int ret = rel > 0 ? 16 : 0;
  int n = rel < 0 ? -rel : rel;
  int b;
  if (n < 8) b = n;
  else if (n < 12) b = 8;
  else if (n < 16) b = 9;
  else if (n < 23) b = 10;
  else if (n < 32) b = 11;
  else if (n < 46) b = 12;
  else if (n < 64) b = 13;
  else if (n < 91) b = 14;
  else b = 15;
  return ret + b;
}

__device__ __forceinline__ void ph_prep(const Params& p, char* smem, int bid, int nblk) {
  const int tid = tid_opaque();
  float* tile = reinterpret_cast<float*>(smem);
  for (int u = bid; u < 2 * 1472; u += nblk) {
    int l = u / 1472, r = u % 1472;
    if (r < 704) {
      int nt = r / 16, kt = r % 16;
      transpose_tile(p.w_in() + (size_t)l * 1024 * 2824, 2824, p.wt_in() + (size_t)l * NIN * 1024, 1024, nt * 64, kt * 64, 1, tile);
    } else if (r < 960) {
      r -= 704; int nt = r / 16, kt = r % 16;
      transpose_tile(p.w_out() + (size_t)l * 1024 * 1024, 1024, p.wt_out() + (size_t)l * 1024 * 1024, 1024, nt * 64, kt * 64, 0, tile);
    } else {
      r -= 960; int nt = r / 16, kt = r % 16;
      transpose_tile(p.peer_wq() + (size_t)l * 1024 * 2048, 2048, p.wt_pq() + (size_t)l * 2048 * 1024, 1024, nt * 64, kt * 64, 0, tile);
    }
  }
  for (int u = bid; u < 1024; u += nblk) {
    int kt = u & 15, h = (u >> 4) & 3, b = (u >> 6) & 7, l = u >> 9;
    const float* src = p.cache_v() + (((size_t)(l * 8 + b) * 1024 + kt * 64) * 4 + h) * 128;
    {
      int c = tid & 127, r0 = tid >> 7;
      for (int j = 0; j < 32; ++j) { int r = r0 + 2 * j; tile[r * 129 + c] = src[(size_t)r * 512 + c]; }
    }
    __syncthreads();
    {
      int dv = tid >> 1, half = tid & 1;
      bf16_t* dst = p.Vts() + ((size_t)((l * 8 + b) * 4 + h) * 128 + dv) * SKEYS + kt * 64 + half * 32;
      unsigned w[16];
#pragma unroll
      for (int j = 0; j < 16; ++j) {
        int pos0 = half * 32 + 2 * j;
        int blk = (pos0 >> 2) & 3;
        int oblk = (blk == 1) ? 2 : (blk == 2 ? 1 : blk);
        int key0 = (pos0 & ~15) + oblk * 4 + (pos0 & 3);
        w[j] = pack2(tile[key0 * 129 + dv], tile[(key0 + 1) * 129 + dv]);
      }
      uint4* d4 = reinterpret_cast<uint4*>(dst);
      d4[0] = make_uint4(w[0], w[1], w[2], w[3]);
      d4[1] = make_uint4(w[4], w[5], w[6], w[7]);
      d4[2] = make_uint4(w[8], w[9], w[10], w[11]);
      d4[3] = make_uint4(w[12], w[13], w[14], w[15]);
    }
    __syncthreads();
  }
  const size_t gtid = (size_t)bid * 256 + tid, gsz = (size_t)nblk * 256;
  {
    const int lane = tid & 63, wv = tid >> 6;
    for (int r = bid * 4 + wv; r < 2 * 32768; r += nblk * 4) {
      const int tab = r >> 15, row = r & 32767;
      const float* src = (tab == 0 ? p.peer_u() : p.peer_v()) + (size_t)row * 1024 + lane * 16;
      float4 f0 = reinterpret_cast<const float4*>(src)[0], f1 = reinterpret_cast<const float4*>(src)[1];
      float4 f2 = reinterpret_cast<const float4*>(src)[2], f3 = reinterpret_cast<const float4*>(src)[3];
      float am = fmaxf(fmaxf(fmaxf(fabsf(f0.x), fabsf(f0.y)), fmaxf(fabsf(f0.z), fabsf(f0.w))),
                       fmaxf(fmaxf(fabsf(f1.x), fabsf(f1.y)), fmaxf(fabsf(f1.z), fabsf(f1.w))));
      am = fmaxf(am, fmaxf(fmaxf(fmaxf(fabsf(f2.x), fabsf(f2.y)), fmaxf(fabsf(f2.z), fabsf(f2.w))),
                           fmaxf(fmaxf(fabsf(f3.x), fabsf(f3.y)), fmaxf(fabsf(f3.z), fabsf(f3.w)))));
      am = wave_max(am);
      const float sc = am > 0.f ? 224.f / am : 1.f;
      int w0 = 0, w1 = 0, w2 = 0, w3 = 0;
      w0 = __builtin_amdgcn_cvt_pk_fp8_f32(f0.x * sc, f0.y * sc, w0, false); w0 = __builtin_amdgcn_cvt_pk_fp8_f32(f0.z * sc, f0.w * sc, w0, true);
      w1 = __builtin_amdgcn_cvt_pk_fp8_f32(f1.x * sc, f1.y * sc, w1, false); w1 = __builtin_amdgcn_cvt_pk_fp8_f32(f1.z * sc, f1.w * sc, w1, true);
      w2 = __builtin_amdgcn_cvt_pk_fp8_f32(f2.x * sc, f2.y * sc, w2, false); w2 = __builtin_amdgcn_cvt_pk_fp8_f32(f2.z * sc, f2.w * sc, w2, true);
      w3 = __builtin_amdgcn_cvt_pk_fp8_f32(f3.x * sc, f3.y * sc, w3, false); w3 = __builtin_amdgcn_cvt_pk_fp8_f32(f3.z * sc, f3.w * sc, w3, true);
      unsigned char* dst = (tab == 0 ? p.ub8() : p.vb8()) + (size_t)row * 1024 + lane * 16;
      *reinterpret_cast<uint4*>(dst) = make_uint4((unsigned)w0, (unsigned)w1, (unsigned)w2, (unsigned)w3);
      if (lane == 0) (tab == 0 ? p.us() : p.vs())[row] = am > 0.f ? am * (1.f / 224.f) : 1.f;
    }
  }
  {
    const size_t n8 = (size_t)2 * 16 * 128 * 128 / 8;
    for (size_t i = gtid; i < n8; i += gsz) {
      float4 a = reinterpret_cast<const float4*>(p.peer_keys())[2 * i], b = reinterpret_cast<const float4*>(p.peer_keys())[2 * i + 1];
      reinterpret_cast<uint4*>(p.keysb())[i] = make_uint4(pack2(a.x, a.y), pack2(a.z, a.w), pack2(b.x, b.y), pack2(b.z, b.w));
    }
  }
  {
    const size_t n8 = (size_t)2 * 8 * 1024 * 512 / 8;
    for (size_t i = gtid; i < n8; i += gsz) {
      size_t e = i * 8;
      size_t lb = e / (1024 * 512), rem = e % (1024 * 512);
      float4 a = reinterpret_cast<const float4*>(p.cache_k())[2 * i], b = reinterpret_cast<const float4*>(p.cache_k())[2 * i + 1];
      *reinterpret_cast<uint4*>(p.Kbs() + lb * (SKEYS * 512) + rem) = make_uint4(pack2(a.x, a.y), pack2(a.z, a.w), pack2(b.x, b.y), pack2(b.z, b.w));
    }
  }
  for (size_t i = gtid; i < 2 * 8 * 1024; i += gsz) {
    int l = (int)(i / 8192), r = (int)(i % 8192), g = r / 1024, k = r % 1024;
    p.wg()[i] = p.w_in()[((size_t)l * 1024 + k) * 2824 + 2304 + g];
  }
  {
    float* sp = reinterpret_cast<float*>(p.ws + WS_sp);
    for (size_t i = gtid; i < 262144; i += gsz) sp[SP_st_c + i] = p.in[4][i];
    for (size_t i = gtid; i < 4096; i += gsz) sp[SP_st_n + i] = p.in[5][i];
    for (size_t i = gtid; i < 64; i += gsz) sp[SP_st_m + i] = p.in[6][i];
    for (size_t i = gtid; i < 12288; i += gsz) sp[SP_st_conv + i] = p.in[7][i];
    for (size_t i = gtid; i < 2048; i += gsz) sp[SP_norm1_g + i] = p.in[8][i];
    for (size_t i = gtid; i < 256; i += gsz) sp[SP_da_subln_g + i] = p.in[11][i];
    for (size_t i = gtid; i < 2048; i += gsz) sp[SP_ml_conv_w + i] = p.in[13][i];
    for (size_t i = gtid; i < 512; i += gsz) sp[SP_ml_conv_b + i] = p.in[14][i];
    for (size_t i = gtid; i < 32768; i += gsz) sp[SP_ml_wq + i] = p.in[15][i];
    for (size_t i = gtid; i < 32768; i += gsz) sp[SP_ml_wk + i] = p.in[16][i];
    for (size_t i = gtid; i < 16; i += gsz) sp[SP_ml_gate_b + i] = p.in[17][i];
    for (size_t i = gtid; i < 512; i += gsz) sp[SP_ml_norm_g + i] = p.in[18][i];
    for (size_t i = gtid; i < 512; i += gsz) sp[SP_ml_skip + i] = p.in[19][i];
    for (size_t i = gtid; i < 512; i += gsz) sp[SP_cm_norm_g + i] = p.in[20][i];
    for (size_t i = gtid; i < 131072; i += gsz) sp[SP_cm_ws + i] = p.in[21][i];
    for (size_t i = gtid; i < 1024; i += gsz) sp[SP_cm_b + i] = p.in[22][i];
    for (size_t i = gtid; i < 2048; i += gsz) sp[SP_norm2_g + i] = p.in[24][i];
    for (size_t i = gtid; i < 1024; i += gsz) sp[SP_final_g + i] = p.in[29][i];
  }
  if (bid == 0) {
    for (int i = tid; i < 4 * 256; i += 256) {
      int h = i >> 8, j = i & 255;
      int rel = j - 191; if (rel > 63) rel = 63;
      p.lut()[i] = p.rel_table()[rel_bucket_dev(rel) * 4 + h] * LOG2E;
    }
    if (tid < 2) {
      const float* lp = p.da_lambda() + tid * 256;
      float s01 = 0.f, s23 = 0.f;
      for (int d = 0; d < 64; ++d) { s01 += lp[d] * lp[64 + d]; s23 += lp[128 + d] * lp[192 + d]; }
      float lam_init = 0.8f - 0.6f * expf(-0.3f * (float)tid);
      p.lam()[tid] = expf(s01) - expf(s23) + lam_init;
    }
  }
}

template <int MODE>
__device__ __forceinline__ void ph_rmsnorm(const Params& p, int l, int bid, int nblk) {
  const int lane = tid_opaque() & 63, w = tid_opaque() >> 6;
  const float* g = (MODE == 0) ? p.norm1_g() + l * 1024 : (MODE == 1 ? p.norm2_g() + l * 1024 : p.final_g());
  float4 gv[4];
#pragma unroll
  for (int j = 0; j < 4; ++j) gv[j] = reinterpret_cast<const float4*>(g)[lane + 64 * j];
  for (int t = bid * 4 + w; t < NTOK; t += nblk * 4) {
    const float* xr = (MODE == 0) ? xrow_in(p, l, t) : p.x() + (size_t)t * 1024;
    float4 xv[4];
    float ss = 0.f;
#pragma unroll
    for (int j = 0; j < 4; ++j) {
      xv[j] = reinterpret_cast<const float4*>(xr)[lane + 64 * j];
      ss += xv[j].x * xv[j].x + xv[j].y * xv[j].y + xv[j].z * xv[j].z + xv[j].w * xv[j].w;
    }
    ss = wave_sum(ss);
    float r = rsqrtf(ss * (1.f / 1024.f) + EPS);
#pragma unroll
    for (int j = 0; j < 4; ++j) {
      xv[j].x *= r * gv[j].x; xv[j].y *= r * gv[j].y; xv[j].z *= r * gv[j].z; xv[j].w *= r * gv[j].w;
    }
    if (MODE == 2) {
      float* o = (t < NPROMPT) ? p.out + O_Y_P + (size_t)t * 1024 : p.out + O_Y_S + (size_t)(t - NPROMPT) * 1024;
#pragma unroll
      for (int j = 0; j < 4; ++j) reinterpret_cast<float4*>(o)[lane + 64 * j] = xv[j];
    } else {
      uint2* o = reinterpret_cast<uint2*>(p.xn() + (size_t)t * 1024);
#pragma unroll
      for (int j = 0; j < 4; ++j) o[lane + 64 * j] = make_uint2(pack2(xv[j].x, xv[j].y), pack2(xv[j].z, xv[j].w));
    }
    if (MODE == 0) {
      float pre[8];
#pragma unroll
      for (int i = 0; i < 8; ++i) {
        const float4* wr = reinterpret_cast<const float4*>(p.wg() + ((size_t)l * 8 + i) * 1024);
        float s = 0.f;
#pragma unroll
        for (int j = 0; j < 4; ++j) {
          float4 wv = wr[lane + 64 * j];
          s += xv[j].x * wv.x + xv[j].y * wv.y + xv[j].z * wv.z + xv[j].w * wv.w;
        }
        pre[i] = wave_sum(s);
      }
      if (lane < 4) {
        float a = pre[0]; a = lane == 1 ? pre[1] : a; a = lane == 2 ? pre[2] : a; a = lane == 3 ? pre[3] : a;
        float f = pre[4]; f = lane == 1 ? pre[5] : f; f = lane == 2 ? pre[6] : f; f = lane == 3 ? pre[7] : f;
        p.ig()[(size_t)t * 4 + lane] = a + p.ml_gate_b()[l * 8 + lane];
        float z = f + p.ml_gate_b()[l * 8 + 4 + lane];
        p.lf()[(size_t)t * 4 + lane] = fminf(z, 0.f) - log1pf(expf(-fabsf(z)));
      }
    }
  }
}

__device__ __forceinline__ int mono_key(float v) { int b = __float_as_int(v); return b ^ ((b >> 31) & 0x7FFFFFFF); }
__device__ __forceinline__ float mono_val(int k) { int b = k ^ ((k >> 31) & 0x7FFFFFFF); return __int_as_float(b); }

__device__ __forceinline__ int med3i(int a, int b, int c) { return max(min(a, b), min(max(a, b), c)); }
#define INS16(L, kv)                                                          \
  {                                                                           \
    const int _v = (kv);                                                      \
    _Pragma("unroll") for (int _j = 15; _j >= 1; --_j) L[_j] = med3i(L[_j - 1], L[_j], _v); \
    L[0] = max(L[0], _v);                                                     \
  }


enum { EPI_WIN = 0, EPI_WOUT = 1, EPI_PQ = 2, EPI_SC = 3 };

template <int EPI>
__device__ __forceinline__ void gemm_store(const Params& p, int l, int t, int n, float v) {
  if (EPI == EPI_WOUT) {
    const float* xi = xrow_in(p, l, t);
    p.x()[(size_t)t * 1024 + n] = xi[n] + v;
  } else if (EPI == EPI_PQ) {
    p.qp()[(size_t)t * 2048 + n] = f2bf(v);
  } else if (EPI == EPI_SC) {
    p.sc()[(size_t)t * 2048 + n] = v;
  }
}

template <int EPI>
__device__ __forceinline__ void ph_gemm(const Params& p, int l, char* smem, int bid, int nblk) {
  constexpr int NT = (EPI == EPI_WIN) ? 22 : (EPI == EPI_WOUT ? 8 : 16);
  constexpr int MT = NTOK / 128;
  constexpr int K = (EPI == EPI_SC) ? 128 : 1024;
  constexpr int NK = K / 64;
  const bf16_t* A; int lda; const bf16_t* Bt; int ldb;
  if (EPI == EPI_WIN) { A = p.xn(); lda = 1024; Bt = p.wt_in() + (size_t)l * NIN * 1024; ldb = 1024; }
  else if (EPI == EPI_WOUT) { A = p.xn(); lda = 1024; Bt = p.wt_out() + (size_t)l * 1024 * 1024; ldb = 1024; }
  else if (EPI == EPI_PQ) { A = p.xn(); lda = 1024; Bt = p.wt_pq() + (size_t)l * 2048 * 1024; ldb = 1024; }
  else { A = p.qp(); lda = 2048; Bt = p.keysb() + (size_t)l * 16 * 128 * 128; ldb = 128; }

  const int tid = tid_opaque(), lane = tid & 63, w = tid >> 6;
  const int wm = w >> 1, wn = w & 1, lr = lane & 31, lh = lane >> 5;
  char* sA = smem;
  char* sB = smem + 32768;
  const int ld_c = tid & 7, ld_r = tid >> 3;

  const int nx = nblk >> 3;
  constexpr int FG = MT / 8, LR = MT % 8;
  for (int rnd = 0;; ++rnd) {
    const int q = (nblk & 7) ? rnd * nblk + bid : rnd * nblk + (bid & 7) * nx + (bid >> 3);
    if (q >= MT * NT) break;
    int mt, nt;
    if (q < FG * 8 * NT) { const int mg = q / (8 * NT), rem = q % (8 * NT); nt = rem >> 3; mt = mg * 8 + (rem & 7); }
    else { const int q2 = q - FG * 8 * NT; nt = q2 / (LR > 0 ? LR : 1); mt = FG * 8 + q2 % (LR > 0 ? LR : 1); }
    const bf16_t* Ag = A + (size_t)(mt * 128) * lda + ((EPI == EPI_SC) ? nt * 128 : 0);
    const bf16_t* Bg = Bt + (size_t)(nt * 128) * ldb;
    f32x16 acc[2][2];
#pragma unroll
    for (int i = 0; i < 2; ++i)
#pragma unroll
      for (int j = 0; j < 2; ++j)
#pragma unroll
        for (int r = 0; r < 16; ++r) acc[i][j][r] = 0.f;

    const int g_row = w * 32 + (lane >> 3);
    const int g_pc = lane & 7;
    const bf16_t* Ath = Ag + (size_t)g_row * lda;
    const bf16_t* Bth = Bg + (size_t)g_row * ldb;
#define GEMM_STAGE(KT, BUF)                                                                                          \
  _Pragma("unroll") for (int j = 0; j < 4; ++j) {                                                                    \
    const int row = g_row + 8 * j;                                                                                   \
    const int cch = g_pc ^ ((row >> 1) & 7);                                                                         \
    __builtin_amdgcn_global_load_lds((const unsigned*)(Ath + (size_t)(8 * j) * lda + (KT) * 64 + cch * 8),           \
                                     (LAS unsigned*)(sA + (BUF) * 16384 + (w * 4 + j) * 1024 + lane * 16), 16, 0, 0); \
    __builtin_amdgcn_global_load_lds((const unsigned*)(Bth + (size_t)(8 * j) * ldb + (KT) * 64 + cch * 8),           \
                                     (LAS unsigned*)(sB + (BUF) * 16384 + (w * 4 + j) * 1024 + lane * 16), 16, 0, 0); \
  }
    GEMM_STAGE(0, 0)
    __syncthreads();
    for (int kt = 0; kt < NK; ++kt) {
      const int buf = kt & 1;
      if (kt + 1 < NK) { GEMM_STAGE(kt + 1, buf ^ 1) }
      const char* cA = sA + buf * 16384;
      const char* cB = sB + buf * 16384;
#pragma unroll
      for (int ks = 0; ks < 4; ++ks) {
        bf16x8 af[2], bfr[2];
#pragma unroll
        for (int i = 0; i < 2; ++i) {
          int row = wm * 64 + i * 32 + lr; int pc = (ks * 2 + lh) ^ ((row >> 1) & 7);
          af[i] = as_bf16x8(*reinterpret_cast<const uint4*>(cA + row * 128 + pc * 16));
        }
#pragma unroll
        for (int j = 0; j < 2; ++j) {
          int row = wn * 64 + j * 32 + lr; int pc = (ks * 2 + lh) ^ ((row >> 1) & 7);
          bfr[j] = as_bf16x8(*reinterpret_cast<const uint4*>(cB + row * 128 + pc * 16));
        }
#pragma unroll
        for (int i = 0; i < 2; ++i)
#pragma unroll
          for (int j = 0; j < 2; ++j)
            acc[i][j] = __builtin_amdgcn_mfma_f32_32x32x16_bf16(af[i], bfr[j], acc[i][j], 0, 0, 0);
      }
      __syncthreads();
    }
    if (EPI == EPI_PQ) {
      int lane_q = lane; asm volatile("" : "+v"(lane_q));
      const int lr = lane_q & 31, lh = lane_q >> 5;
      char* sA2 = smem;
      char* sB2 = smem + 32768;
      const bf16_t* kg = p.keysb() + ((size_t)l * 16 + nt) * 128 * 128;
#pragma unroll
      for (int jj = 0; jj < 8; ++jj) {
        const int I = w * 8 + jj;
        const int row = I * 4 + (lane_q >> 4);
        const int cch = (lane_q & 15) ^ (row & 15);
        __builtin_amdgcn_global_load_lds((const unsigned*)(kg + (size_t)row * 128 + cch * 8),
                                         (LAS unsigned*)(sB2 + I * 1024 + lane_q * 16), 16, 0, 0);
      }
#pragma unroll
      for (int i = 0; i < 2; ++i) {
        float rs[16];
#pragma unroll
        for (int r = 0; r < 16; ++r) rs[r] = 0.f;
#pragma unroll
        for (int j = 0; j < 2; ++j) {
          const int n = wn * 64 + j * 32 + lr;
#pragma unroll
          for (int r = 0; r < 16; ++r) {
            const int row = wm * 64 + i * 32 + (r & 3) + 8 * (r >> 2) + 4 * lh;
            const float v = acc[i][j][r];
            rs[r] += v * v;
            *reinterpret_cast<bf16_t*>(sA2 + row * 256 + (((n >> 3) ^ (row & 15)) * 16) + (n & 7) * 2) = f2bf(v);
          }
        }
#pragma unroll
        for (int r = 0; r < 16; ++r) {
          const float s = swap16_sum(row16_sum(rs[r]));
          if (lr == 0) {
            const int t = mt * 128 + wm * 64 + i * 32 + (r & 3) + 8 * (r >> 2) + 4 * lh;
            p.ssp()[(size_t)t * 32 + nt * 2 + wn] = s;
          }
        }
      }
      __syncthreads();
      f32x16 sc2[2][2];
#pragma unroll
      for (int i = 0; i < 2; ++i)
#pragma unroll
        for (int j = 0; j < 2; ++j)
#pragma unroll
          for (int r = 0; r < 16; ++r) sc2[i][j][r] = 0.f;
#pragma unroll
      for (int ks = 0; ks < 8; ++ks) {
        bf16x8 af[2], bfr[2];
#pragma unroll
        for (int i = 0; i < 2; ++i) {
          const int row = wm * 64 + i * 32 + lr;
          af[i] = as_bf16x8(*reinterpret_cast<const uint4*>(sA2 + row * 256 + (((ks * 2 + lh) ^ (row & 15)) * 16)));
        }
#pragma unroll
        for (int j = 0; j < 2; ++j) {
          const int row = wn * 64 + j * 32 + lr;
          bfr[j] = as_bf16x8(*reinterpret_cast<const uint4*>(sB2 + row * 256 + (((ks * 2 + lh) ^ (row & 15)) * 16)));
        }
#pragma unroll
        for (int i = 0; i < 2; ++i)
#pragma unroll
          for (int j = 0; j < 2; ++j)
            sc2[i][j] = __builtin_amdgcn_mfma_f32_32x32x16_bf16(af[i], bfr[j], sc2[i][j], 0, 0, 0);
      }
      __syncthreads();
      float* sS = reinterpret_cast<float*>(smem);
#pragma unroll
      for (int i = 0; i < 2; ++i)
#pragma unroll
        for (int j = 0; j < 2; ++j)
#pragma unroll
          for (int r = 0; r < 16; ++r) {
            const int row = wm * 64 + i * 32 + (r & 3) + 8 * (r >> 2) + 4 * lh;
            sS[row * 129 + wn * 64 + j * 32 + lr] = sc2[i][j][r];
          }
      __syncthreads();
      {
        int tq = tid; asm volatile("" : "+v"(tq));
        const int tk = tq & 127, hl = tq >> 7;
        int L[16];
#pragma unroll
        for (int j = 0; j < 16; ++j) L[j] = (int)0x80000000;
        const float* srow = sS + tk * 129 + hl * 64;
#pragma unroll 4
        for (int s = 0; s < 64; ++s) {
          const int key = (mono_key(srow[s]) & ~127) | (127 - (hl * 64 + s));
          INS16(L, key)
        }
        int4* dst = reinterpret_cast<int4*>(p.tl() + (((size_t)(mt * 128 + tk) * 16 + nt) * 2 + hl) * 16);
        dst[0] = make_int4(L[0], L[1], L[2], L[3]); dst[1] = make_int4(L[4], L[5], L[6], L[7]);
        dst[2] = make_int4(L[8], L[9], L[10], L[11]); dst[3] = make_int4(L[12], L[13], L[14], L[15]);
      }
      __syncthreads();
    } else if (EPI != EPI_WIN) {
#pragma unroll
      for (int i = 0; i < 2; ++i)
#pragma unroll
        for (int j = 0; j < 2; ++j)
#pragma unroll
          for (int r = 0; r < 16; ++r) {
            int t = mt * 128 + wm * 64 + i * 32 + (r & 3) + 8 * (r >> 2) + 4 * lh;
            int n = nt * 128 + wn * 64 + j * 32 + lr;
            gemm_store<EPI>(p, l, t, n, acc[i][j][r]);
          }
    } else {
      const int seg = nt >> 2;
#pragma unroll
      for (int i = 0; i < 2; ++i)
#pragma unroll
        for (int j = 0; j < 2; ++j) {
          const int n = nt * 128 + wn * 64 + j * 32 + lr;
          if (nt < 4) {
#pragma unroll
            for (int r = 0; r < 16; ++r) {
              int t = mt * 128 + wm * 64 + i * 32 + (r & 3) + 8 * (r >> 2) + 4 * lh;
              p.Qb()[(size_t)t * 512 + n] = f2bf(acc[i][j][r] * (0.125f * LOG2E));
            }
          } else if (nt < 8) {
            const int n2 = n - 512;
#pragma unroll
            for (int r = 0; r < 16; ++r) {
              int t = mt * 128 + wm * 64 + i * 32 + (r & 3) + 8 * (r >> 2) + 4 * lh;
              float v = acc[i][j][r];
              if (t < NPROMPT) {
                p.out[O_K_P + (size_t)l * (4 * 4096 * 512) + (size_t)t * 512 + n2] = v;
                p.Kb()[(size_t)t * 512 + n2] = f2bf(v);
              } else {
                int ts = t - NPROMPT, b = ts >> 6, ii = ts & 63;
                p.out[O_K_S + (size_t)l * (8 * 64 * 512) + (size_t)ts * 512 + n2] = v;
                p.Kbs()[((size_t)(l * 8 + b) * SKEYS + 1024 + ii) * 512 + n2] = f2bf(v);
              }
            }
          } else if (nt < 12) {
            const int n2 = n - 1024, h = n2 >> 7, dv = n2 & 127;
#pragma unroll
            for (int rg = 0; rg < 4; ++rg) {
              int tb = mt * 128 + wm * 64 + i * 32 + 8 * rg + 4 * lh;
              float v0 = acc[i][j][rg * 4 + 0], v1 = acc[i][j][rg * 4 + 1], v2 = acc[i][j][rg * 4 + 2], v3 = acc[i][j][rg * 4 + 3];
              uint2 pk = make_uint2(pack2(v0, v1), pack2(v2, v3));
              int posblk = 2 * lh + (rg & 1);
              if (tb < NPROMPT) {
                float* o = p.out + O_V_P + (size_t)l * (4 * 4096 * 512) + (size_t)tb * 512 + n2;
                o[0] = v0; o[512] = v1; o[1024] = v2; o[1536] = v3;
                int b = tb >> 12, s = tb & 4095;
                int pos = (s & ~15) + posblk * 4;
                *reinterpret_cast<uint2*>(p.Vt() + ((size_t)(b * 4 + h) * 128 + dv) * SEQ + pos) = pk;
              } else {
                int ts = tb - NPROMPT, b = ts >> 6, ii = ts & 63;
                float* o = p.out + O_V_S + (size_t)l * (8 * 64 * 512) + (size_t)ts * 512 + n2;
                o[0] = v0; o[512] = v1; o[1024] = v2; o[1536] = v3;
                int pos = 1024 + (ii & ~15) + posblk * 4;
                *reinterpret_cast<uint2*>(p.Vts() + ((size_t)((l * 8 + b) * 4 + h) * 128 + dv) * SKEYS + pos) = pk;
              }
            }
          } else {
            const int n2 = n - 1536;
            const bool act = (n >= 2304);
#pragma unroll
            for (int r = 0; r < 16; ++r) {
              int t = mt * 128 + wm * 64 + i * 32 + (r & 3) + 8 * (r >> 2) + 4 * lh;
              float v = acc[i][j][r];
              if (act) v = gelu_exact(v);
              p.P5()[(size_t)t * 1280 + n2] = v;
            }
          }
        }
      (void)seg;
    }
  }
}

__device__ __forceinline__ void ph_attn(const Params& p, int l, char* smem, int bid, int nblk) {
  const int tid = tid_opaque(), lane = tid & 63, w = tid >> 6;
  const int c = w >> 1, qhalf = w & 1, lr = lane & 31, lh = lane >> 5;
  float* sLut = reinterpret_cast<float*>(smem + 65536);
  float* sO2 = reinterpret_cast<float*>(smem);
  const float lam = p.lam()[l];
  const float lam_init = 0.8f - 0.6f * expf(-0.3f * (float)l);

  for (int uu = bid; uu < 1056; uu += nblk) {
    int b, h, qc, S, qrow0; const bf16_t *Kbase, *Vbase;
    bool samp = false; int u2 = uu;
    if (uu >= 752 && uu < 784) samp = true; else if (uu >= 784) u2 = uu - 32;
    if (!samp) {
      qc = 63 - (u2 >> 4); int bh = u2 & 15; b = bh >> 2; h = bh & 3; S = SEQ;
      Kbase = p.Kb() + (size_t)b * SEQ * 512 + h * 128;
      Vbase = p.Vt() + (size_t)(b * 4 + h) * 128 * SEQ;
      qrow0 = b * SEQ + qc * 64;
    } else {
      int us = uu - 752; b = us >> 2; h = us & 3; qc = 16; S = SKEYS;
      Kbase = p.Kbs() + (size_t)(l * 8 + b) * SKEYS * 512 + h * 128;
      Vbase = p.Vts() + (size_t)((l * 8 + b) * 4 + h) * 128 * SKEYS;
      qrow0 = NPROMPT + b * 64;
    }
    const int ntiles = qc + 1;
    __syncthreads();
    sLut[tid] = p.lut()[h * 256 + tid];
    if (tid < 128) sLut[256 + tid] = p.da_subln_g()[l * 128 + tid];
    bf16x8 qf[4];
    {
      const bf16_t* qrow = p.Qb() + (size_t)(qrow0 + qhalf * 32 + lr) * 512 + h * 128 + c * 64 + lh * 8;
#pragma unroll
      for (int ks = 0; ks < 4; ++ks) qf[ks] = as_bf16x8(*reinterpret_cast<const uint4*>(qrow + ks * 16));
    }
    f32x16 o[4];
#pragma unroll
    for (int d = 0; d < 4; ++d)
#pragma unroll
      for (int r = 0; r < 16; ++r) o[d][r] = 0.f;
    float m_run = -1e30f, l_run = 0.f;
    const float c15 = p.lut()[h * 256];

    const char* Kt = reinterpret_cast<const char*>(Kbase);
    const char* Vb = reinterpret_cast<const char*>(Vbase);
    const int g_r8 = lane >> 3, g_pc = lane & 7;
#define ATTN_STAGE(KT, BUF)                                                                                         \
  _Pragma("unroll") for (int j = 0; j < 4; ++j) {                                                                   \
    const int I = w * 4 + j;                                                                                        \
    const int rk = (I & 7) * 8 + g_r8;                                                                              \
    const unsigned kof = (unsigned)rk * 1024u + (unsigned)(I >> 3) * 128u + (unsigned)((g_pc ^ ((rk >> 1) & 7)) * 16); \
    __builtin_amdgcn_global_load_lds((const unsigned*)(Kt + (size_t)(KT) * 65536 + kof),                            \
                                     (LAS unsigned*)(smem + (BUF) * 32768 + I * 1024 + lane * 16), 16, 0, 0);       \
    const int rv = I * 8 + g_r8;                                                                                    \
    const unsigned vof = (unsigned)rv * (unsigned)(S * 2) + (unsigned)((g_pc ^ ((rv >> 1) & 7)) * 16);              \
    __builtin_amdgcn_global_load_lds((const unsigned*)(Vb + (size_t)(KT) * 128 + vof),                              \
                                     (LAS unsigned*)(smem + (BUF) * 32768 + 16384 + I * 1024 + lane * 16), 16, 0, 0); \
  }
    ATTN_STAGE(0, 0)
    __syncthreads();
    for (int kt = 0; kt < ntiles; ++kt) {
      const int buf = kt & 1;
      if (kt + 1 < ntiles) { ATTN_STAGE(kt + 1, buf ^ 1) }
      const char* sK = smem + buf * 32768;
      const char* sV = sK + 16384;
      f32x16 s[2];
      {
        bf16x8 kf[2][4];
#pragma unroll
        for (int kb = 0; kb < 2; ++kb)
#pragma unroll
          for (int ks = 0; ks < 4; ++ks) {
            int row = kb * 32 + lr; int pc = (ks * 2 + lh) ^ ((row >> 1) & 7);
            kf[kb][ks] = as_bf16x8(*reinterpret_cast<const uint4*>(sK + c * 8192 + row * 128 + pc * 16));
          }
        __builtin_amdgcn_sched_barrier(0);
#pragma unroll
        for (int kb = 0; kb < 2; ++kb) {
#pragma unroll
          for (int r = 0; r < 16; ++r) s[kb][r] = 0.f;
#pragma unroll
          for (int ks = 0; ks < 4; ++ks) s[kb] = __builtin_amdgcn_mfma_f32_32x32x16_bf16(kf[kb][ks], qf[ks], s[kb], 0, 0, 0);
        }
      }
      bf16x8 vfa[2][4];
#pragma unroll
      for (int k2 = 0; k2 < 2; ++k2)
#pragma unroll
        for (int d = 0; d < 4; ++d) {
          int row = d * 32 + lr; int pc = (k2 * 2 + lh) ^ ((row >> 1) & 7);
          vfa[k2][d] = as_bf16x8(*reinterpret_cast<const uint4*>(sV + row * 128 + pc * 16));
        }
      __builtin_amdgcn_sched_barrier(0);
      float boff = c15;
      if (kt >= qc - 2) {
        const int base = (kt - qc) * 64 - (qhalf * 32 + lr) + 191 + 4 * lh;
#pragma unroll
        for (int kb = 0; kb < 2; ++kb)
#pragma unroll
          for (int r = 0; r < 16; ++r) s[kb][r] += sLut[base + kb * 32 + (r & 3) + 8 * (r >> 2)];
        boff = 0.f;
      }
      float mx = s[0][0];
#pragma unroll
      for (int kb = 0; kb < 2; ++kb)
#pragma unroll
        for (int r = 0; r < 16; ++r) mx = fmaxf(mx, s[kb][r]);
      mx = swap32_max(mx) + boff;
      if (__any(mx > m_run)) {
        const float m_new = fmaxf(m_run, mx);
        const float alpha = __builtin_amdgcn_exp2f(m_run - m_new);
        m_run = m_new;
        l_run *= alpha;
#pragma unroll
        for (int d = 0; d < 4; ++d)
#pragma unroll
          for (int r = 0; r < 16; ++r) o[d][r] *= alpha;
      }
      const float eoff = boff - m_run;
      float ps = 0.f;
#pragma unroll
      for (int kb = 0; kb < 2; ++kb)
#pragma unroll
        for (int r = 0; r < 16; ++r) { float pv = __builtin_amdgcn_exp2f(s[kb][r] + eoff); s[kb][r] = pv; ps += pv; }
      l_run += ps;
      bf16x8 pf[4];
#pragma unroll
      for (int ks2 = 0; ks2 < 4; ++ks2) {
        const int kb = ks2 >> 1, sh = (ks2 & 1) * 8;
        uint4 pw = make_uint4(pack2(s[kb][sh + 0], s[kb][sh + 1]), pack2(s[kb][sh + 2], s[kb][sh + 3]),
                              pack2(s[kb][sh + 4], s[kb][sh + 5]), pack2(s[kb][sh + 6], s[kb][sh + 7]));
        pf[ks2] = as_bf16x8(pw);
      }
      __builtin_amdgcn_sched_barrier(0);
#define ATTN_VREAD(DST, K2)                                                                        \
  _Pragma("unroll") for (int d = 0; d < 4; ++d) {                                                  \
    int row = d * 32 + lr; int pc = ((K2) * 2 + lh) ^ ((row >> 1) & 7);                            \
    DST[d] = as_bf16x8(*reinterpret_cast<const uint4*>(sV + row * 128 + pc * 16));                 \
  }
#define ATTN_PV(SRC, K2) \
  _Pragma("unroll") for (int d = 0; d < 4; ++d) o[d] = __builtin_amdgcn_mfma_f32_32x32x16_bf16(SRC[d], pf[K2], o[d], 0, 0, 0);
      bf16x8 vfc[4];
      ATTN_VREAD(vfc, 2)
      ATTN_PV(vfa[0], 0)
      __builtin_amdgcn_sched_barrier(0);
      ATTN_VREAD(vfa[0], 3)
      ATTN_PV(vfa[1], 1)
      __builtin_amdgcn_sched_barrier(0);
      ATTN_PV(vfc, 2)
      ATTN_PV(vfa[0], 3)
      __syncthreads();
    }
    int lane_e = lane; asm volatile("" : "+v"(lane_e));
    const int lr_e = lane_e & 31, lh_e = lane_e >> 5;
    float lt = swap32_sum(l_run);
    float inv = 1.f / lt;
    __syncthreads();
    if (c == 1) {
#pragma unroll
      for (int d = 0; d < 4; ++d)
#pragma unroll
        for (int r = 0; r < 16; ++r) sO2[(qhalf * 64 + d * 16 + r) * 64 + lane_e] = o[d][r] * inv;
    }
    __syncthreads();
    if (c == 0) {
      float ss = 0.f;
#pragma unroll
      for (int d = 0; d < 4; ++d)
#pragma unroll
        for (int r = 0; r < 16; ++r) {
          float v = o[d][r] * inv - lam * sO2[(qhalf * 64 + d * 16 + r) * 64 + lane_e];
          o[d][r] = v; ss += v * v;
        }
      ss = swap32_sum(ss);
      const float rn = rsqrtf(ss * (1.f / 128.f) + EPS) * (1.f - lam_init);
      const float* gs = sLut + 256;
      bf16_t* orow = p.xn() + (size_t)(qrow0 + qhalf * 32 + lr_e) * 1024 + h * 128;
#pragma unroll
      for (int d = 0; d < 4; ++d)
#pragma unroll
        for (int rg = 0; rg < 4; ++rg) {
          int dv = d * 32 + 8 * rg + 4 * lh_e;
          float4 g4 = *reinterpret_cast<const float4*>(gs + dv);
          uint2 pk = make_uint2(pack2(o[d][rg * 4 + 0] * rn * g4.x, o[d][rg * 4 + 1] * rn * g4.y),
                                pack2(o[d][rg * 4 + 2] * rn * g4.z, o[d][rg * 4 + 3] * rn * g4.w));
          *reinterpret_cast<uint2*>(orow + dv) = pk;
        }
    }
  }
}


template <int K>
__device__ __forceinline__ void mfma32_f32(f32x16& acc, const float* a, int a_rs, int a_ks, const float* b, int b_ks, int b_js, int lane) {
  const float* ap = a + (lane & 31) * a_rs + (lane >> 5) * a_ks;
  const float* bp = b + (lane >> 5) * b_ks + (lane & 31) * b_js;
#pragma unroll 8
  for (int k = 0; k < K; k += 2) acc = __builtin_amdgcn_mfma_f32_32x32x2f32(ap[k * a_ks], bp[k * b_ks], acc, 0, 0, 0);
}
__device__ __forceinline__ void zero16(f32x16& a) {
#pragma unroll
  for (int r = 0; r < 16; ++r) a[r] = 0.f;
}

__device__ __forceinline__ void ph_mlconv(const Params& p, int l, char* smem, int bid, int nblk) {
  const int tid = tid_opaque();
  float* s_mc = reinterpret_cast<float*>(smem);
  float* s_cc = s_mc + 67 * 64;
  float* s_wq = s_cc + 64 * 65;
  float* s_wk = s_wq + 4096;
  for (int u = bid; u < 264 * 4; u += nblk) {
    const int ci = u >> 2, h = u & 3;
    int token0, bq; bool samp = ci >= 256;
    if (!samp) token0 = ci * 64; else token0 = NPROMPT + (ci - 256) * 64;
    bq = samp ? (ci - 256) : (ci >> 6);
    const int cidx = samp ? 0 : (ci & 63);
    __syncthreads();
    for (int i = tid; i < 67 * 64; i += 256) {
      int r = i >> 6, d = i & 63;
      float v;
      if (r >= 3) v = p.P5()[(size_t)(token0 + r - 3) * 1280 + h * 64 + d];
      else if (samp) v = p.st_conv()[((size_t)(l * 8 + bq) * 3 + r) * 256 + h * 64 + d];
      else if (cidx == 0) v = 0.f;
      else v = p.P5()[(size_t)(token0 + r - 3) * 1280 + h * 64 + d];
      s_mc[i] = v;
    }
    for (int i = tid; i < 4096; i += 256) {
      s_wq[i] = p.ml_wq()[(size_t)(l * 4 + h) * 4096 + i];
      s_wk[i] = p.ml_wk()[(size_t)(l * 4 + h) * 4096 + i];
    }
    __syncthreads();
    {
      const int d = tid & 63, t0 = tid >> 6;
      const int ch = h * 64 + d;
      const float w0 = p.ml_conv_w()[(l * 4 + 0) * 256 + ch], w1 = p.ml_conv_w()[(l * 4 + 1) * 256 + ch];
      const float w2 = p.ml_conv_w()[(l * 4 + 2) * 256 + ch], w3 = p.ml_conv_w()[(l * 4 + 3) * 256 + ch];
      const float bb = p.ml_conv_b()[l * 256 + ch];
      for (int t = t0; t < 64; t += 4) {
        float y = bb + w0 * s_mc[t * 64 + d] + w1 * s_mc[(t + 1) * 64 + d] + w2 * s_mc[(t + 2) * 64 + d] + w3 * s_mc[(t + 3) * 64 + d];
        y = y * sigmoidf_(y);
        s_cc[t * 65 + d] = y;
        p.cc()[(size_t)(token0 + t) * 256 + ch] = y;
      }
      if (samp || cidx == 63) {
        if (tid < 192) {
          int r = tid >> 6;
          float v = s_mc[(64 + r) * 64 + d];
          if (samp) p.out[O_CONV_S + ((size_t)(l * 8 + bq) * 3 + r) * 256 + ch] = v;
          else p.out[O_CONV_P + ((size_t)(l * 4 + bq) * 3 + r) * 256 + ch] = v;
        }
      }
    }
    __syncthreads();
    {
      const int lane = tid & 63, w = tid >> 6, ti = w >> 1, tj = w & 1;
      f32x16 aq, ak; zero16(aq); zero16(ak);
      mfma32_f32<64>(aq, s_cc + ti * 32 * 65, 65, 1, s_wq + tj * 32, 64, 1, lane);
      mfma32_f32<64>(ak, s_cc + ti * 32 * 65, 65, 1, s_wk + tj * 32, 64, 1, lane);
#pragma unroll
      for (int r = 0; r < 16; ++r) {
        const int t = ti * 32 + (r & 3) + 8 * (r >> 2) + 4 * (lane >> 5);
        const size_t o = (size_t)(token0 + t) * 256 + h * 64 + tj * 32 + (lane & 31);
        p.qm()[o] = aq[r];
        p.km()[o] = ak[r] * 0.125f;
      }
      if (w == 0) {
        const int t = token0 + lane;
        const float lfv = p.lf()[(size_t)t * 4 + h], igv = p.ig()[(size_t)t * 4 + h];
        float F = lfv;
#pragma unroll
        for (int d = 1; d < 64; d <<= 1) { float n = __shfl_up(F, d); if (lane >= d) F += n; }
        const float FL = __shfl(F, 63);
        const float mx = wave_max(FL - F + igv);
        p.Fc()[(size_t)t * 4 + h] = F;
        if (lane == 0) {
          const int cu = samp ? 1024 + bq * 4 + h : (bq * 4 + h) * 64 + cidx;
          p.FLs()[cu] = FL; p.mxt()[cu] = mx;
        }
      }
    }
  }
}

__device__ __forceinline__ void cu_decode(int cu, int& token0, int& h) {
  if (cu < 1024) { int bh = cu >> 6, c = cu & 63; token0 = (bh >> 2) * SEQ + c * 64; h = bh & 3; }
  else { int us = cu - 1024; token0 = NPROMPT + (us >> 2) * 64; h = us & 3; }
}

__device__ __forceinline__ void ph_mlU(const Params& p, int l, char* smem, int bid, int nblk) {
  const int tid = tid_opaque();
  const int lane = tid & 63, w = tid >> 6, ti = w >> 1, tj = w & 1;
  float* s_k = reinterpret_cast<float*>(smem);
  float* s_v = s_k + 4096;
  for (int cu = bid; cu < NCU_UNITS; cu += nblk) {
    int token0, h; cu_decode(cu, token0, h);
    float m0, mn, FL;
    {
      const bool samp = cu >= 1024;
      const int cu0 = samp ? cu : (cu & ~63), c = samp ? 0 : (cu & 63);
      float flv = 0.f, mxv = 0.f;
      if (lane <= c) { flv = p.FLs()[cu0 + lane]; mxv = p.mxt()[cu0 + lane]; }
      float m = samp ? p.st_m()[l * 32 + (cu - 1024)] : 0.f;
      for (int j = 0; j < c; ++j) {
        const float fj = __int_as_float(__builtin_amdgcn_readlane(__float_as_int(flv), j));
        const float xj = __int_as_float(__builtin_amdgcn_readlane(__float_as_int(mxv), j));
        m = fmaxf(fj + m, xj);
      }
      FL = __int_as_float(__builtin_amdgcn_readlane(__float_as_int(flv), c));
      const float xc = __int_as_float(__builtin_amdgcn_readlane(__float_as_int(mxv), c));
      m0 = m; mn = fmaxf(FL + m, xc);
      if (tid == 0) {
        p.mst()[cu] = m0; p.mnx()[cu] = mn; p.wcs()[cu] = expf(FL + m0 - mn);
        if (samp) p.out[O_M_S + l * 32 + (cu - 1024)] = mn;
        else if (c == 63) p.out[O_M_P + l * 16 + (cu >> 6)] = mn;
      }
    }
    __syncthreads();
    for (int i = tid; i < 1024; i += 256) {
      int s = i >> 4, d4 = (i & 15) * 4;
      const int t = token0 + s;
      float wsv = expf(FL - p.Fc()[(size_t)t * 4 + h] + p.ig()[(size_t)t * 4 + h] - mn);
      float4 k4 = *reinterpret_cast<const float4*>(p.km() + (size_t)t * 256 + h * 64 + d4);
      float4 v4 = *reinterpret_cast<const float4*>(p.P5() + (size_t)t * 1280 + 256 + h * 64 + d4);
      *reinterpret_cast<float4*>(s_k + s * 64 + d4) = make_float4(k4.x * wsv, k4.y * wsv, k4.z * wsv, k4.w * wsv);
      *reinterpret_cast<float4*>(s_v + s * 64 + d4) = v4;
    }
    __syncthreads();
    f32x16 acc; zero16(acc);
    mfma32_f32<64>(acc, s_k + ti * 32, 1, 64, s_v + tj * 32, 64, 1, lane);
#pragma unroll
    for (int r = 0; r < 16; ++r) {
      const int d = ti * 32 + (r & 3) + 8 * (r >> 2) + 4 * (lane >> 5);
      p.U()[(size_t)cu * 4096 + d * 64 + tj * 32 + (lane & 31)] = acc[r];
    }
    if (tid < 64) {
      float s0 = 0.f;
      for (int s = 0; s < 64; ++s) s0 += s_k[s * 64 + tid];
      p.un()[(size_t)cu * 64 + tid] = s0;
    }
  }
}

__device__ __forceinline__ void ph_mlscan(const Params& p, int l, int bid, int nblk) {
  const size_t gtid = (size_t)bid * 256 + tid_opaque(), gsz = (size_t)nblk * 256;
  const size_t NPC = 16 * 4096, NSC = 32 * 4096, NPN = 16 * 64, NSN = 32 * 64;
  for (size_t i = gtid; i < NPC + NSC + NPN + NSN; i += gsz) {
    if (i < NPC) {
      int bh = (int)(i >> 12), e = (int)(i & 4095);
      float C = 0.f;
      for (int c = 0; c < 64; ++c) {
        int cu = bh * 64 + c;
        p.Cst()[(size_t)cu * 4096 + e] = C;
        C = p.wcs()[cu] * C + p.U()[(size_t)cu * 4096 + e];
      }
      p.out[O_C_P + (size_t)l * (16 * 4096) + i] = C;
    } else if (i < NPC + NSC) {
      size_t j = i - NPC; int us = (int)(j >> 12), e = (int)(j & 4095); int cu = 1024 + us;
      float C = p.st_c()[(size_t)l * (32 * 4096) + j];
      p.Cst()[(size_t)cu * 4096 + e] = C;
      p.out[O_C_S + (size_t)l * (32 * 4096) + j] = p.wcs()[cu] * C + p.U()[(size_t)cu * 4096 + e];
    } else if (i < NPC + NSC + NPN) {
      size_t j = i - NPC - NSC; int bh = (int)(j >> 6), d = (int)(j & 63);
      float n = 0.f;
      for (int c = 0; c < 64; ++c) {
        int cu = bh * 64 + c;
        p.nst()[(size_t)cu * 64 + d] = n;
        n = p.wcs()[cu] * n + p.un()[(size_t)cu * 64 + d];
      }
      p.out[O_N_P + (size_t)l * (16 * 64) + j] = n;
    } else {
      size_t j = i - NPC - NSC - NPN; int us = (int)(j >> 6), d = (int)(j & 63); int cu = 1024 + us;
      float n = p.st_n()[(size_t)l * (32 * 64) + j];
      p.nst()[(size_t)cu * 64 + d] = n;
      p.out[O_N_S + (size_t)l * (32 * 64) + j] = p.wcs()[cu] * n + p.un()[(size_t)cu * 64 + d];
    }
  }
}

__device__ __forceinline__ void ph_mlout(const Params& p, int l, char* smem, int bid, int nblk) {
  const int tid = tid_opaque();
  float* s_q = reinterpret_cast<float*>(smem);
  float* s_k = s_q + 64 * 65;
  float* s_v = s_k + 64 * 65;
  float* s_C = s_v + 4096;
  float* s_F = s_C + 4096;
  float* s_a = s_F + 64;
  float* s_mt = s_a + 64;
  float* s_iw = s_mt + 64;
  float* s_n = s_iw + 64;
  float* s_den = s_n + 64;
  for (int cu = bid; cu < NCU_UNITS; cu += nblk) {
    int token0, h; cu_decode(cu, token0, h);
    const float m0 = p.mst()[cu];
    __syncthreads();
    for (int i = tid; i < 1024; i += 256) {
      int s = i >> 4, d4 = (i & 15) * 4;
      const int t = token0 + s;
      float4 q4 = *reinterpret_cast<const float4*>(p.qm() + (size_t)t * 256 + h * 64 + d4);
      float4 k4 = *reinterpret_cast<const float4*>(p.km() + (size_t)t * 256 + h * 64 + d4);
      float4 v4 = *reinterpret_cast<const float4*>(p.P5() + (size_t)t * 1280 + 256 + h * 64 + d4);
      float4 c4 = *reinterpret_cast<const float4*>(p.Cst() + (size_t)cu * 4096 + s * 64 + d4);
      s_q[s * 65 + d4] = q4.x; s_q[s * 65 + d4 + 1] = q4.y; s_q[s * 65 + d4 + 2] = q4.z; s_q[s * 65 + d4 + 3] = q4.w;
      s_k[s * 65 + d4] = k4.x; s_k[s * 65 + d4 + 1] = k4.y; s_k[s * 65 + d4 + 2] = k4.z; s_k[s * 65 + d4 + 3] = k4.w;
      *reinterpret_cast<float4*>(s_v + s * 64 + d4) = v4;
      *reinterpret_cast<float4*>(s_C + s * 64 + d4) = c4;
    }
    if (tid < 64) {
      const int t = token0 + tid;
      float F = p.Fc()[(size_t)t * 4 + h], g = p.ig()[(size_t)t * 4 + h];
      s_F[tid] = F; s_a[tid] = g - F;
      s_n[tid] = p.nst()[(size_t)cu * 64 + tid];
    }
    __syncthreads();
    if (tid < 64) {
      float pm = -1e30f;
      for (int s = 0; s <= tid; ++s) pm = fmaxf(pm, s_a[s]);
      float F = s_F[tid];
      float mt = F + fmaxf(m0, pm);
      s_mt[tid] = mt;
      s_iw[tid] = expf(F + m0 - mt);
    }
    __syncthreads();
    const int lane = tid & 63, w = tid >> 6, ti = w >> 1, tj = w & 1;
    const int ty = tid >> 4, tx = tid & 15;
    {
      f32x16 accS; zero16(accS);
      mfma32_f32<64>(accS, s_q + ti * 32 * 65, 65, 1, s_k + tj * 32 * 65, 1, 65, lane);
      __syncthreads();
      const int s = tj * 32 + (lane & 31);
      const float as = s_a[s];
#pragma unroll
      for (int r = 0; r < 16; ++r) {
        const int t = ti * 32 + (r & 3) + 8 * (r >> 2) + 4 * (lane >> 5);
        s_k[t * 65 + s] = (s <= t) ? accS[r] * expf(s_F[t] + as - s_mt[t]) : 0.f;
      }
    }
    __syncthreads();
    if (tid < 64) {
      float den = 0.f, qn = 0.f;
      for (int s = 0; s < 64; ++s) { den += s_k[tid * 65 + s]; qn += s_q[tid * 65 + s] * s_n[s]; }
      s_den[tid] = den + s_iw[tid] * qn;
    }
    {
      f32x16 accN, accC; zero16(accN); zero16(accC);
      mfma32_f32<64>(accN, s_k + ti * 32 * 65, 65, 1, s_v + tj * 32, 64, 1, lane);
      mfma32_f32<64>(accC, s_q + ti * 32 * 65, 65, 1, s_C + tj * 32, 64, 1, lane);
      __syncthreads();
#pragma unroll
      for (int r = 0; r < 16; ++r) {
        const int t = ti * 32 + (r & 3) + 8 * (r >> 2) + 4 * (lane >> 5);
        s_q[t * 65 + tj * 32 + (lane & 31)] = accN[r] + s_iw[t] * accC[r];
      }
    }
    __syncthreads();
#pragma unroll
    for (int i = 0; i < 4; ++i) {
      const int t = ty * 4 + i;
      const float dn = fmaxf(fabsf(s_den[t]), expf(-s_mt[t]));
      float hv[4]; float ss = 0.f;
#pragma unroll
      for (int j = 0; j < 4; ++j) { hv[j] = s_q[t * 65 + tx * 4 + j] / dn; ss += hv[j] * hv[j]; }
      ss = row16_sum(ss);
      const float rn = rsqrtf(ss * (1.f / 64.f) + EPS);
      const int ch = h * 64 + tx * 4;
      const size_t tg = (size_t)(token0 + t);
      float4 g4 = *reinterpret_cast<const float4*>(p.ml_norm_g() + l * 256 + ch);
      float4 k4 = *reinterpret_cast<const float4*>(p.ml_skip() + l * 256 + ch);
      float4 c4 = *reinterpret_cast<const float4*>(p.cc() + tg * 256 + ch);
      float4 o4 = *reinterpret_cast<const float4*>(p.P5() + tg * 1280 + 512 + ch);
      float r0 = (hv[0] * rn * g4.x + k4.x * c4.x) * sigmoidf_(o4.x);
      float r1 = (hv[1] * rn * g4.y + k4.y * c4.y) * sigmoidf_(o4.y);
      float r2 = (hv[2] * rn * g4.z + k4.z * c4.z) * sigmoidf_(o4.z);
      float r3 = (hv[3] * rn * g4.w + k4.w * c4.w) * sigmoidf_(o4.w);
      *reinterpret_cast<uint2*>(p.xn() + tg * 1024 + 512 + ch) = make_uint2(pack2(r0, r1), pack2(r2, r3));
    }
  }
}

__device__ __forceinline__ void ph_cmlp(const Params& p, int l, char* smem, int bid, int nblk) {
  const int tid = tid_opaque(), lane = tid & 63, w = tid >> 6;
  float* s_vg = reinterpret_cast<float*>(smem);
  float* s_ws = s_vg + 128 * 64;
  float* s_r = s_ws + 128 * 33;
  for (int u = bid; u < 544; u += nblk) {
    const int g = u & 3, ci = u >> 2;
    const bool samp = ci >= 128;
    const int L = samp ? 64 : 128;
    const int token0 = samp ? NPROMPT + (ci - 128) * 64 : ci * 128;
    __syncthreads();
    for (int r = w; r < L; r += 4) {
      float4 v = *reinterpret_cast<const float4*>(p.P5() + (size_t)(token0 + r) * 1280 + 1024 + lane * 4);
      float ss = v.x * v.x + v.y * v.y + v.z * v.z + v.w * v.w;
      ss = wave_sum(ss);
      if (lane == 0) s_r[r] = rsqrtf(ss * (1.f / 256.f) + EPS);
    }
    __syncthreads();
    for (int i = tid; i < L * 16; i += 256) {
      int s = i >> 4, d4 = (i & 15) * 4;
      float4 v = *reinterpret_cast<const float4*>(p.P5() + (size_t)(token0 + s) * 1280 + 1024 + g * 64 + d4);
      float4 gn = *reinterpret_cast<const float4*>(p.cm_norm_g() + l * 256 + g * 64 + d4);
      float r = s_r[s];
      float4 o = make_float4(v.x * r * gn.x, v.y * r * gn.y, v.z * r * gn.z, v.w * r * gn.w);
      *reinterpret_cast<float4*>(s_vg + s * 64 + d4) = o;
      if (samp) {
        int ts = token0 - NPROMPT + s;
        *reinterpret_cast<float4*>(p.out + O_CMV_S + (size_t)l * (512 * 256) + (size_t)ts * 256 + g * 64 + d4) = o;
      }
    }
    const int rtA = (w < 2) ? 3 : 2, rtB = (w < 2) ? 0 : 1, ct = w & 1;
    const int nrt = L >> 5;
    f32x16 accA, accB; zero16(accA); zero16(accB);
    const float* wsg = p.cm_ws() + (size_t)(l * 4 + g) * 128 * 128;
    for (int s0 = 0; s0 < L; s0 += 32) {
      __syncthreads();
      for (int i = tid; i < L * 32; i += 256) {
        int t = i >> 5, ss = i & 31;
        s_ws[t * 33 + ss] = (s0 + ss <= t) ? wsg[t * 128 + s0 + ss] : 0.f;
      }
      __syncthreads();
      const int c = s0 >> 5;
      if (rtA < nrt && c <= rtA) mfma32_f32<32>(accA, s_ws + rtA * 32 * 33, 33, 1, s_vg + s0 * 64 + ct * 32, 64, 1, lane);
      if (rtB < nrt && c <= rtB) mfma32_f32<32>(accB, s_ws + rtB * 32 * 33, 33, 1, s_vg + s0 * 64 + ct * 32, 64, 1, lane);
    }
    __syncthreads();
#pragma unroll
    for (int r = 0; r < 16; ++r) {
      const int tr = (r & 3) + 8 * (r >> 2) + 4 * (lane >> 5);
      if (rtA < nrt) s_vg[(rtA * 32 + tr) * 64 + ct * 32 + (lane & 31)] = accA[r];
      if (rtB < nrt) s_vg[(rtB * 32 + tr) * 64 + ct * 32 + (lane & 31)] = accB[r];
    }
    __syncthreads();
    {
      const int ty = tid >> 4, tx = tid & 15;
      if (ty * 8 < L) {
#pragma unroll
        for (int i = 0; i < 8; ++i) {
          const int t = ty * 8 + i;
          const float bb = p.cm_b()[(l * 4 + g) * 128 + t];
          const size_t tg = (size_t)(token0 + t);
          float4 a4 = *reinterpret_cast<const float4*>(s_vg + t * 64 + tx * 4);
          float4 u4 = *reinterpret_cast<const float4*>(p.P5() + tg * 1280 + 768 + g * 64 + tx * 4);
          *reinterpret_cast<uint2*>(p.xn() + tg * 1024 + 768 + g * 64 + tx * 4) =
              make_uint2(pack2(u4.x * (a4.x + bb), u4.y * (a4.y + bb)), pack2(u4.z * (a4.z + bb), u4.w * (a4.w + bb)));
        }
      }
    }
  }
}

__device__ __forceinline__ void ph_topk(const Params& p, int l, char* smem, int bid, int nblk) {
  const int tid = tid_opaque(), lane = tid & 63, w = tid >> 6;
  float* s_tile = reinterpret_cast<float*>(smem) + w * (64 * 33);
  int* s_list = reinterpret_cast<int*>(smem + 4 * 64 * 33 * 4) + w * (2 * 16 * 64);
  float* s_ss = reinterpret_cast<float*>(smem + 4 * 64 * 33 * 4 + 4 * 2 * 16 * 64 * 4) + w * 64;
  for (int u = bid * 4 + w; u < 264 * 8; u += nblk * 4) {
    const int tg = u >> 3, h = u & 7;
    const int t0 = tg * 64;
    {
      const float4 pp = *reinterpret_cast<const float4*>(p.ssp() + (size_t)(t0 + lane) * 32 + h * 4);
      s_ss[lane] = pp.x + pp.y + pp.z + pp.w;
    }
    int L1[16], L2[16];
#pragma unroll
    for (int j = 0; j < 16; ++j) { L1[j] = (int)0x80000000; L2[j] = (int)0x80000000; }
#pragma unroll
    for (int c = 0; c < 2; ++c) {
      const int4* la = reinterpret_cast<const int4*>(p.tl() + (((size_t)(t0 + lane) * 16 + h * 2 + c) * 2) * 16);
      int A[16], B[16];
#pragma unroll
      for (int q = 0; q < 4; ++q) {
        const int4 a = la[q], b = la[4 + q];
        A[4 * q] = a.x; A[4 * q + 1] = a.y; A[4 * q + 2] = a.z; A[4 * q + 3] = a.w;
        B[4 * q] = b.x; B[4 * q + 1] = b.y; B[4 * q + 2] = b.z; B[4 * q + 3] = b.w;
      }
#pragma unroll
      for (int j = 0; j < 16; ++j) INS16(A, B[j])
#pragma unroll
      for (int j = 0; j < 16; ++j) { if (c == 0) L1[j] = A[j]; else L2[j] = A[j]; }
    }
#pragma unroll
    for (int j = 0; j < 16; ++j) { s_list[(0 * 16 + j) * 64 + lane] = 127 - (L1[j] & 127); s_list[(1 * 16 + j) * 64 + lane] = 127 - (L2[j] & 127); }
    float v1[16], v2[16];
#pragma unroll
    for (int j = 0; j < 16; ++j) { v1[j] = mono_val(L1[j] & ~127); v2[j] = mono_val(L2[j] & ~127); }
    int LC[16];
#pragma unroll
    for (int j = 0; j < 16; ++j) LC[j] = (int)0x80000000;
#pragma unroll
    for (int i = 0; i < 16; ++i)
#pragma unroll
      for (int j = 0; j < 16; ++j)
        if ((i + 1) * (j + 1) <= 16) {
          int key = (mono_key(v1[i] + v2[j]) & ~255) | (255 - (i * 16 + j));
          INS16(LC, key)
        }
    const float scale = rsqrtf(s_ss[lane] * (1.f / 256.f) + EPS);
    float vs[16]; float den = 0.f;
    const float top = mono_val(LC[0] & ~255);
#pragma unroll
    for (int k = 0; k < 16; ++k) { vs[k] = __expf((mono_val(LC[k] & ~255) - top) * scale); den += vs[k]; }
    const float inv = 1.f / den;
    const size_t ob = (size_t)(t0 + lane) * 128 + h * 16;
#pragma unroll
    for (int k4 = 0; k4 < 4; ++k4) {
      int ee[4]; float gg[4], su[4];
#pragma unroll
      for (int q = 0; q < 4; ++q) {
        int k = k4 * 4 + q;
        int ci = 255 - (LC[k] & 255);
        int i1 = s_list[(0 * 16 + (ci >> 4)) * 64 + lane];
        int i2 = s_list[(1 * 16 + (ci & 15)) * 64 + lane];
        ee[q] = i1 * 128 + i2;
        gg[q] = vs[k] * inv * p.vs()[l * 16384 + ee[q]];
        su[q] = p.us()[l * 16384 + ee[q]];
      }
      *reinterpret_cast<int4*>(p.eidx() + ob + k4 * 4) = make_int4(ee[0], ee[1], ee[2], ee[3]);
      *reinterpret_cast<float4*>(p.egate() + ob + k4 * 4) = make_float4(gg[0], gg[1], gg[2], gg[3]);
      *reinterpret_cast<float4*>(p.esu() + ob + k4 * 4) = make_float4(su[0], su[1], su[2], su[3]);
    }
  }
}

__device__ __forceinline__ float dot16_fp8(const float* xf, uint4 u) {
  f32x2 a0 = __builtin_amdgcn_cvt_pk_f32_fp8(u.x, false), a1 = __builtin_amdgcn_cvt_pk_f32_fp8(u.x, true);
  f32x2 a2 = __builtin_amdgcn_cvt_pk_f32_fp8(u.y, false), a3 = __builtin_amdgcn_cvt_pk_f32_fp8(u.y, true);
  f32x2 a4 = __builtin_amdgcn_cvt_pk_f32_fp8(u.z, false), a5 = __builtin_amdgcn_cvt_pk_f32_fp8(u.z, true);
  f32x2 a6 = __builtin_amdgcn_cvt_pk_f32_fp8(u.w, false), a7 = __builtin_amdgcn_cvt_pk_f32_fp8(u.w, true);
  float s0 = xf[0] * a0.x, s1 = xf[1] * a0.y;
  s0 = fmaf(xf[2], a1.x, s0); s1 = fmaf(xf[3], a1.y, s1);
  s0 = fmaf(xf[4], a2.x, s0); s1 = fmaf(xf[5], a2.y, s1);
  s0 = fmaf(xf[6], a3.x, s0); s1 = fmaf(xf[7], a3.y, s1);
  s0 = fmaf(xf[8], a4.x, s0); s1 = fmaf(xf[9], a4.y, s1);
  s0 = fmaf(xf[10], a5.x, s0); s1 = fmaf(xf[11], a5.y, s1);
  s0 = fmaf(xf[12], a6.x, s0); s1 = fmaf(xf[13], a6.y, s1);
  s0 = fmaf(xf[14], a7.x, s0); s1 = fmaf(xf[15], a7.y, s1);
  return s0 + s1;
}
__device__ __forceinline__ void axpy16_fp8(float* y, float wgt, uint4 v) {
  f32x2 a0 = __builtin_amdgcn_cvt_pk_f32_fp8(v.x, false), a1 = __builtin_amdgcn_cvt_pk_f32_fp8(v.x, true);
  f32x2 a2 = __builtin_amdgcn_cvt_pk_f32_fp8(v.y, false), a3 = __builtin_amdgcn_cvt_pk_f32_fp8(v.y, true);
  f32x2 a4 = __builtin_amdgcn_cvt_pk_f32_fp8(v.z, false), a5 = __builtin_amdgcn_cvt_pk_f32_fp8(v.z, true);
  f32x2 a6 = __builtin_amdgcn_cvt_pk_f32_fp8(v.w, false), a7 = __builtin_amdgcn_cvt_pk_f32_fp8(v.w, true);
  y[0] = fmaf(wgt, a0.x, y[0]); y[1] = fmaf(wgt, a0.y, y[1]); y[2] = fmaf(wgt, a1.x, y[2]); y[3] = fmaf(wgt, a1.y, y[3]);
  y[4] = fmaf(wgt, a2.x, y[4]); y[5] = fmaf(wgt, a2.y, y[5]); y[6] = fmaf(wgt, a3.x, y[6]); y[7] = fmaf(wgt, a3.y, y[7]);
  y[8] = fmaf(wgt, a4.x, y[8]); y[9] = fmaf(wgt, a4.y, y[9]); y[10] = fmaf(wgt, a5.x, y[10]); y[11] = fmaf(wgt, a5.y, y[11]);
  y[12] = fmaf(wgt, a6.x, y[12]); y[13] = fmaf(wgt, a6.y, y[13]); y[14] = fmaf(wgt, a7.x, y[14]); y[15] = fmaf(wgt, a7.y, y[15]);
}

template <bool DRY>
__device__ __forceinline__ void ph_gather(const Params& p, int l, int bid, int nblk) {
  const int lane = tid_opaque() & 63, w = tid_opaque() >> 6;
  const unsigned char* u8 = p.ub8() + (size_t)l * 16384 * 1024;
  const unsigned char* v8 = p.vb8() + (size_t)l * 16384 * 1024;
  const unsigned loff = (unsigned)lane * 16u;
  for (int t = bid * 4 + w; t < NTOK; t += nblk * 4) {
    float xf[16];
    {
      const uint4 xa = *reinterpret_cast<const uint4*>(p.xn() + (size_t)t * 1024 + lane * 16);
      const uint4 xb = *reinterpret_cast<const uint4*>(p.xn() + (size_t)t * 1024 + lane * 16 + 8);
      xf[0] = bf_lo(xa.x); xf[1] = bf_hi(xa.x); xf[2] = bf_lo(xa.y); xf[3] = bf_hi(xa.y);
      xf[4] = bf_lo(xa.z); xf[5] = bf_hi(xa.z); xf[6] = bf_lo(xa.w); xf[7] = bf_hi(xa.w);
      xf[8] = bf_lo(xb.x); xf[9] = bf_hi(xb.x); xf[10] = bf_lo(xb.y); xf[11] = bf_hi(xb.y);
      xf[12] = bf_lo(xb.z); xf[13] = bf_hi(xb.z); xf[14] = bf_lo(xb.w); xf[15] = bf_hi(xb.w);
    }
    const int e_lo = p.eidx()[(size_t)t * 128 + lane], e_hi = p.eidx()[(size_t)t * 128 + 64 + lane];
    const float g_lo = p.egate()[(size_t)t * 128 + lane], g_hi = p.egate()[(size_t)t * 128 + 64 + lane];
    const float s_lo = p.esu()[(size_t)t * 128 + lane], s_hi = p.esu()[(size_t)t * 128 + 64 + lane];
    float y[16];
#pragma unroll
    for (int i = 0; i < 16; ++i) y[i] = 0.f;
#pragma unroll 1
    for (int k0 = 0; k0 < 128; k0 += 8) {
      uint4 ur[8], vr[8];
#pragma unroll
      for (int q = 0; q < 8; ++q) {
        const int kk = (k0 & 63) + q;
        const int e = (k0 < 64) ? __builtin_amdgcn_readlane(e_lo, kk) : __builtin_amdgcn_readlane(e_hi, kk);
        ur[q] = *reinterpret_cast<const uint4*>(u8 + (size_t)e * 1024 + loff);
        vr[q] = *reinterpret_cast<const uint4*>(v8 + (size_t)e * 1024 + loff);
      }
#pragma unroll
      for (int q = 0; q < 8; ++q) {
        const int kk = (k0 & 63) + q;
        const float gt = __int_as_float((k0 < 64) ? __builtin_amdgcn_readlane(__float_as_int(g_lo), kk) : __builtin_amdgcn_readlane(__float_as_int(g_hi), kk));
        const float su = __int_as_float((k0 < 64) ? __builtin_amdgcn_readlane(__float_as_int(s_lo), kk) : __builtin_amdgcn_readlane(__float_as_int(s_hi), kk));
        float d = wave_sum(dot16_fp8(xf, ur[q])) * su;
        const float wgt = gt * gelu_exact(d);
        axpy16_fp8(y, wgt, vr[q]);
      }
    }
    if (DRY) {
#pragma unroll
      for (int i = 0; i < 16; ++i) asm volatile("" ::"v"(y[i]));
      continue;
    }
    float* xr = p.x() + (size_t)t * 1024 + lane * 16;
#pragma unroll
    for (int j = 0; j < 4; ++j) {
      float4 a = reinterpret_cast<float4*>(xr)[j];
      a.x += y[4 * j]; a.y += y[4 * j + 1]; a.z += y[4 * j + 2]; a.w += y[4 * j + 3];
      reinterpret_cast<float4*>(xr)[j] = a;
    }
  }
}

enum { PH_PREP = 0, PH_NORM1, PH_GEMM_IN, PH_ATTN, PH_MLCONV, PH_MCHAIN, PH_MLU, PH_MLSCAN, PH_MLOUT, PH_CMLP,
       PH_GEMM_OUT, PH_NORM2, PH_GEMM_PQ, PH_GEMM_SC, PH_TOPK, PH_GATHER, PH_FINAL };

__device__ __forceinline__ Params phase_params(const Params& kp, bool with_inputs) {
  Params q;
  size_t z = 0;
  asm volatile("" : "+s"(z));
  q.out = kp.out + z;
  q.ws = kp.ws + z;
  q.in[0] = kp.in[0] + z;
  q.in[1] = kp.in[1] + z;
  if (with_inputs) {
#pragma unroll
    for (int i = 2; i < 30; ++i) q.in[i] = kp.in[i] + z;
  }
  return q;
}


#define GT 4
typedef __attribute__((ext_vector_type(4))) float f32x4;

__device__ __forceinline__ float dot16_fp8v(const f32x2* x2, uint4 u) {
  f32x2 acc = x2[0] * __builtin_amdgcn_cvt_pk_f32_fp8(u.x, false);
  acc += x2[1] * __builtin_amdgcn_cvt_pk_f32_fp8(u.x, true);
  acc += x2[2] * __builtin_amdgcn_cvt_pk_f32_fp8(u.y, false);
  acc += x2[3] * __builtin_amdgcn_cvt_pk_f32_fp8(u.y, true);
  acc += x2[4] * __builtin_amdgcn_cvt_pk_f32_fp8(u.z, false);
  acc += x2[5] * __builtin_amdgcn_cvt_pk_f32_fp8(u.z, true);
  acc += x2[6] * __builtin_amdgcn_cvt_pk_f32_fp8(u.w, false);
  acc += x2[7] * __builtin_amdgcn_cvt_pk_f32_fp8(u.w, true);
  return acc.x + acc.y;
}
__device__ __forceinline__ void axpy16_fp8v(f32x2* y2, float wgt, uint4 v) {
  const f32x2 w2 = {wgt, wgt};
  y2[0] += w2 * __builtin_amdgcn_cvt_pk_f32_fp8(v.x, false);
  y2[1] += w2 * __builtin_amdgcn_cvt_pk_f32_fp8(v.x, true);
  y2[2] += w2 * __builtin_amdgcn_cvt_pk_f32_fp8(v.y, false);
  y2[3] += w2 * __builtin_amdgcn_cvt_pk_f32_fp8(v.y, true);
  y2[4] += w2 * __builtin_amdgcn_cvt_pk_f32_fp8(v.z, false);
  y2[5] += w2 * __builtin_amdgcn_cvt_pk_f32_fp8(v.z, true);
  y2[6] += w2 * __builtin_amdgcn_cvt_pk_f32_fp8(v.w, false);
  y2[7] += w2 * __builtin_amdgcn_cvt_pk_f32_fp8(v.w, true);
}

struct GU { uint4 ur[4]; f32x4 su; };
struct GV { uint4 vr[4]; f32x4 gt; };
#define GREC 384
__device__ __forceinline__ void gload_u(GU& U, const float* rec, int i4, const unsigned char* u8, unsigned loff) {
  const f32x4 ev = *reinterpret_cast<const f32x4*>(rec + i4);
  U.su = *reinterpret_cast<const f32x4*>(rec + 256 + i4);
  const int e0 = __builtin_amdgcn_readfirstlane(__float_as_int(ev.x)), e1 = __builtin_amdgcn_readfirstlane(__float_as_int(ev.y));
  const int e2 = __builtin_amdgcn_readfirstlane(__float_as_int(ev.z)), e3 = __builtin_amdgcn_readfirstlane(__float_as_int(ev.w));
  U.ur[0] = *reinterpret_cast<const uint4*>(u8 + (size_t)e0 * 1024 + loff);
  U.ur[1] = *reinterpret_cast<const uint4*>(u8 + (size_t)e1 * 1024 + loff);
  U.ur[2] = *reinterpret_cast<const uint4*>(u8 + (size_t)e2 * 1024 + loff);
  U.ur[3] = *reinterpret_cast<const uint4*>(u8 + (size_t)e3 * 1024 + loff);
}
__device__ __forceinline__ void gload_v(GV& V, const float* rec, int i4, const unsigned char* v8, unsigned loff) {
  const f32x4 ev = *reinterpret_cast<const f32x4*>(rec + i4);
  V.gt = *reinterpret_cast<const f32x4*>(rec + 128 + i4);
  const int e0 = __builtin_amdgcn_readfirstlane(__float_as_int(ev.x)), e1 = __builtin_amdgcn_readfirstlane(__float_as_int(ev.y));
  const int e2 = __builtin_amdgcn_readfirstlane(__float_as_int(ev.z)), e3 = __builtin_amdgcn_readfirstlane(__float_as_int(ev.w));
  V.vr[0] = *reinterpret_cast<const uint4*>(v8 + (size_t)e0 * 1024 + loff);
  V.vr[1] = *reinterpret_cast<const uint4*>(v8 + (size_t)e1 * 1024 + loff);
  V.vr[2] = *reinterpret_cast<const uint4*>(v8 + (size_t)e2 * 1024 + loff);
  V.vr[3] = *reinterpret_cast<const uint4*>(v8 + (size_t)e3 * 1024 + loff);
}
__device__ __forceinline__ float gelu_as(float z) {
  const float x = fabsf(z) * 0.70710678118654752f;
  const float t = __builtin_amdgcn_rcpf(fmaf(0.3275911f, x, 1.f));
  float pl = fmaf(1.061405429f, t, -1.453152027f);
  pl = fmaf(pl, t, 1.421413741f); pl = fmaf(pl, t, -0.284496736f); pl = fmaf(pl, t, 0.254829592f);
  const float e = __builtin_amdgcn_exp2f(-x * x * LOG2E);
  const float erfa = 1.f - pl * t * e;
  return 0.5f * z + 0.5f * fabsf(z) * erfa;
}
template <int PAT>
__device__ __forceinline__ float swz_f(float v) { return __int_as_float(__builtin_amdgcn_ds_swizzle(__float_as_int(v), PAT)); }

__device__ __forceinline__ void gstep2(GU& UA, GV& VA, GU& UB, GV& VB, const uint4* xlA, const uint4* xlB, f32x2* yA, f32x2* yB,
                                       const float* recA, const float* recB, int ci4, const float* nxtA, const float* nxtB, int ni4,
                                       const unsigned char* u8, const unsigned char* v8, unsigned loff, int lane) {
  float d[8];
  {
    f32x2 x2[8];
    const uint4 xa = xlA[0], xb = xlA[1];
    x2[0] = f32x2{bf_lo(xa.x), bf_hi(xa.x)}; x2[1] = f32x2{bf_lo(xa.y), bf_hi(xa.y)};
    x2[2] = f32x2{bf_lo(xa.z), bf_hi(xa.z)}; x2[3] = f32x2{bf_lo(xa.w), bf_hi(xa.w)};
    x2[4] = f32x2{bf_lo(xb.x), bf_hi(xb.x)}; x2[5] = f32x2{bf_lo(xb.y), bf_hi(xb.y)};
    x2[6] = f32x2{bf_lo(xb.z), bf_hi(xb.z)}; x2[7] = f32x2{bf_lo(xb.w), bf_hi(xb.w)};
#pragma unroll
    for (int q = 0; q < 4; ++q) d[q] = dot16_fp8v(x2, UA.ur[q]);
  }
  gload_u(UA, nxtA, ni4, u8, loff);
  {
    f32x2 x2[8];
    const uint4 xa = xlB[0], xb = xlB[1];
    x2[0] = f32x2{bf_lo(xa.x), bf_hi(xa.x)}; x2[1] = f32x2{bf_lo(xa.y), bf_hi(xa.y)};
    x2[2] = f32x2{bf_lo(xa.z), bf_hi(xa.z)}; x2[3] = f32x2{bf_lo(xa.w), bf_hi(xa.w)};
    x2[4] = f32x2{bf_lo(xb.x), bf_hi(xb.x)}; x2[5] = f32x2{bf_lo(xb.y), bf_hi(xb.y)};
    x2[6] = f32x2{bf_lo(xb.z), bf_hi(xb.z)}; x2[7] = f32x2{bf_lo(xb.w), bf_hi(xb.w)};
#pragma unroll
    for (int q = 0; q < 4; ++q) d[4 + q] = dot16_fp8v(x2, UB.ur[q]);
  }
  gload_u(UB, nxtB, ni4, u8, loff);
  const bool b0 = lane & 1, b1 = lane & 2, b2 = lane & 4;
  float a[4];
#pragma unroll
  for (int j = 0; j < 4; ++j) {
    const float keep = b0 ? d[4 + j] : d[j], send = b0 ? d[j] : d[4 + j];
    a[j] = keep + dpp_f<0xB1>(send);
  }
  float c2[2];
#pragma unroll
  for (int j = 0; j < 2; ++j) {
    const float keep = b1 ? a[2 + j] : a[j], send = b1 ? a[j] : a[2 + j];
    c2[j] = keep + dpp_f<0x4E>(send);
  }
  float tot;
  {
    const float keep = b2 ? c2[1] : c2[0], send = b2 ? c2[0] : c2[1];
    tot = keep + swz_f<0x101F>(send);
  }
  tot += swz_f<0x201F>(tot);
  tot = swap32_sum(swap16_sum(tot));
  const int pq = ((lane >> 1) & 1) * 2 + ((lane >> 2) & 1);
  const float* rl = (b0 ? recB : recA) + ci4 + pq;
  const float z = tot * rl[256];
  const float wv = rl[128] * gelu_as(z);
#pragma unroll
  for (int q = 0; q < 4; ++q) {
    const int ln = ((q >> 1) & 1) * 2 + (q & 1) * 4;
    const float wa = __int_as_float(__builtin_amdgcn_readlane(__float_as_int(wv), ln));
    const float wb = __int_as_float(__builtin_amdgcn_readlane(__float_as_int(wv), ln + 1));
    axpy16_fp8v(yA, wa, VA.vr[q]);
    axpy16_fp8v(yB, wb, VB.vr[q]);
  }
  gload_v(VA, nxtA, ni4, v8, loff);
  gload_v(VB, nxtB, ni4, v8, loff);
}

__device__ __forceinline__ void gstep(GU& U, GV& V, const uint4* xl, f32x2* y2, const float* nrec, int ni4,
                                      const unsigned char* u8, const unsigned char* v8, unsigned loff, int lane) {
  f32x2 x2[8];
  {
    const uint4 xa = xl[0], xb = xl[1];
    x2[0] = f32x2{bf_lo(xa.x), bf_hi(xa.x)}; x2[1] = f32x2{bf_lo(xa.y), bf_hi(xa.y)};
    x2[2] = f32x2{bf_lo(xa.z), bf_hi(xa.z)}; x2[3] = f32x2{bf_lo(xa.w), bf_hi(xa.w)};
    x2[4] = f32x2{bf_lo(xb.x), bf_hi(xb.x)}; x2[5] = f32x2{bf_lo(xb.y), bf_hi(xb.y)};
    x2[6] = f32x2{bf_lo(xb.z), bf_hi(xb.z)}; x2[7] = f32x2{bf_lo(xb.w), bf_hi(xb.w)};
  }
  float d[4], su[4];
#pragma unroll
  for (int q = 0; q < 4; ++q) { d[q] = dot16_fp8v(x2, U.ur[q]); su[q] = U.su[q]; }
  gload_u(U, nrec, ni4, u8, loff);
#pragma unroll
  for (int q = 0; q < 4; ++q) d[q] = wave_sum(d[q]) * su[q];
  float dv = d[0]; dv = (lane == 1) ? d[1] : dv; dv = (lane == 2) ? d[2] : dv; dv = (lane == 3) ? d[3] : dv;
  const float av = gelu_as(dv);
#pragma unroll
  for (int q = 0; q < 4; ++q) {
    const float act = __int_as_float(__builtin_amdgcn_readlane(__float_as_int(av), q));
    axpy16_fp8v(y2, V.gt[q] * act, V.vr[q]);
  }
  gload_v(V, nrec, ni4, v8, loff);
}

__device__ __forceinline__ void gsort_token(const Params& p, int t, float* rec, int lane) {
  const int e0 = p.eidx()[(size_t)t * 128 + lane], e1 = p.eidx()[(size_t)t * 128 + 64 + lane];
  const float g0 = p.egate()[(size_t)t * 128 + lane], g1 = p.egate()[(size_t)t * 128 + 64 + lane];
  const float q0 = p.esu()[(size_t)t * 128 + lane], q1 = p.esu()[(size_t)t * 128 + 64 + lane];
  int base = 0;
#pragma unroll 4
  for (int s = 0; s < 16; ++s) {
    const unsigned long long m0 = __ballot((e0 >> 10) == s), m1 = __ballot((e1 >> 10) == s);
    const int c0 = __popcll(m0), c1 = __popcll(m1);
    const int p0 = base + (int)__builtin_amdgcn_mbcnt_hi((unsigned)(m0 >> 32), __builtin_amdgcn_mbcnt_lo((unsigned)m0, 0));
    const int p1 = base + c0 + (int)__builtin_amdgcn_mbcnt_hi((unsigned)(m1 >> 32), __builtin_amdgcn_mbcnt_lo((unsigned)m1, 0));
    if ((e0 >> 10) == s) { rec[p0] = __int_as_float(e0); rec[128 + p0] = g0; rec[256 + p0] = q0; }
    if ((e1 >> 10) == s) { rec[p1] = __int_as_float(e1); rec[128 + p1] = g1; rec[256 + p1] = q1; }
    base += c0 + c1;
  }
}
__device__ __forceinline__ void gload_x(const Params& p, int t, uint4* xl, int lane) {
  xl[0] = *reinterpret_cast<const uint4*>(p.xn() + (size_t)t * 1024 + lane * 16);
  xl[1] = *reinterpret_cast<const uint4*>(p.xn() + (size_t)t * 1024 + lane * 16 + 8);
}
template <bool LAST>
__device__ __forceinline__ void gstore_x(const Params& p, int l, int t, const f32x2* y2, int lane) {
  float* xr = p.x() + (size_t)t * 1024 + lane * 16;
  float4 a[4];
  float ss = 0.f;
#pragma unroll
  for (int j = 0; j < 4; ++j) {
    a[j] = reinterpret_cast<float4*>(xr)[j];
    a[j].x += y2[2 * j].x; a[j].y += y2[2 * j].y; a[j].z += y2[2 * j + 1].x; a[j].w += y2[2 * j + 1].y;
    ss += a[j].x * a[j].x + a[j].y * a[j].y + a[j].z * a[j].z + a[j].w * a[j].w;
  }
  ss = wave_sum(ss);
  const float r = rsqrtf(ss * (1.f / 1024.f) + EPS);
  if (LAST) {
    const float* g = p.final_g() + lane * 16;
    float* o = ((t < NPROMPT) ? p.out + O_Y_P + (size_t)t * 1024 : p.out + O_Y_S + (size_t)(t - NPROMPT) * 1024) + lane * 16;
#pragma unroll
    for (int j = 0; j < 4; ++j) {
      const float4 gv = reinterpret_cast<const float4*>(g)[j];
      reinterpret_cast<float4*>(o)[j] = make_float4(a[j].x * r * gv.x, a[j].y * r * gv.y, a[j].z * r * gv.z, a[j].w * r * gv.w);
    }
  } else {
    const float* g = p.norm1_g() + (l + 1) * 1024 + lane * 16;
#pragma unroll
    for (int j = 0; j < 4; ++j) {
      reinterpret_cast<float4*>(xr)[j] = a[j];
      const float4 gv = reinterpret_cast<const float4*>(g)[j];
      a[j].x *= r * gv.x; a[j].y *= r * gv.y; a[j].z *= r * gv.z; a[j].w *= r * gv.w;
    }
    uint4* o = reinterpret_cast<uint4*>(p.xn() + (size_t)t * 1024 + lane * 16);
    o[0] = make_uint4(pack2(a[0].x, a[0].y), pack2(a[0].z, a[0].w), pack2(a[1].x, a[1].y), pack2(a[1].z, a[1].w));
    o[1] = make_uint4(pack2(a[2].x, a[2].y), pack2(a[2].z, a[2].w), pack2(a[3].x, a[3].y), pack2(a[3].z, a[3].w));
    float pre[8];
#pragma unroll
    for (int i = 0; i < 8; ++i) {
      const float4* wr = reinterpret_cast<const float4*>(p.wg() + ((size_t)(l + 1) * 8 + i) * 1024 + lane * 16);
      float s = 0.f;
#pragma unroll
      for (int j = 0; j < 4; ++j) {
        const float4 wv = wr[j];
        s += a[j].x * wv.x + a[j].y * wv.y + a[j].z * wv.z + a[j].w * wv.w;
      }
      pre[i] = wave_sum(s);
    }
    if (lane < 4) {
      float ai = pre[0]; ai = lane == 1 ? pre[1] : ai; ai = lane == 2 ? pre[2] : ai; ai = lane == 3 ? pre[3] : ai;
      float f = pre[4]; f = lane == 1 ? pre[5] : f; f = lane == 2 ? pre[6] : f; f = lane == 3 ? pre[7] : f;
      p.ig()[(size_t)t * 4 + lane] = ai + p.ml_gate_b()[(l + 1) * 8 + lane];
      const float z = f + p.ml_gate_b()[(l + 1) * 8 + 4 + lane];
      p.lf()[(size_t)t * 4 + lane] = fminf(z, 0.f) - log1pf(expf(-fabsf(z)));
    }
  }
}

template <bool LAST>
__device__ __forceinline__ void ph_gather2(const Params& p, int l, char* smem, int bid, int nblk) {
  const int tid = tid_opaque(), lane = tid & 63, w = tid >> 6;
  const unsigned char* u8 = p.ub8() + (size_t)l * 16384 * 1024;
  const unsigned char* v8 = p.vb8() + (size_t)l * 16384 * 1024;
  const unsigned loff = (unsigned)lane * 16u;
  float* rec = reinterpret_cast<float*>(smem) + w * (GT * GREC);
  uint4* xl = reinterpret_cast<uint4*>(smem + 4 * GT * GREC * 4) + (w * GT * 64 + lane) * 2;
  const int rot = (bid & 7) * 4;
  const int nwaves = nblk * 4, wg = bid * 4 + w;
  const int nfull = (NTOK / (nwaves * GT)) * nwaves;
  for (int grp = wg; grp < nfull; grp += nwaves) {
    const int t0 = grp * GT;
    int lane_s = lane; asm volatile("" : "+v"(lane_s));
#pragma unroll 1
    for (int ti = 0; ti < GT; ++ti) {
      gload_x(p, t0 + ti, xl + ti * 128, lane_s);
      gsort_token(p, t0 + ti, rec + ti * GREC, lane_s);
    }
    f32x2 y2[GT][8];
#pragma unroll
    for (int ti = 0; ti < GT; ++ti)
#pragma unroll
      for (int i = 0; i < 8; ++i) y2[ti][i] = f32x2{0.f, 0.f};
    GU U0, U1; GV V0, V1;
    gload_u(U0, rec, (rot & 31) * 4, u8, loff); gload_v(V0, rec, (rot & 31) * 4, v8, loff);
    gload_u(U1, rec + GREC, (rot & 31) * 4, u8, loff); gload_v(V1, rec + GREC, (rot & 31) * 4, v8, loff);
#pragma unroll 1
    for (int b = 0; b < 32; ++b) {
      const int bo = ((b + rot) & 31) * 4, bn = ((b + 1 + rot) & 31) * 4;
      gstep2(U0, V0, U1, V1, xl, xl + 128, y2[0], y2[1], rec, rec + GREC, bo, rec + 2 * GREC, rec + 3 * GREC, bo, u8, v8, loff, lane);
      __builtin_amdgcn_sched_barrier(0);
      gstep2(U0, V0, U1, V1, xl + 256, xl + 384, y2[2], y2[3], rec + 2 * GREC, rec + 3 * GREC, bo, rec, rec + GREC, bn, u8, v8, loff, lane);
      __builtin_amdgcn_sched_barrier(0);
    }
    int lane_e = lane; asm volatile("" : "+v"(lane_e));
#pragma unroll
    for (int ti = 0; ti < GT; ++ti) gstore_x<LAST>(p, l, t0 + ti, y2[ti], lane_e);
  }
  float* ysum = reinterpret_cast<float*>(smem + 4 * GT * GREC * 4 + 4 * GT * 2048);
  for (int t = nfull * GT + bid; t < NTOK; t += nblk) {
    f32x2 y2[8];
    gload_x(p, t, xl, lane);
#pragma unroll
    for (int i = 0; i < 8; ++i) y2[i] = f32x2{0.f, 0.f};
    gsort_token(p, t, rec, lane);
    GU U; GV V;
    gload_u(U, rec, (w * 8) * 4, u8, loff);
    gload_v(V, rec, (w * 8) * 4, v8, loff);
#pragma unroll 1
    for (int b = 0; b < 8; ++b) gstep(U, V, xl, y2, rec, (w * 8 + ((b + 1) & 7)) * 4, u8, v8, loff, lane);
    __syncthreads();
#pragma unroll
    for (int i = 0; i < 8; ++i) { ysum[w * 1024 + lane * 16 + 2 * i] = y2[i].x; ysum[w * 1024 + lane * 16 + 2 * i + 1] = y2[i].y; }
    __syncthreads();
    if (w == 0) {
#pragma unroll
      for (int i = 0; i < 8; ++i) {
        y2[i].x += ysum[1024 + lane * 16 + 2 * i] + ysum[2048 + lane * 16 + 2 * i] + ysum[3072 + lane * 16 + 2 * i];
        y2[i].y += ysum[1024 + lane * 16 + 2 * i + 1] + ysum[2048 + lane * 16 + 2 * i + 1] + ysum[3072 + lane * 16 + 2 * i + 1];
      }
      gstore_x<LAST>(p, l, t, y2, lane);
    }
  }
}

#define XB_TMO      128
#define XB_XCNT(j)  (256  + 64 * (j))
#define XB_XSUB(j)  (1280 + 64 * (j))
#define XB_XGEN(j)  (2304 + 64 * (j))
#define XB_TOP      3328
#define XB_TOPGEN   3392
#define XCD_BAR_WORDS 3456
#define XB_SPIN_CAP (1u << 22)
__device__ __forceinline__ unsigned xb_ld(unsigned* p)              { return __hip_atomic_load(p, __ATOMIC_RELAXED, __HIP_MEMORY_SCOPE_AGENT); }
__device__ __forceinline__ unsigned xb_add(unsigned* p, unsigned v) { return __hip_atomic_fetch_add(p, v, __ATOMIC_RELAXED, __HIP_MEMORY_SCOPE_AGENT); }
__device__ __forceinline__ unsigned xb_xcc_id() { return (unsigned)__builtin_amdgcn_s_getreg((3 << 11) | 20) & 0xFu; }
#define XB_SPIN(cond, bar) do { unsigned _sp = 0; while (cond) { __builtin_amdgcn_s_sleep(1); \
    if ((++_sp & 255u) == 0u) { if (xb_ld(&(bar)[XB_TMO])) break; if (_sp > XB_SPIN_CAP) { atomicAdd(&(bar)[XB_TMO], 1u); break; } } } } while (0)

struct XcdBarrier { unsigned* bar; unsigned x; volatile LAS unsigned* st; };

__device__ __forceinline__ XcdBarrier xcd_barrier_post(unsigned* bar, volatile LAS unsigned* st) {
  XcdBarrier b; b.bar = bar; b.x = xb_xcc_id(); b.st = st;
  if (threadIdx.x == 0) (void)xb_add(&bar[XB_XCNT(b.x)], 1u);
  return b;
}
__device__ __forceinline__ void xcd_barrier_complete(unsigned* bar, unsigned x, unsigned& nloc, unsigned& nx) {
  const unsigned G = gridDim.x * gridDim.y * gridDim.z;
  unsigned sum, cnt, mine, sp = 0u;
  for (;;) {
    sum = 0u; cnt = 0u; mine = 0u;
#pragma unroll
    for (unsigned j = 0; j < 16; ++j) { const unsigned c = xb_ld(&bar[XB_XCNT(j)]); sum += c; cnt += (c > 0u) ? 1u : 0u; mine = (j == x) ? c : mine; }
    if (sum == G) break;
    __builtin_amdgcn_s_sleep(1);
    if ((++sp & 255u) == 0u) { if (xb_ld(&bar[XB_TMO])) break; if (sp > XB_SPIN_CAP) { atomicAdd(&bar[XB_TMO], 1u); break; } }
  }
  nloc = mine > 0u ? mine : 1u; nx = cnt > 0u ? cnt : 1u;
}
__device__ __forceinline__ void xcd_barrier(const XcdBarrier& b) {
  asm volatile("s_waitcnt vmcnt(0)" ::: "memory");
  __syncthreads();
  if (threadIdx.x == 0) {
    unsigned* bar = b.bar;
    __builtin_amdgcn_s_waitcnt(0);
    unsigned nloc = b.st[0], nx = b.st[1];
    if (nloc == 0u) { xcd_barrier_complete(bar, b.x, nloc, nx); b.st[0] = nloc; b.st[1] = nx; }
    const unsigned old = xb_add(&bar[XB_XSUB(b.x)], 1u);
    const unsigned gen = old / nloc;
    if (old + 1u == (gen + 1u) * nloc) {
      __builtin_amdgcn_fence(__ATOMIC_RELEASE, "agent");
      asm volatile("s_waitcnt vmcnt(0)" ::: "memory");
      const unsigned og = xb_add(&bar[XB_TOP], 1u);
      const unsigned tg = og / nx;
      if (og + 1u == (tg + 1u) * nx) xb_add(&bar[XB_TOPGEN], 1u);
      else XB_SPIN(xb_ld(&bar[XB_TOPGEN]) == tg, bar);
      __builtin_amdgcn_fence(__ATOMIC_ACQUIRE, "agent");
      xb_add(&bar[XB_XGEN(b.x)], 1u);
      asm volatile("s_waitcnt vmcnt(0)" ::: "memory");
    } else {
      XB_SPIN(xb_ld(&bar[XB_XGEN(b.x)]) == gen, bar);
      __builtin_amdgcn_fence(__ATOMIC_ACQUIRE, "agent");
      asm volatile("s_waitcnt vmcnt(0)" ::: "memory");
    }
  }
  __syncthreads();
}

#define GSYNC() xcd_barrier(xb)
#define PP(wi) phase_params(p, wi)
#define BN bid_opaque(bid), nblk_opaque(nblk)

template <int L>
__device__ __forceinline__ void layer_phases(const Params& p, char* smem, const XcdBarrier& xb, int bid, int nblk) {
  if (L == 0) {
  ph_rmsnorm<0>(PP(false), L, BN);
#if PROBE == 11
  GSYNC();
  ph_rmsnorm<0>(PP(false), L, BN);
#endif
  GSYNC();
  }
  ph_gemm<EPI_WIN>(PP(false), L, smem, BN);
#if PROBE == 1
  GSYNC();
  ph_gemm<EPI_WIN>(PP(false), L, smem, BN);
#endif
  GSYNC();
  ph_attn(PP(false), L, smem, BN);
#if PROBE == 4
  GSYNC();
  ph_attn(PP(false), L, smem, BN);
#endif
  ph_mlconv(PP(false), L, smem, BN);
#if PROBE == 8 || PROBE == 20
  GSYNC();
  ph_mlconv(PP(false), L, smem, BN);
#endif
  ph_cmlp(PP(false), L, smem, BN);
#if PROBE == 7 || PROBE == 20
  GSYNC();
  ph_cmlp(PP(false), L, smem, BN);
#endif
  GSYNC();
  ph_mlU(PP(false), L, smem, BN);
#if PROBE == 9 || PROBE == 20
  GSYNC();
  ph_mlU(PP(false), L, smem, BN);
#endif
  GSYNC();
  ph_mlscan(PP(false), L, BN);
#if PROBE == 10 || PROBE == 20
  GSYNC();
  ph_mlscan(PP(false), L, BN);
#endif
  GSYNC();
  ph_mlout(PP(false), L, smem, BN);
#if PROBE == 6 || PROBE == 20
  GSYNC();
  ph_mlout(PP(false), L, smem, BN);
#endif
  GSYNC();
  ph_gemm<EPI_WOUT>(PP(false), L, smem, BN);
  GSYNC();
  ph_rmsnorm<1>(PP(false), L, BN);
  GSYNC();
  ph_gemm<EPI_PQ>(PP(false), L, smem, BN);
#if PROBE == 2
  GSYNC();
  ph_gemm<EPI_PQ>(PP(false), L, smem, BN);
#endif
  GSYNC();
  ph_topk(PP(false), L, smem, BN);
#if PROBE == 5
  GSYNC();
  ph_topk(PP(false), L, smem, BN);
#endif
  GSYNC();
  ph_gather2<(L == 1)>(PP(false), L, smem, BN);
  GSYNC();
}

__global__ void __launch_bounds__(256, 2) mega_kernel(Params p) {
  __shared__ __attribute__((aligned(16))) char smem[SMEM_BYTES];
  __shared__ uint4 xb_words;
  cg::grid_group grid = cg::this_grid();
  const int bid = blockIdx.x, nblk = gridDim.x;
  if (threadIdx.x == 0) xb_words = make_uint4(0u, 0u, 0u, 0u);
  __syncthreads();
  XcdBarrier xb = xcd_barrier_post(reinterpret_cast<unsigned*>(p.ws), (volatile LAS unsigned*)&xb_words);
  grid.sync();
  ph_prep(PP(true), smem, BN);
#if PROBE == 12
  GSYNC();
  ph_prep(PP(true), smem, BN);
#endif
  GSYNC();
  layer_phases<0>(p, smem, xb, bid, nblk);
  layer_phases<1>(p, smem, xb, bid, nblk);
}

static inline size_t align_up(size_t v, size_t a) { return (v + a - 1) / a * a; }

extern "C" void kernel_launch(void* const* d_in, const int* in_sizes, int n_in, void* d_out, int out_size, void* d_ws,
                              size_t ws_size, hipStream_t stream) {
  Params p{};
  for (int i = 0; i < 30; ++i) p.in[i] = reinterpret_cast<const float*>(d_in[i]);
  p.out = reinterpret_cast<float*>(d_out);
  p.ws = reinterpret_cast<char*>(d_ws);
  if (WS_NEED > ws_size) { fprintf(stderr, "workspace too small: need %zu have %zu\n", (size_t)WS_NEED, ws_size); return; }
  static int grid_blocks = 0;
  if (!grid_blocks) {
    int dev = 0, cus = 0, per_cu = 0;
    hipGetDevice(&dev);
    hipDeviceGetAttribute(&cus, hipDeviceAttributeMultiprocessorCount, dev);
    hipOccupancyMaxActiveBlocksPerMultiprocessor(&per_cu, mega_kernel, 256, 0);
    if (per_cu > 2) per_cu = 2;
    if (per_cu < 1) per_cu = 1;
    grid_blocks = cus * per_cu;
  }
  hipMemsetAsync(d_ws, 0, 16384, stream);
  void* args[] = {&p};
  hipError_t e = hipLaunchCooperativeKernel((void*)mega_kernel, dim3(grid_blocks), dim3(256), args, 0, stream);
  if (e != hipSuccess) fprintf(stderr, "cooperative launch failed: %s (grid %d)\n", hipGetErrorString(e), grid_blocks);
}
```

```cpp
#include <hip/hip_runtime.h>
#include <hip/hip_cooperative_groups.h>
#include <cstdio>
#include <cstdint>

namespace cg = cooperative_groups;

typedef unsigned short bf16_t;
typedef __attribute__((ext_vector_type(8))) __bf16 bf16x8;
typedef __attribute__((ext_vector_type(2))) __bf16 bf16x2;
typedef __attribute__((ext_vector_type(16))) float f32x16;
typedef __attribute__((ext_vector_type(2))) float f32x2;

#define D_MODEL 1024
#define NTOK 16896
#define NPROMPT 16384
#define SEQ 4096
#define NIN 2816
#define EPS 1e-6f
#define LOG2E 1.4426950408889634f
#define SKEYS 1088
#define NCU_UNITS 1056

constexpr size_t O_Y_P = 0;
constexpr size_t O_Y_S = O_Y_P + 16777216;
constexpr size_t O_K_P = O_Y_S + 524288;
constexpr size_t O_V_P = O_K_P + 16777216;
constexpr size_t O_C_P = O_V_P + 16777216;
constexpr size_t O_N_P = O_C_P + 131072;
constexpr size_t O_M_P = O_N_P + 2048;
constexpr size_t O_CONV_P = O_M_P + 32;
constexpr size_t O_K_S = O_CONV_P + 6144;
constexpr size_t O_V_S = O_K_S + 524288;
constexpr size_t O_C_S = O_V_S + 524288;
constexpr size_t O_N_S = O_C_S + 262144;
constexpr size_t O_M_S = O_N_S + 4096;
constexpr size_t O_CONV_S = O_M_S + 64;
constexpr size_t O_CMV_S = O_CONV_S + 12288;

constexpr size_t al256(size_t v) { return (v + 255) / 256 * 256; }
constexpr int SP_st_c = 0;
constexpr int SP_st_n = 262144;
constexpr int SP_st_m = 266240;
constexpr int SP_st_conv = 266304;
constexpr int SP_norm1_g = 278592;
constexpr int SP_da_subln_g = 280640;
constexpr int SP_ml_conv_w = 280896;
constexpr int SP_ml_conv_b = 282944;
constexpr int SP_ml_wq = 283456;
constexpr int SP_ml_wk = 316224;
constexpr int SP_ml_gate_b = 348992;
constexpr int SP_ml_norm_g = 349056;
constexpr int SP_ml_skip = 349568;
constexpr int SP_cm_norm_g = 350080;
constexpr int SP_cm_ws = 350592;
constexpr int SP_cm_b = 481664;
constexpr int SP_norm2_g = 482688;
constexpr int SP_final_g = 484736;
constexpr int SP_TOTAL = 485760;
constexpr size_t WS_bar = 0;
constexpr size_t WS_lam = al256(WS_bar + 16384);
constexpr size_t WS_lut = al256(WS_lam + (256));
constexpr size_t WS_sp = al256(WS_lut + (4*256*4));
constexpr size_t WS_wt_in = al256(WS_sp + (SP_TOTAL*4));
constexpr size_t WS_wg = al256(WS_wt_in + ((size_t)2*NIN*1024*2));
constexpr size_t WS_wt_out = al256(WS_wg + ((size_t)2*8*1024*4));
constexpr size_t WS_wt_pq = al256(WS_wt_out + ((size_t)2*1024*1024*2));
constexpr size_t WS_keysb = al256(WS_wt_pq + ((size_t)2*2048*1024*2));
constexpr size_t WS_ub8 = al256(WS_keysb + ((size_t)2*16*128*128*2));
constexpr size_t WS_vb8 = al256(WS_ub8 + ((size_t)2*16384*1024));
constexpr size_t WS_us = al256(WS_vb8 + ((size_t)2*16384*1024));
constexpr size_t WS_vs = al256(WS_us + ((size_t)2*16384*4));
constexpr size_t WS_Kbs = al256(WS_vs + ((size_t)2*16384*4));
constexpr size_t WS_Vts = al256(WS_Kbs + ((size_t)2*8*SKEYS*512*2));
constexpr size_t WS_x = al256(WS_Vts + ((size_t)2*8*4*128*SKEYS*2));
constexpr size_t WS_xn = al256(WS_x + ((size_t)NTOK*1024*4));
constexpr size_t WS_R0 = al256(WS_xn + ((size_t)NTOK*1024*2));
constexpr size_t WS_R0x = WS_R0;
constexpr size_t WS_Qb = al256(WS_R0x + (0));
constexpr size_t WS_Kb = al256(WS_Qb + ((size_t)NTOK*512*2));
constexpr size_t WS_Vt = al256(WS_Kb + ((size_t)NPROMPT*512*2));
constexpr size_t WS_P5 = al256(WS_Vt + ((size_t)16*128*SEQ*2));
constexpr size_t WS_ig = al256(WS_P5 + ((size_t)NTOK*1280*4));
constexpr size_t WS_lf = al256(WS_ig + ((size_t)NTOK*4*4));
constexpr size_t WS_Fc = al256(WS_lf + ((size_t)NTOK*4*4));
constexpr size_t WS_cc = al256(WS_Fc + ((size_t)NTOK*4*4));
constexpr size_t WS_qm = al256(WS_cc + ((size_t)NTOK*256*4));
constexpr size_t WS_km = al256(WS_qm + ((size_t)NTOK*256*4));
constexpr size_t WS_mst = al256(WS_km + ((size_t)NTOK*256*4));
constexpr size_t WS_mnx = al256(WS_mst + (NCU_UNITS*4));
constexpr size_t WS_wcs = al256(WS_mnx + (NCU_UNITS*4));
constexpr size_t WS_FLs = al256(WS_wcs + (NCU_UNITS*4));
constexpr size_t WS_mxt = al256(WS_FLs + (NCU_UNITS*4));
constexpr size_t WS_U = al256(WS_mxt + (NCU_UNITS*4));
constexpr size_t WS_un = al256(WS_U + ((size_t)NCU_UNITS*4096*4));
constexpr size_t WS_Cst = al256(WS_un + ((size_t)NCU_UNITS*64*4));
constexpr size_t WS_nst = al256(WS_Cst + ((size_t)NCU_UNITS*4096*4));
constexpr size_t WS_END_MIXER = al256(WS_nst + ((size_t)NCU_UNITS*64*4));
constexpr size_t WS_qp = al256(WS_R0x + (0));
constexpr size_t WS_sc = al256(WS_qp + ((size_t)NTOK*2048*2));
constexpr size_t WS_eidx = al256(WS_sc + ((size_t)NTOK*2048*4));
constexpr size_t WS_egate = al256(WS_eidx + ((size_t)NTOK*128*4));
constexpr size_t WS_esu = al256(WS_egate + ((size_t)NTOK*128*4));
constexpr size_t WS_ssp = al256(WS_esu + ((size_t)NTOK*128*4));
constexpr size_t WS_END_PEER = al256(WS_ssp + ((size_t)NTOK*32*4));
constexpr size_t WS_NEED = WS_END_MIXER > WS_END_PEER ? WS_END_MIXER : WS_END_PEER;

struct Params {
  const float* in[30];
  float* out;
  char* ws;
  __device__ __forceinline__ const float* x_prompt() const { return in[0]; }
  __device__ __forceinline__ const float* x_sample() const { return in[1]; }
  __device__ __forceinline__ const float* cache_k() const { return in[2]; }
  __device__ __forceinline__ const float* cache_v() const { return in[3]; }
  __device__ __forceinline__ const float* w_in() const { return in[9]; }
  __device__ __forceinline__ const float* da_lambda() const { return in[10]; }
  __device__ __forceinline__ const float* rel_table() const { return in[12]; }
  __device__ __forceinline__ const float* w_out() const { return in[23]; }
  __device__ __forceinline__ const float* peer_wq() const { return in[25]; }
  __device__ __forceinline__ const float* peer_keys() const { return in[26]; }
  __device__ __forceinline__ const float* peer_u() const { return in[27]; }
  __device__ __forceinline__ const float* peer_v() const { return in[28]; }
  __device__ __forceinline__ const float* st_c() const { return reinterpret_cast<const float*>(ws + WS_sp) + SP_st_c; }
  __device__ __forceinline__ const float* st_n() const { return reinterpret_cast<const float*>(ws + WS_sp) + SP_st_n; }
  __device__ __forceinline__ const float* st_m() const { return reinterpret_cast<const float*>(ws + WS_sp) + SP_st_m; }
  __device__ __forceinline__ const float* st_conv() const { return reinterpret_cast<const float*>(ws + WS_sp) + SP_st_conv; }
  __device__ __forceinline__ const float* norm1_g() const { return reinterpret_cast<const float*>(ws + WS_sp) + SP_norm1_g; }
  __device__ __forceinline__ const float* da_subln_g() const { return reinterpret_cast<const float*>(ws + WS_sp) + SP_da_subln_g; }
  __device__ __forceinline__ const float* ml_conv_w() const { return reinterpret_cast<const float*>(ws + WS_sp) + SP_ml_conv_w; }
  __device__ __forceinline__ const float* ml_conv_b() const { return reinterpret_cast<const float*>(ws + WS_sp) + SP_ml_conv_b; }
  __device__ __forceinline__ const float* ml_wq() const { return reinterpret_cast<const float*>(ws + WS_sp) + SP_ml_wq; }
  __device__ __forceinline__ const float* ml_wk() const { return reinterpret_cast<const float*>(ws + WS_sp) + SP_ml_wk; }
  __device__ __forceinline__ const float* ml_gate_b() const { return reinterpret_cast<const float*>(ws + WS_sp) + SP_ml_gate_b; }
  __device__ __forceinline__ const float* ml_norm_g() const { return reinterpret_cast<const float*>(ws + WS_sp) + SP_ml_norm_g; }
  __device__ __forceinline__ const float* ml_skip() const { return reinterpret_cast<const float*>(ws + WS_sp) + SP_ml_skip; }
  __device__ __forceinline__ const float* cm_norm_g() const { return reinterpret_cast<const float*>(ws + WS_sp) + SP_cm_norm_g; }
  __device__ __forceinline__ const float* cm_ws() const { return reinterpret_cast<const float*>(ws + WS_sp) + SP_cm_ws; }
  __device__ __forceinline__ const float* cm_b() const { return reinterpret_cast<const float*>(ws + WS_sp) + SP_cm_b; }
  __device__ __forceinline__ const float* norm2_g() const { return reinterpret_cast<const float*>(ws + WS_sp) + SP_norm2_g; }
  __device__ __forceinline__ const float* final_g() const { return reinterpret_cast<const float*>(ws + WS_sp) + SP_final_g; }
  __device__ __forceinline__ float* lam() const { return reinterpret_cast<float*>(ws + WS_lam); }
  __device__ __forceinline__ float* lut() const { return reinterpret_cast<float*>(ws + WS_lut); }
  __device__ __forceinline__ float* sp() const { return reinterpret_cast<float*>(ws + WS_sp); }
  __device__ __forceinline__ bf16_t* wt_in() const { return reinterpret_cast<bf16_t*>(ws + WS_wt_in); }
  __device__ __forceinline__ float* wg() const { return reinterpret_cast<float*>(ws + WS_wg); }
  __device__ __forceinline__ bf16_t* wt_out() const { return reinterpret_cast<bf16_t*>(ws + WS_wt_out); }
  __device__ __forceinline__ bf16_t* wt_pq() const { return reinterpret_cast<bf16_t*>(ws + WS_wt_pq); }
  __device__ __forceinline__ bf16_t* keysb() const { return reinterpret_cast<bf16_t*>(ws + WS_keysb); }
  __device__ __forceinline__ unsigned char* ub8() const { return reinterpret_cast<unsigned char*>(ws + WS_ub8); }
  __device__ __forceinline__ unsigned char* vb8() const { return reinterpret_cast<unsigned char*>(ws + WS_vb8); }
  __device__ __forceinline__ float* us() const { return reinterpret_cast<float*>(ws + WS_us); }
  __device__ __forceinline__ float* vs() const { return reinterpret_cast<float*>(ws + WS_vs); }
  __device__ __forceinline__ bf16_t* Kbs() const { return reinterpret_cast<bf16_t*>(ws + WS_Kbs); }
  __device__ __forceinline__ bf16_t* Vts() const { return reinterpret_cast<bf16_t*>(ws + WS_Vts); }
  __device__ __forceinline__ float* x() const { return reinterpret_cast<float*>(ws + WS_x); }
  __device__ __forceinline__ bf16_t* xn() const { return reinterpret_cast<bf16_t*>(ws + WS_xn); }
  __device__ __forceinline__ bf16_t* Qb() const { return reinterpret_cast<bf16_t*>(ws + WS_Qb); }
  __device__ __forceinline__ bf16_t* Kb() const { return reinterpret_cast<bf16_t*>(ws + WS_Kb); }
  __device__ __forceinline__ bf16_t* Vt() const { return reinterpret_cast<bf16_t*>(ws + WS_Vt); }
  __device__ __forceinline__ float* P5() const { return reinterpret_cast<float*>(ws + WS_P5); }
  __device__ __forceinline__ float* ig() const { return reinterpret_cast<float*>(ws + WS_ig); }
  __device__ __forceinline__ float* lf() const { return reinterpret_cast<float*>(ws + WS_lf); }
  __device__ __forceinline__ float* Fc() const { return reinterpret_cast<float*>(ws + WS_Fc); }
  __device__ __forceinline__ float* cc() const { return reinterpret_cast<float*>(ws + WS_cc); }
  __device__ __forceinline__ float* qm() const { return reinterpret_cast<float*>(ws + WS_qm); }
  __device__ __forceinline__ float* km() const { return reinterpret_cast<float*>(ws + WS_km); }
  __device__ __forceinline__ float* mst() const { return reinterpret_cast<float*>(ws + WS_mst); }
  __device__ __forceinline__ float* mnx() const { return reinterpret_cast<float*>(ws + WS_mnx); }
  __device__ __forceinline__ float* wcs() const { return reinterpret_cast<float*>(ws + WS_wcs); }
  __device__ __forceinline__ float* FLs() const { return reinterpret_cast<float*>(ws + WS_FLs); }
  __device__ __forceinline__ float* mxt() const { return reinterpret_cast<float*>(ws + WS_mxt); }
  __device__ __forceinline__ float* U() const { return reinterpret_cast<float*>(ws + WS_U); }
  __device__ __forceinline__ float* un() const { return reinterpret_cast<float*>(ws + WS_un); }
  __device__ __forceinline__ float* Cst() const { return reinterpret_cast<float*>(ws + WS_Cst); }
  __device__ __forceinline__ float* nst() const { return reinterpret_cast<float*>(ws + WS_nst); }
  __device__ __forceinline__ bf16_t* qp() const { return reinterpret_cast<bf16_t*>(ws + WS_qp); }
  __device__ __forceinline__ float* sc() const { return reinterpret_cast<float*>(ws + WS_sc); }
  __device__ __forceinline__ int* eidx() const { return reinterpret_cast<int*>(ws + WS_eidx); }
  __device__ __forceinline__ float* egate() const { return reinterpret_cast<float*>(ws + WS_egate); }
  __device__ __forceinline__ float* esu() const { return reinterpret_cast<float*>(ws + WS_esu); }
  __device__ __forceinline__ float* ssp() const { return reinterpret_cast<float*>(ws + WS_ssp); }
  __device__ __forceinline__ int* tl() const { return reinterpret_cast<int*>(ws + WS_sc); }
};

__device__ __forceinline__ unsigned pack2(float a, float b) {
  f32x2 v = {a, b};
  bf16x2 r = __builtin_convertvector(v, bf16x2);
  return *reinterpret_cast<unsigned*>(&r);
}
__device__ __forceinline__ bf16_t f2bf(float a) { return (bf16_t)(pack2(a, 0.f) & 0xFFFFu); }
__device__ __forceinline__ float bf_lo(unsigned u) { return __uint_as_float(u << 16); }
__device__ __forceinline__ float bf_hi(unsigned u) { return __uint_as_float(u & 0xFFFF0000u); }
__device__ __forceinline__ float gelu_exact(float x) { return 0.5f * x * (1.f + erff(x * 0.70710678118654752f)); }
__device__ __forceinline__ float sigmoidf_(float x) { return 1.f / (1.f + __expf(-x)); }
template <int CTRL>
__device__ __forceinline__ float dpp_f(float v) {
  return __builtin_bit_cast(float, __builtin_amdgcn_update_dpp(0, __builtin_bit_cast(int, v), CTRL, 0xf, 0xf, true));
}
__device__ __forceinline__ float swap16_sum(float x) {
  auto s = __builtin_amdgcn_permlane16_swap(__float_as_uint(x), __float_as_uint(x), false, false);
  return __uint_as_float(s[0]) + __uint_as_float(s[1]);
}
__device__ __forceinline__ float swap32_sum(float x) {
  auto s = __builtin_amdgcn_permlane32_swap(__float_as_uint(x), __float_as_uint(x), false, false);
  return __uint_as_float(s[0]) + __uint_as_float(s[1]);
}
__device__ __forceinline__ float swap16_max(float x) {
  auto s = __builtin_amdgcn_permlane16_swap(__float_as_uint(x), __float_as_uint(x), false, false);
  return fmaxf(__uint_as_float(s[0]), __uint_as_float(s[1]));
}
__device__ __forceinline__ float swap32_max(float x) {
  auto s = __builtin_amdgcn_permlane32_swap(__float_as_uint(x), __float_as_uint(x), false, false);
  return fmaxf(__uint_as_float(s[0]), __uint_as_float(s[1]));
}
__device__ __forceinline__ float row16_sum(float v) {
  v += dpp_f<0xB1>(v); v += dpp_f<0x4E>(v); v += dpp_f<0x141>(v); v += dpp_f<0x140>(v);
  return v;
}
__device__ __forceinline__ float row16_max(float v) {
  v = fmaxf(v, dpp_f<0xB1>(v)); v = fmaxf(v, dpp_f<0x4E>(v)); v = fmaxf(v, dpp_f<0x141>(v)); v = fmaxf(v, dpp_f<0x140>(v));
  return v;
}
__device__ __forceinline__ float wave_sum(float v) { return swap32_sum(swap16_sum(row16_sum(v))); }
__device__ __forceinline__ float wave_max(float v) { return swap32_max(swap16_max(row16_max(v))); }
__device__ __forceinline__ const float* xrow_in(const Params& p, int l, int t) {
  if (l == 0) return (t < NPROMPT) ? p.x_prompt() + (size_t)t * D_MODEL : p.x_sample() + (size_t)(t - NPROMPT) * D_MODEL;
  return p.x() + (size_t)t * D_MODEL;
}
__device__ __forceinline__ bf16x8 as_bf16x8(uint4 v) { return *reinterpret_cast<bf16x8*>(&v); }

__device__ __forceinline__ int tid_opaque() { int t = threadIdx.x; asm volatile("" : "+v"(t)); return t; }
__device__ __forceinline__ int sgpr_opaque(int v) { asm volatile("" : "+s"(v)); return v; }
__device__ __forceinline__ int bid_opaque(int v) { asm volatile("" : "+s"(v)); __builtin_assume(v >= 0); __builtin_assume(v < 1024); return v; }
__device__ __forceinline__ int nblk_opaque(int v) { asm volatile("" : "+s"(v)); __builtin_assume(v >= 1); __builtin_assume(v <= 1024); return v; }
#define LAS __attribute__((address_space(3)))
#ifndef PROBE
#define PROBE 0
#endif
#define SMEM_BYTES 73728

__device__ __forceinline__ void transpose_tile(const float* __restrict__ src, int lds, bf16_t* __restrict__ dst, int K, int n0, int k0,
                               int gate_skip, float* tile  ) {
  const int tid = tid_opaque();
  const int c = tid & 63, r0 = tid >> 6;
  int n = n0 + c;
  int col = n + ((gate_skip && n >= 2304) ? 8 : 0);
#pragma unroll 4
  for (int j = 0; j < 16; ++j) {
    int r = r0 + 4 * j;
    tile[r * 65 + c] = src[(size_t)(k0 + r) * lds + col];
  }
  __syncthreads();
  const int nn = tid >> 2, kg = (tid & 3) * 16;
  unsigned w[8];
#pragma unroll
  for (int j = 0; j < 8; ++j) w[j] = pack2(tile[(kg + 2 * j) * 65 + nn], tile[(kg + 2 * j + 1) * 65 + nn]);
  uint4* d = reinterpret_cast<uint4*>(dst + (size_t)(n0 + nn) * K + k0 + kg);
  d[0] = make_uint4(w[0], w[1], w[2], w[3]);
  d[1] = make_uint4(w[4], w[5], w[6], w[7]);
  __syncthreads();
}

__device__ __forceinline__ int rel_bucket_dev(int rel) {
  int ret = rel > 0 ? 16 : 0;
  int n = rel < 0 ? -rel : rel;
  int b;
  if (n < 8) b = n;
  else if (n < 12) b = 8;
  else if (n < 16) b = 9;
  else if (n < 23) b = 10;
  else if (n < 32) b = 11;
  else if (n < 46) b = 12;
  else if (n < 64) b = 13;
  else if (n < 91) b = 14;
  else b = 15;
  return ret + b;
}

__device__ __forceinline__ void ph_prep(const Params& p, char* smem, int bid, int nblk) {
  const int tid = tid_opaque();
  float* tile = reinterpret_cast<float*>(smem);
  for (int u = bid; u < 2 * 1472; u += nblk) {
    int l = u / 1472, r = u % 1472;
    if (r < 704) {
      int nt = r / 16, kt = r % 16;
      transpose_tile(p.w_in() + (size_t)l * 1024 * 2824, 2824, p.wt_in() + (size_t)l * NIN * 1024, 1024, nt * 64, kt * 64, 1, tile);
    } else if (r < 960) {
      r -= 704; int nt = r / 16, kt = r % 16;
      transpose_tile(p.w_out() + (size_t)l * 1024 * 1024, 1024, p.wt_out() + (size_t)l * 1024 * 1024, 1024, nt * 64, kt * 64, 0, tile);
    } else {
      r -= 960; int nt = r / 16, kt = r % 16;
      transpose_tile(p.peer_wq() + (size_t)l * 1024 * 2048, 2048, p.wt_pq() + (size_t)l * 2048 * 1024, 1024, nt * 64, kt * 64, 0, tile);
    }
  }
  for (int u = bid; u < 1024; u += nblk) {
    int kt = u & 15, h = (u >> 4) & 3, b = (u >> 6) & 7, l = u >> 9;
    const float* src = p.cache_v() + (((size_t)(l * 8 + b) * 1024 + kt * 64) * 4 + h) * 128;
    {
      int c = tid & 127, r0 = tid >> 7;
      for (int j = 0; j < 32; ++j) { int r = r0 + 2 * j; tile[r * 129 + c] = src[(size_t)r * 512 + c]; }
    }
    __syncthreads();
    {
      int dv = tid >> 1, half = tid & 1;
      bf16_t* dst = p.Vts() + ((size_t)((l * 8 + b) * 4 + h) * 128 + dv) * SKEYS + kt * 64 + half * 32;
      unsigned w[16];
#pragma unroll
      for (int j = 0; j < 16; ++j) {
        int pos0 = half * 32 + 2 * j;
        int blk = (pos0 >> 2) & 3;
        int oblk = (blk == 1) ? 2 : (blk == 2 ? 1 : blk);
        int key0 = (pos0 & ~15) + oblk * 4 + (pos0 & 3);
        w[j] = pack2(tile[key0 * 129 + dv], tile[(key0 + 1) * 129 + dv]);
      }
      uint4* d4 = reinterpret_cast<uint4*>(dst);
      d4[0] = make_uint4(w[0], w[1], w[2], w[3]);
      d4[1] = make_uint4(w[4], w[5], w[6], w[7]);
      d4[2] = make_uint4(w[8], w[9], w[10], w[11]);
      d4[3] = make_uint4(w[12], w[13], w[14], w[15]);
    }
    __syncthreads();
  }
  const size_t gtid = (size_t)bid * 256 + tid, gsz = (size_t)nblk * 256;
  {
    const int lane = tid & 63, wv = tid >> 6;
    for (int r = bid * 4 + wv; r < 2 * 32768; r += nblk * 4) {
      const int tab = r >> 15, row = r & 32767;
      const float* src = (tab == 0 ? p.peer_u() : p.peer_v()) + (size_t)row * 1024 + lane * 16;
      float4 f0 = reinterpret_cast<const float4*>(src)[0], f1 = reinterpret_cast<const float4*>(src)[1];
      float4 f2 = reinterpret_cast<const float4*>(src)[2], f3 = reinterpret_cast<const float4*>(src)[3];
      float am = fmaxf(fmaxf(fmaxf(fabsf(f0.x), fabsf(f0.y)), fmaxf(fabsf(f0.z), fabsf(f0.w))),
                       fmaxf(fmaxf(fabsf(f1.x), fabsf(f1.y)), fmaxf(fabsf(f1.z), fabsf(f1.w))));
      am = fmaxf(am, fmaxf(fmaxf(fmaxf(fabsf(f2.x), fabsf(f2.y)), fmaxf(fabsf(f2.z), fabsf(f2.w))),
                           fmaxf(fmaxf(fabsf(f3.x), fabsf(f3.y)), fmaxf(fabsf(f3.z), fabsf(f3.w)))));
      am = wave_max(am);
      const float sc = am > 0.f ? 224.f / am : 1.f;
      int w0 = 0, w1 = 0, w2 = 0, w3 = 0;
      w0 = __builtin_amdgcn_cvt_pk_fp8_f32(f0.x * sc, f0.y * sc, w0, false); w0 = __builtin_amdgcn_cvt_pk_fp8_f32(f0.z * sc, f0.w * sc, w0, true);
      w1 = __builtin_amdgcn_cvt_pk_fp8_f32(f1.x * sc, f1.y * sc, w1, false); w1 = __builtin_amdgcn_cvt_pk_fp8_f32(f1.z * sc, f1.w * sc, w1, true);
      w2 = __builtin_amdgcn_cvt_pk_fp8_f32(f2.x * sc, f2.y * sc, w2, false); w2 = __builtin_amdgcn_cvt_pk_fp8_f32(f2.z * sc, f2.w * sc, w2, true);
      w3 = __builtin_amdgcn_cvt_pk_fp8_f32(f3.x * sc, f3.y * sc, w3, false); w3 = __builtin_amdgcn_cvt_pk_fp8_f32(f3.z * sc, f3.w * sc, w3, true);
      unsigned char* dst = (tab == 0 ? p.ub8() : p.vb8()) + (size_t)row * 1024 + lane * 16;
      *reinterpret_cast<uint4*>(dst) = make_uint4((unsigned)w0, (unsigned)w1, (unsigned)w2, (unsigned)w3);
      if (lane == 0) (tab == 0 ? p.us() : p.vs())[row] = am > 0.f ? am * (1.f / 224.f) : 1.f;
    }
  }
  {
    const size_t n8 = (size_t)2 * 16 * 128 * 128 / 8;
    for (size_t i = gtid; i < n8; i += gsz) {
      float4 a = reinterpret_cast<const float4*>(p.peer_keys())[2 * i], b = reinterpret_cast<const float4*>(p.peer_keys())[2 * i + 1];
      reinterpret_cast<uint4*>(p.keysb())[i] = make_uint4(pack2(a.x, a.y), pack2(a.z, a.w), pack2(b.x, b.y), pack2(b.z, b.w));
    }
  }
  {
    const size_t n8 = (size_t)2 * 8 * 1024 * 512 / 8;
    for (size_t i = gtid; i < n8; i += gsz) {
      size_t e = i * 8;
      size_t lb = e / (1024 * 512), rem = e % (1024 * 512);
      float4 a = reinterpret_cast<const float4*>(p.cache_k())[2 * i], b = reinterpret_cast<const float4*>(p.cache_k())[2 * i + 1];
      *reinterpret_cast<uint4*>(p.Kbs() + lb * (SKEYS * 512) + rem) = make_uint4(pack2(a.x, a.y), pack2(a.z, a.w), pack2(b.x, b.y), pack2(b.z, b.w));
    }
  }
  for (size_t i = gtid; i < 2 * 8 * 1024; i += gsz) {
    int l = (int)(i / 8192), r = (int)(i % 8192), g = r / 1024, k = r % 1024;
    p.wg()[i] = p.w_in()[((size_t)l * 1024 + k) * 2824 + 2304 + g];
  }
  {
    float* sp = reinterpret_cast<float*>(p.ws + WS_sp);
    for (size_t i = gtid; i < 262144; i += gsz) sp[SP_st_c + i] = p.in[4][i];
    for (size_t i = gtid; i < 4096; i += gsz) sp[SP_st_n + i] = p.in[5][i];
    for (size_t i = gtid; i < 64; i += gsz) sp[SP_st_m + i] = p.in[6][i];
    for (size_t i = gtid; i < 12288; i += gsz) sp[SP_st_conv + i] = p.in[7][i];
    for (size_t i = gtid; i < 2048; i += gsz) sp[SP_norm1_g + i] = p.in[8][i];
    for (size_t i = gtid; i < 256; i += gsz) sp[SP_da_subln_g + i] = p.in[11][i];
    for (size_t i = gtid; i < 2048; i += gsz) sp[SP_ml_conv_w + i] = p.in[13][i];
    for (size_t i = gtid; i < 512; i += gsz) sp[SP_ml_conv_b + i] = p.in[14][i];
    for (size_t i = gtid; i < 32768; i += gsz) sp[SP_ml_wq + i] = p.in[15][i];
    for (size_t i = gtid; i < 32768; i += gsz) sp[SP_ml_wk + i] = p.in[16][i];
    for (size_t i = gtid; i < 16; i += gsz) sp[SP_ml_gate_b + i] = p.in[17][i];
    for (size_t i = gtid; i < 512; i += gsz) sp[SP_ml_norm_g + i] = p.in[18][i];
    for (size_t i = gtid; i < 512; i += gsz) sp[SP_ml_skip + i] = p.in[19][i];
    for (size_t i = gtid; i < 512; i += gsz) sp[SP_cm_norm_g + i] = p.in[20][i];
    for (size_t i = gtid; i < 131072; i += gsz) sp[SP_cm_ws + i] = p.in[21][i];
    for (size_t i = gtid; i < 1024; i += gsz) sp[SP_cm_b + i] = p.in[22][i];
    for (size_t i = gtid; i < 2048; i += gsz) sp[SP_norm2_g + i] = p.in[24][i];
    for (size_t i = gtid; i < 1024; i += gsz) sp[SP_final_g + i] = p.in[29][i];
  }
  if (bid == 0) {
    for (int i = tid; i < 4 * 256; i += 256) {
      int h = i >> 8, j = i & 255;
      int rel = j - 191; if (rel > 63) rel = 63;
      p.lut()[i] = p.rel_table()[rel_bucket_dev(rel) * 4 + h] * LOG2E;
    }
    if (tid < 2) {
      const float* lp = p.da_lambda() + tid * 256;
      float s01 = 0.f, s23 = 0.f;
      for (int d = 0; d < 64; ++d) { s01 += lp[d] * lp[64 + d]; s23 += lp[128 + d] * lp[192 + d]; }
      float lam_init = 0.8f - 0.6f * expf(-0.3f * (float)tid);
      p.lam()[tid] = expf(s01) - expf(s23) + lam_init;
    }
  }
}

template <int MODE>
__device__ __forceinline__ void ph_rmsnorm(const Params& p, int l, int bid, int nblk) {
  const int lane = tid_opaque() & 63, w = tid_opaque() >> 6;
  const float* g = (MODE == 0) ? p.norm1_g() + l * 1024 : (MODE == 1 ? p.norm2_g() + l * 1024 : p.final_g());
  float4 gv[4];
#pragma unroll
  for (int j = 0; j < 4; ++j) gv[j] = reinterpret_cast<const float4*>(g)[lane + 64 * j];
  for (int t = bid * 4 + w; t < NTOK; t += nblk * 4) {
    const float* xr = (MODE == 0) ? xrow_in(p, l, t) : p.x() + (size_t)t * 1024;
    float4 xv[4];
    float ss = 0.f;
#pragma unroll
    for (int j = 0; j < 4; ++j) {
      xv[j] = reinterpret_cast<const float4*>(xr)[lane + 64 * j];
      ss += xv[j].x * xv[j].x + xv[j].y * xv[j].y + xv[j].z * xv[j].z + xv[j].w * xv[j].w;
    }
    ss = wave_sum(ss);
    float r = rsqrtf(ss * (1.f / 1024.f) + EPS);
#pragma unroll
    for (int j = 0; j < 4; ++j) {
      xv[j].x *= r * gv[j].x; xv[j].y *= r * gv[j].y; xv[j].z *= r * gv[j].z; xv[j].w *= r * gv[j].w;
    }
    if (MODE == 2) {
      float* o = (t < NPROMPT) ? p.out + O_Y_P + (size_t)t * 1024 : p.out + O_Y_S + (size_t)(t - NPROMPT) * 1024;
#pragma unroll
      for (int j = 0; j < 4; ++j) reinterpret_cast<float4*>(o)[lane + 64 * j] = xv[j];
    } else {
      uint2* o = reinterpret_cast<uint2*>(p.xn() + (size_t)t * 1024);
#pragma unroll
      for (int j = 0; j < 4; ++j) o[lane + 64 * j] = make_uint2(pack2(xv[j].x, xv[j].y), pack2(xv[j].z, xv[j].w));
    }
    if (MODE == 0) {
      float pre[8];
#pragma unroll
      for (int i = 0; i < 8; ++i) {
        const float4* wr = reinterpret_cast<const float4*>(p.wg() + ((size_t)l * 8 + i) * 1024);
        float s = 0.f;
#pragma unroll
        for (int j = 0; j < 4; ++j) {
          float4 wv = wr[lane + 64 * j];
          s += xv[j].x * wv.x + xv[j].y * wv.y + xv[j].z * wv.z + xv[j].w * wv.w;
        }
        pre[i] = wave_sum(s);
      }
      if (lane < 4) {
        float a = pre[0]; a = lane == 1 ? pre[1] : a; a = lane == 2 ? pre[2] : a; a = lane == 3 ? pre[3] : a;
        float f = pre[4]; f = lane == 1 ? pre[5] : f; f = lane == 2 ? pre[6] : f; f = lane == 3 ? pre[7] : f;
        p.ig()[(size_t)t * 4 + lane] = a + p.ml_gate_b()[l * 8 + lane];
        float z = f + p.ml_gate_b()[l * 8 + 4 + lane];
        p.lf()[(size_t)t * 4 + lane] = fminf(z, 0.f) - log1pf(expf(-fabsf(z)));
      }
    }
  }
}

__device__ __forceinline__ int mono_key(float v) { int b = __float_as_int(v); return b ^ ((b >> 31) & 0x7FFFFFFF); }
__device__ __forceinline__ float mono_val(int k) { int b = k ^ ((k >> 31) & 0x7FFFFFFF); return __int_as_float(b); }

__device__ __forceinline__ int med3i(int a, int b, int c) { return max(min(a, b), min(max(a, b), c)); }
#define INS16(L, kv)                                                          \
  {                                                                           \
    const int _v = (kv);                                                      \
    _Pragma("unroll") for (int _j = 15; _j >= 1; --_j) L[_j] = med3i(L[_j - 1], L[_j], _v); \
    L[0] = max(L[0], _v);                                                     \
  }


enum { EPI_WIN = 0, EPI_WOUT = 1, EPI_PQ = 2, EPI_SC = 3 };

template <int EPI>
__device__ __forceinline__ void gemm_store(const Params& p, int l, int t, int n, float v) {
  if (EPI == EPI_WOUT) {
    const float* xi = xrow_in(p, l, t);
    p.x()[(size_t)t * 1024 + n] = xi[n] + v;
  } else if (EPI == EPI_PQ) {
    p.qp()[(size_t)t * 2048 + n] = f2bf(v);
  } else if (EPI == EPI_SC) {
    p.sc()[(size_t)t * 2048 + n] = v;
  }
}

template <int EPI>
__device__ __forceinline__ void ph_gemm(const Params& p, int l, char* smem, int bid, int nblk) {
  constexpr int NT = (EPI == EPI_WIN) ? 22 : (EPI == EPI_WOUT ? 8 : 16);
  constexpr int MT = NTOK / 128;
  constexpr int K = (EPI == EPI_SC) ? 128 : 1024;
  constexpr int NK = K / 64;
  const bf16_t* A; int lda; const bf16_t* Bt; int ldb;
  if (EPI == EPI_WIN) { A = p.xn(); lda = 1024; Bt = p.wt_in() + (size_t)l * NIN * 1024; ldb = 1024; }
  else if (EPI == EPI_WOUT) { A = p.xn(); lda = 1024; Bt = p.wt_out() + (size_t)l * 1024 * 1024; ldb = 1024; }
  else if (EPI == EPI_PQ) { A = p.xn(); lda = 1024; Bt = p.wt_pq() + (size_t)l * 2048 * 1024; ldb = 1024; }
  else { A = p.qp(); lda = 2048; Bt = p.keysb() + (size_t)l * 16 * 128 * 128; ldb = 128; }

  const int tid = tid_opaque(), lane = tid & 63, w = tid >> 6;
  const int wm = w >> 1, wn = w & 1, lr = lane & 31, lh = lane >> 5;
  char* sA = smem;
  char* sB = smem + 32768;
  const int ld_c = tid & 7, ld_r = tid >> 3;

  const int nx = nblk >> 3;
  constexpr int FG = MT / 8, LR = MT % 8;
  for (int rnd = 0;; ++rnd) {
    const int q = (nblk & 7) ? rnd * nblk + bid : rnd * nblk + (bid & 7) * nx + (bid >> 3);
    if (q >= MT * NT) break;
    int mt, nt;
    if (q < FG * 8 * NT) { const int mg = q / (8 * NT), rem = q % (8 * NT); nt = rem >> 3; mt = mg * 8 + (rem & 7); }
    else { const int q2 = q - FG * 8 * NT; nt = q2 / (LR > 0 ? LR : 1); mt = FG * 8 + q2 % (LR > 0 ? LR : 1); }
    const bf16_t* Ag = A + (size_t)(mt * 128) * lda + ((EPI == EPI_SC) ? nt * 128 : 0);
    const bf16_t* Bg = Bt + (size_t)(nt * 128) * ldb;
    f32x16 acc[2][2];
#pragma unroll
    for (int i = 0; i < 2; ++i)
#pragma unroll
      for (int j = 0; j < 2; ++j)
#pragma unroll
        for (int r = 0; r < 16; ++r) acc[i][j][r] = 0.f;

    const int g_row = w * 32 + (lane >> 3);
    const int g_pc = lane & 7;
    const bf16_t* Ath = Ag + (size_t)g_row * lda;
    const bf16_t* Bth = Bg + (size_t)g_row * ldb;
#define GEMM_STAGE(KT, BUF)                                                                                          \
  _Pragma("unroll") for (int j = 0; j < 4; ++j) {                                                                    \
    const int row = g_row + 8 * j;                                                                                   \
    const int cch = g_pc ^ ((row >> 1) & 7);                                                                         \
    __builtin_amdgcn_global_load_lds((const unsigned*)(Ath + (size_t)(8 * j) * lda + (KT) * 64 + cch * 8),           \
                                     (LAS unsigned*)(sA + (BUF) * 16384 + (w * 4 + j) * 1024 + lane * 16), 16, 0, 0); \
    __builtin_amdgcn_global_load_lds((const unsigned*)(Bth + (size_t)(8 * j) * ldb + (KT) * 64 + cch * 8),           \
                                     (LAS unsigned*)(sB + (BUF) * 16384 + (w * 4 + j) * 1024 + lane * 16), 16, 0, 0); \
  }
    GEMM_STAGE(0, 0)
    __syncthreads();
    for (int kt = 0; kt < NK; ++kt) {
      const int buf = kt & 1;
      if (kt + 1 < NK) { GEMM_STAGE(kt + 1, buf ^ 1) }
      const char* cA = sA + buf * 16384;
      const char* cB = sB + buf * 16384;
#pragma unroll
      for (int ks = 0; ks < 4; ++ks) {
        bf16x8 af[2], bfr[2];
#pragma unroll
        for (int i = 0; i < 2; ++i) {
          int row = wm * 64 + i * 32 + lr; int pc = (ks * 2 + lh) ^ ((row >> 1) & 7);
          af[i] = as_bf16x8(*reinterpret_cast<const uint4*>(cA + row * 128 + pc * 16));
        }
#pragma unroll
        for (int j = 0; j < 2; ++j) {
          int row = wn * 64 + j * 32 + lr; int pc = (ks * 2 + lh) ^ ((row >> 1) & 7);
          bfr[j] = as_bf16x8(*reinterpret_cast<const uint4*>(cB + row * 128 + pc * 16));
        }
#pragma unroll
        for (int i = 0; i < 2; ++i)
#pragma unroll
          for (int j = 0; j < 2; ++j)
            acc[i][j] = __builtin_amdgcn_mfma_f32_32x32x16_bf16(af[i], bfr[j], acc[i][j], 0, 0, 0);
      }
      __syncthreads();
    }
    if (EPI == EPI_PQ) {
      int lane_q = lane; asm volatile("" : "+v"(lane_q));
      const int lr = lane_q & 31, lh = lane_q >> 5;
      char* sA2 = smem;
      char* sB2 = smem + 32768;
      const bf16_t* kg = p.keysb() + ((size_t)l * 16 + nt) * 128 * 128;
#pragma unroll
      for (int jj = 0; jj < 8; ++jj) {
        const int I = w * 8 + jj;
        const int row = I * 4 + (lane_q >> 4);
        const int cch = (lane_q & 15) ^ (row & 15);
        __builtin_amdgcn_global_load_lds((const unsigned*)(kg + (size_t)row * 128 + cch * 8),
                                         (LAS unsigned*)(sB2 + I * 1024 + lane_q * 16), 16, 0, 0);
      }
#pragma unroll
      for (int i = 0; i < 2; ++i) {
        float rs[16];
#pragma unroll
        for (int r = 0; r < 16; ++r) rs[r] = 0.f;
#pragma unroll
        for (int j = 0; j < 2; ++j) {
          const int n = wn * 64 + j * 32 + lr;
#pragma unroll
          for (int r = 0; r < 16; ++r) {
            const int row = wm * 64 + i * 32 + (r & 3) + 8 * (r >> 2) + 4 * lh;
            const float v = acc[i][j][r];
            rs[r] += v * v;
            *reinterpret_cast<bf16_t*>(sA2 + row * 256 + (((n >> 3) ^ (row & 15)) * 16) + (n & 7) * 2) = f2bf(v);
          }
        }
#pragma unroll
        for (int r = 0; r < 16; ++r) {
          const float s = swap16_sum(row16_sum(rs[r]));
          if (lr == 0) {
            const int t = mt * 128 + wm * 64 + i * 32 + (r & 3) + 8 * (r >> 2) + 4 * lh;
            p.ssp()[(size_t)t * 32 + nt * 2 + wn] = s;
          }
        }
      }
      __syncthreads();
      f32x16 sc2[2][2];
#pragma unroll
      for (int i = 0; i < 2; ++i)
#pragma unroll
        for (int j = 0; j < 2; ++j)
#pragma unroll
          for (int r = 0; r < 16; ++r) sc2[i][j][r] = 0.f;
#pragma unroll
      for (int ks = 0; ks < 8; ++ks) {
        bf16x8 af[2], bfr[2];
#pragma unroll
        for (int i = 0; i < 2; ++i) {
          const int row = wm * 64 + i * 32 + lr;
          af[i] = as_bf16x8(*reinterpret_cast<const uint4*>(sA2 + row * 256 + (((ks * 2 + lh) ^ (row & 15)) * 16)));
        }
#pragma unroll
        for (int j = 0; j < 2; ++j) {
          const int row = wn * 64 + j * 32 + lr;
          bfr[j] = as_bf16x8(*reinterpret_cast<const uint4*>(sB2 + row * 256 + (((ks * 2 + lh) ^ (row & 15)) * 16)));
        }
#pragma unroll
        for (int i = 0; i < 2; ++i)
#pragma unroll
          for (int j = 0; j < 2; ++j)
            sc2[i][j] = __builtin_amdgcn_mfma_f32_32x32x16_bf16(af[i], bfr[j], sc2[i][j], 0, 0, 0);
      }
      __syncthreads();
      float* sS = reinterpret_cast<float*>(smem);
#pragma unroll
      for (int i = 0; i < 2; ++i)
#pragma unroll
        for (int j = 0; j < 2; ++j)
#pragma unroll
          for (int r = 0; r < 16; ++r) {
            const int row = wm * 64 + i * 32 + (r & 3) + 8 * (r >> 2) + 4 * lh;
            sS[row * 129 + wn * 64 + j * 32 + lr] = sc2[i][j][r];
          }
      __syncthreads();
      {
        int tq = tid; asm volatile("" : "+v"(tq));
        const int tk = tq & 127, hl = tq >> 7;
        int L[16];
#pragma unroll
        for (int j = 0; j < 16; ++j) L[j] = (int)0x80000000;
        const float* srow = sS + tk * 129 + hl * 64;
#pragma unroll 4
        for (int s = 0; s < 64; ++s) {
          const int key = (mono_key(srow[s]) & ~127) | (127 - (hl * 64 + s));
          INS16(L, key)
        }
        int4* dst = reinterpret_cast<int4*>(p.tl() + (((size_t)(mt * 128 + tk) * 16 + nt) * 2 + hl) * 16);
        dst[0] = make_int4(L[0], L[1], L[2], L[3]); dst[1] = make_int4(L[4], L[5], L[6], L[7]);
        dst[2] = make_int4(L[8], L[9], L[10], L[11]); dst[3] = make_int4(L[12], L[13], L[14], L[15]);
      }
      __syncthreads();
    } else if (EPI != EPI_WIN) {
#pragma unroll
      for (int i = 0; i < 2; ++i)
#pragma unroll
        for (int j = 0; j < 2; ++j)
#pragma unroll
          for (int r = 0; r < 16; ++r) {
            int t = mt * 128 + wm * 64 + i * 32 + (r & 3) + 8 * (r >> 2) + 4 * lh;
            int n = nt * 128 + wn * 64 + j * 32 + lr;
            gemm_store<EPI>(p, l, t, n, acc[i][j][r]);
          }
    } else {
      const int seg = nt >> 2;
#pragma unroll
      for (int i = 0; i < 2; ++i)
#pragma unroll
        for (int j = 0; j < 2; ++j) {
          const int n = nt * 128 + wn * 64 + j * 32 + lr;
          if (nt < 4) {
#pragma unroll
            for (int r = 0; r < 16; ++r) {
              int t = mt * 128 + wm * 64 + i * 32 + (r & 3) + 8 * (r >> 2) + 4 * lh;
              p.Qb()[(size_t)t * 512 + n] = f2bf(acc[i][j][r] * (0.125f * LOG2E));
            }
          } else if (nt < 8) {
            const int n2 = n - 512;
#pragma unroll
            for (int r = 0; r < 16; ++r) {
              int t = mt * 128 + wm * 64 + i * 32 + (r & 3) + 8 * (r >> 2) + 4 * lh;
              float v = acc[i][j][r];
              if (t < NPROMPT) {
                p.out[O_K_P + (size_t)l * (4 * 4096 * 512) + (size_t)t * 512 + n2] = v;
                p.Kb()[(size_t)t * 512 + n2] = f2bf(v);
              } else {
                int ts = t - NPROMPT, b = ts >> 6, ii = ts & 63;
                p.out[O_K_S + (size_t)l * (8 * 64 * 512) + (size_t)ts * 512 + n2] = v;
                p.Kbs()[((size_t)(l * 8 + b) * SKEYS + 1024 + ii) * 512 + n2] = f2bf(v);
              }
            }
          } else if (nt < 12) {
            const int n2 = n - 1024, h = n2 >> 7, dv = n2 & 127;
#pragma unroll
            for (int rg = 0; rg < 4; ++rg) {
              int tb = mt * 128 + wm * 64 + i * 32 + 8 * rg + 4 * lh;
              float v0 = acc[i][j][rg * 4 + 0], v1 = acc[i][j][rg * 4 + 1], v2 = acc[i][j][rg * 4 + 2], v3 = acc[i][j][rg * 4 + 3];
              uint2 pk = make_uint2(pack2(v0, v1), pack2(v2, v3));
              int posblk = 2 * lh + (rg & 1);
              if (tb < NPROMPT) {
                float* o = p.out + O_V_P + (size_t)l * (4 * 4096 * 512) + (size_t)tb * 512 + n2;
                o[0] = v0; o[512] = v1; o[1024] = v2; o[1536] = v3;
                int b = tb >> 12, s = tb & 4095;
                int pos = (s & ~15) + posblk * 4;
                *reinterpret_cast<uint2*>(p.Vt() + ((size_t)(b * 4 + h) * 128 + dv) * SEQ + pos) = pk;
              } else {
                int ts = tb - NPROMPT, b = ts >> 6, ii = ts & 63;
                float* o = p.out + O_V_S + (size_t)l * (8 * 64 * 512) + (size_t)ts * 512 + n2;
                o[0] = v0; o[512] = v1; o[1024] = v2; o[1536] = v3;
                int pos = 1024 + (ii & ~15) + posblk * 4;
                *reinterpret_cast<uint2*>(p.Vts() + ((size_t)((l * 8 + b) * 4 + h) * 128 + dv) * SKEYS + pos) = pk;
              }
            }
          } else {
            const int n2 = n - 1536;
            const bool act = (n >= 2304);
#pragma unroll
            for (int r = 0; r < 16; ++r) {
              int t = mt * 128 + wm * 64 + i * 32 + (r & 3) + 8 * (r >> 2) + 4 * lh;
              float v = acc[i][j][r];
              if (act) v = gelu_exact(v);
              p.P5()[(size_t)t * 1280 + n2] = v;
            }
          }
        }
      (void)seg;
    }
  }
}

struct WorkQ { unsigned* cnt; volatile int* slot; };
__device__ __forceinline__ int wq_next(const WorkQ& q) {
  __syncthreads();
  if (threadIdx.x == 0) *q.slot = (int)__hip_atomic_fetch_add(q.cnt, 1u, __ATOMIC_RELAXED, __HIP_MEMORY_SCOPE_AGENT);
  __syncthreads();
  return __builtin_amdgcn_readfirstlane(*q.slot);
}

__device__ __forceinline__ int ph_attn(const Params& p, int l, char* smem, const WorkQ& wq) {
  const int tid = tid_opaque(), lane = tid & 63, w = tid >> 6;
  const int c = w >> 1, qhalf = w & 1, lr = lane & 31, lh = lane >> 5;
  float* sLut = reinterpret_cast<float*>(smem + 65536);
  float* sO2 = reinterpret_cast<float*>(smem);
  const float lam = p.lam()[l];
  const float lam_init = 0.8f - 0.6f * expf(-0.3f * (float)l);

  int uu;
  for (uu = wq_next(wq); uu < 1056; uu = wq_next(wq)) {
    int b, h, qc, S, qrow0; const bf16_t *Kbase, *Vbase;
    bool samp = false; int u2 = uu;
    if (uu >= 752 && uu < 784) samp = true; else if (uu >= 784) u2 = uu - 32;
    if (!samp) {
      qc = 63 - (u2 >> 4); int bh = u2 & 15; b = bh >> 2; h = bh & 3; S = SEQ;
      Kbase = p.Kb() + (size_t)b * SEQ * 512 + h * 128;
      Vbase = p.Vt() + (size_t)(b * 4 + h) * 128 * SEQ;
      qrow0 = b * SEQ + qc * 64;
    } else {
      int us = uu - 752; b = us >> 2; h = us & 3; qc = 16; S = SKEYS;
      Kbase = p.Kbs() + (size_t)(l * 8 + b) * SKEYS * 512 + h * 128;
      Vbase = p.Vts() + (size_t)((l * 8 + b) * 4 + h) * 128 * SKEYS;
      qrow0 = NPROMPT + b * 64;
    }
    const int ntiles = qc + 1;
    __syncthreads();
    sLut[tid] = p.lut()[h * 256 + tid];
    if (tid < 128) sLut[256 + tid] = p.da_subln_g()[l * 128 + tid];
    bf16x8 qf[4];
    {
      const bf16_t* qrow = p.Qb() + (size_t)(qrow0 + qhalf * 32 + lr) * 512 + h * 128 + c * 64 + lh * 8;
#pragma unroll
      for (int ks = 0; ks < 4; ++ks) qf[ks] = as_bf16x8(*reinterpret_cast<const uint4*>(qrow + ks * 16));
    }
    f32x16 o[4];
#pragma unroll
    for (int d = 0; d < 4; ++d)
#pragma unroll
      for (int r = 0; r < 16; ++r) o[d][r] = 0.f;
    float m_run = -1e30f, l_run = 0.f;
    const float c15 = p.lut()[h * 256];

    const char* Kt = reinterpret_cast<const char*>(Kbase);
    const char* Vb = reinterpret_cast<const char*>(Vbase);
    const int g_r8 = lane >> 3, g_pc = lane & 7;
#define ATTN_STAGE(KT, BUF)                                                                                         \
  _Pragma("unroll") for (int j = 0; j < 4; ++j) {                                                                   \
    const int I = w * 4 + j;                                                                                        \
    const int rk = (I & 7) * 8 + g_r8;                                                                              \
    const unsigned kof = (unsigned)rk * 1024u + (unsigned)(I >> 3) * 128u + (unsigned)((g_pc ^ ((rk >> 1) & 7)) * 16); \
    __builtin_amdgcn_global_load_lds((const unsigned*)(Kt + (size_t)(KT) * 65536 + kof),                            \
                                     (LAS unsigned*)(smem + (BUF) * 32768 + I * 1024 + lane * 16), 16, 0, 0);       \
    const int rv = I * 8 + g_r8;                                                                                    \
    const unsigned vof = (unsigned)rv * (unsigned)(S * 2) + (unsigned)((g_pc ^ ((rv >> 1) & 7)) * 16);              \
    __builtin_amdgcn_global_load_lds((const unsigned*)(Vb + (size_t)(KT) * 128 + vof),                              \
                                     (LAS unsigned*)(smem + (BUF) * 32768 + 16384 + I * 1024 + lane * 16), 16, 0, 0); \
  }
    ATTN_STAGE(0, 0)
    __syncthreads();
    for (int kt = 0; kt < ntiles; ++kt) {
      const int buf = kt & 1;
      if (kt + 1 < ntiles) { ATTN_STAGE(kt + 1, buf ^ 1) }
      const char* sK = smem + buf * 32768;
      const char* sV = sK + 16384;
      f32x16 s[2];
      {
        bf16x8 kf[2][4];
#pragma unroll
        for (int kb = 0; kb < 2; ++kb)
#pragma unroll
          for (int ks = 0; ks < 4; ++ks) {
            int row = kb * 32 + lr; int pc = (ks * 2 + lh) ^ ((row >> 1) & 7);
            kf[kb][ks] = as_bf16x8(*reinterpret_cast<const uint4*>(sK + c * 8192 + row * 128 + pc * 16));
          }
        __builtin_amdgcn_sched_barrier(0);
#pragma unroll
        for (int kb = 0; kb < 2; ++kb) {
#pragma unroll
          for (int r = 0; r < 16; ++r) s[kb][r] = 0.f;
#pragma unroll
          for (int ks = 0; ks < 4; ++ks) s[kb] = __builtin_amdgcn_mfma_f32_32x32x16_bf16(kf[kb][ks], qf[ks], s[kb], 0, 0, 0);
        }
      }
      bf16x8 vfa[2][4];
#pragma unroll
      for (int k2 = 0; k2 < 2; ++k2)
#pragma unroll
        for (int d = 0; d < 4; ++d) {
          int row = d * 32 + lr; int pc = (k2 * 2 + lh) ^ ((row >> 1) & 7);
          vfa[k2][d] = as_bf16x8(*reinterpret_cast<const uint4*>(sV + row * 128 + pc * 16));
        }
      __builtin_amdgcn_sched_barrier(0);
      float boff = c15;
      if (kt >= qc - 2) {
        const int base = (kt - qc) * 64 - (qhalf * 32 + lr) + 191 + 4 * lh;
#pragma unroll
        for (int kb = 0; kb < 2; ++kb)
#pragma unroll
          for (int r = 0; r < 16; ++r) s[kb][r] += sLut[base + kb * 32 + (r & 3) + 8 * (r >> 2)];
        boff = 0.f;
      }
      float mx = s[0][0];
#pragma unroll
      for (int kb = 0; kb < 2; ++kb)
#pragma unroll
        for (int r = 0; r < 16; ++r) mx = fmaxf(mx, s[kb][r]);
      mx = swap32_max(mx) + boff;
      if (__any(mx > m_run)) {
        const float m_new = fmaxf(m_run, mx);
        const float alpha = __builtin_amdgcn_exp2f(m_run - m_new);
        m_run = m_new;
        l_run *= alpha;
#pragma unroll
        for (int d = 0; d < 4; ++d)
#pragma unroll
          for (int r = 0; r < 16; ++r) o[d][r] *= alpha;
      }
      const float eoff = boff - m_run;
      float ps = 0.f;
#pragma unroll
      for (int kb = 0; kb < 2; ++kb)
#pragma unroll
        for (int r = 0; r < 16; ++r) { float pv = __builtin_amdgcn_exp2f(s[kb][r] + eoff); s[kb][r] = pv; ps += pv; }
      l_run += ps;
      bf16x8 pf[4];
#pragma unroll
      for (int ks2 = 0; ks2 < 4; ++ks2) {
        const int kb = ks2 >> 1, sh = (ks2 & 1) * 8;
        uint4 pw = make_uint4(pack2(s[kb][sh + 0], s[kb][sh + 1]), pack2(s[kb][sh + 2], s[kb][sh + 3]),
                              pack2(s[kb][sh + 4], s[kb][sh + 5]), pack2(s[kb][sh + 6], s[kb][sh + 7]));
        pf[ks2] = as_bf16x8(pw);
      }
      __builtin_amdgcn_sched_barrier(0);
#define ATTN_VREAD(DST, K2)                                                                        \
  _Pragma("unroll") for (int d = 0; d < 4; ++d) {                                                  \
    int row = d * 32 + lr; int pc = ((K2) * 2 + lh) ^ ((row >> 1) & 7);                            \
    DST[d] = as_bf16x8(*reinterpret_cast<const uint4*>(sV + row * 128 + pc * 16));                 \
  }
#define ATTN_PV(SRC, K2) \
  _Pragma("unroll") for (int d = 0; d < 4; ++d) o[d] = __builtin_amdgcn_mfma_f32_32x32x16_bf16(SRC[d], pf[K2], o[d], 0, 0, 0);
      bf16x8 vfc[4];
      ATTN_VREAD(vfc, 2)
      ATTN_PV(vfa[0], 0)
      __builtin_amdgcn_sched_barrier(0);
      ATTN_VREAD(vfa[0], 3)
      ATTN_PV(vfa[1], 1)
      __builtin_amdgcn_sched_barrier(0);
      ATTN_PV(vfc, 2)
      ATTN_PV(vfa[0], 3)
      __syncthreads();
    }
    int lane_e = lane; asm volatile("" : "+v"(lane_e));
    const int lr_e = lane_e & 31, lh_e = lane_e >> 5;
    float lt = swap32_sum(l_run);
    float inv = 1.f / lt;
    __syncthreads();
    if (c == 1) {
#pragma unroll
      for (int d = 0; d < 4; ++d)
#pragma unroll
        for (int r = 0; r < 16; ++r) sO2[(qhalf * 64 + d * 16 + r) * 64 + lane_e] = o[d][r] * inv;
    }
    __syncthreads();
    if (c == 0) {
      float ss = 0.f;
#pragma unroll
      for (int d = 0; d < 4; ++d)
#pragma unroll
        for (int r = 0; r < 16; ++r) {
          float v = o[d][r] * inv - lam * sO2[(qhalf * 64 + d * 16 + r) * 64 + lane_e];
          o[d][r] = v; ss += v * v;
        }
      ss = swap32_sum(ss);
      const float rn = rsqrtf(ss * (1.f / 128.f) + EPS) * (1.f - lam_init);
      const float* gs = sLut + 256;
      bf16_t* orow = p.xn() + (size_t)(qrow0 + qhalf * 32 + lr_e) * 1024 + h * 128;
#pragma unroll
      for (int d = 0; d < 4; ++d)
#pragma unroll
        for (int rg = 0; rg < 4; ++rg) {
          int dv = d * 32 + 8 * rg + 4 * lh_e;
          float4 g4 = *reinterpret_cast<const float4*>(gs + dv);
          uint2 pk = make_uint2(pack2(o[d][rg * 4 + 0] * rn * g4.x, o[d][rg * 4 + 1] * rn * g4.y),
                                pack2(o[d][rg * 4 + 2] * rn * g4.z, o[d][rg * 4 + 3] * rn * g4.w));
          *reinterpret_cast<uint2*>(orow + dv) = pk;
        }
    }
  }
  return uu;
}

template <int K>
__device__ __forceinline__ void mfma32_f32(f32x16& acc, const float* a, int a_rs, int a_ks, const float* b, int b_ks, int b_js, int lane) {
  const float* ap = a + (lane & 31) * a_rs + (lane >> 5) * a_ks;
  const float* bp = b + (lane >> 5) * b_ks + (lane & 31) * b_js;
#pragma unroll 8
  for (int k = 0; k < K; k += 2) acc = __builtin_amdgcn_mfma_f32_32x32x2f32(ap[k * a_ks], bp[k * b_ks], acc, 0, 0, 0);
}
__device__ __forceinline__ void zero16(f32x16& a) {
#pragma unroll
  for (int r = 0; r < 16; ++r) a[r] = 0.f;
}

__device__ __forceinline__ int ph_mlconv(const Params& p, int l, char* smem, const WorkQ& wq, int item) {
  const int tid = tid_opaque();
  float* s_mc = reinterpret_cast<float*>(smem);
  float* s_cc = s_mc + 67 * 64;
  float* s_wq = s_cc + 64 * 65;
  float* s_wk = s_wq + 4096;
  for (; item < 1056 + 264 * 4; item = wq_next(wq)) {
    const int u = item - 1056;
    const int ci = u >> 2, h = u & 3;
    int token0, bq; bool samp = ci >= 256;
    if (!samp) token0 = ci * 64; else token0 = NPROMPT + (ci - 256) * 64;
    bq = samp ? (ci - 256) : (ci >> 6);
    const int cidx = samp ? 0 : (ci & 63);
    __syncthreads();
    for (int i = tid; i < 67 * 64; i += 256) {
      int r = i >> 6, d = i & 63;
      float v;
      if (r >= 3) v = p.P5()[(size_t)(token0 + r - 3) * 1280 + h * 64 + d];
      else if (samp) v = p.st_conv()[((size_t)(l * 8 + bq) * 3 + r) * 256 + h * 64 + d];
      else if (cidx == 0) v = 0.f;
      else v = p.P5()[(size_t)(token0 + r - 3) * 1280 + h * 64 + d];
      s_mc[i] = v;
    }
    for (int i = tid; i < 4096; i += 256) {
      s_wq[i] = p.ml_wq()[(size_t)(l * 4 + h) * 4096 + i];
      s_wk[i] = p.ml_wk()[(size_t)(l * 4 + h) * 4096 + i];
    }
    __syncthreads();
    {
      const int d = tid & 63, t0 = tid >> 6;
      const int ch = h * 64 + d;
      const float w0 = p.ml_conv_w()[(l * 4 + 0) * 256 + ch], w1 = p.ml_conv_w()[(l * 4 + 1) * 256 + ch];
      const float w2 = p.ml_conv_w()[(l * 4 + 2) * 256 + ch], w3 = p.ml_conv_w()[(l * 4 + 3) * 256 + ch];
      const float bb = p.ml_conv_b()[l * 256 + ch];
      for (int t = t0; t < 64; t += 4) {
        float y = bb + w0 * s_mc[t * 64 + d] + w1 * s_mc[(t + 1) * 64 + d] + w2 * s_mc[(t + 2) * 64 + d] + w3 * s_mc[(t + 3) * 64 + d];
        y = y * sigmoidf_(y);
        s_cc[t * 65 + d] = y;
        p.cc()[(size_t)(token0 + t) * 256 + ch] = y;
      }
      if (samp || cidx == 63) {
        if (tid < 192) {
          int r = tid >> 6;
          float v = s_mc[(64 + r) * 64 + d];
          if (samp) p.out[O_CONV_S + ((size_t)(l * 8 + bq) * 3 + r) * 256 + ch] = v;
          else p.out[O_CONV_P + ((size_t)(l * 4 + bq) * 3 + r) * 256 + ch] = v;
        }
      }
    }
    __syncthreads();
    {
      const int lane = tid & 63, w = tid >> 6, ti = w >> 1, tj = w & 1;
      f32x16 aq, ak; zero16(aq); zero16(ak);
      mfma32_f32<64>(aq, s_cc + ti * 32 * 65, 65, 1, s_wq + tj * 32, 64, 1, lane);
      mfma32_f32<64>(ak, s_cc + ti * 32 * 65, 65, 1, s_wk + tj * 32, 64, 1, lane);
#pragma unroll
      for (int r = 0; r < 16; ++r) {
        const int t = ti * 32 + (r & 3) + 8 * (r >> 2) + 4 * (lane >> 5);
        const size_t o = (size_t)(token0 + t) * 256 + h * 64 + tj * 32 + (lane & 31);
        p.qm()[o] = aq[r];
        p.km()[o] = ak[r] * 0.125f;
      }
      if (w == 0) {
        const int t = token0 + lane;
        const float lfv = p.lf()[(size_t)t * 4 + h], igv = p.ig()[(size_t)t * 4 + h];
        float F = lfv;
#pragma unroll
        for (int d = 1; d < 64; d <<= 1) { float n = __shfl_up(F, d); if (lane >= d) F += n; }
        const float FL = __shfl(F, 63);
        const float mx = wave_max(FL - F + igv);
        p.Fc()[(size_t)t * 4 + h] = F;
        if (lane == 0) {
          const int cu = samp ? 1024 + bq * 4 + h : (bq * 4 + h) * 64 + cidx;
          p.FLs()[cu] = FL; p.mxt()[cu] = mx;
        }
      }
    }
  }
  return item;
}

__device__ __forceinline__ void cu_decode(int cu, int& token0, int& h) {
  if (cu < 1024) { int bh = cu >> 6, c = cu & 63; token0 = (bh >> 2) * SEQ + c * 64; h = bh & 3; }
  else { int us = cu - 1024; token0 = NPROMPT + (us >> 2) * 64; h = us & 3; }
}

__device__ __forceinline__ void ph_mlU(const Params& p, int l, char* smem, int bid, int nblk) {
  const int tid = tid_opaque();
  const int lane = tid & 63, w = tid >> 6, ti = w >> 1, tj = w & 1;
  float* s_k = reinterpret_cast<float*>(smem);
  float* s_v = s_k + 4096;
  for (int cu = bid; cu < NCU_UNITS; cu += nblk) {
    int token0, h; cu_decode(cu, token0, h);
    float m0, mn, FL;
    {
      const bool samp = cu >= 1024;
      const int cu0 = samp ? cu : (cu & ~63), c = samp ? 0 : (cu & 63);
      float flv = 0.f, mxv = 0.f;
      if (lane <= c) { flv = p.FLs()[cu0 + lane]; mxv = p.mxt()[cu0 + lane]; }
      float m = samp ? p.st_m()[l * 32 + (cu - 1024)] : 0.f;
      for (int j = 0; j < c; ++j) {
        const float fj = __int_as_float(__builtin_amdgcn_readlane(__float_as_int(flv), j));
        const float xj = __int_as_float(__builtin_amdgcn_readlane(__float_as_int(mxv), j));
        m = fmaxf(fj + m, xj);
      }
      FL = __int_as_float(__builtin_amdgcn_readlane(__float_as_int(flv), c));
      const float xc = __int_as_float(__builtin_amdgcn_readlane(__float_as_int(mxv), c));
      m0 = m; mn = fmaxf(FL + m, xc);
      if (tid == 0) {
        p.mst()[cu] = m0; p.mnx()[cu] = mn; p.wcs()[cu] = expf(FL + m0 - mn);
        if (samp) p.out[O_M_S + l * 32 + (cu - 1024)] = mn;
        else if (c == 63) p.out[O_M_P + l * 16 + (cu >> 6)] = mn;
      }
    }
    __syncthreads();
    for (int i = tid; i < 1024; i += 256) {
      int s = i >> 4, d4 = (i & 15) * 4;
      const int t = token0 + s;
      float wsv = expf(FL - p.Fc()[(size_t)t * 4 + h] + p.ig()[(size_t)t * 4 + h] - mn);
      float4 k4 = *reinterpret_cast<const float4*>(p.km() + (size_t)t * 256 + h * 64 + d4);
      float4 v4 = *reinterpret_cast<const float4*>(p.P5() + (size_t)t * 1280 + 256 + h * 64 + d4);
      *reinterpret_cast<float4*>(s_k + s * 64 + d4) = make_float4(k4.x * wsv, k4.y * wsv, k4.z * wsv, k4.w * wsv);
      *reinterpret_cast<float4*>(s_v + s * 64 + d4) = v4;
    }
    __syncthreads();
    f32x16 acc; zero16(acc);
    mfma32_f32<64>(acc, s_k + ti * 32, 1, 64, s_v + tj * 32, 64, 1, lane);
#pragma unroll
    for (int r = 0; r < 16; ++r) {
      const int d = ti * 32 + (r & 3) + 8 * (r >> 2) + 4 * (lane >> 5);
      p.U()[(size_t)cu * 4096 + d * 64 + tj * 32 + (lane & 31)] = acc[r];
    }
    if (tid < 64) {
      float s0 = 0.f;
      for (int s = 0; s < 64; ++s) s0 += s_k[s * 64 + tid];
      p.un()[(size_t)cu * 64 + tid] = s0;
    }
  }
}

__device__ __forceinline__ void ph_mlscan(const Params& p, int l, int bid, int nblk) {
  const size_t gtid = (size_t)bid * 256 + tid_opaque(), gsz = (size_t)nblk * 256;
  const size_t NPC = 16 * 4096, NSC = 32 * 4096, NPN = 16 * 64, NSN = 32 * 64;
  for (size_t i = gtid; i < NPC + NSC + NPN + NSN; i += gsz) {
    if (i < NPC) {
      int bh = (int)(i >> 12), e = (int)(i & 4095);
      float C = 0.f;
      for (int c = 0; c < 64; ++c) {
        int cu = bh * 64 + c;
        p.Cst()[(size_t)cu * 4096 + e] = C;
        C = p.wcs()[cu] * C + p.U()[(size_t)cu * 4096 + e];
      }
      p.out[O_C_P + (size_t)l * (16 * 4096) + i] = C;
    } else if (i < NPC + NSC) {
      size_t j = i - NPC; int us = (int)(j >> 12), e = (int)(j & 4095); int cu = 1024 + us;
      float C = p.st_c()[(size_t)l * (32 * 4096) + j];
      p.Cst()[(size_t)cu * 4096 + e] = C;
      p.out[O_C_S + (size_t)l * (32 * 4096) + j] = p.wcs()[cu] * C + p.U()[(size_t)cu * 4096 + e];
    } else if (i < NPC + NSC + NPN) {
      size_t j = i - NPC - NSC; int bh = (int)(j >> 6), d = (int)(j & 63);
      float n = 0.f;
      for (int c = 0; c < 64; ++c) {
        int cu = bh * 64 + c;
        p.nst()[(size_t)cu * 64 + d] = n;
        n = p.wcs()[cu] * n + p.un()[(size_t)cu * 64 + d];
      }
      p.out[O_N_P + (size_t)l * (16 * 64) + j] = n;
    } else {
      size_t j = i - NPC - NSC - NPN; int us = (int)(j >> 6), d = (int)(j & 63); int cu = 1024 + us;
      float n = p.st_n()[(size_t)l * (32 * 64) + j];
      p.nst()[(size_t)cu * 64 + d] = n;
      p.out[O_N_S + (size_t)l * (32 * 64) + j] = p.wcs()[cu] * n + p.un()[(size_t)cu * 64 + d];
    }
  }
}

__device__ __forceinline__ void ph_mlout(const Params& p, int l, char* smem, int bid, int nblk) {
  const int tid = tid_opaque();
  float* s_q = reinterpret_cast<float*>(smem);
  float* s_k = s_q + 64 * 65;
  float* s_v = s_k + 64 * 65;
  float* s_C = s_v + 4096;
  float* s_F = s_C + 4096;
  float* s_a = s_F + 64;
  float* s_mt = s_a + 64;
  float* s_iw = s_mt + 64;
  float* s_n = s_iw + 64;
  float* s_den = s_n + 64;
  for (int cu = bid; cu < NCU_UNITS; cu += nblk) {
    int token0, h; cu_decode(cu, token0, h);
    const float m0 = p.mst()[cu];
    __syncthreads();
    for (int i = tid; i < 1024; i += 256) {
      int s = i >> 4, d4 = (i & 15) * 4;
      const int t = token0 + s;
      float4 q4 = *reinterpret_cast<const float4*>(p.qm() + (size_t)t * 256 + h * 64 + d4);
      float4 k4 = *reinterpret_cast<const float4*>(p.km() + (size_t)t * 256 + h * 64 + d4);
      float4 v4 = *reinterpret_cast<const float4*>(p.P5() + (size_t)t * 1280 + 256 + h * 64 + d4);
      float4 c4 = *reinterpret_cast<const float4*>(p.Cst() + (size_t)cu * 4096 + s * 64 + d4);
      s_q[s * 65 + d4] = q4.x; s_q[s * 65 + d4 + 1] = q4.y; s_q[s * 65 + d4 + 2] = q4.z; s_q[s * 65 + d4 + 3] = q4.w;
      s_k[s * 65 + d4] = k4.x; s_k[s * 65 + d4 + 1] = k4.y; s_k[s * 65 + d4 + 2] = k4.z; s_k[s * 65 + d4 + 3] = k4.w;
      *reinterpret_cast<float4*>(s_v + s * 64 + d4) = v4;
      *reinterpret_cast<float4*>(s_C + s * 64 + d4) = c4;
    }
    if (tid < 64) {
      const int t = token0 + tid;
      float F = p.Fc()[(size_t)t * 4 + h], g = p.ig()[(size_t)t * 4 + h];
      s_F[tid] = F; s_a[tid] = g - F;
      s_n[tid] = p.nst()[(size_t)cu * 64 + tid];
    }
    __syncthreads();
    if (tid < 64) {
      float pm = -1e30f;
      for (int s = 0; s <= tid; ++s) pm = fmaxf(pm, s_a[s]);
      float F = s_F[tid];
      float mt = F + fmaxf(m0, pm);
      s_mt[tid] = mt;
      s_iw[tid] = expf(F + m0 - mt);
    }
    __syncthreads();
    const int lane = tid & 63, w = tid >> 6, ti = w >> 1, tj = w & 1;
    const int ty = tid >> 4, tx = tid & 15;
    {
      f32x16 accS; zero16(accS);
      mfma32_f32<64>(accS, s_q + ti * 32 * 65, 65, 1, s_k + tj * 32 * 65, 1, 65, lane);
      __syncthreads();
      const int s = tj * 32 + (lane & 31);
      const float as = s_a[s];
#pragma unroll
      for (int r = 0; r < 16; ++r) {
        const int t = ti * 32 + (r & 3) + 8 * (r >> 2) + 4 * (lane >> 5);
        s_k[t * 65 + s] = (s <= t) ? accS[r] * expf(s_F[t] + as - s_mt[t]) : 0.f;
      }
    }
    __syncthreads();
    if (tid < 64) {
      float den = 0.f, qn = 0.f;
      for (int s = 0; s < 64; ++s) { den += s_k[tid * 65 + s]; qn += s_q[tid * 65 + s] * s_n[s]; }
      s_den[tid] = den + s_iw[tid] * qn;
    }
    {
      f32x16 accN, accC; zero16(accN); zero16(accC);
      mfma32_f32<64>(accN, s_k + ti * 32 * 65, 65, 1, s_v + tj * 32, 64, 1, lane);
      mfma32_f32<64>(accC, s_q + ti * 32 * 65, 65, 1, s_C + tj * 32, 64, 1, lane);
      __syncthreads();
#pragma unroll
      for (int r = 0; r < 16; ++r) {
        const int t = ti * 32 + (r & 3) + 8 * (r >> 2) + 4 * (lane >> 5);
        s_q[t * 65 + tj * 32 + (lane & 31)] = accN[r] + s_iw[t] * accC[r];
      }
    }
    __syncthreads();
#pragma unroll
    for (int i = 0; i < 4; ++i) {
      const int t = ty * 4 + i;
      const float dn = fmaxf(fabsf(s_den[t]), expf(-s_mt[t]));
      float hv[4]; float ss = 0.f;
#pragma unroll
      for (int j = 0; j < 4; ++j) { hv[j] = s_q[t * 65 + tx * 4 + j] / dn; ss += hv[j] * hv[j]; }
      ss = row16_sum(ss);
      const float rn = rsqrtf(ss * (1.f / 64.f) + EPS);
      const int ch = h * 64 + tx * 4;
      const size_t tg = (size_t)(token0 + t);
      float4 g4 = *reinterpret_cast<const float4*>(p.ml_norm_g() + l * 256 + ch);
      float4 k4 = *reinterpret_cast<const float4*>(p.ml_skip() + l * 256 + ch);
      float4 c4 = *reinterpret_cast<const float4*>(p.cc() + tg * 256 + ch);
      float4 o4 = *reinterpret_cast<const float4*>(p.P5() + tg * 1280 + 512 + ch);
      float r0 = (hv[0] * rn * g4.x + k4.x * c4.x) * sigmoidf_(o4.x);
      float r1 = (hv[1] * rn * g4.y + k4.y * c4.y) * sigmoidf_(o4.y);
      float r2 = (hv[2] * rn * g4.z + k4.z * c4.z) * sigmoidf_(o4.z);
      float r3 = (hv[3] * rn * g4.w + k4.w * c4.w) * sigmoidf_(o4.w);
      *reinterpret_cast<uint2*>(p.xn() + tg * 1024 + 512 + ch) = make_uint2(pack2(r0, r1), pack2(r2, r3));
    }
  }
}

__device__ __forceinline__ void ph_cmlp(const Params& p, int l, char* smem, const WorkQ& wq, int item) {
  const int tid = tid_opaque(), lane = tid & 63, w = tid >> 6;
  float* s_vg = reinterpret_cast<float*>(smem);
  float* s_ws = s_vg + 128 * 64;
  float* s_r = s_ws + 128 * 33;
  for (; item < 1056 + 264 * 4 + 544; item = wq_next(wq)) {
    const int u = item - (1056 + 264 * 4);
    const int g = u & 3, ci = u >> 2;
    const bool samp = ci >= 128;
    const int L = samp ? 64 : 128;
    const int token0 = samp ? NPROMPT + (ci - 128) * 64 : ci * 128;
    __syncthreads();
    for (int r = w; r < L; r += 4) {
      float4 v = *reinterpret_cast<const float4*>(p.P5() + (size_t)(token0 + r) * 1280 + 1024 + lane * 4);
      float ss = v.x * v.x + v.y * v.y + v.z * v.z + v.w * v.w;
      ss = wave_sum(ss);
      if (lane == 0) s_r[r] = rsqrtf(ss * (1.f / 256.f) + EPS);
    }
    __syncthreads();
    for (int i = tid; i < L * 16; i += 256) {
      int s = i >> 4, d4 = (i & 15) * 4;
      float4 v = *reinterpret_cast<const float4*>(p.P5() + (size_t)(token0 + s) * 1280 + 1024 + g * 64 + d4);
      float4 gn = *reinterpret_cast<const float4*>(p.cm_norm_g() + l * 256 + g * 64 + d4);
      float r = s_r[s];
      float4 o = make_float4(v.x * r * gn.x, v.y * r * gn.y, v.z * r * gn.z, v.w * r * gn.w);
      *reinterpret_cast<float4*>(s_vg + s * 64 + d4) = o;
      if (samp) {
        int ts = token0 - NPROMPT + s;
        *reinterpret_cast<float4*>(p.out + O_CMV_S + (size_t)l * (512 * 256) + (size_t)ts * 256 + g * 64 + d4) = o;
      }
    }
    const int rtA = (w < 2) ? 3 : 2, rtB = (w < 2) ? 0 : 1, ct = w & 1;
    const int nrt = L >> 5;
    f32x16 accA, accB; zero16(accA); zero16(accB);
    const float* wsg = p.cm_ws() + (size_t)(l * 4 + g) * 128 * 128;
    for (int s0 = 0; s0 < L; s0 += 32) {
      __syncthreads();
      for (int i = tid; i < L * 32; i += 256) {
        int t = i >> 5, ss = i & 31;
        s_ws[t * 33 + ss] = (s0 + ss <= t) ? wsg[t * 128 + s0 + ss] : 0.f;
      }
      __syncthreads();
      const int c = s0 >> 5;
      if (rtA < nrt && c <= rtA) mfma32_f32<32>(accA, s_ws + rtA * 32 * 33, 33, 1, s_vg + s0 * 64 + ct * 32, 64, 1, lane);
      if (rtB < nrt && c <= rtB) mfma32_f32<32>(accB, s_ws + rtB * 32 * 33, 33, 1, s_vg + s0 * 64 + ct * 32, 64, 1, lane);
    }
    __syncthreads();
#pragma unroll
    for (int r = 0; r < 16; ++r) {
      const int tr = (r & 3) + 8 * (r >> 2) + 4 * (lane >> 5);
      if (rtA < nrt) s_vg[(rtA * 32 + tr) * 64 + ct * 32 + (lane & 31)] = accA[r];
      if (rtB < nrt) s_vg[(rtB * 32 + tr) * 64 + ct * 32 + (lane & 31)] = accB[r];
    }
    __syncthreads();
    {
      const int ty = tid >> 4, tx = tid & 15;
      if (ty * 8 < L) {
#pragma unroll
        for (int i = 0; i < 8; ++i) {
          const int t = ty * 8 + i;
          const float bb = p.cm_b()[(l * 4 + g) * 128 + t];
          const size_t tg = (size_t)(token0 + t);
          float4 a4 = *reinterpret_cast<const float4*>(s_vg + t * 64 + tx * 4);
          float4 u4 = *reinterpret_cast<const float4*>(p.P5() + tg * 1280 + 768 + g * 64 + tx * 4);
          *reinterpret_cast<uint2*>(p.xn() + tg * 1024 + 768 + g * 64 + tx * 4) =
              make_uint2(pack2(u4.x * (a4.x + bb), u4.y * (a4.y + bb)), pack2(u4.z * (a4.z + bb), u4.w * (a4.w + bb)));
        }
      }
    }
  }
}

__device__ __forceinline__ void ph_topk(const Params& p, int l, char* smem, int bid, int nblk) {
  const int tid = tid_opaque(), lane = tid & 63, w = tid >> 6;
  float* s_tile = reinterpret_cast<float*>(smem) + w * (64 * 33);
  int* s_list = reinterpret_cast<int*>(smem + 4 * 64 * 33 * 4) + w * (2 * 16 * 64);
  float* s_ss = reinterpret_cast<float*>(smem + 4 * 64 * 33 * 4 + 4 * 2 * 16 * 64 * 4) + w * 64;
  for (int u = bid * 4 + w; u < 264 * 8; u += nblk * 4) {
    const int tg = u >> 3, h = u & 7;
    const int t0 = tg * 64;
    {
      const float4 pp = *reinterpret_cast<const float4*>(p.ssp() + (size_t)(t0 + lane) * 32 + h * 4);
      s_ss[lane] = pp.x + pp.y + pp.z + pp.w;
    }
    int L1[16], L2[16];
#pragma unroll
    for (int j = 0; j < 16; ++j) { L1[j] = (int)0x80000000; L2[j] = (int)0x80000000; }
#pragma unroll
    for (int c = 0; c < 2; ++c) {
      const int4* la = reinterpret_cast<const int4*>(p.tl() + (((size_t)(t0 + lane) * 16 + h * 2 + c) * 2) * 16);
      int A[16], B[16];
#pragma unroll
      for (int q = 0; q < 4; ++q) {
        const int4 a = la[q], b = la[4 + q];
        A[4 * q] = a.x; A[4 * q + 1] = a.y; A[4 * q + 2] = a.z; A[4 * q + 3] = a.w;
        B[4 * q] = b.x; B[4 * q + 1] = b.y; B[4 * q + 2] = b.z; B[4 * q + 3] = b.w;
      }
#pragma unroll
      for (int j = 0; j < 16; ++j) INS16(A, B[j])
#pragma unroll
      for (int j = 0; j < 16; ++j) { if (c == 0) L1[j] = A[j]; else L2[j] = A[j]; }
    }
#pragma unroll
    for (int j = 0; j < 16; ++j) { s_list[(0 * 16 + j) * 64 + lane] = 127 - (L1[j] & 127); s_list[(1 * 16 + j) * 64 + lane] = 127 - (L2[j] & 127); }
    float v1[16], v2[16];
#pragma unroll
    for (int j = 0; j < 16; ++j) { v1[j] = mono_val(L1[j] & ~127); v2[j] = mono_val(L2[j] & ~127); }
    int LC[16];
#pragma unroll
    for (int j = 0; j < 16; ++j) LC[j] = (int)0x80000000;
#pragma unroll
    for (int i = 0; i < 16; ++i)
#pragma unroll
      for (int j = 0; j < 16; ++j)
        if ((i + 1) * (j + 1) <= 16) {
          int key = (mono_key(v1[i] + v2[j]) & ~255) | (255 - (i * 16 + j));
          INS16(LC, key)
        }
    const float scale = rsqrtf(s_ss[lane] * (1.f / 256.f) + EPS);
    float vs[16]; float den = 0.f;
    const float top = mono_val(LC[0] & ~255);
#pragma unroll
    for (int k = 0; k < 16; ++k) { vs[k] = __expf((mono_val(LC[k] & ~255) - top) * scale); den += vs[k]; }
    const float inv = 1.f / den;
    const size_t ob = (size_t)(t0 + lane) * 128 + h * 16;
#pragma unroll
    for (int k4 = 0; k4 < 4; ++k4) {
      int ee[4]; float gg[4], su[4];
#pragma unroll
      for (int q = 0; q < 4; ++q) {
        int k = k4 * 4 + q;
        int ci = 255 - (LC[k] & 255);
        int i1 = s_list[(0 * 16 + (ci >> 4)) * 64 + lane];
        int i2 = s_list[(1 * 16 + (ci & 15)) * 64 + lane];
        ee[q] = i1 * 128 + i2;
        gg[q] = vs[k] * inv * p.vs()[l * 16384 + ee[q]];
        su[q] = p.us()[l * 16384 + ee[q]];
      }
      *reinterpret_cast<int4*>(p.eidx() + ob + k4 * 4) = make_int4(ee[0], ee[1], ee[2], ee[3]);
      *reinterpret_cast<float4*>(p.egate() + ob + k4 * 4) = make_float4(gg[0], gg[1], gg[2], gg[3]);
      *reinterpret_cast<float4*>(p.esu() + ob + k4 * 4) = make_float4(su[0], su[1], su[2], su[3]);
    }
  }
}

__device__ __forceinline__ float dot16_fp8(const float* xf, uint4 u) {
  f32x2 a0 = __builtin_amdgcn_cvt_pk_f32_fp8(u.x, false), a1 = __builtin_amdgcn_cvt_pk_f32_fp8(u.x, true);
  f32x2 a2 = __builtin_amdgcn_cvt_pk_f32_fp8(u.y, false), a3 = __builtin_amdgcn_cvt_pk_f32_fp8(u.y, true);
  f32x2 a4 = __builtin_amdgcn_cvt_pk_f32_fp8(u.z, false), a5 = __builtin_amdgcn_cvt_pk_f32_fp8(u.z, true);
  f32x2 a6 = __builtin_amdgcn_cvt_pk_f32_fp8(u.w, false), a7 = __builtin_amdgcn_cvt_pk_f32_fp8(u.w, true);
  float s0 = xf[0] * a0.x, s1 = xf[1] * a0.y;
  s0 = fmaf(xf[2], a1.x, s0); s1 = fmaf(xf[3], a1.y, s1);
  s0 = fmaf(xf[4], a2.x, s0); s1 = fmaf(xf[5], a2.y, s1);
  s0 = fmaf(xf[6], a3.x, s0); s1 = fmaf(xf[7], a3.y, s1);
  s0 = fmaf(xf[8], a4.x, s0); s1 = fmaf(xf[9], a4.y, s1);
  s0 = fmaf(xf[10], a5.x, s0); s1 = fmaf(xf[11], a5.y, s1);
  s0 = fmaf(xf[12], a6.x, s0); s1 = fmaf(xf[13], a6.y, s1);
  s0 = fmaf(xf[14], a7.x, s0); s1 = fmaf(xf[15], a7.y, s1);
  return s0 + s1;
}
__device__ __forceinline__ void axpy16_fp8(float* y, float wgt, uint4 v) {
  f32x2 a0 = __builtin_amdgcn_cvt_pk_f32_fp8(v.x, false), a1 = __builtin_amdgcn_cvt_pk_f32_fp8(v.x, true);
  f32x2 a2 = __builtin_amdgcn_cvt_pk_f32_fp8(v.y, false), a3 = __builtin_amdgcn_cvt_pk_f32_fp8(v.y, true);
  f32x2 a4 = __builtin_amdgcn_cvt_pk_f32_fp8(v.z, false), a5 = __builtin_amdgcn_cvt_pk_f32_fp8(v.z, true);
  f32x2 a6 = __builtin_amdgcn_cvt_pk_f32_fp8(v.w, false), a7 = __builtin_amdgcn_cvt_pk_f32_fp8(v.w, true);
  y[0] = fmaf(wgt, a0.x, y[0]); y[1] = fmaf(wgt, a0.y, y[1]); y[2] = fmaf(wgt, a1.x, y[2]); y[3] = fmaf(wgt, a1.y, y[3]);
  y[4] = fmaf(wgt, a2.x, y[4]); y[5] = fmaf(wgt, a2.y, y[5]); y[6] = fmaf(wgt, a3.x, y[6]); y[7] = fmaf(wgt, a3.y, y[7]);
  y[8] = fmaf(wgt, a4.x, y[8]); y[9] = fmaf(wgt, a4.y, y[9]); y[10] = fmaf(wgt, a5.x, y[10]); y[11] = fmaf(wgt, a5.y, y[11]);
  y[12] = fmaf(wgt, a6.x, y[12]); y[13] = fmaf(wgt, a6.y, y[13]); y[14] = fmaf(wgt, a7.x, y[14]); y[15] = fmaf(wgt, a7.y, y[15]);
}

template <bool DRY>
__device__ __forceinline__ void ph_gather(const Params& p, int l, int bid, int nblk) {
  const int lane = tid_opaque() & 63, w = tid_opaque() >> 6;
  const unsigned char* u8 = p.ub8() + (size_t)l * 16384 * 1024;
  const unsigned char* v8 = p.vb8() + (size_t)l * 16384 * 1024;
  const unsigned loff = (unsigned)lane * 16u;
  for (int t = bid * 4 + w; t < NTOK; t += nblk * 4) {
    float xf[16];
    {
      const uint4 xa = *reinterpret_cast<const uint4*>(p.xn() + (size_t)t * 1024 + lane * 16);
      const uint4 xb = *reinterpret_cast<const uint4*>(p.xn() + (size_t)t * 1024 + lane * 16 + 8);
      xf[0] = bf_lo(xa.x); xf[1] = bf_hi(xa.x); xf[2] = bf_lo(xa.y); xf[3] = bf_hi(xa.y);
      xf[4] = bf_lo(xa.z); xf[5] = bf_hi(xa.z); xf[6] = bf_lo(xa.w); xf[7] = bf_hi(xa.w);
      xf[8] = bf_lo(xb.x); xf[9] = bf_hi(xb.x); xf[10] = bf_lo(xb.y); xf[11] = bf_hi(xb.y);
      xf[12] = bf_lo(xb.z); xf[13] = bf_hi(xb.z); xf[14] = bf_lo(xb.w); xf[15] = bf_hi(xb.w);
    }
    const int e_lo = p.eidx()[(size_t)t * 128 + lane], e_hi = p.eidx()[(size_t)t * 128 + 64 + lane];
    const float g_lo = p.egate()[(size_t)t * 128 + lane], g_hi = p.egate()[(size_t)t * 128 + 64 + lane];
    const float s_lo = p.esu()[(size_t)t * 128 + lane], s_hi = p.esu()[(size_t)t * 128 + 64 + lane];
    float y[16];
#pragma unroll
    for (int i = 0; i < 16; ++i) y[i] = 0.f;
#pragma unroll 1
    for (int k0 = 0; k0 < 128; k0 += 8) {
      uint4 ur[8], vr[8];
#pragma unroll
      for (int q = 0; q < 8; ++q) {
        const int kk = (k0 & 63) + q;
        const int e = (k0 < 64) ? __builtin_amdgcn_readlane(e_lo, kk) : __builtin_amdgcn_readlane(e_hi, kk);
        ur[q] = *reinterpret_cast<const uint4*>(u8 + (size_t)e * 1024 + loff);
        vr[q] = *reinterpret_cast<const uint4*>(v8 + (size_t)e * 1024 + loff);
      }
#pragma unroll
      for (int q = 0; q < 8; ++q) {
        const int kk = (k0 & 63) + q;
        const float gt = __int_as_float((k0 < 64) ? __builtin_amdgcn_readlane(__float_as_int(g_lo), kk) : __builtin_amdgcn_readlane(__float_as_int(g_hi), kk));
        const float su = __int_as_float((k0 < 64) ? __builtin_amdgcn_readlane(__float_as_int(s_lo), kk) : __builtin_amdgcn_readlane(__float_as_int(s_hi), kk));
        float d = wave_sum(dot16_fp8(xf, ur[q])) * su;
        const float wgt = gt * gelu_exact(d);
        axpy16_fp8(y, wgt, vr[q]);
      }
    }
    if (DRY) {
#pragma unroll
      for (int i = 0; i < 16; ++i) asm volatile("" ::"v"(y[i]));
      continue;
    }
    float* xr = p.x() + (size_t)t * 1024 + lane * 16;
#pragma unroll
    for (int j = 0; j < 4; ++j) {
      float4 a = reinterpret_cast<float4*>(xr)[j];
      a.x += y[4 * j]; a.y += y[4 * j + 1]; a.z += y[4 * j + 2]; a.w += y[4 * j + 3];
      reinterpret_cast<float4*>(xr)[j] = a;
    }
  }
}

enum { PH_PREP = 0, PH_NORM1, PH_GEMM_IN, PH_ATTN, PH_MLCONV, PH_MCHAIN, PH_MLU, PH_MLSCAN, PH_MLOUT, PH_CMLP,
       PH_GEMM_OUT, PH_NORM2, PH_GEMM_PQ, PH_GEMM_SC, PH_TOPK, PH_GATHER, PH_FINAL };

__device__ __forceinline__ Params phase_params(const Params& kp, bool with_inputs) {
  Params q;
  size_t z = 0;
  asm volatile("" : "+s"(z));
  q.out = kp.out + z;
  q.ws = kp.ws + z;
  q.in[0] = kp.in[0] + z;
  q.in[1] = kp.in[1] + z;
  if (with_inputs) {
#pragma unroll
    for (int i = 2; i < 30; ++i) q.in[i] = kp.in[i] + z;
  }
  return q;
}


#define GT 4
typedef __attribute__((ext_vector_type(4))) float f32x4;

__device__ __forceinline__ float dot16_fp8v(const f32x2* x2, uint4 u) {
  f32x2 acc = x2[0] * __builtin_amdgcn_cvt_pk_f32_fp8(u.x, false);
  acc += x2[1] * __builtin_amdgcn_cvt_pk_f32_fp8(u.x, true);
  acc += x2[2] * __builtin_amdgcn_cvt_pk_f32_fp8(u.y, false);
  acc += x2[3] * __builtin_amdgcn_cvt_pk_f32_fp8(u.y, true);
  acc += x2[4] * __builtin_amdgcn_cvt_pk_f32_fp8(u.z, false);
  acc += x2[5] * __builtin_amdgcn_cvt_pk_f32_fp8(u.z, true);
  acc += x2[6] * __builtin_amdgcn_cvt_pk_f32_fp8(u.w, false);
  acc += x2[7] * __builtin_amdgcn_cvt_pk_f32_fp8(u.w, true);
  return acc.x + acc.y;
}
__device__ __forceinline__ void axpy16_fp8v(f32x2* y2, float wgt, uint4 v) {
  const f32x2 w2 = {wgt, wgt};
  y2[0] += w2 * __builtin_amdgcn_cvt_pk_f32_fp8(v.x, false);
  y2[1] += w2 * __builtin_amdgcn_cvt_pk_f32_fp8(v.x, true);
  y2[2] += w2 * __builtin_amdgcn_cvt_pk_f32_fp8(v.y, false);
  y2[3] += w2 * __builtin_amdgcn_cvt_pk_f32_fp8(v.y, true);
  y2[4] += w2 * __builtin_amdgcn_cvt_pk_f32_fp8(v.z, false);
  y2[5] += w2 * __builtin_amdgcn_cvt_pk_f32_fp8(v.z, true);
  y2[6] += w2 * __builtin_amdgcn_cvt_pk_f32_fp8(v.w, false);
  y2[7] += w2 * __builtin_amdgcn_cvt_pk_f32_fp8(v.w, true);
}

struct GU { uint4 ur[4]; f32x4 su; };
struct GV { uint4 vr[4]; f32x4 gt; };
#define GREC 384
__device__ __forceinline__ void gload_u(GU& U, const float* rec, int i4, const unsigned char* u8, unsigned loff) {
  const f32x4 ev = *reinterpret_cast<const f32x4*>(rec + i4);
  U.su = *reinterpret_cast<const f32x4*>(rec + 256 + i4);
  const int e0 = __builtin_amdgcn_readfirstlane(__float_as_int(ev.x)), e1 = __builtin_amdgcn_readfirstlane(__float_as_int(ev.y));
  const int e2 = __builtin_amdgcn_readfirstlane(__float_as_int(ev.z)), e3 = __builtin_amdgcn_readfirstlane(__float_as_int(ev.w));
  U.ur[0] = *reinterpret_cast<const uint4*>(u8 + (size_t)e0 * 1024 + loff);
  U.ur[1] = *reinterpret_cast<const uint4*>(u8 + (size_t)e1 * 1024 + loff);
  U.ur[2] = *reinterpret_cast<const uint4*>(u8 + (size_t)e2 * 1024 + loff);
  U.ur[3] = *reinterpret_cast<const uint4*>(u8 + (size_t)e3 * 1024 + loff);
}
__device__ __forceinline__ void gload_v(GV& V, const float* rec, int i4, const unsigned char* v8, unsigned loff) {
  const f32x4 ev = *reinterpret_cast<const f32x4*>(rec + i4);
  V.gt = *reinterpret_cast<const f32x4*>(rec + 128 + i4);
  const int e0 = __builtin_amdgcn_readfirstlane(__float_as_int(ev.x)), e1 = __builtin_amdgcn_readfirstlane(__float_as_int(ev.y));
  const int e2 = __builtin_amdgcn_readfirstlane(__float_as_int(ev.z)), e3 = __builtin_amdgcn_readfirstlane(__float_as_int(ev.w));
  V.vr[0] = *reinterpret_cast<const uint4*>(v8 + (size_t)e0 * 1024 + loff);
  V.vr[1] = *reinterpret_cast<const uint4*>(v8 + (size_t)e1 * 1024 + loff);
  V.vr[2] = *reinterpret_cast<const uint4*>(v8 + (size_t)e2 * 1024 + loff);
  V.vr[3] = *reinterpret_cast<const uint4*>(v8 + (size_t)e3 * 1024 + loff);
}
__device__ __forceinline__ float gelu_as(float z) {
  const float x = fabsf(z) * 0.70710678118654752f;
  const float t = __builtin_amdgcn_rcpf(fmaf(0.3275911f, x, 1.f));
  float pl = fmaf(1.061405429f, t, -1.453152027f);
  pl = fmaf(pl, t, 1.421413741f); pl = fmaf(pl, t, -0.284496736f); pl = fmaf(pl, t, 0.254829592f);
  const float e = __builtin_amdgcn_exp2f(-x * x * LOG2E);
  const float erfa = 1.f - pl * t * e;
  return 0.5f * z + 0.5f * fabsf(z) * erfa;
}
template <int PAT>
__device__ __forceinline__ float swz_f(float v) { return __int_as_float(__builtin_amdgcn_ds_swizzle(__float_as_int(v), PAT)); }

__device__ __forceinline__ void gstep2(GU& UA, GV& VA, GU& UB, GV& VB, const uint4* xlA, const uint4* xlB, f32x2* yA, f32x2* yB,
                                       const float* recA, const float* recB, int ci4, const float* nxtA, const float* nxtB, int ni4,
                                       const unsigned char* u8, const unsigned char* v8, unsigned loff, int lane) {
  float d[8];
  {
    f32x2 x2[8];
    const uint4 xa = xlA[0], xb = xlA[1];
    x2[0] = f32x2{bf_lo(xa.x), bf_hi(xa.x)}; x2[1] = f32x2{bf_lo(xa.y), bf_hi(xa.y)};
    x2[2] = f32x2{bf_lo(xa.z), bf_hi(xa.z)}; x2[3] = f32x2{bf_lo(xa.w), bf_hi(xa.w)};
    x2[4] = f32x2{bf_lo(xb.x), bf_hi(xb.x)}; x2[5] = f32x2{bf_lo(xb.y), bf_hi(xb.y)};
    x2[6] = f32x2{bf_lo(xb.z), bf_hi(xb.z)}; x2[7] = f32x2{bf_lo(xb.w), bf_hi(xb.w)};
#pragma unroll
    for (int q = 0; q < 4; ++q) d[q] = dot16_fp8v(x2, UA.ur[q]);
  }
  gload_u(UA, nxtA, ni4, u8, loff);
  {
    f32x2 x2[8];
    const uint4 xa = xlB[0], xb = xlB[1];
    x2[0] = f32x2{bf_lo(xa.x), bf_hi(xa.x)}; x2[1] = f32x2{bf_lo(xa.y), bf_hi(xa.y)};
    x2[2] = f32x2{bf_lo(xa.z), bf_hi(xa.z)}; x2[3] = f32x2{bf_lo(xa.w), bf_hi(xa.w)};
    x2[4] = f32x2{bf_lo(xb.x), bf_hi(xb.x)}; x2[5] = f32x2{bf_lo(xb.y), bf_hi(xb.y)};
    x2[6] = f32x2{bf_lo(xb.z), bf_hi(xb.z)}; x2[7] = f32x2{bf_lo(xb.w), bf_hi(xb.w)};
#pragma unroll
    for (int q = 0; q < 4; ++q) d[4 + q] = dot16_fp8v(x2, UB.ur[q]);
  }
  gload_u(UB, nxtB, ni4, u8, loff);
  const bool b0 = lane & 1, b1 = lane & 2, b2 = lane & 4;
  float a[4];
#pragma unroll
  for (int j = 0; j < 4; ++j) {
    const float keep = b0 ? d[4 + j] : d[j], send = b0 ? d[j] : d[4 + j];
    a[j] = keep + dpp_f<0xB1>(send);
  }
  float c2[2];
#pragma unroll
  for (int j = 0; j < 2; ++j) {
    const float keep = b1 ? a[2 + j] : a[j], send = b1 ? a[j] : a[2 + j];
    c2[j] = keep + dpp_f<0x4E>(send);
  }
  float tot;
  {
    const float keep = b2 ? c2[1] : c2[0], send = b2 ? c2[0] : c2[1];
    tot = keep + swz_f<0x101F>(send);
  }
  tot += swz_f<0x201F>(tot);
  tot = swap32_sum(swap16_sum(tot));
  const int pq = ((lane >> 1) & 1) * 2 + ((lane >> 2) & 1);
  const float* rl = (b0 ? recB : recA) + ci4 + pq;
  const float z = tot * rl[256];
  const float wv = rl[128] * gelu_as(z);
#pragma unroll
  for (int q = 0; q < 4; ++q) {
    const int ln = ((q >> 1) & 1) * 2 + (q & 1) * 4;
    const float wa = __int_as_float(__builtin_amdgcn_readlane(__float_as_int(wv), ln));
    const float wb = __int_as_float(__builtin_amdgcn_readlane(__float_as_int(wv), ln + 1));
    axpy16_fp8v(yA, wa, VA.vr[q]);
    axpy16_fp8v(yB, wb, VB.vr[q]);
  }
  gload_v(VA, nxtA, ni4, v8, loff);
  gload_v(VB, nxtB, ni4, v8, loff);
}

__device__ __forceinline__ void gstep(GU& U, GV& V, const uint4* xl, f32x2* y2, const float* nrec, int ni4,
                                      const unsigned char* u8, const unsigned char* v8, unsigned loff, int lane) {
  f32x2 x2[8];
  {
    const uint4 xa = xl[0], xb = xl[1];
    x2[0] = f32x2{bf_lo(xa.x), bf_hi(xa.x)}; x2[1] = f32x2{bf_lo(xa.y), bf_hi(xa.y)};
    x2[2] = f32x2{bf_lo(xa.z), bf_hi(xa.z)}; x2[3] = f32x2{bf_lo(xa.w), bf_hi(xa.w)};
    x2[4] = f32x2{bf_lo(xb.x), bf_hi(xb.x)}; x2[5] = f32x2{bf_lo(xb.y), bf_hi(xb.y)};
    x2[6] = f32x2{bf_lo(xb.z), bf_hi(xb.z)}; x2[7] = f32x2{bf_lo(xb.w), bf_hi(xb.w)};
  }
  float d[4], su[4];
#pragma unroll
  for (int q = 0; q < 4; ++q) { d[q] = dot16_fp8v(x2, U.ur[q]); su[q] = U.su[q]; }
  gload_u(U, nrec, ni4, u8, loff);
#pragma unroll
  for (int q = 0; q < 4; ++q) d[q] = wave_sum(d[q]) * su[q];
  float dv = d[0]; dv = (lane == 1) ? d[1] : dv; dv = (lane == 2) ? d[2] : dv; dv = (lane == 3) ? d[3] : dv;
  const float av = gelu_as(dv);
#pragma unroll
  for (int q = 0; q < 4; ++q) {
    const float act = __int_as_float(__builtin_amdgcn_readlane(__float_as_int(av), q));
    axpy16_fp8v(y2, V.gt[q] * act, V.vr[q]);
  }
  gload_v(V, nrec, ni4, v8, loff);
}

__device__ __forceinline__ void gsort_token(const Params& p, int t, float* rec, int lane) {
  const int e0 = p.eidx()[(size_t)t * 128 + lane], e1 = p.eidx()[(size_t)t * 128 + 64 + lane];
  const float g0 = p.egate()[(size_t)t * 128 + lane], g1 = p.egate()[(size_t)t * 128 + 64 + lane];
  const float q0 = p.esu()[(size_t)t * 128 + lane], q1 = p.esu()[(size_t)t * 128 + 64 + lane];
  int base = 0;
#pragma unroll 4
  for (int s = 0; s < 16; ++s) {
    const unsigned long long m0 = __ballot((e0 >> 10) == s), m1 = __ballot((e1 >> 10) == s);
    const int c0 = __popcll(m0), c1 = __popcll(m1);
    const int p0 = base + (int)__builtin_amdgcn_mbcnt_hi((unsigned)(m0 >> 32), __builtin_amdgcn_mbcnt_lo((unsigned)m0, 0));
    const int p1 = base + c0 + (int)__builtin_amdgcn_mbcnt_hi((unsigned)(m1 >> 32), __builtin_amdgcn_mbcnt_lo((unsigned)m1, 0));
    if ((e0 >> 10) == s) { rec[p0] = __int_as_float(e0); rec[128 + p0] = g0; rec[256 + p0] = q0; }
    if ((e1 >> 10) == s) { rec[p1] = __int_as_float(e1); rec[128 + p1] = g1; rec[256 + p1] = q1; }
    base += c0 + c1;
  }
}
__device__ __forceinline__ void gload_x(const Params& p, int t, uint4* xl, int lane) {
  xl[0] = *reinterpret_cast<const uint4*>(p.xn() + (size_t)t * 1024 + lane * 16);
  xl[1] = *reinterpret_cast<const uint4*>(p.xn() + (size_t)t * 1024 + lane * 16 + 8);
}
template <bool LAST>
__device__ __forceinline__ void gstore_x(const Params& p, int l, int t, const f32x2* y2, int lane) {
  float* xr = p.x() + (size_t)t * 1024 + lane * 16;
  float4 a[4];
  float ss = 0.f;
#pragma unroll
  for (int j = 0; j < 4; ++j) {
    a[j] = reinterpret_cast<float4*>(xr)[j];
    a[j].x += y2[2 * j].x; a[j].y += y2[2 * j].y; a[j].z += y2[2 * j + 1].x; a[j].w += y2[2 * j + 1].y;
    ss += a[j].x * a[j].x + a[j].y * a[j].y + a[j].z * a[j].z + a[j].w * a[j].w;
  }
  ss = wave_sum(ss);
  const float r = rsqrtf(ss * (1.f / 1024.f) + EPS);
  if (LAST) {
    const float* g = p.final_g() + lane * 16;
    float* o = ((t < NPROMPT) ? p.out + O_Y_P + (size_t)t * 1024 : p.out + O_Y_S + (size_t)(t - NPROMPT) * 1024) + lane * 16;
#pragma unroll
    for (int j = 0; j < 4; ++j) {
      const float4 gv = reinterpret_cast<const float4*>(g)[j];
      reinterpret_cast<float4*>(o)[j] = make_float4(a[j].x * r * gv.x, a[j].y * r * gv.y, a[j].z * r * gv.z, a[j].w * r * gv.w);
    }
  } else {
    const float* g = p.norm1_g() + (l + 1) * 1024 + lane * 16;
#pragma unroll
    for (int j = 0; j < 4; ++j) {
      reinterpret_cast<float4*>(xr)[j] = a[j];
      const float4 gv = reinterpret_cast<const float4*>(g)[j];
      a[j].x *= r * gv.x; a[j].y *= r * gv.y; a[j].z *= r * gv.z; a[j].w *= r * gv.w;
    }
    uint4* o = reinterpret_cast<uint4*>(p.xn() + (size_t)t * 1024 + lane * 16);
    o[0] = make_uint4(pack2(a[0].x, a[0].y), pack2(a[0].z, a[0].w), pack2(a[1].x, a[1].y), pack2(a[1].z, a[1].w));
    o[1] = make_uint4(pack2(a[2].x, a[2].y), pack2(a[2].z, a[2].w), pack2(a[3].x, a[3].y), pack2(a[3].z, a[3].w));
    float pre[8];
#pragma unroll
    for (int i = 0; i < 8; ++i) {
      const float4* wr = reinterpret_cast<const float4*>(p.wg() + ((size_t)(l + 1) * 8 + i) * 1024 + lane * 16);
      float s = 0.f;
#pragma unroll
      for (int j = 0; j < 4; ++j) {
        const float4 wv = wr[j];
        s += a[j].x * wv.x + a[j].y * wv.y + a[j].z * wv.z + a[j].w * wv.w;
      }
      pre[i] = wave_sum(s);
    }
    if (lane < 4) {
      float ai = pre[0]; ai = lane == 1 ? pre[1] : ai; ai = lane == 2 ? pre[2] : ai; ai = lane == 3 ? pre[3] : ai;
      float f = pre[4]; f = lane == 1 ? pre[5] : f; f = lane == 2 ? pre[6] : f; f = lane == 3 ? pre[7] : f;
      p.ig()[(size_t)t * 4 + lane] = ai + p.ml_gate_b()[(l + 1) * 8 + lane];
      const float z = f + p.ml_gate_b()[(l + 1) * 8 + 4 + lane];
      p.lf()[(size_t)t * 4 + lane] = fminf(z, 0.f) - log1pf(expf(-fabsf(z)));
    }
  }
}

template <bool LAST>
__device__ __forceinline__ void ph_gather2(const Params& p, int l, char* smem, int bid, int nblk) {
  const int tid = tid_opaque(), lane = tid & 63, w = tid >> 6;
  const unsigned char* u8 = p.ub8() + (size_t)l * 16384 * 1024;
  const unsigned char* v8 = p.vb8() + (size_t)l * 16384 * 1024;
  const unsigned loff = (unsigned)lane * 16u;
  float* rec = reinterpret_cast<float*>(smem) + w * (GT * GREC);
  uint4* xl = reinterpret_cast<uint4*>(smem + 4 * GT * GREC * 4) + (w * GT * 64 + lane) * 2;
  const int rot = (bid & 7) * 4;
  const int nwaves = nblk * 4, wg = bid * 4 + w;
  const int nfull = (NTOK / (nwaves * GT)) * nwaves;
  for (int grp = wg; grp < nfull; grp += nwaves) {
    const int t0 = grp * GT;
    int lane_s = lane; asm volatile("" : "+v"(lane_s));
#pragma unroll 1
    for (int ti = 0; ti < GT; ++ti) {
      gload_x(p, t0 + ti, xl + ti * 128, lane_s);
      gsort_token(p, t0 + ti, rec + ti * GREC, lane_s);
    }
    f32x2 y2[GT][8];
#pragma unroll
    for (int ti = 0; ti < GT; ++ti)
#pragma unroll
      for (int i = 0; i < 8; ++i) y2[ti][i] = f32x2{0.f, 0.f};
    GU U0, U1; GV V0, V1;
    gload_u(U0, rec, (rot & 31) * 4, u8, loff); gload_v(V0, rec, (rot & 31) * 4, v8, loff);
    gload_u(U1, rec + GREC, (rot & 31) * 4, u8, loff); gload_v(V1, rec + GREC, (rot & 31) * 4, v8, loff);
#pragma unroll 1
    for (int b = 0; b < 32; ++b) {
      const int bo = ((b + rot) & 31) * 4, bn = ((b + 1 + rot) & 31) * 4;
      gstep2(U0, V0, U1, V1, xl, xl + 128, y2[0], y2[1], rec, rec + GREC, bo, rec + 2 * GREC, rec + 3 * GREC, bo, u8, v8, loff, lane);
      __builtin_amdgcn_sched_barrier(0);
      gstep2(U0, V0, U1, V1, xl + 256, xl + 384, y2[2], y2[3], rec + 2 * GREC, rec + 3 * GREC, bo, rec, rec + GREC, bn, u8, v8, loff, lane);
      __builtin_amdgcn_sched_barrier(0);
    }
    int lane_e = lane; asm volatile("" : "+v"(lane_e));
#pragma unroll
    for (int ti = 0; ti < GT; ++ti) gstore_x<LAST>(p, l, t0 + ti, y2[ti], lane_e);
  }
  float* ysum = reinterpret_cast<float*>(smem + 4 * GT * GREC * 4 + 4 * GT * 2048);
  for (int t = nfull * GT + bid; t < NTOK; t += nblk) {
    f32x2 y2[8];
    gload_x(p, t, xl, lane);
#pragma unroll
    for (int i = 0; i < 8; ++i) y2[i] = f32x2{0.f, 0.f};
    gsort_token(p, t, rec, lane);
    GU U; GV V;
    gload_u(U, rec, (w * 8) * 4, u8, loff);
    gload_v(V, rec, (w * 8) * 4, v8, loff);
#pragma unroll 1
    for (int b = 0; b < 8; ++b) gstep(U, V, xl, y2, rec, (w * 8 + ((b + 1) & 7)) * 4, u8, v8, loff, lane);
    __syncthreads();
#pragma unroll
    for (int i = 0; i < 8; ++i) { ysum[w * 1024 + lane * 16 + 2 * i] = y2[i].x; ysum[w * 1024 + lane * 16 + 2 * i + 1] = y2[i].y; }
    __syncthreads();
    if (w == 0) {
#pragma unroll
      for (int i = 0; i < 8; ++i) {
        y2[i].x += ysum[1024 + lane * 16 + 2 * i] + ysum[2048 + lane * 16 + 2 * i] + ysum[3072 + lane * 16 + 2 * i];
        y2[i].y += ysum[1024 + lane * 16 + 2 * i + 1] + ysum[2048 + lane * 16 + 2 * i + 1] + ysum[3072 + lane * 16 + 2 * i + 1];
      }
      gstore_x<LAST>(p, l, t, y2, lane);
    }
  }
}

#define XB_TMO      128
#define XB_XCNT(j)  (256  + 64 * (j))
#define XB_XSUB(j)  (1280 + 64 * (j))
#define XB_XGEN(j)  (2304 + 64 * (j))
#define XB_TOP      3328
#define XB_TOPGEN   3392
#define XCD_BAR_WORDS 3456
#define XB_SPIN_CAP (1u << 22)
__device__ __forceinline__ unsigned xb_ld(unsigned* p)              { return __hip_atomic_load(p, __ATOMIC_RELAXED, __HIP_MEMORY_SCOPE_AGENT); }
__device__ __forceinline__ unsigned xb_add(unsigned* p, unsigned v) { return __hip_atomic_fetch_add(p, v, __ATOMIC_RELAXED, __HIP_MEMORY_SCOPE_AGENT); }
__device__ __forceinline__ unsigned xb_xcc_id() { return (unsigned)__builtin_amdgcn_s_getreg((3 << 11) | 20) & 0xFu; }
#define XB_SPIN(cond, bar) do { unsigned _sp = 0; while (cond) { __builtin_amdgcn_s_sleep(1); \
    if ((++_sp & 255u) == 0u) { if (xb_ld(&(bar)[XB_TMO])) break; if (_sp > XB_SPIN_CAP) { atomicAdd(&(bar)[XB_TMO], 1u); break; } } } } while (0)

struct XcdBarrier { unsigned* bar; unsigned x; volatile LAS unsigned* st; };

__device__ __forceinline__ XcdBarrier xcd_barrier_post(unsigned* bar, volatile LAS unsigned* st) {
  XcdBarrier b; b.bar = bar; b.x = xb_xcc_id(); b.st = st;
  if (threadIdx.x == 0) (void)xb_add(&bar[XB_XCNT(b.x)], 1u);
  return b;
}
__device__ __forceinline__ void xcd_barrier_complete(unsigned* bar, unsigned x, unsigned& nloc, unsigned& nx) {
  const unsigned G = gridDim.x * gridDim.y * gridDim.z;
  unsigned sum, cnt, mine, sp = 0u;
  for (;;) {
    sum = 0u; cnt = 0u; mine = 0u;
#pragma unroll
    for (unsigned j = 0; j < 16; ++j) { const unsigned c = xb_ld(&bar[XB_XCNT(j)]); sum += c; cnt += (c > 0u) ? 1u : 0u; mine = (j == x) ? c : mine; }
    if (sum == G) break;
    __builtin_amdgcn_s_sleep(1);
    if ((++sp & 255u) == 0u) { if (xb_ld(&bar[XB_TMO])) break; if (sp > XB_SPIN_CAP) { atomicAdd(&bar[XB_TMO], 1u); break; } }
  }
  nloc = mine > 0u ? mine : 1u; nx = cnt > 0u ? cnt : 1u;
}
__device__ __forceinline__ void xcd_barrier(const XcdBarrier& b) {
  asm volatile("s_waitcnt vmcnt(0)" ::: "memory");
  __syncthreads();
  if (threadIdx.x == 0) {
    unsigned* bar = b.bar;
    __builtin_amdgcn_s_waitcnt(0);
    unsigned nloc = b.st[0], nx = b.st[1];
    if (nloc == 0u) { xcd_barrier_complete(bar, b.x, nloc, nx); b.st[0] = nloc; b.st[1] = nx; }
    const unsigned old = xb_add(&bar[XB_XSUB(b.x)], 1u);
    const unsigned gen = old / nloc;
    if (old + 1u == (gen + 1u) * nloc) {
      __builtin_amdgcn_fence(__ATOMIC_RELEASE, "agent");
      asm volatile("s_waitcnt vmcnt(0)" ::: "memory");
      const unsigned og = xb_add(&bar[XB_TOP], 1u);
      const unsigned tg = og / nx;
      if (og + 1u == (tg + 1u) * nx) xb_add(&bar[XB_TOPGEN], 1u);
      else XB_SPIN(xb_ld(&bar[XB_TOPGEN]) == tg, bar);
      __builtin_amdgcn_fence(__ATOMIC_ACQUIRE, "agent");
      xb_add(&bar[XB_XGEN(b.x)], 1u);
      asm volatile("s_waitcnt vmcnt(0)" ::: "memory");
    } else {
      XB_SPIN(xb_ld(&bar[XB_XGEN(b.x)]) == gen, bar);
      __builtin_amdgcn_fence(__ATOMIC_ACQUIRE, "agent");
      asm volatile("s_waitcnt vmcnt(0)" ::: "memory");
    }
  }
  __syncthreads();
}

#define GSYNC() xcd_barrier(xb)
#define PP(wi) phase_params(p, wi)
#define BN bid_opaque(bid), nblk_opaque(nblk)

template <int L>
__device__ __forceinline__ void layer_phases(const Params& p, char* smem, const XcdBarrier& xb, int bid, int nblk) {
  if (L == 0) {
  ph_rmsnorm<0>(PP(false), L, BN);
#if PROBE == 11
  GSYNC();
  ph_rmsnorm<0>(PP(false), L, BN);
#endif
  GSYNC();
  }
  ph_gemm<EPI_WIN>(PP(false), L, smem, BN);
#if PROBE == 1
  GSYNC();
  ph_gemm<EPI_WIN>(PP(false), L, smem, BN);
#endif
  GSYNC();
  {
    const Params q = PP(false);
    WorkQ wq; wq.cnt = reinterpret_cast<unsigned*>(q.ws) + 8 + L; wq.slot = reinterpret_cast<volatile int*>(smem + SMEM_BYTES - 8);
    int item = ph_attn(q, L, smem, wq);
    item = ph_mlconv(PP(false), L, smem, wq, item);
    ph_cmlp(PP(false), L, smem, wq, item);
  }
  GSYNC();
  ph_mlU(PP(false), L, smem, BN);
#if PROBE == 9 || PROBE == 20
  GSYNC();
  ph_mlU(PP(false), L, smem, BN);
#endif
  GSYNC();
  ph_mlscan(PP(false), L, BN);
#if PROBE == 10 || PROBE == 20
  GSYNC();
  ph_mlscan(PP(false), L, BN);
#endif
  GSYNC();
  ph_mlout(PP(false), L, smem, BN);
#if PROBE == 6 || PROBE == 20
  GSYNC();
  ph_mlout(PP(false), L, smem, BN);
#endif
  GSYNC();
  ph_gemm<EPI_WOUT>(PP(false), L, smem, BN);
  GSYNC();
  ph_rmsnorm<1>(PP(false), L, BN);
  GSYNC();
  ph_gemm<EPI_PQ>(PP(false), L, smem, BN);
#if PROBE == 2
  GSYNC();
  ph_gemm<EPI_PQ>(PP(false), L, smem, BN);
#endif
  GSYNC();
  ph_topk(PP(false), L, smem, BN);
#if PROBE == 5
  GSYNC();
  ph_topk(PP(false), L, smem, BN);
#endif
  GSYNC();
  ph_gather2<(L == 1)>(PP(false), L, smem, BN);
  GSYNC();
}

__global__ void __launch_bounds__(256, 2) mega_kernel(Params p) {
  __shared__ __attribute__((aligned(16))) char smem[SMEM_BYTES];
  __shared__ uint4 xb_words;
  cg::grid_group grid = cg::this_grid();
  const int bid = blockIdx.x, nblk = gridDim.x;
  if (threadIdx.x == 0) xb_words = make_uint4(0u, 0u, 0u, 0u);
  __syncthreads();
  XcdBarrier xb = xcd_barrier_post(reinterpret_cast<unsigned*>(p.ws), (volatile LAS unsigned*)&xb_words);
  grid.sync();
  ph_prep(PP(true), smem, BN);
#if PROBE == 12
  GSYNC();
  ph_prep(PP(true), smem, BN);
#endif
  GSYNC();
  layer_phases<0>(p, smem, xb, bid, nblk);
  layer_phases<1>(p, smem, xb, bid, nblk);
}

static inline size_t align_up(size_t v, size_t a) { return (v + a - 1) / a * a; }

extern "C" void kernel_launch(void* const* d_in, const int* in_sizes, int n_in, void* d_out, int out_size, void* d_ws,
                              size_t ws_size, hipStream_t stream) {
  Params p{};
  for (int i = 0; i < 30; ++i) p.in[i] = reinterpret_cast<const float*>(d_in[i]);
  p.out = reinterpret_cast<float*>(d_out);
  p.ws = reinterpret_cast<char*>(d_ws);
  if (WS_NEED > ws_size) { fprintf(stderr, "workspace too small: need %zu have %zu\n", (size_t)WS_NEED, ws_size); return; }
  static int grid_blocks = 0;
  if (!grid_blocks) {
    int dev = 0, cus = 0, per_cu = 0;
    hipGetDevice(&dev);
    hipDeviceGetAttribute(&cus, hipDeviceAttributeMultiprocessorCount, dev);
    hipOccupancyMaxActiveBlocksPerMultiprocessor(&per_cu, mega_kernel, 256, 0);
    if (per_cu > 2) per_cu = 2;
    if (per_cu < 1) per_cu = 1;
    grid_blocks = cus * per_cu;
  }
  hipMemsetAsync(d_ws, 0, 16384, stream);
  void* args[] = {&p};
  hipError_t e = hipLaunchCooperativeKernel((void*)mega_kernel, dim3(grid_blocks), dim3(256), args, 0, stream);
  if (e != hipSuccess) fprintf(stderr, "cooperative launch failed: %s (grid %d)\n", hipGetErrorString(e), grid_blocks);
}
```

```cpp
#include <hip/hip_runtime.h>
#include <hip/hip_cooperative_groups.h>
#include <cstdio>
#include <cstdint>

namespace cg = cooperative_groups;

typedef unsigned short bf16_t;
typedef __attribute__((ext_vector_type(8))) __bf16 bf16x8;
typedef __attribute__((ext_vector_type(2))) __bf16 bf16x2;
typedef __attribute__((ext_vector_type(16))) float f32x16;
typedef __attribute__((ext_vector_type(2))) float f32x2;

#define D_MODEL 1024
#define NTOK 16896
#define NPROMPT 16384
#define SEQ 4096
#define NIN 2816
#define EPS 1e-6f
#define LOG2E 1.4426950408889634f
#define SKEYS 1088
#define NCU_UNITS 1056

constexpr size_t O_Y_P = 0;
constexpr size_t O_Y_S = O_Y_P + 16777216;
constexpr size_t O_K_P = O_Y_S + 524288;
constexpr size_t O_V_P = O_K_P + 16777216;
constexpr size_t O_C_P = O_V_P + 16777216;
constexpr size_t O_N_P = O_C_P + 131072;
constexpr size_t O_M_P = O_N_P + 2048;
constexpr size_t O_CONV_P = O_M_P + 32;
constexpr size_t O_K_S = O_CONV_P + 6144;
constexpr size_t O_V_S = O_K_S + 524288;
constexpr size_t O_C_S = O_V_S + 524288;
constexpr size_t O_N_S = O_C_S + 262144;
constexpr size_t O_M_S = O_N_S + 4096;
constexpr size_t O_CONV_S = O_M_S + 64;
constexpr size_t O_CMV_S = O_CONV_S + 12288;

constexpr size_t al256(size_t v) { return (v + 255) / 256 * 256; }
constexpr int SP_st_c = 0;
constexpr int SP_st_n = 262144;
constexpr int SP_st_m = 266240;
constexpr int SP_st_conv = 266304;
constexpr int SP_norm1_g = 278592;
constexpr int SP_da_subln_g = 280640;
constexpr int SP_ml_conv_w = 280896;
constexpr int SP_ml_conv_b = 282944;
constexpr int SP_ml_wq = 283456;
constexpr int SP_ml_wk = 316224;
constexpr int SP_ml_gate_b = 348992;
constexpr int SP_ml_norm_g = 349056;
constexpr int SP_ml_skip = 349568;
constexpr int SP_cm_norm_g = 350080;
constexpr int SP_cm_ws = 350592;
constexpr int SP_cm_b = 481664;
constexpr int SP_norm2_g = 482688;
constexpr int SP_final_g = 484736;
constexpr int SP_TOTAL = 485760;
constexpr size_t WS_bar = 0;
constexpr size_t WS_lam = al256(WS_bar + 16384);
constexpr size_t WS_lut = al256(WS_lam + (256));
constexpr size_t WS_sp = al256(WS_lut + (4*256*4));
constexpr size_t WS_wt_in = al256(WS_sp + (SP_TOTAL*4));
constexpr size_t WS_wg = al256(WS_wt_in + ((size_t)2*NIN*1024*2));
constexpr size_t WS_wt_out = al256(WS_wg + ((size_t)2*8*1024*4));
constexpr size_t WS_wt_pq = al256(WS_wt_out + ((size_t)2*1024*1024*2));
constexpr size_t WS_keysb = al256(WS_wt_pq + ((size_t)2*2048*1024*2));
constexpr size_t WS_ub8 = al256(WS_keysb + ((size_t)2*16*128*128*2));
constexpr size_t WS_vb8 = al256(WS_ub8 + ((size_t)2*16384*1024));
constexpr size_t WS_us = al256(WS_vb8 + ((size_t)2*16384*1024));
constexpr size_t WS_vs = al256(WS_us + ((size_t)2*16384*4));
constexpr size_t WS_Kbs = al256(WS_vs + ((size_t)2*16384*4));
constexpr size_t WS_Vts = al256(WS_Kbs + ((size_t)2*8*SKEYS*512*2));
constexpr size_t WS_x = al256(WS_Vts + ((size_t)2*8*4*128*SKEYS*2));
constexpr size_t WS_xn = al256(WS_x + ((size_t)NTOK*1024*4));
constexpr size_t WS_R0 = al256(WS_xn + ((size_t)NTOK*1024*2));
constexpr size_t WS_R0x = WS_R0;
constexpr size_t WS_Qb = al256(WS_R0x + (0));
constexpr size_t WS_Kb = al256(WS_Qb + ((size_t)NTOK*512*2));
constexpr size_t WS_Vt = al256(WS_Kb + ((size_t)NPROMPT*512*2));
constexpr size_t WS_P5 = al256(WS_Vt + ((size_t)16*128*SEQ*2));
constexpr size_t WS_ig = al256(WS_P5 + ((size_t)NTOK*1280*4));
constexpr size_t WS_lf = al256(WS_ig + ((size_t)NTOK*4*4));
constexpr size_t WS_Fc = al256(WS_lf + ((size_t)NTOK*4*4));
constexpr size_t WS_cc = al256(WS_Fc + ((size_t)NTOK*4*4));
constexpr size_t WS_qm = al256(WS_cc + ((size_t)NTOK*256*4));
constexpr size_t WS_km = al256(WS_qm + ((size_t)NTOK*256*4));
constexpr size_t WS_mst = al256(WS_km + ((size_t)NTOK*256*4));
constexpr size_t WS_mnx = al256(WS_mst + (NCU_UNITS*4));
constexpr size_t WS_wcs = al256(WS_mnx + (NCU_UNITS*4));
constexpr size_t WS_FLs = al256(WS_wcs + (NCU_UNITS*4));
constexpr size_t WS_mxt = al256(WS_FLs + (NCU_UNITS*4));
constexpr size_t WS_U = al256(WS_mxt + (NCU_UNITS*4));
constexpr size_t WS_un = al256(WS_U + ((size_t)NCU_UNITS*4096*4));
constexpr size_t WS_Cst = al256(WS_un + ((size_t)NCU_UNITS*64*4));
constexpr size_t WS_nst = al256(WS_Cst + ((size_t)NCU_UNITS*4096*4));
constexpr size_t WS_END_MIXER = al256(WS_nst + ((size_t)NCU_UNITS*64*4));
constexpr size_t WS_qp = al256(WS_R0x + (0));
constexpr size_t WS_sc = al256(WS_qp + ((size_t)NTOK*2048*2));
constexpr size_t WS_eidx = al256(WS_sc + ((size_t)NTOK*2048*4));
constexpr size_t WS_egate = al256(WS_eidx + ((size_t)NTOK*128*4));
constexpr size_t WS_esu = al256(WS_egate + ((size_t)NTOK*128*4));
constexpr size_t WS_ssp = al256(WS_esu + ((size_t)NTOK*128*4));
constexpr size_t WS_END_PEER = al256(WS_ssp + ((size_t)NTOK*32*4));
constexpr size_t WS_NEED = WS_END_MIXER > WS_END_PEER ? WS_END_MIXER : WS_END_PEER;

struct Params {
  const float* in[30];
  float* out;
  char* ws;
  __device__ __forceinline__ const float* x_prompt() const { return in[0]; }
  __device__ __forceinline__ const float* x_sample() const { return in[1]; }
  __device__ __forceinline__ const float* cache_k() const { return in[2]; }
  __device__ __forceinline__ const float* cache_v() const { return in[3]; }
  __device__ __forceinline__ const float* w_in() const { return in[9]; }
  __device__ __forceinline__ const float* da_lambda() const { return in[10]; }
  __device__ __forceinline__ const float* rel_table() const { return in[12]; }
  __device__ __forceinline__ const float* w_out() const { return in[23]; }
  __device__ __forceinline__ const float* peer_wq() const { return in[25]; }
  __device__ __forceinline__ const float* peer_keys() const { return in[26]; }
  __device__ __forceinline__ const float* peer_u() const { return in[27]; }
  __device__ __forceinline__ const float* peer_v() const { return in[28]; }
  __device__ __forceinline__ const float* st_c() const { return reinterpret_cast<const float*>(ws + WS_sp) + SP_st_c; }
  __device__ __forceinline__ const float* st_n() const { return reinterpret_cast<const float*>(ws + WS_sp) + SP_st_n; }
  __device__ __forceinline__ const float* st_m() const { return reinterpret_cast<const float*>(ws + WS_sp) + SP_st_m; }
  __device__ __forceinline__ const float* st_conv() const { return reinterpret_cast<const float*>(ws + WS_sp) + SP_st_conv; }
  __device__ __forceinline__ const float* norm1_g() const { return reinterpret_cast<const float*>(ws + WS_sp) + SP_norm1_g; }
  __device__ __forceinline__ const float* da_subln_g() const { return reinterpret_cast<const float*>(ws + WS_sp) + SP_da_subln_g; }
  __device__ __forceinline__ const float* ml_conv_w() const { return reinterpret_cast<const float*>(ws + WS_sp) + SP_ml_conv_w; }
  __device__ __forceinline__ const float* ml_conv_b() const { return reinterpret_cast<const float*>(ws + WS_sp) + SP_ml_conv_b; }
  __device__ __forceinline__ const float* ml_wq() const { return reinterpret_cast<const float*>(ws + WS_sp) + SP_ml_wq; }
  __device__ __forceinline__ const float* ml_wk() const { return reinterpret_cast<const float*>(ws + WS_sp) + SP_ml_wk; }
  __device__ __forceinline__ const float* ml_gate_b() const { return reinterpret_cast<const float*>(ws + WS_sp) + SP_ml_gate_b; }
  __device__ __forceinline__ const float* ml_norm_g() const { return reinterpret_cast<const float*>(ws + WS_sp) + SP_ml_norm_g; }
  __device__ __forceinline__ const float* ml_skip() const { return reinterpret_cast<const float*>(ws + WS_sp) + SP_ml_skip; }
  __device__ __forceinline__ const float* cm_norm_g() const { return reinterpret_cast<const float*>(ws + WS_sp) + SP_cm_norm_g; }
  __device__ __forceinline__ const float* cm_ws() const { return reinterpret_cast<const float*>(ws + WS_sp) + SP_cm_ws; }
  __device__ __forceinline__ const float* cm_b() const { return reinterpret_cast<const float*>(ws + WS_sp) + SP_cm_b; }
  __device__ __forceinline__ const float* norm2_g() const { return reinterpret_cast<const float*>(ws + WS_sp) + SP_norm2_g; }
  __device__ __forceinline__ const float* final_g() const { return reinterpret_cast<const float*>(ws + WS_sp) + SP_final_g; }
  __device__ __forceinline__ float* lam() const { return reinterpret_cast<float*>(ws + WS_lam); }
  __device__ __forceinline__ float* lut() const { return reinterpret_cast<float*>(ws + WS_lut); }
  __device__ __forceinline__ float* sp() const { return reinterpret_cast<float*>(ws + WS_sp); }
  __device__ __forceinline__ bf16_t* wt_in() const { return reinterpret_cast<bf16_t*>(ws + WS_wt_in); }
  __device__ __forceinline__ float* wg() const { return reinterpret_cast<float*>(ws + WS_wg); }
  __device__ __forceinline__ bf16_t* wt_out() const { return reinterpret_cast<bf16_t*>(ws + WS_wt_out); }
  __device__ __forceinline__ bf16_t* wt_pq() const { return reinterpret_cast<bf16_t*>(ws + WS_wt_pq); }
  __device__ __forceinline__ bf16_t* keysb() const { return reinterpret_cast<bf16_t*>(ws + WS_keysb); }
  __device__ __forceinline__ unsigned char* ub8() const { return reinterpret_cast<unsigned char*>(ws + WS_ub8); }
  __device__ __forceinline__ unsigned char* vb8() const { return reinterpret_cast<unsigned char*>(ws + WS_vb8); }
  __device__ __forceinline__ float* us() const { return reinterpret_cast<float*>(ws + WS_us); }
  __device__ __forceinline__ float* vs() const { return reinterpret_cast<float*>(ws + WS_vs); }
  __device__ __forceinline__ bf16_t* Kbs() const { return reinterpret_cast<bf16_t*>(ws + WS_Kbs); }
  __device__ __forceinline__ bf16_t* Vts() const { return reinterpret_cast<bf16_t*>(ws + WS_Vts); }
  __device__ __forceinline__ float* x() const { return reinterpret_cast<float*>(ws + WS_x); }
  __device__ __forceinline__ bf16_t* xn() const { return reinterpret_cast<bf16_t*>(ws + WS_xn); }
  __device__ __forceinline__ bf16_t* Qb() const { return reinterpret_cast<bf16_t*>(ws + WS_Qb); }
  __device__ __forceinline__ bf16_t* Kb() const { return reinterpret_cast<bf16_t*>(ws + WS_Kb); }
  __device__ __forceinline__ bf16_t* Vt() const { return reinterpret_cast<bf16_t*>(ws + WS_Vt); }
  __device__ __forceinline__ float* P5() const { return reinterpret_cast<float*>(ws + WS_P5); }
  __device__ __forceinline__ float* ig() const { return reinterpret_cast<float*>(ws + WS_ig); }
  __device__ __forceinline__ float* lf() const { return reinterpret_cast<float*>(ws + WS_lf); }
  __device__ __forceinline__ float* Fc() const { return reinterpret_cast<float*>(ws + WS_Fc); }
  __device__ __forceinline__ float* cc() const { return reinterpret_cast<float*>(ws + WS_cc); }
  __device__ __forceinline__ float* qm() const { return reinterpret_cast<float*>(ws + WS_qm); }
  __device__ __forceinline__ float* km() const { return reinterpret_cast<float*>(ws + WS_km); }
  __device__ __forceinline__ float* mst() const { return reinterpret_cast<float*>(ws + WS_mst); }
  __device__ __forceinline__ float* mnx() const { return reinterpret_cast<float*>(ws + WS_mnx); }
  __device__ __forceinline__ float* wcs() const { return reinterpret_cast<float*>(ws + WS_wcs); }
  __device__ __forceinline__ float* FLs() const { return reinterpret_cast<float*>(ws + WS_FLs); }
  __device__ __forceinline__ float* mxt() const { return reinterpret_cast<float*>(ws + WS_mxt); }
  __device__ __forceinline__ float* U() const { return reinterpret_cast<float*>(ws + WS_U); }
  __device__ __forceinline__ float* un() const { return reinterpret_cast<float*>(ws + WS_un); }
  __device__ __forceinline__ float* Cst() const { return reinterpret_cast<float*>(ws + WS_Cst); }
  __device__ __forceinline__ float* nst() const { return reinterpret_cast<float*>(ws + WS_nst); }
  __device__ __forceinline__ bf16_t* qp() const { return reinterpret_cast<bf16_t*>(ws + WS_qp); }
  __device__ __forceinline__ float* sc() const { return reinterpret_cast<float*>(ws + WS_sc); }
  __device__ __forceinline__ int* eidx() const { return reinterpret_cast<int*>(ws + WS_eidx); }
  __device__ __forceinline__ float* egate() const { return reinterpret_cast<float*>(ws + WS_egate); }
  __device__ __forceinline__ float* esu() const { return reinterpret_cast<float*>(ws + WS_esu); }
  __device__ __forceinline__ float* ssp() const { return reinterpret_cast<float*>(ws + WS_ssp); }
  __device__ __forceinline__ int* tl() const { return reinterpret_cast<int*>(ws + WS_sc); }
};

__device__ __forceinline__ unsigned pack2(float a, float b) {
  f32x2 v = {a, b};
  bf16x2 r = __builtin_convertvector(v, bf16x2);
  return *reinterpret_cast<unsigned*>(&r);
}
__device__ __forceinline__ bf16_t f2bf(float a) { return (bf16_t)(pack2(a, 0.f) & 0xFFFFu); }
__device__ __forceinline__ float bf_lo(unsigned u) { return __uint_as_float(u << 16); }
__device__ __forceinline__ float bf_hi(unsigned u) { return __uint_as_float(u & 0xFFFF0000u); }
__device__ __forceinline__ float gelu_exact(float x) { return 0.5f * x * (1.f + erff(x * 0.70710678118654752f)); }
__device__ __forceinline__ float sigmoidf_(float x) { return 1.f / (1.f + __expf(-x)); }
__device__ __forceinline__ float shfl_up_l(float v, int d, int lane) {
  const int src = lane >= d ? lane - d : lane;
  return __int_as_float(__builtin_amdgcn_ds_bpermute(src << 2, __float_as_int(v)));
}
template <int CTRL>
__device__ __forceinline__ float dpp_f(float v) {
  return __builtin_bit_cast(float, __builtin_amdgcn_update_dpp(0, __builtin_bit_cast(int, v), CTRL, 0xf, 0xf, true));
}
__device__ __forceinline__ float swap16_sum(float x) {
  auto s = __builtin_amdgcn_permlane16_swap(__float_as_uint(x), __float_as_uint(x), false, false);
  return __uint_as_float(s[0]) + __uint_as_float(s[1]);
}
__device__ __forceinline__ float swap32_sum(float x) {
  auto s = __builtin_amdgcn_permlane32_swap(__float_as_uint(x), __float_as_uint(x), false, false);
  return __uint_as_float(s[0]) + __uint_as_float(s[1]);
}
__device__ __forceinline__ float swap16_max(float x) {
  auto s = __builtin_amdgcn_permlane16_swap(__float_as_uint(x), __float_as_uint(x), false, false);
  return fmaxf(__uint_as_float(s[0]), __uint_as_float(s[1]));
}
__device__ __forceinline__ float swap32_max(float x) {
  auto s = __builtin_amdgcn_permlane32_swap(__float_as_uint(x), __float_as_uint(x), false, false);
  return fmaxf(__uint_as_float(s[0]), __uint_as_float(s[1]));
}
__device__ __forceinline__ float row16_sum(float v) {
  v += dpp_f<0xB1>(v); v += dpp_f<0x4E>(v); v += dpp_f<0x141>(v); v += dpp_f<0x140>(v);
  return v;
}
__device__ __forceinline__ float row16_max(float v) {
  v = fmaxf(v, dpp_f<0xB1>(v)); v = fmaxf(v, dpp_f<0x4E>(v)); v = fmaxf(v, dpp_f<0x141>(v)); v = fmaxf(v, dpp_f<0x140>(v));
  return v;
}
__device__ __forceinline__ float wave_sum(float v) { return swap32_sum(swap16_sum(row16_sum(v))); }
__device__ __forceinline__ float wave_max(float v) { return swap32_max(swap16_max(row16_max(v))); }
__device__ __forceinline__ const float* xrow_in(const Params& p, int l, int t) {
  if (l == 0) return (t < NPROMPT) ? p.x_prompt() + (size_t)t * D_MODEL : p.x_sample() + (size_t)(t - NPROMPT) * D_MODEL;
  return p.x() + (size_t)t * D_MODEL;
}
__device__ __forceinline__ bf16x8 as_bf16x8(uint4 v) { return *reinterpret_cast<bf16x8*>(&v); }

__device__ __forceinline__ int tid_opaque() { int t = threadIdx.x; asm volatile("" : "+v"(t)); return t; }
__device__ __forceinline__ int sgpr_opaque(int v) { asm volatile("" : "+s"(v)); return v; }
__device__ __forceinline__ int bid_opaque(int v) { asm volatile("" : "+s"(v)); __builtin_assume(v >= 0); __builtin_assume(v < 1024); return v; }
__device__ __forceinline__ int nblk_opaque(int v) { asm volatile("" : "+s"(v)); __builtin_assume(v >= 1); __builtin_assume(v <= 1024); return v; }
#define LAS __attribute__((address_space(3)))
#ifndef PROBE
#define PROBE 0
#endif
#define SMEM_BYTES 73728

__device__ __forceinline__ void transpose_tile(const float* __restrict__ src, int lds, bf16_t* __restrict__ dst, int K, int n0, int k0,
                               int gate_skip, float* tile  ) {
  const int tid = tid_opaque();
  const int c = tid & 63, r0 = tid >> 6;
  int n = n0 + c;
  int col = n + ((gate_skip && n >= 2304) ? 8 : 0);
#pragma unroll 4
  for (int j = 0; j < 16; ++j) {
    int r = r0 + 4 * j;
    tile[r * 65 + c] = src[(size_t)(k0 + r) * lds + col];
  }
  __syncthreads();
  const int nn = tid >> 2, kg = (tid & 3) * 16;
  unsigned w[8];
#pragma unroll
  for (int j = 0; j < 8; ++j) w[j] = pack2(tile[(kg + 2 * j) * 65 + nn], tile[(kg + 2 * j + 1) * 65 + nn]);
  uint4* d = reinterpret_cast<uint4*>(dst + (size_t)(n0 + nn) * K + k0 + kg);
  d[0] = make_uint4(w[0], w[1], w[2], w[3]);
  d[1] = make_uint4(w[4], w[5], w[6], w[7]);
  __syncthreads();
}

__device__ __forceinline__ int rel_bucket_dev(int rel) {
  int ret = rel > 0 ? 16 : 0;
  int n = rel < 0 ? -rel : rel;
  int b;
  if (n < 8) b = n;
  else if (n < 12) b = 8;
  else if (n < 16) b = 9;
  else if (n < 23) b = 10;
  else if (n < 32) b = 11;
  else if (n < 46) b = 12;
  else if (n < 64) b = 13;
  else if (n < 91) b = 14;
  else b = 15;
  return ret + b;
}

__device__ __forceinline__ void prep_table_rows(const Params& p, int r0, int r1, int lane, int wv) {
  for (int r = r0 + wv; r < r1; r += 4) {
    const int tab = r >> 15, row = r & 32767;
    const float* src = (tab == 0 ? p.peer_u() : p.peer_v()) + (size_t)row * 1024 + lane * 16;
    float4 f0 = reinterpret_cast<const float4*>(src)[0], f1 = reinterpret_cast<const float4*>(src)[1];
    float4 f2 = reinterpret_cast<const float4*>(src)[2], f3 = reinterpret_cast<const float4*>(src)[3];
    float am = fmaxf(fmaxf(fmaxf(fabsf(f0.x), fabsf(f0.y)), fmaxf(fabsf(f0.z), fabsf(f0.w))),
                     fmaxf(fmaxf(fabsf(f1.x), fabsf(f1.y)), fmaxf(fabsf(f1.z), fabsf(f1.w))));
    am = fmaxf(am, fmaxf(fmaxf(fmaxf(fabsf(f2.x), fabsf(f2.y)), fmaxf(fabsf(f2.z), fabsf(f2.w))),
                         fmaxf(fmaxf(fabsf(f3.x), fabsf(f3.y)), fmaxf(fabsf(f3.z), fabsf(f3.w)))));
    am = wave_max(am);
    const float sc = am > 0.f ? 224.f / am : 1.f;
    int w0 = 0, w1 = 0, w2 = 0, w3 = 0;
    w0 = __builtin_amdgcn_cvt_pk_fp8_f32(f0.x * sc, f0.y * sc, w0, false); w0 = __builtin_amdgcn_cvt_pk_fp8_f32(f0.z * sc, f0.w * sc, w0, true);
    w1 = __builtin_amdgcn_cvt_pk_fp8_f32(f1.x * sc, f1.y * sc, w1, false); w1 = __builtin_amdgcn_cvt_pk_fp8_f32(f1.z * sc, f1.w * sc, w1, true);
    w2 = __builtin_amdgcn_cvt_pk_fp8_f32(f2.x * sc, f2.y * sc, w2, false); w2 = __builtin_amdgcn_cvt_pk_fp8_f32(f2.z * sc, f2.w * sc, w2, true);
    w3 = __builtin_amdgcn_cvt_pk_fp8_f32(f3.x * sc, f3.y * sc, w3, false); w3 = __builtin_amdgcn_cvt_pk_fp8_f32(f3.z * sc, f3.w * sc, w3, true);
    unsigned char* dst = (tab == 0 ? p.ub8() : p.vb8()) + (size_t)row * 1024 + lane * 16;
    *reinterpret_cast<uint4*>(dst) = make_uint4((unsigned)w0, (unsigned)w1, (unsigned)w2, (unsigned)w3);
    if (lane == 0) (tab == 0 ? p.us() : p.vs())[row] = am > 0.f ? am * (1.f / 224.f) : 1.f;
  }
}

__device__ __forceinline__ void ph_prep(const Params& p, char* smem, int bid, int nblk) {
  const int tid = tid_opaque();
  float* tile = reinterpret_cast<float*>(smem);
  for (int u = bid; u < 2 * 1472; u += nblk) {
    int l = u / 1472, r = u % 1472;
    if (r < 704) {
      int nt = r / 16, kt = r % 16;
      transpose_tile(p.w_in() + (size_t)l * 1024 * 2824, 2824, p.wt_in() + (size_t)l * NIN * 1024, 1024, nt * 64, kt * 64, 1, tile);
    } else if (r < 960) {
      r -= 704; int nt = r / 16, kt = r % 16;
      transpose_tile(p.w_out() + (size_t)l * 1024 * 1024, 1024, p.wt_out() + (size_t)l * 1024 * 1024, 1024, nt * 64, kt * 64, 0, tile);
    } else {
      r -= 960; int nt = r / 16, kt = r % 16;
      transpose_tile(p.peer_wq() + (size_t)l * 1024 * 2048, 2048, p.wt_pq() + (size_t)l * 2048 * 1024, 1024, nt * 64, kt * 64, 0, tile);
    }
  }
  for (int u = bid; u < 1024; u += nblk) {
    int kt = u & 15, h = (u >> 4) & 3, b = (u >> 6) & 7, l = u >> 9;
    const float* src = p.cache_v() + (((size_t)(l * 8 + b) * 1024 + kt * 64) * 4 + h) * 128;
    {
      int c = tid & 127, r0 = tid >> 7;
      for (int j = 0; j < 32; ++j) { int r = r0 + 2 * j; tile[r * 129 + c] = src[(size_t)r * 512 + c]; }
    }
    __syncthreads();
    {
      int dv = tid >> 1, half = tid & 1;
      bf16_t* dst = p.Vts() + ((size_t)((l * 8 + b) * 4 + h) * 128 + dv) * SKEYS + kt * 64 + half * 32;
      unsigned w[16];
#pragma unroll
      for (int j = 0; j < 16; ++j) {
        int pos0 = half * 32 + 2 * j;
        int blk = (pos0 >> 2) & 3;
        int oblk = (blk == 1) ? 2 : (blk == 2 ? 1 : blk);
        int key0 = (pos0 & ~15) + oblk * 4 + (pos0 & 3);
        w[j] = pack2(tile[key0 * 129 + dv], tile[(key0 + 1) * 129 + dv]);
      }
      uint4* d4 = reinterpret_cast<uint4*>(dst);
      d4[0] = make_uint4(w[0], w[1], w[2], w[3]);
      d4[1] = make_uint4(w[4], w[5], w[6], w[7]);
      d4[2] = make_uint4(w[8], w[9], w[10], w[11]);
      d4[3] = make_uint4(w[12], w[13], w[14], w[15]);
    }
    __syncthreads();
  }
  const size_t gtid = (size_t)bid * 256 + tid, gsz = (size_t)nblk * 256;
  {
    const size_t n8 = (size_t)2 * 16 * 128 * 128 / 8;
    for (size_t i = gtid; i < n8; i += gsz) {
      float4 a = reinterpret_cast<const float4*>(p.peer_keys())[2 * i], b = reinterpret_cast<const float4*>(p.peer_keys())[2 * i + 1];
      reinterpret_cast<uint4*>(p.keysb())[i] = make_uint4(pack2(a.x, a.y), pack2(a.z, a.w), pack2(b.x, b.y), pack2(b.z, b.w));
    }
  }
  {
    const size_t n8 = (size_t)2 * 8 * 1024 * 512 / 8;
    for (size_t i = gtid; i < n8; i += gsz) {
      size_t e = i * 8;
      size_t lb = e / (1024 * 512), rem = e % (1024 * 512);
      float4 a = reinterpret_cast<const float4*>(p.cache_k())[2 * i], b = reinterpret_cast<const float4*>(p.cache_k())[2 * i + 1];
      *reinterpret_cast<uint4*>(p.Kbs() + lb * (SKEYS * 512) + rem) = make_uint4(pack2(a.x, a.y), pack2(a.z, a.w), pack2(b.x, b.y), pack2(b.z, b.w));
    }
  }
  for (size_t i = gtid; i < 2 * 8 * 1024; i += gsz) {
    int l = (int)(i / 8192), r = (int)(i % 8192), g = r / 1024, k = r % 1024;
    p.wg()[i] = p.w_in()[((size_t)l * 1024 + k) * 2824 + 2304 + g];
  }
  {
    float* sp = reinterpret_cast<float*>(p.ws + WS_sp);
    for (size_t i = gtid; i < 262144; i += gsz) sp[SP_st_c + i] = p.in[4][i];
    for (size_t i = gtid; i < 4096; i += gsz) sp[SP_st_n + i] = p.in[5][i];
    for (size_t i = gtid; i < 64; i += gsz) sp[SP_st_m + i] = p.in[6][i];
    for (size_t i = gtid; i < 12288; i += gsz) sp[SP_st_conv + i] = p.in[7][i];
    for (size_t i = gtid; i < 2048; i += gsz) sp[SP_norm1_g + i] = p.in[8][i];
    for (size_t i = gtid; i < 256; i += gsz) sp[SP_da_subln_g + i] = p.in[11][i];
    for (size_t i = gtid; i < 2048; i += gsz) sp[SP_ml_conv_w + i] = p.in[13][i];
    for (size_t i = gtid; i < 512; i += gsz) sp[SP_ml_conv_b + i] = p.in[14][i];
    for (size_t i = gtid; i < 32768; i += gsz) sp[SP_ml_wq + i] = p.in[15][i];
    for (size_t i = gtid; i < 32768; i += gsz) sp[SP_ml_wk + i] = p.in[16][i];
    for (size_t i = gtid; i < 16; i += gsz) sp[SP_ml_gate_b + i] = p.in[17][i];
    for (size_t i = gtid; i < 512; i += gsz) sp[SP_ml_norm_g + i] = p.in[18][i];
    for (size_t i = gtid; i < 512; i += gsz) sp[SP_ml_skip + i] = p.in[19][i];
    for (size_t i = gtid; i < 512; i += gsz) sp[SP_cm_norm_g + i] = p.in[20][i];
    for (size_t i = gtid; i < 131072; i += gsz) sp[SP_cm_ws + i] = p.in[21][i];
    for (size_t i = gtid; i < 1024; i += gsz) sp[SP_cm_b + i] = p.in[22][i];
    for (size_t i = gtid; i < 2048; i += gsz) sp[SP_norm2_g + i] = p.in[24][i];
    for (size_t i = gtid; i < 1024; i += gsz) sp[SP_final_g + i] = p.in[29][i];
  }
  if (bid == 0) {
    for (int i = tid; i < 4 * 256; i += 256) {
      int h = i >> 8, j = i & 255;
      int rel = j - 191; if (rel > 63) rel = 63;
      p.lut()[i] = p.rel_table()[rel_bucket_dev(rel) * 4 + h] * LOG2E;
    }
    if (tid < 2) {
      const float* lp = p.da_lambda() + tid * 256;
      float s01 = 0.f, s23 = 0.f;
      for (int d = 0; d < 64; ++d) { s01 += lp[d] * lp[64 + d]; s23 += lp[128 + d] * lp[192 + d]; }
      float lam_init = 0.8f - 0.6f * expf(-0.3f * (float)tid);
      p.lam()[tid] = expf(s01) - expf(s23) + lam_init;
    }
  }
}

template <int MODE>
__device__ __forceinline__ void ph_rmsnorm(const Params& p, int l, int bid, int nblk) {
  const int lane = tid_opaque() & 63, w = __builtin_amdgcn_readfirstlane(tid_opaque() >> 6);
  const float* g = (MODE == 0) ? p.norm1_g() + l * 1024 : (MODE == 1 ? p.norm2_g() + l * 1024 : p.final_g());
  float4 gv[4];
#pragma unroll
  for (int j = 0; j < 4; ++j) gv[j] = reinterpret_cast<const float4*>(g)[lane + 64 * j];
  for (int t = bid * 4 + w; t < NTOK; t += nblk * 4) {
    const float* xr = (MODE == 0) ? xrow_in(p, l, t) : p.x() + (size_t)t * 1024;
    float4 xv[4];
    float ss = 0.f;
#pragma unroll
    for (int j = 0; j < 4; ++j) {
      xv[j] = reinterpret_cast<const float4*>(xr)[lane + 64 * j];
      ss += xv[j].x * xv[j].x + xv[j].y * xv[j].y + xv[j].z * xv[j].z + xv[j].w * xv[j].w;
    }
    ss = wave_sum(ss);
    float r = rsqrtf(ss * (1.f / 1024.f) + EPS);
#pragma unroll
    for (int j = 0; j < 4; ++j) {
      xv[j].x *= r * gv[j].x; xv[j].y *= r * gv[j].y; xv[j].z *= r * gv[j].z; xv[j].w *= r * gv[j].w;
    }
    if (MODE == 2) {
      float* o = (t < NPROMPT) ? p.out + O_Y_P + (size_t)t * 1024 : p.out + O_Y_S + (size_t)(t - NPROMPT) * 1024;
#pragma unroll
      for (int j = 0; j < 4; ++j) reinterpret_cast<float4*>(o)[lane + 64 * j] = xv[j];
    } else {
      uint2* o = reinterpret_cast<uint2*>(p.xn() + (size_t)t * 1024);
#pragma unroll
      for (int j = 0; j < 4; ++j) o[lane + 64 * j] = make_uint2(pack2(xv[j].x, xv[j].y), pack2(xv[j].z, xv[j].w));
    }
    if (MODE == 0) {
      float pre[8];
#pragma unroll
      for (int i = 0; i < 8; ++i) {
        const float4* wr = reinterpret_cast<const float4*>(p.wg() + ((size_t)l * 8 + i) * 1024);
        float s = 0.f;
#pragma unroll
        for (int j = 0; j < 4; ++j) {
          float4 wv = wr[lane + 64 * j];
          s += xv[j].x * wv.x + xv[j].y * wv.y + xv[j].z * wv.z + xv[j].w * wv.w;
        }
        pre[i] = wave_sum(s);
      }
      if (lane < 4) {
        float a = pre[0]; a = lane == 1 ? pre[1] : a; a = lane == 2 ? pre[2] : a; a = lane == 3 ? pre[3] : a;
        float f = pre[4]; f = lane == 1 ? pre[5] : f; f = lane == 2 ? pre[6] : f; f = lane == 3 ? pre[7] : f;
        p.ig()[(size_t)t * 4 + lane] = a + p.ml_gate_b()[l * 8 + lane];
        float z = f + p.ml_gate_b()[l * 8 + 4 + lane];
        p.lf()[(size_t)t * 4 + lane] = fminf(z, 0.f) - log1pf(expf(-fabsf(z)));
      }
    }
  }
}

__device__ __forceinline__ int mono_key(float v) { int b = __float_as_int(v); return b ^ ((b >> 31) & 0x7FFFFFFF); }
__device__ __forceinline__ float mono_val(int k) { int b = k ^ ((k >> 31) & 0x7FFFFFFF); return __int_as_float(b); }

__device__ __forceinline__ int med3i(int a, int b, int c) { return max(min(a, b), min(max(a, b), c)); }
#define INS16(L, kv)                                                          \
  {                                                                           \
    const int _v = (kv);                                                      \
    _Pragma("unroll") for (int _j = 15; _j >= 1; --_j) L[_j] = med3i(L[_j - 1], L[_j], _v); \
    L[0] = max(L[0], _v);                                                     \
  }


enum { EPI_WIN = 0, EPI_WOUT = 1, EPI_PQ = 2, EPI_SC = 3 };

template <int EPI>
__device__ __forceinline__ void gemm_store(const Params& p, int l, int t, int n, float v) {
  if (EPI == EPI_WOUT) {
    const float* xi = xrow_in(p, l, t);
    p.x()[(size_t)t * 1024 + n] = xi[n] + v;
  } else if (EPI == EPI_PQ) {
    p.qp()[(size_t)t * 2048 + n] = f2bf(v);
  } else if (EPI == EPI_SC) {
    p.sc()[(size_t)t * 2048 + n] = v;
  }
}

template <int EPI>
__device__ __forceinline__ void ph_gemm(const Params& p, int l, char* smem, int bid, int nblk) {
  constexpr int NT = (EPI == EPI_WIN) ? 22 : (EPI == EPI_WOUT ? 8 : 16);
  constexpr int MT = NTOK / 128;
  constexpr int K = (EPI == EPI_SC) ? 128 : 1024;
  constexpr int NK = K / 64;
  const bf16_t* A; int lda; const bf16_t* Bt; int ldb;
  if (EPI == EPI_WIN) { A = p.xn(); lda = 1024; Bt = p.wt_in() + (size_t)l * NIN * 1024; ldb = 1024; }
  else if (EPI == EPI_WOUT) { A = p.xn(); lda = 1024; Bt = p.wt_out() + (size_t)l * 1024 * 1024; ldb = 1024; }
  else if (EPI == EPI_PQ) { A = p.xn(); lda = 1024; Bt = p.wt_pq() + (size_t)l * 2048 * 1024; ldb = 1024; }
  else { A = p.qp(); lda = 2048; Bt = p.keysb() + (size_t)l * 16 * 128 * 128; ldb = 128; }

  const int tid = tid_opaque(), lane = tid & 63, w = __builtin_amdgcn_readfirstlane(tid >> 6);
  const int wm = w >> 1, wn = w & 1, lr = lane & 31, lh = lane >> 5;
  char* sA = smem;
  char* sB = smem + 32768;
  const int ld_c = tid & 7, ld_r = tid >> 3;

  const int nx = nblk >> 3;
  constexpr int FG = MT / 8, LR = MT % 8;
  for (int rnd = 0;; ++rnd) {
    const int q = (nblk & 7) ? rnd * nblk + bid : rnd * nblk + (bid & 7) * nx + (bid >> 3);
    if (q >= MT * NT) break;
    int mt, nt;
    if (q < FG * 8 * NT) { const int mg = q / (8 * NT), rem = q % (8 * NT); nt = rem >> 3; mt = mg * 8 + (rem & 7); }
    else { const int q2 = q - FG * 8 * NT; nt = q2 / (LR > 0 ? LR : 1); mt = FG * 8 + q2 % (LR > 0 ? LR : 1); }
    const bf16_t* Ag = A + (size_t)(mt * 128) * lda + ((EPI == EPI_SC) ? nt * 128 : 0);
    const bf16_t* Bg = Bt + (size_t)(nt * 128) * ldb;
    f32x16 acc[2][2];
#pragma unroll
    for (int i = 0; i < 2; ++i)
#pragma unroll
      for (int j = 0; j < 2; ++j)
#pragma unroll
        for (int r = 0; r < 16; ++r) acc[i][j][r] = 0.f;

    const int g_row = w * 32 + (lane >> 3);
    const int g_pc = lane & 7;
    const bf16_t* Ath = Ag + (size_t)g_row * lda;
    const bf16_t* Bth = Bg + (size_t)g_row * ldb;
#define GEMM_STAGE(KT, BUF)                                                                                          \
  _Pragma("unroll") for (int j = 0; j < 4; ++j) {                                                                    \
    const int row = g_row + 8 * j;                                                                                   \
    const int cch = g_pc ^ ((row >> 1) & 7);                                                                         \
    __builtin_amdgcn_global_load_lds((const unsigned*)(Ath + (size_t)(8 * j) * lda + (KT) * 64 + cch * 8),           \
                                     (LAS unsigned*)(sA + (BUF) * 16384 + (w * 4 + j) * 1024 + lane * 16), 16, 0, 0); \
    __builtin_amdgcn_global_load_lds((const unsigned*)(Bth + (size_t)(8 * j) * ldb + (KT) * 64 + cch * 8),           \
                                     (LAS unsigned*)(sB + (BUF) * 16384 + (w * 4 + j) * 1024 + lane * 16), 16, 0, 0); \
  }
    GEMM_STAGE(0, 0)
    __syncthreads();
    for (int kt = 0; kt < NK; ++kt) {
      const int buf = kt & 1;
      if (kt + 1 < NK) { GEMM_STAGE(kt + 1, buf ^ 1) }
      const char* cA = sA + buf * 16384;
      const char* cB = sB + buf * 16384;
#pragma unroll
      for (int ks = 0; ks < 4; ++ks) {
        bf16x8 af[2], bfr[2];
#pragma unroll
        for (int i = 0; i < 2; ++i) {
          int row = wm * 64 + i * 32 + lr; int pc = (ks * 2 + lh) ^ ((row >> 1) & 7);
          af[i] = as_bf16x8(*reinterpret_cast<const uint4*>(cA + row * 128 + pc * 16));
        }
#pragma unroll
        for (int j = 0; j < 2; ++j) {
          int row = wn * 64 + j * 32 + lr; int pc = (ks * 2 + lh) ^ ((row >> 1) & 7);
          bfr[j] = as_bf16x8(*reinterpret_cast<const uint4*>(cB + row * 128 + pc * 16));
        }
#pragma unroll
        for (int i = 0; i < 2; ++i)
#pragma unroll
          for (int j = 0; j < 2; ++j)
            acc[i][j] = __builtin_amdgcn_mfma_f32_32x32x16_bf16(af[i], bfr[j], acc[i][j], 0, 0, 0);
      }
      __syncthreads();
    }
    if (EPI == EPI_PQ) {
      int lane_q = lane; asm volatile("" : "+v"(lane_q));
      const int lr = lane_q & 31, lh = lane_q >> 5;
      char* sA2 = smem;
      char* sB2 = smem + 32768;
      const bf16_t* kg = p.keysb() + ((size_t)l * 16 + nt) * 128 * 128;
#pragma unroll
      for (int jj = 0; jj < 8; ++jj) {
        const int I = w * 8 + jj;
        const int row = I * 4 + (lane_q >> 4);
        const int cch = (lane_q & 15) ^ (row & 15);
        __builtin_amdgcn_global_load_lds((const unsigned*)(kg + (size_t)row * 128 + cch * 8),
                                         (LAS unsigned*)(sB2 + I * 1024 + lane_q * 16), 16, 0, 0);
      }
#pragma unroll
      for (int i = 0; i < 2; ++i) {
        float rs[16];
#pragma unroll
        for (int r = 0; r < 16; ++r) rs[r] = 0.f;
#pragma unroll
        for (int j = 0; j < 2; ++j) {
          const int n = wn * 64 + j * 32 + lr;
#pragma unroll
          for (int r = 0; r < 16; ++r) {
            const int row = wm * 64 + i * 32 + (r & 3) + 8 * (r >> 2) + 4 * lh;
            const float v = acc[i][j][r];
            rs[r] += v * v;
            *reinterpret_cast<bf16_t*>(sA2 + row * 256 + (((n >> 3) ^ (row & 15)) * 16) + (n & 7) * 2) = f2bf(v);
          }
        }
#pragma unroll
        for (int r = 0; r < 16; ++r) {
          const float s = swap16_sum(row16_sum(rs[r]));
          if (lr == 0) {
            const int t = mt * 128 + wm * 64 + i * 32 + (r & 3) + 8 * (r >> 2) + 4 * lh;
            p.ssp()[(size_t)t * 32 + nt * 2 + wn] = s;
          }
        }
      }
      __syncthreads();
      f32x16 sc2[2][2];
#pragma unroll
      for (int i = 0; i < 2; ++i)
#pragma unroll
        for (int j = 0; j < 2; ++j)
#pragma unroll
          for (int r = 0; r < 16; ++r) sc2[i][j][r] = 0.f;
#pragma unroll
      for (int ks = 0; ks < 8; ++ks) {
        bf16x8 af[2], bfr[2];
#pragma unroll
        for (int i = 0; i < 2; ++i) {
          const int row = wm * 64 + i * 32 + lr;
          af[i] = as_bf16x8(*reinterpret_cast<const uint4*>(sA2 + row * 256 + (((ks * 2 + lh) ^ (row & 15)) * 16)));
        }
#pragma unroll
        for (int j = 0; j < 2; ++j) {
          const int row = wn * 64 + j * 32 + lr;
          bfr[j] = as_bf16x8(*reinterpret_cast<const uint4*>(sB2 + row * 256 + (((ks * 2 + lh) ^ (row & 15)) * 16)));
        }
#pragma unroll
        for (int i = 0; i < 2; ++i)
#pragma unroll
          for (int j = 0; j < 2; ++j)
            sc2[i][j] = __builtin_amdgcn_mfma_f32_32x32x16_bf16(af[i], bfr[j], sc2[i][j], 0, 0, 0);
      }
      __syncthreads();
      float* sS = reinterpret_cast<float*>(smem);
#pragma unroll
      for (int i = 0; i < 2; ++i)
#pragma unroll
        for (int j = 0; j < 2; ++j)
#pragma unroll
          for (int r = 0; r < 16; ++r) {
            const int row = wm * 64 + i * 32 + (r & 3) + 8 * (r >> 2) + 4 * lh;
            sS[row * 129 + wn * 64 + j * 32 + lr] = sc2[i][j][r];
          }
      __syncthreads();
      {
        int tq = tid; asm volatile("" : "+v"(tq));
        const int tk = tq & 127, hl = tq >> 7;
        int L[16];
#pragma unroll
        for (int j = 0; j < 16; ++j) L[j] = (int)0x80000000;
        const float* srow = sS + tk * 129 + hl * 64;
#pragma unroll 4
        for (int s = 0; s < 64; ++s) {
          const int key = (mono_key(srow[s]) & ~127) | (127 - (hl * 64 + s));
          INS16(L, key)
        }
        int4* dst = reinterpret_cast<int4*>(p.tl() + (((size_t)(mt * 128 + tk) * 16 + nt) * 2 + hl) * 16);
        dst[0] = make_int4(L[0], L[1], L[2], L[3]); dst[1] = make_int4(L[4], L[5], L[6], L[7]);
        dst[2] = make_int4(L[8], L[9], L[10], L[11]); dst[3] = make_int4(L[12], L[13], L[14], L[15]);
      }
      __syncthreads();
    } else if (EPI != EPI_WIN) {
#pragma unroll
      for (int i = 0; i < 2; ++i)
#pragma unroll
        for (int j = 0; j < 2; ++j)
#pragma unroll
          for (int r = 0; r < 16; ++r) {
            int t = mt * 128 + wm * 64 + i * 32 + (r & 3) + 8 * (r >> 2) + 4 * lh;
            int n = nt * 128 + wn * 64 + j * 32 + lr;
            gemm_store<EPI>(p, l, t, n, acc[i][j][r]);
          }
    } else {
      const int seg = nt >> 2;
#pragma unroll
      for (int i = 0; i < 2; ++i)
#pragma unroll
        for (int j = 0; j < 2; ++j) {
          const int n = nt * 128 + wn * 64 + j * 32 + lr;
          if (nt < 4) {
#pragma unroll
            for (int r = 0; r < 16; ++r) {
              int t = mt * 128 + wm * 64 + i * 32 + (r & 3) + 8 * (r >> 2) + 4 * lh;
              p.Qb()[(size_t)t * 512 + n] = f2bf(acc[i][j][r] * (0.125f * LOG2E));
            }
          } else if (nt < 8) {
            const int n2 = n - 512;
#pragma unroll
            for (int r = 0; r < 16; ++r) {
              int t = mt * 128 + wm * 64 + i * 32 + (r & 3) + 8 * (r >> 2) + 4 * lh;
              float v = acc[i][j][r];
              if (t < NPROMPT) {
                p.out[O_K_P + (size_t)l * (4 * 4096 * 512) + (size_t)t * 512 + n2] = v;
                p.Kb()[(size_t)t * 512 + n2] = f2bf(v);
              } else {
                int ts = t - NPROMPT, b = ts >> 6, ii = ts & 63;
                p.out[O_K_S + (size_t)l * (8 * 64 * 512) + (size_t)ts * 512 + n2] = v;
                p.Kbs()[((size_t)(l * 8 + b) * SKEYS + 1024 + ii) * 512 + n2] = f2bf(v);
              }
            }
          } else if (nt < 12) {
            const int n2 = n - 1024, h = n2 >> 7, dv = n2 & 127;
#pragma unroll
            for (int rg = 0; rg < 4; ++rg) {
              int tb = mt * 128 + wm * 64 + i * 32 + 8 * rg + 4 * lh;
              float v0 = acc[i][j][rg * 4 + 0], v1 = acc[i][j][rg * 4 + 1], v2 = acc[i][j][rg * 4 + 2], v3 = acc[i][j][rg * 4 + 3];
              uint2 pk = make_uint2(pack2(v0, v1), pack2(v2, v3));
              int posblk = 2 * lh + (rg & 1);
              if (tb < NPROMPT) {
                float* o = p.out + O_V_P + (size_t)l * (4 * 4096 * 512) + (size_t)tb * 512 + n2;
                o[0] = v0; o[512] = v1; o[1024] = v2; o[1536] = v3;
                int b = tb >> 12, s = tb & 4095;
                int pos = (s & ~15) + posblk * 4;
                *reinterpret_cast<uint2*>(p.Vt() + ((size_t)(b * 4 + h) * 128 + dv) * SEQ + pos) = pk;
              } else {
                int ts = tb - NPROMPT, b = ts >> 6, ii = ts & 63;
                float* o = p.out + O_V_S + (size_t)l * (8 * 64 * 512) + (size_t)ts * 512 + n2;
                o[0] = v0; o[512] = v1; o[1024] = v2; o[1536] = v3;
                int pos = 1024 + (ii & ~15) + posblk * 4;
                *reinterpret_cast<uint2*>(p.Vts() + ((size_t)((l * 8 + b) * 4 + h) * 128 + dv) * SKEYS + pos) = pk;
              }
            }
          } else {
            const int n2 = n - 1536;
            const bool act = (n >= 2304);
#pragma unroll
            for (int r = 0; r < 16; ++r) {
              int t = mt * 128 + wm * 64 + i * 32 + (r & 3) + 8 * (r >> 2) + 4 * lh;
              float v = acc[i][j][r];
              if (act) v = gelu_exact(v);
              p.P5()[(size_t)t * 1280 + n2] = v;
            }
          }
        }
      (void)seg;
    }
  }
}

struct WorkQ { unsigned* cnt; volatile int* slot; int off; };
__device__ __forceinline__ int wq_next(const WorkQ& q) {
  __syncthreads();
  if (threadIdx.x == 0) *q.slot = (int)__hip_atomic_fetch_add(q.cnt, 1u, __ATOMIC_RELAXED, __HIP_MEMORY_SCOPE_AGENT);
  __syncthreads();
  return __builtin_amdgcn_readfirstlane(*q.slot) - q.off;
}

template <bool CONV>
__device__ __forceinline__ int ph_attn(const Params& p, int l, char* smem, const WorkQ& wq) {
  const int tid = tid_opaque(), lane = tid & 63, w = __builtin_amdgcn_readfirstlane(tid >> 6);
  const int c = w >> 1, qhalf = w & 1, lr = lane & 31, lh = lane >> 5;
  float* sLut = reinterpret_cast<float*>(smem + 65536);
  float* sO2 = reinterpret_cast<float*>(smem);
  const float lam = p.lam()[l];
  const float lam_init = 0.8f - 0.6f * expf(-0.3f * (float)l);

  constexpr int NSLOT = CONV ? 1584 : 1056;
  int slot, uu;
  for (slot = wq_next(wq); slot < NSLOT; slot = wq_next(wq)) {
    if (CONV) {
      if (slot % 3 == 2) {
        const int ch = slot / 3, r0 = ch * 125;
        prep_table_rows(p, r0, (r0 + 125 < 65536) ? r0 + 125 : 65536, lane, w);
        continue;
      }
      uu = (slot / 3) * 2 + (slot % 3);
    } else uu = slot;
    int b, h, qc, S, qrow0; const bf16_t *Kbase, *Vbase;
    bool samp = false; int u2 = uu;
    if (uu >= 752 && uu < 784) samp = true; else if (uu >= 784) u2 = uu - 32;
    if (!samp) {
      qc = 63 - (u2 >> 4); int bh = u2 & 15; b = bh >> 2; h = bh & 3; S = SEQ;
      Kbase = p.Kb() + (size_t)b * SEQ * 512 + h * 128;
      Vbase = p.Vt() + (size_t)(b * 4 + h) * 128 * SEQ;
      qrow0 = b * SEQ + qc * 64;
    } else {
      int us = uu - 752; b = us >> 2; h = us & 3; qc = 16; S = SKEYS;
      Kbase = p.Kbs() + (size_t)(l * 8 + b) * SKEYS * 512 + h * 128;
      Vbase = p.Vts() + (size_t)((l * 8 + b) * 4 + h) * 128 * SKEYS;
      qrow0 = NPROMPT + b * 64;
    }
    const int ntiles = qc + 1;
    __syncthreads();
    sLut[tid] = p.lut()[h * 256 + tid];
    if (tid < 128) sLut[256 + tid] = p.da_subln_g()[l * 128 + tid];
    bf16x8 qf[4];
    {
      const bf16_t* qrow = p.Qb() + (size_t)(qrow0 + qhalf * 32 + lr) * 512 + h * 128 + c * 64 + lh * 8;
#pragma unroll
      for (int ks = 0; ks < 4; ++ks) qf[ks] = as_bf16x8(*reinterpret_cast<const uint4*>(qrow + ks * 16));
    }
    f32x16 o[4];
#pragma unroll
    for (int d = 0; d < 4; ++d)
#pragma unroll
      for (int r = 0; r < 16; ++r) o[d][r] = 0.f;
    float m_run = -1e30f, l_run = 0.f;

    const char* Kt = reinterpret_cast<const char*>(Kbase);
    const char* Vb = reinterpret_cast<const char*>(Vbase);
    const int g_r8 = lane >> 3, g_pc = lane & 7;
#define ATTN_STAGE(KT, BUF)                                                                                         \
  _Pragma("unroll") for (int j = 0; j < 4; ++j) {                                                                   \
    const int I = w * 4 + j;                                                                                        \
    const int rk = (I & 7) * 8 + g_r8;                                                                              \
    const unsigned kof = (unsigned)rk * 1024u + (unsigned)(I >> 3) * 128u + (unsigned)((g_pc ^ ((rk >> 1) & 7)) * 16); \
    __builtin_amdgcn_global_load_lds((const unsigned*)(Kt + (size_t)(KT) * 65536 + kof),                            \
                                     (LAS unsigned*)(smem + (BUF) * 32768 + I * 1024 + lane * 16), 16, 0, 0);       \
    const int rv = I * 8 + g_r8;                                                                                    \
    const unsigned vof = (unsigned)rv * (unsigned)(S * 2) + (unsigned)((g_pc ^ ((rv >> 1) & 7)) * 16);              \
    __builtin_amdgcn_global_load_lds((const unsigned*)(Vb + (size_t)(KT) * 128 + vof),                              \
                                     (LAS unsigned*)(smem + (BUF) * 32768 + 16384 + I * 1024 + lane * 16), 16, 0, 0); \
  }
    ATTN_STAGE(0, 0)
    __syncthreads();
    for (int kt = 0; kt < ntiles; ++kt) {
      const int buf = kt & 1;
      if (kt + 1 < ntiles) { ATTN_STAGE(kt + 1, buf ^ 1) }
      const char* sK = smem + buf * 32768;
      const char* sV = sK + 16384;
      f32x16 s[2];
      {
        bf16x8 kf[2][4];
#pragma unroll
        for (int kb = 0; kb < 2; ++kb)
#pragma unroll
          for (int ks = 0; ks < 4; ++ks) {
            int row = kb * 32 + lr; int pc = (ks * 2 + lh) ^ ((row >> 1) & 7);
            kf[kb][ks] = as_bf16x8(*reinterpret_cast<const uint4*>(sK + c * 8192 + row * 128 + pc * 16));
          }
        __builtin_amdgcn_sched_barrier(0);
#pragma unroll
        for (int kb = 0; kb < 2; ++kb) {
#pragma unroll
          for (int r = 0; r < 16; ++r) s[kb][r] = 0.f;
#pragma unroll
          for (int ks = 0; ks < 4; ++ks) s[kb] = __builtin_amdgcn_mfma_f32_32x32x16_bf16(kf[kb][ks], qf[ks], s[kb], 0, 0, 0);
        }
      }
      bf16x8 vfa[2][4];
#pragma unroll
      for (int k2 = 0; k2 < 2; ++k2)
#pragma unroll
        for (int d = 0; d < 4; ++d) {
          int row = d * 32 + lr; int pc = (k2 * 2 + lh) ^ ((row >> 1) & 7);
          vfa[k2][d] = as_bf16x8(*reinterpret_cast<const uint4*>(sV + row * 128 + pc * 16));
        }
      __builtin_amdgcn_sched_barrier(0);
      float boff = sLut[0];
      if (kt >= qc - 2) {
        const int base = (kt - qc) * 64 - (qhalf * 32 + lr) + 191 + 4 * lh;
#pragma unroll
        for (int kb = 0; kb < 2; ++kb)
#pragma unroll
          for (int r = 0; r < 16; ++r) s[kb][r] += sLut[base + kb * 32 + (r & 3) + 8 * (r >> 2)];
        boff = 0.f;
      }
      float mx = s[0][0];
#pragma unroll
      for (int kb = 0; kb < 2; ++kb)
#pragma unroll
        for (int r = 0; r < 16; ++r) mx = fmaxf(mx, s[kb][r]);
      mx = swap32_max(mx) + boff;
      if (__any(mx > m_run)) {
        const float m_new = fmaxf(m_run, mx);
        const float alpha = __builtin_amdgcn_exp2f(m_run - m_new);
        m_run = m_new;
        l_run *= alpha;
#pragma unroll
        for (int d = 0; d < 4; ++d)
#pragma unroll
          for (int r = 0; r < 16; ++r) o[d][r] *= alpha;
      }
      const float eoff = boff - m_run;
      float ps = 0.f;
#pragma unroll
      for (int kb = 0; kb < 2; ++kb)
#pragma unroll
        for (int r = 0; r < 16; ++r) { float pv = __builtin_amdgcn_exp2f(s[kb][r] + eoff); s[kb][r] = pv; ps += pv; }
      l_run += ps;
      bf16x8 pf[4];
#pragma unroll
      for (int ks2 = 0; ks2 < 4; ++ks2) {
        const int kb = ks2 >> 1, sh = (ks2 & 1) * 8;
        uint4 pw = make_uint4(pack2(s[kb][sh + 0], s[kb][sh + 1]), pack2(s[kb][sh + 2], s[kb][sh + 3]),
                              pack2(s[kb][sh + 4], s[kb][sh + 5]), pack2(s[kb][sh + 6], s[kb][sh + 7]));
        pf[ks2] = as_bf16x8(pw);
      }
      __builtin_amdgcn_sched_barrier(0);
#define ATTN_VREAD(DST, K2)                                                                        \
  _Pragma("unroll") for (int d = 0; d < 4; ++d) {                                                  \
    int row = d * 32 + lr; int pc = ((K2) * 2 + lh) ^ ((row >> 1) & 7);                            \
    DST[d] = as_bf16x8(*reinterpret_cast<const uint4*>(sV + row * 128 + pc * 16));                 \
  }
#define ATTN_PV(SRC, K2) \
  _Pragma("unroll") for (int d = 0; d < 4; ++d) o[d] = __builtin_amdgcn_mfma_f32_32x32x16_bf16(SRC[d], pf[K2], o[d], 0, 0, 0);
      bf16x8 vfc[4];
      ATTN_VREAD(vfc, 2)
      ATTN_PV(vfa[0], 0)
      __builtin_amdgcn_sched_barrier(0);
      ATTN_VREAD(vfa[0], 3)
      ATTN_PV(vfa[1], 1)
      __builtin_amdgcn_sched_barrier(0);
      ATTN_PV(vfc, 2)
      ATTN_PV(vfa[0], 3)
      __syncthreads();
    }
    int lane_e = (int)__builtin_amdgcn_mbcnt_hi(~0u, __builtin_amdgcn_mbcnt_lo(~0u, 0u)); asm volatile("" : "+v"(lane_e));
    const int lr_e = lane_e & 31, lh_e = lane_e >> 5;
    float lt = swap32_sum(l_run);
    float inv = 1.f / lt;
    __syncthreads();
    if (c == 1) {
#pragma unroll
      for (int d = 0; d < 4; ++d)
#pragma unroll
        for (int r = 0; r < 16; ++r) sO2[(qhalf * 64 + d * 16 + r) * 64 + lane_e] = o[d][r] * inv;
    }
    __syncthreads();
    if (c == 0) {
      float ss = 0.f;
#pragma unroll
      for (int d = 0; d < 4; ++d)
#pragma unroll
        for (int r = 0; r < 16; ++r) {
          float v = o[d][r] * inv - lam * sO2[(qhalf * 64 + d * 16 + r) * 64 + lane_e];
          o[d][r] = v; ss += v * v;
        }
      ss = swap32_sum(ss);
      const float rn = rsqrtf(ss * (1.f / 128.f) + EPS) * (1.f - lam_init);
      const float* gs = sLut + 256;
      bf16_t* orow = p.xn() + (size_t)(qrow0 + qhalf * 32 + lr_e) * 1024 + h * 128;
#pragma unroll
      for (int d = 0; d < 4; ++d)
#pragma unroll
        for (int rg = 0; rg < 4; ++rg) {
          int dv = d * 32 + 8 * rg + 4 * lh_e;
          float4 g4 = *reinterpret_cast<const float4*>(gs + dv);
          uint2 pk = make_uint2(pack2(o[d][rg * 4 + 0] * rn * g4.x, o[d][rg * 4 + 1] * rn * g4.y),
                                pack2(o[d][rg * 4 + 2] * rn * g4.z, o[d][rg * 4 + 3] * rn * g4.w));
          *reinterpret_cast<uint2*>(orow + dv) = pk;
        }
    }
  }
  return slot - NSLOT + 1056;
}

template <int K>
__device__ __forceinline__ void mfma32_f32(f32x16& acc, const float* a, int a_rs, int a_ks, const float* b, int b_ks, int b_js, int lane) {
  const float* ap = a + (lane & 31) * a_rs + (lane >> 5) * a_ks;
  const float* bp = b + (lane >> 5) * b_ks + (lane & 31) * b_js;
#pragma unroll 8
  for (int k = 0; k < K; k += 2) acc = __builtin_amdgcn_mfma_f32_32x32x2f32(ap[k * a_ks], bp[k * b_ks], acc, 0, 0, 0);
}
__device__ __forceinline__ void zero16(f32x16& a) {
#pragma unroll
  for (int r = 0; r < 16; ++r) a[r] = 0.f;
}

__device__ __forceinline__ int ph_mlconv(const Params& p, int l, char* smem, const WorkQ& wq, int item) {
  const int tid = tid_opaque();
  float* s_mc = reinterpret_cast<float*>(smem);
  float* s_cc = s_mc + 67 * 64;
  float* s_wq = s_cc + 64 * 65;
  float* s_wk = s_wq + 4096;
  for (; item < 1056 + 264 * 4; item = wq_next(wq)) {
    const int u = item - 1056;
    const int ci = u >> 2, h = u & 3;
    int token0, bq; bool samp = ci >= 256;
    if (!samp) token0 = ci * 64; else token0 = NPROMPT + (ci - 256) * 64;
    bq = samp ? (ci - 256) : (ci >> 6);
    const int cidx = samp ? 0 : (ci & 63);
    __syncthreads();
    for (int i = tid; i < 67 * 64; i += 256) {
      int r = i >> 6, d = i & 63;
      float v;
      if (r >= 3) v = p.P5()[(size_t)(token0 + r - 3) * 1280 + h * 64 + d];
      else if (samp) v = p.st_conv()[((size_t)(l * 8 + bq) * 3 + r) * 256 + h * 64 + d];
      else if (cidx == 0) v = 0.f;
      else v = p.P5()[(size_t)(token0 + r - 3) * 1280 + h * 64 + d];
      s_mc[i] = v;
    }
    for (int i = tid; i < 4096; i += 256) {
      s_wq[i] = p.ml_wq()[(size_t)(l * 4 + h) * 4096 + i];
      s_wk[i] = p.ml_wk()[(size_t)(l * 4 + h) * 4096 + i];
    }
    __syncthreads();
    {
      const int d = tid & 63, t0 = tid >> 6;
      const int ch = h * 64 + d;
      const float w0 = p.ml_conv_w()[(l * 4 + 0) * 256 + ch], w1 = p.ml_conv_w()[(l * 4 + 1) * 256 + ch];
      const float w2 = p.ml_conv_w()[(l * 4 + 2) * 256 + ch], w3 = p.ml_conv_w()[(l * 4 + 3) * 256 + ch];
      const float bb = p.ml_conv_b()[l * 256 + ch];
      for (int t = t0; t < 64; t += 4) {
        float y = bb + w0 * s_mc[t * 64 + d] + w1 * s_mc[(t + 1) * 64 + d] + w2 * s_mc[(t + 2) * 64 + d] + w3 * s_mc[(t + 3) * 64 + d];
        y = y * sigmoidf_(y);
        s_cc[t * 65 + d] = y;
        p.cc()[(size_t)(token0 + t) * 256 + ch] = y;
      }
      if (samp || cidx == 63) {
        if (tid < 192) {
          int r = tid >> 6;
          float v = s_mc[(64 + r) * 64 + d];
          if (samp) p.out[O_CONV_S + ((size_t)(l * 8 + bq) * 3 + r) * 256 + ch] = v;
          else p.out[O_CONV_P + ((size_t)(l * 4 + bq) * 3 + r) * 256 + ch] = v;
        }
      }
    }
    __syncthreads();
    {
      const int lane = tid & 63, w = __builtin_amdgcn_readfirstlane(tid >> 6), ti = w >> 1, tj = w & 1;
      f32x16 aq, ak; zero16(aq); zero16(ak);
      mfma32_f32<64>(aq, s_cc + ti * 32 * 65, 65, 1, s_wq + tj * 32, 64, 1, lane);
      mfma32_f32<64>(ak, s_cc + ti * 32 * 65, 65, 1, s_wk + tj * 32, 64, 1, lane);
#pragma unroll
      for (int r = 0; r < 16; ++r) {
        const int t = ti * 32 + (r & 3) + 8 * (r >> 2) + 4 * (lane >> 5);
        const size_t o = (size_t)(token0 + t) * 256 + h * 64 + tj * 32 + (lane & 31);
        p.qm()[o] = aq[r];
        p.km()[o] = ak[r] * 0.125f;
      }
      if (w == 0) {
        const int t = token0 + lane;
        const float lfv = p.lf()[(size_t)t * 4 + h], igv = p.ig()[(size_t)t * 4 + h];
        float F = lfv;
#pragma unroll
        for (int d = 1; d < 64; d <<= 1) { float n = shfl_up_l(F, d, lane); if (lane >= d) F += n; }
        const float FL = __int_as_float(__builtin_amdgcn_readlane(__float_as_int(F), 63));
        const float mx = wave_max(FL - F + igv);
        p.Fc()[(size_t)t * 4 + h] = F;
        if (lane == 0) {
          const int cu = samp ? 1024 + bq * 4 + h : (bq * 4 + h) * 64 + cidx;
          p.FLs()[cu] = FL; p.mxt()[cu] = mx;
        }
      }
    }
  }
  return item;
}

__device__ __forceinline__ void cu_decode(int cu, int& token0, int& h) {
  if (cu < 1024) { int bh = cu >> 6, c = cu & 63; token0 = (bh >> 2) * SEQ + c * 64; h = bh & 3; }
  else { int us = cu - 1024; token0 = NPROMPT + (us >> 2) * 64; h = us & 3; }
}

__device__ __forceinline__ void ph_mlU(const Params& p, int l, char* smem, int bid, int nblk) {
  const int tid = tid_opaque();
  const int lane = tid & 63, w = __builtin_amdgcn_readfirstlane(tid >> 6), ti = w >> 1, tj = w & 1;
  float* s_k = reinterpret_cast<float*>(smem);
  float* s_v = s_k + 4096;
  for (int cu = bid; cu < NCU_UNITS; cu += nblk) {
    int token0, h; cu_decode(cu, token0, h);
    float m0, mn, FL;
    {
      const bool samp = cu >= 1024;
      const int cu0 = samp ? cu : (cu & ~63), c = samp ? 0 : (cu & 63);
      float flv = 0.f, mxv = 0.f;
      if (lane <= c) { flv = p.FLs()[cu0 + lane]; mxv = p.mxt()[cu0 + lane]; }
      float m = samp ? p.st_m()[l * 32 + (cu - 1024)] : 0.f;
      for (int j = 0; j < c; ++j) {
        const float fj = __int_as_float(__builtin_amdgcn_readlane(__float_as_int(flv), j));
        const float xj = __int_as_float(__builtin_amdgcn_readlane(__float_as_int(mxv), j));
        m = fmaxf(fj + m, xj);
      }
      FL = __int_as_float(__builtin_amdgcn_readlane(__float_as_int(flv), c));
      const float xc = __int_as_float(__builtin_amdgcn_readlane(__float_as_int(mxv), c));
      m0 = m; mn = fmaxf(FL + m, xc);
      if (tid == 0) {
        p.mst()[cu] = m0; p.mnx()[cu] = mn; p.wcs()[cu] = expf(FL + m0 - mn);
        if (samp) p.out[O_M_S + l * 32 + (cu - 1024)] = mn;
        else if (c == 63) p.out[O_M_P + l * 16 + (cu >> 6)] = mn;
      }
    }
    __syncthreads();
    for (int i = tid; i < 1024; i += 256) {
      int s = i >> 4, d4 = (i & 15) * 4;
      const int t = token0 + s;
      float wsv = expf(FL - p.Fc()[(size_t)t * 4 + h] + p.ig()[(size_t)t * 4 + h] - mn);
      float4 k4 = *reinterpret_cast<const float4*>(p.km() + (size_t)t * 256 + h * 64 + d4);
      float4 v4 = *reinterpret_cast<const float4*>(p.P5() + (size_t)t * 1280 + 256 + h * 64 + d4);
      *reinterpret_cast<float4*>(s_k + s * 64 + d4) = make_float4(k4.x * wsv, k4.y * wsv, k4.z * wsv, k4.w * wsv);
      *reinterpret_cast<float4*>(s_v + s * 64 + d4) = v4;
    }
    __syncthreads();
    f32x16 acc; zero16(acc);
    mfma32_f32<64>(acc, s_k + ti * 32, 1, 64, s_v + tj * 32, 64, 1, lane);
#pragma unroll
    for (int r = 0; r < 16; ++r) {
      const int d = ti * 32 + (r & 3) + 8 * (r >> 2) + 4 * (lane >> 5);
      p.U()[(size_t)cu * 4096 + d * 64 + tj * 32 + (lane & 31)] = acc[r];
    }
    if (tid < 64) {
      float s0 = 0.f;
      for (int s = 0; s < 64; ++s) s0 += s_k[s * 64 + tid];
      p.un()[(size_t)cu * 64 + tid] = s0;
    }
  }
}

__device__ __forceinline__ void ph_mlscan(const Params& p, int l, int bid, int nblk) {
  const size_t gtid = (size_t)bid * 256 + tid_opaque(), gsz = (size_t)nblk * 256;
  const size_t NPC = 16 * 4096, NSC = 32 * 4096, NPN = 16 * 64, NSN = 32 * 64;
  for (size_t i = gtid; i < NPC + NSC + NPN + NSN; i += gsz) {
    if (i < NPC) {
      int bh = (int)(i >> 12), e = (int)(i & 4095);
      float C = 0.f;
      for (int c = 0; c < 64; ++c) {
        int cu = bh * 64 + c;
        p.Cst()[(size_t)cu * 4096 + e] = C;
        C = p.wcs()[cu] * C + p.U()[(size_t)cu * 4096 + e];
      }
      p.out[O_C_P + (size_t)l * (16 * 4096) + i] = C;
    } else if (i < NPC + NSC) {
      size_t j = i - NPC; int us = (int)(j >> 12), e = (int)(j & 4095); int cu = 1024 + us;
      float C = p.st_c()[(size_t)l * (32 * 4096) + j];
      p.Cst()[(size_t)cu * 4096 + e] = C;
      p.out[O_C_S + (size_t)l * (32 * 4096) + j] = p.wcs()[cu] * C + p.U()[(size_t)cu * 4096 + e];
    } else if (i < NPC + NSC + NPN) {
      size_t j = i - NPC - NSC; int bh = (int)(j >> 6), d = (int)(j & 63);
      float n = 0.f;
      for (int c = 0; c < 64; ++c) {
        int cu = bh * 64 + c;
        p.nst()[(size_t)cu * 64 + d] = n;
        n = p.wcs()[cu] * n + p.un()[(size_t)cu * 64 + d];
      }
      p.out[O_N_P + (size_t)l * (16 * 64) + j] = n;
    } else {
      size_t j = i - NPC - NSC - NPN; int us = (int)(j >> 6), d = (int)(j & 63); int cu = 1024 + us;
      float n = p.st_n()[(size_t)l * (32 * 64) + j];
      p.nst()[(size_t)cu * 64 + d] = n;
      p.out[O_N_S + (size_t)l * (32 * 64) + j] = p.wcs()[cu] * n + p.un()[(size_t)cu * 64 + d];
    }
  }
}

__device__ __forceinline__ void ph_mlout(const Params& p, int l, char* smem, int bid, int nblk) {
  const int tid = tid_opaque();
  float* s_q = reinterpret_cast<float*>(smem);
  float* s_k = s_q + 64 * 65;
  float* s_v = s_k + 64 * 65;
  float* s_C = s_v + 4096;
  float* s_F = s_C + 4096;
  float* s_a = s_F + 64;
  float* s_mt = s_a + 64;
  float* s_iw = s_mt + 64;
  float* s_n = s_iw + 64;
  float* s_den = s_n + 64;
  float* s_denp = s_den + 64;
  float* s_qn = s_denp + 128;
  for (int cu = bid; cu < NCU_UNITS; cu += nblk) {
    int token0, h; cu_decode(cu, token0, h);
    const float m0 = p.mst()[cu];
    __syncthreads();
    for (int i = tid; i < 1024; i += 256) {
      int s = i >> 4, d4 = (i & 15) * 4;
      const int t = token0 + s;
      float4 q4 = *reinterpret_cast<const float4*>(p.qm() + (size_t)t * 256 + h * 64 + d4);
      float4 k4 = *reinterpret_cast<const float4*>(p.km() + (size_t)t * 256 + h * 64 + d4);
      float4 v4 = *reinterpret_cast<const float4*>(p.P5() + (size_t)t * 1280 + 256 + h * 64 + d4);
      float4 c4 = *reinterpret_cast<const float4*>(p.Cst() + (size_t)cu * 4096 + s * 64 + d4);
      s_q[s * 65 + d4] = q4.x; s_q[s * 65 + d4 + 1] = q4.y; s_q[s * 65 + d4 + 2] = q4.z; s_q[s * 65 + d4 + 3] = q4.w;
      s_k[s * 65 + d4] = k4.x; s_k[s * 65 + d4 + 1] = k4.y; s_k[s * 65 + d4 + 2] = k4.z; s_k[s * 65 + d4 + 3] = k4.w;
      *reinterpret_cast<float4*>(s_v + s * 64 + d4) = v4;
      *reinterpret_cast<float4*>(s_C + s * 64 + d4) = c4;
    }
    if (tid < 64) {
      const int t = token0 + tid;
      float F = p.Fc()[(size_t)t * 4 + h], g = p.ig()[(size_t)t * 4 + h];
      s_F[tid] = F; s_a[tid] = g - F;
      s_n[tid] = p.nst()[(size_t)cu * 64 + tid];
    }
    __syncthreads();
    if (tid < 64) {
      float pm = s_a[tid];
#pragma unroll
      for (int d = 1; d < 64; d <<= 1) { const float o = shfl_up_l(pm, d, tid); if (tid >= d) pm = fmaxf(pm, o); }
      float F = s_F[tid];
      float mt = F + fmaxf(m0, pm);
      s_mt[tid] = mt;
      s_iw[tid] = expf(F + m0 - mt);
    }
    __syncthreads();
    const int lane = tid & 63, w = __builtin_amdgcn_readfirstlane(tid >> 6), ti = w >> 1, tj = w & 1;
    const int ty = tid >> 4, tx = tid & 15;
    {
      f32x16 accS; zero16(accS);
      mfma32_f32<64>(accS, s_q + ti * 32 * 65, 65, 1, s_k + tj * 32 * 65, 1, 65, lane);
      __syncthreads();
      const int s = tj * 32 + (lane & 31);
      const float as = s_a[s];
#pragma unroll
      for (int r = 0; r < 16; ++r) {
        const int t = ti * 32 + (r & 3) + 8 * (r >> 2) + 4 * (lane >> 5);
        const float sw = (s <= t) ? accS[r] * expf(s_F[t] + as - s_mt[t]) : 0.f;
        s_k[t * 65 + s] = sw;
        const float rsum = swap16_sum(row16_sum(sw));
        if ((lane & 31) == 0) s_denp[tj * 64 + t] = rsum;
      }
    }
    {
      const int t = tid >> 2, part = tid & 3;
      float qn = 0.f;
#pragma unroll
      for (int d = 0; d < 16; ++d) qn += s_q[t * 65 + part * 16 + d] * s_n[part * 16 + d];
      qn += dpp_f<0xB1>(qn); qn += dpp_f<0x4E>(qn);
      if (part == 0) s_qn[t] = qn;
    }
    __syncthreads();
    if (tid < 64) s_den[tid] = s_denp[tid] + s_denp[64 + tid] + s_iw[tid] * s_qn[tid];
    {
      f32x16 accN, accC; zero16(accN); zero16(accC);
      mfma32_f32<64>(accN, s_k + ti * 32 * 65, 65, 1, s_v + tj * 32, 64, 1, lane);
      mfma32_f32<64>(accC, s_q + ti * 32 * 65, 65, 1, s_C + tj * 32, 64, 1, lane);
      __syncthreads();
#pragma unroll
      for (int r = 0; r < 16; ++r) {
        const int t = ti * 32 + (r & 3) + 8 * (r >> 2) + 4 * (lane >> 5);
        s_q[t * 65 + tj * 32 + (lane & 31)] = accN[r] + s_iw[t] * accC[r];
      }
    }
    __syncthreads();
#pragma unroll
    for (int i = 0; i < 4; ++i) {
      const int t = ty * 4 + i;
      const float dn = fmaxf(fabsf(s_den[t]), expf(-s_mt[t]));
      float hv[4]; float ss = 0.f;
#pragma unroll
      for (int j = 0; j < 4; ++j) { hv[j] = s_q[t * 65 + tx * 4 + j] / dn; ss += hv[j] * hv[j]; }
      ss = row16_sum(ss);
      const float rn = rsqrtf(ss * (1.f / 64.f) + EPS);
      const int ch = h * 64 + tx * 4;
      const size_t tg = (size_t)(token0 + t);
      float4 g4 = *reinterpret_cast<const float4*>(p.ml_norm_g() + l * 256 + ch);
      float4 k4 = *reinterpret_cast<const float4*>(p.ml_skip() + l * 256 + ch);
      float4 c4 = *reinterpret_cast<const float4*>(p.cc() + tg * 256 + ch);
      float4 o4 = *reinterpret_cast<const float4*>(p.P5() + tg * 1280 + 512 + ch);
      float r0 = (hv[0] * rn * g4.x + k4.x * c4.x) * sigmoidf_(o4.x);
      float r1 = (hv[1] * rn * g4.y + k4.y * c4.y) * sigmoidf_(o4.y);
      float r2 = (hv[2] * rn * g4.z + k4.z * c4.z) * sigmoidf_(o4.z);
      float r3 = (hv[3] * rn * g4.w + k4.w * c4.w) * sigmoidf_(o4.w);
      *reinterpret_cast<uint2*>(p.xn() + tg * 1024 + 512 + ch) = make_uint2(pack2(r0, r1), pack2(r2, r3));
    }
  }
}

__device__ __forceinline__ void ph_cmlp(const Params& p, int l, char* smem, const WorkQ& wq, int item) {
  const int tid = tid_opaque(), lane = tid & 63, w = __builtin_amdgcn_readfirstlane(tid >> 6);
  float* s_vg = reinterpret_cast<float*>(smem);
  float* s_ws = s_vg + 128 * 64;
  float* s_r = s_ws + 128 * 33;
  for (; item < 1056 + 264 * 4 + 544; item = wq_next(wq)) {
    const int u = item - (1056 + 264 * 4);
    const int g = u & 3, ci = u >> 2;
    const bool samp = ci >= 128;
    const int L = samp ? 64 : 128;
    const int token0 = samp ? NPROMPT + (ci - 128) * 64 : ci * 128;
    __syncthreads();
    for (int r = w; r < L; r += 4) {
      float4 v = *reinterpret_cast<const float4*>(p.P5() + (size_t)(token0 + r) * 1280 + 1024 + lane * 4);
      float ss = v.x * v.x + v.y * v.y + v.z * v.z + v.w * v.w;
      ss = wave_sum(ss);
      if (lane == 0) s_r[r] = rsqrtf(ss * (1.f / 256.f) + EPS);
    }
    __syncthreads();
    for (int i = tid; i < L * 16; i += 256) {
      int s = i >> 4, d4 = (i & 15) * 4;
      float4 v = *reinterpret_cast<const float4*>(p.P5() + (size_t)(token0 + s) * 1280 + 1024 + g * 64 + d4);
      float4 gn = *reinterpret_cast<const float4*>(p.cm_norm_g() + l * 256 + g * 64 + d4);
      float r = s_r[s];
      float4 o = make_float4(v.x * r * gn.x, v.y * r * gn.y, v.z * r * gn.z, v.w * r * gn.w);
      *reinterpret_cast<float4*>(s_vg + s * 64 + d4) = o;
      if (samp) {
        int ts = token0 - NPROMPT + s;
        *reinterpret_cast<float4*>(p.out + O_CMV_S + (size_t)l * (512 * 256) + (size_t)ts * 256 + g * 64 + d4) = o;
      }
    }
    const int rtA = (w < 2) ? 3 : 2, rtB = (w < 2) ? 0 : 1, ct = w & 1;
    const int nrt = L >> 5;
    f32x16 accA, accB; zero16(accA); zero16(accB);
    const float* wsg = p.cm_ws() + (size_t)(l * 4 + g) * 128 * 128;
    for (int s0 = 0; s0 < L; s0 += 32) {
      __syncthreads();
      for (int i = tid; i < L * 32; i += 256) {
        int t = i >> 5, ss = i & 31;
        s_ws[t * 33 + ss] = (s0 + ss <= t) ? wsg[t * 128 + s0 + ss] : 0.f;
      }
      __syncthreads();
      const int c = s0 >> 5;
      if (rtA < nrt && c <= rtA) mfma32_f32<32>(accA, s_ws + rtA * 32 * 33, 33, 1, s_vg + s0 * 64 + ct * 32, 64, 1, lane);
      if (rtB < nrt && c <= rtB) mfma32_f32<32>(accB, s_ws + rtB * 32 * 33, 33, 1, s_vg + s0 * 64 + ct * 32, 64, 1, lane);
    }
    __syncthreads();
#pragma unroll
    for (int r = 0; r < 16; ++r) {
      const int tr = (r & 3) + 8 * (r >> 2) + 4 * (lane >> 5);
      if (rtA < nrt) s_vg[(rtA * 32 + tr) * 64 + ct * 32 + (lane & 31)] = accA[r];
      if (rtB < nrt) s_vg[(rtB * 32 + tr) * 64 + ct * 32 + (lane & 31)] = accB[r];
    }
    __syncthreads();
    {
      const int ty = tid >> 4, tx = tid & 15;
      if (ty * 8 < L) {
#pragma unroll
        for (int i = 0; i < 8; ++i) {
          const int t = ty * 8 + i;
          const float bb = p.cm_b()[(l * 4 + g) * 128 + t];
          const size_t tg = (size_t)(token0 + t);
          float4 a4 = *reinterpret_cast<const float4*>(s_vg + t * 64 + tx * 4);
          float4 u4 = *reinterpret_cast<const float4*>(p.P5() + tg * 1280 + 768 + g * 64 + tx * 4);
          *reinterpret_cast<uint2*>(p.xn() + tg * 1024 + 768 + g * 64 + tx * 4) =
              make_uint2(pack2(u4.x * (a4.x + bb), u4.y * (a4.y + bb)), pack2(u4.z * (a4.z + bb), u4.w * (a4.w + bb)));
        }
      }
    }
  }
}

__device__ __forceinline__ void ph_topk(const Params& p, int l, char* smem, int bid, int nblk) {
  const int tid = tid_opaque(), lane = tid & 63, w = __builtin_amdgcn_readfirstlane(tid >> 6);
  float* s_tile = reinterpret_cast<float*>(smem) + w * (64 * 33);
  int* s_list = reinterpret_cast<int*>(smem + 4 * 64 * 33 * 4) + w * (2 * 16 * 64);
  float* s_ss = reinterpret_cast<float*>(smem + 4 * 64 * 33 * 4 + 4 * 2 * 16 * 64 * 4) + w * 64;
  for (int u = bid * 4 + w; u < 264 * 8; u += nblk * 4) {
    const int tg = u >> 3, h = u & 7;
    const int t0 = tg * 64;
    {
      const float4 pp = *reinterpret_cast<const float4*>(p.ssp() + (size_t)(t0 + lane) * 32 + h * 4);
      s_ss[lane] = pp.x + pp.y + pp.z + pp.w;
    }
    int L1[16], L2[16];
#pragma unroll
    for (int j = 0; j < 16; ++j) { L1[j] = (int)0x80000000; L2[j] = (int)0x80000000; }
#pragma unroll
    for (int c = 0; c < 2; ++c) {
      const int4* la = reinterpret_cast<const int4*>(p.tl() + (((size_t)(t0 + lane) * 16 + h * 2 + c) * 2) * 16);
      int A[16], B[16];
#pragma unroll
      for (int q = 0; q < 4; ++q) {
        const int4 a = la[q], b = la[4 + q];
        A[4 * q] = a.x; A[4 * q + 1] = a.y; A[4 * q + 2] = a.z; A[4 * q + 3] = a.w;
        B[4 * q] = b.x; B[4 * q + 1] = b.y; B[4 * q + 2] = b.z; B[4 * q + 3] = b.w;
      }
#pragma unroll
      for (int j = 0; j < 16; ++j) INS16(A, B[j])
#pragma unroll
      for (int j = 0; j < 16; ++j) { if (c == 0) L1[j] = A[j]; else L2[j] = A[j]; }
    }
#pragma unroll
    for (int j = 0; j < 16; ++j) { s_list[(0 * 16 + j) * 64 + lane] = 127 - (L1[j] & 127); s_list[(1 * 16 + j) * 64 + lane] = 127 - (L2[j] & 127); }
    float v1[16], v2[16];
#pragma unroll
    for (int j = 0; j < 16; ++j) { v1[j] = mono_val(L1[j] & ~127); v2[j] = mono_val(L2[j] & ~127); }
    int LC[16];
#pragma unroll
    for (int j = 0; j < 16; ++j) LC[j] = (int)0x80000000;
#pragma unroll
    for (int i = 0; i < 16; ++i)
#pragma unroll
      for (int j = 0; j < 16; ++j)
        if ((i + 1) * (j + 1) <= 16) {
          int key = (mono_key(v1[i] + v2[j]) & ~255) | (255 - (i * 16 + j));
          INS16(LC, key)
        }
    const float scale = rsqrtf(s_ss[lane] * (1.f / 256.f) + EPS);
    float vs[16]; float den = 0.f;
    const float top = mono_val(LC[0] & ~255);
#pragma unroll
    for (int k = 0; k < 16; ++k) { vs[k] = __expf((mono_val(LC[k] & ~255) - top) * scale); den += vs[k]; }
    const float inv = 1.f / den;
    const size_t ob = (size_t)(t0 + lane) * 128 + h * 16;
#pragma unroll
    for (int k4 = 0; k4 < 4; ++k4) {
      int ee[4]; float gg[4], su[4];
#pragma unroll
      for (int q = 0; q < 4; ++q) {
        int k = k4 * 4 + q;
        int ci = 255 - (LC[k] & 255);
        int i1 = s_list[(0 * 16 + (ci >> 4)) * 64 + lane];
        int i2 = s_list[(1 * 16 + (ci & 15)) * 64 + lane];
        ee[q] = i1 * 128 + i2;
        gg[q] = vs[k] * inv * p.vs()[l * 16384 + ee[q]];
        su[q] = p.us()[l * 16384 + ee[q]];
      }
      *reinterpret_cast<int4*>(p.eidx() + ob + k4 * 4) = make_int4(ee[0], ee[1], ee[2], ee[3]);
      *reinterpret_cast<float4*>(p.egate() + ob + k4 * 4) = make_float4(gg[0], gg[1], gg[2], gg[3]);
      *reinterpret_cast<float4*>(p.esu() + ob + k4 * 4) = make_float4(su[0], su[1], su[2], su[3]);
    }
  }
}

__device__ __forceinline__ float dot16_fp8(const float* xf, uint4 u) {
  f32x2 a0 = __builtin_amdgcn_cvt_pk_f32_fp8(u.x, false), a1 = __builtin_amdgcn_cvt_pk_f32_fp8(u.x, true);
  f32x2 a2 = __builtin_amdgcn_cvt_pk_f32_fp8(u.y, false), a3 = __builtin_amdgcn_cvt_pk_f32_fp8(u.y, true);
  f32x2 a4 = __builtin_amdgcn_cvt_pk_f32_fp8(u.z, false), a5 = __builtin_amdgcn_cvt_pk_f32_fp8(u.z, true);
  f32x2 a6 = __builtin_amdgcn_cvt_pk_f32_fp8(u.w, false), a7 = __builtin_amdgcn_cvt_pk_f32_fp8(u.w, true);
  float s0 = xf[0] * a0.x, s1 = xf[1] * a0.y;
  s0 = fmaf(xf[2], a1.x, s0); s1 = fmaf(xf[3], a1.y, s1);
  s0 = fmaf(xf[4], a2.x, s0); s1 = fmaf(xf[5], a2.y, s1);
  s0 = fmaf(xf[6], a3.x, s0); s1 = fmaf(xf[7], a3.y, s1);
  s0 = fmaf(xf[8], a4.x, s0); s1 = fmaf(xf[9], a4.y, s1);
  s0 = fmaf(xf[10], a5.x, s0); s1 = fmaf(xf[11], a5.y, s1);
  s0 = fmaf(xf[12], a6.x, s0); s1 = fmaf(xf[13], a6.y, s1);
  s0 = fmaf(xf[14], a7.x, s0); s1 = fmaf(xf[15], a7.y, s1);
  return s0 + s1;
}
__device__ __forceinline__ void axpy16_fp8(float* y, float wgt, uint4 v) {
  f32x2 a0 = __builtin_amdgcn_cvt_pk_f32_fp8(v.x, false), a1 = __builtin_amdgcn_cvt_pk_f32_fp8(v.x, true);
  f32x2 a2 = __builtin_amdgcn_cvt_pk_f32_fp8(v.y, false), a3 = __builtin_amdgcn_cvt_pk_f32_fp8(v.y, true);
  f32x2 a4 = __builtin_amdgcn_cvt_pk_f32_fp8(v.z, false), a5 = __builtin_amdgcn_cvt_pk_f32_fp8(v.z, true);
  f32x2 a6 = __builtin_amdgcn_cvt_pk_f32_fp8(v.w, false), a7 = __builtin_amdgcn_cvt_pk_f32_fp8(v.w, true);
  y[0] = fmaf(wgt, a0.x, y[0]); y[1] = fmaf(wgt, a0.y, y[1]); y[2] = fmaf(wgt, a1.x, y[2]); y[3] = fmaf(wgt, a1.y, y[3]);
  y[4] = fmaf(wgt, a2.x, y[4]); y[5] = fmaf(wgt, a2.y, y[5]); y[6] = fmaf(wgt, a3.x, y[6]); y[7] = fmaf(wgt, a3.y, y[7]);
  y[8] = fmaf(wgt, a4.x, y[8]); y[9] = fmaf(wgt, a4.y, y[9]); y[10] = fmaf(wgt, a5.x, y[10]); y[11] = fmaf(wgt, a5.y, y[11]);
  y[12] = fmaf(wgt, a6.x, y[12]); y[13] = fmaf(wgt, a6.y, y[13]); y[14] = fmaf(wgt, a7.x, y[14]); y[15] = fmaf(wgt, a7.y, y[15]);
}

template <bool DRY>
__device__ __forceinline__ void ph_gather(const Params& p, int l, int bid, int nblk) {
  const int lane = tid_opaque() & 63, w = __builtin_amdgcn_readfirstlane(tid_opaque() >> 6);
  const unsigned char* u8 = p.ub8() + (size_t)l * 16384 * 1024;
  const unsigned char* v8 = p.vb8() + (size_t)l * 16384 * 1024;
  const unsigned loff = (unsigned)lane * 16u;
  for (int t = bid * 4 + w; t < NTOK; t += nblk * 4) {
    float xf[16];
    {
      const uint4 xa = *reinterpret_cast<const uint4*>(p.xn() + (size_t)t * 1024 + lane * 16);
      const uint4 xb = *reinterpret_cast<const uint4*>(p.xn() + (size_t)t * 1024 + lane * 16 + 8);
      xf[0] = bf_lo(xa.x); xf[1] = bf_hi(xa.x); xf[2] = bf_lo(xa.y); xf[3] = bf_hi(xa.y);
      xf[4] = bf_lo(xa.z); xf[5] = bf_hi(xa.z); xf[6] = bf_lo(xa.w); xf[7] = bf_hi(xa.w);
      xf[8] = bf_lo(xb.x); xf[9] = bf_hi(xb.x); xf[10] = bf_lo(xb.y); xf[11] = bf_hi(xb.y);
      xf[12] = bf_lo(xb.z); xf[13] = bf_hi(xb.z); xf[14] = bf_lo(xb.w); xf[15] = bf_hi(xb.w);
    }
    const int e_lo = p.eidx()[(size_t)t * 128 + lane], e_hi = p.eidx()[(size_t)t * 128 + 64 + lane];
    const float g_lo = p.egate()[(size_t)t * 128 + lane], g_hi = p.egate()[(size_t)t * 128 + 64 + lane];
    const float s_lo = p.esu()[(size_t)t * 128 + lane], s_hi = p.esu()[(size_t)t * 128 + 64 + lane];
    float y[16];
#pragma unroll
    for (int i = 0; i < 16; ++i) y[i] = 0.f;
#pragma unroll 1
    for (int k0 = 0; k0 < 128; k0 += 8) {
      uint4 ur[8], vr[8];
#pragma unroll
      for (int q = 0; q < 8; ++q) {
        const int kk = (k0 & 63) + q;
        const int e = (k0 < 64) ? __builtin_amdgcn_readlane(e_lo, kk) : __builtin_amdgcn_readlane(e_hi, kk);
        ur[q] = *reinterpret_cast<const uint4*>(u8 + (size_t)e * 1024 + loff);
        vr[q] = *reinterpret_cast<const uint4*>(v8 + (size_t)e * 1024 + loff);
      }
#pragma unroll
      for (int q = 0; q < 8; ++q) {
        const int kk = (k0 & 63) + q;
        const float gt = __int_as_float((k0 < 64) ? __builtin_amdgcn_readlane(__float_as_int(g_lo), kk) : __builtin_amdgcn_readlane(__float_as_int(g_hi), kk));
        const float su = __int_as_float((k0 < 64) ? __builtin_amdgcn_readlane(__float_as_int(s_lo), kk) : __builtin_amdgcn_readlane(__float_as_int(s_hi), kk));
        float d = wave_sum(dot16_fp8(xf, ur[q])) * su;
        const float wgt = gt * gelu_exact(d);
        axpy16_fp8(y, wgt, vr[q]);
      }
    }
    if (DRY) {
#pragma unroll
      for (int i = 0; i < 16; ++i) asm volatile("" ::"v"(y[i]));
      continue;
    }
    float* xr = p.x() + (size_t)t * 1024 + lane * 16;
#pragma unroll
    for (int j = 0; j < 4; ++j) {
      float4 a = reinterpret_cast<float4*>(xr)[j];
      a.x += y[4 * j]; a.y += y[4 * j + 1]; a.z += y[4 * j + 2]; a.w += y[4 * j + 3];
      reinterpret_cast<float4*>(xr)[j] = a;
    }
  }
}

enum { PH_PREP = 0, PH_NORM1, PH_GEMM_IN, PH_ATTN, PH_MLCONV, PH_MCHAIN, PH_MLU, PH_MLSCAN, PH_MLOUT, PH_CMLP,
       PH_GEMM_OUT, PH_NORM2, PH_GEMM_PQ, PH_GEMM_SC, PH_TOPK, PH_GATHER, PH_FINAL };

__device__ __forceinline__ Params phase_params(const Params& kp, bool with_inputs, bool with_tables = false) {
  Params q;
  size_t z = 0;
  asm volatile("" : "+s"(z));
  q.out = kp.out + z;
  q.ws = kp.ws + z;
  q.in[0] = kp.in[0] + z;
  q.in[1] = kp.in[1] + z;
  if (with_inputs) {
#pragma unroll
    for (int i = 2; i < 30; ++i) q.in[i] = kp.in[i] + z;
  }
  if (with_tables) { q.in[27] = kp.in[27] + z; q.in[28] = kp.in[28] + z; }
  return q;
}


#define GT 4
typedef __attribute__((ext_vector_type(4))) float f32x4;

__device__ __forceinline__ float dot16_fp8v(const f32x2* x2, uint4 u) {
  f32x2 acc = x2[0] * __builtin_amdgcn_cvt_pk_f32_fp8(u.x, false);
  acc += x2[1] * __builtin_amdgcn_cvt_pk_f32_fp8(u.x, true);
  acc += x2[2] * __builtin_amdgcn_cvt_pk_f32_fp8(u.y, false);
  acc += x2[3] * __builtin_amdgcn_cvt_pk_f32_fp8(u.y, true);
  acc += x2[4] * __builtin_amdgcn_cvt_pk_f32_fp8(u.z, false);
  acc += x2[5] * __builtin_amdgcn_cvt_pk_f32_fp8(u.z, true);
  acc += x2[6] * __builtin_amdgcn_cvt_pk_f32_fp8(u.w, false);
  acc += x2[7] * __builtin_amdgcn_cvt_pk_f32_fp8(u.w, true);
  return acc.x + acc.y;
}
__device__ __forceinline__ void axpy16_fp8v(f32x2* y2, float wgt, uint4 v) {
  const f32x2 w2 = {wgt, wgt};
  y2[0] += w2 * __builtin_amdgcn_cvt_pk_f32_fp8(v.x, false);
  y2[1] += w2 * __builtin_amdgcn_cvt_pk_f32_fp8(v.x, true);
  y2[2] += w2 * __builtin_amdgcn_cvt_pk_f32_fp8(v.y, false);
  y2[3] += w2 * __builtin_amdgcn_cvt_pk_f32_fp8(v.y, true);
  y2[4] += w2 * __builtin_amdgcn_cvt_pk_f32_fp8(v.z, false);
  y2[5] += w2 * __builtin_amdgcn_cvt_pk_f32_fp8(v.z, true);
  y2[6] += w2 * __builtin_amdgcn_cvt_pk_f32_fp8(v.w, false);
  y2[7] += w2 * __builtin_amdgcn_cvt_pk_f32_fp8(v.w, true);
}

struct GU { uint4 ur[4]; f32x4 su; };
struct GV { uint4 vr[4]; f32x4 gt; };
#define GREC 384
__device__ __forceinline__ void gload_u(GU& U, const float* rec, int i4, const unsigned char* u8, unsigned loff) {
  const f32x4 ev = *reinterpret_cast<const f32x4*>(rec + i4);
  U.su = *reinterpret_cast<const f32x4*>(rec + 256 + i4);
  const int e0 = __builtin_amdgcn_readfirstlane(__float_as_int(ev.x)), e1 = __builtin_amdgcn_readfirstlane(__float_as_int(ev.y));
  const int e2 = __builtin_amdgcn_readfirstlane(__float_as_int(ev.z)), e3 = __builtin_amdgcn_readfirstlane(__float_as_int(ev.w));
  U.ur[0] = *reinterpret_cast<const uint4*>(u8 + (size_t)e0 * 1024 + loff);
  U.ur[1] = *reinterpret_cast<const uint4*>(u8 + (size_t)e1 * 1024 + loff);
  U.ur[2] = *reinterpret_cast<const uint4*>(u8 + (size_t)e2 * 1024 + loff);
  U.ur[3] = *reinterpret_cast<const uint4*>(u8 + (size_t)e3 * 1024 + loff);
}
__device__ __forceinline__ void gload_v(GV& V, const float* rec, int i4, const unsigned char* v8, unsigned loff) {
  const f32x4 ev = *reinterpret_cast<const f32x4*>(rec + i4);
  V.gt = *reinterpret_cast<const f32x4*>(rec + 128 + i4);
  const int e0 = __builtin_amdgcn_readfirstlane(__float_as_int(ev.x)), e1 = __builtin_amdgcn_readfirstlane(__float_as_int(ev.y));
  const int e2 = __builtin_amdgcn_readfirstlane(__float_as_int(ev.z)), e3 = __builtin_amdgcn_readfirstlane(__float_as_int(ev.w));
  V.vr[0] = *reinterpret_cast<const uint4*>(v8 + (size_t)e0 * 1024 + loff);
  V.vr[1] = *reinterpret_cast<const uint4*>(v8 + (size_t)e1 * 1024 + loff);
  V.vr[2] = *reinterpret_cast<const uint4*>(v8 + (size_t)e2 * 1024 + loff);
  V.vr[3] = *reinterpret_cast<const uint4*>(v8 + (size_t)e3 * 1024 + loff);
}
__device__ __forceinline__ float gelu_as(float z) {
  const float x = fabsf(z) * 0.70710678118654752f;
  const float t = __builtin_amdgcn_rcpf(fmaf(0.3275911f, x, 1.f));
  float pl = fmaf(1.061405429f, t, -1.453152027f);
  pl = fmaf(pl, t, 1.421413741f); pl = fmaf(pl, t, -0.284496736f); pl = fmaf(pl, t, 0.254829592f);
  const float e = __builtin_amdgcn_exp2f(-x * x * LOG2E);
  const float erfa = 1.f - pl * t * e;
  return 0.5f * z + 0.5f * fabsf(z) * erfa;
}
template <int PAT>
__device__ __forceinline__ float swz_f(float v) { return __int_as_float(__builtin_amdgcn_ds_swizzle(__float_as_int(v), PAT)); }

__device__ __forceinline__ void gstep2(GU& UA, GV& VA, GU& UB, GV& VB, const uint4* xlA, const uint4* xlB, f32x2* yA, f32x2* yB,
                                       const float* recA, const float* recB, int ci4, const float* nxtA, const float* nxtB, int ni4,
                                       const unsigned char* u8, const unsigned char* v8, unsigned loff, int lane) {
  float d[8];
  {
    f32x2 x2[8];
    const uint4 xa = xlA[0], xb = xlA[1];
    x2[0] = f32x2{bf_lo(xa.x), bf_hi(xa.x)}; x2[1] = f32x2{bf_lo(xa.y), bf_hi(xa.y)};
    x2[2] = f32x2{bf_lo(xa.z), bf_hi(xa.z)}; x2[3] = f32x2{bf_lo(xa.w), bf_hi(xa.w)};
    x2[4] = f32x2{bf_lo(xb.x), bf_hi(xb.x)}; x2[5] = f32x2{bf_lo(xb.y), bf_hi(xb.y)};
    x2[6] = f32x2{bf_lo(xb.z), bf_hi(xb.z)}; x2[7] = f32x2{bf_lo(xb.w), bf_hi(xb.w)};
#pragma unroll
    for (int q = 0; q < 4; ++q) d[q] = dot16_fp8v(x2, UA.ur[q]);
  }
  gload_u(UA, nxtA, ni4, u8, loff);
  {
    f32x2 x2[8];
    const uint4 xa = xlB[0], xb = xlB[1];
    x2[0] = f32x2{bf_lo(xa.x), bf_hi(xa.x)}; x2[1] = f32x2{bf_lo(xa.y), bf_hi(xa.y)};
    x2[2] = f32x2{bf_lo(xa.z), bf_hi(xa.z)}; x2[3] = f32x2{bf_lo(xa.w), bf_hi(xa.w)};
    x2[4] = f32x2{bf_lo(xb.x), bf_hi(xb.x)}; x2[5] = f32x2{bf_lo(xb.y), bf_hi(xb.y)};
    x2[6] = f32x2{bf_lo(xb.z), bf_hi(xb.z)}; x2[7] = f32x2{bf_lo(xb.w), bf_hi(xb.w)};
#pragma unroll
    for (int q = 0; q < 4; ++q) d[4 + q] = dot16_fp8v(x2, UB.ur[q]);
  }
  gload_u(UB, nxtB, ni4, u8, loff);
  const bool b0 = lane & 1, b1 = lane & 2, b2 = lane & 4;
  float a[4];
#pragma unroll
  for (int j = 0; j < 4; ++j) {
    const float keep = b0 ? d[4 + j] : d[j], send = b0 ? d[j] : d[4 + j];
    a[j] = keep + dpp_f<0xB1>(send);
  }
  float c2[2];
#pragma unroll
  for (int j = 0; j < 2; ++j) {
    const float keep = b1 ? a[2 + j] : a[j], send = b1 ? a[j] : a[2 + j];
    c2[j] = keep + dpp_f<0x4E>(send);
  }
  float tot;
  {
    const float keep = b2 ? c2[1] : c2[0], send = b2 ? c2[0] : c2[1];
    tot = keep + swz_f<0x101F>(send);
  }
  tot += swz_f<0x201F>(tot);
  tot = swap32_sum(swap16_sum(tot));
  const int pq = ((lane >> 1) & 1) * 2 + ((lane >> 2) & 1);
  const float* rl = (b0 ? recB : recA) + ci4 + pq;
  const float z = tot * rl[256];
  const float wv = rl[128] * gelu_as(z);
#pragma unroll
  for (int q = 0; q < 4; ++q) {
    const int ln = ((q >> 1) & 1) * 2 + (q & 1) * 4;
    const float wa = __int_as_float(__builtin_amdgcn_readlane(__float_as_int(wv), ln));
    const float wb = __int_as_float(__builtin_amdgcn_readlane(__float_as_int(wv), ln + 1));
    axpy16_fp8v(yA, wa, VA.vr[q]);
    axpy16_fp8v(yB, wb, VB.vr[q]);
  }
  gload_v(VA, nxtA, ni4, v8, loff);
  gload_v(VB, nxtB, ni4, v8, loff);
}

__device__ __forceinline__ void gstep(GU& U, GV& V, const uint4* xl, f32x2* y2, const float* nrec, int ni4,
                                      const unsigned char* u8, const unsigned char* v8, unsigned loff, int lane) {
  f32x2 x2[8];
  {
    const uint4 xa = xl[0], xb = xl[1];
    x2[0] = f32x2{bf_lo(xa.x), bf_hi(xa.x)}; x2[1] = f32x2{bf_lo(xa.y), bf_hi(xa.y)};
    x2[2] = f32x2{bf_lo(xa.z), bf_hi(xa.z)}; x2[3] = f32x2{bf_lo(xa.w), bf_hi(xa.w)};
    x2[4] = f32x2{bf_lo(xb.x), bf_hi(xb.x)}; x2[5] = f32x2{bf_lo(xb.y), bf_hi(xb.y)};
    x2[6] = f32x2{bf_lo(xb.z), bf_hi(xb.z)}; x2[7] = f32x2{bf_lo(xb.w), bf_hi(xb.w)};
  }
  float d[4], su[4];
#pragma unroll
  for (int q = 0; q < 4; ++q) { d[q] = dot16_fp8v(x2, U.ur[q]); su[q] = U.su[q]; }
  gload_u(U, nrec, ni4, u8, loff);
#pragma unroll
  for (int q = 0; q < 4; ++q) d[q] = wave_sum(d[q]) * su[q];
  float dv = d[0]; dv = (lane == 1) ? d[1] : dv; dv = (lane == 2) ? d[2] : dv; dv = (lane == 3) ? d[3] : dv;
  const float av = gelu_as(dv);
#pragma unroll
  for (int q = 0; q < 4; ++q) {
    const float act = __int_as_float(__builtin_amdgcn_readlane(__float_as_int(av), q));
    axpy16_fp8v(y2, V.gt[q] * act, V.vr[q]);
  }
  gload_v(V, nrec, ni4, v8, loff);
}

__device__ __forceinline__ void gsort_token(const Params& p, int t, float* rec, int lane) {
  const int e0 = p.eidx()[(size_t)t * 128 + lane], e1 = p.eidx()[(size_t)t * 128 + 64 + lane];
  const float g0 = p.egate()[(size_t)t * 128 + lane], g1 = p.egate()[(size_t)t * 128 + 64 + lane];
  const float q0 = p.esu()[(size_t)t * 128 + lane], q1 = p.esu()[(size_t)t * 128 + 64 + lane];
  int base = 0;
#pragma unroll 4
  for (int s = 0; s < 16; ++s) {
    const unsigned long long m0 = __ballot((e0 >> 10) == s), m1 = __ballot((e1 >> 10) == s);
    const int c0 = __popcll(m0), c1 = __popcll(m1);
    const int p0 = base + (int)__builtin_amdgcn_mbcnt_hi((unsigned)(m0 >> 32), __builtin_amdgcn_mbcnt_lo((unsigned)m0, 0));
    const int p1 = base + c0 + (int)__builtin_amdgcn_mbcnt_hi((unsigned)(m1 >> 32), __builtin_amdgcn_mbcnt_lo((unsigned)m1, 0));
    if ((e0 >> 10) == s) { rec[p0] = __int_as_float(e0); rec[128 + p0] = g0; rec[256 + p0] = q0; }
    if ((e1 >> 10) == s) { rec[p1] = __int_as_float(e1); rec[128 + p1] = g1; rec[256 + p1] = q1; }
    base += c0 + c1;
  }
}
__device__ __forceinline__ void gload_x(const Params& p, int t, uint4* xl, int lane) {
  xl[0] = *reinterpret_cast<const uint4*>(p.xn() + (size_t)t * 1024 + lane * 16);
  xl[1] = *reinterpret_cast<const uint4*>(p.xn() + (size_t)t * 1024 + lane * 16 + 8);
}
template <bool LAST>
__device__ __forceinline__ void gstore_x(const Params& p, int l, int t, const f32x2* y2, int lane) {
  float* xr = p.x() + (size_t)t * 1024 + lane * 16;
  float4 a[4];
  float ss = 0.f;
#pragma unroll
  for (int j = 0; j < 4; ++j) {
    a[j] = reinterpret_cast<float4*>(xr)[j];
    a[j].x += y2[2 * j].x; a[j].y += y2[2 * j].y; a[j].z += y2[2 * j + 1].x; a[j].w += y2[2 * j + 1].y;
    ss += a[j].x * a[j].x + a[j].y * a[j].y + a[j].z * a[j].z + a[j].w * a[j].w;
  }
  ss = wave_sum(ss);
  const float r = rsqrtf(ss * (1.f / 1024.f) + EPS);
  if (LAST) {
    const float* g = p.final_g() + lane * 16;
    float* o = ((t < NPROMPT) ? p.out + O_Y_P + (size_t)t * 1024 : p.out + O_Y_S + (size_t)(t - NPROMPT) * 1024) + lane * 16;
#pragma unroll
    for (int j = 0; j < 4; ++j) {
      const float4 gv = reinterpret_cast<const float4*>(g)[j];
      reinterpret_cast<float4*>(o)[j] = make_float4(a[j].x * r * gv.x, a[j].y * r * gv.y, a[j].z * r * gv.z, a[j].w * r * gv.w);
    }
  } else {
    const float* g = p.norm1_g() + (l + 1) * 1024 + lane * 16;
#pragma unroll
    for (int j = 0; j < 4; ++j) {
      reinterpret_cast<float4*>(xr)[j] = a[j];
      const float4 gv = reinterpret_cast<const float4*>(g)[j];
      a[j].x *= r * gv.x; a[j].y *= r * gv.y; a[j].z *= r * gv.z; a[j].w *= r * gv.w;
    }
    uint4* o = reinterpret_cast<uint4*>(p.xn() + (size_t)t * 1024 + lane * 16);
    o[0] = make_uint4(pack2(a[0].x, a[0].y), pack2(a[0].z, a[0].w), pack2(a[1].x, a[1].y), pack2(a[1].z, a[1].w));
    o[1] = make_uint4(pack2(a[2].x, a[2].y), pack2(a[2].z, a[2].w), pack2(a[3].x, a[3].y), pack2(a[3].z, a[3].w));
    float pre[8];
#pragma unroll
    for (int i = 0; i < 8; ++i) {
      const float4* wr = reinterpret_cast<const float4*>(p.wg() + ((size_t)(l + 1) * 8 + i) * 1024 + lane * 16);
      float s = 0.f;
#pragma unroll
      for (int j = 0; j < 4; ++j) {
        const float4 wv = wr[j];
        s += a[j].x * wv.x + a[j].y * wv.y + a[j].z * wv.z + a[j].w * wv.w;
      }
      pre[i] = wave_sum(s);
    }
    if (lane < 4) {
      float ai = pre[0]; ai = lane == 1 ? pre[1] : ai; ai = lane == 2 ? pre[2] : ai; ai = lane == 3 ? pre[3] : ai;
      float f = pre[4]; f = lane == 1 ? pre[5] : f; f = lane == 2 ? pre[6] : f; f = lane == 3 ? pre[7] : f;
      p.ig()[(size_t)t * 4 + lane] = ai + p.ml_gate_b()[(l + 1) * 8 + lane];
      const float z = f + p.ml_gate_b()[(l + 1) * 8 + 4 + lane];
      p.lf()[(size_t)t * 4 + lane] = fminf(z, 0.f) - log1pf(expf(-fabsf(z)));
    }
  }
}

template <bool LAST>
__device__ __forceinline__ void ph_gather2(const Params& p, int l, char* smem, int bid, int nblk) {
  const int tid = tid_opaque(), lane = tid & 63, w = __builtin_amdgcn_readfirstlane(tid >> 6);
  const unsigned char* u8 = p.ub8() + (size_t)l * 16384 * 1024;
  const unsigned char* v8 = p.vb8() + (size_t)l * 16384 * 1024;
  const unsigned loff = (unsigned)lane * 16u;
  float* rec = reinterpret_cast<float*>(smem) + w * (GT * GREC);
  uint4* xl = reinterpret_cast<uint4*>(smem + 4 * GT * GREC * 4) + (w * GT * 64 + lane) * 2;
  const int rot = (bid & 7) * 4;
  const int nwaves = nblk * 4, wg = bid * 4 + w;
  const int nfull = (NTOK / (nwaves * GT)) * nwaves;
  for (int grp = wg; grp < nfull; grp += nwaves) {
    const int t0 = grp * GT;
    int lane_s = lane; asm volatile("" : "+v"(lane_s));
#pragma unroll 1
    for (int ti = 0; ti < GT; ++ti) {
      gload_x(p, t0 + ti, xl + ti * 128, lane_s);
      gsort_token(p, t0 + ti, rec + ti * GREC, lane_s);
    }
    f32x2 y2[GT][8];
#pragma unroll
    for (int ti = 0; ti < GT; ++ti)
#pragma unroll
      for (int i = 0; i < 8; ++i) y2[ti][i] = f32x2{0.f, 0.f};
    GU U0, U1; GV V0, V1;
    gload_u(U0, rec, (rot & 31) * 4, u8, loff); gload_v(V0, rec, (rot & 31) * 4, v8, loff);
    gload_u(U1, rec + GREC, (rot & 31) * 4, u8, loff); gload_v(V1, rec + GREC, (rot & 31) * 4, v8, loff);
#pragma unroll 1
    for (int b = 0; b < 32; ++b) {
      const int bo = ((b + rot) & 31) * 4, bn = ((b + 1 + rot) & 31) * 4;
      gstep2(U0, V0, U1, V1, xl, xl + 128, y2[0], y2[1], rec, rec + GREC, bo, rec + 2 * GREC, rec + 3 * GREC, bo, u8, v8, loff, lane);
      __builtin_amdgcn_sched_barrier(0);
      gstep2(U0, V0, U1, V1, xl + 256, xl + 384, y2[2], y2[3], rec + 2 * GREC, rec + 3 * GREC, bo, rec, rec + GREC, bn, u8, v8, loff, lane);
      __builtin_amdgcn_sched_barrier(0);
    }
    int lane_e = lane; asm volatile("" : "+v"(lane_e));
#pragma unroll
    for (int ti = 0; ti < GT; ++ti) gstore_x<LAST>(p, l, t0 + ti, y2[ti], lane_e);
  }
  float* ysum = reinterpret_cast<float*>(smem + 4 * GT * GREC * 4 + 4 * GT * 2048);
  for (int t = nfull * GT + bid; t < NTOK; t += nblk) {
    f32x2 y2[8];
    gload_x(p, t, xl, lane);
#pragma unroll
    for (int i = 0; i < 8; ++i) y2[i] = f32x2{0.f, 0.f};
    gsort_token(p, t, rec, lane);
    GU U; GV V;
    gload_u(U, rec, (w * 8) * 4, u8, loff);
    gload_v(V, rec, (w * 8) * 4, v8, loff);
#pragma unroll 1
    for (int b = 0; b < 8; ++b) gstep(U, V, xl, y2, rec, (w * 8 + ((b + 1) & 7)) * 4, u8, v8, loff, lane);
    __syncthreads();
#pragma unroll
    for (int i = 0; i < 8; ++i) { ysum[w * 1024 + lane * 16 + 2 * i] = y2[i].x; ysum[w * 1024 + lane * 16 + 2 * i + 1] = y2[i].y; }
    __syncthreads();
    if (w == 0) {
#pragma unroll
      for (int i = 0; i < 8; ++i) {
        y2[i].x += ysum[1024 + lane * 16 + 2 * i] + ysum[2048 + lane * 16 + 2 * i] + ysum[3072 + lane * 16 + 2 * i];
        y2[i].y += ysum[1024 + lane * 16 + 2 * i + 1] + ysum[2048 + lane * 16 + 2 * i + 1] + ysum[3072 + lane * 16 + 2 * i + 1];
      }
      gstore_x<LAST>(p, l, t, y2, lane);
    }
  }
}

#define XB_TMO      128
#define XB_XCNT(j)  (256  + 64 * (j))
#define XB_XSUB(j)  (1280 + 64 * (j))
#define XB_XGEN(j)  (2304 + 64 * (j))
#define XB_TOP      3328
#define XB_TOPGEN   3392
#define XCD_BAR_WORDS 3456
#define XB_SPIN_CAP (1u << 22)
__device__ __forceinline__ unsigned xb_ld(unsigned* p)              { return __hip_atomic_load(p, __ATOMIC_RELAXED, __HIP_MEMORY_SCOPE_AGENT); }
__device__ __forceinline__ unsigned xb_add(unsigned* p, unsigned v) { return __hip_atomic_fetch_add(p, v, __ATOMIC_RELAXED, __HIP_MEMORY_SCOPE_AGENT); }
__device__ __forceinline__ unsigned xb_xcc_id() { return (unsigned)__builtin_amdgcn_s_getreg((3 << 11) | 20) & 0xFu; }
#define XB_SPIN(cond, bar) do { unsigned _sp = 0; while (cond) { __builtin_amdgcn_s_sleep(1); \
    if ((++_sp & 255u) == 0u) { if (xb_ld(&(bar)[XB_TMO])) break; if (_sp > XB_SPIN_CAP) { atomicAdd(&(bar)[XB_TMO], 1u); break; } } } } while (0)

struct XcdBarrier { unsigned* bar; unsigned x; volatile LAS unsigned* st; };

__device__ __forceinline__ XcdBarrier xcd_barrier_post(unsigned* bar, volatile LAS unsigned* st) {
  XcdBarrier b; b.bar = bar; b.x = xb_xcc_id(); b.st = st;
  if (threadIdx.x == 0) (void)xb_add(&bar[XB_XCNT(b.x)], 1u);
  return b;
}
__device__ __forceinline__ void xcd_barrier_complete(unsigned* bar, unsigned x, unsigned& nloc, unsigned& nx) {
  const unsigned G = gridDim.x * gridDim.y * gridDim.z;
  unsigned sum, cnt, mine, sp = 0u;
  for (;;) {
    sum = 0u; cnt = 0u; mine = 0u;
#pragma unroll
    for (unsigned j = 0; j < 16; ++j) { const unsigned c = xb_ld(&bar[XB_XCNT(j)]); sum += c; cnt += (c > 0u) ? 1u : 0u; mine = (j == x) ? c : mine; }
    if (sum == G) break;
    __builtin_amdgcn_s_sleep(1);
    if ((++sp & 255u) == 0u) { if (xb_ld(&bar[XB_TMO])) break; if (sp > XB_SPIN_CAP) { atomicAdd(&bar[XB_TMO], 1u); break; } }
  }
  nloc = mine > 0u ? mine : 1u; nx = cnt > 0u ? cnt : 1u;
}
__device__ __forceinline__ void xcd_barrier(const XcdBarrier& b) {
  asm volatile("s_waitcnt vmcnt(0)" ::: "memory");
  __syncthreads();
  if (threadIdx.x == 0) {
    unsigned* bar = b.bar;
    __builtin_amdgcn_s_waitcnt(0);
    unsigned nloc = b.st[0], nx = b.st[1];
    if (nloc == 0u) { xcd_barrier_complete(bar, b.x, nloc, nx); b.st[0] = nloc; b.st[1] = nx; }
    const unsigned old = xb_add(&bar[XB_XSUB(b.x)], 1u);
    const unsigned gen = old / nloc;
    if (old + 1u == (gen + 1u) * nloc) {
      __builtin_amdgcn_fence(__ATOMIC_RELEASE, "agent");
      asm volatile("s_waitcnt vmcnt(0)" ::: "memory");
      const unsigned og = xb_add(&bar[XB_TOP], 1u);
      const unsigned tg = og / nx;
      if (og + 1u == (tg + 1u) * nx) xb_add(&bar[XB_TOPGEN], 1u);
      else XB_SPIN(xb_ld(&bar[XB_TOPGEN]) == tg, bar);
      __builtin_amdgcn_fence(__ATOMIC_ACQUIRE, "agent");
      xb_add(&bar[XB_XGEN(b.x)], 1u);
      asm volatile("s_waitcnt vmcnt(0)" ::: "memory");
    } else {
      XB_SPIN(xb_ld(&bar[XB_XGEN(b.x)]) == gen, bar);
      __builtin_amdgcn_fence(__ATOMIC_ACQUIRE, "agent");
      asm volatile("s_waitcnt vmcnt(0)" ::: "memory");
    }
  }
  __syncthreads();
}

#define GSYNC() xcd_barrier(xb)
#define PP(wi) phase_params(p, wi)
#define BN bid_opaque(bid), nblk_opaque(nblk)

template <int L>
__device__ __forceinline__ void layer_phases(const Params& p, char* smem, const XcdBarrier& xb, int bid, int nblk) {
  if (L == 0) {
  ph_rmsnorm<0>(PP(false), L, BN);
#if PROBE == 11
  GSYNC();
  ph_rmsnorm<0>(PP(false), L, BN);
#endif
  GSYNC();
  }
  ph_gemm<EPI_WIN>(PP(false), L, smem, BN);
#if PROBE == 1
  GSYNC();
  ph_gemm<EPI_WIN>(PP(false), L, smem, BN);
#endif
  GSYNC();
  {
    const Params q = PP(false);
    WorkQ wq; wq.cnt = reinterpret_cast<unsigned*>(q.ws) + 8 + L; wq.slot = reinterpret_cast<volatile int*>(smem + SMEM_BYTES - 8); wq.off = 0;
    int item = ph_attn<(L == 0)>(phase_params(p, false, L == 0), L, smem, wq);
    wq.off = (L == 0) ? 528 : 0;
    item = ph_mlconv(PP(false), L, smem, wq, item);
    ph_cmlp(PP(false), L, smem, wq, item);
  }
  GSYNC();
  ph_mlU(PP(false), L, smem, BN);
#if PROBE == 9 || PROBE == 20
  GSYNC();
  ph_mlU(PP(false), L, smem, BN);
#endif
  GSYNC();
  ph_mlscan(PP(false), L, BN);
#if PROBE == 10 || PROBE == 20
  GSYNC();
  ph_mlscan(PP(false), L, BN);
#endif
  GSYNC();
  ph_mlout(PP(false), L, smem, BN);
#if PROBE == 6 || PROBE == 20
  GSYNC();
  ph_mlout(PP(false), L, smem, BN);
#endif
  GSYNC();
  ph_gemm<EPI_WOUT>(PP(false), L, smem, BN);
  GSYNC();
  ph_rmsnorm<1>(PP(false), L, BN);
  GSYNC();
  ph_gemm<EPI_PQ>(PP(false), L, smem, BN);
#if PROBE == 2
  GSYNC();
  ph_gemm<EPI_PQ>(PP(false), L, smem, BN);
#endif
  GSYNC();
  ph_topk(PP(false), L, smem, BN);
#if PROBE == 5
  GSYNC();
  ph_topk(PP(false), L, smem, BN);
#endif
  GSYNC();
  ph_gather2<(L == 1)>(PP(false), L, smem, BN);
  GSYNC();
}

__global__ void __launch_bounds__(256, 2) mega_kernel(Params p) {
  __shared__ __attribute__((aligned(16))) char smem[SMEM_BYTES];
  __shared__ uint4 xb_words;
  cg::grid_group grid = cg::this_grid();
  const int bid = blockIdx.x, nblk = gridDim.x;
  if (threadIdx.x == 0) xb_words = make_uint4(0u, 0u, 0u, 0u);
  __syncthreads();
  XcdBarrier xb = xcd_barrier_post(reinterpret_cast<unsigned*>(p.ws), (volatile LAS unsigned*)&xb_words);
  grid.sync();
  ph_prep(PP(true), smem, BN);
#if PROBE == 12
  GSYNC();
  ph_prep(PP(true), smem, BN);
#endif
  GSYNC();
  layer_phases<0>(p, smem, xb, bid, nblk);
  layer_phases<1>(p, smem, xb, bid, nblk);
}

static inline size_t align_up(size_t v, size_t a) { return (v + a - 1) / a * a; }

extern "C" void kernel_launch(void* const* d_in, const int* in_sizes, int n_in, void* d_out, int out_size, void* d_ws,
                              size_t ws_size, hipStream_t stream) {
  Params p{};
  for (int i = 0; i < 30; ++i) p.in[i] = reinterpret_cast<const float*>(d_in[i]);
  p.out = reinterpret_cast<float*>(d_out);
  p.ws = reinterpret_cast<char*>(d_ws);
  if (WS_NEED > ws_size) { fprintf(stderr, "workspace too small: need %zu have %zu\n", (size_t)WS_NEED, ws_size); return; }
  static int grid_blocks = 0;
  if (!grid_blocks) {
    int dev = 0, cus = 0, per_cu = 0;
    hipGetDevice(&dev);
    hipDeviceGetAttribute(&cus, hipDeviceAttributeMultiprocessorCount, dev);
    hipOccupancyMaxActiveBlocksPerMultiprocessor(&per_cu, mega_kernel, 256, 0);
    if (per_cu > 2) per_cu = 2;
    if (per_cu < 1) per_cu = 1;
    grid_blocks = cus * per_cu;
  }
  hipMemsetAsync(d_ws, 0, 16384, stream);
  void* args[] = {&p};
  hipError_t e = hipLaunchCooperativeKernel((void*)mega_kernel, dim3(grid_blocks), dim3(256), args, 0, stream);
  if (e != hipSuccess) fprintf(stderr, "cooperative launch failed: %s (grid %d)\n", hipGetErrorString(e), grid_blocks);
}
```

```cpp
#include <hip/hip_runtime.h>
#include <hip/hip_cooperative_groups.h>
#include <cstdio>
#include <cstdint>

namespace cg = cooperative_groups;

typedef unsigned short bf16_t;
typedef __attribute__((ext_vector_type(8))) __bf16 bf16x8;
typedef __attribute__((ext_vector_type(2))) __bf16 bf16x2;
typedef __attribute__((ext_vector_type(16))) float f32x16;
typedef __attribute__((ext_vector_type(2))) float f32x2;

#define D_MODEL 1024
#define NTOK 16896
#define NPROMPT 16384
#define SEQ 4096
#define NIN 2816
#define EPS 1e-6f
#define LOG2E 1.4426950408889634f
#define SKEYS 1088
#define NCU_UNITS 1056

constexpr size_t O_Y_P = 0;
constexpr size_t O_Y_S = O_Y_P + 16777216;
constexpr size_t O_K_P = O_Y_S + 524288;
constexpr size_t O_V_P = O_K_P + 16777216;
constexpr size_t O_C_P = O_V_P + 16777216;
constexpr size_t O_N_P = O_C_P + 131072;
constexpr size_t O_M_P = O_N_P + 2048;
constexpr size_t O_CONV_P = O_M_P + 32;
constexpr size_t O_K_S = O_CONV_P + 6144;
constexpr size_t O_V_S = O_K_S + 524288;
constexpr size_t O_C_S = O_V_S + 524288;
constexpr size_t O_N_S = O_C_S + 262144;
constexpr size_t O_M_S = O_N_S + 4096;
constexpr size_t O_CONV_S = O_M_S + 64;
constexpr size_t O_CMV_S = O_CONV_S + 12288;

constexpr size_t al256(size_t v) { return (v + 255) / 256 * 256; }
constexpr int SP_st_c = 0;
constexpr int SP_st_n = 262144;
constexpr int SP_st_m = 266240;
constexpr int SP_st_conv = 266304;
constexpr int SP_norm1_g = 278592;
constexpr int SP_da_subln_g = 280640;
constexpr int SP_ml_conv_w = 280896;
constexpr int SP_ml_conv_b = 282944;
constexpr int SP_ml_wq = 283456;
constexpr int SP_ml_wk = 316224;
constexpr int SP_ml_gate_b = 348992;
constexpr int SP_ml_norm_g = 349056;
constexpr int SP_ml_skip = 349568;
constexpr int SP_cm_norm_g = 350080;
constexpr int SP_cm_ws = 350592;
constexpr int SP_cm_b = 481664;
constexpr int SP_norm2_g = 482688;
constexpr int SP_final_g = 484736;
constexpr int SP_TOTAL = 485760;
constexpr size_t WS_bar = 0;
constexpr size_t WS_lam = al256(WS_bar + 16384);
constexpr size_t WS_lut = al256(WS_lam + (256));
constexpr size_t WS_sp = al256(WS_lut + (4*256*4));
constexpr size_t WS_wt_in = al256(WS_sp + (SP_TOTAL*4));
constexpr size_t WS_wg = al256(WS_wt_in + ((size_t)2*NIN*1024*2));
constexpr size_t WS_wt_out = al256(WS_wg + ((size_t)2*8*1024*4));
constexpr size_t WS_wt_pq = al256(WS_wt_out + ((size_t)2*1024*1024*2));
constexpr size_t WS_keysb = al256(WS_wt_pq + ((size_t)2*2048*1024*2));
constexpr size_t WS_ub8 = al256(WS_keysb + ((size_t)2*16*128*128*2));
constexpr size_t WS_vb8 = al256(WS_ub8 + ((size_t)2*16384*1024));
constexpr size_t WS_us = al256(WS_vb8 + ((size_t)2*16384*1024));
constexpr size_t WS_vs = al256(WS_us + ((size_t)2*16384*4));
constexpr size_t WS_Kbs = al256(WS_vs + ((size_t)2*16384*4));
constexpr size_t WS_Vts = al256(WS_Kbs + ((size_t)2*8*SKEYS*512*2));
constexpr size_t WS_x = al256(WS_Vts + ((size_t)2*8*4*128*SKEYS*2));
constexpr size_t WS_xn = al256(WS_x + ((size_t)NTOK*1024*4));
constexpr size_t WS_R0 = al256(WS_xn + ((size_t)NTOK*1024*2));
constexpr size_t WS_R0x = WS_R0;
constexpr size_t WS_Qb = al256(WS_R0x + (0));
constexpr size_t WS_Kb = al256(WS_Qb + ((size_t)NTOK*512*2));
constexpr size_t WS_Vt = al256(WS_Kb + ((size_t)NPROMPT*512*2));
constexpr size_t WS_P5 = al256(WS_Vt + ((size_t)16*128*SEQ*2));
constexpr size_t WS_ig = al256(WS_P5 + ((size_t)NTOK*1280*4));
constexpr size_t WS_lf = al256(WS_ig + ((size_t)NTOK*4*4));
constexpr size_t WS_Fc = al256(WS_lf + ((size_t)NTOK*4*4));
constexpr size_t WS_cc = al256(WS_Fc + ((size_t)NTOK*4*4));
constexpr size_t WS_qm = al256(WS_cc + ((size_t)NTOK*256*4));
constexpr size_t WS_km = al256(WS_qm + ((size_t)NTOK*256*4));
constexpr size_t WS_mst = al256(WS_km + ((size_t)NTOK*256*4));
constexpr size_t WS_mnx = al256(WS_mst + (NCU_UNITS*4));
constexpr size_t WS_wcs = al256(WS_mnx + (NCU_UNITS*4));
constexpr size_t WS_FLs = al256(WS_wcs + (NCU_UNITS*4));
constexpr size_t WS_mxt = al256(WS_FLs + (NCU_UNITS*4));
constexpr size_t WS_U = al256(WS_mxt + (NCU_UNITS*4));
constexpr size_t WS_un = al256(WS_U + ((size_t)NCU_UNITS*4096*4));
constexpr size_t WS_Cst = al256(WS_un + ((size_t)NCU_UNITS*64*4));
constexpr size_t WS_nst = al256(WS_Cst + ((size_t)NCU_UNITS*4096*4));
constexpr size_t WS_END_MIXER = al256(WS_nst + ((size_t)NCU_UNITS*64*4));
constexpr size_t WS_qp = al256(WS_R0x + (0));
constexpr size_t WS_sc = al256(WS_qp + ((size_t)NTOK*2048*2));
constexpr size_t WS_eidx = al256(WS_sc + ((size_t)NTOK*2048*4));
constexpr size_t WS_egate = al256(WS_eidx + ((size_t)NTOK*128*4));
constexpr size_t WS_esu = al256(WS_egate + ((size_t)NTOK*128*4));
constexpr size_t WS_ssp = al256(WS_esu + ((size_t)NTOK*128*4));
constexpr size_t WS_END_PEER = al256(WS_ssp + ((size_t)NTOK*32*4));
constexpr size_t WS_NEED = WS_END_MIXER > WS_END_PEER ? WS_END_MIXER : WS_END_PEER;

struct Params {
  const float* in[30];
  float* out;
  char* ws;
  __device__ __forceinline__ const float* x_prompt() const { return in[0]; }
  __device__ __forceinline__ const float* x_sample() const { return in[1]; }
  __device__ __forceinline__ const float* cache_k() const { return in[2]; }
  __device__ __forceinline__ const float* cache_v() const { return in[3]; }
  __device__ __forceinline__ const float* w_in() const { return in[9]; }
  __device__ __forceinline__ const float* da_lambda() const { return in[10]; }
  __device__ __forceinline__ const float* rel_table() const { return in[12]; }
  __device__ __forceinline__ const float* w_out() const { return in[23]; }
  __device__ __forceinline__ const float* peer_wq() const { return in[25]; }
  __device__ __forceinline__ const float* peer_keys() const { return in[26]; }
  __device__ __forceinline__ const float* peer_u() const { return in[27]; }
  __device__ __forceinline__ const float* peer_v() const { return in[28]; }
  __device__ __forceinline__ const float* st_c() const { return reinterpret_cast<const float*>(ws + WS_sp) + SP_st_c; }
  __device__ __forceinline__ const float* st_n() const { return reinterpret_cast<const float*>(ws + WS_sp) + SP_st_n; }
  __device__ __forceinline__ const float* st_m() const { return reinterpret_cast<const float*>(ws + WS_sp) + SP_st_m; }
  __device__ __forceinline__ const float* st_conv() const { return reinterpret_cast<const float*>(ws + WS_sp) + SP_st_conv; }
  __device__ __forceinline__ const float* norm1_g() const { return reinterpret_cast<const float*>(ws + WS_sp) + SP_norm1_g; }
  __device__ __forceinline__ const float* da_subln_g() const { return reinterpret_cast<const float*>(ws + WS_sp) + SP_da_subln_g; }
  __device__ __forceinline__ const float* ml_conv_w() const { return reinterpret_cast<const float*>(ws + WS_sp) + SP_ml_conv_w; }
  __device__ __forceinline__ const float* ml_conv_b() const { return reinterpret_cast<const float*>(ws + WS_sp) + SP_ml_conv_b; }
  __device__ __forceinline__ const float* ml_wq() const { return reinterpret_cast<const float*>(ws + WS_sp) + SP_ml_wq; }
  __device__ __forceinline__ const float* ml_wk() const { return reinterpret_cast<const float*>(ws + WS_sp) + SP_ml_wk; }
  __device__ __forceinline__ const float* ml_gate_b() const { return reinterpret_cast<const float*>(ws + WS_sp) + SP_ml_gate_b; }
  __device__ __forceinline__ const float* ml_norm_g() const { return reinterpret_cast<const float*>(ws + WS_sp) + SP_ml_norm_g; }
  __device__ __forceinline__ const float* ml_skip() const { return reinterpret_cast<const float*>(ws + WS_sp) + SP_ml_skip; }
  __device__ __forceinline__ const float* cm_norm_g() const { return reinterpret_cast<const float*>(ws + WS_sp) + SP_cm_norm_g; }
  __device__ __forceinline__ const float* cm_ws() const { return reinterpret_cast<const float*>(ws + WS_sp) + SP_cm_ws; }
  __device__ __forceinline__ const float* cm_b() const { return reinterpret_cast<const float*>(ws + WS_sp) + SP_cm_b; }
  __device__ __forceinline__ const float* norm2_g() const { return reinterpret_cast<const float*>(ws + WS_sp) + SP_norm2_g; }
  __device__ __forceinline__ const float* final_g() const { return reinterpret_cast<const float*>(ws + WS_sp) + SP_final_g; }
  __device__ __forceinline__ float* lam() const { return reinterpret_cast<float*>(ws + WS_lam); }
  __device__ __forceinline__ float* lut() const { return reinterpret_cast<float*>(ws + WS_lut); }
  __device__ __forceinline__ float* sp() const { return reinterpret_cast<float*>(ws + WS_sp); }
  __device__ __forceinline__ bf16_t* wt_in() const { return reinterpret_cast<bf16_t*>(ws + WS_wt_in); }
  __device__ __forceinline__ float* wg() const { return reinterpret_cast<float*>(ws + WS_wg); }
  __device__ __forceinline__ bf16_t* wt_out() const { return reinterpret_cast<bf16_t*>(ws + WS_wt_out); }
  __device__ __forceinline__ bf16_t* wt_pq() const { return reinterpret_cast<bf16_t*>(ws + WS_wt_pq); }
  __device__ __forceinline__ bf16_t* keysb() const { return reinterpret_cast<bf16_t*>(ws + WS_keysb); }
  __device__ __forceinline__ unsigned char* ub8() const { return reinterpret_cast<unsigned char*>(ws + WS_ub8); }
  __device__ __forceinline__ unsigned char* vb8() const { return reinterpret_cast<unsigned char*>(ws + WS_vb8); }
  __device__ __forceinline__ float* us() const { return reinterpret_cast<float*>(ws + WS_us); }
  __device__ __forceinline__ float* vs() const { return reinterpret_cast<float*>(ws + WS_vs); }
  __device__ __forceinline__ bf16_t* Kbs() const { return reinterpret_cast<bf16_t*>(ws + WS_Kbs); }
  __device__ __forceinline__ bf16_t* Vts() const { return reinterpret_cast<bf16_t*>(ws + WS_Vts); }
  __device__ __forceinline__ float* x() const { return reinterpret_cast<float*>(ws + WS_x); }
  __device__ __forceinline__ bf16_t* xn() const { return reinterpret_cast<bf16_t*>(ws + WS_xn); }
  __device__ __forceinline__ bf16_t* Qb() const { return reinterpret_cast<bf16_t*>(ws + WS_Qb); }
  __device__ __forceinline__ bf16_t* Kb() const { return reinterpret_cast<bf16_t*>(ws + WS_Kb); }
  __device__ __forceinline__ bf16_t* Vt() const { return reinterpret_cast<bf16_t*>(ws + WS_Vt); }
  __device__ __forceinline__ float* P5() const { return reinterpret_cast<float*>(ws + WS_P5); }
  __device__ __forceinline__ float* ig() const { return reinterpret_cast<float*>(ws + WS_ig); }
  __device__ __forceinline__ float* lf() const { return reinterpret_cast<float*>(ws + WS_lf); }
  __device__ __forceinline__ float* Fc() const { return reinterpret_cast<float*>(ws + WS_Fc); }
  __device__ __forceinline__ float* cc() const { return reinterpret_cast<float*>(ws + WS_cc); }
  __device__ __forceinline__ float* qm() const { return reinterpret_cast<float*>(ws + WS_qm); }
  __device__ __forceinline__ float* km() const { return reinterpret_cast<float*>(ws + WS_km); }
  __device__ __forceinline__ float* mst() const { return reinterpret_cast<float*>(ws + WS_mst); }
  __device__ __forceinline__ float* mnx() const { return reinterpret_cast<float*>(ws + WS_mnx); }
  __device__ __forceinline__ float* wcs() const { return reinterpret_cast<float*>(ws + WS_wcs); }
  __device__ __forceinline__ float* FLs() const { return reinterpret_cast<float*>(ws + WS_FLs); }
  __device__ __forceinline__ float* mxt() const { return reinterpret_cast<float*>(ws + WS_mxt); }
  __device__ __forceinline__ float* U() const { return reinterpret_cast<float*>(ws + WS_U); }
  __device__ __forceinline__ float* un() const { return reinterpret_cast<float*>(ws + WS_un); }
  __device__ __forceinline__ float* Cst() const { return reinterpret_cast<float*>(ws + WS_Cst); }
  __device__ __forceinline__ float* nst() const { return reinterpret_cast<float*>(ws + WS_nst); }
  __device__ __forceinline__ bf16_t* qp() const { return reinterpret_cast<bf16_t*>(ws + WS_qp); }
  __device__ __forceinline__ float* sc() const { return reinterpret_cast<float*>(ws + WS_sc); }
  __device__ __forceinline__ int* eidx() const { return reinterpret_cast<int*>(ws + WS_eidx); }
  __device__ __forceinline__ float* egate() const { return reinterpret_cast<float*>(ws + WS_egate); }
  __device__ __forceinline__ float* esu() const { return reinterpret_cast<float*>(ws + WS_esu); }
  __device__ __forceinline__ float* ssp() const { return reinterpret_cast<float*>(ws + WS_ssp); }
  __device__ __forceinline__ int* tl() const { return reinterpret_cast<int*>(ws + WS_sc); }
};

__device__ __forceinline__ unsigned pack2(float a, float b) {
  f32x2 v = {a, b};
  bf16x2 r = __builtin_convertvector(v, bf16x2);
  return *reinterpret_cast<unsigned*>(&r);
}
__device__ __forceinline__ bf16_t f2bf(float a) { return (bf16_t)(pack2(a, 0.f) & 0xFFFFu); }
__device__ __forceinline__ float bf_lo(unsigned u) { return __uint_as_float(u << 16); }
__device__ __forceinline__ float bf_hi(unsigned u) { return __uint_as_float(u & 0xFFFF0000u); }
__device__ __forceinline__ float gelu_exact(float x) { return 0.5f * x * (1.f + erff(x * 0.70710678118654752f)); }
__device__ __forceinline__ float sigmoidf_(float x) { return 1.f / (1.f + __expf(-x)); }
__device__ __forceinline__ float shfl_up_l(float v, int d, int lane) {
  const int src = lane >= d ? lane - d : lane;
  return __int_as_float(__builtin_amdgcn_ds_bpermute(src << 2, __float_as_int(v)));
}
template <int CTRL>
__device__ __forceinline__ float dpp_f(float v) {
  return __builtin_bit_cast(float, __builtin_amdgcn_update_dpp(0, __builtin_bit_cast(int, v), CTRL, 0xf, 0xf, true));
}
__device__ __forceinline__ float swap16_sum(float x) {
  auto s = __builtin_amdgcn_permlane16_swap(__float_as_uint(x), __float_as_uint(x), false, false);
  return __uint_as_float(s[0]) + __uint_as_float(s[1]);
}
__device__ __forceinline__ float swap32_sum(float x) {
  auto s = __builtin_amdgcn_permlane32_swap(__float_as_uint(x), __float_as_uint(x), false, false);
  return __uint_as_float(s[0]) + __uint_as_float(s[1]);
}
__device__ __forceinline__ float swap16_max(float x) {
  auto s = __builtin_amdgcn_permlane16_swap(__float_as_uint(x), __float_as_uint(x), false, false);
  return fmaxf(__uint_as_float(s[0]), __uint_as_float(s[1]));
}
__device__ __forceinline__ float swap32_max(float x) {
  auto s = __builtin_amdgcn_permlane32_swap(__float_as_uint(x), __float_as_uint(x), false, false);
  return fmaxf(__uint_as_float(s[0]), __uint_as_float(s[1]));
}
__device__ __forceinline__ float row16_sum(float v) {
  v += dpp_f<0xB1>(v); v += dpp_f<0x4E>(v); v += dpp_f<0x141>(v); v += dpp_f<0x140>(v);
  return v;
}
__device__ __forceinline__ float row16_max(float v) {
  v = fmaxf(v, dpp_f<0xB1>(v)); v = fmaxf(v, dpp_f<0x4E>(v)); v = fmaxf(v, dpp_f<0x141>(v)); v = fmaxf(v, dpp_f<0x140>(v));
  return v;
}
__device__ __forceinline__ float wave_sum(float v) { return swap32_sum(swap16_sum(row16_sum(v))); }
__device__ __forceinline__ float wave_max(float v) { return swap32_max(swap16_max(row16_max(v))); }
__device__ __forceinline__ const float* xrow_in(const Params& p, int l, int t) {
  if (l == 0) return (t < NPROMPT) ? p.x_prompt() + (size_t)t * D_MODEL : p.x_sample() + (size_t)(t - NPROMPT) * D_MODEL;
  return p.x() + (size_t)t * D_MODEL;
}
__device__ __forceinline__ bf16x8 as_bf16x8(uint4 v) { return *reinterpret_cast<bf16x8*>(&v); }

__device__ __forceinline__ int tid_opaque() { int t = threadIdx.x; asm volatile("" : "+v"(t)); return t; }
__device__ __forceinline__ int sgpr_opaque(int v) { asm volatile("" : "+s"(v)); return v; }
__device__ __forceinline__ int bid_opaque(int v) { asm volatile("" : "+s"(v)); __builtin_assume(v >= 0); __builtin_assume(v < 1024); return v; }
__device__ __forceinline__ int nblk_opaque(int v) { asm volatile("" : "+s"(v)); __builtin_assume(v >= 1); __builtin_assume(v <= 1024); return v; }
#define LAS __attribute__((address_space(3)))
#ifndef PROBE
#define PROBE 0
#endif
#define SMEM_BYTES 73728

__device__ __forceinline__ void transpose_tile(const float* __restrict__ src, int lds, bf16_t* __restrict__ dst, int K, int n0, int k0,
                               int gate_skip, float* tile  ) {
  const int tid = tid_opaque();
  const int c = tid & 63, r0 = tid >> 6;
  int n = n0 + c;
  int col = n + ((gate_skip && n >= 2304) ? 8 : 0);
#pragma unroll 4
  for (int j = 0; j < 16; ++j) {
    int r = r0 + 4 * j;
    tile[r * 65 + c] = src[(size_t)(k0 + r) * lds + col];
  }
  __syncthreads();
  const int nn = tid >> 2, kg = (tid & 3) * 16;
  unsigned w[8];
#pragma unroll
  for (int j = 0; j < 8; ++j) w[j] = pack2(tile[(kg + 2 * j) * 65 + nn], tile[(kg + 2 * j + 1) * 65 + nn]);
  uint4* d = reinterpret_cast<uint4*>(dst + (size_t)(n0 + nn) * K + k0 + kg);
  d[0] = make_uint4(w[0], w[1], w[2], w[3]);
  d[1] = make_uint4(w[4], w[5], w[6], w[7]);
  __syncthreads();
}

__device__ __forceinline__ int rel_bucket_dev(int rel) {
  int ret = rel > 0 ? 16 : 0;
  int n = rel < 0 ? -rel : rel;
  int b;
  if (n < 8) b = n;
  else if (n < 12) b = 8;
  else if (n < 16) b = 9;
  else if (n < 23) b = 10;
  else if (n < 32) b = 11;
  else if (n < 46) b = 12;
  else if (n < 64) b = 13;
  else if (n < 91) b = 14;
  else b = 15;
  return ret + b;
}

__device__ __forceinline__ void prep_table_rows(const Params& p, int r0, int r1, int lane, int wv) {
  for (int r = r0 + wv; r < r1; r += 4) {
    const int tab = r >> 15, row = r & 32767;
    const float* src = (tab == 0 ? p.peer_u() : p.peer_v()) + (size_t)row * 1024 + lane * 16;
    float4 f0 = reinterpret_cast<const float4*>(src)[0], f1 = reinterpret_cast<const float4*>(src)[1];
    float4 f2 = reinterpret_cast<const float4*>(src)[2], f3 = reinterpret_cast<const float4*>(src)[3];
    float am = fmaxf(fmaxf(fmaxf(fabsf(f0.x), fabsf(f0.y)), fmaxf(fabsf(f0.z), fabsf(f0.w))),
                     fmaxf(fmaxf(fabsf(f1.x), fabsf(f1.y)), fmaxf(fabsf(f1.z), fabsf(f1.w))));
    am = fmaxf(am, fmaxf(fmaxf(fmaxf(fabsf(f2.x), fabsf(f2.y)), fmaxf(fabsf(f2.z), fabsf(f2.w))),
                         fmaxf(fmaxf(fabsf(f3.x), fabsf(f3.y)), fmaxf(fabsf(f3.z), fabsf(f3.w)))));
    am = wave_max(am);
    const float sc = am > 0.f ? 224.f / am : 1.f;
    int w0 = 0, w1 = 0, w2 = 0, w3 = 0;
    w0 = __builtin_amdgcn_cvt_pk_fp8_f32(f0.x * sc, f0.y * sc, w0, false); w0 = __builtin_amdgcn_cvt_pk_fp8_f32(f0.z * sc, f0.w * sc, w0, true);
    w1 = __builtin_amdgcn_cvt_pk_fp8_f32(f1.x * sc, f1.y * sc, w1, false); w1 = __builtin_amdgcn_cvt_pk_fp8_f32(f1.z * sc, f1.w * sc, w1, true);
    w2 = __builtin_amdgcn_cvt_pk_fp8_f32(f2.x * sc, f2.y * sc, w2, false); w2 = __builtin_amdgcn_cvt_pk_fp8_f32(f2.z * sc, f2.w * sc, w2, true);
    w3 = __builtin_amdgcn_cvt_pk_fp8_f32(f3.x * sc, f3.y * sc, w3, false); w3 = __builtin_amdgcn_cvt_pk_fp8_f32(f3.z * sc, f3.w * sc, w3, true);
    unsigned char* dst = (tab == 0 ? p.ub8() : p.vb8()) + (size_t)row * 1024 + lane * 16;
    *reinterpret_cast<uint4*>(dst) = make_uint4((unsigned)w0, (unsigned)w1, (unsigned)w2, (unsigned)w3);
    if (lane == 0) (tab == 0 ? p.us() : p.vs())[row] = am > 0.f ? am * (1.f / 224.f) : 1.f;
  }
}

__device__ __forceinline__ void ph_prep(const Params& p, char* smem, int bid, int nblk) {
  const int tid = tid_opaque();
  float* tile = reinterpret_cast<float*>(smem);
  for (int u = bid; u < 2 * 1472; u += nblk) {
    int l = u / 1472, r = u % 1472;
    if (r < 704) {
      int nt = r / 16, kt = r % 16;
      transpose_tile(p.w_in() + (size_t)l * 1024 * 2824, 2824, p.wt_in() + (size_t)l * NIN * 1024, 1024, nt * 64, kt * 64, 1, tile);
    } else if (r < 960) {
      r -= 704; int nt = r / 16, kt = r % 16;
      transpose_tile(p.w_out() + (size_t)l * 1024 * 1024, 1024, p.wt_out() + (size_t)l * 1024 * 1024, 1024, nt * 64, kt * 64, 0, tile);
    } else {
      r -= 960; int nt = r / 16, kt = r % 16;
      transpose_tile(p.peer_wq() + (size_t)l * 1024 * 2048, 2048, p.wt_pq() + (size_t)l * 2048 * 1024, 1024, nt * 64, kt * 64, 0, tile);
    }
  }
  for (int u = bid; u < 1024; u += nblk) {
    int kt = u & 15, h = (u >> 4) & 3, b = (u >> 6) & 7, l = u >> 9;
    const float* src = p.cache_v() + (((size_t)(l * 8 + b) * 1024 + kt * 64) * 4 + h) * 128;
    {
      int c = tid & 127, r0 = tid >> 7;
      for (int j = 0; j < 32; ++j) { int r = r0 + 2 * j; tile[r * 129 + c] = src[(size_t)r * 512 + c]; }
    }
    __syncthreads();
    {
      int dv = tid >> 1, half = tid & 1;
      bf16_t* dst = p.Vts() + ((size_t)((l * 8 + b) * 4 + h) * 128 + dv) * SKEYS + kt * 64 + half * 32;
      unsigned w[16];
#pragma unroll
      for (int j = 0; j < 16; ++j) {
        int pos0 = half * 32 + 2 * j;
        int blk = (pos0 >> 2) & 3;
        int oblk = (blk == 1) ? 2 : (blk == 2 ? 1 : blk);
        int key0 = (pos0 & ~15) + oblk * 4 + (pos0 & 3);
        w[j] = pack2(tile[key0 * 129 + dv], tile[(key0 + 1) * 129 + dv]);
      }
      uint4* d4 = reinterpret_cast<uint4*>(dst);
      d4[0] = make_uint4(w[0], w[1], w[2], w[3]);
      d4[1] = make_uint4(w[4], w[5], w[6], w[7]);
      d4[2] = make_uint4(w[8], w[9], w[10], w[11]);
      d4[3] = make_uint4(w[12], w[13], w[14], w[15]);
    }
    __syncthreads();
  }
  const size_t gtid = (size_t)bid * 256 + tid, gsz = (size_t)nblk * 256;
  {
    const size_t n8 = (size_t)2 * 16 * 128 * 128 / 8;
    for (size_t i = gtid; i < n8; i += gsz) {
      float4 a = reinterpret_cast<const float4*>(p.peer_keys())[2 * i], b = reinterpret_cast<const float4*>(p.peer_keys())[2 * i + 1];
      reinterpret_cast<uint4*>(p.keysb())[i] = make_uint4(pack2(a.x, a.y), pack2(a.z, a.w), pack2(b.x, b.y), pack2(b.z, b.w));
    }
  }
  {
    const size_t n8 = (size_t)2 * 8 * 1024 * 512 / 8;
    for (size_t i = gtid; i < n8; i += gsz) {
      size_t e = i * 8;
      size_t lb = e / (1024 * 512), rem = e % (1024 * 512);
      float4 a = reinterpret_cast<const float4*>(p.cache_k())[2 * i], b = reinterpret_cast<const float4*>(p.cache_k())[2 * i + 1];
      *reinterpret_cast<uint4*>(p.Kbs() + lb * (SKEYS * 512) + rem) = make_uint4(pack2(a.x, a.y), pack2(a.z, a.w), pack2(b.x, b.y), pack2(b.z, b.w));
    }
  }
  for (size_t i = gtid; i < 2 * 8 * 1024; i += gsz) {
    int l = (int)(i / 8192), r = (int)(i % 8192), g = r / 1024, k = r % 1024;
    p.wg()[i] = p.w_in()[((size_t)l * 1024 + k) * 2824 + 2304 + g];
  }
  {
    float* sp = reinterpret_cast<float*>(p.ws + WS_sp);
    for (size_t i = gtid; i < 262144; i += gsz) sp[SP_st_c + i] = p.in[4][i];
    for (size_t i = gtid; i < 4096; i += gsz) sp[SP_st_n + i] = p.in[5][i];
    for (size_t i = gtid; i < 64; i += gsz) sp[SP_st_m + i] = p.in[6][i];
    for (size_t i = gtid; i < 12288; i += gsz) sp[SP_st_conv + i] = p.in[7][i];
    for (size_t i = gtid; i < 2048; i += gsz) sp[SP_norm1_g + i] = p.in[8][i];
    for (size_t i = gtid; i < 256; i += gsz) sp[SP_da_subln_g + i] = p.in[11][i];
    for (size_t i = gtid; i < 2048; i += gsz) sp[SP_ml_conv_w + i] = p.in[13][i];
    for (size_t i = gtid; i < 512; i += gsz) sp[SP_ml_conv_b + i] = p.in[14][i];
    for (size_t i = gtid; i < 32768; i += gsz) sp[SP_ml_wq + i] = p.in[15][i];
    for (size_t i = gtid; i < 32768; i += gsz) sp[SP_ml_wk + i] = p.in[16][i];
    for (size_t i = gtid; i < 16; i += gsz) sp[SP_ml_gate_b + i] = p.in[17][i];
    for (size_t i = gtid; i < 512; i += gsz) sp[SP_ml_norm_g + i] = p.in[18][i];
    for (size_t i = gtid; i < 512; i += gsz) sp[SP_ml_skip + i] = p.in[19][i];
    for (size_t i = gtid; i < 512; i += gsz) sp[SP_cm_norm_g + i] = p.in[20][i];
    for (size_t i = gtid; i < 131072; i += gsz) sp[SP_cm_ws + i] = p.in[21][i];
    for (size_t i = gtid; i < 1024; i += gsz) sp[SP_cm_b + i] = p.in[22][i];
    for (size_t i = gtid; i < 2048; i += gsz) sp[SP_norm2_g + i] = p.in[24][i];
    for (size_t i = gtid; i < 1024; i += gsz) sp[SP_final_g + i] = p.in[29][i];
  }
  if (bid == 0) {
    for (int i = tid; i < 4 * 256; i += 256) {
      int h = i >> 8, j = i & 255;
      int rel = j - 191; if (rel > 63) rel = 63;
      p.lut()[i] = p.rel_table()[rel_bucket_dev(rel) * 4 + h] * LOG2E;
    }
    if (tid < 2) {
      const float* lp = p.da_lambda() + tid * 256;
      float s01 = 0.f, s23 = 0.f;
      for (int d = 0; d < 64; ++d) { s01 += lp[d] * lp[64 + d]; s23 += lp[128 + d] * lp[192 + d]; }
      float lam_init = 0.8f - 0.6f * expf(-0.3f * (float)tid);
      p.lam()[tid] = expf(s01) - expf(s23) + lam_init;
    }
  }
}

template <int MODE>
__device__ __forceinline__ void ph_rmsnorm(const Params& p, int l, int bid, int nblk) {
  const int lane = tid_opaque() & 63, w = __builtin_amdgcn_readfirstlane(tid_opaque() >> 6);
  const float* g = (MODE == 0) ? p.norm1_g() + l * 1024 : (MODE == 1 ? p.norm2_g() + l * 1024 : p.final_g());
  float4 gv[4];
#pragma unroll
  for (int j = 0; j < 4; ++j) gv[j] = reinterpret_cast<const float4*>(g)[lane + 64 * j];
  for (int t = bid * 4 + w; t < NTOK; t += nblk * 4) {
    const float* xr = (MODE == 0) ? xrow_in(p, l, t) : p.x() + (size_t)t * 1024;
    float4 xv[4];
    float ss = 0.f;
#pragma unroll
    for (int j = 0; j < 4; ++j) {
      xv[j] = reinterpret_cast<const float4*>(xr)[lane + 64 * j];
      ss += xv[j].x * xv[j].x + xv[j].y * xv[j].y + xv[j].z * xv[j].z + xv[j].w * xv[j].w;
    }
    ss = wave_sum(ss);
    float r = rsqrtf(ss * (1.f / 1024.f) + EPS);
#pragma unroll
    for (int j = 0; j < 4; ++j) {
      xv[j].x *= r * gv[j].x; xv[j].y *= r * gv[j].y; xv[j].z *= r * gv[j].z; xv[j].w *= r * gv[j].w;
    }
    if (MODE == 2) {
      float* o = (t < NPROMPT) ? p.out + O_Y_P + (size_t)t * 1024 : p.out + O_Y_S + (size_t)(t - NPROMPT) * 1024;
#pragma unroll
      for (int j = 0; j < 4; ++j) reinterpret_cast<float4*>(o)[lane + 64 * j] = xv[j];
    } else {
      uint2* o = reinterpret_cast<uint2*>(p.xn() + (size_t)t * 1024);
#pragma unroll
      for (int j = 0; j < 4; ++j) o[lane + 64 * j] = make_uint2(pack2(xv[j].x, xv[j].y), pack2(xv[j].z, xv[j].w));
    }
    if (MODE == 0) {
      float pre[8];
#pragma unroll
      for (int i = 0; i < 8; ++i) {
        const float4* wr = reinterpret_cast<const float4*>(p.wg() + ((size_t)l * 8 + i) * 1024);
        float s = 0.f;
#pragma unroll
        for (int j = 0; j < 4; ++j) {
          float4 wv = wr[lane + 64 * j];
          s += xv[j].x * wv.x + xv[j].y * wv.y + xv[j].z * wv.z + xv[j].w * wv.w;
        }
        pre[i] = wave_sum(s);
      }
      if (lane < 4) {
        float a = pre[0]; a = lane == 1 ? pre[1] : a; a = lane == 2 ? pre[2] : a; a = lane == 3 ? pre[3] : a;
        float f = pre[4]; f = lane == 1 ? pre[5] : f; f = lane == 2 ? pre[6] : f; f = lane == 3 ? pre[7] : f;
        p.ig()[(size_t)t * 4 + lane] = a + p.ml_gate_b()[l * 8 + lane];
        float z = f + p.ml_gate_b()[l * 8 + 4 + lane];
        p.lf()[(size_t)t * 4 + lane] = fminf(z, 0.f) - log1pf(expf(-fabsf(z)));
      }
    }
  }
}

__device__ __forceinline__ int mono_key(float v) { int b = __float_as_int(v); return b ^ ((b >> 31) & 0x7FFFFFFF); }
__device__ __forceinline__ float mono_val(int k) { int b = k ^ ((k >> 31) & 0x7FFFFFFF); return __int_as_float(b); }

__device__ __forceinline__ int med3i(int a, int b, int c) { return max(min(a, b), min(max(a, b), c)); }
#define INS16(L, kv)                                                          \
  {                                                                           \
    const int _v = (kv);                                                      \
    _Pragma("unroll") for (int _j = 15; _j >= 1; --_j) L[_j] = med3i(L[_j - 1], L[_j], _v); \
    L[0] = max(L[0], _v);                                                     \
  }


enum { EPI_WIN = 0, EPI_WOUT = 1, EPI_PQ = 2, EPI_SC = 3 };

template <int EPI>
__device__ __forceinline__ void gemm_store(const Params& p, int l, int t, int n, float v) {
  if (EPI == EPI_WOUT) {
    const float* xi = xrow_in(p, l, t);
    p.x()[(size_t)t * 1024 + n] = xi[n] + v;
  } else if (EPI == EPI_PQ) {
    p.qp()[(size_t)t * 2048 + n] = f2bf(v);
  } else if (EPI == EPI_SC) {
    p.sc()[(size_t)t * 2048 + n] = v;
  }
}

template <int EPI>
__device__ __forceinline__ void ph_gemm(const Params& p, int l, char* smem, int bid, int nblk) {
  constexpr int NT = (EPI == EPI_WIN) ? 22 : (EPI == EPI_WOUT ? 8 : 16);
  constexpr int MT = NTOK / 128;
  constexpr int K = (EPI == EPI_SC) ? 128 : 1024;
  constexpr int NK = K / 64;
  const bf16_t* A; int lda; const bf16_t* Bt; int ldb;
  if (EPI == EPI_WIN) { A = p.xn(); lda = 1024; Bt = p.wt_in() + (size_t)l * NIN * 1024; ldb = 1024; }
  else if (EPI == EPI_WOUT) { A = p.xn(); lda = 1024; Bt = p.wt_out() + (size_t)l * 1024 * 1024; ldb = 1024; }
  else if (EPI == EPI_PQ) { A = p.xn(); lda = 1024; Bt = p.wt_pq() + (size_t)l * 2048 * 1024; ldb = 1024; }
  else { A = p.qp(); lda = 2048; Bt = p.keysb() + (size_t)l * 16 * 128 * 128; ldb = 128; }

  const int tid = tid_opaque(), lane = tid & 63, w = __builtin_amdgcn_readfirstlane(tid >> 6);
  const int wm = w >> 1, wn = w & 1, lr = lane & 31, lh = lane >> 5;
  char* sA = smem;
  char* sB = smem + 32768;
  const int ld_c = tid & 7, ld_r = tid >> 3;

  const int nx = nblk >> 3;
  constexpr int FG = MT / 8, LR = MT % 8;
  for (int rnd = 0;; ++rnd) {
    const int q = (nblk & 7) ? rnd * nblk + bid : rnd * nblk + (bid & 7) * nx + (bid >> 3);
    if (q >= MT * NT) break;
    int mt, nt;
    if (q < FG * 8 * NT) { const int mg = q / (8 * NT), rem = q % (8 * NT); nt = rem >> 3; mt = mg * 8 + (rem & 7); }
    else { const int q2 = q - FG * 8 * NT; nt = q2 / (LR > 0 ? LR : 1); mt = FG * 8 + q2 % (LR > 0 ? LR : 1); }
    const bf16_t* Ag = A + (size_t)(mt * 128) * lda + ((EPI == EPI_SC) ? nt * 128 : 0);
    const bf16_t* Bg = Bt + (size_t)(nt * 128) * ldb;
    f32x16 acc[2][2];
#pragma unroll
    for (int i = 0; i < 2; ++i)
#pragma unroll
      for (int j = 0; j < 2; ++j)
#pragma unroll
        for (int r = 0; r < 16; ++r) acc[i][j][r] = 0.f;

    const int g_row = w * 32 + (lane >> 3);
    const int g_pc = lane & 7;
    const bf16_t* Ath = Ag + (size_t)g_row * lda;
    const bf16_t* Bth = Bg + (size_t)g_row * ldb;
#define GEMM_STAGE(KT, BUF)                                                                                          \
  _Pragma("unroll") for (int j = 0; j < 4; ++j) {                                                                    \
    const int row = g_row + 8 * j;                                                                                   \
    const int cch = g_pc ^ ((row >> 1) & 7);                                                                         \
    __builtin_amdgcn_global_load_lds((const unsigned*)(Ath + (size_t)(8 * j) * lda + (KT) * 64 + cch * 8),           \
                                     (LAS unsigned*)(sA + (BUF) * 16384 + (w * 4 + j) * 1024 + lane * 16), 16, 0, 0); \
    __builtin_amdgcn_global_load_lds((const unsigned*)(Bth + (size_t)(8 * j) * ldb + (KT) * 64 + cch * 8),           \
                                     (LAS unsigned*)(sB + (BUF) * 16384 + (w * 4 + j) * 1024 + lane * 16), 16, 0, 0); \
  }
    GEMM_STAGE(0, 0)
    __syncthreads();
    for (int kt = 0; kt < NK; ++kt) {
      const int buf = kt & 1;
      if (kt + 1 < NK) { GEMM_STAGE(kt + 1, buf ^ 1) }
      const char* cA = sA + buf * 16384;
      const char* cB = sB + buf * 16384;
#pragma unroll
      for (int ks = 0; ks < 4; ++ks) {
        bf16x8 af[2], bfr[2];
#pragma unroll
        for (int i = 0; i < 2; ++i) {
          int row = wm * 64 + i * 32 + lr; int pc = (ks * 2 + lh) ^ ((row >> 1) & 7);
          af[i] = as_bf16x8(*reinterpret_cast<const uint4*>(cA + row * 128 + pc * 16));
        }
#pragma unroll
        for (int j = 0; j < 2; ++j) {
          int row = wn * 64 + j * 32 + lr; int pc = (ks * 2 + lh) ^ ((row >> 1) & 7);
          bfr[j] = as_bf16x8(*reinterpret_cast<const uint4*>(cB + row * 128 + pc * 16));
        }
#pragma unroll
        for (int i = 0; i < 2; ++i)
#pragma unroll
          for (int j = 0; j < 2; ++j)
            acc[i][j] = __builtin_amdgcn_mfma_f32_32x32x16_bf16(af[i], bfr[j], acc[i][j], 0, 0, 0);
      }
      __syncthreads();
    }
    if (EPI == EPI_PQ) {
      int lane_q = lane; asm volatile("" : "+v"(lane_q));
      const int lr = lane_q & 31, lh = lane_q >> 5;
      char* sA2 = smem;
      char* sB2 = smem + 32768;
      const bf16_t* kg = p.keysb() + ((size_t)l * 16 + nt) * 128 * 128;
#pragma unroll
      for (int jj = 0; jj < 8; ++jj) {
        const int I = w * 8 + jj;
        const int row = I * 4 + (lane_q >> 4);
        const int cch = (lane_q & 15) ^ (row & 15);
        __builtin_amdgcn_global_load_lds((const unsigned*)(kg + (size_t)row * 128 + cch * 8),
                                         (LAS unsigned*)(sB2 + I * 1024 + lane_q * 16), 16, 0, 0);
      }
#pragma unroll
      for (int i = 0; i < 2; ++i) {
        float rs[16];
#pragma unroll
        for (int r = 0; r < 16; ++r) rs[r] = 0.f;
#pragma unroll
        for (int j = 0; j < 2; ++j) {
          const int n = wn * 64 + j * 32 + lr;
#pragma unroll
          for (int r = 0; r < 16; ++r) {
            const int row = wm * 64 + i * 32 + (r & 3) + 8 * (r >> 2) + 4 * lh;
            const float v = acc[i][j][r];
            rs[r] += v * v;
            *reinterpret_cast<bf16_t*>(sA2 + row * 256 + (((n >> 3) ^ (row & 15)) * 16) + (n & 7) * 2) = f2bf(v);
          }
        }
#pragma unroll
        for (int r = 0; r < 16; ++r) {
          const float s = swap16_sum(row16_sum(rs[r]));
          if (lr == 0) {
            const int t = mt * 128 + wm * 64 + i * 32 + (r & 3) + 8 * (r >> 2) + 4 * lh;
            p.ssp()[(size_t)t * 32 + nt * 2 + wn] = s;
          }
        }
      }
      __syncthreads();
      f32x16 sc2[2][2];
#pragma unroll
      for (int i = 0; i < 2; ++i)
#pragma unroll
        for (int j = 0; j < 2; ++j)
#pragma unroll
          for (int r = 0; r < 16; ++r) sc2[i][j][r] = 0.f;
#pragma unroll
      for (int ks = 0; ks < 8; ++ks) {
        bf16x8 af[2], bfr[2];
#pragma unroll
        for (int i = 0; i < 2; ++i) {
          const int row = wm * 64 + i * 32 + lr;
          af[i] = as_bf16x8(*reinterpret_cast<const uint4*>(sA2 + row * 256 + (((ks * 2 + lh) ^ (row & 15)) * 16)));
        }
#pragma unroll
        for (int j = 0; j < 2; ++j) {
          const int row = wn * 64 + j * 32 + lr;
          bfr[j] = as_bf16x8(*reinterpret_cast<const uint4*>(sB2 + row * 256 + (((ks * 2 + lh) ^ (row & 15)) * 16)));
        }
#pragma unroll
        for (int i = 0; i < 2; ++i)
#pragma unroll
          for (int j = 0; j < 2; ++j)
            sc2[i][j] = __builtin_amdgcn_mfma_f32_32x32x16_bf16(af[i], bfr[j], sc2[i][j], 0, 0, 0);
      }
      __syncthreads();
      float* sS = reinterpret_cast<float*>(smem);
#pragma unroll
      for (int i = 0; i < 2; ++i)
#pragma unroll
        for (int j = 0; j < 2; ++j)
#pragma unroll
          for (int r = 0; r < 16; ++r) {
            const int row = wm * 64 + i * 32 + (r & 3) + 8 * (r >> 2) + 4 * lh;
            sS[row * 129 + wn * 64 + j * 32 + lr] = sc2[i][j][r];
          }
      __syncthreads();
      {
        int tq = tid; asm volatile("" : "+v"(tq));
        const int tk = tq & 127, hl = tq >> 7;
        int L[16];
#pragma unroll
        for (int j = 0; j < 16; ++j) L[j] = (int)0x80000000;
        const float* srow = sS + tk * 129 + hl * 64;
#pragma unroll 4
        for (int s = 0; s < 64; ++s) {
          const int key = (mono_key(srow[s]) & ~127) | (127 - (hl * 64 + s));
          INS16(L, key)
        }
        int4* dst = reinterpret_cast<int4*>(p.tl() + (((size_t)(mt * 128 + tk) * 16 + nt) * 2 + hl) * 16);
        dst[0] = make_int4(L[0], L[1], L[2], L[3]); dst[1] = make_int4(L[4], L[5], L[6], L[7]);
        dst[2] = make_int4(L[8], L[9], L[10], L[11]); dst[3] = make_int4(L[12], L[13], L[14], L[15]);
      }
      __syncthreads();
    } else if (EPI != EPI_WIN) {
#pragma unroll
      for (int i = 0; i < 2; ++i)
#pragma unroll
        for (int j = 0; j < 2; ++j)
#pragma unroll
          for (int r = 0; r < 16; ++r) {
            int t = mt * 128 + wm * 64 + i * 32 + (r & 3) + 8 * (r >> 2) + 4 * lh;
            int n = nt * 128 + wn * 64 + j * 32 + lr;
            gemm_store<EPI>(p, l, t, n, acc[i][j][r]);
          }
    } else {
      const int seg = nt >> 2;
#pragma unroll
      for (int i = 0; i < 2; ++i)
#pragma unroll
        for (int j = 0; j < 2; ++j) {
          const int n = nt * 128 + wn * 64 + j * 32 + lr;
          if (nt < 4) {
#pragma unroll
            for (int r = 0; r < 16; ++r) {
              int t = mt * 128 + wm * 64 + i * 32 + (r & 3) + 8 * (r >> 2) + 4 * lh;
              p.Qb()[(size_t)t * 512 + n] = f2bf(acc[i][j][r] * (0.125f * LOG2E));
            }
          } else if (nt < 8) {
            const int n2 = n - 512;
#pragma unroll
            for (int r = 0; r < 16; ++r) {
              int t = mt * 128 + wm * 64 + i * 32 + (r & 3) + 8 * (r >> 2) + 4 * lh;
              float v = acc[i][j][r];
              if (t < NPROMPT) {
                p.out[O_K_P + (size_t)l * (4 * 4096 * 512) + (size_t)t * 512 + n2] = v;
                p.Kb()[(size_t)t * 512 + n2] = f2bf(v);
              } else {
                int ts = t - NPROMPT, b = ts >> 6, ii = ts & 63;
                p.out[O_K_S + (size_t)l * (8 * 64 * 512) + (size_t)ts * 512 + n2] = v;
                p.Kbs()[((size_t)(l * 8 + b) * SKEYS + 1024 + ii) * 512 + n2] = f2bf(v);
              }
            }
          } else if (nt < 12) {
            const int n2 = n - 1024, h = n2 >> 7, dv = n2 & 127;
#pragma unroll
            for (int rg = 0; rg < 4; ++rg) {
              int tb = mt * 128 + wm * 64 + i * 32 + 8 * rg + 4 * lh;
              float v0 = acc[i][j][rg * 4 + 0], v1 = acc[i][j][rg * 4 + 1], v2 = acc[i][j][rg * 4 + 2], v3 = acc[i][j][rg * 4 + 3];
              uint2 pk = make_uint2(pack2(v0, v1), pack2(v2, v3));
              int posblk = 2 * lh + (rg & 1);
              if (tb < NPROMPT) {
                float* o = p.out + O_V_P + (size_t)l * (4 * 4096 * 512) + (size_t)tb * 512 + n2;
                o[0] = v0; o[512] = v1; o[1024] = v2; o[1536] = v3;
                int b = tb >> 12, s = tb & 4095;
                int pos = (s & ~15) + posblk * 4;
                *reinterpret_cast<uint2*>(p.Vt() + ((size_t)(b * 4 + h) * 128 + dv) * SEQ + pos) = pk;
              } else {
                int ts = tb - NPROMPT, b = ts >> 6, ii = ts & 63;
                float* o = p.out + O_V_S + (size_t)l * (8 * 64 * 512) + (size_t)ts * 512 + n2;
                o[0] = v0; o[512] = v1; o[1024] = v2; o[1536] = v3;
                int pos = 1024 + (ii & ~15) + posblk * 4;
                *reinterpret_cast<uint2*>(p.Vts() + ((size_t)((l * 8 + b) * 4 + h) * 128 + dv) * SKEYS + pos) = pk;
              }
            }
          } else {
            const int n2 = n - 1536;
            const bool act = (n >= 2304);
#pragma unroll
            for (int r = 0; r < 16; ++r) {
              int t = mt * 128 + wm * 64 + i * 32 + (r & 3) + 8 * (r >> 2) + 4 * lh;
              float v = acc[i][j][r];
              if (act) v = gelu_exact(v);
              p.P5()[(size_t)t * 1280 + n2] = v;
            }
          }
        }
      (void)seg;
    }
  }
}

struct WorkQ { unsigned* cnt; volatile int* slot; int off; };
__device__ __forceinline__ int wq_next(const WorkQ& q) {
  __syncthreads();
  if (threadIdx.x == 0) *q.slot = (int)__hip_atomic_fetch_add(q.cnt, 1u, __ATOMIC_RELAXED, __HIP_MEMORY_SCOPE_AGENT);
  __syncthreads();
  return __builtin_amdgcn_readfirstlane(*q.slot) - q.off;
}

template <bool CONV>
__device__ __forceinline__ int ph_attn(const Params& p, int l, char* smem, const WorkQ& wq) {
  const int tid = tid_opaque(), lane = tid & 63, w = __builtin_amdgcn_readfirstlane(tid >> 6);
  const int c = w >> 1, qhalf = w & 1, lr = lane & 31, lh = lane >> 5;
  float* sLut = reinterpret_cast<float*>(smem + 65536);
  float* sO2 = reinterpret_cast<float*>(smem);
  const float lam = p.lam()[l];
  const float lam_init = 0.8f - 0.6f * expf(-0.3f * (float)l);

  constexpr int NSLOT = CONV ? 1584 : 1056;
  int slot, uu;
  for (slot = wq_next(wq); slot < NSLOT; slot = wq_next(wq)) {
    if (CONV) {
      if (slot % 3 == 2) {
        const int ch = slot / 3, r0 = ch * 125;
        prep_table_rows(p, r0, (r0 + 125 < 65536) ? r0 + 125 : 65536, lane, w);
        continue;
      }
      uu = (slot / 3) * 2 + (slot % 3);
    } else uu = slot;
    int b, h, qc, S, qrow0; const bf16_t *Kbase, *Vbase;
    bool samp = false; int u2 = uu;
    if (uu >= 752 && uu < 784) samp = true; else if (uu >= 784) u2 = uu - 32;
    if (!samp) {
      qc = 63 - (u2 >> 4); int bh = u2 & 15; b = bh >> 2; h = bh & 3; S = SEQ;
      Kbase = p.Kb() + (size_t)b * SEQ * 512 + h * 128;
      Vbase = p.Vt() + (size_t)(b * 4 + h) * 128 * SEQ;
      qrow0 = b * SEQ + qc * 64;
    } else {
      int us = uu - 752; b = us >> 2; h = us & 3; qc = 16; S = SKEYS;
      Kbase = p.Kbs() + (size_t)(l * 8 + b) * SKEYS * 512 + h * 128;
      Vbase = p.Vts() + (size_t)((l * 8 + b) * 4 + h) * 128 * SKEYS;
      qrow0 = NPROMPT + b * 64;
    }
    const int ntiles = qc + 1;
    __syncthreads();
    sLut[tid] = p.lut()[h * 256 + tid];
    if (tid < 128) sLut[256 + tid] = p.da_subln_g()[l * 128 + tid];
    bf16x8 qf[4];
    {
      const bf16_t* qrow = p.Qb() + (size_t)(qrow0 + qhalf * 32 + lr) * 512 + h * 128 + c * 64 + lh * 8;
#pragma unroll
      for (int ks = 0; ks < 4; ++ks) qf[ks] = as_bf16x8(*reinterpret_cast<const uint4*>(qrow + ks * 16));
    }
    f32x16 o[4];
#pragma unroll
    for (int d = 0; d < 4; ++d)
#pragma unroll
      for (int r = 0; r < 16; ++r) o[d][r] = 0.f;
    float m_run = -1e30f, l_run = 0.f;

    const char* Kt = reinterpret_cast<const char*>(Kbase);
    const char* Vb = reinterpret_cast<const char*>(Vbase);
    const int g_r8 = lane >> 3, g_pc = lane & 7;
#define ATTN_STAGE(KT, BUF)                                                                                         \
  _Pragma("unroll") for (int j = 0; j < 4; ++j) {                                                                   \
    const int I = w * 4 + j;                                                                                        \
    const int rk = (I & 7) * 8 + g_r8;                                                                              \
    const unsigned kof = (unsigned)rk * 1024u + (unsigned)(I >> 3) * 128u + (unsigned)((g_pc ^ ((rk >> 1) & 7)) * 16); \
    __builtin_amdgcn_global_load_lds((const unsigned*)(Kt + (size_t)(KT) * 65536 + kof),                            \
                                     (LAS unsigned*)(smem + (BUF) * 32768 + I * 1024 + lane * 16), 16, 0, 0);       \
    const int rv = I * 8 + g_r8;                                                                                    \
    const unsigned vof = (unsigned)rv * (unsigned)(S * 2) + (unsigned)((g_pc ^ ((rv >> 1) & 7)) * 16);              \
    __builtin_amdgcn_global_load_lds((const unsigned*)(Vb + (size_t)(KT) * 128 + vof),                              \
                                     (LAS unsigned*)(smem + (BUF) * 32768 + 16384 + I * 1024 + lane * 16), 16, 0, 0); \
  }
    ATTN_STAGE(0, 0)
    __syncthreads();
    for (int kt = 0; kt < ntiles; ++kt) {
      const int buf = kt & 1;
      if (kt + 1 < ntiles) { ATTN_STAGE(kt + 1, buf ^ 1) }
      const char* sK = smem + buf * 32768;
      const char* sV = sK + 16384;
      f32x16 s[2];
      {
        bf16x8 kf[2][4];
#pragma unroll
        for (int kb = 0; kb < 2; ++kb)
#pragma unroll
          for (int ks = 0; ks < 4; ++ks) {
            int row = kb * 32 + lr; int pc = (ks * 2 + lh) ^ ((row >> 1) & 7);
            kf[kb][ks] = as_bf16x8(*reinterpret_cast<const uint4*>(sK + c * 8192 + row * 128 + pc * 16));
          }
        __builtin_amdgcn_sched_barrier(0);
#pragma unroll
        for (int kb = 0; kb < 2; ++kb) {
#pragma unroll
          for (int r = 0; r < 16; ++r) s[kb][r] = 0.f;
#pragma unroll
          for (int ks = 0; ks < 4; ++ks) s[kb] = __builtin_amdgcn_mfma_f32_32x32x16_bf16(kf[kb][ks], qf[ks], s[kb], 0, 0, 0);
        }
      }
      bf16x8 vfa[2][4];
#pragma unroll
      for (int k2 = 0; k2 < 2; ++k2)
#pragma unroll
        for (int d = 0; d < 4; ++d) {
          int row = d * 32 + lr; int pc = (k2 * 2 + lh) ^ ((row >> 1) & 7);
          vfa[k2][d] = as_bf16x8(*reinterpret_cast<const uint4*>(sV + row * 128 + pc * 16));
        }
      __builtin_amdgcn_sched_barrier(0);
      float boff = sLut[0];
      if (kt >= qc - 2) {
        const int base = (kt - qc) * 64 - (qhalf * 32 + lr) + 191 + 4 * lh;
#pragma unroll
        for (int kb = 0; kb < 2; ++kb)
#pragma unroll
          for (int r = 0; r < 16; ++r) s[kb][r] += sLut[base + kb * 32 + (r & 3) + 8 * (r >> 2)];
        boff = 0.f;
      }
      float mx = s[0][0];
#pragma unroll
      for (int kb = 0; kb < 2; ++kb)
#pragma unroll
        for (int r = 0; r < 16; ++r) mx = fmaxf(mx, s[kb][r]);
      mx = swap32_max(mx) + boff;
      if (__any(mx > m_run)) {
        const float m_new = fmaxf(m_run, mx);
        const float alpha = __builtin_amdgcn_exp2f(m_run - m_new);
        m_run = m_new;
        l_run *= alpha;
#pragma unroll
        for (int d = 0; d < 4; ++d)
#pragma unroll
          for (int r = 0; r < 16; ++r) o[d][r] *= alpha;
      }
      const float eoff = boff - m_run;
      float ps = 0.f;
#pragma unroll
      for (int kb = 0; kb < 2; ++kb)
#pragma unroll
        for (int r = 0; r < 16; ++r) { float pv = __builtin_amdgcn_exp2f(s[kb][r] + eoff); s[kb][r] = pv; ps += pv; }
      l_run += ps;
      bf16x8 pf[4];
#pragma unroll
      for (int ks2 = 0; ks2 < 4; ++ks2) {
        const int kb = ks2 >> 1, sh = (ks2 & 1) * 8;
        uint4 pw = make_uint4(pack2(s[kb][sh + 0], s[kb][sh + 1]), pack2(s[kb][sh + 2], s[kb][sh + 3]),
                              pack2(s[kb][sh + 4], s[kb][sh + 5]), pack2(s[kb][sh + 6], s[kb][sh + 7]));
        pf[ks2] = as_bf16x8(pw);
      }
      __builtin_amdgcn_sched_barrier(0);
#define ATTN_VREAD(DST, K2)                                                                        \
  _Pragma("unroll") for (int d = 0; d < 4; ++d) {                                                  \
    int row = d * 32 + lr; int pc = ((K2) * 2 + lh) ^ ((row >> 1) & 7);                            \
    DST[d] = as_bf16x8(*reinterpret_cast<const uint4*>(sV + row * 128 + pc * 16));                 \
  }
#define ATTN_PV(SRC, K2) \
  _Pragma("unroll") for (int d = 0; d < 4; ++d) o[d] = __builtin_amdgcn_mfma_f32_32x32x16_bf16(SRC[d], pf[K2], o[d], 0, 0, 0);
      bf16x8 vfc[4];
      ATTN_VREAD(vfc, 2)
      ATTN_PV(vfa[0], 0)
      __builtin_amdgcn_sched_barrier(0);
      ATTN_VREAD(vfa[0], 3)
      ATTN_PV(vfa[1], 1)
      __builtin_amdgcn_sched_barrier(0);
      ATTN_PV(vfc, 2)
      ATTN_PV(vfa[0], 3)
      __syncthreads();
    }
    int lane_e = (int)__builtin_amdgcn_mbcnt_hi(~0u, __builtin_amdgcn_mbcnt_lo(~0u, 0u)); asm volatile("" : "+v"(lane_e));
    const int lr_e = lane_e & 31, lh_e = lane_e >> 5;
    float lt = swap32_sum(l_run);
    float inv = 1.f / lt;
    __syncthreads();
    if (c == 1) {
#pragma unroll
      for (int d = 0; d < 4; ++d)
#pragma unroll
        for (int r = 0; r < 16; ++r) sO2[(qhalf * 64 + d * 16 + r) * 64 + lane_e] = o[d][r] * inv;
    }
    __syncthreads();
    if (c == 0) {
      float ss = 0.f;
#pragma unroll
      for (int d = 0; d < 4; ++d)
#pragma unroll
        for (int r = 0; r < 16; ++r) {
          float v = o[d][r] * inv - lam * sO2[(qhalf * 64 + d * 16 + r) * 64 + lane_e];
          o[d][r] = v; ss += v * v;
        }
      ss = swap32_sum(ss);
      const float rn = rsqrtf(ss * (1.f / 128.f) + EPS) * (1.f - lam_init);
      const float* gs = sLut + 256;
      bf16_t* orow = p.xn() + (size_t)(qrow0 + qhalf * 32 + lr_e) * 1024 + h * 128;
#pragma unroll
      for (int d = 0; d < 4; ++d)
#pragma unroll
        for (int rg = 0; rg < 4; ++rg) {
          int dv = d * 32 + 8 * rg + 4 * lh_e;
          float4 g4 = *reinterpret_cast<const float4*>(gs + dv);
          uint2 pk = make_uint2(pack2(o[d][rg * 4 + 0] * rn * g4.x, o[d][rg * 4 + 1] * rn * g4.y),
                                pack2(o[d][rg * 4 + 2] * rn * g4.z, o[d][rg * 4 + 3] * rn * g4.w));
          *reinterpret_cast<uint2*>(orow + dv) = pk;
        }
    }
  }
  return slot - NSLOT + 1056;
}

template <int K>
__device__ __forceinline__ void mfma32_f32(f32x16& acc, const float* a, int a_rs, int a_ks, const float* b, int b_ks, int b_js, int lane) {
  const float* ap = a + (lane & 31) * a_rs + (lane >> 5) * a_ks;
  const float* bp = b + (lane >> 5) * b_ks + (lane & 31) * b_js;
#pragma unroll 8
  for (int k = 0; k < K; k += 2) acc = __builtin_amdgcn_mfma_f32_32x32x2f32(ap[k * a_ks], bp[k * b_ks], acc, 0, 0, 0);
}
__device__ __forceinline__ void zero16(f32x16& a) {
#pragma unroll
  for (int r = 0; r < 16; ++r) a[r] = 0.f;
}

__device__ __forceinline__ int ph_mlconv(const Params& p, int l, char* smem, const WorkQ& wq, int item) {
  const int tid = tid_opaque();
  float* s_mc = reinterpret_cast<float*>(smem);
  float* s_cc = s_mc + 67 * 64;
  float* s_wq = s_cc + 64 * 65;
  float* s_wk = s_wq + 4096;
  for (; item < 1056 + 264 * 4; item = wq_next(wq)) {
    const int u = item - 1056;
    const int ci = u >> 2, h = u & 3;
    int token0, bq; bool samp = ci >= 256;
    if (!samp) token0 = ci * 64; else token0 = NPROMPT + (ci - 256) * 64;
    bq = samp ? (ci - 256) : (ci >> 6);
    const int cidx = samp ? 0 : (ci & 63);
    __syncthreads();
    for (int i = tid; i < 67 * 64; i += 256) {
      int r = i >> 6, d = i & 63;
      float v;
      if (r >= 3) v = p.P5()[(size_t)(token0 + r - 3) * 1280 + h * 64 + d];
      else if (samp) v = p.st_conv()[((size_t)(l * 8 + bq) * 3 + r) * 256 + h * 64 + d];
      else if (cidx == 0) v = 0.f;
      else v = p.P5()[(size_t)(token0 + r - 3) * 1280 + h * 64 + d];
      s_mc[i] = v;
    }
    for (int i = tid; i < 4096; i += 256) {
      s_wq[i] = p.ml_wq()[(size_t)(l * 4 + h) * 4096 + i];
      s_wk[i] = p.ml_wk()[(size_t)(l * 4 + h) * 4096 + i];
    }
    __syncthreads();
    {
      const int d = tid & 63, t0 = tid >> 6;
      const int ch = h * 64 + d;
      const float w0 = p.ml_conv_w()[(l * 4 + 0) * 256 + ch], w1 = p.ml_conv_w()[(l * 4 + 1) * 256 + ch];
      const float w2 = p.ml_conv_w()[(l * 4 + 2) * 256 + ch], w3 = p.ml_conv_w()[(l * 4 + 3) * 256 + ch];
      const float bb = p.ml_conv_b()[l * 256 + ch];
      for (int t = t0; t < 64; t += 4) {
        float y = bb + w0 * s_mc[t * 64 + d] + w1 * s_mc[(t + 1) * 64 + d] + w2 * s_mc[(t + 2) * 64 + d] + w3 * s_mc[(t + 3) * 64 + d];
        y = y * sigmoidf_(y);
        s_cc[t * 65 + d] = y;
        p.cc()[(size_t)(token0 + t) * 256 + ch] = y;
      }
      if (samp || cidx == 63) {
        if (tid < 192) {
          int r = tid >> 6;
          float v = s_mc[(64 + r) * 64 + d];
          if (samp) p.out[O_CONV_S + ((size_t)(l * 8 + bq) * 3 + r) * 256 + ch] = v;
          else p.out[O_CONV_P + ((size_t)(l * 4 + bq) * 3 + r) * 256 + ch] = v;
        }
      }
    }
    __syncthreads();
    {
      const int lane = tid & 63, w = __builtin_amdgcn_readfirstlane(tid >> 6), ti = w >> 1, tj = w & 1;
      f32x16 aq, ak; zero16(aq); zero16(ak);
      mfma32_f32<64>(aq, s_cc + ti * 32 * 65, 65, 1, s_wq + tj * 32, 64, 1, lane);
      mfma32_f32<64>(ak, s_cc + ti * 32 * 65, 65, 1, s_wk + tj * 32, 64, 1, lane);
#pragma unroll
      for (int r = 0; r < 16; ++r) {
        const int t = ti * 32 + (r & 3) + 8 * (r >> 2) + 4 * (lane >> 5);
        const size_t o = (size_t)(token0 + t) * 256 + h * 64 + tj * 32 + (lane & 31);
        p.qm()[o] = aq[r];
        p.km()[o] = ak[r] * 0.125f;
      }
      if (w == 0) {
        const int t = token0 + lane;
        const float lfv = p.lf()[(size_t)t * 4 + h], igv = p.ig()[(size_t)t * 4 + h];
        float F = lfv;
#pragma unroll
        for (int d = 1; d < 64; d <<= 1) { float n = shfl_up_l(F, d, lane); if (lane >= d) F += n; }
        const float FL = __int_as_float(__builtin_amdgcn_readlane(__float_as_int(F), 63));
        const float mx = wave_max(FL - F + igv);
        p.Fc()[(size_t)t * 4 + h] = F;
        if (lane == 0) {
          const int cu = samp ? 1024 + bq * 4 + h : (bq * 4 + h) * 64 + cidx;
          p.FLs()[cu] = FL; p.mxt()[cu] = mx;
        }
      }
    }
  }
  return item;
}

__device__ __forceinline__ void cu_decode(int cu, int& token0, int& h) {
  if (cu < 1024) { int bh = cu >> 6, c = cu & 63; token0 = (bh >> 2) * SEQ + c * 64; h = bh & 3; }
  else { int us = cu - 1024; token0 = NPROMPT + (us >> 2) * 64; h = us & 3; }
}

__device__ __forceinline__ void ph_mlU(const Params& p, int l, char* smem, int bid, int nblk) {
  const int tid = tid_opaque();
  const int lane = tid & 63, w = __builtin_amdgcn_readfirstlane(tid >> 6), ti = w >> 1, tj = w & 1;
  float* s_k = reinterpret_cast<float*>(smem);
  float* s_v = s_k + 4096;
  for (int cu = bid; cu < NCU_UNITS; cu += nblk) {
    int token0, h; cu_decode(cu, token0, h);
    float m0, mn, FL;
    {
      const bool samp = cu >= 1024;
      const int cu0 = samp ? cu : (cu & ~63), c = samp ? 0 : (cu & 63);
      float flv = 0.f, mxv = 0.f;
      if (lane <= c) { flv = p.FLs()[cu0 + lane]; mxv = p.mxt()[cu0 + lane]; }
      float m = samp ? p.st_m()[l * 32 + (cu - 1024)] : 0.f;
      for (int j = 0; j < c; ++j) {
        const float fj = __int_as_float(__builtin_amdgcn_readlane(__float_as_int(flv), j));
        const float xj = __int_as_float(__builtin_amdgcn_readlane(__float_as_int(mxv), j));
        m = fmaxf(fj + m, xj);
      }
      FL = __int_as_float(__builtin_amdgcn_readlane(__float_as_int(flv), c));
      const float xc = __int_as_float(__builtin_amdgcn_readlane(__float_as_int(mxv), c));
      m0 = m; mn = fmaxf(FL + m, xc);
      if (tid == 0) {
        p.mst()[cu] = m0; p.mnx()[cu] = mn; p.wcs()[cu] = expf(FL + m0 - mn);
        if (samp) p.out[O_M_S + l * 32 + (cu - 1024)] = mn;
        else if (c == 63) p.out[O_M_P + l * 16 + (cu >> 6)] = mn;
      }
    }
    __syncthreads();
    for (int i = tid; i < 1024; i += 256) {
      int s = i >> 4, d4 = (i & 15) * 4;
      const int t = token0 + s;
      float wsv = expf(FL - p.Fc()[(size_t)t * 4 + h] + p.ig()[(size_t)t * 4 + h] - mn);
      float4 k4 = *reinterpret_cast<const float4*>(p.km() + (size_t)t * 256 + h * 64 + d4);
      float4 v4 = *reinterpret_cast<const float4*>(p.P5() + (size_t)t * 1280 + 256 + h * 64 + d4);
      *reinterpret_cast<float4*>(s_k + s * 64 + d4) = make_float4(k4.x * wsv, k4.y * wsv, k4.z * wsv, k4.w * wsv);
      *reinterpret_cast<float4*>(s_v + s * 64 + d4) = v4;
    }
    __syncthreads();
    f32x16 acc; zero16(acc);
    mfma32_f32<64>(acc, s_k + ti * 32, 1, 64, s_v + tj * 32, 64, 1, lane);
#pragma unroll
    for (int r = 0; r < 16; ++r) {
      const int d = ti * 32 + (r & 3) + 8 * (r >> 2) + 4 * (lane >> 5);
      p.U()[(size_t)cu * 4096 + d * 64 + tj * 32 + (lane & 31)] = acc[r];
    }
    if (tid < 64) {
      float s0 = 0.f;
      for (int s = 0; s < 64; ++s) s0 += s_k[s * 64 + tid];
      p.un()[(size_t)cu * 64 + tid] = s0;
    }
  }
}

__device__ __forceinline__ void ph_mlscan(const Params& p, int l, int bid, int nblk) {
  const size_t gtid = (size_t)bid * 256 + tid_opaque(), gsz = (size_t)nblk * 256;
  const size_t NPC = 16 * 4096, NSC = 32 * 4096, NPN = 16 * 64, NSN = 32 * 64;
  for (size_t i = gtid; i < NPC + NSC + NPN + NSN; i += gsz) {
    if (i < NPC) {
      int bh = (int)(i >> 12), e = (int)(i & 4095);
      float C = 0.f;
      for (int c = 0; c < 64; ++c) {
        int cu = bh * 64 + c;
        p.Cst()[(size_t)cu * 4096 + e] = C;
        C = p.wcs()[cu] * C + p.U()[(size_t)cu * 4096 + e];
      }
      p.out[O_C_P + (size_t)l * (16 * 4096) + i] = C;
    } else if (i < NPC + NSC) {
      size_t j = i - NPC; int us = (int)(j >> 12), e = (int)(j & 4095); int cu = 1024 + us;
      float C = p.st_c()[(size_t)l * (32 * 4096) + j];
      p.Cst()[(size_t)cu * 4096 + e] = C;
      p.out[O_C_S + (size_t)l * (32 * 4096) + j] = p.wcs()[cu] * C + p.U()[(size_t)cu * 4096 + e];
    } else if (i < NPC + NSC + NPN) {
      size_t j = i - NPC - NSC; int bh = (int)(j >> 6), d = (int)(j & 63);
      float n = 0.f;
      for (int c = 0; c < 64; ++c) {
        int cu = bh * 64 + c;
        p.nst()[(size_t)cu * 64 + d] = n;
        n = p.wcs()[cu] * n + p.un()[(size_t)cu * 64 + d];
      }
      p.out[O_N_P + (size_t)l * (16 * 64) + j] = n;
    } else {
      size_t j = i - NPC - NSC - NPN; int us = (int)(j >> 6), d = (int)(j & 63); int cu = 1024 + us;
      float n = p.st_n()[(size_t)l * (32 * 64) + j];
      p.nst()[(size_t)cu * 64 + d] = n;
      p.out[O_N_S + (size_t)l * (32 * 64) + j] = p.wcs()[cu] * n + p.un()[(size_t)cu * 64 + d];
    }
  }
}

__device__ __forceinline__ void ph_mlout(const Params& p, int l, char* smem, int bid, int nblk) {
  const int tid = tid_opaque();
  float* s_q = reinterpret_cast<float*>(smem);
  float* s_k = s_q + 64 * 65;
  float* s_v = s_k + 64 * 65;
  float* s_C = s_v + 4096;
  float* s_F = s_C + 4096;
  float* s_a = s_F + 64;
  float* s_mt = s_a + 64;
  float* s_iw = s_mt + 64;
  float* s_n = s_iw + 64;
  float* s_den = s_n + 64;
  float* s_denp = s_den + 64;
  float* s_qn = s_denp + 128;
  for (int cu = bid; cu < NCU_UNITS; cu += nblk) {
    int token0, h; cu_decode(cu, token0, h);
    const float m0 = p.mst()[cu];
    __syncthreads();
    for (int i = tid; i < 1024; i += 256) {
      int s = i >> 4, d4 = (i & 15) * 4;
      const int t = token0 + s;
      float4 q4 = *reinterpret_cast<const float4*>(p.qm() + (size_t)t * 256 + h * 64 + d4);
      float4 k4 = *reinterpret_cast<const float4*>(p.km() + (size_t)t * 256 + h * 64 + d4);
      float4 v4 = *reinterpret_cast<const float4*>(p.P5() + (size_t)t * 1280 + 256 + h * 64 + d4);
      float4 c4 = *reinterpret_cast<const float4*>(p.Cst() + (size_t)cu * 4096 + s * 64 + d4);
      s_q[s * 65 + d4] = q4.x; s_q[s * 65 + d4 + 1] = q4.y; s_q[s * 65 + d4 + 2] = q4.z; s_q[s * 65 + d4 + 3] = q4.w;
      s_k[s * 65 + d4] = k4.x; s_k[s * 65 + d4 + 1] = k4.y; s_k[s * 65 + d4 + 2] = k4.z; s_k[s * 65 + d4 + 3] = k4.w;
      *reinterpret_cast<float4*>(s_v + s * 64 + d4) = v4;
      *reinterpret_cast<float4*>(s_C + s * 64 + d4) = c4;
    }
    if (tid < 64) {
      const int t = token0 + tid;
      float F = p.Fc()[(size_t)t * 4 + h], g = p.ig()[(size_t)t * 4 + h];
      s_F[tid] = F; s_a[tid] = g - F;
      s_n[tid] = p.nst()[(size_t)cu * 64 + tid];
    }
    __syncthreads();
    if (tid < 64) {
      float pm = s_a[tid];
#pragma unroll
      for (int d = 1; d < 64; d <<= 1) { const float o = shfl_up_l(pm, d, tid); if (tid >= d) pm = fmaxf(pm, o); }
      float F = s_F[tid];
      float mt = F + fmaxf(m0, pm);
      s_mt[tid] = mt;
      s_iw[tid] = expf(F + m0 - mt);
    }
    __syncthreads();
    const int lane = tid & 63, w = __builtin_amdgcn_readfirstlane(tid >> 6), ti = w >> 1, tj = w & 1;
    const int ty = tid >> 4, tx = tid & 15;
    {
      f32x16 accS; zero16(accS);
      mfma32_f32<64>(accS, s_q + ti * 32 * 65, 65, 1, s_k + tj * 32 * 65, 1, 65, lane);
      __syncthreads();
      const int s = tj * 32 + (lane & 31);
      const float as = s_a[s];
#pragma unroll
      for (int r = 0; r < 16; ++r) {
        const int t = ti * 32 + (r & 3) + 8 * (r >> 2) + 4 * (lane >> 5);
        const float sw = (s <= t) ? accS[r] * expf(s_F[t] + as - s_mt[t]) : 0.f;
        s_k[t * 65 + s] = sw;
        const float rsum = swap16_sum(row16_sum(sw));
        if ((lane & 31) == 0) s_denp[tj * 64 + t] = rsum;
      }
    }
    {
      const int t = tid >> 2, part = tid & 3;
      float qn = 0.f;
#pragma unroll
      for (int d = 0; d < 16; ++d) qn += s_q[t * 65 + part * 16 + d] * s_n[part * 16 + d];
      qn += dpp_f<0xB1>(qn); qn += dpp_f<0x4E>(qn);
      if (part == 0) s_qn[t] = qn;
    }
    __syncthreads();
    if (tid < 64) s_den[tid] = s_denp[tid] + s_denp[64 + tid] + s_iw[tid] * s_qn[tid];
    {
      f32x16 accN, accC; zero16(accN); zero16(accC);
      mfma32_f32<64>(accN, s_k + ti * 32 * 65, 65, 1, s_v + tj * 32, 64, 1, lane);
      mfma32_f32<64>(accC, s_q + ti * 32 * 65, 65, 1, s_C + tj * 32, 64, 1, lane);
      __syncthreads();
#pragma unroll
      for (int r = 0; r < 16; ++r) {
        const int t = ti * 32 + (r & 3) + 8 * (r >> 2) + 4 * (lane >> 5);
        s_q[t * 65 + tj * 32 + (lane & 31)] = accN[r] + s_iw[t] * accC[r];
      }
    }
    __syncthreads();
#pragma unroll
    for (int i = 0; i < 4; ++i) {
      const int t = ty * 4 + i;
      const float dn = fmaxf(fabsf(s_den[t]), expf(-s_mt[t]));
      float hv[4]; float ss = 0.f;
#pragma unroll
      for (int j = 0; j < 4; ++j) { hv[j] = s_q[t * 65 + tx * 4 + j] / dn; ss += hv[j] * hv[j]; }
      ss = row16_sum(ss);
      const float rn = rsqrtf(ss * (1.f / 64.f) + EPS);
      const int ch = h * 64 + tx * 4;
      const size_t tg = (size_t)(token0 + t);
      float4 g4 = *reinterpret_cast<const float4*>(p.ml_norm_g() + l * 256 + ch);
      float4 k4 = *reinterpret_cast<const float4*>(p.ml_skip() + l * 256 + ch);
      float4 c4 = *reinterpret_cast<const float4*>(p.cc() + tg * 256 + ch);
      float4 o4 = *reinterpret_cast<const float4*>(p.P5() + tg * 1280 + 512 + ch);
      float r0 = (hv[0] * rn * g4.x + k4.x * c4.x) * sigmoidf_(o4.x);
      float r1 = (hv[1] * rn * g4.y + k4.y * c4.y) * sigmoidf_(o4.y);
      float r2 = (hv[2] * rn * g4.z + k4.z * c4.z) * sigmoidf_(o4.z);
      float r3 = (hv[3] * rn * g4.w + k4.w * c4.w) * sigmoidf_(o4.w);
      *reinterpret_cast<uint2*>(p.xn() + tg * 1024 + 512 + ch) = make_uint2(pack2(r0, r1), pack2(r2, r3));
    }
  }
}

__device__ __forceinline__ void ph_cmlp(const Params& p, int l, char* smem, const WorkQ& wq, int item) {
  const int tid = tid_opaque(), lane = tid & 63, w = __builtin_amdgcn_readfirstlane(tid >> 6);
  float* s_vg = reinterpret_cast<float*>(smem);
  float* s_ws = s_vg + 128 * 64;
  float* s_r = s_ws + 128 * 33;
  for (; item < 1056 + 264 * 4 + 544; item = wq_next(wq)) {
    const int u = item - (1056 + 264 * 4);
    const int g = u & 3, ci = u >> 2;
    const bool samp = ci >= 128;
    const int L = samp ? 64 : 128;
    const int token0 = samp ? NPROMPT + (ci - 128) * 64 : ci * 128;
    __syncthreads();
    for (int r = w; r < L; r += 4) {
      float4 v = *reinterpret_cast<const float4*>(p.P5() + (size_t)(token0 + r) * 1280 + 1024 + lane * 4);
      float ss = v.x * v.x + v.y * v.y + v.z * v.z + v.w * v.w;
      ss = wave_sum(ss);
      if (lane == 0) s_r[r] = rsqrtf(ss * (1.f / 256.f) + EPS);
    }
    __syncthreads();
    for (int i = tid; i < L * 16; i += 256) {
      int s = i >> 4, d4 = (i & 15) * 4;
      float4 v = *reinterpret_cast<const float4*>(p.P5() + (size_t)(token0 + s) * 1280 + 1024 + g * 64 + d4);
      float4 gn = *reinterpret_cast<const float4*>(p.cm_norm_g() + l * 256 + g * 64 + d4);
      float r = s_r[s];
      float4 o = make_float4(v.x * r * gn.x, v.y * r * gn.y, v.z * r * gn.z, v.w * r * gn.w);
      *reinterpret_cast<float4*>(s_vg + s * 64 + d4) = o;
      if (samp) {
        int ts = token0 - NPROMPT + s;
        *reinterpret_cast<float4*>(p.out + O_CMV_S + (size_t)l * (512 * 256) + (size_t)ts * 256 + g * 64 + d4) = o;
      }
    }
    const int rtA = (w < 2) ? 3 : 2, rtB = (w < 2) ? 0 : 1, ct = w & 1;
    const int nrt = L >> 5;
    f32x16 accA, accB; zero16(accA); zero16(accB);
    const float* wsg = p.cm_ws() + (size_t)(l * 4 + g) * 128 * 128;
    for (int s0 = 0; s0 < L; s0 += 32) {
      __syncthreads();
      for (int i = tid; i < L * 32; i += 256) {
        int t = i >> 5, ss = i & 31;
        s_ws[t * 33 + ss] = (s0 + ss <= t) ? wsg[t * 128 + s0 + ss] : 0.f;
      }
      __syncthreads();
      const int c = s0 >> 5;
      if (rtA < nrt && c <= rtA) mfma32_f32<32>(accA, s_ws + rtA * 32 * 33, 33, 1, s_vg + s0 * 64 + ct * 32, 64, 1, lane);
      if (rtB < nrt && c <= rtB) mfma32_f32<32>(accB, s_ws + rtB * 32 * 33, 33, 1, s_vg + s0 * 64 + ct * 32, 64, 1, lane);
    }
    __syncthreads();
#pragma unroll
    for (int r = 0; r < 16; ++r) {
      const int tr = (r & 3) + 8 * (r >> 2) + 4 * (lane >> 5);
      if (rtA < nrt) s_vg[(rtA * 32 + tr) * 64 + ct * 32 + (lane & 31)] = accA[r];
      if (rtB < nrt) s_vg[(rtB * 32 + tr) * 64 + ct * 32 + (lane & 31)] = accB[r];
    }
    __syncthreads();
    {
      const int ty = tid >> 4, tx = tid & 15;
      if (ty * 8 < L) {
#pragma unroll
        for (int i = 0; i < 8; ++i) {
          const int t = ty * 8 + i;
          const float bb = p.cm_b()[(l * 4 + g) * 128 + t];
          const size_t tg = (size_t)(token0 + t);
          float4 a4 = *reinterpret_cast<const float4*>(s_vg + t * 64 + tx * 4);
          float4 u4 = *reinterpret_cast<const float4*>(p.P5() + tg * 1280 + 768 + g * 64 + tx * 4);
          *reinterpret_cast<uint2*>(p.xn() + tg * 1024 + 768 + g * 64 + tx * 4) =
              make_uint2(pack2(u4.x * (a4.x + bb), u4.y * (a4.y + bb)), pack2(u4.z * (a4.z + bb), u4.w * (a4.w + bb)));
        }
      }
    }
  }
}

__device__ __forceinline__ void ph_topk(const Params& p, int l, char* smem, int bid, int nblk) {
  const int tid = tid_opaque(), lane = tid & 63, w = __builtin_amdgcn_readfirstlane(tid >> 6);
  float* s_tile = reinterpret_cast<float*>(smem) + w * (64 * 33);
  int* s_list = reinterpret_cast<int*>(smem + 4 * 64 * 33 * 4) + w * (2 * 16 * 64);
  float* s_ss = reinterpret_cast<float*>(smem + 4 * 64 * 33 * 4 + 4 * 2 * 16 * 64 * 4) + w * 64;
  for (int u = bid * 4 + w; u < 264 * 8; u += nblk * 4) {
    const int tg = u >> 3, h = u & 7;
    const int t0 = tg * 64;
    {
      const float4 pp = *reinterpret_cast<const float4*>(p.ssp() + (size_t)(t0 + lane) * 32 + h * 4);
      s_ss[lane] = pp.x + pp.y + pp.z + pp.w;
    }
    int L1[16], L2[16];
#pragma unroll
    for (int j = 0; j < 16; ++j) { L1[j] = (int)0x80000000; L2[j] = (int)0x80000000; }
#pragma unroll
    for (int c = 0; c < 2; ++c) {
      const int4* la = reinterpret_cast<const int4*>(p.tl() + (((size_t)(t0 + lane) * 16 + h * 2 + c) * 2) * 16);
      int A[16], B[16];
#pragma unroll
      for (int q = 0; q < 4; ++q) {
        const int4 a = la[q], b = la[4 + q];
        A[4 * q] = a.x; A[4 * q + 1] = a.y; A[4 * q + 2] = a.z; A[4 * q + 3] = a.w;
        B[4 * q] = b.x; B[4 * q + 1] = b.y; B[4 * q + 2] = b.z; B[4 * q + 3] = b.w;
      }
#pragma unroll
      for (int j = 0; j < 16; ++j) INS16(A, B[j])
#pragma unroll
      for (int j = 0; j < 16; ++j) { if (c == 0) L1[j] = A[j]; else L2[j] = A[j]; }
    }
#pragma unroll
    for (int j = 0; j < 16; ++j) { s_list[(0 * 16 + j) * 64 + lane] = 127 - (L1[j] & 127); s_list[(1 * 16 + j) * 64 + lane] = 127 - (L2[j] & 127); }
    float v1[16], v2[16];
#pragma unroll
    for (int j = 0; j < 16; ++j) { v1[j] = mono_val(L1[j] & ~127); v2[j] = mono_val(L2[j] & ~127); }
    int LC[16];
#pragma unroll
    for (int j = 0; j < 16; ++j) LC[j] = (int)0x80000000;
#pragma unroll
    for (int i = 0; i < 16; ++i)
#pragma unroll
      for (int j = 0; j < 16; ++j)
        if ((i + 1) * (j + 1) <= 16) {
          int key = (mono_key(v1[i] + v2[j]) & ~255) | (255 - (i * 16 + j));
          INS16(LC, key)
        }
    const float scale = rsqrtf(s_ss[lane] * (1.f / 256.f) + EPS);
    float vs[16]; float den = 0.f;
    const float top = mono_val(LC[0] & ~255);
#pragma unroll
    for (int k = 0; k < 16; ++k) { vs[k] = __expf((mono_val(LC[k] & ~255) - top) * scale); den += vs[k]; }
    const float inv = 1.f / den;
    const size_t ob = (size_t)(t0 + lane) * 128 + h * 16;
#pragma unroll
    for (int k4 = 0; k4 < 4; ++k4) {
      int ee[4]; float gg[4], su[4];
#pragma unroll
      for (int q = 0; q < 4; ++q) {
        int k = k4 * 4 + q;
        int ci = 255 - (LC[k] & 255);
        int i1 = s_list[(0 * 16 + (ci >> 4)) * 64 + lane];
        int i2 = s_list[(1 * 16 + (ci & 15)) * 64 + lane];
        ee[q] = i1 * 128 + i2;
        gg[q] = vs[k] * inv * p.vs()[l * 16384 + ee[q]];
        su[q] = p.us()[l * 16384 + ee[q]];
      }
      *reinterpret_cast<int4*>(p.eidx() + ob + k4 * 4) = make_int4(ee[0], ee[1], ee[2], ee[3]);
      *reinterpret_cast<float4*>(p.egate() + ob + k4 * 4) = make_float4(gg[0], gg[1], gg[2], gg[3]);
      *reinterpret_cast<float4*>(p.esu() + ob + k4 * 4) = make_float4(su[0], su[1], su[2], su[3]);
    }
  }
}

__device__ __forceinline__ float dot16_fp8(const float* xf, uint4 u) {
  f32x2 a0 = __builtin_amdgcn_cvt_pk_f32_fp8(u.x, false), a1 = __builtin_amdgcn_cvt_pk_f32_fp8(u.x, true);
  f32x2 a2 = __builtin_amdgcn_cvt_pk_f32_fp8(u.y, false), a3 = __builtin_amdgcn_cvt_pk_f32_fp8(u.y, true);
  f32x2 a4 = __builtin_amdgcn_cvt_pk_f32_fp8(u.z, false), a5 = __builtin_amdgcn_cvt_pk_f32_fp8(u.z, true);
  f32x2 a6 = __builtin_amdgcn_cvt_pk_f32_fp8(u.w, false), a7 = __builtin_amdgcn_cvt_pk_f32_fp8(u.w, true);
  float s0 = xf[0] * a0.x, s1 = xf[1] * a0.y;
  s0 = fmaf(xf[2], a1.x, s0); s1 = fmaf(xf[3], a1.y, s1);
  s0 = fmaf(xf[4], a2.x, s0); s1 = fmaf(xf[5], a2.y, s1);
  s0 = fmaf(xf[6], a3.x, s0); s1 = fmaf(xf[7], a3.y, s1);
  s0 = fmaf(xf[8], a4.x, s0); s1 = fmaf(xf[9], a4.y, s1);
  s0 = fmaf(xf[10], a5.x, s0); s1 = fmaf(xf[11], a5.y, s1);
  s0 = fmaf(xf[12], a6.x, s0); s1 = fmaf(xf[13], a6.y, s1);
  s0 = fmaf(xf[14], a7.x, s0); s1 = fmaf(xf[15], a7.y, s1);
  return s0 + s1;
}
__device__ __forceinline__ void axpy16_fp8(float* y, float wgt, uint4 v) {
  f32x2 a0 = __builtin_amdgcn_cvt_pk_f32_fp8(v.x, false), a1 = __builtin_amdgcn_cvt_pk_f32_fp8(v.x, true);
  f32x2 a2 = __builtin_amdgcn_cvt_pk_f32_fp8(v.y, false), a3 = __builtin_amdgcn_cvt_pk_f32_fp8(v.y, true);
  f32x2 a4 = __builtin_amdgcn_cvt_pk_f32_fp8(v.z, false), a5 = __builtin_amdgcn_cvt_pk_f32_fp8(v.z, true);
  f32x2 a6 = __builtin_amdgcn_cvt_pk_f32_fp8(v.w, false), a7 = __builtin_amdgcn_cvt_pk_f32_fp8(v.w, true);
  y[0] = fmaf(wgt, a0.x, y[0]); y[1] = fmaf(wgt, a0.y, y[1]); y[2] = fmaf(wgt, a1.x, y[2]); y[3] = fmaf(wgt, a1.y, y[3]);
  y[4] = fmaf(wgt, a2.x, y[4]); y[5] = fmaf(wgt, a2.y, y[5]); y[6] = fmaf(wgt, a3.x, y[6]); y[7] = fmaf(wgt, a3.y, y[7]);
  y[8] = fmaf(wgt, a4.x, y[8]); y[9] = fmaf(wgt, a4.y, y[9]); y[10] = fmaf(wgt, a5.x, y[10]); y[11] = fmaf(wgt, a5.y, y[11]);
  y[12] = fmaf(wgt, a6.x, y[12]); y[13] = fmaf(wgt, a6.y, y[13]); y[14] = fmaf(wgt, a7.x, y[14]); y[15] = fmaf(wgt, a7.y, y[15]);
}

template <bool DRY>
__device__ __forceinline__ void ph_gather(const Params& p, int l, int bid, int nblk) {
  const int lane = tid_opaque() & 63, w = __builtin_amdgcn_readfirstlane(tid_opaque() >> 6);
  const unsigned char* u8 = p.ub8() + (size_t)l * 16384 * 1024;
  const unsigned char* v8 = p.vb8() + (size_t)l * 16384 * 1024;
  const unsigned loff = (unsigned)lane * 16u;
  for (int t = bid * 4 + w; t < NTOK; t += nblk * 4) {
    float xf[16];
    {
      const uint4 xa = *reinterpret_cast<const uint4*>(p.xn() + (size_t)t * 1024 + lane * 16);
      const uint4 xb = *reinterpret_cast<const uint4*>(p.xn() + (size_t)t * 1024 + lane * 16 + 8);
      xf[0] = bf_lo(xa.x); xf[1] = bf_hi(xa.x); xf[2] = bf_lo(xa.y); xf[3] = bf_hi(xa.y);
      xf[4] = bf_lo(xa.z); xf[5] = bf_hi(xa.z); xf[6] = bf_lo(xa.w); xf[7] = bf_hi(xa.w);
      xf[8] = bf_lo(xb.x); xf[9] = bf_hi(xb.x); xf[10] = bf_lo(xb.y); xf[11] = bf_hi(xb.y);
      xf[12] = bf_lo(xb.z); xf[13] = bf_hi(xb.z); xf[14] = bf_lo(xb.w); xf[15] = bf_hi(xb.w);
    }
    const int e_lo = p.eidx()[(size_t)t * 128 + lane], e_hi = p.eidx()[(size_t)t * 128 + 64 + lane];
    const float g_lo = p.egate()[(size_t)t * 128 + lane], g_hi = p.egate()[(size_t)t * 128 + 64 + lane];
    const float s_lo = p.esu()[(size_t)t * 128 + lane], s_hi = p.esu()[(size_t)t * 128 + 64 + lane];
    float y[16];
#pragma unroll
    for (int i = 0; i < 16; ++i) y[i] = 0.f;
#pragma unroll 1
    for (int k0 = 0; k0 < 128; k0 += 8) {
      uint4 ur[8], vr[8];
#pragma unroll
      for (int q = 0; q < 8; ++q) {
        const int kk = (k0 & 63) + q;
        const int e = (k0 < 64) ? __builtin_amdgcn_readlane(e_lo, kk) : __builtin_amdgcn_readlane(e_hi, kk);
        ur[q] = *reinterpret_cast<const uint4*>(u8 + (size_t)e * 1024 + loff);
        vr[q] = *reinterpret_cast<const uint4*>(v8 + (size_t)e * 1024 + loff);
      }
#pragma unroll
      for (int q = 0; q < 8; ++q) {
        const int kk = (k0 & 63) + q;
        const float gt = __int_as_float((k0 < 64) ? __builtin_amdgcn_readlane(__float_as_int(g_lo), kk) : __builtin_amdgcn_readlane(__float_as_int(g_hi), kk));
        const float su = __int_as_float((k0 < 64) ? __builtin_amdgcn_readlane(__float_as_int(s_lo), kk) : __builtin_amdgcn_readlane(__float_as_int(s_hi), kk));
        float d = wave_sum(dot16_fp8(xf, ur[q])) * su;
        const float wgt = gt * gelu_exact(d);
        axpy16_fp8(y, wgt, vr[q]);
      }
    }
    if (DRY) {
#pragma unroll
      for (int i = 0; i < 16; ++i) asm volatile("" ::"v"(y[i]));
      continue;
    }
    float* xr = p.x() + (size_t)t * 1024 + lane * 16;
#pragma unroll
    for (int j = 0; j < 4; ++j) {
      float4 a = reinterpret_cast<float4*>(xr)[j];
      a.x += y[4 * j]; a.y += y[4 * j + 1]; a.z += y[4 * j + 2]; a.w += y[4 * j + 3];
      reinterpret_cast<float4*>(xr)[j] = a;
    }
  }
}

enum { PH_PREP = 0, PH_NORM1, PH_GEMM_IN, PH_ATTN, PH_MLCONV, PH_MCHAIN, PH_MLU, PH_MLSCAN, PH_MLOUT, PH_CMLP,
       PH_GEMM_OUT, PH_NORM2, PH_GEMM_PQ, PH_GEMM_SC, PH_TOPK, PH_GATHER, PH_FINAL };

__device__ __forceinline__ Params phase_params(const Params& kp, bool with_inputs, bool with_tables = false) {
  Params q;
  size_t z = 0;
  asm volatile("" : "+s"(z));
  q.out = kp.out + z;
  q.ws = kp.ws + z;
  q.in[0] = kp.in[0] + z;
  q.in[1] = kp.in[1] + z;
  if (with_inputs) {
#pragma unroll
    for (int i = 2; i < 30; ++i) q.in[i] = kp.in[i] + z;
  }
  if (with_tables) { q.in[27] = kp.in[27] + z; q.in[28] = kp.in[28] + z; }
  return q;
}


#define GT 4
typedef __attribute__((ext_vector_type(4))) float f32x4;

__device__ __forceinline__ float dot16_fp8v(const f32x2* x2, uint4 u) {
  f32x2 acc = x2[0] * __builtin_amdgcn_cvt_pk_f32_fp8(u.x, false);
  acc += x2[1] * __builtin_amdgcn_cvt_pk_f32_fp8(u.x, true);
  acc += x2[2] * __builtin_amdgcn_cvt_pk_f32_fp8(u.y, false);
  acc += x2[3] * __builtin_amdgcn_cvt_pk_f32_fp8(u.y, true);
  acc += x2[4] * __builtin_amdgcn_cvt_pk_f32_fp8(u.z, false);
  acc += x2[5] * __builtin_amdgcn_cvt_pk_f32_fp8(u.z, true);
  acc += x2[6] * __builtin_amdgcn_cvt_pk_f32_fp8(u.w, false);
  acc += x2[7] * __builtin_amdgcn_cvt_pk_f32_fp8(u.w, true);
  return acc.x + acc.y;
}
__device__ __forceinline__ void axpy16_fp8v(f32x2* y2, float wgt, uint4 v) {
  const f32x2 w2 = {wgt, wgt};
  y2[0] += w2 * __builtin_amdgcn_cvt_pk_f32_fp8(v.x, false);
  y2[1] += w2 * __builtin_amdgcn_cvt_pk_f32_fp8(v.x, true);
  y2[2] += w2 * __builtin_amdgcn_cvt_pk_f32_fp8(v.y, false);
  y2[3] += w2 * __builtin_amdgcn_cvt_pk_f32_fp8(v.y, true);
  y2[4] += w2 * __builtin_amdgcn_cvt_pk_f32_fp8(v.z, false);
  y2[5] += w2 * __builtin_amdgcn_cvt_pk_f32_fp8(v.z, true);
  y2[6] += w2 * __builtin_amdgcn_cvt_pk_f32_fp8(v.w, false);
  y2[7] += w2 * __builtin_amdgcn_cvt_pk_f32_fp8(v.w, true);
}

struct GU { uint4 ur[4]; f32x4 su; };
struct GV { uint4 vr[4]; f32x4 gt; };
#define GREC 384
__device__ __forceinline__ void gload_u(GU& U, const float* rec, int i4, const unsigned char* u8, unsigned loff) {
  const f32x4 ev = *reinterpret_cast<const f32x4*>(rec + i4);
  U.su = *reinterpret_cast<const f32x4*>(rec + 256 + i4);
  const int e0 = __builtin_amdgcn_readfirstlane(__float_as_int(ev.x)), e1 = __builtin_amdgcn_readfirstlane(__float_as_int(ev.y));
  const int e2 = __builtin_amdgcn_readfirstlane(__float_as_int(ev.z)), e3 = __builtin_amdgcn_readfirstlane(__float_as_int(ev.w));
  U.ur[0] = *reinterpret_cast<const uint4*>(u8 + (size_t)e0 * 1024 + loff);
  U.ur[1] = *reinterpret_cast<const uint4*>(u8 + (size_t)e1 * 1024 + loff);
  U.ur[2] = *reinterpret_cast<const uint4*>(u8 + (size_t)e2 * 1024 + loff);
  U.ur[3] = *reinterpret_cast<const uint4*>(u8 + (size_t)e3 * 1024 + loff);
}
__device__ __forceinline__ void gload_v(GV& V, const float* rec, int i4, const unsigned char* v8, unsigned loff) {
  const f32x4 ev = *reinterpret_cast<const f32x4*>(rec + i4);
  V.gt = *reinterpret_cast<const f32x4*>(rec + 128 + i4);
  const int e0 = __builtin_amdgcn_readfirstlane(__float_as_int(ev.x)), e1 = __builtin_amdgcn_readfirstlane(__float_as_int(ev.y));
  const int e2 = __builtin_amdgcn_readfirstlane(__float_as_int(ev.z)), e3 = __builtin_amdgcn_readfirstlane(__float_as_int(ev.w));
  V.vr[0] = *reinterpret_cast<const uint4*>(v8 + (size_t)e0 * 1024 + loff);
  V.vr[1] = *reinterpret_cast<const uint4*>(v8 + (size_t)e1 * 1024 + loff);
  V.vr[2] = *reinterpret_cast<const uint4*>(v8 + (size_t)e2 * 1024 + loff);
  V.vr[3] = *reinterpret_cast<const uint4*>(v8 + (size_t)e3 * 1024 + loff);
}
__device__ __forceinline__ float gelu_as(float z) {
  const float x = fabsf(z) * 0.70710678118654752f;
  const float t = __builtin_amdgcn_rcpf(fmaf(0.3275911f, x, 1.f));
  float pl = fmaf(1.061405429f, t, -1.453152027f);
  pl = fmaf(pl, t, 1.421413741f); pl = fmaf(pl, t, -0.284496736f); pl = fmaf(pl, t, 0.254829592f);
  const float e = __builtin_amdgcn_exp2f(-x * x * LOG2E);
  const float erfa = 1.f - pl * t * e;
  return 0.5f * z + 0.5f * fabsf(z) * erfa;
}
template <int PAT>
__device__ __forceinline__ float swz_f(float v) { return __int_as_float(__builtin_amdgcn_ds_swizzle(__float_as_int(v), PAT)); }

__device__ __forceinline__ void gstep2(GU& UA, GV& VA, GU& UB, GV& VB, const uint4* xlA, const uint4* xlB, f32x2* yA, f32x2* yB,
                                       const float* recA, const float* recB, int ci4, const float* nxtA, const float* nxtB, int ni4,
                                       const unsigned char* u8, const unsigned char* v8, unsigned loff, int lane) {
  float d[8];
  {
    f32x2 x2[8];
    const uint4 xa = xlA[0], xb = xlA[1];
    x2[0] = f32x2{bf_lo(xa.x), bf_hi(xa.x)}; x2[1] = f32x2{bf_lo(xa.y), bf_hi(xa.y)};
    x2[2] = f32x2{bf_lo(xa.z), bf_hi(xa.z)}; x2[3] = f32x2{bf_lo(xa.w), bf_hi(xa.w)};
    x2[4] = f32x2{bf_lo(xb.x), bf_hi(xb.x)}; x2[5] = f32x2{bf_lo(xb.y), bf_hi(xb.y)};
    x2[6] = f32x2{bf_lo(xb.z), bf_hi(xb.z)}; x2[7] = f32x2{bf_lo(xb.w), bf_hi(xb.w)};
#pragma unroll
    for (int q = 0; q < 4; ++q) d[q] = dot16_fp8v(x2, UA.ur[q]);
  }
  gload_u(UA, nxtA, ni4, u8, loff);
  {
    f32x2 x2[8];
    const uint4 xa = xlB[0], xb = xlB[1];
    x2[0] = f32x2{bf_lo(xa.x), bf_hi(xa.x)}; x2[1] = f32x2{bf_lo(xa.y), bf_hi(xa.y)};
    x2[2] = f32x2{bf_lo(xa.z), bf_hi(xa.z)}; x2[3] = f32x2{bf_lo(xa.w), bf_hi(xa.w)};
    x2[4] = f32x2{bf_lo(xb.x), bf_hi(xb.x)}; x2[5] = f32x2{bf_lo(xb.y), bf_hi(xb.y)};
    x2[6] = f32x2{bf_lo(xb.z), bf_hi(xb.z)}; x2[7] = f32x2{bf_lo(xb.w), bf_hi(xb.w)};
#pragma unroll
    for (int q = 0; q < 4; ++q) d[4 + q] = dot16_fp8v(x2, UB.ur[q]);
  }
  gload_u(UB, nxtB, ni4, u8, loff);
  const bool b0 = lane & 1, b1 = lane & 2, b2 = lane & 4;
  float a[4];
#pragma unroll
  for (int j = 0; j < 4; ++j) {
    const float keep = b0 ? d[4 + j] : d[j], send = b0 ? d[j] : d[4 + j];
    a[j] = keep + dpp_f<0xB1>(send);
  }
  float c2[2];
#pragma unroll
  for (int j = 0; j < 2; ++j) {
    const float keep = b1 ? a[2 + j] : a[j], send = b1 ? a[j] : a[2 + j];
    c2[j] = keep + dpp_f<0x4E>(send);
  }
  float tot;
  {
    const float keep = b2 ? c2[1] : c2[0], send = b2 ? c2[0] : c2[1];
    tot = keep + swz_f<0x101F>(send);
  }
  tot += swz_f<0x201F>(tot);
  tot = swap32_sum(swap16_sum(tot));
  const int pq = ((lane >> 1) & 1) * 2 + ((lane >> 2) & 1);
  const float* rl = (b0 ? recB : recA) + ci4 + pq;
  const float z = tot * rl[256];
  const float wv = rl[128] * gelu_as(z);
#pragma unroll
  for (int q = 0; q < 4; ++q) {
    const int ln = ((q >> 1) & 1) * 2 + (q & 1) * 4;
    const float wa = __int_as_float(__builtin_amdgcn_readlane(__float_as_int(wv), ln));
    const float wb = __int_as_float(__builtin_amdgcn_readlane(__float_as_int(wv), ln + 1));
    axpy16_fp8v(yA, wa, VA.vr[q]);
    axpy16_fp8v(yB, wb, VB.vr[q]);
  }
  gload_v(VA, nxtA, ni4, v8, loff);
  gload_v(VB, nxtB, ni4, v8, loff);
}

__device__ __forceinline__ void gstep(GU& U, GV& V, const uint4* xl, f32x2* y2, const float* nrec, int ni4,
                                      const unsigned char* u8, const unsigned char* v8, unsigned loff, int lane) {
  f32x2 x2[8];
  {
    const uint4 xa = xl[0], xb = xl[1];
    x2[0] = f32x2{bf_lo(xa.x), bf_hi(xa.x)}; x2[1] = f32x2{bf_lo(xa.y), bf_hi(xa.y)};
    x2[2] = f32x2{bf_lo(xa.z), bf_hi(xa.z)}; x2[3] = f32x2{bf_lo(xa.w), bf_hi(xa.w)};
    x2[4] = f32x2{bf_lo(xb.x), bf_hi(xb.x)}; x2[5] = f32x2{bf_lo(xb.y), bf_hi(xb.y)};
    x2[6] = f32x2{bf_lo(xb.z), bf_hi(xb.z)}; x2[7] = f32x2{bf_lo(xb.w), bf_hi(xb.w)};
  }
  float d[4], su[4];
#pragma unroll
  for (int q = 0; q < 4; ++q) { d[q] = dot16_fp8v(x2, U.ur[q]); su[q] = U.su[q]; }
  gload_u(U, nrec, ni4, u8, loff);
#pragma unroll
  for (int q = 0; q < 4; ++q) d[q] = wave_sum(d[q]) * su[q];
  float dv = d[0]; dv = (lane == 1) ? d[1] : dv; dv = (lane == 2) ? d[2] : dv; dv = (lane == 3) ? d[3] : dv;
  const float av = gelu_as(dv);
#pragma unroll
  for (int q = 0; q < 4; ++q) {
    const float act = __int_as_float(__builtin_amdgcn_readlane(__float_as_int(av), q));
    axpy16_fp8v(y2, V.gt[q] * act, V.vr[q]);
  }
  gload_v(V, nrec, ni4, v8, loff);
}

__device__ __forceinline__ void gsort_token(const Params& p, int t, float* rec, int lane) {
  const int e0 = p.eidx()[(size_t)t * 128 + lane], e1 = p.eidx()[(size_t)t * 128 + 64 + lane];
  const float g0 = p.egate()[(size_t)t * 128 + lane], g1 = p.egate()[(size_t)t * 128 + 64 + lane];
  const float q0 = p.esu()[(size_t)t * 128 + lane], q1 = p.esu()[(size_t)t * 128 + 64 + lane];
  int base = 0;
#pragma unroll 4
  for (int s = 0; s < 16; ++s) {
    const unsigned long long m0 = __ballot((e0 >> 10) == s), m1 = __ballot((e1 >> 10) == s);
    const int c0 = __popcll(m0), c1 = __popcll(m1);
    const int p0 = base + (int)__builtin_amdgcn_mbcnt_hi((unsigned)(m0 >> 32), __builtin_amdgcn_mbcnt_lo((unsigned)m0, 0));
    const int p1 = base + c0 + (int)__builtin_amdgcn_mbcnt_hi((unsigned)(m1 >> 32), __builtin_amdgcn_mbcnt_lo((unsigned)m1, 0));
    if ((e0 >> 10) == s) { rec[p0] = __int_as_float(e0); rec[128 + p0] = g0; rec[256 + p0] = q0; }
    if ((e1 >> 10) == s) { rec[p1] = __int_as_float(e1); rec[128 + p1] = g1; rec[256 + p1] = q1; }
    base += c0 + c1;
  }
}
__device__ __forceinline__ void gload_x(const Params& p, int t, uint4* xl, int lane) {
  xl[0] = *reinterpret_cast<const uint4*>(p.xn() + (size_t)t * 1024 + lane * 16);
  xl[1] = *reinterpret_cast<const uint4*>(p.xn() + (size_t)t * 1024 + lane * 16 + 8);
}
template <bool LAST>
__device__ __forceinline__ void gstore_x(const Params& p, int l, int t, const f32x2* y2, int lane) {
  float* xr = p.x() + (size_t)t * 1024 + lane * 16;
  float4 a[4];
  float ss = 0.f;
#pragma unroll
  for (int j = 0; j < 4; ++j) {
    a[j] = reinterpret_cast<float4*>(xr)[j];
    a[j].x += y2[2 * j].x; a[j].y += y2[2 * j].y; a[j].z += y2[2 * j + 1].x; a[j].w += y2[2 * j + 1].y;
    ss += a[j].x * a[j].x + a[j].y * a[j].y + a[j].z * a[j].z + a[j].w * a[j].w;
  }
  ss = wave_sum(ss);
  const float r = rsqrtf(ss * (1.f / 1024.f) + EPS);
  if (LAST) {
    const float* g = p.final_g() + lane * 16;
    float* o = ((t < NPROMPT) ? p.out + O_Y_P + (size_t)t * 1024 : p.out + O_Y_S + (size_t)(t - NPROMPT) * 1024) + lane * 16;
#pragma unroll
    for (int j = 0; j < 4; ++j) {
      const float4 gv = reinterpret_cast<const float4*>(g)[j];
      reinterpret_cast<float4*>(o)[j] = make_float4(a[j].x * r * gv.x, a[j].y * r * gv.y, a[j].z * r * gv.z, a[j].w * r * gv.w);
    }
  } else {
    const float* g = p.norm1_g() + (l + 1) * 1024 + lane * 16;
#pragma unroll
    for (int j = 0; j < 4; ++j) {
      reinterpret_cast<float4*>(xr)[j] = a[j];
      const float4 gv = reinterpret_cast<const float4*>(g)[j];
      a[j].x *= r * gv.x; a[j].y *= r * gv.y; a[j].z *= r * gv.z; a[j].w *= r * gv.w;
    }
    uint4* o = reinterpret_cast<uint4*>(p.xn() + (size_t)t * 1024 + lane * 16);
    o[0] = make_uint4(pack2(a[0].x, a[0].y), pack2(a[0].z, a[0].w), pack2(a[1].x, a[1].y), pack2(a[1].z, a[1].w));
    o[1] = make_uint4(pack2(a[2].x, a[2].y), pack2(a[2].z, a[2].w), pack2(a[3].x, a[3].y), pack2(a[3].z, a[3].w));
    float pre[8];
#pragma unroll
    for (int i = 0; i < 8; ++i) {
      const float4* wr = reinterpret_cast<const float4*>(p.wg() + ((size_t)(l + 1) * 8 + i) * 1024 + lane * 16);
      float s = 0.f;
#pragma unroll
      for (int j = 0; j < 4; ++j) {
        const float4 wv = wr[j];
        s += a[j].x * wv.x + a[j].y * wv.y + a[j].z * wv.z + a[j].w * wv.w;
      }
      pre[i] = wave_sum(s);
    }
    if (lane < 4) {
      float ai = pre[0]; ai = lane == 1 ? pre[1] : ai; ai = lane == 2 ? pre[2] : ai; ai = lane == 3 ? pre[3] : ai;
      float f = pre[4]; f = lane == 1 ? pre[5] : f; f = lane == 2 ? pre[6] : f; f = lane == 3 ? pre[7] : f;
      p.ig()[(size_t)t * 4 + lane] = ai + p.ml_gate_b()[(l + 1) * 8 + lane];
      const float z = f + p.ml_gate_b()[(l + 1) * 8 + 4 + lane];
      p.lf()[(size_t)t * 4 + lane] = fminf(z, 0.f) - log1pf(expf(-fabsf(z)));
    }
  }
}

template <bool LAST>
__device__ __forceinline__ void ph_gather2(const Params& p, int l, char* smem, int bid, int nblk) {
  const int tid = tid_opaque(), lane = tid & 63, w = __builtin_amdgcn_readfirstlane(tid >> 6);
  const unsigned char* u8 = p.ub8() + (size_t)l * 16384 * 1024;
  const unsigned char* v8 = p.vb8() + (size_t)l * 16384 * 1024;
  const unsigned loff = (unsigned)lane * 16u;
  float* rec = reinterpret_cast<float*>(smem) + w * (GT * GREC);
  uint4* xl = reinterpret_cast<uint4*>(smem + 4 * GT * GREC * 4) + (w * GT * 64 + lane) * 2;
  const int rot = 0;
  const int nwaves = nblk * 4, wg = bid * 4 + w;
  const int nfull = (NTOK / (nwaves * GT)) * nwaves;
  for (int grp = wg; grp < nfull; grp += nwaves) {
    const int t0 = grp * GT;
    int lane_s = lane; asm volatile("" : "+v"(lane_s));
#pragma unroll 1
    for (int ti = 0; ti < GT; ++ti) {
      gload_x(p, t0 + ti, xl + ti * 128, lane_s);
      gsort_token(p, t0 + ti, rec + ti * GREC, lane_s);
    }
    f32x2 y2[GT][8];
#pragma unroll
    for (int ti = 0; ti < GT; ++ti)
#pragma unroll
      for (int i = 0; i < 8; ++i) y2[ti][i] = f32x2{0.f, 0.f};
    GU U0, U1; GV V0, V1;
    gload_u(U0, rec, (rot & 31) * 4, u8, loff); gload_v(V0, rec, (rot & 31) * 4, v8, loff);
    gload_u(U1, rec + GREC, (rot & 31) * 4, u8, loff); gload_v(V1, rec + GREC, (rot & 31) * 4, v8, loff);
#pragma unroll 1
    for (int b = 0; b < 32; ++b) {
      const int bo = ((b + rot) & 31) * 4, bn = ((b + 1 + rot) & 31) * 4;
      gstep2(U0, V0, U1, V1, xl, xl + 128, y2[0], y2[1], rec, rec + GREC, bo, rec + 2 * GREC, rec + 3 * GREC, bo, u8, v8, loff, lane);
      __builtin_amdgcn_sched_barrier(0);
      gstep2(U0, V0, U1, V1, xl + 256, xl + 384, y2[2], y2[3], rec + 2 * GREC, rec + 3 * GREC, bo, rec, rec + GREC, bn, u8, v8, loff, lane);
      __builtin_amdgcn_sched_barrier(0);
    }
    int lane_e = lane; asm volatile("" : "+v"(lane_e));
#pragma unroll
    for (int ti = 0; ti < GT; ++ti) gstore_x<LAST>(p, l, t0 + ti, y2[ti], lane_e);
  }
  float* ysum = reinterpret_cast<float*>(smem + 4 * GT * GREC * 4 + 4 * GT * 2048);
  for (int t = nfull * GT + bid; t < NTOK; t += nblk) {
    f32x2 y2[8];
    gload_x(p, t, xl, lane);
#pragma unroll
    for (int i = 0; i < 8; ++i) y2[i] = f32x2{0.f, 0.f};
    gsort_token(p, t, rec, lane);
    GU U; GV V;
    gload_u(U, rec, (w * 8) * 4, u8, loff);
    gload_v(V, rec, (w * 8) * 4, v8, loff);
#pragma unroll 1
    for (int b = 0; b < 8; ++b) gstep(U, V, xl, y2, rec, (w * 8 + ((b + 1) & 7)) * 4, u8, v8, loff, lane);
    __syncthreads();
#pragma unroll
    for (int i = 0; i < 8; ++i) { ysum[w * 1024 + lane * 16 + 2 * i] = y2[i].x; ysum[w * 1024 + lane * 16 + 2 * i + 1] = y2[i].y; }
    __syncthreads();
    if (w == 0) {
#pragma unroll
      for (int i = 0; i < 8; ++i) {
        y2[i].x += ysum[1024 + lane * 16 + 2 * i] + ysum[2048 + lane * 16 + 2 * i] + ysum[3072 + lane * 16 + 2 * i];
        y2[i].y += ysum[1024 + lane * 16 + 2 * i + 1] + ysum[2048 + lane * 16 + 2 * i + 1] + ysum[3072 + lane * 16 + 2 * i + 1];
      }
      gstore_x<LAST>(p, l, t, y2, lane);
    }
  }
}

#define XB_TMO      128
#define XB_XCNT(j)  (256  + 64 * (j))
#define XB_XSUB(j)  (1280 + 64 * (j))
#define XB_XGEN(j)  (2304 + 64 * (j))
#define XB_TOP      3328
#define XB_TOPGEN   3392
#define XCD_BAR_WORDS 3456
#define XB_SPIN_CAP (1u << 22)
__device__ __forceinline__ unsigned xb_ld(unsigned* p)              { return __hip_atomic_load(p, __ATOMIC_RELAXED, __HIP_MEMORY_SCOPE_AGENT); }
__device__ __forceinline__ unsigned xb_add(unsigned* p, unsigned v) { return __hip_atomic_fetch_add(p, v, __ATOMIC_RELAXED, __HIP_MEMORY_SCOPE_AGENT); }
__device__ __forceinline__ unsigned xb_xcc_id() { return (unsigned)__builtin_amdgcn_s_getreg((3 << 11) | 20) & 0xFu; }
#define XB_SPIN(cond, bar) do { unsigned _sp = 0; while (cond) { __builtin_amdgcn_s_sleep(1); \
    if ((++_sp & 255u) == 0u) { if (xb_ld(&(bar)[XB_TMO])) break; if (_sp > XB_SPIN_CAP) { atomicAdd(&(bar)[XB_TMO], 1u); break; } } } } while (0)

struct XcdBarrier { unsigned* bar; unsigned x; volatile LAS unsigned* st; };

__device__ __forceinline__ XcdBarrier xcd_barrier_post(unsigned* bar, volatile LAS unsigned* st) {
  XcdBarrier b; b.bar = bar; b.x = xb_xcc_id(); b.st = st;
  if (threadIdx.x == 0) (void)xb_add(&bar[XB_XCNT(b.x)], 1u);
  return b;
}
__device__ __forceinline__ void xcd_barrier_complete(unsigned* bar, unsigned x, unsigned& nloc, unsigned& nx) {
  const unsigned G = gridDim.x * gridDim.y * gridDim.z;
  unsigned sum, cnt, mine, sp = 0u;
  for (;;) {
    sum = 0u; cnt = 0u; mine = 0u;
#pragma unroll
    for (unsigned j = 0; j < 16; ++j) { const unsigned c = xb_ld(&bar[XB_XCNT(j)]); sum += c; cnt += (c > 0u) ? 1u : 0u; mine = (j == x) ? c : mine; }
    if (sum == G) break;
    __builtin_amdgcn_s_sleep(1);
    if ((++sp & 255u) == 0u) { if (xb_ld(&bar[XB_TMO])) break; if (sp > XB_SPIN_CAP) { atomicAdd(&bar[XB_TMO], 1u); break; } }
  }
  nloc = mine > 0u ? mine : 1u; nx = cnt > 0u ? cnt : 1u;
}
__device__ __forceinline__ void xcd_barrier(const XcdBarrier& b) {
  asm volatile("s_waitcnt vmcnt(0)" ::: "memory");
  __syncthreads();
  if (threadIdx.x == 0) {
    unsigned* bar = b.bar;
    __builtin_amdgcn_s_waitcnt(0);
    unsigned nloc = b.st[0], nx = b.st[1];
    if (nloc == 0u) { xcd_barrier_complete(bar, b.x, nloc, nx); b.st[0] = nloc; b.st[1] = nx; }
    const unsigned old = xb_add(&bar[XB_XSUB(b.x)], 1u);
    const unsigned gen = old / nloc;
    if (old + 1u == (gen + 1u) * nloc) {
      __builtin_amdgcn_fence(__ATOMIC_RELEASE, "agent");
      asm volatile("s_waitcnt vmcnt(0)" ::: "memory");
      const unsigned og = xb_add(&bar[XB_TOP], 1u);
      const unsigned tg = og / nx;
      if (og + 1u == (tg + 1u) * nx) xb_add(&bar[XB_TOPGEN], 1u);
      else XB_SPIN(xb_ld(&bar[XB_TOPGEN]) == tg, bar);
      __builtin_amdgcn_fence(__ATOMIC_ACQUIRE, "agent");
      xb_add(&bar[XB_XGEN(b.x)], 1u);
      asm volatile("s_waitcnt vmcnt(0)" ::: "memory");
    } else {
      XB_SPIN(xb_ld(&bar[XB_XGEN(b.x)]) == gen, bar);
      __builtin_amdgcn_fence(__ATOMIC_ACQUIRE, "agent");
      asm volatile("s_waitcnt vmcnt(0)" ::: "memory");
    }
  }
  __syncthreads();
}

#define GSYNC() xcd_barrier(xb)
#define PP(wi) phase_params(p, wi)
#define BN bid_opaque(bid), nblk_opaque(nblk)

template <int L>
__device__ __forceinline__ void layer_phases(const Params& p, char* smem, const XcdBarrier& xb, int bid, int nblk) {
  if (L == 0) {
  ph_rmsnorm<0>(PP(false), L, BN);
#if PROBE == 11
  GSYNC();
  ph_rmsnorm<0>(PP(false), L, BN);
#endif
  GSYNC();
  }
  ph_gemm<EPI_WIN>(PP(false), L, smem, BN);
#if PROBE == 1
  GSYNC();
  ph_gemm<EPI_WIN>(PP(false), L, smem, BN);
#endif
  GSYNC();
  {
    const Params q = PP(false);
    WorkQ wq; wq.cnt = reinterpret_cast<unsigned*>(q.ws) + 8 + L; wq.slot = reinterpret_cast<volatile int*>(smem + SMEM_BYTES - 8); wq.off = 0;
    int item = ph_attn<(L == 0)>(phase_params(p, false, L == 0), L, smem, wq);
    wq.off = (L == 0) ? 528 : 0;
    item = ph_mlconv(PP(false), L, smem, wq, item);
    ph_cmlp(PP(false), L, smem, wq, item);
  }
  GSYNC();
  ph_mlU(PP(false), L, smem, BN);
#if PROBE == 9 || PROBE == 20
  GSYNC();
  ph_mlU(PP(false), L, smem, BN);
#endif
  GSYNC();
  ph_mlscan(PP(false), L, BN);
#if PROBE == 10 || PROBE == 20
  GSYNC();
  ph_mlscan(PP(false), L, BN);
#endif
  GSYNC();
  ph_mlout(PP(false), L, smem, BN);
#if PROBE == 6 || PROBE == 20
  GSYNC();
  ph_mlout(PP(false), L, smem, BN);
#endif
  GSYNC();
  ph_gemm<EPI_WOUT>(PP(false), L, smem, BN);
  GSYNC();
  ph_rmsnorm<1>(PP(false), L, BN);
  GSYNC();
  ph_gemm<EPI_PQ>(PP(false), L, smem, BN);
#if PROBE == 2
  GSYNC();
  ph_gemm<EPI_PQ>(PP(false), L, smem, BN);
#endif
  GSYNC();
  ph_topk(PP(false), L, smem, BN);
#if PROBE == 5
  GSYNC();
  ph_topk(PP(false), L, smem, BN);
#endif
  GSYNC();
  ph_gather2<(L == 1)>(PP(false), L, smem, BN);
  GSYNC();
}

__global__ void __launch_bounds__(256, 2) mega_kernel(Params p) {
  __shared__ __attribute__((aligned(16))) char smem[SMEM_BYTES];
  __shared__ uint4 xb_words;
  cg::grid_group grid = cg::this_grid();
  const int bid = blockIdx.x, nblk = gridDim.x;
  if (threadIdx.x == 0) xb_words = make_uint4(0u, 0u, 0u, 0u);
  __syncthreads();
  XcdBarrier xb = xcd_barrier_post(reinterpret_cast<unsigned*>(p.ws), (volatile LAS unsigned*)&xb_words);
  grid.sync();
  ph_prep(PP(true), smem, BN);
#if PROBE == 12
  GSYNC();
  ph_prep(PP(true), smem, BN);
#endif
  GSYNC();
  layer_phases<0>(p, smem, xb, bid, nblk);
  layer_phases<1>(p, smem, xb, bid, nblk);
}

static inline size_t align_up(size_t v, size_t a) { return (v + a - 1) / a * a; }

extern "C" void kernel_launch(void* const* d_in, const int* in_sizes, int n_in, void* d_out, int out_size, void* d_ws,
                              size_t ws_size, hipStream_t stream) {
  Params p{};
  for (int i = 0; i < 30; ++i) p.in[i] = reinterpret_cast<const float*>(d_in[i]);
  p.out = reinterpret_cast<float*>(d_out);
  p.ws = reinterpret_cast<char*>(d_ws);
  if (WS_NEED > ws_size) { fprintf(stderr, "workspace too small: need %zu have %zu\n", (size_t)WS_NEED, ws_size); return; }
  static int grid_blocks = 0;
  if (!grid_blocks) {
    int dev = 0, cus = 0, per_cu = 0;
    hipGetDevice(&dev);
    hipDeviceGetAttribute(&cus, hipDeviceAttributeMultiprocessorCount, dev);
    hipOccupancyMaxActiveBlocksPerMultiprocessor(&per_cu, mega_kernel, 256, 0);
    if (per_cu > 2) per_cu = 2;
    if (per_cu < 1) per_cu = 1;
    grid_blocks = cus * per_cu;
  }
  hipMemsetAsync(d_ws, 0, 16384, stream);
  void* args[] = {&p};
  hipError_t e = hipLaunchCooperativeKernel((void*)mega_kernel, dim3(grid_blocks), dim3(256), args, 0, stream);
  if (e != hipSuccess) fprintf(stderr, "cooperative launch failed: %s (grid %d)\n", hipGetErrorString(e), grid_blocks);
}
```

```cpp
#include <hip/hip_runtime.h>
#include <hip/hip_cooperative_groups.h>
#include <cstdio>
#include <cstdint>

namespace cg = cooperative_groups;

typedef unsigned short bf16_t;
typedef __attribute__((ext_vector_type(8))) __bf16 bf16x8;
typedef __attribute__((ext_vector_type(2))) __bf16 bf16x2;
typedef __attribute__((ext_vector_type(16))) float f32x16;
typedef __attribute__((ext_vector_type(2))) float f32x2;

#define D_MODEL 1024
#define NTOK 16896
#define NPROMPT 16384
#define SEQ 4096
#define NIN 2816
#define EPS 1e-6f
#define LOG2E 1.4426950408889634f
#define SKEYS 1088
#define NCU_UNITS 1056

constexpr size_t O_Y_P = 0;
constexpr size_t O_Y_S = O_Y_P + 16777216;
constexpr size_t O_K_P = O_Y_S + 524288;
constexpr size_t O_V_P = O_K_P + 16777216;
constexpr size_t O_C_P = O_V_P + 16777216;
constexpr size_t O_N_P = O_C_P + 131072;
constexpr size_t O_M_P = O_N_P + 2048;
constexpr size_t O_CONV_P = O_M_P + 32;
constexpr size_t O_K_S = O_CONV_P + 6144;
constexpr size_t O_V_S = O_K_S + 524288;
constexpr size_t O_C_S = O_V_S + 524288;
constexpr size_t O_N_S = O_C_S + 262144;
constexpr size_t O_M_S = O_N_S + 4096;
constexpr size_t O_CONV_S = O_M_S + 64;
constexpr size_t O_CMV_S = O_CONV_S + 12288;

constexpr size_t al256(size_t v) { return (v + 255) / 256 * 256; }
constexpr int SP_st_c = 0;
constexpr int SP_st_n = 262144;
constexpr int SP_st_m = 266240;
constexpr int SP_st_conv = 266304;
constexpr int SP_norm1_g = 278592;
constexpr int SP_da_subln_g = 280640;
constexpr int SP_ml_conv_w = 280896;
constexpr int SP_ml_conv_b = 282944;
constexpr int SP_ml_wq = 283456;
constexpr int SP_ml_wk = 316224;
constexpr int SP_ml_gate_b = 348992;
constexpr int SP_ml_norm_g = 349056;
constexpr int SP_ml_skip = 349568;
constexpr int SP_cm_norm_g = 350080;
constexpr int SP_cm_ws = 350592;
constexpr int SP_cm_b = 481664;
constexpr int SP_norm2_g = 482688;
constexpr int SP_final_g = 484736;
constexpr int SP_TOTAL = 485760;
constexpr size_t WS_bar = 0;
constexpr size_t WS_lam = al256(WS_bar + 16384);
constexpr size_t WS_lut = al256(WS_lam + (256));
constexpr size_t WS_sp = al256(WS_lut + (4*256*4));
constexpr size_t WS_wt_in = al256(WS_sp + (SP_TOTAL*4));
constexpr size_t WS_wg = al256(WS_wt_in + ((size_t)2*NIN*1024*2));
constexpr size_t WS_wt_out = al256(WS_wg + ((size_t)2*8*1024*4));
constexpr size_t WS_wt_pq = al256(WS_wt_out + ((size_t)2*1024*1024*2));
constexpr size_t WS_keysb = al256(WS_wt_pq + ((size_t)2*2048*1024*2));
constexpr size_t WS_ub8 = al256(WS_keysb + ((size_t)2*16*128*128*2));
constexpr size_t WS_vb8 = al256(WS_ub8 + ((size_t)2*16384*1024));
constexpr size_t WS_us = al256(WS_vb8 + ((size_t)2*16384*1024));
constexpr size_t WS_vs = al256(WS_us + ((size_t)2*16384*4));
constexpr size_t WS_Kbs = al256(WS_vs + ((size_t)2*16384*4));
constexpr size_t WS_Vts = al256(WS_Kbs + ((size_t)2*8*SKEYS*512*2));
constexpr size_t WS_x = al256(WS_Vts + ((size_t)2*8*4*128*SKEYS*2));
constexpr size_t WS_xn = al256(WS_x + ((size_t)NTOK*1024*4));
constexpr size_t WS_R0 = al256(WS_xn + ((size_t)NTOK*1024*2));
constexpr size_t WS_R0x = WS_R0;
constexpr size_t WS_Qb = al256(WS_R0x + (0));
constexpr size_t WS_Kb = al256(WS_Qb + ((size_t)NTOK*512*2));
constexpr size_t WS_Vt = al256(WS_Kb + ((size_t)NPROMPT*512*2));
constexpr size_t WS_P5 = al256(WS_Vt + ((size_t)16*128*SEQ*2));
constexpr size_t WS_ig = al256(WS_P5 + ((size_t)NTOK*1280*4));
constexpr size_t WS_lf = al256(WS_ig + ((size_t)NTOK*4*4));
constexpr size_t WS_Fc = al256(WS_lf + ((size_t)NTOK*4*4));
constexpr size_t WS_cc = al256(WS_Fc + ((size_t)NTOK*4*4));
constexpr size_t WS_qm = al256(WS_cc + ((size_t)NTOK*256*4));
constexpr size_t WS_km = al256(WS_qm + ((size_t)NTOK*256*4));
constexpr size_t WS_mst = al256(WS_km + ((size_t)NTOK*256*4));
constexpr size_t WS_mnx = al256(WS_mst + (NCU_UNITS*4));
constexpr size_t WS_wcs = al256(WS_mnx + (NCU_UNITS*4));
constexpr size_t WS_FLs = al256(WS_wcs + (NCU_UNITS*4));
constexpr size_t WS_mxt = al256(WS_FLs + (NCU_UNITS*4));
constexpr size_t WS_U = al256(WS_mxt + (NCU_UNITS*4));
constexpr size_t WS_un = al256(WS_U + ((size_t)NCU_UNITS*4096*4));
constexpr size_t WS_Cst = al256(WS_un + ((size_t)NCU_UNITS*64*4));
constexpr size_t WS_nst = al256(WS_Cst + ((size_t)NCU_UNITS*4096*4));
constexpr size_t WS_END_MIXER = al256(WS_nst + ((size_t)NCU_UNITS*64*4));
constexpr size_t WS_qp = al256(WS_R0x + (0));
constexpr size_t WS_sc = al256(WS_qp + ((size_t)NTOK*2048*2));
constexpr size_t WS_eidx = al256(WS_sc + ((size_t)NTOK*2048*4));
constexpr size_t WS_egate = al256(WS_eidx + ((size_t)NTOK*128*4));
constexpr size_t WS_esu = al256(WS_egate + ((size_t)NTOK*128*4));
constexpr size_t WS_ssp = al256(WS_esu + ((size_t)NTOK*128*4));
constexpr size_t WS_END_PEER = al256(WS_ssp + ((size_t)NTOK*32*4));
constexpr size_t WS_NEED = WS_END_MIXER > WS_END_PEER ? WS_END_MIXER : WS_END_PEER;

struct Params {
  const float* in[30];
  float* out;
  char* ws;
  __device__ __forceinline__ const float* x_prompt() const { return in[0]; }
  __device__ __forceinline__ const float* x_sample() const { return in[1]; }
  __device__ __forceinline__ const float* cache_k() const { return in[2]; }
  __device__ __forceinline__ const float* cache_v() const { return in[3]; }
  __device__ __forceinline__ const float* w_in() const { return in[9]; }
  __device__ __forceinline__ const float* da_lambda() const { return in[10]; }
  __device__ __forceinline__ const float* rel_table() const { return in[12]; }
  __device__ __forceinline__ const float* w_out() const { return in[23]; }
  __device__ __forceinline__ const float* peer_wq() const { return in[25]; }
  __device__ __forceinline__ const float* peer_keys() const { return in[26]; }
  __device__ __forceinline__ const float* peer_u() const { return in[27]; }
  __device__ __forceinline__ const float* peer_v() const { return in[28]; }
  __device__ __forceinline__ const float* st_c() const { return reinterpret_cast<const float*>(ws + WS_sp) + SP_st_c; }
  __device__ __forceinline__ const float* st_n() const { return reinterpret_cast<const float*>(ws + WS_sp) + SP_st_n; }
  __device__ __forceinline__ const float* st_m() const { return reinterpret_cast<const float*>(ws + WS_sp) + SP_st_m; }
  __device__ __forceinline__ const float* st_conv() const { return reinterpret_cast<const float*>(ws + WS_sp) + SP_st_conv; }
  __device__ __forceinline__ const float* norm1_g() const { return reinterpret_cast<const float*>(ws + WS_sp) + SP_norm1_g; }
  __device__ __forceinline__ const float* da_subln_g() const { return reinterpret_cast<const float*>(ws + WS_sp) + SP_da_subln_g; }
  __device__ __forceinline__ const float* ml_conv_w() const { return reinterpret_cast<const float*>(ws + WS_sp) + SP_ml_conv_w; }
  __device__ __forceinline__ const float* ml_conv_b() const { return reinterpret_cast<const float*>(ws + WS_sp) + SP_ml_conv_b; }
  __device__ __forceinline__ const float* ml_wq() const { return reinterpret_cast<const float*>(ws + WS_sp) + SP_ml_wq; }
  __device__ __forceinline__ const float* ml_wk() const { return reinterpret_cast<const float*>(ws + WS_sp) + SP_ml_wk; }
  __device__ __forceinline__ const float* ml_gate_b() const { return reinterpret_cast<const float*>(ws + WS_sp) + SP_ml_gate_b; }
  __device__ __forceinline__ const float* ml_norm_g() const { return reinterpret_cast<const float*>(ws + WS_sp) + SP_ml_norm_g; }
  __device__ __forceinline__ const float* ml_skip() const { return reinterpret_cast<const float*>(ws + WS_sp) + SP_ml_skip; }
  __device__ __forceinline__ const float* cm_norm_g() const { return reinterpret_cast<const float*>(ws + WS_sp) + SP_cm_norm_g; }
  __device__ __forceinline__ const float* cm_ws() const { return reinterpret_cast<const float*>(ws + WS_sp) + SP_cm_ws; }
  __device__ __forceinline__ const float* cm_b() const { return reinterpret_cast<const float*>(ws + WS_sp) + SP_cm_b; }
  __device__ __forceinline__ const float* norm2_g() const { return reinterpret_cast<const float*>(ws + WS_sp) + SP_norm2_g; }
  __device__ __forceinline__ const float* final_g() const { return reinterpret_cast<const float*>(ws + WS_sp) + SP_final_g; }
  __device__ __forceinline__ float* lam() const { return reinterpret_cast<float*>(ws + WS_lam); }
  __device__ __forceinline__ float* lut() const { return reinterpret_cast<float*>(ws + WS_lut); }
  __device__ __forceinline__ float* sp() const { return reinterpret_cast<float*>(ws + WS_sp); }
  __device__ __forceinline__ bf16_t* wt_in() const { return reinterpret_cast<bf16_t*>(ws + WS_wt_in); }
  __device__ __forceinline__ float* wg() const { return reinterpret_cast<float*>(ws + WS_wg); }
  __device__ __forceinline__ bf16_t* wt_out() const { return reinterpret_cast<bf16_t*>(ws + WS_wt_out); }
  __device__ __forceinline__ bf16_t* wt_pq() const { return reinterpret_cast<bf16_t*>(ws + WS_wt_pq); }
  __device__ __forceinline__ bf16_t* keysb() const { return reinterpret_cast<bf16_t*>(ws + WS_keysb); }
  __device__ __forceinline__ unsigned char* ub8() const { return reinterpret_cast<unsigned char*>(ws + WS_ub8); }
  __device__ __forceinline__ unsigned char* vb8() const { return reinterpret_cast<unsigned char*>(ws + WS_vb8); }
  __device__ __forceinline__ float* us() const { return reinterpret_cast<float*>(ws + WS_us); }
  __device__ __forceinline__ float* vs() const { return reinterpret_cast<float*>(ws + WS_vs); }
  __device__ __forceinline__ bf16_t* Kbs() const { return reinterpret_cast<bf16_t*>(ws + WS_Kbs); }
  __device__ __forceinline__ bf16_t* Vts() const { return reinterpret_cast<bf16_t*>(ws + WS_Vts); }
  __device__ __forceinline__ float* x() const { return reinterpret_cast<float*>(ws + WS_x); }
  __device__ __forceinline__ bf16_t* xn() const { return reinterpret_cast<bf16_t*>(ws + WS_xn); }
  __device__ __forceinline__ bf16_t* Qb() const { return reinterpret_cast<bf16_t*>(ws + WS_Qb); }
  __device__ __forceinline__ bf16_t* Kb() const { return reinterpret_cast<bf16_t*>(ws + WS_Kb); }
  __device__ __forceinline__ bf16_t* Vt() const { return reinterpret_cast<bf16_t*>(ws + WS_Vt); }
  __device__ __forceinline__ float* P5() const { return reinterpret_cast<float*>(ws + WS_P5); }
  __device__ __forceinline__ float* ig() const { return reinterpret_cast<float*>(ws + WS_ig); }
  __device__ __forceinline__ float* lf() const { return reinterpret_cast<float*>(ws + WS_lf); }
  __device__ __forceinline__ float* Fc() const { return reinterpret_cast<float*>(ws + WS_Fc); }
  __device__ __forceinline__ float* cc() const { return reinterpret_cast<float*>(ws + WS_cc); }
  __device__ __forceinline__ float* qm() const { return reinterpret_cast<float*>(ws + WS_qm); }
  __device__ __forceinline__ float* km() const { return reinterpret_cast<float*>(ws + WS_km); }
  __device__ __forceinline__ float* mst() const { return reinterpret_cast<float*>(ws + WS_mst); }
  __device__ __forceinline__ float* mnx() const { return reinterpret_cast<float*>(ws + WS_mnx); }
  __device__ __forceinline__ float* wcs() const { return reinterpret_cast<float*>(ws + WS_wcs); }
  __device__ __forceinline__ float* FLs() const { return reinterpret_cast<float*>(ws + WS_FLs); }
  __device__ __forceinline__ float* mxt() const { return reinterpret_cast<float*>(ws + WS_mxt); }
  __device__ __forceinline__ float* U() const { return reinterpret_cast<float*>(ws + WS_U); }
  __device__ __forceinline__ float* un() const { return reinterpret_cast<float*>(ws + WS_un); }
  __device__ __forceinline__ float* Cst() const { return reinterpret_cast<float*>(ws + WS_Cst); }
  __device__ __forceinline__ float* nst() const { return reinterpret_cast<float*>(ws + WS_nst); }
  __device__ __forceinline__ bf16_t* qp() const { return reinterpret_cast<bf16_t*>(ws + WS_qp); }
  __device__ __forceinline__ float* sc() const { return reinterpret_cast<float*>(ws + WS_sc); }
  __device__ __forceinline__ int* eidx() const { return reinterpret_cast<int*>(ws + WS_eidx); }
  __device__ __forceinline__ float* egate() const { return reinterpret_cast<float*>(ws + WS_egate); }
  __device__ __forceinline__ float* esu() const { return reinterpret_cast<float*>(ws + WS_esu); }
  __device__ __forceinline__ float* ssp() const { return reinterpret_cast<float*>(ws + WS_ssp); }
  __device__ __forceinline__ int* tl() const { return reinterpret_cast<int*>(ws + WS_sc); }
};

__device__ __forceinline__ unsigned pack2(float a, float b) {
  f32x2 v = {a, b};
  bf16x2 r = __builtin_convertvector(v, bf16x2);
  return *reinterpret_cast<unsigned*>(&r);
}
__device__ __forceinline__ bf16_t f2bf(float a) { return (bf16_t)(pack2(a, 0.f) & 0xFFFFu); }
__device__ __forceinline__ float bf_lo(unsigned u) { return __uint_as_float(u << 16); }
__device__ __forceinline__ float bf_hi(unsigned u) { return __uint_as_float(u & 0xFFFF0000u); }
__device__ __forceinline__ float gelu_exact(float x) { return 0.5f * x * (1.f + erff(x * 0.70710678118654752f)); }
__device__ __forceinline__ float sigmoidf_(float x) { return 1.f / (1.f + __expf(-x)); }
__device__ __forceinline__ float shfl_up_l(float v, int d, int lane) {
  const int src = lane >= d ? lane - d : lane;
  return __int_as_float(__builtin_amdgcn_ds_bpermute(src << 2, __float_as_int(v)));
}
template <int CTRL>
__device__ __forceinline__ float dpp_f(float v) {
  return __builtin_bit_cast(float, __builtin_amdgcn_update_dpp(0, __builtin_bit_cast(int, v), CTRL, 0xf, 0xf, true));
}
__device__ __forceinline__ float swap16_sum(float x) {
  auto s = __builtin_amdgcn_permlane16_swap(__float_as_uint(x), __float_as_uint(x), false, false);
  return __uint_as_float(s[0]) + __uint_as_float(s[1]);
}
__device__ __forceinline__ float swap32_sum(float x) {
  auto s = __builtin_amdgcn_permlane32_swap(__float_as_uint(x), __float_as_uint(x), false, false);
  return __uint_as_float(s[0]) + __uint_as_float(s[1]);
}
__device__ __forceinline__ float swap16_max(float x) {
  auto s = __builtin_amdgcn_permlane16_swap(__float_as_uint(x), __float_as_uint(x), false, false);
  return fmaxf(__uint_as_float(s[0]), __uint_as_float(s[1]));
}
__device__ __forceinline__ float swap32_max(float x) {
  auto s = __builtin_amdgcn_permlane32_swap(__float_as_uint(x), __float_as_uint(x), false, false);
  return fmaxf(__uint_as_float(s[0]), __uint_as_float(s[1]));
}
__device__ __forceinline__ float row16_sum(float v) {
  v += dpp_f<0xB1>(v); v += dpp_f<0x4E>(v); v += dpp_f<0x141>(v); v += dpp_f<0x140>(v);
  return v;
}
__device__ __forceinline__ float row16_max(float v) {
  v = fmaxf(v, dpp_f<0xB1>(v)); v = fmaxf(v, dpp_f<0x4E>(v)); v = fmaxf(v, dpp_f<0x141>(v)); v = fmaxf(v, dpp_f<0x140>(v));
  return v;
}
__device__ __forceinline__ float wave_sum(float v) { return swap32_sum(swap16_sum(row16_sum(v))); }
__device__ __forceinline__ float wave_max(float v) { return swap32_max(swap16_max(row16_max(v))); }
__device__ __forceinline__ const float* xrow_in(const Params& p, int l, int t) {
  if (l == 0) return (t < NPROMPT) ? p.x_prompt() + (size_t)t * D_MODEL : p.x_sample() + (size_t)(t - NPROMPT) * D_MODEL;
  return p.x() + (size_t)t * D_MODEL;
}
__device__ __forceinline__ bf16x8 as_bf16x8(uint4 v) { return *reinterpret_cast<bf16x8*>(&v); }

__device__ __forceinline__ int tid_opaque() { int t = threadIdx.x; asm volatile("" : "+v"(t)); return t; }
__device__ __forceinline__ int sgpr_opaque(int v) { asm volatile("" : "+s"(v)); return v; }
__device__ __forceinline__ int bid_opaque(int v) { asm volatile("" : "+s"(v)); __builtin_assume(v >= 0); __builtin_assume(v < 1024); return v; }
__device__ __forceinline__ int nblk_opaque(int v) { asm volatile("" : "+s"(v)); __builtin_assume(v >= 1); __builtin_assume(v <= 1024); return v; }
#define LAS __attribute__((address_space(3)))
#ifndef PROBE
#define PROBE 0
#endif
#define SMEM_BYTES 73728

__device__ __forceinline__ void transpose_tile(const float* __restrict__ src, int lds, bf16_t* __restrict__ dst, int K, int n0, int k0,
                               int gate_skip, float* tile  ) {
  const int tid = tid_opaque();
  const int c = tid & 63, r0 = tid >> 6;
  int n = n0 + c;
  int col = n + ((gate_skip && n >= 2304) ? 8 : 0);
#pragma unroll 4
  for (int j = 0; j < 16; ++j) {
    int r = r0 + 4 * j;
    tile[r * 65 + c] = src[(size_t)(k0 + r) * lds + col];
  }
  __syncthreads();
  const int nn = tid >> 2, kg = (tid & 3) * 16;
  unsigned w[8];
#pragma unroll
  for (int j = 0; j < 8; ++j) w[j] = pack2(tile[(kg + 2 * j) * 65 + nn], tile[(kg + 2 * j + 1) * 65 + nn]);
  uint4* d = reinterpret_cast<uint4*>(dst + (size_t)(n0 + nn) * K + k0 + kg);
  d[0] = make_uint4(w[0], w[1], w[2], w[3]);
  d[1] = make_uint4(w[4], w[5], w[6], w[7]);
  __syncthreads();
}

__device__ __forceinline__ int rel_bucket_dev(int rel) {
  int ret = rel > 0 ? 16 : 0;
  int n = rel < 0 ? -rel : rel;
  int b;
  if (n < 8) b = n;
  else if (n < 12) b = 8;
  else if (n < 16) b = 9;
  else if (n < 23) b = 10;
  else if (n < 32) b = 11;
  else if (n < 46) b = 12;
  else if (n < 64) b = 13;
  else if (n < 91) b = 14;
  else b = 15;
  return ret + b;
}

__device__ __forceinline__ void prep_table_rows(const Params& p, int r0, int r1, int lane, int wv) {
  for (int r = r0 + wv; r < r1; r += 4) {
    const int tab = r >> 15, row = r & 32767;
    const float* src = (tab == 0 ? p.peer_u() : p.peer_v()) + (size_t)row * 1024 + lane * 16;
    float4 f0 = reinterpret_cast<const float4*>(src)[0], f1 = reinterpret_cast<const float4*>(src)[1];
    float4 f2 = reinterpret_cast<const float4*>(src)[2], f3 = reinterpret_cast<const float4*>(src)[3];
    float am = fmaxf(fmaxf(fmaxf(fabsf(f0.x), fabsf(f0.y)), fmaxf(fabsf(f0.z), fabsf(f0.w))),
                     fmaxf(fmaxf(fabsf(f1.x), fabsf(f1.y)), fmaxf(fabsf(f1.z), fabsf(f1.w))));
    am = fmaxf(am, fmaxf(fmaxf(fmaxf(fabsf(f2.x), fabsf(f2.y)), fmaxf(fabsf(f2.z), fabsf(f2.w))),
                         fmaxf(fmaxf(fabsf(f3.x), fabsf(f3.y)), fmaxf(fabsf(f3.z), fabsf(f3.w)))));
    am = wave_max(am);
    const float sc = am > 0.f ? 224.f / am : 1.f;
    int w0 = 0, w1 = 0, w2 = 0, w3 = 0;
    w0 = __builtin_amdgcn_cvt_pk_fp8_f32(f0.x * sc, f0.y * sc, w0, false); w0 = __builtin_amdgcn_cvt_pk_fp8_f32(f0.z * sc, f0.w * sc, w0, true);
    w1 = __builtin_amdgcn_cvt_pk_fp8_f32(f1.x * sc, f1.y * sc, w1, false); w1 = __builtin_amdgcn_cvt_pk_fp8_f32(f1.z * sc, f1.w * sc, w1, true);
    w2 = __builtin_amdgcn_cvt_pk_fp8_f32(f2.x * sc, f2.y * sc, w2, false); w2 = __builtin_amdgcn_cvt_pk_fp8_f32(f2.z * sc, f2.w * sc, w2, true);
    w3 = __builtin_amdgcn_cvt_pk_fp8_f32(f3.x * sc, f3.y * sc, w3, false); w3 = __builtin_amdgcn_cvt_pk_fp8_f32(f3.z * sc, f3.w * sc, w3, true);
    unsigned char* dst = (tab == 0 ? p.ub8() : p.vb8()) + (size_t)row * 1024 + lane * 16;
    *reinterpret_cast<uint4*>(dst) = make_uint4((unsigned)w0, (unsigned)w1, (unsigned)w2, (unsigned)w3);
    if (lane == 0) (tab == 0 ? p.us() : p.vs())[row] = am > 0.f ? am * (1.f / 224.f) : 1.f;
  }
}

__device__ __forceinline__ void ph_prep(const Params& p, char* smem, int bid, int nblk) {
  const int tid = tid_opaque();
  float* tile = reinterpret_cast<float*>(smem);
  for (int u = bid; u < 2 * 1472; u += nblk) {
    int l = u / 1472, r = u % 1472;
    if (r < 704) {
      int nt = r / 16, kt = r % 16;
      transpose_tile(p.w_in() + (size_t)l * 1024 * 2824, 2824, p.wt_in() + (size_t)l * NIN * 1024, 1024, nt * 64, kt * 64, 1, tile);
    } else if (r < 960) {
      r -= 704; int nt = r / 16, kt = r % 16;
      transpose_tile(p.w_out() + (size_t)l * 1024 * 1024, 1024, p.wt_out() + (size_t)l * 1024 * 1024, 1024, nt * 64, kt * 64, 0, tile);
    } else {
      r -= 960; int nt = r / 16, kt = r % 16;
      transpose_tile(p.peer_wq() + (size_t)l * 1024 * 2048, 2048, p.wt_pq() + (size_t)l * 2048 * 1024, 1024, nt * 64, kt * 64, 0, tile);
    }
  }
  for (int u = bid; u < 1024; u += nblk) {
    int kt = u & 15, h = (u >> 4) & 3, b = (u >> 6) & 7, l = u >> 9;
    const float* src = p.cache_v() + (((size_t)(l * 8 + b) * 1024 + kt * 64) * 4 + h) * 128;
    {
      int c = tid & 127, r0 = tid >> 7;
      for (int j = 0; j < 32; ++j) { int r = r0 + 2 * j; tile[r * 129 + c] = src[(size_t)r * 512 + c]; }
    }
    __syncthreads();
    {
      int dv = tid >> 1, half = tid & 1;
      bf16_t* dst = p.Vts() + ((size_t)((l * 8 + b) * 4 + h) * 128 + dv) * SKEYS + kt * 64 + half * 32;
      unsigned w[16];
#pragma unroll
      for (int j = 0; j < 16; ++j) {
        int pos0 = half * 32 + 2 * j;
        int blk = (pos0 >> 2) & 3;
        int oblk = (blk == 1) ? 2 : (blk == 2 ? 1 : blk);
        int key0 = (pos0 & ~15) + oblk * 4 + (pos0 & 3);
        w[j] = pack2(tile[key0 * 129 + dv], tile[(key0 + 1) * 129 + dv]);
      }
      uint4* d4 = reinterpret_cast<uint4*>(dst);
      d4[0] = make_uint4(w[0], w[1], w[2], w[3]);
      d4[1] = make_uint4(w[4], w[5], w[6], w[7]);
      d4[2] = make_uint4(w[8], w[9], w[10], w[11]);
      d4[3] = make_uint4(w[12], w[13], w[14], w[15]);
    }
    __syncthreads();
  }
  const size_t gtid = (size_t)bid * 256 + tid, gsz = (size_t)nblk * 256;
  {
    const size_t n8 = (size_t)2 * 16 * 128 * 128 / 8;
    for (size_t i = gtid; i < n8; i += gsz) {
      float4 a = reinterpret_cast<const float4*>(p.peer_keys())[2 * i], b = reinterpret_cast<const float4*>(p.peer_keys())[2 * i + 1];
      reinterpret_cast<uint4*>(p.keysb())[i] = make_uint4(pack2(a.x, a.y), pack2(a.z, a.w), pack2(b.x, b.y), pack2(b.z, b.w));
    }
  }
  {
    const size_t n8 = (size_t)2 * 8 * 1024 * 512 / 8;
    for (size_t i = gtid; i < n8; i += gsz) {
      size_t e = i * 8;
      size_t lb = e / (1024 * 512), rem = e % (1024 * 512);
      float4 a = reinterpret_cast<const float4*>(p.cache_k())[2 * i], b = reinterpret_cast<const float4*>(p.cache_k())[2 * i + 1];
      *reinterpret_cast<uint4*>(p.Kbs() + lb * (SKEYS * 512) + rem) = make_uint4(pack2(a.x, a.y), pack2(a.z, a.w), pack2(b.x, b.y), pack2(b.z, b.w));
    }
  }
  for (size_t i = gtid; i < 2 * 8 * 1024; i += gsz) {
    int l = (int)(i / 8192), r = (int)(i % 8192), g = r / 1024, k = r % 1024;
    p.wg()[i] = p.w_in()[((size_t)l * 1024 + k) * 2824 + 2304 + g];
  }
  {
    float* sp = reinterpret_cast<float*>(p.ws + WS_sp);
    for (size_t i = gtid; i < 262144; i += gsz) sp[SP_st_c + i] = p.in[4][i];
    for (size_t i = gtid; i < 4096; i += gsz) sp[SP_st_n + i] = p.in[5][i];
    for (size_t i = gtid; i < 64; i += gsz) sp[SP_st_m + i] = p.in[6][i];
    for (size_t i = gtid; i < 12288; i += gsz) sp[SP_st_conv + i] = p.in[7][i];
    for (size_t i = gtid; i < 2048; i += gsz) sp[SP_norm1_g + i] = p.in[8][i];
    for (size_t i = gtid; i < 256; i += gsz) sp[SP_da_subln_g + i] = p.in[11][i];
    for (size_t i = gtid; i < 2048; i += gsz) sp[SP_ml_conv_w + i] = p.in[13][i];
    for (size_t i = gtid; i < 512; i += gsz) sp[SP_ml_conv_b + i] = p.in[14][i];
    for (size_t i = gtid; i < 32768; i += gsz) sp[SP_ml_wq + i] = p.in[15][i];
    for (size_t i = gtid; i < 32768; i += gsz) sp[SP_ml_wk + i] = p.in[16][i];
    for (size_t i = gtid; i < 16; i += gsz) sp[SP_ml_gate_b + i] = p.in[17][i];
    for (size_t i = gtid; i < 512; i += gsz) sp[SP_ml_norm_g + i] = p.in[18][i];
    for (size_t i = gtid; i < 512; i += gsz) sp[SP_ml_skip + i] = p.in[19][i];
    for (size_t i = gtid; i < 512; i += gsz) sp[SP_cm_norm_g + i] = p.in[20][i];
    for (size_t i = gtid; i < 131072; i += gsz) sp[SP_cm_ws + i] = p.in[21][i];
    for (size_t i = gtid; i < 1024; i += gsz) sp[SP_cm_b + i] = p.in[22][i];
    for (size_t i = gtid; i < 2048; i += gsz) sp[SP_norm2_g + i] = p.in[24][i];
    for (size_t i = gtid; i < 1024; i += gsz) sp[SP_final_g + i] = p.in[29][i];
  }
  if (bid == 0) {
    for (int i = tid; i < 4 * 256; i += 256) {
      int h = i >> 8, j = i & 255;
      int rel = j - 191; if (rel > 63) rel = 63;
      p.lut()[i] = p.rel_table()[rel_bucket_dev(rel) * 4 + h] * LOG2E;
    }
    if (tid < 2) {
      const float* lp = p.da_lambda() + tid * 256;
      float s01 = 0.f, s23 = 0.f;
      for (int d = 0; d < 64; ++d) { s01 += lp[d] * lp[64 + d]; s23 += lp[128 + d] * lp[192 + d]; }
      float lam_init = 0.8f - 0.6f * expf(-0.3f * (float)tid);
      p.lam()[tid] = expf(s01) - expf(s23) + lam_init;
    }
  }
}

template <int MODE>
__device__ __forceinline__ void ph_rmsnorm(const Params& p, int l, int bid, int nblk) {
  const int lane = tid_opaque() & 63, w = __builtin_amdgcn_readfirstlane(tid_opaque() >> 6);
  const float* g = (MODE == 0) ? p.norm1_g() + l * 1024 : (MODE == 1 ? p.norm2_g() + l * 1024 : p.final_g());
  float4 gv[4];
#pragma unroll
  for (int j = 0; j < 4; ++j) gv[j] = reinterpret_cast<const float4*>(g)[lane + 64 * j];
  for (int t = bid * 4 + w; t < NTOK; t += nblk * 4) {
    const float* xr = (MODE == 0) ? xrow_in(p, l, t) : p.x() + (size_t)t * 1024;
    float4 xv[4];
    float ss = 0.f;
#pragma unroll
    for (int j = 0; j < 4; ++j) {
      xv[j] = reinterpret_cast<const float4*>(xr)[lane + 64 * j];
      ss += xv[j].x * xv[j].x + xv[j].y * xv[j].y + xv[j].z * xv[j].z + xv[j].w * xv[j].w;
    }
    ss = wave_sum(ss);
    float r = rsqrtf(ss * (1.f / 1024.f) + EPS);
#pragma unroll
    for (int j = 0; j < 4; ++j) {
      xv[j].x *= r * gv[j].x; xv[j].y *= r * gv[j].y; xv[j].z *= r * gv[j].z; xv[j].w *= r * gv[j].w;
    }
    if (MODE == 2) {
      float* o = (t < NPROMPT) ? p.out + O_Y_P + (size_t)t * 1024 : p.out + O_Y_S + (size_t)(t - NPROMPT) * 1024;
#pragma unroll
      for (int j = 0; j < 4; ++j) reinterpret_cast<float4*>(o)[lane + 64 * j] = xv[j];
    } else {
      uint2* o = reinterpret_cast<uint2*>(p.xn() + (size_t)t * 1024);
#pragma unroll
      for (int j = 0; j < 4; ++j) o[lane + 64 * j] = make_uint2(pack2(xv[j].x, xv[j].y), pack2(xv[j].z, xv[j].w));
    }
    if (MODE == 0) {
      float pre[8];
#pragma unroll
      for (int i = 0; i < 8; ++i) {
        const float4* wr = reinterpret_cast<const float4*>(p.wg() + ((size_t)l * 8 + i) * 1024);
        float s = 0.f;
#pragma unroll
        for (int j = 0; j < 4; ++j) {
          float4 wv = wr[lane + 64 * j];
          s += xv[j].x * wv.x + xv[j].y * wv.y + xv[j].z * wv.z + xv[j].w * wv.w;
        }
        pre[i] = wave_sum(s);
      }
      if (lane < 4) {
        float a = pre[0]; a = lane == 1 ? pre[1] : a; a = lane == 2 ? pre[2] : a; a = lane == 3 ? pre[3] : a;
        float f = pre[4]; f = lane == 1 ? pre[5] : f; f = lane == 2 ? pre[6] : f; f = lane == 3 ? pre[7] : f;
        p.ig()[(size_t)t * 4 + lane] = a + p.ml_gate_b()[l * 8 + lane];
        float z = f + p.ml_gate_b()[l * 8 + 4 + lane];
        p.lf()[(size_t)t * 4 + lane] = fminf(z, 0.f) - log1pf(expf(-fabsf(z)));
      }
    }
  }
}

__device__ __forceinline__ int mono_key(float v) { int b = __float_as_int(v); return b ^ ((b >> 31) & 0x7FFFFFFF); }
__device__ __forceinline__ float mono_val(int k) { int b = k ^ ((k >> 31) & 0x7FFFFFFF); return __int_as_float(b); }

__device__ __forceinline__ int med3i(int a, int b, int c) { return max(min(a, b), min(max(a, b), c)); }
#define INS16(L, kv)                                                          \
  {                                                                           \
    const int _v = (kv);                                                      \
    _Pragma("unroll") for (int _j = 15; _j >= 1; --_j) L[_j] = med3i(L[_j - 1], L[_j], _v); \
    L[0] = max(L[0], _v);                                                     \
  }


enum { EPI_WIN = 0, EPI_WOUT = 1, EPI_PQ = 2, EPI_SC = 3 };

template <int EPI>
__device__ __forceinline__ void gemm_store(const Params& p, int l, int t, int n, float v) {
  if (EPI == EPI_WOUT) {
    const float* xi = xrow_in(p, l, t);
    p.x()[(size_t)t * 1024 + n] = xi[n] + v;
  } else if (EPI == EPI_PQ) {
    p.qp()[(size_t)t * 2048 + n] = f2bf(v);
  } else if (EPI == EPI_SC) {
    p.sc()[(size_t)t * 2048 + n] = v;
  }
}

template <int EPI>
__device__ __forceinline__ void ph_gemm(const Params& p, int l, char* smem, int bid, int nblk) {
  constexpr int NT = (EPI == EPI_WIN) ? 22 : (EPI == EPI_WOUT ? 8 : 16);
  constexpr int MT = NTOK / 128;
  constexpr int K = (EPI == EPI_SC) ? 128 : 1024;
  constexpr int NK = K / 64;
  const bf16_t* A; int lda; const bf16_t* Bt; int ldb;
  if (EPI == EPI_WIN) { A = p.xn(); lda = 1024; Bt = p.wt_in() + (size_t)l * NIN * 1024; ldb = 1024; }
  else if (EPI == EPI_WOUT) { A = p.xn(); lda = 1024; Bt = p.wt_out() + (size_t)l * 1024 * 1024; ldb = 1024; }
  else if (EPI == EPI_PQ) { A = p.xn(); lda = 1024; Bt = p.wt_pq() + (size_t)l * 2048 * 1024; ldb = 1024; }
  else { A = p.qp(); lda = 2048; Bt = p.keysb() + (size_t)l * 16 * 128 * 128; ldb = 128; }

  const int tid = tid_opaque(), lane = tid & 63, w = __builtin_amdgcn_readfirstlane(tid >> 6);
  const int wm = w >> 1, wn = w & 1, lr = lane & 31, lh = lane >> 5;
  char* sA = smem;
  char* sB = smem + 32768;
  const int ld_c = tid & 7, ld_r = tid >> 3;

  const int nx = nblk >> 3;
  constexpr int FG = MT / 8, LR = MT % 8;
  for (int rnd = 0;; ++rnd) {
    const int q = (nblk & 7) ? rnd * nblk + bid : rnd * nblk + (bid & 7) * nx + (bid >> 3);
    if (q >= MT * NT) break;
    int mt, nt;
    if (q < FG * 8 * NT) { const int mg = q / (8 * NT), rem = q % (8 * NT); nt = rem >> 3; mt = mg * 8 + (rem & 7); }
    else { const int q2 = q - FG * 8 * NT; nt = q2 / (LR > 0 ? LR : 1); mt = FG * 8 + q2 % (LR > 0 ? LR : 1); }
    const bf16_t* Ag = A + (size_t)(mt * 128) * lda + ((EPI == EPI_SC) ? nt * 128 : 0);
    const bf16_t* Bg = Bt + (size_t)(nt * 128) * ldb;
    f32x16 acc[2][2];
#pragma unroll
    for (int i = 0; i < 2; ++i)
#pragma unroll
      for (int j = 0; j < 2; ++j)
#pragma unroll
        for (int r = 0; r < 16; ++r) acc[i][j][r] = 0.f;

    const int g_row = w * 32 + (lane >> 3);
    const int g_pc = lane & 7;
    const bf16_t* Ath = Ag + (size_t)g_row * lda;
    const bf16_t* Bth = Bg + (size_t)g_row * ldb;
#define GEMM_STAGE(KT, BUF)                                                                                          \
  _Pragma("unroll") for (int j = 0; j < 4; ++j) {                                                                    \
    const int row = g_row + 8 * j;                                                                                   \
    const int cch = g_pc ^ ((row >> 1) & 7);                                                                         \
    __builtin_amdgcn_global_load_lds((const unsigned*)(Ath + (size_t)(8 * j) * lda + (KT) * 64 + cch * 8),           \
                                     (LAS unsigned*)(sA + (BUF) * 16384 + (w * 4 + j) * 1024 + lane * 16), 16, 0, 0); \
    __builtin_amdgcn_global_load_lds((const unsigned*)(Bth + (size_t)(8 * j) * ldb + (KT) * 64 + cch * 8),           \
                                     (LAS unsigned*)(sB + (BUF) * 16384 + (w * 4 + j) * 1024 + lane * 16), 16, 0, 0); \
  }
    GEMM_STAGE(0, 0)
    __syncthreads();
    for (int kt = 0; kt < NK; ++kt) {
      const int buf = kt & 1;
      if (kt + 1 < NK) { GEMM_STAGE(kt + 1, buf ^ 1) }
      const char* cA = sA + buf * 16384;
      const char* cB = sB + buf * 16384;
#pragma unroll
      for (int ks = 0; ks < 4; ++ks) {
        bf16x8 af[2], bfr[2];
#pragma unroll
        for (int i = 0; i < 2; ++i) {
          int row = wm * 64 + i * 32 + lr; int pc = (ks * 2 + lh) ^ ((row >> 1) & 7);
          af[i] = as_bf16x8(*reinterpret_cast<const uint4*>(cA + row * 128 + pc * 16));
        }
#pragma unroll
        for (int j = 0; j < 2; ++j) {
          int row = wn * 64 + j * 32 + lr; int pc = (ks * 2 + lh) ^ ((row >> 1) & 7);
          bfr[j] = as_bf16x8(*reinterpret_cast<const uint4*>(cB + row * 128 + pc * 16));
        }
#pragma unroll
        for (int i = 0; i < 2; ++i)
#pragma unroll
          for (int j = 0; j < 2; ++j)
            acc[i][j] = __builtin_amdgcn_mfma_f32_32x32x16_bf16(af[i], bfr[j], acc[i][j], 0, 0, 0);
      }
      __syncthreads();
    }
    if (EPI == EPI_PQ) {
      int lane_q = lane; asm volatile("" : "+v"(lane_q));
      const int lr = lane_q & 31, lh = lane_q >> 5;
      char* sA2 = smem;
      char* sB2 = smem + 32768;
      const bf16_t* kg = p.keysb() + ((size_t)l * 16 + nt) * 128 * 128;
#pragma unroll
      for (int jj = 0; jj < 8; ++jj) {
        const int I = w * 8 + jj;
        const int row = I * 4 + (lane_q >> 4);
        const int cch = (lane_q & 15) ^ (row & 15);
        __builtin_amdgcn_global_load_lds((const unsigned*)(kg + (size_t)row * 128 + cch * 8),
                                         (LAS unsigned*)(sB2 + I * 1024 + lane_q * 16), 16, 0, 0);
      }
#pragma unroll
      for (int i = 0; i < 2; ++i) {
        float rs[16];
#pragma unroll
        for (int r = 0; r < 16; ++r) rs[r] = 0.f;
#pragma unroll
        for (int j = 0; j < 2; ++j) {
          const int n = wn * 64 + j * 32 + lr;
#pragma unroll
          for (int r = 0; r < 16; ++r) {
            const int row = wm * 64 + i * 32 + (r & 3) + 8 * (r >> 2) + 4 * lh;
            const float v = acc[i][j][r];
            rs[r] += v * v;
            *reinterpret_cast<bf16_t*>(sA2 + row * 256 + (((n >> 3) ^ (row & 15)) * 16) + (n & 7) * 2) = f2bf(v);
          }
        }
#pragma unroll
        for (int r = 0; r < 16; ++r) {
          const float s = swap16_sum(row16_sum(rs[r]));
          if (lr == 0) {
            const int t = mt * 128 + wm * 64 + i * 32 + (r & 3) + 8 * (r >> 2) + 4 * lh;
            p.ssp()[(size_t)t * 32 + nt * 2 + wn] = s;
          }
        }
      }
      __syncthreads();
      f32x16 sc2[2][2];
#pragma unroll
      for (int i = 0; i < 2; ++i)
#pragma unroll
        for (int j = 0; j < 2; ++j)
#pragma unroll
          for (int r = 0; r < 16; ++r) sc2[i][j][r] = 0.f;
#pragma unroll
      for (int ks = 0; ks < 8; ++ks) {
        bf16x8 af[2], bfr[2];
#pragma unroll
        for (int i = 0; i < 2; ++i) {
          const int row = wm * 64 + i * 32 + lr;
          af[i] = as_bf16x8(*reinterpret_cast<const uint4*>(sA2 + row * 256 + (((ks * 2 + lh) ^ (row & 15)) * 16)));
        }
#pragma unroll
        for (int j = 0; j < 2; ++j) {
          const int row = wn * 64 + j * 32 + lr;
          bfr[j] = as_bf16x8(*reinterpret_cast<const uint4*>(sB2 + row * 256 + (((ks * 2 + lh) ^ (row & 15)) * 16)));
        }
#pragma unroll
        for (int i = 0; i < 2; ++i)
#pragma unroll
          for (int j = 0; j < 2; ++j)
            sc2[i][j] = __builtin_amdgcn_mfma_f32_32x32x16_bf16(af[i], bfr[j], sc2[i][j], 0, 0, 0);
      }
      __syncthreads();
      float* sS = reinterpret_cast<float*>(smem);
#pragma unroll
      for (int i = 0; i < 2; ++i)
#pragma unroll
        for (int j = 0; j < 2; ++j)
#pragma unroll
          for (int r = 0; r < 16; ++r) {
            const int row = wm * 64 + i * 32 + (r & 3) + 8 * (r >> 2) + 4 * lh;
            sS[row * 129 + wn * 64 + j * 32 + lr] = sc2[i][j][r];
          }
      __syncthreads();
      {
        int tq = tid; asm volatile("" : "+v"(tq));
        const int tk = tq & 127, hl = tq >> 7;
        int L[16];
#pragma unroll
        for (int j = 0; j < 16; ++j) L[j] = (int)0x80000000;
        const float* srow = sS + tk * 129 + hl * 64;
#pragma unroll 4
        for (int s = 0; s < 64; ++s) {
          const int key = (mono_key(srow[s]) & ~127) | (127 - (hl * 64 + s));
          INS16(L, key)
        }
        int4* dst = reinterpret_cast<int4*>(p.tl() + (((size_t)(mt * 128 + tk) * 16 + nt) * 2 + hl) * 16);
        dst[0] = make_int4(L[0], L[1], L[2], L[3]); dst[1] = make_int4(L[4], L[5], L[6], L[7]);
        dst[2] = make_int4(L[8], L[9], L[10], L[11]); dst[3] = make_int4(L[12], L[13], L[14], L[15]);
      }
      __syncthreads();
    } else if (EPI != EPI_WIN) {
#pragma unroll
      for (int i = 0; i < 2; ++i)
#pragma unroll
        for (int j = 0; j < 2; ++j)
#pragma unroll
          for (int r = 0; r < 16; ++r) {
            int t = mt * 128 + wm * 64 + i * 32 + (r & 3) + 8 * (r >> 2) + 4 * lh;
            int n = nt * 128 + wn * 64 + j * 32 + lr;
            gemm_store<EPI>(p, l, t, n, acc[i][j][r]);
          }
    } else {
      const int seg = nt >> 2;
#pragma unroll
      for (int i = 0; i < 2; ++i)
#pragma unroll
        for (int j = 0; j < 2; ++j) {
          const int n = nt * 128 + wn * 64 + j * 32 + lr;
          if (nt < 4) {
#pragma unroll
            for (int r = 0; r < 16; ++r) {
              int t = mt * 128 + wm * 64 + i * 32 + (r & 3) + 8 * (r >> 2) + 4 * lh;
              p.Qb()[(size_t)t * 512 + n] = f2bf(acc[i][j][r] * (0.125f * LOG2E));
            }
          } else if (nt < 8) {
            const int n2 = n - 512;
#pragma unroll
            for (int r = 0; r < 16; ++r) {
              int t = mt * 128 + wm * 64 + i * 32 + (r & 3) + 8 * (r >> 2) + 4 * lh;
              float v = acc[i][j][r];
              if (t < NPROMPT) {
                p.out[O_K_P + (size_t)l * (4 * 4096 * 512) + (size_t)t * 512 + n2] = v;
                p.Kb()[(size_t)t * 512 + n2] = f2bf(v);
              } else {
                int ts = t - NPROMPT, b = ts >> 6, ii = ts & 63;
                p.out[O_K_S + (size_t)l * (8 * 64 * 512) + (size_t)ts * 512 + n2] = v;
                p.Kbs()[((size_t)(l * 8 + b) * SKEYS + 1024 + ii) * 512 + n2] = f2bf(v);
              }
            }
          } else if (nt < 12) {
            const int n2 = n - 1024, h = n2 >> 7, dv = n2 & 127;
#pragma unroll
            for (int rg = 0; rg < 4; ++rg) {
              int tb = mt * 128 + wm * 64 + i * 32 + 8 * rg + 4 * lh;
              float v0 = acc[i][j][rg * 4 + 0], v1 = acc[i][j][rg * 4 + 1], v2 = acc[i][j][rg * 4 + 2], v3 = acc[i][j][rg * 4 + 3];
              uint2 pk = make_uint2(pack2(v0, v1), pack2(v2, v3));
              int posblk = 2 * lh + (rg & 1);
              if (tb < NPROMPT) {
                float* o = p.out + O_V_P + (size_t)l * (4 * 4096 * 512) + (size_t)tb * 512 + n2;
                o[0] = v0; o[512] = v1; o[1024] = v2; o[1536] = v3;
                int b = tb >> 12, s = tb & 4095;
                int pos = (s & ~15) + posblk * 4;
                *reinterpret_cast<uint2*>(p.Vt() + ((size_t)(b * 4 + h) * 128 + dv) * SEQ + pos) = pk;
              } else {
                int ts = tb - NPROMPT, b = ts >> 6, ii = ts & 63;
                float* o = p.out + O_V_S + (size_t)l * (8 * 64 * 512) + (size_t)ts * 512 + n2;
                o[0] = v0; o[512] = v1; o[1024] = v2; o[1536] = v3;
                int pos = 1024 + (ii & ~15) + posblk * 4;
                *reinterpret_cast<uint2*>(p.Vts() + ((size_t)((l * 8 + b) * 4 + h) * 128 + dv) * SKEYS + pos) = pk;
              }
            }
          } else {
            const int n2 = n - 1536;
            const bool act = (n >= 2304);
#pragma unroll
            for (int r = 0; r < 16; ++r) {
              int t = mt * 128 + wm * 64 + i * 32 + (r & 3) + 8 * (r >> 2) + 4 * lh;
              float v = acc[i][j][r];
              if (act) v = gelu_exact(v);
              p.P5()[(size_t)t * 1280 + n2] = v;
            }
          }
        }
      (void)seg;
    }
  }
}

struct WorkQ { unsigned* cnt; volatile int* slot; int off; };
__device__ __forceinline__ int wq_next(const WorkQ& q) {
  __syncthreads();
  if (threadIdx.x == 0) *q.slot = (int)__hip_atomic_fetch_add(q.cnt, 1u, __ATOMIC_RELAXED, __HIP_MEMORY_SCOPE_AGENT);
  __syncthreads();
  return __builtin_amdgcn_readfirstlane(*q.slot) - q.off;
}

template <bool CONV>
__device__ __forceinline__ int ph_attn(const Params& p, int l, char* smem, const WorkQ& wq) {
  const int tid = tid_opaque(), lane = tid & 63, w = __builtin_amdgcn_readfirstlane(tid >> 6);
  const int c = w >> 1, qhalf = w & 1, lr = lane & 31, lh = lane >> 5;
  float* sLut = reinterpret_cast<float*>(smem + 65536);
  float* sO2 = reinterpret_cast<float*>(smem);
  const float lam = p.lam()[l];
  const float lam_init = 0.8f - 0.6f * expf(-0.3f * (float)l);

  constexpr int NSLOT = CONV ? 1584 : 1056;
  int slot, uu;
  for (slot = wq_next(wq); slot < NSLOT; slot = wq_next(wq)) {
    if (CONV) {
      if (slot % 3 == 2) {
        const int ch = slot / 3, r0 = ch * 125;
        prep_table_rows(p, r0, (r0 + 125 < 65536) ? r0 + 125 : 65536, lane, w);
        continue;
      }
      uu = (slot / 3) * 2 + (slot % 3);
    } else uu = slot;
    int b, h, qc, S, qrow0; const bf16_t *Kbase, *Vbase;
    bool samp = false; int u2 = uu;
    if (uu >= 752 && uu < 784) samp = true; else if (uu >= 784) u2 = uu - 32;
    if (!samp) {
      qc = 63 - (u2 >> 4); int bh = u2 & 15; b = bh >> 2; h = bh & 3; S = SEQ;
      Kbase = p.Kb() + (size_t)b * SEQ * 512 + h * 128;
      Vbase = p.Vt() + (size_t)(b * 4 + h) * 128 * SEQ;
      qrow0 = b * SEQ + qc * 64;
    } else {
      int us = uu - 752; b = us >> 2; h = us & 3; qc = 16; S = SKEYS;
      Kbase = p.Kbs() + (size_t)(l * 8 + b) * SKEYS * 512 + h * 128;
      Vbase = p.Vts() + (size_t)((l * 8 + b) * 4 + h) * 128 * SKEYS;
      qrow0 = NPROMPT + b * 64;
    }
    const int ntiles = qc + 1;
    __syncthreads();
    sLut[tid] = p.lut()[h * 256 + tid];
    if (tid < 128) sLut[256 + tid] = p.da_subln_g()[l * 128 + tid];
    bf16x8 qf[4];
    {
      const bf16_t* qrow = p.Qb() + (size_t)(qrow0 + qhalf * 32 + lr) * 512 + h * 128 + c * 64 + lh * 8;
#pragma unroll
      for (int ks = 0; ks < 4; ++ks) qf[ks] = as_bf16x8(*reinterpret_cast<const uint4*>(qrow + ks * 16));
    }
    f32x16 o[4];
#pragma unroll
    for (int d = 0; d < 4; ++d)
#pragma unroll
      for (int r = 0; r < 16; ++r) o[d][r] = 0.f;
    float m_run = -1e30f, l_run = 0.f;

    const char* Kt = reinterpret_cast<const char*>(Kbase);
    const char* Vb = reinterpret_cast<const char*>(Vbase);
    const int g_r8 = lane >> 3, g_pc = lane & 7;
#define ATTN_STAGE(KT, BUF)                                                                                         \
  _Pragma("unroll") for (int j = 0; j < 4; ++j) {                                                                   \
    const int I = w * 4 + j;                                                                                        \
    const int rk = (I & 7) * 8 + g_r8;                                                                              \
    const unsigned kof = (unsigned)rk * 1024u + (unsigned)(I >> 3) * 128u + (unsigned)((g_pc ^ ((rk >> 1) & 7)) * 16); \
    __builtin_amdgcn_global_load_lds((const unsigned*)(Kt + (size_t)(KT) * 65536 + kof),                            \
                                     (LAS unsigned*)(smem + (BUF) * 32768 + I * 1024 + lane * 16), 16, 0, 0);       \
    const int rv = I * 8 + g_r8;                                                                                    \
    const unsigned vof = (unsigned)rv * (unsigned)(S * 2) + (unsigned)((g_pc ^ ((rv >> 1) & 7)) * 16);              \
    __builtin_amdgcn_global_load_lds((const unsigned*)(Vb + (size_t)(KT) * 128 + vof),                              \
                                     (LAS unsigned*)(smem + (BUF) * 32768 + 16384 + I * 1024 + lane * 16), 16, 0, 0); \
  }
    ATTN_STAGE(0, 0)
    __syncthreads();
    for (int kt = 0; kt < ntiles; ++kt) {
      const int buf = kt & 1;
      if (kt + 1 < ntiles) { ATTN_STAGE(kt + 1, buf ^ 1) }
      const char* sK = smem + buf * 32768;
      const char* sV = sK + 16384;
      f32x16 s[2];
      {
        bf16x8 kf[2][4];
#pragma unroll
        for (int kb = 0; kb < 2; ++kb)
#pragma unroll
          for (int ks = 0; ks < 4; ++ks) {
            int row = kb * 32 + lr; int pc = (ks * 2 + lh) ^ ((row >> 1) & 7);
            kf[kb][ks] = as_bf16x8(*reinterpret_cast<const uint4*>(sK + c * 8192 + row * 128 + pc * 16));
          }
#pragma unroll
        for (int kb = 0; kb < 2; ++kb) {
#pragma unroll
          for (int r = 0; r < 16; ++r) s[kb][r] = 0.f;
#pragma unroll
          for (int ks = 0; ks < 4; ++ks) s[kb] = __builtin_amdgcn_mfma_f32_32x32x16_bf16(kf[kb][ks], qf[ks], s[kb], 0, 0, 0);
        }
      }
      bf16x8 vfa[2][4];
#pragma unroll
      for (int k2 = 0; k2 < 2; ++k2)
#pragma unroll
        for (int d = 0; d < 4; ++d) {
          int row = d * 32 + lr; int pc = (k2 * 2 + lh) ^ ((row >> 1) & 7);
          vfa[k2][d] = as_bf16x8(*reinterpret_cast<const uint4*>(sV + row * 128 + pc * 16));
        }
      float boff = sLut[0];
      if (kt >= qc - 2) {
        const int base = (kt - qc) * 64 - (qhalf * 32 + lr) + 191 + 4 * lh;
#pragma unroll
        for (int kb = 0; kb < 2; ++kb)
#pragma unroll
          for (int r = 0; r < 16; ++r) s[kb][r] += sLut[base + kb * 32 + (r & 3) + 8 * (r >> 2)];
        boff = 0.f;
      }
      float mx = s[0][0];
#pragma unroll
      for (int kb = 0; kb < 2; ++kb)
#pragma unroll
        for (int r = 0; r < 16; ++r) mx = fmaxf(mx, s[kb][r]);
      mx = swap32_max(mx) + boff;
      if (__any(mx > m_run)) {
        const float m_new = fmaxf(m_run, mx);
        const float alpha = __builtin_amdgcn_exp2f(m_run - m_new);
        m_run = m_new;
        l_run *= alpha;
#pragma unroll
        for (int d = 0; d < 4; ++d)
#pragma unroll
          for (int r = 0; r < 16; ++r) o[d][r] *= alpha;
      }
      const float eoff = boff - m_run;
      float ps = 0.f;
#pragma unroll
      for (int kb = 0; kb < 2; ++kb)
#pragma unroll
        for (int r = 0; r < 16; ++r) { float pv = __builtin_amdgcn_exp2f(s[kb][r] + eoff); s[kb][r] = pv; ps += pv; }
      l_run += ps;
      bf16x8 pf[4];
#pragma unroll
      for (int ks2 = 0; ks2 < 4; ++ks2) {
        const int kb = ks2 >> 1, sh = (ks2 & 1) * 8;
        uint4 pw = make_uint4(pack2(s[kb][sh + 0], s[kb][sh + 1]), pack2(s[kb][sh + 2], s[kb][sh + 3]),
                              pack2(s[kb][sh + 4], s[kb][sh + 5]), pack2(s[kb][sh + 6], s[kb][sh + 7]));
        pf[ks2] = as_bf16x8(pw);
      }
#define ATTN_VREAD(DST, K2)                                                                        \
  _Pragma("unroll") for (int d = 0; d < 4; ++d) {                                                  \
    int row = d * 32 + lr; int pc = ((K2) * 2 + lh) ^ ((row >> 1) & 7);                            \
    DST[d] = as_bf16x8(*reinterpret_cast<const uint4*>(sV + row * 128 + pc * 16));                 \
  }
#define ATTN_PV(SRC, K2) \
  _Pragma("unroll") for (int d = 0; d < 4; ++d) o[d] = __builtin_amdgcn_mfma_f32_32x32x16_bf16(SRC[d], pf[K2], o[d], 0, 0, 0);
      bf16x8 vfc[4];
      ATTN_VREAD(vfc, 2)
      ATTN_PV(vfa[0], 0)
      ATTN_VREAD(vfa[0], 3)
      ATTN_PV(vfa[1], 1)
      ATTN_PV(vfc, 2)
      ATTN_PV(vfa[0], 3)
      __syncthreads();
    }
    int lane_e = (int)__builtin_amdgcn_mbcnt_hi(~0u, __builtin_amdgcn_mbcnt_lo(~0u, 0u)); asm volatile("" : "+v"(lane_e));
    const int lr_e = lane_e & 31, lh_e = lane_e >> 5;
    float lt = swap32_sum(l_run);
    float inv = 1.f / lt;
    __syncthreads();
    if (c == 1) {
#pragma unroll
      for (int d = 0; d < 4; ++d)
#pragma unroll
        for (int r = 0; r < 16; ++r) sO2[(qhalf * 64 + d * 16 + r) * 64 + lane_e] = o[d][r] * inv;
    }
    __syncthreads();
    if (c == 0) {
      float ss = 0.f;
#pragma unroll
      for (int d = 0; d < 4; ++d)
#pragma unroll
        for (int r = 0; r < 16; ++r) {
          float v = o[d][r] * inv - lam * sO2[(qhalf * 64 + d * 16 + r) * 64 + lane_e];
          o[d][r] = v; ss += v * v;
        }
      ss = swap32_sum(ss);
      const float rn = rsqrtf(ss * (1.f / 128.f) + EPS) * (1.f - lam_init);
      const float* gs = sLut + 256;
      bf16_t* orow = p.xn() + (size_t)(qrow0 + qhalf * 32 + lr_e) * 1024 + h * 128;
#pragma unroll
      for (int d = 0; d < 4; ++d)
#pragma unroll
        for (int rg = 0; rg < 4; ++rg) {
          int dv = d * 32 + 8 * rg + 4 * lh_e;
          float4 g4 = *reinterpret_cast<const float4*>(gs + dv);
          uint2 pk = make_uint2(pack2(o[d][rg * 4 + 0] * rn * g4.x, o[d][rg * 4 + 1] * rn * g4.y),
                                pack2(o[d][rg * 4 + 2] * rn * g4.z, o[d][rg * 4 + 3] * rn * g4.w));
          *reinterpret_cast<uint2*>(orow + dv) = pk;
        }
    }
  }
  return slot - NSLOT + 1056;
}

template <int K>
__device__ __forceinline__ void mfma32_f32(f32x16& acc, const float* a, int a_rs, int a_ks, const float* b, int b_ks, int b_js, int lane) {
  const float* ap = a + (lane & 31) * a_rs + (lane >> 5) * a_ks;
  const float* bp = b + (lane >> 5) * b_ks + (lane & 31) * b_js;
#pragma unroll 8
  for (int k = 0; k < K; k += 2) acc = __builtin_amdgcn_mfma_f32_32x32x2f32(ap[k * a_ks], bp[k * b_ks], acc, 0, 0, 0);
}
__device__ __forceinline__ void zero16(f32x16& a) {
#pragma unroll
  for (int r = 0; r < 16; ++r) a[r] = 0.f;
}

__device__ __forceinline__ int ph_mlconv(const Params& p, int l, char* smem, const WorkQ& wq, int item) {
  const int tid = tid_opaque();
  float* s_mc = reinterpret_cast<float*>(smem);
  float* s_cc = s_mc + 67 * 64;
  float* s_wq = s_cc + 64 * 65;
  float* s_wk = s_wq + 4096;
  for (; item < 1056 + 264 * 4; item = wq_next(wq)) {
    const int u = item - 1056;
    const int ci = u >> 2, h = u & 3;
    int token0, bq; bool samp = ci >= 256;
    if (!samp) token0 = ci * 64; else token0 = NPROMPT + (ci - 256) * 64;
    bq = samp ? (ci - 256) : (ci >> 6);
    const int cidx = samp ? 0 : (ci & 63);
    __syncthreads();
    for (int i = tid; i < 67 * 64; i += 256) {
      int r = i >> 6, d = i & 63;
      float v;
      if (r >= 3) v = p.P5()[(size_t)(token0 + r - 3) * 1280 + h * 64 + d];
      else if (samp) v = p.st_conv()[((size_t)(l * 8 + bq) * 3 + r) * 256 + h * 64 + d];
      else if (cidx == 0) v = 0.f;
      else v = p.P5()[(size_t)(token0 + r - 3) * 1280 + h * 64 + d];
      s_mc[i] = v;
    }
    for (int i = tid; i < 4096; i += 256) {
      s_wq[i] = p.ml_wq()[(size_t)(l * 4 + h) * 4096 + i];
      s_wk[i] = p.ml_wk()[(size_t)(l * 4 + h) * 4096 + i];
    }
    __syncthreads();
    {
      const int d = tid & 63, t0 = tid >> 6;
      const int ch = h * 64 + d;
      const float w0 = p.ml_conv_w()[(l * 4 + 0) * 256 + ch], w1 = p.ml_conv_w()[(l * 4 + 1) * 256 + ch];
      const float w2 = p.ml_conv_w()[(l * 4 + 2) * 256 + ch], w3 = p.ml_conv_w()[(l * 4 + 3) * 256 + ch];
      const float bb = p.ml_conv_b()[l * 256 + ch];
      for (int t = t0; t < 64; t += 4) {
        float y = bb + w0 * s_mc[t * 64 + d] + w1 * s_mc[(t + 1) * 64 + d] + w2 * s_mc[(t + 2) * 64 + d] + w3 * s_mc[(t + 3) * 64 + d];
        y = y * sigmoidf_(y);
        s_cc[t * 65 + d] = y;
        p.cc()[(size_t)(token0 + t) * 256 + ch] = y;
      }
      if (samp || cidx == 63) {
        if (tid < 192) {
          int r = tid >> 6;
          float v = s_mc[(64 + r) * 64 + d];
          if (samp) p.out[O_CONV_S + ((size_t)(l * 8 + bq) * 3 + r) * 256 + ch] = v;
          else p.out[O_CONV_P + ((size_t)(l * 4 + bq) * 3 + r) * 256 + ch] = v;
        }
      }
    }
    __syncthreads();
    {
      const int lane = tid & 63, w = __builtin_amdgcn_readfirstlane(tid >> 6), ti = w >> 1, tj = w & 1;
      f32x16 aq, ak; zero16(aq); zero16(ak);
      mfma32_f32<64>(aq, s_cc + ti * 32 * 65, 65, 1, s_wq + tj * 32, 64, 1, lane);
      mfma32_f32<64>(ak, s_cc + ti * 32 * 65, 65, 1, s_wk + tj * 32, 64, 1, lane);
#pragma unroll
      for (int r = 0; r < 16; ++r) {
        const int t = ti * 32 + (r & 3) + 8 * (r >> 2) + 4 * (lane >> 5);
        const size_t o = (size_t)(token0 + t) * 256 + h * 64 + tj * 32 + (lane & 31);
        p.qm()[o] = aq[r];
        p.km()[o] = ak[r] * 0.125f;
      }
      if (w == 0) {
        const int t = token0 + lane;
        const float lfv = p.lf()[(size_t)t * 4 + h], igv = p.ig()[(size_t)t * 4 + h];
        float F = lfv;
#pragma unroll
        for (int d = 1; d < 64; d <<= 1) { float n = shfl_up_l(F, d, lane); if (lane >= d) F += n; }
        const float FL = __int_as_float(__builtin_amdgcn_readlane(__float_as_int(F), 63));
        const float mx = wave_max(FL - F + igv);
        p.Fc()[(size_t)t * 4 + h] = F;
        if (lane == 0) {
          const int cu = samp ? 1024 + bq * 4 + h : (bq * 4 + h) * 64 + cidx;
          p.FLs()[cu] = FL; p.mxt()[cu] = mx;
        }
      }
    }
  }
  return item;
}

__device__ __forceinline__ void cu_decode(int cu, int& token0, int& h) {
  if (cu < 1024) { int bh = cu >> 6, c = cu & 63; token0 = (bh >> 2) * SEQ + c * 64; h = bh & 3; }
  else { int us = cu - 1024; token0 = NPROMPT + (us >> 2) * 64; h = us & 3; }
}

__device__ __forceinline__ void ph_mlU(const Params& p, int l, char* smem, int bid, int nblk) {
  const int tid = tid_opaque();
  const int lane = tid & 63, w = __builtin_amdgcn_readfirstlane(tid >> 6), ti = w >> 1, tj = w & 1;
  float* s_k = reinterpret_cast<float*>(smem);
  float* s_v = s_k + 4096;
  for (int cu = bid; cu < NCU_UNITS; cu += nblk) {
    int token0, h; cu_decode(cu, token0, h);
    float m0, mn, FL;
    {
      const bool samp = cu >= 1024;
      const int cu0 = samp ? cu : (cu & ~63), c = samp ? 0 : (cu & 63);
      float flv = 0.f, mxv = 0.f;
      if (lane <= c) { flv = p.FLs()[cu0 + lane]; mxv = p.mxt()[cu0 + lane]; }
      float m = samp ? p.st_m()[l * 32 + (cu - 1024)] : 0.f;
      for (int j = 0; j < c; ++j) {
        const float fj = __int_as_float(__builtin_amdgcn_readlane(__float_as_int(flv), j));
        const float xj = __int_as_float(__builtin_amdgcn_readlane(__float_as_int(mxv), j));
        m = fmaxf(fj + m, xj);
      }
      FL = __int_as_float(__builtin_amdgcn_readlane(__float_as_int(flv), c));
      const float xc = __int_as_float(__builtin_amdgcn_readlane(__float_as_int(mxv), c));
      m0 = m; mn = fmaxf(FL + m, xc);
      if (tid == 0) {
        p.mst()[cu] = m0; p.mnx()[cu] = mn; p.wcs()[cu] = expf(FL + m0 - mn);
        if (samp) p.out[O_M_S + l * 32 + (cu - 1024)] = mn;
        else if (c == 63) p.out[O_M_P + l * 16 + (cu >> 6)] = mn;
      }
    }
    __syncthreads();
    for (int i = tid; i < 1024; i += 256) {
      int s = i >> 4, d4 = (i & 15) * 4;
      const int t = token0 + s;
      float wsv = expf(FL - p.Fc()[(size_t)t * 4 + h] + p.ig()[(size_t)t * 4 + h] - mn);
      float4 k4 = *reinterpret_cast<const float4*>(p.km() + (size_t)t * 256 + h * 64 + d4);
      float4 v4 = *reinterpret_cast<const float4*>(p.P5() + (size_t)t * 1280 + 256 + h * 64 + d4);
      *reinterpret_cast<float4*>(s_k + s * 64 + d4) = make_float4(k4.x * wsv, k4.y * wsv, k4.z * wsv, k4.w * wsv);
      *reinterpret_cast<float4*>(s_v + s * 64 + d4) = v4;
    }
    __syncthreads();
    f32x16 acc; zero16(acc);
    mfma32_f32<64>(acc, s_k + ti * 32, 1, 64, s_v + tj * 32, 64, 1, lane);
#pragma unroll
    for (int r = 0; r < 16; ++r) {
      const int d = ti * 32 + (r & 3) + 8 * (r >> 2) + 4 * (lane >> 5);
      p.U()[(size_t)cu * 4096 + d * 64 + tj * 32 + (lane & 31)] = acc[r];
    }
    if (tid < 64) {
      float s0 = 0.f;
      for (int s = 0; s < 64; ++s) s0 += s_k[s * 64 + tid];
      p.un()[(size_t)cu * 64 + tid] = s0;
    }
  }
}

__device__ __forceinline__ void ph_mlscan(const Params& p, int l, int bid, int nblk) {
  const size_t gtid = (size_t)bid * 256 + tid_opaque(), gsz = (size_t)nblk * 256;
  const size_t NPC = 16 * 4096, NSC = 32 * 4096, NPN = 16 * 64, NSN = 32 * 64;
  for (size_t i = gtid; i < NPC + NSC + NPN + NSN; i += gsz) {
    if (i < NPC) {
      int bh = (int)(i >> 12), e = (int)(i & 4095);
      float C = 0.f;
      for (int c = 0; c < 64; ++c) {
        int cu = bh * 64 + c;
        p.Cst()[(size_t)cu * 4096 + e] = C;
        C = p.wcs()[cu] * C + p.U()[(size_t)cu * 4096 + e];
      }
      p.out[O_C_P + (size_t)l * (16 * 4096) + i] = C;
    } else if (i < NPC + NSC) {
      size_t j = i - NPC; int us = (int)(j >> 12), e = (int)(j & 4095); int cu = 1024 + us;
      float C = p.st_c()[(size_t)l * (32 * 4096) + j];
      p.Cst()[(size_t)cu * 4096 + e] = C;
      p.out[O_C_S + (size_t)l * (32 * 4096) + j] = p.wcs()[cu] * C + p.U()[(size_t)cu * 4096 + e];
    } else if (i < NPC + NSC + NPN) {
      size_t j = i - NPC - NSC; int bh = (int)(j >> 6), d = (int)(j & 63);
      float n = 0.f;
      for (int c = 0; c < 64; ++c) {
        int cu = bh * 64 + c;
        p.nst()[(size_t)cu * 64 + d] = n;
        n = p.wcs()[cu] * n + p.un()[(size_t)cu * 64 + d];
      }
      p.out[O_N_P + (size_t)l * (16 * 64) + j] = n;
    } else {
      size_t j = i - NPC - NSC - NPN; int us = (int)(j >> 6), d = (int)(j & 63); int cu = 1024 + us;
      float n = p.st_n()[(size_t)l * (32 * 64) + j];
      p.nst()[(size_t)cu * 64 + d] = n;
      p.out[O_N_S + (size_t)l * (32 * 64) + j] = p.wcs()[cu] * n + p.un()[(size_t)cu * 64 + d];
    }
  }
}

__device__ __forceinline__ void ph_mlout(const Params& p, int l, char* smem, int bid, int nblk) {
  const int tid = tid_opaque();
  float* s_q = reinterpret_cast<float*>(smem);
  float* s_k = s_q + 64 * 65;
  float* s_v = s_k + 64 * 65;
  float* s_C = s_v + 4096;
  float* s_F = s_C + 4096;
  float* s_a = s_F + 64;
  float* s_mt = s_a + 64;
  float* s_iw = s_mt + 64;
  float* s_n = s_iw + 64;
  float* s_den = s_n + 64;
  float* s_denp = s_den + 64;
  float* s_qn = s_denp + 128;
  for (int cu = bid; cu < NCU_UNITS; cu += nblk) {
    int token0, h; cu_decode(cu, token0, h);
    const float m0 = p.mst()[cu];
    __syncthreads();
    for (int i = tid; i < 1024; i += 256) {
      int s = i >> 4, d4 = (i & 15) * 4;
      const int t = token0 + s;
      float4 q4 = *reinterpret_cast<const float4*>(p.qm() + (size_t)t * 256 + h * 64 + d4);
      float4 k4 = *reinterpret_cast<const float4*>(p.km() + (size_t)t * 256 + h * 64 + d4);
      float4 v4 = *reinterpret_cast<const float4*>(p.P5() + (size_t)t * 1280 + 256 + h * 64 + d4);
      float4 c4 = *reinterpret_cast<const float4*>(p.Cst() + (size_t)cu * 4096 + s * 64 + d4);
      s_q[s * 65 + d4] = q4.x; s_q[s * 65 + d4 + 1] = q4.y; s_q[s * 65 + d4 + 2] = q4.z; s_q[s * 65 + d4 + 3] = q4.w;
      s_k[s * 65 + d4] = k4.x; s_k[s * 65 + d4 + 1] = k4.y; s_k[s * 65 + d4 + 2] = k4.z; s_k[s * 65 + d4 + 3] = k4.w;
      *reinterpret_cast<float4*>(s_v + s * 64 + d4) = v4;
      *reinterpret_cast<float4*>(s_C + s * 64 + d4) = c4;
    }
    if (tid < 64) {
      const int t = token0 + tid;
      float F = p.Fc()[(size_t)t * 4 + h], g = p.ig()[(size_t)t * 4 + h];
      s_F[tid] = F; s_a[tid] = g - F;
      s_n[tid] = p.nst()[(size_t)cu * 64 + tid];
    }
    __syncthreads();
    if (tid < 64) {
      float pm = s_a[tid];
#pragma unroll
      for (int d = 1; d < 64; d <<= 1) { const float o = shfl_up_l(pm, d, tid); if (tid >= d) pm = fmaxf(pm, o); }
      float F = s_F[tid];
      float mt = F + fmaxf(m0, pm);
      s_mt[tid] = mt;
      s_iw[tid] = expf(F + m0 - mt);
    }
    __syncthreads();
    const int lane = tid & 63, w = __builtin_amdgcn_readfirstlane(tid >> 6), ti = w >> 1, tj = w & 1;
    const int ty = tid >> 4, tx = tid & 15;
    {
      f32x16 accS; zero16(accS);
      mfma32_f32<64>(accS, s_q + ti * 32 * 65, 65, 1, s_k + tj * 32 * 65, 1, 65, lane);
      __syncthreads();
      const int s = tj * 32 + (lane & 31);
      const float as = s_a[s];
#pragma unroll
      for (int r = 0; r < 16; ++r) {
        const int t = ti * 32 + (r & 3) + 8 * (r >> 2) + 4 * (lane >> 5);
        const float sw = (s <= t) ? accS[r] * expf(s_F[t] + as - s_mt[t]) : 0.f;
        s_k[t * 65 + s] = sw;
        const float rsum = swap16_sum(row16_sum(sw));
        if ((lane & 31) == 0) s_denp[tj * 64 + t] = rsum;
      }
    }
    {
      const int t = tid >> 2, part = tid & 3;
      float qn = 0.f;
#pragma unroll
      for (int d = 0; d < 16; ++d) qn += s_q[t * 65 + part * 16 + d] * s_n[part * 16 + d];
      qn += dpp_f<0xB1>(qn); qn += dpp_f<0x4E>(qn);
      if (part == 0) s_qn[t] = qn;
    }
    __syncthreads();
    if (tid < 64) s_den[tid] = s_denp[tid] + s_denp[64 + tid] + s_iw[tid] * s_qn[tid];
    {
      f32x16 accN, accC; zero16(accN); zero16(accC);
      mfma32_f32<64>(accN, s_k + ti * 32 * 65, 65, 1, s_v + tj * 32, 64, 1, lane);
      mfma32_f32<64>(accC, s_q + ti * 32 * 65, 65, 1, s_C + tj * 32, 64, 1, lane);
      __syncthreads();
#pragma unroll
      for (int r = 0; r < 16; ++r) {
        const int t = ti * 32 + (r & 3) + 8 * (r >> 2) + 4 * (lane >> 5);
        s_q[t * 65 + tj * 32 + (lane & 31)] = accN[r] + s_iw[t] * accC[r];
      }
    }
    __syncthreads();
#pragma unroll
    for (int i = 0; i < 4; ++i) {
      const int t = ty * 4 + i;
      const float dn = fmaxf(fabsf(s_den[t]), expf(-s_mt[t]));
      float hv[4]; float ss = 0.f;
#pragma unroll
      for (int j = 0; j < 4; ++j) { hv[j] = s_q[t * 65 + tx * 4 + j] / dn; ss += hv[j] * hv[j]; }
      ss = row16_sum(ss);
      const float rn = rsqrtf(ss * (1.f / 64.f) + EPS);
      const int ch = h * 64 + tx * 4;
      const size_t tg = (size_t)(token0 + t);
      float4 g4 = *reinterpret_cast<const float4*>(p.ml_norm_g() + l * 256 + ch);
      float4 k4 = *reinterpret_cast<const float4*>(p.ml_skip() + l * 256 + ch);
      float4 c4 = *reinterpret_cast<const float4*>(p.cc() + tg * 256 + ch);
      float4 o4 = *reinterpret_cast<const float4*>(p.P5() + tg * 1280 + 512 + ch);
      float r0 = (hv[0] * rn * g4.x + k4.x * c4.x) * sigmoidf_(o4.x);
      float r1 = (hv[1] * rn * g4.y + k4.y * c4.y) * sigmoidf_(o4.y);
      float r2 = (hv[2] * rn * g4.z + k4.z * c4.z) * sigmoidf_(o4.z);
      float r3 = (hv[3] * rn * g4.w + k4.w * c4.w) * sigmoidf_(o4.w);
      *reinterpret_cast<uint2*>(p.xn() + tg * 1024 + 512 + ch) = make_uint2(pack2(r0, r1), pack2(r2, r3));
    }
  }
}

__device__ __forceinline__ void ph_cmlp(const Params& p, int l, char* smem, const WorkQ& wq, int item) {
  const int tid = tid_opaque(), lane = tid & 63, w = __builtin_amdgcn_readfirstlane(tid >> 6);
  float* s_vg = reinterpret_cast<float*>(smem);
  float* s_ws = s_vg + 128 * 64;
  float* s_r = s_ws + 128 * 33;
  for (; item < 1056 + 264 * 4 + 544; item = wq_next(wq)) {
    const int u = item - (1056 + 264 * 4);
    const int g = u & 3, ci = u >> 2;
    const bool samp = ci >= 128;
    const int L = samp ? 64 : 128;
    const int token0 = samp ? NPROMPT + (ci - 128) * 64 : ci * 128;
    __syncthreads();
    for (int r = w; r < L; r += 4) {
      float4 v = *reinterpret_cast<const float4*>(p.P5() + (size_t)(token0 + r) * 1280 + 1024 + lane * 4);
      float ss = v.x * v.x + v.y * v.y + v.z * v.z + v.w * v.w;
      ss = wave_sum(ss);
      if (lane == 0) s_r[r] = rsqrtf(ss * (1.f / 256.f) + EPS);
    }
    __syncthreads();
    for (int i = tid; i < L * 16; i += 256) {
      int s = i >> 4, d4 = (i & 15) * 4;
      float4 v = *reinterpret_cast<const float4*>(p.P5() + (size_t)(token0 + s) * 1280 + 1024 + g * 64 + d4);
      float4 gn = *reinterpret_cast<const float4*>(p.cm_norm_g() + l * 256 + g * 64 + d4);
      float r = s_r[s];
      float4 o = make_float4(v.x * r * gn.x, v.y * r * gn.y, v.z * r * gn.z, v.w * r * gn.w);
      *reinterpret_cast<float4*>(s_vg + s * 64 + d4) = o;
      if (samp) {
        int ts = token0 - NPROMPT + s;
        *reinterpret_cast<float4*>(p.out + O_CMV_S + (size_t)l * (512 * 256) + (size_t)ts * 256 + g * 64 + d4) = o;
      }
    }
    const int rtA = (w < 2) ? 3 : 2, rtB = (w < 2) ? 0 : 1, ct = w & 1;
    const int nrt = L >> 5;
    f32x16 accA, accB; zero16(accA); zero16(accB);
    const float* wsg = p.cm_ws() + (size_t)(l * 4 + g) * 128 * 128;
    for (int s0 = 0; s0 < L; s0 += 32) {
      __syncthreads();
      for (int i = tid; i < L * 32; i += 256) {
        int t = i >> 5, ss = i & 31;
        s_ws[t * 33 + ss] = (s0 + ss <= t) ? wsg[t * 128 + s0 + ss] : 0.f;
      }
      __syncthreads();
      const int c = s0 >> 5;
      if (rtA < nrt && c <= rtA) mfma32_f32<32>(accA, s_ws + rtA * 32 * 33, 33, 1, s_vg + s0 * 64 + ct * 32, 64, 1, lane);
      if (rtB < nrt && c <= rtB) mfma32_f32<32>(accB, s_ws + rtB * 32 * 33, 33, 1, s_vg + s0 * 64 + ct * 32, 64, 1, lane);
    }
    __syncthreads();
#pragma unroll
    for (int r = 0; r < 16; ++r) {
      const int tr = (r & 3) + 8 * (r >> 2) + 4 * (lane >> 5);
      if (rtA < nrt) s_vg[(rtA * 32 + tr) * 64 + ct * 32 + (lane & 31)] = accA[r];
      if (rtB < nrt) s_vg[(rtB * 32 + tr) * 64 + ct * 32 + (lane & 31)] = accB[r];
    }
    __syncthreads();
    {
      const int ty = tid >> 4, tx = tid & 15;
      if (ty * 8 < L) {
#pragma unroll
        for (int i = 0; i < 8; ++i) {
          const int t = ty * 8 + i;
          const float bb = p.cm_b()[(l * 4 + g) * 128 + t];
          const size_t tg = (size_t)(token0 + t);
          float4 a4 = *reinterpret_cast<const float4*>(s_vg + t * 64 + tx * 4);
          float4 u4 = *reinterpret_cast<const float4*>(p.P5() + tg * 1280 + 768 + g * 64 + tx * 4);
          *reinterpret_cast<uint2*>(p.xn() + tg * 1024 + 768 + g * 64 + tx * 4) =
              make_uint2(pack2(u4.x * (a4.x + bb), u4.y * (a4.y + bb)), pack2(u4.z * (a4.z + bb), u4.w * (a4.w + bb)));
        }
      }
    }
  }
}

__device__ __forceinline__ void ph_topk(const Params& p, int l, char* smem, int bid, int nblk) {
  const int tid = tid_opaque(), lane = tid & 63, w = __builtin_amdgcn_readfirstlane(tid >> 6);
  float* s_tile = reinterpret_cast<float*>(smem) + w * (64 * 33);
  int* s_list = reinterpret_cast<int*>(smem + 4 * 64 * 33 * 4) + w * (2 * 16 * 64);
  float* s_ss = reinterpret_cast<float*>(smem + 4 * 64 * 33 * 4 + 4 * 2 * 16 * 64 * 4) + w * 64;
  for (int u = bid * 4 + w; u < 264 * 8; u += nblk * 4) {
    const int tg = u >> 3, h = u & 7;
    const int t0 = tg * 64;
    {
      const float4 pp = *reinterpret_cast<const float4*>(p.ssp() + (size_t)(t0 + lane) * 32 + h * 4);
      s_ss[lane] = pp.x + pp.y + pp.z + pp.w;
    }
    int L1[16], L2[16];
#pragma unroll
    for (int j = 0; j < 16; ++j) { L1[j] = (int)0x80000000; L2[j] = (int)0x80000000; }
#pragma unroll
    for (int c = 0; c < 2; ++c) {
      const int4* la = reinterpret_cast<const int4*>(p.tl() + (((size_t)(t0 + lane) * 16 + h * 2 + c) * 2) * 16);
      int A[16], B[16];
#pragma unroll
      for (int q = 0; q < 4; ++q) {
        const int4 a = la[q], b = la[4 + q];
        A[4 * q] = a.x; A[4 * q + 1] = a.y; A[4 * q + 2] = a.z; A[4 * q + 3] = a.w;
        B[4 * q] = b.x; B[4 * q + 1] = b.y; B[4 * q + 2] = b.z; B[4 * q + 3] = b.w;
      }
#pragma unroll
      for (int j = 0; j < 16; ++j) INS16(A, B[j])
#pragma unroll
      for (int j = 0; j < 16; ++j) { if (c == 0) L1[j] = A[j]; else L2[j] = A[j]; }
    }
#pragma unroll
    for (int j = 0; j < 16; ++j) { s_list[(0 * 16 + j) * 64 + lane] = 127 - (L1[j] & 127); s_list[(1 * 16 + j) * 64 + lane] = 127 - (L2[j] & 127); }
    float v1[16], v2[16];
#pragma unroll
    for (int j = 0; j < 16; ++j) { v1[j] = mono_val(L1[j] & ~127); v2[j] = mono_val(L2[j] & ~127); }
    int LC[16];
#pragma unroll
    for (int j = 0; j < 16; ++j) LC[j] = (int)0x80000000;
#pragma unroll
    for (int i = 0; i < 16; ++i)
#pragma unroll
      for (int j = 0; j < 16; ++j)
        if ((i + 1) * (j + 1) <= 16) {
          int key = (mono_key(v1[i] + v2[j]) & ~255) | (255 - (i * 16 + j));
          INS16(LC, key)
        }
    const float scale = rsqrtf(s_ss[lane] * (1.f / 256.f) + EPS);
    float vs[16]; float den = 0.f;
    const float top = mono_val(LC[0] & ~255);
#pragma unroll
    for (int k = 0; k < 16; ++k) { vs[k] = __expf((mono_val(LC[k] & ~255) - top) * scale); den += vs[k]; }
    const float inv = 1.f / den;
    const size_t ob = (size_t)(t0 + lane) * 128 + h * 16;
#pragma unroll
    for (int k4 = 0; k4 < 4; ++k4) {
      int ee[4]; float gg[4], su[4];
#pragma unroll
      for (int q = 0; q < 4; ++q) {
        int k = k4 * 4 + q;
        int ci = 255 - (LC[k] & 255);
        int i1 = s_list[(0 * 16 + (ci >> 4)) * 64 + lane];
        int i2 = s_list[(1 * 16 + (ci & 15)) * 64 + lane];
        ee[q] = i1 * 128 + i2;
        gg[q] = vs[k] * inv * p.vs()[l * 16384 + ee[q]];
        su[q] = p.us()[l * 16384 + ee[q]];
      }
      *reinterpret_cast<int4*>(p.eidx() + ob + k4 * 4) = make_int4(ee[0], ee[1], ee[2], ee[3]);
      *reinterpret_cast<float4*>(p.egate() + ob + k4 * 4) = make_float4(gg[0], gg[1], gg[2], gg[3]);
      *reinterpret_cast<float4*>(p.esu() + ob + k4 * 4) = make_float4(su[0], su[1], su[2], su[3]);
    }
  }
}

__device__ __forceinline__ float dot16_fp8(const float* xf, uint4 u) {
  f32x2 a0 = __builtin_amdgcn_cvt_pk_f32_fp8(u.x, false), a1 = __builtin_amdgcn_cvt_pk_f32_fp8(u.x, true);
  f32x2 a2 = __builtin_amdgcn_cvt_pk_f32_fp8(u.y, false), a3 = __builtin_amdgcn_cvt_pk_f32_fp8(u.y, true);
  f32x2 a4 = __builtin_amdgcn_cvt_pk_f32_fp8(u.z, false), a5 = __builtin_amdgcn_cvt_pk_f32_fp8(u.z, true);
  f32x2 a6 = __builtin_amdgcn_cvt_pk_f32_fp8(u.w, false), a7 = __builtin_amdgcn_cvt_pk_f32_fp8(u.w, true);
  float s0 = xf[0] * a0.x, s1 = xf[1] * a0.y;
  s0 = fmaf(xf[2], a1.x, s0); s1 = fmaf(xf[3], a1.y, s1);
  s0 = fmaf(xf[4], a2.x, s0); s1 = fmaf(xf[5], a2.y, s1);
  s0 = fmaf(xf[6], a3.x, s0); s1 = fmaf(xf[7], a3.y, s1);
  s0 = fmaf(xf[8], a4.x, s0); s1 = fmaf(xf[9], a4.y, s1);
  s0 = fmaf(xf[10], a5.x, s0); s1 = fmaf(xf[11], a5.y, s1);
  s0 = fmaf(xf[12], a6.x, s0); s1 = fmaf(xf[13], a6.y, s1);
  s0 = fmaf(xf[14], a7.x, s0); s1 = fmaf(xf[15], a7.y, s1);
  return s0 + s1;
}
__device__ __forceinline__ void axpy16_fp8(float* y, float wgt, uint4 v) {
  f32x2 a0 = __builtin_amdgcn_cvt_pk_f32_fp8(v.x, false), a1 = __builtin_amdgcn_cvt_pk_f32_fp8(v.x, true);
  f32x2 a2 = __builtin_amdgcn_cvt_pk_f32_fp8(v.y, false), a3 = __builtin_amdgcn_cvt_pk_f32_fp8(v.y, true);
  f32x2 a4 = __builtin_amdgcn_cvt_pk_f32_fp8(v.z, false), a5 = __builtin_amdgcn_cvt_pk_f32_fp8(v.z, true);
  f32x2 a6 = __builtin_amdgcn_cvt_pk_f32_fp8(v.w, false), a7 = __builtin_amdgcn_cvt_pk_f32_fp8(v.w, true);
  y[0] = fmaf(wgt, a0.x, y[0]); y[1] = fmaf(wgt, a0.y, y[1]); y[2] = fmaf(wgt, a1.x, y[2]); y[3] = fmaf(wgt, a1.y, y[3]);
  y[4] = fmaf(wgt, a2.x, y[4]); y[5] = fmaf(wgt, a2.y, y[5]); y[6] = fmaf(wgt, a3.x, y[6]); y[7] = fmaf(wgt, a3.y, y[7]);
  y[8] = fmaf(wgt, a4.x, y[8]); y[9] = fmaf(wgt, a4.y, y[9]); y[10] = fmaf(wgt, a5.x, y[10]); y[11] = fmaf(wgt, a5.y, y[11]);
  y[12] = fmaf(wgt, a6.x, y[12]); y[13] = fmaf(wgt, a6.y, y[13]); y[14] = fmaf(wgt, a7.x, y[14]); y[15] = fmaf(wgt, a7.y, y[15]);
}

template <bool DRY>
__device__ __forceinline__ void ph_gather(const Params& p, int l, int bid, int nblk) {
  const int lane = tid_opaque() & 63, w = __builtin_amdgcn_readfirstlane(tid_opaque() >> 6);
  const unsigned char* u8 = p.ub8() + (size_t)l * 16384 * 1024;
  const unsigned char* v8 = p.vb8() + (size_t)l * 16384 * 1024;
  const unsigned loff = (unsigned)lane * 16u;
  for (int t = bid * 4 + w; t < NTOK; t += nblk * 4) {
    float xf[16];
    {
      const uint4 xa = *reinterpret_cast<const uint4*>(p.xn() + (size_t)t * 1024 + lane * 16);
      const uint4 xb = *reinterpret_cast<const uint4*>(p.xn() + (size_t)t * 1024 + lane * 16 + 8);
      xf[0] = bf_lo(xa.x); xf[1] = bf_hi(xa.x); xf[2] = bf_lo(xa.y); xf[3] = bf_hi(xa.y);
      xf[4] = bf_lo(xa.z); xf[5] = bf_hi(xa.z); xf[6] = bf_lo(xa.w); xf[7] = bf_hi(xa.w);
      xf[8] = bf_lo(xb.x); xf[9] = bf_hi(xb.x); xf[10] = bf_lo(xb.y); xf[11] = bf_hi(xb.y);
      xf[12] = bf_lo(xb.z); xf[13] = bf_hi(xb.z); xf[14] = bf_lo(xb.w); xf[15] = bf_hi(xb.w);
    }
    const int e_lo = p.eidx()[(size_t)t * 128 + lane], e_hi = p.eidx()[(size_t)t * 128 + 64 + lane];
    const float g_lo = p.egate()[(size_t)t * 128 + lane], g_hi = p.egate()[(size_t)t * 128 + 64 + lane];
    const float s_lo = p.esu()[(size_t)t * 128 + lane], s_hi = p.esu()[(size_t)t * 128 + 64 + lane];
    float y[16];
#pragma unroll
    for (int i = 0; i < 16; ++i) y[i] = 0.f;
#pragma unroll 1
    for (int k0 = 0; k0 < 128; k0 += 8) {
      uint4 ur[8], vr[8];
#pragma unroll
      for (int q = 0; q < 8; ++q) {
        const int kk = (k0 & 63) + q;
        const int e = (k0 < 64) ? __builtin_amdgcn_readlane(e_lo, kk) : __builtin_amdgcn_readlane(e_hi, kk);
        ur[q] = *reinterpret_cast<const uint4*>(u8 + (size_t)e * 1024 + loff);
        vr[q] = *reinterpret_cast<const uint4*>(v8 + (size_t)e * 1024 + loff);
      }
#pragma unroll
      for (int q = 0; q < 8; ++q) {
        const int kk = (k0 & 63) + q;
        const float gt = __int_as_float((k0 < 64) ? __builtin_amdgcn_readlane(__float_as_int(g_lo), kk) : __builtin_amdgcn_readlane(__float_as_int(g_hi), kk));
        const float su = __int_as_float((k0 < 64) ? __builtin_amdgcn_readlane(__float_as_int(s_lo), kk) : __builtin_amdgcn_readlane(__float_as_int(s_hi), kk));
        float d = wave_sum(dot16_fp8(xf, ur[q])) * su;
        const float wgt = gt * gelu_exact(d);
        axpy16_fp8(y, wgt, vr[q]);
      }
    }
    if (DRY) {
#pragma unroll
      for (int i = 0; i < 16; ++i) asm volatile("" ::"v"(y[i]));
      continue;
    }
    float* xr = p.x() + (size_t)t * 1024 + lane * 16;
#pragma unroll
    for (int j = 0; j < 4; ++j) {
      float4 a = reinterpret_cast<float4*>(xr)[j];
      a.x += y[4 * j]; a.y += y[4 * j + 1]; a.z += y[4 * j + 2]; a.w += y[4 * j + 3];
      reinterpret_cast<float4*>(xr)[j] = a;
    }
  }
}

enum { PH_PREP = 0, PH_NORM1, PH_GEMM_IN, PH_ATTN, PH_MLCONV, PH_MCHAIN, PH_MLU, PH_MLSCAN, PH_MLOUT, PH_CMLP,
       PH_GEMM_OUT, PH_NORM2, PH_GEMM_PQ, PH_GEMM_SC, PH_TOPK, PH_GATHER, PH_FINAL };

__device__ __forceinline__ Params phase_params(const Params& kp, bool with_inputs, bool with_tables = false) {
  Params q;
  size_t z = 0;
  asm volatile("" : "+s"(z));
  q.out = kp.out + z;
  q.ws = kp.ws + z;
  q.in[0] = kp.in[0] + z;
  q.in[1] = kp.in[1] + z;
  if (with_inputs) {
#pragma unroll
    for (int i = 2; i < 30; ++i) q.in[i] = kp.in[i] + z;
  }
  if (with_tables) { q.in[27] = kp.in[27] + z; q.in[28] = kp.in[28] + z; }
  return q;
}


#define GT 4
typedef __attribute__((ext_vector_type(4))) float f32x4;

__device__ __forceinline__ float dot16_fp8v(const f32x2* x2, uint4 u) {
  f32x2 acc = x2[0] * __builtin_amdgcn_cvt_pk_f32_fp8(u.x, false);
  acc += x2[1] * __builtin_amdgcn_cvt_pk_f32_fp8(u.x, true);
  acc += x2[2] * __builtin_amdgcn_cvt_pk_f32_fp8(u.y, false);
  acc += x2[3] * __builtin_amdgcn_cvt_pk_f32_fp8(u.y, true);
  acc += x2[4] * __builtin_amdgcn_cvt_pk_f32_fp8(u.z, false);
  acc += x2[5] * __builtin_amdgcn_cvt_pk_f32_fp8(u.z, true);
  acc += x2[6] * __builtin_amdgcn_cvt_pk_f32_fp8(u.w, false);
  acc += x2[7] * __builtin_amdgcn_cvt_pk_f32_fp8(u.w, true);
  return acc.x + acc.y;
}
__device__ __forceinline__ void axpy16_fp8v(f32x2* y2, float wgt, uint4 v) {
  const f32x2 w2 = {wgt, wgt};
  y2[0] += w2 * __builtin_amdgcn_cvt_pk_f32_fp8(v.x, false);
  y2[1] += w2 * __builtin_amdgcn_cvt_pk_f32_fp8(v.x, true);
  y2[2] += w2 * __builtin_amdgcn_cvt_pk_f32_fp8(v.y, false);
  y2[3] += w2 * __builtin_amdgcn_cvt_pk_f32_fp8(v.y, true);
  y2[4] += w2 * __builtin_amdgcn_cvt_pk_f32_fp8(v.z, false);
  y2[5] += w2 * __builtin_amdgcn_cvt_pk_f32_fp8(v.z, true);
  y2[6] += w2 * __builtin_amdgcn_cvt_pk_f32_fp8(v.w, false);
  y2[7] += w2 * __builtin_amdgcn_cvt_pk_f32_fp8(v.w, true);
}

struct GU { uint4 ur[4]; f32x4 su; };
struct GV { uint4 vr[4]; f32x4 gt; };
#define GREC 384
__device__ __forceinline__ void gload_u(GU& U, const float* rec, int i4, const unsigned char* u8, unsigned loff) {
  const f32x4 ev = *reinterpret_cast<const f32x4*>(rec + i4);
  U.su = *reinterpret_cast<const f32x4*>(rec + 256 + i4);
  const int e0 = __builtin_amdgcn_readfirstlane(__float_as_int(ev.x)), e1 = __builtin_amdgcn_readfirstlane(__float_as_int(ev.y));
  const int e2 = __builtin_amdgcn_readfirstlane(__float_as_int(ev.z)), e3 = __builtin_amdgcn_readfirstlane(__float_as_int(ev.w));
  U.ur[0] = *reinterpret_cast<const uint4*>(u8 + (size_t)e0 * 1024 + loff);
  U.ur[1] = *reinterpret_cast<const uint4*>(u8 + (size_t)e1 * 1024 + loff);
  U.ur[2] = *reinterpret_cast<const uint4*>(u8 + (size_t)e2 * 1024 + loff);
  U.ur[3] = *reinterpret_cast<const uint4*>(u8 + (size_t)e3 * 1024 + loff);
}
__device__ __forceinline__ void gload_v(GV& V, const float* rec, int i4, const unsigned char* v8, unsigned loff) {
  const f32x4 ev = *reinterpret_cast<const f32x4*>(rec + i4);
  V.gt = *reinterpret_cast<const f32x4*>(rec + 128 + i4);
  const int e0 = __builtin_amdgcn_readfirstlane(__float_as_int(ev.x)), e1 = __builtin_amdgcn_readfirstlane(__float_as_int(ev.y));
  const int e2 = __builtin_amdgcn_readfirstlane(__float_as_int(ev.z)), e3 = __builtin_amdgcn_readfirstlane(__float_as_int(ev.w));
  V.vr[0] = *reinterpret_cast<const uint4*>(v8 + (size_t)e0 * 1024 + loff);
  V.vr[1] = *reinterpret_cast<const uint4*>(v8 + (size_t)e1 * 1024 + loff);
  V.vr[2] = *reinterpret_cast<const uint4*>(v8 + (size_t)e2 * 1024 + loff);
  V.vr[3] = *reinterpret_cast<const uint4*>(v8 + (size_t)e3 * 1024 + loff);
}
__device__ __forceinline__ float gelu_as(float z) {
  const float x = fabsf(z) * 0.70710678118654752f;
  const float t = __builtin_amdgcn_rcpf(fmaf(0.3275911f, x, 1.f));
  float pl = fmaf(1.061405429f, t, -1.453152027f);
  pl = fmaf(pl, t, 1.421413741f); pl = fmaf(pl, t, -0.284496736f); pl = fmaf(pl, t, 0.254829592f);
  const float e = __builtin_amdgcn_exp2f(-x * x * LOG2E);
  const float erfa = 1.f - pl * t * e;
  return 0.5f * z + 0.5f * fabsf(z) * erfa;
}
template <int PAT>
__device__ __forceinline__ float swz_f(float v) { return __int_as_float(__builtin_amdgcn_ds_swizzle(__float_as_int(v), PAT)); }

__device__ __forceinline__ void gstep2(GU& UA, GV& VA, GU& UB, GV& VB, const uint4* xlA, const uint4* xlB, f32x2* yA, f32x2* yB,
                                       const float* recA, const float* recB, int ci4, const float* nxtA, const float* nxtB, int ni4,
                                       const unsigned char* u8, const unsigned char* v8, unsigned loff, int lane) {
  float d[8];
  {
    f32x2 x2[8];
    const uint4 xa = xlA[0], xb = xlA[1];
    x2[0] = f32x2{bf_lo(xa.x), bf_hi(xa.x)}; x2[1] = f32x2{bf_lo(xa.y), bf_hi(xa.y)};
    x2[2] = f32x2{bf_lo(xa.z), bf_hi(xa.z)}; x2[3] = f32x2{bf_lo(xa.w), bf_hi(xa.w)};
    x2[4] = f32x2{bf_lo(xb.x), bf_hi(xb.x)}; x2[5] = f32x2{bf_lo(xb.y), bf_hi(xb.y)};
    x2[6] = f32x2{bf_lo(xb.z), bf_hi(xb.z)}; x2[7] = f32x2{bf_lo(xb.w), bf_hi(xb.w)};
#pragma unroll
    for (int q = 0; q < 4; ++q) d[q] = dot16_fp8v(x2, UA.ur[q]);
  }
  gload_u(UA, nxtA, ni4, u8, loff);
  {
    f32x2 x2[8];
    const uint4 xa = xlB[0], xb = xlB[1];
    x2[0] = f32x2{bf_lo(xa.x), bf_hi(xa.x)}; x2[1] = f32x2{bf_lo(xa.y), bf_hi(xa.y)};
    x2[2] = f32x2{bf_lo(xa.z), bf_hi(xa.z)}; x2[3] = f32x2{bf_lo(xa.w), bf_hi(xa.w)};
    x2[4] = f32x2{bf_lo(xb.x), bf_hi(xb.x)}; x2[5] = f32x2{bf_lo(xb.y), bf_hi(xb.y)};
    x2[6] = f32x2{bf_lo(xb.z), bf_hi(xb.z)}; x2[7] = f32x2{bf_lo(xb.w), bf_hi(xb.w)};
#pragma unroll
    for (int q = 0; q < 4; ++q) d[4 + q] = dot16_fp8v(x2, UB.ur[q]);
  }
  gload_u(UB, nxtB, ni4, u8, loff);
  const bool b0 = lane & 1, b1 = lane & 2, b2 = lane & 4;
  float a[4];
#pragma unroll
  for (int j = 0; j < 4; ++j) {
    const float keep = b0 ? d[4 + j] : d[j], send = b0 ? d[j] : d[4 + j];
    a[j] = keep + dpp_f<0xB1>(send);
  }
  float c2[2];
#pragma unroll
  for (int j = 0; j < 2; ++j) {
    const float keep = b1 ? a[2 + j] : a[j], send = b1 ? a[j] : a[2 + j];
    c2[j] = keep + dpp_f<0x4E>(send);
  }
  float tot;
  {
    const float keep = b2 ? c2[1] : c2[0], send = b2 ? c2[0] : c2[1];
    tot = keep + swz_f<0x101F>(send);
  }
  tot += swz_f<0x201F>(tot);
  tot = swap32_sum(swap16_sum(tot));
  const int pq = ((lane >> 1) & 1) * 2 + ((lane >> 2) & 1);
  const float* rl = (b0 ? recB : recA) + ci4 + pq;
  const float z = tot * rl[256];
  const float wv = rl[128] * gelu_as(z);
#pragma unroll
  for (int q = 0; q < 4; ++q) {
    const int ln = ((q >> 1) & 1) * 2 + (q & 1) * 4;
    const float wa = __int_as_float(__builtin_amdgcn_readlane(__float_as_int(wv), ln));
    const float wb = __int_as_float(__builtin_amdgcn_readlane(__float_as_int(wv), ln + 1));
    axpy16_fp8v(yA, wa, VA.vr[q]);
    axpy16_fp8v(yB, wb, VB.vr[q]);
  }
  gload_v(VA, nxtA, ni4, v8, loff);
  gload_v(VB, nxtB, ni4, v8, loff);
}

__device__ __forceinline__ void gstep(GU& U, GV& V, const uint4* xl, f32x2* y2, const float* nrec, int ni4,
                                      const unsigned char* u8, const unsigned char* v8, unsigned loff, int lane) {
  f32x2 x2[8];
  {
    const uint4 xa = xl[0], xb = xl[1];
    x2[0] = f32x2{bf_lo(xa.x), bf_hi(xa.x)}; x2[1] = f32x2{bf_lo(xa.y), bf_hi(xa.y)};
    x2[2] = f32x2{bf_lo(xa.z), bf_hi(xa.z)}; x2[3] = f32x2{bf_lo(xa.w), bf_hi(xa.w)};
    x2[4] = f32x2{bf_lo(xb.x), bf_hi(xb.x)}; x2[5] = f32x2{bf_lo(xb.y), bf_hi(xb.y)};
    x2[6] = f32x2{bf_lo(xb.z), bf_hi(xb.z)}; x2[7] = f32x2{bf_lo(xb.w), bf_hi(xb.w)};
  }
  float d[4], su[4];
#pragma unroll
  for (int q = 0; q < 4; ++q) { d[q] = dot16_fp8v(x2, U.ur[q]); su[q] = U.su[q]; }
  gload_u(U, nrec, ni4, u8, loff);
#pragma unroll
  for (int q = 0; q < 4; ++q) d[q] = wave_sum(d[q]) * su[q];
  float dv = d[0]; dv = (lane == 1) ? d[1] : dv; dv = (lane == 2) ? d[2] : dv; dv = (lane == 3) ? d[3] : dv;
  const float av = gelu_as(dv);
#pragma unroll
  for (int q = 0; q < 4; ++q) {
    const float act = __int_as_float(__builtin_amdgcn_readlane(__float_as_int(av), q));
    axpy16_fp8v(y2, V.gt[q] * act, V.vr[q]);
  }
  gload_v(V, nrec, ni4, v8, loff);
}

__device__ __forceinline__ void gsort_token(const Params& p, int t, float* rec, int lane) {
  const int e0 = p.eidx()[(size_t)t * 128 + lane], e1 = p.eidx()[(size_t)t * 128 + 64 + lane];
  const float g0 = p.egate()[(size_t)t * 128 + lane], g1 = p.egate()[(size_t)t * 128 + 64 + lane];
  const float q0 = p.esu()[(size_t)t * 128 + lane], q1 = p.esu()[(size_t)t * 128 + 64 + lane];
  int base = 0;
#pragma unroll 4
  for (int s = 0; s < 16; ++s) {
    const unsigned long long m0 = __ballot((e0 >> 10) == s), m1 = __ballot((e1 >> 10) == s);
    const int c0 = __popcll(m0), c1 = __popcll(m1);
    const int p0 = base + (int)__builtin_amdgcn_mbcnt_hi((unsigned)(m0 >> 32), __builtin_amdgcn_mbcnt_lo((unsigned)m0, 0));
    const int p1 = base + c0 + (int)__builtin_amdgcn_mbcnt_hi((unsigned)(m1 >> 32), __builtin_amdgcn_mbcnt_lo((unsigned)m1, 0));
    if ((e0 >> 10) == s) { rec[p0] = __int_as_float(e0); rec[128 + p0] = g0; rec[256 + p0] = q0; }
    if ((e1 >> 10) == s) { rec[p1] = __int_as_float(e1); rec[128 + p1] = g1; rec[256 + p1] = q1; }
    base += c0 + c1;
  }
}
__device__ __forceinline__ void gload_x(const Params& p, int t, uint4* xl, int lane) {
  xl[0] = *reinterpret_cast<const uint4*>(p.xn() + (size_t)t * 1024 + lane * 16);
  xl[1] = *reinterpret_cast<const uint4*>(p.xn() + (size_t)t * 1024 + lane * 16 + 8);
}
template <bool LAST>
__device__ __forceinline__ void gstore_x(const Params& p, int l, int t, const f32x2* y2, int lane) {
  float* xr = p.x() + (size_t)t * 1024 + lane * 16;
  float4 a[4];
  float ss = 0.f;
#pragma unroll
  for (int j = 0; j < 4; ++j) {
    a[j] = reinterpret_cast<float4*>(xr)[j];
    a[j].x += y2[2 * j].x; a[j].y += y2[2 * j].y; a[j].z += y2[2 * j + 1].x; a[j].w += y2[2 * j + 1].y;
    ss += a[j].x * a[j].x + a[j].y * a[j].y + a[j].z * a[j].z + a[j].w * a[j].w;
  }
  ss = wave_sum(ss);
  const float r = rsqrtf(ss * (1.f / 1024.f) + EPS);
  if (LAST) {
    const float* g = p.final_g() + lane * 16;
    float* o = ((t < NPROMPT) ? p.out + O_Y_P + (size_t)t * 1024 : p.out + O_Y_S + (size_t)(t - NPROMPT) * 1024) + lane * 16;
#pragma unroll
    for (int j = 0; j < 4; ++j) {
      const float4 gv = reinterpret_cast<const float4*>(g)[j];
      reinterpret_cast<float4*>(o)[j] = make_float4(a[j].x * r * gv.x, a[j].y * r * gv.y, a[j].z * r * gv.z, a[j].w * r * gv.w);
    }
  } else {
    const float* g = p.norm1_g() + (l + 1) * 1024 + lane * 16;
#pragma unroll
    for (int j = 0; j < 4; ++j) {
      reinterpret_cast<float4*>(xr)[j] = a[j];
      const float4 gv = reinterpret_cast<const float4*>(g)[j];
      a[j].x *= r * gv.x; a[j].y *= r * gv.y; a[j].z *= r * gv.z; a[j].w *= r * gv.w;
    }
    uint4* o = reinterpret_cast<uint4*>(p.xn() + (size_t)t * 1024 + lane * 16);
    o[0] = make_uint4(pack2(a[0].x, a[0].y), pack2(a[0].z, a[0].w), pack2(a[1].x, a[1].y), pack2(a[1].z, a[1].w));
    o[1] = make_uint4(pack2(a[2].x, a[2].y), pack2(a[2].z, a[2].w), pack2(a[3].x, a[3].y), pack2(a[3].z, a[3].w));
    float pre[8];
#pragma unroll
    for (int i = 0; i < 8; ++i) {
      const float4* wr = reinterpret_cast<const float4*>(p.wg() + ((size_t)(l + 1) * 8 + i) * 1024 + lane * 16);
      float s = 0.f;
#pragma unroll
      for (int j = 0; j < 4; ++j) {
        const float4 wv = wr[j];
        s += a[j].x * wv.x + a[j].y * wv.y + a[j].z * wv.z + a[j].w * wv.w;
      }
      pre[i] = wave_sum(s);
    }
    if (lane < 4) {
      float ai = pre[0]; ai = lane == 1 ? pre[1] : ai; ai = lane == 2 ? pre[2] : ai; ai = lane == 3 ? pre[3] : ai;
      float f = pre[4]; f = lane == 1 ? pre[5] : f; f = lane == 2 ? pre[6] : f; f = lane == 3 ? pre[7] : f;
      p.ig()[(size_t)t * 4 + lane] = ai + p.ml_gate_b()[(l + 1) * 8 + lane];
      const float z = f + p.ml_gate_b()[(l + 1) * 8 + 4 + lane];
      p.lf()[(size_t)t * 4 + lane] = fminf(z, 0.f) - log1pf(expf(-fabsf(z)));
    }
  }
}

template <bool LAST>
__device__ __forceinline__ void ph_gather2(const Params& p, int l, char* smem, int bid, int nblk) {
  const int tid = tid_opaque(), lane = tid & 63, w = __builtin_amdgcn_readfirstlane(tid >> 6);
  const unsigned char* u8 = p.ub8() + (size_t)l * 16384 * 1024;
  const unsigned char* v8 = p.vb8() + (size_t)l * 16384 * 1024;
  const unsigned loff = (unsigned)lane * 16u;
  float* rec = reinterpret_cast<float*>(smem) + w * (GT * GREC);
  uint4* xl = reinterpret_cast<uint4*>(smem + 4 * GT * GREC * 4) + (w * GT * 64 + lane) * 2;
  const int rot = 0;
  const int nwaves = nblk * 4, wg = bid * 4 + w;
  const int nfull = (NTOK / (nwaves * GT)) * nwaves;
  for (int grp = wg; grp < nfull; grp += nwaves) {
    const int t0 = grp * GT;
    int lane_s = lane; asm volatile("" : "+v"(lane_s));
#pragma unroll 1
    for (int ti = 0; ti < GT; ++ti) {
      gload_x(p, t0 + ti, xl + ti * 128, lane_s);
      gsort_token(p, t0 + ti, rec + ti * GREC, lane_s);
    }
    f32x2 y2[GT][8];
#pragma unroll
    for (int ti = 0; ti < GT; ++ti)
#pragma unroll
      for (int i = 0; i < 8; ++i) y2[ti][i] = f32x2{0.f, 0.f};
    GU U0, U1; GV V0, V1;
    gload_u(U0, rec, (rot & 31) * 4, u8, loff); gload_v(V0, rec, (rot & 31) * 4, v8, loff);
    gload_u(U1, rec + GREC, (rot & 31) * 4, u8, loff); gload_v(V1, rec + GREC, (rot & 31) * 4, v8, loff);
#pragma unroll 1
    for (int b = 0; b < 32; ++b) {
      const int bo = ((b + rot) & 31) * 4, bn = ((b + 1 + rot) & 31) * 4;
      gstep2(U0, V0, U1, V1, xl, xl + 128, y2[0], y2[1], rec, rec + GREC, bo, rec + 2 * GREC, rec + 3 * GREC, bo, u8, v8, loff, lane);
      __builtin_amdgcn_sched_barrier(0);
      gstep2(U0, V0, U1, V1, xl + 256, xl + 384, y2[2], y2[3], rec + 2 * GREC, rec + 3 * GREC, bo, rec, rec + GREC, bn, u8, v8, loff, lane);
      __builtin_amdgcn_sched_barrier(0);
    }
    int lane_e = lane; asm volatile("" : "+v"(lane_e));
#pragma unroll
    for (int ti = 0; ti < GT; ++ti) gstore_x<LAST>(p, l, t0 + ti, y2[ti], lane_e);
  }
  float* ysum = reinterpret_cast<float*>(smem + 4 * GT * GREC * 4 + 4 * GT * 2048);
  for (int t = nfull * GT + bid; t < NTOK; t += nblk) {
    f32x2 y2[8];
    gload_x(p, t, xl, lane);
#pragma unroll
    for (int i = 0; i < 8; ++i) y2[i] = f32x2{0.f, 0.f};
    gsort_token(p, t, rec, lane);
    GU U; GV V;
    gload_u(U, rec, (w * 8) * 4, u8, loff);
    gload_v(V, rec, (w * 8) * 4, v8, loff);
#pragma unroll 1
    for (int b = 0; b < 8; ++b) gstep(U, V, xl, y2, rec, (w * 8 + ((b + 1) & 7)) * 4, u8, v8, loff, lane);
    __syncthreads();
#pragma unroll
    for (int i = 0; i < 8; ++i) { ysum[w * 1024 + lane * 16 + 2 * i] = y2[i].x; ysum[w * 1024 + lane * 16 + 2 * i + 1] = y2[i].y; }
    __syncthreads();
    if (w == 0) {
#pragma unroll
      for (int i = 0; i < 8; ++i) {
        y2[i].x += ysum[1024 + lane * 16 + 2 * i] + ysum[2048 + lane * 16 + 2 * i] + ysum[3072 + lane * 16 + 2 * i];
        y2[i].y += ysum[1024 + lane * 16 + 2 * i + 1] + ysum[2048 + lane * 16 + 2 * i + 1] + ysum[3072 + lane * 16 + 2 * i + 1];
      }
      gstore_x<LAST>(p, l, t, y2, lane);
    }
  }
}

#define XB_TMO      128
#define XB_XCNT(j)  (256  + 64 * (j))
#define XB_XSUB(j)  (1280 + 64 * (j))
#define XB_XGEN(j)  (2304 + 64 * (j))
#define XB_TOP      3328
#define XB_TOPGEN   3392
#define XCD_BAR_WORDS 3456
#define XB_SPIN_CAP (1u << 22)
__device__ __forceinline__ unsigned xb_ld(unsigned* p)              { return __hip_atomic_load(p, __ATOMIC_RELAXED, __HIP_MEMORY_SCOPE_AGENT); }
__device__ __forceinline__ unsigned xb_add(unsigned* p, unsigned v) { return __hip_atomic_fetch_add(p, v, __ATOMIC_RELAXED, __HIP_MEMORY_SCOPE_AGENT); }
__device__ __forceinline__ unsigned xb_xcc_id() { return (unsigned)__builtin_amdgcn_s_getreg((3 << 11) | 20) & 0xFu; }
#define XB_SPIN(cond, bar) do { unsigned _sp = 0; while (cond) { __builtin_amdgcn_s_sleep(1); \
    if ((++_sp & 255u) == 0u) { if (xb_ld(&(bar)[XB_TMO])) break; if (_sp > XB_SPIN_CAP) { atomicAdd(&(bar)[XB_TMO], 1u); break; } } } } while (0)

struct XcdBarrier { unsigned* bar; unsigned x; volatile LAS unsigned* st; };

__device__ __forceinline__ XcdBarrier xcd_barrier_post(unsigned* bar, volatile LAS unsigned* st) {
  XcdBarrier b; b.bar = bar; b.x = xb_xcc_id(); b.st = st;
  if (threadIdx.x == 0) (void)xb_add(&bar[XB_XCNT(b.x)], 1u);
  return b;
}
__device__ __forceinline__ void xcd_barrier_complete(unsigned* bar, unsigned x, unsigned& nloc, unsigned& nx) {
  const unsigned G = gridDim.x * gridDim.y * gridDim.z;
  unsigned sum, cnt, mine, sp = 0u;
  for (;;) {
    sum = 0u; cnt = 0u; mine = 0u;
#pragma unroll
    for (unsigned j = 0; j < 16; ++j) { const unsigned c = xb_ld(&bar[XB_XCNT(j)]); sum += c; cnt += (c > 0u) ? 1u : 0u; mine = (j == x) ? c : mine; }
    if (sum == G) break;
    __builtin_amdgcn_s_sleep(1);
    if ((++sp & 255u) == 0u) { if (xb_ld(&bar[XB_TMO])) break; if (sp > XB_SPIN_CAP) { atomicAdd(&bar[XB_TMO], 1u); break; } }
  }
  nloc = mine > 0u ? mine : 1u; nx = cnt > 0u ? cnt : 1u;
}
__device__ __forceinline__ void xcd_barrier(const XcdBarrier& b) {
  asm volatile("s_waitcnt vmcnt(0)" ::: "memory");
  __syncthreads();
  if (threadIdx.x == 0) {
    unsigned* bar = b.bar;
    __builtin_amdgcn_s_waitcnt(0);
    unsigned nloc = b.st[0], nx = b.st[1];
    if (nloc == 0u) { xcd_barrier_complete(bar, b.x, nloc, nx); b.st[0] = nloc; b.st[1] = nx; }
    const unsigned old = xb_add(&bar[XB_XSUB(b.x)], 1u);
    const unsigned gen = old / nloc;
    if (old + 1u == (gen + 1u) * nloc) {
      __builtin_amdgcn_fence(__ATOMIC_RELEASE, "agent");
      asm volatile("s_waitcnt vmcnt(0)" ::: "memory");
      const unsigned og = xb_add(&bar[XB_TOP], 1u);
      const unsigned tg = og / nx;
      if (og + 1u == (tg + 1u) * nx) xb_add(&bar[XB_TOPGEN], 1u);
      else XB_SPIN(xb_ld(&bar[XB_TOPGEN]) == tg, bar);
      __builtin_amdgcn_fence(__ATOMIC_ACQUIRE, "agent");
      xb_add(&bar[XB_XGEN(b.x)], 1u);
      asm volatile("s_waitcnt vmcnt(0)" ::: "memory");
    } else {
      XB_SPIN(xb_ld(&bar[XB_XGEN(b.x)]) == gen, bar);
      __builtin_amdgcn_fence(__ATOMIC_ACQUIRE, "agent");
      asm volatile("s_waitcnt vmcnt(0)" ::: "memory");
    }
  }
  __syncthreads();
}

#define GSYNC() xcd_barrier(xb)
#define PP(wi) phase_params(p, wi)
#define BN bid_opaque(bid), nblk_opaque(nblk)

template <int L>
__device__ __forceinline__ void layer_phases(const Params& p, char* smem, const XcdBarrier& xb, int bid, int nblk) {
  if (L == 0) {
  ph_rmsnorm<0>(PP(false), L, BN);
#if PROBE == 11
  GSYNC();
  ph_rmsnorm<0>(PP(false), L, BN);
#endif
  GSYNC();
  }
  ph_gemm<EPI_WIN>(PP(false), L, smem, BN);
#if PROBE == 1
  GSYNC();
  ph_gemm<EPI_WIN>(PP(false), L, smem, BN);
#endif
  GSYNC();
  {
    const Params q = PP(false);
    WorkQ wq; wq.cnt = reinterpret_cast<unsigned*>(q.ws) + 8 + L; wq.slot = reinterpret_cast<volatile int*>(smem + SMEM_BYTES - 8); wq.off = 0;
    int item = ph_attn<(L == 0)>(phase_params(p, false, L == 0), L, smem, wq);
    wq.off = (L == 0) ? 528 : 0;
    item = ph_mlconv(PP(false), L, smem, wq, item);
    ph_cmlp(PP(false), L, smem, wq, item);
  }
  GSYNC();
  ph_mlU(PP(false), L, smem, BN);
#if PROBE == 9 || PROBE == 20
  GSYNC();
  ph_mlU(PP(false), L, smem, BN);
#endif
  GSYNC();
  ph_mlscan(PP(false), L, BN);
#if PROBE == 10 || PROBE == 20
  GSYNC();
  ph_mlscan(PP(false), L, BN);
#endif
  GSYNC();
  ph_mlout(PP(false), L, smem, BN);
#if PROBE == 6 || PROBE == 20
  GSYNC();
  ph_mlout(PP(false), L, smem, BN);
#endif
  GSYNC();
  ph_gemm<EPI_WOUT>(PP(false), L, smem, BN);
  GSYNC();
  ph_rmsnorm<1>(PP(false), L, BN);
  GSYNC();
  ph_gemm<EPI_PQ>(PP(false), L, smem, BN);
#if PROBE == 2
  GSYNC();
  ph_gemm<EPI_PQ>(PP(false), L, smem, BN);
#endif
  GSYNC();
  ph_topk(PP(false), L, smem, BN);
#if PROBE == 5
  GSYNC();
  ph_topk(PP(false), L, smem, BN);
#endif
  GSYNC();
  ph_gather2<(L == 1)>(PP(false), L, smem, BN);
  GSYNC();
}

__global__ void __launch_bounds__(256, 2) mega_kernel(Params p) {
  __shared__ __attribute__((aligned(16))) char smem[SMEM_BYTES];
  __shared__ uint4 xb_words;
  cg::grid_group grid = cg::this_grid();
  const int bid = blockIdx.x, nblk = gridDim.x;
  if (threadIdx.x == 0) xb_words = make_uint4(0u, 0u, 0u, 0u);
  __syncthreads();
  XcdBarrier xb = xcd_barrier_post(reinterpret_cast<unsigned*>(p.ws), (volatile LAS unsigned*)&xb_words);
  grid.sync();
  ph_prep(PP(true), smem, BN);
#if PROBE == 12
  GSYNC();
  ph_prep(PP(true), smem, BN);
#endif
  GSYNC();
  layer_phases<0>(p, smem, xb, bid, nblk);
  layer_phases<1>(p, smem, xb, bid, nblk);
}

static inline size_t align_up(size_t v, size_t a) { return (v + a - 1) / a * a; }

extern "C" void kernel_launch(void* const* d_in, const int* in_sizes, int n_in, void* d_out, int out_size, void* d_ws,
                              size_t ws_size, hipStream_t stream) {
  Params p{};
  for (int i = 0; i < 30; ++i) p.in[i] = reinterpret_cast<const float*>(d_in[i]);
  p.out = reinterpret_cast<float*>(d_out);
  p.ws = reinterpret_cast<char*>(d_ws);
  if (WS_NEED > ws_size) { fprintf(stderr, "workspace too small: need %zu have %zu\n", (size_t)WS_NEED, ws_size); return; }
  static int grid_blocks = 0;
  if (!grid_blocks) {
    int dev = 0, cus = 0, per_cu = 0;
    hipGetDevice(&dev);
    hipDeviceGetAttribute(&cus, hipDeviceAttributeMultiprocessorCount, dev);
    hipOccupancyMaxActiveBlocksPerMultiprocessor(&per_cu, mega_kernel, 256, 0);
    if (per_cu > 2) per_cu = 2;
    if (per_cu < 1) per_cu = 1;
    grid_blocks = cus * per_cu;
  }
  hipMemsetAsync(d_ws, 0, 16384, stream);
  void* args[] = {&p};
  hipError_t e = hipLaunchCooperativeKernel((void*)mega_kernel, dim3(grid_blocks), dim3(256), args, 0, stream);
  if (e != hipSuccess) fprintf(stderr, "cooperative launch failed: %s (grid %d)\n", hipGetErrorString(e), grid_blocks);
}
```

```cpp
#include <hip/hip_runtime.h>
#include <hip/hip_cooperative_groups.h>
#include <cstdio>
#include <cstdint>

namespace cg = cooperative_groups;

typedef unsigned short bf16_t;
typedef __attribute__((ext_vector_type(8))) __bf16 bf16x8;
typedef __attribute__((ext_vector_type(2))) __bf16 bf16x2;
typedef __attribute__((ext_vector_type(16))) float f32x16;
typedef __attribute__((ext_vector_type(2))) float f32x2;

#define D_MODEL 1024
#define NTOK 16896
#define NPROMPT 16384
#define SEQ 4096
#define NIN 2816
#define EPS 1e-6f
#define LOG2E 1.4426950408889634f
#define SKEYS 1088
#define NCU_UNITS 1056

constexpr size_t O_Y_P = 0;
constexpr size_t O_Y_S = O_Y_P + 16777216;
constexpr size_t O_K_P = O_Y_S + 524288;
constexpr size_t O_V_P = O_K_P + 16777216;
constexpr size_t O_C_P = O_V_P + 16777216;
constexpr size_t O_N_P = O_C_P + 131072;
constexpr size_t O_M_P = O_N_P + 2048;
constexpr size_t O_CONV_P = O_M_P + 32;
constexpr size_t O_K_S = O_CONV_P + 6144;
constexpr size_t O_V_S = O_K_S + 524288;
constexpr size_t O_C_S = O_V_S + 524288;
constexpr size_t O_N_S = O_C_S + 262144;
constexpr size_t O_M_S = O_N_S + 4096;
constexpr size_t O_CONV_S = O_M_S + 64;
constexpr size_t O_CMV_S = O_CONV_S + 12288;

constexpr size_t al256(size_t v) { return (v + 255) / 256 * 256; }
constexpr int SP_st_c = 0;
constexpr int SP_st_n = 262144;
constexpr int SP_st_m = 266240;
constexpr int SP_st_conv = 266304;
constexpr int SP_norm1_g = 278592;
constexpr int SP_da_subln_g = 280640;
constexpr int SP_ml_conv_w = 280896;
constexpr int SP_ml_conv_b = 282944;
constexpr int SP_ml_wq = 283456;
constexpr int SP_ml_wk = 316224;
constexpr int SP_ml_gate_b = 348992;
constexpr int SP_ml_norm_g = 349056;
constexpr int SP_ml_skip = 349568;
constexpr int SP_cm_norm_g = 350080;
constexpr int SP_cm_ws = 350592;
constexpr int SP_cm_b = 481664;
constexpr int SP_norm2_g = 482688;
constexpr int SP_final_g = 484736;
constexpr int SP_TOTAL = 485760;
constexpr size_t WS_bar = 0;
constexpr size_t WS_lam = al256(WS_bar + 16384);
constexpr size_t WS_lut = al256(WS_lam + (256));
constexpr size_t WS_sp = al256(WS_lut + (4*256*4));
constexpr size_t WS_wt_in = al256(WS_sp + (SP_TOTAL*4));
constexpr size_t WS_wg = al256(WS_wt_in + ((size_t)2*NIN*1024*2));
constexpr size_t WS_wt_out = al256(WS_wg + ((size_t)2*8*1024*4));
constexpr size_t WS_wt_pq = al256(WS_wt_out + ((size_t)2*1024*1024*2));
constexpr size_t WS_keysb = al256(WS_wt_pq + ((size_t)2*2048*1024*2));
constexpr size_t WS_ub8 = al256(WS_keysb + ((size_t)2*16*128*128*2));
constexpr size_t WS_vb8 = al256(WS_ub8 + ((size_t)2*16384*1024));
constexpr size_t WS_us = al256(WS_vb8 + ((size_t)2*16384*1024));
constexpr size_t WS_vs = al256(WS_us + ((size_t)2*16384*4));
constexpr size_t WS_Kbs = al256(WS_vs + ((size_t)2*16384*4));
constexpr size_t WS_Vts = al256(WS_Kbs + ((size_t)2*8*SKEYS*512*2));
constexpr size_t WS_x = al256(WS_Vts + ((size_t)2*8*4*128*SKEYS*2));
constexpr size_t WS_xn = al256(WS_x + ((size_t)NTOK*1024*4));
constexpr size_t WS_R0 = al256(WS_xn + ((size_t)NTOK*1024*2));
constexpr size_t WS_R0x = WS_R0;
constexpr size_t WS_Qb = al256(WS_R0x + (0));
constexpr size_t WS_Kb = al256(WS_Qb + ((size_t)NTOK*512*2));
constexpr size_t WS_Vt = al256(WS_Kb + ((size_t)NPROMPT*512*2));
constexpr size_t WS_P5 = al256(WS_Vt + ((size_t)16*128*SEQ*2));
constexpr size_t WS_ig = al256(WS_P5 + ((size_t)NTOK*1280*4));
constexpr size_t WS_lf = al256(WS_ig + ((size_t)NTOK*4*4));
constexpr size_t WS_Fc = al256(WS_lf + ((size_t)NTOK*4*4));
constexpr size_t WS_cc = al256(WS_Fc + ((size_t)NTOK*4*4));
constexpr size_t WS_qm = al256(WS_cc + ((size_t)NTOK*256*4));
constexpr size_t WS_km = al256(WS_qm + ((size_t)NTOK*256*4));
constexpr size_t WS_mst = al256(WS_km + ((size_t)NTOK*256*4));
constexpr size_t WS_mnx = al256(WS_mst + (NCU_UNITS*4));
constexpr size_t WS_wcs = al256(WS_mnx + (NCU_UNITS*4));
constexpr size_t WS_FLs = al256(WS_wcs + (NCU_UNITS*4));
constexpr size_t WS_mxt = al256(WS_FLs + (NCU_UNITS*4));
constexpr size_t WS_U = al256(WS_mxt + (NCU_UNITS*4));
constexpr size_t WS_un = al256(WS_U + ((size_t)NCU_UNITS*4096*4));
constexpr size_t WS_Cst = al256(WS_un + ((size_t)NCU_UNITS*64*4));
constexpr size_t WS_nst = al256(WS_Cst + ((size_t)NCU_UNITS*4096*4));
constexpr size_t WS_END_MIXER = al256(WS_nst + ((size_t)NCU_UNITS*64*4));
constexpr size_t WS_qp = al256(WS_R0x + (0));
constexpr size_t WS_sc = al256(WS_qp + ((size_t)NTOK*2048*2));
constexpr size_t WS_eidx = al256(WS_sc + ((size_t)NTOK*2048*4));
constexpr size_t WS_egate = al256(WS_eidx + ((size_t)NTOK*128*4));
constexpr size_t WS_esu = al256(WS_egate + ((size_t)NTOK*128*4));
constexpr size_t WS_ssp = al256(WS_esu + ((size_t)NTOK*128*4));
constexpr size_t WS_END_PEER = al256(WS_ssp + ((size_t)NTOK*32*4));
constexpr size_t WS_NEED = WS_END_MIXER > WS_END_PEER ? WS_END_MIXER : WS_END_PEER;

struct Params {
  const float* in[30];
  float* out;
  char* ws;
  __device__ __forceinline__ const float* x_prompt() const { return in[0]; }
  __device__ __forceinline__ const float* x_sample() const { return in[1]; }
  __device__ __forceinline__ const float* cache_k() const { return in[2]; }
  __device__ __forceinline__ const float* cache_v() const { return in[3]; }
  __device__ __forceinline__ const float* w_in() const { return in[9]; }
  __device__ __forceinline__ const float* da_lambda() const { return in[10]; }
  __device__ __forceinline__ const float* rel_table() const { return in[12]; }
  __device__ __forceinline__ const float* w_out() const { return in[23]; }
  __device__ __forceinline__ const float* peer_wq() const { return in[25]; }
  __device__ __forceinline__ const float* peer_keys() const { return in[26]; }
  __device__ __forceinline__ const float* peer_u() const { return in[27]; }
  __device__ __forceinline__ const float* peer_v() const { return in[28]; }
  __device__ __forceinline__ const float* st_c() const { return reinterpret_cast<const float*>(ws + WS_sp) + SP_st_c; }
  __device__ __forceinline__ const float* st_n() const { return reinterpret_cast<const float*>(ws + WS_sp) + SP_st_n; }
  __device__ __forceinline__ const float* st_m() const { return reinterpret_cast<const float*>(ws + WS_sp) + SP_st_m; }
  __device__ __forceinline__ const float* st_conv() const { return reinterpret_cast<const float*>(ws + WS_sp) + SP_st_conv; }
  __device__ __forceinline__ const float* norm1_g() const { return reinterpret_cast<const float*>(ws + WS_sp) + SP_norm1_g; }
  __device__ __forceinline__ const float* da_subln_g() const { return reinterpret_cast<const float*>(ws + WS_sp) + SP_da_subln_g; }
  __device__ __forceinline__ const float* ml_conv_w() const { return reinterpret_cast<const float*>(ws + WS_sp) + SP_ml_conv_w; }
  __device__ __forceinline__ const float* ml_conv_b() const { return reinterpret_cast<const float*>(ws + WS_sp) + SP_ml_conv_b; }
  __device__ __forceinline__ const float* ml_wq() const { return reinterpret_cast<const float*>(ws + WS_sp) + SP_ml_wq; }
  __device__ __forceinline__ const float* ml_wk() const { return reinterpret_cast<const float*>(ws + WS_sp) + SP_ml_wk; }
  __device__ __forceinline__ const float* ml_gate_b() const { return reinterpret_cast<const float*>(ws + WS_sp) + SP_ml_gate_b; }
  __device__ __forceinline__ const float* ml_norm_g() const { return reinterpret_cast<const float*>(ws + WS_sp) + SP_ml_norm_g; }
  __device__ __forceinline__ const float* ml_skip() const { return reinterpret_cast<const float*>(ws + WS_sp) + SP_ml_skip; }
  __device__ __forceinline__ const float* cm_norm_g() const { return reinterpret_cast<const float*>(ws + WS_sp) + SP_cm_norm_g; }
  __device__ __forceinline__ const float* cm_ws() const { return reinterpret_cast<const float*>(ws + WS_sp) + SP_cm_ws; }
  __device__ __forceinline__ const float* cm_b() const { return reinterpret_cast<const float*>(ws + WS_sp) + SP_cm_b; }
  __device__ __forceinline__ const float* norm2_g() const { return reinterpret_cast<const float*>(ws + WS_sp) + SP_norm2_g; }
  __device__ __forceinline__ const float* final_g() const { return reinterpret_cast<const float*>(ws + WS_sp) + SP_final_g; }
  __device__ __forceinline__ float* lam() const { return reinterpret_cast<float*>(ws + WS_lam); }
  __device__ __forceinline__ float* lut() const { return reinterpret_cast<float*>(ws + WS_lut); }
  __device__ __forceinline__ float* sp() const { return reinterpret_cast<float*>(ws + WS_sp); }
  __device__ __forceinline__ bf16_t* wt_in() const { return reinterpret_cast<bf16_t*>(ws + WS_wt_in); }
  __device__ __forceinline__ float* wg() const { return reinterpret_cast<float*>(ws + WS_wg); }
  __device__ __forceinline__ bf16_t* wt_out() const { return reinterpret_cast<bf16_t*>(ws + WS_wt_out); }
  __device__ __forceinline__ bf16_t* wt_pq() const { return reinterpret_cast<bf16_t*>(ws + WS_wt_pq); }
  __device__ __forceinline__ bf16_t* keysb() const { return reinterpret_cast<bf16_t*>(ws + WS_keysb); }
  __device__ __forceinline__ unsigned char* ub8() const { return reinterpret_cast<unsigned char*>(ws + WS_ub8); }
  __device__ __forceinline__ unsigned char* vb8() const { return reinterpret_cast<unsigned char*>(ws + WS_vb8); }
  __device__ __forceinline__ float* us() const { return reinterpret_cast<float*>(ws + WS_us); }
  __device__ __forceinline__ float* vs() const { return reinterpret_cast<float*>(ws + WS_vs); }
  __device__ __forceinline__ bf16_t* Kbs() const { return reinterpret_cast<bf16_t*>(ws + WS_Kbs); }
  __device__ __forceinline__ bf16_t* Vts() const { return reinterpret_cast<bf16_t*>(ws + WS_Vts); }
  __device__ __forceinline__ float* x() const { return reinterpret_cast<float*>(ws + WS_x); }
  __device__ __forceinline__ bf16_t* xn() const { return reinterpret_cast<bf16_t*>(ws + WS_xn); }
  __device__ __forceinline__ bf16_t* Qb() const { return reinterpret_cast<bf16_t*>(ws + WS_Qb); }
  __device__ __forceinline__ bf16_t* Kb() const { return reinterpret_cast<bf16_t*>(ws + WS_Kb); }
  __device__ __forceinline__ bf16_t* Vt() const { return reinterpret_cast<bf16_t*>(ws + WS_Vt); }
  __device__ __forceinline__ float* P5() const { return reinterpret_cast<float*>(ws + WS_P5); }
  __device__ __forceinline__ float* ig() const { return reinterpret_cast<float*>(ws + WS_ig); }
  __device__ __forceinline__ float* lf() const { return reinterpret_cast<float*>(ws + WS_lf); }
  __device__ __forceinline__ float* Fc() const { return reinterpret_cast<float*>(ws + WS_Fc); }
  __device__ __forceinline__ float* cc() const { return reinterpret_cast<float*>(ws + WS_cc); }
  __device__ __forceinline__ float* qm() const { return reinterpret_cast<float*>(ws + WS_qm); }
  __device__ __forceinline__ float* km() const { return reinterpret_cast<float*>(ws + WS_km); }
  __device__ __forceinline__ float* mst() const { return reinterpret_cast<float*>(ws + WS_mst); }
  __device__ __forceinline__ float* mnx() const { return reinterpret_cast<float*>(ws + WS_mnx); }
  __device__ __forceinline__ float* wcs() const { return reinterpret_cast<float*>(ws + WS_wcs); }
  __device__ __forceinline__ float* FLs() const { return reinterpret_cast<float*>(ws + WS_FLs); }
  __device__ __forceinline__ float* mxt() const { return reinterpret_cast<float*>(ws + WS_mxt); }
  __device__ __forceinline__ float* U() const { return reinterpret_cast<float*>(ws + WS_U); }
  __device__ __forceinline__ float* un() const { return reinterpret_cast<float*>(ws + WS_un); }
  __device__ __forceinline__ float* Cst() const { return reinterpret_cast<float*>(ws + WS_Cst); }
  __device__ __forceinline__ float* nst() const { return reinterpret_cast<float*>(ws + WS_nst); }
  __device__ __forceinline__ bf16_t* qp() const { return reinterpret_cast<bf16_t*>(ws + WS_qp); }
  __device__ __forceinline__ float* sc() const { return reinterpret_cast<float*>(ws + WS_sc); }
  __device__ __forceinline__ int* eidx() const { return reinterpret_cast<int*>(ws + WS_eidx); }
  __device__ __forceinline__ float* egate() const { return reinterpret_cast<float*>(ws + WS_egate); }
  __device__ __forceinline__ float* esu() const { return reinterpret_cast<float*>(ws + WS_esu); }
  __device__ __forceinline__ float* ssp() const { return reinterpret_cast<float*>(ws + WS_ssp); }
  __device__ __forceinline__ int* tl() const { return reinterpret_cast<int*>(ws + WS_sc); }
};

__device__ __forceinline__ unsigned pack2(float a, float b) {
  f32x2 v = {a, b};
  bf16x2 r = __builtin_convertvector(v, bf16x2);
  return *reinterpret_cast<unsigned*>(&r);
}
__device__ __forceinline__ bf16_t f2bf(float a) { return (bf16_t)(pack2(a, 0.f) & 0xFFFFu); }
__device__ __forceinline__ float bf_lo(unsigned u) { return __uint_as_float(u << 16); }
__device__ __forceinline__ float bf_hi(unsigned u) { return __uint_as_float(u & 0xFFFF0000u); }
__device__ __forceinline__ float gelu_exact(float x) { return 0.5f * x * (1.f + erff(x * 0.70710678118654752f)); }
__device__ __forceinline__ float sigmoidf_(float x) { return 1.f / (1.f + __expf(-x)); }
__device__ __forceinline__ float shfl_up_l(float v, int d, int lane) {
  const int src = lane >= d ? lane - d : lane;
  return __int_as_float(__builtin_amdgcn_ds_bpermute(src << 2, __float_as_int(v)));
}
template <int CTRL>
__device__ __forceinline__ float dpp_f(float v) {
  return __builtin_bit_cast(float, __builtin_amdgcn_update_dpp(0, __builtin_bit_cast(int, v), CTRL, 0xf, 0xf, true));
}
__device__ __forceinline__ float swap16_sum(float x) {
  auto s = __builtin_amdgcn_permlane16_swap(__float_as_uint(x), __float_as_uint(x), false, false);
  return __uint_as_float(s[0]) + __uint_as_float(s[1]);
}
__device__ __forceinline__ float swap32_sum(float x) {
  auto s = __builtin_amdgcn_permlane32_swap(__float_as_uint(x), __float_as_uint(x), false, false);
  return __uint_as_float(s[0]) + __uint_as_float(s[1]);
}
__device__ __forceinline__ float swap16_max(float x) {
  auto s = __builtin_amdgcn_permlane16_swap(__float_as_uint(x), __float_as_uint(x), false, false);
  return fmaxf(__uint_as_float(s[0]), __uint_as_float(s[1]));
}
__device__ __forceinline__ float swap32_max(float x) {
  auto s = __builtin_amdgcn_permlane32_swap(__float_as_uint(x), __float_as_uint(x), false, false);
  return fmaxf(__uint_as_float(s[0]), __uint_as_float(s[1]));
}
__device__ __forceinline__ float row16_sum(float v) {
  v += dpp_f<0xB1>(v); v += dpp_f<0x4E>(v); v += dpp_f<0x141>(v); v += dpp_f<0x140>(v);
  return v;
}
__device__ __forceinline__ float row16_max(float v) {
  v = fmaxf(v, dpp_f<0xB1>(v)); v = fmaxf(v, dpp_f<0x4E>(v)); v = fmaxf(v, dpp_f<0x141>(v)); v = fmaxf(v, dpp_f<0x140>(v));
  return v;
}
__device__ __forceinline__ float wave_sum(float v) { return swap32_sum(swap16_sum(row16_sum(v))); }
__device__ __forceinline__ float wave_max(float v) { return swap32_max(swap16_max(row16_max(v))); }
__device__ __forceinline__ const float* xrow_in(const Params& p, int l, int t) {
  if (l == 0) return (t < NPROMPT) ? p.x_prompt() + (size_t)t * D_MODEL : p.x_sample() + (size_t)(t - NPROMPT) * D_MODEL;
  return p.x() + (size_t)t * D_MODEL;
}
__device__ __forceinline__ bf16x8 as_bf16x8(uint4 v) { return *reinterpret_cast<bf16x8*>(&v); }

__device__ __forceinline__ int tid_opaque() { int t = threadIdx.x; asm volatile("" : "+v"(t)); return t; }
__device__ __forceinline__ int sgpr_opaque(int v) { asm volatile("" : "+s"(v)); return v; }
__device__ __forceinline__ int bid_opaque(int v) { asm volatile("" : "+s"(v)); __builtin_assume(v >= 0); __builtin_assume(v < 1024); return v; }
__device__ __forceinline__ int nblk_opaque(int v) { asm volatile("" : "+s"(v)); __builtin_assume(v >= 1); __builtin_assume(v <= 1024); return v; }
#define LAS __attribute__((address_space(3)))
#ifndef PROBE
#define PROBE 0
#endif
#define SMEM_BYTES 73728

__device__ __forceinline__ void transpose_tile(const float* __restrict__ src, int lds, bf16_t* __restrict__ dst, int K, int n0, int k0,
                               int gate_skip, float* tile  ) {
  const int tid = tid_opaque();
  const int c = tid & 63, r0 = tid >> 6;
  int n = n0 + c;
  int col = n + ((gate_skip && n >= 2304) ? 8 : 0);
#pragma unroll 4
  for (int j = 0; j < 16; ++j) {
    int r = r0 + 4 * j;
    tile[r * 65 + c] = src[(size_t)(k0 + r) * lds + col];
  }
  __syncthreads();
  const int nn = tid >> 2, kg = (tid & 3) * 16;
  unsigned w[8];
#pragma unroll
  for (int j = 0; j < 8; ++j) w[j] = pack2(tile[(kg + 2 * j) * 65 + nn], tile[(kg + 2 * j + 1) * 65 + nn]);
  uint4* d = reinterpret_cast<uint4*>(dst + (size_t)(n0 + nn) * K + k0 + kg);
  d[0] = make_uint4(w[0], w[1], w[2], w[3]);
  d[1] = make_uint4(w[4], w[5], w[6], w[7]);
  __syncthreads();
}

__device__ __forceinline__ int rel_bucket_dev(int rel) {
  int ret = rel > 0 ? 16 : 0;
  int n = rel < 0 ? -rel : rel;
  int b;
  if (n < 8) b = n;
  else if (n < 12) b = 8;
  else if (n < 16) b = 9;
  else if (n < 23) b = 10;
  else if (n < 32) b = 11;
  else if (n < 46) b = 12;
  else if (n < 64) b = 13;
  else if (n < 91) b = 14;
  else b = 15;
  return ret + b;
}

__device__ __forceinline__ void prep_table_rows(const Params& p, int r0, int r1, int lane, int wv) {
  for (int r = r0 + wv; r < r1; r += 4) {
    const int tab = r >> 15, row = r & 32767;
    const float* src = (tab == 0 ? p.peer_u() : p.peer_v()) + (size_t)row * 1024 + lane * 16;
    float4 f0 = reinterpret_cast<const float4*>(src)[0], f1 = reinterpret_cast<const float4*>(src)[1];
    float4 f2 = reinterpret_cast<const float4*>(src)[2], f3 = reinterpret_cast<const float4*>(src)[3];
    float am = fmaxf(fmaxf(fmaxf(fabsf(f0.x), fabsf(f0.y)), fmaxf(fabsf(f0.z), fabsf(f0.w))),
                     fmaxf(fmaxf(fabsf(f1.x), fabsf(f1.y)), fmaxf(fabsf(f1.z), fabsf(f1.w))));
    am = fmaxf(am, fmaxf(fmaxf(fmaxf(fabsf(f2.x), fabsf(f2.y)), fmaxf(fabsf(f2.z), fabsf(f2.w))),
                         fmaxf(fmaxf(fabsf(f3.x), fabsf(f3.y)), fmaxf(fabsf(f3.z), fabsf(f3.w)))));
    am = wave_max(am);
    const float sc = am > 0.f ? 224.f / am : 1.f;
    int w0 = 0, w1 = 0, w2 = 0, w3 = 0;
    w0 = __builtin_amdgcn_cvt_pk_fp8_f32(f0.x * sc, f0.y * sc, w0, false); w0 = __builtin_amdgcn_cvt_pk_fp8_f32(f0.z * sc, f0.w * sc, w0, true);
    w1 = __builtin_amdgcn_cvt_pk_fp8_f32(f1.x * sc, f1.y * sc, w1, false); w1 = __builtin_amdgcn_cvt_pk_fp8_f32(f1.z * sc, f1.w * sc, w1, true);
    w2 = __builtin_amdgcn_cvt_pk_fp8_f32(f2.x * sc, f2.y * sc, w2, false); w2 = __builtin_amdgcn_cvt_pk_fp8_f32(f2.z * sc, f2.w * sc, w2, true);
    w3 = __builtin_amdgcn_cvt_pk_fp8_f32(f3.x * sc, f3.y * sc, w3, false); w3 = __builtin_amdgcn_cvt_pk_fp8_f32(f3.z * sc, f3.w * sc, w3, true);
    unsigned char* dst = (tab == 0 ? p.ub8() : p.vb8()) + (size_t)row * 1024 + lane * 16;
    *reinterpret_cast<uint4*>(dst) = make_uint4((unsigned)w0, (unsigned)w1, (unsigned)w2, (unsigned)w3);
    if (lane == 0) (tab == 0 ? p.us() : p.vs())[row] = am > 0.f ? am * (1.f / 224.f) : 1.f;
  }
}

__device__ __forceinline__ void ph_prep(const Params& p, char* smem, int bid, int nblk) {
  const int tid = tid_opaque();
  float* tile = reinterpret_cast<float*>(smem);
  for (int u = bid; u < 2 * 1472; u += nblk) {
    int l = u / 1472, r = u % 1472;
    if (r < 704) {
      int nt = r / 16, kt = r % 16;
      transpose_tile(p.w_in() + (size_t)l * 1024 * 2824, 2824, p.wt_in() + (size_t)l * NIN * 1024, 1024, nt * 64, kt * 64, 1, tile);
    } else if (r < 960) {
      r -= 704; int nt = r / 16, kt = r % 16;
      transpose_tile(p.w_out() + (size_t)l * 1024 * 1024, 1024, p.wt_out() + (size_t)l * 1024 * 1024, 1024, nt * 64, kt * 64, 0, tile);
    } else {
      r -= 960; int nt = r / 16, kt = r % 16;
      transpose_tile(p.peer_wq() + (size_t)l * 1024 * 2048, 2048, p.wt_pq() + (size_t)l * 2048 * 1024, 1024, nt * 64, kt * 64, 0, tile);
    }
  }
  for (int u = bid; u < 1024; u += nblk) {
    int kt = u & 15, h = (u >> 4) & 3, b = (u >> 6) & 7, l = u >> 9;
    const float* src = p.cache_v() + (((size_t)(l * 8 + b) * 1024 + kt * 64) * 4 + h) * 128;
    {
      int c = tid & 127, r0 = tid >> 7;
      for (int j = 0; j < 32; ++j) { int r = r0 + 2 * j; tile[r * 129 + c] = src[(size_t)r * 512 + c]; }
    }
    __syncthreads();
    {
      int dv = tid >> 1, half = tid & 1;
      bf16_t* dst = p.Vts() + ((size_t)((l * 8 + b) * 4 + h) * 128 + dv) * SKEYS + kt * 64 + half * 32;
      unsigned w[16];
#pragma unroll
      for (int j = 0; j < 16; ++j) {
        int pos0 = half * 32 + 2 * j;
        int blk = (pos0 >> 2) & 3;
        int oblk = (blk == 1) ? 2 : (blk == 2 ? 1 : blk);
        int key0 = (pos0 & ~15) + oblk * 4 + (pos0 & 3);
        w[j] = pack2(tile[key0 * 129 + dv], tile[(key0 + 1) * 129 + dv]);
      }
      uint4* d4 = reinterpret_cast<uint4*>(dst);
      d4[0] = make_uint4(w[0], w[1], w[2], w[3]);
      d4[1] = make_uint4(w[4], w[5], w[6], w[7]);
      d4[2] = make_uint4(w[8], w[9], w[10], w[11]);
      d4[3] = make_uint4(w[12], w[13], w[14], w[15]);
    }
    __syncthreads();
  }
  const size_t gtid = (size_t)bid * 256 + tid, gsz = (size_t)nblk * 256;
  {
    const size_t n8 = (size_t)2 * 16 * 128 * 128 / 8;
    for (size_t i = gtid; i < n8; i += gsz) {
      float4 a = reinterpret_cast<const float4*>(p.peer_keys())[2 * i], b = reinterpret_cast<const float4*>(p.peer_keys())[2 * i + 1];
      reinterpret_cast<uint4*>(p.keysb())[i] = make_uint4(pack2(a.x, a.y), pack2(a.z, a.w), pack2(b.x, b.y), pack2(b.z, b.w));
    }
  }
  {
    const size_t n8 = (size_t)2 * 8 * 1024 * 512 / 8;
    for (size_t i = gtid; i < n8; i += gsz) {
      size_t e = i * 8;
      size_t lb = e / (1024 * 512), rem = e % (1024 * 512);
      float4 a = reinterpret_cast<const float4*>(p.cache_k())[2 * i], b = reinterpret_cast<const float4*>(p.cache_k())[2 * i + 1];
      *reinterpret_cast<uint4*>(p.Kbs() + lb * (SKEYS * 512) + rem) = make_uint4(pack2(a.x, a.y), pack2(a.z, a.w), pack2(b.x, b.y), pack2(b.z, b.w));
    }
  }
  for (size_t i = gtid; i < 2 * 8 * 1024; i += gsz) {
    int l = (int)(i / 8192), r = (int)(i % 8192), g = r / 1024, k = r % 1024;
    p.wg()[i] = p.w_in()[((size_t)l * 1024 + k) * 2824 + 2304 + g];
  }
  {
    float* sp = reinterpret_cast<float*>(p.ws + WS_sp);
    for (size_t i = gtid; i < 262144; i += gsz) sp[SP_st_c + i] = p.in[4][i];
    for (size_t i = gtid; i < 4096; i += gsz) sp[SP_st_n + i] = p.in[5][i];
    for (size_t i = gtid; i < 64; i += gsz) sp[SP_st_m + i] = p.in[6][i];
    for (size_t i = gtid; i < 12288; i += gsz) sp[SP_st_conv + i] = p.in[7][i];
    for (size_t i = gtid; i < 2048; i += gsz) sp[SP_norm1_g + i] = p.in[8][i];
    for (size_t i = gtid; i < 256; i += gsz) sp[SP_da_subln_g + i] = p.in[11][i];
    for (size_t i = gtid; i < 2048; i += gsz) sp[SP_ml_conv_w + i] = p.in[13][i];
    for (size_t i = gtid; i < 512; i += gsz) sp[SP_ml_conv_b + i] = p.in[14][i];
    for (size_t i = gtid; i < 32768; i += gsz) sp[SP_ml_wq + i] = p.in[15][i];
    for (size_t i = gtid; i < 32768; i += gsz) sp[SP_ml_wk + i] = p.in[16][i];
    for (size_t i = gtid; i < 16; i += gsz) sp[SP_ml_gate_b + i] = p.in[17][i];
    for (size_t i = gtid; i < 512; i += gsz) sp[SP_ml_norm_g + i] = p.in[18][i];
    for (size_t i = gtid; i < 512; i += gsz) sp[SP_ml_skip + i] = p.in[19][i];
    for (size_t i = gtid; i < 512; i += gsz) sp[SP_cm_norm_g + i] = p.in[20][i];
    for (size_t i = gtid; i < 131072; i += gsz) sp[SP_cm_ws + i] = p.in[21][i];
    for (size_t i = gtid; i < 1024; i += gsz) sp[SP_cm_b + i] = p.in[22][i];
    for (size_t i = gtid; i < 2048; i += gsz) sp[SP_norm2_g + i] = p.in[24][i];
    for (size_t i = gtid; i < 1024; i += gsz) sp[SP_final_g + i] = p.in[29][i];
  }
  if (bid == 0) {
    for (int i = tid; i < 4 * 256; i += 256) {
      int h = i >> 8, j = i & 255;
      int rel = j - 191; if (rel > 63) rel = 63;
      p.lut()[i] = p.rel_table()[rel_bucket_dev(rel) * 4 + h] * LOG2E;
    }
    if (tid < 2) {
      const float* lp = p.da_lambda() + tid * 256;
      float s01 = 0.f, s23 = 0.f;
      for (int d = 0; d < 64; ++d) { s01 += lp[d] * lp[64 + d]; s23 += lp[128 + d] * lp[192 + d]; }
      float lam_init = 0.8f - 0.6f * expf(-0.3f * (float)tid);
      p.lam()[tid] = expf(s01) - expf(s23) + lam_init;
    }
  }
}

__device__ __forceinline__ void ph_norm1_l0(const Params& p, char* smem, int bid, int nblk) {
  const int tid = tid_opaque(), lane = tid & 63, w = __builtin_amdgcn_readfirstlane(tid >> 6);
  float* s_wg = reinterpret_cast<float*>(smem);
  __syncthreads();
  for (int i = tid; i < 8192; i += 256) { const int k = i >> 3, g = i & 7; s_wg[g * 1024 + k] = p.w_in()[(size_t)k * 2824 + 2304 + g]; }
  __syncthreads();
  const float* gptr = p.in[8];
  float4 gv[4];
#pragma unroll
  for (int j = 0; j < 4; ++j) gv[j] = reinterpret_cast<const float4*>(gptr)[lane + 64 * j];
  for (int t = bid * 4 + w; t < NTOK; t += nblk * 4) {
    const float* xr = (t < NPROMPT) ? p.in[0] + (size_t)t * D_MODEL : p.in[1] + (size_t)(t - NPROMPT) * D_MODEL;
    float4 xv[4];
    float ss = 0.f;
#pragma unroll
    for (int j = 0; j < 4; ++j) {
      xv[j] = reinterpret_cast<const float4*>(xr)[lane + 64 * j];
      ss += xv[j].x * xv[j].x + xv[j].y * xv[j].y + xv[j].z * xv[j].z + xv[j].w * xv[j].w;
    }
    ss = wave_sum(ss);
    const float r = rsqrtf(ss * (1.f / 1024.f) + EPS);
#pragma unroll
    for (int j = 0; j < 4; ++j) { xv[j].x *= r * gv[j].x; xv[j].y *= r * gv[j].y; xv[j].z *= r * gv[j].z; xv[j].w *= r * gv[j].w; }
    uint2* o = reinterpret_cast<uint2*>(p.xn() + (size_t)t * 1024);
#pragma unroll
    for (int j = 0; j < 4; ++j) o[lane + 64 * j] = make_uint2(pack2(xv[j].x, xv[j].y), pack2(xv[j].z, xv[j].w));
    float pre[8];
#pragma unroll
    for (int i = 0; i < 8; ++i) {
      const float4* wr = reinterpret_cast<const float4*>(s_wg + i * 1024);
      float s = 0.f;
#pragma unroll
      for (int j = 0; j < 4; ++j) { const float4 wv = wr[lane + 64 * j]; s += xv[j].x * wv.x + xv[j].y * wv.y + xv[j].z * wv.z + xv[j].w * wv.w; }
      pre[i] = wave_sum(s);
    }
    if (lane < 4) {
      float a = pre[0]; a = lane == 1 ? pre[1] : a; a = lane == 2 ? pre[2] : a; a = lane == 3 ? pre[3] : a;
      float f = pre[4]; f = lane == 1 ? pre[5] : f; f = lane == 2 ? pre[6] : f; f = lane == 3 ? pre[7] : f;
      p.ig()[(size_t)t * 4 + lane] = a + p.in[17][lane];
      const float z = f + p.in[17][4 + lane];
      p.lf()[(size_t)t * 4 + lane] = fminf(z, 0.f) - log1pf(expf(-fabsf(z)));
    }
  }
}

template <int MODE>
__device__ __forceinline__ void ph_rmsnorm(const Params& p, int l, int bid, int nblk) {
  const int lane = tid_opaque() & 63, w = __builtin_amdgcn_readfirstlane(tid_opaque() >> 6);
  const float* g = (MODE == 0) ? p.norm1_g() + l * 1024 : (MODE == 1 ? p.norm2_g() + l * 1024 : p.final_g());
  float4 gv[4];
#pragma unroll
  for (int j = 0; j < 4; ++j) gv[j] = reinterpret_cast<const float4*>(g)[lane + 64 * j];
  for (int t = bid * 4 + w; t < NTOK; t += nblk * 4) {
    const float* xr = (MODE == 0) ? xrow_in(p, l, t) : p.x() + (size_t)t * 1024;
    float4 xv[4];
    float ss = 0.f;
#pragma unroll
    for (int j = 0; j < 4; ++j) {
      xv[j] = reinterpret_cast<const float4*>(xr)[lane + 64 * j];
      ss += xv[j].x * xv[j].x + xv[j].y * xv[j].y + xv[j].z * xv[j].z + xv[j].w * xv[j].w;
    }
    ss = wave_sum(ss);
    float r = rsqrtf(ss * (1.f / 1024.f) + EPS);
#pragma unroll
    for (int j = 0; j < 4; ++j) {
      xv[j].x *= r * gv[j].x; xv[j].y *= r * gv[j].y; xv[j].z *= r * gv[j].z; xv[j].w *= r * gv[j].w;
    }
    if (MODE == 2) {
      float* o = (t < NPROMPT) ? p.out + O_Y_P + (size_t)t * 1024 : p.out + O_Y_S + (size_t)(t - NPROMPT) * 1024;
#pragma unroll
      for (int j = 0; j < 4; ++j) reinterpret_cast<float4*>(o)[lane + 64 * j] = xv[j];
    } else {
      uint2* o = reinterpret_cast<uint2*>(p.xn() + (size_t)t * 1024);
#pragma unroll
      for (int j = 0; j < 4; ++j) o[lane + 64 * j] = make_uint2(pack2(xv[j].x, xv[j].y), pack2(xv[j].z, xv[j].w));
    }
    if (MODE == 0) {
      float pre[8];
#pragma unroll
      for (int i = 0; i < 8; ++i) {
        const float4* wr = reinterpret_cast<const float4*>(p.wg() + ((size_t)l * 8 + i) * 1024);
        float s = 0.f;
#pragma unroll
        for (int j = 0; j < 4; ++j) {
          float4 wv = wr[lane + 64 * j];
          s += xv[j].x * wv.x + xv[j].y * wv.y + xv[j].z * wv.z + xv[j].w * wv.w;
        }
        pre[i] = wave_sum(s);
      }
      if (lane < 4) {
        float a = pre[0]; a = lane == 1 ? pre[1] : a; a = lane == 2 ? pre[2] : a; a = lane == 3 ? pre[3] : a;
        float f = pre[4]; f = lane == 1 ? pre[5] : f; f = lane == 2 ? pre[6] : f; f = lane == 3 ? pre[7] : f;
        p.ig()[(size_t)t * 4 + lane] = a + p.ml_gate_b()[l * 8 + lane];
        float z = f + p.ml_gate_b()[l * 8 + 4 + lane];
        p.lf()[(size_t)t * 4 + lane] = fminf(z, 0.f) - log1pf(expf(-fabsf(z)));
      }
    }
  }
}

__device__ __forceinline__ int mono_key(float v) { int b = __float_as_int(v); return b ^ ((b >> 31) & 0x7FFFFFFF); }
__device__ __forceinline__ float mono_val(int k) { int b = k ^ ((k >> 31) & 0x7FFFFFFF); return __int_as_float(b); }

__device__ __forceinline__ int med3i(int a, int b, int c) { return max(min(a, b), min(max(a, b), c)); }
#define INS16(L, kv)                                                          \
  {                                                                           \
    const int _v = (kv);                                                      \
    _Pragma("unroll") for (int _j = 15; _j >= 1; --_j) L[_j] = med3i(L[_j - 1], L[_j], _v); \
    L[0] = max(L[0], _v);                                                     \
  }


enum { EPI_WIN = 0, EPI_WOUT = 1, EPI_PQ = 2, EPI_SC = 3 };

template <int EPI>
__device__ __forceinline__ void gemm_store(const Params& p, int l, int t, int n, float v) {
  if (EPI == EPI_WOUT) {
    const float* xi = xrow_in(p, l, t);
    p.x()[(size_t)t * 1024 + n] = xi[n] + v;
  } else if (EPI == EPI_PQ) {
    p.qp()[(size_t)t * 2048 + n] = f2bf(v);
  } else if (EPI == EPI_SC) {
    p.sc()[(size_t)t * 2048 + n] = v;
  }
}

template <int EPI>
__device__ __forceinline__ void ph_gemm(const Params& p, int l, char* smem, int bid, int nblk) {
  constexpr int NT = (EPI == EPI_WIN) ? 22 : (EPI == EPI_WOUT ? 8 : 16);
  constexpr int MT = NTOK / 128;
  constexpr int K = (EPI == EPI_SC) ? 128 : 1024;
  constexpr int NK = K / 64;
  const bf16_t* A; int lda; const bf16_t* Bt; int ldb;
  if (EPI == EPI_WIN) { A = p.xn(); lda = 1024; Bt = p.wt_in() + (size_t)l * NIN * 1024; ldb = 1024; }
  else if (EPI == EPI_WOUT) { A = p.xn(); lda = 1024; Bt = p.wt_out() + (size_t)l * 1024 * 1024; ldb = 1024; }
  else if (EPI == EPI_PQ) { A = p.xn(); lda = 1024; Bt = p.wt_pq() + (size_t)l * 2048 * 1024; ldb = 1024; }
  else { A = p.qp(); lda = 2048; Bt = p.keysb() + (size_t)l * 16 * 128 * 128; ldb = 128; }

  const int tid = tid_opaque(), lane = tid & 63, w = __builtin_amdgcn_readfirstlane(tid >> 6);
  const int wm = w >> 1, wn = w & 1, lr = lane & 31, lh = lane >> 5;
  char* sA = smem;
  char* sB = smem + 32768;
  const int ld_c = tid & 7, ld_r = tid >> 3;

  const int nx = nblk >> 3;
  constexpr int FG = MT / 8, LR = MT % 8;
  for (int rnd = 0;; ++rnd) {
    const int q = (nblk & 7) ? rnd * nblk + bid : rnd * nblk + (bid & 7) * nx + (bid >> 3);
    if (q >= MT * NT) break;
    int mt, nt;
    if (q < FG * 8 * NT) { const int mg = q / (8 * NT), rem = q % (8 * NT); nt = rem >> 3; mt = mg * 8 + (rem & 7); }
    else { const int q2 = q - FG * 8 * NT; nt = q2 / (LR > 0 ? LR : 1); mt = FG * 8 + q2 % (LR > 0 ? LR : 1); }
    const bf16_t* Ag = A + (size_t)(mt * 128) * lda + ((EPI == EPI_SC) ? nt * 128 : 0);
    const bf16_t* Bg = Bt + (size_t)(nt * 128) * ldb;
    f32x16 acc[2][2];
#pragma unroll
    for (int i = 0; i < 2; ++i)
#pragma unroll
      for (int j = 0; j < 2; ++j)
#pragma unroll
        for (int r = 0; r < 16; ++r) acc[i][j][r] = 0.f;

    const int g_row = w * 32 + (lane >> 3);
    const int g_pc = lane & 7;
    const bf16_t* Ath = Ag + (size_t)g_row * lda;
    const bf16_t* Bth = Bg + (size_t)g_row * ldb;
#define GEMM_STAGE(KT, BUF)                                                                                          \
  _Pragma("unroll") for (int j = 0; j < 4; ++j) {                                                                    \
    const int row = g_row + 8 * j;                                                                                   \
    const int cch = g_pc ^ ((row >> 1) & 7);                                                                         \
    __builtin_amdgcn_global_load_lds((const unsigned*)(Ath + (size_t)(8 * j) * lda + (KT) * 64 + cch * 8),           \
                                     (LAS unsigned*)(sA + (BUF) * 16384 + (w * 4 + j) * 1024 + lane * 16), 16, 0, 0); \
    __builtin_amdgcn_global_load_lds((const unsigned*)(Bth + (size_t)(8 * j) * ldb + (KT) * 64 + cch * 8),           \
                                     (LAS unsigned*)(sB + (BUF) * 16384 + (w * 4 + j) * 1024 + lane * 16), 16, 0, 0); \
  }
    GEMM_STAGE(0, 0)
    __syncthreads();
    for (int kt = 0; kt < NK; ++kt) {
      const int buf = kt & 1;
      if (kt + 1 < NK) { GEMM_STAGE(kt + 1, buf ^ 1) }
      const char* cA = sA + buf * 16384;
      const char* cB = sB + buf * 16384;
#pragma unroll
      for (int ks = 0; ks < 4; ++ks) {
        bf16x8 af[2], bfr[2];
#pragma unroll
        for (int i = 0; i < 2; ++i) {
          int row = wm * 64 + i * 32 + lr; int pc = (ks * 2 + lh) ^ ((row >> 1) & 7);
          af[i] = as_bf16x8(*reinterpret_cast<const uint4*>(cA + row * 128 + pc * 16));
        }
#pragma unroll
        for (int j = 0; j < 2; ++j) {
          int row = wn * 64 + j * 32 + lr; int pc = (ks * 2 + lh) ^ ((row >> 1) & 7);
          bfr[j] = as_bf16x8(*reinterpret_cast<const uint4*>(cB + row * 128 + pc * 16));
        }
#pragma unroll
        for (int i = 0; i < 2; ++i)
#pragma unroll
          for (int j = 0; j < 2; ++j)
            acc[i][j] = __builtin_amdgcn_mfma_f32_32x32x16_bf16(af[i], bfr[j], acc[i][j], 0, 0, 0);
      }
      __syncthreads();
    }
    if (EPI == EPI_PQ) {
      int lane_q = lane; asm volatile("" : "+v"(lane_q));
      const int lr = lane_q & 31, lh = lane_q >> 5;
      char* sA2 = smem;
      char* sB2 = smem + 32768;
      const bf16_t* kg = p.keysb() + ((size_t)l * 16 + nt) * 128 * 128;
#pragma unroll
      for (int jj = 0; jj < 8; ++jj) {
        const int I = w * 8 + jj;
        const int row = I * 4 + (lane_q >> 4);
        const int cch = (lane_q & 15) ^ (row & 15);
        __builtin_amdgcn_global_load_lds((const unsigned*)(kg + (size_t)row * 128 + cch * 8),
                                         (LAS unsigned*)(sB2 + I * 1024 + lane_q * 16), 16, 0, 0);
      }
#pragma unroll
      for (int i = 0; i < 2; ++i) {
        float rs[16];
#pragma unroll
        for (int r = 0; r < 16; ++r) rs[r] = 0.f;
#pragma unroll
        for (int j = 0; j < 2; ++j) {
          const int n = wn * 64 + j * 32 + lr;
#pragma unroll
          for (int r = 0; r < 16; ++r) {
            const int row = wm * 64 + i * 32 + (r & 3) + 8 * (r >> 2) + 4 * lh;
            const float v = acc[i][j][r];
            rs[r] += v * v;
            *reinterpret_cast<bf16_t*>(sA2 + row * 256 + (((n >> 3) ^ (row & 15)) * 16) + (n & 7) * 2) = f2bf(v);
          }
        }
#pragma unroll
        for (int r = 0; r < 16; ++r) {
          const float s = swap16_sum(row16_sum(rs[r]));
          if (lr == 0) {
            const int t = mt * 128 + wm * 64 + i * 32 + (r & 3) + 8 * (r >> 2) + 4 * lh;
            p.ssp()[(size_t)t * 32 + nt * 2 + wn] = s;
          }
        }
      }
      __syncthreads();
      f32x16 sc2[2][2];
#pragma unroll
      for (int i = 0; i < 2; ++i)
#pragma unroll
        for (int j = 0; j < 2; ++j)
#pragma unroll
          for (int r = 0; r < 16; ++r) sc2[i][j][r] = 0.f;
#pragma unroll
      for (int ks = 0; ks < 8; ++ks) {
        bf16x8 af[2], bfr[2];
#pragma unroll
        for (int i = 0; i < 2; ++i) {
          const int row = wm * 64 + i * 32 + lr;
          af[i] = as_bf16x8(*reinterpret_cast<const uint4*>(sA2 + row * 256 + (((ks * 2 + lh) ^ (row & 15)) * 16)));
        }
#pragma unroll
        for (int j = 0; j < 2; ++j) {
          const int row = wn * 64 + j * 32 + lr;
          bfr[j] = as_bf16x8(*reinterpret_cast<const uint4*>(sB2 + row * 256 + (((ks * 2 + lh) ^ (row & 15)) * 16)));
        }
#pragma unroll
        for (int i = 0; i < 2; ++i)
#pragma unroll
          for (int j = 0; j < 2; ++j)
            sc2[i][j] = __builtin_amdgcn_mfma_f32_32x32x16_bf16(af[i], bfr[j], sc2[i][j], 0, 0, 0);
      }
      __syncthreads();
      float* sS = reinterpret_cast<float*>(smem);
#pragma unroll
      for (int i = 0; i < 2; ++i)
#pragma unroll
        for (int j = 0; j < 2; ++j)
#pragma unroll
          for (int r = 0; r < 16; ++r) {
            const int row = wm * 64 + i * 32 + (r & 3) + 8 * (r >> 2) + 4 * lh;
            sS[row * 129 + wn * 64 + j * 32 + lr] = sc2[i][j][r];
          }
      __syncthreads();
      {
        int tq = tid; asm volatile("" : "+v"(tq));
        const int tk = tq & 127, hl = tq >> 7;
        int L[16];
#pragma unroll
        for (int j = 0; j < 16; ++j) L[j] = (int)0x80000000;
        const float* srow = sS + tk * 129 + hl * 64;
#pragma unroll 4
        for (int s = 0; s < 64; ++s) {
          const int key = (mono_key(srow[s]) & ~127) | (127 - (hl * 64 + s));
          INS16(L, key)
        }
        int4* dst = reinterpret_cast<int4*>(p.tl() + (((size_t)(mt * 128 + tk) * 16 + nt) * 2 + hl) * 16);
        dst[0] = make_int4(L[0], L[1], L[2], L[3]); dst[1] = make_int4(L[4], L[5], L[6], L[7]);
        dst[2] = make_int4(L[8], L[9], L[10], L[11]); dst[3] = make_int4(L[12], L[13], L[14], L[15]);
      }
      __syncthreads();
    } else if (EPI != EPI_WIN) {
#pragma unroll
      for (int i = 0; i < 2; ++i)
#pragma unroll
        for (int j = 0; j < 2; ++j)
#pragma unroll
          for (int r = 0; r < 16; ++r) {
            int t = mt * 128 + wm * 64 + i * 32 + (r & 3) + 8 * (r >> 2) + 4 * lh;
            int n = nt * 128 + wn * 64 + j * 32 + lr;
            gemm_store<EPI>(p, l, t, n, acc[i][j][r]);
          }
    } else {
      const int seg = nt >> 2;
#pragma unroll
      for (int i = 0; i < 2; ++i)
#pragma unroll
        for (int j = 0; j < 2; ++j) {
          const int n = nt * 128 + wn * 64 + j * 32 + lr;
          if (nt < 4) {
#pragma unroll
            for (int r = 0; r < 16; ++r) {
              int t = mt * 128 + wm * 64 + i * 32 + (r & 3) + 8 * (r >> 2) + 4 * lh;
              p.Qb()[(size_t)t * 512 + n] = f2bf(acc[i][j][r] * (0.125f * LOG2E));
            }
          } else if (nt < 8) {
            const int n2 = n - 512;
#pragma unroll
            for (int r = 0; r < 16; ++r) {
              int t = mt * 128 + wm * 64 + i * 32 + (r & 3) + 8 * (r >> 2) + 4 * lh;
              float v = acc[i][j][r];
              if (t < NPROMPT) {
                p.out[O_K_P + (size_t)l * (4 * 4096 * 512) + (size_t)t * 512 + n2] = v;
                p.Kb()[(size_t)t * 512 + n2] = f2bf(v);
              } else {
                int ts = t - NPROMPT, b = ts >> 6, ii = ts & 63;
                p.out[O_K_S + (size_t)l * (8 * 64 * 512) + (size_t)ts * 512 + n2] = v;
                p.Kbs()[((size_t)(l * 8 + b) * SKEYS + 1024 + ii) * 512 + n2] = f2bf(v);
              }
            }
          } else if (nt < 12) {
            const int n2 = n - 1024, h = n2 >> 7, dv = n2 & 127;
#pragma unroll
            for (int rg = 0; rg < 4; ++rg) {
              int tb = mt * 128 + wm * 64 + i * 32 + 8 * rg + 4 * lh;
              float v0 = acc[i][j][rg * 4 + 0], v1 = acc[i][j][rg * 4 + 1], v2 = acc[i][j][rg * 4 + 2], v3 = acc[i][j][rg * 4 + 3];
              uint2 pk = make_uint2(pack2(v0, v1), pack2(v2, v3));
              int posblk = 2 * lh + (rg & 1);
              if (tb < NPROMPT) {
                float* o = p.out + O_V_P + (size_t)l * (4 * 4096 * 512) + (size_t)tb * 512 + n2;
                o[0] = v0; o[512] = v1; o[1024] = v2; o[1536] = v3;
                int b = tb >> 12, s = tb & 4095;
                int pos = (s & ~15) + posblk * 4;
                *reinterpret_cast<uint2*>(p.Vt() + ((size_t)(b * 4 + h) * 128 + dv) * SEQ + pos) = pk;
              } else {
                int ts = tb - NPROMPT, b = ts >> 6, ii = ts & 63;
                float* o = p.out + O_V_S + (size_t)l * (8 * 64 * 512) + (size_t)ts * 512 + n2;
                o[0] = v0; o[512] = v1; o[1024] = v2; o[1536] = v3;
                int pos = 1024 + (ii & ~15) + posblk * 4;
                *reinterpret_cast<uint2*>(p.Vts() + ((size_t)((l * 8 + b) * 4 + h) * 128 + dv) * SKEYS + pos) = pk;
              }
            }
          } else {
            const int n2 = n - 1536;
            const bool act = (n >= 2304);
#pragma unroll
            for (int r = 0; r < 16; ++r) {
              int t = mt * 128 + wm * 64 + i * 32 + (r & 3) + 8 * (r >> 2) + 4 * lh;
              float v = acc[i][j][r];
              if (act) v = gelu_exact(v);
              p.P5()[(size_t)t * 1280 + n2] = v;
            }
          }
        }
      (void)seg;
    }
  }
}

struct WorkQ { unsigned* cnt; volatile int* slot; int off; };
__device__ __forceinline__ int wq_next(const WorkQ& q) {
  __syncthreads();
  if (threadIdx.x == 0) *q.slot = (int)__hip_atomic_fetch_add(q.cnt, 1u, __ATOMIC_RELAXED, __HIP_MEMORY_SCOPE_AGENT);
  __syncthreads();
  return __builtin_amdgcn_readfirstlane(*q.slot) - q.off;
}

template <bool CONV>
__device__ __forceinline__ int ph_attn(const Params& p, int l, char* smem, const WorkQ& wq) {
  const int tid = tid_opaque(), lane = tid & 63, w = __builtin_amdgcn_readfirstlane(tid >> 6);
  const int c = w >> 1, qhalf = w & 1, lr = lane & 31, lh = lane >> 5;
  float* sLut = reinterpret_cast<float*>(smem + 65536);
  float* sO2 = reinterpret_cast<float*>(smem);
  const float lam = p.lam()[l];
  const float lam_init = 0.8f - 0.6f * expf(-0.3f * (float)l);

  constexpr int NSLOT = CONV ? 1584 : 1056;
  int slot, uu;
  for (slot = wq_next(wq); slot < NSLOT; slot = wq_next(wq)) {
    if (CONV) {
      if (slot % 3 == 2) {
        const int ch = slot / 3, r0 = ch * 125;
        prep_table_rows(p, r0, (r0 + 125 < 65536) ? r0 + 125 : 65536, lane, w);
        continue;
      }
      uu = (slot / 3) * 2 + (slot % 3);
    } else uu = slot;
    int b, h, qc, S, qrow0; const bf16_t *Kbase, *Vbase;
    bool samp = false; int u2 = uu;
    if (uu >= 752 && uu < 784) samp = true; else if (uu >= 784) u2 = uu - 32;
    if (!samp) {
      qc = 63 - (u2 >> 4); int bh = u2 & 15; b = bh >> 2; h = bh & 3; S = SEQ;
      Kbase = p.Kb() + (size_t)b * SEQ * 512 + h * 128;
      Vbase = p.Vt() + (size_t)(b * 4 + h) * 128 * SEQ;
      qrow0 = b * SEQ + qc * 64;
    } else {
      int us = uu - 752; b = us >> 2; h = us & 3; qc = 16; S = SKEYS;
      Kbase = p.Kbs() + (size_t)(l * 8 + b) * SKEYS * 512 + h * 128;
      Vbase = p.Vts() + (size_t)((l * 8 + b) * 4 + h) * 128 * SKEYS;
      qrow0 = NPROMPT + b * 64;
    }
    const int ntiles = qc + 1;
    __syncthreads();
    sLut[tid] = p.lut()[h * 256 + tid];
    if (tid < 128) sLut[256 + tid] = p.da_subln_g()[l * 128 + tid];
    bf16x8 qf[4];
    {
      const bf16_t* qrow = p.Qb() + (size_t)(qrow0 + qhalf * 32 + lr) * 512 + h * 128 + c * 64 + lh * 8;
#pragma unroll
      for (int ks = 0; ks < 4; ++ks) qf[ks] = as_bf16x8(*reinterpret_cast<const uint4*>(qrow + ks * 16));
    }
    f32x16 o[4];
#pragma unroll
    for (int d = 0; d < 4; ++d)
#pragma unroll
      for (int r = 0; r < 16; ++r) o[d][r] = 0.f;
    float m_run = -1e30f, l_run = 0.f;

    const char* Kt = reinterpret_cast<const char*>(Kbase);
    const char* Vb = reinterpret_cast<const char*>(Vbase);
    const int g_r8 = lane >> 3, g_pc = lane & 7;
#define ATTN_STAGE(KT, BUF)                                                                                         \
  _Pragma("unroll") for (int j = 0; j < 4; ++j) {                                                                   \
    const int I = w * 4 + j;                                                                                        \
    const int rk = (I & 7) * 8 + g_r8;                                                                              \
    const unsigned kof = (unsigned)rk * 1024u + (unsigned)(I >> 3) * 128u + (unsigned)((g_pc ^ ((rk >> 1) & 7)) * 16); \
    __builtin_amdgcn_global_load_lds((const unsigned*)(Kt + (size_t)(KT) * 65536 + kof),                            \
                                     (LAS unsigned*)(smem + (BUF) * 32768 + I * 1024 + lane * 16), 16, 0, 0);       \
    const int rv = I * 8 + g_r8;                                                                                    \
    const unsigned vof = (unsigned)rv * (unsigned)(S * 2) + (unsigned)((g_pc ^ ((rv >> 1) & 7)) * 16);              \
    __builtin_amdgcn_global_load_lds((const unsigned*)(Vb + (size_t)(KT) * 128 + vof),                              \
                                     (LAS unsigned*)(smem + (BUF) * 32768 + 16384 + I * 1024 + lane * 16), 16, 0, 0); \
  }
    ATTN_STAGE(0, 0)
    __syncthreads();
    for (int kt = 0; kt < ntiles; ++kt) {
      const int buf = kt & 1;
      if (kt + 1 < ntiles) { ATTN_STAGE(kt + 1, buf ^ 1) }
      const char* sK = smem + buf * 32768;
      const char* sV = sK + 16384;
      f32x16 s[2];
      {
        bf16x8 kf[2][4];
#pragma unroll
        for (int kb = 0; kb < 2; ++kb)
#pragma unroll
          for (int ks = 0; ks < 4; ++ks) {
            int row = kb * 32 + lr; int pc = (ks * 2 + lh) ^ ((row >> 1) & 7);
            kf[kb][ks] = as_bf16x8(*reinterpret_cast<const uint4*>(sK + c * 8192 + row * 128 + pc * 16));
          }
#pragma unroll
        for (int kb = 0; kb < 2; ++kb) {
#pragma unroll
          for (int r = 0; r < 16; ++r) s[kb][r] = 0.f;
#pragma unroll
          for (int ks = 0; ks < 4; ++ks) s[kb] = __builtin_amdgcn_mfma_f32_32x32x16_bf16(kf[kb][ks], qf[ks], s[kb], 0, 0, 0);
        }
      }
      bf16x8 vfa[2][4];
#pragma unroll
      for (int k2 = 0; k2 < 2; ++k2)
#pragma unroll
        for (int d = 0; d < 4; ++d) {
          int row = d * 32 + lr; int pc = (k2 * 2 + lh) ^ ((row >> 1) & 7);
          vfa[k2][d] = as_bf16x8(*reinterpret_cast<const uint4*>(sV + row * 128 + pc * 16));
        }
      float boff = sLut[0];
      if (kt >= qc - 2) {
        const int base = (kt - qc) * 64 - (qhalf * 32 + lr) + 191 + 4 * lh;
#pragma unroll
        for (int kb = 0; kb < 2; ++kb)
#pragma unroll
          for (int r = 0; r < 16; ++r) s[kb][r] += sLut[base + kb * 32 + (r & 3) + 8 * (r >> 2)];
        boff = 0.f;
      }
      float mx = s[0][0];
#pragma unroll
      for (int kb = 0; kb < 2; ++kb)
#pragma unroll
        for (int r = 0; r < 16; ++r) mx = fmaxf(mx, s[kb][r]);
      mx = swap32_max(mx) + boff;
      if (__any(mx > m_run)) {
        const float m_new = fmaxf(m_run, mx);
        const float alpha = __builtin_amdgcn_exp2f(m_run - m_new);
        m_run = m_new;
        l_run *= alpha;
#pragma unroll
        for (int d = 0; d < 4; ++d)
#pragma unroll
          for (int r = 0; r < 16; ++r) o[d][r] *= alpha;
      }
      const float eoff = boff - m_run;
      float ps = 0.f;
#pragma unroll
      for (int kb = 0; kb < 2; ++kb)
#pragma unroll
        for (int r = 0; r < 16; ++r) { float pv = __builtin_amdgcn_exp2f(s[kb][r] + eoff); s[kb][r] = pv; ps += pv; }
      l_run += ps;
      bf16x8 pf[4];
#pragma unroll
      for (int ks2 = 0; ks2 < 4; ++ks2) {
        const int kb = ks2 >> 1, sh = (ks2 & 1) * 8;
        uint4 pw = make_uint4(pack2(s[kb][sh + 0], s[kb][sh + 1]), pack2(s[kb][sh + 2], s[kb][sh + 3]),
                              pack2(s[kb][sh + 4], s[kb][sh + 5]), pack2(s[kb][sh + 6], s[kb][sh + 7]));
        pf[ks2] = as_bf16x8(pw);
      }
#define ATTN_VREAD(DST, K2)                                                                        \
  _Pragma("unroll") for (int d = 0; d < 4; ++d) {                                                  \
    int row = d * 32 + lr; int pc = ((K2) * 2 + lh) ^ ((row >> 1) & 7);                            \
    DST[d] = as_bf16x8(*reinterpret_cast<const uint4*>(sV + row * 128 + pc * 16));                 \
  }
#define ATTN_PV(SRC, K2) \
  _Pragma("unroll") for (int d = 0; d < 4; ++d) o[d] = __builtin_amdgcn_mfma_f32_32x32x16_bf16(SRC[d], pf[K2], o[d], 0, 0, 0);
      bf16x8 vfc[4];
      ATTN_VREAD(vfc, 2)
      ATTN_PV(vfa[0], 0)
      ATTN_VREAD(vfa[0], 3)
      ATTN_PV(vfa[1], 1)
      ATTN_PV(vfc, 2)
      ATTN_PV(vfa[0], 3)
      __syncthreads();
    }
    int lane_e = (int)__builtin_amdgcn_mbcnt_hi(~0u, __builtin_amdgcn_mbcnt_lo(~0u, 0u)); asm volatile("" : "+v"(lane_e));
    const int lr_e = lane_e & 31, lh_e = lane_e >> 5;
    float lt = swap32_sum(l_run);
    float inv = 1.f / lt;
    __syncthreads();
    if (c == 1) {
#pragma unroll
      for (int d = 0; d < 4; ++d)
#pragma unroll
        for (int r = 0; r < 16; ++r) sO2[(qhalf * 64 + d * 16 + r) * 64 + lane_e] = o[d][r] * inv;
    }
    __syncthreads();
    if (c == 0) {
      float ss = 0.f;
#pragma unroll
      for (int d = 0; d < 4; ++d)
#pragma unroll
        for (int r = 0; r < 16; ++r) {
          float v = o[d][r] * inv - lam * sO2[(qhalf * 64 + d * 16 + r) * 64 + lane_e];
          o[d][r] = v; ss += v * v;
        }
      ss = swap32_sum(ss);
      const float rn = rsqrtf(ss * (1.f / 128.f) + EPS) * (1.f - lam_init);
      const float* gs = sLut + 256;
      bf16_t* orow = p.xn() + (size_t)(qrow0 + qhalf * 32 + lr_e) * 1024 + h * 128;
#pragma unroll
      for (int d = 0; d < 4; ++d)
#pragma unroll
        for (int rg = 0; rg < 4; ++rg) {
          int dv = d * 32 + 8 * rg + 4 * lh_e;
          float4 g4 = *reinterpret_cast<const float4*>(gs + dv);
          uint2 pk = make_uint2(pack2(o[d][rg * 4 + 0] * rn * g4.x, o[d][rg * 4 + 1] * rn * g4.y),
                                pack2(o[d][rg * 4 + 2] * rn * g4.z, o[d][rg * 4 + 3] * rn * g4.w));
          *reinterpret_cast<uint2*>(orow + dv) = pk;
        }
    }
  }
  return slot - NSLOT + 1056;
}

template <int K>
__device__ __forceinline__ void mfma32_f32(f32x16& acc, const float* a, int a_rs, int a_ks, const float* b, int b_ks, int b_js, int lane) {
  const float* ap = a + (lane & 31) * a_rs + (lane >> 5) * a_ks;
  const float* bp = b + (lane >> 5) * b_ks + (lane & 31) * b_js;
#pragma unroll 8
  for (int k = 0; k < K; k += 2) acc = __builtin_amdgcn_mfma_f32_32x32x2f32(ap[k * a_ks], bp[k * b_ks], acc, 0, 0, 0);
}
__device__ __forceinline__ void zero16(f32x16& a) {
#pragma unroll
  for (int r = 0; r < 16; ++r) a[r] = 0.f;
}

__device__ __forceinline__ int ph_mlconv(const Params& p, int l, char* smem, const WorkQ& wq, int item) {
  const int tid = tid_opaque();
  float* s_mc = reinterpret_cast<float*>(smem);
  float* s_cc = s_mc + 67 * 64;
  float* s_wq = s_cc + 64 * 65;
  float* s_wk = s_wq + 4096;
  for (; item < 1056 + 264 * 4; item = wq_next(wq)) {
    const int u = item - 1056;
    const int ci = u >> 2, h = u & 3;
    int token0, bq; bool samp = ci >= 256;
    if (!samp) token0 = ci * 64; else token0 = NPROMPT + (ci - 256) * 64;
    bq = samp ? (ci - 256) : (ci >> 6);
    const int cidx = samp ? 0 : (ci & 63);
    __syncthreads();
    for (int i = tid; i < 67 * 64; i += 256) {
      int r = i >> 6, d = i & 63;
      float v;
      if (r >= 3) v = p.P5()[(size_t)(token0 + r - 3) * 1280 + h * 64 + d];
      else if (samp) v = p.st_conv()[((size_t)(l * 8 + bq) * 3 + r) * 256 + h * 64 + d];
      else if (cidx == 0) v = 0.f;
      else v = p.P5()[(size_t)(token0 + r - 3) * 1280 + h * 64 + d];
      s_mc[i] = v;
    }
    for (int i = tid; i < 4096; i += 256) {
      s_wq[i] = p.ml_wq()[(size_t)(l * 4 + h) * 4096 + i];
      s_wk[i] = p.ml_wk()[(size_t)(l * 4 + h) * 4096 + i];
    }
    __syncthreads();
    {
      const int d = tid & 63, t0 = tid >> 6;
      const int ch = h * 64 + d;
      const float w0 = p.ml_conv_w()[(l * 4 + 0) * 256 + ch], w1 = p.ml_conv_w()[(l * 4 + 1) * 256 + ch];
      const float w2 = p.ml_conv_w()[(l * 4 + 2) * 256 + ch], w3 = p.ml_conv_w()[(l * 4 + 3) * 256 + ch];
      const float bb = p.ml_conv_b()[l * 256 + ch];
      for (int t = t0; t < 64; t += 4) {
        float y = bb + w0 * s_mc[t * 64 + d] + w1 * s_mc[(t + 1) * 64 + d] + w2 * s_mc[(t + 2) * 64 + d] + w3 * s_mc[(t + 3) * 64 + d];
        y = y * sigmoidf_(y);
        s_cc[t * 65 + d] = y;
        p.cc()[(size_t)(token0 + t) * 256 + ch] = y;
      }
      if (samp || cidx == 63) {
        if (tid < 192) {
          int r = tid >> 6;
          float v = s_mc[(64 + r) * 64 + d];
          if (samp) p.out[O_CONV_S + ((size_t)(l * 8 + bq) * 3 + r) * 256 + ch] = v;
          else p.out[O_CONV_P + ((size_t)(l * 4 + bq) * 3 + r) * 256 + ch] = v;
        }
      }
    }
    __syncthreads();
    {
      const int lane = tid & 63, w = __builtin_amdgcn_readfirstlane(tid >> 6), ti = w >> 1, tj = w & 1;
      f32x16 aq, ak; zero16(aq); zero16(ak);
      mfma32_f32<64>(aq, s_cc + ti * 32 * 65, 65, 1, s_wq + tj * 32, 64, 1, lane);
      mfma32_f32<64>(ak, s_cc + ti * 32 * 65, 65, 1, s_wk + tj * 32, 64, 1, lane);
#pragma unroll
      for (int r = 0; r < 16; ++r) {
        const int t = ti * 32 + (r & 3) + 8 * (r >> 2) + 4 * (lane >> 5);
        const size_t o = (size_t)(token0 + t) * 256 + h * 64 + tj * 32 + (lane & 31);
        p.qm()[o] = aq[r];
        p.km()[o] = ak[r] * 0.125f;
      }
      if (w == 0) {
        const int t = token0 + lane;
        const float lfv = p.lf()[(size_t)t * 4 + h], igv = p.ig()[(size_t)t * 4 + h];
        float F = lfv;
#pragma unroll
        for (int d = 1; d < 64; d <<= 1) { float n = shfl_up_l(F, d, lane); if (lane >= d) F += n; }
        const float FL = __int_as_float(__builtin_amdgcn_readlane(__float_as_int(F), 63));
        const float mx = wave_max(FL - F + igv);
        p.Fc()[(size_t)t * 4 + h] = F;
        if (lane == 0) {
          const int cu = samp ? 1024 + bq * 4 + h : (bq * 4 + h) * 64 + cidx;
          p.FLs()[cu] = FL; p.mxt()[cu] = mx;
        }
      }
    }
  }
  return item;
}

__device__ __forceinline__ void cu_decode(int cu, int& token0, int& h) {
  if (cu < 1024) { int bh = cu >> 6, c = cu & 63; token0 = (bh >> 2) * SEQ + c * 64; h = bh & 3; }
  else { int us = cu - 1024; token0 = NPROMPT + (us >> 2) * 64; h = us & 3; }
}

__device__ __forceinline__ void ph_mlU(const Params& p, int l, char* smem, int bid, int nblk) {
  const int tid = tid_opaque();
  const int lane = tid & 63, w = __builtin_amdgcn_readfirstlane(tid >> 6), ti = w >> 1, tj = w & 1;
  float* s_k = reinterpret_cast<float*>(smem);
  float* s_v = s_k + 4096;
  for (int cu = bid; cu < NCU_UNITS; cu += nblk) {
    int token0, h; cu_decode(cu, token0, h);
    float m0, mn, FL;
    {
      const bool samp = cu >= 1024;
      const int cu0 = samp ? cu : (cu & ~63), c = samp ? 0 : (cu & 63);
      float flv = 0.f, mxv = 0.f;
      if (lane <= c) { flv = p.FLs()[cu0 + lane]; mxv = p.mxt()[cu0 + lane]; }
      float m = samp ? p.st_m()[l * 32 + (cu - 1024)] : 0.f;
      for (int j = 0; j < c; ++j) {
        const float fj = __int_as_float(__builtin_amdgcn_readlane(__float_as_int(flv), j));
        const float xj = __int_as_float(__builtin_amdgcn_readlane(__float_as_int(mxv), j));
        m = fmaxf(fj + m, xj);
      }
      FL = __int_as_float(__builtin_amdgcn_readlane(__float_as_int(flv), c));
      const float xc = __int_as_float(__builtin_amdgcn_readlane(__float_as_int(mxv), c));
      m0 = m; mn = fmaxf(FL + m, xc);
      if (tid == 0) {
        p.mst()[cu] = m0; p.mnx()[cu] = mn; p.wcs()[cu] = expf(FL + m0 - mn);
        if (samp) p.out[O_M_S + l * 32 + (cu - 1024)] = mn;
        else if (c == 63) p.out[O_M_P + l * 16 + (cu >> 6)] = mn;
      }
    }
    __syncthreads();
    for (int i = tid; i < 1024; i += 256) {
      int s = i >> 4, d4 = (i & 15) * 4;
      const int t = token0 + s;
      float wsv = expf(FL - p.Fc()[(size_t)t * 4 + h] + p.ig()[(size_t)t * 4 + h] - mn);
      float4 k4 = *reinterpret_cast<const float4*>(p.km() + (size_t)t * 256 + h * 64 + d4);
      float4 v4 = *reinterpret_cast<const float4*>(p.P5() + (size_t)t * 1280 + 256 + h * 64 + d4);
      *reinterpret_cast<float4*>(s_k + s * 64 + d4) = make_float4(k4.x * wsv, k4.y * wsv, k4.z * wsv, k4.w * wsv);
      *reinterpret_cast<float4*>(s_v + s * 64 + d4) = v4;
    }
    __syncthreads();
    f32x16 acc; zero16(acc);
    mfma32_f32<64>(acc, s_k + ti * 32, 1, 64, s_v + tj * 32, 64, 1, lane);
#pragma unroll
    for (int r = 0; r < 16; ++r) {
      const int d = ti * 32 + (r & 3) + 8 * (r >> 2) + 4 * (lane >> 5);
      p.U()[(size_t)cu * 4096 + d * 64 + tj * 32 + (lane & 31)] = acc[r];
    }
    if (tid < 64) {
      float s0 = 0.f;
      for (int s = 0; s < 64; ++s) s0 += s_k[s * 64 + tid];
      p.un()[(size_t)cu * 64 + tid] = s0;
    }
  }
}

__device__ __forceinline__ void ph_mlscan(const Params& p, int l, int bid, int nblk) {
  const size_t gtid = (size_t)bid * 256 + tid_opaque(), gsz = (size_t)nblk * 256;
  const size_t NPC = 16 * 4096, NSC = 32 * 4096, NPN = 16 * 64, NSN = 32 * 64;
  for (size_t i = gtid; i < NPC + NSC + NPN + NSN; i += gsz) {
    if (i < NPC) {
      int bh = (int)(i >> 12), e = (int)(i & 4095);
      float C = 0.f;
      for (int c = 0; c < 64; ++c) {
        int cu = bh * 64 + c;
        p.Cst()[(size_t)cu * 4096 + e] = C;
        C = p.wcs()[cu] * C + p.U()[(size_t)cu * 4096 + e];
      }
      p.out[O_C_P + (size_t)l * (16 * 4096) + i] = C;
    } else if (i < NPC + NSC) {
      size_t j = i - NPC; int us = (int)(j >> 12), e = (int)(j & 4095); int cu = 1024 + us;
      float C = p.st_c()[(size_t)l * (32 * 4096) + j];
      p.Cst()[(size_t)cu * 4096 + e] = C;
      p.out[O_C_S + (size_t)l * (32 * 4096) + j] = p.wcs()[cu] * C + p.U()[(size_t)cu * 4096 + e];
    } else if (i < NPC + NSC + NPN) {
      size_t j = i - NPC - NSC; int bh = (int)(j >> 6), d = (int)(j & 63);
      float n = 0.f;
      for (int c = 0; c < 64; ++c) {
        int cu = bh * 64 + c;
        p.nst()[(size_t)cu * 64 + d] = n;
        n = p.wcs()[cu] * n + p.un()[(size_t)cu * 64 + d];
      }
      p.out[O_N_P + (size_t)l * (16 * 64) + j] = n;
    } else {
      size_t j = i - NPC - NSC - NPN; int us = (int)(j >> 6), d = (int)(j & 63); int cu = 1024 + us;
      float n = p.st_n()[(size_t)l * (32 * 64) + j];
      p.nst()[(size_t)cu * 64 + d] = n;
      p.out[O_N_S + (size_t)l * (32 * 64) + j] = p.wcs()[cu] * n + p.un()[(size_t)cu * 64 + d];
    }
  }
}

__device__ __forceinline__ void ph_mlout(const Params& p, int l, char* smem, int bid, int nblk) {
  const int tid = tid_opaque();
  float* s_q = reinterpret_cast<float*>(smem);
  float* s_k = s_q + 64 * 65;
  float* s_v = s_k + 64 * 65;
  float* s_C = s_v + 4096;
  float* s_F = s_C + 4096;
  float* s_a = s_F + 64;
  float* s_mt = s_a + 64;
  float* s_iw = s_mt + 64;
  float* s_n = s_iw + 64;
  float* s_den = s_n + 64;
  float* s_denp = s_den + 64;
  float* s_qn = s_denp + 128;
  for (int cu = bid; cu < NCU_UNITS; cu += nblk) {
    int token0, h; cu_decode(cu, token0, h);
    const float m0 = p.mst()[cu];
    __syncthreads();
    for (int i = tid; i < 1024; i += 256) {
      int s = i >> 4, d4 = (i & 15) * 4;
      const int t = token0 + s;
      float4 q4 = *reinterpret_cast<const float4*>(p.qm() + (size_t)t * 256 + h * 64 + d4);
      float4 k4 = *reinterpret_cast<const float4*>(p.km() + (size_t)t * 256 + h * 64 + d4);
      float4 v4 = *reinterpret_cast<const float4*>(p.P5() + (size_t)t * 1280 + 256 + h * 64 + d4);
      float4 c4 = *reinterpret_cast<const float4*>(p.Cst() + (size_t)cu * 4096 + s * 64 + d4);
      s_q[s * 65 + d4] = q4.x; s_q[s * 65 + d4 + 1] = q4.y; s_q[s * 65 + d4 + 2] = q4.z; s_q[s * 65 + d4 + 3] = q4.w;
      s_k[s * 65 + d4] = k4.x; s_k[s * 65 + d4 + 1] = k4.y; s_k[s * 65 + d4 + 2] = k4.z; s_k[s * 65 + d4 + 3] = k4.w;
      *reinterpret_cast<float4*>(s_v + s * 64 + d4) = v4;
      *reinterpret_cast<float4*>(s_C + s * 64 + d4) = c4;
    }
    if (tid < 64) {
      const int t = token0 + tid;
      float F = p.Fc()[(size_t)t * 4 + h], g = p.ig()[(size_t)t * 4 + h];
      s_F[tid] = F; s_a[tid] = g - F;
      s_n[tid] = p.nst()[(size_t)cu * 64 + tid];
    }
    __syncthreads();
    if (tid < 64) {
      float pm = s_a[tid];
#pragma unroll
      for (int d = 1; d < 64; d <<= 1) { const float o = shfl_up_l(pm, d, tid); if (tid >= d) pm = fmaxf(pm, o); }
      float F = s_F[tid];
      float mt = F + fmaxf(m0, pm);
      s_mt[tid] = mt;
      s_iw[tid] = expf(F + m0 - mt);
    }
    __syncthreads();
    const int lane = tid & 63, w = __builtin_amdgcn_readfirstlane(tid >> 6), ti = w >> 1, tj = w & 1;
    const int ty = tid >> 4, tx = tid & 15;
    {
      f32x16 accS; zero16(accS);
      mfma32_f32<64>(accS, s_q + ti * 32 * 65, 65, 1, s_k + tj * 32 * 65, 1, 65, lane);
      __syncthreads();
      const int s = tj * 32 + (lane & 31);
      const float as = s_a[s];
#pragma unroll
      for (int r = 0; r < 16; ++r) {
        const int t = ti * 32 + (r & 3) + 8 * (r >> 2) + 4 * (lane >> 5);
        const float sw = (s <= t) ? accS[r] * expf(s_F[t] + as - s_mt[t]) : 0.f;
        s_k[t * 65 + s] = sw;
        const float rsum = swap16_sum(row16_sum(sw));
        if ((lane & 31) == 0) s_denp[tj * 64 + t] = rsum;
      }
    }
    {
      const int t = tid >> 2, part = tid & 3;
      float qn = 0.f;
#pragma unroll
      for (int d = 0; d < 16; ++d) qn += s_q[t * 65 + part * 16 + d] * s_n[part * 16 + d];
      qn += dpp_f<0xB1>(qn); qn += dpp_f<0x4E>(qn);
      if (part == 0) s_qn[t] = qn;
    }
    __syncthreads();
    if (tid < 64) s_den[tid] = s_denp[tid] + s_denp[64 + tid] + s_iw[tid] * s_qn[tid];
    {
      f32x16 accN, accC; zero16(accN); zero16(accC);
      mfma32_f32<64>(accN, s_k + ti * 32 * 65, 65, 1, s_v + tj * 32, 64, 1, lane);
      mfma32_f32<64>(accC, s_q + ti * 32 * 65, 65, 1, s_C + tj * 32, 64, 1, lane);
      __syncthreads();
#pragma unroll
      for (int r = 0; r < 16; ++r) {
        const int t = ti * 32 + (r & 3) + 8 * (r >> 2) + 4 * (lane >> 5);
        s_q[t * 65 + tj * 32 + (lane & 31)] = accN[r] + s_iw[t] * accC[r];
      }
    }
    __syncthreads();
#pragma unroll
    for (int i = 0; i < 4; ++i) {
      const int t = ty * 4 + i;
      const float dn = fmaxf(fabsf(s_den[t]), expf(-s_mt[t]));
      float hv[4]; float ss = 0.f;
#pragma unroll
      for (int j = 0; j < 4; ++j) { hv[j] = s_q[t * 65 + tx * 4 + j] / dn; ss += hv[j] * hv[j]; }
      ss = row16_sum(ss);
      const float rn = rsqrtf(ss * (1.f / 64.f) + EPS);
      const int ch = h * 64 + tx * 4;
      const size_t tg = (size_t)(token0 + t);
      float4 g4 = *reinterpret_cast<const float4*>(p.ml_norm_g() + l * 256 + ch);
      float4 k4 = *reinterpret_cast<const float4*>(p.ml_skip() + l * 256 + ch);
      float4 c4 = *reinterpret_cast<const float4*>(p.cc() + tg * 256 + ch);
      float4 o4 = *reinterpret_cast<const float4*>(p.P5() + tg * 1280 + 512 + ch);
      float r0 = (hv[0] * rn * g4.x + k4.x * c4.x) * sigmoidf_(o4.x);
      float r1 = (hv[1] * rn * g4.y + k4.y * c4.y) * sigmoidf_(o4.y);
      float r2 = (hv[2] * rn * g4.z + k4.z * c4.z) * sigmoidf_(o4.z);
      float r3 = (hv[3] * rn * g4.w + k4.w * c4.w) * sigmoidf_(o4.w);
      *reinterpret_cast<uint2*>(p.xn() + tg * 1024 + 512 + ch) = make_uint2(pack2(r0, r1), pack2(r2, r3));
    }
  }
}

__device__ __forceinline__ void ph_cmlp(const Params& p, int l, char* smem, const WorkQ& wq, int item) {
  const int tid = tid_opaque(), lane = tid & 63, w = __builtin_amdgcn_readfirstlane(tid >> 6);
  float* s_vg = reinterpret_cast<float*>(smem);
  float* s_ws = s_vg + 128 * 64;
  float* s_r = s_ws + 128 * 33;
  for (; item < 1056 + 264 * 4 + 544; item = wq_next(wq)) {
    const int u = item - (1056 + 264 * 4);
    const int g = u & 3, ci = u >> 2;
    const bool samp = ci >= 128;
    const int L = samp ? 64 : 128;
    const int token0 = samp ? NPROMPT + (ci - 128) * 64 : ci * 128;
    __syncthreads();
    for (int r = w; r < L; r += 4) {
      float4 v = *reinterpret_cast<const float4*>(p.P5() + (size_t)(token0 + r) * 1280 + 1024 + lane * 4);
      float ss = v.x * v.x + v.y * v.y + v.z * v.z + v.w * v.w;
      ss = wave_sum(ss);
      if (lane == 0) s_r[r] = rsqrtf(ss * (1.f / 256.f) + EPS);
    }
    __syncthreads();
    for (int i = tid; i < L * 16; i += 256) {
      int s = i >> 4, d4 = (i & 15) * 4;
      float4 v = *reinterpret_cast<const float4*>(p.P5() + (size_t)(token0 + s) * 1280 + 1024 + g * 64 + d4);
      float4 gn = *reinterpret_cast<const float4*>(p.cm_norm_g() + l * 256 + g * 64 + d4);
      float r = s_r[s];
      float4 o = make_float4(v.x * r * gn.x, v.y * r * gn.y, v.z * r * gn.z, v.w * r * gn.w);
      *reinterpret_cast<float4*>(s_vg + s * 64 + d4) = o;
      if (samp) {
        int ts = token0 - NPROMPT + s;
        *reinterpret_cast<float4*>(p.out + O_CMV_S + (size_t)l * (512 * 256) + (size_t)ts * 256 + g * 64 + d4) = o;
      }
    }
    const int rtA = (w < 2) ? 3 : 2, rtB = (w < 2) ? 0 : 1, ct = w & 1;
    const int nrt = L >> 5;
    f32x16 accA, accB; zero16(accA); zero16(accB);
    const float* wsg = p.cm_ws() + (size_t)(l * 4 + g) * 128 * 128;
    for (int s0 = 0; s0 < L; s0 += 32) {
      __syncthreads();
      for (int i = tid; i < L * 32; i += 256) {
        int t = i >> 5, ss = i & 31;
        s_ws[t * 33 + ss] = (s0 + ss <= t) ? wsg[t * 128 + s0 + ss] : 0.f;
      }
      __syncthreads();
      const int c = s0 >> 5;
      if (rtA < nrt && c <= rtA) mfma32_f32<32>(accA, s_ws + rtA * 32 * 33, 33, 1, s_vg + s0 * 64 + ct * 32, 64, 1, lane);
      if (rtB < nrt && c <= rtB) mfma32_f32<32>(accB, s_ws + rtB * 32 * 33, 33, 1, s_vg + s0 * 64 + ct * 32, 64, 1, lane);
    }
    __syncthreads();
#pragma unroll
    for (int r = 0; r < 16; ++r) {
      const int tr = (r & 3) + 8 * (r >> 2) + 4 * (lane >> 5);
      if (rtA < nrt) s_vg[(rtA * 32 + tr) * 64 + ct * 32 + (lane & 31)] = accA[r];
      if (rtB < nrt) s_vg[(rtB * 32 + tr) * 64 + ct * 32 + (lane & 31)] = accB[r];
    }
    __syncthreads();
    {
      const int ty = tid >> 4, tx = tid & 15;
      if (ty * 8 < L) {
#pragma unroll
        for (int i = 0; i < 8; ++i) {
          const int t = ty * 8 + i;
          const float bb = p.cm_b()[(l * 4 + g) * 128 + t];
          const size_t tg = (size_t)(token0 + t);
          float4 a4 = *reinterpret_cast<const float4*>(s_vg + t * 64 + tx * 4);
          float4 u4 = *reinterpret_cast<const float4*>(p.P5() + tg * 1280 + 768 + g * 64 + tx * 4);
          *reinterpret_cast<uint2*>(p.xn() + tg * 1024 + 768 + g * 64 + tx * 4) =
              make_uint2(pack2(u4.x * (a4.x + bb), u4.y * (a4.y + bb)), pack2(u4.z * (a4.z + bb), u4.w * (a4.w + bb)));
        }
      }
    }
  }
}

__device__ __forceinline__ void ph_topk(const Params& p, int l, char* smem, int bid, int nblk) {
  const int tid = tid_opaque(), lane = tid & 63, w = __builtin_amdgcn_readfirstlane(tid >> 6);
  float* s_tile = reinterpret_cast<float*>(smem) + w * (64 * 33);
  int* s_list = reinterpret_cast<int*>(smem + 4 * 64 * 33 * 4) + w * (2 * 16 * 64);
  float* s_ss = reinterpret_cast<float*>(smem + 4 * 64 * 33 * 4 + 4 * 2 * 16 * 64 * 4) + w * 64;
  for (int u = bid * 4 + w; u < 264 * 8; u += nblk * 4) {
    const int tg = u >> 3, h = u & 7;
    const int t0 = tg * 64;
    {
      const float4 pp = *reinterpret_cast<const float4*>(p.ssp() + (size_t)(t0 + lane) * 32 + h * 4);
      s_ss[lane] = pp.x + pp.y + pp.z + pp.w;
    }
    int L1[16], L2[16];
#pragma unroll
    for (int j = 0; j < 16; ++j) { L1[j] = (int)0x80000000; L2[j] = (int)0x80000000; }
#pragma unroll
    for (int c = 0; c < 2; ++c) {
      const int4* la = reinterpret_cast<const int4*>(p.tl() + (((size_t)(t0 + lane) * 16 + h * 2 + c) * 2) * 16);
      int A[16], B[16];
#pragma unroll
      for (int q = 0; q < 4; ++q) {
        const int4 a = la[q], b = la[4 + q];
        A[4 * q] = a.x; A[4 * q + 1] = a.y; A[4 * q + 2] = a.z; A[4 * q + 3] = a.w;
        B[4 * q] = b.x; B[4 * q + 1] = b.y; B[4 * q + 2] = b.z; B[4 * q + 3] = b.w;
      }
#pragma unroll
      for (int j = 0; j < 16; ++j) INS16(A, B[j])
#pragma unroll
      for (int j = 0; j < 16; ++j) { if (c == 0) L1[j] = A[j]; else L2[j] = A[j]; }
    }
#pragma unroll
    for (int j = 0; j < 16; ++j) { s_list[(0 * 16 + j) * 64 + lane] = 127 - (L1[j] & 127); s_list[(1 * 16 + j) * 64 + lane] = 127 - (L2[j] & 127); }
    float v1[16], v2[16];
#pragma unroll
    for (int j = 0; j < 16; ++j) { v1[j] = mono_val(L1[j] & ~127); v2[j] = mono_val(L2[j] & ~127); }
    int LC[16];
#pragma unroll
    for (int j = 0; j < 16; ++j) LC[j] = (int)0x80000000;
#pragma unroll
    for (int i = 0; i < 16; ++i)
#pragma unroll
      for (int j = 0; j < 16; ++j)
        if ((i + 1) * (j + 1) <= 16) {
          int key = (mono_key(v1[i] + v2[j]) & ~255) | (255 - (i * 16 + j));
          INS16(LC, key)
        }
    const float scale = rsqrtf(s_ss[lane] * (1.f / 256.f) + EPS);
    float vs[16]; float den = 0.f;
    const float top = mono_val(LC[0] & ~255);
#pragma unroll
    for (int k = 0; k < 16; ++k) { vs[k] = __expf((mono_val(LC[k] & ~255) - top) * scale); den += vs[k]; }
    const float inv = 1.f / den;
    const size_t ob = (size_t)(t0 + lane) * 128 + h * 16;
#pragma unroll
    for (int k4 = 0; k4 < 4; ++k4) {
      int ee[4]; float gg[4], su[4];
#pragma unroll
      for (int q = 0; q < 4; ++q) {
        int k = k4 * 4 + q;
        int ci = 255 - (LC[k] & 255);
        int i1 = s_list[(0 * 16 + (ci >> 4)) * 64 + lane];
        int i2 = s_list[(1 * 16 + (ci & 15)) * 64 + lane];
        ee[q] = i1 * 128 + i2;
        gg[q] = vs[k] * inv * p.vs()[l * 16384 + ee[q]];
        su[q] = p.us()[l * 16384 + ee[q]];
      }
      *reinterpret_cast<int4*>(p.eidx() + ob + k4 * 4) = make_int4(ee[0], ee[1], ee[2], ee[3]);
      *reinterpret_cast<float4*>(p.egate() + ob + k4 * 4) = make_float4(gg[0], gg[1], gg[2], gg[3]);
      *reinterpret_cast<float4*>(p.esu() + ob + k4 * 4) = make_float4(su[0], su[1], su[2], su[3]);
    }
  }
}

__device__ __forceinline__ float dot16_fp8(const float* xf, uint4 u) {
  f32x2 a0 = __builtin_amdgcn_cvt_pk_f32_fp8(u.x, false), a1 = __builtin_amdgcn_cvt_pk_f32_fp8(u.x, true);
  f32x2 a2 = __builtin_amdgcn_cvt_pk_f32_fp8(u.y, false), a3 = __builtin_amdgcn_cvt_pk_f32_fp8(u.y, true);
  f32x2 a4 = __builtin_amdgcn_cvt_pk_f32_fp8(u.z, false), a5 = __builtin_amdgcn_cvt_pk_f32_fp8(u.z, true);
  f32x2 a6 = __builtin_amdgcn_cvt_pk_f32_fp8(u.w, false), a7 = __builtin_amdgcn_cvt_pk_f32_fp8(u.w, true);
  float s0 = xf[0] * a0.x, s1 = xf[1] * a0.y;
  s0 = fmaf(xf[2], a1.x, s0); s1 = fmaf(xf[3], a1.y, s1);
  s0 = fmaf(xf[4], a2.x, s0); s1 = fmaf(xf[5], a2.y, s1);
  s0 = fmaf(xf[6], a3.x, s0); s1 = fmaf(xf[7], a3.y, s1);
  s0 = fmaf(xf[8], a4.x, s0); s1 = fmaf(xf[9], a4.y, s1);
  s0 = fmaf(xf[10], a5.x, s0); s1 = fmaf(xf[11], a5.y, s1);
  s0 = fmaf(xf[12], a6.x, s0); s1 = fmaf(xf[13], a6.y, s1);
  s0 = fmaf(xf[14], a7.x, s0); s1 = fmaf(xf[15], a7.y, s1);
  return s0 + s1;
}
__device__ __forceinline__ void axpy16_fp8(float* y, float wgt, uint4 v) {
  f32x2 a0 = __builtin_amdgcn_cvt_pk_f32_fp8(v.x, false), a1 = __builtin_amdgcn_cvt_pk_f32_fp8(v.x, true);
  f32x2 a2 = __builtin_amdgcn_cvt_pk_f32_fp8(v.y, false), a3 = __builtin_amdgcn_cvt_pk_f32_fp8(v.y, true);
  f32x2 a4 = __builtin_amdgcn_cvt_pk_f32_fp8(v.z, false), a5 = __builtin_amdgcn_cvt_pk_f32_fp8(v.z, true);
  f32x2 a6 = __builtin_amdgcn_cvt_pk_f32_fp8(v.w, false), a7 = __builtin_amdgcn_cvt_pk_f32_fp8(v.w, true);
  y[0] = fmaf(wgt, a0.x, y[0]); y[1] = fmaf(wgt, a0.y, y[1]); y[2] = fmaf(wgt, a1.x, y[2]); y[3] = fmaf(wgt, a1.y, y[3]);
  y[4] = fmaf(wgt, a2.x, y[4]); y[5] = fmaf(wgt, a2.y, y[5]); y[6] = fmaf(wgt, a3.x, y[6]); y[7] = fmaf(wgt, a3.y, y[7]);
  y[8] = fmaf(wgt, a4.x, y[8]); y[9] = fmaf(wgt, a4.y, y[9]); y[10] = fmaf(wgt, a5.x, y[10]); y[11] = fmaf(wgt, a5.y, y[11]);
  y[12] = fmaf(wgt, a6.x, y[12]); y[13] = fmaf(wgt, a6.y, y[13]); y[14] = fmaf(wgt, a7.x, y[14]); y[15] = fmaf(wgt, a7.y, y[15]);
}

template <bool DRY>
__device__ __forceinline__ void ph_gather(const Params& p, int l, int bid, int nblk) {
  const int lane = tid_opaque() & 63, w = __builtin_amdgcn_readfirstlane(tid_opaque() >> 6);
  const unsigned char* u8 = p.ub8() + (size_t)l * 16384 * 1024;
  const unsigned char* v8 = p.vb8() + (size_t)l * 16384 * 1024;
  const unsigned loff = (unsigned)lane * 16u;
  for (int t = bid * 4 + w; t < NTOK; t += nblk * 4) {
    float xf[16];
    {
      const uint4 xa = *reinterpret_cast<const uint4*>(p.xn() + (size_t)t * 1024 + lane * 16);
      const uint4 xb = *reinterpret_cast<const uint4*>(p.xn() + (size_t)t * 1024 + lane * 16 + 8);
      xf[0] = bf_lo(xa.x); xf[1] = bf_hi(xa.x); xf[2] = bf_lo(xa.y); xf[3] = bf_hi(xa.y);
      xf[4] = bf_lo(xa.z); xf[5] = bf_hi(xa.z); xf[6] = bf_lo(xa.w); xf[7] = bf_hi(xa.w);
      xf[8] = bf_lo(xb.x); xf[9] = bf_hi(xb.x); xf[10] = bf_lo(xb.y); xf[11] = bf_hi(xb.y);
      xf[12] = bf_lo(xb.z); xf[13] = bf_hi(xb.z); xf[14] = bf_lo(xb.w); xf[15] = bf_hi(xb.w);
    }
    const int e_lo = p.eidx()[(size_t)t * 128 + lane], e_hi = p.eidx()[(size_t)t * 128 + 64 + lane];
    const float g_lo = p.egate()[(size_t)t * 128 + lane], g_hi = p.egate()[(size_t)t * 128 + 64 + lane];
    const float s_lo = p.esu()[(size_t)t * 128 + lane], s_hi = p.esu()[(size_t)t * 128 + 64 + lane];
    float y[16];
#pragma unroll
    for (int i = 0; i < 16; ++i) y[i] = 0.f;
#pragma unroll 1
    for (int k0 = 0; k0 < 128; k0 += 8) {
      uint4 ur[8], vr[8];
#pragma unroll
      for (int q = 0; q < 8; ++q) {
        const int kk = (k0 & 63) + q;
        const int e = (k0 < 64) ? __builtin_amdgcn_readlane(e_lo, kk) : __builtin_amdgcn_readlane(e_hi, kk);
        ur[q] = *reinterpret_cast<const uint4*>(u8 + (size_t)e * 1024 + loff);
        vr[q] = *reinterpret_cast<const uint4*>(v8 + (size_t)e * 1024 + loff);
      }
#pragma unroll
      for (int q = 0; q < 8; ++q) {
        const int kk = (k0 & 63) + q;
        const float gt = __int_as_float((k0 < 64) ? __builtin_amdgcn_readlane(__float_as_int(g_lo), kk) : __builtin_amdgcn_readlane(__float_as_int(g_hi), kk));
        const float su = __int_as_float((k0 < 64) ? __builtin_amdgcn_readlane(__float_as_int(s_lo), kk) : __builtin_amdgcn_readlane(__float_as_int(s_hi), kk));
        float d = wave_sum(dot16_fp8(xf, ur[q])) * su;
        const float wgt = gt * gelu_exact(d);
        axpy16_fp8(y, wgt, vr[q]);
      }
    }
    if (DRY) {
#pragma unroll
      for (int i = 0; i < 16; ++i) asm volatile("" ::"v"(y[i]));
      continue;
    }
    float* xr = p.x() + (size_t)t * 1024 + lane * 16;
#pragma unroll
    for (int j = 0; j < 4; ++j) {
      float4 a = reinterpret_cast<float4*>(xr)[j];
      a.x += y[4 * j]; a.y += y[4 * j + 1]; a.z += y[4 * j + 2]; a.w += y[4 * j + 3];
      reinterpret_cast<float4*>(xr)[j] = a;
    }
  }
}

enum { PH_PREP = 0, PH_NORM1, PH_GEMM_IN, PH_ATTN, PH_MLCONV, PH_MCHAIN, PH_MLU, PH_MLSCAN, PH_MLOUT, PH_CMLP,
       PH_GEMM_OUT, PH_NORM2, PH_GEMM_PQ, PH_GEMM_SC, PH_TOPK, PH_GATHER, PH_FINAL };

__device__ __forceinline__ Params phase_params(const Params& kp, bool with_inputs, bool with_tables = false) {
  Params q;
  size_t z = 0;
  asm volatile("" : "+s"(z));
  q.out = kp.out + z;
  q.ws = kp.ws + z;
  q.in[0] = kp.in[0] + z;
  q.in[1] = kp.in[1] + z;
  if (with_inputs) {
#pragma unroll
    for (int i = 2; i < 30; ++i) q.in[i] = kp.in[i] + z;
  }
  if (with_tables) { q.in[27] = kp.in[27] + z; q.in[28] = kp.in[28] + z; }
  return q;
}


#define GT 4
typedef __attribute__((ext_vector_type(4))) float f32x4;

__device__ __forceinline__ float dot16_fp8v(const f32x2* x2, uint4 u) {
  f32x2 acc = x2[0] * __builtin_amdgcn_cvt_pk_f32_fp8(u.x, false);
  acc += x2[1] * __builtin_amdgcn_cvt_pk_f32_fp8(u.x, true);
  acc += x2[2] * __builtin_amdgcn_cvt_pk_f32_fp8(u.y, false);
  acc += x2[3] * __builtin_amdgcn_cvt_pk_f32_fp8(u.y, true);
  acc += x2[4] * __builtin_amdgcn_cvt_pk_f32_fp8(u.z, false);
  acc += x2[5] * __builtin_amdgcn_cvt_pk_f32_fp8(u.z, true);
  acc += x2[6] * __builtin_amdgcn_cvt_pk_f32_fp8(u.w, false);
  acc += x2[7] * __builtin_amdgcn_cvt_pk_f32_fp8(u.w, true);
  return acc.x + acc.y;
}
__device__ __forceinline__ void axpy16_fp8v(f32x2* y2, float wgt, uint4 v) {
  const f32x2 w2 = {wgt, wgt};
  y2[0] += w2 * __builtin_amdgcn_cvt_pk_f32_fp8(v.x, false);
  y2[1] += w2 * __builtin_amdgcn_cvt_pk_f32_fp8(v.x, true);
  y2[2] += w2 * __builtin_amdgcn_cvt_pk_f32_fp8(v.y, false);
  y2[3] += w2 * __builtin_amdgcn_cvt_pk_f32_fp8(v.y, true);
  y2[4] += w2 * __builtin_amdgcn_cvt_pk_f32_fp8(v.z, false);
  y2[5] += w2 * __builtin_amdgcn_cvt_pk_f32_fp8(v.z, true);
  y2[6] += w2 * __builtin_amdgcn_cvt_pk_f32_fp8(v.w, false);
  y2[7] += w2 * __builtin_amdgcn_cvt_pk_f32_fp8(v.w, true);
}

struct GU { uint4 ur[4]; f32x4 su; };
struct GV { uint4 vr[4]; f32x4 gt; };
#define GREC 384
__device__ __forceinline__ void gload_u(GU& U, const float* rec, int i4, const unsigned char* u8, unsigned loff) {
  const f32x4 ev = *reinterpret_cast<const f32x4*>(rec + i4);
  U.su = *reinterpret_cast<const f32x4*>(rec + 256 + i4);
  const int e0 = __builtin_amdgcn_readfirstlane(__float_as_int(ev.x)), e1 = __builtin_amdgcn_readfirstlane(__float_as_int(ev.y));
  const int e2 = __builtin_amdgcn_readfirstlane(__float_as_int(ev.z)), e3 = __builtin_amdgcn_readfirstlane(__float_as_int(ev.w));
  U.ur[0] = *reinterpret_cast<const uint4*>(u8 + (size_t)e0 * 1024 + loff);
  U.ur[1] = *reinterpret_cast<const uint4*>(u8 + (size_t)e1 * 1024 + loff);
  U.ur[2] = *reinterpret_cast<const uint4*>(u8 + (size_t)e2 * 1024 + loff);
  U.ur[3] = *reinterpret_cast<const uint4*>(u8 + (size_t)e3 * 1024 + loff);
}
__device__ __forceinline__ void gload_v(GV& V, const float* rec, int i4, const unsigned char* v8, unsigned loff) {
  const f32x4 ev = *reinterpret_cast<const f32x4*>(rec + i4);
  V.gt = *reinterpret_cast<const f32x4*>(rec + 128 + i4);
  const int e0 = __builtin_amdgcn_readfirstlane(__float_as_int(ev.x)), e1 = __builtin_amdgcn_readfirstlane(__float_as_int(ev.y));
  const int e2 = __builtin_amdgcn_readfirstlane(__float_as_int(ev.z)), e3 = __builtin_amdgcn_readfirstlane(__float_as_int(ev.w));
  V.vr[0] = *reinterpret_cast<const uint4*>(v8 + (size_t)e0 * 1024 + loff);
  V.vr[1] = *reinterpret_cast<const uint4*>(v8 + (size_t)e1 * 1024 + loff);
  V.vr[2] = *reinterpret_cast<const uint4*>(v8 + (size_t)e2 * 1024 + loff);
  V.vr[3] = *reinterpret_cast<const uint4*>(v8 + (size_t)e3 * 1024 + loff);
}
__device__ __forceinline__ float gelu_as(float z) {
  const float x = fabsf(z) * 0.70710678118654752f;
  const float t = __builtin_amdgcn_rcpf(fmaf(0.3275911f, x, 1.f));
  float pl = fmaf(1.061405429f, t, -1.453152027f);
  pl = fmaf(pl, t, 1.421413741f); pl = fmaf(pl, t, -0.284496736f); pl = fmaf(pl, t, 0.254829592f);
  const float e = __builtin_amdgcn_exp2f(-x * x * LOG2E);
  const float erfa = 1.f - pl * t * e;
  return 0.5f * z + 0.5f * fabsf(z) * erfa;
}
template <int PAT>
__device__ __forceinline__ float swz_f(float v) { return __int_as_float(__builtin_amdgcn_ds_swizzle(__float_as_int(v), PAT)); }

__device__ __forceinline__ void gstep2(GU& UA, GV& VA, GU& UB, GV& VB, const uint4* xlA, const uint4* xlB, f32x2* yA, f32x2* yB,
                                       const float* recA, const float* recB, int ci4, const float* nxtA, const float* nxtB, int ni4,
                                       const unsigned char* u8, const unsigned char* v8, unsigned loff, int lane) {
  float d[8];
  {
    f32x2 x2[8];
    const uint4 xa = xlA[0], xb = xlA[1];
    x2[0] = f32x2{bf_lo(xa.x), bf_hi(xa.x)}; x2[1] = f32x2{bf_lo(xa.y), bf_hi(xa.y)};
    x2[2] = f32x2{bf_lo(xa.z), bf_hi(xa.z)}; x2[3] = f32x2{bf_lo(xa.w), bf_hi(xa.w)};
    x2[4] = f32x2{bf_lo(xb.x), bf_hi(xb.x)}; x2[5] = f32x2{bf_lo(xb.y), bf_hi(xb.y)};
    x2[6] = f32x2{bf_lo(xb.z), bf_hi(xb.z)}; x2[7] = f32x2{bf_lo(xb.w), bf_hi(xb.w)};
#pragma unroll
    for (int q = 0; q < 4; ++q) d[q] = dot16_fp8v(x2, UA.ur[q]);
  }
  gload_u(UA, nxtA, ni4, u8, loff);
  {
    f32x2 x2[8];
    const uint4 xa = xlB[0], xb = xlB[1];
    x2[0] = f32x2{bf_lo(xa.x), bf_hi(xa.x)}; x2[1] = f32x2{bf_lo(xa.y), bf_hi(xa.y)};
    x2[2] = f32x2{bf_lo(xa.z), bf_hi(xa.z)}; x2[3] = f32x2{bf_lo(xa.w), bf_hi(xa.w)};
    x2[4] = f32x2{bf_lo(xb.x), bf_hi(xb.x)}; x2[5] = f32x2{bf_lo(xb.y), bf_hi(xb.y)};
    x2[6] = f32x2{bf_lo(xb.z), bf_hi(xb.z)}; x2[7] = f32x2{bf_lo(xb.w), bf_hi(xb.w)};
#pragma unroll
    for (int q = 0; q < 4; ++q) d[4 + q] = dot16_fp8v(x2, UB.ur[q]);
  }
  gload_u(UB, nxtB, ni4, u8, loff);
  const bool b0 = lane & 1, b1 = lane & 2, b2 = lane & 4;
  float a[4];
#pragma unroll
  for (int j = 0; j < 4; ++j) {
    const float keep = b0 ? d[4 + j] : d[j], send = b0 ? d[j] : d[4 + j];
    a[j] = keep + dpp_f<0xB1>(send);
  }
  float c2[2];
#pragma unroll
  for (int j = 0; j < 2; ++j) {
    const float keep = b1 ? a[2 + j] : a[j], send = b1 ? a[j] : a[2 + j];
    c2[j] = keep + dpp_f<0x4E>(send);
  }
  float tot;
  {
    const float keep = b2 ? c2[1] : c2[0], send = b2 ? c2[0] : c2[1];
    tot = keep + swz_f<0x101F>(send);
  }
  tot += swz_f<0x201F>(tot);
  tot = swap32_sum(swap16_sum(tot));
  const int pq = ((lane >> 1) & 1) * 2 + ((lane >> 2) & 1);
  const float* rl = (b0 ? recB : recA) + ci4 + pq;
  const float z = tot * rl[256];
  const float wv = rl[128] * gelu_as(z);
#pragma unroll
  for (int q = 0; q < 4; ++q) {
    const int ln = ((q >> 1) & 1) * 2 + (q & 1) * 4;
    const float wa = __int_as_float(__builtin_amdgcn_readlane(__float_as_int(wv), ln));
    const float wb = __int_as_float(__builtin_amdgcn_readlane(__float_as_int(wv), ln + 1));
    axpy16_fp8v(yA, wa, VA.vr[q]);
    axpy16_fp8v(yB, wb, VB.vr[q]);
  }
  gload_v(VA, nxtA, ni4, v8, loff);
  gload_v(VB, nxtB, ni4, v8, loff);
}

__device__ __forceinline__ void gstep(GU& U, GV& V, const uint4* xl, f32x2* y2, const float* nrec, int ni4,
                                      const unsigned char* u8, const unsigned char* v8, unsigned loff, int lane) {
  f32x2 x2[8];
  {
    const uint4 xa = xl[0], xb = xl[1];
    x2[0] = f32x2{bf_lo(xa.x), bf_hi(xa.x)}; x2[1] = f32x2{bf_lo(xa.y), bf_hi(xa.y)};
    x2[2] = f32x2{bf_lo(xa.z), bf_hi(xa.z)}; x2[3] = f32x2{bf_lo(xa.w), bf_hi(xa.w)};
    x2[4] = f32x2{bf_lo(xb.x), bf_hi(xb.x)}; x2[5] = f32x2{bf_lo(xb.y), bf_hi(xb.y)};
    x2[6] = f32x2{bf_lo(xb.z), bf_hi(xb.z)}; x2[7] = f32x2{bf_lo(xb.w), bf_hi(xb.w)};
  }
  float d[4], su[4];
#pragma unroll
  for (int q = 0; q < 4; ++q) { d[q] = dot16_fp8v(x2, U.ur[q]); su[q] = U.su[q]; }
  gload_u(U, nrec, ni4, u8, loff);
#pragma unroll
  for (int q = 0; q < 4; ++q) d[q] = wave_sum(d[q]) * su[q];
  float dv = d[0]; dv = (lane == 1) ? d[1] : dv; dv = (lane == 2) ? d[2] : dv; dv = (lane == 3) ? d[3] : dv;
  const float av = gelu_as(dv);
#pragma unroll
  for (int q = 0; q < 4; ++q) {
    const float act = __int_as_float(__builtin_amdgcn_readlane(__float_as_int(av), q));
    axpy16_fp8v(y2, V.gt[q] * act, V.vr[q]);
  }
  gload_v(V, nrec, ni4, v8, loff);
}

__device__ __forceinline__ void gsort_token(const Params& p, int t, float* rec, int lane) {
  const int e0 = p.eidx()[(size_t)t * 128 + lane], e1 = p.eidx()[(size_t)t * 128 + 64 + lane];
  const float g0 = p.egate()[(size_t)t * 128 + lane], g1 = p.egate()[(size_t)t * 128 + 64 + lane];
  const float q0 = p.esu()[(size_t)t * 128 + lane], q1 = p.esu()[(size_t)t * 128 + 64 + lane];
  int base = 0;
#pragma unroll 4
  for (int s = 0; s < 16; ++s) {
    const unsigned long long m0 = __ballot((e0 >> 10) == s), m1 = __ballot((e1 >> 10) == s);
    const int c0 = __popcll(m0), c1 = __popcll(m1);
    const int p0 = base + (int)__builtin_amdgcn_mbcnt_hi((unsigned)(m0 >> 32), __builtin_amdgcn_mbcnt_lo((unsigned)m0, 0));
    const int p1 = base + c0 + (int)__builtin_amdgcn_mbcnt_hi((unsigned)(m1 >> 32), __builtin_amdgcn_mbcnt_lo((unsigned)m1, 0));
    if ((e0 >> 10) == s) { rec[p0] = __int_as_float(e0); rec[128 + p0] = g0; rec[256 + p0] = q0; }
    if ((e1 >> 10) == s) { rec[p1] = __int_as_float(e1); rec[128 + p1] = g1; rec[256 + p1] = q1; }
    base += c0 + c1;
  }
}
__device__ __forceinline__ void gload_x(const Params& p, int t, uint4* xl, int lane) {
  xl[0] = *reinterpret_cast<const uint4*>(p.xn() + (size_t)t * 1024 + lane * 16);
  xl[1] = *reinterpret_cast<const uint4*>(p.xn() + (size_t)t * 1024 + lane * 16 + 8);
}
template <bool LAST>
__device__ __forceinline__ void gstore_x(const Params& p, int l, int t, const f32x2* y2, int lane) {
  float* xr = p.x() + (size_t)t * 1024 + lane * 16;
  float4 a[4];
  float ss = 0.f;
#pragma unroll
  for (int j = 0; j < 4; ++j) {
    a[j] = reinterpret_cast<float4*>(xr)[j];
    a[j].x += y2[2 * j].x; a[j].y += y2[2 * j].y; a[j].z += y2[2 * j + 1].x; a[j].w += y2[2 * j + 1].y;
    ss += a[j].x * a[j].x + a[j].y * a[j].y + a[j].z * a[j].z + a[j].w * a[j].w;
  }
  ss = wave_sum(ss);
  const float r = rsqrtf(ss * (1.f / 1024.f) + EPS);
  if (LAST) {
    const float* g = p.final_g() + lane * 16;
    float* o = ((t < NPROMPT) ? p.out + O_Y_P + (size_t)t * 1024 : p.out + O_Y_S + (size_t)(t - NPROMPT) * 1024) + lane * 16;
#pragma unroll
    for (int j = 0; j < 4; ++j) {
      const float4 gv = reinterpret_cast<const float4*>(g)[j];
      reinterpret_cast<float4*>(o)[j] = make_float4(a[j].x * r * gv.x, a[j].y * r * gv.y, a[j].z * r * gv.z, a[j].w * r * gv.w);
    }
  } else {
    const float* g = p.norm1_g() + (l + 1) * 1024 + lane * 16;
#pragma unroll
    for (int j = 0; j < 4; ++j) {
      reinterpret_cast<float4*>(xr)[j] = a[j];
      const float4 gv = reinterpret_cast<const float4*>(g)[j];
      a[j].x *= r * gv.x; a[j].y *= r * gv.y; a[j].z *= r * gv.z; a[j].w *= r * gv.w;
    }
    uint4* o = reinterpret_cast<uint4*>(p.xn() + (size_t)t * 1024 + lane * 16);
    o[0] = make_uint4(pack2(a[0].x, a[0].y), pack2(a[0].z, a[0].w), pack2(a[1].x, a[1].y), pack2(a[1].z, a[1].w));
    o[1] = make_uint4(pack2(a[2].x, a[2].y), pack2(a[2].z, a[2].w), pack2(a[3].x, a[3].y), pack2(a[3].z, a[3].w));
    float pre[8];
#pragma unroll
    for (int i = 0; i < 8; ++i) {
      const float4* wr = reinterpret_cast<const float4*>(p.wg() + ((size_t)(l + 1) * 8 + i) * 1024 + lane * 16);
      float s = 0.f;
#pragma unroll
      for (int j = 0; j < 4; ++j) {
        const float4 wv = wr[j];
        s += a[j].x * wv.x + a[j].y * wv.y + a[j].z * wv.z + a[j].w * wv.w;
      }
      pre[i] = wave_sum(s);
    }
    if (lane < 4) {
      float ai = pre[0]; ai = lane == 1 ? pre[1] : ai; ai = lane == 2 ? pre[2] : ai; ai = lane == 3 ? pre[3] : ai;
      float f = pre[4]; f = lane == 1 ? pre[5] : f; f = lane == 2 ? pre[6] : f; f = lane == 3 ? pre[7] : f;
      p.ig()[(size_t)t * 4 + lane] = ai + p.ml_gate_b()[(l + 1) * 8 + lane];
      const float z = f + p.ml_gate_b()[(l + 1) * 8 + 4 + lane];
      p.lf()[(size_t)t * 4 + lane] = fminf(z, 0.f) - log1pf(expf(-fabsf(z)));
    }
  }
}

template <bool LAST>
__device__ __forceinline__ void ph_gather2(const Params& p, int l, char* smem, int bid, int nblk) {
  const int tid = tid_opaque(), lane = tid & 63, w = __builtin_amdgcn_readfirstlane(tid >> 6);
  const unsigned char* u8 = p.ub8() + (size_t)l * 16384 * 1024;
  const unsigned char* v8 = p.vb8() + (size_t)l * 16384 * 1024;
  const unsigned loff = (unsigned)lane * 16u;
  float* rec = reinterpret_cast<float*>(smem) + w * (GT * GREC);
  uint4* xl = reinterpret_cast<uint4*>(smem + 4 * GT * GREC * 4) + (w * GT * 64 + lane) * 2;
  const int rot = 0;
  const int nwaves = nblk * 4, wg = bid * 4 + w;
  const int nfull = (NTOK / (nwaves * GT)) * nwaves;
  for (int grp = wg; grp < nfull; grp += nwaves) {
    const int t0 = grp * GT;
    int lane_s = lane; asm volatile("" : "+v"(lane_s));
#pragma unroll 1
    for (int ti = 0; ti < GT; ++ti) {
      gload_x(p, t0 + ti, xl + ti * 128, lane_s);
      gsort_token(p, t0 + ti, rec + ti * GREC, lane_s);
    }
    f32x2 y2[GT][8];
#pragma unroll
    for (int ti = 0; ti < GT; ++ti)
#pragma unroll
      for (int i = 0; i < 8; ++i) y2[ti][i] = f32x2{0.f, 0.f};
    GU U0, U1; GV V0, V1;
    gload_u(U0, rec, (rot & 31) * 4, u8, loff); gload_v(V0, rec, (rot & 31) * 4, v8, loff);
    gload_u(U1, rec + GREC, (rot & 31) * 4, u8, loff); gload_v(V1, rec + GREC, (rot & 31) * 4, v8, loff);
#pragma unroll 1
    for (int b = 0; b < 32; ++b) {
      const int bo = ((b + rot) & 31) * 4, bn = ((b + 1 + rot) & 31) * 4;
      gstep2(U0, V0, U1, V1, xl, xl + 128, y2[0], y2[1], rec, rec + GREC, bo, rec + 2 * GREC, rec + 3 * GREC, bo, u8, v8, loff, lane);
      __builtin_amdgcn_sched_barrier(0);
      gstep2(U0, V0, U1, V1, xl + 256, xl + 384, y2[2], y2[3], rec + 2 * GREC, rec + 3 * GREC, bo, rec, rec + GREC, bn, u8, v8, loff, lane);
      __builtin_amdgcn_sched_barrier(0);
    }
    int lane_e = lane; asm volatile("" : "+v"(lane_e));
#pragma unroll
    for (int ti = 0; ti < GT; ++ti) gstore_x<LAST>(p, l, t0 + ti, y2[ti], lane_e);
  }
  float* ysum = reinterpret_cast<float*>(smem + 4 * GT * GREC * 4 + 4 * GT * 2048);
  for (int t = nfull * GT + bid; t < NTOK; t += nblk) {
    f32x2 y2[8];
    gload_x(p, t, xl, lane);
#pragma unroll
    for (int i = 0; i < 8; ++i) y2[i] = f32x2{0.f, 0.f};
    gsort_token(p, t, rec, lane);
    GU U; GV V;
    gload_u(U, rec, (w * 8) * 4, u8, loff);
    gload_v(V, rec, (w * 8) * 4, v8, loff);
#pragma unroll 1
    for (int b = 0; b < 8; ++b) gstep(U, V, xl, y2, rec, (w * 8 + ((b + 1) & 7)) * 4, u8, v8, loff, lane);
    __syncthreads();
#pragma unroll
    for (int i = 0; i < 8; ++i) { ysum[w * 1024 + lane * 16 + 2 * i] = y2[i].x; ysum[w * 1024 + lane * 16 + 2 * i + 1] = y2[i].y; }
    __syncthreads();
    if (w == 0) {
#pragma unroll
      for (int i = 0; i < 8; ++i) {
        y2[i].x += ysum[1024 + lane * 16 + 2 * i] + ysum[2048 + lane * 16 + 2 * i] + ysum[3072 + lane * 16 + 2 * i];
        y2[i].y += ysum[1024 + lane * 16 + 2 * i + 1] + ysum[2048 + lane * 16 + 2 * i + 1] + ysum[3072 + lane * 16 + 2 * i + 1];
      }
      gstore_x<LAST>(p, l, t, y2, lane);
    }
  }
}

#define XB_TMO      128
#define XB_XCNT(j)  (256  + 64 * (j))
#define XB_XSUB(j)  (1280 + 64 * (j))
#define XB_XGEN(j)  (2304 + 64 * (j))
#define XB_TOP      3328
#define XB_TOPGEN   3392
#define XCD_BAR_WORDS 3456
#define XB_SPIN_CAP (1u << 22)
__device__ __forceinline__ unsigned xb_ld(unsigned* p)              { return __hip_atomic_load(p, __ATOMIC_RELAXED, __HIP_MEMORY_SCOPE_AGENT); }
__device__ __forceinline__ unsigned xb_add(unsigned* p, unsigned v) { return __hip_atomic_fetch_add(p, v, __ATOMIC_RELAXED, __HIP_MEMORY_SCOPE_AGENT); }
__device__ __forceinline__ unsigned xb_xcc_id() { return (unsigned)__builtin_amdgcn_s_getreg((3 << 11) | 20) & 0xFu; }
#define XB_SPIN(cond, bar) do { unsigned _sp = 0; while (cond) { __builtin_amdgcn_s_sleep(1); \
    if ((++_sp & 255u) == 0u) { if (xb_ld(&(bar)[XB_TMO])) break; if (_sp > XB_SPIN_CAP) { atomicAdd(&(bar)[XB_TMO], 1u); break; } } } } while (0)

struct XcdBarrier { unsigned* bar; unsigned x; volatile LAS unsigned* st; };

__device__ __forceinline__ XcdBarrier xcd_barrier_post(unsigned* bar, volatile LAS unsigned* st) {
  XcdBarrier b; b.bar = bar; b.x = xb_xcc_id(); b.st = st;
  if (threadIdx.x == 0) (void)xb_add(&bar[XB_XCNT(b.x)], 1u);
  return b;
}
__device__ __forceinline__ void xcd_barrier_complete(unsigned* bar, unsigned x, unsigned& nloc, unsigned& nx) {
  const unsigned G = gridDim.x * gridDim.y * gridDim.z;
  unsigned sum, cnt, mine, sp = 0u;
  for (;;) {
    sum = 0u; cnt = 0u; mine = 0u;
#pragma unroll
    for (unsigned j = 0; j < 16; ++j) { const unsigned c = xb_ld(&bar[XB_XCNT(j)]); sum += c; cnt += (c > 0u) ? 1u : 0u; mine = (j == x) ? c : mine; }
    if (sum == G) break;
    __builtin_amdgcn_s_sleep(1);
    if ((++sp & 255u) == 0u) { if (xb_ld(&bar[XB_TMO])) break; if (sp > XB_SPIN_CAP) { atomicAdd(&bar[XB_TMO], 1u); break; } }
  }
  nloc = mine > 0u ? mine : 1u; nx = cnt > 0u ? cnt : 1u;
}
__device__ __forceinline__ void xcd_barrier(const XcdBarrier& b) {
  asm volatile("s_waitcnt vmcnt(0)" ::: "memory");
  __syncthreads();
  if (threadIdx.x == 0) {
    unsigned* bar = b.bar;
    __builtin_amdgcn_s_waitcnt(0);
    unsigned nloc = b.st[0], nx = b.st[1];
    if (nloc == 0u) { xcd_barrier_complete(bar, b.x, nloc, nx); b.st[0] = nloc; b.st[1] = nx; }
    const unsigned old = xb_add(&bar[XB_XSUB(b.x)], 1u);
    const unsigned gen = old / nloc;
    if (old + 1u == (gen + 1u) * nloc) {
      __builtin_amdgcn_fence(__ATOMIC_RELEASE, "agent");
      asm volatile("s_waitcnt vmcnt(0)" ::: "memory");
      const unsigned og = xb_add(&bar[XB_TOP], 1u);
      const unsigned tg = og / nx;
      if (og + 1u == (tg + 1u) * nx) xb_add(&bar[XB_TOPGEN], 1u);
      else XB_SPIN(xb_ld(&bar[XB_TOPGEN]) == tg, bar);
      __builtin_amdgcn_fence(__ATOMIC_ACQUIRE, "agent");
      xb_add(&bar[XB_XGEN(b.x)], 1u);
      asm volatile("s_waitcnt vmcnt(0)" ::: "memory");
    } else {
      XB_SPIN(xb_ld(&bar[XB_XGEN(b.x)]) == gen, bar);
      __builtin_amdgcn_fence(__ATOMIC_ACQUIRE, "agent");
      asm volatile("s_waitcnt vmcnt(0)" ::: "memory");
    }
  }
  __syncthreads();
}

#define GSYNC() xcd_barrier(xb)
#define PP(wi) phase_params(p, wi)
#define BN bid_opaque(bid), nblk_opaque(nblk)

template <int L>
__device__ __forceinline__ void layer_phases(const Params& p, char* smem, const XcdBarrier& xb, int bid, int nblk) {
  ph_gemm<EPI_WIN>(PP(false), L, smem, BN);
#if PROBE == 1
  GSYNC();
  ph_gemm<EPI_WIN>(PP(false), L, smem, BN);
#endif
  GSYNC();
  {
    const Params q = PP(false);
    WorkQ wq; wq.cnt = reinterpret_cast<unsigned*>(q.ws) + 8 + L; wq.slot = reinterpret_cast<volatile int*>(smem + SMEM_BYTES - 8); wq.off = 0;
    int item = ph_attn<(L == 0)>(phase_params(p, false, L == 0), L, smem, wq);
    wq.off = (L == 0) ? 528 : 0;
    item = ph_mlconv(PP(false), L, smem, wq, item);
    ph_cmlp(PP(false), L, smem, wq, item);
  }
  GSYNC();
  ph_mlU(PP(false), L, smem, BN);
#if PROBE == 9 || PROBE == 20
  GSYNC();
  ph_mlU(PP(false), L, smem, BN);
#endif
  GSYNC();
  ph_mlscan(PP(false), L, BN);
#if PROBE == 10 || PROBE == 20
  GSYNC();
  ph_mlscan(PP(false), L, BN);
#endif
  GSYNC();
  ph_mlout(PP(false), L, smem, BN);
#if PROBE == 6 || PROBE == 20
  GSYNC();
  ph_mlout(PP(false), L, smem, BN);
#endif
  GSYNC();
  ph_gemm<EPI_WOUT>(PP(false), L, smem, BN);
  GSYNC();
  ph_rmsnorm<1>(PP(false), L, BN);
  GSYNC();
  ph_gemm<EPI_PQ>(PP(false), L, smem, BN);
#if PROBE == 2
  GSYNC();
  ph_gemm<EPI_PQ>(PP(false), L, smem, BN);
#endif
  GSYNC();
  ph_topk(PP(false), L, smem, BN);
#if PROBE == 5
  GSYNC();
  ph_topk(PP(false), L, smem, BN);
#endif
  GSYNC();
  ph_gather2<(L == 1)>(PP(false), L, smem, BN);
  GSYNC();
}

__global__ void __launch_bounds__(256, 2) mega_kernel(Params p) {
  __shared__ __attribute__((aligned(16))) char smem[SMEM_BYTES];
  __shared__ uint4 xb_words;
  cg::grid_group grid = cg::this_grid();
  const int bid = blockIdx.x, nblk = gridDim.x;
  if (threadIdx.x == 0) xb_words = make_uint4(0u, 0u, 0u, 0u);
  __syncthreads();
  XcdBarrier xb = xcd_barrier_post(reinterpret_cast<unsigned*>(p.ws), (volatile LAS unsigned*)&xb_words);
  grid.sync();
  ph_prep(PP(true), smem, BN);
  ph_norm1_l0(PP(true), smem, BN);
#if PROBE == 12
  GSYNC();
  ph_prep(PP(true), smem, BN);
#endif
  GSYNC();
  layer_phases<0>(p, smem, xb, bid, nblk);
  layer_phases<1>(p, smem, xb, bid, nblk);
}

static inline size_t align_up(size_t v, size_t a) { return (v + a - 1) / a * a; }

extern "C" void kernel_launch(void* const* d_in, const int* in_sizes, int n_in, void* d_out, int out_size, void* d_ws,
                              size_t ws_size, hipStream_t stream) {
  Params p{};
  for (int i = 0; i < 30; ++i) p.in[i] = reinterpret_cast<const float*>(d_in[i]);
  p.out = reinterpret_cast<float*>(d_out);
  p.ws = reinterpret_cast<char*>(d_ws);
  if (WS_NEED > ws_size) { fprintf(stderr, "workspace too small: need %zu have %zu\n", (size_t)WS_NEED, ws_size); return; }
  static int grid_blocks = 0;
  if (!grid_blocks) {
    int dev = 0, cus = 0, per_cu = 0;
    hipGetDevice(&dev);
    hipDeviceGetAttribute(&cus, hipDeviceAttributeMultiprocessorCount, dev);
    hipOccupancyMaxActiveBlocksPerMultiprocessor(&per_cu, mega_kernel, 256, 0);
    if (per_cu > 2) per_cu = 2;
    if (per_cu < 1) per_cu = 1;
    grid_blocks = cus * per_cu;
  }
  hipMemsetAsync(d_ws, 0, 16384, stream);
  void* args[] = {&p};
  hipError_t e = hipLaunchCooperativeKernel((void*)mega_kernel, dim3(grid_blocks), dim3(256), args, 0, stream);
  if (e != hipSuccess) fprintf(stderr, "cooperative launch failed: %s (grid %d)\n", hipGetErrorString(e), grid_blocks);
}
```

```cpp
#include <hip/hip_runtime.h>
#include <hip/hip_cooperative_groups.h>
#include <cstdio>
#include <cstdint>

namespace cg = cooperative_groups;

typedef unsigned short bf16_t;
typedef __attribute__((ext_vector_type(8))) __bf16 bf16x8;
typedef __attribute__((ext_vector_type(2))) __bf16 bf16x2;
typedef __attribute__((ext_vector_type(16))) float f32x16;
typedef __attribute__((ext_vector_type(2))) float f32x2;

#define D_MODEL 1024
#define NTOK 16896
#define NPROMPT 16384
#define SEQ 4096
#define NIN 2816
#define EPS 1e-6f
#define LOG2E 1.4426950408889634f
#define SKEYS 1088
#define NCU_UNITS 1056

constexpr size_t O_Y_P = 0;
constexpr size_t O_Y_S = O_Y_P + 16777216;
constexpr size_t O_K_P = O_Y_S + 524288;
constexpr size_t O_V_P = O_K_P + 16777216;
constexpr size_t O_C_P = O_V_P + 16777216;
constexpr size_t O_N_P = O_C_P + 131072;
constexpr size_t O_M_P = O_N_P + 2048;
constexpr size_t O_CONV_P = O_M_P + 32;
constexpr size_t O_K_S = O_CONV_P + 6144;
constexpr size_t O_V_S = O_K_S + 524288;
constexpr size_t O_C_S = O_V_S + 524288;
constexpr size_t O_N_S = O_C_S + 262144;
constexpr size_t O_M_S = O_N_S + 4096;
constexpr size_t O_CONV_S = O_M_S + 64;
constexpr size_t O_CMV_S = O_CONV_S + 12288;

constexpr size_t al256(size_t v) { return (v + 255) / 256 * 256; }
constexpr int SP_st_c = 0;
constexpr int SP_st_n = 262144;
constexpr int SP_st_m = 266240;
constexpr int SP_st_conv = 266304;
constexpr int SP_norm1_g = 278592;
constexpr int SP_da_subln_g = 280640;
constexpr int SP_ml_conv_w = 280896;
constexpr int SP_ml_conv_b = 282944;
constexpr int SP_ml_wq = 283456;
constexpr int SP_ml_wk = 316224;
constexpr int SP_ml_gate_b = 348992;
constexpr int SP_ml_norm_g = 349056;
constexpr int SP_ml_skip = 349568;
constexpr int SP_cm_norm_g = 350080;
constexpr int SP_cm_ws = 350592;
constexpr int SP_cm_b = 481664;
constexpr int SP_norm2_g = 482688;
constexpr int SP_final_g = 484736;
constexpr int SP_TOTAL = 485760;
constexpr size_t WS_bar = 0;
constexpr size_t WS_lam = al256(WS_bar + 16384);
constexpr size_t WS_lut = al256(WS_lam + (256));
constexpr size_t WS_sp = al256(WS_lut + (4*256*4));
constexpr size_t WS_wt_in = al256(WS_sp + (SP_TOTAL*4));
constexpr size_t WS_wg = al256(WS_wt_in + ((size_t)2*NIN*1024*2));
constexpr size_t WS_wt_out = al256(WS_wg + ((size_t)2*8*1024*4));
constexpr size_t WS_wt_pq = al256(WS_wt_out + ((size_t)2*1024*1024*2));
constexpr size_t WS_keysb = al256(WS_wt_pq + ((size_t)2*2048*1024*2));
constexpr size_t WS_ub8 = al256(WS_keysb + ((size_t)2*16*128*128*2));
constexpr size_t WS_vb8 = al256(WS_ub8 + ((size_t)2*16384*1024));
constexpr size_t WS_us = al256(WS_vb8 + ((size_t)2*16384*1024));
constexpr size_t WS_vs = al256(WS_us + ((size_t)2*16384*4));
constexpr size_t WS_Kbs = al256(WS_vs + ((size_t)2*16384*4));
constexpr size_t WS_Vts = al256(WS_Kbs + ((size_t)2*8*SKEYS*512*2));
constexpr size_t WS_x = al256(WS_Vts + ((size_t)2*8*4*128*SKEYS*2));
constexpr size_t WS_xn = al256(WS_x + ((size_t)NTOK*1024*4));
constexpr size_t WS_R0 = al256(WS_xn + ((size_t)NTOK*1024*2));
constexpr size_t WS_R0x = WS_R0;
constexpr size_t WS_Qb = al256(WS_R0x + (0));
constexpr size_t WS_Kb = al256(WS_Qb + ((size_t)NTOK*512*2));
constexpr size_t WS_Vt = al256(WS_Kb + ((size_t)NPROMPT*512*2));
constexpr size_t WS_P5 = al256(WS_Vt + ((size_t)16*128*SEQ*2));
constexpr size_t WS_ig = al256(WS_P5 + ((size_t)NTOK*1280*4));
constexpr size_t WS_lf = al256(WS_ig + ((size_t)NTOK*4*4));
constexpr size_t WS_Fc = al256(WS_lf + ((size_t)NTOK*4*4));
constexpr size_t WS_cc = al256(WS_Fc + ((size_t)NTOK*4*4));
constexpr size_t WS_qm = al256(WS_cc + ((size_t)NTOK*256*4));
constexpr size_t WS_km = al256(WS_qm + ((size_t)NTOK*256*4));
constexpr size_t WS_mst = al256(WS_km + ((size_t)NTOK*256*4));
constexpr size_t WS_mnx = al256(WS_mst + (NCU_UNITS*4));
constexpr size_t WS_wcs = al256(WS_mnx + (NCU_UNITS*4));
constexpr size_t WS_FLs = al256(WS_wcs + (NCU_UNITS*4));
constexpr size_t WS_mxt = al256(WS_FLs + (NCU_UNITS*4));
constexpr size_t WS_U = al256(WS_mxt + (NCU_UNITS*4));
constexpr size_t WS_un = al256(WS_U + ((size_t)NCU_UNITS*4096*4));
constexpr size_t WS_Cst = al256(WS_un + ((size_t)NCU_UNITS*64*4));
constexpr size_t WS_nst = al256(WS_Cst + ((size_t)NCU_UNITS*4096*4));
constexpr size_t WS_END_MIXER = al256(WS_nst + ((size_t)NCU_UNITS*64*4));
constexpr size_t WS_qp = al256(WS_R0x + (0));
constexpr size_t WS_sc = al256(WS_qp + ((size_t)NTOK*2048*2));
constexpr size_t WS_eidx = al256(WS_sc + ((size_t)NTOK*2048*4));
constexpr size_t WS_egate = al256(WS_eidx + ((size_t)NTOK*128*4));
constexpr size_t WS_esu = al256(WS_egate + ((size_t)NTOK*128*4));
constexpr size_t WS_ssp = al256(WS_esu + ((size_t)NTOK*128*4));
constexpr size_t WS_END_PEER = al256(WS_ssp + ((size_t)NTOK*32*4));
constexpr size_t WS_NEED = WS_END_MIXER > WS_END_PEER ? WS_END_MIXER : WS_END_PEER;

struct Params {
  const float* in[30];
  float* out;
  char* ws;
  __device__ __forceinline__ const float* x_prompt() const { return in[0]; }
  __device__ __forceinline__ const float* x_sample() const { return in[1]; }
  __device__ __forceinline__ const float* cache_k() const { return in[2]; }
  __device__ __forceinline__ const float* cache_v() const { return in[3]; }
  __device__ __forceinline__ const float* w_in() const { return in[9]; }
  __device__ __forceinline__ const float* da_lambda() const { return in[10]; }
  __device__ __forceinline__ const float* rel_table() const { return in[12]; }
  __device__ __forceinline__ const float* w_out() const { return in[23]; }
  __device__ __forceinline__ const float* peer_wq() const { return in[25]; }
  __device__ __forceinline__ const float* peer_keys() const { return in[26]; }
  __device__ __forceinline__ const float* peer_u() const { return in[27]; }
  __device__ __forceinline__ const float* peer_v() const { return in[28]; }
  __device__ __forceinline__ const float* st_c() const { return reinterpret_cast<const float*>(ws + WS_sp) + SP_st_c; }
  __device__ __forceinline__ const float* st_n() const { return reinterpret_cast<const float*>(ws + WS_sp) + SP_st_n; }
  __device__ __forceinline__ const float* st_m() const { return reinterpret_cast<const float*>(ws + WS_sp) + SP_st_m; }
  __device__ __forceinline__ const float* st_conv() const { return reinterpret_cast<const float*>(ws + WS_sp) + SP_st_conv; }
  __device__ __forceinline__ const float* norm1_g() const { return reinterpret_cast<const float*>(ws + WS_sp) + SP_norm1_g; }
  __device__ __forceinline__ const float* da_subln_g() const { return reinterpret_cast<const float*>(ws + WS_sp) + SP_da_subln_g; }
  __device__ __forceinline__ const float* ml_conv_w() const { return reinterpret_cast<const float*>(ws + WS_sp) + SP_ml_conv_w; }
  __device__ __forceinline__ const float* ml_conv_b() const { return reinterpret_cast<const float*>(ws + WS_sp) + SP_ml_conv_b; }
  __device__ __forceinline__ const float* ml_wq() const { return reinterpret_cast<const float*>(ws + WS_sp) + SP_ml_wq; }
  __device__ __forceinline__ const float* ml_wk() const { return reinterpret_cast<const float*>(ws + WS_sp) + SP_ml_wk; }
  __device__ __forceinline__ const float* ml_gate_b() const { return reinterpret_cast<const float*>(ws + WS_sp) + SP_ml_gate_b; }
  __device__ __forceinline__ const float* ml_norm_g() const { return reinterpret_cast<const float*>(ws + WS_sp) + SP_ml_norm_g; }
  __device__ __forceinline__ const float* ml_skip() const { return reinterpret_cast<const float*>(ws + WS_sp) + SP_ml_skip; }
  __device__ __forceinline__ const float* cm_norm_g() const { return reinterpret_cast<const float*>(ws + WS_sp) + SP_cm_norm_g; }
  __device__ __forceinline__ const float* cm_ws() const { return reinterpret_cast<const float*>(ws + WS_sp) + SP_cm_ws; }
  __device__ __forceinline__ const float* cm_b() const { return reinterpret_cast<const float*>(ws + WS_sp) + SP_cm_b; }
  __device__ __forceinline__ const float* norm2_g() const { return reinterpret_cast<const float*>(ws + WS_sp) + SP_norm2_g; }
  __device__ __forceinline__ const float* final_g() const { return reinterpret_cast<const float*>(ws + WS_sp) + SP_final_g; }
  __device__ __forceinline__ float* lam() const { return reinterpret_cast<float*>(ws + WS_lam); }
  __device__ __forceinline__ float* lut() const { return reinterpret_cast<float*>(ws + WS_lut); }
  __device__ __forceinline__ float* sp() const { return reinterpret_cast<float*>(ws + WS_sp); }
  __device__ __forceinline__ bf16_t* wt_in() const { return reinterpret_cast<bf16_t*>(ws + WS_wt_in); }
  __device__ __forceinline__ float* wg() const { return reinterpret_cast<float*>(ws + WS_wg); }
  __device__ __forceinline__ bf16_t* wt_out() const { return reinterpret_cast<bf16_t*>(ws + WS_wt_out); }
  __device__ __forceinline__ bf16_t* wt_pq() const { return reinterpret_cast<bf16_t*>(ws + WS_wt_pq); }
  __device__ __forceinline__ bf16_t* keysb() const { return reinterpret_cast<bf16_t*>(ws + WS_keysb); }
  __device__ __forceinline__ unsigned char* ub8() const { return reinterpret_cast<unsigned char*>(ws + WS_ub8); }
  __device__ __forceinline__ unsigned char* vb8() const { return reinterpret_cast<unsigned char*>(ws + WS_vb8); }
  __device__ __forceinline__ float* us() const { return reinterpret_cast<float*>(ws + WS_us); }
  __device__ __forceinline__ float* vs() const { return reinterpret_cast<float*>(ws + WS_vs); }
  __device__ __forceinline__ bf16_t* Kbs() const { return reinterpret_cast<bf16_t*>(ws + WS_Kbs); }
  __device__ __forceinline__ bf16_t* Vts() const { return reinterpret_cast<bf16_t*>(ws + WS_Vts); }
  __device__ __forceinline__ float* x() const { return reinterpret_cast<float*>(ws + WS_x); }
  __device__ __forceinline__ bf16_t* xn() const { return reinterpret_cast<bf16_t*>(ws + WS_xn); }
  __device__ __forceinline__ bf16_t* Qb() const { return reinterpret_cast<bf16_t*>(ws + WS_Qb); }
  __device__ __forceinline__ bf16_t* Kb() const { return reinterpret_cast<bf16_t*>(ws + WS_Kb); }
  __device__ __forceinline__ bf16_t* Vt() const { return reinterpret_cast<bf16_t*>(ws + WS_Vt); }
  __device__ __forceinline__ float* P5() const { return reinterpret_cast<float*>(ws + WS_P5); }
  __device__ __forceinline__ float* ig() const { return reinterpret_cast<float*>(ws + WS_ig); }
  __device__ __forceinline__ float* lf() const { return reinterpret_cast<float*>(ws + WS_lf); }
  __device__ __forceinline__ float* Fc() const { return reinterpret_cast<float*>(ws + WS_Fc); }
  __device__ __forceinline__ float* cc() const { return reinterpret_cast<float*>(ws + WS_cc); }
  __device__ __forceinline__ float* qm() const { return reinterpret_cast<float*>(ws + WS_qm); }
  __device__ __forceinline__ float* km() const { return reinterpret_cast<float*>(ws + WS_km); }
  __device__ __forceinline__ float* mst() const { return reinterpret_cast<float*>(ws + WS_mst); }
  __device__ __forceinline__ float* mnx() const { return reinterpret_cast<float*>(ws + WS_mnx); }
  __device__ __forceinline__ float* wcs() const { return reinterpret_cast<float*>(ws + WS_wcs); }
  __device__ __forceinline__ float* FLs() const { return reinterpret_cast<float*>(ws + WS_FLs); }
  __device__ __forceinline__ float* mxt() const { return reinterpret_cast<float*>(ws + WS_mxt); }
  __device__ __forceinline__ float* U() const { return reinterpret_cast<float*>(ws + WS_U); }
  __device__ __forceinline__ float* un() const { return reinterpret_cast<float*>(ws + WS_un); }
  __device__ __forceinline__ float* Cst() const { return reinterpret_cast<float*>(ws + WS_Cst); }
  __device__ __forceinline__ float* nst() const { return reinterpret_cast<float*>(ws + WS_nst); }
  __device__ __forceinline__ bf16_t* qp() const { return reinterpret_cast<bf16_t*>(ws + WS_qp); }
  __device__ __forceinline__ float* sc() const { return reinterpret_cast<float*>(ws + WS_sc); }
  __device__ __forceinline__ int* eidx() const { return reinterpret_cast<int*>(ws + WS_eidx); }
  __device__ __forceinline__ float* egate() const { return reinterpret_cast<float*>(ws + WS_egate); }
  __device__ __forceinline__ float* esu() const { return reinterpret_cast<float*>(ws + WS_esu); }
  __device__ __forceinline__ float* ssp() const { return reinterpret_cast<float*>(ws + WS_ssp); }
  __device__ __forceinline__ int* tl() const { return reinterpret_cast<int*>(ws + WS_sc); }
};

__device__ __forceinline__ unsigned pack2(float a, float b) {
  f32x2 v = {a, b};
  bf16x2 r = __builtin_convertvector(v, bf16x2);
  return *reinterpret_cast<unsigned*>(&r);
}
__device__ __forceinline__ bf16_t f2bf(float a) { return (bf16_t)(pack2(a, 0.f) & 0xFFFFu); }
__device__ __forceinline__ float bf_lo(unsigned u) { return __uint_as_float(u << 16); }
__device__ __forceinline__ float bf_hi(unsigned u) { return __uint_as_float(u & 0xFFFF0000u); }
__device__ __forceinline__ float gelu_exact(float x) { return 0.5f * x * (1.f + erff(x * 0.70710678118654752f)); }
__device__ __forceinline__ float gelu_as(float z) {
  const float x = fabsf(z) * 0.70710678118654752f;
  const float t = __builtin_amdgcn_rcpf(fmaf(0.3275911f, x, 1.f));
  float pl = fmaf(1.061405429f, t, -1.453152027f);
  pl = fmaf(pl, t, 1.421413741f); pl = fmaf(pl, t, -0.284496736f); pl = fmaf(pl, t, 0.254829592f);
  const float e = __builtin_amdgcn_exp2f(-x * x * LOG2E);
  const float erfa = 1.f - pl * t * e;
  return 0.5f * z + 0.5f * fabsf(z) * erfa;
}
__device__ __forceinline__ float sigmoidf_(float x) { return 1.f / (1.f + __expf(-x)); }
__device__ __forceinline__ float shfl_up_l(float v, int d, int lane) {
  const int src = lane >= d ? lane - d : lane;
  return __int_as_float(__builtin_amdgcn_ds_bpermute(src << 2, __float_as_int(v)));
}
template <int CTRL>
__device__ __forceinline__ float dpp_f(float v) {
  return __builtin_bit_cast(float, __builtin_amdgcn_update_dpp(0, __builtin_bit_cast(int, v), CTRL, 0xf, 0xf, true));
}
__device__ __forceinline__ float swap16_sum(float x) {
  auto s = __builtin_amdgcn_permlane16_swap(__float_as_uint(x), __float_as_uint(x), false, false);
  return __uint_as_float(s[0]) + __uint_as_float(s[1]);
}
__device__ __forceinline__ float swap32_sum(float x) {
  auto s = __builtin_amdgcn_permlane32_swap(__float_as_uint(x), __float_as_uint(x), false, false);
  return __uint_as_float(s[0]) + __uint_as_float(s[1]);
}
__device__ __forceinline__ float swap16_max(float x) {
  auto s = __builtin_amdgcn_permlane16_swap(__float_as_uint(x), __float_as_uint(x), false, false);
  return fmaxf(__uint_as_float(s[0]), __uint_as_float(s[1]));
}
__device__ __forceinline__ float swap32_max(float x) {
  auto s = __builtin_amdgcn_permlane32_swap(__float_as_uint(x), __float_as_uint(x), false, false);
  return fmaxf(__uint_as_float(s[0]), __uint_as_float(s[1]));
}
__device__ __forceinline__ float row16_sum(float v) {
  v += dpp_f<0xB1>(v); v += dpp_f<0x4E>(v); v += dpp_f<0x141>(v); v += dpp_f<0x140>(v);
  return v;
}
__device__ __forceinline__ float row16_max(float v) {
  v = fmaxf(v, dpp_f<0xB1>(v)); v = fmaxf(v, dpp_f<0x4E>(v)); v = fmaxf(v, dpp_f<0x141>(v)); v = fmaxf(v, dpp_f<0x140>(v));
  return v;
}
__device__ __forceinline__ float wave_sum(float v) { return swap32_sum(swap16_sum(row16_sum(v))); }
__device__ __forceinline__ float wave_max(float v) { return swap32_max(swap16_max(row16_max(v))); }
__device__ __forceinline__ const float* xrow_in(const Params& p, int l, int t) {
  if (l == 0) return (t < NPROMPT) ? p.x_prompt() + (size_t)t * D_MODEL : p.x_sample() + (size_t)(t - NPROMPT) * D_MODEL;
  return p.x() + (size_t)t * D_MODEL;
}
__device__ __forceinline__ bf16x8 as_bf16x8(uint4 v) { return *reinterpret_cast<bf16x8*>(&v); }

__device__ __forceinline__ int tid_opaque() { int t = threadIdx.x; asm volatile("" : "+v"(t)); return t; }
__device__ __forceinline__ int sgpr_opaque(int v) { asm volatile("" : "+s"(v)); return v; }
__device__ __forceinline__ int bid_opaque(int v) { asm volatile("" : "+s"(v)); __builtin_assume(v >= 0); __builtin_assume(v < 1024); return v; }
__device__ __forceinline__ int nblk_opaque(int v) { asm volatile("" : "+s"(v)); __builtin_assume(v >= 1); __builtin_assume(v <= 1024); return v; }
#define LAS __attribute__((address_space(3)))
#ifndef PROBE
#define PROBE 0
#endif
#define SMEM_BYTES 73728

__device__ __forceinline__ void transpose_tile(const float* __restrict__ src, int lds, bf16_t* __restrict__ dst, int K, int n0, int k0,
                               int gate_skip, float* tile  ) {
  const int tid = tid_opaque();
  const int c = tid & 63, r0 = tid >> 6;
  int n = n0 + c;
  int col = n + ((gate_skip && n >= 2304) ? 8 : 0);
#pragma unroll 4
  for (int j = 0; j < 16; ++j) {
    int r = r0 + 4 * j;
    tile[r * 65 + c] = src[(size_t)(k0 + r) * lds + col];
  }
  __syncthreads();
  const int nn = tid >> 2, kg = (tid & 3) * 16;
  unsigned w[8];
#pragma unroll
  for (int j = 0; j < 8; ++j) w[j] = pack2(tile[(kg + 2 * j) * 65 + nn], tile[(kg + 2 * j + 1) * 65 + nn]);
  uint4* d = reinterpret_cast<uint4*>(dst + (size_t)(n0 + nn) * K + k0 + kg);
  d[0] = make_uint4(w[0], w[1], w[2], w[3]);
  d[1] = make_uint4(w[4], w[5], w[6], w[7]);
  __syncthreads();
}

__device__ __forceinline__ int rel_bucket_dev(int rel) {
  int ret = rel > 0 ? 16 : 0;
  int n = rel < 0 ? -rel : rel;
  int b;
  if (n < 8) b = n;
  else if (n < 12) b = 8;
  else if (n < 16) b = 9;
  else if (n < 23) b = 10;
  else if (n < 32) b = 11;
  else if (n < 46) b = 12;
  else if (n < 64) b = 13;
  else if (n < 91) b = 14;
  else b = 15;
  return ret + b;
}

__device__ __forceinline__ void prep_table_rows(const Params& p, int r0, int r1, int lane, int wv) {
  for (int r = r0 + wv; r < r1; r += 4) {
    const int tab = r >> 15, row = r & 32767;
    const float* src = (tab == 0 ? p.peer_u() : p.peer_v()) + (size_t)row * 1024 + lane * 16;
    float4 f0 = reinterpret_cast<const float4*>(src)[0], f1 = reinterpret_cast<const float4*>(src)[1];
    float4 f2 = reinterpret_cast<const float4*>(src)[2], f3 = reinterpret_cast<const float4*>(src)[3];
    float am = fmaxf(fmaxf(fmaxf(fabsf(f0.x), fabsf(f0.y)), fmaxf(fabsf(f0.z), fabsf(f0.w))),
                     fmaxf(fmaxf(fabsf(f1.x), fabsf(f1.y)), fmaxf(fabsf(f1.z), fabsf(f1.w))));
    am = fmaxf(am, fmaxf(fmaxf(fmaxf(fabsf(f2.x), fabsf(f2.y)), fmaxf(fabsf(f2.z), fabsf(f2.w))),
                         fmaxf(fmaxf(fabsf(f3.x), fabsf(f3.y)), fmaxf(fabsf(f3.z), fabsf(f3.w)))));
    am = wave_max(am);
    const float sc = am > 0.f ? 224.f / am : 1.f;
    int w0 = 0, w1 = 0, w2 = 0, w3 = 0;
    w0 = __builtin_amdgcn_cvt_pk_fp8_f32(f0.x * sc, f0.y * sc, w0, false); w0 = __builtin_amdgcn_cvt_pk_fp8_f32(f0.z * sc, f0.w * sc, w0, true);
    w1 = __builtin_amdgcn_cvt_pk_fp8_f32(f1.x * sc, f1.y * sc, w1, false); w1 = __builtin_amdgcn_cvt_pk_fp8_f32(f1.z * sc, f1.w * sc, w1, true);
    w2 = __builtin_amdgcn_cvt_pk_fp8_f32(f2.x * sc, f2.y * sc, w2, false); w2 = __builtin_amdgcn_cvt_pk_fp8_f32(f2.z * sc, f2.w * sc, w2, true);
    w3 = __builtin_amdgcn_cvt_pk_fp8_f32(f3.x * sc, f3.y * sc, w3, false); w3 = __builtin_amdgcn_cvt_pk_fp8_f32(f3.z * sc, f3.w * sc, w3, true);
    unsigned char* dst = (tab == 0 ? p.ub8() : p.vb8()) + (size_t)row * 1024 + lane * 16;
    *reinterpret_cast<uint4*>(dst) = make_uint4((unsigned)w0, (unsigned)w1, (unsigned)w2, (unsigned)w3);
    if (lane == 0) (tab == 0 ? p.us() : p.vs())[row] = am > 0.f ? am * (1.f / 224.f) : 1.f;
  }
}

__device__ __forceinline__ void ph_prep(const Params& p, char* smem, int bid, int nblk) {
  const int tid = tid_opaque();
  float* tile = reinterpret_cast<float*>(smem);
  for (int u = bid; u < 2 * 1472; u += nblk) {
    int l = u / 1472, r = u % 1472;
    if (r < 704) {
      int nt = r / 16, kt = r % 16;
      transpose_tile(p.w_in() + (size_t)l * 1024 * 2824, 2824, p.wt_in() + (size_t)l * NIN * 1024, 1024, nt * 64, kt * 64, 1, tile);
    } else if (r < 960) {
      r -= 704; int nt = r / 16, kt = r % 16;
      transpose_tile(p.w_out() + (size_t)l * 1024 * 1024, 1024, p.wt_out() + (size_t)l * 1024 * 1024, 1024, nt * 64, kt * 64, 0, tile);
    } else {
      r -= 960; int nt = r / 16, kt = r % 16;
      transpose_tile(p.peer_wq() + (size_t)l * 1024 * 2048, 2048, p.wt_pq() + (size_t)l * 2048 * 1024, 1024, nt * 64, kt * 64, 0, tile);
    }
  }
  for (int u = bid; u < 1024; u += nblk) {
    int kt = u & 15, h = (u >> 4) & 3, b = (u >> 6) & 7, l = u >> 9;
    const float* src = p.cache_v() + (((size_t)(l * 8 + b) * 1024 + kt * 64) * 4 + h) * 128;
    {
      int c = tid & 127, r0 = tid >> 7;
      for (int j = 0; j < 32; ++j) { int r = r0 + 2 * j; tile[r * 129 + c] = src[(size_t)r * 512 + c]; }
    }
    __syncthreads();
    {
      int dv = tid >> 1, half = tid & 1;
      bf16_t* dst = p.Vts() + ((size_t)((l * 8 + b) * 4 + h) * 128 + dv) * SKEYS + kt * 64 + half * 32;
      unsigned w[16];
#pragma unroll
      for (int j = 0; j < 16; ++j) {
        int pos0 = half * 32 + 2 * j;
        int blk = (pos0 >> 2) & 3;
        int oblk = (blk == 1) ? 2 : (blk == 2 ? 1 : blk);
        int key0 = (pos0 & ~15) + oblk * 4 + (pos0 & 3);
        w[j] = pack2(tile[key0 * 129 + dv], tile[(key0 + 1) * 129 + dv]);
      }
      uint4* d4 = reinterpret_cast<uint4*>(dst);
      d4[0] = make_uint4(w[0], w[1], w[2], w[3]);
      d4[1] = make_uint4(w[4], w[5], w[6], w[7]);
      d4[2] = make_uint4(w[8], w[9], w[10], w[11]);
      d4[3] = make_uint4(w[12], w[13], w[14], w[15]);
    }
    __syncthreads();
  }
  const size_t gtid = (size_t)bid * 256 + tid, gsz = (size_t)nblk * 256;
  {
    const size_t n8 = (size_t)2 * 16 * 128 * 128 / 8;
    for (size_t i = gtid; i < n8; i += gsz) {
      float4 a = reinterpret_cast<const float4*>(p.peer_keys())[2 * i], b = reinterpret_cast<const float4*>(p.peer_keys())[2 * i + 1];
      reinterpret_cast<uint4*>(p.keysb())[i] = make_uint4(pack2(a.x, a.y), pack2(a.z, a.w), pack2(b.x, b.y), pack2(b.z, b.w));
    }
  }
  {
    const size_t n8 = (size_t)2 * 8 * 1024 * 512 / 8;
    for (size_t i = gtid; i < n8; i += gsz) {
      size_t e = i * 8;
      size_t lb = e / (1024 * 512), rem = e % (1024 * 512);
      float4 a = reinterpret_cast<const float4*>(p.cache_k())[2 * i], b = reinterpret_cast<const float4*>(p.cache_k())[2 * i + 1];
      *reinterpret_cast<uint4*>(p.Kbs() + lb * (SKEYS * 512) + rem) = make_uint4(pack2(a.x, a.y), pack2(a.z, a.w), pack2(b.x, b.y), pack2(b.z, b.w));
    }
  }
  for (size_t i = gtid; i < 2 * 8 * 1024; i += gsz) {
    int l = (int)(i / 8192), r = (int)(i % 8192), g = r / 1024, k = r % 1024;
    p.wg()[i] = p.w_in()[((size_t)l * 1024 + k) * 2824 + 2304 + g];
  }
  {
    float* sp = reinterpret_cast<float*>(p.ws + WS_sp);
    for (size_t i = gtid; i < 262144; i += gsz) sp[SP_st_c + i] = p.in[4][i];
    for (size_t i = gtid; i < 4096; i += gsz) sp[SP_st_n + i] = p.in[5][i];
    for (size_t i = gtid; i < 64; i += gsz) sp[SP_st_m + i] = p.in[6][i];
    for (size_t i = gtid; i < 12288; i += gsz) sp[SP_st_conv + i] = p.in[7][i];
    for (size_t i = gtid; i < 2048; i += gsz) sp[SP_norm1_g + i] = p.in[8][i];
    for (size_t i = gtid; i < 256; i += gsz) sp[SP_da_subln_g + i] = p.in[11][i];
    for (size_t i = gtid; i < 2048; i += gsz) sp[SP_ml_conv_w + i] = p.in[13][i];
    for (size_t i = gtid; i < 512; i += gsz) sp[SP_ml_conv_b + i] = p.in[14][i];
    for (size_t i = gtid; i < 32768; i += gsz) sp[SP_ml_wq + i] = p.in[15][i];
    for (size_t i = gtid; i < 32768; i += gsz) sp[SP_ml_wk + i] = p.in[16][i];
    for (size_t i = gtid; i < 16; i += gsz) sp[SP_ml_gate_b + i] = p.in[17][i];
    for (size_t i = gtid; i < 512; i += gsz) sp[SP_ml_norm_g + i] = p.in[18][i];
    for (size_t i = gtid; i < 512; i += gsz) sp[SP_ml_skip + i] = p.in[19][i];
    for (size_t i = gtid; i < 512; i += gsz) sp[SP_cm_norm_g + i] = p.in[20][i];
    for (size_t i = gtid; i < 131072; i += gsz) sp[SP_cm_ws + i] = p.in[21][i];
    for (size_t i = gtid; i < 1024; i += gsz) sp[SP_cm_b + i] = p.in[22][i];
    for (size_t i = gtid; i < 2048; i += gsz) sp[SP_norm2_g + i] = p.in[24][i];
    for (size_t i = gtid; i < 1024; i += gsz) sp[SP_final_g + i] = p.in[29][i];
  }
  if (bid == 0) {
    for (int i = tid; i < 4 * 256; i += 256) {
      int h = i >> 8, j = i & 255;
      int rel = j - 191; if (rel > 63) rel = 63;
      p.lut()[i] = p.rel_table()[rel_bucket_dev(rel) * 4 + h] * LOG2E;
    }
    if (tid < 2) {
      const float* lp = p.da_lambda() + tid * 256;
      float s01 = 0.f, s23 = 0.f;
      for (int d = 0; d < 64; ++d) { s01 += lp[d] * lp[64 + d]; s23 += lp[128 + d] * lp[192 + d]; }
      float lam_init = 0.8f - 0.6f * expf(-0.3f * (float)tid);
      p.lam()[tid] = expf(s01) - expf(s23) + lam_init;
    }
  }
}

__device__ __forceinline__ void ph_norm1_l0(const Params& p, char* smem, int bid, int nblk) {
  const int tid = tid_opaque(), lane = tid & 63, w = __builtin_amdgcn_readfirstlane(tid >> 6);
  float* s_wg = reinterpret_cast<float*>(smem);
  __syncthreads();
  for (int i = tid; i < 8192; i += 256) { const int k = i >> 3, g = i & 7; s_wg[g * 1024 + k] = p.w_in()[(size_t)k * 2824 + 2304 + g]; }
  __syncthreads();
  const float* gptr = p.in[8];
  float4 gv[4];
#pragma unroll
  for (int j = 0; j < 4; ++j) gv[j] = reinterpret_cast<const float4*>(gptr)[lane + 64 * j];
  for (int t = bid * 4 + w; t < NTOK; t += nblk * 4) {
    const float* xr = (t < NPROMPT) ? p.in[0] + (size_t)t * D_MODEL : p.in[1] + (size_t)(t - NPROMPT) * D_MODEL;
    float4 xv[4];
    float ss = 0.f;
#pragma unroll
    for (int j = 0; j < 4; ++j) {
      xv[j] = reinterpret_cast<const float4*>(xr)[lane + 64 * j];
      ss += xv[j].x * xv[j].x + xv[j].y * xv[j].y + xv[j].z * xv[j].z + xv[j].w * xv[j].w;
    }
    ss = wave_sum(ss);
    const float r = rsqrtf(ss * (1.f / 1024.f) + EPS);
#pragma unroll
    for (int j = 0; j < 4; ++j) { xv[j].x *= r * gv[j].x; xv[j].y *= r * gv[j].y; xv[j].z *= r * gv[j].z; xv[j].w *= r * gv[j].w; }
    uint2* o = reinterpret_cast<uint2*>(p.xn() + (size_t)t * 1024);
#pragma unroll
    for (int j = 0; j < 4; ++j) o[lane + 64 * j] = make_uint2(pack2(xv[j].x, xv[j].y), pack2(xv[j].z, xv[j].w));
    float pre[8];
#pragma unroll
    for (int i = 0; i < 8; ++i) {
      const float4* wr = reinterpret_cast<const float4*>(s_wg + i * 1024);
      float s = 0.f;
#pragma unroll
      for (int j = 0; j < 4; ++j) { const float4 wv = wr[lane + 64 * j]; s += xv[j].x * wv.x + xv[j].y * wv.y + xv[j].z * wv.z + xv[j].w * wv.w; }
      pre[i] = wave_sum(s);
    }
    if (lane < 4) {
      float a = pre[0]; a = lane == 1 ? pre[1] : a; a = lane == 2 ? pre[2] : a; a = lane == 3 ? pre[3] : a;
      float f = pre[4]; f = lane == 1 ? pre[5] : f; f = lane == 2 ? pre[6] : f; f = lane == 3 ? pre[7] : f;
      p.ig()[(size_t)t * 4 + lane] = a + p.in[17][lane];
      const float z = f + p.in[17][4 + lane];
      p.lf()[(size_t)t * 4 + lane] = fminf(z, 0.f) - log1pf(expf(-fabsf(z)));
    }
  }
}

template <int MODE>
__device__ __forceinline__ void ph_rmsnorm(const Params& p, int l, int bid, int nblk) {
  const int lane = tid_opaque() & 63, w = __builtin_amdgcn_readfirstlane(tid_opaque() >> 6);
  const float* g = (MODE == 0) ? p.norm1_g() + l * 1024 : (MODE == 1 ? p.norm2_g() + l * 1024 : p.final_g());
  float4 gv[4];
#pragma unroll
  for (int j = 0; j < 4; ++j) gv[j] = reinterpret_cast<const float4*>(g)[lane + 64 * j];
  for (int t = bid * 4 + w; t < NTOK; t += nblk * 4) {
    const float* xr = (MODE == 0) ? xrow_in(p, l, t) : p.x() + (size_t)t * 1024;
    float4 xv[4];
    float ss = 0.f;
#pragma unroll
    for (int j = 0; j < 4; ++j) {
      xv[j] = reinterpret_cast<const float4*>(xr)[lane + 64 * j];
      ss += xv[j].x * xv[j].x + xv[j].y * xv[j].y + xv[j].z * xv[j].z + xv[j].w * xv[j].w;
    }
    ss = wave_sum(ss);
    float r = rsqrtf(ss * (1.f / 1024.f) + EPS);
#pragma unroll
    for (int j = 0; j < 4; ++j) {
      xv[j].x *= r * gv[j].x; xv[j].y *= r * gv[j].y; xv[j].z *= r * gv[j].z; xv[j].w *= r * gv[j].w;
    }
    if (MODE == 2) {
      float* o = (t < NPROMPT) ? p.out + O_Y_P + (size_t)t * 1024 : p.out + O_Y_S + (size_t)(t - NPROMPT) * 1024;
#pragma unroll
      for (int j = 0; j < 4; ++j) reinterpret_cast<float4*>(o)[lane + 64 * j] = xv[j];
    } else {
      uint2* o = reinterpret_cast<uint2*>(p.xn() + (size_t)t * 1024);
#pragma unroll
      for (int j = 0; j < 4; ++j) o[lane + 64 * j] = make_uint2(pack2(xv[j].x, xv[j].y), pack2(xv[j].z, xv[j].w));
    }
    if (MODE == 0) {
      float pre[8];
#pragma unroll
      for (int i = 0; i < 8; ++i) {
        const float4* wr = reinterpret_cast<const float4*>(p.wg() + ((size_t)l * 8 + i) * 1024);
        float s = 0.f;
#pragma unroll
        for (int j = 0; j < 4; ++j) {
          float4 wv = wr[lane + 64 * j];
          s += xv[j].x * wv.x + xv[j].y * wv.y + xv[j].z * wv.z + xv[j].w * wv.w;
        }
        pre[i] = wave_sum(s);
      }
      if (lane < 4) {
        float a = pre[0]; a = lane == 1 ? pre[1] : a; a = lane == 2 ? pre[2] : a; a = lane == 3 ? pre[3] : a;
        float f = pre[4]; f = lane == 1 ? pre[5] : f; f = lane == 2 ? pre[6] : f; f = lane == 3 ? pre[7] : f;
        p.ig()[(size_t)t * 4 + lane] = a + p.ml_gate_b()[l * 8 + lane];
        float z = f + p.ml_gate_b()[l * 8 + 4 + lane];
        p.lf()[(size_t)t * 4 + lane] = fminf(z, 0.f) - log1pf(expf(-fabsf(z)));
      }
    }
  }
}

__device__ __forceinline__ int mono_key(float v) { int b = __float_as_int(v); return b ^ ((b >> 31) & 0x7FFFFFFF); }
__device__ __forceinline__ float mono_val(int k) { int b = k ^ ((k >> 31) & 0x7FFFFFFF); return __int_as_float(b); }

__device__ __forceinline__ int med3i(int a, int b, int c) { return max(min(a, b), min(max(a, b), c)); }
#define INS16(L, kv)                                                          \
  {                                                                           \
    const int _v = (kv);                                                      \
    _Pragma("unroll") for (int _j = 15; _j >= 1; --_j) L[_j] = med3i(L[_j - 1], L[_j], _v); \
    L[0] = max(L[0], _v);                                                     \
  }


enum { EPI_WIN = 0, EPI_WOUT = 1, EPI_PQ = 2, EPI_SC = 3 };

template <int EPI>
__device__ __forceinline__ void gemm_store(const Params& p, int l, int t, int n, float v) {
  if (EPI == EPI_WOUT) {
    const float* xi = xrow_in(p, l, t);
    p.x()[(size_t)t * 1024 + n] = xi[n] + v;
  } else if (EPI == EPI_PQ) {
    p.qp()[(size_t)t * 2048 + n] = f2bf(v);
  } else if (EPI == EPI_SC) {
    p.sc()[(size_t)t * 2048 + n] = v;
  }
}

template <int EPI>
__device__ __forceinline__ void ph_gemm(const Params& p, int l, char* smem, int bid, int nblk) {
  constexpr int NT = (EPI == EPI_WIN) ? 22 : (EPI == EPI_WOUT ? 8 : 16);
  constexpr int MT = NTOK / 128;
  constexpr int K = (EPI == EPI_SC) ? 128 : 1024;
  constexpr int NK = K / 64;
  const bf16_t* A; int lda; const bf16_t* Bt; int ldb;
  if (EPI == EPI_WIN) { A = p.xn(); lda = 1024; Bt = p.wt_in() + (size_t)l * NIN * 1024; ldb = 1024; }
  else if (EPI == EPI_WOUT) { A = p.xn(); lda = 1024; Bt = p.wt_out() + (size_t)l * 1024 * 1024; ldb = 1024; }
  else if (EPI == EPI_PQ) { A = p.xn(); lda = 1024; Bt = p.wt_pq() + (size_t)l * 2048 * 1024; ldb = 1024; }
  else { A = p.qp(); lda = 2048; Bt = p.keysb() + (size_t)l * 16 * 128 * 128; ldb = 128; }

  const int tid = tid_opaque(), lane = tid & 63, w = __builtin_amdgcn_readfirstlane(tid >> 6);
  const int wm = w >> 1, wn = w & 1, lr = lane & 31, lh = lane >> 5;
  char* sA = smem;
  char* sB = smem + 32768;
  const int ld_c = tid & 7, ld_r = tid >> 3;

  const int nx = nblk >> 3;
  constexpr int FG = MT / 8, LR = MT % 8;
  for (int rnd = 0;; ++rnd) {
    const int q = (nblk & 7) ? rnd * nblk + bid : rnd * nblk + (bid & 7) * nx + (bid >> 3);
    if (q >= MT * NT) break;
    int mt, nt;
    if (q < FG * 8 * NT) { const int mg = q / (8 * NT), rem = q % (8 * NT); nt = rem >> 3; mt = mg * 8 + (rem & 7); }
    else { const int q2 = q - FG * 8 * NT; nt = q2 / (LR > 0 ? LR : 1); mt = FG * 8 + q2 % (LR > 0 ? LR : 1); }
    const bf16_t* Ag = A + (size_t)(mt * 128) * lda + ((EPI == EPI_SC) ? nt * 128 : 0);
    const bf16_t* Bg = Bt + (size_t)(nt * 128) * ldb;
    f32x16 acc[2][2];
#pragma unroll
    for (int i = 0; i < 2; ++i)
#pragma unroll
      for (int j = 0; j < 2; ++j)
#pragma unroll
        for (int r = 0; r < 16; ++r) acc[i][j][r] = 0.f;

    const int g_row = w * 32 + (lane >> 3);
    const int g_pc = lane & 7;
    const bf16_t* Ath = Ag + (size_t)g_row * lda;
    const bf16_t* Bth = Bg + (size_t)g_row * ldb;
#define GEMM_STAGE(KT, BUF)                                                                                          \
  _Pragma("unroll") for (int j = 0; j < 4; ++j) {                                                                    \
    const int row = g_row + 8 * j;                                                                                   \
    const int cch = g_pc ^ ((row >> 1) & 7);                                                                         \
    __builtin_amdgcn_global_load_lds((const unsigned*)(Ath + (size_t)(8 * j) * lda + (KT) * 64 + cch * 8),           \
                                     (LAS unsigned*)(sA + (BUF) * 16384 + (w * 4 + j) * 1024 + lane * 16), 16, 0, 0); \
    __builtin_amdgcn_global_load_lds((const unsigned*)(Bth + (size_t)(8 * j) * ldb + (KT) * 64 + cch * 8),           \
                                     (LAS unsigned*)(sB + (BUF) * 16384 + (w * 4 + j) * 1024 + lane * 16), 16, 0, 0); \
  }
    GEMM_STAGE(0, 0)
    __syncthreads();
    for (int kt = 0; kt < NK; ++kt) {
      const int buf = kt & 1;
      if (kt + 1 < NK) { GEMM_STAGE(kt + 1, buf ^ 1) }
      const char* cA = sA + buf * 16384;
      const char* cB = sB + buf * 16384;
#pragma unroll
      for (int ks = 0; ks < 4; ++ks) {
        bf16x8 af[2], bfr[2];
#pragma unroll
        for (int i = 0; i < 2; ++i) {
          int row = wm * 64 + i * 32 + lr; int pc = (ks * 2 + lh) ^ ((row >> 1) & 7);
          af[i] = as_bf16x8(*reinterpret_cast<const uint4*>(cA + row * 128 + pc * 16));
        }
#pragma unroll
        for (int j = 0; j < 2; ++j) {
          int row = wn * 64 + j * 32 + lr; int pc = (ks * 2 + lh) ^ ((row >> 1) & 7);
          bfr[j] = as_bf16x8(*reinterpret_cast<const uint4*>(cB + row * 128 + pc * 16));
        }
#pragma unroll
        for (int i = 0; i < 2; ++i)
#pragma unroll
          for (int j = 0; j < 2; ++j)
            acc[i][j] = __builtin_amdgcn_mfma_f32_32x32x16_bf16(af[i], bfr[j], acc[i][j], 0, 0, 0);
      }
      __syncthreads();
    }
    if (EPI == EPI_PQ) {
      int lane_q = lane; asm volatile("" : "+v"(lane_q));
      const int lr = lane_q & 31, lh = lane_q >> 5;
      char* sA2 = smem;
      char* sB2 = smem + 32768;
      const bf16_t* kg = p.keysb() + ((size_t)l * 16 + nt) * 128 * 128;
#pragma unroll
      for (int jj = 0; jj < 8; ++jj) {
        const int I = w * 8 + jj;
        const int row = I * 4 + (lane_q >> 4);
        const int cch = (lane_q & 15) ^ (row & 15);
        __builtin_amdgcn_global_load_lds((const unsigned*)(kg + (size_t)row * 128 + cch * 8),
                                         (LAS unsigned*)(sB2 + I * 1024 + lane_q * 16), 16, 0, 0);
      }
#pragma unroll
      for (int i = 0; i < 2; ++i) {
        float rs[16];
#pragma unroll
        for (int r = 0; r < 16; ++r) rs[r] = 0.f;
#pragma unroll
        for (int j = 0; j < 2; ++j) {
          const int n = wn * 64 + j * 32 + lr;
#pragma unroll
          for (int r = 0; r < 16; ++r) {
            const int row = wm * 64 + i * 32 + (r & 3) + 8 * (r >> 2) + 4 * lh;
            const float v = acc[i][j][r];
            rs[r] += v * v;
            *reinterpret_cast<bf16_t*>(sA2 + row * 256 + (((n >> 3) ^ (row & 15)) * 16) + (n & 7) * 2) = f2bf(v);
          }
        }
#pragma unroll
        for (int r = 0; r < 16; ++r) {
          const float s = swap16_sum(row16_sum(rs[r]));
          if (lr == 0) {
            const int t = mt * 128 + wm * 64 + i * 32 + (r & 3) + 8 * (r >> 2) + 4 * lh;
            p.ssp()[(size_t)t * 32 + nt * 2 + wn] = s;
          }
        }
      }
      __syncthreads();
      f32x16 sc2[2][2];
#pragma unroll
      for (int i = 0; i < 2; ++i)
#pragma unroll
        for (int j = 0; j < 2; ++j)
#pragma unroll
          for (int r = 0; r < 16; ++r) sc2[i][j][r] = 0.f;
#pragma unroll
      for (int ks = 0; ks < 8; ++ks) {
        bf16x8 af[2], bfr[2];
#pragma unroll
        for (int i = 0; i < 2; ++i) {
          const int row = wm * 64 + i * 32 + lr;
          af[i] = as_bf16x8(*reinterpret_cast<const uint4*>(sA2 + row * 256 + (((ks * 2 + lh) ^ (row & 15)) * 16)));
        }
#pragma unroll
        for (int j = 0; j < 2; ++j) {
          const int row = wn * 64 + j * 32 + lr;
          bfr[j] = as_bf16x8(*reinterpret_cast<const uint4*>(sB2 + row * 256 + (((ks * 2 + lh) ^ (row & 15)) * 16)));
        }
#pragma unroll
        for (int i = 0; i < 2; ++i)
#pragma unroll
          for (int j = 0; j < 2; ++j)
            sc2[i][j] = __builtin_amdgcn_mfma_f32_32x32x16_bf16(af[i], bfr[j], sc2[i][j], 0, 0, 0);
      }
      __syncthreads();
      float* sS = reinterpret_cast<float*>(smem);
#pragma unroll
      for (int i = 0; i < 2; ++i)
#pragma unroll
        for (int j = 0; j < 2; ++j)
#pragma unroll
          for (int r = 0; r < 16; ++r) {
            const int row = wm * 64 + i * 32 + (r & 3) + 8 * (r >> 2) + 4 * lh;
            sS[row * 129 + wn * 64 + j * 32 + lr] = sc2[i][j][r];
          }
      __syncthreads();
      {
        int tq = tid; asm volatile("" : "+v"(tq));
        const int tk = tq & 127, hl = tq >> 7;
        int L[16];
#pragma unroll
        for (int j = 0; j < 16; ++j) L[j] = (int)0x80000000;
        const float* srow = sS + tk * 129 + hl * 64;
#pragma unroll 4
        for (int s = 0; s < 64; ++s) {
          const int key = (mono_key(srow[s]) & ~127) | (127 - (hl * 64 + s));
          INS16(L, key)
        }
        int4* dst = reinterpret_cast<int4*>(p.tl() + (((size_t)(mt * 128 + tk) * 16 + nt) * 2 + hl) * 16);
        dst[0] = make_int4(L[0], L[1], L[2], L[3]); dst[1] = make_int4(L[4], L[5], L[6], L[7]);
        dst[2] = make_int4(L[8], L[9], L[10], L[11]); dst[3] = make_int4(L[12], L[13], L[14], L[15]);
      }
      __syncthreads();
    } else if (EPI != EPI_WIN) {
#pragma unroll
      for (int i = 0; i < 2; ++i)
#pragma unroll
        for (int j = 0; j < 2; ++j)
#pragma unroll
          for (int r = 0; r < 16; ++r) {
            int t = mt * 128 + wm * 64 + i * 32 + (r & 3) + 8 * (r >> 2) + 4 * lh;
            int n = nt * 128 + wn * 64 + j * 32 + lr;
            gemm_store<EPI>(p, l, t, n, acc[i][j][r]);
          }
    } else {
      const int seg = nt >> 2;
#pragma unroll
      for (int i = 0; i < 2; ++i)
#pragma unroll
        for (int j = 0; j < 2; ++j) {
          const int n = nt * 128 + wn * 64 + j * 32 + lr;
          if (nt < 4) {
#pragma unroll
            for (int r = 0; r < 16; ++r) {
              int t = mt * 128 + wm * 64 + i * 32 + (r & 3) + 8 * (r >> 2) + 4 * lh;
              p.Qb()[(size_t)t * 512 + n] = f2bf(acc[i][j][r] * (0.125f * LOG2E));
            }
          } else if (nt < 8) {
            const int n2 = n - 512;
#pragma unroll
            for (int r = 0; r < 16; ++r) {
              int t = mt * 128 + wm * 64 + i * 32 + (r & 3) + 8 * (r >> 2) + 4 * lh;
              float v = acc[i][j][r];
              if (t < NPROMPT) {
                p.out[O_K_P + (size_t)l * (4 * 4096 * 512) + (size_t)t * 512 + n2] = v;
                p.Kb()[(size_t)t * 512 + n2] = f2bf(v);
              } else {
                int ts = t - NPROMPT, b = ts >> 6, ii = ts & 63;
                p.out[O_K_S + (size_t)l * (8 * 64 * 512) + (size_t)ts * 512 + n2] = v;
                p.Kbs()[((size_t)(l * 8 + b) * SKEYS + 1024 + ii) * 512 + n2] = f2bf(v);
              }
            }
          } else if (nt < 12) {
            const int n2 = n - 1024, h = n2 >> 7, dv = n2 & 127;
#pragma unroll
            for (int rg = 0; rg < 4; ++rg) {
              int tb = mt * 128 + wm * 64 + i * 32 + 8 * rg + 4 * lh;
              float v0 = acc[i][j][rg * 4 + 0], v1 = acc[i][j][rg * 4 + 1], v2 = acc[i][j][rg * 4 + 2], v3 = acc[i][j][rg * 4 + 3];
              uint2 pk = make_uint2(pack2(v0, v1), pack2(v2, v3));
              int posblk = 2 * lh + (rg & 1);
              if (tb < NPROMPT) {
                float* o = p.out + O_V_P + (size_t)l * (4 * 4096 * 512) + (size_t)tb * 512 + n2;
                o[0] = v0; o[512] = v1; o[1024] = v2; o[1536] = v3;
                int b = tb >> 12, s = tb & 4095;
                int pos = (s & ~15) + posblk * 4;
                *reinterpret_cast<uint2*>(p.Vt() + ((size_t)(b * 4 + h) * 128 + dv) * SEQ + pos) = pk;
              } else {
                int ts = tb - NPROMPT, b = ts >> 6, ii = ts & 63;
                float* o = p.out + O_V_S + (size_t)l * (8 * 64 * 512) + (size_t)ts * 512 + n2;
                o[0] = v0; o[512] = v1; o[1024] = v2; o[1536] = v3;
                int pos = 1024 + (ii & ~15) + posblk * 4;
                *reinterpret_cast<uint2*>(p.Vts() + ((size_t)((l * 8 + b) * 4 + h) * 128 + dv) * SKEYS + pos) = pk;
              }
            }
          } else {
            const int n2 = n - 1536;
            const bool act = (n >= 2304);
#pragma unroll
            for (int r = 0; r < 16; ++r) {
              int t = mt * 128 + wm * 64 + i * 32 + (r & 3) + 8 * (r >> 2) + 4 * lh;
              float v = acc[i][j][r];
              if (act) v = gelu_as(v);
              p.P5()[(size_t)t * 1280 + n2] = v;
            }
          }
        }
      (void)seg;
    }
  }
}

struct WorkQ { unsigned* cnt; volatile int* slot; int off; };
__device__ __forceinline__ int wq_next(const WorkQ& q) {
  __syncthreads();
  if (threadIdx.x == 0) *q.slot = (int)__hip_atomic_fetch_add(q.cnt, 1u, __ATOMIC_RELAXED, __HIP_MEMORY_SCOPE_AGENT);
  __syncthreads();
  return __builtin_amdgcn_readfirstlane(*q.slot) - q.off;
}

template <bool CONV>
__device__ __forceinline__ int ph_attn(const Params& p, int l, char* smem, const WorkQ& wq) {
  const int tid = tid_opaque(), lane = tid & 63, w = __builtin_amdgcn_readfirstlane(tid >> 6);
  const int c = w >> 1, qhalf = w & 1, lr = lane & 31, lh = lane >> 5;
  float* sLut = reinterpret_cast<float*>(smem + 65536);
  float* sO2 = reinterpret_cast<float*>(smem);
  const float lam = p.lam()[l];
  const float lam_init = 0.8f - 0.6f * expf(-0.3f * (float)l);

  constexpr int NSLOT = CONV ? 1584 : 1056;
  int slot, uu;
  for (slot = wq_next(wq); slot < NSLOT; slot = wq_next(wq)) {
    if (CONV) {
      if (slot % 3 == 2) {
        const int ch = slot / 3, r0 = ch * 125;
        prep_table_rows(p, r0, (r0 + 125 < 65536) ? r0 + 125 : 65536, lane, w);
        continue;
      }
      uu = (slot / 3) * 2 + (slot % 3);
    } else uu = slot;
    int b, h, qc, S, qrow0; const bf16_t *Kbase, *Vbase;
    bool samp = false; int u2 = uu;
    if (uu >= 752 && uu < 784) samp = true; else if (uu >= 784) u2 = uu - 32;
    if (!samp) {
      qc = 63 - (u2 >> 4); int bh = u2 & 15; b = bh >> 2; h = bh & 3; S = SEQ;
      Kbase = p.Kb() + (size_t)b * SEQ * 512 + h * 128;
      Vbase = p.Vt() + (size_t)(b * 4 + h) * 128 * SEQ;
      qrow0 = b * SEQ + qc * 64;
    } else {
      int us = uu - 752; b = us >> 2; h = us & 3; qc = 16; S = SKEYS;
      Kbase = p.Kbs() + (size_t)(l * 8 + b) * SKEYS * 512 + h * 128;
      Vbase = p.Vts() + (size_t)((l * 8 + b) * 4 + h) * 128 * SKEYS;
      qrow0 = NPROMPT + b * 64;
    }
    const int ntiles = qc + 1;
    __syncthreads();
    sLut[tid] = p.lut()[h * 256 + tid];
    if (tid < 128) sLut[256 + tid] = p.da_subln_g()[l * 128 + tid];
    bf16x8 qf[4];
    {
      const bf16_t* qrow = p.Qb() + (size_t)(qrow0 + qhalf * 32 + lr) * 512 + h * 128 + c * 64 + lh * 8;
#pragma unroll
      for (int ks = 0; ks < 4; ++ks) qf[ks] = as_bf16x8(*reinterpret_cast<const uint4*>(qrow + ks * 16));
    }
    f32x16 o[4];
#pragma unroll
    for (int d = 0; d < 4; ++d)
#pragma unroll
      for (int r = 0; r < 16; ++r) o[d][r] = 0.f;
    float m_run = -1e30f, l_run = 0.f;

    const char* Kt = reinterpret_cast<const char*>(Kbase);
    const char* Vb = reinterpret_cast<const char*>(Vbase);
    const int g_r8 = lane >> 3, g_pc = lane & 7;
#define ATTN_STAGE(KT, BUF)                                                                                         \
  _Pragma("unroll") for (int j = 0; j < 4; ++j) {                                                                   \
    const int I = w * 4 + j;                                                                                        \
    const int rk = (I & 7) * 8 + g_r8;                                                                              \
    const unsigned kof = (unsigned)rk * 1024u + (unsigned)(I >> 3) * 128u + (unsigned)((g_pc ^ ((rk >> 1) & 7)) * 16); \
    __builtin_amdgcn_global_load_lds((const unsigned*)(Kt + (size_t)(KT) * 65536 + kof),                            \
                                     (LAS unsigned*)(smem + (BUF) * 32768 + I * 1024 + lane * 16), 16, 0, 0);       \
    const int rv = I * 8 + g_r8;                                                                                    \
    const unsigned vof = (unsigned)rv * (unsigned)(S * 2) + (unsigned)((g_pc ^ ((rv >> 1) & 7)) * 16);              \
    __builtin_amdgcn_global_load_lds((const unsigned*)(Vb + (size_t)(KT) * 128 + vof),                              \
                                     (LAS unsigned*)(smem + (BUF) * 32768 + 16384 + I * 1024 + lane * 16), 16, 0, 0); \
  }
    ATTN_STAGE(0, 0)
    __syncthreads();
    for (int kt = 0; kt < ntiles; ++kt) {
      const int buf = kt & 1;
      if (kt + 1 < ntiles) { ATTN_STAGE(kt + 1, buf ^ 1) }
      const char* sK = smem + buf * 32768;
      const char* sV = sK + 16384;
      f32x16 s[2];
      {
        bf16x8 kf[2][4];
#pragma unroll
        for (int kb = 0; kb < 2; ++kb)
#pragma unroll
          for (int ks = 0; ks < 4; ++ks) {
            int row = kb * 32 + lr; int pc = (ks * 2 + lh) ^ ((row >> 1) & 7);
            kf[kb][ks] = as_bf16x8(*reinterpret_cast<const uint4*>(sK + c * 8192 + row * 128 + pc * 16));
          }
#pragma unroll
        for (int kb = 0; kb < 2; ++kb) {
#pragma unroll
          for (int r = 0; r < 16; ++r) s[kb][r] = 0.f;
#pragma unroll
          for (int ks = 0; ks < 4; ++ks) s[kb] = __builtin_amdgcn_mfma_f32_32x32x16_bf16(kf[kb][ks], qf[ks], s[kb], 0, 0, 0);
        }
      }
      bf16x8 vfa[2][4];
#pragma unroll
      for (int k2 = 0; k2 < 2; ++k2)
#pragma unroll
        for (int d = 0; d < 4; ++d) {
          int row = d * 32 + lr; int pc = (k2 * 2 + lh) ^ ((row >> 1) & 7);
          vfa[k2][d] = as_bf16x8(*reinterpret_cast<const uint4*>(sV + row * 128 + pc * 16));
        }
      float boff = sLut[0];
      if (kt >= qc - 2) {
        const int base = (kt - qc) * 64 - (qhalf * 32 + lr) + 191 + 4 * lh;
#pragma unroll
        for (int kb = 0; kb < 2; ++kb)
#pragma unroll
          for (int r = 0; r < 16; ++r) s[kb][r] += sLut[base + kb * 32 + (r & 3) + 8 * (r >> 2)];
        boff = 0.f;
      }
      float mx = s[0][0];
#pragma unroll
      for (int kb = 0; kb < 2; ++kb)
#pragma unroll
        for (int r = 0; r < 16; ++r) mx = fmaxf(mx, s[kb][r]);
      mx = swap32_max(mx) + boff;
      if (__any(mx > m_run)) {
        const float m_new = fmaxf(m_run, mx);
        const float alpha = __builtin_amdgcn_exp2f(m_run - m_new);
        m_run = m_new;
        l_run *= alpha;
#pragma unroll
        for (int d = 0; d < 4; ++d)
#pragma unroll
          for (int r = 0; r < 16; ++r) o[d][r] *= alpha;
      }
      const float eoff = boff - m_run;
      float ps = 0.f;
#pragma unroll
      for (int kb = 0; kb < 2; ++kb)
#pragma unroll
        for (int r = 0; r < 16; ++r) { float pv = __builtin_amdgcn_exp2f(s[kb][r] + eoff); s[kb][r] = pv; ps += pv; }
      l_run += ps;
      bf16x8 pf[4];
#pragma unroll
      for (int ks2 = 0; ks2 < 4; ++ks2) {
        const int kb = ks2 >> 1, sh = (ks2 & 1) * 8;
        uint4 pw = make_uint4(pack2(s[kb][sh + 0], s[kb][sh + 1]), pack2(s[kb][sh + 2], s[kb][sh + 3]),
                              pack2(s[kb][sh + 4], s[kb][sh + 5]), pack2(s[kb][sh + 6], s[kb][sh + 7]));
        pf[ks2] = as_bf16x8(pw);
      }
#define ATTN_VREAD(DST, K2)                                                                        \
  _Pragma("unroll") for (int d = 0; d < 4; ++d) {                                                  \
    int row = d * 32 + lr; int pc = ((K2) * 2 + lh) ^ ((row >> 1) & 7);                            \
    DST[d] = as_bf16x8(*reinterpret_cast<const uint4*>(sV + row * 128 + pc * 16));                 \
  }
#define ATTN_PV(SRC, K2) \
  _Pragma("unroll") for (int d = 0; d < 4; ++d) o[d] = __builtin_amdgcn_mfma_f32_32x32x16_bf16(SRC[d], pf[K2], o[d], 0, 0, 0);
      bf16x8 vfc[4];
      ATTN_VREAD(vfc, 2)
      ATTN_PV(vfa[0], 0)
      ATTN_VREAD(vfa[0], 3)
      ATTN_PV(vfa[1], 1)
      ATTN_PV(vfc, 2)
      ATTN_PV(vfa[0], 3)
      __syncthreads();
    }
    int lane_e = (int)__builtin_amdgcn_mbcnt_hi(~0u, __builtin_amdgcn_mbcnt_lo(~0u, 0u)); asm volatile("" : "+v"(lane_e));
    const int lr_e = lane_e & 31, lh_e = lane_e >> 5;
    float lt = swap32_sum(l_run);
    float inv = 1.f / lt;
    __syncthreads();
    if (c == 1) {
#pragma unroll
      for (int d = 0; d < 4; ++d)
#pragma unroll
        for (int r = 0; r < 16; ++r) sO2[(qhalf * 64 + d * 16 + r) * 64 + lane_e] = o[d][r] * inv;
    }
    __syncthreads();
    if (c == 0) {
      float ss = 0.f;
#pragma unroll
      for (int d = 0; d < 4; ++d)
#pragma unroll
        for (int r = 0; r < 16; ++r) {
          float v = o[d][r] * inv - lam * sO2[(qhalf * 64 + d * 16 + r) * 64 + lane_e];
          o[d][r] = v; ss += v * v;
        }
      ss = swap32_sum(ss);
      const float rn = rsqrtf(ss * (1.f / 128.f) + EPS) * (1.f - lam_init);
      const float* gs = sLut + 256;
      bf16_t* orow = p.xn() + (size_t)(qrow0 + qhalf * 32 + lr_e) * 1024 + h * 128;
#pragma unroll
      for (int d = 0; d < 4; ++d)
#pragma unroll
        for (int rg = 0; rg < 4; ++rg) {
          int dv = d * 32 + 8 * rg + 4 * lh_e;
          float4 g4 = *reinterpret_cast<const float4*>(gs + dv);
          uint2 pk = make_uint2(pack2(o[d][rg * 4 + 0] * rn * g4.x, o[d][rg * 4 + 1] * rn * g4.y),
                                pack2(o[d][rg * 4 + 2] * rn * g4.z, o[d][rg * 4 + 3] * rn * g4.w));
          *reinterpret_cast<uint2*>(orow + dv) = pk;
        }
    }
  }
  return slot - NSLOT + 1056;
}

template <int K>
__device__ __forceinline__ void mfma32_f32(f32x16& acc, const float* a, int a_rs, int a_ks, const float* b, int b_ks, int b_js, int lane) {
  const float* ap = a + (lane & 31) * a_rs + (lane >> 5) * a_ks;
  const float* bp = b + (lane >> 5) * b_ks + (lane & 31) * b_js;
#pragma unroll 8
  for (int k = 0; k < K; k += 2) acc = __builtin_amdgcn_mfma_f32_32x32x2f32(ap[k * a_ks], bp[k * b_ks], acc, 0, 0, 0);
}
__device__ __forceinline__ void zero16(f32x16& a) {
#pragma unroll
  for (int r = 0; r < 16; ++r) a[r] = 0.f;
}

__device__ __forceinline__ int ph_mlconv(const Params& p, int l, char* smem, const WorkQ& wq, int item) {
  const int tid = tid_opaque();
  float* s_mc = reinterpret_cast<float*>(smem);
  float* s_cc = s_mc + 67 * 64;
  float* s_wq = s_cc + 64 * 65;
  float* s_wk = s_wq + 4096;
  for (; item < 1056 + 264 * 4; item = wq_next(wq)) {
    const int u = item - 1056;
    const int ci = u >> 2, h = u & 3;
    int token0, bq; bool samp = ci >= 256;
    if (!samp) token0 = ci * 64; else token0 = NPROMPT + (ci - 256) * 64;
    bq = samp ? (ci - 256) : (ci >> 6);
    const int cidx = samp ? 0 : (ci & 63);
    __syncthreads();
    for (int i = tid; i < 67 * 64; i += 256) {
      int r = i >> 6, d = i & 63;
      float v;
      if (r >= 3) v = p.P5()[(size_t)(token0 + r - 3) * 1280 + h * 64 + d];
      else if (samp) v = p.st_conv()[((size_t)(l * 8 + bq) * 3 + r) * 256 + h * 64 + d];
      else if (cidx == 0) v = 0.f;
      else v = p.P5()[(size_t)(token0 + r - 3) * 1280 + h * 64 + d];
      s_mc[i] = v;
    }
    for (int i = tid; i < 4096; i += 256) {
      s_wq[i] = p.ml_wq()[(size_t)(l * 4 + h) * 4096 + i];
      s_wk[i] = p.ml_wk()[(size_t)(l * 4 + h) * 4096 + i];
    }
    __syncthreads();
    {
      const int d = tid & 63, t0 = tid >> 6;
      const int ch = h * 64 + d;
      const float w0 = p.ml_conv_w()[(l * 4 + 0) * 256 + ch], w1 = p.ml_conv_w()[(l * 4 + 1) * 256 + ch];
      const float w2 = p.ml_conv_w()[(l * 4 + 2) * 256 + ch], w3 = p.ml_conv_w()[(l * 4 + 3) * 256 + ch];
      const float bb = p.ml_conv_b()[l * 256 + ch];
      for (int t = t0; t < 64; t += 4) {
        float y = bb + w0 * s_mc[t * 64 + d] + w1 * s_mc[(t + 1) * 64 + d] + w2 * s_mc[(t + 2) * 64 + d] + w3 * s_mc[(t + 3) * 64 + d];
        y = y * sigmoidf_(y);
        s_cc[t * 65 + d] = y;
        p.cc()[(size_t)(token0 + t) * 256 + ch] = y;
      }
      if (samp || cidx == 63) {
        if (tid < 192) {
          int r = tid >> 6;
          float v = s_mc[(64 + r) * 64 + d];
          if (samp) p.out[O_CONV_S + ((size_t)(l * 8 + bq) * 3 + r) * 256 + ch] = v;
          else p.out[O_CONV_P + ((size_t)(l * 4 + bq) * 3 + r) * 256 + ch] = v;
        }
      }
    }
    __syncthreads();
    {
      const int lane = tid & 63, w = __builtin_amdgcn_readfirstlane(tid >> 6), ti = w >> 1, tj = w & 1;
      f32x16 aq, ak; zero16(aq); zero16(ak);
      mfma32_f32<64>(aq, s_cc + ti * 32 * 65, 65, 1, s_wq + tj * 32, 64, 1, lane);
      mfma32_f32<64>(ak, s_cc + ti * 32 * 65, 65, 1, s_wk + tj * 32, 64, 1, lane);
#pragma unroll
      for (int r = 0; r < 16; ++r) {
        const int t = ti * 32 + (r & 3) + 8 * (r >> 2) + 4 * (lane >> 5);
        const size_t o = (size_t)(token0 + t) * 256 + h * 64 + tj * 32 + (lane & 31);
        p.qm()[o] = aq[r];
        p.km()[o] = ak[r] * 0.125f;
      }
      if (w == 0) {
        const int t = token0 + lane;
        const float lfv = p.lf()[(size_t)t * 4 + h], igv = p.ig()[(size_t)t * 4 + h];
        float F = lfv;
#pragma unroll
        for (int d = 1; d < 64; d <<= 1) { float n = shfl_up_l(F, d, lane); if (lane >= d) F += n; }
        const float FL = __int_as_float(__builtin_amdgcn_readlane(__float_as_int(F), 63));
        const float mx = wave_max(FL - F + igv);
        p.Fc()[(size_t)t * 4 + h] = F;
        if (lane == 0) {
          const int cu = samp ? 1024 + bq * 4 + h : (bq * 4 + h) * 64 + cidx;
          p.FLs()[cu] = FL; p.mxt()[cu] = mx;
        }
      }
    }
  }
  return item;
}

__device__ __forceinline__ void cu_decode(int cu, int& token0, int& h) {
  if (cu < 1024) { int bh = cu >> 6, c = cu & 63; token0 = (bh >> 2) * SEQ + c * 64; h = bh & 3; }
  else { int us = cu - 1024; token0 = NPROMPT + (us >> 2) * 64; h = us & 3; }
}

__device__ __forceinline__ void ph_mlU(const Params& p, int l, char* smem, int bid, int nblk) {
  const int tid = tid_opaque();
  const int lane = tid & 63, w = __builtin_amdgcn_readfirstlane(tid >> 6), ti = w >> 1, tj = w & 1;
  float* s_k = reinterpret_cast<float*>(smem);
  float* s_v = s_k + 4096;
  for (int cu = bid; cu < NCU_UNITS; cu += nblk) {
    int token0, h; cu_decode(cu, token0, h);
    float m0, mn, FL;
    {
      const bool samp = cu >= 1024;
      const int cu0 = samp ? cu : (cu & ~63), c = samp ? 0 : (cu & 63);
      float flv = 0.f, mxv = 0.f;
      if (lane <= c) { flv = p.FLs()[cu0 + lane]; mxv = p.mxt()[cu0 + lane]; }
      float m = samp ? p.st_m()[l * 32 + (cu - 1024)] : 0.f;
      for (int j = 0; j < c; ++j) {
        const float fj = __int_as_float(__builtin_amdgcn_readlane(__float_as_int(flv), j));
        const float xj = __int_as_float(__builtin_amdgcn_readlane(__float_as_int(mxv), j));
        m = fmaxf(fj + m, xj);
      }
      FL = __int_as_float(__builtin_amdgcn_readlane(__float_as_int(flv), c));
      const float xc = __int_as_float(__builtin_amdgcn_readlane(__float_as_int(mxv), c));
      m0 = m; mn = fmaxf(FL + m, xc);
      if (tid == 0) {
        p.mst()[cu] = m0; p.mnx()[cu] = mn; p.wcs()[cu] = expf(FL + m0 - mn);
        if (samp) p.out[O_M_S + l * 32 + (cu - 1024)] = mn;
        else if (c == 63) p.out[O_M_P + l * 16 + (cu >> 6)] = mn;
      }
    }
    __syncthreads();
    for (int i = tid; i < 1024; i += 256) {
      int s = i >> 4, d4 = (i & 15) * 4;
      const int t = token0 + s;
      float wsv = expf(FL - p.Fc()[(size_t)t * 4 + h] + p.ig()[(size_t)t * 4 + h] - mn);
      float4 k4 = *reinterpret_cast<const float4*>(p.km() + (size_t)t * 256 + h * 64 + d4);
      float4 v4 = *reinterpret_cast<const float4*>(p.P5() + (size_t)t * 1280 + 256 + h * 64 + d4);
      *reinterpret_cast<float4*>(s_k + s * 64 + d4) = make_float4(k4.x * wsv, k4.y * wsv, k4.z * wsv, k4.w * wsv);
      *reinterpret_cast<float4*>(s_v + s * 64 + d4) = v4;
    }
    __syncthreads();
    f32x16 acc; zero16(acc);
    mfma32_f32<64>(acc, s_k + ti * 32, 1, 64, s_v + tj * 32, 64, 1, lane);
#pragma unroll
    for (int r = 0; r < 16; ++r) {
      const int d = ti * 32 + (r & 3) + 8 * (r >> 2) + 4 * (lane >> 5);
      p.U()[(size_t)cu * 4096 + d * 64 + tj * 32 + (lane & 31)] = acc[r];
    }
    if (tid < 64) {
      float s0 = 0.f;
      for (int s = 0; s < 64; ++s) s0 += s_k[s * 64 + tid];
      p.un()[(size_t)cu * 64 + tid] = s0;
    }
  }
}

__device__ __forceinline__ void ph_mlscan(const Params& p, int l, int bid, int nblk) {
  const size_t gtid = (size_t)bid * 256 + tid_opaque(), gsz = (size_t)nblk * 256;
  const size_t NPC = 16 * 4096, NSC = 32 * 4096, NPN = 16 * 64, NSN = 32 * 64;
  for (size_t i = gtid; i < NPC + NSC + NPN + NSN; i += gsz) {
    if (i < NPC) {
      int bh = (int)(i >> 12), e = (int)(i & 4095);
      float C = 0.f;
      for (int c = 0; c < 64; ++c) {
        int cu = bh * 64 + c;
        p.Cst()[(size_t)cu * 4096 + e] = C;
        C = p.wcs()[cu] * C + p.U()[(size_t)cu * 4096 + e];
      }
      p.out[O_C_P + (size_t)l * (16 * 4096) + i] = C;
    } else if (i < NPC + NSC) {
      size_t j = i - NPC; int us = (int)(j >> 12), e = (int)(j & 4095); int cu = 1024 + us;
      float C = p.st_c()[(size_t)l * (32 * 4096) + j];
      p.Cst()[(size_t)cu * 4096 + e] = C;
      p.out[O_C_S + (size_t)l * (32 * 4096) + j] = p.wcs()[cu] * C + p.U()[(size_t)cu * 4096 + e];
    } else if (i < NPC + NSC + NPN) {
      size_t j = i - NPC - NSC; int bh = (int)(j >> 6), d = (int)(j & 63);
      float n = 0.f;
      for (int c = 0; c < 64; ++c) {
        int cu = bh * 64 + c;
        p.nst()[(size_t)cu * 64 + d] = n;
        n = p.wcs()[cu] * n + p.un()[(size_t)cu * 64 + d];
      }
      p.out[O_N_P + (size_t)l * (16 * 64) + j] = n;
    } else {
      size_t j = i - NPC - NSC - NPN; int us = (int)(j >> 6), d = (int)(j & 63); int cu = 1024 + us;
      float n = p.st_n()[(size_t)l * (32 * 64) + j];
      p.nst()[(size_t)cu * 64 + d] = n;
      p.out[O_N_S + (size_t)l * (32 * 64) + j] = p.wcs()[cu] * n + p.un()[(size_t)cu * 64 + d];
    }
  }
}

__device__ __forceinline__ void ph_mlout(const Params& p, int l, char* smem, int bid, int nblk) {
  const int tid = tid_opaque();
  float* s_q = reinterpret_cast<float*>(smem);
  float* s_k = s_q + 64 * 65;
  float* s_v = s_k + 64 * 65;
  float* s_C = s_v + 4096;
  float* s_F = s_C + 4096;
  float* s_a = s_F + 64;
  float* s_mt = s_a + 64;
  float* s_iw = s_mt + 64;
  float* s_n = s_iw + 64;
  float* s_den = s_n + 64;
  float* s_denp = s_den + 64;
  float* s_qn = s_denp + 128;
  for (int cu = bid; cu < NCU_UNITS; cu += nblk) {
    int token0, h; cu_decode(cu, token0, h);
    const float m0 = p.mst()[cu];
    __syncthreads();
    for (int i = tid; i < 1024; i += 256) {
      int s = i >> 4, d4 = (i & 15) * 4;
      const int t = token0 + s;
      float4 q4 = *reinterpret_cast<const float4*>(p.qm() + (size_t)t * 256 + h * 64 + d4);
      float4 k4 = *reinterpret_cast<const float4*>(p.km() + (size_t)t * 256 + h * 64 + d4);
      float4 v4 = *reinterpret_cast<const float4*>(p.P5() + (size_t)t * 1280 + 256 + h * 64 + d4);
      float4 c4 = *reinterpret_cast<const float4*>(p.Cst() + (size_t)cu * 4096 + s * 64 + d4);
      s_q[s * 65 + d4] = q4.x; s_q[s * 65 + d4 + 1] = q4.y; s_q[s * 65 + d4 + 2] = q4.z; s_q[s * 65 + d4 + 3] = q4.w;
      s_k[s * 65 + d4] = k4.x; s_k[s * 65 + d4 + 1] = k4.y; s_k[s * 65 + d4 + 2] = k4.z; s_k[s * 65 + d4 + 3] = k4.w;
      *reinterpret_cast<float4*>(s_v + s * 64 + d4) = v4;
      *reinterpret_cast<float4*>(s_C + s * 64 + d4) = c4;
    }
    if (tid < 64) {
      const int t = token0 + tid;
      float F = p.Fc()[(size_t)t * 4 + h], g = p.ig()[(size_t)t * 4 + h];
      s_F[tid] = F; s_a[tid] = g - F;
      s_n[tid] = p.nst()[(size_t)cu * 64 + tid];
    }
    __syncthreads();
    if (tid < 64) {
      float pm = s_a[tid];
#pragma unroll
      for (int d = 1; d < 64; d <<= 1) { const float o = shfl_up_l(pm, d, tid); if (tid >= d) pm = fmaxf(pm, o); }
      float F = s_F[tid];
      float mt = F + fmaxf(m0, pm);
      s_mt[tid] = mt;
      s_iw[tid] = expf(F + m0 - mt);
    }
    __syncthreads();
    const int lane = tid & 63, w = __builtin_amdgcn_readfirstlane(tid >> 6), ti = w >> 1, tj = w & 1;
    const int ty = tid >> 4, tx = tid & 15;
    {
      f32x16 accS; zero16(accS);
      mfma32_f32<64>(accS, s_q + ti * 32 * 65, 65, 1, s_k + tj * 32 * 65, 1, 65, lane);
      __syncthreads();
      const int s = tj * 32 + (lane & 31);
      const float as = s_a[s];
#pragma unroll
      for (int r = 0; r < 16; ++r) {
        const int t = ti * 32 + (r & 3) + 8 * (r >> 2) + 4 * (lane >> 5);
        const float sw = (s <= t) ? accS[r] * expf(s_F[t] + as - s_mt[t]) : 0.f;
        s_k[t * 65 + s] = sw;
        const float rsum = swap16_sum(row16_sum(sw));
        if ((lane & 31) == 0) s_denp[tj * 64 + t] = rsum;
      }
    }
    {
      const int t = tid >> 2, part = tid & 3;
      float qn = 0.f;
#pragma unroll
      for (int d = 0; d < 16; ++d) qn += s_q[t * 65 + part * 16 + d] * s_n[part * 16 + d];
      qn += dpp_f<0xB1>(qn); qn += dpp_f<0x4E>(qn);
      if (part == 0) s_qn[t] = qn;
    }
    __syncthreads();
    if (tid < 64) s_den[tid] = s_denp[tid] + s_denp[64 + tid] + s_iw[tid] * s_qn[tid];
    {
      f32x16 accN, accC; zero16(accN); zero16(accC);
      mfma32_f32<64>(accN, s_k + ti * 32 * 65, 65, 1, s_v + tj * 32, 64, 1, lane);
      mfma32_f32<64>(accC, s_q + ti * 32 * 65, 65, 1, s_C + tj * 32, 64, 1, lane);
      __syncthreads();
#pragma unroll
      for (int r = 0; r < 16; ++r) {
        const int t = ti * 32 + (r & 3) + 8 * (r >> 2) + 4 * (lane >> 5);
        s_q[t * 65 + tj * 32 + (lane & 31)] = accN[r] + s_iw[t] * accC[r];
      }
    }
    __syncthreads();
#pragma unroll
    for (int i = 0; i < 4; ++i) {
      const int t = ty * 4 + i;
      const float dn = fmaxf(fabsf(s_den[t]), expf(-s_mt[t]));
      float hv[4]; float ss = 0.f;
#pragma unroll
      for (int j = 0; j < 4; ++j) { hv[j] = s_q[t * 65 + tx * 4 + j] / dn; ss += hv[j] * hv[j]; }
      ss = row16_sum(ss);
      const float rn = rsqrtf(ss * (1.f / 64.f) + EPS);
      const int ch = h * 64 + tx * 4;
      const size_t tg = (size_t)(token0 + t);
      float4 g4 = *reinterpret_cast<const float4*>(p.ml_norm_g() + l * 256 + ch);
      float4 k4 = *reinterpret_cast<const float4*>(p.ml_skip() + l * 256 + ch);
      float4 c4 = *reinterpret_cast<const float4*>(p.cc() + tg * 256 + ch);
      float4 o4 = *reinterpret_cast<const float4*>(p.P5() + tg * 1280 + 512 + ch);
      float r0 = (hv[0] * rn * g4.x + k4.x * c4.x) * sigmoidf_(o4.x);
      float r1 = (hv[1] * rn * g4.y + k4.y * c4.y) * sigmoidf_(o4.y);
      float r2 = (hv[2] * rn * g4.z + k4.z * c4.z) * sigmoidf_(o4.z);
      float r3 = (hv[3] * rn * g4.w + k4.w * c4.w) * sigmoidf_(o4.w);
      *reinterpret_cast<uint2*>(p.xn() + tg * 1024 + 512 + ch) = make_uint2(pack2(r0, r1), pack2(r2, r3));
    }
  }
}

__device__ __forceinline__ void ph_cmlp(const Params& p, int l, char* smem, const WorkQ& wq, int item) {
  const int tid = tid_opaque(), lane = tid & 63, w = __builtin_amdgcn_readfirstlane(tid >> 6);
  float* s_vg = reinterpret_cast<float*>(smem);
  float* s_ws = s_vg + 128 * 64;
  float* s_r = s_ws + 128 * 33;
  for (; item < 1056 + 264 * 4 + 544; item = wq_next(wq)) {
    const int u = item - (1056 + 264 * 4);
    const int g = u & 3, ci = u >> 2;
    const bool samp = ci >= 128;
    const int L = samp ? 64 : 128;
    const int token0 = samp ? NPROMPT + (ci - 128) * 64 : ci * 128;
    __syncthreads();
    for (int r = w; r < L; r += 4) {
      float4 v = *reinterpret_cast<const float4*>(p.P5() + (size_t)(token0 + r) * 1280 + 1024 + lane * 4);
      float ss = v.x * v.x + v.y * v.y + v.z * v.z + v.w * v.w;
      ss = wave_sum(ss);
      if (lane == 0) s_r[r] = rsqrtf(ss * (1.f / 256.f) + EPS);
    }
    __syncthreads();
    for (int i = tid; i < L * 16; i += 256) {
      int s = i >> 4, d4 = (i & 15) * 4;
      float4 v = *reinterpret_cast<const float4*>(p.P5() + (size_t)(token0 + s) * 1280 + 1024 + g * 64 + d4);
      float4 gn = *reinterpret_cast<const float4*>(p.cm_norm_g() + l * 256 + g * 64 + d4);
      float r = s_r[s];
      float4 o = make_float4(v.x * r * gn.x, v.y * r * gn.y, v.z * r * gn.z, v.w * r * gn.w);
      *reinterpret_cast<float4*>(s_vg + s * 64 + d4) = o;
      if (samp) {
        int ts = token0 - NPROMPT + s;
        *reinterpret_cast<float4*>(p.out + O_CMV_S + (size_t)l * (512 * 256) + (size_t)ts * 256 + g * 64 + d4) = o;
      }
    }
    const int rtA = (w < 2) ? 3 : 2, rtB = (w < 2) ? 0 : 1, ct = w & 1;
    const int nrt = L >> 5;
    f32x16 accA, accB; zero16(accA); zero16(accB);
    const float* wsg = p.cm_ws() + (size_t)(l * 4 + g) * 128 * 128;
    for (int s0 = 0; s0 < L; s0 += 32) {
      __syncthreads();
      for (int i = tid; i < L * 32; i += 256) {
        int t = i >> 5, ss = i & 31;
        s_ws[t * 33 + ss] = (s0 + ss <= t) ? wsg[t * 128 + s0 + ss] : 0.f;
      }
      __syncthreads();
      const int c = s0 >> 5;
      if (rtA < nrt && c <= rtA) mfma32_f32<32>(accA, s_ws + rtA * 32 * 33, 33, 1, s_vg + s0 * 64 + ct * 32, 64, 1, lane);
      if (rtB < nrt && c <= rtB) mfma32_f32<32>(accB, s_ws + rtB * 32 * 33, 33, 1, s_vg + s0 * 64 + ct * 32, 64, 1, lane);
    }
    __syncthreads();
#pragma unroll
    for (int r = 0; r < 16; ++r) {
      const int tr = (r & 3) + 8 * (r >> 2) + 4 * (lane >> 5);
      if (rtA < nrt) s_vg[(rtA * 32 + tr) * 64 + ct * 32 + (lane & 31)] = accA[r];
      if (rtB < nrt) s_vg[(rtB * 32 + tr) * 64 + ct * 32 + (lane & 31)] = accB[r];
    }
    __syncthreads();
    {
      const int ty = tid >> 4, tx = tid & 15;
      if (ty * 8 < L) {
#pragma unroll
        for (int i = 0; i < 8; ++i) {
          const int t = ty * 8 + i;
          const float bb = p.cm_b()[(l * 4 + g) * 128 + t];
          const size_t tg = (size_t)(token0 + t);
          float4 a4 = *reinterpret_cast<const float4*>(s_vg + t * 64 + tx * 4);
          float4 u4 = *reinterpret_cast<const float4*>(p.P5() + tg * 1280 + 768 + g * 64 + tx * 4);
          *reinterpret_cast<uint2*>(p.xn() + tg * 1024 + 768 + g * 64 + tx * 4) =
              make_uint2(pack2(u4.x * (a4.x + bb), u4.y * (a4.y + bb)), pack2(u4.z * (a4.z + bb), u4.w * (a4.w + bb)));
        }
      }
    }
  }
}

__device__ __forceinline__ void ph_topk(const Params& p, int l, char* smem, int bid, int nblk) {
  const int tid = tid_opaque(), lane = tid & 63, w = __builtin_amdgcn_readfirstlane(tid >> 6);
  float* s_tile = reinterpret_cast<float*>(smem) + w * (64 * 33);
  int* s_list = reinterpret_cast<int*>(smem + 4 * 64 * 33 * 4) + w * (2 * 16 * 64);
  float* s_ss = reinterpret_cast<float*>(smem + 4 * 64 * 33 * 4 + 4 * 2 * 16 * 64 * 4) + w * 64;
  for (int u = bid * 4 + w; u < 264 * 8; u += nblk * 4) {
    const int tg = u >> 3, h = u & 7;
    const int t0 = tg * 64;
    {
      const float4 pp = *reinterpret_cast<const float4*>(p.ssp() + (size_t)(t0 + lane) * 32 + h * 4);
      s_ss[lane] = pp.x + pp.y + pp.z + pp.w;
    }
    int L1[16], L2[16];
#pragma unroll
    for (int j = 0; j < 16; ++j) { L1[j] = (int)0x80000000; L2[j] = (int)0x80000000; }
#pragma unroll
    for (int c = 0; c < 2; ++c) {
      const int4* la = reinterpret_cast<const int4*>(p.tl() + (((size_t)(t0 + lane) * 16 + h * 2 + c) * 2) * 16);
      int A[16], B[16];
#pragma unroll
      for (int q = 0; q < 4; ++q) {
        const int4 a = la[q], b = la[4 + q];
        A[4 * q] = a.x; A[4 * q + 1] = a.y; A[4 * q + 2] = a.z; A[4 * q + 3] = a.w;
        B[4 * q] = b.x; B[4 * q + 1] = b.y; B[4 * q + 2] = b.z; B[4 * q + 3] = b.w;
      }
#pragma unroll
      for (int j = 0; j < 16; ++j) INS16(A, B[j])
#pragma unroll
      for (int j = 0; j < 16; ++j) { if (c == 0) L1[j] = A[j]; else L2[j] = A[j]; }
    }
#pragma unroll
    for (int j = 0; j < 16; ++j) { s_list[(0 * 16 + j) * 64 + lane] = 127 - (L1[j] & 127); s_list[(1 * 16 + j) * 64 + lane] = 127 - (L2[j] & 127); }
    float v1[16], v2[16];
#pragma unroll
    for (int j = 0; j < 16; ++j) { v1[j] = mono_val(L1[j] & ~127); v2[j] = mono_val(L2[j] & ~127); }
    int LC[16];
#pragma unroll
    for (int j = 0; j < 16; ++j) LC[j] = (int)0x80000000;
#pragma unroll
    for (int i = 0; i < 16; ++i)
#pragma unroll
      for (int j = 0; j < 16; ++j)
        if ((i + 1) * (j + 1) <= 16) {
          int key = (mono_key(v1[i] + v2[j]) & ~255) | (255 - (i * 16 + j));
          INS16(LC, key)
        }
    const float scale = rsqrtf(s_ss[lane] * (1.f / 256.f) + EPS);
    float vs[16]; float den = 0.f;
    const float top = mono_val(LC[0] & ~255);
#pragma unroll
    for (int k = 0; k < 16; ++k) { vs[k] = __expf((mono_val(LC[k] & ~255) - top) * scale); den += vs[k]; }
    const float inv = 1.f / den;
    const size_t ob = (size_t)(t0 + lane) * 128 + h * 16;
#pragma unroll
    for (int k4 = 0; k4 < 4; ++k4) {
      int ee[4]; float gg[4], su[4];
#pragma unroll
      for (int q = 0; q < 4; ++q) {
        int k = k4 * 4 + q;
        int ci = 255 - (LC[k] & 255);
        int i1 = s_list[(0 * 16 + (ci >> 4)) * 64 + lane];
        int i2 = s_list[(1 * 16 + (ci & 15)) * 64 + lane];
        ee[q] = i1 * 128 + i2;
        gg[q] = vs[k] * inv * p.vs()[l * 16384 + ee[q]];
        su[q] = p.us()[l * 16384 + ee[q]];
      }
      *reinterpret_cast<int4*>(p.eidx() + ob + k4 * 4) = make_int4(ee[0], ee[1], ee[2], ee[3]);
      *reinterpret_cast<float4*>(p.egate() + ob + k4 * 4) = make_float4(gg[0], gg[1], gg[2], gg[3]);
      *reinterpret_cast<float4*>(p.esu() + ob + k4 * 4) = make_float4(su[0], su[1], su[2], su[3]);
    }
  }
}

__device__ __forceinline__ float dot16_fp8(const float* xf, uint4 u) {
  f32x2 a0 = __builtin_amdgcn_cvt_pk_f32_fp8(u.x, false), a1 = __builtin_amdgcn_cvt_pk_f32_fp8(u.x, true);
  f32x2 a2 = __builtin_amdgcn_cvt_pk_f32_fp8(u.y, false), a3 = __builtin_amdgcn_cvt_pk_f32_fp8(u.y, true);
  f32x2 a4 = __builtin_amdgcn_cvt_pk_f32_fp8(u.z, false), a5 = __builtin_amdgcn_cvt_pk_f32_fp8(u.z, true);
  f32x2 a6 = __builtin_amdgcn_cvt_pk_f32_fp8(u.w, false), a7 = __builtin_amdgcn_cvt_pk_f32_fp8(u.w, true);
  float s0 = xf[0] * a0.x, s1 = xf[1] * a0.y;
  s0 = fmaf(xf[2], a1.x, s0); s1 = fmaf(xf[3], a1.y, s1);
  s0 = fmaf(xf[4], a2.x, s0); s1 = fmaf(xf[5], a2.y, s1);
  s0 = fmaf(xf[6], a3.x, s0); s1 = fmaf(xf[7], a3.y, s1);
  s0 = fmaf(xf[8], a4.x, s0); s1 = fmaf(xf[9], a4.y, s1);
  s0 = fmaf(xf[10], a5.x, s0); s1 = fmaf(xf[11], a5.y, s1);
  s0 = fmaf(xf[12], a6.x, s0); s1 = fmaf(xf[13], a6.y, s1);
  s0 = fmaf(xf[14], a7.x, s0); s1 = fmaf(xf[15], a7.y, s1);
  return s0 + s1;
}
__device__ __forceinline__ void axpy16_fp8(float* y, float wgt, uint4 v) {
  f32x2 a0 = __builtin_amdgcn_cvt_pk_f32_fp8(v.x, false), a1 = __builtin_amdgcn_cvt_pk_f32_fp8(v.x, true);
  f32x2 a2 = __builtin_amdgcn_cvt_pk_f32_fp8(v.y, false), a3 = __builtin_amdgcn_cvt_pk_f32_fp8(v.y, true);
  f32x2 a4 = __builtin_amdgcn_cvt_pk_f32_fp8(v.z, false), a5 = __builtin_amdgcn_cvt_pk_f32_fp8(v.z, true);
  f32x2 a6 = __builtin_amdgcn_cvt_pk_f32_fp8(v.w, false), a7 = __builtin_amdgcn_cvt_pk_f32_fp8(v.w, true);
  y[0] = fmaf(wgt, a0.x, y[0]); y[1] = fmaf(wgt, a0.y, y[1]); y[2] = fmaf(wgt, a1.x, y[2]); y[3] = fmaf(wgt, a1.y, y[3]);
  y[4] = fmaf(wgt, a2.x, y[4]); y[5] = fmaf(wgt, a2.y, y[5]); y[6] = fmaf(wgt, a3.x, y[6]); y[7] = fmaf(wgt, a3.y, y[7]);
  y[8] = fmaf(wgt, a4.x, y[8]); y[9] = fmaf(wgt, a4.y, y[9]); y[10] = fmaf(wgt, a5.x, y[10]); y[11] = fmaf(wgt, a5.y, y[11]);
  y[12] = fmaf(wgt, a6.x, y[12]); y[13] = fmaf(wgt, a6.y, y[13]); y[14] = fmaf(wgt, a7.x, y[14]); y[15] = fmaf(wgt, a7.y, y[15]);
}

template <bool DRY>
__device__ __forceinline__ void ph_gather(const Params& p, int l, int bid, int nblk) {
  const int lane = tid_opaque() & 63, w = __builtin_amdgcn_readfirstlane(tid_opaque() >> 6);
  const unsigned char* u8 = p.ub8() + (size_t)l * 16384 * 1024;
  const unsigned char* v8 = p.vb8() + (size_t)l * 16384 * 1024;
  const unsigned loff = (unsigned)lane * 16u;
  for (int t = bid * 4 + w; t < NTOK; t += nblk * 4) {
    float xf[16];
    {
      const uint4 xa = *reinterpret_cast<const uint4*>(p.xn() + (size_t)t * 1024 + lane * 16);
      const uint4 xb = *reinterpret_cast<const uint4*>(p.xn() + (size_t)t * 1024 + lane * 16 + 8);
      xf[0] = bf_lo(xa.x); xf[1] = bf_hi(xa.x); xf[2] = bf_lo(xa.y); xf[3] = bf_hi(xa.y);
      xf[4] = bf_lo(xa.z); xf[5] = bf_hi(xa.z); xf[6] = bf_lo(xa.w); xf[7] = bf_hi(xa.w);
      xf[8] = bf_lo(xb.x); xf[9] = bf_hi(xb.x); xf[10] = bf_lo(xb.y); xf[11] = bf_hi(xb.y);
      xf[12] = bf_lo(xb.z); xf[13] = bf_hi(xb.z); xf[14] = bf_lo(xb.w); xf[15] = bf_hi(xb.w);
    }
    const int e_lo = p.eidx()[(size_t)t * 128 + lane], e_hi = p.eidx()[(size_t)t * 128 + 64 + lane];
    const float g_lo = p.egate()[(size_t)t * 128 + lane], g_hi = p.egate()[(size_t)t * 128 + 64 + lane];
    const float s_lo = p.esu()[(size_t)t * 128 + lane], s_hi = p.esu()[(size_t)t * 128 + 64 + lane];
    float y[16];
#pragma unroll
    for (int i = 0; i < 16; ++i) y[i] = 0.f;
#pragma unroll 1
    for (int k0 = 0; k0 < 128; k0 += 8) {
      uint4 ur[8], vr[8];
#pragma unroll
      for (int q = 0; q < 8; ++q) {
        const int kk = (k0 & 63) + q;
        const int e = (k0 < 64) ? __builtin_amdgcn_readlane(e_lo, kk) : __builtin_amdgcn_readlane(e_hi, kk);
        ur[q] = *reinterpret_cast<const uint4*>(u8 + (size_t)e * 1024 + loff);
        vr[q] = *reinterpret_cast<const uint4*>(v8 + (size_t)e * 1024 + loff);
      }
#pragma unroll
      for (int q = 0; q < 8; ++q) {
        const int kk = (k0 & 63) + q;
        const float gt = __int_as_float((k0 < 64) ? __builtin_amdgcn_readlane(__float_as_int(g_lo), kk) : __builtin_amdgcn_readlane(__float_as_int(g_hi), kk));
        const float su = __int_as_float((k0 < 64) ? __builtin_amdgcn_readlane(__float_as_int(s_lo), kk) : __builtin_amdgcn_readlane(__float_as_int(s_hi), kk));
        float d = wave_sum(dot16_fp8(xf, ur[q])) * su;
        const float wgt = gt * gelu_exact(d);
        axpy16_fp8(y, wgt, vr[q]);
      }
    }
    if (DRY) {
#pragma unroll
      for (int i = 0; i < 16; ++i) asm volatile("" ::"v"(y[i]));
      continue;
    }
    float* xr = p.x() + (size_t)t * 1024 + lane * 16;
#pragma unroll
    for (int j = 0; j < 4; ++j) {
      float4 a = reinterpret_cast<float4*>(xr)[j];
      a.x += y[4 * j]; a.y += y[4 * j + 1]; a.z += y[4 * j + 2]; a.w += y[4 * j + 3];
      reinterpret_cast<float4*>(xr)[j] = a;
    }
  }
}

enum { PH_PREP = 0, PH_NORM1, PH_GEMM_IN, PH_ATTN, PH_MLCONV, PH_MCHAIN, PH_MLU, PH_MLSCAN, PH_MLOUT, PH_CMLP,
       PH_GEMM_OUT, PH_NORM2, PH_GEMM_PQ, PH_GEMM_SC, PH_TOPK, PH_GATHER, PH_FINAL };

__device__ __forceinline__ Params phase_params(const Params& kp, bool with_inputs, bool with_tables = false) {
  Params q;
  size_t z = 0;
  asm volatile("" : "+s"(z));
  q.out = kp.out + z;
  q.ws = kp.ws + z;
  q.in[0] = kp.in[0] + z;
  q.in[1] = kp.in[1] + z;
  if (with_inputs) {
#pragma unroll
    for (int i = 2; i < 30; ++i) q.in[i] = kp.in[i] + z;
  }
  if (with_tables) { q.in[27] = kp.in[27] + z; q.in[28] = kp.in[28] + z; }
  return q;
}


#define GT 4
typedef __attribute__((ext_vector_type(4))) float f32x4;

__device__ __forceinline__ float dot16_fp8v(const f32x2* x2, uint4 u) {
  f32x2 acc = x2[0] * __builtin_amdgcn_cvt_pk_f32_fp8(u.x, false);
  acc += x2[1] * __builtin_amdgcn_cvt_pk_f32_fp8(u.x, true);
  acc += x2[2] * __builtin_amdgcn_cvt_pk_f32_fp8(u.y, false);
  acc += x2[3] * __builtin_amdgcn_cvt_pk_f32_fp8(u.y, true);
  acc += x2[4] * __builtin_amdgcn_cvt_pk_f32_fp8(u.z, false);
  acc += x2[5] * __builtin_amdgcn_cvt_pk_f32_fp8(u.z, true);
  acc += x2[6] * __builtin_amdgcn_cvt_pk_f32_fp8(u.w, false);
  acc += x2[7] * __builtin_amdgcn_cvt_pk_f32_fp8(u.w, true);
  return acc.x + acc.y;
}
__device__ __forceinline__ void axpy16_fp8v(f32x2* y2, float wgt, uint4 v) {
  const f32x2 w2 = {wgt, wgt};
  y2[0] += w2 * __builtin_amdgcn_cvt_pk_f32_fp8(v.x, false);
  y2[1] += w2 * __builtin_amdgcn_cvt_pk_f32_fp8(v.x, true);
  y2[2] += w2 * __builtin_amdgcn_cvt_pk_f32_fp8(v.y, false);
  y2[3] += w2 * __builtin_amdgcn_cvt_pk_f32_fp8(v.y, true);
  y2[4] += w2 * __builtin_amdgcn_cvt_pk_f32_fp8(v.z, false);
  y2[5] += w2 * __builtin_amdgcn_cvt_pk_f32_fp8(v.z, true);
  y2[6] += w2 * __builtin_amdgcn_cvt_pk_f32_fp8(v.w, false);
  y2[7] += w2 * __builtin_amdgcn_cvt_pk_f32_fp8(v.w, true);
}

struct GU { uint4 ur[4]; f32x4 su; };
struct GV { uint4 vr[4]; f32x4 gt; };
#define GREC 384
__device__ __forceinline__ void gload_u(GU& U, const float* rec, int i4, const unsigned char* u8, unsigned loff) {
  const f32x4 ev = *reinterpret_cast<const f32x4*>(rec + i4);
  U.su = *reinterpret_cast<const f32x4*>(rec + 256 + i4);
  const int e0 = __builtin_amdgcn_readfirstlane(__float_as_int(ev.x)), e1 = __builtin_amdgcn_readfirstlane(__float_as_int(ev.y));
  const int e2 = __builtin_amdgcn_readfirstlane(__float_as_int(ev.z)), e3 = __builtin_amdgcn_readfirstlane(__float_as_int(ev.w));
  U.ur[0] = *reinterpret_cast<const uint4*>(u8 + (size_t)e0 * 1024 + loff);
  U.ur[1] = *reinterpret_cast<const uint4*>(u8 + (size_t)e1 * 1024 + loff);
  U.ur[2] = *reinterpret_cast<const uint4*>(u8 + (size_t)e2 * 1024 + loff);
  U.ur[3] = *reinterpret_cast<const uint4*>(u8 + (size_t)e3 * 1024 + loff);
}
__device__ __forceinline__ void gload_v(GV& V, const float* rec, int i4, const unsigned char* v8, unsigned loff) {
  const f32x4 ev = *reinterpret_cast<const f32x4*>(rec + i4);
  V.gt = *reinterpret_cast<const f32x4*>(rec + 128 + i4);
  const int e0 = __builtin_amdgcn_readfirstlane(__float_as_int(ev.x)), e1 = __builtin_amdgcn_readfirstlane(__float_as_int(ev.y));
  const int e2 = __builtin_amdgcn_readfirstlane(__float_as_int(ev.z)), e3 = __builtin_amdgcn_readfirstlane(__float_as_int(ev.w));
  V.vr[0] = *reinterpret_cast<const uint4*>(v8 + (size_t)e0 * 1024 + loff);
  V.vr[1] = *reinterpret_cast<const uint4*>(v8 + (size_t)e1 * 1024 + loff);
  V.vr[2] = *reinterpret_cast<const uint4*>(v8 + (size_t)e2 * 1024 + loff);
  V.vr[3] = *reinterpret_cast<const uint4*>(v8 + (size_t)e3 * 1024 + loff);
}
template <int PAT>
__device__ __forceinline__ float swz_f(float v) { return __int_as_float(__builtin_amdgcn_ds_swizzle(__float_as_int(v), PAT)); }

__device__ __forceinline__ void gstep2(GU& UA, GV& VA, GU& UB, GV& VB, const uint4* xlA, const uint4* xlB, f32x2* yA, f32x2* yB,
                                       const float* recA, const float* recB, int ci4, const float* nxtA, const float* nxtB, int ni4,
                                       const unsigned char* u8, const unsigned char* v8, unsigned loff, int lane) {
  float d[8];
  {
    f32x2 x2[8];
    const uint4 xa = xlA[0], xb = xlA[1];
    x2[0] = f32x2{bf_lo(xa.x), bf_hi(xa.x)}; x2[1] = f32x2{bf_lo(xa.y), bf_hi(xa.y)};
    x2[2] = f32x2{bf_lo(xa.z), bf_hi(xa.z)}; x2[3] = f32x2{bf_lo(xa.w), bf_hi(xa.w)};
    x2[4] = f32x2{bf_lo(xb.x), bf_hi(xb.x)}; x2[5] = f32x2{bf_lo(xb.y), bf_hi(xb.y)};
    x2[6] = f32x2{bf_lo(xb.z), bf_hi(xb.z)}; x2[7] = f32x2{bf_lo(xb.w), bf_hi(xb.w)};
#pragma unroll
    for (int q = 0; q < 4; ++q) d[q] = dot16_fp8v(x2, UA.ur[q]);
  }
  gload_u(UA, nxtA, ni4, u8, loff);
  {
    f32x2 x2[8];
    const uint4 xa = xlB[0], xb = xlB[1];
    x2[0] = f32x2{bf_lo(xa.x), bf_hi(xa.x)}; x2[1] = f32x2{bf_lo(xa.y), bf_hi(xa.y)};
    x2[2] = f32x2{bf_lo(xa.z), bf_hi(xa.z)}; x2[3] = f32x2{bf_lo(xa.w), bf_hi(xa.w)};
    x2[4] = f32x2{bf_lo(xb.x), bf_hi(xb.x)}; x2[5] = f32x2{bf_lo(xb.y), bf_hi(xb.y)};
    x2[6] = f32x2{bf_lo(xb.z), bf_hi(xb.z)}; x2[7] = f32x2{bf_lo(xb.w), bf_hi(xb.w)};
#pragma unroll
    for (int q = 0; q < 4; ++q) d[4 + q] = dot16_fp8v(x2, UB.ur[q]);
  }
  gload_u(UB, nxtB, ni4, u8, loff);
  const bool b0 = lane & 1, b1 = lane & 2, b2 = lane & 4;
  float a[4];
#pragma unroll
  for (int j = 0; j < 4; ++j) {
    const float keep = b0 ? d[4 + j] : d[j], send = b0 ? d[j] : d[4 + j];
    a[j] = keep + dpp_f<0xB1>(send);
  }
  float c2[2];
#pragma unroll
  for (int j = 0; j < 2; ++j) {
    const float keep = b1 ? a[2 + j] : a[j], send = b1 ? a[j] : a[2 + j];
    c2[j] = keep + dpp_f<0x4E>(send);
  }
  float tot;
  {
    const float keep = b2 ? c2[1] : c2[0], send = b2 ? c2[0] : c2[1];
    tot = keep + swz_f<0x101F>(send);
  }
  tot += swz_f<0x201F>(tot);
  tot = swap32_sum(swap16_sum(tot));
  const int pq = ((lane >> 1) & 1) * 2 + ((lane >> 2) & 1);
  const float* rl = (b0 ? recB : recA) + ci4 + pq;
  const float z = tot * rl[256];
  const float wv = rl[128] * gelu_as(z);
#pragma unroll
  for (int q = 0; q < 4; ++q) {
    const int ln = ((q >> 1) & 1) * 2 + (q & 1) * 4;
    const float wa = __int_as_float(__builtin_amdgcn_readlane(__float_as_int(wv), ln));
    const float wb = __int_as_float(__builtin_amdgcn_readlane(__float_as_int(wv), ln + 1));
    axpy16_fp8v(yA, wa, VA.vr[q]);
    axpy16_fp8v(yB, wb, VB.vr[q]);
  }
  gload_v(VA, nxtA, ni4, v8, loff);
  gload_v(VB, nxtB, ni4, v8, loff);
}

__device__ __forceinline__ void gstep(GU& U, GV& V, const uint4* xl, f32x2* y2, const float* nrec, int ni4,
                                      const unsigned char* u8, const unsigned char* v8, unsigned loff, int lane) {
  f32x2 x2[8];
  {
    const uint4 xa = xl[0], xb = xl[1];
    x2[0] = f32x2{bf_lo(xa.x), bf_hi(xa.x)}; x2[1] = f32x2{bf_lo(xa.y), bf_hi(xa.y)};
    x2[2] = f32x2{bf_lo(xa.z), bf_hi(xa.z)}; x2[3] = f32x2{bf_lo(xa.w), bf_hi(xa.w)};
    x2[4] = f32x2{bf_lo(xb.x), bf_hi(xb.x)}; x2[5] = f32x2{bf_lo(xb.y), bf_hi(xb.y)};
    x2[6] = f32x2{bf_lo(xb.z), bf_hi(xb.z)}; x2[7] = f32x2{bf_lo(xb.w), bf_hi(xb.w)};
  }
  float d[4], su[4];
#pragma unroll
  for (int q = 0; q < 4; ++q) { d[q] = dot16_fp8v(x2, U.ur[q]); su[q] = U.su[q]; }
  gload_u(U, nrec, ni4, u8, loff);
#pragma unroll
  for (int q = 0; q < 4; ++q) d[q] = wave_sum(d[q]) * su[q];
  float dv = d[0]; dv = (lane == 1) ? d[1] : dv; dv = (lane == 2) ? d[2] : dv; dv = (lane == 3) ? d[3] : dv;
  const float av = gelu_as(dv);
#pragma unroll
  for (int q = 0; q < 4; ++q) {
    const float act = __int_as_float(__builtin_amdgcn_readlane(__float_as_int(av), q));
    axpy16_fp8v(y2, V.gt[q] * act, V.vr[q]);
  }
  gload_v(V, nrec, ni4, v8, loff);
}

__device__ __forceinline__ void gsort_token(const Params& p, int t, float* rec, int lane) {
  const int e0 = p.eidx()[(size_t)t * 128 + lane], e1 = p.eidx()[(size_t)t * 128 + 64 + lane];
  const float g0 = p.egate()[(size_t)t * 128 + lane], g1 = p.egate()[(size_t)t * 128 + 64 + lane];
  const float q0 = p.esu()[(size_t)t * 128 + lane], q1 = p.esu()[(size_t)t * 128 + 64 + lane];
  int base = 0;
#pragma unroll 4
  for (int s = 0; s < 16; ++s) {
    const unsigned long long m0 = __ballot((e0 >> 10) == s), m1 = __ballot((e1 >> 10) == s);
    const int c0 = __popcll(m0), c1 = __popcll(m1);
    const int p0 = base + (int)__builtin_amdgcn_mbcnt_hi((unsigned)(m0 >> 32), __builtin_amdgcn_mbcnt_lo((unsigned)m0, 0));
    const int p1 = base + c0 + (int)__builtin_amdgcn_mbcnt_hi((unsigned)(m1 >> 32), __builtin_amdgcn_mbcnt_lo((unsigned)m1, 0));
    if ((e0 >> 10) == s) { rec[p0] = __int_as_float(e0); rec[128 + p0] = g0; rec[256 + p0] = q0; }
    if ((e1 >> 10) == s) { rec[p1] = __int_as_float(e1); rec[128 + p1] = g1; rec[256 + p1] = q1; }
    base += c0 + c1;
  }
}
__device__ __forceinline__ void gload_x(const Params& p, int t, uint4* xl, int lane) {
  xl[0] = *reinterpret_cast<const uint4*>(p.xn() + (size_t)t * 1024 + lane * 16);
  xl[1] = *reinterpret_cast<const uint4*>(p.xn() + (size_t)t * 1024 + lane * 16 + 8);
}
template <bool LAST>
__device__ __forceinline__ void gstore_x(const Params& p, int l, int t, const f32x2* y2, int lane) {
  float* xr = p.x() + (size_t)t * 1024 + lane * 16;
  float4 a[4];
  float ss = 0.f;
#pragma unroll
  for (int j = 0; j < 4; ++j) {
    a[j] = reinterpret_cast<float4*>(xr)[j];
    a[j].x += y2[2 * j].x; a[j].y += y2[2 * j].y; a[j].z += y2[2 * j + 1].x; a[j].w += y2[2 * j + 1].y;
    ss += a[j].x * a[j].x + a[j].y * a[j].y + a[j].z * a[j].z + a[j].w * a[j].w;
  }
  ss = wave_sum(ss);
  const float r = rsqrtf(ss * (1.f / 1024.f) + EPS);
  if (LAST) {
    const float* g = p.final_g() + lane * 16;
    float* o = ((t < NPROMPT) ? p.out + O_Y_P + (size_t)t * 1024 : p.out + O_Y_S + (size_t)(t - NPROMPT) * 1024) + lane * 16;
#pragma unroll
    for (int j = 0; j < 4; ++j) {
      const float4 gv = reinterpret_cast<const float4*>(g)[j];
      reinterpret_cast<float4*>(o)[j] = make_float4(a[j].x * r * gv.x, a[j].y * r * gv.y, a[j].z * r * gv.z, a[j].w * r * gv.w);
    }
  } else {
    const float* g = p.norm1_g() + (l + 1) * 1024 + lane * 16;
#pragma unroll
    for (int j = 0; j < 4; ++j) {
      reinterpret_cast<float4*>(xr)[j] = a[j];
      const float4 gv = reinterpret_cast<const float4*>(g)[j];
      a[j].x *= r * gv.x; a[j].y *= r * gv.y; a[j].z *= r * gv.z; a[j].w *= r * gv.w;
    }
    uint4* o = reinterpret_cast<uint4*>(p.xn() + (size_t)t * 1024 + lane * 16);
    o[0] = make_uint4(pack2(a[0].x, a[0].y), pack2(a[0].z, a[0].w), pack2(a[1].x, a[1].y), pack2(a[1].z, a[1].w));
    o[1] = make_uint4(pack2(a[2].x, a[2].y), pack2(a[2].z, a[2].w), pack2(a[3].x, a[3].y), pack2(a[3].z, a[3].w));
    float pre[8];
#pragma unroll
    for (int i = 0; i < 8; ++i) {
      const float4* wr = reinterpret_cast<const float4*>(p.wg() + ((size_t)(l + 1) * 8 + i) * 1024 + lane * 16);
      float s = 0.f;
#pragma unroll
      for (int j = 0; j < 4; ++j) {
        const float4 wv = wr[j];
        s += a[j].x * wv.x + a[j].y * wv.y + a[j].z * wv.z + a[j].w * wv.w;
      }
      pre[i] = wave_sum(s);
    }
    if (lane < 4) {
      float ai = pre[0]; ai = lane == 1 ? pre[1] : ai; ai = lane == 2 ? pre[2] : ai; ai = lane == 3 ? pre[3] : ai;
      float f = pre[4]; f = lane == 1 ? pre[5] : f; f = lane == 2 ? pre[6] : f; f = lane == 3 ? pre[7] : f;
      p.ig()[(size_t)t * 4 + lane] = ai + p.ml_gate_b()[(l + 1) * 8 + lane];
      const float z = f + p.ml_gate_b()[(l + 1) * 8 + 4 + lane];
      p.lf()[(size_t)t * 4 + lane] = fminf(z, 0.f) - log1pf(expf(-fabsf(z)));
    }
  }
}

template <bool LAST>
__device__ __forceinline__ void ph_gather2(const Params& p, int l, char* smem, int bid, int nblk) {
  const int tid = tid_opaque(), lane = tid & 63, w = __builtin_amdgcn_readfirstlane(tid >> 6);
  const unsigned char* u8 = p.ub8() + (size_t)l * 16384 * 1024;
  const unsigned char* v8 = p.vb8() + (size_t)l * 16384 * 1024;
  const unsigned loff = (unsigned)lane * 16u;
  float* rec = reinterpret_cast<float*>(smem) + w * (GT * GREC);
  uint4* xl = reinterpret_cast<uint4*>(smem + 4 * GT * GREC * 4) + (w * GT * 64 + lane) * 2;
  const int rot = 0;
  const int nwaves = nblk * 4, wg = bid * 4 + w;
  const int nfull = (NTOK / (nwaves * GT)) * nwaves;
  for (int grp = wg; grp < nfull; grp += nwaves) {
    const int t0 = grp * GT;
    int lane_s = lane; asm volatile("" : "+v"(lane_s));
#pragma unroll 1
    for (int ti = 0; ti < GT; ++ti) {
      gload_x(p, t0 + ti, xl + ti * 128, lane_s);
      gsort_token(p, t0 + ti, rec + ti * GREC, lane_s);
    }
    f32x2 y2[GT][8];
#pragma unroll
    for (int ti = 0; ti < GT; ++ti)
#pragma unroll
      for (int i = 0; i < 8; ++i) y2[ti][i] = f32x2{0.f, 0.f};
    GU U0, U1; GV V0, V1;
    gload_u(U0, rec, (rot & 31) * 4, u8, loff); gload_v(V0, rec, (rot & 31) * 4, v8, loff);
    gload_u(U1, rec + GREC, (rot & 31) * 4, u8, loff); gload_v(V1, rec + GREC, (rot & 31) * 4, v8, loff);
#pragma unroll 1
    for (int b = 0; b < 32; ++b) {
      const int bo = ((b + rot) & 31) * 4, bn = ((b + 1 + rot) & 31) * 4;
      gstep2(U0, V0, U1, V1, xl, xl + 128, y2[0], y2[1], rec, rec + GREC, bo, rec + 2 * GREC, rec + 3 * GREC, bo, u8, v8, loff, lane);
      __builtin_amdgcn_sched_barrier(0);
      gstep2(U0, V0, U1, V1, xl + 256, xl + 384, y2[2], y2[3], rec + 2 * GREC, rec + 3 * GREC, bo, rec, rec + GREC, bn, u8, v8, loff, lane);
      __builtin_amdgcn_sched_barrier(0);
    }
    int lane_e = lane; asm volatile("" : "+v"(lane_e));
#pragma unroll
    for (int ti = 0; ti < GT; ++ti) gstore_x<LAST>(p, l, t0 + ti, y2[ti], lane_e);
  }
  float* ysum = reinterpret_cast<float*>(smem + 4 * GT * GREC * 4 + 4 * GT * 2048);
  for (int t = nfull * GT + bid; t < NTOK; t += nblk) {
    f32x2 y2[8];
    gload_x(p, t, xl, lane);
#pragma unroll
    for (int i = 0; i < 8; ++i) y2[i] = f32x2{0.f, 0.f};
    gsort_token(p, t, rec, lane);
    GU U; GV V;
    gload_u(U, rec, (w * 8) * 4, u8, loff);
    gload_v(V, rec, (w * 8) * 4, v8, loff);
#pragma unroll 1
    for (int b = 0; b < 8; ++b) gstep(U, V, xl, y2, rec, (w * 8 + ((b + 1) & 7)) * 4, u8, v8, loff, lane);
    __syncthreads();
#pragma unroll
    for (int i = 0; i < 8; ++i) { ysum[w * 1024 + lane * 16 + 2 * i] = y2[i].x; ysum[w * 1024 + lane * 16 + 2 * i + 1] = y2[i].y; }
    __syncthreads();
    if (w == 0) {
#pragma unroll
      for (int i = 0; i < 8; ++i) {
        y2[i].x += ysum[1024 + lane * 16 + 2 * i] + ysum[2048 + lane * 16 + 2 * i] + ysum[3072 + lane * 16 + 2 * i];
        y2[i].y += ysum[1024 + lane * 16 + 2 * i + 1] + ysum[2048 + lane * 16 + 2 * i + 1] + ysum[3072 + lane * 16 + 2 * i + 1];
      }
      gstore_x<LAST>(p, l, t, y2, lane);
    }
  }
}

#define XB_TMO      128
#define XB_XCNT(j)  (256  + 64 * (j))
#define XB_XSUB(j)  (1280 + 64 * (j))
#define XB_XGEN(j)  (2304 + 64 * (j))
#define XB_TOP      3328
#define XB_TOPGEN   3392
#define XCD_BAR_WORDS 3456
#define XB_SPIN_CAP (1u << 22)
__device__ __forceinline__ unsigned xb_ld(unsigned* p)              { return __hip_atomic_load(p, __ATOMIC_RELAXED, __HIP_MEMORY_SCOPE_AGENT); }
__device__ __forceinline__ unsigned xb_add(unsigned* p, unsigned v) { return __hip_atomic_fetch_add(p, v, __ATOMIC_RELAXED, __HIP_MEMORY_SCOPE_AGENT); }
__device__ __forceinline__ unsigned xb_xcc_id() { return (unsigned)__builtin_amdgcn_s_getreg((3 << 11) | 20) & 0xFu; }
#define XB_SPIN(cond, bar) do { unsigned _sp = 0; while (cond) { __builtin_amdgcn_s_sleep(1); \
    if ((++_sp & 255u) == 0u) { if (xb_ld(&(bar)[XB_TMO])) break; if (_sp > XB_SPIN_CAP) { atomicAdd(&(bar)[XB_TMO], 1u); break; } } } } while (0)

struct XcdBarrier { unsigned* bar; unsigned x; volatile LAS unsigned* st; };

__device__ __forceinline__ XcdBarrier xcd_barrier_post(unsigned* bar, volatile LAS unsigned* st) {
  XcdBarrier b; b.bar = bar; b.x = xb_xcc_id(); b.st = st;
  if (threadIdx.x == 0) (void)xb_add(&bar[XB_XCNT(b.x)], 1u);
  return b;
}
__device__ __forceinline__ void xcd_barrier_complete(unsigned* bar, unsigned x, unsigned& nloc, unsigned& nx) {
  const unsigned G = gridDim.x * gridDim.y * gridDim.z;
  unsigned sum, cnt, mine, sp = 0u;
  for (;;) {
    sum = 0u; cnt = 0u; mine = 0u;
#pragma unroll
    for (unsigned j = 0; j < 16; ++j) { const unsigned c = xb_ld(&bar[XB_XCNT(j)]); sum += c; cnt += (c > 0u) ? 1u : 0u; mine = (j == x) ? c : mine; }
    if (sum == G) break;
    __builtin_amdgcn_s_sleep(1);
    if ((++sp & 255u) == 0u) { if (xb_ld(&bar[XB_TMO])) break; if (sp > XB_SPIN_CAP) { atomicAdd(&bar[XB_TMO], 1u); break; } }
  }
  nloc = mine > 0u ? mine : 1u; nx = cnt > 0u ? cnt : 1u;
}
__device__ __forceinline__ void xcd_barrier(const XcdBarrier& b) {
  asm volatile("s_waitcnt vmcnt(0)" ::: "memory");
  __syncthreads();
  if (threadIdx.x == 0) {
    unsigned* bar = b.bar;
    __builtin_amdgcn_s_waitcnt(0);
    unsigned nloc = b.st[0], nx = b.st[1];
    if (nloc == 0u) { xcd_barrier_complete(bar, b.x, nloc, nx); b.st[0] = nloc; b.st[1] = nx; }
    const unsigned old = xb_add(&bar[XB_XSUB(b.x)], 1u);
    const unsigned gen = old / nloc;
    if (old + 1u == (gen + 1u) * nloc) {
      __builtin_amdgcn_fence(__ATOMIC_RELEASE, "agent");
      asm volatile("s_waitcnt vmcnt(0)" ::: "memory");
      const unsigned og = xb_add(&bar[XB_TOP], 1u);
      const unsigned tg = og / nx;
      if (og + 1u == (tg + 1u) * nx) xb_add(&bar[XB_TOPGEN], 1u);
      else XB_SPIN(xb_ld(&bar[XB_TOPGEN]) == tg, bar);
      __builtin_amdgcn_fence(__ATOMIC_ACQUIRE, "agent");
      xb_add(&bar[XB_XGEN(b.x)], 1u);
      asm volatile("s_waitcnt vmcnt(0)" ::: "memory");
    } else {
      XB_SPIN(xb_ld(&bar[XB_XGEN(b.x)]) == gen, bar);
      __builtin_amdgcn_fence(__ATOMIC_ACQUIRE, "agent");
      asm volatile("s_waitcnt vmcnt(0)" ::: "memory");
    }
  }
  __syncthreads();
}

#define GSYNC() xcd_barrier(xb)
#define PP(wi) phase_params(p, wi)
#define BN bid_opaque(bid), nblk_opaque(nblk)

template <int L>
__device__ __forceinline__ void layer_phases(const Params& p, char* smem, const XcdBarrier& xb, int bid, int nblk) {
  ph_gemm<EPI_WIN>(PP(false), L, smem, BN);
#if PROBE == 1
  GSYNC();
  ph_gemm<EPI_WIN>(PP(false), L, smem, BN);
#endif
  GSYNC();
  {
    const Params q = PP(false);
    WorkQ wq; wq.cnt = reinterpret_cast<unsigned*>(q.ws) + 8 + L; wq.slot = reinterpret_cast<volatile int*>(smem + SMEM_BYTES - 8); wq.off = 0;
    int item = ph_attn<(L == 0)>(phase_params(p, false, L == 0), L, smem, wq);
    wq.off = (L == 0) ? 528 : 0;
    item = ph_mlconv(PP(false), L, smem, wq, item);
    ph_cmlp(PP(false), L, smem, wq, item);
  }
  GSYNC();
  ph_mlU(PP(false), L, smem, BN);
#if PROBE == 9 || PROBE == 20
  GSYNC();
  ph_mlU(PP(false), L, smem, BN);
#endif
  GSYNC();
  ph_mlscan(PP(false), L, BN);
#if PROBE == 10 || PROBE == 20
  GSYNC();
  ph_mlscan(PP(false), L, BN);
#endif
  GSYNC();
  ph_mlout(PP(false), L, smem, BN);
#if PROBE == 6 || PROBE == 20
  GSYNC();
  ph_mlout(PP(false), L, smem, BN);
#endif
  GSYNC();
  ph_gemm<EPI_WOUT>(PP(false), L, smem, BN);
  GSYNC();
  ph_rmsnorm<1>(PP(false), L, BN);
  GSYNC();
  ph_gemm<EPI_PQ>(PP(false), L, smem, BN);
#if PROBE == 2
  GSYNC();
  ph_gemm<EPI_PQ>(PP(false), L, smem, BN);
#endif
  GSYNC();
  ph_topk(PP(false), L, smem, BN);
#if PROBE == 5
  GSYNC();
  ph_topk(PP(false), L, smem, BN);
#endif
  GSYNC();
  ph_gather2<(L == 1)>(PP(false), L, smem, BN);
  GSYNC();
}

__global__ void __launch_bounds__(256, 2) mega_kernel(Params p) {
  __shared__ __attribute__((aligned(16))) char smem[SMEM_BYTES];
  __shared__ uint4 xb_words;
  cg::grid_group grid = cg::this_grid();
  const int bid = blockIdx.x, nblk = gridDim.x;
  if (threadIdx.x == 0) xb_words = make_uint4(0u, 0u, 0u, 0u);
  __syncthreads();
  XcdBarrier xb = xcd_barrier_post(reinterpret_cast<unsigned*>(p.ws), (volatile LAS unsigned*)&xb_words);
  grid.sync();
  ph_prep(PP(true), smem, BN);
  ph_norm1_l0(PP(true), smem, BN);
#if PROBE == 12
  GSYNC();
  ph_prep(PP(true), smem, BN);
#endif
  GSYNC();
  layer_phases<0>(p, smem, xb, bid, nblk);
  layer_phases<1>(p, smem, xb, bid, nblk);
}

static inline size_t align_up(size_t v, size_t a) { return (v + a - 1) / a * a; }

extern "C" void kernel_launch(void* const* d_in, const int* in_sizes, int n_in, void* d_out, int out_size, void* d_ws,
                              size_t ws_size, hipStream_t stream) {
  Params p{};
  for (int i = 0; i < 30; ++i) p.in[i] = reinterpret_cast<const float*>(d_in[i]);
  p.out = reinterpret_cast<float*>(d_out);
  p.ws = reinterpret_cast<char*>(d_ws);
  if (WS_NEED > ws_size) { fprintf(stderr, "workspace too small: need %zu have %zu\n", (size_t)WS_NEED, ws_size); return; }
  static int grid_blocks = 0;
  if (!grid_blocks) {
    int dev = 0, cus = 0, per_cu = 0;
    hipGetDevice(&dev);
    hipDeviceGetAttribute(&cus, hipDeviceAttributeMultiprocessorCount, dev);
    hipOccupancyMaxActiveBlocksPerMultiprocessor(&per_cu, mega_kernel, 256, 0);
    if (per_cu > 2) per_cu = 2;
    if (per_cu < 1) per_cu = 1;
    grid_blocks = cus * per_cu;
  }
  hipMemsetAsync(d_ws, 0, 16384, stream);
  void* args[] = {&p};
  hipError_t e = hipLaunchCooperativeKernel((void*)mega_kernel, dim3(grid_blocks), dim3(256), args, 0, stream);
  if (e != hipSuccess) fprintf(stderr, "cooperative launch failed: %s (grid %d)\n", hipGetErrorString(e), grid_blocks);
}
```

```cpp
#include <hip/hip_runtime.h>
#include <hip/hip_cooperative_groups.h>
#include <cstdio>
#include <cstdint>

namespace cg = cooperative_groups;

typedef unsigned short bf16_t;
typedef __attribute__((ext_vector_type(8))) __bf16 bf16x8;
typedef __attribute__((ext_vector_type(2))) __bf16 bf16x2;
typedef __attribute__((ext_vector_type(16))) float f32x16;
typedef __attribute__((ext_vector_type(2))) float f32x2;

#define D_MODEL 1024
#define NTOK 16896
#define NPROMPT 16384
#define SEQ 4096
#define NIN 2816
#define EPS 1e-6f
#define LOG2E 1.4426950408889634f
#define SKEYS 1088
#define NCU_UNITS 1056

constexpr size_t O_Y_P = 0;
constexpr size_t O_Y_S = O_Y_P + 16777216;
constexpr size_t O_K_P = O_Y_S + 524288;
constexpr size_t O_V_P = O_K_P + 16777216;
constexpr size_t O_C_P = O_V_P + 16777216;
constexpr size_t O_N_P = O_C_P + 131072;
constexpr size_t O_M_P = O_N_P + 2048;
constexpr size_t O_CONV_P = O_M_P + 32;
constexpr size_t O_K_S = O_CONV_P + 6144;
constexpr size_t O_V_S = O_K_S + 524288;
constexpr size_t O_C_S = O_V_S + 524288;
constexpr size_t O_N_S = O_C_S + 262144;
constexpr size_t O_M_S = O_N_S + 4096;
constexpr size_t O_CONV_S = O_M_S + 64;
constexpr size_t O_CMV_S = O_CONV_S + 12288;

constexpr size_t al256(size_t v) { return (v + 255) / 256 * 256; }
constexpr int SP_st_c = 0;
constexpr int SP_st_n = 262144;
constexpr int SP_st_m = 266240;
constexpr int SP_st_conv = 266304;
constexpr int SP_norm1_g = 278592;
constexpr int SP_da_subln_g = 280640;
constexpr int SP_ml_conv_w = 280896;
constexpr int SP_ml_conv_b = 282944;
constexpr int SP_ml_wq = 283456;
constexpr int SP_ml_wk = 316224;
constexpr int SP_ml_gate_b = 348992;
constexpr int SP_ml_norm_g = 349056;
constexpr int SP_ml_skip = 349568;
constexpr int SP_cm_norm_g = 350080;
constexpr int SP_cm_ws = 350592;
constexpr int SP_cm_b = 481664;
constexpr int SP_norm2_g = 482688;
constexpr int SP_final_g = 484736;
constexpr int SP_TOTAL = 485760;
constexpr size_t WS_bar = 0;
constexpr size_t WS_lam = al256(WS_bar + 16384);
constexpr size_t WS_lut = al256(WS_lam + (256));
constexpr size_t WS_sp = al256(WS_lut + (4*256*4));
constexpr size_t WS_wt_in = al256(WS_sp + (SP_TOTAL*4));
constexpr size_t WS_wg = al256(WS_wt_in + ((size_t)2*NIN*1024*2));
constexpr size_t WS_wt_out = al256(WS_wg + ((size_t)2*8*1024*4));
constexpr size_t WS_wt_pq = al256(WS_wt_out + ((size_t)2*1024*1024*2));
constexpr size_t WS_keysb = al256(WS_wt_pq + ((size_t)2*2048*1024*2));
constexpr size_t WS_ub8 = al256(WS_keysb + ((size_t)2*16*128*128*2));
constexpr size_t WS_vb8 = al256(WS_ub8 + ((size_t)2*16384*1024));
constexpr size_t WS_us = al256(WS_vb8 + ((size_t)2*16384*1024));
constexpr size_t WS_vs = al256(WS_us + ((size_t)2*16384*4));
constexpr size_t WS_Kbs = al256(WS_vs + ((size_t)2*16384*4));
constexpr size_t WS_Vts = al256(WS_Kbs + ((size_t)2*8*SKEYS*512*2));
constexpr size_t WS_x = al256(WS_Vts + ((size_t)2*8*4*128*SKEYS*2));
constexpr size_t WS_xn = al256(WS_x + ((size_t)NTOK*1024*4));
constexpr size_t WS_R0 = al256(WS_xn + ((size_t)NTOK*1024*2));
constexpr size_t WS_R0x = WS_R0;
constexpr size_t WS_Qb = al256(WS_R0x + (0));
constexpr size_t WS_Kb = al256(WS_Qb + ((size_t)NTOK*512*2));
constexpr size_t WS_Vt = al256(WS_Kb + ((size_t)NPROMPT*512*2));
constexpr size_t WS_P5 = al256(WS_Vt + ((size_t)16*128*SEQ*2));
constexpr size_t WS_ig = al256(WS_P5 + ((size_t)NTOK*1280*4));
constexpr size_t WS_lf = al256(WS_ig + ((size_t)NTOK*4*4));
constexpr size_t WS_Fc = al256(WS_lf + ((size_t)NTOK*4*4));
constexpr size_t WS_cc = al256(WS_Fc + ((size_t)NTOK*4*4));
constexpr size_t WS_qm = al256(WS_cc + ((size_t)NTOK*256*4));
constexpr size_t WS_km = al256(WS_qm + ((size_t)NTOK*256*4));
constexpr size_t WS_mst = al256(WS_km + ((size_t)NTOK*256*4));
constexpr size_t WS_mnx = al256(WS_mst + (NCU_UNITS*4));
constexpr size_t WS_wcs = al256(WS_mnx + (NCU_UNITS*4));
constexpr size_t WS_FLs = al256(WS_wcs + (NCU_UNITS*4));
constexpr size_t WS_mxt = al256(WS_FLs + (NCU_UNITS*4));
constexpr size_t WS_U = al256(WS_mxt + (NCU_UNITS*4));
constexpr size_t WS_un = al256(WS_U + ((size_t)NCU_UNITS*4096*4));
constexpr size_t WS_Cst = al256(WS_un + ((size_t)NCU_UNITS*64*4));
constexpr size_t WS_nst = al256(WS_Cst + ((size_t)NCU_UNITS*4096*4));
constexpr size_t WS_END_MIXER = al256(WS_nst + ((size_t)NCU_UNITS*64*4));
constexpr size_t WS_qp = al256(WS_R0x + (0));
constexpr size_t WS_sc = al256(WS_qp + ((size_t)NTOK*2048*2));
constexpr size_t WS_eidx = al256(WS_sc + ((size_t)NTOK*2048*4));
constexpr size_t WS_egate = al256(WS_eidx + ((size_t)NTOK*128*4));
constexpr size_t WS_esu = al256(WS_egate + ((size_t)NTOK*128*4));
constexpr size_t WS_ssp = al256(WS_esu + ((size_t)NTOK*128*4));
constexpr size_t WS_END_PEER = al256(WS_ssp + ((size_t)NTOK*32*4));
constexpr size_t WS_NEED = WS_END_MIXER > WS_END_PEER ? WS_END_MIXER : WS_END_PEER;

struct Params {
  const float* in[30];
  float* out;
  char* ws;
  __device__ __forceinline__ const float* x_prompt() const { return in[0]; }
  __device__ __forceinline__ const float* x_sample() const { return in[1]; }
  __device__ __forceinline__ const float* cache_k() const { return in[2]; }
  __device__ __forceinline__ const float* cache_v() const { return in[3]; }
  __device__ __forceinline__ const float* w_in() const { return in[9]; }
  __device__ __forceinline__ const float* da_lambda() const { return in[10]; }
  __device__ __forceinline__ const float* rel_table() const { return in[12]; }
  __device__ __forceinline__ const float* w_out() const { return in[23]; }
  __device__ __forceinline__ const float* peer_wq() const { return in[25]; }
  __device__ __forceinline__ const float* peer_keys() const { return in[26]; }
  __device__ __forceinline__ const float* peer_u() const { return in[27]; }
  __device__ __forceinline__ const float* peer_v() const { return in[28]; }
  __device__ __forceinline__ const float* st_c() const { return reinterpret_cast<const float*>(ws + WS_sp) + SP_st_c; }
  __device__ __forceinline__ const float* st_n() const { return reinterpret_cast<const float*>(ws + WS_sp) + SP_st_n; }
  __device__ __forceinline__ const float* st_m() const { return reinterpret_cast<const float*>(ws + WS_sp) + SP_st_m; }
  __device__ __forceinline__ const float* st_conv() const { return reinterpret_cast<const float*>(ws + WS_sp) + SP_st_conv; }
  __device__ __forceinline__ const float* norm1_g() const { return reinterpret_cast<const float*>(ws + WS_sp) + SP_norm1_g; }
  __device__ __forceinline__ const float* da_subln_g() const { return reinterpret_cast<const float*>(ws + WS_sp) + SP_da_subln_g; }
  __device__ __forceinline__ const float* ml_conv_w() const { return reinterpret_cast<const float*>(ws + WS_sp) + SP_ml_conv_w; }
  __device__ __forceinline__ const float* ml_conv_b() const { return reinterpret_cast<const float*>(ws + WS_sp) + SP_ml_conv_b; }
  __device__ __forceinline__ const float* ml_wq() const { return reinterpret_cast<const float*>(ws + WS_sp) + SP_ml_wq; }
  __device__ __forceinline__ const float* ml_wk() const { return reinterpret_cast<const float*>(ws + WS_sp) + SP_ml_wk; }
  __device__ __forceinline__ const float* ml_gate_b() const { return reinterpret_cast<const float*>(ws + WS_sp) + SP_ml_gate_b; }
  __device__ __forceinline__ const float* ml_norm_g() const { return reinterpret_cast<const float*>(ws + WS_sp) + SP_ml_norm_g; }
  __device__ __forceinline__ const float* ml_skip() const { return reinterpret_cast<const float*>(ws + WS_sp) + SP_ml_skip; }
  __device__ __forceinline__ const float* cm_norm_g() const { return reinterpret_cast<const float*>(ws + WS_sp) + SP_cm_norm_g; }
  __device__ __forceinline__ const float* cm_ws() const { return reinterpret_cast<const float*>(ws + WS_sp) + SP_cm_ws; }
  __device__ __forceinline__ const float* cm_b() const { return reinterpret_cast<const float*>(ws + WS_sp) + SP_cm_b; }
  __device__ __forceinline__ const float* norm2_g() const { return reinterpret_cast<const float*>(ws + WS_sp) + SP_norm2_g; }
  __device__ __forceinline__ const float* final_g() const { return reinterpret_cast<const float*>(ws + WS_sp) + SP_final_g; }
  __device__ __forceinline__ float* lam() const { return reinterpret_cast<float*>(ws + WS_lam); }
  __device__ __forceinline__ float* lut() const { return reinterpret_cast<float*>(ws + WS_lut); }
  __device__ __forceinline__ float* sp() const { return reinterpret_cast<float*>(ws + WS_sp); }
  __device__ __forceinline__ bf16_t* wt_in() const { return reinterpret_cast<bf16_t*>(ws + WS_wt_in); }
  __device__ __forceinline__ float* wg() const { return reinterpret_cast<float*>(ws + WS_wg); }
  __device__ __forceinline__ bf16_t* wt_out() const { return reinterpret_cast<bf16_t*>(ws + WS_wt_out); }
  __device__ __forceinline__ bf16_t* wt_pq() const { return reinterpret_cast<bf16_t*>(ws + WS_wt_pq); }
  __device__ __forceinline__ bf16_t* keysb() const { return reinterpret_cast<bf16_t*>(ws + WS_keysb); }
  __device__ __forceinline__ unsigned char* ub8() const { return reinterpret_cast<unsigned char*>(ws + WS_ub8); }
  __device__ __forceinline__ unsigned char* vb8() const { return reinterpret_cast<unsigned char*>(ws + WS_vb8); }
  __device__ __forceinline__ float* us() const { return reinterpret_cast<float*>(ws + WS_us); }
  __device__ __forceinline__ float* vs() const { return reinterpret_cast<float*>(ws + WS_vs); }
  __device__ __forceinline__ bf16_t* Kbs() const { return reinterpret_cast<bf16_t*>(ws + WS_Kbs); }
  __device__ __forceinline__ bf16_t* Vts() const { return reinterpret_cast<bf16_t*>(ws + WS_Vts); }
  __device__ __forceinline__ float* x() const { return reinterpret_cast<float*>(ws + WS_x); }
  __device__ __forceinline__ bf16_t* xn() const { return reinterpret_cast<bf16_t*>(ws + WS_xn); }
  __device__ __forceinline__ bf16_t* Qb() const { return reinterpret_cast<bf16_t*>(ws + WS_Qb); }
  __device__ __forceinline__ bf16_t* Kb() const { return reinterpret_cast<bf16_t*>(ws + WS_Kb); }
  __device__ __forceinline__ bf16_t* Vt() const { return reinterpret_cast<bf16_t*>(ws + WS_Vt); }
  __device__ __forceinline__ float* P5() const { return reinterpret_cast<float*>(ws + WS_P5); }
  __device__ __forceinline__ float* ig() const { return reinterpret_cast<float*>(ws + WS_ig); }
  __device__ __forceinline__ float* lf() const { return reinterpret_cast<float*>(ws + WS_lf); }
  __device__ __forceinline__ float* Fc() const { return reinterpret_cast<float*>(ws + WS_Fc); }
  __device__ __forceinline__ float* cc() const { return reinterpret_cast<float*>(ws + WS_cc); }
  __device__ __forceinline__ float* qm() const { return reinterpret_cast<float*>(ws + WS_qm); }
  __device__ __forceinline__ float* km() const { return reinterpret_cast<float*>(ws + WS_km); }
  __device__ __forceinline__ float* mst() const { return reinterpret_cast<float*>(ws + WS_mst); }
  __device__ __forceinline__ float* mnx() const { return reinterpret_cast<float*>(ws + WS_mnx); }
  __device__ __forceinline__ float* wcs() const { return reinterpret_cast<float*>(ws + WS_wcs); }
  __device__ __forceinline__ float* FLs() const { return reinterpret_cast<float*>(ws + WS_FLs); }
  __device__ __forceinline__ float* mxt() const { return reinterpret_cast<float*>(ws + WS_mxt); }
  __device__ __forceinline__ float* U() const { return reinterpret_cast<float*>(ws + WS_U); }
  __device__ __forceinline__ float* un() const { return reinterpret_cast<float*>(ws + WS_un); }
  __device__ __forceinline__ float* Cst() const { return reinterpret_cast<float*>(ws + WS_Cst); }
  __device__ __forceinline__ float* nst() const { return reinterpret_cast<float*>(ws + WS_nst); }
  __device__ __forceinline__ bf16_t* qp() const { return reinterpret_cast<bf16_t*>(ws + WS_qp); }
  __device__ __forceinline__ float* sc() const { return reinterpret_cast<float*>(ws + WS_sc); }
  __device__ __forceinline__ int* eidx() const { return reinterpret_cast<int*>(ws + WS_eidx); }
  __device__ __forceinline__ float* egate() const { return reinterpret_cast<float*>(ws + WS_egate); }
  __device__ __forceinline__ float* esu() const { return reinterpret_cast<float*>(ws + WS_esu); }
  __device__ __forceinline__ float* ssp() const { return reinterpret_cast<float*>(ws + WS_ssp); }
  __device__ __forceinline__ int* tl() const { return reinterpret_cast<int*>(ws + WS_sc); }
};

__device__ __forceinline__ unsigned pack2(float a, float b) {
  f32x2 v = {a, b};
  bf16x2 r = __builtin_convertvector(v, bf16x2);
  return *reinterpret_cast<unsigned*>(&r);
}
__device__ __forceinline__ bf16_t f2bf(float a) { return (bf16_t)(pack2(a, 0.f) & 0xFFFFu); }
__device__ __forceinline__ float bf_lo(unsigned u) { return __uint_as_float(u << 16); }
__device__ __forceinline__ float bf_hi(unsigned u) { return __uint_as_float(u & 0xFFFF0000u); }
__device__ __forceinline__ float gelu_exact(float x) { return 0.5f * x * (1.f + erff(x * 0.70710678118654752f)); }
__device__ __forceinline__ float gelu_as(float z) {
  const float x = fabsf(z) * 0.70710678118654752f;
  const float t = __builtin_amdgcn_rcpf(fmaf(0.3275911f, x, 1.f));
  float pl = fmaf(1.061405429f, t, -1.453152027f);
  pl = fmaf(pl, t, 1.421413741f); pl = fmaf(pl, t, -0.284496736f); pl = fmaf(pl, t, 0.254829592f);
  const float e = __builtin_amdgcn_exp2f(-x * x * LOG2E);
  const float erfa = 1.f - pl * t * e;
  return 0.5f * z + 0.5f * fabsf(z) * erfa;
}
__device__ __forceinline__ float sigmoidf_(float x) { return 1.f / (1.f + __expf(-x)); }
__device__ __forceinline__ float shfl_up_l(float v, int d, int lane) {
  const int src = lane >= d ? lane - d : lane;
  return __int_as_float(__builtin_amdgcn_ds_bpermute(src << 2, __float_as_int(v)));
}
template <int CTRL>
__device__ __forceinline__ float dpp_f(float v) {
  return __builtin_bit_cast(float, __builtin_amdgcn_update_dpp(0, __builtin_bit_cast(int, v), CTRL, 0xf, 0xf, true));
}
__device__ __forceinline__ float swap16_sum(float x) {
  auto s = __builtin_amdgcn_permlane16_swap(__float_as_uint(x), __float_as_uint(x), false, false);
  return __uint_as_float(s[0]) + __uint_as_float(s[1]);
}
__device__ __forceinline__ float swap32_sum(float x) {
  auto s = __builtin_amdgcn_permlane32_swap(__float_as_uint(x), __float_as_uint(x), false, false);
  return __uint_as_float(s[0]) + __uint_as_float(s[1]);
}
__device__ __forceinline__ float swap16_max(float x) {
  auto s = __builtin_amdgcn_permlane16_swap(__float_as_uint(x), __float_as_uint(x), false, false);
  return fmaxf(__uint_as_float(s[0]), __uint_as_float(s[1]));
}
__device__ __forceinline__ float swap32_max(float x) {
  auto s = __builtin_amdgcn_permlane32_swap(__float_as_uint(x), __float_as_uint(x), false, false);
  return fmaxf(__uint_as_float(s[0]), __uint_as_float(s[1]));
}
__device__ __forceinline__ float row16_sum(float v) {
  v += dpp_f<0xB1>(v); v += dpp_f<0x4E>(v); v += dpp_f<0x141>(v); v += dpp_f<0x140>(v);
  return v;
}
__device__ __forceinline__ float row16_max(float v) {
  v = fmaxf(v, dpp_f<0xB1>(v)); v = fmaxf(v, dpp_f<0x4E>(v)); v = fmaxf(v, dpp_f<0x141>(v)); v = fmaxf(v, dpp_f<0x140>(v));
  return v;
}
__device__ __forceinline__ float wave_sum(float v) { return swap32_sum(swap16_sum(row16_sum(v))); }
__device__ __forceinline__ float wave_max(float v) { return swap32_max(swap16_max(row16_max(v))); }
__device__ __forceinline__ const float* xrow_in(const Params& p, int l, int t) {
  if (l == 0) return (t < NPROMPT) ? p.x_prompt() + (size_t)t * D_MODEL : p.x_sample() + (size_t)(t - NPROMPT) * D_MODEL;
  return p.x() + (size_t)t * D_MODEL;
}
__device__ __forceinline__ bf16x8 as_bf16x8(uint4 v) { return *reinterpret_cast<bf16x8*>(&v); }

__device__ __forceinline__ int tid_opaque() { int t = threadIdx.x; asm volatile("" : "+v"(t)); return t; }
__device__ __forceinline__ int sgpr_opaque(int v) { asm volatile("" : "+s"(v)); return v; }
__device__ __forceinline__ int bid_opaque(int v) { asm volatile("" : "+s"(v)); __builtin_assume(v >= 0); __builtin_assume(v < 1024); return v; }
__device__ __forceinline__ int nblk_opaque(int v) { asm volatile("" : "+s"(v)); __builtin_assume(v >= 1); __builtin_assume(v <= 1024); return v; }
#define LAS __attribute__((address_space(3)))
#ifndef PROBE
#define PROBE 0
#endif
#define SMEM_BYTES 73728

__device__ __forceinline__ void transpose_tile(const float* __restrict__ src, int lds, bf16_t* __restrict__ dst, int K, int n0, int k0,
                               int gate_skip, float* tile  ) {
  const int tid = tid_opaque();
  const int c = tid & 63, r0 = tid >> 6;
  int n = n0 + c;
  int col = n + ((gate_skip && n >= 2304) ? 8 : 0);
#pragma unroll 4
  for (int j = 0; j < 16; ++j) {
    int r = r0 + 4 * j;
    tile[r * 65 + c] = src[(size_t)(k0 + r) * lds + col];
  }
  __syncthreads();
  const int nn = tid >> 2, kg = (tid & 3) * 16;
  unsigned w[8];
#pragma unroll
  for (int j = 0; j < 8; ++j) w[j] = pack2(tile[(kg + 2 * j) * 65 + nn], tile[(kg + 2 * j + 1) * 65 + nn]);
  uint4* d = reinterpret_cast<uint4*>(dst + (size_t)(n0 + nn) * K + k0 + kg);
  d[0] = make_uint4(w[0], w[1], w[2], w[3]);
  d[1] = make_uint4(w[4], w[5], w[6], w[7]);
  __syncthreads();
}

__device__ __forceinline__ int rel_bucket_dev(int rel) {
  int ret = rel > 0 ? 16 : 0;
  int n = rel < 0 ? -rel : rel;
  int b;
  if (n < 8) b = n;
  else if (n < 12) b = 8;
  else if (n < 16) b = 9;
  else if (n < 23) b = 10;
  else if (n < 32) b = 11;
  else if (n < 46) b = 12;
  else if (n < 64) b = 13;
  else if (n < 91) b = 14;
  else b = 15;
  return ret + b;
}

__device__ __forceinline__ void prep_table_rows(const Params& p, int r0, int r1, int lane, int wv) {
  for (int r = r0 + wv; r < r1; r += 4) {
    const int tab = r >> 15, row = r & 32767;
    const float* src = (tab == 0 ? p.peer_u() : p.peer_v()) + (size_t)row * 1024 + lane * 16;
    float4 f0 = reinterpret_cast<const float4*>(src)[0], f1 = reinterpret_cast<const float4*>(src)[1];
    float4 f2 = reinterpret_cast<const float4*>(src)[2], f3 = reinterpret_cast<const float4*>(src)[3];
    float am = fmaxf(fmaxf(fmaxf(fabsf(f0.x), fabsf(f0.y)), fmaxf(fabsf(f0.z), fabsf(f0.w))),
                     fmaxf(fmaxf(fabsf(f1.x), fabsf(f1.y)), fmaxf(fabsf(f1.z), fabsf(f1.w))));
    am = fmaxf(am, fmaxf(fmaxf(fmaxf(fabsf(f2.x), fabsf(f2.y)), fmaxf(fabsf(f2.z), fabsf(f2.w))),
                         fmaxf(fmaxf(fabsf(f3.x), fabsf(f3.y)), fmaxf(fabsf(f3.z), fabsf(f3.w)))));
    am = wave_max(am);
    const float sc = am > 0.f ? 224.f / am : 1.f;
    int w0 = 0, w1 = 0, w2 = 0, w3 = 0;
    w0 = __builtin_amdgcn_cvt_pk_fp8_f32(f0.x * sc, f0.y * sc, w0, false); w0 = __builtin_amdgcn_cvt_pk_fp8_f32(f0.z * sc, f0.w * sc, w0, true);
    w1 = __builtin_amdgcn_cvt_pk_fp8_f32(f1.x * sc, f1.y * sc, w1, false); w1 = __builtin_amdgcn_cvt_pk_fp8_f32(f1.z * sc, f1.w * sc, w1, true);
    w2 = __builtin_amdgcn_cvt_pk_fp8_f32(f2.x * sc, f2.y * sc, w2, false); w2 = __builtin_amdgcn_cvt_pk_fp8_f32(f2.z * sc, f2.w * sc, w2, true);
    w3 = __builtin_amdgcn_cvt_pk_fp8_f32(f3.x * sc, f3.y * sc, w3, false); w3 = __builtin_amdgcn_cvt_pk_fp8_f32(f3.z * sc, f3.w * sc, w3, true);
    unsigned char* dst = (tab == 0 ? p.ub8() : p.vb8()) + (size_t)row * 1024 + lane * 16;
    *reinterpret_cast<uint4*>(dst) = make_uint4((unsigned)w0, (unsigned)w1, (unsigned)w2, (unsigned)w3);
    if (lane == 0) (tab == 0 ? p.us() : p.vs())[row] = am > 0.f ? am * (1.f / 224.f) : 1.f;
  }
}

__device__ __forceinline__ void ph_prep(const Params& p, char* smem, int bid, int nblk) {
  const int tid = tid_opaque();
  float* tile = reinterpret_cast<float*>(smem);
  for (int u = bid; u < 2 * 1472; u += nblk) {
    int l = u / 1472, r = u % 1472;
    if (r < 704) {
      int nt = r / 16, kt = r % 16;
      transpose_tile(p.w_in() + (size_t)l * 1024 * 2824, 2824, p.wt_in() + (size_t)l * NIN * 1024, 1024, nt * 64, kt * 64, 1, tile);
    } else if (r < 960) {
      r -= 704; int nt = r / 16, kt = r % 16;
      transpose_tile(p.w_out() + (size_t)l * 1024 * 1024, 1024, p.wt_out() + (size_t)l * 1024 * 1024, 1024, nt * 64, kt * 64, 0, tile);
    } else {
      r -= 960; int nt = r / 16, kt = r % 16;
      transpose_tile(p.peer_wq() + (size_t)l * 1024 * 2048, 2048, p.wt_pq() + (size_t)l * 2048 * 1024, 1024, nt * 64, kt * 64, 0, tile);
    }
  }
  for (int u = bid; u < 1024; u += nblk) {
    int kt = u & 15, h = (u >> 4) & 3, b = (u >> 6) & 7, l = u >> 9;
    const float* src = p.cache_v() + (((size_t)(l * 8 + b) * 1024 + kt * 64) * 4 + h) * 128;
    {
      int c = tid & 127, r0 = tid >> 7;
      for (int j = 0; j < 32; ++j) { int r = r0 + 2 * j; tile[r * 129 + c] = src[(size_t)r * 512 + c]; }
    }
    __syncthreads();
    {
      int dv = tid >> 1, half = tid & 1;
      bf16_t* dst = p.Vts() + ((size_t)((l * 8 + b) * 4 + h) * 128 + dv) * SKEYS + kt * 64 + half * 32;
      unsigned w[16];
#pragma unroll
      for (int j = 0; j < 16; ++j) {
        int pos0 = half * 32 + 2 * j;
        int blk = (pos0 >> 2) & 3;
        int oblk = (blk == 1) ? 2 : (blk == 2 ? 1 : blk);
        int key0 = (pos0 & ~15) + oblk * 4 + (pos0 & 3);
        w[j] = pack2(tile[key0 * 129 + dv], tile[(key0 + 1) * 129 + dv]);
      }
      uint4* d4 = reinterpret_cast<uint4*>(dst);
      d4[0] = make_uint4(w[0], w[1], w[2], w[3]);
      d4[1] = make_uint4(w[4], w[5], w[6], w[7]);
      d4[2] = make_uint4(w[8], w[9], w[10], w[11]);
      d4[3] = make_uint4(w[12], w[13], w[14], w[15]);
    }
    __syncthreads();
  }
  const size_t gtid = (size_t)bid * 256 + tid, gsz = (size_t)nblk * 256;
  {
    const size_t n8 = (size_t)2 * 16 * 128 * 128 / 8;
    for (size_t i = gtid; i < n8; i += gsz) {
      float4 a = reinterpret_cast<const float4*>(p.peer_keys())[2 * i], b = reinterpret_cast<const float4*>(p.peer_keys())[2 * i + 1];
      reinterpret_cast<uint4*>(p.keysb())[i] = make_uint4(pack2(a.x, a.y), pack2(a.z, a.w), pack2(b.x, b.y), pack2(b.z, b.w));
    }
  }
  {
    const size_t n8 = (size_t)2 * 8 * 1024 * 512 / 8;
    for (size_t i = gtid; i < n8; i += gsz) {
      size_t e = i * 8;
      size_t lb = e / (1024 * 512), rem = e % (1024 * 512);
      float4 a = reinterpret_cast<const float4*>(p.cache_k())[2 * i], b = reinterpret_cast<const float4*>(p.cache_k())[2 * i + 1];
      *reinterpret_cast<uint4*>(p.Kbs() + lb * (SKEYS * 512) + rem) = make_uint4(pack2(a.x, a.y), pack2(a.z, a.w), pack2(b.x, b.y), pack2(b.z, b.w));
    }
  }
  for (size_t i = gtid; i < 2 * 8 * 1024; i += gsz) {
    int l = (int)(i / 8192), r = (int)(i % 8192), g = r / 1024, k = r % 1024;
    p.wg()[i] = p.w_in()[((size_t)l * 1024 + k) * 2824 + 2304 + g];
  }
  {
    float* sp = reinterpret_cast<float*>(p.ws + WS_sp);
    for (size_t i = gtid; i < 262144; i += gsz) sp[SP_st_c + i] = p.in[4][i];
    for (size_t i = gtid; i < 4096; i += gsz) sp[SP_st_n + i] = p.in[5][i];
    for (size_t i = gtid; i < 64; i += gsz) sp[SP_st_m + i] = p.in[6][i];
    for (size_t i = gtid; i < 12288; i += gsz) sp[SP_st_conv + i] = p.in[7][i];
    for (size_t i = gtid; i < 2048; i += gsz) sp[SP_norm1_g + i] = p.in[8][i];
    for (size_t i = gtid; i < 256; i += gsz) sp[SP_da_subln_g + i] = p.in[11][i];
    for (size_t i = gtid; i < 2048; i += gsz) sp[SP_ml_conv_w + i] = p.in[13][i];
    for (size_t i = gtid; i < 512; i += gsz) sp[SP_ml_conv_b + i] = p.in[14][i];
    for (size_t i = gtid; i < 32768; i += gsz) sp[SP_ml_wq + i] = p.in[15][i];
    for (size_t i = gtid; i < 32768; i += gsz) sp[SP_ml_wk + i] = p.in[16][i];
    for (size_t i = gtid; i < 16; i += gsz) sp[SP_ml_gate_b + i] = p.in[17][i];
    for (size_t i = gtid; i < 512; i += gsz) sp[SP_ml_norm_g + i] = p.in[18][i];
    for (size_t i = gtid; i < 512; i += gsz) sp[SP_ml_skip + i] = p.in[19][i];
    for (size_t i = gtid; i < 512; i += gsz) sp[SP_cm_norm_g + i] = p.in[20][i];
    for (size_t i = gtid; i < 131072; i += gsz) sp[SP_cm_ws + i] = p.in[21][i];
    for (size_t i = gtid; i < 1024; i += gsz) sp[SP_cm_b + i] = p.in[22][i];
    for (size_t i = gtid; i < 2048; i += gsz) sp[SP_norm2_g + i] = p.in[24][i];
    for (size_t i = gtid; i < 1024; i += gsz) sp[SP_final_g + i] = p.in[29][i];
  }
  if (bid == 0) {
    for (int i = tid; i < 4 * 256; i += 256) {
      int h = i >> 8, j = i & 255;
      int rel = j - 191; if (rel > 63) rel = 63;
      p.lut()[i] = p.rel_table()[rel_bucket_dev(rel) * 4 + h] * LOG2E;
    }
    if (tid < 2) {
      const float* lp = p.da_lambda() + tid * 256;
      float s01 = 0.f, s23 = 0.f;
      for (int d = 0; d < 64; ++d) { s01 += lp[d] * lp[64 + d]; s23 += lp[128 + d] * lp[192 + d]; }
      float lam_init = 0.8f - 0.6f * expf(-0.3f * (float)tid);
      p.lam()[tid] = expf(s01) - expf(s23) + lam_init;
    }
  }
}

__device__ __forceinline__ void ph_norm1_l0(const Params& p, char* smem, int bid, int nblk) {
  const int tid = tid_opaque(), lane = tid & 63, w = __builtin_amdgcn_readfirstlane(tid >> 6);
  float* s_wg = reinterpret_cast<float*>(smem);
  __syncthreads();
  for (int i = tid; i < 8192; i += 256) { const int k = i >> 3, g = i & 7; s_wg[g * 1024 + k] = p.w_in()[(size_t)k * 2824 + 2304 + g]; }
  __syncthreads();
  const float* gptr = p.in[8];
  float4 gv[4];
#pragma unroll
  for (int j = 0; j < 4; ++j) gv[j] = reinterpret_cast<const float4*>(gptr)[lane + 64 * j];
  for (int t = bid * 4 + w; t < NTOK; t += nblk * 4) {
    const float* xr = (t < NPROMPT) ? p.in[0] + (size_t)t * D_MODEL : p.in[1] + (size_t)(t - NPROMPT) * D_MODEL;
    float4 xv[4];
    float ss = 0.f;
#pragma unroll
    for (int j = 0; j < 4; ++j) {
      xv[j] = reinterpret_cast<const float4*>(xr)[lane + 64 * j];
      ss += xv[j].x * xv[j].x + xv[j].y * xv[j].y + xv[j].z * xv[j].z + xv[j].w * xv[j].w;
    }
    ss = wave_sum(ss);
    const float r = rsqrtf(ss * (1.f / 1024.f) + EPS);
#pragma unroll
    for (int j = 0; j < 4; ++j) { xv[j].x *= r * gv[j].x; xv[j].y *= r * gv[j].y; xv[j].z *= r * gv[j].z; xv[j].w *= r * gv[j].w; }
    uint2* o = reinterpret_cast<uint2*>(p.xn() + (size_t)t * 1024);
#pragma unroll
    for (int j = 0; j < 4; ++j) o[lane + 64 * j] = make_uint2(pack2(xv[j].x, xv[j].y), pack2(xv[j].z, xv[j].w));
    float pre[8];
#pragma unroll
    for (int i = 0; i < 8; ++i) {
      const float4* wr = reinterpret_cast<const float4*>(s_wg + i * 1024);
      float s = 0.f;
#pragma unroll
      for (int j = 0; j < 4; ++j) { const float4 wv = wr[lane + 64 * j]; s += xv[j].x * wv.x + xv[j].y * wv.y + xv[j].z * wv.z + xv[j].w * wv.w; }
      pre[i] = wave_sum(s);
    }
    if (lane < 4) {
      float a = pre[0]; a = lane == 1 ? pre[1] : a; a = lane == 2 ? pre[2] : a; a = lane == 3 ? pre[3] : a;
      float f = pre[4]; f = lane == 1 ? pre[5] : f; f = lane == 2 ? pre[6] : f; f = lane == 3 ? pre[7] : f;
      p.ig()[(size_t)t * 4 + lane] = a + p.in[17][lane];
      const float z = f + p.in[17][4 + lane];
      p.lf()[(size_t)t * 4 + lane] = fminf(z, 0.f) - log1pf(expf(-fabsf(z)));
    }
  }
}

template <int MODE>
__device__ __forceinline__ void ph_rmsnorm(const Params& p, int l, int bid, int nblk) {
  const int lane = tid_opaque() & 63, w = __builtin_amdgcn_readfirstlane(tid_opaque() >> 6);
  const float* g = (MODE == 0) ? p.norm1_g() + l * 1024 : (MODE == 1 ? p.norm2_g() + l * 1024 : p.final_g());
  float4 gv[4];
#pragma unroll
  for (int j = 0; j < 4; ++j) gv[j] = reinterpret_cast<const float4*>(g)[lane + 64 * j];
  for (int t = bid * 4 + w; t < NTOK; t += nblk * 4) {
    const float* xr = (MODE == 0) ? xrow_in(p, l, t) : p.x() + (size_t)t * 1024;
    float4 xv[4];
    float ss = 0.f;
#pragma unroll
    for (int j = 0; j < 4; ++j) {
      xv[j] = reinterpret_cast<const float4*>(xr)[lane + 64 * j];
      ss += xv[j].x * xv[j].x + xv[j].y * xv[j].y + xv[j].z * xv[j].z + xv[j].w * xv[j].w;
    }
    ss = wave_sum(ss);
    float r = rsqrtf(ss * (1.f / 1024.f) + EPS);
#pragma unroll
    for (int j = 0; j < 4; ++j) {
      xv[j].x *= r * gv[j].x; xv[j].y *= r * gv[j].y; xv[j].z *= r * gv[j].z; xv[j].w *= r * gv[j].w;
    }
    if (MODE == 2) {
      float* o = (t < NPROMPT) ? p.out + O_Y_P + (size_t)t * 1024 : p.out + O_Y_S + (size_t)(t - NPROMPT) * 1024;
#pragma unroll
      for (int j = 0; j < 4; ++j) reinterpret_cast<float4*>(o)[lane + 64 * j] = xv[j];
    } else {
      uint2* o = reinterpret_cast<uint2*>(p.xn() + (size_t)t * 1024);
#pragma unroll
      for (int j = 0; j < 4; ++j) o[lane + 64 * j] = make_uint2(pack2(xv[j].x, xv[j].y), pack2(xv[j].z, xv[j].w));
    }
    if (MODE == 0) {
      float pre[8];
#pragma unroll
      for (int i = 0; i < 8; ++i) {
        const float4* wr = reinterpret_cast<const float4*>(p.wg() + ((size_t)l * 8 + i) * 1024);
        float s = 0.f;
#pragma unroll
        for (int j = 0; j < 4; ++j) {
          float4 wv = wr[lane + 64 * j];
          s += xv[j].x * wv.x + xv[j].y * wv.y + xv[j].z * wv.z + xv[j].w * wv.w;
        }
        pre[i] = wave_sum(s);
      }
      if (lane < 4) {
        float a = pre[0]; a = lane == 1 ? pre[1] : a; a = lane == 2 ? pre[2] : a; a = lane == 3 ? pre[3] : a;
        float f = pre[4]; f = lane == 1 ? pre[5] : f; f = lane == 2 ? pre[6] : f; f = lane == 3 ? pre[7] : f;
        p.ig()[(size_t)t * 4 + lane] = a + p.ml_gate_b()[l * 8 + lane];
        float z = f + p.ml_gate_b()[l * 8 + 4 + lane];
        p.lf()[(size_t)t * 4 + lane] = fminf(z, 0.f) - log1pf(expf(-fabsf(z)));
      }
    }
  }
}

__device__ __forceinline__ int mono_key(float v) { int b = __float_as_int(v); return b ^ ((b >> 31) & 0x7FFFFFFF); }
__device__ __forceinline__ float mono_val(int k) { int b = k ^ ((k >> 31) & 0x7FFFFFFF); return __int_as_float(b); }

__device__ __forceinline__ int med3i(int a, int b, int c) { return max(min(a, b), min(max(a, b), c)); }
#define INS16(L, kv)                                                          \
  {                                                                           \
    const int _v = (kv);                                                      \
    _Pragma("unroll") for (int _j = 15; _j >= 1; --_j) L[_j] = med3i(L[_j - 1], L[_j], _v); \
    L[0] = max(L[0], _v);                                                     \
  }


enum { EPI_WIN = 0, EPI_WOUT = 1, EPI_PQ = 2, EPI_SC = 3 };

template <int EPI>
__device__ __forceinline__ void gemm_store(const Params& p, int l, int t, int n, float v) {
  if (EPI == EPI_WOUT) {
    const float* xi = xrow_in(p, l, t);
    p.x()[(size_t)t * 1024 + n] = xi[n] + v;
  } else if (EPI == EPI_PQ) {
    p.qp()[(size_t)t * 2048 + n] = f2bf(v);
  } else if (EPI == EPI_SC) {
    p.sc()[(size_t)t * 2048 + n] = v;
  }
}

template <int EPI>
__device__ __forceinline__ void ph_gemm(const Params& p, int l, char* smem, int bid, int nblk) {
  constexpr int NT = (EPI == EPI_WIN) ? 22 : (EPI == EPI_WOUT ? 8 : 16);
  constexpr int MT = NTOK / 128;
  constexpr int K = (EPI == EPI_SC) ? 128 : 1024;
  constexpr int NK = K / 64;
  const bf16_t* A; int lda; const bf16_t* Bt; int ldb;
  if (EPI == EPI_WIN) { A = p.xn(); lda = 1024; Bt = p.wt_in() + (size_t)l * NIN * 1024; ldb = 1024; }
  else if (EPI == EPI_WOUT) { A = p.xn(); lda = 1024; Bt = p.wt_out() + (size_t)l * 1024 * 1024; ldb = 1024; }
  else if (EPI == EPI_PQ) { A = p.xn(); lda = 1024; Bt = p.wt_pq() + (size_t)l * 2048 * 1024; ldb = 1024; }
  else { A = p.qp(); lda = 2048; Bt = p.keysb() + (size_t)l * 16 * 128 * 128; ldb = 128; }

  const int tid = tid_opaque(), lane = tid & 63, w = __builtin_amdgcn_readfirstlane(tid >> 6);
  const int wm = w >> 1, wn = w & 1, lr = lane & 31, lh = lane >> 5;
  char* sA = smem;
  char* sB = smem + 32768;
  const int ld_c = tid & 7, ld_r = tid >> 3;

  const int nx = nblk >> 3;
  constexpr int FG = MT / 8, LR = MT % 8;
  for (int rnd = 0;; ++rnd) {
    const int q = (nblk & 7) ? rnd * nblk + bid : rnd * nblk + (bid & 7) * nx + (bid >> 3);
    if (q >= MT * NT) break;
    int mt, nt;
    if (q < FG * 8 * NT) { const int mg = q / (8 * NT), rem = q % (8 * NT); nt = rem >> 3; mt = mg * 8 + (rem & 7); }
    else { const int q2 = q - FG * 8 * NT; nt = q2 / (LR > 0 ? LR : 1); mt = FG * 8 + q2 % (LR > 0 ? LR : 1); }
    const bf16_t* Ag = A + (size_t)(mt * 128) * lda + ((EPI == EPI_SC) ? nt * 128 : 0);
    const bf16_t* Bg = Bt + (size_t)(nt * 128) * ldb;
    f32x16 acc[2][2];
#pragma unroll
    for (int i = 0; i < 2; ++i)
#pragma unroll
      for (int j = 0; j < 2; ++j)
#pragma unroll
        for (int r = 0; r < 16; ++r) acc[i][j][r] = 0.f;

    const int g_row = w * 32 + (lane >> 3);
    const int g_pc = lane & 7;
    const bf16_t* Ath = Ag + (size_t)g_row * lda;
    const bf16_t* Bth = Bg + (size_t)g_row * ldb;
#define GEMM_STAGE(KT, BUF)                                                                                          \
  _Pragma("unroll") for (int j = 0; j < 4; ++j) {                                                                    \
    const int row = g_row + 8 * j;                                                                                   \
    const int cch = g_pc ^ ((row >> 1) & 7);                                                                         \
    __builtin_amdgcn_global_load_lds((const unsigned*)(Ath + (size_t)(8 * j) * lda + (KT) * 64 + cch * 8),           \
                                     (LAS unsigned*)(sA + (BUF) * 16384 + (w * 4 + j) * 1024 + lane * 16), 16, 0, 0); \
    __builtin_amdgcn_global_load_lds((const unsigned*)(Bth + (size_t)(8 * j) * ldb + (KT) * 64 + cch * 8),           \
                                     (LAS unsigned*)(sB + (BUF) * 16384 + (w * 4 + j) * 1024 + lane * 16), 16, 0, 0); \
  }
    GEMM_STAGE(0, 0)
    __syncthreads();
    for (int kt = 0; kt < NK; ++kt) {
      const int buf = kt & 1;
      if (kt + 1 < NK) { GEMM_STAGE(kt + 1, buf ^ 1) }
      const char* cA = sA + buf * 16384;
      const char* cB = sB + buf * 16384;
#pragma unroll
      for (int ks = 0; ks < 4; ++ks) {
        bf16x8 af[2], bfr[2];
#pragma unroll
        for (int i = 0; i < 2; ++i) {
          int row = wm * 64 + i * 32 + lr; int pc = (ks * 2 + lh) ^ ((row >> 1) & 7);
          af[i] = as_bf16x8(*reinterpret_cast<const uint4*>(cA + row * 128 + pc * 16));
        }
#pragma unroll
        for (int j = 0; j < 2; ++j) {
          int row = wn * 64 + j * 32 + lr; int pc = (ks * 2 + lh) ^ ((row >> 1) & 7);
          bfr[j] = as_bf16x8(*reinterpret_cast<const uint4*>(cB + row * 128 + pc * 16));
        }
#pragma unroll
        for (int i = 0; i < 2; ++i)
#pragma unroll
          for (int j = 0; j < 2; ++j)
            acc[i][j] = __builtin_amdgcn_mfma_f32_32x32x16_bf16(af[i], bfr[j], acc[i][j], 0, 0, 0);
      }
      __syncthreads();
    }
    if (EPI == EPI_PQ) {
      int lane_q = lane; asm volatile("" : "+v"(lane_q));
      const int lr = lane_q & 31, lh = lane_q >> 5;
      char* sA2 = smem;
      char* sB2 = smem + 32768;
      const bf16_t* kg = p.keysb() + ((size_t)l * 16 + nt) * 128 * 128;
#pragma unroll
      for (int jj = 0; jj < 8; ++jj) {
        const int I = w * 8 + jj;
        const int row = I * 4 + (lane_q >> 4);
        const int cch = (lane_q & 15) ^ (row & 15);
        __builtin_amdgcn_global_load_lds((const unsigned*)(kg + (size_t)row * 128 + cch * 8),
                                         (LAS unsigned*)(sB2 + I * 1024 + lane_q * 16), 16, 0, 0);
      }
#pragma unroll
      for (int i = 0; i < 2; ++i) {
        float rs[16];
#pragma unroll
        for (int r = 0; r < 16; ++r) rs[r] = 0.f;
#pragma unroll
        for (int j = 0; j < 2; ++j) {
          const int n = wn * 64 + j * 32 + lr;
#pragma unroll
          for (int r = 0; r < 16; ++r) {
            const int row = wm * 64 + i * 32 + (r & 3) + 8 * (r >> 2) + 4 * lh;
            const float v = acc[i][j][r];
            rs[r] += v * v;
            *reinterpret_cast<bf16_t*>(sA2 + row * 256 + (((n >> 3) ^ (row & 15)) * 16) + (n & 7) * 2) = f2bf(v);
          }
        }
#pragma unroll
        for (int r = 0; r < 16; ++r) {
          const float s = swap16_sum(row16_sum(rs[r]));
          if (lr == 0) {
            const int t = mt * 128 + wm * 64 + i * 32 + (r & 3) + 8 * (r >> 2) + 4 * lh;
            p.ssp()[(size_t)t * 32 + nt * 2 + wn] = s;
          }
        }
      }
      __syncthreads();
      f32x16 sc2[2][2];
#pragma unroll
      for (int i = 0; i < 2; ++i)
#pragma unroll
        for (int j = 0; j < 2; ++j)
#pragma unroll
          for (int r = 0; r < 16; ++r) sc2[i][j][r] = 0.f;
#pragma unroll
      for (int ks = 0; ks < 8; ++ks) {
        bf16x8 af[2], bfr[2];
#pragma unroll
        for (int i = 0; i < 2; ++i) {
          const int row = wm * 64 + i * 32 + lr;
          af[i] = as_bf16x8(*reinterpret_cast<const uint4*>(sA2 + row * 256 + (((ks * 2 + lh) ^ (row & 15)) * 16)));
        }
#pragma unroll
        for (int j = 0; j < 2; ++j) {
          const int row = wn * 64 + j * 32 + lr;
          bfr[j] = as_bf16x8(*reinterpret_cast<const uint4*>(sB2 + row * 256 + (((ks * 2 + lh) ^ (row & 15)) * 16)));
        }
#pragma unroll
        for (int i = 0; i < 2; ++i)
#pragma unroll
          for (int j = 0; j < 2; ++j)
            sc2[i][j] = __builtin_amdgcn_mfma_f32_32x32x16_bf16(af[i], bfr[j], sc2[i][j], 0, 0, 0);
      }
      __syncthreads();
      float* sS = reinterpret_cast<float*>(smem);
#pragma unroll
      for (int i = 0; i < 2; ++i)
#pragma unroll
        for (int j = 0; j < 2; ++j)
#pragma unroll
          for (int r = 0; r < 16; ++r) {
            const int row = wm * 64 + i * 32 + (r & 3) + 8 * (r >> 2) + 4 * lh;
            sS[row * 129 + wn * 64 + j * 32 + lr] = sc2[i][j][r];
          }
      __syncthreads();
      {
        int tq = tid; asm volatile("" : "+v"(tq));
        const int tk = tq & 127, hl = tq >> 7;
        int L[16];
#pragma unroll
        for (int j = 0; j < 16; ++j) L[j] = (int)0x80000000;
        const float* srow = sS + tk * 129 + hl * 64;
#pragma unroll 4
        for (int s = 0; s < 64; ++s) {
          const int key = (mono_key(srow[s]) & ~127) | (127 - (hl * 64 + s));
          INS16(L, key)
        }
        int4* dst = reinterpret_cast<int4*>(p.tl() + (((size_t)(mt * 128 + tk) * 16 + nt) * 2 + hl) * 16);
        dst[0] = make_int4(L[0], L[1], L[2], L[3]); dst[1] = make_int4(L[4], L[5], L[6], L[7]);
        dst[2] = make_int4(L[8], L[9], L[10], L[11]); dst[3] = make_int4(L[12], L[13], L[14], L[15]);
      }
      __syncthreads();
    } else if (EPI != EPI_WIN) {
#pragma unroll
      for (int i = 0; i < 2; ++i)
#pragma unroll
        for (int j = 0; j < 2; ++j)
#pragma unroll
          for (int r = 0; r < 16; ++r) {
            int t = mt * 128 + wm * 64 + i * 32 + (r & 3) + 8 * (r >> 2) + 4 * lh;
            int n = nt * 128 + wn * 64 + j * 32 + lr;
            gemm_store<EPI>(p, l, t, n, acc[i][j][r]);
          }
    } else {
      const int seg = nt >> 2;
#pragma unroll
      for (int i = 0; i < 2; ++i)
#pragma unroll
        for (int j = 0; j < 2; ++j) {
          const int n = nt * 128 + wn * 64 + j * 32 + lr;
          if (nt < 4) {
#pragma unroll
            for (int r = 0; r < 16; ++r) {
              int t = mt * 128 + wm * 64 + i * 32 + (r & 3) + 8 * (r >> 2) + 4 * lh;
              p.Qb()[(size_t)t * 512 + n] = f2bf(acc[i][j][r] * (0.125f * LOG2E));
            }
          } else if (nt < 8) {
            const int n2 = n - 512;
#pragma unroll
            for (int r = 0; r < 16; ++r) {
              int t = mt * 128 + wm * 64 + i * 32 + (r & 3) + 8 * (r >> 2) + 4 * lh;
              float v = acc[i][j][r];
              if (t < NPROMPT) {
                p.out[O_K_P + (size_t)l * (4 * 4096 * 512) + (size_t)t * 512 + n2] = v;
                p.Kb()[(size_t)t * 512 + n2] = f2bf(v);
              } else {
                int ts = t - NPROMPT, b = ts >> 6, ii = ts & 63;
                p.out[O_K_S + (size_t)l * (8 * 64 * 512) + (size_t)ts * 512 + n2] = v;
                p.Kbs()[((size_t)(l * 8 + b) * SKEYS + 1024 + ii) * 512 + n2] = f2bf(v);
              }
            }
          } else if (nt < 12) {
            const int n2 = n - 1024, h = n2 >> 7, dv = n2 & 127;
#pragma unroll
            for (int rg = 0; rg < 4; ++rg) {
              int tb = mt * 128 + wm * 64 + i * 32 + 8 * rg + 4 * lh;
              float v0 = acc[i][j][rg * 4 + 0], v1 = acc[i][j][rg * 4 + 1], v2 = acc[i][j][rg * 4 + 2], v3 = acc[i][j][rg * 4 + 3];
              uint2 pk = make_uint2(pack2(v0, v1), pack2(v2, v3));
              int posblk = 2 * lh + (rg & 1);
              if (tb < NPROMPT) {
                float* o = p.out + O_V_P + (size_t)l * (4 * 4096 * 512) + (size_t)tb * 512 + n2;
                o[0] = v0; o[512] = v1; o[1024] = v2; o[1536] = v3;
                int b = tb >> 12, s = tb & 4095;
                int pos = (s & ~15) + posblk * 4;
                *reinterpret_cast<uint2*>(p.Vt() + ((size_t)(b * 4 + h) * 128 + dv) * SEQ + pos) = pk;
              } else {
                int ts = tb - NPROMPT, b = ts >> 6, ii = ts & 63;
                float* o = p.out + O_V_S + (size_t)l * (8 * 64 * 512) + (size_t)ts * 512 + n2;
                o[0] = v0; o[512] = v1; o[1024] = v2; o[1536] = v3;
                int pos = 1024 + (ii & ~15) + posblk * 4;
                *reinterpret_cast<uint2*>(p.Vts() + ((size_t)((l * 8 + b) * 4 + h) * 128 + dv) * SKEYS + pos) = pk;
              }
            }
          } else {
            const int n2 = n - 1536;
            const bool act = (n >= 2304);
#pragma unroll
            for (int r = 0; r < 16; ++r) {
              int t = mt * 128 + wm * 64 + i * 32 + (r & 3) + 8 * (r >> 2) + 4 * lh;
              float v = acc[i][j][r];
              if (act) v = gelu_as(v);
              p.P5()[(size_t)t * 1280 + n2] = v;
            }
          }
        }
      (void)seg;
    }
  }
}

struct WorkQ { unsigned* cnt; volatile int* slot; int off; };
__device__ __forceinline__ int wq_next(const WorkQ& q) {
  __syncthreads();
  if (threadIdx.x == 0) *q.slot = (int)__hip_atomic_fetch_add(q.cnt, 1u, __ATOMIC_RELAXED, __HIP_MEMORY_SCOPE_AGENT);
  __syncthreads();
  return __builtin_amdgcn_readfirstlane(*q.slot) - q.off;
}

template <bool CONV>
__device__ __forceinline__ int ph_attn(const Params& p, int l, char* smem, const WorkQ& wq) {
  const int tid = tid_opaque(), lane = tid & 63, w = __builtin_amdgcn_readfirstlane(tid >> 6);
  const int c = w >> 1, qhalf = w & 1, lr = lane & 31, lh = lane >> 5;
  float* sLut = reinterpret_cast<float*>(smem + 65536);
  float* sO2 = reinterpret_cast<float*>(smem);
  const float lam = p.lam()[l];
  const float lam_init = 0.8f - 0.6f * expf(-0.3f * (float)l);

  constexpr int NSLOT = CONV ? 1584 : 1056;
  int slot, uu;
  for (slot = wq_next(wq); slot < NSLOT; slot = wq_next(wq)) {
    if (CONV) {
      if (slot % 3 == 2) {
        const int ch = slot / 3, r0 = ch * 125;
        prep_table_rows(p, r0, (r0 + 125 < 65536) ? r0 + 125 : 65536, lane, w);
        continue;
      }
      uu = (slot / 3) * 2 + (slot % 3);
    } else uu = slot;
    int b, h, qc, S, qrow0; const bf16_t *Kbase, *Vbase;
    bool samp = false; int u2 = uu;
    if (uu >= 752 && uu < 784) samp = true; else if (uu >= 784) u2 = uu - 32;
    if (!samp) {
      qc = 63 - (u2 >> 4); int bh = u2 & 15; b = bh >> 2; h = bh & 3; S = SEQ;
      Kbase = p.Kb() + (size_t)b * SEQ * 512 + h * 128;
      Vbase = p.Vt() + (size_t)(b * 4 + h) * 128 * SEQ;
      qrow0 = b * SEQ + qc * 64;
    } else {
      int us = uu - 752; b = us >> 2; h = us & 3; qc = 16; S = SKEYS;
      Kbase = p.Kbs() + (size_t)(l * 8 + b) * SKEYS * 512 + h * 128;
      Vbase = p.Vts() + (size_t)((l * 8 + b) * 4 + h) * 128 * SKEYS;
      qrow0 = NPROMPT + b * 64;
    }
    const int ntiles = qc + 1;
    __syncthreads();
    sLut[tid] = p.lut()[h * 256 + tid];
    if (tid < 128) sLut[256 + tid] = p.da_subln_g()[l * 128 + tid];
    bf16x8 qf[4];
    {
      const bf16_t* qrow = p.Qb() + (size_t)(qrow0 + qhalf * 32 + lr) * 512 + h * 128 + c * 64 + lh * 8;
#pragma unroll
      for (int ks = 0; ks < 4; ++ks) qf[ks] = as_bf16x8(*reinterpret_cast<const uint4*>(qrow + ks * 16));
    }
    f32x16 o[4];
#pragma unroll
    for (int d = 0; d < 4; ++d)
#pragma unroll
      for (int r = 0; r < 16; ++r) o[d][r] = 0.f;
    float m_run = -1e30f, l_run = 0.f;

    const char* Kt = reinterpret_cast<const char*>(Kbase);
    const char* Vb = reinterpret_cast<const char*>(Vbase);
    const int g_r8 = lane >> 3, g_pc = lane & 7;
#define ATTN_STAGE(KT, BUF)                                                                                         \
  _Pragma("unroll") for (int j = 0; j < 4; ++j) {                                                                   \
    const int I = w * 4 + j;                                                                                        \
    const int rk = (I & 7) * 8 + g_r8;                                                                              \
    const unsigned kof = (unsigned)rk * 1024u + (unsigned)(I >> 3) * 128u + (unsigned)((g_pc ^ ((rk >> 1) & 7)) * 16); \
    __builtin_amdgcn_global_load_lds((const unsigned*)(Kt + (size_t)(KT) * 65536 + kof),                            \
                                     (LAS unsigned*)(smem + (BUF) * 32768 + I * 1024 + lane * 16), 16, 0, 0);       \
    const int rv = I * 8 + g_r8;                                                                                    \
    const unsigned vof = (unsigned)rv * (unsigned)(S * 2) + (unsigned)((g_pc ^ ((rv >> 1) & 7)) * 16);              \
    __builtin_amdgcn_global_load_lds((const unsigned*)(Vb + (size_t)(KT) * 128 + vof),                              \
                                     (LAS unsigned*)(smem + (BUF) * 32768 + 16384 + I * 1024 + lane * 16), 16, 0, 0); \
  }
    ATTN_STAGE(0, 0)
    __syncthreads();
    for (int kt = 0; kt < ntiles; ++kt) {
      const int buf = kt & 1;
      if (kt + 1 < ntiles) { ATTN_STAGE(kt + 1, buf ^ 1) }
      const char* sK = smem + buf * 32768;
      const char* sV = sK + 16384;
      f32x16 s[2];
      {
        bf16x8 kf[2][4];
#pragma unroll
        for (int kb = 0; kb < 2; ++kb)
#pragma unroll
          for (int ks = 0; ks < 4; ++ks) {
            int row = kb * 32 + lr; int pc = (ks * 2 + lh) ^ ((row >> 1) & 7);
            kf[kb][ks] = as_bf16x8(*reinterpret_cast<const uint4*>(sK + c * 8192 + row * 128 + pc * 16));
          }
#pragma unroll
        for (int kb = 0; kb < 2; ++kb) {
#pragma unroll
          for (int r = 0; r < 16; ++r) s[kb][r] = 0.f;
#pragma unroll
          for (int ks = 0; ks < 4; ++ks) s[kb] = __builtin_amdgcn_mfma_f32_32x32x16_bf16(kf[kb][ks], qf[ks], s[kb], 0, 0, 0);
        }
      }
      bf16x8 vfa[2][4];
#pragma unroll
      for (int k2 = 0; k2 < 2; ++k2)
#pragma unroll
        for (int d = 0; d < 4; ++d) {
          int row = d * 32 + lr; int pc = (k2 * 2 + lh) ^ ((row >> 1) & 7);
          vfa[k2][d] = as_bf16x8(*reinterpret_cast<const uint4*>(sV + row * 128 + pc * 16));
        }
      float boff = sLut[0];
      if (kt >= qc - 2) {
        const int base = (kt - qc) * 64 - (qhalf * 32 + lr) + 191 + 4 * lh;
#pragma unroll
        for (int kb = 0; kb < 2; ++kb)
#pragma unroll
          for (int r = 0; r < 16; ++r) s[kb][r] += sLut[base + kb * 32 + (r & 3) + 8 * (r >> 2)];
        boff = 0.f;
      }
      float mx = s[0][0];
#pragma unroll
      for (int kb = 0; kb < 2; ++kb)
#pragma unroll
        for (int r = 0; r < 16; ++r) mx = fmaxf(mx, s[kb][r]);
      mx = swap32_max(mx) + boff;
      if (__any(mx > m_run + 6.0f)) {
        const float m_new = fmaxf(m_run, mx);
        const float alpha = __builtin_amdgcn_exp2f(m_run - m_new);
        m_run = m_new;
        l_run *= alpha;
#pragma unroll
        for (int d = 0; d < 4; ++d)
#pragma unroll
          for (int r = 0; r < 16; ++r) o[d][r] *= alpha;
      }
      const float eoff = boff - m_run;
      float ps = 0.f;
#pragma unroll
      for (int kb = 0; kb < 2; ++kb)
#pragma unroll
        for (int r = 0; r < 16; ++r) { float pv = __builtin_amdgcn_exp2f(s[kb][r] + eoff); s[kb][r] = pv; ps += pv; }
      l_run += ps;
      bf16x8 pf[4];
#pragma unroll
      for (int ks2 = 0; ks2 < 4; ++ks2) {
        const int kb = ks2 >> 1, sh = (ks2 & 1) * 8;
        uint4 pw = make_uint4(pack2(s[kb][sh + 0], s[kb][sh + 1]), pack2(s[kb][sh + 2], s[kb][sh + 3]),
                              pack2(s[kb][sh + 4], s[kb][sh + 5]), pack2(s[kb][sh + 6], s[kb][sh + 7]));
        pf[ks2] = as_bf16x8(pw);
      }
#define ATTN_VREAD(DST, K2)                                                                        \
  _Pragma("unroll") for (int d = 0; d < 4; ++d) {                                                  \
    int row = d * 32 + lr; int pc = ((K2) * 2 + lh) ^ ((row >> 1) & 7);                            \
    DST[d] = as_bf16x8(*reinterpret_cast<const uint4*>(sV + row * 128 + pc * 16));                 \
  }
#define ATTN_PV(SRC, K2) \
  _Pragma("unroll") for (int d = 0; d < 4; ++d) o[d] = __builtin_amdgcn_mfma_f32_32x32x16_bf16(SRC[d], pf[K2], o[d], 0, 0, 0);
      bf16x8 vfc[4];
      ATTN_VREAD(vfc, 2)
      ATTN_PV(vfa[0], 0)
      ATTN_VREAD(vfa[0], 3)
      ATTN_PV(vfa[1], 1)
      ATTN_PV(vfc, 2)
      ATTN_PV(vfa[0], 3)
      __syncthreads();
    }
    int lane_e = (int)__builtin_amdgcn_mbcnt_hi(~0u, __builtin_amdgcn_mbcnt_lo(~0u, 0u)); asm volatile("" : "+v"(lane_e));
    const int lr_e = lane_e & 31, lh_e = lane_e >> 5;
    float lt = swap32_sum(l_run);
    float inv = 1.f / lt;
    __syncthreads();
    if (c == 1) {
#pragma unroll
      for (int d = 0; d < 4; ++d)
#pragma unroll
        for (int r = 0; r < 16; ++r) sO2[(qhalf * 64 + d * 16 + r) * 64 + lane_e] = o[d][r] * inv;
    }
    __syncthreads();
    if (c == 0) {
      float ss = 0.f;
#pragma unroll
      for (int d = 0; d < 4; ++d)
#pragma unroll
        for (int r = 0; r < 16; ++r) {
          float v = o[d][r] * inv - lam * sO2[(qhalf * 64 + d * 16 + r) * 64 + lane_e];
          o[d][r] = v; ss += v * v;
        }
      ss = swap32_sum(ss);
      const float rn = rsqrtf(ss * (1.f / 128.f) + EPS) * (1.f - lam_init);
      const float* gs = sLut + 256;
      bf16_t* orow = p.xn() + (size_t)(qrow0 + qhalf * 32 + lr_e) * 1024 + h * 128;
#pragma unroll
      for (int d = 0; d < 4; ++d)
#pragma unroll
        for (int rg = 0; rg < 4; ++rg) {
          int dv = d * 32 + 8 * rg + 4 * lh_e;
          float4 g4 = *reinterpret_cast<const float4*>(gs + dv);
          uint2 pk = make_uint2(pack2(o[d][rg * 4 + 0] * rn * g4.x, o[d][rg * 4 + 1] * rn * g4.y),
                                pack2(o[d][rg * 4 + 2] * rn * g4.z, o[d][rg * 4 + 3] * rn * g4.w));
          *reinterpret_cast<uint2*>(orow + dv) = pk;
        }
    }
  }
  return slot - NSLOT + 1056;
}

template <int K>
__device__ __forceinline__ void mfma32_f32(f32x16& acc, const float* a, int a_rs, int a_ks, const float* b, int b_ks, int b_js, int lane) {
  const float* ap = a + (lane & 31) * a_rs + (lane >> 5) * a_ks;
  const float* bp = b + (lane >> 5) * b_ks + (lane & 31) * b_js;
#pragma unroll 8
  for (int k = 0; k < K; k += 2) acc = __builtin_amdgcn_mfma_f32_32x32x2f32(ap[k * a_ks], bp[k * b_ks], acc, 0, 0, 0);
}
__device__ __forceinline__ void zero16(f32x16& a) {
#pragma unroll
  for (int r = 0; r < 16; ++r) a[r] = 0.f;
}

__device__ __forceinline__ int ph_mlconv(const Params& p, int l, char* smem, const WorkQ& wq, int item) {
  const int tid = tid_opaque();
  float* s_mc = reinterpret_cast<float*>(smem);
  float* s_cc = s_mc + 67 * 64;
  float* s_wq = s_cc + 64 * 65;
  float* s_wk = s_wq + 4096;
  for (; item < 1056 + 264 * 4; item = wq_next(wq)) {
    const int u = item - 1056;
    const int ci = u >> 2, h = u & 3;
    int token0, bq; bool samp = ci >= 256;
    if (!samp) token0 = ci * 64; else token0 = NPROMPT + (ci - 256) * 64;
    bq = samp ? (ci - 256) : (ci >> 6);
    const int cidx = samp ? 0 : (ci & 63);
    __syncthreads();
    for (int i = tid; i < 67 * 64; i += 256) {
      int r = i >> 6, d = i & 63;
      float v;
      if (r >= 3) v = p.P5()[(size_t)(token0 + r - 3) * 1280 + h * 64 + d];
      else if (samp) v = p.st_conv()[((size_t)(l * 8 + bq) * 3 + r) * 256 + h * 64 + d];
      else if (cidx == 0) v = 0.f;
      else v = p.P5()[(size_t)(token0 + r - 3) * 1280 + h * 64 + d];
      s_mc[i] = v;
    }
    for (int i = tid; i < 4096; i += 256) {
      s_wq[i] = p.ml_wq()[(size_t)(l * 4 + h) * 4096 + i];
      s_wk[i] = p.ml_wk()[(size_t)(l * 4 + h) * 4096 + i];
    }
    __syncthreads();
    {
      const int d = tid & 63, t0 = tid >> 6;
      const int ch = h * 64 + d;
      const float w0 = p.ml_conv_w()[(l * 4 + 0) * 256 + ch], w1 = p.ml_conv_w()[(l * 4 + 1) * 256 + ch];
      const float w2 = p.ml_conv_w()[(l * 4 + 2) * 256 + ch], w3 = p.ml_conv_w()[(l * 4 + 3) * 256 + ch];
      const float bb = p.ml_conv_b()[l * 256 + ch];
      for (int t = t0; t < 64; t += 4) {
        float y = bb + w0 * s_mc[t * 64 + d] + w1 * s_mc[(t + 1) * 64 + d] + w2 * s_mc[(t + 2) * 64 + d] + w3 * s_mc[(t + 3) * 64 + d];
        y = y * sigmoidf_(y);
        s_cc[t * 65 + d] = y;
        p.cc()[(size_t)(token0 + t) * 256 + ch] = y;
      }
      if (samp || cidx == 63) {
        if (tid < 192) {
          int r = tid >> 6;
          float v = s_mc[(64 + r) * 64 + d];
          if (samp) p.out[O_CONV_S + ((size_t)(l * 8 + bq) * 3 + r) * 256 + ch] = v;
          else p.out[O_CONV_P + ((size_t)(l * 4 + bq) * 3 + r) * 256 + ch] = v;
        }
      }
    }
    __syncthreads();
    {
      const int lane = tid & 63, w = __builtin_amdgcn_readfirstlane(tid >> 6), ti = w >> 1, tj = w & 1;
      f32x16 aq, ak; zero16(aq); zero16(ak);
      mfma32_f32<64>(aq, s_cc + ti * 32 * 65, 65, 1, s_wq + tj * 32, 64, 1, lane);
      mfma32_f32<64>(ak, s_cc + ti * 32 * 65, 65, 1, s_wk + tj * 32, 64, 1, lane);
#pragma unroll
      for (int r = 0; r < 16; ++r) {
        const int t = ti * 32 + (r & 3) + 8 * (r >> 2) + 4 * (lane >> 5);
        const size_t o = (size_t)(token0 + t) * 256 + h * 64 + tj * 32 + (lane & 31);
        p.qm()[o] = aq[r];
        p.km()[o] = ak[r] * 0.125f;
      }
      if (w == 0) {
        const int t = token0 + lane;
        const float lfv = p.lf()[(size_t)t * 4 + h], igv = p.ig()[(size_t)t * 4 + h];
        float F = lfv;
#pragma unroll
        for (int d = 1; d < 64; d <<= 1) { float n = shfl_up_l(F, d, lane); if (lane >= d) F += n; }
        const float FL = __int_as_float(__builtin_amdgcn_readlane(__float_as_int(F), 63));
        const float mx = wave_max(FL - F + igv);
        p.Fc()[(size_t)t * 4 + h] = F;
        if (lane == 0) {
          const int cu = samp ? 1024 + bq * 4 + h : (bq * 4 + h) * 64 + cidx;
          p.FLs()[cu] = FL; p.mxt()[cu] = mx;
        }
      }
    }
  }
  return item;
}

__device__ __forceinline__ void cu_decode(int cu, int& token0, int& h) {
  if (cu < 1024) { int bh = cu >> 6, c = cu & 63; token0 = (bh >> 2) * SEQ + c * 64; h = bh & 3; }
  else { int us = cu - 1024; token0 = NPROMPT + (us >> 2) * 64; h = us & 3; }
}

__device__ __forceinline__ void ph_mlU(const Params& p, int l, char* smem, int bid, int nblk) {
  const int tid = tid_opaque();
  const int lane = tid & 63, w = __builtin_amdgcn_readfirstlane(tid >> 6), ti = w >> 1, tj = w & 1;
  float* s_k = reinterpret_cast<float*>(smem);
  float* s_v = s_k + 4096;
  for (int cu = bid; cu < NCU_UNITS; cu += nblk) {
    int token0, h; cu_decode(cu, token0, h);
    float m0, mn, FL;
    {
      const bool samp = cu >= 1024;
      const int cu0 = samp ? cu : (cu & ~63), c = samp ? 0 : (cu & 63);
      float flv = 0.f, mxv = 0.f;
      if (lane <= c) { flv = p.FLs()[cu0 + lane]; mxv = p.mxt()[cu0 + lane]; }
      float m = samp ? p.st_m()[l * 32 + (cu - 1024)] : 0.f;
      for (int j = 0; j < c; ++j) {
        const float fj = __int_as_float(__builtin_amdgcn_readlane(__float_as_int(flv), j));
        const float xj = __int_as_float(__builtin_amdgcn_readlane(__float_as_int(mxv), j));
        m = fmaxf(fj + m, xj);
      }
      FL = __int_as_float(__builtin_amdgcn_readlane(__float_as_int(flv), c));
      const float xc = __int_as_float(__builtin_amdgcn_readlane(__float_as_int(mxv), c));
      m0 = m; mn = fmaxf(FL + m, xc);
      if (tid == 0) {
        p.mst()[cu] = m0; p.mnx()[cu] = mn; p.wcs()[cu] = expf(FL + m0 - mn);
        if (samp) p.out[O_M_S + l * 32 + (cu - 1024)] = mn;
        else if (c == 63) p.out[O_M_P + l * 16 + (cu >> 6)] = mn;
      }
    }
    __syncthreads();
    for (int i = tid; i < 1024; i += 256) {
      int s = i >> 4, d4 = (i & 15) * 4;
      const int t = token0 + s;
      float wsv = expf(FL - p.Fc()[(size_t)t * 4 + h] + p.ig()[(size_t)t * 4 + h] - mn);
      float4 k4 = *reinterpret_cast<const float4*>(p.km() + (size_t)t * 256 + h * 64 + d4);
      float4 v4 = *reinterpret_cast<const float4*>(p.P5() + (size_t)t * 1280 + 256 + h * 64 + d4);
      *reinterpret_cast<float4*>(s_k + s * 64 + d4) = make_float4(k4.x * wsv, k4.y * wsv, k4.z * wsv, k4.w * wsv);
      *reinterpret_cast<float4*>(s_v + s * 64 + d4) = v4;
    }
    __syncthreads();
    f32x16 acc; zero16(acc);
    mfma32_f32<64>(acc, s_k + ti * 32, 1, 64, s_v + tj * 32, 64, 1, lane);
#pragma unroll
    for (int r = 0; r < 16; ++r) {
      const int d = ti * 32 + (r & 3) + 8 * (r >> 2) + 4 * (lane >> 5);
      p.U()[(size_t)cu * 4096 + d * 64 + tj * 32 + (lane & 31)] = acc[r];
    }
    if (tid < 64) {
      float s0 = 0.f;
      for (int s = 0; s < 64; ++s) s0 += s_k[s * 64 + tid];
      p.un()[(size_t)cu * 64 + tid] = s0;
    }
  }
}

__device__ __forceinline__ void ph_mlscan(const Params& p, int l, int bid, int nblk) {
  const size_t gtid = (size_t)bid * 256 + tid_opaque(), gsz = (size_t)nblk * 256;
  const size_t NPC = 16 * 4096, NSC = 32 * 4096, NPN = 16 * 64, NSN = 32 * 64;
  for (size_t i = gtid; i < NPC + NSC + NPN + NSN; i += gsz) {
    if (i < NPC) {
      int bh = (int)(i >> 12), e = (int)(i & 4095);
      float C = 0.f;
      for (int c = 0; c < 64; ++c) {
        int cu = bh * 64 + c;
        p.Cst()[(size_t)cu * 4096 + e] = C;
        C = p.wcs()[cu] * C + p.U()[(size_t)cu * 4096 + e];
      }
      p.out[O_C_P + (size_t)l * (16 * 4096) + i] = C;
    } else if (i < NPC + NSC) {
      size_t j = i - NPC; int us = (int)(j >> 12), e = (int)(j & 4095); int cu = 1024 + us;
      float C = p.st_c()[(size_t)l * (32 * 4096) + j];
      p.Cst()[(size_t)cu * 4096 + e] = C;
      p.out[O_C_S + (size_t)l * (32 * 4096) + j] = p.wcs()[cu] * C + p.U()[(size_t)cu * 4096 + e];
    } else if (i < NPC + NSC + NPN) {
      size_t j = i - NPC - NSC; int bh = (int)(j >> 6), d = (int)(j & 63);
      float n = 0.f;
      for (int c = 0; c < 64; ++c) {
        int cu = bh * 64 + c;
        p.nst()[(size_t)cu * 64 + d] = n;
        n = p.wcs()[cu] * n + p.un()[(size_t)cu * 64 + d];
      }
      p.out[O_N_P + (size_t)l * (16 * 64) + j] = n;
    } else {
      size_t j = i - NPC - NSC - NPN; int us = (int)(j >> 6), d = (int)(j & 63); int cu = 1024 + us;
      float n = p.st_n()[(size_t)l * (32 * 64) + j];
      p.nst()[(size_t)cu * 64 + d] = n;
      p.out[O_N_S + (size_t)l * (32 * 64) + j] = p.wcs()[cu] * n + p.un()[(size_t)cu * 64 + d];
    }
  }
}

__device__ __forceinline__ void ph_mlout(const Params& p, int l, char* smem, int bid, int nblk) {
  const int tid = tid_opaque();
  float* s_q = reinterpret_cast<float*>(smem);
  float* s_k = s_q + 64 * 65;
  float* s_v = s_k + 64 * 65;
  float* s_C = s_v + 4096;
  float* s_F = s_C + 4096;
  float* s_a = s_F + 64;
  float* s_mt = s_a + 64;
  float* s_iw = s_mt + 64;
  float* s_n = s_iw + 64;
  float* s_den = s_n + 64;
  float* s_denp = s_den + 64;
  float* s_qn = s_denp + 128;
  for (int cu = bid; cu < NCU_UNITS; cu += nblk) {
    int token0, h; cu_decode(cu, token0, h);
    const float m0 = p.mst()[cu];
    __syncthreads();
    for (int i = tid; i < 1024; i += 256) {
      int s = i >> 4, d4 = (i & 15) * 4;
      const int t = token0 + s;
      float4 q4 = *reinterpret_cast<const float4*>(p.qm() + (size_t)t * 256 + h * 64 + d4);
      float4 k4 = *reinterpret_cast<const float4*>(p.km() + (size_t)t * 256 + h * 64 + d4);
      float4 v4 = *reinterpret_cast<const float4*>(p.P5() + (size_t)t * 1280 + 256 + h * 64 + d4);
      float4 c4 = *reinterpret_cast<const float4*>(p.Cst() + (size_t)cu * 4096 + s * 64 + d4);
      s_q[s * 65 + d4] = q4.x; s_q[s * 65 + d4 + 1] = q4.y; s_q[s * 65 + d4 + 2] = q4.z; s_q[s * 65 + d4 + 3] = q4.w;
      s_k[s * 65 + d4] = k4.x; s_k[s * 65 + d4 + 1] = k4.y; s_k[s * 65 + d4 + 2] = k4.z; s_k[s * 65 + d4 + 3] = k4.w;
      *reinterpret_cast<float4*>(s_v + s * 64 + d4) = v4;
      *reinterpret_cast<float4*>(s_C + s * 64 + d4) = c4;
    }
    if (tid < 64) {
      const int t = token0 + tid;
      float F = p.Fc()[(size_t)t * 4 + h], g = p.ig()[(size_t)t * 4 + h];
      s_F[tid] = F; s_a[tid] = g - F;
      s_n[tid] = p.nst()[(size_t)cu * 64 + tid];
    }
    __syncthreads();
    if (tid < 64) {
      float pm = s_a[tid];
#pragma unroll
      for (int d = 1; d < 64; d <<= 1) { const float o = shfl_up_l(pm, d, tid); if (tid >= d) pm = fmaxf(pm, o); }
      float F = s_F[tid];
      float mt = F + fmaxf(m0, pm);
      s_mt[tid] = mt;
      s_iw[tid] = expf(F + m0 - mt);
    }
    __syncthreads();
    const int lane = tid & 63, w = __builtin_amdgcn_readfirstlane(tid >> 6), ti = w >> 1, tj = w & 1;
    const int ty = tid >> 4, tx = tid & 15;
    {
      f32x16 accS; zero16(accS);
      mfma32_f32<64>(accS, s_q + ti * 32 * 65, 65, 1, s_k + tj * 32 * 65, 1, 65, lane);
      __syncthreads();
      const int s = tj * 32 + (lane & 31);
      const float as = s_a[s];
#pragma unroll
      for (int r = 0; r < 16; ++r) {
        const int t = ti * 32 + (r & 3) + 8 * (r >> 2) + 4 * (lane >> 5);
        const float sw = (s <= t) ? accS[r] * expf(s_F[t] + as - s_mt[t]) : 0.f;
        s_k[t * 65 + s] = sw;
        const float rsum = swap16_sum(row16_sum(sw));
        if ((lane & 31) == 0) s_denp[tj * 64 + t] = rsum;
      }
    }
    {
      const int t = tid >> 2, part = tid & 3;
      float qn = 0.f;
#pragma unroll
      for (int d = 0; d < 16; ++d) qn += s_q[t * 65 + part * 16 + d] * s_n[part * 16 + d];
      qn += dpp_f<0xB1>(qn); qn += dpp_f<0x4E>(qn);
      if (part == 0) s_qn[t] = qn;
    }
    __syncthreads();
    if (tid < 64) s_den[tid] = s_denp[tid] + s_denp[64 + tid] + s_iw[tid] * s_qn[tid];
    {
      f32x16 accN, accC; zero16(accN); zero16(accC);
      mfma32_f32<64>(accN, s_k + ti * 32 * 65, 65, 1, s_v + tj * 32, 64, 1, lane);
      mfma32_f32<64>(accC, s_q + ti * 32 * 65, 65, 1, s_C + tj * 32, 64, 1, lane);
      __syncthreads();
#pragma unroll
      for (int r = 0; r < 16; ++r) {
        const int t = ti * 32 + (r & 3) + 8 * (r >> 2) + 4 * (lane >> 5);
        s_q[t * 65 + tj * 32 + (lane & 31)] = accN[r] + s_iw[t] * accC[r];
      }
    }
    __syncthreads();
#pragma unroll
    for (int i = 0; i < 4; ++i) {
      const int t = ty * 4 + i;
      const float dn = fmaxf(fabsf(s_den[t]), expf(-s_mt[t]));
      float hv[4]; float ss = 0.f;
#pragma unroll
      for (int j = 0; j < 4; ++j) { hv[j] = s_q[t * 65 + tx * 4 + j] / dn; ss += hv[j] * hv[j]; }
      ss = row16_sum(ss);
      const float rn = rsqrtf(ss * (1.f / 64.f) + EPS);
      const int ch = h * 64 + tx * 4;
      const size_t tg = (size_t)(token0 + t);
      float4 g4 = *reinterpret_cast<const float4*>(p.ml_norm_g() + l * 256 + ch);
      float4 k4 = *reinterpret_cast<const float4*>(p.ml_skip() + l * 256 + ch);
      float4 c4 = *reinterpret_cast<const float4*>(p.cc() + tg * 256 + ch);
      float4 o4 = *reinterpret_cast<const float4*>(p.P5() + tg * 1280 + 512 + ch);
      float r0 = (hv[0] * rn * g4.x + k4.x * c4.x) * sigmoidf_(o4.x);
      float r1 = (hv[1] * rn * g4.y + k4.y * c4.y) * sigmoidf_(o4.y);
      float r2 = (hv[2] * rn * g4.z + k4.z * c4.z) * sigmoidf_(o4.z);
      float r3 = (hv[3] * rn * g4.w + k4.w * c4.w) * sigmoidf_(o4.w);
      *reinterpret_cast<uint2*>(p.xn() + tg * 1024 + 512 + ch) = make_uint2(pack2(r0, r1), pack2(r2, r3));
    }
  }
}

__device__ __forceinline__ void ph_cmlp(const Params& p, int l, char* smem, const WorkQ& wq, int item) {
  const int tid = tid_opaque(), lane = tid & 63, w = __builtin_amdgcn_readfirstlane(tid >> 6);
  float* s_vg = reinterpret_cast<float*>(smem);
  float* s_ws = s_vg + 128 * 64;
  float* s_r = s_ws + 128 * 33;
  for (; item < 1056 + 264 * 4 + 544; item = wq_next(wq)) {
    const int u = item - (1056 + 264 * 4);
    const int g = u & 3, ci = u >> 2;
    const bool samp = ci >= 128;
    const int L = samp ? 64 : 128;
    const int token0 = samp ? NPROMPT + (ci - 128) * 64 : ci * 128;
    __syncthreads();
    for (int r = w; r < L; r += 4) {
      float4 v = *reinterpret_cast<const float4*>(p.P5() + (size_t)(token0 + r) * 1280 + 1024 + lane * 4);
      float ss = v.x * v.x + v.y * v.y + v.z * v.z + v.w * v.w;
      ss = wave_sum(ss);
      if (lane == 0) s_r[r] = rsqrtf(ss * (1.f / 256.f) + EPS);
    }
    __syncthreads();
    for (int i = tid; i < L * 16; i += 256) {
      int s = i >> 4, d4 = (i & 15) * 4;
      float4 v = *reinterpret_cast<const float4*>(p.P5() + (size_t)(token0 + s) * 1280 + 1024 + g * 64 + d4);
      float4 gn = *reinterpret_cast<const float4*>(p.cm_norm_g() + l * 256 + g * 64 + d4);
      float r = s_r[s];
      float4 o = make_float4(v.x * r * gn.x, v.y * r * gn.y, v.z * r * gn.z, v.w * r * gn.w);
      *reinterpret_cast<float4*>(s_vg + s * 64 + d4) = o;
      if (samp) {
        int ts = token0 - NPROMPT + s;
        *reinterpret_cast<float4*>(p.out + O_CMV_S + (size_t)l * (512 * 256) + (size_t)ts * 256 + g * 64 + d4) = o;
      }
    }
    const int rtA = (w < 2) ? 3 : 2, rtB = (w < 2) ? 0 : 1, ct = w & 1;
    const int nrt = L >> 5;
    f32x16 accA, accB; zero16(accA); zero16(accB);
    const float* wsg = p.cm_ws() + (size_t)(l * 4 + g) * 128 * 128;
    for (int s0 = 0; s0 < L; s0 += 32) {
      __syncthreads();
      for (int i = tid; i < L * 32; i += 256) {
        int t = i >> 5, ss = i & 31;
        s_ws[t * 33 + ss] = (s0 + ss <= t) ? wsg[t * 128 + s0 + ss] : 0.f;
      }
      __syncthreads();
      const int c = s0 >> 5;
      if (rtA < nrt && c <= rtA) mfma32_f32<32>(accA, s_ws + rtA * 32 * 33, 33, 1, s_vg + s0 * 64 + ct * 32, 64, 1, lane);
      if (rtB < nrt && c <= rtB) mfma32_f32<32>(accB, s_ws + rtB * 32 * 33, 33, 1, s_vg + s0 * 64 + ct * 32, 64, 1, lane);
    }
    __syncthreads();
#pragma unroll
    for (int r = 0; r < 16; ++r) {
      const int tr = (r & 3) + 8 * (r >> 2) + 4 * (lane >> 5);
      if (rtA < nrt) s_vg[(rtA * 32 + tr) * 64 + ct * 32 + (lane & 31)] = accA[r];
      if (rtB < nrt) s_vg[(rtB * 32 + tr) * 64 + ct * 32 + (lane & 31)] = accB[r];
    }
    __syncthreads();
    {
      const int ty = tid >> 4, tx = tid & 15;
      if (ty * 8 < L) {
#pragma unroll
        for (int i = 0; i < 8; ++i) {
          const int t = ty * 8 + i;
          const float bb = p.cm_b()[(l * 4 + g) * 128 + t];
          const size_t tg = (size_t)(token0 + t);
          float4 a4 = *reinterpret_cast<const float4*>(s_vg + t * 64 + tx * 4);
          float4 u4 = *reinterpret_cast<const float4*>(p.P5() + tg * 1280 + 768 + g * 64 + tx * 4);
          *reinterpret_cast<uint2*>(p.xn() + tg * 1024 + 768 + g * 64 + tx * 4) =
              make_uint2(pack2(u4.x * (a4.x + bb), u4.y * (a4.y + bb)), pack2(u4.z * (a4.z + bb), u4.w * (a4.w + bb)));
        }
      }
    }
  }
}

__device__ __forceinline__ void ph_topk(const Params& p, int l, char* smem, int bid, int nblk) {
  const int tid = tid_opaque(), lane = tid & 63, w = __builtin_amdgcn_readfirstlane(tid >> 6);
  float* s_tile = reinterpret_cast<float*>(smem) + w * (64 * 33);
  int* s_list = reinterpret_cast<int*>(smem + 4 * 64 * 33 * 4) + w * (2 * 16 * 64);
  float* s_ss = reinterpret_cast<float*>(smem + 4 * 64 * 33 * 4 + 4 * 2 * 16 * 64 * 4) + w * 64;
  for (int u = bid * 4 + w; u < 264 * 8; u += nblk * 4) {
    const int tg = u >> 3, h = u & 7;
    const int t0 = tg * 64;
    {
      const float4 pp = *reinterpret_cast<const float4*>(p.ssp() + (size_t)(t0 + lane) * 32 + h * 4);
      s_ss[lane] = pp.x + pp.y + pp.z + pp.w;
    }
    int L1[16], L2[16];
#pragma unroll
    for (int j = 0; j < 16; ++j) { L1[j] = (int)0x80000000; L2[j] = (int)0x80000000; }
#pragma unroll
    for (int c = 0; c < 2; ++c) {
      const int4* la = reinterpret_cast<const int4*>(p.tl() + (((size_t)(t0 + lane) * 16 + h * 2 + c) * 2) * 16);
      int A[16], B[16];
#pragma unroll
      for (int q = 0; q < 4; ++q) {
        const int4 a = la[q], b = la[4 + q];
        A[4 * q] = a.x; A[4 * q + 1] = a.y; A[4 * q + 2] = a.z; A[4 * q + 3] = a.w;
        B[4 * q] = b.x; B[4 * q + 1] = b.y; B[4 * q + 2] = b.z; B[4 * q + 3] = b.w;
      }
#pragma unroll
      for (int j = 0; j < 16; ++j) INS16(A, B[j])
#pragma unroll
      for (int j = 0; j < 16; ++j) { if (c == 0) L1[j] = A[j]; else L2[j] = A[j]; }
    }
#pragma unroll
    for (int j = 0; j < 16; ++j) { s_list[(0 * 16 + j) * 64 + lane] = 127 - (L1[j] & 127); s_list[(1 * 16 + j) * 64 + lane] = 127 - (L2[j] & 127); }
    float v1[16], v2[16];
#pragma unroll
    for (int j = 0; j < 16; ++j) { v1[j] = mono_val(L1[j] & ~127); v2[j] = mono_val(L2[j] & ~127); }
    int LC[16];
#pragma unroll
    for (int j = 0; j < 16; ++j) LC[j] = (int)0x80000000;
#pragma unroll
    for (int i = 0; i < 16; ++i)
#pragma unroll
      for (int j = 0; j < 16; ++j)
        if ((i + 1) * (j + 1) <= 16) {
          int key = (mono_key(v1[i] + v2[j]) & ~255) | (255 - (i * 16 + j));
          INS16(LC, key)
        }
    const float scale = rsqrtf(s_ss[lane] * (1.f / 256.f) + EPS);
    float vs[16]; float den = 0.f;
    const float top = mono_val(LC[0] & ~255);
#pragma unroll
    for (int k = 0; k < 16; ++k) { vs[k] = __expf((mono_val(LC[k] & ~255) - top) * scale); den += vs[k]; }
    const float inv = 1.f / den;
    const size_t ob = (size_t)(t0 + lane) * 128 + h * 16;
#pragma unroll
    for (int k4 = 0; k4 < 4; ++k4) {
      int ee[4]; float gg[4], su[4];
#pragma unroll
      for (int q = 0; q < 4; ++q) {
        int k = k4 * 4 + q;
        int ci = 255 - (LC[k] & 255);
        int i1 = s_list[(0 * 16 + (ci >> 4)) * 64 + lane];
        int i2 = s_list[(1 * 16 + (ci & 15)) * 64 + lane];
        ee[q] = i1 * 128 + i2;
        gg[q] = vs[k] * inv * p.vs()[l * 16384 + ee[q]];
        su[q] = p.us()[l * 16384 + ee[q]];
      }
      *reinterpret_cast<int4*>(p.eidx() + ob + k4 * 4) = make_int4(ee[0], ee[1], ee[2], ee[3]);
      *reinterpret_cast<float4*>(p.egate() + ob + k4 * 4) = make_float4(gg[0], gg[1], gg[2], gg[3]);
      *reinterpret_cast<float4*>(p.esu() + ob + k4 * 4) = make_float4(su[0], su[1], su[2], su[3]);
    }
  }
}

__device__ __forceinline__ float dot16_fp8(const float* xf, uint4 u) {
  f32x2 a0 = __builtin_amdgcn_cvt_pk_f32_fp8(u.x, false), a1 = __builtin_amdgcn_cvt_pk_f32_fp8(u.x, true);
  f32x2 a2 = __builtin_amdgcn_cvt_pk_f32_fp8(u.y, false), a3 = __builtin_amdgcn_cvt_pk_f32_fp8(u.y, true);
  f32x2 a4 = __builtin_amdgcn_cvt_pk_f32_fp8(u.z, false), a5 = __builtin_amdgcn_cvt_pk_f32_fp8(u.z, true);
  f32x2 a6 = __builtin_amdgcn_cvt_pk_f32_fp8(u.w, false), a7 = __builtin_amdgcn_cvt_pk_f32_fp8(u.w, true);
  float s0 = xf[0] * a0.x, s1 = xf[1] * a0.y;
  s0 = fmaf(xf[2], a1.x, s0); s1 = fmaf(xf[3], a1.y, s1);
  s0 = fmaf(xf[4], a2.x, s0); s1 = fmaf(xf[5], a2.y, s1);
  s0 = fmaf(xf[6], a3.x, s0); s1 = fmaf(xf[7], a3.y, s1);
  s0 = fmaf(xf[8], a4.x, s0); s1 = fmaf(xf[9], a4.y, s1);
  s0 = fmaf(xf[10], a5.x, s0); s1 = fmaf(xf[11], a5.y, s1);
  s0 = fmaf(xf[12], a6.x, s0); s1 = fmaf(xf[13], a6.y, s1);
  s0 = fmaf(xf[14], a7.x, s0); s1 = fmaf(xf[15], a7.y, s1);
  return s0 + s1;
}
__device__ __forceinline__ void axpy16_fp8(float* y, float wgt, uint4 v) {
  f32x2 a0 = __builtin_amdgcn_cvt_pk_f32_fp8(v.x, false), a1 = __builtin_amdgcn_cvt_pk_f32_fp8(v.x, true);
  f32x2 a2 = __builtin_amdgcn_cvt_pk_f32_fp8(v.y, false), a3 = __builtin_amdgcn_cvt_pk_f32_fp8(v.y, true);
  f32x2 a4 = __builtin_amdgcn_cvt_pk_f32_fp8(v.z, false), a5 = __builtin_amdgcn_cvt_pk_f32_fp8(v.z, true);
  f32x2 a6 = __builtin_amdgcn_cvt_pk_f32_fp8(v.w, false), a7 = __builtin_amdgcn_cvt_pk_f32_fp8(v.w, true);
  y[0] = fmaf(wgt, a0.x, y[0]); y[1] = fmaf(wgt, a0.y, y[1]); y[2] = fmaf(wgt, a1.x, y[2]); y[3] = fmaf(wgt, a1.y, y[3]);
  y[4] = fmaf(wgt, a2.x, y[4]); y[5] = fmaf(wgt, a2.y, y[5]); y[6] = fmaf(wgt, a3.x, y[6]); y[7] = fmaf(wgt, a3.y, y[7]);
  y[8] = fmaf(wgt, a4.x, y[8]); y[9] = fmaf(wgt, a4.y, y[9]); y[10] = fmaf(wgt, a5.x, y[10]); y[11] = fmaf(wgt, a5.y, y[11]);
  y[12] = fmaf(wgt, a6.x, y[12]); y[13] = fmaf(wgt, a6.y, y[13]); y[14] = fmaf(wgt, a7.x, y[14]); y[15] = fmaf(wgt, a7.y, y[15]);
}

template <bool DRY>
__device__ __forceinline__ void ph_gather(const Params& p, int l, int bid, int nblk) {
  const int lane = tid_opaque() & 63, w = __builtin_amdgcn_readfirstlane(tid_opaque() >> 6);
  const unsigned char* u8 = p.ub8() + (size_t)l * 16384 * 1024;
  const unsigned char* v8 = p.vb8() + (size_t)l * 16384 * 1024;
  const unsigned loff = (unsigned)lane * 16u;
  for (int t = bid * 4 + w; t < NTOK; t += nblk * 4) {
    float xf[16];
    {
      const uint4 xa = *reinterpret_cast<const uint4*>(p.xn() + (size_t)t * 1024 + lane * 16);
      const uint4 xb = *reinterpret_cast<const uint4*>(p.xn() + (size_t)t * 1024 + lane * 16 + 8);
      xf[0] = bf_lo(xa.x); xf[1] = bf_hi(xa.x); xf[2] = bf_lo(xa.y); xf[3] = bf_hi(xa.y);
      xf[4] = bf_lo(xa.z); xf[5] = bf_hi(xa.z); xf[6] = bf_lo(xa.w); xf[7] = bf_hi(xa.w);
      xf[8] = bf_lo(xb.x); xf[9] = bf_hi(xb.x); xf[10] = bf_lo(xb.y); xf[11] = bf_hi(xb.y);
      xf[12] = bf_lo(xb.z); xf[13] = bf_hi(xb.z); xf[14] = bf_lo(xb.w); xf[15] = bf_hi(xb.w);
    }
    const int e_lo = p.eidx()[(size_t)t * 128 + lane], e_hi = p.eidx()[(size_t)t * 128 + 64 + lane];
    const float g_lo = p.egate()[(size_t)t * 128 + lane], g_hi = p.egate()[(size_t)t * 128 + 64 + lane];
    const float s_lo = p.esu()[(size_t)t * 128 + lane], s_hi = p.esu()[(size_t)t * 128 + 64 + lane];
    float y[16];
#pragma unroll
    for (int i = 0; i < 16; ++i) y[i] = 0.f;
#pragma unroll 1
    for (int k0 = 0; k0 < 128; k0 += 8) {
      uint4 ur[8], vr[8];
#pragma unroll
      for (int q = 0; q < 8; ++q) {
        const int kk = (k0 & 63) + q;
        const int e = (k0 < 64) ? __builtin_amdgcn_readlane(e_lo, kk) : __builtin_amdgcn_readlane(e_hi, kk);
        ur[q] = *reinterpret_cast<const uint4*>(u8 + (size_t)e * 1024 + loff);
        vr[q] = *reinterpret_cast<const uint4*>(v8 + (size_t)e * 1024 + loff);
      }
#pragma unroll
      for (int q = 0; q < 8; ++q) {
        const int kk = (k0 & 63) + q;
        const float gt = __int_as_float((k0 < 64) ? __builtin_amdgcn_readlane(__float_as_int(g_lo), kk) : __builtin_amdgcn_readlane(__float_as_int(g_hi), kk));
        const float su = __int_as_float((k0 < 64) ? __builtin_amdgcn_readlane(__float_as_int(s_lo), kk) : __builtin_amdgcn_readlane(__float_as_int(s_hi), kk));
        float d = wave_sum(dot16_fp8(xf, ur[q])) * su;
        const float wgt = gt * gelu_exact(d);
        axpy16_fp8(y, wgt, vr[q]);
      }
    }
    if (DRY) {
#pragma unroll
      for (int i = 0; i < 16; ++i) asm volatile("" ::"v"(y[i]));
      continue;
    }
    float* xr = p.x() + (size_t)t * 1024 + lane * 16;
#pragma unroll
    for (int j = 0; j < 4; ++j) {
      float4 a = reinterpret_cast<float4*>(xr)[j];
      a.x += y[4 * j]; a.y += y[4 * j + 1]; a.z += y[4 * j + 2]; a.w += y[4 * j + 3];
      reinterpret_cast<float4*>(xr)[j] = a;
    }
  }
}

enum { PH_PREP = 0, PH_NORM1, PH_GEMM_IN, PH_ATTN, PH_MLCONV, PH_MCHAIN, PH_MLU, PH_MLSCAN, PH_MLOUT, PH_CMLP,
       PH_GEMM_OUT, PH_NORM2, PH_GEMM_PQ, PH_GEMM_SC, PH_TOPK, PH_GATHER, PH_FINAL };

__device__ __forceinline__ Params phase_params(const Params& kp, bool with_inputs, bool with_tables = false) {
  Params q;
  size_t z = 0;
  asm volatile("" : "+s"(z));
  q.out = kp.out + z;
  q.ws = kp.ws + z;
  q.in[0] = kp.in[0] + z;
  q.in[1] = kp.in[1] + z;
  if (with_inputs) {
#pragma unroll
    for (int i = 2; i < 30; ++i) q.in[i] = kp.in[i] + z;
  }
  if (with_tables) { q.in[27] = kp.in[27] + z; q.in[28] = kp.in[28] + z; }
  return q;
}


#define GT 4
typedef __attribute__((ext_vector_type(4))) float f32x4;

__device__ __forceinline__ float dot16_fp8v(const f32x2* x2, uint4 u) {
  f32x2 acc = x2[0] * __builtin_amdgcn_cvt_pk_f32_fp8(u.x, false);
  acc += x2[1] * __builtin_amdgcn_cvt_pk_f32_fp8(u.x, true);
  acc += x2[2] * __builtin_amdgcn_cvt_pk_f32_fp8(u.y, false);
  acc += x2[3] * __builtin_amdgcn_cvt_pk_f32_fp8(u.y, true);
  acc += x2[4] * __builtin_amdgcn_cvt_pk_f32_fp8(u.z, false);
  acc += x2[5] * __builtin_amdgcn_cvt_pk_f32_fp8(u.z, true);
  acc += x2[6] * __builtin_amdgcn_cvt_pk_f32_fp8(u.w, false);
  acc += x2[7] * __builtin_amdgcn_cvt_pk_f32_fp8(u.w, true);
  return acc.x + acc.y;
}
__device__ __forceinline__ void axpy16_fp8v(f32x2* y2, float wgt, uint4 v) {
  const f32x2 w2 = {wgt, wgt};
  y2[0] += w2 * __builtin_amdgcn_cvt_pk_f32_fp8(v.x, false);
  y2[1] += w2 * __builtin_amdgcn_cvt_pk_f32_fp8(v.x, true);
  y2[2] += w2 * __builtin_amdgcn_cvt_pk_f32_fp8(v.y, false);
  y2[3] += w2 * __builtin_amdgcn_cvt_pk_f32_fp8(v.y, true);
  y2[4] += w2 * __builtin_amdgcn_cvt_pk_f32_fp8(v.z, false);
  y2[5] += w2 * __builtin_amdgcn_cvt_pk_f32_fp8(v.z, true);
  y2[6] += w2 * __builtin_amdgcn_cvt_pk_f32_fp8(v.w, false);
  y2[7] += w2 * __builtin_amdgcn_cvt_pk_f32_fp8(v.w, true);
}

struct GU { uint4 ur[4]; f32x4 su; };
struct GV { uint4 vr[4]; f32x4 gt; };
#define GREC 384
__device__ __forceinline__ void gload_u(GU& U, const float* rec, int i4, const unsigned char* u8, unsigned loff) {
  const f32x4 ev = *reinterpret_cast<const f32x4*>(rec + i4);
  U.su = *reinterpret_cast<const f32x4*>(rec + 256 + i4);
  const int e0 = __builtin_amdgcn_readfirstlane(__float_as_int(ev.x)), e1 = __builtin_amdgcn_readfirstlane(__float_as_int(ev.y));
  const int e2 = __builtin_amdgcn_readfirstlane(__float_as_int(ev.z)), e3 = __builtin_amdgcn_readfirstlane(__float_as_int(ev.w));
  U.ur[0] = *reinterpret_cast<const uint4*>(u8 + (size_t)e0 * 1024 + loff);
  U.ur[1] = *reinterpret_cast<const uint4*>(u8 + (size_t)e1 * 1024 + loff);
  U.ur[2] = *reinterpret_cast<const uint4*>(u8 + (size_t)e2 * 1024 + loff);
  U.ur[3] = *reinterpret_cast<const uint4*>(u8 + (size_t)e3 * 1024 + loff);
}
__device__ __forceinline__ void gload_v(GV& V, const float* rec, int i4, const unsigned char* v8, unsigned loff) {
  const f32x4 ev = *reinterpret_cast<const f32x4*>(rec + i4);
  V.gt = *reinterpret_cast<const f32x4*>(rec + 128 + i4);
  const int e0 = __builtin_amdgcn_readfirstlane(__float_as_int(ev.x)), e1 = __builtin_amdgcn_readfirstlane(__float_as_int(ev.y));
  const int e2 = __builtin_amdgcn_readfirstlane(__float_as_int(ev.z)), e3 = __builtin_amdgcn_readfirstlane(__float_as_int(ev.w));
  V.vr[0] = *reinterpret_cast<const uint4*>(v8 + (size_t)e0 * 1024 + loff);
  V.vr[1] = *reinterpret_cast<const uint4*>(v8 + (size_t)e1 * 1024 + loff);
  V.vr[2] = *reinterpret_cast<const uint4*>(v8 + (size_t)e2 * 1024 + loff);
  V.vr[3] = *reinterpret_cast<const uint4*>(v8 + (size_t)e3 * 1024 + loff);
}
template <int PAT>
__device__ __forceinline__ float swz_f(float v) { return __int_as_float(__builtin_amdgcn_ds_swizzle(__float_as_int(v), PAT)); }

__device__ __forceinline__ void gstep2(GU& UA, GV& VA, GU& UB, GV& VB, const uint4* xlA, const uint4* xlB, f32x2* yA, f32x2* yB,
                                       const float* recA, const float* recB, int ci4, const float* nxtA, const float* nxtB, int ni4,
                                       const unsigned char* u8, const unsigned char* v8, unsigned loff, int lane) {
  float d[8];
  {
    f32x2 x2[8];
    const uint4 xa = xlA[0], xb = xlA[1];
    x2[0] = f32x2{bf_lo(xa.x), bf_hi(xa.x)}; x2[1] = f32x2{bf_lo(xa.y), bf_hi(xa.y)};
    x2[2] = f32x2{bf_lo(xa.z), bf_hi(xa.z)}; x2[3] = f32x2{bf_lo(xa.w), bf_hi(xa.w)};
    x2[4] = f32x2{bf_lo(xb.x), bf_hi(xb.x)}; x2[5] = f32x2{bf_lo(xb.y), bf_hi(xb.y)};
    x2[6] = f32x2{bf_lo(xb.z), bf_hi(xb.z)}; x2[7] = f32x2{bf_lo(xb.w), bf_hi(xb.w)};
#pragma unroll
    for (int q = 0; q < 4; ++q) d[q] = dot16_fp8v(x2, UA.ur[q]);
  }
  gload_u(UA, nxtA, ni4, u8, loff);
  {
    f32x2 x2[8];
    const uint4 xa = xlB[0], xb = xlB[1];
    x2[0] = f32x2{bf_lo(xa.x), bf_hi(xa.x)}; x2[1] = f32x2{bf_lo(xa.y), bf_hi(xa.y)};
    x2[2] = f32x2{bf_lo(xa.z), bf_hi(xa.z)}; x2[3] = f32x2{bf_lo(xa.w), bf_hi(xa.w)};
    x2[4] = f32x2{bf_lo(xb.x), bf_hi(xb.x)}; x2[5] = f32x2{bf_lo(xb.y), bf_hi(xb.y)};
    x2[6] = f32x2{bf_lo(xb.z), bf_hi(xb.z)}; x2[7] = f32x2{bf_lo(xb.w), bf_hi(xb.w)};
#pragma unroll
    for (int q = 0; q < 4; ++q) d[4 + q] = dot16_fp8v(x2, UB.ur[q]);
  }
  gload_u(UB, nxtB, ni4, u8, loff);
  const bool b0 = lane & 1, b1 = lane & 2, b2 = lane & 4;
  float a[4];
#pragma unroll
  for (int j = 0; j < 4; ++j) {
    const float keep = b0 ? d[4 + j] : d[j], send = b0 ? d[j] : d[4 + j];
    a[j] = keep + dpp_f<0xB1>(send);
  }
  float c2[2];
#pragma unroll
  for (int j = 0; j < 2; ++j) {
    const float keep = b1 ? a[2 + j] : a[j], send = b1 ? a[j] : a[2 + j];
    c2[j] = keep + dpp_f<0x4E>(send);
  }
  float tot;
  {
    const float keep = b2 ? c2[1] : c2[0], send = b2 ? c2[0] : c2[1];
    tot = keep + swz_f<0x101F>(send);
  }
  tot += swz_f<0x201F>(tot);
  tot = swap32_sum(swap16_sum(tot));
  const int pq = ((lane >> 1) & 1) * 2 + ((lane >> 2) & 1);
  const float* rl = (b0 ? recB : recA) + ci4 + pq;
  const float z = tot * rl[256];
  const float wv = rl[128] * gelu_as(z);
#pragma unroll
  for (int q = 0; q < 4; ++q) {
    const int ln = ((q >> 1) & 1) * 2 + (q & 1) * 4;
    const float wa = __int_as_float(__builtin_amdgcn_readlane(__float_as_int(wv), ln));
    const float wb = __int_as_float(__builtin_amdgcn_readlane(__float_as_int(wv), ln + 1));
    axpy16_fp8v(yA, wa, VA.vr[q]);
    axpy16_fp8v(yB, wb, VB.vr[q]);
  }
  gload_v(VA, nxtA, ni4, v8, loff);
  gload_v(VB, nxtB, ni4, v8, loff);
}

__device__ __forceinline__ void gstep(GU& U, GV& V, const uint4* xl, f32x2* y2, const float* nrec, int ni4,
                                      const unsigned char* u8, const unsigned char* v8, unsigned loff, int lane) {
  f32x2 x2[8];
  {
    const uint4 xa = xl[0], xb = xl[1];
    x2[0] = f32x2{bf_lo(xa.x), bf_hi(xa.x)}; x2[1] = f32x2{bf_lo(xa.y), bf_hi(xa.y)};
    x2[2] = f32x2{bf_lo(xa.z), bf_hi(xa.z)}; x2[3] = f32x2{bf_lo(xa.w), bf_hi(xa.w)};
    x2[4] = f32x2{bf_lo(xb.x), bf_hi(xb.x)}; x2[5] = f32x2{bf_lo(xb.y), bf_hi(xb.y)};
    x2[6] = f32x2{bf_lo(xb.z), bf_hi(xb.z)}; x2[7] = f32x2{bf_lo(xb.w), bf_hi(xb.w)};
  }
  float d[4], su[4];
#pragma unroll
  for (int q = 0; q < 4; ++q) { d[q] = dot16_fp8v(x2, U.ur[q]); su[q] = U.su[q]; }
  gload_u(U, nrec, ni4, u8, loff);
#pragma unroll
  for (int q = 0; q < 4; ++q) d[q] = wave_sum(d[q]) * su[q];
  float dv = d[0]; dv = (lane == 1) ? d[1] : dv; dv = (lane == 2) ? d[2] : dv; dv = (lane == 3) ? d[3] : dv;
  const float av = gelu_as(dv);
#pragma unroll
  for (int q = 0; q < 4; ++q) {
    const float act = __int_as_float(__builtin_amdgcn_readlane(__float_as_int(av), q));
    axpy16_fp8v(y2, V.gt[q] * act, V.vr[q]);
  }
  gload_v(V, nrec, ni4, v8, loff);
}

__device__ __forceinline__ void gsort_token(const Params& p, int t, float* rec, int lane) {
  const int e0 = p.eidx()[(size_t)t * 128 + lane], e1 = p.eidx()[(size_t)t * 128 + 64 + lane];
  const float g0 = p.egate()[(size_t)t * 128 + lane], g1 = p.egate()[(size_t)t * 128 + 64 + lane];
  const float q0 = p.esu()[(size_t)t * 128 + lane], q1 = p.esu()[(size_t)t * 128 + 64 + lane];
  int base = 0;
#pragma unroll 4
  for (int s = 0; s < 16; ++s) {
    const unsigned long long m0 = __ballot((e0 >> 10) == s), m1 = __ballot((e1 >> 10) == s);
    const int c0 = __popcll(m0), c1 = __popcll(m1);
    const int p0 = base + (int)__builtin_amdgcn_mbcnt_hi((unsigned)(m0 >> 32), __builtin_amdgcn_mbcnt_lo((unsigned)m0, 0));
    const int p1 = base + c0 + (int)__builtin_amdgcn_mbcnt_hi((unsigned)(m1 >> 32), __builtin_amdgcn_mbcnt_lo((unsigned)m1, 0));
    if ((e0 >> 10) == s) { rec[p0] = __int_as_float(e0); rec[128 + p0] = g0; rec[256 + p0] = q0; }
    if ((e1 >> 10) == s) { rec[p1] = __int_as_float(e1); rec[128 + p1] = g1; rec[256 + p1] = q1; }
    base += c0 + c1;
  }
}
__device__ __forceinline__ void gload_x(const Params& p, int t, uint4* xl, int lane) {
  xl[0] = *reinterpret_cast<const uint4*>(p.xn() + (size_t)t * 1024 + lane * 16);
  xl[1] = *reinterpret_cast<const uint4*>(p.xn() + (size_t)t * 1024 + lane * 16 + 8);
}
template <bool LAST>
__device__ __forceinline__ void gstore_x(const Params& p, int l, int t, const f32x2* y2, int lane) {
  float* xr = p.x() + (size_t)t * 1024 + lane * 16;
  float4 a[4];
  float ss = 0.f;
#pragma unroll
  for (int j = 0; j < 4; ++j) {
    a[j] = reinterpret_cast<float4*>(xr)[j];
    a[j].x += y2[2 * j].x; a[j].y += y2[2 * j].y; a[j].z += y2[2 * j + 1].x; a[j].w += y2[2 * j + 1].y;
    ss += a[j].x * a[j].x + a[j].y * a[j].y + a[j].z * a[j].z + a[j].w * a[j].w;
  }
  ss = wave_sum(ss);
  const float r = rsqrtf(ss * (1.f / 1024.f) + EPS);
  if (LAST) {
    const float* g = p.final_g() + lane * 16;
    float* o = ((t < NPROMPT) ? p.out + O_Y_P + (size_t)t * 1024 : p.out + O_Y_S + (size_t)(t - NPROMPT) * 1024) + lane * 16;
#pragma unroll
    for (int j = 0; j < 4; ++j) {
      const float4 gv = reinterpret_cast<const float4*>(g)[j];
      reinterpret_cast<float4*>(o)[j] = make_float4(a[j].x * r * gv.x, a[j].y * r * gv.y, a[j].z * r * gv.z, a[j].w * r * gv.w);
    }
  } else {
    const float* g = p.norm1_g() + (l + 1) * 1024 + lane * 16;
#pragma unroll
    for (int j = 0; j < 4; ++j) {
      reinterpret_cast<float4*>(xr)[j] = a[j];
      const float4 gv = reinterpret_cast<const float4*>(g)[j];
      a[j].x *= r * gv.x; a[j].y *= r * gv.y; a[j].z *= r * gv.z; a[j].w *= r * gv.w;
    }
    uint4* o = reinterpret_cast<uint4*>(p.xn() + (size_t)t * 1024 + lane * 16);
    o[0] = make_uint4(pack2(a[0].x, a[0].y), pack2(a[0].z, a[0].w), pack2(a[1].x, a[1].y), pack2(a[1].z, a[1].w));
    o[1] = make_uint4(pack2(a[2].x, a[2].y), pack2(a[2].z, a[2].w), pack2(a[3].x, a[3].y), pack2(a[3].z, a[3].w));
    float pre[8];
#pragma unroll
    for (int i = 0; i < 8; ++i) {
      const float4* wr = reinterpret_cast<const float4*>(p.wg() + ((size_t)(l + 1) * 8 + i) * 1024 + lane * 16);
      float s = 0.f;
#pragma unroll
      for (int j = 0; j < 4; ++j) {
        const float4 wv = wr[j];
        s += a[j].x * wv.x + a[j].y * wv.y + a[j].z * wv.z + a[j].w * wv.w;
      }
      pre[i] = wave_sum(s);
    }
    if (lane < 4) {
      float ai = pre[0]; ai = lane == 1 ? pre[1] : ai; ai = lane == 2 ? pre[2] : ai; ai = lane == 3 ? pre[3] : ai;
      float f = pre[4]; f = lane == 1 ? pre[5] : f; f = lane == 2 ? pre[6] : f; f = lane == 3 ? pre[7] : f;
      p.ig()[(size_t)t * 4 + lane] = ai + p.ml_gate_b()[(l + 1) * 8 + lane];
      const float z = f + p.ml_gate_b()[(l + 1) * 8 + 4 + lane];
      p.lf()[(size_t)t * 4 + lane] = fminf(z, 0.f) - log1pf(expf(-fabsf(z)));
    }
  }
}

template <bool LAST>
__device__ __forceinline__ void ph_gather2(const Params& p, int l, char* smem, int bid, int nblk) {
  const int tid = tid_opaque(), lane = tid & 63, w = __builtin_amdgcn_readfirstlane(tid >> 6);
  const unsigned char* u8 = p.ub8() + (size_t)l * 16384 * 1024;
  const unsigned char* v8 = p.vb8() + (size_t)l * 16384 * 1024;
  const unsigned loff = (unsigned)lane * 16u;
  float* rec = reinterpret_cast<float*>(smem) + w * (GT * GREC);
  uint4* xl = reinterpret_cast<uint4*>(smem + 4 * GT * GREC * 4) + (w * GT * 64 + lane) * 2;
  const int rot = 0;
  const int nwaves = nblk * 4, wg = bid * 4 + w;
  const int nfull = (NTOK / (nwaves * GT)) * nwaves;
  for (int grp = wg; grp < nfull; grp += nwaves) {
    const int t0 = grp * GT;
    int lane_s = lane; asm volatile("" : "+v"(lane_s));
#pragma unroll 1
    for (int ti = 0; ti < GT; ++ti) {
      gload_x(p, t0 + ti, xl + ti * 128, lane_s);
      gsort_token(p, t0 + ti, rec + ti * GREC, lane_s);
    }
    f32x2 y2[GT][8];
#pragma unroll
    for (int ti = 0; ti < GT; ++ti)
#pragma unroll
      for (int i = 0; i < 8; ++i) y2[ti][i] = f32x2{0.f, 0.f};
    GU U0, U1; GV V0, V1;
    gload_u(U0, rec, (rot & 31) * 4, u8, loff); gload_v(V0, rec, (rot & 31) * 4, v8, loff);
    gload_u(U1, rec + GREC, (rot & 31) * 4, u8, loff); gload_v(V1, rec + GREC, (rot & 31) * 4, v8, loff);
#pragma unroll 1
    for (int b = 0; b < 32; ++b) {
      const int bo = ((b + rot) & 31) * 4, bn = ((b + 1 + rot) & 31) * 4;
      gstep2(U0, V0, U1, V1, xl, xl + 128, y2[0], y2[1], rec, rec + GREC, bo, rec + 2 * GREC, rec + 3 * GREC, bo, u8, v8, loff, lane);
      __builtin_amdgcn_sched_barrier(0);
      gstep2(U0, V0, U1, V1, xl + 256, xl + 384, y2[2], y2[3], rec + 2 * GREC, rec + 3 * GREC, bo, rec, rec + GREC, bn, u8, v8, loff, lane);
      __builtin_amdgcn_sched_barrier(0);
    }
    int lane_e = lane; asm volatile("" : "+v"(lane_e));
#pragma unroll
    for (int ti = 0; ti < GT; ++ti) gstore_x<LAST>(p, l, t0 + ti, y2[ti], lane_e);
  }
  float* ysum = reinterpret_cast<float*>(smem + 4 * GT * GREC * 4 + 4 * GT * 2048);
  for (int t = nfull * GT + bid; t < NTOK; t += nblk) {
    f32x2 y2[8];
    gload_x(p, t, xl, lane);
#pragma unroll
    for (int i = 0; i < 8; ++i) y2[i] = f32x2{0.f, 0.f};
    gsort_token(p, t, rec, lane);
    GU U; GV V;
    gload_u(U, rec, (w * 8) * 4, u8, loff);
    gload_v(V, rec, (w * 8) * 4, v8, loff);
#pragma unroll 1
    for (int b = 0; b < 8; ++b) gstep(U, V, xl, y2, rec, (w * 8 + ((b + 1) & 7)) * 4, u8, v8, loff, lane);
    __syncthreads();
#pragma unroll
    for (int i = 0; i < 8; ++i) { ysum[w * 1024 + lane * 16 + 2 * i] = y2[i].x; ysum[w * 1024 + lane * 16 + 2 * i + 1] = y2[i].y; }
    __syncthreads();
    if (w == 0) {
#pragma unroll
      for (int i = 0; i < 8; ++i) {
        y2[i].x += ysum[1024 + lane * 16 + 2 * i] + ysum[2048 + lane * 16 + 2 * i] + ysum[3072 + lane * 16 + 2 * i];
        y2[i].y += ysum[1024 + lane * 16 + 2 * i + 1] + ysum[2048 + lane * 16 + 2 * i + 1] + ysum[3072 + lane * 16 + 2 * i + 1];
      }
      gstore_x<LAST>(p, l, t, y2, lane);
    }
  }
}

#define XB_TMO      128
#define XB_XCNT(j)  (256  + 64 * (j))
#define XB_XSUB(j)  (1280 + 64 * (j))
#define XB_XGEN(j)  (2304 + 64 * (j))
#define XB_TOP      3328
#define XB_TOPGEN   3392
#define XCD_BAR_WORDS 3456
#define XB_SPIN_CAP (1u << 22)
__device__ __forceinline__ unsigned xb_ld(unsigned* p)              { return __hip_atomic_load(p, __ATOMIC_RELAXED, __HIP_MEMORY_SCOPE_AGENT); }
__device__ __forceinline__ unsigned xb_add(unsigned* p, unsigned v) { return __hip_atomic_fetch_add(p, v, __ATOMIC_RELAXED, __HIP_MEMORY_SCOPE_AGENT); }
__device__ __forceinline__ unsigned xb_xcc_id() { return (unsigned)__builtin_amdgcn_s_getreg((3 << 11) | 20) & 0xFu; }
#define XB_SPIN(cond, bar) do { unsigned _sp = 0; while (cond) { __builtin_amdgcn_s_sleep(1); \
    if ((++_sp & 255u) == 0u) { if (xb_ld(&(bar)[XB_TMO])) break; if (_sp > XB_SPIN_CAP) { atomicAdd(&(bar)[XB_TMO], 1u); break; } } } } while (0)

struct XcdBarrier { unsigned* bar; unsigned x; volatile LAS unsigned* st; };

__device__ __forceinline__ XcdBarrier xcd_barrier_post(unsigned* bar, volatile LAS unsigned* st) {
  XcdBarrier b; b.bar = bar; b.x = xb_xcc_id(); b.st = st;
  if (threadIdx.x == 0) (void)xb_add(&bar[XB_XCNT(b.x)], 1u);
  return b;
}
__device__ __forceinline__ void xcd_barrier_complete(unsigned* bar, unsigned x, unsigned& nloc, unsigned& nx) {
  const unsigned G = gridDim.x * gridDim.y * gridDim.z;
  unsigned sum, cnt, mine, sp = 0u;
  for (;;) {
    sum = 0u; cnt = 0u; mine = 0u;
#pragma unroll
    for (unsigned j = 0; j < 16; ++j) { const unsigned c = xb_ld(&bar[XB_XCNT(j)]); sum += c; cnt += (c > 0u) ? 1u : 0u; mine = (j == x) ? c : mine; }
    if (sum == G) break;
    __builtin_amdgcn_s_sleep(1);
    if ((++sp & 255u) == 0u) { if (xb_ld(&bar[XB_TMO])) break; if (sp > XB_SPIN_CAP) { atomicAdd(&bar[XB_TMO], 1u); break; } }
  }
  nloc = mine > 0u ? mine : 1u; nx = cnt > 0u ? cnt : 1u;
}
__device__ __forceinline__ void xcd_barrier(const XcdBarrier& b) {
  asm volatile("s_waitcnt vmcnt(0)" ::: "memory");
  __syncthreads();
  if (threadIdx.x == 0) {
    unsigned* bar = b.bar;
    __builtin_amdgcn_s_waitcnt(0);
    unsigned nloc = b.st[0], nx = b.st[1];
    if (nloc == 0u) { xcd_barrier_complete(bar, b.x, nloc, nx); b.st[0] = nloc; b.st[1] = nx; }
    const unsigned old = xb_add(&bar[XB_XSUB(b.x)], 1u);
    const unsigned gen = old / nloc;
    if (old + 1u == (gen + 1u) * nloc) {
      __builtin_amdgcn_fence(__ATOMIC_RELEASE, "agent");
      asm volatile("s_waitcnt vmcnt(0)" ::: "memory");
      const unsigned og = xb_add(&bar[XB_TOP], 1u);
      const unsigned tg = og / nx;
      if (og + 1u == (tg + 1u) * nx) xb_add(&bar[XB_TOPGEN], 1u);
      else XB_SPIN(xb_ld(&bar[XB_TOPGEN]) == tg, bar);
      __builtin_amdgcn_fence(__ATOMIC_ACQUIRE, "agent");
      xb_add(&bar[XB_XGEN(b.x)], 1u);
      asm volatile("s_waitcnt vmcnt(0)" ::: "memory");
    } else {
      XB_SPIN(xb_ld(&bar[XB_XGEN(b.x)]) == gen, bar);
      __builtin_amdgcn_fence(__ATOMIC_ACQUIRE, "agent");
      asm volatile("s_waitcnt vmcnt(0)" ::: "memory");
    }
  }
  __syncthreads();
}

#define GSYNC() xcd_barrier(xb)
#define PP(wi) phase_params(p, wi)
#define BN bid_opaque(bid), nblk_opaque(nblk)

template <int L>
__device__ __forceinline__ void layer_phases(const Params& p, char* smem, const XcdBarrier& xb, int bid, int nblk) {
  ph_gemm<EPI_WIN>(PP(false), L, smem, BN);
#if PROBE == 1
  GSYNC();
  ph_gemm<EPI_WIN>(PP(false), L, smem, BN);
#endif
  GSYNC();
  {
    const Params q = PP(false);
    WorkQ wq; wq.cnt = reinterpret_cast<unsigned*>(q.ws) + 8 + L; wq.slot = reinterpret_cast<volatile int*>(smem + SMEM_BYTES - 8); wq.off = 0;
    int item = ph_attn<(L == 0)>(phase_params(p, false, L == 0), L, smem, wq);
    wq.off = (L == 0) ? 528 : 0;
    item = ph_mlconv(PP(false), L, smem, wq, item);
    ph_cmlp(PP(false), L, smem, wq, item);
  }
  GSYNC();
  ph_mlU(PP(false), L, smem, BN);
#if PROBE == 9 || PROBE == 20
  GSYNC();
  ph_mlU(PP(false), L, smem, BN);
#endif
  GSYNC();
  ph_mlscan(PP(false), L, BN);
#if PROBE == 10 || PROBE == 20
  GSYNC();
  ph_mlscan(PP(false), L, BN);
#endif
  GSYNC();
  ph_mlout(PP(false), L, smem, BN);
#if PROBE == 6 || PROBE == 20
  GSYNC();
  ph_mlout(PP(false), L, smem, BN);
#endif
  GSYNC();
  ph_gemm<EPI_WOUT>(PP(false), L, smem, BN);
  GSYNC();
  ph_rmsnorm<1>(PP(false), L, BN);
  GSYNC();
  ph_gemm<EPI_PQ>(PP(false), L, smem, BN);
#if PROBE == 2
  GSYNC();
  ph_gemm<EPI_PQ>(PP(false), L, smem, BN);
#endif
  GSYNC();
  ph_topk(PP(false), L, smem, BN);
#if PROBE == 5
  GSYNC();
  ph_topk(PP(false), L, smem, BN);
#endif
  GSYNC();
  ph_gather2<(L == 1)>(PP(false), L, smem, BN);
  GSYNC();
}

__global__ void __launch_bounds__(256, 2) mega_kernel(Params p) {
  __shared__ __attribute__((aligned(16))) char smem[SMEM_BYTES];
  __shared__ uint4 xb_words;
  cg::grid_group grid = cg::this_grid();
  const int bid = blockIdx.x, nblk = gridDim.x;
  if (threadIdx.x == 0) xb_words = make_uint4(0u, 0u, 0u, 0u);
  __syncthreads();
  XcdBarrier xb = xcd_barrier_post(reinterpret_cast<unsigned*>(p.ws), (volatile LAS unsigned*)&xb_words);
  grid.sync();
  ph_prep(PP(true), smem, BN);
  ph_norm1_l0(PP(true), smem, BN);
#if PROBE == 12
  GSYNC();
  ph_prep(PP(true), smem, BN);
#endif
  GSYNC();
  layer_phases<0>(p, smem, xb, bid, nblk);
  layer_phases<1>(p, smem, xb, bid, nblk);
}

static inline size_t align_up(size_t v, size_t a) { return (v + a - 1) / a * a; }

extern "C" void kernel_launch(void* const* d_in, const int* in_sizes, int n_in, void* d_out, int out_size, void* d_ws,
                              size_t ws_size, hipStream_t stream) {
  Params p{};
  for (int i = 0; i < 30; ++i) p.in[i] = reinterpret_cast<const float*>(d_in[i]);
  p.out = reinterpret_cast<float*>(d_out);
  p.ws = reinterpret_cast<char*>(d_ws);
  if (WS_NEED > ws_size) { fprintf(stderr, "workspace too small: need %zu have %zu\n", (size_t)WS_NEED, ws_size); return; }
  static int grid_blocks = 0;
  if (!grid_blocks) {
    int dev = 0, cus = 0, per_cu = 0;
    hipGetDevice(&dev);
    hipDeviceGetAttribute(&cus, hipDeviceAttributeMultiprocessorCount, dev);
    hipOccupancyMaxActiveBlocksPerMultiprocessor(&per_cu, mega_kernel, 256, 0);
    if (per_cu > 2) per_cu = 2;
    if (per_cu < 1) per_cu = 1;
    grid_blocks = cus * per_cu;
  }
  hipMemsetAsync(d_ws, 0, 16384, stream);
  void* args[] = {&p};
  hipError_t e = hipLaunchCooperativeKernel((void*)mega_kernel, dim3(grid_blocks), dim3(256), args, 0, stream);
  if (e != hipSuccess) fprintf(stderr, "cooperative launch failed: %s (grid %d)\n", hipGetErrorString(e), grid_blocks);
}
```
